# Optimizing an MI355X kernel written in HIP

```python
import jax, jax.numpy as jnp
from jax import lax
import numpy as np


D_MODEL = 1024
BATCH = 4
SEQ = 8192
DEPTH = 1

CHUNK = 64
LN_EPS = 1e-5
ALPHA = (2.0 * DEPTH) ** 0.25
BETA = (8.0 * DEPTH) ** -0.25

A_HEAD = 64
A_WIDTH = D_MODEL // 2
A_HEADS = A_WIDTH // A_HEAD
A_DECAY_LORA = 64
A_ICLR_LORA = 64
A_GATE_LORA = 128
A_GN_EPS = 64e-5
A_IN = 3 * A_WIDTH + A_DECAY_LORA + A_ICLR_LORA + A_GATE_LORA
A_SPLITS = (A_WIDTH, 2 * A_WIDTH, 3 * A_WIDTH, 3 * A_WIDTH + A_DECAY_LORA,
            3 * A_WIDTH + A_DECAY_LORA + A_ICLR_LORA)

B_WIDTH = D_MODEL // 2
B_HEADS = 4
B_DV = B_WIDTH // B_HEADS
B_DK = B_DV // 2
B_WIDTH_K = B_HEADS * B_DK
B_GATE_LORA = 16
B_GATE_NORM = 16.0
B_CONV = 4
B_RMS_EPS = 1e-5
B_QKV = 2 * B_WIDTH_K + B_WIDTH
B_IN = B_QKV + B_GATE_LORA + B_WIDTH
B_SPLITS = (B_QKV, B_QKV + B_GATE_LORA)

D_MIX = A_WIDTH + B_WIDTH
IN_COLS = A_IN + B_IN

P_HEADS = 8
P_KEYS = 128
P_EXPERTS = P_KEYS * P_KEYS
P_HALF = 128
P_TOPK = 16
P_TOKEN_BLOCK = 128

kernel_name = "hymba_rwkv7_gla_peer_deepnorm"


def layer_norm(x, g, b):
    xf = x.astype(jnp.float32)
    mu = jnp.mean(xf, axis=-1, keepdims=True)
    var = jnp.mean(jnp.square(xf - mu), axis=-1, keepdims=True)
    return ((xf - mu) * lax.rsqrt(var + LN_EPS) * g + b).astype(x.dtype)


def token_shift(p, mu):
    prev = jnp.pad(p, ((0, 0), (1, 0), (0, 0)))[:, :-1]
    return p + (prev - p) * mu


def causal_conv(p, w):
    T = p.shape[1]
    pad = jnp.pad(p, ((0, 0), (B_CONV - 1, 0), (0, 0)))
    return sum(w[j] * pad[:, j:j + T] for j in range(B_CONV))


def rwkv7_scan(r, decay, k, v, kk, b):
    Bn, _, H, N = r.shape

    def step(S, inp):
        r_t, w_t, k_t, v_t, kk_t, b_t = inp
        sa = jnp.einsum('bhvk,bhk->bhv', S, -kk_t)
        S = S * w_t[:, :, None, :] + sa[..., None] * b_t[:, :, None, :] + v_t[..., None] * k_t[:, :, None, :]
        return S, jnp.einsum('bhvk,bhk->bhv', S, r_t)

    xs = tuple(jnp.moveaxis(t, 1, 0) for t in (r, decay, k, v, kk, b))
    S0 = jnp.zeros((Bn, H, N, N), jnp.float32)
    _, y = lax.scan(step, S0, xs)
    return jnp.moveaxis(y, 0, 1)


def rwkv7_group(p, mu, w0, w2, a0, a2, g2, k_k, k_a, r_k, gn_g, gn_b):
    Bn, T, _ = p.shape
    p = token_shift(p, mu)
    r, k, v, wd, ad, gd = jnp.split(p, A_SPLITS, axis=-1)
    w = -jax.nn.softplus(-(w0 + jnp.tanh(wd) @ w2)) - 0.5
    a = jax.nn.sigmoid(a0 + ad @ a2)
    g = jax.nn.sigmoid(gd) @ g2

    def hd(t):
        return t.astype(jnp.float32).reshape(Bn, T, A_HEADS, A_HEAD)

    kk = hd(k * k_k)
    kk = kk / jnp.maximum(jnp.sqrt(jnp.sum(kk * kk, axis=-1, keepdims=True)), 1e-12)
    a_h = hd(a)
    k_h = hd(k * (1 + (a - 1) * k_a))
    r_h, v_h = hd(r), hd(v)
    decay = jnp.exp(-jnp.exp(hd(w)))
    y = rwkv7_scan(r_h, decay, k_h, v_h, kk, kk * a_h)
    mean = jnp.mean(y, axis=-1, keepdims=True)
    var = jnp.mean(jnp.square(y - mean), axis=-1, keepdims=True)
    y = ((y - mean) * lax.rsqrt(var + A_GN_EPS)).reshape(Bn, T, A_WIDTH) * gn_g + gn_b
    bonus = jnp.sum(r_h * k_h * r_k, axis=-1, keepdims=True) * v_h
    y = y + bonus.reshape(Bn, T, A_WIDTH)
    return (y * g).astype(p.dtype)


def gla_chunked(q, k, v, gk):
    Bn, T, H, DK = q.shape
    n = T // CHUNK

    def to_chunks(t):
        return jnp.moveaxis(t.reshape(Bn, n, CHUNK, H, t.shape[-1]), 1, 0)

    causal = jnp.tril(jnp.ones((CHUNK, CHUNK), bool))[None, :, :, None, None]

    def step(S, inp):
        qc, kc, vc, gc = inp
        G = jnp.cumsum(gc, axis=1)
        o_inter = jnp.einsum('bihd,bhdv->bihv', qc * jnp.exp(G), S)
        diff = G[:, :, None] - G[:, None]
        dec = jnp.exp(jnp.where(causal, diff, -jnp.inf))
        A = jnp.einsum('bihd,bjhd,bijhd->bhij', qc, kc, dec)
        o_intra = jnp.einsum('bhij,bjhv->bihv', A, vc)
        G_last = G[:, -1]
        k_dec = kc * jnp.exp(G_last[:, None] - G)
        S = S * jnp.exp(G_last)[..., None] + jnp.einsum('bjhd,bjhv->bhdv', k_dec, vc)
        return S, o_inter + o_intra

    S0 = jnp.zeros((Bn, H, DK, v.shape[-1]), jnp.float32)
    _, o = lax.scan(step, S0, (to_chunks(q), to_chunks(k), to_chunks(v), to_chunks(gk)))
    return jnp.moveaxis(o, 0, 1).reshape(Bn, T, H, v.shape[-1])


def gla_group(p, conv_w, gk_w2, gk_b, norm_g):
    Bn, T, _ = p.shape
    qkv, gkd, g = jnp.split(p, B_SPLITS, axis=-1)
    qkv = jax.nn.silu(causal_conv(qkv, conv_w))
    q, k, v = jnp.split(qkv, (B_WIDTH_K, 2 * B_WIDTH_K), axis=-1)
    gk = jax.nn.log_sigmoid((gkd @ gk_w2 + gk_b).astype(jnp.float32)) / B_GATE_NORM

    def hd(t, d):
        return t.astype(jnp.float32).reshape(Bn, T, B_HEADS, d)

    o = gla_chunked(hd(q, B_DK) * (B_DK ** -0.5), hd(k, B_DK), hd(v, B_DV), hd(gk, B_DK))
    o = o * lax.rsqrt(jnp.mean(o * o, axis=-1, keepdims=True) + B_RMS_EPS) * norm_g
    o = o * jax.nn.silu(hd(g, B_DV))
    return o.reshape(Bn, T, B_WIDTH).astype(p.dtype)


def peer(h, w_q, sub_keys, u_tab, v_tab):
    Bn, T, D = h.shape
    n_tok = Bn * T
    tok = h.reshape(n_tok, D)
    q = (tok @ w_q).reshape(n_tok, P_HEADS, 2, P_HALF).astype(jnp.float32)
    s = jnp.einsum('nhpc,hpkc->nhpk', q, sub_keys.astype(jnp.float32))
    sv, si = lax.top_k(s, P_TOPK)
    cand = sv[:, :, 0, :, None] + sv[:, :, 1, None, :]
    cv, ci = lax.top_k(cand.reshape(n_tok, P_HEADS, P_TOPK * P_TOPK), P_TOPK)
    e1 = jnp.take_along_axis(si[:, :, 0], ci // P_TOPK, axis=-1)
    e2 = jnp.take_along_axis(si[:, :, 1], ci % P_TOPK, axis=-1)
    ids = (e1 * P_KEYS + e2).reshape(n_tok // P_TOKEN_BLOCK, P_TOKEN_BLOCK, P_HEADS * P_TOPK)
    gates = jax.nn.softmax(cv, axis=-1).reshape(n_tok // P_TOKEN_BLOCK, P_TOKEN_BLOCK, P_HEADS * P_TOPK)
    xb = tok.reshape(n_tok // P_TOKEN_BLOCK, P_TOKEN_BLOCK, D)

    def block(args):
        x_b, id_b, g_b = args
        u = u_tab[id_b]
        act = jax.nn.gelu(jnp.einsum('td,tkd->tk', x_b, u), approximate=False) * g_b
        return jnp.einsum('tk,tkd->td', act, v_tab[id_b]).astype(h.dtype)

    out = lax.map(block, (xb, ids, gates))
    return out.reshape(Bn, T, D)


def setup_inputs(seed: int = 0) -> dict:
    key = jax.random.key(seed)
    ks = iter(jax.random.split(key, 40))
    L = DEPTH

    def nrm(shape, scale):
        return jax.random.normal(next(ks), shape, jnp.float32) * scale

    def gain(shape):
        return 1.0 + nrm(shape, 0.02)

    def uni(shape, lo, hi):
        return jax.random.uniform(next(ks), shape, jnp.float32, lo, hi)

    return {
        'x': nrm((BATCH, SEQ, D_MODEL), 1.0),
        'ln_in_g': gain((D_MODEL,)),
        'ln_in_b': nrm((D_MODEL,), 0.02),
        'w_in': nrm((L, D_MODEL, IN_COLS), D_MODEL ** -0.5),
        'a_mu': uni((L, A_IN), 0.0, 1.0),
        'a_w0': uni((L, A_WIDTH), -5.0, -0.5),
        'a_w2': nrm((L, A_DECAY_LORA, A_WIDTH), 0.5 * A_DECAY_LORA ** -0.5),
        'a_a0': nrm((L, A_WIDTH), 0.1),
        'a_a2': nrm((L, A_ICLR_LORA, A_WIDTH), A_ICLR_LORA ** -0.5),
        'a_g2': nrm((L, A_GATE_LORA, A_WIDTH), A_GATE_LORA ** -0.5),
        'a_k_k': 0.85 + nrm((L, A_WIDTH), 0.02),
        'a_k_a': gain((L, A_WIDTH)),
        'a_r_k': nrm((L, A_HEADS, A_HEAD), 0.1),
        'a_gn_g': gain((L, A_WIDTH)),
        'a_gn_b': nrm((L, A_WIDTH), 0.02),
        'b_conv': nrm((L, B_CONV, B_QKV), B_CONV ** -0.5),
        'b_gk_w2': nrm((L, B_GATE_LORA, B_WIDTH_K), B_GATE_LORA ** -0.5),
        'b_gk_b': nrm((L, B_WIDTH_K), 0.1),
        'b_norm_g': gain((L, B_DV)),
        'w_out': nrm((L, D_MIX, D_MODEL), BETA * D_MIX ** -0.5),
        'ln1_g': gain((L, D_MODEL)),
        'ln1_b': nrm((L, D_MODEL), 0.02),
        'p_wq': nrm((L, D_MODEL, P_HEADS * 2 * P_HALF), D_MODEL ** -0.5),
        'p_keys': nrm((L, P_HEADS, 2, P_KEYS, P_HALF), P_HALF ** -0.5),
        'p_u': nrm((L, P_EXPERTS, D_MODEL), D_MODEL ** -0.5),
        'p_v': nrm((L, P_EXPERTS, D_MODEL), BETA),
        'ln2_g': gain((L, D_MODEL)),
        'ln2_b': nrm((L, D_MODEL), 0.02),
    }


def reference(x, ln_in_g, ln_in_b, w_in, a_mu, a_w0, a_w2, a_a0, a_a2, a_g2, a_k_k, a_k_a,
              a_r_k, a_gn_g, a_gn_b, b_conv, b_gk_w2, b_gk_b, b_norm_g, w_out, ln1_g, ln1_b,
              p_wq, p_keys, p_u, p_v, ln2_g, ln2_b):
    h = layer_norm(x, ln_in_g, ln_in_b)
    for l in range(DEPTH):
        p = h @ w_in[l]
        pa, pb = jnp.split(p, (A_IN,), axis=-1)
        ya = rwkv7_group(pa, a_mu[l], a_w0[l], a_w2[l], a_a0[l], a_a2[l], a_g2[l],
                         a_k_k[l], a_k_a[l], a_r_k[l], a_gn_g[l], a_gn_b[l])
        yb = gla_group(pb, b_conv[l], b_gk_w2[l], b_gk_b[l], b_norm_g[l])
        y = jnp.concatenate([ya, yb], axis=-1) @ w_out[l]
        h = layer_norm(ALPHA * h + y, ln1_g[l], ln1_b[l])
        f = peer(h, p_wq[l], p_keys[l], p_u[l], p_v[l])
        h = layer_norm(ALPHA * h + f, ln2_g[l], ln2_b[l])
    return h
```

```cpp
#include <hip/hip_runtime.h>
#include <hip/hip_cooperative_groups.h>
#include <cstdio>
#include <cstdint>
namespace cg = cooperative_groups;

#ifndef MK_ONE_LAUNCH
#define MK_ONE_LAUNCH 1
#endif

namespace pg8 {
#define PG8_LAS __attribute__((address_space(3)))
typedef unsigned short bf16_t;
typedef short bf16x8 __attribute__((ext_vector_type(8)));
typedef float f32x4 __attribute__((ext_vector_type(4)));
typedef unsigned u32x4 __attribute__((ext_vector_type(4)));
typedef unsigned u32x2 __attribute__((ext_vector_type(2)));
constexpr int BM = 256, BK = 64, HALF = 128, HTB = HALF * BK * 2, STAGE_BYTES = 8 * HTB, NXCD = 8, WGM = 8;

__host__ __device__ __forceinline__ int lds_byte(int r, int c) { const int st = (r >> 4) * 2 + (c >> 5), rr = r & 15, cc = c & 31, ob = rr * 64 + cc * 2; return st * 1024 + (ob ^ (((ob >> 9) & 1) << 5)); }
__host__ __device__ __forceinline__ void stage_rc(int b, int& R, int& C) { const int st = b / 1024, sb = b % 1024, swz = sb ^ (((sb >> 9) & 1) << 5); R = (st >> 1) * 16 + swz / 64; C = (st & 1) * 32 + (swz % 64) / 2; }
__host__ __device__ __forceinline__ int perm32(int rho) { const int n = rho >> 4, i = rho & 15; return 8 * (i >> 2) + 4 * n + (i & 3); }

struct Unit { int pm, pn; };
struct Gemm { const bf16_t* A; const bf16_t* Bt; int M, N, K, lda, ldb, a_pn_koff; };

struct StaticOrder {
    int nM, nN, nwg, G, c;
    __host__ __device__ void init(int M, int N, int G_, int c_) { nM = M / BM; nN = N / BM; nwg = nM * nN; G = G_; c = c_; }
    __host__ __device__ bool next(int i, Unit& u) const {
        const long L = (long)i * G + c; if (L >= nwg) return false;
        int wgid = (int)L; { const int q = nwg / NXCD, r = nwg % NXCD, xcd = wgid % NXCD, off = wgid / NXCD; wgid = (xcd < r ? xcd * (q + 1) : r * (q + 1) + (xcd - r) * q) + off; }
        const int nig = WGM * nN, gid = wgid / nig, fm = gid * WGM, gsz = (nM - fm) < WGM ? (nM - fm) : WGM;
        u.pm = fm + ((wgid % nig) % gsz); u.pn = (wgid % nig) / gsz; return true;
    }
    __device__ __forceinline__ void a_ready(const Unit&) const {}
    __device__ __forceinline__ void done(const Unit&) const {}
};

__device__ __forceinline__ unsigned cvt_pk_bf16(float lo, float hi) { unsigned r; asm volatile("v_cvt_pk_bf16_f32 %0, %1, %2" : "=v"(r) : "v"(lo), "v"(hi)); return r; }

struct EpiBf16 {
    static constexpr bool PERM = true;
    bf16_t* O; int ldc;
    __device__ __forceinline__ void operator()(const f32x4 (&acc)[2][2][4][2], const Unit& u, int wr, int wc, int fr, int fq) const {
        const int row0 = u.pm * BM + wr * 64 + fr; const int col0 = u.pn * BM + wc * 32 + 8 * fq;
#pragma unroll
        for (int ai = 0; ai < 2; ++ai)
#pragma unroll
            for (int m = 0; m < 4; ++m) { bf16_t* rowp = O + (size_t)(row0 + ai * HALF + m * 16) * ldc + col0;
#pragma unroll
                for (int bj = 0; bj < 2; ++bj) { const f32x4 v0 = acc[ai][bj][m][0], v1 = acc[ai][bj][m][1];
                    u32x4 w; w.x = cvt_pk_bf16(v0[0], v0[1]); w.y = cvt_pk_bf16(v0[2], v0[3]); w.z = cvt_pk_bf16(v1[0], v1[1]); w.w = cvt_pk_bf16(v1[2], v1[3]);
                    *(u32x4*)(rowp + bj * HALF) = w; } }
    }
};
struct EpiResF32 {
    static constexpr bool PERM = false;
    float* Z; const bf16_t* R; int ldc; float alpha;
    __device__ __forceinline__ void operator()(const f32x4 (&acc)[2][2][4][2], const Unit& u, int wr, int wc, int fr, int fq) const {
        const int row0 = u.pm * BM + wr * 64 + fr; const int col0 = u.pn * BM + wc * 32 + 4 * fq;
#pragma unroll
        for (int ai = 0; ai < 2; ++ai)
#pragma unroll
            for (int m = 0; m < 4; ++m) { const size_t off = (size_t)(row0 + ai * HALF + m * 16) * ldc + col0;
#pragma unroll
                for (int bj = 0; bj < 2; ++bj)
#pragma unroll
                    for (int n = 0; n < 2; ++n) { const size_t o2 = off + bj * HALF + n * 16; const u32x2 rb = *(const u32x2*)(R + o2);
                        f32x4 h; h[0] = __uint_as_float(rb.x << 16); h[1] = __uint_as_float(rb.x & 0xffff0000u); h[2] = __uint_as_float(rb.y << 16); h[3] = __uint_as_float(rb.y & 0xffff0000u);
                        *(f32x4*)(Z + o2) = h * alpha + acc[ai][bj][m][n]; } }
    }
};

template <class Epi, class Sched, bool ALIGN_EPI = false, bool SP2 = false>
__device__ __forceinline__ void gemm_phase(PG8_LAS unsigned char* lds, const Gemm g, const Sched& S, const Epi& E) {
    const int tid = threadIdx.x, wid = __builtin_amdgcn_readfirstlane(tid >> 6), lane = tid & 63, wr = wid >> 2, wc = wid & 3, fr = lane & 15, fq = lane >> 4;
    const int K = g.K, nt = K / BK;
    unsigned voffA[2], voffB[2];
#pragma unroll
    for (int i = 0; i < 2; ++i) { int R, C; stage_rc(tid * 16 + i * 8192, R, C); const int Rb = Epi::PERM ? ((R & ~31) + perm32(R & 31)) : R;
        voffA[i] = (unsigned)(R * g.lda + C) * 2u; voffB[i] = (unsigned)(Rb * g.ldb + C) * 2u; }
    const size_t kstep = (size_t)(BK * 2);
    const size_t hstepA = (size_t)HALF * g.lda * 2, hstepB = (size_t)HALF * g.ldb * 2;
    const size_t tstepA = 2 * hstepA, tstepB = 2 * hstepB;
    const size_t pnA = (size_t)g.a_pn_koff * 2;
    const unsigned ldsw = (unsigned)wid * 1024u;
    const int aoff = lds_byte(wr * 64 + fr, fq * 8), boff = lds_byte(wc * 32 + fr, fq * 8);
#define PG8_SA(b, h) (((b) * 2 + (h)) * HTB)
#define PG8_SB(b, h) ((4 + (b) * 2 + (h)) * HTB)
#define PG8_STAGE(bufoff, gbase, voff) do { _Pragma("unroll") for (int _i = 0; _i < 2; ++_i) \
        __builtin_amdgcn_global_load_lds((const unsigned*)((const char*)(gbase) + (voff)[_i]), (PG8_LAS unsigned*)(lds + (bufoff) + ldsw + _i * 8192), 16, 0, 0); } while (0)
#define PG8_LDA(dst, b, h) do { _Pragma("unroll") for (int m = 0; m < 4; ++m) _Pragma("unroll") for (int k = 0; k < 2; ++k) dst[m][k] = *(const PG8_LAS bf16x8*)(lds + PG8_SA(b, h) + aoff + m * 2048 + k * 1024); } while (0)
#define PG8_LDB(dst, b, h) do { _Pragma("unroll") for (int n = 0; n < 2; ++n) _Pragma("unroll") for (int k = 0; k < 2; ++k) dst[n][k] = *(const PG8_LAS bf16x8*)(lds + PG8_SB(b, h) + boff + n * 2048 + k * 1024); } while (0)
#define PG8_MMA(ai, bj, At, Bt) do { __builtin_amdgcn_s_setprio(1); _Pragma("unroll") for (int m = 0; m < 4; ++m) _Pragma("unroll") for (int n = 0; n < 2; ++n) _Pragma("unroll") for (int k = 0; k < 2; ++k) \
        acc[ai][bj][m][n] = __builtin_amdgcn_mfma_f32_16x16x32_bf16(Bt[n][k], At[m][k], acc[ai][bj][m][n], 0, 0, 0); __builtin_amdgcn_s_setprio(0); } while (0)
#define PG8_WAIT_V(n) asm volatile("s_waitcnt vmcnt(" #n ")" ::: "memory")
#define PG8_WAIT_L(n) asm volatile("s_waitcnt lgkmcnt(" #n ")" ::: "memory")
#define PG8_BAR __builtin_amdgcn_s_barrier()
#define PG8_SCHED __builtin_amdgcn_sched_barrier(0)
    Unit cur, nxt; int ui = 0;
    if (!S.next(0, cur)) return;
    f32x4 acc[2][2][4][2];
#pragma unroll
    for (int a = 0; a < 2; ++a)
#pragma unroll
        for (int b = 0; b < 2; ++b)
#pragma unroll
            for (int m = 0; m < 4; ++m)
#pragma unroll
                for (int n = 0; n < 2; ++n) acc[a][b][m][n] = (f32x4){0.f, 0.f, 0.f, 0.f};
    bf16x8 At[4][2], B0[2][2], B1[2][2];
    const char* cA = (const char*)g.A + (size_t)cur.pm * tstepA + (size_t)cur.pn * pnA; const char* cB = (const char*)g.Bt + (size_t)cur.pn * tstepB;
    S.a_ready(cur);
    if constexpr (SP2) {
        PG8_STAGE(PG8_SB(0, 0), cB, voffB); PG8_STAGE(PG8_SB(0, 1), cB + hstepB, voffB); PG8_STAGE(PG8_SA(0, 0), cA, voffA); PG8_STAGE(PG8_SA(0, 1), cA + hstepA, voffA);
        if (wr == 1) PG8_BAR;
        PG8_WAIT_V(2); PG8_BAR;
        PG8_STAGE(PG8_SB(1, 0), cB + kstep, voffB); PG8_STAGE(PG8_SA(1, 0), cA + kstep, voffA); PG8_STAGE(PG8_SB(1, 1), cB + hstepB + kstep, voffB);
        PG8_WAIT_V(6); PG8_BAR;
    } else {
        PG8_STAGE(PG8_SB(0, 0), cB, voffB); PG8_STAGE(PG8_SA(0, 0), cA, voffA); PG8_STAGE(PG8_SB(0, 1), cB + hstepB, voffB); PG8_STAGE(PG8_SA(0, 1), cA + hstepA, voffA);
        if (wr == 1) PG8_BAR;
        PG8_WAIT_V(4); PG8_BAR;
        PG8_STAGE(PG8_SB(1, 0), cB + kstep, voffB); PG8_STAGE(PG8_SA(1, 0), cA + kstep, voffA); PG8_STAGE(PG8_SB(1, 1), cB + hstepB + kstep, voffB);
        PG8_WAIT_V(6); PG8_BAR;
    }
    for (;;) {
        const bool has_next = S.next(ui + 1, nxt);
        const char* nA = has_next ? (const char*)g.A + (size_t)nxt.pm * tstepA + (size_t)nxt.pn * pnA : cA; const char* nB = has_next ? (const char*)g.Bt + (size_t)nxt.pn * tstepB : cB;
        for (int t = 0; t < nt; t += 2) {
            const bool last = (t == nt - 2);
            const char* a1 = cA + (size_t)(t + 1) * kstep;
            const char* a2 = last ? nA : cA + (size_t)(t + 2) * kstep; const char* b2 = last ? nB : cB + (size_t)(t + 2) * kstep;
            const char* a3 = a2 + kstep; const char* b3 = b2 + kstep;
            if (last && has_next) S.a_ready(nxt);
            if constexpr (SP2) {
            PG8_LDB(B0, 0, 0); PG8_LDB(B1, 0, 1); PG8_SCHED; PG8_LDA(At, 0, 0); PG8_STAGE(PG8_SA(1, 1), a1 + hstepA, voffA);
            PG8_WAIT_V(8); PG8_WAIT_L(0); PG8_BAR; PG8_MMA(0, 0, At, B0); PG8_MMA(0, 1, At, B1); PG8_BAR; PG8_SCHED;
            PG8_LDA(At, 0, 1); PG8_STAGE(PG8_SB(0, 0), b2, voffB); PG8_STAGE(PG8_SB(0, 1), b2 + hstepB, voffB); PG8_STAGE(PG8_SA(0, 0), a2, voffA);
            PG8_WAIT_V(8); PG8_WAIT_L(0); PG8_BAR; PG8_MMA(1, 0, At, B0); PG8_MMA(1, 1, At, B1); PG8_BAR; PG8_SCHED;
            PG8_LDB(B0, 1, 0); PG8_LDB(B1, 1, 1); PG8_SCHED; PG8_LDA(At, 1, 0); PG8_STAGE(PG8_SA(0, 1), a2 + hstepA, voffA);
            PG8_WAIT_V(8); PG8_WAIT_L(0); PG8_BAR; PG8_MMA(0, 0, At, B0); PG8_MMA(0, 1, At, B1); PG8_BAR; PG8_SCHED;
            PG8_LDA(At, 1, 1); PG8_STAGE(PG8_SB(1, 0), b3, voffB); PG8_STAGE(PG8_SB(1, 1), b3 + hstepB, voffB); PG8_STAGE(PG8_SA(1, 0), a3, voffA);
            PG8_WAIT_V(8); PG8_WAIT_L(0); PG8_BAR; PG8_MMA(1, 0, At, B0); PG8_MMA(1, 1, At, B1); PG8_BAR; PG8_SCHED;
            } else {
            PG8_LDB(B0, 0, 0); PG8_SCHED; PG8_LDA(At, 0, 0); PG8_STAGE(PG8_SA(1, 1), a1 + hstepA, voffA);
            PG8_WAIT_L(8); PG8_BAR; PG8_WAIT_L(0); PG8_MMA(0, 0, At, B0); PG8_BAR; PG8_SCHED;
            PG8_LDB(B1, 0, 1); PG8_STAGE(PG8_SB(0, 0), b2, voffB);
            PG8_BAR; PG8_WAIT_L(0); PG8_MMA(0, 1, At, B1); PG8_BAR;
            PG8_LDA(At, 0, 1); PG8_STAGE(PG8_SA(0, 0), a2, voffA);
            PG8_BAR; PG8_WAIT_L(0); PG8_MMA(1, 0, At, B0); PG8_BAR; PG8_SCHED;
            PG8_STAGE(PG8_SB(0, 1), b2 + hstepB, voffB);
            PG8_WAIT_V(6); PG8_BAR; PG8_MMA(1, 1, At, B1); PG8_BAR;
            PG8_LDB(B0, 1, 0); PG8_SCHED; PG8_LDA(At, 1, 0); PG8_STAGE(PG8_SA(0, 1), a2 + hstepA, voffA);
            PG8_WAIT_L(8); PG8_BAR; PG8_WAIT_L(0); PG8_MMA(0, 0, At, B0); PG8_BAR; PG8_SCHED;
            PG8_LDB(B1, 1, 1); PG8_STAGE(PG8_SB(1, 0), b3, voffB);
            PG8_BAR; PG8_WAIT_L(0); PG8_MMA(0, 1, At, B1); PG8_BAR;
            PG8_LDA(At, 1, 1); PG8_STAGE(PG8_SA(1, 0), a3, voffA);
            PG8_BAR; PG8_WAIT_L(0); PG8_MMA(1, 0, At, B0); PG8_BAR; PG8_SCHED;
            PG8_STAGE(PG8_SB(1, 1), b3 + hstepB, voffB);
            PG8_WAIT_V(6); PG8_BAR; PG8_MMA(1, 1, At, B1); PG8_BAR;
            }
        }
        if constexpr (ALIGN_EPI) { if (wr == 0) PG8_BAR; }
        E(acc, cur, wr, wc, fr, fq); S.done(cur);
        if (!has_next) break;
#pragma unroll
        for (int a = 0; a < 2; ++a)
#pragma unroll
            for (int b = 0; b < 2; ++b)
#pragma unroll
                for (int m = 0; m < 4; ++m)
#pragma unroll
                    for (int n = 0; n < 2; ++n) acc[a][b][m][n] = (f32x4){0.f, 0.f, 0.f, 0.f};
        cur = nxt; cA = nA; cB = nB; ++ui;
        if constexpr (ALIGN_EPI) { if (wr == 1) PG8_BAR; }
    }
    PG8_WAIT_V(0);
    if constexpr (!ALIGN_EPI) { if (wr == 0) PG8_BAR; }
    PG8_BAR;
#undef PG8_SA
#undef PG8_SB
#undef PG8_STAGE
#undef PG8_LDA
#undef PG8_LDB
#undef PG8_MMA
#undef PG8_WAIT_V
#undef PG8_WAIT_L
#undef PG8_BAR
#undef PG8_SCHED
}
}

constexpr int NWAVES = 8, NTHR = NWAVES * 64;
constexpr int D = 1024, NBATCH = 4, T = 8192, M = NBATCH * T;
constexpr int A_W = 512, A_IN = 1792, IN_COLS = 3344, NP = 3584;
constexpr int C_R = 0, C_K = 512, C_V = 1024, C_WD = 1536, C_AD = 1600, C_GD = 1664;
constexpr int C_BQ = 1792, C_BK = 2048, C_BV = 2304, C_GKD = 2816, C_BG = 2832;
constexpr int NQ = 2048;
constexpr float LN_EPS = 1e-5f, GN_EPS = 64e-5f, RMS_EPS = 1e-5f;
constexpr float ALPHA = 1.189207115002721f;

typedef unsigned short bf16;
typedef float f32x4 __attribute__((ext_vector_type(4)));
typedef unsigned u32x4 __attribute__((ext_vector_type(4)));
typedef unsigned u32x2 __attribute__((ext_vector_type(2)));
#define LAS __attribute__((address_space(3)))

constexpr size_t MiB = 1u << 20;
constexpr size_t WS_WIN = 1 * MiB, WS_WOUT = 8 * MiB, WS_WQ = 10 * MiB, WS_KBD = 14 * MiB;
constexpr size_t WS_H0 = 16 * MiB;
constexpr size_t WS_P = 80 * MiB;
constexpr size_t WS_WL = 304 * MiB, WS_AA = 336 * MiB, WS_GG = 368 * MiB;
constexpr size_t WS_GK = 400 * MiB;
constexpr size_t WS_MIX = 416 * MiB;
constexpr size_t WS_Z = 80 * MiB;
constexpr size_t WS_H1 = 208 * MiB;
constexpr size_t WS_Q = 272 * MiB;
constexpr size_t WS_S = 80 * MiB;
constexpr size_t WS_IDS = 400 * MiB, WS_GATES = 416 * MiB;
constexpr size_t WS_END = 480 * MiB;

constexpr int LDS_BYTES = 147456;

struct Params {
    const float* in[28];
    float* out; unsigned char* ws;
    int ph_lo, ph_hi;
};

__device__ __forceinline__ float bf2f(unsigned u) { return __uint_as_float(u << 16); }
__device__ __forceinline__ unsigned f2bf(float f) { unsigned u = __float_as_uint(f); return (u + 0x7fffu + ((u >> 16) & 1u)) >> 16; }
__device__ __forceinline__ unsigned pk2(float lo, float hi) { return f2bf(lo) | (f2bf(hi) << 16); }
__device__ __forceinline__ float wave_sum(float v) {
#pragma unroll
    for (int o = 1; o < 64; o <<= 1) v += __shfl_xor(v, o);
    return v;
}
__device__ __forceinline__ float wave_max(float v) {
#pragma unroll
    for (int o = 1; o < 64; o <<= 1) v = fmaxf(v, __shfl_xor(v, o));
    return v;
}
__device__ __forceinline__ int wave_min_i(int v) {
#pragma unroll
    for (int o = 1; o < 64; o <<= 1) v = min(v, __shfl_xor(v, o));
    return v;
}
__device__ __forceinline__ float sigmoidf_(float x) { return 1.f / (1.f + __expf(-x)); }
__device__ __forceinline__ float softplusf_(float x) { return fmaxf(x, 0.f) + log1pf(__expf(-fabsf(x))); }
__device__ __forceinline__ float siluf_(float x) { return x * sigmoidf_(x); }

__device__ __forceinline__ void transpose_convert(const float* W, int K, int N, int Npad, bf16* WT, int gtid, int gthreads) {
    const int kc = K / 8, total = Npad * kc;
    for (int idx = gtid; idx < total; idx += gthreads) {
        const int n = idx % Npad, c = idx / Npad; float v[8];
#pragma unroll
        for (int j = 0; j < 8; ++j) v[j] = (n < N) ? W[(size_t)(8 * c + j) * N + n] : 0.f;
        u32x4 o; o.x = pk2(v[0], v[1]); o.y = pk2(v[2], v[3]); o.z = pk2(v[4], v[5]); o.w = pk2(v[6], v[7]);
        *(u32x4*)(WT + (size_t)n * K + 8 * c) = o;
    }
}
__device__ __forceinline__ void ln_row_bf16(const float* xrow, const float* g, const float* b, bf16* orow, int lane) {
    const f32x4* xr = (const f32x4*)xrow + lane; f32x4 v[4]; float s = 0.f;
#pragma unroll
    for (int j = 0; j < 4; ++j) { v[j] = xr[64 * j]; s += (v[j][0] + v[j][1]) + (v[j][2] + v[j][3]); }
    const float mean = wave_sum(s) * (1.f / D); float s2 = 0.f;
#pragma unroll
    for (int j = 0; j < 4; ++j) { v[j] = v[j] - mean; s2 += (v[j][0] * v[j][0] + v[j][1] * v[j][1]) + (v[j][2] * v[j][2] + v[j][3] * v[j][3]); }
    const float rstd = 1.f / sqrtf(wave_sum(s2) * (1.f / D) + LN_EPS);
    u32x2* o8 = (u32x2*)orow + lane;
#pragma unroll
    for (int j = 0; j < 4; ++j) { const f32x4 gg = ((const f32x4*)g)[lane + 64 * j], bb = ((const f32x4*)b)[lane + 64 * j]; const f32x4 y = v[j] * rstd * gg + bb;
        u32x2 w; w.x = pk2(y[0], y[1]); w.y = pk2(y[2], y[3]); o8[64 * j] = w; }
}
__device__ __forceinline__ void phase_prologue(const Params& P) {
    const int tid = threadIdx.x, lane = tid & 63, wave = tid >> 6;
    const int gtid = blockIdx.x * NTHR + tid, gthreads = gridDim.x * NTHR;
    unsigned char* ws = P.ws;
    transpose_convert(P.in[3], D, IN_COLS, NP, (bf16*)(ws + WS_WIN), gtid, gthreads);
    transpose_convert(P.in[19], D, D, D, (bf16*)(ws + WS_WOUT), gtid, gthreads);
    transpose_convert(P.in[22], D, NQ, NQ, (bf16*)(ws + WS_WQ), gtid, gthreads);
    {
        const float* keys = P.in[23]; bf16* kbd = (bf16*)(ws + WS_KBD);
        for (int idx = gtid; idx < 8 * 256 * 32; idx += gthreads) {
            const int kc = idx & 31, n = (idx >> 5) & 255, h = idx >> 13; const int k0 = kc * 8, hn = n >> 7, key = n & 127, hk = k0 >> 7, c0 = k0 & 127;
            u32x4 o = (u32x4){0u, 0u, 0u, 0u};
            if (hn == hk) { const float* s = keys + ((size_t)((h * 2 + hn) * 128 + key)) * 128 + c0; o.x = pk2(s[0], s[1]); o.y = pk2(s[2], s[3]); o.z = pk2(s[4], s[5]); o.w = pk2(s[6], s[7]); }
            *(u32x4*)(kbd + ((size_t)(h * 256 + n)) * 256 + k0) = o;
        }
    }
    const int gw = blockIdx.x * NWAVES + wave, ngw = gridDim.x * NWAVES;
    for (int m = gw; m < M; m += ngw) ln_row_bf16(P.in[0] + (size_t)m * D, P.in[1], P.in[2], (bf16*)(ws + WS_H0) + (size_t)m * D, lane);
}

__device__ __forceinline__ void phase_prep(const Params& P, LAS unsigned char* lds) {
    const int tid = threadIdx.x;
    unsigned char* ws = P.ws;
    const bf16* p = (const bf16*)(ws + WS_P);
    const float* mu = P.in[4]; const float* w0 = P.in[5]; const float* w2 = P.in[6]; const float* a0 = P.in[7]; const float* a2 = P.in[8]; const float* g2 = P.in[9];
    const float* gkw2 = P.in[16]; const float* gkb = P.in[17];
    bf16* WL = (bf16*)(ws + WS_WL); bf16* AA = (bf16*)(ws + WS_AA); bf16* GG = (bf16*)(ws + WS_GG); bf16* GK = (bf16*)(ws + WS_GK);
    LAS float* act = (LAS float*)lds;
    LAS float* gkd = (LAS float*)(lds + 64 * 260 * 4);
    constexpr int AS = 260;
    for (int tile = blockIdx.x; tile < M / 64; tile += gridDim.x) {
        const int m0 = tile * 64;
        __syncthreads();
        for (int idx = tid; idx < 64 * 256; idx += NTHR) {
            const int j = idx & 255, tok = idx >> 8, m = m0 + tok, t = m & (T - 1);
            const float cur = bf2f(p[(size_t)m * NP + C_WD + j]);
            const float prev = (t > 0) ? bf2f(p[(size_t)(m - 1) * NP + C_WD + j]) : 0.f;
            const float x = cur + (prev - cur) * mu[C_WD + j];
            float v;
            if (j < 64) v = tanhf(x); else if (j < 128) v = x; else v = sigmoidf_(x);
            act[tok * AS + j] = v;
        }
        for (int idx = tid; idx < 64 * 16; idx += NTHR) { const int j = idx & 15, tok = idx >> 4; gkd[tok * 16 + j] = bf2f(p[(size_t)(m0 + tok) * NP + C_GKD + j]); }
        __syncthreads();
        const int c = tid;
        float acc[64];
#pragma unroll
        for (int i = 0; i < 64; ++i) acc[i] = 0.f;
        for (int j = 0; j < 64; j += 4) {
            const float x0 = w2[(j + 0) * A_W + c], x1 = w2[(j + 1) * A_W + c], x2 = w2[(j + 2) * A_W + c], x3 = w2[(j + 3) * A_W + c];
#pragma unroll
            for (int i = 0; i < 64; ++i) { const f32x4 a = *(const LAS f32x4*)(act + i * AS + j); acc[i] += a[0] * x0 + a[1] * x1 + a[2] * x2 + a[3] * x3; }
        }
        { const float b0 = w0[c];
#pragma unroll
          for (int i = 0; i < 64; ++i) { const float z = b0 + acc[i]; const float w = -softplusf_(-z) - 0.5f; WL[(size_t)(m0 + i) * A_W + c] = (bf16)f2bf(-__expf(w)); } }
#pragma unroll
        for (int i = 0; i < 64; ++i) acc[i] = 0.f;
        for (int j = 0; j < 64; j += 4) {
            const float x0 = a2[(j + 0) * A_W + c], x1 = a2[(j + 1) * A_W + c], x2 = a2[(j + 2) * A_W + c], x3 = a2[(j + 3) * A_W + c];
#pragma unroll
            for (int i = 0; i < 64; ++i) { const f32x4 a = *(const LAS f32x4*)(act + i * AS + 64 + j); acc[i] += a[0] * x0 + a[1] * x1 + a[2] * x2 + a[3] * x3; }
        }
        { const float b0 = a0[c];
#pragma unroll
          for (int i = 0; i < 64; ++i) AA[(size_t)(m0 + i) * A_W + c] = (bf16)f2bf(sigmoidf_(b0 + acc[i])); }
#pragma unroll
        for (int i = 0; i < 64; ++i) acc[i] = 0.f;
        for (int j = 0; j < 128; j += 4) {
            const float x0 = g2[(j + 0) * A_W + c], x1 = g2[(j + 1) * A_W + c], x2 = g2[(j + 2) * A_W + c], x3 = g2[(j + 3) * A_W + c];
#pragma unroll
            for (int i = 0; i < 64; ++i) { const f32x4 a = *(const LAS f32x4*)(act + i * AS + 128 + j); acc[i] += a[0] * x0 + a[1] * x1 + a[2] * x2 + a[3] * x3; }
        }
#pragma unroll
        for (int i = 0; i < 64; ++i) GG[(size_t)(m0 + i) * A_W + c] = (bf16)f2bf(acc[i]);
        { const int cc = tid & 255, th = tid >> 8; float wv[16];
#pragma unroll
          for (int j = 0; j < 16; ++j) wv[j] = gkw2[j * 256 + cc];
          const float bb = gkb[cc];
          for (int i = 0; i < 32; ++i) { const int tok = th * 32 + i; float s = bb;
#pragma unroll
              for (int j = 0; j < 16; ++j) s += gkd[tok * 16 + j] * wv[j];
              GK[(size_t)(m0 + tok) * 256 + cc] = (bf16)f2bf(-softplusf_(-s) * (1.f / 16.f)); } }
    }
}

constexpr int CH = 32;
__device__ __forceinline__ float red8(float v) { v += __shfl_xor(v, 1); v += __shfl_xor(v, 2); v += __shfl_xor(v, 4); return v; }
__device__ __forceinline__ float red4(float v) { v += __shfl_xor(v, 1); v += __shfl_xor(v, 2); return v; }

__device__ __forceinline__ void rwkv_item(const Params& P, LAS unsigned char* lds, int b, int h) {
    const int tid = threadIdx.x, lane = tid & 63, wave = tid >> 6;
    unsigned char* ws = P.ws;
    const bf16* p = (const bf16*)(ws + WS_P); const bf16* WL = (const bf16*)(ws + WS_WL); const bf16* AA = (const bf16*)(ws + WS_AA); const bf16* GG = (const bf16*)(ws + WS_GG);
    bf16* MIX = (bf16*)(ws + WS_MIX);
    const float* mu = P.in[4]; const float* k_k = P.in[10]; const float* k_a = P.in[11]; const float* r_k = P.in[12]; const float* gn_g = P.in[13]; const float* gn_b = P.in[14];
    LAS float* R = (LAS float*)lds; LAS float* DEC = R + CH * 64; LAS float* KH = DEC + CH * 64; LAS float* KK = KH + CH * 64; LAS float* BB = KK + CH * 64; LAS float* V = BB + CH * 64;
    LAS float* Y = V + CH * 64; LAS float* BON = Y + CH * 64;
    const int col = h * 64 + lane;
    const float mu_r = mu[C_R + col], mu_k = mu[C_K + col], mu_v = mu[C_V + col], kkc = k_k[col], kac = k_a[col], rkc = r_k[col], gng = gn_g[col], gnb = gn_b[col];
    float S[8];
#pragma unroll
    for (int j = 0; j < 8; ++j) S[j] = 0.f;
    const int row = wave * 8 + (lane >> 3), ks = (lane & 7) * 8;
    for (int t0 = 0; t0 < T; t0 += CH) {
        __syncthreads();
        for (int tt = wave; tt < CH; tt += NWAVES) {
            const int t = t0 + tt; const size_t m = (size_t)b * T + t;
            const bf16* pr = p + m * NP; const bf16* pp = pr - NP; const bool hp = t > 0;
            const float rc = bf2f(pr[C_R + col]), kc = bf2f(pr[C_K + col]), vc = bf2f(pr[C_V + col]);
            const float rp = hp ? bf2f(pp[C_R + col]) : 0.f, kp = hp ? bf2f(pp[C_K + col]) : 0.f, vp = hp ? bf2f(pp[C_V + col]) : 0.f;
            const float r = rc + (rp - rc) * mu_r, k = kc + (kp - kc) * mu_k, v = vc + (vp - vc) * mu_v;
            const float a = bf2f(AA[m * A_W + col]), wl = bf2f(WL[m * A_W + col]);
            const float kr = k * kkc; const float nrm = sqrtf(wave_sum(kr * kr)); const float kk = kr / fmaxf(nrm, 1e-12f);
            const float kh = k * (1.f + (a - 1.f) * kac);
            const float bon = wave_sum(r * kh * rkc);
            R[tt * 64 + lane] = r; DEC[tt * 64 + lane] = __expf(wl); KH[tt * 64 + lane] = kh; KK[tt * 64 + lane] = kk; BB[tt * 64 + lane] = kk * a; V[tt * 64 + lane] = v;
            if (lane == 0) BON[tt] = bon;
        }
        __syncthreads();
        for (int tt = 0; tt < CH; ++tt) {
            const f32x4 k0 = *(const LAS f32x4*)(KK + tt * 64 + ks), k1 = *(const LAS f32x4*)(KK + tt * 64 + ks + 4);
            const f32x4 d0 = *(const LAS f32x4*)(DEC + tt * 64 + ks), d1 = *(const LAS f32x4*)(DEC + tt * 64 + ks + 4);
            const f32x4 b0 = *(const LAS f32x4*)(BB + tt * 64 + ks), b1 = *(const LAS f32x4*)(BB + tt * 64 + ks + 4);
            const f32x4 h0 = *(const LAS f32x4*)(KH + tt * 64 + ks), h1 = *(const LAS f32x4*)(KH + tt * 64 + ks + 4);
            const f32x4 r0 = *(const LAS f32x4*)(R + tt * 64 + ks), r1 = *(const LAS f32x4*)(R + tt * 64 + ks + 4);
            const float vv = V[tt * 64 + row];
            float sa = 0.f;
#pragma unroll
            for (int j = 0; j < 4; ++j) sa += S[j] * k0[j] + S[4 + j] * k1[j];
            sa = -red8(sa);
            float y = 0.f;
#pragma unroll
            for (int j = 0; j < 4; ++j) {
                S[j] = S[j] * d0[j] + sa * b0[j] + vv * h0[j]; S[4 + j] = S[4 + j] * d1[j] + sa * b1[j] + vv * h1[j];
                y += S[j] * r0[j] + S[4 + j] * r1[j];
            }
            y = red8(y);
            if ((lane & 7) == 0) Y[tt * 64 + row] = y;
        }
        __syncthreads();
        for (int tt = wave; tt < CH; tt += NWAVES) {
            const size_t m = (size_t)b * T + t0 + tt;
            const float y = Y[tt * 64 + lane]; const float mean = wave_sum(y) * (1.f / 64.f); const float d = y - mean; const float var = wave_sum(d * d) * (1.f / 64.f);
            float o = d * (1.f / sqrtf(var + GN_EPS)) * gng + gnb;
            o += BON[tt] * V[tt * 64 + lane];
            o *= bf2f(GG[m * A_W + col]);
            MIX[m * D + col] = (bf16)f2bf(o);
        }
    }
}

__device__ __forceinline__ void gla_item(const Params& P, LAS unsigned char* lds, int b, int h) {
    const int tid = threadIdx.x, lane = tid & 63, wave = tid >> 6;
    unsigned char* ws = P.ws;
    const bf16* p = (const bf16*)(ws + WS_P); const bf16* GK = (const bf16*)(ws + WS_GK);
    bf16* MIX = (bf16*)(ws + WS_MIX);
    const float* conv = P.in[15]; const float* norm_g = P.in[18];
    LAS float* Q = (LAS float*)lds; LAS float* K = Q + CH * 64; LAS float* DEC = K + CH * 64; LAS float* V = DEC + CH * 64; LAS float* O = V + CH * 128;
    const int cq = h * 64 + lane, ck = 256 + h * 64 + lane, cv0 = 512 + h * 128 + lane, cv1 = cv0 + 64;
    float wq[4], wk[4], wv0[4], wv1[4];
#pragma unroll
    for (int j = 0; j < 4; ++j) { wq[j] = conv[j * 1024 + cq]; wk[j] = conv[j * 1024 + ck]; wv0[j] = conv[j * 1024 + cv0]; wv1[j] = conv[j * 1024 + cv1]; }
    const float ng0 = norm_g[lane], ng1 = norm_g[lane + 64];
    float S[16];
#pragma unroll
    for (int j = 0; j < 16; ++j) S[j] = 0.f;
    const int row = wave * 16 + (lane >> 2), ks = (lane & 3) * 16;
    for (int t0 = 0; t0 < T; t0 += CH) {
        __syncthreads();
        for (int tt = wave; tt < CH; tt += NWAVES) {
            const int t = t0 + tt; const size_t m = (size_t)b * T + t;
            float aq = 0.f, ak = 0.f, av0 = 0.f, av1 = 0.f;
#pragma unroll
            for (int j = 0; j < 4; ++j) { const int ts = t - 3 + j; if (ts >= 0) { const bf16* pr = p + (m - 3 + j) * NP + C_BQ;
                aq += wq[j] * bf2f(pr[cq]); ak += wk[j] * bf2f(pr[ck]); av0 += wv0[j] * bf2f(pr[cv0]); av1 += wv1[j] * bf2f(pr[cv1]); } }
            Q[tt * 64 + lane] = siluf_(aq) * 0.125f; K[tt * 64 + lane] = siluf_(ak); V[tt * 128 + lane] = siluf_(av0); V[tt * 128 + 64 + lane] = siluf_(av1);
            DEC[tt * 64 + lane] = __expf(bf2f(GK[m * 256 + h * 64 + lane]));
        }
        __syncthreads();
        for (int tt = 0; tt < CH; ++tt) {
            const float vv = V[tt * 128 + row]; float o = 0.f;
#pragma unroll
            for (int q4 = 0; q4 < 4; ++q4) {
                const f32x4 kk = *(const LAS f32x4*)(K + tt * 64 + ks + 4 * q4), dd = *(const LAS f32x4*)(DEC + tt * 64 + ks + 4 * q4), qq = *(const LAS f32x4*)(Q + tt * 64 + ks + 4 * q4);
#pragma unroll
                for (int j = 0; j < 4; ++j) { S[4 * q4 + j] = S[4 * q4 + j] * dd[j] + vv * kk[j]; o += S[4 * q4 + j] * qq[j]; }
            }
            o = red4(o);
            if ((lane & 3) == 0) O[tt * 128 + row] = o;
        }
        __syncthreads();
        for (int tt = wave; tt < CH; tt += NWAVES) {
            const size_t m = (size_t)b * T + t0 + tt;
            const float o0 = O[tt * 128 + lane], o1 = O[tt * 128 + 64 + lane];
            const float ms = wave_sum(o0 * o0 + o1 * o1) * (1.f / 128.f); const float rs = 1.f / sqrtf(ms + RMS_EPS);
            const float g0 = bf2f(p[m * NP + C_BG + h * 128 + lane]), g1 = bf2f(p[m * NP + C_BG + h * 128 + 64 + lane]);
            MIX[m * D + 512 + h * 128 + lane] = (bf16)f2bf(o0 * rs * ng0 * siluf_(g0));
            MIX[m * D + 512 + h * 128 + 64 + lane] = (bf16)f2bf(o1 * rs * ng1 * siluf_(g1));
        }
    }
}
__device__ __forceinline__ void phase_scan(const Params& P, LAS unsigned char* lds) {
    for (int it = blockIdx.x; it < 48; it += gridDim.x) {
        if (it < 32) rwkv_item(P, lds, it >> 3, it & 7); else gla_item(P, lds, (it - 32) >> 2, (it - 32) & 3);
        __syncthreads();
    }
}

__device__ __forceinline__ void phase_ln1(const Params& P) {
    const int lane = threadIdx.x & 63, wave = threadIdx.x >> 6; const int gw = blockIdx.x * NWAVES + wave, ngw = gridDim.x * NWAVES;
    for (int m = gw; m < M; m += ngw) ln_row_bf16((const float*)(P.ws + WS_Z) + (size_t)m * D, P.in[20], P.in[21], (bf16*)(P.ws + WS_H1) + (size_t)m * D, lane);
}

__device__ __forceinline__ void phase_topk(const Params& P) {
    const int lane = threadIdx.x & 63, wave = threadIdx.x >> 6; const int gw = blockIdx.x * NWAVES + wave, ngw = gridDim.x * NWAVES;
    const bf16* Sc = (const bf16*)(P.ws + WS_S); int* IDS = (int*)(P.ws + WS_IDS); float* GATES = (float*)(P.ws + WS_GATES);
    const float NEG = -INFINITY;
    for (int item = gw; item < M * 8; item += ngw) {
        const int m = item >> 3, h = item & 7; const bf16* s = Sc + (size_t)m * NQ + h * 256;
        float sv[2]; int si[2];
#pragma unroll
        for (int half = 0; half < 2; ++half) {
            float a0 = bf2f(s[half * 128 + lane]), a1 = bf2f(s[half * 128 + 64 + lane]); float mv = 0.f; int mi = 0;
            for (int it = 0; it < 16; ++it) {
                const float wm = wave_max(fmaxf(a0, a1));
                const int ci = (a0 == wm) ? lane : ((a1 == wm) ? 64 + lane : 9999);
                const int wi = wave_min_i(ci);
                if (lane == it) { mv = wm; mi = wi; }
                if (wi == lane) a0 = NEG; if (wi == 64 + lane) a1 = NEG;
            }
            sv[half] = mv; si[half] = mi;
        }
        float c[4]; const float s0 = __shfl(sv[0], lane >> 2);
#pragma unroll
        for (int q = 0; q < 4; ++q) c[q] = s0 + __shfl(sv[1], 4 * (lane & 3) + q);
        float cvv = 0.f; int cii = 0;
        for (int it = 0; it < 16; ++it) {
            const float wm = wave_max(fmaxf(fmaxf(c[0], c[1]), fmaxf(c[2], c[3])));
            int ci = 9999;
#pragma unroll
            for (int q = 3; q >= 0; --q) if (c[q] == wm) ci = 4 * lane + q;
            const int wi = wave_min_i(ci);
            if (lane == it) { cvv = wm; cii = wi; }
#pragma unroll
            for (int q = 0; q < 4; ++q) if (wi == 4 * lane + q) c[q] = NEG;
        }
        const int e1 = __shfl(si[0], (cii >> 4) & 15), e2 = __shfl(si[1], cii & 15);
        const float cmax = __shfl(cvv, 0);
        const float e = (lane < 16) ? __expf(cvv - cmax) : 0.f;
        const float den = wave_sum(e);
        if (lane < 16) { IDS[(size_t)m * 128 + h * 16 + lane] = e1 * 128 + e2; GATES[(size_t)m * 128 + h * 16 + lane] = e / den; }
    }
}

__device__ __forceinline__ void phase_peer(const Params& P) {
    const int lane = threadIdx.x & 63, wave = threadIdx.x >> 6; const int gw = blockIdx.x * NWAVES + wave, ngw = gridDim.x * NWAVES;
    const bf16* H1 = (const bf16*)(P.ws + WS_H1); const int* IDS = (const int*)(P.ws + WS_IDS); const float* GATES = (const float*)(P.ws + WS_GATES);
    const float* UT = P.in[24]; const float* VT = P.in[25]; const float* g2 = P.in[26]; const float* b2 = P.in[27];
    for (int m = gw; m < M; m += ngw) {
        f32x4 hv[4];
#pragma unroll
        for (int j = 0; j < 4; ++j) { const u32x2 w = *((const u32x2*)(H1 + (size_t)m * D) + lane + 64 * j); hv[j][0] = bf2f(w.x & 0xffffu); hv[j][1] = __uint_as_float(w.x & 0xffff0000u); hv[j][2] = bf2f(w.y & 0xffffu); hv[j][3] = __uint_as_float(w.y & 0xffff0000u); }
        f32x4 acc[4];
#pragma unroll
        for (int j = 0; j < 4; ++j) acc[j] = (f32x4){0.f, 0.f, 0.f, 0.f};
        const int id0 = IDS[(size_t)m * 128 + lane], id1 = IDS[(size_t)m * 128 + 64 + lane];
        const float gt0 = GATES[(size_t)m * 128 + lane], gt1 = GATES[(size_t)m * 128 + 64 + lane];
        for (int e0 = 0; e0 < 128; e0 += 4) {
            int id[4]; float gt[4];
#pragma unroll
            for (int q = 0; q < 4; ++q) { const int e = e0 + q; id[q] = __builtin_amdgcn_readfirstlane(__shfl(e < 64 ? id0 : id1, e & 63)); gt[q] = __shfl(e < 64 ? gt0 : gt1, e & 63); }
            f32x4 u[4][4];
#pragma unroll
            for (int q = 0; q < 4; ++q)
#pragma unroll
                for (int j = 0; j < 4; ++j) u[q][j] = ((const f32x4*)(UT + (size_t)id[q] * D))[lane + 64 * j];
            float act[4];
#pragma unroll
            for (int q = 0; q < 4; ++q) { float s = 0.f;
#pragma unroll
                for (int j = 0; j < 4; ++j) s += (u[q][j][0] * hv[j][0] + u[q][j][1] * hv[j][1]) + (u[q][j][2] * hv[j][2] + u[q][j][3] * hv[j][3]);
                s = wave_sum(s); act[q] = 0.5f * s * (1.f + erff(s * 0.70710678118f)) * gt[q]; }
#pragma unroll
            for (int q = 0; q < 4; ++q)
#pragma unroll
                for (int j = 0; j < 4; ++j) u[q][j] = ((const f32x4*)(VT + (size_t)id[q] * D))[lane + 64 * j];
#pragma unroll
            for (int q = 0; q < 4; ++q)
#pragma unroll
                for (int j = 0; j < 4; ++j) acc[j] += u[q][j] * act[q];
        }
        float s = 0.f;
#pragma unroll
        for (int j = 0; j < 4; ++j) { acc[j] = hv[j] * ALPHA + acc[j]; s += (acc[j][0] + acc[j][1]) + (acc[j][2] + acc[j][3]); }
        const float mean = wave_sum(s) * (1.f / D); float s2 = 0.f;
#pragma unroll
        for (int j = 0; j < 4; ++j) { acc[j] = acc[j] - mean; s2 += (acc[j][0] * acc[j][0] + acc[j][1] * acc[j][1]) + (acc[j][2] * acc[j][2] + acc[j][3] * acc[j][3]); }
        const float rstd = 1.f / sqrtf(wave_sum(s2) * (1.f / D) + LN_EPS);
#pragma unroll
        for (int j = 0; j < 4; ++j) { const f32x4 gg = ((const f32x4*)g2)[lane + 64 * j], bb = ((const f32x4*)b2)[lane + 64 * j]; ((f32x4*)(P.out + (size_t)m * D))[lane + 64 * j] = acc[j] * rstd * gg + bb; }
    }
}

constexpr int N_PHASES = 10;
__global__ void __launch_bounds__(NTHR, 2) fwd_kernel(Params P) {
    extern __shared__ __attribute__((aligned(16))) unsigned char lds_raw[];
    LAS unsigned char* lds = (LAS unsigned char*)lds_raw;
    cg::grid_group grid = cg::this_grid();
    const int lo = P.ph_lo, hi = P.ph_hi;
    unsigned char* ws = P.ws;
#define IN(k) (lo <= (k) && (k) < hi)
#define SEAM(k) do { if (IN(k) && IN((k) + 1)) grid.sync(); } while (0)
    if (IN(0)) phase_prologue(P);
    SEAM(0);
    if (IN(1)) {
        pg8::Gemm g{(const bf16*)(ws + WS_H0), (const bf16*)(ws + WS_WIN), M, NP, D, D, D, 0}; pg8::StaticOrder S; S.init(M, NP, gridDim.x, blockIdx.x);
        pg8::EpiBf16 E{(bf16*)(ws + WS_P), NP};
        pg8::gemm_phase<pg8::EpiBf16, pg8::StaticOrder, true, true>(lds, g, S, E);
    }
    SEAM(1);
    if (IN(2)) phase_prep(P, lds);
    SEAM(2);
    if (IN(3)) phase_scan(P, lds);
    SEAM(3);
    if (IN(4)) {
        pg8::Gemm g{(const bf16*)(ws + WS_MIX), (const bf16*)(ws + WS_WOUT), M, D, D, D, D, 0}; pg8::StaticOrder S; S.init(M, D, gridDim.x, blockIdx.x);
        pg8::EpiResF32 E{(float*)(ws + WS_Z), (const bf16*)(ws + WS_H0), D, ALPHA};
        pg8::gemm_phase<pg8::EpiResF32, pg8::StaticOrder, true, true>(lds, g, S, E);
    }
    SEAM(4);
    if (IN(5)) phase_ln1(P);
    SEAM(5);
    if (IN(6)) {
        pg8::Gemm g{(const bf16*)(ws + WS_H1), (const bf16*)(ws + WS_WQ), M, NQ, D, D, D, 0}; pg8::StaticOrder S; S.init(M, NQ, gridDim.x, blockIdx.x);
        pg8::EpiBf16 E{(bf16*)(ws + WS_Q), NQ};
        pg8::gemm_phase<pg8::EpiBf16, pg8::StaticOrder, true, true>(lds, g, S, E);
    }
    SEAM(6);
    if (IN(7)) {
        pg8::Gemm g{(const bf16*)(ws + WS_Q), (const bf16*)(ws + WS_KBD), M, NQ, 256, NQ, 256, 256}; pg8::StaticOrder S; S.init(M, NQ, gridDim.x, blockIdx.x);
        pg8::EpiBf16 E{(bf16*)(ws + WS_S), NQ};
        pg8::gemm_phase<pg8::EpiBf16, pg8::StaticOrder, true, true>(lds, g, S, E);
    }
    SEAM(7);
    if (IN(8)) phase_topk(P);
    SEAM(8);
    if (IN(9)) phase_peer(P);
#undef IN
#undef SEAM
}

extern "C" void kernel_launch(void* const* d_in, const int* in_sizes, int n_in, void* d_out, int out_size, void* d_ws, size_t ws_size, hipStream_t stream) {
    static int grid = 0;
    if (grid == 0) {
        if (n_in != 28 || out_size != M * D || ws_size < WS_END) { fprintf(stderr, "kernel_launch: unexpected shapes (n_in %d out %d ws %zu)\n", n_in, out_size, ws_size); grid = -1; return; }
        int dev = 0, cus = 0, per_cu = 0;
        (void)hipGetDevice(&dev); (void)hipDeviceGetAttribute(&cus, hipDeviceAttributeMultiprocessorCount, dev);
        (void)hipFuncSetAttribute((const void*)fwd_kernel, hipFuncAttributeMaxDynamicSharedMemorySize, LDS_BYTES);
        (void)hipOccupancyMaxActiveBlocksPerMultiprocessor(&per_cu, (const void*)fwd_kernel, NTHR, LDS_BYTES);
        if (per_cu < 1) { fprintf(stderr, "kernel_launch: occupancy query says %d blocks per CU\n", per_cu); per_cu = 1; }
        (void)hipGetLastError();
        grid = cus;
    }
    if (grid < 0) return;
    Params p{};
    for (int i = 0; i < 28; ++i) p.in[i] = (const float*)d_in[i];
    p.out = (float*)d_out; p.ws = (unsigned char*)d_ws;
#if MK_ONE_LAUNCH
    p.ph_lo = 0; p.ph_hi = N_PHASES;
    void* args[] = {&p};
    hipError_t e = hipLaunchCooperativeKernel((const void*)fwd_kernel, dim3(grid), dim3(NTHR), args, LDS_BYTES, stream);
    if (e != hipSuccess) fprintf(stderr, "cooperative launch failed: %s (grid %d)\n", hipGetErrorString(e), grid);
#else
    for (int ph = 0; ph < N_PHASES; ++ph) {
        p.ph_lo = ph; p.ph_hi = ph + 1;
        hipLaunchKernelGGL(fwd_kernel, dim3(grid), dim3(NTHR), LDS_BYTES, stream, p);
    }
#endif
}
```

```cpp
#include <hip/hip_runtime.h>
#include <hip/hip_cooperative_groups.h>
#include <cstdio>
#include <cstdint>
namespace cg = cooperative_groups;

#ifndef MK_ONE_LAUNCH
#define MK_ONE_LAUNCH 1
#endif

namespace pg8 {
#define PG8_LAS __attribute__((address_space(3)))
typedef unsigned short bf16_t;
typedef short bf16x8 __attribute__((ext_vector_type(8)));
typedef float f32x4 __attribute__((ext_vector_type(4)));
typedef unsigned u32x4 __attribute__((ext_vector_type(4)));
typedef unsigned u32x2 __attribute__((ext_vector_type(2)));
constexpr int BM = 256, BK = 64, HALF = 128, HTB = HALF * BK * 2, STAGE_BYTES = 8 * HTB, NXCD = 8, WGM = 8;

__host__ __device__ __forceinline__ int lds_byte(int r, int c) { const int st = (r >> 4) * 2 + (c >> 5), rr = r & 15, cc = c & 31, ob = rr * 64 + cc * 2; return st * 1024 + (ob ^ (((ob >> 9) & 1) << 5)); }
__host__ __device__ __forceinline__ void stage_rc(int b, int& R, int& C) { const int st = b / 1024, sb = b % 1024, swz = sb ^ (((sb >> 9) & 1) << 5); R = (st >> 1) * 16 + swz / 64; C = (st & 1) * 32 + (swz % 64) / 2; }
__host__ __device__ __forceinline__ int perm32(int rho) { const int n = rho >> 4, i = rho & 15; return 8 * (i >> 2) + 4 * n + (i & 3); }

struct Unit { int pm, pn; };
struct Gemm { const bf16_t* A; const bf16_t* Bt; int M, N, K, lda, ldb, a_pn_koff; };

struct StaticOrder {
    int nM, nN, nwg, G, c;
    __host__ __device__ void init(int M, int N, int G_, int c_) { nM = M / BM; nN = N / BM; nwg = nM * nN; G = G_; c = c_; }
    __host__ __device__ bool next(int i, Unit& u) const {
        const long L = (long)i * G + c; if (L >= nwg) return false;
        int wgid = (int)L; { const int q = nwg / NXCD, r = nwg % NXCD, xcd = wgid % NXCD, off = wgid / NXCD; wgid = (xcd < r ? xcd * (q + 1) : r * (q + 1) + (xcd - r) * q) + off; }
        const int nig = WGM * nN, gid = wgid / nig, fm = gid * WGM, gsz = (nM - fm) < WGM ? (nM - fm) : WGM;
        u.pm = fm + ((wgid % nig) % gsz); u.pn = (wgid % nig) / gsz; return true;
    }
    __device__ __forceinline__ void a_ready(const Unit&) const {}
    __device__ __forceinline__ void done(const Unit&) const {}
};

__device__ __forceinline__ unsigned cvt_pk_bf16(float lo, float hi) { unsigned r; asm volatile("v_cvt_pk_bf16_f32 %0, %1, %2" : "=v"(r) : "v"(lo), "v"(hi)); return r; }

struct EpiBf16 {
    static constexpr bool PERM = true;
    bf16_t* O; int ldc;
    __device__ __forceinline__ void operator()(const f32x4 (&acc)[2][2][4][2], const Unit& u, int wr, int wc, int fr, int fq) const {
        const int row0 = u.pm * BM + wr * 64 + fr; const int col0 = u.pn * BM + wc * 32 + 8 * fq;
#pragma unroll
        for (int ai = 0; ai < 2; ++ai)
#pragma unroll
            for (int m = 0; m < 4; ++m) { bf16_t* rowp = O + (size_t)(row0 + ai * HALF + m * 16) * ldc + col0;
#pragma unroll
                for (int bj = 0; bj < 2; ++bj) { const f32x4 v0 = acc[ai][bj][m][0], v1 = acc[ai][bj][m][1];
                    u32x4 w; w.x = cvt_pk_bf16(v0[0], v0[1]); w.y = cvt_pk_bf16(v0[2], v0[3]); w.z = cvt_pk_bf16(v1[0], v1[1]); w.w = cvt_pk_bf16(v1[2], v1[3]);
                    *(u32x4*)(rowp + bj * HALF) = w; } }
    }
};
struct EpiResF32 {
    static constexpr bool PERM = false;
    float* Z; const bf16_t* R; int ldc; float alpha;
    __device__ __forceinline__ void operator()(const f32x4 (&acc)[2][2][4][2], const Unit& u, int wr, int wc, int fr, int fq) const {
        const int row0 = u.pm * BM + wr * 64 + fr; const int col0 = u.pn * BM + wc * 32 + 4 * fq;
#pragma unroll
        for (int ai = 0; ai < 2; ++ai)
#pragma unroll
            for (int m = 0; m < 4; ++m) { const size_t off = (size_t)(row0 + ai * HALF + m * 16) * ldc + col0;
#pragma unroll
                for (int bj = 0; bj < 2; ++bj)
#pragma unroll
                    for (int n = 0; n < 2; ++n) { const size_t o2 = off + bj * HALF + n * 16; const u32x2 rb = *(const u32x2*)(R + o2);
                        f32x4 h; h[0] = __uint_as_float(rb.x << 16); h[1] = __uint_as_float(rb.x & 0xffff0000u); h[2] = __uint_as_float(rb.y << 16); h[3] = __uint_as_float(rb.y & 0xffff0000u);
                        *(f32x4*)(Z + o2) = h * alpha + acc[ai][bj][m][n]; } }
    }
};

template <class Epi, class Sched, bool ALIGN_EPI = false, bool SP2 = false>
__device__ __forceinline__ void gemm_phase(PG8_LAS unsigned char* lds, const Gemm g, const Sched& S, const Epi& E) {
    const int tid = threadIdx.x, wid = __builtin_amdgcn_readfirstlane(tid >> 6), lane = tid & 63, wr = wid >> 2, wc = wid & 3, fr = lane & 15, fq = lane >> 4;
    const int K = g.K, nt = K / BK;
    unsigned voffA[2], voffB[2];
#pragma unroll
    for (int i = 0; i < 2; ++i) { int R, C; stage_rc(tid * 16 + i * 8192, R, C); const int Rb = Epi::PERM ? ((R & ~31) + perm32(R & 31)) : R;
        voffA[i] = (unsigned)(R * g.lda + C) * 2u; voffB[i] = (unsigned)(Rb * g.ldb + C) * 2u; }
    const size_t kstep = (size_t)(BK * 2);
    const size_t hstepA = (size_t)HALF * g.lda * 2, hstepB = (size_t)HALF * g.ldb * 2;
    const size_t tstepA = 2 * hstepA, tstepB = 2 * hstepB;
    const size_t pnA = (size_t)g.a_pn_koff * 2;
    const unsigned ldsw = (unsigned)wid * 1024u;
    const int aoff = lds_byte(wr * 64 + fr, fq * 8), boff = lds_byte(wc * 32 + fr, fq * 8);
#define PG8_SA(b, h) (((b) * 2 + (h)) * HTB)
#define PG8_SB(b, h) ((4 + (b) * 2 + (h)) * HTB)
#define PG8_STAGE(bufoff, gbase, voff) do { _Pragma("unroll") for (int _i = 0; _i < 2; ++_i) \
        __builtin_amdgcn_global_load_lds((const unsigned*)((const char*)(gbase) + (voff)[_i]), (PG8_LAS unsigned*)(lds + (bufoff) + ldsw + _i * 8192), 16, 0, 0); } while (0)
#define PG8_LDA(dst, b, h) do { _Pragma("unroll") for (int m = 0; m < 4; ++m) _Pragma("unroll") for (int k = 0; k < 2; ++k) dst[m][k] = *(const PG8_LAS bf16x8*)(lds + PG8_SA(b, h) + aoff + m * 2048 + k * 1024); } while (0)
#define PG8_LDB(dst, b, h) do { _Pragma("unroll") for (int n = 0; n < 2; ++n) _Pragma("unroll") for (int k = 0; k < 2; ++k) dst[n][k] = *(const PG8_LAS bf16x8*)(lds + PG8_SB(b, h) + boff + n * 2048 + k * 1024); } while (0)
#define PG8_MMA(ai, bj, At, Bt) do { __builtin_amdgcn_s_setprio(1); _Pragma("unroll") for (int m = 0; m < 4; ++m) _Pragma("unroll") for (int n = 0; n < 2; ++n) _Pragma("unroll") for (int k = 0; k < 2; ++k) \
        acc[ai][bj][m][n] = __builtin_amdgcn_mfma_f32_16x16x32_bf16(Bt[n][k], At[m][k], acc[ai][bj][m][n], 0, 0, 0); __builtin_amdgcn_s_setprio(0); } while (0)
#define PG8_WAIT_V(n) asm volatile("s_waitcnt vmcnt(" #n ")" ::: "memory")
#define PG8_WAIT_L(n) asm volatile("s_waitcnt lgkmcnt(" #n ")" ::: "memory")
#define PG8_BAR __builtin_amdgcn_s_barrier()
#define PG8_SCHED __builtin_amdgcn_sched_barrier(0)
    Unit cur, nxt; int ui = 0;
    if (!S.next(0, cur)) return;
    f32x4 acc[2][2][4][2];
#pragma unroll
    for (int a = 0; a < 2; ++a)
#pragma unroll
        for (int b = 0; b < 2; ++b)
#pragma unroll
            for (int m = 0; m < 4; ++m)
#pragma unroll
                for (int n = 0; n < 2; ++n) acc[a][b][m][n] = (f32x4){0.f, 0.f, 0.f, 0.f};
    bf16x8 At[4][2], B0[2][2], B1[2][2];
    const char* cA = (const char*)g.A + (size_t)cur.pm * tstepA + (size_t)cur.pn * pnA; const char* cB = (const char*)g.Bt + (size_t)cur.pn * tstepB;
    S.a_ready(cur);
    if constexpr (SP2) {
        PG8_STAGE(PG8_SB(0, 0), cB, voffB); PG8_STAGE(PG8_SB(0, 1), cB + hstepB, voffB); PG8_STAGE(PG8_SA(0, 0), cA, voffA); PG8_STAGE(PG8_SA(0, 1), cA + hstepA, voffA);
        if (wr == 1) PG8_BAR;
        PG8_WAIT_V(2); PG8_BAR;
        PG8_STAGE(PG8_SB(1, 0), cB + kstep, voffB); PG8_STAGE(PG8_SA(1, 0), cA + kstep, voffA); PG8_STAGE(PG8_SB(1, 1), cB + hstepB + kstep, voffB);
        PG8_WAIT_V(6); PG8_BAR;
    } else {
        PG8_STAGE(PG8_SB(0, 0), cB, voffB); PG8_STAGE(PG8_SA(0, 0), cA, voffA); PG8_STAGE(PG8_SB(0, 1), cB + hstepB, voffB); PG8_STAGE(PG8_SA(0, 1), cA + hstepA, voffA);
        if (wr == 1) PG8_BAR;
        PG8_WAIT_V(4); PG8_BAR;
        PG8_STAGE(PG8_SB(1, 0), cB + kstep, voffB); PG8_STAGE(PG8_SA(1, 0), cA + kstep, voffA); PG8_STAGE(PG8_SB(1, 1), cB + hstepB + kstep, voffB);
        PG8_WAIT_V(6); PG8_BAR;
    }
    for (;;) {
        const bool has_next = S.next(ui + 1, nxt);
        const char* nA = has_next ? (const char*)g.A + (size_t)nxt.pm * tstepA + (size_t)nxt.pn * pnA : cA; const char* nB = has_next ? (const char*)g.Bt + (size_t)nxt.pn * tstepB : cB;
        for (int t = 0; t < nt; t += 2) {
            const bool last = (t == nt - 2);
            const char* a1 = cA + (size_t)(t + 1) * kstep;
            const char* a2 = last ? nA : cA + (size_t)(t + 2) * kstep; const char* b2 = last ? nB : cB + (size_t)(t + 2) * kstep;
            const char* a3 = a2 + kstep; const char* b3 = b2 + kstep;
            if (last && has_next) S.a_ready(nxt);
            if constexpr (SP2) {
            PG8_LDB(B0, 0, 0); PG8_LDB(B1, 0, 1); PG8_SCHED; PG8_LDA(At, 0, 0); PG8_STAGE(PG8_SA(1, 1), a1 + hstepA, voffA);
            PG8_WAIT_V(8); PG8_WAIT_L(0); PG8_BAR; PG8_MMA(0, 0, At, B0); PG8_MMA(0, 1, At, B1); PG8_BAR; PG8_SCHED;
            PG8_LDA(At, 0, 1); PG8_STAGE(PG8_SB(0, 0), b2, voffB); PG8_STAGE(PG8_SB(0, 1), b2 + hstepB, voffB); PG8_STAGE(PG8_SA(0, 0), a2, voffA);
            PG8_WAIT_V(8); PG8_WAIT_L(0); PG8_BAR; PG8_MMA(1, 0, At, B0); PG8_MMA(1, 1, At, B1); PG8_BAR; PG8_SCHED;
            PG8_LDB(B0, 1, 0); PG8_LDB(B1, 1, 1); PG8_SCHED; PG8_LDA(At, 1, 0); PG8_STAGE(PG8_SA(0, 1), a2 + hstepA, voffA);
            PG8_WAIT_V(8); PG8_WAIT_L(0); PG8_BAR; PG8_MMA(0, 0, At, B0); PG8_MMA(0, 1, At, B1); PG8_BAR; PG8_SCHED;
            PG8_LDA(At, 1, 1); PG8_STAGE(PG8_SB(1, 0), b3, voffB); PG8_STAGE(PG8_SB(1, 1), b3 + hstepB, voffB); PG8_STAGE(PG8_SA(1, 0), a3, voffA);
            PG8_WAIT_V(8); PG8_WAIT_L(0); PG8_BAR; PG8_MMA(1, 0, At, B0); PG8_MMA(1, 1, At, B1); PG8_BAR; PG8_SCHED;
            } else {
            PG8_LDB(B0, 0, 0); PG8_SCHED; PG8_LDA(At, 0, 0); PG8_STAGE(PG8_SA(1, 1), a1 + hstepA, voffA);
            PG8_WAIT_L(8); PG8_BAR; PG8_WAIT_L(0); PG8_MMA(0, 0, At, B0); PG8_BAR; PG8_SCHED;
            PG8_LDB(B1, 0, 1); PG8_STAGE(PG8_SB(0, 0), b2, voffB);
            PG8_BAR; PG8_WAIT_L(0); PG8_MMA(0, 1, At, B1); PG8_BAR;
            PG8_LDA(At, 0, 1); PG8_STAGE(PG8_SA(0, 0), a2, voffA);
            PG8_BAR; PG8_WAIT_L(0); PG8_MMA(1, 0, At, B0); PG8_BAR; PG8_SCHED;
            PG8_STAGE(PG8_SB(0, 1), b2 + hstepB, voffB);
            PG8_WAIT_V(6); PG8_BAR; PG8_MMA(1, 1, At, B1); PG8_BAR;
            PG8_LDB(B0, 1, 0); PG8_SCHED; PG8_LDA(At, 1, 0); PG8_STAGE(PG8_SA(0, 1), a2 + hstepA, voffA);
            PG8_WAIT_L(8); PG8_BAR; PG8_WAIT_L(0); PG8_MMA(0, 0, At, B0); PG8_BAR; PG8_SCHED;
            PG8_LDB(B1, 1, 1); PG8_STAGE(PG8_SB(1, 0), b3, voffB);
            PG8_BAR; PG8_WAIT_L(0); PG8_MMA(0, 1, At, B1); PG8_BAR;
            PG8_LDA(At, 1, 1); PG8_STAGE(PG8_SA(1, 0), a3, voffA);
            PG8_BAR; PG8_WAIT_L(0); PG8_MMA(1, 0, At, B0); PG8_BAR; PG8_SCHED;
            PG8_STAGE(PG8_SB(1, 1), b3 + hstepB, voffB);
            PG8_WAIT_V(6); PG8_BAR; PG8_MMA(1, 1, At, B1); PG8_BAR;
            }
        }
        if constexpr (ALIGN_EPI) { if (wr == 0) PG8_BAR; }
        E(acc, cur, wr, wc, fr, fq); S.done(cur);
        if (!has_next) break;
#pragma unroll
        for (int a = 0; a < 2; ++a)
#pragma unroll
            for (int b = 0; b < 2; ++b)
#pragma unroll
                for (int m = 0; m < 4; ++m)
#pragma unroll
                    for (int n = 0; n < 2; ++n) acc[a][b][m][n] = (f32x4){0.f, 0.f, 0.f, 0.f};
        cur = nxt; cA = nA; cB = nB; ++ui;
        if constexpr (ALIGN_EPI) { if (wr == 1) PG8_BAR; }
    }
    PG8_WAIT_V(0);
    if constexpr (!ALIGN_EPI) { if (wr == 0) PG8_BAR; }
    PG8_BAR;
#undef PG8_SA
#undef PG8_SB
#undef PG8_STAGE
#undef PG8_LDA
#undef PG8_LDB
#undef PG8_MMA
#undef PG8_WAIT_V
#undef PG8_WAIT_L
#undef PG8_BAR
#undef PG8_SCHED
}
}

constexpr int NWAVES = 8, NTHR = NWAVES * 64;
constexpr int D = 1024, NBATCH = 4, T = 8192, M = NBATCH * T;
constexpr int A_W = 512, A_IN = 1792, IN_COLS = 3344, NP = 3584;
constexpr int C_R = 0, C_K = 512, C_V = 1024, C_WD = 1536, C_AD = 1600, C_GD = 1664;
constexpr int C_BQ = 1792, C_BK = 2048, C_BV = 2304, C_GKD = 2816, C_BG = 2832;
constexpr int NQ = 2048;
constexpr float LN_EPS = 1e-5f, GN_EPS = 64e-5f, RMS_EPS = 1e-5f;
constexpr float ALPHA = 1.189207115002721f;

typedef unsigned short bf16;
typedef float f32x4 __attribute__((ext_vector_type(4)));
typedef unsigned u32x4 __attribute__((ext_vector_type(4)));
typedef unsigned u32x2 __attribute__((ext_vector_type(2)));
#define LAS __attribute__((address_space(3)))

constexpr size_t MiB = 1u << 20;
constexpr size_t WS_WIN = 1 * MiB, WS_WOUT = 8 * MiB, WS_WQ = 10 * MiB, WS_KBD = 14 * MiB;
constexpr size_t WS_H0 = 16 * MiB;
constexpr size_t WS_P = 80 * MiB;
constexpr size_t WS_WL = 304 * MiB, WS_AA = 336 * MiB, WS_GG = 368 * MiB;
constexpr size_t WS_GK = 400 * MiB;
constexpr size_t WS_MIX = 416 * MiB;
constexpr size_t WS_Z = 80 * MiB;
constexpr size_t WS_H1 = 208 * MiB;
constexpr size_t WS_Q = 272 * MiB;
constexpr size_t WS_S = 80 * MiB;
constexpr size_t WS_IDS = 400 * MiB, WS_GATES = 416 * MiB;
constexpr size_t WS_UT = 432 * MiB, WS_VT = 464 * MiB;
constexpr size_t WS_END = 496 * MiB;

constexpr int LDS_BYTES = 147456;

struct Params {
    const float* in[28];
    float* out; unsigned char* ws;
    int ph_lo, ph_hi;
};

__device__ __forceinline__ float bf2f(unsigned u) { return __uint_as_float(u << 16); }
__device__ __forceinline__ unsigned f2bf(float f) { unsigned u = __float_as_uint(f); return (u + 0x7fffu + ((u >> 16) & 1u)) >> 16; }
__device__ __forceinline__ unsigned pk2(float lo, float hi) { return f2bf(lo) | (f2bf(hi) << 16); }
__device__ __forceinline__ float wave_sum(float v) {
#pragma unroll
    for (int o = 1; o < 64; o <<= 1) v += __shfl_xor(v, o);
    return v;
}
__device__ __forceinline__ float wave_max(float v) {
#pragma unroll
    for (int o = 1; o < 64; o <<= 1) v = fmaxf(v, __shfl_xor(v, o));
    return v;
}
__device__ __forceinline__ int wave_min_i(int v) {
#pragma unroll
    for (int o = 1; o < 64; o <<= 1) v = min(v, __shfl_xor(v, o));
    return v;
}
__device__ __forceinline__ float sigmoidf_(float x) { return 1.f / (1.f + __expf(-x)); }
__device__ __forceinline__ float softplusf_(float x) { return fmaxf(x, 0.f) + log1pf(__expf(-fabsf(x))); }
__device__ __forceinline__ float siluf_(float x) { return x * sigmoidf_(x); }

__device__ __forceinline__ void transpose_convert(const float* W, int K, int N, int Npad, bf16* WT, int gtid, int gthreads) {
    const int kc = K / 8, total = Npad * kc;
    for (int idx = gtid; idx < total; idx += gthreads) {
        const int n = idx % Npad, c = idx / Npad; float v[8];
#pragma unroll
        for (int j = 0; j < 8; ++j) v[j] = (n < N) ? W[(size_t)(8 * c + j) * N + n] : 0.f;
        u32x4 o; o.x = pk2(v[0], v[1]); o.y = pk2(v[2], v[3]); o.z = pk2(v[4], v[5]); o.w = pk2(v[6], v[7]);
        *(u32x4*)(WT + (size_t)n * K + 8 * c) = o;
    }
}
__device__ __forceinline__ void ln_row_bf16(const float* xrow, const float* g, const float* b, bf16* orow, int lane) {
    const f32x4* xr = (const f32x4*)xrow + lane; f32x4 v[4]; float s = 0.f;
#pragma unroll
    for (int j = 0; j < 4; ++j) { v[j] = xr[64 * j]; s += (v[j][0] + v[j][1]) + (v[j][2] + v[j][3]); }
    const float mean = wave_sum(s) * (1.f / D); float s2 = 0.f;
#pragma unroll
    for (int j = 0; j < 4; ++j) { v[j] = v[j] - mean; s2 += (v[j][0] * v[j][0] + v[j][1] * v[j][1]) + (v[j][2] * v[j][2] + v[j][3] * v[j][3]); }
    const float rstd = 1.f / sqrtf(wave_sum(s2) * (1.f / D) + LN_EPS);
    u32x2* o8 = (u32x2*)orow + lane;
#pragma unroll
    for (int j = 0; j < 4; ++j) { const f32x4 gg = ((const f32x4*)g)[lane + 64 * j], bb = ((const f32x4*)b)[lane + 64 * j]; const f32x4 y = v[j] * rstd * gg + bb;
        u32x2 w; w.x = pk2(y[0], y[1]); w.y = pk2(y[2], y[3]); o8[64 * j] = w; }
}
__device__ __forceinline__ void phase_prologue(const Params& P) {
    const int tid = threadIdx.x, lane = tid & 63, wave = tid >> 6;
    const int gtid = blockIdx.x * NTHR + tid, gthreads = gridDim.x * NTHR;
    unsigned char* ws = P.ws;
    transpose_convert(P.in[3], D, IN_COLS, NP, (bf16*)(ws + WS_WIN), gtid, gthreads);
    transpose_convert(P.in[19], D, D, D, (bf16*)(ws + WS_WOUT), gtid, gthreads);
    transpose_convert(P.in[22], D, NQ, NQ, (bf16*)(ws + WS_WQ), gtid, gthreads);
    {
        const float* keys = P.in[23]; bf16* kbd = (bf16*)(ws + WS_KBD);
        for (int idx = gtid; idx < 8 * 256 * 32; idx += gthreads) {
            const int kc = idx & 31, n = (idx >> 5) & 255, h = idx >> 13; const int k0 = kc * 8, hn = n >> 7, key = n & 127, hk = k0 >> 7, c0 = k0 & 127;
            u32x4 o = (u32x4){0u, 0u, 0u, 0u};
            if (hn == hk) { const float* s = keys + ((size_t)((h * 2 + hn) * 128 + key)) * 128 + c0; o.x = pk2(s[0], s[1]); o.y = pk2(s[2], s[3]); o.z = pk2(s[4], s[5]); o.w = pk2(s[6], s[7]); }
            *(u32x4*)(kbd + ((size_t)(h * 256 + n)) * 256 + k0) = o;
        }
    }
    const int gw = blockIdx.x * NWAVES + wave, ngw = gridDim.x * NWAVES;
    for (int m = gw; m < M; m += ngw) ln_row_bf16(P.in[0] + (size_t)m * D, P.in[1], P.in[2], (bf16*)(ws + WS_H0) + (size_t)m * D, lane);
}

__device__ __forceinline__ void phase_prep(const Params& P, LAS unsigned char* lds) {
    const int tid = threadIdx.x;
    unsigned char* ws = P.ws;
    const bf16* p = (const bf16*)(ws + WS_P);
    const float* mu = P.in[4]; const float* w0 = P.in[5]; const float* w2 = P.in[6]; const float* a0 = P.in[7]; const float* a2 = P.in[8]; const float* g2 = P.in[9];
    const float* gkw2 = P.in[16]; const float* gkb = P.in[17];
    bf16* WL = (bf16*)(ws + WS_WL); bf16* AA = (bf16*)(ws + WS_AA); bf16* GG = (bf16*)(ws + WS_GG); bf16* GK = (bf16*)(ws + WS_GK);
    LAS float* act = (LAS float*)lds;
    LAS float* gkd = (LAS float*)(lds + 64 * 260 * 4);
    constexpr int AS = 260;
    for (int tile = blockIdx.x; tile < M / 64; tile += gridDim.x) {
        const int m0 = tile * 64;
        __syncthreads();
        for (int idx = tid; idx < 64 * 256; idx += NTHR) {
            const int j = idx & 255, tok = idx >> 8, m = m0 + tok, t = m & (T - 1);
            const float cur = bf2f(p[(size_t)m * NP + C_WD + j]);
            const float prev = (t > 0) ? bf2f(p[(size_t)(m - 1) * NP + C_WD + j]) : 0.f;
            const float x = cur + (prev - cur) * mu[C_WD + j];
            float v;
            if (j < 64) v = tanhf(x); else if (j < 128) v = x; else v = sigmoidf_(x);
            act[tok * AS + j] = v;
        }
        for (int idx = tid; idx < 64 * 16; idx += NTHR) { const int j = idx & 15, tok = idx >> 4; gkd[tok * 16 + j] = bf2f(p[(size_t)(m0 + tok) * NP + C_GKD + j]); }
        __syncthreads();
        const int c = tid;
        float acc[64];
#pragma unroll
        for (int i = 0; i < 64; ++i) acc[i] = 0.f;
        for (int j = 0; j < 64; j += 4) {
            const float x0 = w2[(j + 0) * A_W + c], x1 = w2[(j + 1) * A_W + c], x2 = w2[(j + 2) * A_W + c], x3 = w2[(j + 3) * A_W + c];
#pragma unroll
            for (int i = 0; i < 64; ++i) { const f32x4 a = *(const LAS f32x4*)(act + i * AS + j); acc[i] += a[0] * x0 + a[1] * x1 + a[2] * x2 + a[3] * x3; }
        }
        { const float b0 = w0[c];
#pragma unroll
          for (int i = 0; i < 64; ++i) { const float z = b0 + acc[i]; const float w = -softplusf_(-z) - 0.5f; WL[(size_t)(m0 + i) * A_W + c] = (bf16)f2bf(-__expf(w)); } }
#pragma unroll
        for (int i = 0; i < 64; ++i) acc[i] = 0.f;
        for (int j = 0; j < 64; j += 4) {
            const float x0 = a2[(j + 0) * A_W + c], x1 = a2[(j + 1) * A_W + c], x2 = a2[(j + 2) * A_W + c], x3 = a2[(j + 3) * A_W + c];
#pragma unroll
            for (int i = 0; i < 64; ++i) { const f32x4 a = *(const LAS f32x4*)(act + i * AS + 64 + j); acc[i] += a[0] * x0 + a[1] * x1 + a[2] * x2 + a[3] * x3; }
        }
        { const float b0 = a0[c];
#pragma unroll
          for (int i = 0; i < 64; ++i) AA[(size_t)(m0 + i) * A_W + c] = (bf16)f2bf(sigmoidf_(b0 + acc[i])); }
#pragma unroll
        for (int i = 0; i < 64; ++i) acc[i] = 0.f;
        for (int j = 0; j < 128; j += 4) {
            const float x0 = g2[(j + 0) * A_W + c], x1 = g2[(j + 1) * A_W + c], x2 = g2[(j + 2) * A_W + c], x3 = g2[(j + 3) * A_W + c];
#pragma unroll
            for (int i = 0; i < 64; ++i) { const f32x4 a = *(const LAS f32x4*)(act + i * AS + 128 + j); acc[i] += a[0] * x0 + a[1] * x1 + a[2] * x2 + a[3] * x3; }
        }
#pragma unroll
        for (int i = 0; i < 64; ++i) GG[(size_t)(m0 + i) * A_W + c] = (bf16)f2bf(acc[i]);
        { const int cc = tid & 255, th = tid >> 8; float wv[16];
#pragma unroll
          for (int j = 0; j < 16; ++j) wv[j] = gkw2[j * 256 + cc];
          const float bb = gkb[cc];
          for (int i = 0; i < 32; ++i) { const int tok = th * 32 + i; float s = bb;
#pragma unroll
              for (int j = 0; j < 16; ++j) s += gkd[tok * 16 + j] * wv[j];
              GK[(size_t)(m0 + tok) * 256 + cc] = (bf16)f2bf(-softplusf_(-s) * (1.f / 16.f)); } }
    }
}

constexpr int CH = 32;
__device__ __forceinline__ float red8(float v) { v += __shfl_xor(v, 1); v += __shfl_xor(v, 2); v += __shfl_xor(v, 4); return v; }
__device__ __forceinline__ float red4(float v) { v += __shfl_xor(v, 1); v += __shfl_xor(v, 2); return v; }

__device__ __forceinline__ void rwkv_item(const Params& P, LAS unsigned char* lds, int b, int h) {
    const int tid = threadIdx.x, lane = tid & 63, wave = tid >> 6;
    unsigned char* ws = P.ws;
    const bf16* p = (const bf16*)(ws + WS_P); const bf16* WL = (const bf16*)(ws + WS_WL); const bf16* AA = (const bf16*)(ws + WS_AA); const bf16* GG = (const bf16*)(ws + WS_GG);
    bf16* MIX = (bf16*)(ws + WS_MIX);
    const float* mu = P.in[4]; const float* k_k = P.in[10]; const float* k_a = P.in[11]; const float* r_k = P.in[12]; const float* gn_g = P.in[13]; const float* gn_b = P.in[14];
    LAS float* R = (LAS float*)lds; LAS float* DEC = R + CH * 64; LAS float* KH = DEC + CH * 64; LAS float* KK = KH + CH * 64; LAS float* BB = KK + CH * 64; LAS float* V = BB + CH * 64;
    LAS float* Y = V + CH * 64; LAS float* BON = Y + CH * 64;
    const int col = h * 64 + lane;
    const float mu_r = mu[C_R + col], mu_k = mu[C_K + col], mu_v = mu[C_V + col], kkc = k_k[col], kac = k_a[col], rkc = r_k[col], gng = gn_g[col], gnb = gn_b[col];
    float S[8];
#pragma unroll
    for (int j = 0; j < 8; ++j) S[j] = 0.f;
    const int row = wave * 8 + (lane >> 3), ks = (lane & 7) * 8;
    for (int t0 = 0; t0 < T; t0 += CH) {
        __syncthreads();
        for (int tt = wave; tt < CH; tt += NWAVES) {
            const int t = t0 + tt; const size_t m = (size_t)b * T + t;
            const bf16* pr = p + m * NP; const bf16* pp = pr - NP; const bool hp = t > 0;
            const float rc = bf2f(pr[C_R + col]), kc = bf2f(pr[C_K + col]), vc = bf2f(pr[C_V + col]);
            const float rp = hp ? bf2f(pp[C_R + col]) : 0.f, kp = hp ? bf2f(pp[C_K + col]) : 0.f, vp = hp ? bf2f(pp[C_V + col]) : 0.f;
            const float r = rc + (rp - rc) * mu_r, k = kc + (kp - kc) * mu_k, v = vc + (vp - vc) * mu_v;
            const float a = bf2f(AA[m * A_W + col]), wl = bf2f(WL[m * A_W + col]);
            const float kr = k * kkc; const float nrm = sqrtf(wave_sum(kr * kr)); const float kk = kr / fmaxf(nrm, 1e-12f);
            const float kh = k * (1.f + (a - 1.f) * kac);
            const float bon = wave_sum(r * kh * rkc);
            R[tt * 64 + lane] = r; DEC[tt * 64 + lane] = __expf(wl); KH[tt * 64 + lane] = kh; KK[tt * 64 + lane] = kk; BB[tt * 64 + lane] = kk * a; V[tt * 64 + lane] = v;
            if (lane == 0) BON[tt] = bon;
        }
        __syncthreads();
        for (int tt = 0; tt < CH; ++tt) {
            const f32x4 k0 = *(const LAS f32x4*)(KK + tt * 64 + ks), k1 = *(const LAS f32x4*)(KK + tt * 64 + ks + 4);
            const f32x4 d0 = *(const LAS f32x4*)(DEC + tt * 64 + ks), d1 = *(const LAS f32x4*)(DEC + tt * 64 + ks + 4);
            const f32x4 b0 = *(const LAS f32x4*)(BB + tt * 64 + ks), b1 = *(const LAS f32x4*)(BB + tt * 64 + ks + 4);
            const f32x4 h0 = *(const LAS f32x4*)(KH + tt * 64 + ks), h1 = *(const LAS f32x4*)(KH + tt * 64 + ks + 4);
            const f32x4 r0 = *(const LAS f32x4*)(R + tt * 64 + ks), r1 = *(const LAS f32x4*)(R + tt * 64 + ks + 4);
            const float vv = V[tt * 64 + row];
            float sa = 0.f;
#pragma unroll
            for (int j = 0; j < 4; ++j) sa += S[j] * k0[j] + S[4 + j] * k1[j];
            sa = -red8(sa);
            float y = 0.f;
#pragma unroll
            for (int j = 0; j < 4; ++j) {
                S[j] = S[j] * d0[j] + sa * b0[j] + vv * h0[j]; S[4 + j] = S[4 + j] * d1[j] + sa * b1[j] + vv * h1[j];
                y += S[j] * r0[j] + S[4 + j] * r1[j];
            }
            y = red8(y);
            if ((lane & 7) == 0) Y[tt * 64 + row] = y;
        }
        __syncthreads();
        for (int tt = wave; tt < CH; tt += NWAVES) {
            const size_t m = (size_t)b * T + t0 + tt;
            const float y = Y[tt * 64 + lane]; const float mean = wave_sum(y) * (1.f / 64.f); const float d = y - mean; const float var = wave_sum(d * d) * (1.f / 64.f);
            float o = d * (1.f / sqrtf(var + GN_EPS)) * gng + gnb;
            o += BON[tt] * V[tt * 64 + lane];
            o *= bf2f(GG[m * A_W + col]);
            MIX[m * D + col] = (bf16)f2bf(o);
        }
    }
}

__device__ __forceinline__ void gla_item(const Params& P, LAS unsigned char* lds, int b, int h) {
    const int tid = threadIdx.x, lane = tid & 63, wave = tid >> 6;
    unsigned char* ws = P.ws;
    const bf16* p = (const bf16*)(ws + WS_P); const bf16* GK = (const bf16*)(ws + WS_GK);
    bf16* MIX = (bf16*)(ws + WS_MIX);
    const float* conv = P.in[15]; const float* norm_g = P.in[18];
    LAS float* Q = (LAS float*)lds; LAS float* K = Q + CH * 64; LAS float* DEC = K + CH * 64; LAS float* V = DEC + CH * 64; LAS float* O = V + CH * 128;
    const int cq = h * 64 + lane, ck = 256 + h * 64 + lane, cv0 = 512 + h * 128 + lane, cv1 = cv0 + 64;
    float wq[4], wk[4], wv0[4], wv1[4];
#pragma unroll
    for (int j = 0; j < 4; ++j) { wq[j] = conv[j * 1024 + cq]; wk[j] = conv[j * 1024 + ck]; wv0[j] = conv[j * 1024 + cv0]; wv1[j] = conv[j * 1024 + cv1]; }
    const float ng0 = norm_g[lane], ng1 = norm_g[lane + 64];
    float S[16];
#pragma unroll
    for (int j = 0; j < 16; ++j) S[j] = 0.f;
    const int row = wave * 16 + (lane >> 2), ks = (lane & 3) * 16;
    for (int t0 = 0; t0 < T; t0 += CH) {
        __syncthreads();
        for (int tt = wave; tt < CH; tt += NWAVES) {
            const int t = t0 + tt; const size_t m = (size_t)b * T + t;
            float aq = 0.f, ak = 0.f, av0 = 0.f, av1 = 0.f;
#pragma unroll
            for (int j = 0; j < 4; ++j) { const int ts = t - 3 + j; if (ts >= 0) { const bf16* pr = p + (m - 3 + j) * NP + C_BQ;
                aq += wq[j] * bf2f(pr[cq]); ak += wk[j] * bf2f(pr[ck]); av0 += wv0[j] * bf2f(pr[cv0]); av1 += wv1[j] * bf2f(pr[cv1]); } }
            Q[tt * 64 + lane] = siluf_(aq) * 0.125f; K[tt * 64 + lane] = siluf_(ak); V[tt * 128 + lane] = siluf_(av0); V[tt * 128 + 64 + lane] = siluf_(av1);
            DEC[tt * 64 + lane] = __expf(bf2f(GK[m * 256 + h * 64 + lane]));
        }
        __syncthreads();
        for (int tt = 0; tt < CH; ++tt) {
            const float vv = V[tt * 128 + row]; float o = 0.f;
#pragma unroll
            for (int q4 = 0; q4 < 4; ++q4) {
                const f32x4 kk = *(const LAS f32x4*)(K + tt * 64 + ks + 4 * q4), dd = *(const LAS f32x4*)(DEC + tt * 64 + ks + 4 * q4), qq = *(const LAS f32x4*)(Q + tt * 64 + ks + 4 * q4);
#pragma unroll
                for (int j = 0; j < 4; ++j) { S[4 * q4 + j] = S[4 * q4 + j] * dd[j] + vv * kk[j]; o += S[4 * q4 + j] * qq[j]; }
            }
            o = red4(o);
            if ((lane & 3) == 0) O[tt * 128 + row] = o;
        }
        __syncthreads();
        for (int tt = wave; tt < CH; tt += NWAVES) {
            const size_t m = (size_t)b * T + t0 + tt;
            const float o0 = O[tt * 128 + lane], o1 = O[tt * 128 + 64 + lane];
            const float ms = wave_sum(o0 * o0 + o1 * o1) * (1.f / 128.f); const float rs = 1.f / sqrtf(ms + RMS_EPS);
            const float g0 = bf2f(p[m * NP + C_BG + h * 128 + lane]), g1 = bf2f(p[m * NP + C_BG + h * 128 + 64 + lane]);
            MIX[m * D + 512 + h * 128 + lane] = (bf16)f2bf(o0 * rs * ng0 * siluf_(g0));
            MIX[m * D + 512 + h * 128 + 64 + lane] = (bf16)f2bf(o1 * rs * ng1 * siluf_(g1));
        }
    }
}
__device__ __forceinline__ void phase_scan(const Params& P, LAS unsigned char* lds) {
    for (int it = blockIdx.x; it < 48; it += gridDim.x) {
        if (it < 32) rwkv_item(P, lds, it >> 3, it & 7); else gla_item(P, lds, (it - 32) >> 2, (it - 32) & 3);
        __syncthreads();
    }
}

__device__ __forceinline__ void phase_ln1(const Params& P) {
    const int lane = threadIdx.x & 63, wave = threadIdx.x >> 6; const int gw = blockIdx.x * NWAVES + wave, ngw = gridDim.x * NWAVES;
    for (int m = gw; m < M; m += ngw) ln_row_bf16((const float*)(P.ws + WS_Z) + (size_t)m * D, P.in[20], P.in[21], (bf16*)(P.ws + WS_H1) + (size_t)m * D, lane);
    const int gtid = blockIdx.x * NTHR + threadIdx.x, gthreads = gridDim.x * NTHR;
#pragma unroll
    for (int tb = 0; tb < 2; ++tb) {
        const f32x4* src = (const f32x4*)P.in[24 + tb]; u32x4* dst = (u32x4*)(P.ws + (tb ? WS_VT : WS_UT));
        for (int i = gtid; i < 16384 * D / 8; i += gthreads) { const f32x4 a = src[2 * i], b = src[2 * i + 1]; u32x4 o; o.x = pk2(a[0], a[1]); o.y = pk2(a[2], a[3]); o.z = pk2(b[0], b[1]); o.w = pk2(b[2], b[3]); dst[i] = o; }
    }
}

__device__ __forceinline__ void phase_topk(const Params& P) {
    const int lane = threadIdx.x & 63, wave = threadIdx.x >> 6; const int gw = blockIdx.x * NWAVES + wave, ngw = gridDim.x * NWAVES;
    const bf16* Sc = (const bf16*)(P.ws + WS_S); int* IDS = (int*)(P.ws + WS_IDS); float* GATES = (float*)(P.ws + WS_GATES);
    const float NEG = -INFINITY;
    for (int item = gw; item < M * 8; item += ngw) {
        const int m = item >> 3, h = item & 7; const bf16* s = Sc + (size_t)m * NQ + h * 256;
        float sv[2]; int si[2];
#pragma unroll
        for (int half = 0; half < 2; ++half) {
            float a0 = bf2f(s[half * 128 + lane]), a1 = bf2f(s[half * 128 + 64 + lane]); float mv = 0.f; int mi = 0;
            for (int it = 0; it < 16; ++it) {
                const float wm = wave_max(fmaxf(a0, a1));
                const int ci = (a0 == wm) ? lane : ((a1 == wm) ? 64 + lane : 9999);
                const int wi = wave_min_i(ci);
                if (lane == it) { mv = wm; mi = wi; }
                if (wi == lane) a0 = NEG; if (wi == 64 + lane) a1 = NEG;
            }
            sv[half] = mv; si[half] = mi;
        }
        float c[4]; const float s0 = __shfl(sv[0], lane >> 2);
#pragma unroll
        for (int q = 0; q < 4; ++q) c[q] = s0 + __shfl(sv[1], 4 * (lane & 3) + q);
        float cvv = 0.f; int cii = 0;
        for (int it = 0; it < 16; ++it) {
            const float wm = wave_max(fmaxf(fmaxf(c[0], c[1]), fmaxf(c[2], c[3])));
            int ci = 9999;
#pragma unroll
            for (int q = 3; q >= 0; --q) if (c[q] == wm) ci = 4 * lane + q;
            const int wi = wave_min_i(ci);
            if (lane == it) { cvv = wm; cii = wi; }
#pragma unroll
            for (int q = 0; q < 4; ++q) if (wi == 4 * lane + q) c[q] = NEG;
        }
        const int e1 = __shfl(si[0], (cii >> 4) & 15), e2 = __shfl(si[1], cii & 15);
        const float cmax = __shfl(cvv, 0);
        const float e = (lane < 16) ? __expf(cvv - cmax) : 0.f;
        const float den = wave_sum(e);
        if (lane < 16) { IDS[(size_t)m * 128 + h * 16 + lane] = e1 * 128 + e2; GATES[(size_t)m * 128 + h * 16 + lane] = e / den; }
    }
}

typedef __bf16 bf16x2_t __attribute__((ext_vector_type(2)));
__device__ __forceinline__ float dot2bf(unsigned a, unsigned b, float c) { return __builtin_amdgcn_fdot2_f32_bf16(__builtin_bit_cast(bf16x2_t, a), __builtin_bit_cast(bf16x2_t, b), c, false); }
#define DPP_ADD(v, ctrl) ((v) + __builtin_bit_cast(float, __builtin_amdgcn_update_dpp(0, __builtin_bit_cast(int, (v)), (ctrl), 0xf, 0xf, false)))
__device__ __forceinline__ float rlf(float v, int l) { return __builtin_bit_cast(float, __builtin_amdgcn_readlane(__builtin_bit_cast(int, v), l)); }
__device__ __forceinline__ float wave_sum_u(float v) {
    v = DPP_ADD(v, 0xB1); v = DPP_ADD(v, 0x4E); v = DPP_ADD(v, 0x141); v = DPP_ADD(v, 0x140);
    return (rlf(v, 0) + rlf(v, 16)) + (rlf(v, 32) + rlf(v, 48));
}
__device__ __forceinline__ void peer_load4(u32x4 (&buf)[4][2], const bf16* TAB, int idreg, int g, int lane) {
#pragma unroll
    for (int q = 0; q < 4; ++q) { const int id = __builtin_amdgcn_readlane(idreg, 4 * g + q); const u32x4* rp = (const u32x4*)(TAB + (size_t)id * D); buf[q][0] = rp[lane]; buf[q][1] = rp[64 + lane]; }
}
__device__ __forceinline__ void peer_dots4(const u32x4 (&buf)[4][2], const u32x4& hA, const u32x4& hB, int g, float& d, int lane) {
#pragma unroll
    for (int q = 0; q < 4; ++q) { float s = 0.f;
#pragma unroll
        for (int i = 0; i < 4; ++i) { s = dot2bf(buf[q][0][i], hA[i], s); s = dot2bf(buf[q][1][i], hB[i], s); }
        const float tot = wave_sum_u(s);
        d = (lane == 4 * g + q) ? tot : d; }
}
__device__ __forceinline__ void peer_axpy4(const u32x4 (&buf)[4][2], float actreg, int g, float (&acc)[16]) {
#pragma unroll
    for (int q = 0; q < 4; ++q) { const float a = rlf(actreg, 4 * g + q);
#pragma unroll
        for (int i = 0; i < 4; ++i) { const unsigned w0 = buf[q][0][i], w1 = buf[q][1][i];
            acc[2 * i] += a * __uint_as_float(w0 << 16); acc[2 * i + 1] += a * __uint_as_float(w0 & 0xffff0000u);
            acc[8 + 2 * i] += a * __uint_as_float(w1 << 16); acc[8 + 2 * i + 1] += a * __uint_as_float(w1 & 0xffff0000u); } }
}
__device__ __forceinline__ void phase_peer(const Params& P) {
    const int lane = threadIdx.x & 63, wave = threadIdx.x >> 6; const int gw = blockIdx.x * NWAVES + wave, ngw = gridDim.x * NWAVES;
    const bf16* H1 = (const bf16*)(P.ws + WS_H1); const int* IDS = (const int*)(P.ws + WS_IDS); const float* GATES = (const float*)(P.ws + WS_GATES);
    const bf16* UT = (const bf16*)(P.ws + WS_UT); const bf16* VT = (const bf16*)(P.ws + WS_VT); const float* g2 = P.in[26]; const float* b2 = P.in[27];
    for (int m = gw; m < M; m += ngw) {
        const u32x4* hp = (const u32x4*)(H1 + (size_t)m * D);
        const u32x4 hA = hp[lane], hB = hp[64 + lane];
        const int id_lo = IDS[(size_t)m * 128 + lane], id_hi = IDS[(size_t)m * 128 + 64 + lane];
        const float gt_lo = GATES[(size_t)m * 128 + lane], gt_hi = GATES[(size_t)m * 128 + 64 + lane];
        float d_lo = 0.f, d_hi = 0.f;
        u32x4 A0[4][2], A1[4][2];
        peer_load4(A0, UT, id_lo, 0, lane);
        for (int g = 0; g < 16; g += 2) {
            peer_load4(A1, UT, id_lo, g + 1, lane); peer_dots4(A0, hA, hB, g, d_lo, lane);
            if (g + 2 < 16) peer_load4(A0, UT, id_lo, g + 2, lane); else peer_load4(A0, UT, id_hi, 0, lane);
            peer_dots4(A1, hA, hB, g + 1, d_lo, lane);
        }
        for (int g = 0; g < 16; g += 2) {
            peer_load4(A1, UT, id_hi, g + 1, lane); peer_dots4(A0, hA, hB, g, d_hi, lane);
            if (g + 2 < 16) peer_load4(A0, UT, id_hi, g + 2, lane); else peer_load4(A0, VT, id_lo, 0, lane);
            peer_dots4(A1, hA, hB, g + 1, d_hi, lane);
        }
        const float act_lo = 0.5f * d_lo * (1.f + erff(d_lo * 0.70710678118f)) * gt_lo, act_hi = 0.5f * d_hi * (1.f + erff(d_hi * 0.70710678118f)) * gt_hi;
        float acc[16];
#pragma unroll
        for (int i = 0; i < 16; ++i) acc[i] = 0.f;
        for (int g = 0; g < 16; g += 2) {
            peer_load4(A1, VT, id_lo, g + 1, lane); peer_axpy4(A0, act_lo, g, acc);
            if (g + 2 < 16) peer_load4(A0, VT, id_lo, g + 2, lane); else peer_load4(A0, VT, id_hi, 0, lane);
            peer_axpy4(A1, act_lo, g + 1, acc);
        }
        for (int g = 0; g < 16; g += 2) {
            peer_load4(A1, VT, id_hi, g + 1, lane); peer_axpy4(A0, act_hi, g, acc);
            if (g + 2 < 16) peer_load4(A0, VT, id_hi, g + 2, lane);
            peer_axpy4(A1, act_hi, g + 1, acc);
        }
        float s = 0.f;
#pragma unroll
        for (int i = 0; i < 4; ++i) { acc[2 * i] += ALPHA * __uint_as_float(hA[i] << 16); acc[2 * i + 1] += ALPHA * __uint_as_float(hA[i] & 0xffff0000u);
            acc[8 + 2 * i] += ALPHA * __uint_as_float(hB[i] << 16); acc[8 + 2 * i + 1] += ALPHA * __uint_as_float(hB[i] & 0xffff0000u); }
#pragma unroll
        for (int i = 0; i < 16; ++i) s += acc[i];
        const float mean = wave_sum(s) * (1.f / D); float s2 = 0.f;
#pragma unroll
        for (int i = 0; i < 16; ++i) { acc[i] -= mean; s2 += acc[i] * acc[i]; }
        const float rstd = 1.f / sqrtf(wave_sum(s2) * (1.f / D) + LN_EPS);
#pragma unroll
        for (int hf = 0; hf < 2; ++hf)
#pragma unroll
            for (int c4 = 0; c4 < 2; ++c4) { const int e0 = hf * 512 + 8 * lane + 4 * c4; const f32x4 gg = *(const f32x4*)(g2 + e0), bb = *(const f32x4*)(b2 + e0); f32x4 o;
#pragma unroll
                for (int j = 0; j < 4; ++j) o[j] = acc[hf * 8 + c4 * 4 + j] * rstd * gg[j] + bb[j];
                *(f32x4*)(P.out + (size_t)m * D + e0) = o; }
    }
}

constexpr int N_PHASES = 10;
__global__ void __launch_bounds__(NTHR, 2) fwd_kernel(Params P) {
    extern __shared__ __attribute__((aligned(16))) unsigned char lds_raw[];
    LAS unsigned char* lds = (LAS unsigned char*)lds_raw;
    cg::grid_group grid = cg::this_grid();
    const int lo = P.ph_lo, hi = P.ph_hi;
    unsigned char* ws = P.ws;
#define IN(k) (lo <= (k) && (k) < hi)
#define SEAM(k) do { if (IN(k) && IN((k) + 1)) grid.sync(); } while (0)
    if (IN(0)) phase_prologue(P);
    SEAM(0);
    if (IN(1)) {
        pg8::Gemm g{(const bf16*)(ws + WS_H0), (const bf16*)(ws + WS_WIN), M, NP, D, D, D, 0}; pg8::StaticOrder S; S.init(M, NP, gridDim.x, blockIdx.x);
        pg8::EpiBf16 E{(bf16*)(ws + WS_P), NP};
        pg8::gemm_phase<pg8::EpiBf16, pg8::StaticOrder, true, true>(lds, g, S, E);
    }
    SEAM(1);
    if (IN(2)) phase_prep(P, lds);
    SEAM(2);
    if (IN(3)) phase_scan(P, lds);
    SEAM(3);
    if (IN(4)) {
        pg8::Gemm g{(const bf16*)(ws + WS_MIX), (const bf16*)(ws + WS_WOUT), M, D, D, D, D, 0}; pg8::StaticOrder S; S.init(M, D, gridDim.x, blockIdx.x);
        pg8::EpiResF32 E{(float*)(ws + WS_Z), (const bf16*)(ws + WS_H0), D, ALPHA};
        pg8::gemm_phase<pg8::EpiResF32, pg8::StaticOrder, true, true>(lds, g, S, E);
    }
    SEAM(4);
    if (IN(5)) phase_ln1(P);
    SEAM(5);
    if (IN(6)) {
        pg8::Gemm g{(const bf16*)(ws + WS_H1), (const bf16*)(ws + WS_WQ), M, NQ, D, D, D, 0}; pg8::StaticOrder S; S.init(M, NQ, gridDim.x, blockIdx.x);
        pg8::EpiBf16 E{(bf16*)(ws + WS_Q), NQ};
        pg8::gemm_phase<pg8::EpiBf16, pg8::StaticOrder, true, true>(lds, g, S, E);
    }
    SEAM(6);
    if (IN(7)) {
        pg8::Gemm g{(const bf16*)(ws + WS_Q), (const bf16*)(ws + WS_KBD), M, NQ, 256, NQ, 256, 256}; pg8::StaticOrder S; S.init(M, NQ, gridDim.x, blockIdx.x);
        pg8::EpiBf16 E{(bf16*)(ws + WS_S), NQ};
        pg8::gemm_phase<pg8::EpiBf16, pg8::StaticOrder, true, true>(lds, g, S, E);
    }
    SEAM(7);
    if (IN(8)) phase_topk(P);
    SEAM(8);
    if (IN(9)) phase_peer(P);
#undef IN
#undef SEAM
}

extern "C" void kernel_launch(void* const* d_in, const int* in_sizes, int n_in, void* d_out, int out_size, void* d_ws, size_t ws_size, hipStream_t stream) {
    static int grid = 0;
    if (grid == 0) {
        if (n_in != 28 || out_size != M * D || ws_size < WS_END) { fprintf(stderr, "kernel_launch: unexpected shapes (n_in %d out %d ws %zu)\n", n_in, out_size, ws_size); grid = -1; return; }
        int dev = 0, cus = 0, per_cu = 0;
        (void)hipGetDevice(&dev); (void)hipDeviceGetAttribute(&cus, hipDeviceAttributeMultiprocessorCount, dev);
        (void)hipFuncSetAttribute((const void*)fwd_kernel, hipFuncAttributeMaxDynamicSharedMemorySize, LDS_BYTES);
        (void)hipOccupancyMaxActiveBlocksPerMultiprocessor(&per_cu, (const void*)fwd_kernel, NTHR, LDS_BYTES);
        if (per_cu < 1) { fprintf(stderr, "kernel_launch: occupancy query says %d blocks per CU\n", per_cu); per_cu = 1; }
        (void)hipGetLastError();
        grid = cus;
    }
    if (grid < 0) return;
    Params p{};
    for (int i = 0; i < 28; ++i) p.in[i] = (const float*)d_in[i];
    p.out = (float*)d_out; p.ws = (unsigned char*)d_ws;
#if MK_ONE_LAUNCH
    p.ph_lo = 0; p.ph_hi = N_PHASES;
    void* args[] = {&p};
    hipError_t e = hipLaunchCooperativeKernel((const void*)fwd_kernel, dim3(grid), dim3(NTHR), args, LDS_BYTES, stream);
    if (e != hipSuccess) fprintf(stderr, "cooperative launch failed: %s (grid %d)\n", hipGetErrorString(e), grid);
#else
    for (int ph = 0; ph < N_PHASES; ++ph) {
        p.ph_lo = ph; p.ph_hi = ph + 1;
        hipLaunchKernelGGL(fwd_kernel, dim3(grid), dim3(NTHR), LDS_BYTES, stream, p);
    }
#endif
}
```

```cpp
#include <hip/hip_runtime.h>
#include <hip/hip_cooperative_groups.h>
#include <cstdio>
#include <cstdint>
namespace cg = cooperative_groups;

#ifndef MK_ONE_LAUNCH
#define MK_ONE_LAUNCH 1
#endif

namespace pg8 {
#define PG8_LAS __attribute__((address_space(3)))
typedef unsigned short bf16_t;
typedef short bf16x8 __attribute__((ext_vector_type(8)));
typedef float f32x4 __attribute__((ext_vector_type(4)));
typedef unsigned u32x4 __attribute__((ext_vector_type(4)));
typedef unsigned u32x2 __attribute__((ext_vector_type(2)));
constexpr int BM = 256, BK = 64, HALF = 128, HTB = HALF * BK * 2, STAGE_BYTES = 8 * HTB, NXCD = 8, WGM = 8;

__host__ __device__ __forceinline__ int lds_byte(int r, int c) { const int st = (r >> 4) * 2 + (c >> 5), rr = r & 15, cc = c & 31, ob = rr * 64 + cc * 2; return st * 1024 + (ob ^ (((ob >> 9) & 1) << 5)); }
__host__ __device__ __forceinline__ void stage_rc(int b, int& R, int& C) { const int st = b / 1024, sb = b % 1024, swz = sb ^ (((sb >> 9) & 1) << 5); R = (st >> 1) * 16 + swz / 64; C = (st & 1) * 32 + (swz % 64) / 2; }
__host__ __device__ __forceinline__ int perm32(int rho) { const int n = rho >> 4, i = rho & 15; return 8 * (i >> 2) + 4 * n + (i & 3); }

struct Unit { int pm, pn; };
struct Gemm { const bf16_t* A; const bf16_t* Bt; int M, N, K, lda, ldb, a_pn_koff; };

struct StaticOrder {
    int nM, nN, nwg, G, c;
    __host__ __device__ void init(int M, int N, int G_, int c_) { nM = M / BM; nN = N / BM; nwg = nM * nN; G = G_; c = c_; }
    __host__ __device__ bool next(int i, Unit& u) const {
        const long L = (long)i * G + c; if (L >= nwg) return false;
        int wgid = (int)L; { const int q = nwg / NXCD, r = nwg % NXCD, xcd = wgid % NXCD, off = wgid / NXCD; wgid = (xcd < r ? xcd * (q + 1) : r * (q + 1) + (xcd - r) * q) + off; }
        const int nig = WGM * nN, gid = wgid / nig, fm = gid * WGM, gsz = (nM - fm) < WGM ? (nM - fm) : WGM;
        u.pm = fm + ((wgid % nig) % gsz); u.pn = (wgid % nig) / gsz; return true;
    }
    __device__ __forceinline__ void a_ready(const Unit&) const {}
    __device__ __forceinline__ void done(const Unit&) const {}
};

__device__ __forceinline__ unsigned cvt_pk_bf16(float lo, float hi) { unsigned r; asm volatile("v_cvt_pk_bf16_f32 %0, %1, %2" : "=v"(r) : "v"(lo), "v"(hi)); return r; }

struct EpiBf16 {
    static constexpr bool PERM = true;
    bf16_t* O; int ldc;
    __device__ __forceinline__ void operator()(const f32x4 (&acc)[2][2][4][2], const Unit& u, int wr, int wc, int fr, int fq) const {
        const int row0 = u.pm * BM + wr * 64 + fr; const int col0 = u.pn * BM + wc * 32 + 8 * fq;
#pragma unroll
        for (int ai = 0; ai < 2; ++ai)
#pragma unroll
            for (int m = 0; m < 4; ++m) { bf16_t* rowp = O + (size_t)(row0 + ai * HALF + m * 16) * ldc + col0;
#pragma unroll
                for (int bj = 0; bj < 2; ++bj) { const f32x4 v0 = acc[ai][bj][m][0], v1 = acc[ai][bj][m][1];
                    u32x4 w; w.x = cvt_pk_bf16(v0[0], v0[1]); w.y = cvt_pk_bf16(v0[2], v0[3]); w.z = cvt_pk_bf16(v1[0], v1[1]); w.w = cvt_pk_bf16(v1[2], v1[3]);
                    *(u32x4*)(rowp + bj * HALF) = w; } }
    }
};
struct EpiResF32 {
    static constexpr bool PERM = false;
    float* Z; const bf16_t* R; int ldc; float alpha;
    __device__ __forceinline__ void operator()(const f32x4 (&acc)[2][2][4][2], const Unit& u, int wr, int wc, int fr, int fq) const {
        const int row0 = u.pm * BM + wr * 64 + fr; const int col0 = u.pn * BM + wc * 32 + 4 * fq;
#pragma unroll
        for (int ai = 0; ai < 2; ++ai)
#pragma unroll
            for (int m = 0; m < 4; ++m) { const size_t off = (size_t)(row0 + ai * HALF + m * 16) * ldc + col0;
#pragma unroll
                for (int bj = 0; bj < 2; ++bj)
#pragma unroll
                    for (int n = 0; n < 2; ++n) { const size_t o2 = off + bj * HALF + n * 16; const u32x2 rb = *(const u32x2*)(R + o2);
                        f32x4 h; h[0] = __uint_as_float(rb.x << 16); h[1] = __uint_as_float(rb.x & 0xffff0000u); h[2] = __uint_as_float(rb.y << 16); h[3] = __uint_as_float(rb.y & 0xffff0000u);
                        *(f32x4*)(Z + o2) = h * alpha + acc[ai][bj][m][n]; } }
    }
};

template <class Epi, class Sched, bool ALIGN_EPI = false, bool SP2 = false>
__device__ __forceinline__ void gemm_phase(PG8_LAS unsigned char* lds, const Gemm g, const Sched& S, const Epi& E) {
    const int tid = threadIdx.x, wid = __builtin_amdgcn_readfirstlane(tid >> 6), lane = tid & 63, wr = wid >> 2, wc = wid & 3, fr = lane & 15, fq = lane >> 4;
    const int K = g.K, nt = K / BK;
    unsigned voffA[2], voffB[2];
#pragma unroll
    for (int i = 0; i < 2; ++i) { int R, C; stage_rc(tid * 16 + i * 8192, R, C); const int Rb = Epi::PERM ? ((R & ~31) + perm32(R & 31)) : R;
        voffA[i] = (unsigned)(R * g.lda + C) * 2u; voffB[i] = (unsigned)(Rb * g.ldb + C) * 2u; }
    const size_t kstep = (size_t)(BK * 2);
    const size_t hstepA = (size_t)HALF * g.lda * 2, hstepB = (size_t)HALF * g.ldb * 2;
    const size_t tstepA = 2 * hstepA, tstepB = 2 * hstepB;
    const size_t pnA = (size_t)g.a_pn_koff * 2;
    const unsigned ldsw = (unsigned)wid * 1024u;
    const int aoff = lds_byte(wr * 64 + fr, fq * 8), boff = lds_byte(wc * 32 + fr, fq * 8);
#define PG8_SA(b, h) (((b) * 2 + (h)) * HTB)
#define PG8_SB(b, h) ((4 + (b) * 2 + (h)) * HTB)
#define PG8_STAGE(bufoff, gbase, voff) do { _Pragma("unroll") for (int _i = 0; _i < 2; ++_i) \
        __builtin_amdgcn_global_load_lds((const unsigned*)((const char*)(gbase) + (voff)[_i]), (PG8_LAS unsigned*)(lds + (bufoff) + ldsw + _i * 8192), 16, 0, 0); } while (0)
#define PG8_LDA(dst, b, h) do { _Pragma("unroll") for (int m = 0; m < 4; ++m) _Pragma("unroll") for (int k = 0; k < 2; ++k) dst[m][k] = *(const PG8_LAS bf16x8*)(lds + PG8_SA(b, h) + aoff + m * 2048 + k * 1024); } while (0)
#define PG8_LDB(dst, b, h) do { _Pragma("unroll") for (int n = 0; n < 2; ++n) _Pragma("unroll") for (int k = 0; k < 2; ++k) dst[n][k] = *(const PG8_LAS bf16x8*)(lds + PG8_SB(b, h) + boff + n * 2048 + k * 1024); } while (0)
#define PG8_MMA(ai, bj, At, Bt) do { __builtin_amdgcn_s_setprio(1); _Pragma("unroll") for (int m = 0; m < 4; ++m) _Pragma("unroll") for (int n = 0; n < 2; ++n) _Pragma("unroll") for (int k = 0; k < 2; ++k) \
        acc[ai][bj][m][n] = __builtin_amdgcn_mfma_f32_16x16x32_bf16(Bt[n][k], At[m][k], acc[ai][bj][m][n], 0, 0, 0); __builtin_amdgcn_s_setprio(0); } while (0)
#define PG8_WAIT_V(n) asm volatile("s_waitcnt vmcnt(" #n ")" ::: "memory")
#define PG8_WAIT_L(n) asm volatile("s_waitcnt lgkmcnt(" #n ")" ::: "memory")
#define PG8_BAR __builtin_amdgcn_s_barrier()
#define PG8_SCHED __builtin_amdgcn_sched_barrier(0)
    Unit cur, nxt; int ui = 0;
    if (!S.next(0, cur)) return;
    f32x4 acc[2][2][4][2];
#pragma unroll
    for (int a = 0; a < 2; ++a)
#pragma unroll
        for (int b = 0; b < 2; ++b)
#pragma unroll
            for (int m = 0; m < 4; ++m)
#pragma unroll
                for (int n = 0; n < 2; ++n) acc[a][b][m][n] = (f32x4){0.f, 0.f, 0.f, 0.f};
    bf16x8 At[4][2], B0[2][2], B1[2][2];
    const char* cA = (const char*)g.A + (size_t)cur.pm * tstepA + (size_t)cur.pn * pnA; const char* cB = (const char*)g.Bt + (size_t)cur.pn * tstepB;
    S.a_ready(cur);
    if constexpr (SP2) {
        PG8_STAGE(PG8_SB(0, 0), cB, voffB); PG8_STAGE(PG8_SB(0, 1), cB + hstepB, voffB); PG8_STAGE(PG8_SA(0, 0), cA, voffA); PG8_STAGE(PG8_SA(0, 1), cA + hstepA, voffA);
        if (wr == 1) PG8_BAR;
        PG8_WAIT_V(2); PG8_BAR;
        PG8_STAGE(PG8_SB(1, 0), cB + kstep, voffB); PG8_STAGE(PG8_SA(1, 0), cA + kstep, voffA); PG8_STAGE(PG8_SB(1, 1), cB + hstepB + kstep, voffB);
        PG8_WAIT_V(6); PG8_BAR;
    } else {
        PG8_STAGE(PG8_SB(0, 0), cB, voffB); PG8_STAGE(PG8_SA(0, 0), cA, voffA); PG8_STAGE(PG8_SB(0, 1), cB + hstepB, voffB); PG8_STAGE(PG8_SA(0, 1), cA + hstepA, voffA);
        if (wr == 1) PG8_BAR;
        PG8_WAIT_V(4); PG8_BAR;
        PG8_STAGE(PG8_SB(1, 0), cB + kstep, voffB); PG8_STAGE(PG8_SA(1, 0), cA + kstep, voffA); PG8_STAGE(PG8_SB(1, 1), cB + hstepB + kstep, voffB);
        PG8_WAIT_V(6); PG8_BAR;
    }
    for (;;) {
        const bool has_next = S.next(ui + 1, nxt);
        const char* nA = has_next ? (const char*)g.A + (size_t)nxt.pm * tstepA + (size_t)nxt.pn * pnA : cA; const char* nB = has_next ? (const char*)g.Bt + (size_t)nxt.pn * tstepB : cB;
        for (int t = 0; t < nt; t += 2) {
            const bool last = (t == nt - 2);
            const char* a1 = cA + (size_t)(t + 1) * kstep;
            const char* a2 = last ? nA : cA + (size_t)(t + 2) * kstep; const char* b2 = last ? nB : cB + (size_t)(t + 2) * kstep;
            const char* a3 = a2 + kstep; const char* b3 = b2 + kstep;
            if (last && has_next) S.a_ready(nxt);
            if constexpr (SP2) {
            PG8_LDB(B0, 0, 0); PG8_LDB(B1, 0, 1); PG8_SCHED; PG8_LDA(At, 0, 0); PG8_STAGE(PG8_SA(1, 1), a1 + hstepA, voffA);
            PG8_WAIT_V(8); PG8_WAIT_L(0); PG8_BAR; PG8_MMA(0, 0, At, B0); PG8_MMA(0, 1, At, B1); PG8_BAR; PG8_SCHED;
            PG8_LDA(At, 0, 1); PG8_STAGE(PG8_SB(0, 0), b2, voffB); PG8_STAGE(PG8_SB(0, 1), b2 + hstepB, voffB); PG8_STAGE(PG8_SA(0, 0), a2, voffA);
            PG8_WAIT_V(8); PG8_WAIT_L(0); PG8_BAR; PG8_MMA(1, 0, At, B0); PG8_MMA(1, 1, At, B1); PG8_BAR; PG8_SCHED;
            PG8_LDB(B0, 1, 0); PG8_LDB(B1, 1, 1); PG8_SCHED; PG8_LDA(At, 1, 0); PG8_STAGE(PG8_SA(0, 1), a2 + hstepA, voffA);
            PG8_WAIT_V(8); PG8_WAIT_L(0); PG8_BAR; PG8_MMA(0, 0, At, B0); PG8_MMA(0, 1, At, B1); PG8_BAR; PG8_SCHED;
            PG8_LDA(At, 1, 1); PG8_STAGE(PG8_SB(1, 0), b3, voffB); PG8_STAGE(PG8_SB(1, 1), b3 + hstepB, voffB); PG8_STAGE(PG8_SA(1, 0), a3, voffA);
            PG8_WAIT_V(8); PG8_WAIT_L(0); PG8_BAR; PG8_MMA(1, 0, At, B0); PG8_MMA(1, 1, At, B1); PG8_BAR; PG8_SCHED;
            } else {
            PG8_LDB(B0, 0, 0); PG8_SCHED; PG8_LDA(At, 0, 0); PG8_STAGE(PG8_SA(1, 1), a1 + hstepA, voffA);
            PG8_WAIT_L(8); PG8_BAR; PG8_WAIT_L(0); PG8_MMA(0, 0, At, B0); PG8_BAR; PG8_SCHED;
            PG8_LDB(B1, 0, 1); PG8_STAGE(PG8_SB(0, 0), b2, voffB);
            PG8_BAR; PG8_WAIT_L(0); PG8_MMA(0, 1, At, B1); PG8_BAR;
            PG8_LDA(At, 0, 1); PG8_STAGE(PG8_SA(0, 0), a2, voffA);
            PG8_BAR; PG8_WAIT_L(0); PG8_MMA(1, 0, At, B0); PG8_BAR; PG8_SCHED;
            PG8_STAGE(PG8_SB(0, 1), b2 + hstepB, voffB);
            PG8_WAIT_V(6); PG8_BAR; PG8_MMA(1, 1, At, B1); PG8_BAR;
            PG8_LDB(B0, 1, 0); PG8_SCHED; PG8_LDA(At, 1, 0); PG8_STAGE(PG8_SA(0, 1), a2 + hstepA, voffA);
            PG8_WAIT_L(8); PG8_BAR; PG8_WAIT_L(0); PG8_MMA(0, 0, At, B0); PG8_BAR; PG8_SCHED;
            PG8_LDB(B1, 1, 1); PG8_STAGE(PG8_SB(1, 0), b3, voffB);
            PG8_BAR; PG8_WAIT_L(0); PG8_MMA(0, 1, At, B1); PG8_BAR;
            PG8_LDA(At, 1, 1); PG8_STAGE(PG8_SA(1, 0), a3, voffA);
            PG8_BAR; PG8_WAIT_L(0); PG8_MMA(1, 0, At, B0); PG8_BAR; PG8_SCHED;
            PG8_STAGE(PG8_SB(1, 1), b3 + hstepB, voffB);
            PG8_WAIT_V(6); PG8_BAR; PG8_MMA(1, 1, At, B1); PG8_BAR;
            }
        }
        if constexpr (ALIGN_EPI) { if (wr == 0) PG8_BAR; }
        E(acc, cur, wr, wc, fr, fq); S.done(cur);
        if (!has_next) break;
#pragma unroll
        for (int a = 0; a < 2; ++a)
#pragma unroll
            for (int b = 0; b < 2; ++b)
#pragma unroll
                for (int m = 0; m < 4; ++m)
#pragma unroll
                    for (int n = 0; n < 2; ++n) acc[a][b][m][n] = (f32x4){0.f, 0.f, 0.f, 0.f};
        cur = nxt; cA = nA; cB = nB; ++ui;
        if constexpr (ALIGN_EPI) { if (wr == 1) PG8_BAR; }
    }
    PG8_WAIT_V(0);
    if constexpr (!ALIGN_EPI) { if (wr == 0) PG8_BAR; }
    PG8_BAR;
#undef PG8_SA
#undef PG8_SB
#undef PG8_STAGE
#undef PG8_LDA
#undef PG8_LDB
#undef PG8_MMA
#undef PG8_WAIT_V
#undef PG8_WAIT_L
#undef PG8_BAR
#undef PG8_SCHED
}
}

constexpr int NWAVES = 8, NTHR = NWAVES * 64;
constexpr int D = 1024, NBATCH = 4, T = 8192, M = NBATCH * T;
constexpr int A_W = 512, A_IN = 1792, IN_COLS = 3344, NP = 3584;
constexpr int C_R = 0, C_K = 512, C_V = 1024, C_WD = 1536, C_AD = 1600, C_GD = 1664;
constexpr int C_BQ = 1792, C_BK = 2048, C_BV = 2304, C_GKD = 2816, C_BG = 2832;
constexpr int NQ = 2048;
constexpr float LN_EPS = 1e-5f, GN_EPS = 64e-5f, RMS_EPS = 1e-5f;
constexpr float ALPHA = 1.189207115002721f;

typedef unsigned short bf16;
typedef float f32x4 __attribute__((ext_vector_type(4)));
typedef unsigned u32x4 __attribute__((ext_vector_type(4)));
typedef unsigned u32x2 __attribute__((ext_vector_type(2)));
#define LAS __attribute__((address_space(3)))

constexpr size_t MiB = 1u << 20;
constexpr size_t WS_WIN = 1 * MiB, WS_WOUT = 8 * MiB, WS_WQ = 10 * MiB, WS_KBD = 14 * MiB;
constexpr size_t WS_H0 = 16 * MiB;
constexpr size_t WS_P = 80 * MiB;
constexpr size_t WS_WL = 304 * MiB, WS_AA = 336 * MiB, WS_GG = 368 * MiB;
constexpr size_t WS_GK = 400 * MiB;
constexpr size_t WS_MIX = 416 * MiB;
constexpr size_t WS_Z = 80 * MiB;
constexpr size_t WS_H1 = 208 * MiB;
constexpr size_t WS_Q = 272 * MiB;
constexpr size_t WS_S = 80 * MiB;
constexpr size_t WS_IDS = 400 * MiB, WS_GATES = 416 * MiB;
constexpr size_t WS_UT = 432 * MiB, WS_VT = 464 * MiB;
constexpr size_t WS_END = 496 * MiB;

constexpr int LDS_BYTES = 147456;

struct Params {
    const float* in[28];
    float* out; unsigned char* ws;
    int ph_lo, ph_hi;
};

__device__ __forceinline__ float bf2f(unsigned u) { return __uint_as_float(u << 16); }
__device__ __forceinline__ unsigned f2bf(float f) { unsigned u = __float_as_uint(f); return (u + 0x7fffu + ((u >> 16) & 1u)) >> 16; }
__device__ __forceinline__ unsigned pk2(float lo, float hi) { return f2bf(lo) | (f2bf(hi) << 16); }
#define DPP_F(v, ctrl) __builtin_bit_cast(float, __builtin_amdgcn_update_dpp(0, __builtin_bit_cast(int, (v)), (ctrl), 0xf, 0xf, false))
#define DPP_ADD(v, ctrl) ((v) + DPP_F(v, ctrl))
__device__ __forceinline__ float rlf(float v, int l) { return __builtin_bit_cast(float, __builtin_amdgcn_readlane(__builtin_bit_cast(int, v), l)); }
__device__ __forceinline__ float wave_sum_u(float v) {
    v = DPP_ADD(v, 0xB1); v = DPP_ADD(v, 0x4E); v = DPP_ADD(v, 0x141); v = DPP_ADD(v, 0x140);
    return (rlf(v, 0) + rlf(v, 16)) + (rlf(v, 32) + rlf(v, 48));
}
__device__ __forceinline__ float wave_sum(float v) { return wave_sum_u(v); }
__device__ __forceinline__ float sigmoidf_(float x) { return 1.f / (1.f + __expf(-x)); }
__device__ __forceinline__ float softplusf_(float x) { return fmaxf(x, 0.f) + log1pf(__expf(-fabsf(x))); }
__device__ __forceinline__ float siluf_(float x) { return x * sigmoidf_(x); }

__device__ __forceinline__ void transpose_convert(const float* W, int K, int N, int Npad, bf16* WT, int gtid, int gthreads) {
    const int kc = K / 8, total = Npad * kc;
    for (int idx = gtid; idx < total; idx += gthreads) {
        const int n = idx % Npad, c = idx / Npad; float v[8];
#pragma unroll
        for (int j = 0; j < 8; ++j) v[j] = (n < N) ? W[(size_t)(8 * c + j) * N + n] : 0.f;
        u32x4 o; o.x = pk2(v[0], v[1]); o.y = pk2(v[2], v[3]); o.z = pk2(v[4], v[5]); o.w = pk2(v[6], v[7]);
        *(u32x4*)(WT + (size_t)n * K + 8 * c) = o;
    }
}
__device__ __forceinline__ void ln_row_bf16(const float* xrow, const float* g, const float* b, bf16* orow, int lane) {
    const f32x4* xr = (const f32x4*)xrow + lane; f32x4 v[4]; float s = 0.f;
#pragma unroll
    for (int j = 0; j < 4; ++j) { v[j] = xr[64 * j]; s += (v[j][0] + v[j][1]) + (v[j][2] + v[j][3]); }
    const float mean = wave_sum(s) * (1.f / D); float s2 = 0.f;
#pragma unroll
    for (int j = 0; j < 4; ++j) { v[j] = v[j] - mean; s2 += (v[j][0] * v[j][0] + v[j][1] * v[j][1]) + (v[j][2] * v[j][2] + v[j][3] * v[j][3]); }
    const float rstd = 1.f / sqrtf(wave_sum(s2) * (1.f / D) + LN_EPS);
    u32x2* o8 = (u32x2*)orow + lane;
#pragma unroll
    for (int j = 0; j < 4; ++j) { const f32x4 gg = ((const f32x4*)g)[lane + 64 * j], bb = ((const f32x4*)b)[lane + 64 * j]; const f32x4 y = v[j] * rstd * gg + bb;
        u32x2 w; w.x = pk2(y[0], y[1]); w.y = pk2(y[2], y[3]); o8[64 * j] = w; }
}
__device__ __forceinline__ void phase_prologue(const Params& P) {
    const int tid = threadIdx.x, lane = tid & 63, wave = tid >> 6;
    const int gtid = blockIdx.x * NTHR + tid, gthreads = gridDim.x * NTHR;
    unsigned char* ws = P.ws;
    transpose_convert(P.in[3], D, IN_COLS, NP, (bf16*)(ws + WS_WIN), gtid, gthreads);
    transpose_convert(P.in[19], D, D, D, (bf16*)(ws + WS_WOUT), gtid, gthreads);
    transpose_convert(P.in[22], D, NQ, NQ, (bf16*)(ws + WS_WQ), gtid, gthreads);
    {
        const float* keys = P.in[23]; bf16* kbd = (bf16*)(ws + WS_KBD);
        for (int idx = gtid; idx < 8 * 256 * 32; idx += gthreads) {
            const int kc = idx & 31, n = (idx >> 5) & 255, h = idx >> 13; const int k0 = kc * 8, hn = n >> 7, key = n & 127, hk = k0 >> 7, c0 = k0 & 127;
            u32x4 o = (u32x4){0u, 0u, 0u, 0u};
            if (hn == hk) { const float* s = keys + ((size_t)((h * 2 + hn) * 128 + key)) * 128 + c0; o.x = pk2(s[0], s[1]); o.y = pk2(s[2], s[3]); o.z = pk2(s[4], s[5]); o.w = pk2(s[6], s[7]); }
            *(u32x4*)(kbd + ((size_t)(h * 256 + n)) * 256 + k0) = o;
        }
    }
    const int gw = blockIdx.x * NWAVES + wave, ngw = gridDim.x * NWAVES;
    for (int m = gw; m < M; m += ngw) ln_row_bf16(P.in[0] + (size_t)m * D, P.in[1], P.in[2], (bf16*)(ws + WS_H0) + (size_t)m * D, lane);
}

__device__ __forceinline__ void phase_prep(const Params& P, LAS unsigned char* lds) {
    const int tid = threadIdx.x;
    unsigned char* ws = P.ws;
    const bf16* p = (const bf16*)(ws + WS_P);
    const float* mu = P.in[4]; const float* w0 = P.in[5]; const float* w2 = P.in[6]; const float* a0 = P.in[7]; const float* a2 = P.in[8]; const float* g2 = P.in[9];
    const float* gkw2 = P.in[16]; const float* gkb = P.in[17];
    bf16* WL = (bf16*)(ws + WS_WL); bf16* AA = (bf16*)(ws + WS_AA); bf16* GG = (bf16*)(ws + WS_GG); bf16* GK = (bf16*)(ws + WS_GK);
    LAS float* act = (LAS float*)lds;
    LAS float* gkd = (LAS float*)(lds + 64 * 260 * 4);
    constexpr int AS = 260;
    for (int tile = blockIdx.x; tile < M / 64; tile += gridDim.x) {
        const int m0 = tile * 64;
        __syncthreads();
        for (int idx = tid; idx < 64 * 256; idx += NTHR) {
            const int j = idx & 255, tok = idx >> 8, m = m0 + tok, t = m & (T - 1);
            const float cur = bf2f(p[(size_t)m * NP + C_WD + j]);
            const float prev = (t > 0) ? bf2f(p[(size_t)(m - 1) * NP + C_WD + j]) : 0.f;
            const float x = cur + (prev - cur) * mu[C_WD + j];
            float v;
            if (j < 64) v = tanhf(x); else if (j < 128) v = x; else v = sigmoidf_(x);
            act[tok * AS + j] = v;
        }
        for (int idx = tid; idx < 64 * 16; idx += NTHR) { const int j = idx & 15, tok = idx >> 4; gkd[tok * 16 + j] = bf2f(p[(size_t)(m0 + tok) * NP + C_GKD + j]); }
        __syncthreads();
        const int c = tid;
        float acc[64];
#pragma unroll
        for (int i = 0; i < 64; ++i) acc[i] = 0.f;
        for (int j = 0; j < 64; j += 4) {
            const float x0 = w2[(j + 0) * A_W + c], x1 = w2[(j + 1) * A_W + c], x2 = w2[(j + 2) * A_W + c], x3 = w2[(j + 3) * A_W + c];
#pragma unroll
            for (int i = 0; i < 64; ++i) { const f32x4 a = *(const LAS f32x4*)(act + i * AS + j); acc[i] += a[0] * x0 + a[1] * x1 + a[2] * x2 + a[3] * x3; }
        }
        { const float b0 = w0[c];
#pragma unroll
          for (int i = 0; i < 64; ++i) { const float z = b0 + acc[i]; const float w = -softplusf_(-z) - 0.5f; WL[(size_t)(m0 + i) * A_W + c] = (bf16)f2bf(-__expf(w)); } }
#pragma unroll
        for (int i = 0; i < 64; ++i) acc[i] = 0.f;
        for (int j = 0; j < 64; j += 4) {
            const float x0 = a2[(j + 0) * A_W + c], x1 = a2[(j + 1) * A_W + c], x2 = a2[(j + 2) * A_W + c], x3 = a2[(j + 3) * A_W + c];
#pragma unroll
            for (int i = 0; i < 64; ++i) { const f32x4 a = *(const LAS f32x4*)(act + i * AS + 64 + j); acc[i] += a[0] * x0 + a[1] * x1 + a[2] * x2 + a[3] * x3; }
        }
        { const float b0 = a0[c];
#pragma unroll
          for (int i = 0; i < 64; ++i) AA[(size_t)(m0 + i) * A_W + c] = (bf16)f2bf(sigmoidf_(b0 + acc[i])); }
#pragma unroll
        for (int i = 0; i < 64; ++i) acc[i] = 0.f;
        for (int j = 0; j < 128; j += 4) {
            const float x0 = g2[(j + 0) * A_W + c], x1 = g2[(j + 1) * A_W + c], x2 = g2[(j + 2) * A_W + c], x3 = g2[(j + 3) * A_W + c];
#pragma unroll
            for (int i = 0; i < 64; ++i) { const f32x4 a = *(const LAS f32x4*)(act + i * AS + 128 + j); acc[i] += a[0] * x0 + a[1] * x1 + a[2] * x2 + a[3] * x3; }
        }
#pragma unroll
        for (int i = 0; i < 64; ++i) GG[(size_t)(m0 + i) * A_W + c] = (bf16)f2bf(acc[i]);
        { const int cc = tid & 255, th = tid >> 8; float wv[16];
#pragma unroll
          for (int j = 0; j < 16; ++j) wv[j] = gkw2[j * 256 + cc];
          const float bb = gkb[cc];
          for (int i = 0; i < 32; ++i) { const int tok = th * 32 + i; float s = bb;
#pragma unroll
              for (int j = 0; j < 16; ++j) s += gkd[tok * 16 + j] * wv[j];
              GK[(size_t)(m0 + tok) * 256 + cc] = (bf16)f2bf(-softplusf_(-s) * (1.f / 16.f)); } }
    }
}

constexpr int CH = 32;
__device__ __forceinline__ float red8(float v) { v = DPP_ADD(v, 0xB1); v = DPP_ADD(v, 0x4E); v = DPP_ADD(v, 0x141); return v; }
__device__ __forceinline__ float red4(float v) { v = DPP_ADD(v, 0xB1); v = DPP_ADD(v, 0x4E); return v; }

__device__ __forceinline__ void rwkv_item(const Params& P, LAS unsigned char* lds, int b, int h) {
    const int tid = threadIdx.x, lane = tid & 63, wave = tid >> 6;
    unsigned char* ws = P.ws;
    const bf16* p = (const bf16*)(ws + WS_P); const bf16* WL = (const bf16*)(ws + WS_WL); const bf16* AA = (const bf16*)(ws + WS_AA); const bf16* GG = (const bf16*)(ws + WS_GG);
    bf16* MIX = (bf16*)(ws + WS_MIX);
    const float* mu = P.in[4]; const float* k_k = P.in[10]; const float* k_a = P.in[11]; const float* r_k = P.in[12]; const float* gn_g = P.in[13]; const float* gn_b = P.in[14];
    LAS float* R = (LAS float*)lds; LAS float* DEC = R + CH * 64; LAS float* KH = DEC + CH * 64; LAS float* KK = KH + CH * 64; LAS float* BB = KK + CH * 64; LAS float* V = BB + CH * 64;
    LAS float* Y = V + CH * 64; LAS float* BON = Y + CH * 64;
    const int col = h * 64 + lane;
    const float mu_r = mu[C_R + col], mu_k = mu[C_K + col], mu_v = mu[C_V + col], kkc = k_k[col], kac = k_a[col], rkc = r_k[col], gng = gn_g[col], gnb = gn_b[col];
    float S[8];
#pragma unroll
    for (int j = 0; j < 8; ++j) S[j] = 0.f;
    const int row = wave * 8 + (lane >> 3), ks = (lane & 7) * 8;
    for (int t0 = 0; t0 < T; t0 += CH) {
        __syncthreads();
        for (int tt = wave; tt < CH; tt += NWAVES) {
            const int t = t0 + tt; const size_t m = (size_t)b * T + t;
            const bf16* pr = p + m * NP; const bf16* pp = pr - NP; const bool hp = t > 0;
            const float rc = bf2f(pr[C_R + col]), kc = bf2f(pr[C_K + col]), vc = bf2f(pr[C_V + col]);
            const float rp = hp ? bf2f(pp[C_R + col]) : 0.f, kp = hp ? bf2f(pp[C_K + col]) : 0.f, vp = hp ? bf2f(pp[C_V + col]) : 0.f;
            const float r = rc + (rp - rc) * mu_r, k = kc + (kp - kc) * mu_k, v = vc + (vp - vc) * mu_v;
            const float a = bf2f(AA[m * A_W + col]), wl = bf2f(WL[m * A_W + col]);
            const float kr = k * kkc; const float nrm = sqrtf(wave_sum(kr * kr)); const float kk = kr / fmaxf(nrm, 1e-12f);
            const float kh = k * (1.f + (a - 1.f) * kac);
            const float bon = wave_sum(r * kh * rkc);
            R[tt * 64 + lane] = r; DEC[tt * 64 + lane] = __expf(wl); KH[tt * 64 + lane] = kh; KK[tt * 64 + lane] = kk; BB[tt * 64 + lane] = kk * a; V[tt * 64 + lane] = v;
            if (lane == 0) BON[tt] = bon;
        }
        __syncthreads();
        for (int tt = 0; tt < CH; ++tt) {
            const f32x4 k0 = *(const LAS f32x4*)(KK + tt * 64 + ks), k1 = *(const LAS f32x4*)(KK + tt * 64 + ks + 4);
            const f32x4 d0 = *(const LAS f32x4*)(DEC + tt * 64 + ks), d1 = *(const LAS f32x4*)(DEC + tt * 64 + ks + 4);
            const f32x4 b0 = *(const LAS f32x4*)(BB + tt * 64 + ks), b1 = *(const LAS f32x4*)(BB + tt * 64 + ks + 4);
            const f32x4 h0 = *(const LAS f32x4*)(KH + tt * 64 + ks), h1 = *(const LAS f32x4*)(KH + tt * 64 + ks + 4);
            const f32x4 r0 = *(const LAS f32x4*)(R + tt * 64 + ks), r1 = *(const LAS f32x4*)(R + tt * 64 + ks + 4);
            const float vv = V[tt * 64 + row];
            float sa = 0.f;
#pragma unroll
            for (int j = 0; j < 4; ++j) sa += S[j] * k0[j] + S[4 + j] * k1[j];
            sa = -red8(sa);
            float y = 0.f;
#pragma unroll
            for (int j = 0; j < 4; ++j) {
                S[j] = S[j] * d0[j] + sa * b0[j] + vv * h0[j]; S[4 + j] = S[4 + j] * d1[j] + sa * b1[j] + vv * h1[j];
                y += S[j] * r0[j] + S[4 + j] * r1[j];
            }
            y = red8(y);
            if ((lane & 7) == 0) Y[tt * 64 + row] = y;
        }
        __syncthreads();
        for (int tt = wave; tt < CH; tt += NWAVES) {
            const size_t m = (size_t)b * T + t0 + tt;
            const float y = Y[tt * 64 + lane]; const float mean = wave_sum(y) * (1.f / 64.f); const float d = y - mean; const float var = wave_sum(d * d) * (1.f / 64.f);
            float o = d * (1.f / sqrtf(var + GN_EPS)) * gng + gnb;
            o += BON[tt] * V[tt * 64 + lane];
            o *= bf2f(GG[m * A_W + col]);
            MIX[m * D + col] = (bf16)f2bf(o);
        }
    }
}

__device__ __forceinline__ void gla_item(const Params& P, LAS unsigned char* lds, int b, int h) {
    const int tid = threadIdx.x, lane = tid & 63, wave = tid >> 6;
    unsigned char* ws = P.ws;
    const bf16* p = (const bf16*)(ws + WS_P); const bf16* GK = (const bf16*)(ws + WS_GK);
    bf16* MIX = (bf16*)(ws + WS_MIX);
    const float* conv = P.in[15]; const float* norm_g = P.in[18];
    LAS float* Q = (LAS float*)lds; LAS float* K = Q + CH * 64; LAS float* DEC = K + CH * 64; LAS float* V = DEC + CH * 64; LAS float* O = V + CH * 128;
    const int cq = h * 64 + lane, ck = 256 + h * 64 + lane, cv0 = 512 + h * 128 + lane, cv1 = cv0 + 64;
    float wq[4], wk[4], wv0[4], wv1[4];
#pragma unroll
    for (int j = 0; j < 4; ++j) { wq[j] = conv[j * 1024 + cq]; wk[j] = conv[j * 1024 + ck]; wv0[j] = conv[j * 1024 + cv0]; wv1[j] = conv[j * 1024 + cv1]; }
    const float ng0 = norm_g[lane], ng1 = norm_g[lane + 64];
    float S[16];
#pragma unroll
    for (int j = 0; j < 16; ++j) S[j] = 0.f;
    const int row = wave * 16 + (lane >> 2), ks = (lane & 3) * 16;
    for (int t0 = 0; t0 < T; t0 += CH) {
        __syncthreads();
        for (int tt = wave; tt < CH; tt += NWAVES) {
            const int t = t0 + tt; const size_t m = (size_t)b * T + t;
            float aq = 0.f, ak = 0.f, av0 = 0.f, av1 = 0.f;
#pragma unroll
            for (int j = 0; j < 4; ++j) { const int ts = t - 3 + j; if (ts >= 0) { const bf16* pr = p + (m - 3 + j) * NP + C_BQ;
                aq += wq[j] * bf2f(pr[cq]); ak += wk[j] * bf2f(pr[ck]); av0 += wv0[j] * bf2f(pr[cv0]); av1 += wv1[j] * bf2f(pr[cv1]); } }
            Q[tt * 64 + lane] = siluf_(aq) * 0.125f; K[tt * 64 + lane] = siluf_(ak); V[tt * 128 + lane] = siluf_(av0); V[tt * 128 + 64 + lane] = siluf_(av1);
            DEC[tt * 64 + lane] = __expf(bf2f(GK[m * 256 + h * 64 + lane]));
        }
        __syncthreads();
        for (int tt = 0; tt < CH; ++tt) {
            const float vv = V[tt * 128 + row]; float o = 0.f;
#pragma unroll
            for (int q4 = 0; q4 < 4; ++q4) {
                const f32x4 kk = *(const LAS f32x4*)(K + tt * 64 + ks + 4 * q4), dd = *(const LAS f32x4*)(DEC + tt * 64 + ks + 4 * q4), qq = *(const LAS f32x4*)(Q + tt * 64 + ks + 4 * q4);
#pragma unroll
                for (int j = 0; j < 4; ++j) { S[4 * q4 + j] = S[4 * q4 + j] * dd[j] + vv * kk[j]; o += S[4 * q4 + j] * qq[j]; }
            }
            o = red4(o);
            if ((lane & 3) == 0) O[tt * 128 + row] = o;
        }
        __syncthreads();
        for (int tt = wave; tt < CH; tt += NWAVES) {
            const size_t m = (size_t)b * T + t0 + tt;
            const float o0 = O[tt * 128 + lane], o1 = O[tt * 128 + 64 + lane];
            const float ms = wave_sum(o0 * o0 + o1 * o1) * (1.f / 128.f); const float rs = 1.f / sqrtf(ms + RMS_EPS);
            const float g0 = bf2f(p[m * NP + C_BG + h * 128 + lane]), g1 = bf2f(p[m * NP + C_BG + h * 128 + 64 + lane]);
            MIX[m * D + 512 + h * 128 + lane] = (bf16)f2bf(o0 * rs * ng0 * siluf_(g0));
            MIX[m * D + 512 + h * 128 + 64 + lane] = (bf16)f2bf(o1 * rs * ng1 * siluf_(g1));
        }
    }
}
__device__ __forceinline__ void phase_scan(const Params& P, LAS unsigned char* lds) {
    for (int it = blockIdx.x; it < 48; it += gridDim.x) {
        if (it < 32) rwkv_item(P, lds, it >> 3, it & 7); else gla_item(P, lds, (it - 32) >> 2, (it - 32) & 3);
        __syncthreads();
    }
}

__device__ __forceinline__ void phase_ln1(const Params& P) {
    const int lane = threadIdx.x & 63, wave = threadIdx.x >> 6; const int gw = blockIdx.x * NWAVES + wave, ngw = gridDim.x * NWAVES;
    for (int m = gw; m < M; m += ngw) ln_row_bf16((const float*)(P.ws + WS_Z) + (size_t)m * D, P.in[20], P.in[21], (bf16*)(P.ws + WS_H1) + (size_t)m * D, lane);
    const int gtid = blockIdx.x * NTHR + threadIdx.x, gthreads = gridDim.x * NTHR;
#pragma unroll
    for (int tb = 0; tb < 2; ++tb) {
        const f32x4* src = (const f32x4*)P.in[24 + tb]; u32x4* dst = (u32x4*)(P.ws + (tb ? WS_VT : WS_UT));
        for (int i = gtid; i < 16384 * D / 8; i += gthreads) { const f32x4 a = src[2 * i], b = src[2 * i + 1]; u32x4 o; o.x = pk2(a[0], a[1]); o.y = pk2(a[2], a[3]); o.z = pk2(b[0], b[1]); o.w = pk2(b[2], b[3]); dst[i] = o; }
    }
}

#define TK_INS(L, x) do { _Pragma("unroll") for (int _j = 0; _j < 16; ++_j) { const unsigned _h = max(L[_j], x); x = min(L[_j], x); L[_j] = _h; } } while (0)
__device__ __forceinline__ void topk128(const u32x4* r, unsigned (&L)[16]) {
#pragma unroll
    for (int j = 0; j < 16; ++j) L[j] = 0u;
    u32x4 cur = r[0];
    for (int c = 0; c < 16; ++c) {
        const u32x4 nxt = r[(c + 1) & 15];
        const unsigned kb = 0xFFFFu - 8u * (unsigned)c;
#pragma unroll
        for (int d = 0; d < 4; ++d) {
            unsigned w = cur[d]; const unsigned msk = ((w >> 15) & 0x00010001u) * 0xFFFFu; w ^= (msk | 0x80008000u);
            unsigned x0 = (w << 16) | (kb - 2u * d), x1 = (w & 0xFFFF0000u) | (kb - 2u * d - 1u);
            TK_INS(L, x0); TK_INS(L, x1);
        }
        cur = nxt;
    }
}
__device__ __forceinline__ void phase_topk(const Params& P) {
    const int gl = blockIdx.x * NTHR + threadIdx.x, nl = gridDim.x * NTHR;
    const bf16* Sc = (const bf16*)(P.ws + WS_S); int* IDS = (int*)(P.ws + WS_IDS); float* GATES = (float*)(P.ws + WS_GATES);
    for (int item = gl; item < M * 8; item += nl) {
        const u32x4* row = (const u32x4*)(Sc + (size_t)item * 256);
        unsigned L0[16], L1[16];
        topk128(row, L0); topk128(row + 16, L1);
        float f0[16], f1[16]; unsigned p0[16], p1[16];
#pragma unroll
        for (int i = 0; i < 16; ++i) {
            f0[i] = __uint_as_float((L0[i] & 0x80000000u) ? (L0[i] & 0x7FFF0000u) : (~L0[i] & 0xFFFF0000u)); p0[i] = (~L0[i] & 0x7Fu) << 7;
            f1[i] = __uint_as_float((L1[i] & 0x80000000u) ? (L1[i] & 0x7FFF0000u) : (~L1[i] & 0xFFFF0000u)); p1[i] = (~L1[i] & 0x7Fu);
        }
        unsigned C[16];
#pragma unroll
        for (int j = 0; j < 16; ++j) C[j] = 0u;
#pragma unroll
        for (int i = 0; i < 16; ++i)
#pragma unroll
            for (int j = 0; j < 16; ++j)
                if ((i + 1) * (j + 1) <= 16) {
                    const unsigned b = __float_as_uint(f0[i] + f1[j]); const unsigned mono = b ^ ((unsigned)((int)b >> 31) | 0x80000000u);
                    unsigned key = (mono & 0xFFFFC000u) | p0[i] | p1[j];
                    TK_INS(C, key);
                }
        float cv[16];
#pragma unroll
        for (int r = 0; r < 16; ++r) cv[r] = __uint_as_float((C[r] & 0x80000000u) ? (C[r] & 0x7FFFC000u) : (~C[r] & 0xFFFFC000u));
        const float cmax = cv[0]; float den = 0.f;
#pragma unroll
        for (int r = 0; r < 16; ++r) { cv[r] = __expf(cv[r] - cmax); den += cv[r]; }
        const float inv = 1.f / den;
        u32x4* ido = (u32x4*)(IDS + (size_t)item * 16); f32x4* go = (f32x4*)(GATES + (size_t)item * 16);
#pragma unroll
        for (int q = 0; q < 4; ++q) { u32x4 o; o.x = C[4 * q] & 0x3FFFu; o.y = C[4 * q + 1] & 0x3FFFu; o.z = C[4 * q + 2] & 0x3FFFu; o.w = C[4 * q + 3] & 0x3FFFu; ido[q] = o;
            f32x4 g; g[0] = cv[4 * q] * inv; g[1] = cv[4 * q + 1] * inv; g[2] = cv[4 * q + 2] * inv; g[3] = cv[4 * q + 3] * inv; go[q] = g; }
    }
}

typedef __bf16 bf16x2_t __attribute__((ext_vector_type(2)));
__device__ __forceinline__ float dot2bf(unsigned a, unsigned b, float c) { return __builtin_amdgcn_fdot2_f32_bf16(__builtin_bit_cast(bf16x2_t, a), __builtin_bit_cast(bf16x2_t, b), c, false); }
__device__ __forceinline__ void peer_load4(u32x4 (&buf)[4][2], const bf16* TAB, int idreg, int g, int lane) {
#pragma unroll
    for (int q = 0; q < 4; ++q) { const int id = __builtin_amdgcn_readlane(idreg, 4 * g + q); const u32x4* rp = (const u32x4*)(TAB + (size_t)id * D); buf[q][0] = rp[lane]; buf[q][1] = rp[64 + lane]; }
}
__device__ __forceinline__ void peer_dots4(const u32x4 (&buf)[4][2], const u32x4& hA, const u32x4& hB, int g, float& d, int lane) {
#pragma unroll
    for (int q = 0; q < 4; ++q) { float s = 0.f;
#pragma unroll
        for (int i = 0; i < 4; ++i) { s = dot2bf(buf[q][0][i], hA[i], s); s = dot2bf(buf[q][1][i], hB[i], s); }
        const float tot = wave_sum_u(s);
        d = (lane == 4 * g + q) ? tot : d; }
}
__device__ __forceinline__ void peer_axpy4(const u32x4 (&buf)[4][2], float actreg, int g, float (&acc)[16]) {
#pragma unroll
    for (int q = 0; q < 4; ++q) { const float a = rlf(actreg, 4 * g + q);
#pragma unroll
        for (int i = 0; i < 4; ++i) { const unsigned w0 = buf[q][0][i], w1 = buf[q][1][i];
            acc[2 * i] += a * __uint_as_float(w0 << 16); acc[2 * i + 1] += a * __uint_as_float(w0 & 0xffff0000u);
            acc[8 + 2 * i] += a * __uint_as_float(w1 << 16); acc[8 + 2 * i + 1] += a * __uint_as_float(w1 & 0xffff0000u); } }
}
__device__ __forceinline__ void phase_peer(const Params& P) {
    const int lane = threadIdx.x & 63, wave = threadIdx.x >> 6; const int gw = blockIdx.x * NWAVES + wave, ngw = gridDim.x * NWAVES;
    const bf16* H1 = (const bf16*)(P.ws + WS_H1); const int* IDS = (const int*)(P.ws + WS_IDS); const float* GATES = (const float*)(P.ws + WS_GATES);
    const bf16* UT = (const bf16*)(P.ws + WS_UT); const bf16* VT = (const bf16*)(P.ws + WS_VT); const float* g2 = P.in[26]; const float* b2 = P.in[27];
    for (int m = gw; m < M; m += ngw) {
        const u32x4* hp = (const u32x4*)(H1 + (size_t)m * D);
        const u32x4 hA = hp[lane], hB = hp[64 + lane];
        const int id_lo = IDS[(size_t)m * 128 + lane], id_hi = IDS[(size_t)m * 128 + 64 + lane];
        const float gt_lo = GATES[(size_t)m * 128 + lane], gt_hi = GATES[(size_t)m * 128 + 64 + lane];
        float d_lo = 0.f, d_hi = 0.f;
        u32x4 A0[4][2], A1[4][2];
        peer_load4(A0, UT, id_lo, 0, lane);
        for (int g = 0; g < 16; g += 2) {
            peer_load4(A1, UT, id_lo, g + 1, lane); peer_dots4(A0, hA, hB, g, d_lo, lane);
            if (g + 2 < 16) peer_load4(A0, UT, id_lo, g + 2, lane); else peer_load4(A0, UT, id_hi, 0, lane);
            peer_dots4(A1, hA, hB, g + 1, d_lo, lane);
        }
        for (int g = 0; g < 16; g += 2) {
            peer_load4(A1, UT, id_hi, g + 1, lane); peer_dots4(A0, hA, hB, g, d_hi, lane);
            if (g + 2 < 16) peer_load4(A0, UT, id_hi, g + 2, lane); else peer_load4(A0, VT, id_lo, 0, lane);
            peer_dots4(A1, hA, hB, g + 1, d_hi, lane);
        }
        const float act_lo = 0.5f * d_lo * (1.f + erff(d_lo * 0.70710678118f)) * gt_lo, act_hi = 0.5f * d_hi * (1.f + erff(d_hi * 0.70710678118f)) * gt_hi;
        float acc[16];
#pragma unroll
        for (int i = 0; i < 16; ++i) acc[i] = 0.f;
        for (int g = 0; g < 16; g += 2) {
            peer_load4(A1, VT, id_lo, g + 1, lane); peer_axpy4(A0, act_lo, g, acc);
            if (g + 2 < 16) peer_load4(A0, VT, id_lo, g + 2, lane); else peer_load4(A0, VT, id_hi, 0, lane);
            peer_axpy4(A1, act_lo, g + 1, acc);
        }
        for (int g = 0; g < 16; g += 2) {
            peer_load4(A1, VT, id_hi, g + 1, lane); peer_axpy4(A0, act_hi, g, acc);
            if (g + 2 < 16) peer_load4(A0, VT, id_hi, g + 2, lane);
            peer_axpy4(A1, act_hi, g + 1, acc);
        }
        float s = 0.f;
#pragma unroll
        for (int i = 0; i < 4; ++i) { acc[2 * i] += ALPHA * __uint_as_float(hA[i] << 16); acc[2 * i + 1] += ALPHA * __uint_as_float(hA[i] & 0xffff0000u);
            acc[8 + 2 * i] += ALPHA * __uint_as_float(hB[i] << 16); acc[8 + 2 * i + 1] += ALPHA * __uint_as_float(hB[i] & 0xffff0000u); }
#pragma unroll
        for (int i = 0; i < 16; ++i) s += acc[i];
        const float mean = wave_sum(s) * (1.f / D); float s2 = 0.f;
#pragma unroll
        for (int i = 0; i < 16; ++i) { acc[i] -= mean; s2 += acc[i] * acc[i]; }
        const float rstd = 1.f / sqrtf(wave_sum(s2) * (1.f / D) + LN_EPS);
#pragma unroll
        for (int hf = 0; hf < 2; ++hf)
#pragma unroll
            for (int c4 = 0; c4 < 2; ++c4) { const int e0 = hf * 512 + 8 * lane + 4 * c4; const f32x4 gg = *(const f32x4*)(g2 + e0), bb = *(const f32x4*)(b2 + e0); f32x4 o;
#pragma unroll
                for (int j = 0; j < 4; ++j) o[j] = acc[hf * 8 + c4 * 4 + j] * rstd * gg[j] + bb[j];
                *(f32x4*)(P.out + (size_t)m * D + e0) = o; }
    }
}

constexpr int N_PHASES = 10;
__global__ void __launch_bounds__(NTHR, 2) fwd_kernel(Params P) {
    extern __shared__ __attribute__((aligned(16))) unsigned char lds_raw[];
    LAS unsigned char* lds = (LAS unsigned char*)lds_raw;
    cg::grid_group grid = cg::this_grid();
    const int lo = P.ph_lo, hi = P.ph_hi;
    unsigned char* ws = P.ws;
#define IN(k) (lo <= (k) && (k) < hi)
#define SEAM(k) do { if (IN(k) && IN((k) + 1)) grid.sync(); } while (0)
    if (IN(0)) phase_prologue(P);
    SEAM(0);
    if (IN(1)) {
        pg8::Gemm g{(const bf16*)(ws + WS_H0), (const bf16*)(ws + WS_WIN), M, NP, D, D, D, 0}; pg8::StaticOrder S; S.init(M, NP, gridDim.x, blockIdx.x);
        pg8::EpiBf16 E{(bf16*)(ws + WS_P), NP};
        pg8::gemm_phase<pg8::EpiBf16, pg8::StaticOrder, true, true>(lds, g, S, E);
    }
    SEAM(1);
    if (IN(2)) phase_prep(P, lds);
    SEAM(2);
    if (IN(3)) phase_scan(P, lds);
    SEAM(3);
    if (IN(4)) {
        pg8::Gemm g{(const bf16*)(ws + WS_MIX), (const bf16*)(ws + WS_WOUT), M, D, D, D, D, 0}; pg8::StaticOrder S; S.init(M, D, gridDim.x, blockIdx.x);
        pg8::EpiResF32 E{(float*)(ws + WS_Z), (const bf16*)(ws + WS_H0), D, ALPHA};
        pg8::gemm_phase<pg8::EpiResF32, pg8::StaticOrder, true, true>(lds, g, S, E);
    }
    SEAM(4);
    if (IN(5)) phase_ln1(P);
    SEAM(5);
    if (IN(6)) {
        pg8::Gemm g{(const bf16*)(ws + WS_H1), (const bf16*)(ws + WS_WQ), M, NQ, D, D, D, 0}; pg8::StaticOrder S; S.init(M, NQ, gridDim.x, blockIdx.x);
        pg8::EpiBf16 E{(bf16*)(ws + WS_Q), NQ};
        pg8::gemm_phase<pg8::EpiBf16, pg8::StaticOrder, true, true>(lds, g, S, E);
    }
    SEAM(6);
    if (IN(7)) {
        pg8::Gemm g{(const bf16*)(ws + WS_Q), (const bf16*)(ws + WS_KBD), M, NQ, 256, NQ, 256, 256}; pg8::StaticOrder S; S.init(M, NQ, gridDim.x, blockIdx.x);
        pg8::EpiBf16 E{(bf16*)(ws + WS_S), NQ};
        pg8::gemm_phase<pg8::EpiBf16, pg8::StaticOrder, true, true>(lds, g, S, E);
    }
    SEAM(7);
    if (IN(8)) phase_topk(P);
    SEAM(8);
    if (IN(9)) phase_peer(P);
#undef IN
#undef SEAM
}

extern "C" void kernel_launch(void* const* d_in, const int* in_sizes, int n_in, void* d_out, int out_size, void* d_ws, size_t ws_size, hipStream_t stream) {
    static int grid = 0;
    if (grid == 0) {
        if (n_in != 28 || out_size != M * D || ws_size < WS_END) { fprintf(stderr, "kernel_launch: unexpected shapes (n_in %d out %d ws %zu)\n", n_in, out_size, ws_size); grid = -1; return; }
        int dev = 0, cus = 0, per_cu = 0;
        (void)hipGetDevice(&dev); (void)hipDeviceGetAttribute(&cus, hipDeviceAttributeMultiprocessorCount, dev);
        (void)hipFuncSetAttribute((const void*)fwd_kernel, hipFuncAttributeMaxDynamicSharedMemorySize, LDS_BYTES);
        (void)hipOccupancyMaxActiveBlocksPerMultiprocessor(&per_cu, (const void*)fwd_kernel, NTHR, LDS_BYTES);
        if (per_cu < 1) { fprintf(stderr, "kernel_launch: occupancy query says %d blocks per CU\n", per_cu); per_cu = 1; }
        (void)hipGetLastError();
        grid = cus;
    }
    if (grid < 0) return;
    Params p{};
    for (int i = 0; i < 28; ++i) p.in[i] = (const float*)d_in[i];
    p.out = (float*)d_out; p.ws = (unsigned char*)d_ws;
#if MK_ONE_LAUNCH
    p.ph_lo = 0; p.ph_hi = N_PHASES;
    void* args[] = {&p};
    hipError_t e = hipLaunchCooperativeKernel((const void*)fwd_kernel, dim3(grid), dim3(NTHR), args, LDS_BYTES, stream);
    if (e != hipSuccess) fprintf(stderr, "cooperative launch failed: %s (grid %d)\n", hipGetErrorString(e), grid);
#else
    for (int ph = 0; ph < N_PHASES; ++ph) {
        p.ph_lo = ph; p.ph_hi = ph + 1;
        hipLaunchKernelGGL(fwd_kernel, dim3(grid), dim3(NTHR), LDS_BYTES, stream, p);
    }
#endif
}
```

```cpp
#include <hip/hip_runtime.h>
#include <hip/hip_cooperative_groups.h>
#include <cstdio>
#include <cstdint>
namespace cg = cooperative_groups;

#ifndef MK_ONE_LAUNCH
#define MK_ONE_LAUNCH 1
#endif

namespace pg8 {
#define PG8_LAS __attribute__((address_space(3)))
typedef unsigned short bf16_t;
typedef short bf16x8 __attribute__((ext_vector_type(8)));
typedef float f32x4 __attribute__((ext_vector_type(4)));
typedef unsigned u32x4 __attribute__((ext_vector_type(4)));
typedef unsigned u32x2 __attribute__((ext_vector_type(2)));
constexpr int BM = 256, BK = 64, HALF = 128, HTB = HALF * BK * 2, STAGE_BYTES = 8 * HTB, NXCD = 8, WGM = 8;

__host__ __device__ __forceinline__ int lds_byte(int r, int c) { const int st = (r >> 4) * 2 + (c >> 5), rr = r & 15, cc = c & 31, ob = rr * 64 + cc * 2; return st * 1024 + (ob ^ (((ob >> 9) & 1) << 5)); }
__host__ __device__ __forceinline__ void stage_rc(int b, int& R, int& C) { const int st = b / 1024, sb = b % 1024, swz = sb ^ (((sb >> 9) & 1) << 5); R = (st >> 1) * 16 + swz / 64; C = (st & 1) * 32 + (swz % 64) / 2; }
__host__ __device__ __forceinline__ int perm32(int rho) { const int n = rho >> 4, i = rho & 15; return 8 * (i >> 2) + 4 * n + (i & 3); }

struct Unit { int pm, pn; };
struct Gemm { const bf16_t* A; const bf16_t* Bt; int M, N, K, lda, ldb, a_pn_koff; };

struct StaticOrder {
    int nM, nN, nwg, G, c;
    __host__ __device__ void init(int M, int N, int G_, int c_) { nM = M / BM; nN = N / BM; nwg = nM * nN; G = G_; c = c_; }
    __host__ __device__ bool next(int i, Unit& u) const {
        const long L = (long)i * G + c; if (L >= nwg) return false;
        int wgid = (int)L; { const int q = nwg / NXCD, r = nwg % NXCD, xcd = wgid % NXCD, off = wgid / NXCD; wgid = (xcd < r ? xcd * (q + 1) : r * (q + 1) + (xcd - r) * q) + off; }
        const int nig = WGM * nN, gid = wgid / nig, fm = gid * WGM, gsz = (nM - fm) < WGM ? (nM - fm) : WGM;
        u.pm = fm + ((wgid % nig) % gsz); u.pn = (wgid % nig) / gsz; return true;
    }
    __device__ __forceinline__ void a_ready(const Unit&) const {}
    __device__ __forceinline__ void done(const Unit&) const {}
};

__device__ __forceinline__ unsigned cvt_pk_bf16(float lo, float hi) { unsigned r; asm volatile("v_cvt_pk_bf16_f32 %0, %1, %2" : "=v"(r) : "v"(lo), "v"(hi)); return r; }

struct EpiBf16 {
    static constexpr bool PERM = true;
    bf16_t* O; int ldc;
    __device__ __forceinline__ void operator()(const f32x4 (&acc)[2][2][4][2], const Unit& u, int wr, int wc, int fr, int fq) const {
        const int row0 = u.pm * BM + wr * 64 + fr; const int col0 = u.pn * BM + wc * 32 + 8 * fq;
#pragma unroll
        for (int ai = 0; ai < 2; ++ai)
#pragma unroll
            for (int m = 0; m < 4; ++m) { bf16_t* rowp = O + (size_t)(row0 + ai * HALF + m * 16) * ldc + col0;
#pragma unroll
                for (int bj = 0; bj < 2; ++bj) { const f32x4 v0 = acc[ai][bj][m][0], v1 = acc[ai][bj][m][1];
                    u32x4 w; w.x = cvt_pk_bf16(v0[0], v0[1]); w.y = cvt_pk_bf16(v0[2], v0[3]); w.z = cvt_pk_bf16(v1[0], v1[1]); w.w = cvt_pk_bf16(v1[2], v1[3]);
                    *(u32x4*)(rowp + bj * HALF) = w; } }
    }
};
struct EpiResF32 {
    static constexpr bool PERM = false;
    float* Z; const bf16_t* R; int ldc; float alpha;
    __device__ __forceinline__ void operator()(const f32x4 (&acc)[2][2][4][2], const Unit& u, int wr, int wc, int fr, int fq) const {
        const int row0 = u.pm * BM + wr * 64 + fr; const int col0 = u.pn * BM + wc * 32 + 4 * fq;
#pragma unroll
        for (int ai = 0; ai < 2; ++ai)
#pragma unroll
            for (int m = 0; m < 4; ++m) { const size_t off = (size_t)(row0 + ai * HALF + m * 16) * ldc + col0;
#pragma unroll
                for (int bj = 0; bj < 2; ++bj)
#pragma unroll
                    for (int n = 0; n < 2; ++n) { const size_t o2 = off + bj * HALF + n * 16; const u32x2 rb = *(const u32x2*)(R + o2);
                        f32x4 h; h[0] = __uint_as_float(rb.x << 16); h[1] = __uint_as_float(rb.x & 0xffff0000u); h[2] = __uint_as_float(rb.y << 16); h[3] = __uint_as_float(rb.y & 0xffff0000u);
                        *(f32x4*)(Z + o2) = h * alpha + acc[ai][bj][m][n]; } }
    }
};

template <class Epi, class Sched, bool ALIGN_EPI = false, bool SP2 = false>
__device__ __forceinline__ void gemm_phase(PG8_LAS unsigned char* lds, const Gemm g, const Sched& S, const Epi& E) {
    const int tid = threadIdx.x, wid = __builtin_amdgcn_readfirstlane(tid >> 6), lane = tid & 63, wr = wid >> 2, wc = wid & 3, fr = lane & 15, fq = lane >> 4;
    const int K = g.K, nt = K / BK;
    unsigned voffA[2], voffB[2];
#pragma unroll
    for (int i = 0; i < 2; ++i) { int R, C; stage_rc(tid * 16 + i * 8192, R, C); const int Rb = Epi::PERM ? ((R & ~31) + perm32(R & 31)) : R;
        voffA[i] = (unsigned)(R * g.lda + C) * 2u; voffB[i] = (unsigned)(Rb * g.ldb + C) * 2u; }
    const size_t kstep = (size_t)(BK * 2);
    const size_t hstepA = (size_t)HALF * g.lda * 2, hstepB = (size_t)HALF * g.ldb * 2;
    const size_t tstepA = 2 * hstepA, tstepB = 2 * hstepB;
    const size_t pnA = (size_t)g.a_pn_koff * 2;
    const unsigned ldsw = (unsigned)wid * 1024u;
    const int aoff = lds_byte(wr * 64 + fr, fq * 8), boff = lds_byte(wc * 32 + fr, fq * 8);
#define PG8_SA(b, h) (((b) * 2 + (h)) * HTB)
#define PG8_SB(b, h) ((4 + (b) * 2 + (h)) * HTB)
#define PG8_STAGE(bufoff, gbase, voff) do { _Pragma("unroll") for (int _i = 0; _i < 2; ++_i) \
        __builtin_amdgcn_global_load_lds((const unsigned*)((const char*)(gbase) + (voff)[_i]), (PG8_LAS unsigned*)(lds + (bufoff) + ldsw + _i * 8192), 16, 0, 0); } while (0)
#define PG8_LDA(dst, b, h) do { _Pragma("unroll") for (int m = 0; m < 4; ++m) _Pragma("unroll") for (int k = 0; k < 2; ++k) dst[m][k] = *(const PG8_LAS bf16x8*)(lds + PG8_SA(b, h) + aoff + m * 2048 + k * 1024); } while (0)
#define PG8_LDB(dst, b, h) do { _Pragma("unroll") for (int n = 0; n < 2; ++n) _Pragma("unroll") for (int k = 0; k < 2; ++k) dst[n][k] = *(const PG8_LAS bf16x8*)(lds + PG8_SB(b, h) + boff + n * 2048 + k * 1024); } while (0)
#define PG8_MMA(ai, bj, At, Bt) do { __builtin_amdgcn_s_setprio(1); _Pragma("unroll") for (int m = 0; m < 4; ++m) _Pragma("unroll") for (int n = 0; n < 2; ++n) _Pragma("unroll") for (int k = 0; k < 2; ++k) \
        acc[ai][bj][m][n] = __builtin_amdgcn_mfma_f32_16x16x32_bf16(Bt[n][k], At[m][k], acc[ai][bj][m][n], 0, 0, 0); __builtin_amdgcn_s_setprio(0); } while (0)
#define PG8_WAIT_V(n) asm volatile("s_waitcnt vmcnt(" #n ")" ::: "memory")
#define PG8_WAIT_L(n) asm volatile("s_waitcnt lgkmcnt(" #n ")" ::: "memory")
#define PG8_BAR __builtin_amdgcn_s_barrier()
#define PG8_SCHED __builtin_amdgcn_sched_barrier(0)
    Unit cur, nxt; int ui = 0;
    if (!S.next(0, cur)) return;
    f32x4 acc[2][2][4][2];
#pragma unroll
    for (int a = 0; a < 2; ++a)
#pragma unroll
        for (int b = 0; b < 2; ++b)
#pragma unroll
            for (int m = 0; m < 4; ++m)
#pragma unroll
                for (int n = 0; n < 2; ++n) acc[a][b][m][n] = (f32x4){0.f, 0.f, 0.f, 0.f};
    bf16x8 At[4][2], B0[2][2], B1[2][2];
    const char* cA = (const char*)g.A + (size_t)cur.pm * tstepA + (size_t)cur.pn * pnA; const char* cB = (const char*)g.Bt + (size_t)cur.pn * tstepB;
    S.a_ready(cur);
    if constexpr (SP2) {
        PG8_STAGE(PG8_SB(0, 0), cB, voffB); PG8_STAGE(PG8_SB(0, 1), cB + hstepB, voffB); PG8_STAGE(PG8_SA(0, 0), cA, voffA); PG8_STAGE(PG8_SA(0, 1), cA + hstepA, voffA);
        if (wr == 1) PG8_BAR;
        PG8_WAIT_V(2); PG8_BAR;
        PG8_STAGE(PG8_SB(1, 0), cB + kstep, voffB); PG8_STAGE(PG8_SA(1, 0), cA + kstep, voffA); PG8_STAGE(PG8_SB(1, 1), cB + hstepB + kstep, voffB);
        PG8_WAIT_V(6); PG8_BAR;
    } else {
        PG8_STAGE(PG8_SB(0, 0), cB, voffB); PG8_STAGE(PG8_SA(0, 0), cA, voffA); PG8_STAGE(PG8_SB(0, 1), cB + hstepB, voffB); PG8_STAGE(PG8_SA(0, 1), cA + hstepA, voffA);
        if (wr == 1) PG8_BAR;
        PG8_WAIT_V(4); PG8_BAR;
        PG8_STAGE(PG8_SB(1, 0), cB + kstep, voffB); PG8_STAGE(PG8_SA(1, 0), cA + kstep, voffA); PG8_STAGE(PG8_SB(1, 1), cB + hstepB + kstep, voffB);
        PG8_WAIT_V(6); PG8_BAR;
    }
    for (;;) {
        const bool has_next = S.next(ui + 1, nxt);
        const char* nA = has_next ? (const char*)g.A + (size_t)nxt.pm * tstepA + (size_t)nxt.pn * pnA : cA; const char* nB = has_next ? (const char*)g.Bt + (size_t)nxt.pn * tstepB : cB;
        for (int t = 0; t < nt; t += 2) {
            const bool last = (t == nt - 2);
            const char* a1 = cA + (size_t)(t + 1) * kstep;
            const char* a2 = last ? nA : cA + (size_t)(t + 2) * kstep; const char* b2 = last ? nB : cB + (size_t)(t + 2) * kstep;
            const char* a3 = a2 + kstep; const char* b3 = b2 + kstep;
            if (last && has_next) S.a_ready(nxt);
            if constexpr (SP2) {
            PG8_LDB(B0, 0, 0); PG8_LDB(B1, 0, 1); PG8_SCHED; PG8_LDA(At, 0, 0); PG8_STAGE(PG8_SA(1, 1), a1 + hstepA, voffA);
            PG8_WAIT_V(8); PG8_WAIT_L(0); PG8_BAR; PG8_MMA(0, 0, At, B0); PG8_MMA(0, 1, At, B1); PG8_BAR; PG8_SCHED;
            PG8_LDA(At, 0, 1); PG8_STAGE(PG8_SB(0, 0), b2, voffB); PG8_STAGE(PG8_SB(0, 1), b2 + hstepB, voffB); PG8_STAGE(PG8_SA(0, 0), a2, voffA);
            PG8_WAIT_V(8); PG8_WAIT_L(0); PG8_BAR; PG8_MMA(1, 0, At, B0); PG8_MMA(1, 1, At, B1); PG8_BAR; PG8_SCHED;
            PG8_LDB(B0, 1, 0); PG8_LDB(B1, 1, 1); PG8_SCHED; PG8_LDA(At, 1, 0); PG8_STAGE(PG8_SA(0, 1), a2 + hstepA, voffA);
            PG8_WAIT_V(8); PG8_WAIT_L(0); PG8_BAR; PG8_MMA(0, 0, At, B0); PG8_MMA(0, 1, At, B1); PG8_BAR; PG8_SCHED;
            PG8_LDA(At, 1, 1); PG8_STAGE(PG8_SB(1, 0), b3, voffB); PG8_STAGE(PG8_SB(1, 1), b3 + hstepB, voffB); PG8_STAGE(PG8_SA(1, 0), a3, voffA);
            PG8_WAIT_V(8); PG8_WAIT_L(0); PG8_BAR; PG8_MMA(1, 0, At, B0); PG8_MMA(1, 1, At, B1); PG8_BAR; PG8_SCHED;
            } else {
            PG8_LDB(B0, 0, 0); PG8_SCHED; PG8_LDA(At, 0, 0); PG8_STAGE(PG8_SA(1, 1), a1 + hstepA, voffA);
            PG8_WAIT_L(8); PG8_BAR; PG8_WAIT_L(0); PG8_MMA(0, 0, At, B0); PG8_BAR; PG8_SCHED;
            PG8_LDB(B1, 0, 1); PG8_STAGE(PG8_SB(0, 0), b2, voffB);
            PG8_BAR; PG8_WAIT_L(0); PG8_MMA(0, 1, At, B1); PG8_BAR;
            PG8_LDA(At, 0, 1); PG8_STAGE(PG8_SA(0, 0), a2, voffA);
            PG8_BAR; PG8_WAIT_L(0); PG8_MMA(1, 0, At, B0); PG8_BAR; PG8_SCHED;
            PG8_STAGE(PG8_SB(0, 1), b2 + hstepB, voffB);
            PG8_WAIT_V(6); PG8_BAR; PG8_MMA(1, 1, At, B1); PG8_BAR;
            PG8_LDB(B0, 1, 0); PG8_SCHED; PG8_LDA(At, 1, 0); PG8_STAGE(PG8_SA(0, 1), a2 + hstepA, voffA);
            PG8_WAIT_L(8); PG8_BAR; PG8_WAIT_L(0); PG8_MMA(0, 0, At, B0); PG8_BAR; PG8_SCHED;
            PG8_LDB(B1, 1, 1); PG8_STAGE(PG8_SB(1, 0), b3, voffB);
            PG8_BAR; PG8_WAIT_L(0); PG8_MMA(0, 1, At, B1); PG8_BAR;
            PG8_LDA(At, 1, 1); PG8_STAGE(PG8_SA(1, 0), a3, voffA);
            PG8_BAR; PG8_WAIT_L(0); PG8_MMA(1, 0, At, B0); PG8_BAR; PG8_SCHED;
            PG8_STAGE(PG8_SB(1, 1), b3 + hstepB, voffB);
            PG8_WAIT_V(6); PG8_BAR; PG8_MMA(1, 1, At, B1); PG8_BAR;
            }
        }
        if constexpr (ALIGN_EPI) { if (wr == 0) PG8_BAR; }
        E(acc, cur, wr, wc, fr, fq); S.done(cur);
        if (!has_next) break;
#pragma unroll
        for (int a = 0; a < 2; ++a)
#pragma unroll
            for (int b = 0; b < 2; ++b)
#pragma unroll
                for (int m = 0; m < 4; ++m)
#pragma unroll
                    for (int n = 0; n < 2; ++n) acc[a][b][m][n] = (f32x4){0.f, 0.f, 0.f, 0.f};
        cur = nxt; cA = nA; cB = nB; ++ui;
        if constexpr (ALIGN_EPI) { if (wr == 1) PG8_BAR; }
    }
    PG8_WAIT_V(0);
    if constexpr (!ALIGN_EPI) { if (wr == 0) PG8_BAR; }
    PG8_BAR;
#undef PG8_SA
#undef PG8_SB
#undef PG8_STAGE
#undef PG8_LDA
#undef PG8_LDB
#undef PG8_MMA
#undef PG8_WAIT_V
#undef PG8_WAIT_L
#undef PG8_BAR
#undef PG8_SCHED
}
}

constexpr int NWAVES = 8, NTHR = NWAVES * 64;
constexpr int D = 1024, NBATCH = 4, T = 8192, M = NBATCH * T;
constexpr int A_W = 512, A_IN = 1792, IN_COLS = 3344, NP = 3584;
constexpr int C_R = 0, C_K = 512, C_V = 1024, C_WD = 1536, C_AD = 1600, C_GD = 1664;
constexpr int C_BQ = 1792, C_BK = 2048, C_BV = 2304, C_GKD = 2816, C_BG = 2832;
constexpr int NQ = 2048;
constexpr float LN_EPS = 1e-5f, GN_EPS = 64e-5f, RMS_EPS = 1e-5f;
constexpr float ALPHA = 1.189207115002721f;

typedef unsigned short bf16;
typedef float f32x4 __attribute__((ext_vector_type(4)));
typedef unsigned u32x4 __attribute__((ext_vector_type(4)));
typedef unsigned u32x2 __attribute__((ext_vector_type(2)));
#define LAS __attribute__((address_space(3)))

constexpr size_t MiB = 1u << 20;
constexpr size_t WS_WIN = 1 * MiB, WS_WOUT = 8 * MiB, WS_WQ = 10 * MiB, WS_KBD = 14 * MiB;
constexpr size_t WS_H0 = 16 * MiB;
constexpr size_t WS_P = 80 * MiB;
constexpr size_t WS_WL = 304 * MiB, WS_AA = 336 * MiB, WS_GG = 368 * MiB;
constexpr size_t WS_GK = 400 * MiB;
constexpr size_t WS_MIX = 416 * MiB;
constexpr size_t WS_Z = 80 * MiB;
constexpr size_t WS_H1 = 208 * MiB;
constexpr size_t WS_Q = 272 * MiB;
constexpr size_t WS_S = 80 * MiB;
constexpr size_t WS_IDS = 400 * MiB, WS_GATES = 416 * MiB;
constexpr size_t WS_UT = 432 * MiB, WS_VT = 464 * MiB;
constexpr size_t WS_END = 496 * MiB;

constexpr int LDS_BYTES = 147456;

struct Params {
    const float* in[28];
    float* out; unsigned char* ws;
    int ph_lo, ph_hi;
};

__device__ __forceinline__ float bf2f(unsigned u) { return __uint_as_float(u << 16); }
__device__ __forceinline__ unsigned f2bf(float f) { unsigned u = __float_as_uint(f); return (u + 0x7fffu + ((u >> 16) & 1u)) >> 16; }
__device__ __forceinline__ unsigned pk2(float lo, float hi) { return f2bf(lo) | (f2bf(hi) << 16); }
#define DPP_F(v, ctrl) __builtin_bit_cast(float, __builtin_amdgcn_update_dpp(0, __builtin_bit_cast(int, (v)), (ctrl), 0xf, 0xf, false))
#define DPP_ADD(v, ctrl) ((v) + DPP_F(v, ctrl))
__device__ __forceinline__ float rlf(float v, int l) { return __builtin_bit_cast(float, __builtin_amdgcn_readlane(__builtin_bit_cast(int, v), l)); }
__device__ __forceinline__ float wave_sum_u(float v) {
    v = DPP_ADD(v, 0xB1); v = DPP_ADD(v, 0x4E); v = DPP_ADD(v, 0x141); v = DPP_ADD(v, 0x140);
    return (rlf(v, 0) + rlf(v, 16)) + (rlf(v, 32) + rlf(v, 48));
}
__device__ __forceinline__ float wave_sum(float v) { return wave_sum_u(v); }
__device__ __forceinline__ float sigmoidf_(float x) { return 1.f / (1.f + __expf(-x)); }
__device__ __forceinline__ float softplusf_(float x) { return fmaxf(x, 0.f) + log1pf(__expf(-fabsf(x))); }
__device__ __forceinline__ float siluf_(float x) { return x * sigmoidf_(x); }

__device__ __forceinline__ void transpose_convert(const float* W, int K, int N, int Npad, bf16* WT, int gtid, int gthreads) {
    const int kc = K / 8, total = Npad * kc;
    for (int idx = gtid; idx < total; idx += gthreads) {
        const int n = idx % Npad, c = idx / Npad; float v[8];
#pragma unroll
        for (int j = 0; j < 8; ++j) v[j] = (n < N) ? W[(size_t)(8 * c + j) * N + n] : 0.f;
        u32x4 o; o.x = pk2(v[0], v[1]); o.y = pk2(v[2], v[3]); o.z = pk2(v[4], v[5]); o.w = pk2(v[6], v[7]);
        *(u32x4*)(WT + (size_t)n * K + 8 * c) = o;
    }
}
__device__ __forceinline__ void ln_row_bf16(const float* xrow, const float* g, const float* b, bf16* orow, int lane) {
    const f32x4* xr = (const f32x4*)xrow + lane; f32x4 v[4]; float s = 0.f;
#pragma unroll
    for (int j = 0; j < 4; ++j) { v[j] = xr[64 * j]; s += (v[j][0] + v[j][1]) + (v[j][2] + v[j][3]); }
    const float mean = wave_sum(s) * (1.f / D); float s2 = 0.f;
#pragma unroll
    for (int j = 0; j < 4; ++j) { v[j] = v[j] - mean; s2 += (v[j][0] * v[j][0] + v[j][1] * v[j][1]) + (v[j][2] * v[j][2] + v[j][3] * v[j][3]); }
    const float rstd = 1.f / sqrtf(wave_sum(s2) * (1.f / D) + LN_EPS);
    u32x2* o8 = (u32x2*)orow + lane;
#pragma unroll
    for (int j = 0; j < 4; ++j) { const f32x4 gg = ((const f32x4*)g)[lane + 64 * j], bb = ((const f32x4*)b)[lane + 64 * j]; const f32x4 y = v[j] * rstd * gg + bb;
        u32x2 w; w.x = pk2(y[0], y[1]); w.y = pk2(y[2], y[3]); o8[64 * j] = w; }
}
__device__ __forceinline__ void phase_prologue(const Params& P) {
    const int tid = threadIdx.x, lane = tid & 63, wave = tid >> 6;
    const int gtid = blockIdx.x * NTHR + tid, gthreads = gridDim.x * NTHR;
    unsigned char* ws = P.ws;
    transpose_convert(P.in[3], D, IN_COLS, NP, (bf16*)(ws + WS_WIN), gtid, gthreads);
    transpose_convert(P.in[19], D, D, D, (bf16*)(ws + WS_WOUT), gtid, gthreads);
    transpose_convert(P.in[22], D, NQ, NQ, (bf16*)(ws + WS_WQ), gtid, gthreads);
    {
        const float* keys = P.in[23]; bf16* kbd = (bf16*)(ws + WS_KBD);
        for (int idx = gtid; idx < 8 * 256 * 32; idx += gthreads) {
            const int kc = idx & 31, n = (idx >> 5) & 255, h = idx >> 13; const int k0 = kc * 8, hn = n >> 7, key = n & 127, hk = k0 >> 7, c0 = k0 & 127;
            u32x4 o = (u32x4){0u, 0u, 0u, 0u};
            if (hn == hk) { const float* s = keys + ((size_t)((h * 2 + hn) * 128 + key)) * 128 + c0; o.x = pk2(s[0], s[1]); o.y = pk2(s[2], s[3]); o.z = pk2(s[4], s[5]); o.w = pk2(s[6], s[7]); }
            *(u32x4*)(kbd + ((size_t)(h * 256 + n)) * 256 + k0) = o;
        }
    }
    const int gw = blockIdx.x * NWAVES + wave, ngw = gridDim.x * NWAVES;
    for (int m = gw; m < M; m += ngw) ln_row_bf16(P.in[0] + (size_t)m * D, P.in[1], P.in[2], (bf16*)(ws + WS_H0) + (size_t)m * D, lane);
}

__device__ __forceinline__ void phase_prep(const Params& P, LAS unsigned char* lds) {
    const int tid = threadIdx.x;
    unsigned char* ws = P.ws;
    const bf16* p = (const bf16*)(ws + WS_P);
    const float* mu = P.in[4]; const float* w0 = P.in[5]; const float* w2 = P.in[6]; const float* a0 = P.in[7]; const float* a2 = P.in[8]; const float* g2 = P.in[9];
    const float* gkw2 = P.in[16]; const float* gkb = P.in[17];
    bf16* WL = (bf16*)(ws + WS_WL); bf16* AA = (bf16*)(ws + WS_AA); bf16* GG = (bf16*)(ws + WS_GG); bf16* GK = (bf16*)(ws + WS_GK);
    LAS float* act = (LAS float*)lds;
    LAS float* gkd = (LAS float*)(lds + 64 * 260 * 4);
    constexpr int AS = 260;
    for (int tile = blockIdx.x; tile < M / 64; tile += gridDim.x) {
        const int m0 = tile * 64;
        __syncthreads();
        for (int idx = tid; idx < 64 * 256; idx += NTHR) {
            const int j = idx & 255, tok = idx >> 8, m = m0 + tok, t = m & (T - 1);
            const float cur = bf2f(p[(size_t)m * NP + C_WD + j]);
            const float prev = (t > 0) ? bf2f(p[(size_t)(m - 1) * NP + C_WD + j]) : 0.f;
            const float x = cur + (prev - cur) * mu[C_WD + j];
            float v;
            if (j < 64) v = tanhf(x); else if (j < 128) v = x; else v = sigmoidf_(x);
            act[tok * AS + j] = v;
        }
        for (int idx = tid; idx < 64 * 16; idx += NTHR) { const int j = idx & 15, tok = idx >> 4; gkd[tok * 16 + j] = bf2f(p[(size_t)(m0 + tok) * NP + C_GKD + j]); }
        __syncthreads();
        const int c = tid;
        float acc[64];
#pragma unroll
        for (int i = 0; i < 64; ++i) acc[i] = 0.f;
        for (int j = 0; j < 64; j += 4) {
            const float x0 = w2[(j + 0) * A_W + c], x1 = w2[(j + 1) * A_W + c], x2 = w2[(j + 2) * A_W + c], x3 = w2[(j + 3) * A_W + c];
#pragma unroll
            for (int i = 0; i < 64; ++i) { const f32x4 a = *(const LAS f32x4*)(act + i * AS + j); acc[i] += a[0] * x0 + a[1] * x1 + a[2] * x2 + a[3] * x3; }
        }
        { const float b0 = w0[c];
#pragma unroll
          for (int i = 0; i < 64; ++i) { const float z = b0 + acc[i]; const float w = -softplusf_(-z) - 0.5f; WL[(size_t)(m0 + i) * A_W + c] = (bf16)f2bf(-__expf(w)); } }
#pragma unroll
        for (int i = 0; i < 64; ++i) acc[i] = 0.f;
        for (int j = 0; j < 64; j += 4) {
            const float x0 = a2[(j + 0) * A_W + c], x1 = a2[(j + 1) * A_W + c], x2 = a2[(j + 2) * A_W + c], x3 = a2[(j + 3) * A_W + c];
#pragma unroll
            for (int i = 0; i < 64; ++i) { const f32x4 a = *(const LAS f32x4*)(act + i * AS + 64 + j); acc[i] += a[0] * x0 + a[1] * x1 + a[2] * x2 + a[3] * x3; }
        }
        { const float b0 = a0[c];
#pragma unroll
          for (int i = 0; i < 64; ++i) AA[(size_t)(m0 + i) * A_W + c] = (bf16)f2bf(sigmoidf_(b0 + acc[i])); }
#pragma unroll
        for (int i = 0; i < 64; ++i) acc[i] = 0.f;
        for (int j = 0; j < 128; j += 4) {
            const float x0 = g2[(j + 0) * A_W + c], x1 = g2[(j + 1) * A_W + c], x2 = g2[(j + 2) * A_W + c], x3 = g2[(j + 3) * A_W + c];
#pragma unroll
            for (int i = 0; i < 64; ++i) { const f32x4 a = *(const LAS f32x4*)(act + i * AS + 128 + j); acc[i] += a[0] * x0 + a[1] * x1 + a[2] * x2 + a[3] * x3; }
        }
#pragma unroll
        for (int i = 0; i < 64; ++i) GG[(size_t)(m0 + i) * A_W + c] = (bf16)f2bf(acc[i]);
        { const int cc = tid & 255, th = tid >> 8; float wv[16];
#pragma unroll
          for (int j = 0; j < 16; ++j) wv[j] = gkw2[j * 256 + cc];
          const float bb = gkb[cc];
          for (int i = 0; i < 32; ++i) { const int tok = th * 32 + i; float s = bb;
#pragma unroll
              for (int j = 0; j < 16; ++j) s += gkd[tok * 16 + j] * wv[j];
              GK[(size_t)(m0 + tok) * 256 + cc] = (bf16)f2bf(-softplusf_(-s) * (1.f / 16.f)); } }
    }
}

constexpr int CH = 32;
__device__ __forceinline__ float red8(float v) { v = DPP_ADD(v, 0xB1); v = DPP_ADD(v, 0x4E); v = DPP_ADD(v, 0x141); return v; }
__device__ __forceinline__ float red4(float v) { v = DPP_ADD(v, 0xB1); v = DPP_ADD(v, 0x4E); return v; }

constexpr int RW_BUF = 6 * CH * 64 + 64;
__device__ __forceinline__ void rw_load(const bf16* p, const bf16* AA, const bf16* WL, const bf16* GG, int b, int t0, int col, int wave,
        unsigned (&rc)[4], unsigned (&kc)[4], unsigned (&vc)[4], unsigned (&rp)[4], unsigned (&kp)[4], unsigned (&vp)[4], unsigned (&a)[4], unsigned (&wl)[4], unsigned (&gg)[4]) {
#pragma unroll
    for (int q = 0; q < 4; ++q) {
        const int t = t0 + wave + 8 * q; const size_t m = (size_t)b * T + t; const bf16* pr = p + m * NP; const bf16* pp = (t > 0) ? pr - NP : pr;
        rc[q] = pr[C_R + col]; kc[q] = pr[C_K + col]; vc[q] = pr[C_V + col]; rp[q] = pp[C_R + col]; kp[q] = pp[C_K + col]; vp[q] = pp[C_V + col];
        a[q] = AA[m * A_W + col]; wl[q] = WL[m * A_W + col]; gg[q] = GG[m * A_W + col];
    }
}
__device__ __forceinline__ void rw_prep(LAS float* B, int t0, int wave, int lane, float mu_r, float mu_k, float mu_v, float kkc, float kac, float rkc,
        const unsigned (&rc_)[4], const unsigned (&kc_)[4], const unsigned (&vc_)[4], const unsigned (&rp_)[4], const unsigned (&kp_)[4], const unsigned (&vp_)[4], const unsigned (&a_)[4], const unsigned (&wl_)[4]) {
    LAS float* R = B; LAS float* DEC = R + CH * 64; LAS float* KH = DEC + CH * 64; LAS float* KK = KH + CH * 64; LAS float* BB = KK + CH * 64; LAS float* V = BB + CH * 64; LAS float* BON = V + CH * 64;
#pragma unroll
    for (int q = 0; q < 4; ++q) {
        const int tt = wave + 8 * q; const float hp = (t0 + tt > 0) ? 1.f : 0.f;
        const float rc = bf2f(rc_[q]), kc = bf2f(kc_[q]), vc = bf2f(vc_[q]), rp = bf2f(rp_[q]) * hp, kp = bf2f(kp_[q]) * hp, vp = bf2f(vp_[q]) * hp;
        const float r = rc + (rp - rc) * mu_r, k = kc + (kp - kc) * mu_k, v = vc + (vp - vc) * mu_v;
        const float a = bf2f(a_[q]), wl = bf2f(wl_[q]);
        const float kr = k * kkc; const float nrm = sqrtf(wave_sum(kr * kr)); const float kk = kr / fmaxf(nrm, 1e-12f);
        const float kh = k * (1.f + (a - 1.f) * kac);
        const float bon = wave_sum(r * kh * rkc);
        R[tt * 64 + lane] = r; DEC[tt * 64 + lane] = __expf(wl); KH[tt * 64 + lane] = kh; KK[tt * 64 + lane] = kk; BB[tt * 64 + lane] = kk * a; V[tt * 64 + lane] = v;
        if (lane == 0) BON[tt] = bon;
    }
}
__device__ __forceinline__ void rwkv_item(const Params& P, LAS unsigned char* lds, int b, int h) {
    const int tid = threadIdx.x, lane = tid & 63, wave = tid >> 6;
    unsigned char* ws = P.ws;
    const bf16* p = (const bf16*)(ws + WS_P); const bf16* WL = (const bf16*)(ws + WS_WL); const bf16* AA = (const bf16*)(ws + WS_AA); const bf16* GG = (const bf16*)(ws + WS_GG);
    bf16* MIX = (bf16*)(ws + WS_MIX);
    const float* mu = P.in[4]; const float* k_k = P.in[10]; const float* k_a = P.in[11]; const float* r_k = P.in[12]; const float* gn_g = P.in[13]; const float* gn_b = P.in[14];
    LAS float* BUF = (LAS float*)lds; LAS float* Y = BUF + 2 * RW_BUF;
    const int col = h * 64 + lane;
    const float mu_r = mu[C_R + col], mu_k = mu[C_K + col], mu_v = mu[C_V + col], kkc = k_k[col], kac = k_a[col], rkc = r_k[col], gng = gn_g[col], gnb = gn_b[col];
    float S[8];
#pragma unroll
    for (int j = 0; j < 8; ++j) S[j] = 0.f;
    const int row = wave * 8 + (lane >> 3), ks = (lane & 7) * 8;
    unsigned rc[4], kc[4], vc[4], rp[4], kp[4], vp[4], a[4], wl[4], gg[4], ggc[4];
    __syncthreads();
    rw_load(p, AA, WL, GG, b, 0, col, wave, rc, kc, vc, rp, kp, vp, a, wl, gg);
    rw_prep(BUF, 0, wave, lane, mu_r, mu_k, mu_v, kkc, kac, rkc, rc, kc, vc, rp, kp, vp, a, wl);
    __syncthreads();
    for (int ci = 0; ci < T / CH; ++ci) {
        const int t0 = ci * CH; LAS float* B = BUF + (ci & 1) * RW_BUF;
        LAS float* R = B; LAS float* DEC = R + CH * 64; LAS float* KH = DEC + CH * 64; LAS float* KK = KH + CH * 64; LAS float* BB = KK + CH * 64; LAS float* V = BB + CH * 64; LAS float* BON = V + CH * 64;
#pragma unroll
        for (int q = 0; q < 4; ++q) ggc[q] = gg[q];
        const bool more = (ci + 1 < T / CH);
        if (more) rw_load(p, AA, WL, GG, b, t0 + CH, col, wave, rc, kc, vc, rp, kp, vp, a, wl, gg);
        for (int tt = 0; tt < CH; ++tt) {
            const f32x4 k0 = *(const LAS f32x4*)(KK + tt * 64 + ks), k1 = *(const LAS f32x4*)(KK + tt * 64 + ks + 4);
            const f32x4 d0 = *(const LAS f32x4*)(DEC + tt * 64 + ks), d1 = *(const LAS f32x4*)(DEC + tt * 64 + ks + 4);
            const f32x4 b0 = *(const LAS f32x4*)(BB + tt * 64 + ks), b1 = *(const LAS f32x4*)(BB + tt * 64 + ks + 4);
            const f32x4 h0 = *(const LAS f32x4*)(KH + tt * 64 + ks), h1 = *(const LAS f32x4*)(KH + tt * 64 + ks + 4);
            const f32x4 r0 = *(const LAS f32x4*)(R + tt * 64 + ks), r1 = *(const LAS f32x4*)(R + tt * 64 + ks + 4);
            const float vv = V[tt * 64 + row];
            float sa0 = 0.f, sa1 = 0.f;
#pragma unroll
            for (int j = 0; j < 4; ++j) { sa0 += S[j] * k0[j]; sa1 += S[4 + j] * k1[j]; }
            const float sa = -red8(sa0 + sa1);
            float y0 = 0.f, y1 = 0.f;
#pragma unroll
            for (int j = 0; j < 4; ++j) {
                S[j] = S[j] * d0[j] + sa * b0[j] + vv * h0[j]; S[4 + j] = S[4 + j] * d1[j] + sa * b1[j] + vv * h1[j];
                y0 += S[j] * r0[j]; y1 += S[4 + j] * r1[j];
            }
            const float y = red8(y0 + y1);
            if ((lane & 7) == 0) Y[tt * 64 + row] = y;
        }
        __syncthreads();
        if (more) rw_prep(BUF + ((ci + 1) & 1) * RW_BUF, t0 + CH, wave, lane, mu_r, mu_k, mu_v, kkc, kac, rkc, rc, kc, vc, rp, kp, vp, a, wl);
#pragma unroll
        for (int q = 0; q < 4; ++q) {
            const int tt = wave + 8 * q; const size_t m = (size_t)b * T + t0 + tt;
            const float y = Y[tt * 64 + lane]; const float mean = wave_sum(y) * (1.f / 64.f); const float d = y - mean; const float var = wave_sum(d * d) * (1.f / 64.f);
            float o = d * (1.f / sqrtf(var + GN_EPS)) * gng + gnb;
            o += BON[tt] * V[tt * 64 + lane];
            o *= bf2f(ggc[q]);
            MIX[m * D + col] = (bf16)f2bf(o);
        }
        __syncthreads();
    }
}

constexpr int GL_BUF = 3 * CH * 64 + CH * 128;
__device__ __forceinline__ void gl_load(const bf16* p, const bf16* GK, int b, int h, int t0, int lane, int wave, unsigned (&x)[4][4][4], unsigned (&gk)[4], unsigned (&g0)[4], unsigned (&g1)[4]) {
    const int cq = h * 64 + lane, ck = 256 + h * 64 + lane, cv0 = 512 + h * 128 + lane, cv1 = cv0 + 64;
#pragma unroll
    for (int q = 0; q < 4; ++q) {
        const int t = t0 + wave + 8 * q; const size_t m = (size_t)b * T + t;
#pragma unroll
        for (int j = 0; j < 4; ++j) { const int back = 3 - j; const bf16* pr = p + (m - (size_t)((t >= back) ? back : 0)) * NP + C_BQ;
            x[q][j][0] = pr[cq]; x[q][j][1] = pr[ck]; x[q][j][2] = pr[cv0]; x[q][j][3] = pr[cv1]; }
        gk[q] = GK[m * 256 + h * 64 + lane];
        g0[q] = p[m * NP + C_BG + h * 128 + lane]; g1[q] = p[m * NP + C_BG + h * 128 + 64 + lane];
    }
}
__device__ __forceinline__ void gl_prep(LAS float* B, int t0, int wave, int lane, const float (&wq)[4], const float (&wk)[4], const float (&wv0)[4], const float (&wv1)[4],
        const unsigned (&x)[4][4][4], const unsigned (&gk)[4]) {
    LAS float* Q = B; LAS float* K = Q + CH * 64; LAS float* DEC = K + CH * 64; LAS float* V = DEC + CH * 64;
#pragma unroll
    for (int q = 0; q < 4; ++q) {
        const int tt = wave + 8 * q, t = t0 + tt; float aq = 0.f, ak = 0.f, av0 = 0.f, av1 = 0.f;
#pragma unroll
        for (int j = 0; j < 4; ++j) { const float ok = (t >= 3 - j) ? 1.f : 0.f;
            aq += wq[j] * ok * bf2f(x[q][j][0]); ak += wk[j] * ok * bf2f(x[q][j][1]); av0 += wv0[j] * ok * bf2f(x[q][j][2]); av1 += wv1[j] * ok * bf2f(x[q][j][3]); }
        Q[tt * 64 + lane] = siluf_(aq) * 0.125f; K[tt * 64 + lane] = siluf_(ak); V[tt * 128 + lane] = siluf_(av0); V[tt * 128 + 64 + lane] = siluf_(av1);
        DEC[tt * 64 + lane] = __expf(bf2f(gk[q]));
    }
}
__device__ __forceinline__ void gla_item(const Params& P, LAS unsigned char* lds, int b, int h) {
    const int tid = threadIdx.x, lane = tid & 63, wave = tid >> 6;
    unsigned char* ws = P.ws;
    const bf16* p = (const bf16*)(ws + WS_P); const bf16* GK = (const bf16*)(ws + WS_GK);
    bf16* MIX = (bf16*)(ws + WS_MIX);
    const float* conv = P.in[15]; const float* norm_g = P.in[18];
    LAS float* BUF = (LAS float*)lds; LAS float* O = BUF + 2 * GL_BUF;
    const int cq = h * 64 + lane, ck = 256 + h * 64 + lane, cv0 = 512 + h * 128 + lane, cv1 = cv0 + 64;
    float wq[4], wk[4], wv0[4], wv1[4];
#pragma unroll
    for (int j = 0; j < 4; ++j) { wq[j] = conv[j * 1024 + cq]; wk[j] = conv[j * 1024 + ck]; wv0[j] = conv[j * 1024 + cv0]; wv1[j] = conv[j * 1024 + cv1]; }
    const float ng0 = norm_g[lane], ng1 = norm_g[lane + 64];
    float S[16];
#pragma unroll
    for (int j = 0; j < 16; ++j) S[j] = 0.f;
    const int row = wave * 16 + (lane >> 2), ks = (lane & 3) * 16;
    unsigned x[4][4][4], gk[4], g0[4], g1[4], g0c[4], g1c[4];
    __syncthreads();
    gl_load(p, GK, b, h, 0, lane, wave, x, gk, g0, g1);
    gl_prep(BUF, 0, wave, lane, wq, wk, wv0, wv1, x, gk);
    __syncthreads();
    for (int ci = 0; ci < T / CH; ++ci) {
        const int t0 = ci * CH; LAS float* B = BUF + (ci & 1) * GL_BUF;
        LAS float* Q = B; LAS float* K = Q + CH * 64; LAS float* DEC = K + CH * 64; LAS float* V = DEC + CH * 64;
#pragma unroll
        for (int q = 0; q < 4; ++q) { g0c[q] = g0[q]; g1c[q] = g1[q]; }
        const bool more = (ci + 1 < T / CH);
        if (more) gl_load(p, GK, b, h, t0 + CH, lane, wave, x, gk, g0, g1);
        for (int tt = 0; tt < CH; ++tt) {
            const float vv = V[tt * 128 + row]; float o0 = 0.f, o1 = 0.f;
#pragma unroll
            for (int q4 = 0; q4 < 4; ++q4) {
                const f32x4 kk = *(const LAS f32x4*)(K + tt * 64 + ks + 4 * q4), dd = *(const LAS f32x4*)(DEC + tt * 64 + ks + 4 * q4), qq = *(const LAS f32x4*)(Q + tt * 64 + ks + 4 * q4);
#pragma unroll
                for (int j = 0; j < 4; ++j) { S[4 * q4 + j] = S[4 * q4 + j] * dd[j] + vv * kk[j]; if (q4 & 1) o1 += S[4 * q4 + j] * qq[j]; else o0 += S[4 * q4 + j] * qq[j]; }
            }
            const float o = red4(o0 + o1);
            if ((lane & 3) == 0) O[tt * 128 + row] = o;
        }
        __syncthreads();
        if (more) gl_prep(BUF + ((ci + 1) & 1) * GL_BUF, t0 + CH, wave, lane, wq, wk, wv0, wv1, x, gk);
#pragma unroll
        for (int q = 0; q < 4; ++q) {
            const int tt = wave + 8 * q; const size_t m = (size_t)b * T + t0 + tt;
            const float o0 = O[tt * 128 + lane], o1 = O[tt * 128 + 64 + lane];
            const float ms = wave_sum(o0 * o0 + o1 * o1) * (1.f / 128.f); const float rs = 1.f / sqrtf(ms + RMS_EPS);
            MIX[m * D + 512 + h * 128 + lane] = (bf16)f2bf(o0 * rs * ng0 * siluf_(bf2f(g0c[q])));
            MIX[m * D + 512 + h * 128 + 64 + lane] = (bf16)f2bf(o1 * rs * ng1 * siluf_(bf2f(g1c[q])));
        }
        __syncthreads();
    }
}
__device__ __forceinline__ void phase_scan(const Params& P, LAS unsigned char* lds) {
    for (int it = blockIdx.x; it < 48; it += gridDim.x) {
        if (it < 32) rwkv_item(P, lds, it >> 3, it & 7); else gla_item(P, lds, (it - 32) >> 2, (it - 32) & 3);
        __syncthreads();
    }
}

__device__ __forceinline__ void phase_ln1(const Params& P) {
    const int lane = threadIdx.x & 63, wave = threadIdx.x >> 6; const int gw = blockIdx.x * NWAVES + wave, ngw = gridDim.x * NWAVES;
    for (int m = gw; m < M; m += ngw) ln_row_bf16((const float*)(P.ws + WS_Z) + (size_t)m * D, P.in[20], P.in[21], (bf16*)(P.ws + WS_H1) + (size_t)m * D, lane);
    const int gtid = blockIdx.x * NTHR + threadIdx.x, gthreads = gridDim.x * NTHR;
#pragma unroll
    for (int tb = 0; tb < 2; ++tb) {
        const f32x4* src = (const f32x4*)P.in[24 + tb]; u32x4* dst = (u32x4*)(P.ws + (tb ? WS_VT : WS_UT));
        for (int i = gtid; i < 16384 * D / 8; i += gthreads) { const f32x4 a = src[2 * i], b = src[2 * i + 1]; u32x4 o; o.x = pk2(a[0], a[1]); o.y = pk2(a[2], a[3]); o.z = pk2(b[0], b[1]); o.w = pk2(b[2], b[3]); dst[i] = o; }
    }
}

#define TK_INS(L, x) do { _Pragma("unroll") for (int _j = 0; _j < 16; ++_j) { const unsigned _h = max(L[_j], x); x = min(L[_j], x); L[_j] = _h; } } while (0)
__device__ __forceinline__ void topk128(const u32x4* r, unsigned (&L)[16]) {
#pragma unroll
    for (int j = 0; j < 16; ++j) L[j] = 0u;
    u32x4 cur = r[0];
    for (int c = 0; c < 16; ++c) {
        const u32x4 nxt = r[(c + 1) & 15];
        const unsigned kb = 0xFFFFu - 8u * (unsigned)c;
#pragma unroll
        for (int d = 0; d < 4; ++d) {
            unsigned w = cur[d]; const unsigned msk = ((w >> 15) & 0x00010001u) * 0xFFFFu; w ^= (msk | 0x80008000u);
            unsigned x0 = (w << 16) | (kb - 2u * d), x1 = (w & 0xFFFF0000u) | (kb - 2u * d - 1u);
            TK_INS(L, x0); TK_INS(L, x1);
        }
        cur = nxt;
    }
}
__device__ __forceinline__ void phase_topk(const Params& P) {
    const int gl = blockIdx.x * NTHR + threadIdx.x, nl = gridDim.x * NTHR;
    const bf16* Sc = (const bf16*)(P.ws + WS_S); int* IDS = (int*)(P.ws + WS_IDS); float* GATES = (float*)(P.ws + WS_GATES);
    for (int item = gl; item < M * 8; item += nl) {
        const u32x4* row = (const u32x4*)(Sc + (size_t)item * 256);
        unsigned L0[16], L1[16];
        topk128(row, L0); topk128(row + 16, L1);
        float f0[16], f1[16]; unsigned p0[16], p1[16];
#pragma unroll
        for (int i = 0; i < 16; ++i) {
            f0[i] = __uint_as_float((L0[i] & 0x80000000u) ? (L0[i] & 0x7FFF0000u) : (~L0[i] & 0xFFFF0000u)); p0[i] = (~L0[i] & 0x7Fu) << 7;
            f1[i] = __uint_as_float((L1[i] & 0x80000000u) ? (L1[i] & 0x7FFF0000u) : (~L1[i] & 0xFFFF0000u)); p1[i] = (~L1[i] & 0x7Fu);
        }
        unsigned C[16];
#pragma unroll
        for (int j = 0; j < 16; ++j) C[j] = 0u;
#pragma unroll
        for (int i = 0; i < 16; ++i)
#pragma unroll
            for (int j = 0; j < 16; ++j)
                if ((i + 1) * (j + 1) <= 16) {
                    const unsigned b = __float_as_uint(f0[i] + f1[j]); const unsigned mono = b ^ ((unsigned)((int)b >> 31) | 0x80000000u);
                    unsigned key = (mono & 0xFFFFC000u) | p0[i] | p1[j];
                    TK_INS(C, key);
                }
        float cv[16];
#pragma unroll
        for (int r = 0; r < 16; ++r) cv[r] = __uint_as_float((C[r] & 0x80000000u) ? (C[r] & 0x7FFFC000u) : (~C[r] & 0xFFFFC000u));
        const float cmax = cv[0]; float den = 0.f;
#pragma unroll
        for (int r = 0; r < 16; ++r) { cv[r] = __expf(cv[r] - cmax); den += cv[r]; }
        const float inv = 1.f / den;
        u32x4* ido = (u32x4*)(IDS + (size_t)item * 16); f32x4* go = (f32x4*)(GATES + (size_t)item * 16);
#pragma unroll
        for (int q = 0; q < 4; ++q) { u32x4 o; o.x = C[4 * q] & 0x3FFFu; o.y = C[4 * q + 1] & 0x3FFFu; o.z = C[4 * q + 2] & 0x3FFFu; o.w = C[4 * q + 3] & 0x3FFFu; ido[q] = o;
            f32x4 g; g[0] = cv[4 * q] * inv; g[1] = cv[4 * q + 1] * inv; g[2] = cv[4 * q + 2] * inv; g[3] = cv[4 * q + 3] * inv; go[q] = g; }
    }
}

typedef __bf16 bf16x2_t __attribute__((ext_vector_type(2)));
__device__ __forceinline__ float dot2bf(unsigned a, unsigned b, float c) { return __builtin_amdgcn_fdot2_f32_bf16(__builtin_bit_cast(bf16x2_t, a), __builtin_bit_cast(bf16x2_t, b), c, false); }
__device__ __forceinline__ void peer_load4(u32x4 (&buf)[4][2], const bf16* TAB, int idreg, int g, int lane) {
#pragma unroll
    for (int q = 0; q < 4; ++q) { const int id = __builtin_amdgcn_readlane(idreg, 4 * g + q); const u32x4* rp = (const u32x4*)(TAB + (size_t)id * D); buf[q][0] = rp[lane]; buf[q][1] = rp[64 + lane]; }
}
__device__ __forceinline__ void peer_dots4(const u32x4 (&buf)[4][2], const u32x4& hA, const u32x4& hB, int g, float& d, int lane) {
#pragma unroll
    for (int q = 0; q < 4; ++q) { float s = 0.f;
#pragma unroll
        for (int i = 0; i < 4; ++i) { s = dot2bf(buf[q][0][i], hA[i], s); s = dot2bf(buf[q][1][i], hB[i], s); }
        const float tot = wave_sum_u(s);
        d = (lane == 4 * g + q) ? tot : d; }
}
__device__ __forceinline__ void peer_axpy4(const u32x4 (&buf)[4][2], float actreg, int g, float (&acc)[16]) {
#pragma unroll
    for (int q = 0; q < 4; ++q) { const float a = rlf(actreg, 4 * g + q);
#pragma unroll
        for (int i = 0; i < 4; ++i) { const unsigned w0 = buf[q][0][i], w1 = buf[q][1][i];
            acc[2 * i] += a * __uint_as_float(w0 << 16); acc[2 * i + 1] += a * __uint_as_float(w0 & 0xffff0000u);
            acc[8 + 2 * i] += a * __uint_as_float(w1 << 16); acc[8 + 2 * i + 1] += a * __uint_as_float(w1 & 0xffff0000u); } }
}
__device__ __forceinline__ void phase_peer(const Params& P) {
    const int lane = threadIdx.x & 63, wave = threadIdx.x >> 6; const int gw = blockIdx.x * NWAVES + wave, ngw = gridDim.x * NWAVES;
    const bf16* H1 = (const bf16*)(P.ws + WS_H1); const int* IDS = (const int*)(P.ws + WS_IDS); const float* GATES = (const float*)(P.ws + WS_GATES);
    const bf16* UT = (const bf16*)(P.ws + WS_UT); const bf16* VT = (const bf16*)(P.ws + WS_VT); const float* g2 = P.in[26]; const float* b2 = P.in[27];
    for (int m = gw; m < M; m += ngw) {
        const u32x4* hp = (const u32x4*)(H1 + (size_t)m * D);
        const u32x4 hA = hp[lane], hB = hp[64 + lane];
        const int id_lo = IDS[(size_t)m * 128 + lane], id_hi = IDS[(size_t)m * 128 + 64 + lane];
        const float gt_lo = GATES[(size_t)m * 128 + lane], gt_hi = GATES[(size_t)m * 128 + 64 + lane];
        float d_lo = 0.f, d_hi = 0.f;
        u32x4 A0[4][2], A1[4][2];
        peer_load4(A0, UT, id_lo, 0, lane);
        for (int g = 0; g < 16; g += 2) {
            peer_load4(A1, UT, id_lo, g + 1, lane); peer_dots4(A0, hA, hB, g, d_lo, lane);
            if (g + 2 < 16) peer_load4(A0, UT, id_lo, g + 2, lane); else peer_load4(A0, UT, id_hi, 0, lane);
            peer_dots4(A1, hA, hB, g + 1, d_lo, lane);
        }
        for (int g = 0; g < 16; g += 2) {
            peer_load4(A1, UT, id_hi, g + 1, lane); peer_dots4(A0, hA, hB, g, d_hi, lane);
            if (g + 2 < 16) peer_load4(A0, UT, id_hi, g + 2, lane); else peer_load4(A0, VT, id_lo, 0, lane);
            peer_dots4(A1, hA, hB, g + 1, d_hi, lane);
        }
        const float act_lo = 0.5f * d_lo * (1.f + erff(d_lo * 0.70710678118f)) * gt_lo, act_hi = 0.5f * d_hi * (1.f + erff(d_hi * 0.70710678118f)) * gt_hi;
        float acc[16];
#pragma unroll
        for (int i = 0; i < 16; ++i) acc[i] = 0.f;
        for (int g = 0; g < 16; g += 2) {
            peer_load4(A1, VT, id_lo, g + 1, lane); peer_axpy4(A0, act_lo, g, acc);
            if (g + 2 < 16) peer_load4(A0, VT, id_lo, g + 2, lane); else peer_load4(A0, VT, id_hi, 0, lane);
            peer_axpy4(A1, act_lo, g + 1, acc);
        }
        for (int g = 0; g < 16; g += 2) {
            peer_load4(A1, VT, id_hi, g + 1, lane); peer_axpy4(A0, act_hi, g, acc);
            if (g + 2 < 16) peer_load4(A0, VT, id_hi, g + 2, lane);
            peer_axpy4(A1, act_hi, g + 1, acc);
        }
        float s = 0.f;
#pragma unroll
        for (int i = 0; i < 4; ++i) { acc[2 * i] += ALPHA * __uint_as_float(hA[i] << 16); acc[2 * i + 1] += ALPHA * __uint_as_float(hA[i] & 0xffff0000u);
            acc[8 + 2 * i] += ALPHA * __uint_as_float(hB[i] << 16); acc[8 + 2 * i + 1] += ALPHA * __uint_as_float(hB[i] & 0xffff0000u); }
#pragma unroll
        for (int i = 0; i < 16; ++i) s += acc[i];
        const float mean = wave_sum(s) * (1.f / D); float s2 = 0.f;
#pragma unroll
        for (int i = 0; i < 16; ++i) { acc[i] -= mean; s2 += acc[i] * acc[i]; }
        const float rstd = 1.f / sqrtf(wave_sum(s2) * (1.f / D) + LN_EPS);
#pragma unroll
        for (int hf = 0; hf < 2; ++hf)
#pragma unroll
            for (int c4 = 0; c4 < 2; ++c4) { const int e0 = hf * 512 + 8 * lane + 4 * c4; const f32x4 gg = *(const f32x4*)(g2 + e0), bb = *(const f32x4*)(b2 + e0); f32x4 o;
#pragma unroll
                for (int j = 0; j < 4; ++j) o[j] = acc[hf * 8 + c4 * 4 + j] * rstd * gg[j] + bb[j];
                *(f32x4*)(P.out + (size_t)m * D + e0) = o; }
    }
}

constexpr int N_PHASES = 10;
__global__ void __launch_bounds__(NTHR, 2) fwd_kernel(Params P) {
    extern __shared__ __attribute__((aligned(16))) unsigned char lds_raw[];
    LAS unsigned char* lds = (LAS unsigned char*)lds_raw;
    cg::grid_group grid = cg::this_grid();
    const int lo = P.ph_lo, hi = P.ph_hi;
    unsigned char* ws = P.ws;
#define IN(k) (lo <= (k) && (k) < hi)
#define SEAM(k) do { if (IN(k) && IN((k) + 1)) grid.sync(); } while (0)
    if (IN(0)) phase_prologue(P);
    SEAM(0);
    if (IN(1)) {
        pg8::Gemm g{(const bf16*)(ws + WS_H0), (const bf16*)(ws + WS_WIN), M, NP, D, D, D, 0}; pg8::StaticOrder S; S.init(M, NP, gridDim.x, blockIdx.x);
        pg8::EpiBf16 E{(bf16*)(ws + WS_P), NP};
        pg8::gemm_phase<pg8::EpiBf16, pg8::StaticOrder, true, true>(lds, g, S, E);
    }
    SEAM(1);
    if (IN(2)) phase_prep(P, lds);
    SEAM(2);
    if (IN(3)) phase_scan(P, lds);
    SEAM(3);
    if (IN(4)) {
        pg8::Gemm g{(const bf16*)(ws + WS_MIX), (const bf16*)(ws + WS_WOUT), M, D, D, D, D, 0}; pg8::StaticOrder S; S.init(M, D, gridDim.x, blockIdx.x);
        pg8::EpiResF32 E{(float*)(ws + WS_Z), (const bf16*)(ws + WS_H0), D, ALPHA};
        pg8::gemm_phase<pg8::EpiResF32, pg8::StaticOrder, true, true>(lds, g, S, E);
    }
    SEAM(4);
    if (IN(5)) phase_ln1(P);
    SEAM(5);
    if (IN(6)) {
        pg8::Gemm g{(const bf16*)(ws + WS_H1), (const bf16*)(ws + WS_WQ), M, NQ, D, D, D, 0}; pg8::StaticOrder S; S.init(M, NQ, gridDim.x, blockIdx.x);
        pg8::EpiBf16 E{(bf16*)(ws + WS_Q), NQ};
        pg8::gemm_phase<pg8::EpiBf16, pg8::StaticOrder, true, true>(lds, g, S, E);
    }
    SEAM(6);
    if (IN(7)) {
        pg8::Gemm g{(const bf16*)(ws + WS_Q), (const bf16*)(ws + WS_KBD), M, NQ, 256, NQ, 256, 256}; pg8::StaticOrder S; S.init(M, NQ, gridDim.x, blockIdx.x);
        pg8::EpiBf16 E{(bf16*)(ws + WS_S), NQ};
        pg8::gemm_phase<pg8::EpiBf16, pg8::StaticOrder, true, true>(lds, g, S, E);
    }
    SEAM(7);
    if (IN(8)) phase_topk(P);
    SEAM(8);
    if (IN(9)) phase_peer(P);
#undef IN
#undef SEAM
}

extern "C" void kernel_launch(void* const* d_in, const int* in_sizes, int n_in, void* d_out, int out_size, void* d_ws, size_t ws_size, hipStream_t stream) {
    static int grid = 0;
    if (grid == 0) {
        if (n_in != 28 || out_size != M * D || ws_size < WS_END) { fprintf(stderr, "kernel_launch: unexpected shapes (n_in %d out %d ws %zu)\n", n_in, out_size, ws_size); grid = -1; return; }
        int dev = 0, cus = 0, per_cu = 0;
        (void)hipGetDevice(&dev); (void)hipDeviceGetAttribute(&cus, hipDeviceAttributeMultiprocessorCount, dev);
        (void)hipFuncSetAttribute((const void*)fwd_kernel, hipFuncAttributeMaxDynamicSharedMemorySize, LDS_BYTES);
        (void)hipOccupancyMaxActiveBlocksPerMultiprocessor(&per_cu, (const void*)fwd_kernel, NTHR, LDS_BYTES);
        if (per_cu < 1) { fprintf(stderr, "kernel_launch: occupancy query says %d blocks per CU\n", per_cu); per_cu = 1; }
        (void)hipGetLastError();
        grid = cus;
    }
    if (grid < 0) return;
    Params p{};
    for (int i = 0; i < 28; ++i) p.in[i] = (const float*)d_in[i];
    p.out = (float*)d_out; p.ws = (unsigned char*)d_ws;
#if MK_ONE_LAUNCH
    p.ph_lo = 0; p.ph_hi = N_PHASES;
    void* args[] = {&p};
    hipError_t e = hipLaunchCooperativeKernel((const void*)fwd_kernel, dim3(grid), dim3(NTHR), args, LDS_BYTES, stream);
    if (e != hipSuccess) fprintf(stderr, "cooperative launch failed: %s (grid %d)\n", hipGetErrorString(e), grid);
#else
    for (int ph = 0; ph < N_PHASES; ++ph) {
        p.ph_lo = ph; p.ph_hi = ph + 1;
        hipLaunchKernelGGL(fwd_kernel, dim3(grid), dim3(NTHR), LDS_BYTES, stream, p);
    }
#endif
}
```

```cpp
#include <hip/hip_runtime.h>
#include <hip/hip_cooperative_groups.h>
#include <cstdio>
#include <cstdint>
namespace cg = cooperative_groups;

#ifndef MK_ONE_LAUNCH
#define MK_ONE_LAUNCH 1
#endif

namespace pg8 {
#define PG8_LAS __attribute__((address_space(3)))
typedef unsigned short bf16_t;
typedef short bf16x8 __attribute__((ext_vector_type(8)));
typedef float f32x4 __attribute__((ext_vector_type(4)));
typedef unsigned u32x4 __attribute__((ext_vector_type(4)));
typedef unsigned u32x2 __attribute__((ext_vector_type(2)));
constexpr int BM = 256, BK = 64, HALF = 128, HTB = HALF * BK * 2, STAGE_BYTES = 8 * HTB, NXCD = 8, WGM = 8;

__host__ __device__ __forceinline__ int lds_byte(int r, int c) { const int st = (r >> 4) * 2 + (c >> 5), rr = r & 15, cc = c & 31, ob = rr * 64 + cc * 2; return st * 1024 + (ob ^ (((ob >> 9) & 1) << 5)); }
__host__ __device__ __forceinline__ void stage_rc(int b, int& R, int& C) { const int st = b / 1024, sb = b % 1024, swz = sb ^ (((sb >> 9) & 1) << 5); R = (st >> 1) * 16 + swz / 64; C = (st & 1) * 32 + (swz % 64) / 2; }
__host__ __device__ __forceinline__ int perm32(int rho) { const int n = rho >> 4, i = rho & 15; return 8 * (i >> 2) + 4 * n + (i & 3); }

struct Unit { int pm, pn; };
struct Gemm { const bf16_t* A; const bf16_t* Bt; int M, N, K, lda, ldb, a_pn_koff; };

struct StaticOrder {
    int nM, nN, nwg, G, c;
    __host__ __device__ void init(int M, int N, int G_, int c_) { nM = M / BM; nN = N / BM; nwg = nM * nN; G = G_; c = c_; }
    __host__ __device__ bool next(int i, Unit& u) const {
        const long L = (long)i * G + c; if (L >= nwg) return false;
        int wgid = (int)L; { const int q = nwg / NXCD, r = nwg % NXCD, xcd = wgid % NXCD, off = wgid / NXCD; wgid = (xcd < r ? xcd * (q + 1) : r * (q + 1) + (xcd - r) * q) + off; }
        const int nig = WGM * nN, gid = wgid / nig, fm = gid * WGM, gsz = (nM - fm) < WGM ? (nM - fm) : WGM;
        u.pm = fm + ((wgid % nig) % gsz); u.pn = (wgid % nig) / gsz; return true;
    }
    __device__ __forceinline__ void a_ready(const Unit&) const {}
    __device__ __forceinline__ void done(const Unit&) const {}
};

__device__ __forceinline__ unsigned cvt_pk_bf16(float lo, float hi) { unsigned r; asm volatile("v_cvt_pk_bf16_f32 %0, %1, %2" : "=v"(r) : "v"(lo), "v"(hi)); return r; }

struct EpiBf16 {
    static constexpr bool PERM = true;
    bf16_t* O; int ldc;
    __device__ __forceinline__ void operator()(const f32x4 (&acc)[2][2][4][2], const Unit& u, int wr, int wc, int fr, int fq) const {
        const int row0 = u.pm * BM + wr * 64 + fr; const int col0 = u.pn * BM + wc * 32 + 8 * fq;
#pragma unroll
        for (int ai = 0; ai < 2; ++ai)
#pragma unroll
            for (int m = 0; m < 4; ++m) { bf16_t* rowp = O + (size_t)(row0 + ai * HALF + m * 16) * ldc + col0;
#pragma unroll
                for (int bj = 0; bj < 2; ++bj) { const f32x4 v0 = acc[ai][bj][m][0], v1 = acc[ai][bj][m][1];
                    u32x4 w; w.x = cvt_pk_bf16(v0[0], v0[1]); w.y = cvt_pk_bf16(v0[2], v0[3]); w.z = cvt_pk_bf16(v1[0], v1[1]); w.w = cvt_pk_bf16(v1[2], v1[3]);
                    *(u32x4*)(rowp + bj * HALF) = w; } }
    }
};
struct EpiResF32 {
    static constexpr bool PERM = false;
    float* Z; const bf16_t* R; int ldc; float alpha;
    __device__ __forceinline__ void operator()(const f32x4 (&acc)[2][2][4][2], const Unit& u, int wr, int wc, int fr, int fq) const {
        const int row0 = u.pm * BM + wr * 64 + fr; const int col0 = u.pn * BM + wc * 32 + 4 * fq;
#pragma unroll
        for (int ai = 0; ai < 2; ++ai)
#pragma unroll
            for (int m = 0; m < 4; ++m) { const size_t off = (size_t)(row0 + ai * HALF + m * 16) * ldc + col0;
#pragma unroll
                for (int bj = 0; bj < 2; ++bj)
#pragma unroll
                    for (int n = 0; n < 2; ++n) { const size_t o2 = off + bj * HALF + n * 16; const u32x2 rb = *(const u32x2*)(R + o2);
                        f32x4 h; h[0] = __uint_as_float(rb.x << 16); h[1] = __uint_as_float(rb.x & 0xffff0000u); h[2] = __uint_as_float(rb.y << 16); h[3] = __uint_as_float(rb.y & 0xffff0000u);
                        *(f32x4*)(Z + o2) = h * alpha + acc[ai][bj][m][n]; } }
    }
};

template <class Epi, class Sched, bool ALIGN_EPI = false, bool SP2 = false>
__device__ __forceinline__ void gemm_phase(PG8_LAS unsigned char* lds, const Gemm g, const Sched& S, const Epi& E) {
    const int tid = threadIdx.x, wid = __builtin_amdgcn_readfirstlane(tid >> 6), lane = tid & 63, wr = wid >> 2, wc = wid & 3, fr = lane & 15, fq = lane >> 4;
    const int K = g.K, nt = K / BK;
    unsigned voffA[2], voffB[2];
#pragma unroll
    for (int i = 0; i < 2; ++i) { int R, C; stage_rc(tid * 16 + i * 8192, R, C); const int Rb = Epi::PERM ? ((R & ~31) + perm32(R & 31)) : R;
        voffA[i] = (unsigned)(R * g.lda + C) * 2u; voffB[i] = (unsigned)(Rb * g.ldb + C) * 2u; }
    const size_t kstep = (size_t)(BK * 2);
    const size_t hstepA = (size_t)HALF * g.lda * 2, hstepB = (size_t)HALF * g.ldb * 2;
    const size_t tstepA = 2 * hstepA, tstepB = 2 * hstepB;
    const size_t pnA = (size_t)g.a_pn_koff * 2;
    const unsigned ldsw = (unsigned)wid * 1024u;
    const int aoff = lds_byte(wr * 64 + fr, fq * 8), boff = lds_byte(wc * 32 + fr, fq * 8);
#define PG8_SA(b, h) (((b) * 2 + (h)) * HTB)
#define PG8_SB(b, h) ((4 + (b) * 2 + (h)) * HTB)
#define PG8_STAGE(bufoff, gbase, voff) do { _Pragma("unroll") for (int _i = 0; _i < 2; ++_i) \
        __builtin_amdgcn_global_load_lds((const unsigned*)((const char*)(gbase) + (voff)[_i]), (PG8_LAS unsigned*)(lds + (bufoff) + ldsw + _i * 8192), 16, 0, 0); } while (0)
#define PG8_LDA(dst, b, h) do { _Pragma("unroll") for (int m = 0; m < 4; ++m) _Pragma("unroll") for (int k = 0; k < 2; ++k) dst[m][k] = *(const PG8_LAS bf16x8*)(lds + PG8_SA(b, h) + aoff + m * 2048 + k * 1024); } while (0)
#define PG8_LDB(dst, b, h) do { _Pragma("unroll") for (int n = 0; n < 2; ++n) _Pragma("unroll") for (int k = 0; k < 2; ++k) dst[n][k] = *(const PG8_LAS bf16x8*)(lds + PG8_SB(b, h) + boff + n * 2048 + k * 1024); } while (0)
#define PG8_MMA(ai, bj, At, Bt) do { __builtin_amdgcn_s_setprio(1); _Pragma("unroll") for (int m = 0; m < 4; ++m) _Pragma("unroll") for (int n = 0; n < 2; ++n) _Pragma("unroll") for (int k = 0; k < 2; ++k) \
        acc[ai][bj][m][n] = __builtin_amdgcn_mfma_f32_16x16x32_bf16(Bt[n][k], At[m][k], acc[ai][bj][m][n], 0, 0, 0); __builtin_amdgcn_s_setprio(0); } while (0)
#define PG8_WAIT_V(n) asm volatile("s_waitcnt vmcnt(" #n ")" ::: "memory")
#define PG8_WAIT_L(n) asm volatile("s_waitcnt lgkmcnt(" #n ")" ::: "memory")
#define PG8_BAR __builtin_amdgcn_s_barrier()
#define PG8_SCHED __builtin_amdgcn_sched_barrier(0)
    Unit cur, nxt; int ui = 0;
    if (!S.next(0, cur)) return;
    f32x4 acc[2][2][4][2];
#pragma unroll
    for (int a = 0; a < 2; ++a)
#pragma unroll
        for (int b = 0; b < 2; ++b)
#pragma unroll
            for (int m = 0; m < 4; ++m)
#pragma unroll
                for (int n = 0; n < 2; ++n) acc[a][b][m][n] = (f32x4){0.f, 0.f, 0.f, 0.f};
    bf16x8 At[4][2], B0[2][2], B1[2][2];
    const char* cA = (const char*)g.A + (size_t)cur.pm * tstepA + (size_t)cur.pn * pnA; const char* cB = (const char*)g.Bt + (size_t)cur.pn * tstepB;
    S.a_ready(cur);
    if constexpr (SP2) {
        PG8_STAGE(PG8_SB(0, 0), cB, voffB); PG8_STAGE(PG8_SB(0, 1), cB + hstepB, voffB); PG8_STAGE(PG8_SA(0, 0), cA, voffA); PG8_STAGE(PG8_SA(0, 1), cA + hstepA, voffA);
        if (wr == 1) PG8_BAR;
        PG8_WAIT_V(2); PG8_BAR;
        PG8_STAGE(PG8_SB(1, 0), cB + kstep, voffB); PG8_STAGE(PG8_SA(1, 0), cA + kstep, voffA); PG8_STAGE(PG8_SB(1, 1), cB + hstepB + kstep, voffB);
        PG8_WAIT_V(6); PG8_BAR;
    } else {
        PG8_STAGE(PG8_SB(0, 0), cB, voffB); PG8_STAGE(PG8_SA(0, 0), cA, voffA); PG8_STAGE(PG8_SB(0, 1), cB + hstepB, voffB); PG8_STAGE(PG8_SA(0, 1), cA + hstepA, voffA);
        if (wr == 1) PG8_BAR;
        PG8_WAIT_V(4); PG8_BAR;
        PG8_STAGE(PG8_SB(1, 0), cB + kstep, voffB); PG8_STAGE(PG8_SA(1, 0), cA + kstep, voffA); PG8_STAGE(PG8_SB(1, 1), cB + hstepB + kstep, voffB);
        PG8_WAIT_V(6); PG8_BAR;
    }
    for (;;) {
        const bool has_next = S.next(ui + 1, nxt);
        const char* nA = has_next ? (const char*)g.A + (size_t)nxt.pm * tstepA + (size_t)nxt.pn * pnA : cA; const char* nB = has_next ? (const char*)g.Bt + (size_t)nxt.pn * tstepB : cB;
        for (int t = 0; t < nt; t += 2) {
            const bool last = (t == nt - 2);
            const char* a1 = cA + (size_t)(t + 1) * kstep;
            const char* a2 = last ? nA : cA + (size_t)(t + 2) * kstep; const char* b2 = last ? nB : cB + (size_t)(t + 2) * kstep;
            const char* a3 = a2 + kstep; const char* b3 = b2 + kstep;
            if (last && has_next) S.a_ready(nxt);
            if constexpr (SP2) {
            PG8_LDB(B0, 0, 0); PG8_LDB(B1, 0, 1); PG8_SCHED; PG8_LDA(At, 0, 0); PG8_STAGE(PG8_SA(1, 1), a1 + hstepA, voffA);
            PG8_WAIT_V(8); PG8_WAIT_L(0); PG8_BAR; PG8_MMA(0, 0, At, B0); PG8_MMA(0, 1, At, B1); PG8_BAR; PG8_SCHED;
            PG8_LDA(At, 0, 1); PG8_STAGE(PG8_SB(0, 0), b2, voffB); PG8_STAGE(PG8_SB(0, 1), b2 + hstepB, voffB); PG8_STAGE(PG8_SA(0, 0), a2, voffA);
            PG8_WAIT_V(8); PG8_WAIT_L(0); PG8_BAR; PG8_MMA(1, 0, At, B0); PG8_MMA(1, 1, At, B1); PG8_BAR; PG8_SCHED;
            PG8_LDB(B0, 1, 0); PG8_LDB(B1, 1, 1); PG8_SCHED; PG8_LDA(At, 1, 0); PG8_STAGE(PG8_SA(0, 1), a2 + hstepA, voffA);
            PG8_WAIT_V(8); PG8_WAIT_L(0); PG8_BAR; PG8_MMA(0, 0, At, B0); PG8_MMA(0, 1, At, B1); PG8_BAR; PG8_SCHED;
            PG8_LDA(At, 1, 1); PG8_STAGE(PG8_SB(1, 0), b3, voffB); PG8_STAGE(PG8_SB(1, 1), b3 + hstepB, voffB); PG8_STAGE(PG8_SA(1, 0), a3, voffA);
            PG8_WAIT_V(8); PG8_WAIT_L(0); PG8_BAR; PG8_MMA(1, 0, At, B0); PG8_MMA(1, 1, At, B1); PG8_BAR; PG8_SCHED;
            } else {
            PG8_LDB(B0, 0, 0); PG8_SCHED; PG8_LDA(At, 0, 0); PG8_STAGE(PG8_SA(1, 1), a1 + hstepA, voffA);
            PG8_WAIT_L(8); PG8_BAR; PG8_WAIT_L(0); PG8_MMA(0, 0, At, B0); PG8_BAR; PG8_SCHED;
            PG8_LDB(B1, 0, 1); PG8_STAGE(PG8_SB(0, 0), b2, voffB);
            PG8_BAR; PG8_WAIT_L(0); PG8_MMA(0, 1, At, B1); PG8_BAR;
            PG8_LDA(At, 0, 1); PG8_STAGE(PG8_SA(0, 0), a2, voffA);
            PG8_BAR; PG8_WAIT_L(0); PG8_MMA(1, 0, At, B0); PG8_BAR; PG8_SCHED;
            PG8_STAGE(PG8_SB(0, 1), b2 + hstepB, voffB);
            PG8_WAIT_V(6); PG8_BAR; PG8_MMA(1, 1, At, B1); PG8_BAR;
            PG8_LDB(B0, 1, 0); PG8_SCHED; PG8_LDA(At, 1, 0); PG8_STAGE(PG8_SA(0, 1), a2 + hstepA, voffA);
            PG8_WAIT_L(8); PG8_BAR; PG8_WAIT_L(0); PG8_MMA(0, 0, At, B0); PG8_BAR; PG8_SCHED;
            PG8_LDB(B1, 1, 1); PG8_STAGE(PG8_SB(1, 0), b3, voffB);
            PG8_BAR; PG8_WAIT_L(0); PG8_MMA(0, 1, At, B1); PG8_BAR;
            PG8_LDA(At, 1, 1); PG8_STAGE(PG8_SA(1, 0), a3, voffA);
            PG8_BAR; PG8_WAIT_L(0); PG8_MMA(1, 0, At, B0); PG8_BAR; PG8_SCHED;
            PG8_STAGE(PG8_SB(1, 1), b3 + hstepB, voffB);
            PG8_WAIT_V(6); PG8_BAR; PG8_MMA(1, 1, At, B1); PG8_BAR;
            }
        }
        if constexpr (ALIGN_EPI) { if (wr == 0) PG8_BAR; }
        E(acc, cur, wr, wc, fr, fq); S.done(cur);
        if (!has_next) break;
#pragma unroll
        for (int a = 0; a < 2; ++a)
#pragma unroll
            for (int b = 0; b < 2; ++b)
#pragma unroll
                for (int m = 0; m < 4; ++m)
#pragma unroll
                    for (int n = 0; n < 2; ++n) acc[a][b][m][n] = (f32x4){0.f, 0.f, 0.f, 0.f};
        cur = nxt; cA = nA; cB = nB; ++ui;
        if constexpr (ALIGN_EPI) { if (wr == 1) PG8_BAR; }
    }
    PG8_WAIT_V(0);
    if constexpr (!ALIGN_EPI) { if (wr == 0) PG8_BAR; }
    PG8_BAR;
#undef PG8_SA
#undef PG8_SB
#undef PG8_STAGE
#undef PG8_LDA
#undef PG8_LDB
#undef PG8_MMA
#undef PG8_WAIT_V
#undef PG8_WAIT_L
#undef PG8_BAR
#undef PG8_SCHED
}
}

constexpr int NWAVES = 8, NTHR = NWAVES * 64;
constexpr int D = 1024, NBATCH = 4, T = 8192, M = NBATCH * T;
constexpr int A_W = 512, A_IN = 1792, IN_COLS = 3344, NP = 3584;
constexpr int C_R = 0, C_K = 512, C_V = 1024, C_WD = 1536, C_AD = 1600, C_GD = 1664;
constexpr int C_BQ = 1792, C_BK = 2048, C_BV = 2304, C_GKD = 2816, C_BG = 2832;
constexpr int NQ = 2048;
constexpr float LN_EPS = 1e-5f, GN_EPS = 64e-5f, RMS_EPS = 1e-5f;
constexpr float ALPHA = 1.189207115002721f;

typedef unsigned short bf16;
typedef float f32x4 __attribute__((ext_vector_type(4)));
typedef unsigned u32x4 __attribute__((ext_vector_type(4)));
typedef unsigned u32x2 __attribute__((ext_vector_type(2)));
#define LAS __attribute__((address_space(3)))

constexpr size_t MiB = 1u << 20;
constexpr size_t WS_WIN = 1 * MiB, WS_WOUT = 8 * MiB, WS_WQ = 10 * MiB, WS_KBD = 14 * MiB;
constexpr size_t WS_H0 = 16 * MiB;
constexpr size_t WS_P = 80 * MiB;
constexpr size_t WS_WL = 304 * MiB, WS_AA = 336 * MiB, WS_GG = 368 * MiB;
constexpr size_t WS_GK = 400 * MiB;
constexpr size_t WS_MIX = 416 * MiB;
constexpr size_t WS_Z = 80 * MiB;
constexpr size_t WS_H1 = 208 * MiB;
constexpr size_t WS_Q = 272 * MiB;
constexpr size_t WS_S = 80 * MiB;
constexpr size_t WS_IDS = 400 * MiB, WS_GATES = 416 * MiB;
constexpr size_t WS_UT = 432 * MiB, WS_VT = 464 * MiB;
constexpr int NSEG = 16, LSEG = 8192 / NSEG;
constexpr size_t WS_YI = WS_WL;
constexpr size_t WS_YIG = WS_GK;
constexpr size_t WS_SER = 480 * MiB;
constexpr size_t WS_SEG = 496 * MiB;
constexpr size_t WS_CEND = 504 * MiB;
constexpr size_t WS_END = 505 * MiB;

constexpr int LDS_BYTES = 147456;

struct Params {
    const float* in[28];
    float* out; unsigned char* ws;
    int ph_lo, ph_hi;
};

__device__ __forceinline__ float bf2f(unsigned u) { return __uint_as_float(u << 16); }
__device__ __forceinline__ unsigned f2bf(float f) { unsigned u = __float_as_uint(f); return (u + 0x7fffu + ((u >> 16) & 1u)) >> 16; }
__device__ __forceinline__ unsigned pk2(float lo, float hi) { return f2bf(lo) | (f2bf(hi) << 16); }
#define DPP_F(v, ctrl) __builtin_bit_cast(float, __builtin_amdgcn_update_dpp(0, __builtin_bit_cast(int, (v)), (ctrl), 0xf, 0xf, false))
#define DPP_ADD(v, ctrl) ((v) + DPP_F(v, ctrl))
__device__ __forceinline__ float rlf(float v, int l) { return __builtin_bit_cast(float, __builtin_amdgcn_readlane(__builtin_bit_cast(int, v), l)); }
__device__ __forceinline__ float wave_sum_u(float v) {
    v = DPP_ADD(v, 0xB1); v = DPP_ADD(v, 0x4E); v = DPP_ADD(v, 0x141); v = DPP_ADD(v, 0x140);
    return (rlf(v, 0) + rlf(v, 16)) + (rlf(v, 32) + rlf(v, 48));
}
__device__ __forceinline__ float wave_sum(float v) { return wave_sum_u(v); }
__device__ __forceinline__ float sigmoidf_(float x) { return 1.f / (1.f + __expf(-x)); }
__device__ __forceinline__ float softplusf_(float x) { return fmaxf(x, 0.f) + log1pf(__expf(-fabsf(x))); }
__device__ __forceinline__ float siluf_(float x) { return x * sigmoidf_(x); }

__device__ __forceinline__ void transpose_convert(const float* W, int K, int N, int Npad, bf16* WT, int gtid, int gthreads) {
    const int kc = K / 8, total = Npad * kc;
    for (int idx = gtid; idx < total; idx += gthreads) {
        const int n = idx % Npad, c = idx / Npad; float v[8];
#pragma unroll
        for (int j = 0; j < 8; ++j) v[j] = (n < N) ? W[(size_t)(8 * c + j) * N + n] : 0.f;
        u32x4 o; o.x = pk2(v[0], v[1]); o.y = pk2(v[2], v[3]); o.z = pk2(v[4], v[5]); o.w = pk2(v[6], v[7]);
        *(u32x4*)(WT + (size_t)n * K + 8 * c) = o;
    }
}
__device__ __forceinline__ void ln_row_bf16(const float* xrow, const float* g, const float* b, bf16* orow, int lane) {
    const f32x4* xr = (const f32x4*)xrow + lane; f32x4 v[4]; float s = 0.f;
#pragma unroll
    for (int j = 0; j < 4; ++j) { v[j] = xr[64 * j]; s += (v[j][0] + v[j][1]) + (v[j][2] + v[j][3]); }
    const float mean = wave_sum(s) * (1.f / D); float s2 = 0.f;
#pragma unroll
    for (int j = 0; j < 4; ++j) { v[j] = v[j] - mean; s2 += (v[j][0] * v[j][0] + v[j][1] * v[j][1]) + (v[j][2] * v[j][2] + v[j][3] * v[j][3]); }
    const float rstd = 1.f / sqrtf(wave_sum(s2) * (1.f / D) + LN_EPS);
    u32x2* o8 = (u32x2*)orow + lane;
#pragma unroll
    for (int j = 0; j < 4; ++j) { const f32x4 gg = ((const f32x4*)g)[lane + 64 * j], bb = ((const f32x4*)b)[lane + 64 * j]; const f32x4 y = v[j] * rstd * gg + bb;
        u32x2 w; w.x = pk2(y[0], y[1]); w.y = pk2(y[2], y[3]); o8[64 * j] = w; }
}
__device__ __forceinline__ void phase_prologue(const Params& P) {
    const int tid = threadIdx.x, lane = tid & 63, wave = tid >> 6;
    const int gtid = blockIdx.x * NTHR + tid, gthreads = gridDim.x * NTHR;
    unsigned char* ws = P.ws;
    transpose_convert(P.in[3], D, IN_COLS, NP, (bf16*)(ws + WS_WIN), gtid, gthreads);
    transpose_convert(P.in[19], D, D, D, (bf16*)(ws + WS_WOUT), gtid, gthreads);
    transpose_convert(P.in[22], D, NQ, NQ, (bf16*)(ws + WS_WQ), gtid, gthreads);
    {
        const float* keys = P.in[23]; bf16* kbd = (bf16*)(ws + WS_KBD);
        for (int idx = gtid; idx < 8 * 256 * 32; idx += gthreads) {
            const int kc = idx & 31, n = (idx >> 5) & 255, h = idx >> 13; const int k0 = kc * 8, hn = n >> 7, key = n & 127, hk = k0 >> 7, c0 = k0 & 127;
            u32x4 o = (u32x4){0u, 0u, 0u, 0u};
            if (hn == hk) { const float* s = keys + ((size_t)((h * 2 + hn) * 128 + key)) * 128 + c0; o.x = pk2(s[0], s[1]); o.y = pk2(s[2], s[3]); o.z = pk2(s[4], s[5]); o.w = pk2(s[6], s[7]); }
            *(u32x4*)(kbd + ((size_t)(h * 256 + n)) * 256 + k0) = o;
        }
    }
    const int gw = blockIdx.x * NWAVES + wave, ngw = gridDim.x * NWAVES;
    for (int m = gw; m < M; m += ngw) ln_row_bf16(P.in[0] + (size_t)m * D, P.in[1], P.in[2], (bf16*)(ws + WS_H0) + (size_t)m * D, lane);
}

__device__ __forceinline__ void phase_prep(const Params& P, LAS unsigned char* lds) {
    const int tid = threadIdx.x;
    unsigned char* ws = P.ws;
    const bf16* p = (const bf16*)(ws + WS_P);
    const float* mu = P.in[4]; const float* w0 = P.in[5]; const float* w2 = P.in[6]; const float* a0 = P.in[7]; const float* a2 = P.in[8]; const float* g2 = P.in[9];
    const float* gkw2 = P.in[16]; const float* gkb = P.in[17];
    bf16* WL = (bf16*)(ws + WS_WL); bf16* AA = (bf16*)(ws + WS_AA); bf16* GG = (bf16*)(ws + WS_GG); bf16* GK = (bf16*)(ws + WS_GK);
    LAS float* act = (LAS float*)lds;
    LAS float* gkd = (LAS float*)(lds + 64 * 260 * 4);
    constexpr int AS = 260;
    for (int tile = blockIdx.x; tile < M / 64; tile += gridDim.x) {
        const int m0 = tile * 64;
        __syncthreads();
        for (int idx = tid; idx < 64 * 256; idx += NTHR) {
            const int j = idx & 255, tok = idx >> 8, m = m0 + tok, t = m & (T - 1);
            const float cur = bf2f(p[(size_t)m * NP + C_WD + j]);
            const float prev = (t > 0) ? bf2f(p[(size_t)(m - 1) * NP + C_WD + j]) : 0.f;
            const float x = cur + (prev - cur) * mu[C_WD + j];
            float v;
            if (j < 64) v = tanhf(x); else if (j < 128) v = x; else v = sigmoidf_(x);
            act[tok * AS + j] = v;
        }
        for (int idx = tid; idx < 64 * 16; idx += NTHR) { const int j = idx & 15, tok = idx >> 4; gkd[tok * 16 + j] = bf2f(p[(size_t)(m0 + tok) * NP + C_GKD + j]); }
        __syncthreads();
        const int c = tid;
        float acc[64];
#pragma unroll
        for (int i = 0; i < 64; ++i) acc[i] = 0.f;
        for (int j = 0; j < 64; j += 4) {
            const float x0 = w2[(j + 0) * A_W + c], x1 = w2[(j + 1) * A_W + c], x2 = w2[(j + 2) * A_W + c], x3 = w2[(j + 3) * A_W + c];
#pragma unroll
            for (int i = 0; i < 64; ++i) { const f32x4 a = *(const LAS f32x4*)(act + i * AS + j); acc[i] += a[0] * x0 + a[1] * x1 + a[2] * x2 + a[3] * x3; }
        }
        { const float b0 = w0[c];
#pragma unroll
          for (int i = 0; i < 64; ++i) { const float z = b0 + acc[i]; const float w = -softplusf_(-z) - 0.5f; WL[(size_t)(m0 + i) * A_W + c] = (bf16)f2bf(-__expf(w)); } }
#pragma unroll
        for (int i = 0; i < 64; ++i) acc[i] = 0.f;
        for (int j = 0; j < 64; j += 4) {
            const float x0 = a2[(j + 0) * A_W + c], x1 = a2[(j + 1) * A_W + c], x2 = a2[(j + 2) * A_W + c], x3 = a2[(j + 3) * A_W + c];
#pragma unroll
            for (int i = 0; i < 64; ++i) { const f32x4 a = *(const LAS f32x4*)(act + i * AS + 64 + j); acc[i] += a[0] * x0 + a[1] * x1 + a[2] * x2 + a[3] * x3; }
        }
        { const float b0 = a0[c];
#pragma unroll
          for (int i = 0; i < 64; ++i) AA[(size_t)(m0 + i) * A_W + c] = (bf16)f2bf(sigmoidf_(b0 + acc[i])); }
#pragma unroll
        for (int i = 0; i < 64; ++i) acc[i] = 0.f;
        for (int j = 0; j < 128; j += 4) {
            const float x0 = g2[(j + 0) * A_W + c], x1 = g2[(j + 1) * A_W + c], x2 = g2[(j + 2) * A_W + c], x3 = g2[(j + 3) * A_W + c];
#pragma unroll
            for (int i = 0; i < 64; ++i) { const f32x4 a = *(const LAS f32x4*)(act + i * AS + 128 + j); acc[i] += a[0] * x0 + a[1] * x1 + a[2] * x2 + a[3] * x3; }
        }
#pragma unroll
        for (int i = 0; i < 64; ++i) GG[(size_t)(m0 + i) * A_W + c] = (bf16)f2bf(acc[i]);
        { const int cc = tid & 255, th = tid >> 8; float wv[16];
#pragma unroll
          for (int j = 0; j < 16; ++j) wv[j] = gkw2[j * 256 + cc];
          const float bb = gkb[cc];
          for (int i = 0; i < 32; ++i) { const int tok = th * 32 + i; float s = bb;
#pragma unroll
              for (int j = 0; j < 16; ++j) s += gkd[tok * 16 + j] * wv[j];
              GK[(size_t)(m0 + tok) * 256 + cc] = (bf16)f2bf(-softplusf_(-s) * (1.f / 16.f)); } }
    }
}

constexpr int CH = 32;
__device__ __forceinline__ float red8(float v) { v = DPP_ADD(v, 0xB1); v = DPP_ADD(v, 0x4E); v = DPP_ADD(v, 0x141); return v; }
__device__ __forceinline__ float red4(float v) { v = DPP_ADD(v, 0xB1); v = DPP_ADD(v, 0x4E); return v; }

constexpr int RW_BUF = 6 * CH * 64;
__device__ __forceinline__ void rw_load(const bf16* p, const bf16* AA, const bf16* WL, int b, int t0, int col, int wave,
        unsigned (&rc)[4], unsigned (&kc)[4], unsigned (&vc)[4], unsigned (&rp)[4], unsigned (&kp)[4], unsigned (&vp)[4], unsigned (&a)[4], unsigned (&wl)[4]) {
#pragma unroll
    for (int q = 0; q < 4; ++q) {
        const int t = t0 + wave + 8 * q; const size_t m = (size_t)b * T + t; const bf16* pr = p + m * NP; const bf16* pp = (t > 0) ? pr - NP : pr;
        rc[q] = pr[C_R + col]; kc[q] = pr[C_K + col]; vc[q] = pr[C_V + col]; rp[q] = pp[C_R + col]; kp[q] = pp[C_K + col]; vp[q] = pp[C_V + col];
        a[q] = AA[m * A_W + col]; wl[q] = WL[m * A_W + col];
    }
}
__device__ __forceinline__ void rw_prep(LAS float* B, int t0, int wave, int lane, float mu_r, float mu_k, float mu_v, float kkc, float kac,
        const unsigned (&rc_)[4], const unsigned (&kc_)[4], const unsigned (&vc_)[4], const unsigned (&rp_)[4], const unsigned (&kp_)[4], const unsigned (&vp_)[4], const unsigned (&a_)[4], const unsigned (&wl_)[4]) {
    LAS float* R = B; LAS float* DEC = R + CH * 64; LAS float* KH = DEC + CH * 64; LAS float* KK = KH + CH * 64; LAS float* BB = KK + CH * 64; LAS float* V = BB + CH * 64;
#pragma unroll
    for (int q = 0; q < 4; ++q) {
        const int tt = wave + 8 * q; const float hp = (t0 + tt > 0) ? 1.f : 0.f;
        const float rc = bf2f(rc_[q]), kc = bf2f(kc_[q]), vc = bf2f(vc_[q]), rp = bf2f(rp_[q]) * hp, kp = bf2f(kp_[q]) * hp, vp = bf2f(vp_[q]) * hp;
        const float r = rc + (rp - rc) * mu_r, k = kc + (kp - kc) * mu_k, v = vc + (vp - vc) * mu_v;
        const float a = bf2f(a_[q]), wl = bf2f(wl_[q]);
        const float kr = k * kkc; const float nrm = sqrtf(wave_sum(kr * kr)); const float kk = kr / fmaxf(nrm, 1e-12f);
        const float kh = k * (1.f + (a - 1.f) * kac);
        R[tt * 64 + lane] = r; DEC[tt * 64 + lane] = __expf(wl); KH[tt * 64 + lane] = kh; KK[tt * 64 + lane] = kk; BB[tt * 64 + lane] = kk * a; V[tt * 64 + lane] = v;
    }
}
__device__ __forceinline__ void rwkv_item(const Params& P, LAS unsigned char* lds, int b, int h, int seg) {
    const int tid = threadIdx.x, lane = tid & 63, wave = tid >> 6;
    unsigned char* ws = P.ws;
    const bf16* p = (const bf16*)(ws + WS_P); const bf16* WL = (const bf16*)(ws + WS_WL); const bf16* AA = (const bf16*)(ws + WS_AA);
    bf16* MIX = (bf16*)(ws + WS_MIX); bf16* YI = (bf16*)(ws + WS_YI);
    const float* mu = P.in[4]; const float* k_k = P.in[10]; const float* k_a = P.in[11];
    LAS float* BUF = (LAS float*)lds; LAS float* Y = BUF + 2 * RW_BUF;
    const int col = h * 64 + lane;
    const float mu_r = mu[C_R + col], mu_k = mu[C_K + col], mu_v = mu[C_V + col], kkc = k_k[col], kac = k_a[col];
    const int row = wave * 16 + (lane >> 2), ks = (lane & 3) * 16; const int ident = row >> 6, vrow = row & 63;
    float* SE = (float*)(ws + WS_SER) + ((((size_t)(b * 8 + h) * NSEG + seg) * 2 + ident) * 4096) + vrow * 64 + ks;
    float S[16];
#pragma unroll
    for (int j = 0; j < 16; ++j) S[j] = (ident && (ks + j == vrow)) ? 1.f : 0.f;
    const float vmask = ident ? 0.f : 1.f;
    const int tbeg = seg * LSEG;
    unsigned rc[4], kc[4], vc[4], rp[4], kp[4], vp[4], a[4], wl[4];
    __syncthreads();
    rw_load(p, AA, WL, b, tbeg, col, wave, rc, kc, vc, rp, kp, vp, a, wl);
    rw_prep(BUF, tbeg, wave, lane, mu_r, mu_k, mu_v, kkc, kac, rc, kc, vc, rp, kp, vp, a, wl);
    __syncthreads();
    for (int ci = 0; ci < LSEG / CH; ++ci) {
        const int t0 = tbeg + ci * CH; LAS float* B = BUF + (ci & 1) * RW_BUF;
        LAS float* R = B; LAS float* DEC = R + CH * 64; LAS float* KH = DEC + CH * 64; LAS float* KK = KH + CH * 64; LAS float* BB = KK + CH * 64; LAS float* V = BB + CH * 64;
        const bool more = (ci + 1 < LSEG / CH);
        if (more) rw_load(p, AA, WL, b, t0 + CH, col, wave, rc, kc, vc, rp, kp, vp, a, wl);
        for (int tt = 0; tt < CH; ++tt) {
            const float vv = V[tt * 64 + vrow] * vmask;
            float sa0 = 0.f, sa1 = 0.f;
#pragma unroll
            for (int q4 = 0; q4 < 4; ++q4) { const f32x4 kq = *(const LAS f32x4*)(KK + tt * 64 + ks + 4 * q4);
#pragma unroll
                for (int j = 0; j < 4; ++j) { if (q4 & 1) sa1 += S[4 * q4 + j] * kq[j]; else sa0 += S[4 * q4 + j] * kq[j]; } }
            const float sa = -red4(sa0 + sa1);
            float y0 = 0.f, y1 = 0.f;
#pragma unroll
            for (int q4 = 0; q4 < 4; ++q4) {
                const f32x4 dq = *(const LAS f32x4*)(DEC + tt * 64 + ks + 4 * q4), bq = *(const LAS f32x4*)(BB + tt * 64 + ks + 4 * q4), hq = *(const LAS f32x4*)(KH + tt * 64 + ks + 4 * q4), rq = *(const LAS f32x4*)(R + tt * 64 + ks + 4 * q4);
#pragma unroll
                for (int j = 0; j < 4; ++j) { S[4 * q4 + j] = S[4 * q4 + j] * dq[j] + sa * bq[j] + vv * hq[j]; if (q4 & 1) y1 += S[4 * q4 + j] * rq[j]; else y0 += S[4 * q4 + j] * rq[j]; }
            }
            const float y = red4(y0 + y1);
            if ((lane & 3) == 0) Y[tt * 128 + row] = y;
        }
        __syncthreads();
        if (more) rw_prep(BUF + ((ci + 1) & 1) * RW_BUF, t0 + CH, wave, lane, mu_r, mu_k, mu_v, kkc, kac, rc, kc, vc, rp, kp, vp, a, wl);
#pragma unroll
        for (int q = 0; q < 4; ++q) {
            const int tt = wave + 8 * q; const size_t m = (size_t)b * T + t0 + tt;
            MIX[m * D + col] = (bf16)f2bf(Y[tt * 128 + lane]); YI[m * 512 + col] = (bf16)f2bf(Y[tt * 128 + 64 + lane]);
        }
        __syncthreads();
    }
#pragma unroll
    for (int q4 = 0; q4 < 4; ++q4) *(f32x4*)(SE + 4 * q4) = (f32x4){S[4 * q4], S[4 * q4 + 1], S[4 * q4 + 2], S[4 * q4 + 3]};
}

constexpr int GL_BUF = 3 * CH * 64 + CH * 128;
__device__ __forceinline__ void gl_load(const bf16* p, const bf16* GK, int b, int h, int t0, int lane, int wave, unsigned (&x)[4][4][4], unsigned (&gk)[4]) {
    const int cq = h * 64 + lane, ck = 256 + h * 64 + lane, cv0 = 512 + h * 128 + lane, cv1 = cv0 + 64;
#pragma unroll
    for (int q = 0; q < 4; ++q) {
        const int t = t0 + wave + 8 * q; const size_t m = (size_t)b * T + t;
#pragma unroll
        for (int j = 0; j < 4; ++j) { const int back = 3 - j; const bf16* pr = p + (m - (size_t)((t >= back) ? back : 0)) * NP + C_BQ;
            x[q][j][0] = pr[cq]; x[q][j][1] = pr[ck]; x[q][j][2] = pr[cv0]; x[q][j][3] = pr[cv1]; }
        gk[q] = GK[m * 256 + h * 64 + lane];
    }
}
__device__ __forceinline__ void gl_prep(LAS float* B, int t0, int wave, int lane, const float (&wq)[4], const float (&wk)[4], const float (&wv0)[4], const float (&wv1)[4],
        const unsigned (&x)[4][4][4], const unsigned (&gk)[4]) {
    LAS float* Q = B; LAS float* K = Q + CH * 64; LAS float* DEC = K + CH * 64; LAS float* V = DEC + CH * 64;
#pragma unroll
    for (int q = 0; q < 4; ++q) {
        const int tt = wave + 8 * q, t = t0 + tt; float aq = 0.f, ak = 0.f, av0 = 0.f, av1 = 0.f;
#pragma unroll
        for (int j = 0; j < 4; ++j) { const float ok = (t >= 3 - j) ? 1.f : 0.f;
            aq += wq[j] * ok * bf2f(x[q][j][0]); ak += wk[j] * ok * bf2f(x[q][j][1]); av0 += wv0[j] * ok * bf2f(x[q][j][2]); av1 += wv1[j] * ok * bf2f(x[q][j][3]); }
        Q[tt * 64 + lane] = siluf_(aq) * 0.125f; K[tt * 64 + lane] = siluf_(ak); V[tt * 128 + lane] = siluf_(av0); V[tt * 128 + 64 + lane] = siluf_(av1);
        DEC[tt * 64 + lane] = __expf(bf2f(gk[q]));
    }
}
__device__ __forceinline__ void gla_item(const Params& P, LAS unsigned char* lds, int b, int h, int seg) {
    const int tid = threadIdx.x, lane = tid & 63, wave = tid >> 6;
    unsigned char* ws = P.ws;
    const bf16* p = (const bf16*)(ws + WS_P); const bf16* GK = (const bf16*)(ws + WS_GK);
    bf16* MIX = (bf16*)(ws + WS_MIX); bf16* YIG = (bf16*)(ws + WS_YIG);
    float* SE = (float*)(ws + WS_SEG) + ((size_t)(b * 4 + h) * NSEG + seg) * 8192; float* CE = (float*)(ws + WS_CEND) + ((size_t)(b * 4 + h) * NSEG + seg) * 64;
    const float* conv = P.in[15];
    LAS float* BUF = (LAS float*)lds; LAS float* O = BUF + 2 * GL_BUF; LAS float* YL = O + CH * 128;
    const int cq = h * 64 + lane, ck = 256 + h * 64 + lane, cv0 = 512 + h * 128 + lane, cv1 = cv0 + 64;
    float wq[4], wk[4], wv0[4], wv1[4];
#pragma unroll
    for (int j = 0; j < 4; ++j) { wq[j] = conv[j * 1024 + cq]; wk[j] = conv[j * 1024 + ck]; wv0[j] = conv[j * 1024 + cv0]; wv1[j] = conv[j * 1024 + cv1]; }
    float S[16], c[16];
#pragma unroll
    for (int j = 0; j < 16; ++j) { S[j] = 0.f; c[j] = 1.f; }
    const int row = wave * 16 + (lane >> 2), ks = (lane & 3) * 16;
    const int tbeg = seg * LSEG;
    unsigned x[4][4][4], gk[4];
    __syncthreads();
    gl_load(p, GK, b, h, tbeg, lane, wave, x, gk);
    gl_prep(BUF, tbeg, wave, lane, wq, wk, wv0, wv1, x, gk);
    __syncthreads();
    for (int ci = 0; ci < LSEG / CH; ++ci) {
        const int t0 = tbeg + ci * CH; LAS float* B = BUF + (ci & 1) * GL_BUF;
        LAS float* Q = B; LAS float* K = Q + CH * 64; LAS float* DEC = K + CH * 64; LAS float* V = DEC + CH * 64;
        const bool more = (ci + 1 < LSEG / CH);
        if (more) gl_load(p, GK, b, h, t0 + CH, lane, wave, x, gk);
        for (int tt = 0; tt < CH; ++tt) {
            const float vv = V[tt * 128 + row]; float o0 = 0.f, o1 = 0.f;
#pragma unroll
            for (int q4 = 0; q4 < 4; ++q4) {
                const f32x4 kk = *(const LAS f32x4*)(K + tt * 64 + ks + 4 * q4), dd = *(const LAS f32x4*)(DEC + tt * 64 + ks + 4 * q4), qq = *(const LAS f32x4*)(Q + tt * 64 + ks + 4 * q4);
#pragma unroll
                for (int j = 0; j < 4; ++j) { S[4 * q4 + j] = S[4 * q4 + j] * dd[j] + vv * kk[j]; if (q4 & 1) o1 += S[4 * q4 + j] * qq[j]; else o0 += S[4 * q4 + j] * qq[j]; }
                if (wave == 0) { f32x4 yi;
#pragma unroll
                    for (int j = 0; j < 4; ++j) { c[4 * q4 + j] *= dd[j]; yi[j] = c[4 * q4 + j] * qq[j]; }
                    if (lane < 4) *(LAS f32x4*)(YL + tt * 64 + ks + 4 * q4) = yi; }
            }
            const float o = red4(o0 + o1);
            if ((lane & 3) == 0) O[tt * 128 + row] = o;
        }
        __syncthreads();
        if (more) gl_prep(BUF + ((ci + 1) & 1) * GL_BUF, t0 + CH, wave, lane, wq, wk, wv0, wv1, x, gk);
#pragma unroll
        for (int q = 0; q < 4; ++q) {
            const int tt = wave + 8 * q; const size_t m = (size_t)b * T + t0 + tt;
            MIX[m * D + 512 + h * 128 + lane] = (bf16)f2bf(O[tt * 128 + lane]); MIX[m * D + 512 + h * 128 + 64 + lane] = (bf16)f2bf(O[tt * 128 + 64 + lane]);
            YIG[m * 256 + h * 64 + lane] = (bf16)f2bf(YL[tt * 64 + lane]);
        }
        __syncthreads();
    }
#pragma unroll
    for (int q4 = 0; q4 < 4; ++q4) *(f32x4*)(SE + row * 64 + ks + 4 * q4) = (f32x4){S[4 * q4], S[4 * q4 + 1], S[4 * q4 + 2], S[4 * q4 + 3]};
    if (wave == 0 && lane < 4) {
#pragma unroll
        for (int q4 = 0; q4 < 4; ++q4) *(f32x4*)(CE + ks + 4 * q4) = (f32x4){c[4 * q4], c[4 * q4 + 1], c[4 * q4 + 2], c[4 * q4 + 3]};
    }
}
__device__ __forceinline__ void phase_scan(const Params& P, LAS unsigned char* lds) {
    for (int it = blockIdx.x; it < 512 + 256; it += gridDim.x) {
        if (it < 512) { const int bh = it >> 4; rwkv_item(P, lds, bh >> 3, bh & 7, it & 15); }
        else { const int g = it - 512, bh = g >> 4; gla_item(P, lds, bh >> 2, bh & 3, g & 15); }
        __syncthreads();
    }
}
__device__ __forceinline__ void phase_fixup(const Params& P, LAS unsigned char* lds) {
    const int tid = threadIdx.x;
    for (int it = blockIdx.x; it < 48; it += gridDim.x) {
        if (it < 32) {
            float* SE = (float*)(P.ws + WS_SER) + (size_t)it * NSEG * 2 * 4096;
            LAS float* Sc = (LAS float*)lds; LAS float* Ph = Sc + 64 * 65;
            const int v = tid >> 3, kq = (tid & 7) * 8;
            __syncthreads();
            for (int i = tid; i < 64 * 65; i += NTHR) Sc[i] = 0.f;
            for (int seg = 0; seg < NSEG - 1; ++seg) {
                float* s0 = SE + (size_t)(seg * 2 + 0) * 4096; const float* ph = SE + (size_t)(seg * 2 + 1) * 4096;
                __syncthreads();
                for (int i = tid; i < 1024; i += NTHR) *(LAS f32x4*)(Ph + 4 * i) = *(const f32x4*)(ph + 4 * i);
                f32x4 a0 = *(const f32x4*)(s0 + v * 64 + kq), a1 = *(const f32x4*)(s0 + v * 64 + kq + 4);
                __syncthreads();
                for (int j = 0; j < 64; ++j) { const float sv = Sc[v * 65 + j]; a0 += *(const LAS f32x4*)(Ph + j * 64 + kq) * sv; a1 += *(const LAS f32x4*)(Ph + j * 64 + kq + 4) * sv; }
                __syncthreads();
#pragma unroll
                for (int i = 0; i < 4; ++i) { Sc[v * 65 + kq + i] = a0[i]; Sc[v * 65 + kq + 4 + i] = a1[i]; }
                *(f32x4*)(s0 + v * 64 + kq) = a0; *(f32x4*)(s0 + v * 64 + kq + 4) = a1;
            }
        } else {
            const int bh = it - 32; float* SE = (float*)(P.ws + WS_SEG) + (size_t)bh * NSEG * 8192; const float* CE = (const float*)(P.ws + WS_CEND) + (size_t)bh * NSEG * 64;
            const int v = tid >> 2, d0 = (tid & 3) * 16; f32x4 sc[4];
#pragma unroll
            for (int q = 0; q < 4; ++q) sc[q] = (f32x4){0.f, 0.f, 0.f, 0.f};
            for (int seg = 0; seg < NSEG - 1; ++seg) {
#pragma unroll
                for (int q = 0; q < 4; ++q) { float* sp = SE + (size_t)seg * 8192 + v * 64 + d0 + 4 * q; sc[q] = sc[q] * *(const f32x4*)(CE + seg * 64 + d0 + 4 * q) + *(const f32x4*)sp; *(f32x4*)sp = sc[q]; }
            }
        }
    }
}
__device__ __forceinline__ void phase_correct(const Params& P, LAS unsigned char* lds) {
    const int tid = threadIdx.x, lane = tid & 63, wave = tid >> 6;
    unsigned char* ws = P.ws;
    const bf16* p = (const bf16*)(ws + WS_P); const bf16* AA = (const bf16*)(ws + WS_AA); const bf16* GG = (const bf16*)(ws + WS_GG);
    bf16* MIX = (bf16*)(ws + WS_MIX); const bf16* YI = (const bf16*)(ws + WS_YI); const bf16* YIG = (const bf16*)(ws + WS_YIG);
    const float* mu = P.in[4]; const float* k_a = P.in[11]; const float* r_k = P.in[12]; const float* gn_g = P.in[13]; const float* gn_b = P.in[14]; const float* norm_g = P.in[18];
    LAS float* SL = (LAS float*)lds;
    for (int it = blockIdx.x; it < 512 + 256; it += gridDim.x) {
        __syncthreads();
        if (it < 512) {
            const int seg = it & 15, bh = it >> 4, b = bh >> 3, h = bh & 7;
            if (seg > 0) { const float* ss = (const float*)(ws + WS_SER) + (((size_t)bh * NSEG + (seg - 1)) * 2) * 4096;
                for (int i = tid; i < 4096; i += NTHR) SL[(i & 63) * 65 + (i >> 6)] = ss[i]; }
            __syncthreads();
            const int col = h * 64 + lane;
            const float mu_r = mu[C_R + col], mu_k = mu[C_K + col], mu_v = mu[C_V + col], kac = k_a[col], rkc = r_k[col], gng = gn_g[col], gnb = gn_b[col];
            for (int i0 = 0; i0 < 64; i0 += 4) {
                float y[4], yi[4], r[4], k[4], v[4], a[4], g[4];
#pragma unroll
                for (int u = 0; u < 4; ++u) {
                    const int t = seg * LSEG + wave * 64 + i0 + u; const size_t m = (size_t)b * T + t; const bf16* pr = p + m * NP; const bf16* pp = (t > 0) ? pr - NP : pr; const float hp = (t > 0) ? 1.f : 0.f;
                    y[u] = bf2f(MIX[m * D + col]); yi[u] = bf2f(YI[m * 512 + col]);
                    const float rc = bf2f(pr[C_R + col]), kc = bf2f(pr[C_K + col]), vc = bf2f(pr[C_V + col]);
                    r[u] = rc + (bf2f(pp[C_R + col]) * hp - rc) * mu_r; k[u] = kc + (bf2f(pp[C_K + col]) * hp - kc) * mu_k; v[u] = vc + (bf2f(pp[C_V + col]) * hp - vc) * mu_v;
                    a[u] = bf2f(AA[m * A_W + col]); g[u] = bf2f(GG[m * A_W + col]);
                }
                if (seg > 0) {
                    for (int j = 0; j < 64; ++j) { const float sv = SL[j * 65 + lane];
#pragma unroll
                        for (int u = 0; u < 4; ++u) y[u] += rlf(yi[u], j) * sv; }
                }
#pragma unroll
                for (int u = 0; u < 4; ++u) {
                    const size_t m = (size_t)b * T + seg * LSEG + wave * 64 + i0 + u;
                    const float kh = k[u] * (1.f + (a[u] - 1.f) * kac); const float bon = wave_sum(r[u] * kh * rkc);
                    const float mean = wave_sum(y[u]) * (1.f / 64.f); const float d = y[u] - mean; const float var = wave_sum(d * d) * (1.f / 64.f);
                    float o = d * (1.f / sqrtf(var + GN_EPS)) * gng + gnb; o += bon * v[u]; o *= g[u];
                    MIX[m * D + col] = (bf16)f2bf(o);
                }
            }
        } else {
            const int g_ = it - 512, seg = g_ & 15, bh = g_ >> 4, b = bh >> 2, h = bh & 3;
            if (seg > 0) { const float* ss = (const float*)(ws + WS_SEG) + ((size_t)bh * NSEG + (seg - 1)) * 8192;
                for (int i = tid; i < 8192; i += NTHR) SL[(i & 63) * 129 + (i >> 6)] = ss[i]; }
            __syncthreads();
            const float ng0 = norm_g[lane], ng1 = norm_g[lane + 64];
            for (int i0 = 0; i0 < 64; i0 += 4) {
                float o0[4], o1[4], yi[4], g0[4], g1[4];
#pragma unroll
                for (int u = 0; u < 4; ++u) {
                    const size_t m = (size_t)b * T + seg * LSEG + wave * 64 + i0 + u;
                    o0[u] = bf2f(MIX[m * D + 512 + h * 128 + lane]); o1[u] = bf2f(MIX[m * D + 512 + h * 128 + 64 + lane]); yi[u] = bf2f(YIG[m * 256 + h * 64 + lane]);
                    g0[u] = bf2f(p[m * NP + C_BG + h * 128 + lane]); g1[u] = bf2f(p[m * NP + C_BG + h * 128 + 64 + lane]);
                }
                if (seg > 0) {
                    for (int d = 0; d < 64; ++d) { const float s0 = SL[d * 129 + lane], s1 = SL[d * 129 + 64 + lane];
#pragma unroll
                        for (int u = 0; u < 4; ++u) { const float q = rlf(yi[u], d); o0[u] += q * s0; o1[u] += q * s1; } }
                }
#pragma unroll
                for (int u = 0; u < 4; ++u) {
                    const size_t m = (size_t)b * T + seg * LSEG + wave * 64 + i0 + u;
                    const float ms = wave_sum(o0[u] * o0[u] + o1[u] * o1[u]) * (1.f / 128.f); const float rs = 1.f / sqrtf(ms + RMS_EPS);
                    MIX[m * D + 512 + h * 128 + lane] = (bf16)f2bf(o0[u] * rs * ng0 * siluf_(g0[u])); MIX[m * D + 512 + h * 128 + 64 + lane] = (bf16)f2bf(o1[u] * rs * ng1 * siluf_(g1[u]));
                }
            }
        }
    }
}

__device__ __forceinline__ void phase_ln1(const Params& P) {
    const int lane = threadIdx.x & 63, wave = threadIdx.x >> 6; const int gw = blockIdx.x * NWAVES + wave, ngw = gridDim.x * NWAVES;
    for (int m = gw; m < M; m += ngw) ln_row_bf16((const float*)(P.ws + WS_Z) + (size_t)m * D, P.in[20], P.in[21], (bf16*)(P.ws + WS_H1) + (size_t)m * D, lane);
    const int gtid = blockIdx.x * NTHR + threadIdx.x, gthreads = gridDim.x * NTHR;
#pragma unroll
    for (int tb = 0; tb < 2; ++tb) {
        const f32x4* src = (const f32x4*)P.in[24 + tb]; u32x4* dst = (u32x4*)(P.ws + (tb ? WS_VT : WS_UT));
        for (int i = gtid; i < 16384 * D / 8; i += gthreads) { const f32x4 a = src[2 * i], b = src[2 * i + 1]; u32x4 o; o.x = pk2(a[0], a[1]); o.y = pk2(a[2], a[3]); o.z = pk2(b[0], b[1]); o.w = pk2(b[2], b[3]); dst[i] = o; }
    }
}

#define TK_INS(L, x) do { _Pragma("unroll") for (int _j = 0; _j < 16; ++_j) { const unsigned _h = max(L[_j], x); x = min(L[_j], x); L[_j] = _h; } } while (0)
__device__ __forceinline__ void topk128(const u32x4* r, unsigned (&L)[16]) {
#pragma unroll
    for (int j = 0; j < 16; ++j) L[j] = 0u;
    u32x4 cur = r[0];
    for (int c = 0; c < 16; ++c) {
        const u32x4 nxt = r[(c + 1) & 15];
        const unsigned kb = 0xFFFFu - 8u * (unsigned)c;
#pragma unroll
        for (int d = 0; d < 4; ++d) {
            unsigned w = cur[d]; const unsigned msk = ((w >> 15) & 0x00010001u) * 0xFFFFu; w ^= (msk | 0x80008000u);
            unsigned x0 = (w << 16) | (kb - 2u * d), x1 = (w & 0xFFFF0000u) | (kb - 2u * d - 1u);
            TK_INS(L, x0); TK_INS(L, x1);
        }
        cur = nxt;
    }
}
__device__ __forceinline__ void phase_topk(const Params& P) {
    const int gl = blockIdx.x * NTHR + threadIdx.x, nl = gridDim.x * NTHR;
    const bf16* Sc = (const bf16*)(P.ws + WS_S); int* IDS = (int*)(P.ws + WS_IDS); float* GATES = (float*)(P.ws + WS_GATES);
    for (int item = gl; item < M * 8; item += nl) {
        const u32x4* row = (const u32x4*)(Sc + (size_t)item * 256);
        unsigned L0[16], L1[16];
        topk128(row, L0); topk128(row + 16, L1);
        float f0[16], f1[16]; unsigned p0[16], p1[16];
#pragma unroll
        for (int i = 0; i < 16; ++i) {
            f0[i] = __uint_as_float((L0[i] & 0x80000000u) ? (L0[i] & 0x7FFF0000u) : (~L0[i] & 0xFFFF0000u)); p0[i] = (~L0[i] & 0x7Fu) << 7;
            f1[i] = __uint_as_float((L1[i] & 0x80000000u) ? (L1[i] & 0x7FFF0000u) : (~L1[i] & 0xFFFF0000u)); p1[i] = (~L1[i] & 0x7Fu);
        }
        unsigned C[16];
#pragma unroll
        for (int j = 0; j < 16; ++j) C[j] = 0u;
#pragma unroll
        for (int i = 0; i < 16; ++i)
#pragma unroll
            for (int j = 0; j < 16; ++j)
                if ((i + 1) * (j + 1) <= 16) {
                    const unsigned b = __float_as_uint(f0[i] + f1[j]); const unsigned mono = b ^ ((unsigned)((int)b >> 31) | 0x80000000u);
                    unsigned key = (mono & 0xFFFFC000u) | p0[i] | p1[j];
                    TK_INS(C, key);
                }
        float cv[16];
#pragma unroll
        for (int r = 0; r < 16; ++r) cv[r] = __uint_as_float((C[r] & 0x80000000u) ? (C[r] & 0x7FFFC000u) : (~C[r] & 0xFFFFC000u));
        const float cmax = cv[0]; float den = 0.f;
#pragma unroll
        for (int r = 0; r < 16; ++r) { cv[r] = __expf(cv[r] - cmax); den += cv[r]; }
        const float inv = 1.f / den;
        u32x4* ido = (u32x4*)(IDS + (size_t)item * 16); f32x4* go = (f32x4*)(GATES + (size_t)item * 16);
#pragma unroll
        for (int q = 0; q < 4; ++q) { u32x4 o; o.x = C[4 * q] & 0x3FFFu; o.y = C[4 * q + 1] & 0x3FFFu; o.z = C[4 * q + 2] & 0x3FFFu; o.w = C[4 * q + 3] & 0x3FFFu; ido[q] = o;
            f32x4 g; g[0] = cv[4 * q] * inv; g[1] = cv[4 * q + 1] * inv; g[2] = cv[4 * q + 2] * inv; g[3] = cv[4 * q + 3] * inv; go[q] = g; }
    }
}

typedef __bf16 bf16x2_t __attribute__((ext_vector_type(2)));
__device__ __forceinline__ float dot2bf(unsigned a, unsigned b, float c) { return __builtin_amdgcn_fdot2_f32_bf16(__builtin_bit_cast(bf16x2_t, a), __builtin_bit_cast(bf16x2_t, b), c, false); }
__device__ __forceinline__ void peer_load4(u32x4 (&buf)[4][2], const bf16* TAB, int idreg, int g, int lane) {
#pragma unroll
    for (int q = 0; q < 4; ++q) { const int id = __builtin_amdgcn_readlane(idreg, 4 * g + q); const u32x4* rp = (const u32x4*)(TAB + (size_t)id * D); buf[q][0] = rp[lane]; buf[q][1] = rp[64 + lane]; }
}
__device__ __forceinline__ void peer_dots4(const u32x4 (&buf)[4][2], const u32x4& hA, const u32x4& hB, int g, float& d, int lane) {
#pragma unroll
    for (int q = 0; q < 4; ++q) { float s = 0.f;
#pragma unroll
        for (int i = 0; i < 4; ++i) { s = dot2bf(buf[q][0][i], hA[i], s); s = dot2bf(buf[q][1][i], hB[i], s); }
        const float tot = wave_sum_u(s);
        d = (lane == 4 * g + q) ? tot : d; }
}
__device__ __forceinline__ void peer_axpy4(const u32x4 (&buf)[4][2], float actreg, int g, float (&acc)[16]) {
#pragma unroll
    for (int q = 0; q < 4; ++q) { const float a = rlf(actreg, 4 * g + q);
#pragma unroll
        for (int i = 0; i < 4; ++i) { const unsigned w0 = buf[q][0][i], w1 = buf[q][1][i];
            acc[2 * i] += a * __uint_as_float(w0 << 16); acc[2 * i + 1] += a * __uint_as_float(w0 & 0xffff0000u);
            acc[8 + 2 * i] += a * __uint_as_float(w1 << 16); acc[8 + 2 * i + 1] += a * __uint_as_float(w1 & 0xffff0000u); } }
}
__device__ __forceinline__ void phase_peer(const Params& P) {
    const int lane = threadIdx.x & 63, wave = threadIdx.x >> 6; const int gw = blockIdx.x * NWAVES + wave, ngw = gridDim.x * NWAVES;
    const bf16* H1 = (const bf16*)(P.ws + WS_H1); const int* IDS = (const int*)(P.ws + WS_IDS); const float* GATES = (const float*)(P.ws + WS_GATES);
    const bf16* UT = (const bf16*)(P.ws + WS_UT); const bf16* VT = (const bf16*)(P.ws + WS_VT); const float* g2 = P.in[26]; const float* b2 = P.in[27];
    for (int m = gw; m < M; m += ngw) {
        const u32x4* hp = (const u32x4*)(H1 + (size_t)m * D);
        const u32x4 hA = hp[lane], hB = hp[64 + lane];
        const int id_lo = IDS[(size_t)m * 128 + lane], id_hi = IDS[(size_t)m * 128 + 64 + lane];
        const float gt_lo = GATES[(size_t)m * 128 + lane], gt_hi = GATES[(size_t)m * 128 + 64 + lane];
        float d_lo = 0.f, d_hi = 0.f;
        u32x4 A0[4][2], A1[4][2];
        peer_load4(A0, UT, id_lo, 0, lane);
        for (int g = 0; g < 16; g += 2) {
            peer_load4(A1, UT, id_lo, g + 1, lane); peer_dots4(A0, hA, hB, g, d_lo, lane);
            if (g + 2 < 16) peer_load4(A0, UT, id_lo, g + 2, lane); else peer_load4(A0, UT, id_hi, 0, lane);
            peer_dots4(A1, hA, hB, g + 1, d_lo, lane);
        }
        for (int g = 0; g < 16; g += 2) {
            peer_load4(A1, UT, id_hi, g + 1, lane); peer_dots4(A0, hA, hB, g, d_hi, lane);
            if (g + 2 < 16) peer_load4(A0, UT, id_hi, g + 2, lane); else peer_load4(A0, VT, id_lo, 0, lane);
            peer_dots4(A1, hA, hB, g + 1, d_hi, lane);
        }
        const float act_lo = 0.5f * d_lo * (1.f + erff(d_lo * 0.70710678118f)) * gt_lo, act_hi = 0.5f * d_hi * (1.f + erff(d_hi * 0.70710678118f)) * gt_hi;
        float acc[16];
#pragma unroll
        for (int i = 0; i < 16; ++i) acc[i] = 0.f;
        for (int g = 0; g < 16; g += 2) {
            peer_load4(A1, VT, id_lo, g + 1, lane); peer_axpy4(A0, act_lo, g, acc);
            if (g + 2 < 16) peer_load4(A0, VT, id_lo, g + 2, lane); else peer_load4(A0, VT, id_hi, 0, lane);
            peer_axpy4(A1, act_lo, g + 1, acc);
        }
        for (int g = 0; g < 16; g += 2) {
            peer_load4(A1, VT, id_hi, g + 1, lane); peer_axpy4(A0, act_hi, g, acc);
            if (g + 2 < 16) peer_load4(A0, VT, id_hi, g + 2, lane);
            peer_axpy4(A1, act_hi, g + 1, acc);
        }
        float s = 0.f;
#pragma unroll
        for (int i = 0; i < 4; ++i) { acc[2 * i] += ALPHA * __uint_as_float(hA[i] << 16); acc[2 * i + 1] += ALPHA * __uint_as_float(hA[i] & 0xffff0000u);
            acc[8 + 2 * i] += ALPHA * __uint_as_float(hB[i] << 16); acc[8 + 2 * i + 1] += ALPHA * __uint_as_float(hB[i] & 0xffff0000u); }
#pragma unroll
        for (int i = 0; i < 16; ++i) s += acc[i];
        const float mean = wave_sum(s) * (1.f / D); float s2 = 0.f;
#pragma unroll
        for (int i = 0; i < 16; ++i) { acc[i] -= mean; s2 += acc[i] * acc[i]; }
        const float rstd = 1.f / sqrtf(wave_sum(s2) * (1.f / D) + LN_EPS);
#pragma unroll
        for (int hf = 0; hf < 2; ++hf)
#pragma unroll
            for (int c4 = 0; c4 < 2; ++c4) { const int e0 = hf * 512 + 8 * lane + 4 * c4; const f32x4 gg = *(const f32x4*)(g2 + e0), bb = *(const f32x4*)(b2 + e0); f32x4 o;
#pragma unroll
                for (int j = 0; j < 4; ++j) o[j] = acc[hf * 8 + c4 * 4 + j] * rstd * gg[j] + bb[j];
                *(f32x4*)(P.out + (size_t)m * D + e0) = o; }
    }
}

constexpr int N_PHASES = 12;
__global__ void __launch_bounds__(NTHR, 2) fwd_kernel(Params P) {
    extern __shared__ __attribute__((aligned(16))) unsigned char lds_raw[];
    LAS unsigned char* lds = (LAS unsigned char*)lds_raw;
    cg::grid_group grid = cg::this_grid();
    const int lo = P.ph_lo, hi = P.ph_hi;
    unsigned char* ws = P.ws;
#define IN(k) (lo <= (k) && (k) < hi)
#define SEAM(k) do { if (IN(k) && IN((k) + 1)) grid.sync(); } while (0)
    if (IN(0)) phase_prologue(P);
    SEAM(0);
    if (IN(1)) {
        pg8::Gemm g{(const bf16*)(ws + WS_H0), (const bf16*)(ws + WS_WIN), M, NP, D, D, D, 0}; pg8::StaticOrder S; S.init(M, NP, gridDim.x, blockIdx.x);
        pg8::EpiBf16 E{(bf16*)(ws + WS_P), NP};
        pg8::gemm_phase<pg8::EpiBf16, pg8::StaticOrder, true, true>(lds, g, S, E);
    }
    SEAM(1);
    if (IN(2)) phase_prep(P, lds);
    SEAM(2);
    if (IN(3)) phase_scan(P, lds);
    SEAM(3);
    if (IN(4)) phase_fixup(P, lds);
    SEAM(4);
    if (IN(5)) phase_correct(P, lds);
    SEAM(5);
    if (IN(6)) {
        pg8::Gemm g{(const bf16*)(ws + WS_MIX), (const bf16*)(ws + WS_WOUT), M, D, D, D, D, 0}; pg8::StaticOrder S; S.init(M, D, gridDim.x, blockIdx.x);
        pg8::EpiResF32 E{(float*)(ws + WS_Z), (const bf16*)(ws + WS_H0), D, ALPHA};
        pg8::gemm_phase<pg8::EpiResF32, pg8::StaticOrder, true, true>(lds, g, S, E);
    }
    SEAM(6);
    if (IN(7)) phase_ln1(P);
    SEAM(7);
    if (IN(8)) {
        pg8::Gemm g{(const bf16*)(ws + WS_H1), (const bf16*)(ws + WS_WQ), M, NQ, D, D, D, 0}; pg8::StaticOrder S; S.init(M, NQ, gridDim.x, blockIdx.x);
        pg8::EpiBf16 E{(bf16*)(ws + WS_Q), NQ};
        pg8::gemm_phase<pg8::EpiBf16, pg8::StaticOrder, true, true>(lds, g, S, E);
    }
    SEAM(8);
    if (IN(9)) {
        pg8::Gemm g{(const bf16*)(ws + WS_Q), (const bf16*)(ws + WS_KBD), M, NQ, 256, NQ, 256, 256}; pg8::StaticOrder S; S.init(M, NQ, gridDim.x, blockIdx.x);
        pg8::EpiBf16 E{(bf16*)(ws + WS_S), NQ};
        pg8::gemm_phase<pg8::EpiBf16, pg8::StaticOrder, true, true>(lds, g, S, E);
    }
    SEAM(9);
    if (IN(10)) phase_topk(P);
    SEAM(10);
    if (IN(11)) phase_peer(P);
#undef IN
#undef SEAM
}

extern "C" void kernel_launch(void* const* d_in, const int* in_sizes, int n_in, void* d_out, int out_size, void* d_ws, size_t ws_size, hipStream_t stream) {
    static int grid = 0;
    if (grid == 0) {
        if (n_in != 28 || out_size != M * D || ws_size < WS_END) { fprintf(stderr, "kernel_launch: unexpected shapes (n_in %d out %d ws %zu)\n", n_in, out_size, ws_size); grid = -1; return; }
        int dev = 0, cus = 0, per_cu = 0;
        (void)hipGetDevice(&dev); (void)hipDeviceGetAttribute(&cus, hipDeviceAttributeMultiprocessorCount, dev);
        (void)hipFuncSetAttribute((const void*)fwd_kernel, hipFuncAttributeMaxDynamicSharedMemorySize, LDS_BYTES);
        (void)hipOccupancyMaxActiveBlocksPerMultiprocessor(&per_cu, (const void*)fwd_kernel, NTHR, LDS_BYTES);
        if (per_cu < 1) { fprintf(stderr, "kernel_launch: occupancy query says %d blocks per CU\n", per_cu); per_cu = 1; }
        (void)hipGetLastError();
        grid = cus;
    }
    if (grid < 0) return;
    Params p{};
    for (int i = 0; i < 28; ++i) p.in[i] = (const float*)d_in[i];
    p.out = (float*)d_out; p.ws = (unsigned char*)d_ws;
#if MK_ONE_LAUNCH
    p.ph_lo = 0; p.ph_hi = N_PHASES;
    void* args[] = {&p};
    hipError_t e = hipLaunchCooperativeKernel((const void*)fwd_kernel, dim3(grid), dim3(NTHR), args, LDS_BYTES, stream);
    if (e != hipSuccess) fprintf(stderr, "cooperative launch failed: %s (grid %d)\n", hipGetErrorString(e), grid);
#else
    for (int ph = 0; ph < N_PHASES; ++ph) {
        p.ph_lo = ph; p.ph_hi = ph + 1;
        hipLaunchKernelGGL(fwd_kernel, dim3(grid), dim3(NTHR), LDS_BYTES, stream, p);
    }
#endif
}
```

```cpp
#include <hip/hip_runtime.h>
#include <hip/hip_cooperative_groups.h>
#include <cstdio>
#include <cstdint>
namespace cg = cooperative_groups;

#ifndef MK_ONE_LAUNCH
#define MK_ONE_LAUNCH 1
#endif

namespace pg8 {
#define PG8_LAS __attribute__((address_space(3)))
typedef unsigned short bf16_t;
typedef short bf16x8 __attribute__((ext_vector_type(8)));
typedef float f32x4 __attribute__((ext_vector_type(4)));
typedef unsigned u32x4 __attribute__((ext_vector_type(4)));
typedef unsigned u32x2 __attribute__((ext_vector_type(2)));
constexpr int BM = 256, BK = 64, HALF = 128, HTB = HALF * BK * 2, STAGE_BYTES = 8 * HTB, NXCD = 8, WGM = 8;

__host__ __device__ __forceinline__ int lds_byte(int r, int c) { const int st = (r >> 4) * 2 + (c >> 5), rr = r & 15, cc = c & 31, ob = rr * 64 + cc * 2; return st * 1024 + (ob ^ (((ob >> 9) & 1) << 5)); }
__host__ __device__ __forceinline__ void stage_rc(int b, int& R, int& C) { const int st = b / 1024, sb = b % 1024, swz = sb ^ (((sb >> 9) & 1) << 5); R = (st >> 1) * 16 + swz / 64; C = (st & 1) * 32 + (swz % 64) / 2; }
__host__ __device__ __forceinline__ int perm32(int rho) { const int n = rho >> 4, i = rho & 15; return 8 * (i >> 2) + 4 * n + (i & 3); }

struct Unit { int pm, pn; };
struct Gemm { const bf16_t* A; const bf16_t* Bt; int M, N, K, lda, ldb, a_pn_koff; };

struct StaticOrder {
    int nM, nN, nwg, G, c;
    __host__ __device__ void init(int M, int N, int G_, int c_) { nM = M / BM; nN = N / BM; nwg = nM * nN; G = G_; c = c_; }
    __host__ __device__ bool next(int i, Unit& u) const {
        const long L = (long)i * G + c; if (L >= nwg) return false;
        int wgid = (int)L; { const int q = nwg / NXCD, r = nwg % NXCD, xcd = wgid % NXCD, off = wgid / NXCD; wgid = (xcd < r ? xcd * (q + 1) : r * (q + 1) + (xcd - r) * q) + off; }
        const int nig = WGM * nN, gid = wgid / nig, fm = gid * WGM, gsz = (nM - fm) < WGM ? (nM - fm) : WGM;
        u.pm = fm + ((wgid % nig) % gsz); u.pn = (wgid % nig) / gsz; return true;
    }
    __device__ __forceinline__ void a_ready(const Unit&) const {}
    __device__ __forceinline__ void done(const Unit&) const {}
};

__device__ __forceinline__ unsigned cvt_pk_bf16(float lo, float hi) { unsigned r; asm volatile("v_cvt_pk_bf16_f32 %0, %1, %2" : "=v"(r) : "v"(lo), "v"(hi)); return r; }

struct EpiBf16 {
    static constexpr bool PERM = true;
    bf16_t* O; int ldc;
    __device__ __forceinline__ void operator()(const f32x4 (&acc)[2][2][4][2], const Unit& u, int wr, int wc, int fr, int fq) const {
        const int row0 = u.pm * BM + wr * 64 + fr; const int col0 = u.pn * BM + wc * 32 + 8 * fq;
#pragma unroll
        for (int ai = 0; ai < 2; ++ai)
#pragma unroll
            for (int m = 0; m < 4; ++m) { bf16_t* rowp = O + (size_t)(row0 + ai * HALF + m * 16) * ldc + col0;
#pragma unroll
                for (int bj = 0; bj < 2; ++bj) { const f32x4 v0 = acc[ai][bj][m][0], v1 = acc[ai][bj][m][1];
                    u32x4 w; w.x = cvt_pk_bf16(v0[0], v0[1]); w.y = cvt_pk_bf16(v0[2], v0[3]); w.z = cvt_pk_bf16(v1[0], v1[1]); w.w = cvt_pk_bf16(v1[2], v1[3]);
                    *(u32x4*)(rowp + bj * HALF) = w; } }
    }
};
struct EpiResF32 {
    static constexpr bool PERM = false;
    float* Z; const bf16_t* R; int ldc; float alpha;
    __device__ __forceinline__ void operator()(const f32x4 (&acc)[2][2][4][2], const Unit& u, int wr, int wc, int fr, int fq) const {
        const int row0 = u.pm * BM + wr * 64 + fr; const int col0 = u.pn * BM + wc * 32 + 4 * fq;
#pragma unroll
        for (int ai = 0; ai < 2; ++ai)
#pragma unroll
            for (int m = 0; m < 4; ++m) { const size_t off = (size_t)(row0 + ai * HALF + m * 16) * ldc + col0;
#pragma unroll
                for (int bj = 0; bj < 2; ++bj)
#pragma unroll
                    for (int n = 0; n < 2; ++n) { const size_t o2 = off + bj * HALF + n * 16; const u32x2 rb = *(const u32x2*)(R + o2);
                        f32x4 h; h[0] = __uint_as_float(rb.x << 16); h[1] = __uint_as_float(rb.x & 0xffff0000u); h[2] = __uint_as_float(rb.y << 16); h[3] = __uint_as_float(rb.y & 0xffff0000u);
                        *(f32x4*)(Z + o2) = h * alpha + acc[ai][bj][m][n]; } }
    }
};

template <class Epi, class Sched, bool ALIGN_EPI = false, bool SP2 = false>
__device__ __forceinline__ void gemm_phase(PG8_LAS unsigned char* lds, const Gemm g, const Sched& S, const Epi& E) {
    const int tid = threadIdx.x, wid = __builtin_amdgcn_readfirstlane(tid >> 6), lane = tid & 63, wr = wid >> 2, wc = wid & 3, fr = lane & 15, fq = lane >> 4;
    const int K = g.K, nt = K / BK;
    unsigned voffA[2], voffB[2];
#pragma unroll
    for (int i = 0; i < 2; ++i) { int R, C; stage_rc(tid * 16 + i * 8192, R, C); const int Rb = Epi::PERM ? ((R & ~31) + perm32(R & 31)) : R;
        voffA[i] = (unsigned)(R * g.lda + C) * 2u; voffB[i] = (unsigned)(Rb * g.ldb + C) * 2u; }
    const size_t kstep = (size_t)(BK * 2);
    const size_t hstepA = (size_t)HALF * g.lda * 2, hstepB = (size_t)HALF * g.ldb * 2;
    const size_t tstepA = 2 * hstepA, tstepB = 2 * hstepB;
    const size_t pnA = (size_t)g.a_pn_koff * 2;
    const unsigned ldsw = (unsigned)wid * 1024u;
    const int aoff = lds_byte(wr * 64 + fr, fq * 8), boff = lds_byte(wc * 32 + fr, fq * 8);
#define PG8_SA(b, h) (((b) * 2 + (h)) * HTB)
#define PG8_SB(b, h) ((4 + (b) * 2 + (h)) * HTB)
#define PG8_STAGE(bufoff, gbase, voff) do { _Pragma("unroll") for (int _i = 0; _i < 2; ++_i) \
        __builtin_amdgcn_global_load_lds((const unsigned*)((const char*)(gbase) + (voff)[_i]), (PG8_LAS unsigned*)(lds + (bufoff) + ldsw + _i * 8192), 16, 0, 0); } while (0)
#define PG8_LDA(dst, b, h) do { _Pragma("unroll") for (int m = 0; m < 4; ++m) _Pragma("unroll") for (int k = 0; k < 2; ++k) dst[m][k] = *(const PG8_LAS bf16x8*)(lds + PG8_SA(b, h) + aoff + m * 2048 + k * 1024); } while (0)
#define PG8_LDB(dst, b, h) do { _Pragma("unroll") for (int n = 0; n < 2; ++n) _Pragma("unroll") for (int k = 0; k < 2; ++k) dst[n][k] = *(const PG8_LAS bf16x8*)(lds + PG8_SB(b, h) + boff + n * 2048 + k * 1024); } while (0)
#define PG8_MMA(ai, bj, At, Bt) do { __builtin_amdgcn_s_setprio(1); _Pragma("unroll") for (int m = 0; m < 4; ++m) _Pragma("unroll") for (int n = 0; n < 2; ++n) _Pragma("unroll") for (int k = 0; k < 2; ++k) \
        acc[ai][bj][m][n] = __builtin_amdgcn_mfma_f32_16x16x32_bf16(Bt[n][k], At[m][k], acc[ai][bj][m][n], 0, 0, 0); __builtin_amdgcn_s_setprio(0); } while (0)
#define PG8_WAIT_V(n) asm volatile("s_waitcnt vmcnt(" #n ")" ::: "memory")
#define PG8_WAIT_L(n) asm volatile("s_waitcnt lgkmcnt(" #n ")" ::: "memory")
#define PG8_BAR __builtin_amdgcn_s_barrier()
#define PG8_SCHED __builtin_amdgcn_sched_barrier(0)
    Unit cur, nxt; int ui = 0;
    if (!S.next(0, cur)) return;
    f32x4 acc[2][2][4][2];
#pragma unroll
    for (int a = 0; a < 2; ++a)
#pragma unroll
        for (int b = 0; b < 2; ++b)
#pragma unroll
            for (int m = 0; m < 4; ++m)
#pragma unroll
                for (int n = 0; n < 2; ++n) acc[a][b][m][n] = (f32x4){0.f, 0.f, 0.f, 0.f};
    bf16x8 At[4][2], B0[2][2], B1[2][2];
    const char* cA = (const char*)g.A + (size_t)cur.pm * tstepA + (size_t)cur.pn * pnA; const char* cB = (const char*)g.Bt + (size_t)cur.pn * tstepB;
    S.a_ready(cur);
    if constexpr (SP2) {
        PG8_STAGE(PG8_SB(0, 0), cB, voffB); PG8_STAGE(PG8_SB(0, 1), cB + hstepB, voffB); PG8_STAGE(PG8_SA(0, 0), cA, voffA); PG8_STAGE(PG8_SA(0, 1), cA + hstepA, voffA);
        if (wr == 1) PG8_BAR;
        PG8_WAIT_V(2); PG8_BAR;
        PG8_STAGE(PG8_SB(1, 0), cB + kstep, voffB); PG8_STAGE(PG8_SA(1, 0), cA + kstep, voffA); PG8_STAGE(PG8_SB(1, 1), cB + hstepB + kstep, voffB);
        PG8_WAIT_V(6); PG8_BAR;
    } else {
        PG8_STAGE(PG8_SB(0, 0), cB, voffB); PG8_STAGE(PG8_SA(0, 0), cA, voffA); PG8_STAGE(PG8_SB(0, 1), cB + hstepB, voffB); PG8_STAGE(PG8_SA(0, 1), cA + hstepA, voffA);
        if (wr == 1) PG8_BAR;
        PG8_WAIT_V(4); PG8_BAR;
        PG8_STAGE(PG8_SB(1, 0), cB + kstep, voffB); PG8_STAGE(PG8_SA(1, 0), cA + kstep, voffA); PG8_STAGE(PG8_SB(1, 1), cB + hstepB + kstep, voffB);
        PG8_WAIT_V(6); PG8_BAR;
    }
    for (;;) {
        const bool has_next = S.next(ui + 1, nxt);
        const char* nA = has_next ? (const char*)g.A + (size_t)nxt.pm * tstepA + (size_t)nxt.pn * pnA : cA; const char* nB = has_next ? (const char*)g.Bt + (size_t)nxt.pn * tstepB : cB;
        for (int t = 0; t < nt; t += 2) {
            const bool last = (t == nt - 2);
            const char* a1 = cA + (size_t)(t + 1) * kstep;
            const char* a2 = last ? nA : cA + (size_t)(t + 2) * kstep; const char* b2 = last ? nB : cB + (size_t)(t + 2) * kstep;
            const char* a3 = a2 + kstep; const char* b3 = b2 + kstep;
            if (last && has_next) S.a_ready(nxt);
            if constexpr (SP2) {
            PG8_LDB(B0, 0, 0); PG8_LDB(B1, 0, 1); PG8_SCHED; PG8_LDA(At, 0, 0); PG8_STAGE(PG8_SA(1, 1), a1 + hstepA, voffA);
            PG8_WAIT_V(8); PG8_WAIT_L(0); PG8_BAR; PG8_MMA(0, 0, At, B0); PG8_MMA(0, 1, At, B1); PG8_BAR; PG8_SCHED;
            PG8_LDA(At, 0, 1); PG8_STAGE(PG8_SB(0, 0), b2, voffB); PG8_STAGE(PG8_SB(0, 1), b2 + hstepB, voffB); PG8_STAGE(PG8_SA(0, 0), a2, voffA);
            PG8_WAIT_V(8); PG8_WAIT_L(0); PG8_BAR; PG8_MMA(1, 0, At, B0); PG8_MMA(1, 1, At, B1); PG8_BAR; PG8_SCHED;
            PG8_LDB(B0, 1, 0); PG8_LDB(B1, 1, 1); PG8_SCHED; PG8_LDA(At, 1, 0); PG8_STAGE(PG8_SA(0, 1), a2 + hstepA, voffA);
            PG8_WAIT_V(8); PG8_WAIT_L(0); PG8_BAR; PG8_MMA(0, 0, At, B0); PG8_MMA(0, 1, At, B1); PG8_BAR; PG8_SCHED;
            PG8_LDA(At, 1, 1); PG8_STAGE(PG8_SB(1, 0), b3, voffB); PG8_STAGE(PG8_SB(1, 1), b3 + hstepB, voffB); PG8_STAGE(PG8_SA(1, 0), a3, voffA);
            PG8_WAIT_V(8); PG8_WAIT_L(0); PG8_BAR; PG8_MMA(1, 0, At, B0); PG8_MMA(1, 1, At, B1); PG8_BAR; PG8_SCHED;
            } else {
            PG8_LDB(B0, 0, 0); PG8_SCHED; PG8_LDA(At, 0, 0); PG8_STAGE(PG8_SA(1, 1), a1 + hstepA, voffA);
            PG8_WAIT_L(8); PG8_BAR; PG8_WAIT_L(0); PG8_MMA(0, 0, At, B0); PG8_BAR; PG8_SCHED;
            PG8_LDB(B1, 0, 1); PG8_STAGE(PG8_SB(0, 0), b2, voffB);
            PG8_BAR; PG8_WAIT_L(0); PG8_MMA(0, 1, At, B1); PG8_BAR;
            PG8_LDA(At, 0, 1); PG8_STAGE(PG8_SA(0, 0), a2, voffA);
            PG8_BAR; PG8_WAIT_L(0); PG8_MMA(1, 0, At, B0); PG8_BAR; PG8_SCHED;
            PG8_STAGE(PG8_SB(0, 1), b2 + hstepB, voffB);
            PG8_WAIT_V(6); PG8_BAR; PG8_MMA(1, 1, At, B1); PG8_BAR;
            PG8_LDB(B0, 1, 0); PG8_SCHED; PG8_LDA(At, 1, 0); PG8_STAGE(PG8_SA(0, 1), a2 + hstepA, voffA);
            PG8_WAIT_L(8); PG8_BAR; PG8_WAIT_L(0); PG8_MMA(0, 0, At, B0); PG8_BAR; PG8_SCHED;
            PG8_LDB(B1, 1, 1); PG8_STAGE(PG8_SB(1, 0), b3, voffB);
            PG8_BAR; PG8_WAIT_L(0); PG8_MMA(0, 1, At, B1); PG8_BAR;
            PG8_LDA(At, 1, 1); PG8_STAGE(PG8_SA(1, 0), a3, voffA);
            PG8_BAR; PG8_WAIT_L(0); PG8_MMA(1, 0, At, B0); PG8_BAR; PG8_SCHED;
            PG8_STAGE(PG8_SB(1, 1), b3 + hstepB, voffB);
            PG8_WAIT_V(6); PG8_BAR; PG8_MMA(1, 1, At, B1); PG8_BAR;
            }
        }
        if constexpr (ALIGN_EPI) { if (wr == 0) PG8_BAR; }
        E(acc, cur, wr, wc, fr, fq); S.done(cur);
        if (!has_next) break;
#pragma unroll
        for (int a = 0; a < 2; ++a)
#pragma unroll
            for (int b = 0; b < 2; ++b)
#pragma unroll
                for (int m = 0; m < 4; ++m)
#pragma unroll
                    for (int n = 0; n < 2; ++n) acc[a][b][m][n] = (f32x4){0.f, 0.f, 0.f, 0.f};
        cur = nxt; cA = nA; cB = nB; ++ui;
        if constexpr (ALIGN_EPI) { if (wr == 1) PG8_BAR; }
    }
    PG8_WAIT_V(0);
    if constexpr (!ALIGN_EPI) { if (wr == 0) PG8_BAR; }
    PG8_BAR;
#undef PG8_SA
#undef PG8_SB
#undef PG8_STAGE
#undef PG8_LDA
#undef PG8_LDB
#undef PG8_MMA
#undef PG8_WAIT_V
#undef PG8_WAIT_L
#undef PG8_BAR
#undef PG8_SCHED
}
}

constexpr int NWAVES = 8, NTHR = NWAVES * 64;
constexpr int D = 1024, NBATCH = 4, T = 8192, M = NBATCH * T;
constexpr int A_W = 512, A_IN = 1792, IN_COLS = 3344, NP = 3584;
constexpr int C_R = 0, C_K = 512, C_V = 1024, C_WD = 1536, C_AD = 1600, C_GD = 1664;
constexpr int C_BQ = 1792, C_BK = 2048, C_BV = 2304, C_GKD = 2816, C_BG = 2832;
constexpr int NQ = 2048;
constexpr float LN_EPS = 1e-5f, GN_EPS = 64e-5f, RMS_EPS = 1e-5f;
constexpr float ALPHA = 1.189207115002721f;

typedef unsigned short bf16;
typedef float f32x4 __attribute__((ext_vector_type(4)));
typedef unsigned u32x4 __attribute__((ext_vector_type(4)));
typedef unsigned u32x2 __attribute__((ext_vector_type(2)));
#define LAS __attribute__((address_space(3)))

constexpr size_t MiB = 1u << 20;
constexpr size_t WS_WIN = 1 * MiB, WS_WOUT = 8 * MiB, WS_WQ = 10 * MiB, WS_KBD = 14 * MiB;
constexpr size_t WS_H0 = 16 * MiB;
constexpr size_t WS_P = 80 * MiB;
constexpr size_t WS_WL = 304 * MiB, WS_AA = 336 * MiB, WS_GG = 368 * MiB;
constexpr size_t WS_GK = 400 * MiB;
constexpr size_t WS_MIX = 416 * MiB;
constexpr size_t WS_Z = 80 * MiB;
constexpr size_t WS_H1 = 208 * MiB;
constexpr size_t WS_Q = 272 * MiB;
constexpr size_t WS_S = 80 * MiB;
constexpr size_t WS_IDS = 400 * MiB, WS_GATES = 416 * MiB;
constexpr size_t WS_UT = 432 * MiB, WS_VT = 448 * MiB;
constexpr size_t WS_SU = 464 * MiB, WS_SV = 465 * MiB;
constexpr int NSEG = 16, LSEG = 8192 / NSEG;
constexpr size_t WS_YI = WS_WL;
constexpr size_t WS_YIG = WS_GK;
constexpr size_t WS_SER = 480 * MiB;
constexpr size_t WS_SEG = 496 * MiB;
constexpr size_t WS_CEND = 504 * MiB;
constexpr size_t WS_END = 505 * MiB;

constexpr int LDS_BYTES = 147456;

struct Params {
    const float* in[28];
    float* out; unsigned char* ws;
    int ph_lo, ph_hi;
};

__device__ __forceinline__ float bf2f(unsigned u) { return __uint_as_float(u << 16); }
__device__ __forceinline__ unsigned f2bf(float f) { unsigned u = __float_as_uint(f); return (u + 0x7fffu + ((u >> 16) & 1u)) >> 16; }
__device__ __forceinline__ unsigned pk2(float lo, float hi) { return f2bf(lo) | (f2bf(hi) << 16); }
#define DPP_F(v, ctrl) __builtin_bit_cast(float, __builtin_amdgcn_update_dpp(0, __builtin_bit_cast(int, (v)), (ctrl), 0xf, 0xf, false))
#define DPP_ADD(v, ctrl) ((v) + DPP_F(v, ctrl))
__device__ __forceinline__ float rlf(float v, int l) { return __builtin_bit_cast(float, __builtin_amdgcn_readlane(__builtin_bit_cast(int, v), l)); }
__device__ __forceinline__ float wave_sum_u(float v) {
    v = DPP_ADD(v, 0xB1); v = DPP_ADD(v, 0x4E); v = DPP_ADD(v, 0x141); v = DPP_ADD(v, 0x140);
    return (rlf(v, 0) + rlf(v, 16)) + (rlf(v, 32) + rlf(v, 48));
}
__device__ __forceinline__ float wave_sum(float v) { return wave_sum_u(v); }
#define DPP_I(v, ctrl) __builtin_amdgcn_update_dpp(0, (v), (ctrl), 0xf, 0xf, false)
__device__ __forceinline__ int wave_sum_i(int v) {
    v += DPP_I(v, 0xB1); v += DPP_I(v, 0x4E); v += DPP_I(v, 0x141); v += DPP_I(v, 0x140);
    return (__builtin_amdgcn_readlane(v, 0) + __builtin_amdgcn_readlane(v, 16)) + (__builtin_amdgcn_readlane(v, 32) + __builtin_amdgcn_readlane(v, 48));
}
__device__ __forceinline__ float wave_max_u(float v) {
    v = fmaxf(v, DPP_F(v, 0xB1)); v = fmaxf(v, DPP_F(v, 0x4E)); v = fmaxf(v, DPP_F(v, 0x141)); v = fmaxf(v, DPP_F(v, 0x140));
    return fmaxf(fmaxf(rlf(v, 0), rlf(v, 16)), fmaxf(rlf(v, 32), rlf(v, 48)));
}
__device__ __forceinline__ unsigned pack_i8(float a, float b, float c, float d, float inv, int off) {
    const int q0 = __float2int_rn(a * inv) + off, q1 = __float2int_rn(b * inv) + off, q2 = __float2int_rn(c * inv) + off, q3 = __float2int_rn(d * inv) + off;
    return (unsigned)(q0 & 0xff) | ((unsigned)(q1 & 0xff) << 8) | ((unsigned)(q2 & 0xff) << 16) | ((unsigned)(q3 & 0xff) << 24);
}
__device__ __forceinline__ float sigmoidf_(float x) { return 1.f / (1.f + __expf(-x)); }
__device__ __forceinline__ float softplusf_(float x) { return fmaxf(x, 0.f) + log1pf(__expf(-fabsf(x))); }
__device__ __forceinline__ float siluf_(float x) { return x * sigmoidf_(x); }

__device__ __forceinline__ void transpose_convert(const float* W, int K, int N, int Npad, bf16* WT, int gtid, int gthreads) {
    const int kc = K / 8, total = Npad * kc;
    for (int idx = gtid; idx < total; idx += gthreads) {
        const int n = idx % Npad, c = idx / Npad; float v[8];
#pragma unroll
        for (int j = 0; j < 8; ++j) v[j] = (n < N) ? W[(size_t)(8 * c + j) * N + n] : 0.f;
        u32x4 o; o.x = pk2(v[0], v[1]); o.y = pk2(v[2], v[3]); o.z = pk2(v[4], v[5]); o.w = pk2(v[6], v[7]);
        *(u32x4*)(WT + (size_t)n * K + 8 * c) = o;
    }
}
__device__ __forceinline__ void ln_row_bf16(const float* xrow, const float* g, const float* b, bf16* orow, int lane) {
    const f32x4* xr = (const f32x4*)xrow + lane; f32x4 v[4]; float s = 0.f;
#pragma unroll
    for (int j = 0; j < 4; ++j) { v[j] = xr[64 * j]; s += (v[j][0] + v[j][1]) + (v[j][2] + v[j][3]); }
    const float mean = wave_sum(s) * (1.f / D); float s2 = 0.f;
#pragma unroll
    for (int j = 0; j < 4; ++j) { v[j] = v[j] - mean; s2 += (v[j][0] * v[j][0] + v[j][1] * v[j][1]) + (v[j][2] * v[j][2] + v[j][3] * v[j][3]); }
    const float rstd = 1.f / sqrtf(wave_sum(s2) * (1.f / D) + LN_EPS);
    u32x2* o8 = (u32x2*)orow + lane;
#pragma unroll
    for (int j = 0; j < 4; ++j) { const f32x4 gg = ((const f32x4*)g)[lane + 64 * j], bb = ((const f32x4*)b)[lane + 64 * j]; const f32x4 y = v[j] * rstd * gg + bb;
        u32x2 w; w.x = pk2(y[0], y[1]); w.y = pk2(y[2], y[3]); o8[64 * j] = w; }
}
__device__ __forceinline__ void phase_prologue(const Params& P) {
    const int tid = threadIdx.x, lane = tid & 63, wave = tid >> 6;
    const int gtid = blockIdx.x * NTHR + tid, gthreads = gridDim.x * NTHR;
    unsigned char* ws = P.ws;
    transpose_convert(P.in[3], D, IN_COLS, NP, (bf16*)(ws + WS_WIN), gtid, gthreads);
    transpose_convert(P.in[19], D, D, D, (bf16*)(ws + WS_WOUT), gtid, gthreads);
    transpose_convert(P.in[22], D, NQ, NQ, (bf16*)(ws + WS_WQ), gtid, gthreads);
    {
        const float* keys = P.in[23]; bf16* kbd = (bf16*)(ws + WS_KBD);
        for (int idx = gtid; idx < 8 * 256 * 32; idx += gthreads) {
            const int kc = idx & 31, n = (idx >> 5) & 255, h = idx >> 13; const int k0 = kc * 8, hn = n >> 7, key = n & 127, hk = k0 >> 7, c0 = k0 & 127;
            u32x4 o = (u32x4){0u, 0u, 0u, 0u};
            if (hn == hk) { const float* s = keys + ((size_t)((h * 2 + hn) * 128 + key)) * 128 + c0; o.x = pk2(s[0], s[1]); o.y = pk2(s[2], s[3]); o.z = pk2(s[4], s[5]); o.w = pk2(s[6], s[7]); }
            *(u32x4*)(kbd + ((size_t)(h * 256 + n)) * 256 + k0) = o;
        }
    }
    const int gw = blockIdx.x * NWAVES + wave, ngw = gridDim.x * NWAVES;
    for (int m = gw; m < M; m += ngw) ln_row_bf16(P.in[0] + (size_t)m * D, P.in[1], P.in[2], (bf16*)(ws + WS_H0) + (size_t)m * D, lane);
}

__device__ __forceinline__ void phase_prep(const Params& P, LAS unsigned char* lds) {
    const int tid = threadIdx.x;
    unsigned char* ws = P.ws;
    const bf16* p = (const bf16*)(ws + WS_P);
    const float* mu = P.in[4]; const float* w0 = P.in[5]; const float* w2 = P.in[6]; const float* a0 = P.in[7]; const float* a2 = P.in[8]; const float* g2 = P.in[9];
    const float* gkw2 = P.in[16]; const float* gkb = P.in[17];
    bf16* WL = (bf16*)(ws + WS_WL); bf16* AA = (bf16*)(ws + WS_AA); bf16* GG = (bf16*)(ws + WS_GG); bf16* GK = (bf16*)(ws + WS_GK);
    LAS float* act = (LAS float*)lds;
    LAS float* gkd = (LAS float*)(lds + 64 * 260 * 4);
    constexpr int AS = 260;
    for (int tile = blockIdx.x; tile < M / 64; tile += gridDim.x) {
        const int m0 = tile * 64;
        __syncthreads();
        for (int idx = tid; idx < 64 * 256; idx += NTHR) {
            const int j = idx & 255, tok = idx >> 8, m = m0 + tok, t = m & (T - 1);
            const float cur = bf2f(p[(size_t)m * NP + C_WD + j]);
            const float prev = (t > 0) ? bf2f(p[(size_t)(m - 1) * NP + C_WD + j]) : 0.f;
            const float x = cur + (prev - cur) * mu[C_WD + j];
            float v;
            if (j < 64) v = tanhf(x); else if (j < 128) v = x; else v = sigmoidf_(x);
            act[tok * AS + j] = v;
        }
        for (int idx = tid; idx < 64 * 16; idx += NTHR) { const int j = idx & 15, tok = idx >> 4; gkd[tok * 16 + j] = bf2f(p[(size_t)(m0 + tok) * NP + C_GKD + j]); }
        __syncthreads();
        const int c = tid;
        float acc[64];
#pragma unroll
        for (int i = 0; i < 64; ++i) acc[i] = 0.f;
        for (int j = 0; j < 64; j += 4) {
            const float x0 = w2[(j + 0) * A_W + c], x1 = w2[(j + 1) * A_W + c], x2 = w2[(j + 2) * A_W + c], x3 = w2[(j + 3) * A_W + c];
#pragma unroll
            for (int i = 0; i < 64; ++i) { const f32x4 a = *(const LAS f32x4*)(act + i * AS + j); acc[i] += a[0] * x0 + a[1] * x1 + a[2] * x2 + a[3] * x3; }
        }
        { const float b0 = w0[c];
#pragma unroll
          for (int i = 0; i < 64; ++i) { const float z = b0 + acc[i]; const float w = -softplusf_(-z) - 0.5f; WL[(size_t)(m0 + i) * A_W + c] = (bf16)f2bf(-__expf(w)); } }
#pragma unroll
        for (int i = 0; i < 64; ++i) acc[i] = 0.f;
        for (int j = 0; j < 64; j += 4) {
            const float x0 = a2[(j + 0) * A_W + c], x1 = a2[(j + 1) * A_W + c], x2 = a2[(j + 2) * A_W + c], x3 = a2[(j + 3) * A_W + c];
#pragma unroll
            for (int i = 0; i < 64; ++i) { const f32x4 a = *(const LAS f32x4*)(act + i * AS + 64 + j); acc[i] += a[0] * x0 + a[1] * x1 + a[2] * x2 + a[3] * x3; }
        }
        { const float b0 = a0[c];
#pragma unroll
          for (int i = 0; i < 64; ++i) AA[(size_t)(m0 + i) * A_W + c] = (bf16)f2bf(sigmoidf_(b0 + acc[i])); }
#pragma unroll
        for (int i = 0; i < 64; ++i) acc[i] = 0.f;
        for (int j = 0; j < 128; j += 4) {
            const float x0 = g2[(j + 0) * A_W + c], x1 = g2[(j + 1) * A_W + c], x2 = g2[(j + 2) * A_W + c], x3 = g2[(j + 3) * A_W + c];
#pragma unroll
            for (int i = 0; i < 64; ++i) { const f32x4 a = *(const LAS f32x4*)(act + i * AS + 128 + j); acc[i] += a[0] * x0 + a[1] * x1 + a[2] * x2 + a[3] * x3; }
        }
#pragma unroll
        for (int i = 0; i < 64; ++i) GG[(size_t)(m0 + i) * A_W + c] = (bf16)f2bf(acc[i]);
        { const int cc = tid & 255, th = tid >> 8; float wv[16];
#pragma unroll
          for (int j = 0; j < 16; ++j) wv[j] = gkw2[j * 256 + cc];
          const float bb = gkb[cc];
          for (int i = 0; i < 32; ++i) { const int tok = th * 32 + i; float s = bb;
#pragma unroll
              for (int j = 0; j < 16; ++j) s += gkd[tok * 16 + j] * wv[j];
              GK[(size_t)(m0 + tok) * 256 + cc] = (bf16)f2bf(-softplusf_(-s) * (1.f / 16.f)); } }
    }
}

constexpr int CH = 32;
__device__ __forceinline__ float red8(float v) { v = DPP_ADD(v, 0xB1); v = DPP_ADD(v, 0x4E); v = DPP_ADD(v, 0x141); return v; }
__device__ __forceinline__ float red4(float v) { v = DPP_ADD(v, 0xB1); v = DPP_ADD(v, 0x4E); return v; }

constexpr int RW_BUF = 6 * CH * 64;
__device__ __forceinline__ void rw_load(const bf16* p, const bf16* AA, const bf16* WL, int b, int t0, int col, int wave,
        unsigned (&rc)[4], unsigned (&kc)[4], unsigned (&vc)[4], unsigned (&rp)[4], unsigned (&kp)[4], unsigned (&vp)[4], unsigned (&a)[4], unsigned (&wl)[4]) {
#pragma unroll
    for (int q = 0; q < 4; ++q) {
        const int t = t0 + wave + 8 * q; const size_t m = (size_t)b * T + t; const bf16* pr = p + m * NP; const bf16* pp = (t > 0) ? pr - NP : pr;
        rc[q] = pr[C_R + col]; kc[q] = pr[C_K + col]; vc[q] = pr[C_V + col]; rp[q] = pp[C_R + col]; kp[q] = pp[C_K + col]; vp[q] = pp[C_V + col];
        a[q] = AA[m * A_W + col]; wl[q] = WL[m * A_W + col];
    }
}
__device__ __forceinline__ void rw_prep(LAS float* B, int t0, int wave, int lane, float mu_r, float mu_k, float mu_v, float kkc, float kac,
        const unsigned (&rc_)[4], const unsigned (&kc_)[4], const unsigned (&vc_)[4], const unsigned (&rp_)[4], const unsigned (&kp_)[4], const unsigned (&vp_)[4], const unsigned (&a_)[4], const unsigned (&wl_)[4]) {
    LAS float* R = B; LAS float* DEC = R + CH * 64; LAS float* KH = DEC + CH * 64; LAS float* KK = KH + CH * 64; LAS float* BB = KK + CH * 64; LAS float* V = BB + CH * 64;
#pragma unroll
    for (int q = 0; q < 4; ++q) {
        const int tt = wave + 8 * q; const float hp = (t0 + tt > 0) ? 1.f : 0.f;
        const float rc = bf2f(rc_[q]), kc = bf2f(kc_[q]), vc = bf2f(vc_[q]), rp = bf2f(rp_[q]) * hp, kp = bf2f(kp_[q]) * hp, vp = bf2f(vp_[q]) * hp;
        const float r = rc + (rp - rc) * mu_r, k = kc + (kp - kc) * mu_k, v = vc + (vp - vc) * mu_v;
        const float a = bf2f(a_[q]), wl = bf2f(wl_[q]);
        const float kr = k * kkc; const float nrm = sqrtf(wave_sum(kr * kr)); const float kk = kr / fmaxf(nrm, 1e-12f);
        const float kh = k * (1.f + (a - 1.f) * kac);
        R[tt * 64 + lane] = r; DEC[tt * 64 + lane] = __expf(wl); KH[tt * 64 + lane] = kh; KK[tt * 64 + lane] = kk; BB[tt * 64 + lane] = kk * a; V[tt * 64 + lane] = v;
    }
}
__device__ __forceinline__ void rwkv_item(const Params& P, LAS unsigned char* lds, int b, int h, int seg) {
    const int tid = threadIdx.x, lane = tid & 63, wave = tid >> 6;
    unsigned char* ws = P.ws;
    const bf16* p = (const bf16*)(ws + WS_P); const bf16* WL = (const bf16*)(ws + WS_WL); const bf16* AA = (const bf16*)(ws + WS_AA);
    bf16* MIX = (bf16*)(ws + WS_MIX); bf16* YI = (bf16*)(ws + WS_YI);
    const float* mu = P.in[4]; const float* k_k = P.in[10]; const float* k_a = P.in[11];
    LAS float* BUF = (LAS float*)lds; LAS float* Y = BUF + 2 * RW_BUF;
    const int col = h * 64 + lane;
    const float mu_r = mu[C_R + col], mu_k = mu[C_K + col], mu_v = mu[C_V + col], kkc = k_k[col], kac = k_a[col];
    const int row = wave * 16 + (lane >> 2), ks = (lane & 3) * 16; const int ident = row >> 6, vrow = row & 63;
    float* SE = (float*)(ws + WS_SER) + ((((size_t)(b * 8 + h) * NSEG + seg) * 2 + ident) * 4096) + vrow * 64 + ks;
    float S[16];
#pragma unroll
    for (int j = 0; j < 16; ++j) S[j] = (ident && (ks + j == vrow)) ? 1.f : 0.f;
    const float vmask = ident ? 0.f : 1.f;
    const int tbeg = seg * LSEG;
    unsigned rc[4], kc[4], vc[4], rp[4], kp[4], vp[4], a[4], wl[4];
    __syncthreads();
    rw_load(p, AA, WL, b, tbeg, col, wave, rc, kc, vc, rp, kp, vp, a, wl);
    rw_prep(BUF, tbeg, wave, lane, mu_r, mu_k, mu_v, kkc, kac, rc, kc, vc, rp, kp, vp, a, wl);
    __syncthreads();
    for (int ci = 0; ci < LSEG / CH; ++ci) {
        const int t0 = tbeg + ci * CH; LAS float* B = BUF + (ci & 1) * RW_BUF;
        LAS float* R = B; LAS float* DEC = R + CH * 64; LAS float* KH = DEC + CH * 64; LAS float* KK = KH + CH * 64; LAS float* BB = KK + CH * 64; LAS float* V = BB + CH * 64;
        const bool more = (ci + 1 < LSEG / CH);
        if (more) rw_load(p, AA, WL, b, t0 + CH, col, wave, rc, kc, vc, rp, kp, vp, a, wl);
        for (int tt = 0; tt < CH; ++tt) {
            const float vv = V[tt * 64 + vrow] * vmask;
            float sa0 = 0.f, sa1 = 0.f;
#pragma unroll
            for (int q4 = 0; q4 < 4; ++q4) { const f32x4 kq = *(const LAS f32x4*)(KK + tt * 64 + ks + 4 * q4);
#pragma unroll
                for (int j = 0; j < 4; ++j) { if (q4 & 1) sa1 += S[4 * q4 + j] * kq[j]; else sa0 += S[4 * q4 + j] * kq[j]; } }
            const float sa = -red4(sa0 + sa1);
            float y0 = 0.f, y1 = 0.f;
#pragma unroll
            for (int q4 = 0; q4 < 4; ++q4) {
                const f32x4 dq = *(const LAS f32x4*)(DEC + tt * 64 + ks + 4 * q4), bq = *(const LAS f32x4*)(BB + tt * 64 + ks + 4 * q4), hq = *(const LAS f32x4*)(KH + tt * 64 + ks + 4 * q4), rq = *(const LAS f32x4*)(R + tt * 64 + ks + 4 * q4);
#pragma unroll
                for (int j = 0; j < 4; ++j) { S[4 * q4 + j] = S[4 * q4 + j] * dq[j] + sa * bq[j] + vv * hq[j]; if (q4 & 1) y1 += S[4 * q4 + j] * rq[j]; else y0 += S[4 * q4 + j] * rq[j]; }
            }
            const float y = red4(y0 + y1);
            if ((lane & 3) == 0) Y[tt * 128 + row] = y;
        }
        __syncthreads();
        if (more) rw_prep(BUF + ((ci + 1) & 1) * RW_BUF, t0 + CH, wave, lane, mu_r, mu_k, mu_v, kkc, kac, rc, kc, vc, rp, kp, vp, a, wl);
#pragma unroll
        for (int q = 0; q < 4; ++q) {
            const int tt = wave + 8 * q; const size_t m = (size_t)b * T + t0 + tt;
            MIX[m * D + col] = (bf16)f2bf(Y[tt * 128 + lane]); YI[m * 512 + col] = (bf16)f2bf(Y[tt * 128 + 64 + lane]);
        }
        __syncthreads();
    }
#pragma unroll
    for (int q4 = 0; q4 < 4; ++q4) *(f32x4*)(SE + 4 * q4) = (f32x4){S[4 * q4], S[4 * q4 + 1], S[4 * q4 + 2], S[4 * q4 + 3]};
}

constexpr int GL_BUF = 3 * CH * 64 + CH * 128;
__device__ __forceinline__ void gl_load(const bf16* p, const bf16* GK, int b, int h, int t0, int lane, int wave, unsigned (&x)[4][4][4], unsigned (&gk)[4]) {
    const int cq = h * 64 + lane, ck = 256 + h * 64 + lane, cv0 = 512 + h * 128 + lane, cv1 = cv0 + 64;
#pragma unroll
    for (int q = 0; q < 4; ++q) {
        const int t = t0 + wave + 8 * q; const size_t m = (size_t)b * T + t;
#pragma unroll
        for (int j = 0; j < 4; ++j) { const int back = 3 - j; const bf16* pr = p + (m - (size_t)((t >= back) ? back : 0)) * NP + C_BQ;
            x[q][j][0] = pr[cq]; x[q][j][1] = pr[ck]; x[q][j][2] = pr[cv0]; x[q][j][3] = pr[cv1]; }
        gk[q] = GK[m * 256 + h * 64 + lane];
    }
}
__device__ __forceinline__ void gl_prep(LAS float* B, int t0, int wave, int lane, const float (&wq)[4], const float (&wk)[4], const float (&wv0)[4], const float (&wv1)[4],
        const unsigned (&x)[4][4][4], const unsigned (&gk)[4]) {
    LAS float* Q = B; LAS float* K = Q + CH * 64; LAS float* DEC = K + CH * 64; LAS float* V = DEC + CH * 64;
#pragma unroll
    for (int q = 0; q < 4; ++q) {
        const int tt = wave + 8 * q, t = t0 + tt; float aq = 0.f, ak = 0.f, av0 = 0.f, av1 = 0.f;
#pragma unroll
        for (int j = 0; j < 4; ++j) { const float ok = (t >= 3 - j) ? 1.f : 0.f;
            aq += wq[j] * ok * bf2f(x[q][j][0]); ak += wk[j] * ok * bf2f(x[q][j][1]); av0 += wv0[j] * ok * bf2f(x[q][j][2]); av1 += wv1[j] * ok * bf2f(x[q][j][3]); }
        Q[tt * 64 + lane] = siluf_(aq) * 0.125f; K[tt * 64 + lane] = siluf_(ak); V[tt * 128 + lane] = siluf_(av0); V[tt * 128 + 64 + lane] = siluf_(av1);
        DEC[tt * 64 + lane] = __expf(bf2f(gk[q]));
    }
}
__device__ __forceinline__ void gla_item(const Params& P, LAS unsigned char* lds, int b, int h, int seg) {
    const int tid = threadIdx.x, lane = tid & 63, wave = tid >> 6;
    unsigned char* ws = P.ws;
    const bf16* p = (const bf16*)(ws + WS_P); const bf16* GK = (const bf16*)(ws + WS_GK);
    bf16* MIX = (bf16*)(ws + WS_MIX); bf16* YIG = (bf16*)(ws + WS_YIG);
    float* SE = (float*)(ws + WS_SEG) + ((size_t)(b * 4 + h) * NSEG + seg) * 8192; float* CE = (float*)(ws + WS_CEND) + ((size_t)(b * 4 + h) * NSEG + seg) * 64;
    const float* conv = P.in[15];
    LAS float* BUF = (LAS float*)lds; LAS float* O = BUF + 2 * GL_BUF; LAS float* YL = O + CH * 128;
    const int cq = h * 64 + lane, ck = 256 + h * 64 + lane, cv0 = 512 + h * 128 + lane, cv1 = cv0 + 64;
    float wq[4], wk[4], wv0[4], wv1[4];
#pragma unroll
    for (int j = 0; j < 4; ++j) { wq[j] = conv[j * 1024 + cq]; wk[j] = conv[j * 1024 + ck]; wv0[j] = conv[j * 1024 + cv0]; wv1[j] = conv[j * 1024 + cv1]; }
    float S[16], c[16];
#pragma unroll
    for (int j = 0; j < 16; ++j) { S[j] = 0.f; c[j] = 1.f; }
    const int row = wave * 16 + (lane >> 2), ks = (lane & 3) * 16;
    const int tbeg = seg * LSEG;
    unsigned x[4][4][4], gk[4];
    __syncthreads();
    gl_load(p, GK, b, h, tbeg, lane, wave, x, gk);
    gl_prep(BUF, tbeg, wave, lane, wq, wk, wv0, wv1, x, gk);
    __syncthreads();
    for (int ci = 0; ci < LSEG / CH; ++ci) {
        const int t0 = tbeg + ci * CH; LAS float* B = BUF + (ci & 1) * GL_BUF;
        LAS float* Q = B; LAS float* K = Q + CH * 64; LAS float* DEC = K + CH * 64; LAS float* V = DEC + CH * 64;
        const bool more = (ci + 1 < LSEG / CH);
        if (more) gl_load(p, GK, b, h, t0 + CH, lane, wave, x, gk);
        for (int tt = 0; tt < CH; ++tt) {
            const float vv = V[tt * 128 + row]; float o0 = 0.f, o1 = 0.f;
#pragma unroll
            for (int q4 = 0; q4 < 4; ++q4) {
                const f32x4 kk = *(const LAS f32x4*)(K + tt * 64 + ks + 4 * q4), dd = *(const LAS f32x4*)(DEC + tt * 64 + ks + 4 * q4), qq = *(const LAS f32x4*)(Q + tt * 64 + ks + 4 * q4);
#pragma unroll
                for (int j = 0; j < 4; ++j) { S[4 * q4 + j] = S[4 * q4 + j] * dd[j] + vv * kk[j]; if (q4 & 1) o1 += S[4 * q4 + j] * qq[j]; else o0 += S[4 * q4 + j] * qq[j]; }
                if (wave == 0) { f32x4 yi;
#pragma unroll
                    for (int j = 0; j < 4; ++j) { c[4 * q4 + j] *= dd[j]; yi[j] = c[4 * q4 + j] * qq[j]; }
                    if (lane < 4) *(LAS f32x4*)(YL + tt * 64 + ks + 4 * q4) = yi; }
            }
            const float o = red4(o0 + o1);
            if ((lane & 3) == 0) O[tt * 128 + row] = o;
        }
        __syncthreads();
        if (more) gl_prep(BUF + ((ci + 1) & 1) * GL_BUF, t0 + CH, wave, lane, wq, wk, wv0, wv1, x, gk);
#pragma unroll
        for (int q = 0; q < 4; ++q) {
            const int tt = wave + 8 * q; const size_t m = (size_t)b * T + t0 + tt;
            MIX[m * D + 512 + h * 128 + lane] = (bf16)f2bf(O[tt * 128 + lane]); MIX[m * D + 512 + h * 128 + 64 + lane] = (bf16)f2bf(O[tt * 128 + 64 + lane]);
            YIG[m * 256 + h * 64 + lane] = (bf16)f2bf(YL[tt * 64 + lane]);
        }
        __syncthreads();
    }
#pragma unroll
    for (int q4 = 0; q4 < 4; ++q4) *(f32x4*)(SE + row * 64 + ks + 4 * q4) = (f32x4){S[4 * q4], S[4 * q4 + 1], S[4 * q4 + 2], S[4 * q4 + 3]};
    if (wave == 0 && lane < 4) {
#pragma unroll
        for (int q4 = 0; q4 < 4; ++q4) *(f32x4*)(CE + ks + 4 * q4) = (f32x4){c[4 * q4], c[4 * q4 + 1], c[4 * q4 + 2], c[4 * q4 + 3]};
    }
}
__device__ __forceinline__ void phase_scan(const Params& P, LAS unsigned char* lds) {
    for (int it = blockIdx.x; it < 512 + 256; it += gridDim.x) {
        if (it < 512) { const int bh = it >> 4; rwkv_item(P, lds, bh >> 3, bh & 7, it & 15); }
        else { const int g = it - 512, bh = g >> 4; gla_item(P, lds, bh >> 2, bh & 3, g & 15); }
        __syncthreads();
    }
}
__device__ __forceinline__ void phase_fixup(const Params& P, LAS unsigned char* lds) {
    const int tid = threadIdx.x;
    for (int it = blockIdx.x; it < 48; it += gridDim.x) {
        if (it < 32) {
            float* SE = (float*)(P.ws + WS_SER) + (size_t)it * NSEG * 2 * 4096;
            LAS float* Sc = (LAS float*)lds; LAS float* Ph = Sc + 64 * 65;
            const int v = tid >> 3, kq = (tid & 7) * 8;
            __syncthreads();
            for (int i = tid; i < 64 * 65; i += NTHR) Sc[i] = 0.f;
            for (int seg = 0; seg < NSEG - 1; ++seg) {
                float* s0 = SE + (size_t)(seg * 2 + 0) * 4096; const float* ph = SE + (size_t)(seg * 2 + 1) * 4096;
                __syncthreads();
                for (int i = tid; i < 1024; i += NTHR) *(LAS f32x4*)(Ph + 4 * i) = *(const f32x4*)(ph + 4 * i);
                f32x4 a0 = *(const f32x4*)(s0 + v * 64 + kq), a1 = *(const f32x4*)(s0 + v * 64 + kq + 4);
                __syncthreads();
                for (int j = 0; j < 64; ++j) { const float sv = Sc[v * 65 + j]; a0 += *(const LAS f32x4*)(Ph + j * 64 + kq) * sv; a1 += *(const LAS f32x4*)(Ph + j * 64 + kq + 4) * sv; }
                __syncthreads();
#pragma unroll
                for (int i = 0; i < 4; ++i) { Sc[v * 65 + kq + i] = a0[i]; Sc[v * 65 + kq + 4 + i] = a1[i]; }
                *(f32x4*)(s0 + v * 64 + kq) = a0; *(f32x4*)(s0 + v * 64 + kq + 4) = a1;
            }
        } else {
            const int bh = it - 32; float* SE = (float*)(P.ws + WS_SEG) + (size_t)bh * NSEG * 8192; const float* CE = (const float*)(P.ws + WS_CEND) + (size_t)bh * NSEG * 64;
            const int v = tid >> 2, d0 = (tid & 3) * 16; f32x4 sc[4];
#pragma unroll
            for (int q = 0; q < 4; ++q) sc[q] = (f32x4){0.f, 0.f, 0.f, 0.f};
            for (int seg = 0; seg < NSEG - 1; ++seg) {
#pragma unroll
                for (int q = 0; q < 4; ++q) { float* sp = SE + (size_t)seg * 8192 + v * 64 + d0 + 4 * q; sc[q] = sc[q] * *(const f32x4*)(CE + seg * 64 + d0 + 4 * q) + *(const f32x4*)sp; *(f32x4*)sp = sc[q]; }
            }
        }
    }
}
__device__ __forceinline__ void phase_correct(const Params& P, LAS unsigned char* lds) {
    const int tid = threadIdx.x, lane = tid & 63, wave = tid >> 6;
    unsigned char* ws = P.ws;
    const bf16* p = (const bf16*)(ws + WS_P); const bf16* AA = (const bf16*)(ws + WS_AA); const bf16* GG = (const bf16*)(ws + WS_GG);
    bf16* MIX = (bf16*)(ws + WS_MIX); const bf16* YI = (const bf16*)(ws + WS_YI); const bf16* YIG = (const bf16*)(ws + WS_YIG);
    const float* mu = P.in[4]; const float* k_a = P.in[11]; const float* r_k = P.in[12]; const float* gn_g = P.in[13]; const float* gn_b = P.in[14]; const float* norm_g = P.in[18];
    LAS float* SL = (LAS float*)lds;
    for (int it = blockIdx.x; it < 512 + 256; it += gridDim.x) {
        __syncthreads();
        if (it < 512) {
            const int seg = it & 15, bh = it >> 4, b = bh >> 3, h = bh & 7;
            if (seg > 0) { const float* ss = (const float*)(ws + WS_SER) + (((size_t)bh * NSEG + (seg - 1)) * 2) * 4096;
                for (int i = tid; i < 4096; i += NTHR) SL[(i & 63) * 65 + (i >> 6)] = ss[i]; }
            __syncthreads();
            const int col = h * 64 + lane;
            const float mu_r = mu[C_R + col], mu_k = mu[C_K + col], mu_v = mu[C_V + col], kac = k_a[col], rkc = r_k[col], gng = gn_g[col], gnb = gn_b[col];
            for (int i0 = 0; i0 < 64; i0 += 4) {
                float y[4], yi[4], r[4], k[4], v[4], a[4], g[4];
#pragma unroll
                for (int u = 0; u < 4; ++u) {
                    const int t = seg * LSEG + wave * 64 + i0 + u; const size_t m = (size_t)b * T + t; const bf16* pr = p + m * NP; const bf16* pp = (t > 0) ? pr - NP : pr; const float hp = (t > 0) ? 1.f : 0.f;
                    y[u] = bf2f(MIX[m * D + col]); yi[u] = bf2f(YI[m * 512 + col]);
                    const float rc = bf2f(pr[C_R + col]), kc = bf2f(pr[C_K + col]), vc = bf2f(pr[C_V + col]);
                    r[u] = rc + (bf2f(pp[C_R + col]) * hp - rc) * mu_r; k[u] = kc + (bf2f(pp[C_K + col]) * hp - kc) * mu_k; v[u] = vc + (bf2f(pp[C_V + col]) * hp - vc) * mu_v;
                    a[u] = bf2f(AA[m * A_W + col]); g[u] = bf2f(GG[m * A_W + col]);
                }
                if (seg > 0) {
                    for (int j = 0; j < 64; ++j) { const float sv = SL[j * 65 + lane];
#pragma unroll
                        for (int u = 0; u < 4; ++u) y[u] += rlf(yi[u], j) * sv; }
                }
#pragma unroll
                for (int u = 0; u < 4; ++u) {
                    const size_t m = (size_t)b * T + seg * LSEG + wave * 64 + i0 + u;
                    const float kh = k[u] * (1.f + (a[u] - 1.f) * kac); const float bon = wave_sum(r[u] * kh * rkc);
                    const float mean = wave_sum(y[u]) * (1.f / 64.f); const float d = y[u] - mean; const float var = wave_sum(d * d) * (1.f / 64.f);
                    float o = d * (1.f / sqrtf(var + GN_EPS)) * gng + gnb; o += bon * v[u]; o *= g[u];
                    MIX[m * D + col] = (bf16)f2bf(o);
                }
            }
        } else {
            const int g_ = it - 512, seg = g_ & 15, bh = g_ >> 4, b = bh >> 2, h = bh & 3;
            if (seg > 0) { const float* ss = (const float*)(ws + WS_SEG) + ((size_t)bh * NSEG + (seg - 1)) * 8192;
                for (int i = tid; i < 8192; i += NTHR) SL[(i & 63) * 129 + (i >> 6)] = ss[i]; }
            __syncthreads();
            const float ng0 = norm_g[lane], ng1 = norm_g[lane + 64];
            for (int i0 = 0; i0 < 64; i0 += 4) {
                float o0[4], o1[4], yi[4], g0[4], g1[4];
#pragma unroll
                for (int u = 0; u < 4; ++u) {
                    const size_t m = (size_t)b * T + seg * LSEG + wave * 64 + i0 + u;
                    o0[u] = bf2f(MIX[m * D + 512 + h * 128 + lane]); o1[u] = bf2f(MIX[m * D + 512 + h * 128 + 64 + lane]); yi[u] = bf2f(YIG[m * 256 + h * 64 + lane]);
                    g0[u] = bf2f(p[m * NP + C_BG + h * 128 + lane]); g1[u] = bf2f(p[m * NP + C_BG + h * 128 + 64 + lane]);
                }
                if (seg > 0) {
                    for (int d = 0; d < 64; ++d) { const float s0 = SL[d * 129 + lane], s1 = SL[d * 129 + 64 + lane];
#pragma unroll
                        for (int u = 0; u < 4; ++u) { const float q = rlf(yi[u], d); o0[u] += q * s0; o1[u] += q * s1; } }
                }
#pragma unroll
                for (int u = 0; u < 4; ++u) {
                    const size_t m = (size_t)b * T + seg * LSEG + wave * 64 + i0 + u;
                    const float ms = wave_sum(o0[u] * o0[u] + o1[u] * o1[u]) * (1.f / 128.f); const float rs = 1.f / sqrtf(ms + RMS_EPS);
                    MIX[m * D + 512 + h * 128 + lane] = (bf16)f2bf(o0[u] * rs * ng0 * siluf_(g0[u])); MIX[m * D + 512 + h * 128 + 64 + lane] = (bf16)f2bf(o1[u] * rs * ng1 * siluf_(g1[u]));
                }
            }
        }
    }
}

__device__ __forceinline__ void phase_ln1(const Params& P) {
    const int lane = threadIdx.x & 63, wave = threadIdx.x >> 6; const int gw = blockIdx.x * NWAVES + wave, ngw = gridDim.x * NWAVES;
    for (int m = gw; m < M; m += ngw) ln_row_bf16((const float*)(P.ws + WS_Z) + (size_t)m * D, P.in[20], P.in[21], (bf16*)(P.ws + WS_H1) + (size_t)m * D, lane);
#pragma unroll
    for (int tb = 0; tb < 2; ++tb) {
        const float* src = P.in[24 + tb]; unsigned char* dst = P.ws + (tb ? WS_VT : WS_UT); float* sc = (float*)(P.ws + (tb ? WS_SV : WS_SU));
        for (int e = gw; e < 16384; e += ngw) {
            const f32x4* sp = (const f32x4*)(src + (size_t)e * D) + 4 * lane; f32x4 a[4]; float mx = 0.f;
#pragma unroll
            for (int j = 0; j < 4; ++j) { a[j] = sp[j]; mx = fmaxf(fmaxf(mx, fmaxf(fabsf(a[j][0]), fabsf(a[j][1]))), fmaxf(fabsf(a[j][2]), fabsf(a[j][3]))); }
            mx = wave_max_u(mx); const float inv = mx > 0.f ? 127.f / mx : 0.f;
            u32x4 o;
#pragma unroll
            for (int j = 0; j < 4; ++j) o[j] = pack_i8(a[j][0], a[j][1], a[j][2], a[j][3], inv, tb ? 128 : 0);
            *((u32x4*)(dst + (size_t)e * D) + lane) = o;
            if (lane == 0) sc[e] = mx * (1.f / 127.f);
        }
    }
}

#define TK_INS(L, x) do { _Pragma("unroll") for (int _j = 0; _j < 16; ++_j) { const unsigned _h = max(L[_j], x); x = min(L[_j], x); L[_j] = _h; } } while (0)
__device__ __forceinline__ void topk128(const u32x4* r, unsigned (&L)[16]) {
#pragma unroll
    for (int j = 0; j < 16; ++j) L[j] = 0u;
    u32x4 cur = r[0];
    for (int c = 0; c < 16; ++c) {
        const u32x4 nxt = r[(c + 1) & 15];
        const unsigned kb = 0xFFFFu - 8u * (unsigned)c;
#pragma unroll
        for (int d = 0; d < 4; ++d) {
            unsigned w = cur[d]; const unsigned msk = ((w >> 15) & 0x00010001u) * 0xFFFFu; w ^= (msk | 0x80008000u);
            unsigned x0 = (w << 16) | (kb - 2u * d), x1 = (w & 0xFFFF0000u) | (kb - 2u * d - 1u);
            TK_INS(L, x0); TK_INS(L, x1);
        }
        cur = nxt;
    }
}
__device__ __forceinline__ void phase_topk(const Params& P) {
    const int gl = blockIdx.x * NTHR + threadIdx.x, nl = gridDim.x * NTHR;
    const bf16* Sc = (const bf16*)(P.ws + WS_S); int* IDS = (int*)(P.ws + WS_IDS); float* GATES = (float*)(P.ws + WS_GATES);
    for (int item = gl; item < M * 8; item += nl) {
        const u32x4* row = (const u32x4*)(Sc + (size_t)item * 256);
        unsigned L0[16], L1[16];
        topk128(row, L0); topk128(row + 16, L1);
        float f0[16], f1[16]; unsigned p0[16], p1[16];
#pragma unroll
        for (int i = 0; i < 16; ++i) {
            f0[i] = __uint_as_float((L0[i] & 0x80000000u) ? (L0[i] & 0x7FFF0000u) : (~L0[i] & 0xFFFF0000u)); p0[i] = (~L0[i] & 0x7Fu) << 7;
            f1[i] = __uint_as_float((L1[i] & 0x80000000u) ? (L1[i] & 0x7FFF0000u) : (~L1[i] & 0xFFFF0000u)); p1[i] = (~L1[i] & 0x7Fu);
        }
        unsigned C[16];
#pragma unroll
        for (int j = 0; j < 16; ++j) C[j] = 0u;
#pragma unroll
        for (int i = 0; i < 16; ++i)
#pragma unroll
            for (int j = 0; j < 16; ++j)
                if ((i + 1) * (j + 1) <= 16) {
                    const unsigned b = __float_as_uint(f0[i] + f1[j]); const unsigned mono = b ^ ((unsigned)((int)b >> 31) | 0x80000000u);
                    unsigned key = (mono & 0xFFFFC000u) | p0[i] | p1[j];
                    TK_INS(C, key);
                }
        float cv[16];
#pragma unroll
        for (int r = 0; r < 16; ++r) cv[r] = __uint_as_float((C[r] & 0x80000000u) ? (C[r] & 0x7FFFC000u) : (~C[r] & 0xFFFFC000u));
        const float cmax = cv[0]; float den = 0.f;
#pragma unroll
        for (int r = 0; r < 16; ++r) { cv[r] = __expf(cv[r] - cmax); den += cv[r]; }
        const float inv = 1.f / den;
        u32x4* ido = (u32x4*)(IDS + (size_t)item * 16); f32x4* go = (f32x4*)(GATES + (size_t)item * 16);
#pragma unroll
        for (int q = 0; q < 4; ++q) { u32x4 o; o.x = C[4 * q] & 0x3FFFu; o.y = C[4 * q + 1] & 0x3FFFu; o.z = C[4 * q + 2] & 0x3FFFu; o.w = C[4 * q + 3] & 0x3FFFu; ido[q] = o;
            f32x4 g; g[0] = cv[4 * q] * inv; g[1] = cv[4 * q + 1] * inv; g[2] = cv[4 * q + 2] * inv; g[3] = cv[4 * q + 3] * inv; go[q] = g; }
    }
}

typedef __bf16 bf16x2_t __attribute__((ext_vector_type(2)));
__device__ __forceinline__ float dot2bf(unsigned a, unsigned b, float c) { return __builtin_amdgcn_fdot2_f32_bf16(__builtin_bit_cast(bf16x2_t, a), __builtin_bit_cast(bf16x2_t, b), c, false); }
__device__ __forceinline__ void peer_load8(u32x4 (&buf)[8], const unsigned char* TAB, int idreg, int g, int lane) {
#pragma unroll
    for (int q = 0; q < 8; ++q) { const int id = __builtin_amdgcn_readlane(idreg, 8 * g + q); buf[q] = *((const u32x4*)(TAB + (size_t)id * D) + lane); }
}
__device__ __forceinline__ void peer_dots8(const u32x4 (&buf)[8], const u32x4& hq, int g, float& d, int lane) {
#pragma unroll
    for (int q = 0; q < 8; ++q) { int s = 0;
#pragma unroll
        for (int i = 0; i < 4; ++i) s = __builtin_amdgcn_sdot4((int)buf[q][i], (int)hq[i], s, false);
        const int tot = wave_sum_i(s);
        d = (lane == 8 * g + q) ? (float)tot : d; }
}
__device__ __forceinline__ void peer_axpy8(const u32x4 (&buf)[8], float areg, int g, float (&acc)[16]) {
#pragma unroll
    for (int q = 0; q < 8; ++q) { const float a = rlf(areg, 8 * g + q);
#pragma unroll
        for (int i = 0; i < 4; ++i) { const unsigned w = buf[q][i];
            acc[4 * i] += a * (float)(w & 0xffu); acc[4 * i + 1] += a * (float)((w >> 8) & 0xffu); acc[4 * i + 2] += a * (float)((w >> 16) & 0xffu); acc[4 * i + 3] += a * (float)(w >> 24); } }
}
__device__ __forceinline__ void phase_peer(const Params& P) {
    const int lane = threadIdx.x & 63, wave = threadIdx.x >> 6; const int gw = blockIdx.x * NWAVES + wave, ngw = gridDim.x * NWAVES;
    const bf16* H1 = (const bf16*)(P.ws + WS_H1); const int* IDS = (const int*)(P.ws + WS_IDS); const float* GATES = (const float*)(P.ws + WS_GATES);
    const unsigned char* UT = P.ws + WS_UT; const unsigned char* VT = P.ws + WS_VT; const float* SU = (const float*)(P.ws + WS_SU); const float* SV = (const float*)(P.ws + WS_SV);
    const float* g2 = P.in[26]; const float* b2 = P.in[27];
    for (int m = gw; m < M; m += ngw) {
        const u32x4* hp = (const u32x4*)(H1 + (size_t)m * D) + 2 * lane; const u32x4 hA = hp[0], hB = hp[1];
        float hv[16]; float hmx = 0.f;
#pragma unroll
        for (int i = 0; i < 4; ++i) { hv[2 * i] = __uint_as_float(hA[i] << 16); hv[2 * i + 1] = __uint_as_float(hA[i] & 0xffff0000u); hv[8 + 2 * i] = __uint_as_float(hB[i] << 16); hv[8 + 2 * i + 1] = __uint_as_float(hB[i] & 0xffff0000u); }
#pragma unroll
        for (int i = 0; i < 16; ++i) hmx = fmaxf(hmx, fabsf(hv[i]));
        hmx = wave_max_u(hmx); const float hinv = hmx > 0.f ? 127.f / hmx : 0.f, hsc = hmx * (1.f / 127.f);
        u32x4 hq;
#pragma unroll
        for (int i = 0; i < 4; ++i) hq[i] = pack_i8(hv[4 * i], hv[4 * i + 1], hv[4 * i + 2], hv[4 * i + 3], hinv, 0);
        const int id_lo = IDS[(size_t)m * 128 + lane], id_hi = IDS[(size_t)m * 128 + 64 + lane];
        const float gt_lo = GATES[(size_t)m * 128 + lane], gt_hi = GATES[(size_t)m * 128 + 64 + lane];
        const float su_lo = SU[id_lo], su_hi = SU[id_hi], sv_lo = SV[id_lo], sv_hi = SV[id_hi];
        float d_lo = 0.f, d_hi = 0.f;
        u32x4 A0[8], A1[8];
        peer_load8(A0, UT, id_lo, 0, lane);
        for (int g = 0; g < 8; g += 2) {
            peer_load8(A1, UT, id_lo, g + 1, lane); peer_dots8(A0, hq, g, d_lo, lane);
            if (g + 2 < 8) peer_load8(A0, UT, id_lo, g + 2, lane); else peer_load8(A0, UT, id_hi, 0, lane);
            peer_dots8(A1, hq, g + 1, d_lo, lane);
        }
        for (int g = 0; g < 8; g += 2) {
            peer_load8(A1, UT, id_hi, g + 1, lane); peer_dots8(A0, hq, g, d_hi, lane);
            if (g + 2 < 8) peer_load8(A0, UT, id_hi, g + 2, lane); else peer_load8(A0, VT, id_lo, 0, lane);
            peer_dots8(A1, hq, g + 1, d_hi, lane);
        }
        const float x_lo = d_lo * su_lo * hsc, x_hi = d_hi * su_hi * hsc;
        const float a_lo = 0.5f * x_lo * (1.f + erff(x_lo * 0.70710678118f)) * gt_lo * sv_lo, a_hi = 0.5f * x_hi * (1.f + erff(x_hi * 0.70710678118f)) * gt_hi * sv_hi;
        const float c0 = 128.f * wave_sum(a_lo + a_hi);
        float acc[16];
#pragma unroll
        for (int i = 0; i < 16; ++i) acc[i] = 0.f;
        for (int g = 0; g < 8; g += 2) {
            peer_load8(A1, VT, id_lo, g + 1, lane); peer_axpy8(A0, a_lo, g, acc);
            if (g + 2 < 8) peer_load8(A0, VT, id_lo, g + 2, lane); else peer_load8(A0, VT, id_hi, 0, lane);
            peer_axpy8(A1, a_lo, g + 1, acc);
        }
        for (int g = 0; g < 8; g += 2) {
            peer_load8(A1, VT, id_hi, g + 1, lane); peer_axpy8(A0, a_hi, g, acc);
            if (g + 2 < 8) peer_load8(A0, VT, id_hi, g + 2, lane);
            peer_axpy8(A1, a_hi, g + 1, acc);
        }
        float s = 0.f;
#pragma unroll
        for (int i = 0; i < 16; ++i) { acc[i] = ALPHA * hv[i] + (acc[i] - c0); s += acc[i]; }
        const float mean = wave_sum(s) * (1.f / D); float s2 = 0.f;
#pragma unroll
        for (int i = 0; i < 16; ++i) { acc[i] -= mean; s2 += acc[i] * acc[i]; }
        const float rstd = 1.f / sqrtf(wave_sum(s2) * (1.f / D) + LN_EPS);
#pragma unroll
        for (int c4 = 0; c4 < 4; ++c4) { const int e0 = 16 * lane + 4 * c4; const f32x4 gg = *(const f32x4*)(g2 + e0), bb = *(const f32x4*)(b2 + e0); f32x4 o;
#pragma unroll
            for (int j = 0; j < 4; ++j) o[j] = acc[c4 * 4 + j] * rstd * gg[j] + bb[j];
            *(f32x4*)(P.out + (size_t)m * D + e0) = o; }
    }
}

constexpr int N_PHASES = 12;
__global__ void __launch_bounds__(NTHR, 2) fwd_kernel(Params P) {
    extern __shared__ __attribute__((aligned(16))) unsigned char lds_raw[];
    LAS unsigned char* lds = (LAS unsigned char*)lds_raw;
    cg::grid_group grid = cg::this_grid();
    const int lo = P.ph_lo, hi = P.ph_hi;
    unsigned char* ws = P.ws;
#define IN(k) (lo <= (k) && (k) < hi)
#define SEAM(k) do { if (IN(k) && IN((k) + 1)) grid.sync(); } while (0)
    if (IN(0)) phase_prologue(P);
    SEAM(0);
    if (IN(1)) {
        pg8::Gemm g{(const bf16*)(ws + WS_H0), (const bf16*)(ws + WS_WIN), M, NP, D, D, D, 0}; pg8::StaticOrder S; S.init(M, NP, gridDim.x, blockIdx.x);
        pg8::EpiBf16 E{(bf16*)(ws + WS_P), NP};
        pg8::gemm_phase<pg8::EpiBf16, pg8::StaticOrder, true, true>(lds, g, S, E);
    }
    SEAM(1);
    if (IN(2)) phase_prep(P, lds);
    SEAM(2);
    if (IN(3)) phase_scan(P, lds);
    SEAM(3);
    if (IN(4)) phase_fixup(P, lds);
    SEAM(4);
    if (IN(5)) phase_correct(P, lds);
    SEAM(5);
    if (IN(6)) {
        pg8::Gemm g{(const bf16*)(ws + WS_MIX), (const bf16*)(ws + WS_WOUT), M, D, D, D, D, 0}; pg8::StaticOrder S; S.init(M, D, gridDim.x, blockIdx.x);
        pg8::EpiResF32 E{(float*)(ws + WS_Z), (const bf16*)(ws + WS_H0), D, ALPHA};
        pg8::gemm_phase<pg8::EpiResF32, pg8::StaticOrder, true, true>(lds, g, S, E);
    }
    SEAM(6);
    if (IN(7)) phase_ln1(P);
    SEAM(7);
    if (IN(8)) {
        pg8::Gemm g{(const bf16*)(ws + WS_H1), (const bf16*)(ws + WS_WQ), M, NQ, D, D, D, 0}; pg8::StaticOrder S; S.init(M, NQ, gridDim.x, blockIdx.x);
        pg8::EpiBf16 E{(bf16*)(ws + WS_Q), NQ};
        pg8::gemm_phase<pg8::EpiBf16, pg8::StaticOrder, true, true>(lds, g, S, E);
    }
    SEAM(8);
    if (IN(9)) {
        pg8::Gemm g{(const bf16*)(ws + WS_Q), (const bf16*)(ws + WS_KBD), M, NQ, 256, NQ, 256, 256}; pg8::StaticOrder S; S.init(M, NQ, gridDim.x, blockIdx.x);
        pg8::EpiBf16 E{(bf16*)(ws + WS_S), NQ};
        pg8::gemm_phase<pg8::EpiBf16, pg8::StaticOrder, true, true>(lds, g, S, E);
    }
    SEAM(9);
    if (IN(10)) phase_topk(P);
    SEAM(10);
    if (IN(11)) phase_peer(P);
#undef IN
#undef SEAM
}

extern "C" void kernel_launch(void* const* d_in, const int* in_sizes, int n_in, void* d_out, int out_size, void* d_ws, size_t ws_size, hipStream_t stream) {
    static int grid = 0;
    if (grid == 0) {
        if (n_in != 28 || out_size != M * D || ws_size < WS_END) { fprintf(stderr, "kernel_launch: unexpected shapes (n_in %d out %d ws %zu)\n", n_in, out_size, ws_size); grid = -1; return; }
        int dev = 0, cus = 0, per_cu = 0;
        (void)hipGetDevice(&dev); (void)hipDeviceGetAttribute(&cus, hipDeviceAttributeMultiprocessorCount, dev);
        (void)hipFuncSetAttribute((const void*)fwd_kernel, hipFuncAttributeMaxDynamicSharedMemorySize, LDS_BYTES);
        (void)hipOccupancyMaxActiveBlocksPerMultiprocessor(&per_cu, (const void*)fwd_kernel, NTHR, LDS_BYTES);
        if (per_cu < 1) { fprintf(stderr, "kernel_launch: occupancy query says %d blocks per CU\n", per_cu); per_cu = 1; }
        (void)hipGetLastError();
        grid = cus;
    }
    if (grid < 0) return;
    Params p{};
    for (int i = 0; i < 28; ++i) p.in[i] = (const float*)d_in[i];
    p.out = (float*)d_out; p.ws = (unsigned char*)d_ws;
#if MK_ONE_LAUNCH
    p.ph_lo = 0; p.ph_hi = N_PHASES;
    void* args[] = {&p};
    hipError_t e = hipLaunchCooperativeKernel((const void*)fwd_kernel, dim3(grid), dim3(NTHR), args, LDS_BYTES, stream);
    if (e != hipSuccess) fprintf(stderr, "cooperative launch failed: %s (grid %d)\n", hipGetErrorString(e), grid);
#else
    for (int ph = 0; ph < N_PHASES; ++ph) {
        p.ph_lo = ph; p.ph_hi = ph + 1;
        hipLaunchKernelGGL(fwd_kernel, dim3(grid), dim3(NTHR), LDS_BYTES, stream, p);
    }
#endif
}
```

```cpp
#include <hip/hip_runtime.h>
#include <hip/hip_cooperative_groups.h>
#include <cstdio>
#include <cstdint>
namespace cg = cooperative_groups;

#ifndef MK_ONE_LAUNCH
#define MK_ONE_LAUNCH 1
#endif

namespace pg8 {
#define PG8_LAS __attribute__((address_space(3)))
typedef unsigned short bf16_t;
typedef short bf16x8 __attribute__((ext_vector_type(8)));
typedef float f32x4 __attribute__((ext_vector_type(4)));
typedef unsigned u32x4 __attribute__((ext_vector_type(4)));
typedef unsigned u32x2 __attribute__((ext_vector_type(2)));
constexpr int BM = 256, BK = 64, HALF = 128, HTB = HALF * BK * 2, STAGE_BYTES = 8 * HTB, NXCD = 8, WGM = 8;

__host__ __device__ __forceinline__ int lds_byte(int r, int c) { const int st = (r >> 4) * 2 + (c >> 5), rr = r & 15, cc = c & 31, ob = rr * 64 + cc * 2; return st * 1024 + (ob ^ (((ob >> 9) & 1) << 5)); }
__host__ __device__ __forceinline__ void stage_rc(int b, int& R, int& C) { const int st = b / 1024, sb = b % 1024, swz = sb ^ (((sb >> 9) & 1) << 5); R = (st >> 1) * 16 + swz / 64; C = (st & 1) * 32 + (swz % 64) / 2; }
__host__ __device__ __forceinline__ int perm32(int rho) { const int n = rho >> 4, i = rho & 15; return 8 * (i >> 2) + 4 * n + (i & 3); }

struct Unit { int pm, pn; };
struct Gemm { const bf16_t* A; const bf16_t* Bt; int M, N, K, lda, ldb, a_pn_koff; };

struct StaticOrder {
    int nM, nN, nwg, G, c;
    __host__ __device__ void init(int M, int N, int G_, int c_) { nM = M / BM; nN = N / BM; nwg = nM * nN; G = G_; c = c_; }
    __host__ __device__ bool next(int i, Unit& u) const {
        const long L = (long)i * G + c; if (L >= nwg) return false;
        int wgid = (int)L; { const int q = nwg / NXCD, r = nwg % NXCD, xcd = wgid % NXCD, off = wgid / NXCD; wgid = (xcd < r ? xcd * (q + 1) : r * (q + 1) + (xcd - r) * q) + off; }
        const int nig = WGM * nN, gid = wgid / nig, fm = gid * WGM, gsz = (nM - fm) < WGM ? (nM - fm) : WGM;
        u.pm = fm + ((wgid % nig) % gsz); u.pn = (wgid % nig) / gsz; return true;
    }
    __device__ __forceinline__ void a_ready(const Unit&) const {}
    __device__ __forceinline__ void done(const Unit&) const {}
};

__device__ __forceinline__ unsigned cvt_pk_bf16(float lo, float hi) { unsigned r; asm volatile("v_cvt_pk_bf16_f32 %0, %1, %2" : "=v"(r) : "v"(lo), "v"(hi)); return r; }

struct EpiBf16 {
    static constexpr bool PERM = true;
    bf16_t* O; int ldc;
    __device__ __forceinline__ void operator()(const f32x4 (&acc)[2][2][4][2], const Unit& u, int wr, int wc, int fr, int fq) const {
        const int row0 = u.pm * BM + wr * 64 + fr; const int col0 = u.pn * BM + wc * 32 + 8 * fq;
#pragma unroll
        for (int ai = 0; ai < 2; ++ai)
#pragma unroll
            for (int m = 0; m < 4; ++m) { bf16_t* rowp = O + (size_t)(row0 + ai * HALF + m * 16) * ldc + col0;
#pragma unroll
                for (int bj = 0; bj < 2; ++bj) { const f32x4 v0 = acc[ai][bj][m][0], v1 = acc[ai][bj][m][1];
                    u32x4 w; w.x = cvt_pk_bf16(v0[0], v0[1]); w.y = cvt_pk_bf16(v0[2], v0[3]); w.z = cvt_pk_bf16(v1[0], v1[1]); w.w = cvt_pk_bf16(v1[2], v1[3]);
                    *(u32x4*)(rowp + bj * HALF) = w; } }
    }
};
struct EpiResF32 {
    static constexpr bool PERM = false;
    float* Z; const bf16_t* R; int ldc; float alpha;
    __device__ __forceinline__ void operator()(const f32x4 (&acc)[2][2][4][2], const Unit& u, int wr, int wc, int fr, int fq) const {
        const int row0 = u.pm * BM + wr * 64 + fr; const int col0 = u.pn * BM + wc * 32 + 4 * fq;
#pragma unroll
        for (int ai = 0; ai < 2; ++ai)
#pragma unroll
            for (int m = 0; m < 4; ++m) { const size_t off = (size_t)(row0 + ai * HALF + m * 16) * ldc + col0;
#pragma unroll
                for (int bj = 0; bj < 2; ++bj)
#pragma unroll
                    for (int n = 0; n < 2; ++n) { const size_t o2 = off + bj * HALF + n * 16; const u32x2 rb = *(const u32x2*)(R + o2);
                        f32x4 h; h[0] = __uint_as_float(rb.x << 16); h[1] = __uint_as_float(rb.x & 0xffff0000u); h[2] = __uint_as_float(rb.y << 16); h[3] = __uint_as_float(rb.y & 0xffff0000u);
                        *(f32x4*)(Z + o2) = h * alpha + acc[ai][bj][m][n]; } }
    }
};

template <class Epi, class Sched, bool ALIGN_EPI = false, bool SP2 = false>
__device__ __forceinline__ void gemm_phase(PG8_LAS unsigned char* lds, const Gemm g, const Sched& S, const Epi& E) {
    const int tid = threadIdx.x, wid = __builtin_amdgcn_readfirstlane(tid >> 6), lane = tid & 63, wr = wid >> 2, wc = wid & 3, fr = lane & 15, fq = lane >> 4;
    const int K = g.K, nt = K / BK;
    unsigned voffA[2], voffB[2];
#pragma unroll
    for (int i = 0; i < 2; ++i) { int R, C; stage_rc(tid * 16 + i * 8192, R, C); const int Rb = Epi::PERM ? ((R & ~31) + perm32(R & 31)) : R;
        voffA[i] = (unsigned)(R * g.lda + C) * 2u; voffB[i] = (unsigned)(Rb * g.ldb + C) * 2u; }
    const size_t kstep = (size_t)(BK * 2);
    const size_t hstepA = (size_t)HALF * g.lda * 2, hstepB = (size_t)HALF * g.ldb * 2;
    const size_t tstepA = 2 * hstepA, tstepB = 2 * hstepB;
    const size_t pnA = (size_t)g.a_pn_koff * 2;
    const unsigned ldsw = (unsigned)wid * 1024u;
    const int aoff = lds_byte(wr * 64 + fr, fq * 8), boff = lds_byte(wc * 32 + fr, fq * 8);
#define PG8_SA(b, h) (((b) * 2 + (h)) * HTB)
#define PG8_SB(b, h) ((4 + (b) * 2 + (h)) * HTB)
#define PG8_STAGE(bufoff, gbase, voff) do { _Pragma("unroll") for (int _i = 0; _i < 2; ++_i) \
        __builtin_amdgcn_global_load_lds((const unsigned*)((const char*)(gbase) + (voff)[_i]), (PG8_LAS unsigned*)(lds + (bufoff) + ldsw + _i * 8192), 16, 0, 0); } while (0)
#define PG8_LDA(dst, b, h) do { _Pragma("unroll") for (int m = 0; m < 4; ++m) _Pragma("unroll") for (int k = 0; k < 2; ++k) dst[m][k] = *(const PG8_LAS bf16x8*)(lds + PG8_SA(b, h) + aoff + m * 2048 + k * 1024); } while (0)
#define PG8_LDB(dst, b, h) do { _Pragma("unroll") for (int n = 0; n < 2; ++n) _Pragma("unroll") for (int k = 0; k < 2; ++k) dst[n][k] = *(const PG8_LAS bf16x8*)(lds + PG8_SB(b, h) + boff + n * 2048 + k * 1024); } while (0)
#define PG8_MMA(ai, bj, At, Bt) do { __builtin_amdgcn_s_setprio(1); _Pragma("unroll") for (int m = 0; m < 4; ++m) _Pragma("unroll") for (int n = 0; n < 2; ++n) _Pragma("unroll") for (int k = 0; k < 2; ++k) \
        acc[ai][bj][m][n] = __builtin_amdgcn_mfma_f32_16x16x32_bf16(Bt[n][k], At[m][k], acc[ai][bj][m][n], 0, 0, 0); __builtin_amdgcn_s_setprio(0); } while (0)
#define PG8_WAIT_V(n) asm volatile("s_waitcnt vmcnt(" #n ")" ::: "memory")
#define PG8_WAIT_L(n) asm volatile("s_waitcnt lgkmcnt(" #n ")" ::: "memory")
#define PG8_BAR __builtin_amdgcn_s_barrier()
#define PG8_SCHED __builtin_amdgcn_sched_barrier(0)
    Unit cur, nxt; int ui = 0;
    if (!S.next(0, cur)) return;
    f32x4 acc[2][2][4][2];
#pragma unroll
    for (int a = 0; a < 2; ++a)
#pragma unroll
        for (int b = 0; b < 2; ++b)
#pragma unroll
            for (int m = 0; m < 4; ++m)
#pragma unroll
                for (int n = 0; n < 2; ++n) acc[a][b][m][n] = (f32x4){0.f, 0.f, 0.f, 0.f};
    bf16x8 At[4][2], B0[2][2], B1[2][2];
    const char* cA = (const char*)g.A + (size_t)cur.pm * tstepA + (size_t)cur.pn * pnA; const char* cB = (const char*)g.Bt + (size_t)cur.pn * tstepB;
    S.a_ready(cur);
    if constexpr (SP2) {
        PG8_STAGE(PG8_SB(0, 0), cB, voffB); PG8_STAGE(PG8_SB(0, 1), cB + hstepB, voffB); PG8_STAGE(PG8_SA(0, 0), cA, voffA); PG8_STAGE(PG8_SA(0, 1), cA + hstepA, voffA);
        if (wr == 1) PG8_BAR;
        PG8_WAIT_V(2); PG8_BAR;
        PG8_STAGE(PG8_SB(1, 0), cB + kstep, voffB); PG8_STAGE(PG8_SA(1, 0), cA + kstep, voffA); PG8_STAGE(PG8_SB(1, 1), cB + hstepB + kstep, voffB);
        PG8_WAIT_V(6); PG8_BAR;
    } else {
        PG8_STAGE(PG8_SB(0, 0), cB, voffB); PG8_STAGE(PG8_SA(0, 0), cA, voffA); PG8_STAGE(PG8_SB(0, 1), cB + hstepB, voffB); PG8_STAGE(PG8_SA(0, 1), cA + hstepA, voffA);
        if (wr == 1) PG8_BAR;
        PG8_WAIT_V(4); PG8_BAR;
        PG8_STAGE(PG8_SB(1, 0), cB + kstep, voffB); PG8_STAGE(PG8_SA(1, 0), cA + kstep, voffA); PG8_STAGE(PG8_SB(1, 1), cB + hstepB + kstep, voffB);
        PG8_WAIT_V(6); PG8_BAR;
    }
    for (;;) {
        const bool has_next = S.next(ui + 1, nxt);
        const char* nA = has_next ? (const char*)g.A + (size_t)nxt.pm * tstepA + (size_t)nxt.pn * pnA : cA; const char* nB = has_next ? (const char*)g.Bt + (size_t)nxt.pn * tstepB : cB;
        for (int t = 0; t < nt; t += 2) {
            const bool last = (t == nt - 2);
            const char* a1 = cA + (size_t)(t + 1) * kstep;
            const char* a2 = last ? nA : cA + (size_t)(t + 2) * kstep; const char* b2 = last ? nB : cB + (size_t)(t + 2) * kstep;
            const char* a3 = a2 + kstep; const char* b3 = b2 + kstep;
            if (last && has_next) S.a_ready(nxt);
            if constexpr (SP2) {
            PG8_LDB(B0, 0, 0); PG8_LDB(B1, 0, 1); PG8_SCHED; PG8_LDA(At, 0, 0); PG8_STAGE(PG8_SA(1, 1), a1 + hstepA, voffA);
            PG8_WAIT_V(8); PG8_WAIT_L(0); PG8_BAR; PG8_MMA(0, 0, At, B0); PG8_MMA(0, 1, At, B1); PG8_BAR; PG8_SCHED;
            PG8_LDA(At, 0, 1); PG8_STAGE(PG8_SB(0, 0), b2, voffB); PG8_STAGE(PG8_SB(0, 1), b2 + hstepB, voffB); PG8_STAGE(PG8_SA(0, 0), a2, voffA);
            PG8_WAIT_V(8); PG8_WAIT_L(0); PG8_BAR; PG8_MMA(1, 0, At, B0); PG8_MMA(1, 1, At, B1); PG8_BAR; PG8_SCHED;
            PG8_LDB(B0, 1, 0); PG8_LDB(B1, 1, 1); PG8_SCHED; PG8_LDA(At, 1, 0); PG8_STAGE(PG8_SA(0, 1), a2 + hstepA, voffA);
            PG8_WAIT_V(8); PG8_WAIT_L(0); PG8_BAR; PG8_MMA(0, 0, At, B0); PG8_MMA(0, 1, At, B1); PG8_BAR; PG8_SCHED;
            PG8_LDA(At, 1, 1); PG8_STAGE(PG8_SB(1, 0), b3, voffB); PG8_STAGE(PG8_SB(1, 1), b3 + hstepB, voffB); PG8_STAGE(PG8_SA(1, 0), a3, voffA);
            PG8_WAIT_V(8); PG8_WAIT_L(0); PG8_BAR; PG8_MMA(1, 0, At, B0); PG8_MMA(1, 1, At, B1); PG8_BAR; PG8_SCHED;
            } else {
            PG8_LDB(B0, 0, 0); PG8_SCHED; PG8_LDA(At, 0, 0); PG8_STAGE(PG8_SA(1, 1), a1 + hstepA, voffA);
            PG8_WAIT_L(8); PG8_BAR; PG8_WAIT_L(0); PG8_MMA(0, 0, At, B0); PG8_BAR; PG8_SCHED;
            PG8_LDB(B1, 0, 1); PG8_STAGE(PG8_SB(0, 0), b2, voffB);
            PG8_BAR; PG8_WAIT_L(0); PG8_MMA(0, 1, At, B1); PG8_BAR;
            PG8_LDA(At, 0, 1); PG8_STAGE(PG8_SA(0, 0), a2, voffA);
            PG8_BAR; PG8_WAIT_L(0); PG8_MMA(1, 0, At, B0); PG8_BAR; PG8_SCHED;
            PG8_STAGE(PG8_SB(0, 1), b2 + hstepB, voffB);
            PG8_WAIT_V(6); PG8_BAR; PG8_MMA(1, 1, At, B1); PG8_BAR;
            PG8_LDB(B0, 1, 0); PG8_SCHED; PG8_LDA(At, 1, 0); PG8_STAGE(PG8_SA(0, 1), a2 + hstepA, voffA);
            PG8_WAIT_L(8); PG8_BAR; PG8_WAIT_L(0); PG8_MMA(0, 0, At, B0); PG8_BAR; PG8_SCHED;
            PG8_LDB(B1, 1, 1); PG8_STAGE(PG8_SB(1, 0), b3, voffB);
            PG8_BAR; PG8_WAIT_L(0); PG8_MMA(0, 1, At, B1); PG8_BAR;
            PG8_LDA(At, 1, 1); PG8_STAGE(PG8_SA(1, 0), a3, voffA);
            PG8_BAR; PG8_WAIT_L(0); PG8_MMA(1, 0, At, B0); PG8_BAR; PG8_SCHED;
            PG8_STAGE(PG8_SB(1, 1), b3 + hstepB, voffB);
            PG8_WAIT_V(6); PG8_BAR; PG8_MMA(1, 1, At, B1); PG8_BAR;
            }
        }
        if constexpr (ALIGN_EPI) { if (wr == 0) PG8_BAR; }
        E(acc, cur, wr, wc, fr, fq); S.done(cur);
        if (!has_next) break;
#pragma unroll
        for (int a = 0; a < 2; ++a)
#pragma unroll
            for (int b = 0; b < 2; ++b)
#pragma unroll
                for (int m = 0; m < 4; ++m)
#pragma unroll
                    for (int n = 0; n < 2; ++n) acc[a][b][m][n] = (f32x4){0.f, 0.f, 0.f, 0.f};
        cur = nxt; cA = nA; cB = nB; ++ui;
        if constexpr (ALIGN_EPI) { if (wr == 1) PG8_BAR; }
    }
    PG8_WAIT_V(0);
    if constexpr (!ALIGN_EPI) { if (wr == 0) PG8_BAR; }
    PG8_BAR;
#undef PG8_SA
#undef PG8_SB
#undef PG8_STAGE
#undef PG8_LDA
#undef PG8_LDB
#undef PG8_MMA
#undef PG8_WAIT_V
#undef PG8_WAIT_L
#undef PG8_BAR
#undef PG8_SCHED
}
}

constexpr int NWAVES = 8, NTHR = NWAVES * 64;
constexpr int D = 1024, NBATCH = 4, T = 8192, M = NBATCH * T;
constexpr int A_W = 512, A_IN = 1792, IN_COLS = 3344, NP = 3584;
constexpr int C_R = 0, C_K = 512, C_V = 1024, C_WD = 1536, C_AD = 1600, C_GD = 1664;
constexpr int C_BQ = 1792, C_BK = 2048, C_BV = 2304, C_GKD = 2816, C_BG = 2832;
constexpr int NQ = 2048;
constexpr float LN_EPS = 1e-5f, GN_EPS = 64e-5f, RMS_EPS = 1e-5f;
constexpr float ALPHA = 1.189207115002721f;

typedef unsigned short bf16;
typedef float f32x4 __attribute__((ext_vector_type(4)));
typedef unsigned u32x4 __attribute__((ext_vector_type(4)));
typedef unsigned u32x2 __attribute__((ext_vector_type(2)));
#define LAS __attribute__((address_space(3)))

constexpr size_t MiB = 1u << 20;
constexpr size_t WS_WIN = 1 * MiB, WS_WOUT = 8 * MiB, WS_WQ = 10 * MiB, WS_KBD = 14 * MiB;
constexpr size_t WS_H0 = 16 * MiB;
constexpr size_t WS_P = 80 * MiB;
constexpr size_t WS_WL = 304 * MiB, WS_AA = 336 * MiB, WS_GG = 368 * MiB;
constexpr size_t WS_GK = 400 * MiB;
constexpr size_t WS_MIX = 416 * MiB;
constexpr size_t WS_Z = 80 * MiB;
constexpr size_t WS_H1 = 208 * MiB;
constexpr size_t WS_Q = 272 * MiB;
constexpr size_t WS_S = 80 * MiB;
constexpr size_t WS_IDS = 400 * MiB, WS_GATES = 416 * MiB;
constexpr size_t WS_UT = 432 * MiB, WS_VT = 448 * MiB;
constexpr size_t WS_SU = 464 * MiB, WS_SV = 465 * MiB;
constexpr int NSEG = 16, LSEG = 8192 / NSEG;
constexpr size_t WS_YI = WS_WL;
constexpr size_t WS_YIG = WS_GK;
constexpr size_t WS_SER = 480 * MiB;
constexpr size_t WS_SEG = 496 * MiB;
constexpr size_t WS_CEND = 504 * MiB;
constexpr size_t WS_END = 505 * MiB;

constexpr int LDS_BYTES = 147456, LDS_MISC = LDS_BYTES - 256;
constexpr size_t WS_CTL = 0, CTL_BYTES = 16384;

struct Params {
    const float* in[28];
    float* out; unsigned char* ws;
    int ph_lo, ph_hi;
};

__device__ __forceinline__ float bf2f(unsigned u) { return __uint_as_float(u << 16); }
__device__ __forceinline__ unsigned f2bf(float f) { unsigned u = __float_as_uint(f); return (u + 0x7fffu + ((u >> 16) & 1u)) >> 16; }
__device__ __forceinline__ unsigned pk2(float lo, float hi) { return f2bf(lo) | (f2bf(hi) << 16); }
#define DPP_F(v, ctrl) __builtin_bit_cast(float, __builtin_amdgcn_update_dpp(0, __builtin_bit_cast(int, (v)), (ctrl), 0xf, 0xf, false))
#define DPP_ADD(v, ctrl) ((v) + DPP_F(v, ctrl))
__device__ __forceinline__ float rlf(float v, int l) { return __builtin_bit_cast(float, __builtin_amdgcn_readlane(__builtin_bit_cast(int, v), l)); }
__device__ __forceinline__ float wave_sum_u(float v) {
    v = DPP_ADD(v, 0xB1); v = DPP_ADD(v, 0x4E); v = DPP_ADD(v, 0x141); v = DPP_ADD(v, 0x140);
    return (rlf(v, 0) + rlf(v, 16)) + (rlf(v, 32) + rlf(v, 48));
}
__device__ __forceinline__ float wave_sum(float v) { return wave_sum_u(v); }
#define DPP_I(v, ctrl) __builtin_amdgcn_update_dpp(0, (v), (ctrl), 0xf, 0xf, false)
__device__ __forceinline__ int wave_sum_i(int v) {
    v += DPP_I(v, 0xB1); v += DPP_I(v, 0x4E); v += DPP_I(v, 0x141); v += DPP_I(v, 0x140);
    return (__builtin_amdgcn_readlane(v, 0) + __builtin_amdgcn_readlane(v, 16)) + (__builtin_amdgcn_readlane(v, 32) + __builtin_amdgcn_readlane(v, 48));
}
__device__ __forceinline__ float wave_max_u(float v) {
    v = fmaxf(v, DPP_F(v, 0xB1)); v = fmaxf(v, DPP_F(v, 0x4E)); v = fmaxf(v, DPP_F(v, 0x141)); v = fmaxf(v, DPP_F(v, 0x140));
    return fmaxf(fmaxf(rlf(v, 0), rlf(v, 16)), fmaxf(rlf(v, 32), rlf(v, 48)));
}
__device__ __forceinline__ unsigned pack_i8(float a, float b, float c, float d, float inv, int off) {
    const int q0 = __float2int_rn(a * inv) + off, q1 = __float2int_rn(b * inv) + off, q2 = __float2int_rn(c * inv) + off, q3 = __float2int_rn(d * inv) + off;
    return (unsigned)(q0 & 0xff) | ((unsigned)(q1 & 0xff) << 8) | ((unsigned)(q2 & 0xff) << 16) | ((unsigned)(q3 & 0xff) << 24);
}
__device__ __forceinline__ float sigmoidf_(float x) { return 1.f / (1.f + __expf(-x)); }
__device__ __forceinline__ float softplusf_(float x) { return fmaxf(x, 0.f) + log1pf(__expf(-fabsf(x))); }
__device__ __forceinline__ float siluf_(float x) { return x * sigmoidf_(x); }

__device__ __forceinline__ void transpose_convert(const float* W, int K, int N, int Npad, bf16* WT, int gtid, int gthreads) {
    const int kc = K / 8, total = Npad * kc;
    for (int idx = gtid; idx < total; idx += gthreads) {
        const int n = idx % Npad, c = idx / Npad; float v[8];
#pragma unroll
        for (int j = 0; j < 8; ++j) v[j] = (n < N) ? W[(size_t)(8 * c + j) * N + n] : 0.f;
        u32x4 o; o.x = pk2(v[0], v[1]); o.y = pk2(v[2], v[3]); o.z = pk2(v[4], v[5]); o.w = pk2(v[6], v[7]);
        *(u32x4*)(WT + (size_t)n * K + 8 * c) = o;
    }
}
__device__ __forceinline__ void ln_row_bf16(const float* xrow, const float* g, const float* b, bf16* orow, int lane) {
    const f32x4* xr = (const f32x4*)xrow + lane; f32x4 v[4]; float s = 0.f;
#pragma unroll
    for (int j = 0; j < 4; ++j) { v[j] = xr[64 * j]; s += (v[j][0] + v[j][1]) + (v[j][2] + v[j][3]); }
    const float mean = wave_sum(s) * (1.f / D); float s2 = 0.f;
#pragma unroll
    for (int j = 0; j < 4; ++j) { v[j] = v[j] - mean; s2 += (v[j][0] * v[j][0] + v[j][1] * v[j][1]) + (v[j][2] * v[j][2] + v[j][3] * v[j][3]); }
    const float rstd = 1.f / sqrtf(wave_sum(s2) * (1.f / D) + LN_EPS);
    u32x2* o8 = (u32x2*)orow + lane;
#pragma unroll
    for (int j = 0; j < 4; ++j) { const f32x4 gg = ((const f32x4*)g)[lane + 64 * j], bb = ((const f32x4*)b)[lane + 64 * j]; const f32x4 y = v[j] * rstd * gg + bb;
        u32x2 w; w.x = pk2(y[0], y[1]); w.y = pk2(y[2], y[3]); o8[64 * j] = w; }
}
__device__ __forceinline__ void phase_prologue(const Params& P) {
    const int tid = threadIdx.x, lane = tid & 63, wave = tid >> 6;
    const int gtid = blockIdx.x * NTHR + tid, gthreads = gridDim.x * NTHR;
    unsigned char* ws = P.ws;
    transpose_convert(P.in[3], D, IN_COLS, NP, (bf16*)(ws + WS_WIN), gtid, gthreads);
    transpose_convert(P.in[19], D, D, D, (bf16*)(ws + WS_WOUT), gtid, gthreads);
    transpose_convert(P.in[22], D, NQ, NQ, (bf16*)(ws + WS_WQ), gtid, gthreads);
    {
        const float* keys = P.in[23]; bf16* kbd = (bf16*)(ws + WS_KBD);
        for (int idx = gtid; idx < 8 * 256 * 32; idx += gthreads) {
            const int kc = idx & 31, n = (idx >> 5) & 255, h = idx >> 13; const int k0 = kc * 8, hn = n >> 7, key = n & 127, hk = k0 >> 7, c0 = k0 & 127;
            u32x4 o = (u32x4){0u, 0u, 0u, 0u};
            if (hn == hk) { const float* s = keys + ((size_t)((h * 2 + hn) * 128 + key)) * 128 + c0; o.x = pk2(s[0], s[1]); o.y = pk2(s[2], s[3]); o.z = pk2(s[4], s[5]); o.w = pk2(s[6], s[7]); }
            *(u32x4*)(kbd + ((size_t)(h * 256 + n)) * 256 + k0) = o;
        }
    }
    const int gw = blockIdx.x * NWAVES + wave, ngw = gridDim.x * NWAVES;
    for (int m = gw; m < M; m += ngw) ln_row_bf16(P.in[0] + (size_t)m * D, P.in[1], P.in[2], (bf16*)(ws + WS_H0) + (size_t)m * D, lane);
}

__device__ __forceinline__ void phase_prep(const Params& P, LAS unsigned char* lds) {
    const int tid = threadIdx.x;
    unsigned char* ws = P.ws;
    const bf16* p = (const bf16*)(ws + WS_P);
    const float* mu = P.in[4]; const float* w0 = P.in[5]; const float* w2 = P.in[6]; const float* a0 = P.in[7]; const float* a2 = P.in[8]; const float* g2 = P.in[9];
    const float* gkw2 = P.in[16]; const float* gkb = P.in[17];
    bf16* WL = (bf16*)(ws + WS_WL); bf16* AA = (bf16*)(ws + WS_AA); bf16* GG = (bf16*)(ws + WS_GG); bf16* GK = (bf16*)(ws + WS_GK);
    LAS float* act = (LAS float*)lds;
    LAS float* gkd = (LAS float*)(lds + 64 * 260 * 4);
    constexpr int AS = 260;
    for (int tile = blockIdx.x; tile < M / 64; tile += gridDim.x) {
        const int m0 = tile * 64;
        __syncthreads();
        for (int idx = tid; idx < 64 * 256; idx += NTHR) {
            const int j = idx & 255, tok = idx >> 8, m = m0 + tok, t = m & (T - 1);
            const float cur = bf2f(p[(size_t)m * NP + C_WD + j]);
            const float prev = (t > 0) ? bf2f(p[(size_t)(m - 1) * NP + C_WD + j]) : 0.f;
            const float x = cur + (prev - cur) * mu[C_WD + j];
            float v;
            if (j < 64) v = tanhf(x); else if (j < 128) v = x; else v = sigmoidf_(x);
            act[tok * AS + j] = v;
        }
        for (int idx = tid; idx < 64 * 16; idx += NTHR) { const int j = idx & 15, tok = idx >> 4; gkd[tok * 16 + j] = bf2f(p[(size_t)(m0 + tok) * NP + C_GKD + j]); }
        __syncthreads();
        const int c = tid;
        float acc[64];
#pragma unroll
        for (int i = 0; i < 64; ++i) acc[i] = 0.f;
        for (int j = 0; j < 64; j += 4) {
            const float x0 = w2[(j + 0) * A_W + c], x1 = w2[(j + 1) * A_W + c], x2 = w2[(j + 2) * A_W + c], x3 = w2[(j + 3) * A_W + c];
#pragma unroll
            for (int i = 0; i < 64; ++i) { const f32x4 a = *(const LAS f32x4*)(act + i * AS + j); acc[i] += a[0] * x0 + a[1] * x1 + a[2] * x2 + a[3] * x3; }
        }
        { const float b0 = w0[c];
#pragma unroll
          for (int i = 0; i < 64; ++i) { const float z = b0 + acc[i]; const float w = -softplusf_(-z) - 0.5f; WL[(size_t)(m0 + i) * A_W + c] = (bf16)f2bf(-__expf(w)); } }
#pragma unroll
        for (int i = 0; i < 64; ++i) acc[i] = 0.f;
        for (int j = 0; j < 64; j += 4) {
            const float x0 = a2[(j + 0) * A_W + c], x1 = a2[(j + 1) * A_W + c], x2 = a2[(j + 2) * A_W + c], x3 = a2[(j + 3) * A_W + c];
#pragma unroll
            for (int i = 0; i < 64; ++i) { const f32x4 a = *(const LAS f32x4*)(act + i * AS + 64 + j); acc[i] += a[0] * x0 + a[1] * x1 + a[2] * x2 + a[3] * x3; }
        }
        { const float b0 = a0[c];
#pragma unroll
          for (int i = 0; i < 64; ++i) AA[(size_t)(m0 + i) * A_W + c] = (bf16)f2bf(sigmoidf_(b0 + acc[i])); }
#pragma unroll
        for (int i = 0; i < 64; ++i) acc[i] = 0.f;
        for (int j = 0; j < 128; j += 4) {
            const float x0 = g2[(j + 0) * A_W + c], x1 = g2[(j + 1) * A_W + c], x2 = g2[(j + 2) * A_W + c], x3 = g2[(j + 3) * A_W + c];
#pragma unroll
            for (int i = 0; i < 64; ++i) { const f32x4 a = *(const LAS f32x4*)(act + i * AS + 128 + j); acc[i] += a[0] * x0 + a[1] * x1 + a[2] * x2 + a[3] * x3; }
        }
#pragma unroll
        for (int i = 0; i < 64; ++i) GG[(size_t)(m0 + i) * A_W + c] = (bf16)f2bf(acc[i]);
        { const int cc = tid & 255, th = tid >> 8; float wv[16];
#pragma unroll
          for (int j = 0; j < 16; ++j) wv[j] = gkw2[j * 256 + cc];
          const float bb = gkb[cc];
          for (int i = 0; i < 32; ++i) { const int tok = th * 32 + i; float s = bb;
#pragma unroll
              for (int j = 0; j < 16; ++j) s += gkd[tok * 16 + j] * wv[j];
              GK[(size_t)(m0 + tok) * 256 + cc] = (bf16)f2bf(-softplusf_(-s) * (1.f / 16.f)); } }
    }
}

constexpr int CH = 32;
__device__ __forceinline__ float red8(float v) { v = DPP_ADD(v, 0xB1); v = DPP_ADD(v, 0x4E); v = DPP_ADD(v, 0x141); return v; }
__device__ __forceinline__ float red4(float v) { v = DPP_ADD(v, 0xB1); v = DPP_ADD(v, 0x4E); return v; }

constexpr int RW_BUF = 6 * CH * 64;
__device__ __forceinline__ void rw_load(const bf16* p, const bf16* AA, const bf16* WL, int b, int t0, int col, int wave,
        unsigned (&rc)[4], unsigned (&kc)[4], unsigned (&vc)[4], unsigned (&rp)[4], unsigned (&kp)[4], unsigned (&vp)[4], unsigned (&a)[4], unsigned (&wl)[4]) {
#pragma unroll
    for (int q = 0; q < 4; ++q) {
        const int t = t0 + wave + 8 * q; const size_t m = (size_t)b * T + t; const bf16* pr = p + m * NP; const bf16* pp = (t > 0) ? pr - NP : pr;
        rc[q] = pr[C_R + col]; kc[q] = pr[C_K + col]; vc[q] = pr[C_V + col]; rp[q] = pp[C_R + col]; kp[q] = pp[C_K + col]; vp[q] = pp[C_V + col];
        a[q] = AA[m * A_W + col]; wl[q] = WL[m * A_W + col];
    }
}
__device__ __forceinline__ void rw_prep(LAS float* B, int t0, int wave, int lane, float mu_r, float mu_k, float mu_v, float kkc, float kac,
        const unsigned (&rc_)[4], const unsigned (&kc_)[4], const unsigned (&vc_)[4], const unsigned (&rp_)[4], const unsigned (&kp_)[4], const unsigned (&vp_)[4], const unsigned (&a_)[4], const unsigned (&wl_)[4]) {
    LAS float* R = B; LAS float* DEC = R + CH * 64; LAS float* KH = DEC + CH * 64; LAS float* KK = KH + CH * 64; LAS float* BB = KK + CH * 64; LAS float* V = BB + CH * 64;
#pragma unroll
    for (int q = 0; q < 4; ++q) {
        const int tt = wave + 8 * q; const float hp = (t0 + tt > 0) ? 1.f : 0.f;
        const float rc = bf2f(rc_[q]), kc = bf2f(kc_[q]), vc = bf2f(vc_[q]), rp = bf2f(rp_[q]) * hp, kp = bf2f(kp_[q]) * hp, vp = bf2f(vp_[q]) * hp;
        const float r = rc + (rp - rc) * mu_r, k = kc + (kp - kc) * mu_k, v = vc + (vp - vc) * mu_v;
        const float a = bf2f(a_[q]), wl = bf2f(wl_[q]);
        const float kr = k * kkc; const float nrm = sqrtf(wave_sum(kr * kr)); const float kk = kr / fmaxf(nrm, 1e-12f);
        const float kh = k * (1.f + (a - 1.f) * kac);
        R[tt * 64 + lane] = r; DEC[tt * 64 + lane] = __expf(wl); KH[tt * 64 + lane] = kh; KK[tt * 64 + lane] = kk; BB[tt * 64 + lane] = kk * a; V[tt * 64 + lane] = v;
    }
}
__device__ __forceinline__ void rwkv_item(const Params& P, LAS unsigned char* lds, int b, int h, int seg) {
    const int tid = threadIdx.x, lane = tid & 63, wave = tid >> 6;
    unsigned char* ws = P.ws;
    const bf16* p = (const bf16*)(ws + WS_P); const bf16* WL = (const bf16*)(ws + WS_WL); const bf16* AA = (const bf16*)(ws + WS_AA);
    bf16* MIX = (bf16*)(ws + WS_MIX); bf16* YI = (bf16*)(ws + WS_YI);
    const float* mu = P.in[4]; const float* k_k = P.in[10]; const float* k_a = P.in[11];
    LAS float* BUF = (LAS float*)lds; LAS float* Y = BUF + 2 * RW_BUF;
    const int col = h * 64 + lane;
    const float mu_r = mu[C_R + col], mu_k = mu[C_K + col], mu_v = mu[C_V + col], kkc = k_k[col], kac = k_a[col];
    const int row = wave * 16 + (lane >> 2), ks = (lane & 3) * 16; const int ident = row >> 6, vrow = row & 63;
    float* SE = (float*)(ws + WS_SER) + ((((size_t)(b * 8 + h) * NSEG + seg) * 2 + ident) * 4096) + vrow * 64 + ks;
    float S[16];
#pragma unroll
    for (int j = 0; j < 16; ++j) S[j] = (ident && (ks + j == vrow)) ? 1.f : 0.f;
    const float vmask = ident ? 0.f : 1.f;
    const int tbeg = seg * LSEG;
    unsigned rc[4], kc[4], vc[4], rp[4], kp[4], vp[4], a[4], wl[4];
    __syncthreads();
    rw_load(p, AA, WL, b, tbeg, col, wave, rc, kc, vc, rp, kp, vp, a, wl);
    rw_prep(BUF, tbeg, wave, lane, mu_r, mu_k, mu_v, kkc, kac, rc, kc, vc, rp, kp, vp, a, wl);
    __syncthreads();
    for (int ci = 0; ci < LSEG / CH; ++ci) {
        const int t0 = tbeg + ci * CH; LAS float* B = BUF + (ci & 1) * RW_BUF;
        LAS float* R = B; LAS float* DEC = R + CH * 64; LAS float* KH = DEC + CH * 64; LAS float* KK = KH + CH * 64; LAS float* BB = KK + CH * 64; LAS float* V = BB + CH * 64;
        const bool more = (ci + 1 < LSEG / CH);
        if (more) rw_load(p, AA, WL, b, t0 + CH, col, wave, rc, kc, vc, rp, kp, vp, a, wl);
        for (int tt = 0; tt < CH; ++tt) {
            const float vv = V[tt * 64 + vrow] * vmask;
            float sa0 = 0.f, sa1 = 0.f;
#pragma unroll
            for (int q4 = 0; q4 < 4; ++q4) { const f32x4 kq = *(const LAS f32x4*)(KK + tt * 64 + ks + 4 * q4);
#pragma unroll
                for (int j = 0; j < 4; ++j) { if (q4 & 1) sa1 += S[4 * q4 + j] * kq[j]; else sa0 += S[4 * q4 + j] * kq[j]; } }
            const float sa = -red4(sa0 + sa1);
            float y0 = 0.f, y1 = 0.f;
#pragma unroll
            for (int q4 = 0; q4 < 4; ++q4) {
                const f32x4 dq = *(const LAS f32x4*)(DEC + tt * 64 + ks + 4 * q4), bq = *(const LAS f32x4*)(BB + tt * 64 + ks + 4 * q4), hq = *(const LAS f32x4*)(KH + tt * 64 + ks + 4 * q4), rq = *(const LAS f32x4*)(R + tt * 64 + ks + 4 * q4);
#pragma unroll
                for (int j = 0; j < 4; ++j) { S[4 * q4 + j] = S[4 * q4 + j] * dq[j] + sa * bq[j] + vv * hq[j]; if (q4 & 1) y1 += S[4 * q4 + j] * rq[j]; else y0 += S[4 * q4 + j] * rq[j]; }
            }
            const float y = red4(y0 + y1);
            if ((lane & 3) == 0) Y[tt * 128 + row] = y;
        }
        __syncthreads();
        if (more) rw_prep(BUF + ((ci + 1) & 1) * RW_BUF, t0 + CH, wave, lane, mu_r, mu_k, mu_v, kkc, kac, rc, kc, vc, rp, kp, vp, a, wl);
#pragma unroll
        for (int q = 0; q < 4; ++q) {
            const int tt = wave + 8 * q; const size_t m = (size_t)b * T + t0 + tt;
            MIX[m * D + col] = (bf16)f2bf(Y[tt * 128 + lane]); YI[m * 512 + col] = (bf16)f2bf(Y[tt * 128 + 64 + lane]);
        }
        __syncthreads();
    }
#pragma unroll
    for (int q4 = 0; q4 < 4; ++q4) *(f32x4*)(SE + 4 * q4) = (f32x4){S[4 * q4], S[4 * q4 + 1], S[4 * q4 + 2], S[4 * q4 + 3]};
}

constexpr int GL_BUF = 3 * CH * 64 + CH * 128;
__device__ __forceinline__ void gl_load(const bf16* p, const bf16* GK, int b, int h, int t0, int lane, int wave, unsigned (&x)[4][4][4], unsigned (&gk)[4]) {
    const int cq = h * 64 + lane, ck = 256 + h * 64 + lane, cv0 = 512 + h * 128 + lane, cv1 = cv0 + 64;
#pragma unroll
    for (int q = 0; q < 4; ++q) {
        const int t = t0 + wave + 8 * q; const size_t m = (size_t)b * T + t;
#pragma unroll
        for (int j = 0; j < 4; ++j) { const int back = 3 - j; const bf16* pr = p + (m - (size_t)((t >= back) ? back : 0)) * NP + C_BQ;
            x[q][j][0] = pr[cq]; x[q][j][1] = pr[ck]; x[q][j][2] = pr[cv0]; x[q][j][3] = pr[cv1]; }
        gk[q] = GK[m * 256 + h * 64 + lane];
    }
}
__device__ __forceinline__ void gl_prep(LAS float* B, int t0, int wave, int lane, const float (&wq)[4], const float (&wk)[4], const float (&wv0)[4], const float (&wv1)[4],
        const unsigned (&x)[4][4][4], const unsigned (&gk)[4]) {
    LAS float* Q = B; LAS float* K = Q + CH * 64; LAS float* DEC = K + CH * 64; LAS float* V = DEC + CH * 64;
#pragma unroll
    for (int q = 0; q < 4; ++q) {
        const int tt = wave + 8 * q, t = t0 + tt; float aq = 0.f, ak = 0.f, av0 = 0.f, av1 = 0.f;
#pragma unroll
        for (int j = 0; j < 4; ++j) { const float ok = (t >= 3 - j) ? 1.f : 0.f;
            aq += wq[j] * ok * bf2f(x[q][j][0]); ak += wk[j] * ok * bf2f(x[q][j][1]); av0 += wv0[j] * ok * bf2f(x[q][j][2]); av1 += wv1[j] * ok * bf2f(x[q][j][3]); }
        Q[tt * 64 + lane] = siluf_(aq) * 0.125f; K[tt * 64 + lane] = siluf_(ak); V[tt * 128 + lane] = siluf_(av0); V[tt * 128 + 64 + lane] = siluf_(av1);
        DEC[tt * 64 + lane] = __expf(bf2f(gk[q]));
    }
}
__device__ __forceinline__ void gla_item(const Params& P, LAS unsigned char* lds, int b, int h, int seg) {
    const int tid = threadIdx.x, lane = tid & 63, wave = tid >> 6;
    unsigned char* ws = P.ws;
    const bf16* p = (const bf16*)(ws + WS_P); const bf16* GK = (const bf16*)(ws + WS_GK);
    bf16* MIX = (bf16*)(ws + WS_MIX); bf16* YIG = (bf16*)(ws + WS_YIG);
    float* SE = (float*)(ws + WS_SEG) + ((size_t)(b * 4 + h) * NSEG + seg) * 8192; float* CE = (float*)(ws + WS_CEND) + ((size_t)(b * 4 + h) * NSEG + seg) * 64;
    const float* conv = P.in[15];
    LAS float* BUF = (LAS float*)lds; LAS float* O = BUF + 2 * GL_BUF; LAS float* YL = O + CH * 128;
    const int cq = h * 64 + lane, ck = 256 + h * 64 + lane, cv0 = 512 + h * 128 + lane, cv1 = cv0 + 64;
    float wq[4], wk[4], wv0[4], wv1[4];
#pragma unroll
    for (int j = 0; j < 4; ++j) { wq[j] = conv[j * 1024 + cq]; wk[j] = conv[j * 1024 + ck]; wv0[j] = conv[j * 1024 + cv0]; wv1[j] = conv[j * 1024 + cv1]; }
    float S[16], c[16];
#pragma unroll
    for (int j = 0; j < 16; ++j) { S[j] = 0.f; c[j] = 1.f; }
    const int row = wave * 16 + (lane >> 2), ks = (lane & 3) * 16;
    const int tbeg = seg * LSEG;
    unsigned x[4][4][4], gk[4];
    __syncthreads();
    gl_load(p, GK, b, h, tbeg, lane, wave, x, gk);
    gl_prep(BUF, tbeg, wave, lane, wq, wk, wv0, wv1, x, gk);
    __syncthreads();
    for (int ci = 0; ci < LSEG / CH; ++ci) {
        const int t0 = tbeg + ci * CH; LAS float* B = BUF + (ci & 1) * GL_BUF;
        LAS float* Q = B; LAS float* K = Q + CH * 64; LAS float* DEC = K + CH * 64; LAS float* V = DEC + CH * 64;
        const bool more = (ci + 1 < LSEG / CH);
        if (more) gl_load(p, GK, b, h, t0 + CH, lane, wave, x, gk);
        for (int tt = 0; tt < CH; ++tt) {
            const float vv = V[tt * 128 + row]; float o0 = 0.f, o1 = 0.f;
#pragma unroll
            for (int q4 = 0; q4 < 4; ++q4) {
                const f32x4 kk = *(const LAS f32x4*)(K + tt * 64 + ks + 4 * q4), dd = *(const LAS f32x4*)(DEC + tt * 64 + ks + 4 * q4), qq = *(const LAS f32x4*)(Q + tt * 64 + ks + 4 * q4);
#pragma unroll
                for (int j = 0; j < 4; ++j) { S[4 * q4 + j] = S[4 * q4 + j] * dd[j] + vv * kk[j]; if (q4 & 1) o1 += S[4 * q4 + j] * qq[j]; else o0 += S[4 * q4 + j] * qq[j]; }
                if (wave == 0) { f32x4 yi;
#pragma unroll
                    for (int j = 0; j < 4; ++j) { c[4 * q4 + j] *= dd[j]; yi[j] = c[4 * q4 + j] * qq[j]; }
                    if (lane < 4) *(LAS f32x4*)(YL + tt * 64 + ks + 4 * q4) = yi; }
            }
            const float o = red4(o0 + o1);
            if ((lane & 3) == 0) O[tt * 128 + row] = o;
        }
        __syncthreads();
        if (more) gl_prep(BUF + ((ci + 1) & 1) * GL_BUF, t0 + CH, wave, lane, wq, wk, wv0, wv1, x, gk);
#pragma unroll
        for (int q = 0; q < 4; ++q) {
            const int tt = wave + 8 * q; const size_t m = (size_t)b * T + t0 + tt;
            MIX[m * D + 512 + h * 128 + lane] = (bf16)f2bf(O[tt * 128 + lane]); MIX[m * D + 512 + h * 128 + 64 + lane] = (bf16)f2bf(O[tt * 128 + 64 + lane]);
            YIG[m * 256 + h * 64 + lane] = (bf16)f2bf(YL[tt * 64 + lane]);
        }
        __syncthreads();
    }
#pragma unroll
    for (int q4 = 0; q4 < 4; ++q4) *(f32x4*)(SE + row * 64 + ks + 4 * q4) = (f32x4){S[4 * q4], S[4 * q4 + 1], S[4 * q4 + 2], S[4 * q4 + 3]};
    if (wave == 0 && lane < 4) {
#pragma unroll
        for (int q4 = 0; q4 < 4; ++q4) *(f32x4*)(CE + ks + 4 * q4) = (f32x4){c[4 * q4], c[4 * q4 + 1], c[4 * q4 + 2], c[4 * q4 + 3]};
    }
}
__device__ __forceinline__ void phase_scan(const Params& P, LAS unsigned char* lds) {
    for (int it = blockIdx.x; it < 512 + 256; it += gridDim.x) {
        if (it < 512) { const int bh = it >> 4; rwkv_item(P, lds, bh >> 3, bh & 7, it & 15); }
        else { const int g = it - 512, bh = g >> 4; gla_item(P, lds, bh >> 2, bh & 3, g & 15); }
        __syncthreads();
    }
}
__device__ __forceinline__ void phase_fixup(const Params& P, LAS unsigned char* lds) {
    const int tid = threadIdx.x;
    for (int it = blockIdx.x; it < 48; it += gridDim.x) {
        if (it < 32) {
            float* SE = (float*)(P.ws + WS_SER) + (size_t)it * NSEG * 2 * 4096;
            LAS float* Sc = (LAS float*)lds; LAS float* Ph = Sc + 64 * 65;
            const int v = tid >> 3, kq = (tid & 7) * 8;
            __syncthreads();
            for (int i = tid; i < 64 * 65; i += NTHR) Sc[i] = 0.f;
            for (int seg = 0; seg < NSEG - 1; ++seg) {
                float* s0 = SE + (size_t)(seg * 2 + 0) * 4096; const float* ph = SE + (size_t)(seg * 2 + 1) * 4096;
                __syncthreads();
                for (int i = tid; i < 1024; i += NTHR) *(LAS f32x4*)(Ph + 4 * i) = *(const f32x4*)(ph + 4 * i);
                f32x4 a0 = *(const f32x4*)(s0 + v * 64 + kq), a1 = *(const f32x4*)(s0 + v * 64 + kq + 4);
                __syncthreads();
                for (int j = 0; j < 64; ++j) { const float sv = Sc[v * 65 + j]; a0 += *(const LAS f32x4*)(Ph + j * 64 + kq) * sv; a1 += *(const LAS f32x4*)(Ph + j * 64 + kq + 4) * sv; }
                __syncthreads();
#pragma unroll
                for (int i = 0; i < 4; ++i) { Sc[v * 65 + kq + i] = a0[i]; Sc[v * 65 + kq + 4 + i] = a1[i]; }
                *(f32x4*)(s0 + v * 64 + kq) = a0; *(f32x4*)(s0 + v * 64 + kq + 4) = a1;
            }
        } else {
            const int bh = it - 32; float* SE = (float*)(P.ws + WS_SEG) + (size_t)bh * NSEG * 8192; const float* CE = (const float*)(P.ws + WS_CEND) + (size_t)bh * NSEG * 64;
            const int v = tid >> 2, d0 = (tid & 3) * 16; f32x4 sc[4];
#pragma unroll
            for (int q = 0; q < 4; ++q) sc[q] = (f32x4){0.f, 0.f, 0.f, 0.f};
            for (int seg = 0; seg < NSEG - 1; ++seg) {
#pragma unroll
                for (int q = 0; q < 4; ++q) { float* sp = SE + (size_t)seg * 8192 + v * 64 + d0 + 4 * q; sc[q] = sc[q] * *(const f32x4*)(CE + seg * 64 + d0 + 4 * q) + *(const f32x4*)sp; *(f32x4*)sp = sc[q]; }
            }
        }
    }
}
__device__ __forceinline__ void phase_correct(const Params& P, LAS unsigned char* lds) {
    const int tid = threadIdx.x, lane = tid & 63, wave = tid >> 6;
    unsigned char* ws = P.ws;
    const bf16* p = (const bf16*)(ws + WS_P); const bf16* AA = (const bf16*)(ws + WS_AA); const bf16* GG = (const bf16*)(ws + WS_GG);
    bf16* MIX = (bf16*)(ws + WS_MIX); const bf16* YI = (const bf16*)(ws + WS_YI); const bf16* YIG = (const bf16*)(ws + WS_YIG);
    const float* mu = P.in[4]; const float* k_a = P.in[11]; const float* r_k = P.in[12]; const float* gn_g = P.in[13]; const float* gn_b = P.in[14]; const float* norm_g = P.in[18];
    LAS float* SL = (LAS float*)lds;
    for (int it = blockIdx.x; it < 512 + 256; it += gridDim.x) {
        __syncthreads();
        if (it < 512) {
            const int seg = it & 15, bh = it >> 4, b = bh >> 3, h = bh & 7;
            if (seg > 0) { const float* ss = (const float*)(ws + WS_SER) + (((size_t)bh * NSEG + (seg - 1)) * 2) * 4096;
                for (int i = tid; i < 4096; i += NTHR) SL[(i & 63) * 65 + (i >> 6)] = ss[i]; }
            __syncthreads();
            const int col = h * 64 + lane;
            const float mu_r = mu[C_R + col], mu_k = mu[C_K + col], mu_v = mu[C_V + col], kac = k_a[col], rkc = r_k[col], gng = gn_g[col], gnb = gn_b[col];
            for (int i0 = 0; i0 < 64; i0 += 4) {
                float y[4], yi[4], r[4], k[4], v[4], a[4], g[4];
#pragma unroll
                for (int u = 0; u < 4; ++u) {
                    const int t = seg * LSEG + wave * 64 + i0 + u; const size_t m = (size_t)b * T + t; const bf16* pr = p + m * NP; const bf16* pp = (t > 0) ? pr - NP : pr; const float hp = (t > 0) ? 1.f : 0.f;
                    y[u] = bf2f(MIX[m * D + col]); yi[u] = bf2f(YI[m * 512 + col]);
                    const float rc = bf2f(pr[C_R + col]), kc = bf2f(pr[C_K + col]), vc = bf2f(pr[C_V + col]);
                    r[u] = rc + (bf2f(pp[C_R + col]) * hp - rc) * mu_r; k[u] = kc + (bf2f(pp[C_K + col]) * hp - kc) * mu_k; v[u] = vc + (bf2f(pp[C_V + col]) * hp - vc) * mu_v;
                    a[u] = bf2f(AA[m * A_W + col]); g[u] = bf2f(GG[m * A_W + col]);
                }
                if (seg > 0) {
                    for (int j = 0; j < 64; ++j) { const float sv = SL[j * 65 + lane];
#pragma unroll
                        for (int u = 0; u < 4; ++u) y[u] += rlf(yi[u], j) * sv; }
                }
#pragma unroll
                for (int u = 0; u < 4; ++u) {
                    const size_t m = (size_t)b * T + seg * LSEG + wave * 64 + i0 + u;
                    const float kh = k[u] * (1.f + (a[u] - 1.f) * kac); const float bon = wave_sum(r[u] * kh * rkc);
                    const float mean = wave_sum(y[u]) * (1.f / 64.f); const float d = y[u] - mean; const float var = wave_sum(d * d) * (1.f / 64.f);
                    float o = d * (1.f / sqrtf(var + GN_EPS)) * gng + gnb; o += bon * v[u]; o *= g[u];
                    MIX[m * D + col] = (bf16)f2bf(o);
                }
            }
        } else {
            const int g_ = it - 512, seg = g_ & 15, bh = g_ >> 4, b = bh >> 2, h = bh & 3;
            if (seg > 0) { const float* ss = (const float*)(ws + WS_SEG) + ((size_t)bh * NSEG + (seg - 1)) * 8192;
                for (int i = tid; i < 8192; i += NTHR) SL[(i & 63) * 129 + (i >> 6)] = ss[i]; }
            __syncthreads();
            const float ng0 = norm_g[lane], ng1 = norm_g[lane + 64];
            for (int i0 = 0; i0 < 64; i0 += 4) {
                float o0[4], o1[4], yi[4], g0[4], g1[4];
#pragma unroll
                for (int u = 0; u < 4; ++u) {
                    const size_t m = (size_t)b * T + seg * LSEG + wave * 64 + i0 + u;
                    o0[u] = bf2f(MIX[m * D + 512 + h * 128 + lane]); o1[u] = bf2f(MIX[m * D + 512 + h * 128 + 64 + lane]); yi[u] = bf2f(YIG[m * 256 + h * 64 + lane]);
                    g0[u] = bf2f(p[m * NP + C_BG + h * 128 + lane]); g1[u] = bf2f(p[m * NP + C_BG + h * 128 + 64 + lane]);
                }
                if (seg > 0) {
                    for (int d = 0; d < 64; ++d) { const float s0 = SL[d * 129 + lane], s1 = SL[d * 129 + 64 + lane];
#pragma unroll
                        for (int u = 0; u < 4; ++u) { const float q = rlf(yi[u], d); o0[u] += q * s0; o1[u] += q * s1; } }
                }
#pragma unroll
                for (int u = 0; u < 4; ++u) {
                    const size_t m = (size_t)b * T + seg * LSEG + wave * 64 + i0 + u;
                    const float ms = wave_sum(o0[u] * o0[u] + o1[u] * o1[u]) * (1.f / 128.f); const float rs = 1.f / sqrtf(ms + RMS_EPS);
                    MIX[m * D + 512 + h * 128 + lane] = (bf16)f2bf(o0[u] * rs * ng0 * siluf_(g0[u])); MIX[m * D + 512 + h * 128 + 64 + lane] = (bf16)f2bf(o1[u] * rs * ng1 * siluf_(g1[u]));
                }
            }
        }
    }
}

__device__ __forceinline__ void phase_ln1(const Params& P) {
    const int lane = threadIdx.x & 63, wave = threadIdx.x >> 6; const int gw = blockIdx.x * NWAVES + wave, ngw = gridDim.x * NWAVES;
    for (int m = gw; m < M; m += ngw) ln_row_bf16((const float*)(P.ws + WS_Z) + (size_t)m * D, P.in[20], P.in[21], (bf16*)(P.ws + WS_H1) + (size_t)m * D, lane);
#pragma unroll
    for (int tb = 0; tb < 2; ++tb) {
        const float* src = P.in[24 + tb]; unsigned char* dst = P.ws + (tb ? WS_VT : WS_UT); float* sc = (float*)(P.ws + (tb ? WS_SV : WS_SU));
        for (int e = gw; e < 16384; e += ngw) {
            const f32x4* sp = (const f32x4*)(src + (size_t)e * D) + 4 * lane; f32x4 a[4]; float mx = 0.f;
#pragma unroll
            for (int j = 0; j < 4; ++j) { a[j] = sp[j]; mx = fmaxf(fmaxf(mx, fmaxf(fabsf(a[j][0]), fabsf(a[j][1]))), fmaxf(fabsf(a[j][2]), fabsf(a[j][3]))); }
            mx = wave_max_u(mx); const float inv = mx > 0.f ? 127.f / mx : 0.f;
            u32x4 o;
#pragma unroll
            for (int j = 0; j < 4; ++j) o[j] = pack_i8(a[j][0], a[j][1], a[j][2], a[j][3], inv, tb ? 128 : 0);
            *((u32x4*)(dst + (size_t)e * D) + lane) = o;
            if (lane == 0) sc[e] = mx * (1.f / 127.f);
        }
    }
}

#define TK_INS(L, x) do { _Pragma("unroll") for (int _j = 0; _j < 16; ++_j) { const unsigned _h = max(L[_j], x); x = min(L[_j], x); L[_j] = _h; } } while (0)
__device__ __forceinline__ void topk128(const u32x4* r, unsigned (&L)[16]) {
#pragma unroll
    for (int j = 0; j < 16; ++j) L[j] = 0u;
    u32x4 cur = r[0];
    for (int c = 0; c < 16; ++c) {
        const u32x4 nxt = r[(c + 1) & 15];
        const unsigned kb = 0xFFFFu - 8u * (unsigned)c;
#pragma unroll
        for (int d = 0; d < 4; ++d) {
            unsigned w = cur[d]; const unsigned msk = ((w >> 15) & 0x00010001u) * 0xFFFFu; w ^= (msk | 0x80008000u);
            unsigned x0 = (w << 16) | (kb - 2u * d), x1 = (w & 0xFFFF0000u) | (kb - 2u * d - 1u);
            TK_INS(L, x0); TK_INS(L, x1);
        }
        cur = nxt;
    }
}
__device__ __forceinline__ void phase_topk(const Params& P) {
    const int gl = blockIdx.x * NTHR + threadIdx.x, nl = gridDim.x * NTHR;
    const bf16* Sc = (const bf16*)(P.ws + WS_S); int* IDS = (int*)(P.ws + WS_IDS); float* GATES = (float*)(P.ws + WS_GATES);
    for (int item = gl; item < M * 8; item += nl) {
        const u32x4* row = (const u32x4*)(Sc + (size_t)item * 256);
        unsigned L0[16], L1[16];
        topk128(row, L0); topk128(row + 16, L1);
        float f0[16], f1[16]; unsigned p0[16], p1[16];
#pragma unroll
        for (int i = 0; i < 16; ++i) {
            f0[i] = __uint_as_float((L0[i] & 0x80000000u) ? (L0[i] & 0x7FFF0000u) : (~L0[i] & 0xFFFF0000u)); p0[i] = (~L0[i] & 0x7Fu) << 7;
            f1[i] = __uint_as_float((L1[i] & 0x80000000u) ? (L1[i] & 0x7FFF0000u) : (~L1[i] & 0xFFFF0000u)); p1[i] = (~L1[i] & 0x7Fu);
        }
        unsigned C[16];
#pragma unroll
        for (int j = 0; j < 16; ++j) C[j] = 0u;
#pragma unroll
        for (int i = 0; i < 16; ++i)
#pragma unroll
            for (int j = 0; j < 16; ++j)
                if ((i + 1) * (j + 1) <= 16) {
                    const unsigned b = __float_as_uint(f0[i] + f1[j]); const unsigned mono = b ^ ((unsigned)((int)b >> 31) | 0x80000000u);
                    unsigned key = (mono & 0xFFFFC000u) | p0[i] | p1[j];
                    TK_INS(C, key);
                }
        float cv[16];
#pragma unroll
        for (int r = 0; r < 16; ++r) cv[r] = __uint_as_float((C[r] & 0x80000000u) ? (C[r] & 0x7FFFC000u) : (~C[r] & 0xFFFFC000u));
        const float cmax = cv[0]; float den = 0.f;
#pragma unroll
        for (int r = 0; r < 16; ++r) { cv[r] = __expf(cv[r] - cmax); den += cv[r]; }
        const float inv = 1.f / den;
        u32x4* ido = (u32x4*)(IDS + (size_t)item * 16); f32x4* go = (f32x4*)(GATES + (size_t)item * 16);
#pragma unroll
        for (int q = 0; q < 4; ++q) { u32x4 o; o.x = C[4 * q] & 0x3FFFu; o.y = C[4 * q + 1] & 0x3FFFu; o.z = C[4 * q + 2] & 0x3FFFu; o.w = C[4 * q + 3] & 0x3FFFu; ido[q] = o;
            f32x4 g; g[0] = cv[4 * q] * inv; g[1] = cv[4 * q + 1] * inv; g[2] = cv[4 * q + 2] * inv; g[3] = cv[4 * q + 3] * inv; go[q] = g; }
    }
}

typedef __bf16 bf16x2_t __attribute__((ext_vector_type(2)));
__device__ __forceinline__ float dot2bf(unsigned a, unsigned b, float c) { return __builtin_amdgcn_fdot2_f32_bf16(__builtin_bit_cast(bf16x2_t, a), __builtin_bit_cast(bf16x2_t, b), c, false); }
__device__ __forceinline__ void peer_load8(u32x4 (&buf)[8], const unsigned char* TAB, int idreg, int g, int lane) {
#pragma unroll
    for (int q = 0; q < 8; ++q) { const int id = __builtin_amdgcn_readlane(idreg, 8 * g + q); buf[q] = *((const u32x4*)(TAB + (size_t)id * D) + lane); }
}
__device__ __forceinline__ void peer_dots8(const u32x4 (&buf)[8], const u32x4& hq, int g, float& d, int lane) {
#pragma unroll
    for (int q = 0; q < 8; ++q) { int s = 0;
#pragma unroll
        for (int i = 0; i < 4; ++i) s = __builtin_amdgcn_sdot4((int)buf[q][i], (int)hq[i], s, false);
        const int tot = wave_sum_i(s);
        d = (lane == 8 * g + q) ? (float)tot : d; }
}
__device__ __forceinline__ void peer_axpy8(const u32x4 (&buf)[8], float areg, int g, float (&acc)[16]) {
#pragma unroll
    for (int q = 0; q < 8; ++q) { const float a = rlf(areg, 8 * g + q);
#pragma unroll
        for (int i = 0; i < 4; ++i) { const unsigned w = buf[q][i];
            acc[4 * i] += a * (float)(w & 0xffu); acc[4 * i + 1] += a * (float)((w >> 8) & 0xffu); acc[4 * i + 2] += a * (float)((w >> 16) & 0xffu); acc[4 * i + 3] += a * (float)(w >> 24); } }
}
__device__ __forceinline__ void phase_peer(const Params& P) {
    const int lane = threadIdx.x & 63, wave = threadIdx.x >> 6; const int gw = blockIdx.x * NWAVES + wave, ngw = gridDim.x * NWAVES;
    const bf16* H1 = (const bf16*)(P.ws + WS_H1); const int* IDS = (const int*)(P.ws + WS_IDS); const float* GATES = (const float*)(P.ws + WS_GATES);
    const unsigned char* UT = P.ws + WS_UT; const unsigned char* VT = P.ws + WS_VT; const float* SU = (const float*)(P.ws + WS_SU); const float* SV = (const float*)(P.ws + WS_SV);
    const float* g2 = P.in[26]; const float* b2 = P.in[27];
    for (int m = gw; m < M; m += ngw) {
        const u32x4* hp = (const u32x4*)(H1 + (size_t)m * D) + 2 * lane; const u32x4 hA = hp[0], hB = hp[1];
        float hv[16]; float hmx = 0.f;
#pragma unroll
        for (int i = 0; i < 4; ++i) { hv[2 * i] = __uint_as_float(hA[i] << 16); hv[2 * i + 1] = __uint_as_float(hA[i] & 0xffff0000u); hv[8 + 2 * i] = __uint_as_float(hB[i] << 16); hv[8 + 2 * i + 1] = __uint_as_float(hB[i] & 0xffff0000u); }
#pragma unroll
        for (int i = 0; i < 16; ++i) hmx = fmaxf(hmx, fabsf(hv[i]));
        hmx = wave_max_u(hmx); const float hinv = hmx > 0.f ? 127.f / hmx : 0.f, hsc = hmx * (1.f / 127.f);
        u32x4 hq;
#pragma unroll
        for (int i = 0; i < 4; ++i) hq[i] = pack_i8(hv[4 * i], hv[4 * i + 1], hv[4 * i + 2], hv[4 * i + 3], hinv, 0);
        const int id_lo = IDS[(size_t)m * 128 + lane], id_hi = IDS[(size_t)m * 128 + 64 + lane];
        const float gt_lo = GATES[(size_t)m * 128 + lane], gt_hi = GATES[(size_t)m * 128 + 64 + lane];
        const float su_lo = SU[id_lo], su_hi = SU[id_hi], sv_lo = SV[id_lo], sv_hi = SV[id_hi];
        float d_lo = 0.f, d_hi = 0.f;
        u32x4 A0[8], A1[8];
        peer_load8(A0, UT, id_lo, 0, lane);
        for (int g = 0; g < 8; g += 2) {
            peer_load8(A1, UT, id_lo, g + 1, lane); peer_dots8(A0, hq, g, d_lo, lane);
            if (g + 2 < 8) peer_load8(A0, UT, id_lo, g + 2, lane); else peer_load8(A0, UT, id_hi, 0, lane);
            peer_dots8(A1, hq, g + 1, d_lo, lane);
        }
        for (int g = 0; g < 8; g += 2) {
            peer_load8(A1, UT, id_hi, g + 1, lane); peer_dots8(A0, hq, g, d_hi, lane);
            if (g + 2 < 8) peer_load8(A0, UT, id_hi, g + 2, lane); else peer_load8(A0, VT, id_lo, 0, lane);
            peer_dots8(A1, hq, g + 1, d_hi, lane);
        }
        const float x_lo = d_lo * su_lo * hsc, x_hi = d_hi * su_hi * hsc;
        const float a_lo = 0.5f * x_lo * (1.f + erff(x_lo * 0.70710678118f)) * gt_lo * sv_lo, a_hi = 0.5f * x_hi * (1.f + erff(x_hi * 0.70710678118f)) * gt_hi * sv_hi;
        const float c0 = 128.f * wave_sum(a_lo + a_hi);
        float acc[16];
#pragma unroll
        for (int i = 0; i < 16; ++i) acc[i] = 0.f;
        for (int g = 0; g < 8; g += 2) {
            peer_load8(A1, VT, id_lo, g + 1, lane); peer_axpy8(A0, a_lo, g, acc);
            if (g + 2 < 8) peer_load8(A0, VT, id_lo, g + 2, lane); else peer_load8(A0, VT, id_hi, 0, lane);
            peer_axpy8(A1, a_lo, g + 1, acc);
        }
        for (int g = 0; g < 8; g += 2) {
            peer_load8(A1, VT, id_hi, g + 1, lane); peer_axpy8(A0, a_hi, g, acc);
            if (g + 2 < 8) peer_load8(A0, VT, id_hi, g + 2, lane);
            peer_axpy8(A1, a_hi, g + 1, acc);
        }
        float s = 0.f;
#pragma unroll
        for (int i = 0; i < 16; ++i) { acc[i] = ALPHA * hv[i] + (acc[i] - c0); s += acc[i]; }
        const float mean = wave_sum(s) * (1.f / D); float s2 = 0.f;
#pragma unroll
        for (int i = 0; i < 16; ++i) { acc[i] -= mean; s2 += acc[i] * acc[i]; }
        const float rstd = 1.f / sqrtf(wave_sum(s2) * (1.f / D) + LN_EPS);
#pragma unroll
        for (int c4 = 0; c4 < 4; ++c4) { const int e0 = 16 * lane + 4 * c4; const f32x4 gg = *(const f32x4*)(g2 + e0), bb = *(const f32x4*)(b2 + e0); f32x4 o;
#pragma unroll
            for (int j = 0; j < 4; ++j) o[j] = acc[c4 * 4 + j] * rstd * gg[j] + bb[j];
            *(f32x4*)(P.out + (size_t)m * D + e0) = o; }
    }
}

#define XB_TMO      128
#define XB_XCNT(j)  (256  + 64 * (j))
#define XB_XSUB(j)  (1280 + 64 * (j))
#define XB_XGEN(j)  (2304 + 64 * (j))
#define XB_TOP      3328
#define XB_TOPGEN   3392
#define XCD_BAR_WORDS 3456
#define XB_SPIN_CAP (1u << 18)
__device__ __forceinline__ unsigned xb_ld(unsigned* p)              { return __hip_atomic_load(p, __ATOMIC_RELAXED, __HIP_MEMORY_SCOPE_AGENT); }
__device__ __forceinline__ unsigned xb_add(unsigned* p, unsigned v) { return __hip_atomic_fetch_add(p, v, __ATOMIC_RELAXED, __HIP_MEMORY_SCOPE_AGENT); }
__device__ __forceinline__ unsigned xb_xcc_id() { return (unsigned)__builtin_amdgcn_s_getreg((3 << 11) | 20) & 0xFu; }
#define XB_SPIN(cond, bar) do { unsigned _sp = 0; while (cond) { __builtin_amdgcn_s_sleep(1); \
    if ((++_sp & 255u) == 0u) { if (xb_ld(&(bar)[XB_TMO])) break; if (_sp > XB_SPIN_CAP) { atomicAdd(&(bar)[XB_TMO], 1u); break; } } } } while (0)
struct XcdBarrier { unsigned* bar; unsigned x; volatile LAS unsigned* st; };
__device__ __forceinline__ XcdBarrier xcd_barrier_post(unsigned* bar, volatile LAS unsigned* st) {
    XcdBarrier b; b.bar = bar; b.x = xb_xcc_id(); b.st = st;
    if (threadIdx.x == 0) (void)xb_add(&bar[XB_XCNT(b.x)], 1u);
    return b;
}
__device__ __forceinline__ void xcd_barrier_complete(unsigned* bar, unsigned x, unsigned& nloc, unsigned& nx) {
    const unsigned G = gridDim.x * gridDim.y * gridDim.z;
    unsigned sum, cnt, mine, sp = 0u;
    for (;;) {
        sum = 0u; cnt = 0u; mine = 0u;
#pragma unroll
        for (unsigned j = 0; j < 16; ++j) { const unsigned c = xb_ld(&bar[XB_XCNT(j)]); sum += c; cnt += (c > 0u) ? 1u : 0u; mine = (j == x) ? c : mine; }
        if (sum == G) break;
        __builtin_amdgcn_s_sleep(1);
        if ((++sp & 255u) == 0u) { if (xb_ld(&bar[XB_TMO])) break; if (sp > XB_SPIN_CAP) { atomicAdd(&bar[XB_TMO], 1u); break; } }
    }
    nloc = mine > 0u ? mine : 1u; nx = cnt > 0u ? cnt : 1u;
}
__device__ __forceinline__ void xcd_barrier(const XcdBarrier& b) {
    asm volatile("s_waitcnt vmcnt(0)" ::: "memory");
    __syncthreads();
    if (threadIdx.x == 0) {
        unsigned* bar = b.bar;
        __builtin_amdgcn_s_waitcnt(0);
        unsigned nloc = b.st[0], nx = b.st[1];
        if (nloc == 0u) { xcd_barrier_complete(bar, b.x, nloc, nx); b.st[0] = nloc; b.st[1] = nx; }
        const unsigned old = xb_add(&bar[XB_XSUB(b.x)], 1u);
        const unsigned gen = old / nloc;
        if (old + 1u == (gen + 1u) * nloc) {
            __builtin_amdgcn_fence(__ATOMIC_RELEASE, "agent");
            asm volatile("s_waitcnt vmcnt(0)" ::: "memory");
            const unsigned og = xb_add(&bar[XB_TOP], 1u);
            const unsigned tg = og / nx;
            if (og + 1u == (tg + 1u) * nx) xb_add(&bar[XB_TOPGEN], 1u);
            else XB_SPIN(xb_ld(&bar[XB_TOPGEN]) == tg, bar);
            __builtin_amdgcn_fence(__ATOMIC_ACQUIRE, "agent");
            xb_add(&bar[XB_XGEN(b.x)], 1u);
            asm volatile("s_waitcnt vmcnt(0)" ::: "memory");
        } else {
            XB_SPIN(xb_ld(&bar[XB_XGEN(b.x)]) == gen, bar);
            __builtin_amdgcn_fence(__ATOMIC_ACQUIRE, "agent");
            asm volatile("s_waitcnt vmcnt(0)" ::: "memory");
        }
    }
    __syncthreads();
}

constexpr int N_PHASES = 12;
__global__ void __launch_bounds__(NTHR, 2) fwd_kernel(Params P) {
    extern __shared__ __attribute__((aligned(16))) unsigned char lds_raw[];
    LAS unsigned char* lds = (LAS unsigned char*)lds_raw;
    cg::grid_group grid = cg::this_grid();
    const int lo = P.ph_lo, hi = P.ph_hi;
    unsigned char* ws = P.ws;
    volatile LAS unsigned* bst = (volatile LAS unsigned*)(lds + LDS_MISC);
    if (threadIdx.x < 16) bst[threadIdx.x] = 0u;
    __syncthreads();
    const XcdBarrier bar = xcd_barrier_post((unsigned*)(ws + WS_CTL), bst);
#define IN(k) (lo <= (k) && (k) < hi)
#define SEAM(k) do { if (IN(k) && IN((k) + 1)) { if ((k) == 0) grid.sync(); else xcd_barrier(bar); } } while (0)
    if (IN(0)) phase_prologue(P);
    SEAM(0);
    if (IN(1)) {
        pg8::Gemm g{(const bf16*)(ws + WS_H0), (const bf16*)(ws + WS_WIN), M, NP, D, D, D, 0}; pg8::StaticOrder S; S.init(M, NP, gridDim.x, blockIdx.x);
        pg8::EpiBf16 E{(bf16*)(ws + WS_P), NP};
        pg8::gemm_phase<pg8::EpiBf16, pg8::StaticOrder, true, true>(lds, g, S, E);
    }
    SEAM(1);
    if (IN(2)) phase_prep(P, lds);
    SEAM(2);
    if (IN(3)) phase_scan(P, lds);
    SEAM(3);
    if (IN(4)) phase_fixup(P, lds);
    SEAM(4);
    if (IN(5)) phase_correct(P, lds);
    SEAM(5);
    if (IN(6)) {
        pg8::Gemm g{(const bf16*)(ws + WS_MIX), (const bf16*)(ws + WS_WOUT), M, D, D, D, D, 0}; pg8::StaticOrder S; S.init(M, D, gridDim.x, blockIdx.x);
        pg8::EpiResF32 E{(float*)(ws + WS_Z), (const bf16*)(ws + WS_H0), D, ALPHA};
        pg8::gemm_phase<pg8::EpiResF32, pg8::StaticOrder, true, true>(lds, g, S, E);
    }
    SEAM(6);
    if (IN(7)) phase_ln1(P);
    SEAM(7);
    if (IN(8)) {
        pg8::Gemm g{(const bf16*)(ws + WS_H1), (const bf16*)(ws + WS_WQ), M, NQ, D, D, D, 0}; pg8::StaticOrder S; S.init(M, NQ, gridDim.x, blockIdx.x);
        pg8::EpiBf16 E{(bf16*)(ws + WS_Q), NQ};
        pg8::gemm_phase<pg8::EpiBf16, pg8::StaticOrder, true, true>(lds, g, S, E);
    }
    SEAM(8);
    if (IN(9)) {
        pg8::Gemm g{(const bf16*)(ws + WS_Q), (const bf16*)(ws + WS_KBD), M, NQ, 256, NQ, 256, 256}; pg8::StaticOrder S; S.init(M, NQ, gridDim.x, blockIdx.x);
        pg8::EpiBf16 E{(bf16*)(ws + WS_S), NQ};
        pg8::gemm_phase<pg8::EpiBf16, pg8::StaticOrder, true, true>(lds, g, S, E);
    }
    SEAM(9);
    if (IN(10)) phase_topk(P);
    SEAM(10);
    if (IN(11)) phase_peer(P);
#undef IN
#undef SEAM
}

extern "C" void kernel_launch(void* const* d_in, const int* in_sizes, int n_in, void* d_out, int out_size, void* d_ws, size_t ws_size, hipStream_t stream) {
    static int grid = 0;
    if (grid == 0) {
        if (n_in != 28 || out_size != M * D || ws_size < WS_END) { fprintf(stderr, "kernel_launch: unexpected shapes (n_in %d out %d ws %zu)\n", n_in, out_size, ws_size); grid = -1; return; }
        int dev = 0, cus = 0, per_cu = 0;
        (void)hipGetDevice(&dev); (void)hipDeviceGetAttribute(&cus, hipDeviceAttributeMultiprocessorCount, dev);
        (void)hipFuncSetAttribute((const void*)fwd_kernel, hipFuncAttributeMaxDynamicSharedMemorySize, LDS_BYTES);
        (void)hipOccupancyMaxActiveBlocksPerMultiprocessor(&per_cu, (const void*)fwd_kernel, NTHR, LDS_BYTES);
        if (per_cu < 1) { fprintf(stderr, "kernel_launch: occupancy query says %d blocks per CU\n", per_cu); per_cu = 1; }
        (void)hipGetLastError();
        grid = cus;
    }
    if (grid < 0) return;
    Params p{};
    for (int i = 0; i < 28; ++i) p.in[i] = (const float*)d_in[i];
    p.out = (float*)d_out; p.ws = (unsigned char*)d_ws;
    (void)hipMemsetAsync((char*)d_ws + WS_CTL, 0, CTL_BYTES, stream);
#if MK_ONE_LAUNCH
    p.ph_lo = 0; p.ph_hi = N_PHASES;
    void* args[] = {&p};
    hipError_t e = hipLaunchCooperativeKernel((const void*)fwd_kernel, dim3(grid), dim3(NTHR), args, LDS_BYTES, stream);
    if (e != hipSuccess) fprintf(stderr, "cooperative launch failed: %s (grid %d)\n", hipGetErrorString(e), grid);
#else
    for (int ph = 0; ph < N_PHASES; ++ph) {
        p.ph_lo = ph; p.ph_hi = ph + 1;
        hipLaunchKernelGGL(fwd_kernel, dim3(grid), dim3(NTHR), LDS_BYTES, stream, p);
    }
#endif
}
```

```cpp
#include <hip/hip_runtime.h>
#include <hip/hip_cooperative_groups.h>
#include <cstdio>
#include <cstdint>
namespace cg = cooperative_groups;

#ifndef MK_ONE_LAUNCH
#define MK_ONE_LAUNCH 1
#endif

namespace pg8 {
#define PG8_LAS __attribute__((address_space(3)))
typedef unsigned short bf16_t;
typedef short bf16x8 __attribute__((ext_vector_type(8)));
typedef float f32x4 __attribute__((ext_vector_type(4)));
typedef unsigned u32x4 __attribute__((ext_vector_type(4)));
typedef unsigned u32x2 __attribute__((ext_vector_type(2)));
constexpr int BM = 256, BK = 64, HALF = 128, HTB = HALF * BK * 2, STAGE_BYTES = 8 * HTB, NXCD = 8, WGM = 8;

__host__ __device__ __forceinline__ int lds_byte(int r, int c) { const int st = (r >> 4) * 2 + (c >> 5), rr = r & 15, cc = c & 31, ob = rr * 64 + cc * 2; return st * 1024 + (ob ^ (((ob >> 9) & 1) << 5)); }
__host__ __device__ __forceinline__ void stage_rc(int b, int& R, int& C) { const int st = b / 1024, sb = b % 1024, swz = sb ^ (((sb >> 9) & 1) << 5); R = (st >> 1) * 16 + swz / 64; C = (st & 1) * 32 + (swz % 64) / 2; }
__host__ __device__ __forceinline__ int perm32(int rho) { const int n = rho >> 4, i = rho & 15; return 8 * (i >> 2) + 4 * n + (i & 3); }

struct Unit { int pm, pn; };
struct Gemm { const bf16_t* A; const bf16_t* Bt; int M, N, K, lda, ldb, a_pn_koff; };

struct StaticOrder {
    int nM, nN, nwg, G, c;
    __host__ __device__ void init(int M, int N, int G_, int c_) { nM = M / BM; nN = N / BM; nwg = nM * nN; G = G_; c = c_; }
    __host__ __device__ bool next(int i, Unit& u) const {
        const long L = (long)i * G + c; if (L >= nwg) return false;
        int wgid = (int)L; { const int q = nwg / NXCD, r = nwg % NXCD, xcd = wgid % NXCD, off = wgid / NXCD; wgid = (xcd < r ? xcd * (q + 1) : r * (q + 1) + (xcd - r) * q) + off; }
        const int nig = WGM * nN, gid = wgid / nig, fm = gid * WGM, gsz = (nM - fm) < WGM ? (nM - fm) : WGM;
        u.pm = fm + ((wgid % nig) % gsz); u.pn = (wgid % nig) / gsz; return true;
    }
    __device__ __forceinline__ void a_ready(const Unit&) const {}
    __device__ __forceinline__ void done(const Unit&) const {}
};

__device__ __forceinline__ unsigned cvt_pk_bf16(float lo, float hi) { unsigned r; asm volatile("v_cvt_pk_bf16_f32 %0, %1, %2" : "=v"(r) : "v"(lo), "v"(hi)); return r; }

struct EpiBf16 {
    static constexpr bool PERM = true;
    bf16_t* O; int ldc;
    __device__ __forceinline__ void operator()(const f32x4 (&acc)[2][2][4][2], const Unit& u, int wr, int wc, int fr, int fq) const {
        const int row0 = u.pm * BM + wr * 64 + fr; const int col0 = u.pn * BM + wc * 32 + 8 * fq;
#pragma unroll
        for (int ai = 0; ai < 2; ++ai)
#pragma unroll
            for (int m = 0; m < 4; ++m) { bf16_t* rowp = O + (size_t)(row0 + ai * HALF + m * 16) * ldc + col0;
#pragma unroll
                for (int bj = 0; bj < 2; ++bj) { const f32x4 v0 = acc[ai][bj][m][0], v1 = acc[ai][bj][m][1];
                    u32x4 w; w.x = cvt_pk_bf16(v0[0], v0[1]); w.y = cvt_pk_bf16(v0[2], v0[3]); w.z = cvt_pk_bf16(v1[0], v1[1]); w.w = cvt_pk_bf16(v1[2], v1[3]);
                    *(u32x4*)(rowp + bj * HALF) = w; } }
    }
};
struct EpiResF32 {
    static constexpr bool PERM = false;
    float* Z; const bf16_t* R; int ldc; float alpha;
    __device__ __forceinline__ void operator()(const f32x4 (&acc)[2][2][4][2], const Unit& u, int wr, int wc, int fr, int fq) const {
        const int row0 = u.pm * BM + wr * 64 + fr; const int col0 = u.pn * BM + wc * 32 + 4 * fq;
#pragma unroll
        for (int ai = 0; ai < 2; ++ai)
#pragma unroll
            for (int m = 0; m < 4; ++m) { const size_t off = (size_t)(row0 + ai * HALF + m * 16) * ldc + col0;
#pragma unroll
                for (int bj = 0; bj < 2; ++bj)
#pragma unroll
                    for (int n = 0; n < 2; ++n) { const size_t o2 = off + bj * HALF + n * 16; const u32x2 rb = *(const u32x2*)(R + o2);
                        f32x4 h; h[0] = __uint_as_float(rb.x << 16); h[1] = __uint_as_float(rb.x & 0xffff0000u); h[2] = __uint_as_float(rb.y << 16); h[3] = __uint_as_float(rb.y & 0xffff0000u);
                        *(f32x4*)(Z + o2) = h * alpha + acc[ai][bj][m][n]; } }
    }
};

template <class Epi, class Sched, bool ALIGN_EPI = false, bool SP2 = false>
__device__ __forceinline__ void gemm_phase(PG8_LAS unsigned char* lds, const Gemm g, const Sched& S, const Epi& E) {
    const int tid = threadIdx.x, wid = __builtin_amdgcn_readfirstlane(tid >> 6), lane = tid & 63, wr = wid >> 2, wc = wid & 3, fr = lane & 15, fq = lane >> 4;
    const int K = g.K, nt = K / BK;
    unsigned voffA[2], voffB[2];
#pragma unroll
    for (int i = 0; i < 2; ++i) { int R, C; stage_rc(tid * 16 + i * 8192, R, C); const int Rb = Epi::PERM ? ((R & ~31) + perm32(R & 31)) : R;
        voffA[i] = (unsigned)(R * g.lda + C) * 2u; voffB[i] = (unsigned)(Rb * g.ldb + C) * 2u; }
    const size_t kstep = (size_t)(BK * 2);
    const size_t hstepA = (size_t)HALF * g.lda * 2, hstepB = (size_t)HALF * g.ldb * 2;
    const size_t tstepA = 2 * hstepA, tstepB = 2 * hstepB;
    const size_t pnA = (size_t)g.a_pn_koff * 2;
    const unsigned ldsw = (unsigned)wid * 1024u;
    const int aoff = lds_byte(wr * 64 + fr, fq * 8), boff = lds_byte(wc * 32 + fr, fq * 8);
#define PG8_SA(b, h) (((b) * 2 + (h)) * HTB)
#define PG8_SB(b, h) ((4 + (b) * 2 + (h)) * HTB)
#define PG8_STAGE(bufoff, gbase, voff) do { _Pragma("unroll") for (int _i = 0; _i < 2; ++_i) \
        __builtin_amdgcn_global_load_lds((const unsigned*)((const char*)(gbase) + (voff)[_i]), (PG8_LAS unsigned*)(lds + (bufoff) + ldsw + _i * 8192), 16, 0, 0); } while (0)
#define PG8_LDA(dst, b, h) do { _Pragma("unroll") for (int m = 0; m < 4; ++m) _Pragma("unroll") for (int k = 0; k < 2; ++k) dst[m][k] = *(const PG8_LAS bf16x8*)(lds + PG8_SA(b, h) + aoff + m * 2048 + k * 1024); } while (0)
#define PG8_LDB(dst, b, h) do { _Pragma("unroll") for (int n = 0; n < 2; ++n) _Pragma("unroll") for (int k = 0; k < 2; ++k) dst[n][k] = *(const PG8_LAS bf16x8*)(lds + PG8_SB(b, h) + boff + n * 2048 + k * 1024); } while (0)
#define PG8_MMA(ai, bj, At, Bt) do { __builtin_amdgcn_s_setprio(1); _Pragma("unroll") for (int m = 0; m < 4; ++m) _Pragma("unroll") for (int n = 0; n < 2; ++n) _Pragma("unroll") for (int k = 0; k < 2; ++k) \
        acc[ai][bj][m][n] = __builtin_amdgcn_mfma_f32_16x16x32_bf16(Bt[n][k], At[m][k], acc[ai][bj][m][n], 0, 0, 0); __builtin_amdgcn_s_setprio(0); } while (0)
#define PG8_WAIT_V(n) asm volatile("s_waitcnt vmcnt(" #n ")" ::: "memory")
#define PG8_WAIT_L(n) asm volatile("s_waitcnt lgkmcnt(" #n ")" ::: "memory")
#define PG8_BAR __builtin_amdgcn_s_barrier()
#define PG8_SCHED __builtin_amdgcn_sched_barrier(0)
    Unit cur, nxt; int ui = 0;
    if (!S.next(0, cur)) return;
    f32x4 acc[2][2][4][2];
#pragma unroll
    for (int a = 0; a < 2; ++a)
#pragma unroll
        for (int b = 0; b < 2; ++b)
#pragma unroll
            for (int m = 0; m < 4; ++m)
#pragma unroll
                for (int n = 0; n < 2; ++n) acc[a][b][m][n] = (f32x4){0.f, 0.f, 0.f, 0.f};
    bf16x8 At[4][2], B0[2][2], B1[2][2];
    const char* cA = (const char*)g.A + (size_t)cur.pm * tstepA + (size_t)cur.pn * pnA; const char* cB = (const char*)g.Bt + (size_t)cur.pn * tstepB;
    S.a_ready(cur);
    if constexpr (SP2) {
        PG8_STAGE(PG8_SB(0, 0), cB, voffB); PG8_STAGE(PG8_SB(0, 1), cB + hstepB, voffB); PG8_STAGE(PG8_SA(0, 0), cA, voffA); PG8_STAGE(PG8_SA(0, 1), cA + hstepA, voffA);
        if (wr == 1) PG8_BAR;
        PG8_WAIT_V(2); PG8_BAR;
        PG8_STAGE(PG8_SB(1, 0), cB + kstep, voffB); PG8_STAGE(PG8_SA(1, 0), cA + kstep, voffA); PG8_STAGE(PG8_SB(1, 1), cB + hstepB + kstep, voffB);
        PG8_WAIT_V(6); PG8_BAR;
    } else {
        PG8_STAGE(PG8_SB(0, 0), cB, voffB); PG8_STAGE(PG8_SA(0, 0), cA, voffA); PG8_STAGE(PG8_SB(0, 1), cB + hstepB, voffB); PG8_STAGE(PG8_SA(0, 1), cA + hstepA, voffA);
        if (wr == 1) PG8_BAR;
        PG8_WAIT_V(4); PG8_BAR;
        PG8_STAGE(PG8_SB(1, 0), cB + kstep, voffB); PG8_STAGE(PG8_SA(1, 0), cA + kstep, voffA); PG8_STAGE(PG8_SB(1, 1), cB + hstepB + kstep, voffB);
        PG8_WAIT_V(6); PG8_BAR;
    }
    for (;;) {
        const bool has_next = S.next(ui + 1, nxt);
        const char* nA = has_next ? (const char*)g.A + (size_t)nxt.pm * tstepA + (size_t)nxt.pn * pnA : cA; const char* nB = has_next ? (const char*)g.Bt + (size_t)nxt.pn * tstepB : cB;
        for (int t = 0; t < nt; t += 2) {
            const bool last = (t == nt - 2);
            const char* a1 = cA + (size_t)(t + 1) * kstep;
            const char* a2 = last ? nA : cA + (size_t)(t + 2) * kstep; const char* b2 = last ? nB : cB + (size_t)(t + 2) * kstep;
            const char* a3 = a2 + kstep; const char* b3 = b2 + kstep;
            if (last && has_next) S.a_ready(nxt);
            if constexpr (SP2) {
            PG8_LDB(B0, 0, 0); PG8_LDB(B1, 0, 1); PG8_SCHED; PG8_LDA(At, 0, 0); PG8_STAGE(PG8_SA(1, 1), a1 + hstepA, voffA);
            PG8_WAIT_V(8); PG8_WAIT_L(0); PG8_BAR; PG8_MMA(0, 0, At, B0); PG8_MMA(0, 1, At, B1); PG8_BAR; PG8_SCHED;
            PG8_LDA(At, 0, 1); PG8_STAGE(PG8_SB(0, 0), b2, voffB); PG8_STAGE(PG8_SB(0, 1), b2 + hstepB, voffB); PG8_STAGE(PG8_SA(0, 0), a2, voffA);
            PG8_WAIT_V(8); PG8_WAIT_L(0); PG8_BAR; PG8_MMA(1, 0, At, B0); PG8_MMA(1, 1, At, B1); PG8_BAR; PG8_SCHED;
            PG8_LDB(B0, 1, 0); PG8_LDB(B1, 1, 1); PG8_SCHED; PG8_LDA(At, 1, 0); PG8_STAGE(PG8_SA(0, 1), a2 + hstepA, voffA);
            PG8_WAIT_V(8); PG8_WAIT_L(0); PG8_BAR; PG8_MMA(0, 0, At, B0); PG8_MMA(0, 1, At, B1); PG8_BAR; PG8_SCHED;
            PG8_LDA(At, 1, 1); PG8_STAGE(PG8_SB(1, 0), b3, voffB); PG8_STAGE(PG8_SB(1, 1), b3 + hstepB, voffB); PG8_STAGE(PG8_SA(1, 0), a3, voffA);
            PG8_WAIT_V(8); PG8_WAIT_L(0); PG8_BAR; PG8_MMA(1, 0, At, B0); PG8_MMA(1, 1, At, B1); PG8_BAR; PG8_SCHED;
            } else {
            PG8_LDB(B0, 0, 0); PG8_SCHED; PG8_LDA(At, 0, 0); PG8_STAGE(PG8_SA(1, 1), a1 + hstepA, voffA);
            PG8_WAIT_L(8); PG8_BAR; PG8_WAIT_L(0); PG8_MMA(0, 0, At, B0); PG8_BAR; PG8_SCHED;
            PG8_LDB(B1, 0, 1); PG8_STAGE(PG8_SB(0, 0), b2, voffB);
            PG8_BAR; PG8_WAIT_L(0); PG8_MMA(0, 1, At, B1); PG8_BAR;
            PG8_LDA(At, 0, 1); PG8_STAGE(PG8_SA(0, 0), a2, voffA);
            PG8_BAR; PG8_WAIT_L(0); PG8_MMA(1, 0, At, B0); PG8_BAR; PG8_SCHED;
            PG8_STAGE(PG8_SB(0, 1), b2 + hstepB, voffB);
            PG8_WAIT_V(6); PG8_BAR; PG8_MMA(1, 1, At, B1); PG8_BAR;
            PG8_LDB(B0, 1, 0); PG8_SCHED; PG8_LDA(At, 1, 0); PG8_STAGE(PG8_SA(0, 1), a2 + hstepA, voffA);
            PG8_WAIT_L(8); PG8_BAR; PG8_WAIT_L(0); PG8_MMA(0, 0, At, B0); PG8_BAR; PG8_SCHED;
            PG8_LDB(B1, 1, 1); PG8_STAGE(PG8_SB(1, 0), b3, voffB);
            PG8_BAR; PG8_WAIT_L(0); PG8_MMA(0, 1, At, B1); PG8_BAR;
            PG8_LDA(At, 1, 1); PG8_STAGE(PG8_SA(1, 0), a3, voffA);
            PG8_BAR; PG8_WAIT_L(0); PG8_MMA(1, 0, At, B0); PG8_BAR; PG8_SCHED;
            PG8_STAGE(PG8_SB(1, 1), b3 + hstepB, voffB);
            PG8_WAIT_V(6); PG8_BAR; PG8_MMA(1, 1, At, B1); PG8_BAR;
            }
        }
        if constexpr (ALIGN_EPI) { if (wr == 0) PG8_BAR; }
        E(acc, cur, wr, wc, fr, fq); S.done(cur);
        if (!has_next) break;
#pragma unroll
        for (int a = 0; a < 2; ++a)
#pragma unroll
            for (int b = 0; b < 2; ++b)
#pragma unroll
                for (int m = 0; m < 4; ++m)
#pragma unroll
                    for (int n = 0; n < 2; ++n) acc[a][b][m][n] = (f32x4){0.f, 0.f, 0.f, 0.f};
        cur = nxt; cA = nA; cB = nB; ++ui;
        if constexpr (ALIGN_EPI) { if (wr == 1) PG8_BAR; }
    }
    PG8_WAIT_V(0);
    if constexpr (!ALIGN_EPI) { if (wr == 0) PG8_BAR; }
    PG8_BAR;
#undef PG8_SA
#undef PG8_SB
#undef PG8_STAGE
#undef PG8_LDA
#undef PG8_LDB
#undef PG8_MMA
#undef PG8_WAIT_V
#undef PG8_WAIT_L
#undef PG8_BAR
#undef PG8_SCHED
}
}

constexpr int NWAVES = 8, NTHR = NWAVES * 64;
constexpr int D = 1024, NBATCH = 4, T = 8192, M = NBATCH * T;
constexpr int A_W = 512, A_IN = 1792, IN_COLS = 3344, NP = 3584;
constexpr int C_R = 0, C_K = 512, C_V = 1024, C_WD = 1536, C_AD = 1600, C_GD = 1664;
constexpr int C_BQ = 1792, C_BK = 2048, C_BV = 2304, C_GKD = 2816, C_BG = 2832;
constexpr int NQ = 2048;
constexpr float LN_EPS = 1e-5f, GN_EPS = 64e-5f, RMS_EPS = 1e-5f;
constexpr float ALPHA = 1.189207115002721f;

typedef unsigned short bf16;
typedef float f32x4 __attribute__((ext_vector_type(4)));
typedef unsigned u32x4 __attribute__((ext_vector_type(4)));
typedef unsigned u32x2 __attribute__((ext_vector_type(2)));
#define LAS __attribute__((address_space(3)))

constexpr size_t MiB = 1u << 20;
constexpr size_t WS_WIN = 1 * MiB, WS_WOUT = 8 * MiB, WS_WQ = 10 * MiB, WS_KBD = 14 * MiB;
constexpr size_t WS_W2T = 15 * MiB, WS_A2T = WS_W2T + 65536, WS_G2T = WS_A2T + 65536;
constexpr size_t WS_H0 = 16 * MiB;
constexpr size_t WS_P = 80 * MiB;
constexpr size_t WS_WL = 304 * MiB, WS_AA = 336 * MiB, WS_GG = 368 * MiB;
constexpr size_t WS_GK = 400 * MiB;
constexpr size_t WS_MIX = 416 * MiB;
constexpr size_t WS_Z = 80 * MiB;
constexpr size_t WS_H1 = 208 * MiB;
constexpr size_t WS_Q = 272 * MiB;
constexpr size_t WS_S = 80 * MiB;
constexpr size_t WS_IDS = 400 * MiB, WS_GATES = 416 * MiB;
constexpr size_t WS_UT = 432 * MiB, WS_VT = 448 * MiB;
constexpr size_t WS_SU = 464 * MiB, WS_SV = 465 * MiB;
constexpr int NSEG = 16, LSEG = 8192 / NSEG;
constexpr size_t WS_YI = WS_WL;
constexpr size_t WS_YIG = WS_GK;
constexpr size_t WS_SER = 480 * MiB;
constexpr size_t WS_SEG = 496 * MiB;
constexpr size_t WS_CEND = 504 * MiB;
constexpr size_t WS_END = 505 * MiB;

constexpr int LDS_BYTES = 147456, LDS_MISC = LDS_BYTES - 256;
constexpr size_t WS_CTL = 0, CTL_BYTES = 16384;

struct Params {
    const float* in[28];
    float* out; unsigned char* ws;
    int ph_lo, ph_hi;
};

__device__ __forceinline__ float bf2f(unsigned u) { return __uint_as_float(u << 16); }
__device__ __forceinline__ unsigned f2bf(float f) { unsigned u = __float_as_uint(f); return (u + 0x7fffu + ((u >> 16) & 1u)) >> 16; }
__device__ __forceinline__ unsigned pk2(float lo, float hi) { return f2bf(lo) | (f2bf(hi) << 16); }
#define DPP_F(v, ctrl) __builtin_bit_cast(float, __builtin_amdgcn_update_dpp(0, __builtin_bit_cast(int, (v)), (ctrl), 0xf, 0xf, false))
#define DPP_ADD(v, ctrl) ((v) + DPP_F(v, ctrl))
__device__ __forceinline__ float rlf(float v, int l) { return __builtin_bit_cast(float, __builtin_amdgcn_readlane(__builtin_bit_cast(int, v), l)); }
__device__ __forceinline__ float wave_sum_u(float v) {
    v = DPP_ADD(v, 0xB1); v = DPP_ADD(v, 0x4E); v = DPP_ADD(v, 0x141); v = DPP_ADD(v, 0x140);
    return (rlf(v, 0) + rlf(v, 16)) + (rlf(v, 32) + rlf(v, 48));
}
__device__ __forceinline__ float wave_sum(float v) { return wave_sum_u(v); }
#define DPP_I(v, ctrl) __builtin_amdgcn_update_dpp(0, (v), (ctrl), 0xf, 0xf, false)
__device__ __forceinline__ int wave_sum_i(int v) {
    v += DPP_I(v, 0xB1); v += DPP_I(v, 0x4E); v += DPP_I(v, 0x141); v += DPP_I(v, 0x140);
    return (__builtin_amdgcn_readlane(v, 0) + __builtin_amdgcn_readlane(v, 16)) + (__builtin_amdgcn_readlane(v, 32) + __builtin_amdgcn_readlane(v, 48));
}
__device__ __forceinline__ float wave_max_u(float v) {
    v = fmaxf(v, DPP_F(v, 0xB1)); v = fmaxf(v, DPP_F(v, 0x4E)); v = fmaxf(v, DPP_F(v, 0x141)); v = fmaxf(v, DPP_F(v, 0x140));
    return fmaxf(fmaxf(rlf(v, 0), rlf(v, 16)), fmaxf(rlf(v, 32), rlf(v, 48)));
}
__device__ __forceinline__ unsigned pack_i8(float a, float b, float c, float d, float inv, int off) {
    const int q0 = __float2int_rn(a * inv) + off, q1 = __float2int_rn(b * inv) + off, q2 = __float2int_rn(c * inv) + off, q3 = __float2int_rn(d * inv) + off;
    return (unsigned)(q0 & 0xff) | ((unsigned)(q1 & 0xff) << 8) | ((unsigned)(q2 & 0xff) << 16) | ((unsigned)(q3 & 0xff) << 24);
}
__device__ __forceinline__ float sigmoidf_(float x) { return 1.f / (1.f + __expf(-x)); }
__device__ __forceinline__ float softplusf_(float x) { return fmaxf(x, 0.f) + log1pf(__expf(-fabsf(x))); }
__device__ __forceinline__ float siluf_(float x) { return x * sigmoidf_(x); }

__device__ __forceinline__ void transpose_convert(const float* W, int K, int N, int Npad, bf16* WT, int gtid, int gthreads) {
    const int kc = K / 8, total = Npad * kc;
    for (int idx = gtid; idx < total; idx += gthreads) {
        const int n = idx % Npad, c = idx / Npad; float v[8];
#pragma unroll
        for (int j = 0; j < 8; ++j) v[j] = (n < N) ? W[(size_t)(8 * c + j) * N + n] : 0.f;
        u32x4 o; o.x = pk2(v[0], v[1]); o.y = pk2(v[2], v[3]); o.z = pk2(v[4], v[5]); o.w = pk2(v[6], v[7]);
        *(u32x4*)(WT + (size_t)n * K + 8 * c) = o;
    }
}
__device__ __forceinline__ void ln_row_bf16(const float* xrow, const float* g, const float* b, bf16* orow, int lane) {
    const f32x4* xr = (const f32x4*)xrow + lane; f32x4 v[4]; float s = 0.f;
#pragma unroll
    for (int j = 0; j < 4; ++j) { v[j] = xr[64 * j]; s += (v[j][0] + v[j][1]) + (v[j][2] + v[j][3]); }
    const float mean = wave_sum(s) * (1.f / D); float s2 = 0.f;
#pragma unroll
    for (int j = 0; j < 4; ++j) { v[j] = v[j] - mean; s2 += (v[j][0] * v[j][0] + v[j][1] * v[j][1]) + (v[j][2] * v[j][2] + v[j][3] * v[j][3]); }
    const float rstd = 1.f / sqrtf(wave_sum(s2) * (1.f / D) + LN_EPS);
    u32x2* o8 = (u32x2*)orow + lane;
#pragma unroll
    for (int j = 0; j < 4; ++j) { const f32x4 gg = ((const f32x4*)g)[lane + 64 * j], bb = ((const f32x4*)b)[lane + 64 * j]; const f32x4 y = v[j] * rstd * gg + bb;
        u32x2 w; w.x = pk2(y[0], y[1]); w.y = pk2(y[2], y[3]); o8[64 * j] = w; }
}
__device__ __forceinline__ void phase_prologue(const Params& P) {
    const int tid = threadIdx.x, lane = tid & 63, wave = tid >> 6;
    const int gtid = blockIdx.x * NTHR + tid, gthreads = gridDim.x * NTHR;
    unsigned char* ws = P.ws;
    transpose_convert(P.in[3], D, IN_COLS, NP, (bf16*)(ws + WS_WIN), gtid, gthreads);
    transpose_convert(P.in[19], D, D, D, (bf16*)(ws + WS_WOUT), gtid, gthreads);
    transpose_convert(P.in[22], D, NQ, NQ, (bf16*)(ws + WS_WQ), gtid, gthreads);
    transpose_convert(P.in[6], 64, A_W, A_W, (bf16*)(ws + WS_W2T), gtid, gthreads);
    transpose_convert(P.in[8], 64, A_W, A_W, (bf16*)(ws + WS_A2T), gtid, gthreads);
    transpose_convert(P.in[9], 128, A_W, A_W, (bf16*)(ws + WS_G2T), gtid, gthreads);
    {
        const float* keys = P.in[23]; bf16* kbd = (bf16*)(ws + WS_KBD);
        for (int idx = gtid; idx < 8 * 256 * 32; idx += gthreads) {
            const int kc = idx & 31, n = (idx >> 5) & 255, h = idx >> 13; const int k0 = kc * 8, hn = n >> 7, key = n & 127, hk = k0 >> 7, c0 = k0 & 127;
            u32x4 o = (u32x4){0u, 0u, 0u, 0u};
            if (hn == hk) { const float* s = keys + ((size_t)((h * 2 + hn) * 128 + key)) * 128 + c0; o.x = pk2(s[0], s[1]); o.y = pk2(s[2], s[3]); o.z = pk2(s[4], s[5]); o.w = pk2(s[6], s[7]); }
            *(u32x4*)(kbd + ((size_t)(h * 256 + n)) * 256 + k0) = o;
        }
    }
    const int gw = blockIdx.x * NWAVES + wave, ngw = gridDim.x * NWAVES;
    for (int m = gw; m < M; m += ngw) ln_row_bf16(P.in[0] + (size_t)m * D, P.in[1], P.in[2], (bf16*)(ws + WS_H0) + (size_t)m * D, lane);
}

typedef short bf16x8_t __attribute__((ext_vector_type(8)));
template <int KS, int LDA>
__device__ __forceinline__ void lora_mm(f32x4 (&acc)[4][4], const LAS bf16* ACT, const bf16* WT, int c0, int fr, int fq) {
#pragma unroll
    for (int mt = 0; mt < 4; ++mt)
#pragma unroll
        for (int nt = 0; nt < 4; ++nt) acc[mt][nt] = (f32x4){0.f, 0.f, 0.f, 0.f};
#pragma unroll
    for (int s = 0; s < KS; ++s) {
        bf16x8_t af[4], bfr[4];
#pragma unroll
        for (int mt = 0; mt < 4; ++mt) af[mt] = *(const LAS bf16x8_t*)(ACT + (mt * 16 + fr) * LDA + 32 * s + 8 * fq);
#pragma unroll
        for (int nt = 0; nt < 4; ++nt) bfr[nt] = *(const bf16x8_t*)(WT + (size_t)(c0 + nt * 16 + fr) * (32 * KS) + 32 * s + 8 * fq);
#pragma unroll
        for (int mt = 0; mt < 4; ++mt)
#pragma unroll
            for (int nt = 0; nt < 4; ++nt) acc[mt][nt] = __builtin_amdgcn_mfma_f32_16x16x32_bf16(bfr[nt], af[mt], acc[mt][nt], 0, 0, 0);
    }
}
__device__ __forceinline__ void phase_prep(const Params& P, LAS unsigned char* lds) {
    const int tid = threadIdx.x, lane = tid & 63, wave = __builtin_amdgcn_readfirstlane(tid >> 6), fr = lane & 15, fq = lane >> 4;
    unsigned char* ws = P.ws;
    const bf16* p = (const bf16*)(ws + WS_P);
    const float* mu = P.in[4]; const float* w0 = P.in[5]; const float* a0 = P.in[7];
    const float* gkw2 = P.in[16]; const float* gkb = P.in[17];
    const bf16* W2T = (const bf16*)(ws + WS_W2T); const bf16* A2T = (const bf16*)(ws + WS_A2T); const bf16* G2T = (const bf16*)(ws + WS_G2T);
    bf16* WL = (bf16*)(ws + WS_WL); bf16* AA = (bf16*)(ws + WS_AA); bf16* GG = (bf16*)(ws + WS_GG); bf16* GK = (bf16*)(ws + WS_GK);
    LAS bf16* TW = (LAS bf16*)lds; LAS bf16* AD = TW + 64 * 72; LAS bf16* SG = AD + 64 * 72;
    LAS float* gkd = (LAS float*)(SG + 64 * 136);
    const int c0 = wave * 64;
    for (int tile = blockIdx.x; tile < M / 64; tile += gridDim.x) {
        const int m0 = tile * 64;
        __syncthreads();
        for (int idx = tid; idx < 64 * 256; idx += NTHR) {
            const int j = idx & 255, tok = idx >> 8, m = m0 + tok, t = m & (T - 1);
            const float cur = bf2f(p[(size_t)m * NP + C_WD + j]);
            const float prev = (t > 0) ? bf2f(p[(size_t)(m - 1) * NP + C_WD + j]) : 0.f;
            const float x = cur + (prev - cur) * mu[C_WD + j];
            if (j < 64) TW[tok * 72 + j] = (bf16)f2bf(tanhf(x)); else if (j < 128) AD[tok * 72 + j - 64] = (bf16)f2bf(x); else SG[tok * 136 + j - 128] = (bf16)f2bf(sigmoidf_(x));
        }
        for (int idx = tid; idx < 64 * 16; idx += NTHR) { const int j = idx & 15, tok = idx >> 4; gkd[tok * 16 + j] = bf2f(p[(size_t)(m0 + tok) * NP + C_GKD + j]); }
        __syncthreads();
        f32x4 acc[4][4];
        lora_mm<2, 72>(acc, TW, W2T, c0, fr, fq);
#pragma unroll
        for (int nt = 0; nt < 4; ++nt) { const int c = c0 + nt * 16 + 4 * fq; const f32x4 b = *(const f32x4*)(w0 + c);
#pragma unroll
            for (int mt = 0; mt < 4; ++mt) { float o[4];
#pragma unroll
                for (int i = 0; i < 4; ++i) { const float z = b[i] + acc[mt][nt][i]; o[i] = -__expf(-softplusf_(-z) - 0.5f); }
                u32x2 w; w.x = pk2(o[0], o[1]); w.y = pk2(o[2], o[3]); *(u32x2*)(WL + (size_t)(m0 + mt * 16 + fr) * A_W + c) = w; } }
        lora_mm<2, 72>(acc, AD, A2T, c0, fr, fq);
#pragma unroll
        for (int nt = 0; nt < 4; ++nt) { const int c = c0 + nt * 16 + 4 * fq; const f32x4 b = *(const f32x4*)(a0 + c);
#pragma unroll
            for (int mt = 0; mt < 4; ++mt) { float o[4];
#pragma unroll
                for (int i = 0; i < 4; ++i) o[i] = sigmoidf_(b[i] + acc[mt][nt][i]);
                u32x2 w; w.x = pk2(o[0], o[1]); w.y = pk2(o[2], o[3]); *(u32x2*)(AA + (size_t)(m0 + mt * 16 + fr) * A_W + c) = w; } }
        lora_mm<4, 136>(acc, SG, G2T, c0, fr, fq);
#pragma unroll
        for (int nt = 0; nt < 4; ++nt) { const int c = c0 + nt * 16 + 4 * fq;
#pragma unroll
            for (int mt = 0; mt < 4; ++mt) { u32x2 w; w.x = pk2(acc[mt][nt][0], acc[mt][nt][1]); w.y = pk2(acc[mt][nt][2], acc[mt][nt][3]); *(u32x2*)(GG + (size_t)(m0 + mt * 16 + fr) * A_W + c) = w; } }
        { const int cc = tid & 255, th = tid >> 8; float wv[16];
#pragma unroll
          for (int j = 0; j < 16; ++j) wv[j] = gkw2[j * 256 + cc];
          const float bb = gkb[cc];
          for (int i = 0; i < 32; ++i) { const int tok = th * 32 + i; float sacc = bb;
#pragma unroll
              for (int j = 0; j < 16; ++j) sacc += gkd[tok * 16 + j] * wv[j];
              GK[(size_t)(m0 + tok) * 256 + cc] = (bf16)f2bf(-softplusf_(-sacc) * (1.f / 16.f)); } }
    }
}

constexpr int CH = 32;
__device__ __forceinline__ float red8(float v) { v = DPP_ADD(v, 0xB1); v = DPP_ADD(v, 0x4E); v = DPP_ADD(v, 0x141); return v; }
__device__ __forceinline__ float red4(float v) { v = DPP_ADD(v, 0xB1); v = DPP_ADD(v, 0x4E); return v; }

constexpr int RW_BUF = 6 * CH * 64;
__device__ __forceinline__ void rw_load(const bf16* p, const bf16* AA, const bf16* WL, int b, int t0, int col, int wave,
        unsigned (&rc)[4], unsigned (&kc)[4], unsigned (&vc)[4], unsigned (&rp)[4], unsigned (&kp)[4], unsigned (&vp)[4], unsigned (&a)[4], unsigned (&wl)[4]) {
#pragma unroll
    for (int q = 0; q < 4; ++q) {
        const int t = t0 + wave + 8 * q; const size_t m = (size_t)b * T + t; const bf16* pr = p + m * NP; const bf16* pp = (t > 0) ? pr - NP : pr;
        rc[q] = pr[C_R + col]; kc[q] = pr[C_K + col]; vc[q] = pr[C_V + col]; rp[q] = pp[C_R + col]; kp[q] = pp[C_K + col]; vp[q] = pp[C_V + col];
        a[q] = AA[m * A_W + col]; wl[q] = WL[m * A_W + col];
    }
}
__device__ __forceinline__ void rw_prep(LAS float* B, int t0, int wave, int lane, float mu_r, float mu_k, float mu_v, float kkc, float kac,
        const unsigned (&rc_)[4], const unsigned (&kc_)[4], const unsigned (&vc_)[4], const unsigned (&rp_)[4], const unsigned (&kp_)[4], const unsigned (&vp_)[4], const unsigned (&a_)[4], const unsigned (&wl_)[4]) {
    LAS float* R = B; LAS float* DEC = R + CH * 64; LAS float* KH = DEC + CH * 64; LAS float* KK = KH + CH * 64; LAS float* BB = KK + CH * 64; LAS float* V = BB + CH * 64;
#pragma unroll
    for (int q = 0; q < 4; ++q) {
        const int tt = wave + 8 * q; const float hp = (t0 + tt > 0) ? 1.f : 0.f;
        const float rc = bf2f(rc_[q]), kc = bf2f(kc_[q]), vc = bf2f(vc_[q]), rp = bf2f(rp_[q]) * hp, kp = bf2f(kp_[q]) * hp, vp = bf2f(vp_[q]) * hp;
        const float r = rc + (rp - rc) * mu_r, k = kc + (kp - kc) * mu_k, v = vc + (vp - vc) * mu_v;
        const float a = bf2f(a_[q]), wl = bf2f(wl_[q]);
        const float kr = k * kkc; const float nrm = sqrtf(wave_sum(kr * kr)); const float kk = kr / fmaxf(nrm, 1e-12f);
        const float kh = k * (1.f + (a - 1.f) * kac);
        R[tt * 64 + lane] = r; DEC[tt * 64 + lane] = __expf(wl); KH[tt * 64 + lane] = kh; KK[tt * 64 + lane] = kk; BB[tt * 64 + lane] = kk * a; V[tt * 64 + lane] = v;
    }
}
__device__ __forceinline__ void rwkv_item(const Params& P, LAS unsigned char* lds, int b, int h, int seg) {
    const int tid = threadIdx.x, lane = tid & 63, wave = tid >> 6;
    unsigned char* ws = P.ws;
    const bf16* p = (const bf16*)(ws + WS_P); const bf16* WL = (const bf16*)(ws + WS_WL); const bf16* AA = (const bf16*)(ws + WS_AA);
    bf16* MIX = (bf16*)(ws + WS_MIX); bf16* YI = (bf16*)(ws + WS_YI);
    const float* mu = P.in[4]; const float* k_k = P.in[10]; const float* k_a = P.in[11];
    LAS float* BUF = (LAS float*)lds; LAS float* Y = BUF + 2 * RW_BUF;
    const int col = h * 64 + lane;
    const float mu_r = mu[C_R + col], mu_k = mu[C_K + col], mu_v = mu[C_V + col], kkc = k_k[col], kac = k_a[col];
    const int row = wave * 16 + (lane >> 2), ks = (lane & 3) * 16; const int ident = row >> 6, vrow = row & 63;
    float* SE = (float*)(ws + WS_SER) + ((((size_t)(b * 8 + h) * NSEG + seg) * 2 + ident) * 4096) + vrow * 64 + ks;
    float S[16];
#pragma unroll
    for (int j = 0; j < 16; ++j) S[j] = (ident && (ks + j == vrow)) ? 1.f : 0.f;
    const float vmask = ident ? 0.f : 1.f;
    const int tbeg = seg * LSEG;
    unsigned rc[4], kc[4], vc[4], rp[4], kp[4], vp[4], a[4], wl[4];
    __syncthreads();
    rw_load(p, AA, WL, b, tbeg, col, wave, rc, kc, vc, rp, kp, vp, a, wl);
    rw_prep(BUF, tbeg, wave, lane, mu_r, mu_k, mu_v, kkc, kac, rc, kc, vc, rp, kp, vp, a, wl);
    __syncthreads();
    for (int ci = 0; ci < LSEG / CH; ++ci) {
        const int t0 = tbeg + ci * CH; LAS float* B = BUF + (ci & 1) * RW_BUF;
        LAS float* R = B; LAS float* DEC = R + CH * 64; LAS float* KH = DEC + CH * 64; LAS float* KK = KH + CH * 64; LAS float* BB = KK + CH * 64; LAS float* V = BB + CH * 64;
        const bool more = (ci + 1 < LSEG / CH);
        if (more) rw_load(p, AA, WL, b, t0 + CH, col, wave, rc, kc, vc, rp, kp, vp, a, wl);
        for (int tt = 0; tt < CH; ++tt) {
            const float vv = V[tt * 64 + vrow] * vmask;
            float sa0 = 0.f, sa1 = 0.f;
#pragma unroll
            for (int q4 = 0; q4 < 4; ++q4) { const f32x4 kq = *(const LAS f32x4*)(KK + tt * 64 + ks + 4 * q4);
#pragma unroll
                for (int j = 0; j < 4; ++j) { if (q4 & 1) sa1 += S[4 * q4 + j] * kq[j]; else sa0 += S[4 * q4 + j] * kq[j]; } }
            const float sa = -red4(sa0 + sa1);
            float y0 = 0.f, y1 = 0.f;
#pragma unroll
            for (int q4 = 0; q4 < 4; ++q4) {
                const f32x4 dq = *(const LAS f32x4*)(DEC + tt * 64 + ks + 4 * q4), bq = *(const LAS f32x4*)(BB + tt * 64 + ks + 4 * q4), hq = *(const LAS f32x4*)(KH + tt * 64 + ks + 4 * q4), rq = *(const LAS f32x4*)(R + tt * 64 + ks + 4 * q4);
#pragma unroll
                for (int j = 0; j < 4; ++j) { S[4 * q4 + j] = S[4 * q4 + j] * dq[j] + sa * bq[j] + vv * hq[j]; if (q4 & 1) y1 += S[4 * q4 + j] * rq[j]; else y0 += S[4 * q4 + j] * rq[j]; }
            }
            const float y = red4(y0 + y1);
            if ((lane & 3) == 0) Y[tt * 128 + row] = y;
        }
        __syncthreads();
        if (more) rw_prep(BUF + ((ci + 1) & 1) * RW_BUF, t0 + CH, wave, lane, mu_r, mu_k, mu_v, kkc, kac, rc, kc, vc, rp, kp, vp, a, wl);
#pragma unroll
        for (int q = 0; q < 4; ++q) {
            const int tt = wave + 8 * q; const size_t m = (size_t)b * T + t0 + tt;
            MIX[m * D + col] = (bf16)f2bf(Y[tt * 128 + lane]); YI[m * 512 + col] = (bf16)f2bf(Y[tt * 128 + 64 + lane]);
        }
        __syncthreads();
    }
#pragma unroll
    for (int q4 = 0; q4 < 4; ++q4) *(f32x4*)(SE + 4 * q4) = (f32x4){S[4 * q4], S[4 * q4 + 1], S[4 * q4 + 2], S[4 * q4 + 3]};
}

constexpr int GL_BUF = 3 * CH * 64 + CH * 128;
__device__ __forceinline__ void gl_load(const bf16* p, const bf16* GK, int b, int h, int t0, int lane, int wave, unsigned (&x)[4][4][4], unsigned (&gk)[4]) {
    const int cq = h * 64 + lane, ck = 256 + h * 64 + lane, cv0 = 512 + h * 128 + lane, cv1 = cv0 + 64;
#pragma unroll
    for (int q = 0; q < 4; ++q) {
        const int t = t0 + wave + 8 * q; const size_t m = (size_t)b * T + t;
#pragma unroll
        for (int j = 0; j < 4; ++j) { const int back = 3 - j; const bf16* pr = p + (m - (size_t)((t >= back) ? back : 0)) * NP + C_BQ;
            x[q][j][0] = pr[cq]; x[q][j][1] = pr[ck]; x[q][j][2] = pr[cv0]; x[q][j][3] = pr[cv1]; }
        gk[q] = GK[m * 256 + h * 64 + lane];
    }
}
__device__ __forceinline__ void gl_prep(LAS float* B, int t0, int wave, int lane, const float (&wq)[4], const float (&wk)[4], const float (&wv0)[4], const float (&wv1)[4],
        const unsigned (&x)[4][4][4], const unsigned (&gk)[4]) {
    LAS float* Q = B; LAS float* K = Q + CH * 64; LAS float* DEC = K + CH * 64; LAS float* V = DEC + CH * 64;
#pragma unroll
    for (int q = 0; q < 4; ++q) {
        const int tt = wave + 8 * q, t = t0 + tt; float aq = 0.f, ak = 0.f, av0 = 0.f, av1 = 0.f;
#pragma unroll
        for (int j = 0; j < 4; ++j) { const float ok = (t >= 3 - j) ? 1.f : 0.f;
            aq += wq[j] * ok * bf2f(x[q][j][0]); ak += wk[j] * ok * bf2f(x[q][j][1]); av0 += wv0[j] * ok * bf2f(x[q][j][2]); av1 += wv1[j] * ok * bf2f(x[q][j][3]); }
        Q[tt * 64 + lane] = siluf_(aq) * 0.125f; K[tt * 64 + lane] = siluf_(ak); V[tt * 128 + lane] = siluf_(av0); V[tt * 128 + 64 + lane] = siluf_(av1);
        DEC[tt * 64 + lane] = __expf(bf2f(gk[q]));
    }
}
__device__ __forceinline__ void gla_item(const Params& P, LAS unsigned char* lds, int b, int h, int seg) {
    const int tid = threadIdx.x, lane = tid & 63, wave = tid >> 6;
    unsigned char* ws = P.ws;
    const bf16* p = (const bf16*)(ws + WS_P); const bf16* GK = (const bf16*)(ws + WS_GK);
    bf16* MIX = (bf16*)(ws + WS_MIX); bf16* YIG = (bf16*)(ws + WS_YIG);
    float* SE = (float*)(ws + WS_SEG) + ((size_t)(b * 4 + h) * NSEG + seg) * 8192; float* CE = (float*)(ws + WS_CEND) + ((size_t)(b * 4 + h) * NSEG + seg) * 64;
    const float* conv = P.in[15];
    LAS float* BUF = (LAS float*)lds; LAS float* O = BUF + 2 * GL_BUF; LAS float* YL = O + CH * 128;
    const int cq = h * 64 + lane, ck = 256 + h * 64 + lane, cv0 = 512 + h * 128 + lane, cv1 = cv0 + 64;
    float wq[4], wk[4], wv0[4], wv1[4];
#pragma unroll
    for (int j = 0; j < 4; ++j) { wq[j] = conv[j * 1024 + cq]; wk[j] = conv[j * 1024 + ck]; wv0[j] = conv[j * 1024 + cv0]; wv1[j] = conv[j * 1024 + cv1]; }
    float S[16], c[16];
#pragma unroll
    for (int j = 0; j < 16; ++j) { S[j] = 0.f; c[j] = 1.f; }
    const int row = wave * 16 + (lane >> 2), ks = (lane & 3) * 16;
    const int tbeg = seg * LSEG;
    unsigned x[4][4][4], gk[4];
    __syncthreads();
    gl_load(p, GK, b, h, tbeg, lane, wave, x, gk);
    gl_prep(BUF, tbeg, wave, lane, wq, wk, wv0, wv1, x, gk);
    __syncthreads();
    for (int ci = 0; ci < LSEG / CH; ++ci) {
        const int t0 = tbeg + ci * CH; LAS float* B = BUF + (ci & 1) * GL_BUF;
        LAS float* Q = B; LAS float* K = Q + CH * 64; LAS float* DEC = K + CH * 64; LAS float* V = DEC + CH * 64;
        const bool more = (ci + 1 < LSEG / CH);
        if (more) gl_load(p, GK, b, h, t0 + CH, lane, wave, x, gk);
        for (int tt = 0; tt < CH; ++tt) {
            const float vv = V[tt * 128 + row]; float o0 = 0.f, o1 = 0.f;
#pragma unroll
            for (int q4 = 0; q4 < 4; ++q4) {
                const f32x4 kk = *(const LAS f32x4*)(K + tt * 64 + ks + 4 * q4), dd = *(const LAS f32x4*)(DEC + tt * 64 + ks + 4 * q4), qq = *(const LAS f32x4*)(Q + tt * 64 + ks + 4 * q4);
#pragma unroll
                for (int j = 0; j < 4; ++j) { S[4 * q4 + j] = S[4 * q4 + j] * dd[j] + vv * kk[j]; if (q4 & 1) o1 += S[4 * q4 + j] * qq[j]; else o0 += S[4 * q4 + j] * qq[j]; }
                if (wave == 0) { f32x4 yi;
#pragma unroll
                    for (int j = 0; j < 4; ++j) { c[4 * q4 + j] *= dd[j]; yi[j] = c[4 * q4 + j] * qq[j]; }
                    if (lane < 4) *(LAS f32x4*)(YL + tt * 64 + ks + 4 * q4) = yi; }
            }
            const float o = red4(o0 + o1);
            if ((lane & 3) == 0) O[tt * 128 + row] = o;
        }
        __syncthreads();
        if (more) gl_prep(BUF + ((ci + 1) & 1) * GL_BUF, t0 + CH, wave, lane, wq, wk, wv0, wv1, x, gk);
#pragma unroll
        for (int q = 0; q < 4; ++q) {
            const int tt = wave + 8 * q; const size_t m = (size_t)b * T + t0 + tt;
            MIX[m * D + 512 + h * 128 + lane] = (bf16)f2bf(O[tt * 128 + lane]); MIX[m * D + 512 + h * 128 + 64 + lane] = (bf16)f2bf(O[tt * 128 + 64 + lane]);
            YIG[m * 256 + h * 64 + lane] = (bf16)f2bf(YL[tt * 64 + lane]);
        }
        __syncthreads();
    }
#pragma unroll
    for (int q4 = 0; q4 < 4; ++q4) *(f32x4*)(SE + row * 64 + ks + 4 * q4) = (f32x4){S[4 * q4], S[4 * q4 + 1], S[4 * q4 + 2], S[4 * q4 + 3]};
    if (wave == 0 && lane < 4) {
#pragma unroll
        for (int q4 = 0; q4 < 4; ++q4) *(f32x4*)(CE + ks + 4 * q4) = (f32x4){c[4 * q4], c[4 * q4 + 1], c[4 * q4 + 2], c[4 * q4 + 3]};
    }
}
__device__ __forceinline__ void phase_scan(const Params& P, LAS unsigned char* lds) {
    for (int it = blockIdx.x; it < 512 + 256; it += gridDim.x) {
        if (it < 512) { const int bh = it >> 4; rwkv_item(P, lds, bh >> 3, bh & 7, it & 15); }
        else { const int g = it - 512, bh = g >> 4; gla_item(P, lds, bh >> 2, bh & 3, g & 15); }
        __syncthreads();
    }
}
__device__ __forceinline__ void phase_fixup(const Params& P, LAS unsigned char* lds) {
    const int tid = threadIdx.x;
    for (int it = blockIdx.x; it < 48; it += gridDim.x) {
        if (it < 32) {
            float* SE = (float*)(P.ws + WS_SER) + (size_t)it * NSEG * 2 * 4096;
            LAS float* Sc = (LAS float*)lds; LAS float* Ph = Sc + 64 * 65;
            const int v = tid >> 3, kq = (tid & 7) * 8;
            __syncthreads();
            for (int i = tid; i < 64 * 65; i += NTHR) Sc[i] = 0.f;
            for (int seg = 0; seg < NSEG - 1; ++seg) {
                float* s0 = SE + (size_t)(seg * 2 + 0) * 4096; const float* ph = SE + (size_t)(seg * 2 + 1) * 4096;
                __syncthreads();
                for (int i = tid; i < 1024; i += NTHR) *(LAS f32x4*)(Ph + 4 * i) = *(const f32x4*)(ph + 4 * i);
                f32x4 a0 = *(const f32x4*)(s0 + v * 64 + kq), a1 = *(const f32x4*)(s0 + v * 64 + kq + 4);
                __syncthreads();
                for (int j = 0; j < 64; ++j) { const float sv = Sc[v * 65 + j]; a0 += *(const LAS f32x4*)(Ph + j * 64 + kq) * sv; a1 += *(const LAS f32x4*)(Ph + j * 64 + kq + 4) * sv; }
                __syncthreads();
#pragma unroll
                for (int i = 0; i < 4; ++i) { Sc[v * 65 + kq + i] = a0[i]; Sc[v * 65 + kq + 4 + i] = a1[i]; }
                *(f32x4*)(s0 + v * 64 + kq) = a0; *(f32x4*)(s0 + v * 64 + kq + 4) = a1;
            }
        } else {
            const int bh = it - 32; float* SE = (float*)(P.ws + WS_SEG) + (size_t)bh * NSEG * 8192; const float* CE = (const float*)(P.ws + WS_CEND) + (size_t)bh * NSEG * 64;
            const int v = tid >> 2, d0 = (tid & 3) * 16; f32x4 sc[4];
#pragma unroll
            for (int q = 0; q < 4; ++q) sc[q] = (f32x4){0.f, 0.f, 0.f, 0.f};
            for (int seg = 0; seg < NSEG - 1; ++seg) {
#pragma unroll
                for (int q = 0; q < 4; ++q) { float* sp = SE + (size_t)seg * 8192 + v * 64 + d0 + 4 * q; sc[q] = sc[q] * *(const f32x4*)(CE + seg * 64 + d0 + 4 * q) + *(const f32x4*)sp; *(f32x4*)sp = sc[q]; }
            }
        }
    }
}
__device__ __forceinline__ void phase_correct(const Params& P, LAS unsigned char* lds) {
    const int tid = threadIdx.x, lane = tid & 63, wave = tid >> 6;
    unsigned char* ws = P.ws;
    const bf16* p = (const bf16*)(ws + WS_P); const bf16* AA = (const bf16*)(ws + WS_AA); const bf16* GG = (const bf16*)(ws + WS_GG);
    bf16* MIX = (bf16*)(ws + WS_MIX); const bf16* YI = (const bf16*)(ws + WS_YI); const bf16* YIG = (const bf16*)(ws + WS_YIG);
    const float* mu = P.in[4]; const float* k_a = P.in[11]; const float* r_k = P.in[12]; const float* gn_g = P.in[13]; const float* gn_b = P.in[14]; const float* norm_g = P.in[18];
    LAS float* SL = (LAS float*)lds;
    for (int it = blockIdx.x; it < 512 + 256; it += gridDim.x) {
        __syncthreads();
        if (it < 512) {
            const int seg = it & 15, bh = it >> 4, b = bh >> 3, h = bh & 7;
            if (seg > 0) { const float* ss = (const float*)(ws + WS_SER) + (((size_t)bh * NSEG + (seg - 1)) * 2) * 4096;
                for (int i = tid; i < 4096; i += NTHR) SL[(i & 63) * 65 + (i >> 6)] = ss[i]; }
            __syncthreads();
            const int col = h * 64 + lane;
            const float mu_r = mu[C_R + col], mu_k = mu[C_K + col], mu_v = mu[C_V + col], kac = k_a[col], rkc = r_k[col], gng = gn_g[col], gnb = gn_b[col];
            for (int i0 = 0; i0 < 64; i0 += 4) {
                float y[4], yi[4], r[4], k[4], v[4], a[4], g[4];
#pragma unroll
                for (int u = 0; u < 4; ++u) {
                    const int t = seg * LSEG + wave * 64 + i0 + u; const size_t m = (size_t)b * T + t; const bf16* pr = p + m * NP; const bf16* pp = (t > 0) ? pr - NP : pr; const float hp = (t > 0) ? 1.f : 0.f;
                    y[u] = bf2f(MIX[m * D + col]); yi[u] = bf2f(YI[m * 512 + col]);
                    const float rc = bf2f(pr[C_R + col]), kc = bf2f(pr[C_K + col]), vc = bf2f(pr[C_V + col]);
                    r[u] = rc + (bf2f(pp[C_R + col]) * hp - rc) * mu_r; k[u] = kc + (bf2f(pp[C_K + col]) * hp - kc) * mu_k; v[u] = vc + (bf2f(pp[C_V + col]) * hp - vc) * mu_v;
                    a[u] = bf2f(AA[m * A_W + col]); g[u] = bf2f(GG[m * A_W + col]);
                }
                if (seg > 0) {
                    for (int j = 0; j < 64; ++j) { const float sv = SL[j * 65 + lane];
#pragma unroll
                        for (int u = 0; u < 4; ++u) y[u] += rlf(yi[u], j) * sv; }
                }
#pragma unroll
                for (int u = 0; u < 4; ++u) {
                    const size_t m = (size_t)b * T + seg * LSEG + wave * 64 + i0 + u;
                    const float kh = k[u] * (1.f + (a[u] - 1.f) * kac); const float bon = wave_sum(r[u] * kh * rkc);
                    const float mean = wave_sum(y[u]) * (1.f / 64.f); const float d = y[u] - mean; const float var = wave_sum(d * d) * (1.f / 64.f);
                    float o = d * (1.f / sqrtf(var + GN_EPS)) * gng + gnb; o += bon * v[u]; o *= g[u];
                    MIX[m * D + col] = (bf16)f2bf(o);
                }
            }
        } else {
            const int g_ = it - 512, seg = g_ & 15, bh = g_ >> 4, b = bh >> 2, h = bh & 3;
            if (seg > 0) { const float* ss = (const float*)(ws + WS_SEG) + ((size_t)bh * NSEG + (seg - 1)) * 8192;
                for (int i = tid; i < 8192; i += NTHR) SL[(i & 63) * 129 + (i >> 6)] = ss[i]; }
            __syncthreads();
            const float ng0 = norm_g[lane], ng1 = norm_g[lane + 64];
            for (int i0 = 0; i0 < 64; i0 += 4) {
                float o0[4], o1[4], yi[4], g0[4], g1[4];
#pragma unroll
                for (int u = 0; u < 4; ++u) {
                    const size_t m = (size_t)b * T + seg * LSEG + wave * 64 + i0 + u;
                    o0[u] = bf2f(MIX[m * D + 512 + h * 128 + lane]); o1[u] = bf2f(MIX[m * D + 512 + h * 128 + 64 + lane]); yi[u] = bf2f(YIG[m * 256 + h * 64 + lane]);
                    g0[u] = bf2f(p[m * NP + C_BG + h * 128 + lane]); g1[u] = bf2f(p[m * NP + C_BG + h * 128 + 64 + lane]);
                }
                if (seg > 0) {
                    for (int d = 0; d < 64; ++d) { const float s0 = SL[d * 129 + lane], s1 = SL[d * 129 + 64 + lane];
#pragma unroll
                        for (int u = 0; u < 4; ++u) { const float q = rlf(yi[u], d); o0[u] += q * s0; o1[u] += q * s1; } }
                }
#pragma unroll
                for (int u = 0; u < 4; ++u) {
                    const size_t m = (size_t)b * T + seg * LSEG + wave * 64 + i0 + u;
                    const float ms = wave_sum(o0[u] * o0[u] + o1[u] * o1[u]) * (1.f / 128.f); const float rs = 1.f / sqrtf(ms + RMS_EPS);
                    MIX[m * D + 512 + h * 128 + lane] = (bf16)f2bf(o0[u] * rs * ng0 * siluf_(g0[u])); MIX[m * D + 512 + h * 128 + 64 + lane] = (bf16)f2bf(o1[u] * rs * ng1 * siluf_(g1[u]));
                }
            }
        }
    }
}

__device__ __forceinline__ void phase_ln1(const Params& P) {
    const int lane = threadIdx.x & 63, wave = threadIdx.x >> 6; const int gw = blockIdx.x * NWAVES + wave, ngw = gridDim.x * NWAVES;
    for (int m = gw; m < M; m += ngw) ln_row_bf16((const float*)(P.ws + WS_Z) + (size_t)m * D, P.in[20], P.in[21], (bf16*)(P.ws + WS_H1) + (size_t)m * D, lane);
#pragma unroll
    for (int tb = 0; tb < 2; ++tb) {
        const float* src = P.in[24 + tb]; unsigned char* dst = P.ws + (tb ? WS_VT : WS_UT); float* sc = (float*)(P.ws + (tb ? WS_SV : WS_SU));
        for (int e = gw; e < 16384; e += ngw) {
            const f32x4* sp = (const f32x4*)(src + (size_t)e * D) + 4 * lane; f32x4 a[4]; float mx = 0.f;
#pragma unroll
            for (int j = 0; j < 4; ++j) { a[j] = sp[j]; mx = fmaxf(fmaxf(mx, fmaxf(fabsf(a[j][0]), fabsf(a[j][1]))), fmaxf(fabsf(a[j][2]), fabsf(a[j][3]))); }
            mx = wave_max_u(mx); const float inv = mx > 0.f ? 127.f / mx : 0.f;
            u32x4 o;
#pragma unroll
            for (int j = 0; j < 4; ++j) o[j] = pack_i8(a[j][0], a[j][1], a[j][2], a[j][3], inv, tb ? 128 : 0);
            *((u32x4*)(dst + (size_t)e * D) + lane) = o;
            if (lane == 0) sc[e] = mx * (1.f / 127.f);
        }
    }
}

#define TK_INS(L, x) do { _Pragma("unroll") for (int _j = 0; _j < 16; ++_j) { const unsigned _h = max(L[_j], x); x = min(L[_j], x); L[_j] = _h; } } while (0)
__device__ __forceinline__ void topk128(const u32x4* r, unsigned (&L)[16]) {
#pragma unroll
    for (int j = 0; j < 16; ++j) L[j] = 0u;
    u32x4 cur = r[0];
    for (int c = 0; c < 16; ++c) {
        const u32x4 nxt = r[(c + 1) & 15];
        const unsigned kb = 0xFFFFu - 8u * (unsigned)c;
#pragma unroll
        for (int d = 0; d < 4; ++d) {
            unsigned w = cur[d]; const unsigned msk = ((w >> 15) & 0x00010001u) * 0xFFFFu; w ^= (msk | 0x80008000u);
            unsigned x0 = (w << 16) | (kb - 2u * d), x1 = (w & 0xFFFF0000u) | (kb - 2u * d - 1u);
            TK_INS(L, x0); TK_INS(L, x1);
        }
        cur = nxt;
    }
}
__device__ __forceinline__ void phase_topk(const Params& P) {
    const int gl = blockIdx.x * NTHR + threadIdx.x, nl = gridDim.x * NTHR;
    const bf16* Sc = (const bf16*)(P.ws + WS_S); int* IDS = (int*)(P.ws + WS_IDS); float* GATES = (float*)(P.ws + WS_GATES);
    for (int item = gl; item < M * 8; item += nl) {
        const u32x4* row = (const u32x4*)(Sc + (size_t)item * 256);
        unsigned L0[16], L1[16];
        topk128(row, L0); topk128(row + 16, L1);
        float f0[16], f1[16]; unsigned p0[16], p1[16];
#pragma unroll
        for (int i = 0; i < 16; ++i) {
            f0[i] = __uint_as_float((L0[i] & 0x80000000u) ? (L0[i] & 0x7FFF0000u) : (~L0[i] & 0xFFFF0000u)); p0[i] = (~L0[i] & 0x7Fu) << 7;
            f1[i] = __uint_as_float((L1[i] & 0x80000000u) ? (L1[i] & 0x7FFF0000u) : (~L1[i] & 0xFFFF0000u)); p1[i] = (~L1[i] & 0x7Fu);
        }
        unsigned C[16];
#pragma unroll
        for (int j = 0; j < 16; ++j) C[j] = 0u;
#pragma unroll
        for (int i = 0; i < 16; ++i)
#pragma unroll
            for (int j = 0; j < 16; ++j)
                if ((i + 1) * (j + 1) <= 16) {
                    const unsigned b = __float_as_uint(f0[i] + f1[j]); const unsigned mono = b ^ ((unsigned)((int)b >> 31) | 0x80000000u);
                    unsigned key = (mono & 0xFFFFC000u) | p0[i] | p1[j];
                    TK_INS(C, key);
                }
        float cv[16];
#pragma unroll
        for (int r = 0; r < 16; ++r) cv[r] = __uint_as_float((C[r] & 0x80000000u) ? (C[r] & 0x7FFFC000u) : (~C[r] & 0xFFFFC000u));
        const float cmax = cv[0]; float den = 0.f;
#pragma unroll
        for (int r = 0; r < 16; ++r) { cv[r] = __expf(cv[r] - cmax); den += cv[r]; }
        const float inv = 1.f / den;
        u32x4* ido = (u32x4*)(IDS + (size_t)item * 16); f32x4* go = (f32x4*)(GATES + (size_t)item * 16);
#pragma unroll
        for (int q = 0; q < 4; ++q) { u32x4 o; o.x = C[4 * q] & 0x3FFFu; o.y = C[4 * q + 1] & 0x3FFFu; o.z = C[4 * q + 2] & 0x3FFFu; o.w = C[4 * q + 3] & 0x3FFFu; ido[q] = o;
            f32x4 g; g[0] = cv[4 * q] * inv; g[1] = cv[4 * q + 1] * inv; g[2] = cv[4 * q + 2] * inv; g[3] = cv[4 * q + 3] * inv; go[q] = g; }
    }
}

typedef __bf16 bf16x2_t __attribute__((ext_vector_type(2)));
__device__ __forceinline__ float dot2bf(unsigned a, unsigned b, float c) { return __builtin_amdgcn_fdot2_f32_bf16(__builtin_bit_cast(bf16x2_t, a), __builtin_bit_cast(bf16x2_t, b), c, false); }
__device__ __forceinline__ void peer_load8(u32x4 (&buf)[8], const unsigned char* TAB, int idreg, int g, int lane) {
#pragma unroll
    for (int q = 0; q < 8; ++q) { const int id = __builtin_amdgcn_readlane(idreg, 8 * g + q); buf[q] = *((const u32x4*)(TAB + (size_t)id * D) + lane); }
}
__device__ __forceinline__ void peer_dots8(const u32x4 (&buf)[8], const u32x4& hq, int g, float& d, int lane) {
#pragma unroll
    for (int q = 0; q < 8; ++q) { int s = 0;
#pragma unroll
        for (int i = 0; i < 4; ++i) s = __builtin_amdgcn_sdot4((int)buf[q][i], (int)hq[i], s, false);
        const int tot = wave_sum_i(s);
        d = (lane == 8 * g + q) ? (float)tot : d; }
}
__device__ __forceinline__ void peer_axpy8(const u32x4 (&buf)[8], float areg, int g, float (&acc)[16]) {
#pragma unroll
    for (int q = 0; q < 8; ++q) { const float a = rlf(areg, 8 * g + q);
#pragma unroll
        for (int i = 0; i < 4; ++i) { const unsigned w = buf[q][i];
            acc[4 * i] += a * (float)(w & 0xffu); acc[4 * i + 1] += a * (float)((w >> 8) & 0xffu); acc[4 * i + 2] += a * (float)((w >> 16) & 0xffu); acc[4 * i + 3] += a * (float)(w >> 24); } }
}
__device__ __forceinline__ void phase_peer(const Params& P) {
    const int lane = threadIdx.x & 63, wave = threadIdx.x >> 6; const int gw = blockIdx.x * NWAVES + wave, ngw = gridDim.x * NWAVES;
    const bf16* H1 = (const bf16*)(P.ws + WS_H1); const int* IDS = (const int*)(P.ws + WS_IDS); const float* GATES = (const float*)(P.ws + WS_GATES);
    const unsigned char* UT = P.ws + WS_UT; const unsigned char* VT = P.ws + WS_VT; const float* SU = (const float*)(P.ws + WS_SU); const float* SV = (const float*)(P.ws + WS_SV);
    const float* g2 = P.in[26]; const float* b2 = P.in[27];
    for (int m = gw; m < M; m += ngw) {
        const u32x4* hp = (const u32x4*)(H1 + (size_t)m * D) + 2 * lane; const u32x4 hA = hp[0], hB = hp[1];
        float hv[16]; float hmx = 0.f;
#pragma unroll
        for (int i = 0; i < 4; ++i) { hv[2 * i] = __uint_as_float(hA[i] << 16); hv[2 * i + 1] = __uint_as_float(hA[i] & 0xffff0000u); hv[8 + 2 * i] = __uint_as_float(hB[i] << 16); hv[8 + 2 * i + 1] = __uint_as_float(hB[i] & 0xffff0000u); }
#pragma unroll
        for (int i = 0; i < 16; ++i) hmx = fmaxf(hmx, fabsf(hv[i]));
        hmx = wave_max_u(hmx); const float hinv = hmx > 0.f ? 127.f / hmx : 0.f, hsc = hmx * (1.f / 127.f);
        u32x4 hq;
#pragma unroll
        for (int i = 0; i < 4; ++i) hq[i] = pack_i8(hv[4 * i], hv[4 * i + 1], hv[4 * i + 2], hv[4 * i + 3], hinv, 0);
        const int id_lo = IDS[(size_t)m * 128 + lane], id_hi = IDS[(size_t)m * 128 + 64 + lane];
        const float gt_lo = GATES[(size_t)m * 128 + lane], gt_hi = GATES[(size_t)m * 128 + 64 + lane];
        const float su_lo = SU[id_lo], su_hi = SU[id_hi], sv_lo = SV[id_lo], sv_hi = SV[id_hi];
        float d_lo = 0.f, d_hi = 0.f;
        u32x4 A0[8], A1[8];
        peer_load8(A0, UT, id_lo, 0, lane);
        for (int g = 0; g < 8; g += 2) {
            peer_load8(A1, UT, id_lo, g + 1, lane); peer_dots8(A0, hq, g, d_lo, lane);
            if (g + 2 < 8) peer_load8(A0, UT, id_lo, g + 2, lane); else peer_load8(A0, UT, id_hi, 0, lane);
            peer_dots8(A1, hq, g + 1, d_lo, lane);
        }
        for (int g = 0; g < 8; g += 2) {
            peer_load8(A1, UT, id_hi, g + 1, lane); peer_dots8(A0, hq, g, d_hi, lane);
            if (g + 2 < 8) peer_load8(A0, UT, id_hi, g + 2, lane); else peer_load8(A0, VT, id_lo, 0, lane);
            peer_dots8(A1, hq, g + 1, d_hi, lane);
        }
        const float x_lo = d_lo * su_lo * hsc, x_hi = d_hi * su_hi * hsc;
        const float a_lo = 0.5f * x_lo * (1.f + erff(x_lo * 0.70710678118f)) * gt_lo * sv_lo, a_hi = 0.5f * x_hi * (1.f + erff(x_hi * 0.70710678118f)) * gt_hi * sv_hi;
        const float c0 = 128.f * wave_sum(a_lo + a_hi);
        float acc[16];
#pragma unroll
        for (int i = 0; i < 16; ++i) acc[i] = 0.f;
        for (int g = 0; g < 8; g += 2) {
            peer_load8(A1, VT, id_lo, g + 1, lane); peer_axpy8(A0, a_lo, g, acc);
            if (g + 2 < 8) peer_load8(A0, VT, id_lo, g + 2, lane); else peer_load8(A0, VT, id_hi, 0, lane);
            peer_axpy8(A1, a_lo, g + 1, acc);
        }
        for (int g = 0; g < 8; g += 2) {
            peer_load8(A1, VT, id_hi, g + 1, lane); peer_axpy8(A0, a_hi, g, acc);
            if (g + 2 < 8) peer_load8(A0, VT, id_hi, g + 2, lane);
            peer_axpy8(A1, a_hi, g + 1, acc);
        }
        float s = 0.f;
#pragma unroll
        for (int i = 0; i < 16; ++i) { acc[i] = ALPHA * hv[i] + (acc[i] - c0); s += acc[i]; }
        const float mean = wave_sum(s) * (1.f / D); float s2 = 0.f;
#pragma unroll
        for (int i = 0; i < 16; ++i) { acc[i] -= mean; s2 += acc[i] * acc[i]; }
        const float rstd = 1.f / sqrtf(wave_sum(s2) * (1.f / D) + LN_EPS);
#pragma unroll
        for (int c4 = 0; c4 < 4; ++c4) { const int e0 = 16 * lane + 4 * c4; const f32x4 gg = *(const f32x4*)(g2 + e0), bb = *(const f32x4*)(b2 + e0); f32x4 o;
#pragma unroll
            for (int j = 0; j < 4; ++j) o[j] = acc[c4 * 4 + j] * rstd * gg[j] + bb[j];
            *(f32x4*)(P.out + (size_t)m * D + e0) = o; }
    }
}

#define XB_TMO      128
#define XB_XCNT(j)  (256  + 64 * (j))
#define XB_XSUB(j)  (1280 + 64 * (j))
#define XB_XGEN(j)  (2304 + 64 * (j))
#define XB_TOP      3328
#define XB_TOPGEN   3392
#define XCD_BAR_WORDS 3456
#define XB_SPIN_CAP (1u << 18)
__device__ __forceinline__ unsigned xb_ld(unsigned* p)              { return __hip_atomic_load(p, __ATOMIC_RELAXED, __HIP_MEMORY_SCOPE_AGENT); }
__device__ __forceinline__ unsigned xb_add(unsigned* p, unsigned v) { return __hip_atomic_fetch_add(p, v, __ATOMIC_RELAXED, __HIP_MEMORY_SCOPE_AGENT); }
__device__ __forceinline__ unsigned xb_xcc_id() { return (unsigned)__builtin_amdgcn_s_getreg((3 << 11) | 20) & 0xFu; }
#define XB_SPIN(cond, bar) do { unsigned _sp = 0; while (cond) { __builtin_amdgcn_s_sleep(1); \
    if ((++_sp & 255u) == 0u) { if (xb_ld(&(bar)[XB_TMO])) break; if (_sp > XB_SPIN_CAP) { atomicAdd(&(bar)[XB_TMO], 1u); break; } } } } while (0)
struct XcdBarrier { unsigned* bar; unsigned x; volatile LAS unsigned* st; };
__device__ __forceinline__ XcdBarrier xcd_barrier_post(unsigned* bar, volatile LAS unsigned* st) {
    XcdBarrier b; b.bar = bar; b.x = xb_xcc_id(); b.st = st;
    if (threadIdx.x == 0) (void)xb_add(&bar[XB_XCNT(b.x)], 1u);
    return b;
}
__device__ __forceinline__ void xcd_barrier_complete(unsigned* bar, unsigned x, unsigned& nloc, unsigned& nx) {
    const unsigned G = gridDim.x * gridDim.y * gridDim.z;
    unsigned sum, cnt, mine, sp = 0u;
    for (;;) {
        sum = 0u; cnt = 0u; mine = 0u;
#pragma unroll
        for (unsigned j = 0; j < 16; ++j) { const unsigned c = xb_ld(&bar[XB_XCNT(j)]); sum += c; cnt += (c > 0u) ? 1u : 0u; mine = (j == x) ? c : mine; }
        if (sum == G) break;
        __builtin_amdgcn_s_sleep(1);
        if ((++sp & 255u) == 0u) { if (xb_ld(&bar[XB_TMO])) break; if (sp > XB_SPIN_CAP) { atomicAdd(&bar[XB_TMO], 1u); break; } }
    }
    nloc = mine > 0u ? mine : 1u; nx = cnt > 0u ? cnt : 1u;
}
__device__ __forceinline__ void xcd_barrier(const XcdBarrier& b) {
    asm volatile("s_waitcnt vmcnt(0)" ::: "memory");
    __syncthreads();
    if (threadIdx.x == 0) {
        unsigned* bar = b.bar;
        __builtin_amdgcn_s_waitcnt(0);
        unsigned nloc = b.st[0], nx = b.st[1];
        if (nloc == 0u) { xcd_barrier_complete(bar, b.x, nloc, nx); b.st[0] = nloc; b.st[1] = nx; }
        const unsigned old = xb_add(&bar[XB_XSUB(b.x)], 1u);
        const unsigned gen = old / nloc;
        if (old + 1u == (gen + 1u) * nloc) {
            __builtin_amdgcn_fence(__ATOMIC_RELEASE, "agent");
            asm volatile("s_waitcnt vmcnt(0)" ::: "memory");
            const unsigned og = xb_add(&bar[XB_TOP], 1u);
            const unsigned tg = og / nx;
            if (og + 1u == (tg + 1u) * nx) xb_add(&bar[XB_TOPGEN], 1u);
            else XB_SPIN(xb_ld(&bar[XB_TOPGEN]) == tg, bar);
            __builtin_amdgcn_fence(__ATOMIC_ACQUIRE, "agent");
            xb_add(&bar[XB_XGEN(b.x)], 1u);
            asm volatile("s_waitcnt vmcnt(0)" ::: "memory");
        } else {
            XB_SPIN(xb_ld(&bar[XB_XGEN(b.x)]) == gen, bar);
            __builtin_amdgcn_fence(__ATOMIC_ACQUIRE, "agent");
            asm volatile("s_waitcnt vmcnt(0)" ::: "memory");
        }
    }
    __syncthreads();
}

constexpr int N_PHASES = 12;
__global__ void __launch_bounds__(NTHR, 2) fwd_kernel(Params P) {
    extern __shared__ __attribute__((aligned(16))) unsigned char lds_raw[];
    LAS unsigned char* lds = (LAS unsigned char*)lds_raw;
    cg::grid_group grid = cg::this_grid();
    const int lo = P.ph_lo, hi = P.ph_hi;
    unsigned char* ws = P.ws;
    volatile LAS unsigned* bst = (volatile LAS unsigned*)(lds + LDS_MISC);
    if (threadIdx.x < 16) bst[threadIdx.x] = 0u;
    __syncthreads();
    const XcdBarrier bar = xcd_barrier_post((unsigned*)(ws + WS_CTL), bst);
#define IN(k) (lo <= (k) && (k) < hi)
#define SEAM(k) do { if (IN(k) && IN((k) + 1)) { if ((k) == 0) grid.sync(); else xcd_barrier(bar); } } while (0)
    if (IN(0)) phase_prologue(P);
    SEAM(0);
    if (IN(1)) {
        pg8::Gemm g{(const bf16*)(ws + WS_H0), (const bf16*)(ws + WS_WIN), M, NP, D, D, D, 0}; pg8::StaticOrder S; S.init(M, NP, gridDim.x, blockIdx.x);
        pg8::EpiBf16 E{(bf16*)(ws + WS_P), NP};
        pg8::gemm_phase<pg8::EpiBf16, pg8::StaticOrder, true, true>(lds, g, S, E);
    }
    SEAM(1);
    if (IN(2)) phase_prep(P, lds);
    SEAM(2);
    if (IN(3)) phase_scan(P, lds);
    SEAM(3);
    if (IN(4)) phase_fixup(P, lds);
    SEAM(4);
    if (IN(5)) phase_correct(P, lds);
    SEAM(5);
    if (IN(6)) {
        pg8::Gemm g{(const bf16*)(ws + WS_MIX), (const bf16*)(ws + WS_WOUT), M, D, D, D, D, 0}; pg8::StaticOrder S; S.init(M, D, gridDim.x, blockIdx.x);
        pg8::EpiResF32 E{(float*)(ws + WS_Z), (const bf16*)(ws + WS_H0), D, ALPHA};
        pg8::gemm_phase<pg8::EpiResF32, pg8::StaticOrder, true, true>(lds, g, S, E);
    }
    SEAM(6);
    if (IN(7)) phase_ln1(P);
    SEAM(7);
    if (IN(8)) {
        pg8::Gemm g{(const bf16*)(ws + WS_H1), (const bf16*)(ws + WS_WQ), M, NQ, D, D, D, 0}; pg8::StaticOrder S; S.init(M, NQ, gridDim.x, blockIdx.x);
        pg8::EpiBf16 E{(bf16*)(ws + WS_Q), NQ};
        pg8::gemm_phase<pg8::EpiBf16, pg8::StaticOrder, true, true>(lds, g, S, E);
    }
    SEAM(8);
    if (IN(9)) {
        pg8::Gemm g{(const bf16*)(ws + WS_Q), (const bf16*)(ws + WS_KBD), M, NQ, 256, NQ, 256, 256}; pg8::StaticOrder S; S.init(M, NQ, gridDim.x, blockIdx.x);
        pg8::EpiBf16 E{(bf16*)(ws + WS_S), NQ};
        pg8::gemm_phase<pg8::EpiBf16, pg8::StaticOrder, true, true>(lds, g, S, E);
    }
    SEAM(9);
    if (IN(10)) phase_topk(P);
    SEAM(10);
    if (IN(11)) phase_peer(P);
#undef IN
#undef SEAM
}

extern "C" void kernel_launch(void* const* d_in, const int* in_sizes, int n_in, void* d_out, int out_size, void* d_ws, size_t ws_size, hipStream_t stream) {
    static int grid = 0;
    if (grid == 0) {
        if (n_in != 28 || out_size != M * D || ws_size < WS_END) { fprintf(stderr, "kernel_launch: unexpected shapes (n_in %d out %d ws %zu)\n", n_in, out_size, ws_size); grid = -1; return; }
        int dev = 0, cus = 0, per_cu = 0;
        (void)hipGetDevice(&dev); (void)hipDeviceGetAttribute(&cus, hipDeviceAttributeMultiprocessorCount, dev);
        (void)hipFuncSetAttribute((const void*)fwd_kernel, hipFuncAttributeMaxDynamicSharedMemorySize, LDS_BYTES);
        (void)hipOccupancyMaxActiveBlocksPerMultiprocessor(&per_cu, (const void*)fwd_kernel, NTHR, LDS_BYTES);
        if (per_cu < 1) { fprintf(stderr, "kernel_launch: occupancy query says %d blocks per CU\n", per_cu); per_cu = 1; }
        (void)hipGetLastError();
        grid = cus;
    }
    if (grid < 0) return;
    Params p{};
    for (int i = 0; i < 28; ++i) p.in[i] = (const float*)d_in[i];
    p.out = (float*)d_out; p.ws = (unsigned char*)d_ws;
    (void)hipMemsetAsync((char*)d_ws + WS_CTL, 0, CTL_BYTES, stream);
#if MK_ONE_LAUNCH
    p.ph_lo = 0; p.ph_hi = N_PHASES;
    void* args[] = {&p};
    hipError_t e = hipLaunchCooperativeKernel((const void*)fwd_kernel, dim3(grid), dim3(NTHR), args, LDS_BYTES, stream);
    if (e != hipSuccess) fprintf(stderr, "cooperative launch failed: %s (grid %d)\n", hipGetErrorString(e), grid);
#else
    for (int ph = 0; ph < N_PHASES; ++ph) {
        p.ph_lo = ph; p.ph_hi = ph + 1;
        hipLaunchKernelGGL(fwd_kernel, dim3(grid), dim3(NTHR), LDS_BYTES, stream, p);
    }
#endif
}
```

```cpp
#include <hip/hip_runtime.h>
#include <hip/hip_cooperative_groups.h>
#include <cstdio>
#include <cstdint>
namespace cg = cooperative_groups;

#ifndef MK_ONE_LAUNCH
#define MK_ONE_LAUNCH 1
#endif

namespace pg8 {
#define PG8_LAS __attribute__((address_space(3)))
typedef unsigned short bf16_t;
typedef short bf16x8 __attribute__((ext_vector_type(8)));
typedef float f32x4 __attribute__((ext_vector_type(4)));
typedef float f32x2 __attribute__((ext_vector_type(2)));
typedef unsigned u32x4 __attribute__((ext_vector_type(4)));
typedef unsigned u32x2 __attribute__((ext_vector_type(2)));
constexpr int BM = 256, BK = 64, HALF = 128, HTB = HALF * BK * 2, STAGE_BYTES = 8 * HTB, NXCD = 8, WGM = 8;

__host__ __device__ __forceinline__ int lds_byte(int r, int c) { const int st = (r >> 4) * 2 + (c >> 5), rr = r & 15, cc = c & 31, ob = rr * 64 + cc * 2; return st * 1024 + (ob ^ (((ob >> 9) & 1) << 5)); }
__host__ __device__ __forceinline__ void stage_rc(int b, int& R, int& C) { const int st = b / 1024, sb = b % 1024, swz = sb ^ (((sb >> 9) & 1) << 5); R = (st >> 1) * 16 + swz / 64; C = (st & 1) * 32 + (swz % 64) / 2; }
__host__ __device__ __forceinline__ int perm32(int rho) { const int n = rho >> 4, i = rho & 15; return 8 * (i >> 2) + 4 * n + (i & 3); }

struct Unit { int pm, pn; };
struct Gemm { const bf16_t* A; const bf16_t* Bt; int M, N, K, lda, ldb, a_pn_koff; };

struct StaticOrder {
    int nM, nN, nwg, G, c;
    __host__ __device__ void init(int M, int N, int G_, int c_) { nM = M / BM; nN = N / BM; nwg = nM * nN; G = G_; c = c_; }
    __host__ __device__ bool next(int i, Unit& u) const {
        const long L = (long)i * G + c; if (L >= nwg) return false;
        int wgid = (int)L; { const int q = nwg / NXCD, r = nwg % NXCD, xcd = wgid % NXCD, off = wgid / NXCD; wgid = (xcd < r ? xcd * (q + 1) : r * (q + 1) + (xcd - r) * q) + off; }
        const int nig = WGM * nN, gid = wgid / nig, fm = gid * WGM, gsz = (nM - fm) < WGM ? (nM - fm) : WGM;
        u.pm = fm + ((wgid % nig) % gsz); u.pn = (wgid % nig) / gsz; return true;
    }
    __device__ __forceinline__ void a_ready(const Unit&) const {}
    __device__ __forceinline__ void done(const Unit&) const {}
};

__device__ __forceinline__ unsigned cvt_pk_bf16(float lo, float hi) { unsigned r; asm volatile("v_cvt_pk_bf16_f32 %0, %1, %2" : "=v"(r) : "v"(lo), "v"(hi)); return r; }

struct EpiBf16 {
    static constexpr bool PERM = true;
    bf16_t* O; int ldc;
    __device__ __forceinline__ void operator()(const f32x4 (&acc)[2][2][4][2], const Unit& u, int wr, int wc, int fr, int fq) const {
        const int row0 = u.pm * BM + wr * 64 + fr; const int col0 = u.pn * BM + wc * 32 + 8 * fq;
#pragma unroll
        for (int ai = 0; ai < 2; ++ai)
#pragma unroll
            for (int m = 0; m < 4; ++m) { bf16_t* rowp = O + (size_t)(row0 + ai * HALF + m * 16) * ldc + col0;
#pragma unroll
                for (int bj = 0; bj < 2; ++bj) { const f32x4 v0 = acc[ai][bj][m][0], v1 = acc[ai][bj][m][1];
                    u32x4 w; w.x = cvt_pk_bf16(v0[0], v0[1]); w.y = cvt_pk_bf16(v0[2], v0[3]); w.z = cvt_pk_bf16(v1[0], v1[1]); w.w = cvt_pk_bf16(v1[2], v1[3]);
                    *(u32x4*)(rowp + bj * HALF) = w; } }
    }
};
struct EpiResF32 {
    static constexpr bool PERM = false;
    float* Z; const bf16_t* R; int ldc; float alpha;
    __device__ __forceinline__ void operator()(const f32x4 (&acc)[2][2][4][2], const Unit& u, int wr, int wc, int fr, int fq) const {
        const int row0 = u.pm * BM + wr * 64 + fr; const int col0 = u.pn * BM + wc * 32 + 4 * fq;
#pragma unroll
        for (int ai = 0; ai < 2; ++ai)
#pragma unroll
            for (int m = 0; m < 4; ++m) { const size_t off = (size_t)(row0 + ai * HALF + m * 16) * ldc + col0;
#pragma unroll
                for (int bj = 0; bj < 2; ++bj)
#pragma unroll
                    for (int n = 0; n < 2; ++n) { const size_t o2 = off + bj * HALF + n * 16; const u32x2 rb = *(const u32x2*)(R + o2);
                        f32x4 h; h[0] = __uint_as_float(rb.x << 16); h[1] = __uint_as_float(rb.x & 0xffff0000u); h[2] = __uint_as_float(rb.y << 16); h[3] = __uint_as_float(rb.y & 0xffff0000u);
                        *(f32x4*)(Z + o2) = h * alpha + acc[ai][bj][m][n]; } }
    }
};

template <class Epi, class Sched, bool ALIGN_EPI = false, bool SP2 = false>
__device__ __forceinline__ void gemm_phase(PG8_LAS unsigned char* lds, const Gemm g, const Sched& S, const Epi& E) {
    const int tid = threadIdx.x, wid = __builtin_amdgcn_readfirstlane(tid >> 6), lane = tid & 63, wr = wid >> 2, wc = wid & 3, fr = lane & 15, fq = lane >> 4;
    const int K = g.K, nt = K / BK;
    unsigned voffA[2], voffB[2];
#pragma unroll
    for (int i = 0; i < 2; ++i) { int R, C; stage_rc(tid * 16 + i * 8192, R, C); const int Rb = Epi::PERM ? ((R & ~31) + perm32(R & 31)) : R;
        voffA[i] = (unsigned)(R * g.lda + C) * 2u; voffB[i] = (unsigned)(Rb * g.ldb + C) * 2u; }
    const size_t kstep = (size_t)(BK * 2);
    const size_t hstepA = (size_t)HALF * g.lda * 2, hstepB = (size_t)HALF * g.ldb * 2;
    const size_t tstepA = 2 * hstepA, tstepB = 2 * hstepB;
    const size_t pnA = (size_t)g.a_pn_koff * 2;
    const unsigned ldsw = (unsigned)wid * 1024u;
    const int aoff = lds_byte(wr * 64 + fr, fq * 8), boff = lds_byte(wc * 32 + fr, fq * 8);
#define PG8_SA(b, h) (((b) * 2 + (h)) * HTB)
#define PG8_SB(b, h) ((4 + (b) * 2 + (h)) * HTB)
#define PG8_STAGE(bufoff, gbase, voff) do { _Pragma("unroll") for (int _i = 0; _i < 2; ++_i) \
        __builtin_amdgcn_global_load_lds((const unsigned*)((const char*)(gbase) + (voff)[_i]), (PG8_LAS unsigned*)(lds + (bufoff) + ldsw + _i * 8192), 16, 0, 0); } while (0)
#define PG8_LDA(dst, b, h) do { _Pragma("unroll") for (int m = 0; m < 4; ++m) _Pragma("unroll") for (int k = 0; k < 2; ++k) dst[m][k] = *(const PG8_LAS bf16x8*)(lds + PG8_SA(b, h) + aoff + m * 2048 + k * 1024); } while (0)
#define PG8_LDB(dst, b, h) do { _Pragma("unroll") for (int n = 0; n < 2; ++n) _Pragma("unroll") for (int k = 0; k < 2; ++k) dst[n][k] = *(const PG8_LAS bf16x8*)(lds + PG8_SB(b, h) + boff + n * 2048 + k * 1024); } while (0)
#define PG8_MMA(ai, bj, At, Bt) do { __builtin_amdgcn_s_setprio(1); _Pragma("unroll") for (int m = 0; m < 4; ++m) _Pragma("unroll") for (int n = 0; n < 2; ++n) _Pragma("unroll") for (int k = 0; k < 2; ++k) \
        acc[ai][bj][m][n] = __builtin_amdgcn_mfma_f32_16x16x32_bf16(Bt[n][k], At[m][k], acc[ai][bj][m][n], 0, 0, 0); __builtin_amdgcn_s_setprio(0); } while (0)
#define PG8_WAIT_V(n) asm volatile("s_waitcnt vmcnt(" #n ")" ::: "memory")
#define PG8_WAIT_L(n) asm volatile("s_waitcnt lgkmcnt(" #n ")" ::: "memory")
#define PG8_BAR __builtin_amdgcn_s_barrier()
#define PG8_SCHED __builtin_amdgcn_sched_barrier(0)
    Unit cur, nxt; int ui = 0;
    if (!S.next(0, cur)) return;
    f32x4 acc[2][2][4][2];
#pragma unroll
    for (int a = 0; a < 2; ++a)
#pragma unroll
        for (int b = 0; b < 2; ++b)
#pragma unroll
            for (int m = 0; m < 4; ++m)
#pragma unroll
                for (int n = 0; n < 2; ++n) acc[a][b][m][n] = (f32x4){0.f, 0.f, 0.f, 0.f};
    bf16x8 At[4][2], B0[2][2], B1[2][2];
    const char* cA = (const char*)g.A + (size_t)cur.pm * tstepA + (size_t)cur.pn * pnA; const char* cB = (const char*)g.Bt + (size_t)cur.pn * tstepB;
    S.a_ready(cur);
    if constexpr (SP2) {
        PG8_STAGE(PG8_SB(0, 0), cB, voffB); PG8_STAGE(PG8_SB(0, 1), cB + hstepB, voffB); PG8_STAGE(PG8_SA(0, 0), cA, voffA); PG8_STAGE(PG8_SA(0, 1), cA + hstepA, voffA);
        if (wr == 1) PG8_BAR;
        PG8_WAIT_V(2); PG8_BAR;
        PG8_STAGE(PG8_SB(1, 0), cB + kstep, voffB); PG8_STAGE(PG8_SA(1, 0), cA + kstep, voffA); PG8_STAGE(PG8_SB(1, 1), cB + hstepB + kstep, voffB);
        PG8_WAIT_V(6); PG8_BAR;
    } else {
        PG8_STAGE(PG8_SB(0, 0), cB, voffB); PG8_STAGE(PG8_SA(0, 0), cA, voffA); PG8_STAGE(PG8_SB(0, 1), cB + hstepB, voffB); PG8_STAGE(PG8_SA(0, 1), cA + hstepA, voffA);
        if (wr == 1) PG8_BAR;
        PG8_WAIT_V(4); PG8_BAR;
        PG8_STAGE(PG8_SB(1, 0), cB + kstep, voffB); PG8_STAGE(PG8_SA(1, 0), cA + kstep, voffA); PG8_STAGE(PG8_SB(1, 1), cB + hstepB + kstep, voffB);
        PG8_WAIT_V(6); PG8_BAR;
    }
    for (;;) {
        const bool has_next = S.next(ui + 1, nxt);
        const char* nA = has_next ? (const char*)g.A + (size_t)nxt.pm * tstepA + (size_t)nxt.pn * pnA : cA; const char* nB = has_next ? (const char*)g.Bt + (size_t)nxt.pn * tstepB : cB;
        for (int t = 0; t < nt; t += 2) {
            const bool last = (t == nt - 2);
            const char* a1 = cA + (size_t)(t + 1) * kstep;
            const char* a2 = last ? nA : cA + (size_t)(t + 2) * kstep; const char* b2 = last ? nB : cB + (size_t)(t + 2) * kstep;
            const char* a3 = a2 + kstep; const char* b3 = b2 + kstep;
            if (last && has_next) S.a_ready(nxt);
            if constexpr (SP2) {
            PG8_LDB(B0, 0, 0); PG8_LDB(B1, 0, 1); PG8_SCHED; PG8_LDA(At, 0, 0); PG8_STAGE(PG8_SA(1, 1), a1 + hstepA, voffA);
            PG8_WAIT_V(8); PG8_WAIT_L(0); PG8_BAR; PG8_MMA(0, 0, At, B0); PG8_MMA(0, 1, At, B1); PG8_BAR; PG8_SCHED;
            PG8_LDA(At, 0, 1); PG8_STAGE(PG8_SB(0, 0), b2, voffB); PG8_STAGE(PG8_SB(0, 1), b2 + hstepB, voffB); PG8_STAGE(PG8_SA(0, 0), a2, voffA);
            PG8_WAIT_V(8); PG8_WAIT_L(0); PG8_BAR; PG8_MMA(1, 0, At, B0); PG8_MMA(1, 1, At, B1); PG8_BAR; PG8_SCHED;
            PG8_LDB(B0, 1, 0); PG8_LDB(B1, 1, 1); PG8_SCHED; PG8_LDA(At, 1, 0); PG8_STAGE(PG8_SA(0, 1), a2 + hstepA, voffA);
            PG8_WAIT_V(8); PG8_WAIT_L(0); PG8_BAR; PG8_MMA(0, 0, At, B0); PG8_MMA(0, 1, At, B1); PG8_BAR; PG8_SCHED;
            PG8_LDA(At, 1, 1); PG8_STAGE(PG8_SB(1, 0), b3, voffB); PG8_STAGE(PG8_SB(1, 1), b3 + hstepB, voffB); PG8_STAGE(PG8_SA(1, 0), a3, voffA);
            PG8_WAIT_V(8); PG8_WAIT_L(0); PG8_BAR; PG8_MMA(1, 0, At, B0); PG8_MMA(1, 1, At, B1); PG8_BAR; PG8_SCHED;
            } else {
            PG8_LDB(B0, 0, 0); PG8_SCHED; PG8_LDA(At, 0, 0); PG8_STAGE(PG8_SA(1, 1), a1 + hstepA, voffA);
            PG8_WAIT_L(8); PG8_BAR; PG8_WAIT_L(0); PG8_MMA(0, 0, At, B0); PG8_BAR; PG8_SCHED;
            PG8_LDB(B1, 0, 1); PG8_STAGE(PG8_SB(0, 0), b2, voffB);
            PG8_BAR; PG8_WAIT_L(0); PG8_MMA(0, 1, At, B1); PG8_BAR;
            PG8_LDA(At, 0, 1); PG8_STAGE(PG8_SA(0, 0), a2, voffA);
            PG8_BAR; PG8_WAIT_L(0); PG8_MMA(1, 0, At, B0); PG8_BAR; PG8_SCHED;
            PG8_STAGE(PG8_SB(0, 1), b2 + hstepB, voffB);
            PG8_WAIT_V(6); PG8_BAR; PG8_MMA(1, 1, At, B1); PG8_BAR;
            PG8_LDB(B0, 1, 0); PG8_SCHED; PG8_LDA(At, 1, 0); PG8_STAGE(PG8_SA(0, 1), a2 + hstepA, voffA);
            PG8_WAIT_L(8); PG8_BAR; PG8_WAIT_L(0); PG8_MMA(0, 0, At, B0); PG8_BAR; PG8_SCHED;
            PG8_LDB(B1, 1, 1); PG8_STAGE(PG8_SB(1, 0), b3, voffB);
            PG8_BAR; PG8_WAIT_L(0); PG8_MMA(0, 1, At, B1); PG8_BAR;
            PG8_LDA(At, 1, 1); PG8_STAGE(PG8_SA(1, 0), a3, voffA);
            PG8_BAR; PG8_WAIT_L(0); PG8_MMA(1, 0, At, B0); PG8_BAR; PG8_SCHED;
            PG8_STAGE(PG8_SB(1, 1), b3 + hstepB, voffB);
            PG8_WAIT_V(6); PG8_BAR; PG8_MMA(1, 1, At, B1); PG8_BAR;
            }
        }
        if constexpr (ALIGN_EPI) { if (wr == 0) PG8_BAR; }
        E(acc, cur, wr, wc, fr, fq); S.done(cur);
        if (!has_next) break;
#pragma unroll
        for (int a = 0; a < 2; ++a)
#pragma unroll
            for (int b = 0; b < 2; ++b)
#pragma unroll
                for (int m = 0; m < 4; ++m)
#pragma unroll
                    for (int n = 0; n < 2; ++n) acc[a][b][m][n] = (f32x4){0.f, 0.f, 0.f, 0.f};
        cur = nxt; cA = nA; cB = nB; ++ui;
        if constexpr (ALIGN_EPI) { if (wr == 1) PG8_BAR; }
    }
    PG8_WAIT_V(0);
    if constexpr (!ALIGN_EPI) { if (wr == 0) PG8_BAR; }
    PG8_BAR;
#undef PG8_SA
#undef PG8_SB
#undef PG8_STAGE
#undef PG8_LDA
#undef PG8_LDB
#undef PG8_MMA
#undef PG8_WAIT_V
#undef PG8_WAIT_L
#undef PG8_BAR
#undef PG8_SCHED
}
}

constexpr int NWAVES = 8, NTHR = NWAVES * 64;
constexpr int D = 1024, NBATCH = 4, T = 8192, M = NBATCH * T;
constexpr int A_W = 512, A_IN = 1792, IN_COLS = 3344, NP = 3584;
constexpr int C_R = 0, C_K = 512, C_V = 1024, C_WD = 1536, C_AD = 1600, C_GD = 1664;
constexpr int C_BQ = 1792, C_BK = 2048, C_BV = 2304, C_GKD = 2816, C_BG = 2832;
constexpr int NQ = 2048;
constexpr float LN_EPS = 1e-5f, GN_EPS = 64e-5f, RMS_EPS = 1e-5f;
constexpr float ALPHA = 1.189207115002721f;

typedef unsigned short bf16;
typedef float f32x4 __attribute__((ext_vector_type(4)));
typedef float f32x2 __attribute__((ext_vector_type(2)));
typedef unsigned u32x4 __attribute__((ext_vector_type(4)));
typedef unsigned u32x2 __attribute__((ext_vector_type(2)));
#define LAS __attribute__((address_space(3)))

constexpr size_t MiB = 1u << 20;
constexpr size_t WS_WIN = 1 * MiB, WS_WOUT = 8 * MiB, WS_WQ = 10 * MiB, WS_KBD = 14 * MiB;
constexpr size_t WS_W2T = 15 * MiB, WS_A2T = WS_W2T + 65536, WS_G2T = WS_A2T + 65536;
constexpr size_t WS_H0 = 16 * MiB;
constexpr size_t WS_P = 80 * MiB;
constexpr size_t WS_WL = 304 * MiB, WS_AA = 336 * MiB, WS_GG = 368 * MiB;
constexpr size_t WS_GK = 400 * MiB;
constexpr size_t WS_MIX = 416 * MiB;
constexpr size_t WS_Z = 80 * MiB;
constexpr size_t WS_H1 = 208 * MiB;
constexpr size_t WS_Q = 272 * MiB;
constexpr size_t WS_S = 80 * MiB;
constexpr size_t WS_IDS = 400 * MiB, WS_GATES = 416 * MiB;
constexpr size_t WS_UT = 432 * MiB, WS_VT = 448 * MiB;
constexpr size_t WS_SU = 464 * MiB, WS_SV = 465 * MiB;
constexpr int NSEG = 16, LSEG = 8192 / NSEG;
constexpr size_t WS_YI = WS_WL;
constexpr size_t WS_YIG = WS_GK;
constexpr size_t WS_SER = 480 * MiB;
constexpr size_t WS_SEG = 496 * MiB;
constexpr size_t WS_CEND = 504 * MiB;
constexpr size_t WS_END = 505 * MiB;

constexpr int LDS_BYTES = 147456, LDS_MISC = LDS_BYTES - 256;
constexpr size_t WS_CTL = 0, CTL_BYTES = 16384;

struct Params {
    const float* in[28];
    float* out; unsigned char* ws;
    int ph_lo, ph_hi;
};

__device__ __forceinline__ float bf2f(unsigned u) { return __uint_as_float(u << 16); }
__device__ __forceinline__ unsigned f2bf(float f) { unsigned u = __float_as_uint(f); return (u + 0x7fffu + ((u >> 16) & 1u)) >> 16; }
__device__ __forceinline__ unsigned pk2(float lo, float hi) { return f2bf(lo) | (f2bf(hi) << 16); }
#define DPP_F(v, ctrl) __builtin_bit_cast(float, __builtin_amdgcn_update_dpp(0, __builtin_bit_cast(int, (v)), (ctrl), 0xf, 0xf, false))
#define DPP_ADD(v, ctrl) ((v) + DPP_F(v, ctrl))
__device__ __forceinline__ float rlf(float v, int l) { return __builtin_bit_cast(float, __builtin_amdgcn_readlane(__builtin_bit_cast(int, v), l)); }
__device__ __forceinline__ float wave_sum_u(float v) {
    v = DPP_ADD(v, 0xB1); v = DPP_ADD(v, 0x4E); v = DPP_ADD(v, 0x141); v = DPP_ADD(v, 0x140);
    return (rlf(v, 0) + rlf(v, 16)) + (rlf(v, 32) + rlf(v, 48));
}
__device__ __forceinline__ float wave_sum(float v) { return wave_sum_u(v); }
#define DPP_I(v, ctrl) __builtin_amdgcn_update_dpp(0, (v), (ctrl), 0xf, 0xf, false)
__device__ __forceinline__ int wave_sum_i(int v) {
    v += DPP_I(v, 0xB1); v += DPP_I(v, 0x4E); v += DPP_I(v, 0x141); v += DPP_I(v, 0x140);
    return (__builtin_amdgcn_readlane(v, 0) + __builtin_amdgcn_readlane(v, 16)) + (__builtin_amdgcn_readlane(v, 32) + __builtin_amdgcn_readlane(v, 48));
}
__device__ __forceinline__ float wave_max_u(float v) {
    v = fmaxf(v, DPP_F(v, 0xB1)); v = fmaxf(v, DPP_F(v, 0x4E)); v = fmaxf(v, DPP_F(v, 0x141)); v = fmaxf(v, DPP_F(v, 0x140));
    return fmaxf(fmaxf(rlf(v, 0), rlf(v, 16)), fmaxf(rlf(v, 32), rlf(v, 48)));
}
__device__ __forceinline__ unsigned pack_i8(float a, float b, float c, float d, float inv, int off) {
    const int q0 = __float2int_rn(a * inv) + off, q1 = __float2int_rn(b * inv) + off, q2 = __float2int_rn(c * inv) + off, q3 = __float2int_rn(d * inv) + off;
    return (unsigned)(q0 & 0xff) | ((unsigned)(q1 & 0xff) << 8) | ((unsigned)(q2 & 0xff) << 16) | ((unsigned)(q3 & 0xff) << 24);
}
__device__ __forceinline__ float sigmoidf_(float x) { return 1.f / (1.f + __expf(-x)); }
__device__ __forceinline__ float softplusf_(float x) { return fmaxf(x, 0.f) + log1pf(__expf(-fabsf(x))); }
__device__ __forceinline__ float siluf_(float x) { return x * sigmoidf_(x); }

__device__ __forceinline__ void transpose_convert(const float* W, int K, int N, int Npad, bf16* WT, int gtid, int gthreads) {
    const int kc = K / 8, total = Npad * kc;
    for (int idx = gtid; idx < total; idx += gthreads) {
        const int n = idx % Npad, c = idx / Npad; float v[8];
#pragma unroll
        for (int j = 0; j < 8; ++j) v[j] = (n < N) ? W[(size_t)(8 * c + j) * N + n] : 0.f;
        u32x4 o; o.x = pk2(v[0], v[1]); o.y = pk2(v[2], v[3]); o.z = pk2(v[4], v[5]); o.w = pk2(v[6], v[7]);
        *(u32x4*)(WT + (size_t)n * K + 8 * c) = o;
    }
}
__device__ __forceinline__ void ln_row_bf16(const float* xrow, const float* g, const float* b, bf16* orow, int lane) {
    const f32x4* xr = (const f32x4*)xrow + lane; f32x4 v[4]; float s = 0.f;
#pragma unroll
    for (int j = 0; j < 4; ++j) { v[j] = xr[64 * j]; s += (v[j][0] + v[j][1]) + (v[j][2] + v[j][3]); }
    const float mean = wave_sum(s) * (1.f / D); float s2 = 0.f;
#pragma unroll
    for (int j = 0; j < 4; ++j) { v[j] = v[j] - mean; s2 += (v[j][0] * v[j][0] + v[j][1] * v[j][1]) + (v[j][2] * v[j][2] + v[j][3] * v[j][3]); }
    const float rstd = 1.f / sqrtf(wave_sum(s2) * (1.f / D) + LN_EPS);
    u32x2* o8 = (u32x2*)orow + lane;
#pragma unroll
    for (int j = 0; j < 4; ++j) { const f32x4 gg = ((const f32x4*)g)[lane + 64 * j], bb = ((const f32x4*)b)[lane + 64 * j]; const f32x4 y = v[j] * rstd * gg + bb;
        u32x2 w; w.x = pk2(y[0], y[1]); w.y = pk2(y[2], y[3]); o8[64 * j] = w; }
}
__device__ __forceinline__ void phase_prologue(const Params& P) {
    const int tid = threadIdx.x, lane = tid & 63, wave = tid >> 6;
    const int gtid = blockIdx.x * NTHR + tid, gthreads = gridDim.x * NTHR;
    unsigned char* ws = P.ws;
    transpose_convert(P.in[3], D, IN_COLS, NP, (bf16*)(ws + WS_WIN), gtid, gthreads);
    transpose_convert(P.in[19], D, D, D, (bf16*)(ws + WS_WOUT), gtid, gthreads);
    transpose_convert(P.in[22], D, NQ, NQ, (bf16*)(ws + WS_WQ), gtid, gthreads);
    transpose_convert(P.in[6], 64, A_W, A_W, (bf16*)(ws + WS_W2T), gtid, gthreads);
    transpose_convert(P.in[8], 64, A_W, A_W, (bf16*)(ws + WS_A2T), gtid, gthreads);
    transpose_convert(P.in[9], 128, A_W, A_W, (bf16*)(ws + WS_G2T), gtid, gthreads);
    {
        const float* keys = P.in[23]; bf16* kbd = (bf16*)(ws + WS_KBD);
        for (int idx = gtid; idx < 8 * 256 * 32; idx += gthreads) {
            const int kc = idx & 31, n = (idx >> 5) & 255, h = idx >> 13; const int k0 = kc * 8, hn = n >> 7, key = n & 127, hk = k0 >> 7, c0 = k0 & 127;
            u32x4 o = (u32x4){0u, 0u, 0u, 0u};
            if (hn == hk) { const float* s = keys + ((size_t)((h * 2 + hn) * 128 + key)) * 128 + c0; o.x = pk2(s[0], s[1]); o.y = pk2(s[2], s[3]); o.z = pk2(s[4], s[5]); o.w = pk2(s[6], s[7]); }
            *(u32x4*)(kbd + ((size_t)(h * 256 + n)) * 256 + k0) = o;
        }
    }
    const int gw = blockIdx.x * NWAVES + wave, ngw = gridDim.x * NWAVES;
    for (int m = gw; m < M; m += ngw) ln_row_bf16(P.in[0] + (size_t)m * D, P.in[1], P.in[2], (bf16*)(ws + WS_H0) + (size_t)m * D, lane);
}

typedef short bf16x8_t __attribute__((ext_vector_type(8)));
template <int KS, int LDA>
__device__ __forceinline__ void lora_mm(f32x4 (&acc)[4][4], const LAS bf16* ACT, const bf16* WT, int c0, int fr, int fq) {
#pragma unroll
    for (int mt = 0; mt < 4; ++mt)
#pragma unroll
        for (int nt = 0; nt < 4; ++nt) acc[mt][nt] = (f32x4){0.f, 0.f, 0.f, 0.f};
#pragma unroll
    for (int s = 0; s < KS; ++s) {
        bf16x8_t af[4], bfr[4];
#pragma unroll
        for (int mt = 0; mt < 4; ++mt) af[mt] = *(const LAS bf16x8_t*)(ACT + (mt * 16 + fr) * LDA + 32 * s + 8 * fq);
#pragma unroll
        for (int nt = 0; nt < 4; ++nt) bfr[nt] = *(const bf16x8_t*)(WT + (size_t)(c0 + nt * 16 + fr) * (32 * KS) + 32 * s + 8 * fq);
#pragma unroll
        for (int mt = 0; mt < 4; ++mt)
#pragma unroll
            for (int nt = 0; nt < 4; ++nt) acc[mt][nt] = __builtin_amdgcn_mfma_f32_16x16x32_bf16(bfr[nt], af[mt], acc[mt][nt], 0, 0, 0);
    }
}
__device__ __forceinline__ void phase_prep(const Params& P, LAS unsigned char* lds) {
    const int tid = threadIdx.x, lane = tid & 63, wave = __builtin_amdgcn_readfirstlane(tid >> 6), fr = lane & 15, fq = lane >> 4;
    unsigned char* ws = P.ws;
    const bf16* p = (const bf16*)(ws + WS_P);
    const float* mu = P.in[4]; const float* w0 = P.in[5]; const float* a0 = P.in[7];
    const float* gkw2 = P.in[16]; const float* gkb = P.in[17];
    const bf16* W2T = (const bf16*)(ws + WS_W2T); const bf16* A2T = (const bf16*)(ws + WS_A2T); const bf16* G2T = (const bf16*)(ws + WS_G2T);
    bf16* WL = (bf16*)(ws + WS_WL); bf16* AA = (bf16*)(ws + WS_AA); bf16* GG = (bf16*)(ws + WS_GG); bf16* GK = (bf16*)(ws + WS_GK);
    LAS bf16* TW = (LAS bf16*)lds; LAS bf16* AD = TW + 64 * 72; LAS bf16* SG = AD + 64 * 72;
    LAS float* gkd = (LAS float*)(SG + 64 * 136);
    const int c0 = wave * 64;
    for (int tile = blockIdx.x; tile < M / 64; tile += gridDim.x) {
        const int m0 = tile * 64;
        __syncthreads();
        for (int idx = tid; idx < 64 * 256; idx += NTHR) {
            const int j = idx & 255, tok = idx >> 8, m = m0 + tok, t = m & (T - 1);
            const float cur = bf2f(p[(size_t)m * NP + C_WD + j]);
            const float prev = (t > 0) ? bf2f(p[(size_t)(m - 1) * NP + C_WD + j]) : 0.f;
            const float x = cur + (prev - cur) * mu[C_WD + j];
            if (j < 64) TW[tok * 72 + j] = (bf16)f2bf(tanhf(x)); else if (j < 128) AD[tok * 72 + j - 64] = (bf16)f2bf(x); else SG[tok * 136 + j - 128] = (bf16)f2bf(sigmoidf_(x));
        }
        for (int idx = tid; idx < 64 * 16; idx += NTHR) { const int j = idx & 15, tok = idx >> 4; gkd[tok * 16 + j] = bf2f(p[(size_t)(m0 + tok) * NP + C_GKD + j]); }
        __syncthreads();
        f32x4 acc[4][4];
        lora_mm<2, 72>(acc, TW, W2T, c0, fr, fq);
#pragma unroll
        for (int nt = 0; nt < 4; ++nt) { const int c = c0 + nt * 16 + 4 * fq; const f32x4 b = *(const f32x4*)(w0 + c);
#pragma unroll
            for (int mt = 0; mt < 4; ++mt) { float o[4];
#pragma unroll
                for (int i = 0; i < 4; ++i) { const float z = b[i] + acc[mt][nt][i]; o[i] = -__expf(-softplusf_(-z) - 0.5f); }
                u32x2 w; w.x = pk2(o[0], o[1]); w.y = pk2(o[2], o[3]); *(u32x2*)(WL + (size_t)(m0 + mt * 16 + fr) * A_W + c) = w; } }
        lora_mm<2, 72>(acc, AD, A2T, c0, fr, fq);
#pragma unroll
        for (int nt = 0; nt < 4; ++nt) { const int c = c0 + nt * 16 + 4 * fq; const f32x4 b = *(const f32x4*)(a0 + c);
#pragma unroll
            for (int mt = 0; mt < 4; ++mt) { float o[4];
#pragma unroll
                for (int i = 0; i < 4; ++i) o[i] = sigmoidf_(b[i] + acc[mt][nt][i]);
                u32x2 w; w.x = pk2(o[0], o[1]); w.y = pk2(o[2], o[3]); *(u32x2*)(AA + (size_t)(m0 + mt * 16 + fr) * A_W + c) = w; } }
        lora_mm<4, 136>(acc, SG, G2T, c0, fr, fq);
#pragma unroll
        for (int nt = 0; nt < 4; ++nt) { const int c = c0 + nt * 16 + 4 * fq;
#pragma unroll
            for (int mt = 0; mt < 4; ++mt) { u32x2 w; w.x = pk2(acc[mt][nt][0], acc[mt][nt][1]); w.y = pk2(acc[mt][nt][2], acc[mt][nt][3]); *(u32x2*)(GG + (size_t)(m0 + mt * 16 + fr) * A_W + c) = w; } }
        { const int cc = tid & 255, th = tid >> 8; float wv[16];
#pragma unroll
          for (int j = 0; j < 16; ++j) wv[j] = gkw2[j * 256 + cc];
          const float bb = gkb[cc];
          for (int i = 0; i < 32; ++i) { const int tok = th * 32 + i; float sacc = bb;
#pragma unroll
              for (int j = 0; j < 16; ++j) sacc += gkd[tok * 16 + j] * wv[j];
              GK[(size_t)(m0 + tok) * 256 + cc] = (bf16)f2bf(-softplusf_(-sacc) * (1.f / 16.f)); } }
    }
}

constexpr int CH = 32;
__device__ __forceinline__ float red8(float v) { v = DPP_ADD(v, 0xB1); v = DPP_ADD(v, 0x4E); v = DPP_ADD(v, 0x141); return v; }
__device__ __forceinline__ float red4(float v) { v = DPP_ADD(v, 0xB1); v = DPP_ADD(v, 0x4E); return v; }

constexpr int RW_BUF = 6 * CH * 64;
__device__ __forceinline__ void rw_load(const bf16* p, const bf16* AA, const bf16* WL, int b, int t0, int col, int wave,
        unsigned (&rc)[4], unsigned (&kc)[4], unsigned (&vc)[4], unsigned (&rp)[4], unsigned (&kp)[4], unsigned (&vp)[4], unsigned (&a)[4], unsigned (&wl)[4]) {
#pragma unroll
    for (int q = 0; q < 4; ++q) {
        const int t = t0 + wave + 8 * q; const size_t m = (size_t)b * T + t; const bf16* pr = p + m * NP; const bf16* pp = (t > 0) ? pr - NP : pr;
        rc[q] = pr[C_R + col]; kc[q] = pr[C_K + col]; vc[q] = pr[C_V + col]; rp[q] = pp[C_R + col]; kp[q] = pp[C_K + col]; vp[q] = pp[C_V + col];
        a[q] = AA[m * A_W + col]; wl[q] = WL[m * A_W + col];
    }
}
__device__ __forceinline__ void rw_prep(LAS float* B, int t0, int wave, int lane, float mu_r, float mu_k, float mu_v, float kkc, float kac,
        const unsigned (&rc_)[4], const unsigned (&kc_)[4], const unsigned (&vc_)[4], const unsigned (&rp_)[4], const unsigned (&kp_)[4], const unsigned (&vp_)[4], const unsigned (&a_)[4], const unsigned (&wl_)[4]) {
    LAS float* R = B; LAS float* DEC = R + CH * 64; LAS float* KH = DEC + CH * 64; LAS float* KK = KH + CH * 64; LAS float* BB = KK + CH * 64; LAS float* V = BB + CH * 64;
#pragma unroll
    for (int q = 0; q < 4; ++q) {
        const int tt = wave + 8 * q; const float hp = (t0 + tt > 0) ? 1.f : 0.f;
        const float rc = bf2f(rc_[q]), kc = bf2f(kc_[q]), vc = bf2f(vc_[q]), rp = bf2f(rp_[q]) * hp, kp = bf2f(kp_[q]) * hp, vp = bf2f(vp_[q]) * hp;
        const float r = rc + (rp - rc) * mu_r, k = kc + (kp - kc) * mu_k, v = vc + (vp - vc) * mu_v;
        const float a = bf2f(a_[q]), wl = bf2f(wl_[q]);
        const float kr = k * kkc; const float nrm = sqrtf(wave_sum(kr * kr)); const float kk = kr / fmaxf(nrm, 1e-12f);
        const float kh = k * (1.f + (a - 1.f) * kac);
        R[tt * 64 + lane] = r; DEC[tt * 64 + lane] = __expf(wl); KH[tt * 64 + lane] = kh; KK[tt * 64 + lane] = kk; BB[tt * 64 + lane] = kk * a; V[tt * 64 + lane] = v;
    }
}
__device__ __forceinline__ void rwkv_item(const Params& P, LAS unsigned char* lds, int b, int h, int seg) {
    const int tid = threadIdx.x, lane = tid & 63, wave = tid >> 6;
    unsigned char* ws = P.ws;
    const bf16* p = (const bf16*)(ws + WS_P); const bf16* WL = (const bf16*)(ws + WS_WL); const bf16* AA = (const bf16*)(ws + WS_AA);
    bf16* MIX = (bf16*)(ws + WS_MIX); bf16* YI = (bf16*)(ws + WS_YI);
    const float* mu = P.in[4]; const float* k_k = P.in[10]; const float* k_a = P.in[11];
    LAS float* BUF = (LAS float*)lds; LAS float* Y = BUF + 2 * RW_BUF;
    const int col = h * 64 + lane;
    const float mu_r = mu[C_R + col], mu_k = mu[C_K + col], mu_v = mu[C_V + col], kkc = k_k[col], kac = k_a[col];
    const int r0 = wave * 16 + 2 * (lane >> 3), s8 = (lane & 7) * 8; const int ident = r0 >> 6, vr0 = r0 & 63, vr1 = vr0 + 1;
    float* SE = (float*)(ws + WS_SER) + ((((size_t)(b * 8 + h) * NSEG + seg) * 2 + ident) * 4096) + vr0 * 64 + s8;
    f32x2 S0[4], S1[4];
#pragma unroll
    for (int i = 0; i < 4; ++i) { S0[i] = (f32x2){(ident && (s8 + 2 * i == vr0)) ? 1.f : 0.f, (ident && (s8 + 2 * i + 1 == vr0)) ? 1.f : 0.f};
        S1[i] = (f32x2){(ident && (s8 + 2 * i == vr1)) ? 1.f : 0.f, (ident && (s8 + 2 * i + 1 == vr1)) ? 1.f : 0.f}; }
    const float vmask = ident ? 0.f : 1.f;
    const int tbeg = seg * LSEG;
    unsigned rc[4], kc[4], vc[4], rp[4], kp[4], vp[4], a[4], wl[4];
    __syncthreads();
    rw_load(p, AA, WL, b, tbeg, col, wave, rc, kc, vc, rp, kp, vp, a, wl);
    rw_prep(BUF, tbeg, wave, lane, mu_r, mu_k, mu_v, kkc, kac, rc, kc, vc, rp, kp, vp, a, wl);
    __syncthreads();
    for (int ci = 0; ci < LSEG / CH; ++ci) {
        const int t0 = tbeg + ci * CH; LAS float* B = BUF + (ci & 1) * RW_BUF;
        LAS float* R = B; LAS float* DEC = R + CH * 64; LAS float* KH = DEC + CH * 64; LAS float* KK = KH + CH * 64; LAS float* BB = KK + CH * 64; LAS float* V = BB + CH * 64;
        const bool more = (ci + 1 < LSEG / CH);
        if (more) rw_load(p, AA, WL, b, t0 + CH, col, wave, rc, kc, vc, rp, kp, vp, a, wl);
        for (int tt = 0; tt < CH; ++tt) {
            const f32x4 k0 = *(const LAS f32x4*)(KK + tt * 64 + s8), k1 = *(const LAS f32x4*)(KK + tt * 64 + s8 + 4);
            const f32x4 d0 = *(const LAS f32x4*)(DEC + tt * 64 + s8), d1 = *(const LAS f32x4*)(DEC + tt * 64 + s8 + 4);
            const f32x4 b0 = *(const LAS f32x4*)(BB + tt * 64 + s8), b1 = *(const LAS f32x4*)(BB + tt * 64 + s8 + 4);
            const f32x4 h0 = *(const LAS f32x4*)(KH + tt * 64 + s8), h1 = *(const LAS f32x4*)(KH + tt * 64 + s8 + 4);
            const f32x4 q0 = *(const LAS f32x4*)(R + tt * 64 + s8), q1 = *(const LAS f32x4*)(R + tt * 64 + s8 + 4);
            const float vv0 = V[tt * 64 + vr0] * vmask, vv1 = V[tt * 64 + vr1] * vmask;
            const f32x2 kk[4] = {k0.lo, k0.hi, k1.lo, k1.hi}, dd[4] = {d0.lo, d0.hi, d1.lo, d1.hi}, bb[4] = {b0.lo, b0.hi, b1.lo, b1.hi}, hh[4] = {h0.lo, h0.hi, h1.lo, h1.hi}, rr[4] = {q0.lo, q0.hi, q1.lo, q1.hi};
            f32x2 a0 = S0[0] * kk[0], a1 = S1[0] * kk[0];
#pragma unroll
            for (int i = 1; i < 4; ++i) { a0 = S0[i] * kk[i] + a0; a1 = S1[i] * kk[i] + a1; }
            const float sa0 = -red8(a0.x + a0.y), sa1 = -red8(a1.x + a1.y);
            f32x2 y0 = (f32x2){0.f, 0.f}, y1 = (f32x2){0.f, 0.f};
#pragma unroll
            for (int i = 0; i < 4; ++i) {
                S0[i] = hh[i] * vv0 + (bb[i] * sa0 + S0[i] * dd[i]); S1[i] = hh[i] * vv1 + (bb[i] * sa1 + S1[i] * dd[i]);
                y0 = S0[i] * rr[i] + y0; y1 = S1[i] * rr[i] + y1;
            }
            const float yy0 = red8(y0.x + y0.y), yy1 = red8(y1.x + y1.y);
            if ((lane & 7) == 0) { Y[tt * 128 + r0] = yy0; Y[tt * 128 + r0 + 1] = yy1; }
        }
        __syncthreads();
        if (more) rw_prep(BUF + ((ci + 1) & 1) * RW_BUF, t0 + CH, wave, lane, mu_r, mu_k, mu_v, kkc, kac, rc, kc, vc, rp, kp, vp, a, wl);
#pragma unroll
        for (int q = 0; q < 4; ++q) {
            const int tt = wave + 8 * q; const size_t m = (size_t)b * T + t0 + tt;
            MIX[m * D + col] = (bf16)f2bf(Y[tt * 128 + lane]); YI[m * 512 + col] = (bf16)f2bf(Y[tt * 128 + 64 + lane]);
        }
        __syncthreads();
    }
    *(f32x4*)(SE) = (f32x4){S0[0].x, S0[0].y, S0[1].x, S0[1].y}; *(f32x4*)(SE + 4) = (f32x4){S0[2].x, S0[2].y, S0[3].x, S0[3].y};
    *(f32x4*)(SE + 64) = (f32x4){S1[0].x, S1[0].y, S1[1].x, S1[1].y}; *(f32x4*)(SE + 68) = (f32x4){S1[2].x, S1[2].y, S1[3].x, S1[3].y};
}

constexpr int GL_BUF = 3 * CH * 64 + CH * 128;
__device__ __forceinline__ void gl_load(const bf16* p, const bf16* GK, int b, int h, int t0, int lane, int wave, unsigned (&x)[4][4][4], unsigned (&gk)[4]) {
    const int cq = h * 64 + lane, ck = 256 + h * 64 + lane, cv0 = 512 + h * 128 + lane, cv1 = cv0 + 64;
#pragma unroll
    for (int q = 0; q < 4; ++q) {
        const int t = t0 + wave + 8 * q; const size_t m = (size_t)b * T + t;
#pragma unroll
        for (int j = 0; j < 4; ++j) { const int back = 3 - j; const bf16* pr = p + (m - (size_t)((t >= back) ? back : 0)) * NP + C_BQ;
            x[q][j][0] = pr[cq]; x[q][j][1] = pr[ck]; x[q][j][2] = pr[cv0]; x[q][j][3] = pr[cv1]; }
        gk[q] = GK[m * 256 + h * 64 + lane];
    }
}
__device__ __forceinline__ void gl_prep(LAS float* B, int t0, int wave, int lane, const float (&wq)[4], const float (&wk)[4], const float (&wv0)[4], const float (&wv1)[4],
        const unsigned (&x)[4][4][4], const unsigned (&gk)[4]) {
    LAS float* Q = B; LAS float* K = Q + CH * 64; LAS float* DEC = K + CH * 64; LAS float* V = DEC + CH * 64;
#pragma unroll
    for (int q = 0; q < 4; ++q) {
        const int tt = wave + 8 * q, t = t0 + tt; float aq = 0.f, ak = 0.f, av0 = 0.f, av1 = 0.f;
#pragma unroll
        for (int j = 0; j < 4; ++j) { const float ok = (t >= 3 - j) ? 1.f : 0.f;
            aq += wq[j] * ok * bf2f(x[q][j][0]); ak += wk[j] * ok * bf2f(x[q][j][1]); av0 += wv0[j] * ok * bf2f(x[q][j][2]); av1 += wv1[j] * ok * bf2f(x[q][j][3]); }
        Q[tt * 64 + lane] = siluf_(aq) * 0.125f; K[tt * 64 + lane] = siluf_(ak); V[tt * 128 + lane] = siluf_(av0); V[tt * 128 + 64 + lane] = siluf_(av1);
        DEC[tt * 64 + lane] = __expf(bf2f(gk[q]));
    }
}
__device__ __forceinline__ void gla_item(const Params& P, LAS unsigned char* lds, int b, int h, int seg) {
    const int tid = threadIdx.x, lane = tid & 63, wave = tid >> 6;
    unsigned char* ws = P.ws;
    const bf16* p = (const bf16*)(ws + WS_P); const bf16* GK = (const bf16*)(ws + WS_GK);
    bf16* MIX = (bf16*)(ws + WS_MIX); bf16* YIG = (bf16*)(ws + WS_YIG);
    float* SE = (float*)(ws + WS_SEG) + ((size_t)(b * 4 + h) * NSEG + seg) * 8192; float* CE = (float*)(ws + WS_CEND) + ((size_t)(b * 4 + h) * NSEG + seg) * 64;
    const float* conv = P.in[15];
    LAS float* BUF = (LAS float*)lds; LAS float* O = BUF + 2 * GL_BUF; LAS float* YL = O + CH * 128;
    const int cq = h * 64 + lane, ck = 256 + h * 64 + lane, cv0 = 512 + h * 128 + lane, cv1 = cv0 + 64;
    float wq[4], wk[4], wv0[4], wv1[4];
#pragma unroll
    for (int j = 0; j < 4; ++j) { wq[j] = conv[j * 1024 + cq]; wk[j] = conv[j * 1024 + ck]; wv0[j] = conv[j * 1024 + cv0]; wv1[j] = conv[j * 1024 + cv1]; }
    const int r0 = wave * 16 + 2 * (lane >> 3), s8 = (lane & 7) * 8;
    f32x2 S0[4], S1[4], c[4];
#pragma unroll
    for (int i = 0; i < 4; ++i) { S0[i] = (f32x2){0.f, 0.f}; S1[i] = (f32x2){0.f, 0.f}; c[i] = (f32x2){1.f, 1.f}; }
    const int tbeg = seg * LSEG;
    unsigned x[4][4][4], gk[4];
    __syncthreads();
    gl_load(p, GK, b, h, tbeg, lane, wave, x, gk);
    gl_prep(BUF, tbeg, wave, lane, wq, wk, wv0, wv1, x, gk);
    __syncthreads();
    for (int ci = 0; ci < LSEG / CH; ++ci) {
        const int t0 = tbeg + ci * CH; LAS float* B = BUF + (ci & 1) * GL_BUF;
        LAS float* Q = B; LAS float* K = Q + CH * 64; LAS float* DEC = K + CH * 64; LAS float* V = DEC + CH * 64;
        const bool more = (ci + 1 < LSEG / CH);
        if (more) gl_load(p, GK, b, h, t0 + CH, lane, wave, x, gk);
        for (int tt = 0; tt < CH; ++tt) {
            const f32x4 k0 = *(const LAS f32x4*)(K + tt * 64 + s8), k1 = *(const LAS f32x4*)(K + tt * 64 + s8 + 4);
            const f32x4 d0 = *(const LAS f32x4*)(DEC + tt * 64 + s8), d1 = *(const LAS f32x4*)(DEC + tt * 64 + s8 + 4);
            const f32x4 q0 = *(const LAS f32x4*)(Q + tt * 64 + s8), q1 = *(const LAS f32x4*)(Q + tt * 64 + s8 + 4);
            const float vv0 = V[tt * 128 + r0], vv1 = V[tt * 128 + r0 + 1];
            const f32x2 kk[4] = {k0.lo, k0.hi, k1.lo, k1.hi}, dd[4] = {d0.lo, d0.hi, d1.lo, d1.hi}, qq[4] = {q0.lo, q0.hi, q1.lo, q1.hi};
            f32x2 y0 = (f32x2){0.f, 0.f}, y1 = (f32x2){0.f, 0.f};
#pragma unroll
            for (int i = 0; i < 4; ++i) {
                S0[i] = kk[i] * vv0 + S0[i] * dd[i]; S1[i] = kk[i] * vv1 + S1[i] * dd[i];
                y0 = S0[i] * qq[i] + y0; y1 = S1[i] * qq[i] + y1;
            }
            if (wave == 0) {
#pragma unroll
                for (int i = 0; i < 4; ++i) c[i] = c[i] * dd[i];
                if (lane < 8) { const f32x2 e0 = c[0] * qq[0], e1 = c[1] * qq[1], e2 = c[2] * qq[2], e3 = c[3] * qq[3];
                    *(LAS f32x4*)(YL + tt * 64 + s8) = (f32x4){e0.x, e0.y, e1.x, e1.y}; *(LAS f32x4*)(YL + tt * 64 + s8 + 4) = (f32x4){e2.x, e2.y, e3.x, e3.y}; }
            }
            const float o0 = red8(y0.x + y0.y), o1 = red8(y1.x + y1.y);
            if ((lane & 7) == 0) { O[tt * 128 + r0] = o0; O[tt * 128 + r0 + 1] = o1; }
        }
        __syncthreads();
        if (more) gl_prep(BUF + ((ci + 1) & 1) * GL_BUF, t0 + CH, wave, lane, wq, wk, wv0, wv1, x, gk);
#pragma unroll
        for (int q = 0; q < 4; ++q) {
            const int tt = wave + 8 * q; const size_t m = (size_t)b * T + t0 + tt;
            MIX[m * D + 512 + h * 128 + lane] = (bf16)f2bf(O[tt * 128 + lane]); MIX[m * D + 512 + h * 128 + 64 + lane] = (bf16)f2bf(O[tt * 128 + 64 + lane]);
            YIG[m * 256 + h * 64 + lane] = (bf16)f2bf(YL[tt * 64 + lane]);
        }
        __syncthreads();
    }
    *(f32x4*)(SE + r0 * 64 + s8) = (f32x4){S0[0].x, S0[0].y, S0[1].x, S0[1].y}; *(f32x4*)(SE + r0 * 64 + s8 + 4) = (f32x4){S0[2].x, S0[2].y, S0[3].x, S0[3].y};
    *(f32x4*)(SE + (r0 + 1) * 64 + s8) = (f32x4){S1[0].x, S1[0].y, S1[1].x, S1[1].y}; *(f32x4*)(SE + (r0 + 1) * 64 + s8 + 4) = (f32x4){S1[2].x, S1[2].y, S1[3].x, S1[3].y};
    if (wave == 0 && lane < 8) { *(f32x4*)(CE + s8) = (f32x4){c[0].x, c[0].y, c[1].x, c[1].y}; *(f32x4*)(CE + s8 + 4) = (f32x4){c[2].x, c[2].y, c[3].x, c[3].y}; }
}
__device__ __forceinline__ void phase_scan(const Params& P, LAS unsigned char* lds) {
    for (int it = blockIdx.x; it < 512 + 256; it += gridDim.x) {
        if (it < 512) { const int bh = it >> 4; rwkv_item(P, lds, bh >> 3, bh & 7, it & 15); }
        else { const int g = it - 512, bh = g >> 4; gla_item(P, lds, bh >> 2, bh & 3, g & 15); }
        __syncthreads();
    }
}
__device__ __forceinline__ void phase_fixup(const Params& P, LAS unsigned char* lds) {
    const int tid = threadIdx.x;
    for (int it = blockIdx.x; it < 48; it += gridDim.x) {
        if (it < 32) {
            float* SE = (float*)(P.ws + WS_SER) + (size_t)it * NSEG * 2 * 4096;
            LAS float* Sc = (LAS float*)lds; LAS float* Ph = Sc + 64 * 65;
            const int v = tid >> 3, kq = (tid & 7) * 8;
            __syncthreads();
            for (int i = tid; i < 64 * 65; i += NTHR) Sc[i] = 0.f;
            for (int seg = 0; seg < NSEG - 1; ++seg) {
                float* s0 = SE + (size_t)(seg * 2 + 0) * 4096; const float* ph = SE + (size_t)(seg * 2 + 1) * 4096;
                __syncthreads();
                for (int i = tid; i < 1024; i += NTHR) *(LAS f32x4*)(Ph + 4 * i) = *(const f32x4*)(ph + 4 * i);
                f32x4 a0 = *(const f32x4*)(s0 + v * 64 + kq), a1 = *(const f32x4*)(s0 + v * 64 + kq + 4);
                __syncthreads();
                for (int j = 0; j < 64; ++j) { const float sv = Sc[v * 65 + j]; a0 += *(const LAS f32x4*)(Ph + j * 64 + kq) * sv; a1 += *(const LAS f32x4*)(Ph + j * 64 + kq + 4) * sv; }
                __syncthreads();
#pragma unroll
                for (int i = 0; i < 4; ++i) { Sc[v * 65 + kq + i] = a0[i]; Sc[v * 65 + kq + 4 + i] = a1[i]; }
                *(f32x4*)(s0 + v * 64 + kq) = a0; *(f32x4*)(s0 + v * 64 + kq + 4) = a1;
            }
        } else {
            const int bh = it - 32; float* SE = (float*)(P.ws + WS_SEG) + (size_t)bh * NSEG * 8192; const float* CE = (const float*)(P.ws + WS_CEND) + (size_t)bh * NSEG * 64;
            const int v = tid >> 2, d0 = (tid & 3) * 16; f32x4 sc[4];
#pragma unroll
            for (int q = 0; q < 4; ++q) sc[q] = (f32x4){0.f, 0.f, 0.f, 0.f};
            for (int seg = 0; seg < NSEG - 1; ++seg) {
#pragma unroll
                for (int q = 0; q < 4; ++q) { float* sp = SE + (size_t)seg * 8192 + v * 64 + d0 + 4 * q; sc[q] = sc[q] * *(const f32x4*)(CE + seg * 64 + d0 + 4 * q) + *(const f32x4*)sp; *(f32x4*)sp = sc[q]; }
            }
        }
    }
}
__device__ __forceinline__ void phase_correct(const Params& P, LAS unsigned char* lds) {
    const int tid = threadIdx.x, lane = tid & 63, wave = tid >> 6;
    unsigned char* ws = P.ws;
    const bf16* p = (const bf16*)(ws + WS_P); const bf16* AA = (const bf16*)(ws + WS_AA); const bf16* GG = (const bf16*)(ws + WS_GG);
    bf16* MIX = (bf16*)(ws + WS_MIX); const bf16* YI = (const bf16*)(ws + WS_YI); const bf16* YIG = (const bf16*)(ws + WS_YIG);
    const float* mu = P.in[4]; const float* k_a = P.in[11]; const float* r_k = P.in[12]; const float* gn_g = P.in[13]; const float* gn_b = P.in[14]; const float* norm_g = P.in[18];
    LAS float* SL = (LAS float*)lds;
    for (int it = blockIdx.x; it < 512 + 256; it += gridDim.x) {
        __syncthreads();
        if (it < 512) {
            const int seg = it & 15, bh = it >> 4, b = bh >> 3, h = bh & 7;
            if (seg > 0) { const float* ss = (const float*)(ws + WS_SER) + (((size_t)bh * NSEG + (seg - 1)) * 2) * 4096;
                for (int i = tid; i < 4096; i += NTHR) SL[(i & 63) * 65 + (i >> 6)] = ss[i]; }
            __syncthreads();
            const int col = h * 64 + lane;
            const float mu_r = mu[C_R + col], mu_k = mu[C_K + col], mu_v = mu[C_V + col], kac = k_a[col], rkc = r_k[col], gng = gn_g[col], gnb = gn_b[col];
            for (int i0 = 0; i0 < 64; i0 += 4) {
                float y[4], yi[4], r[4], k[4], v[4], a[4], g[4];
#pragma unroll
                for (int u = 0; u < 4; ++u) {
                    const int t = seg * LSEG + wave * 64 + i0 + u; const size_t m = (size_t)b * T + t; const bf16* pr = p + m * NP; const bf16* pp = (t > 0) ? pr - NP : pr; const float hp = (t > 0) ? 1.f : 0.f;
                    y[u] = bf2f(MIX[m * D + col]); yi[u] = bf2f(YI[m * 512 + col]);
                    const float rc = bf2f(pr[C_R + col]), kc = bf2f(pr[C_K + col]), vc = bf2f(pr[C_V + col]);
                    r[u] = rc + (bf2f(pp[C_R + col]) * hp - rc) * mu_r; k[u] = kc + (bf2f(pp[C_K + col]) * hp - kc) * mu_k; v[u] = vc + (bf2f(pp[C_V + col]) * hp - vc) * mu_v;
                    a[u] = bf2f(AA[m * A_W + col]); g[u] = bf2f(GG[m * A_W + col]);
                }
                if (seg > 0) {
                    for (int j = 0; j < 64; ++j) { const float sv = SL[j * 65 + lane];
#pragma unroll
                        for (int u = 0; u < 4; ++u) y[u] += rlf(yi[u], j) * sv; }
                }
#pragma unroll
                for (int u = 0; u < 4; ++u) {
                    const size_t m = (size_t)b * T + seg * LSEG + wave * 64 + i0 + u;
                    const float kh = k[u] * (1.f + (a[u] - 1.f) * kac); const float bon = wave_sum(r[u] * kh * rkc);
                    const float mean = wave_sum(y[u]) * (1.f / 64.f); const float d = y[u] - mean; const float var = wave_sum(d * d) * (1.f / 64.f);
                    float o = d * (1.f / sqrtf(var + GN_EPS)) * gng + gnb; o += bon * v[u]; o *= g[u];
                    MIX[m * D + col] = (bf16)f2bf(o);
                }
            }
        } else {
            const int g_ = it - 512, seg = g_ & 15, bh = g_ >> 4, b = bh >> 2, h = bh & 3;
            if (seg > 0) { const float* ss = (const float*)(ws + WS_SEG) + ((size_t)bh * NSEG + (seg - 1)) * 8192;
                for (int i = tid; i < 8192; i += NTHR) SL[(i & 63) * 129 + (i >> 6)] = ss[i]; }
            __syncthreads();
            const float ng0 = norm_g[lane], ng1 = norm_g[lane + 64];
            for (int i0 = 0; i0 < 64; i0 += 4) {
                float o0[4], o1[4], yi[4], g0[4], g1[4];
#pragma unroll
                for (int u = 0; u < 4; ++u) {
                    const size_t m = (size_t)b * T + seg * LSEG + wave * 64 + i0 + u;
                    o0[u] = bf2f(MIX[m * D + 512 + h * 128 + lane]); o1[u] = bf2f(MIX[m * D + 512 + h * 128 + 64 + lane]); yi[u] = bf2f(YIG[m * 256 + h * 64 + lane]);
                    g0[u] = bf2f(p[m * NP + C_BG + h * 128 + lane]); g1[u] = bf2f(p[m * NP + C_BG + h * 128 + 64 + lane]);
                }
                if (seg > 0) {
                    for (int d = 0; d < 64; ++d) { const float s0 = SL[d * 129 + lane], s1 = SL[d * 129 + 64 + lane];
#pragma unroll
                        for (int u = 0; u < 4; ++u) { const float q = rlf(yi[u], d); o0[u] += q * s0; o1[u] += q * s1; } }
                }
#pragma unroll
                for (int u = 0; u < 4; ++u) {
                    const size_t m = (size_t)b * T + seg * LSEG + wave * 64 + i0 + u;
                    const float ms = wave_sum(o0[u] * o0[u] + o1[u] * o1[u]) * (1.f / 128.f); const float rs = 1.f / sqrtf(ms + RMS_EPS);
                    MIX[m * D + 512 + h * 128 + lane] = (bf16)f2bf(o0[u] * rs * ng0 * siluf_(g0[u])); MIX[m * D + 512 + h * 128 + 64 + lane] = (bf16)f2bf(o1[u] * rs * ng1 * siluf_(g1[u]));
                }
            }
        }
    }
}

__device__ __forceinline__ void phase_ln1(const Params& P) {
    const int lane = threadIdx.x & 63, wave = threadIdx.x >> 6; const int gw = blockIdx.x * NWAVES + wave, ngw = gridDim.x * NWAVES;
    for (int m = gw; m < M; m += ngw) ln_row_bf16((const float*)(P.ws + WS_Z) + (size_t)m * D, P.in[20], P.in[21], (bf16*)(P.ws + WS_H1) + (size_t)m * D, lane);
#pragma unroll
    for (int tb = 0; tb < 2; ++tb) {
        const float* src = P.in[24 + tb]; unsigned char* dst = P.ws + (tb ? WS_VT : WS_UT); float* sc = (float*)(P.ws + (tb ? WS_SV : WS_SU));
        for (int e = gw; e < 16384; e += ngw) {
            const f32x4* sp = (const f32x4*)(src + (size_t)e * D) + 4 * lane; f32x4 a[4]; float mx = 0.f;
#pragma unroll
            for (int j = 0; j < 4; ++j) { a[j] = sp[j]; mx = fmaxf(fmaxf(mx, fmaxf(fabsf(a[j][0]), fabsf(a[j][1]))), fmaxf(fabsf(a[j][2]), fabsf(a[j][3]))); }
            mx = wave_max_u(mx); const float inv = mx > 0.f ? 127.f / mx : 0.f;
            u32x4 o;
#pragma unroll
            for (int j = 0; j < 4; ++j) o[j] = pack_i8(a[j][0], a[j][1], a[j][2], a[j][3], inv, tb ? 128 : 0);
            *((u32x4*)(dst + (size_t)e * D) + lane) = o;
            if (lane == 0) sc[e] = mx * (1.f / 127.f);
        }
    }
}

#define TK_INS(L, x) do { _Pragma("unroll") for (int _j = 0; _j < 16; ++_j) { const unsigned _h = max(L[_j], x); x = min(L[_j], x); L[_j] = _h; } } while (0)
__device__ __forceinline__ void topk128(const u32x4* r, unsigned (&L)[16]) {
#pragma unroll
    for (int j = 0; j < 16; ++j) L[j] = 0u;
    u32x4 cur = r[0];
    for (int c = 0; c < 16; ++c) {
        const u32x4 nxt = r[(c + 1) & 15];
        const unsigned kb = 0xFFFFu - 8u * (unsigned)c;
#pragma unroll
        for (int d = 0; d < 4; ++d) {
            unsigned w = cur[d]; const unsigned msk = ((w >> 15) & 0x00010001u) * 0xFFFFu; w ^= (msk | 0x80008000u);
            unsigned x0 = (w << 16) | (kb - 2u * d), x1 = (w & 0xFFFF0000u) | (kb - 2u * d - 1u);
            TK_INS(L, x0); TK_INS(L, x1);
        }
        cur = nxt;
    }
}
__device__ __forceinline__ void phase_topk(const Params& P) {
    const int gl = blockIdx.x * NTHR + threadIdx.x, nl = gridDim.x * NTHR;
    const bf16* Sc = (const bf16*)(P.ws + WS_S); int* IDS = (int*)(P.ws + WS_IDS); float* GATES = (float*)(P.ws + WS_GATES);
    for (int item = gl; item < M * 8; item += nl) {
        const u32x4* row = (const u32x4*)(Sc + (size_t)item * 256);
        unsigned L0[16], L1[16];
        topk128(row, L0); topk128(row + 16, L1);
        float f0[16], f1[16]; unsigned p0[16], p1[16];
#pragma unroll
        for (int i = 0; i < 16; ++i) {
            f0[i] = __uint_as_float((L0[i] & 0x80000000u) ? (L0[i] & 0x7FFF0000u) : (~L0[i] & 0xFFFF0000u)); p0[i] = (~L0[i] & 0x7Fu) << 7;
            f1[i] = __uint_as_float((L1[i] & 0x80000000u) ? (L1[i] & 0x7FFF0000u) : (~L1[i] & 0xFFFF0000u)); p1[i] = (~L1[i] & 0x7Fu);
        }
        unsigned C[16];
#pragma unroll
        for (int j = 0; j < 16; ++j) C[j] = 0u;
#pragma unroll
        for (int i = 0; i < 16; ++i)
#pragma unroll
            for (int j = 0; j < 16; ++j)
                if ((i + 1) * (j + 1) <= 16) {
                    const unsigned b = __float_as_uint(f0[i] + f1[j]); const unsigned mono = b ^ ((unsigned)((int)b >> 31) | 0x80000000u);
                    unsigned key = (mono & 0xFFFFC000u) | p0[i] | p1[j];
                    TK_INS(C, key);
                }
        float cv[16];
#pragma unroll
        for (int r = 0; r < 16; ++r) cv[r] = __uint_as_float((C[r] & 0x80000000u) ? (C[r] & 0x7FFFC000u) : (~C[r] & 0xFFFFC000u));
        const float cmax = cv[0]; float den = 0.f;
#pragma unroll
        for (int r = 0; r < 16; ++r) { cv[r] = __expf(cv[r] - cmax); den += cv[r]; }
        const float inv = 1.f / den;
        u32x4* ido = (u32x4*)(IDS + (size_t)item * 16); f32x4* go = (f32x4*)(GATES + (size_t)item * 16);
#pragma unroll
        for (int q = 0; q < 4; ++q) { u32x4 o; o.x = C[4 * q] & 0x3FFFu; o.y = C[4 * q + 1] & 0x3FFFu; o.z = C[4 * q + 2] & 0x3FFFu; o.w = C[4 * q + 3] & 0x3FFFu; ido[q] = o;
            f32x4 g; g[0] = cv[4 * q] * inv; g[1] = cv[4 * q + 1] * inv; g[2] = cv[4 * q + 2] * inv; g[3] = cv[4 * q + 3] * inv; go[q] = g; }
    }
}

typedef __bf16 bf16x2_t __attribute__((ext_vector_type(2)));
__device__ __forceinline__ float dot2bf(unsigned a, unsigned b, float c) { return __builtin_amdgcn_fdot2_f32_bf16(__builtin_bit_cast(bf16x2_t, a), __builtin_bit_cast(bf16x2_t, b), c, false); }
__device__ __forceinline__ void peer_load8(u32x4 (&buf)[8], const unsigned char* TAB, int idreg, int g, int lane) {
#pragma unroll
    for (int q = 0; q < 8; ++q) { const int id = __builtin_amdgcn_readlane(idreg, 8 * g + q); buf[q] = *((const u32x4*)(TAB + (size_t)id * D) + lane); }
}
__device__ __forceinline__ void peer_dots8(const u32x4 (&buf)[8], const u32x4& hq, int g, float& d, int lane) {
#pragma unroll
    for (int q = 0; q < 8; ++q) { int s = 0;
#pragma unroll
        for (int i = 0; i < 4; ++i) s = __builtin_amdgcn_sdot4((int)buf[q][i], (int)hq[i], s, false);
        const int tot = wave_sum_i(s);
        d = (lane == 8 * g + q) ? (float)tot : d; }
}
__device__ __forceinline__ void peer_axpy8(const u32x4 (&buf)[8], float areg, int g, float (&acc)[16]) {
#pragma unroll
    for (int q = 0; q < 8; ++q) { const float a = rlf(areg, 8 * g + q);
#pragma unroll
        for (int i = 0; i < 4; ++i) { const unsigned w = buf[q][i];
            acc[4 * i] += a * (float)(w & 0xffu); acc[4 * i + 1] += a * (float)((w >> 8) & 0xffu); acc[4 * i + 2] += a * (float)((w >> 16) & 0xffu); acc[4 * i + 3] += a * (float)(w >> 24); } }
}
__device__ __forceinline__ void phase_peer(const Params& P) {
    const int lane = threadIdx.x & 63, wave = threadIdx.x >> 6; const int gw = blockIdx.x * NWAVES + wave, ngw = gridDim.x * NWAVES;
    const bf16* H1 = (const bf16*)(P.ws + WS_H1); const int* IDS = (const int*)(P.ws + WS_IDS); const float* GATES = (const float*)(P.ws + WS_GATES);
    const unsigned char* UT = P.ws + WS_UT; const unsigned char* VT = P.ws + WS_VT; const float* SU = (const float*)(P.ws + WS_SU); const float* SV = (const float*)(P.ws + WS_SV);
    const float* g2 = P.in[26]; const float* b2 = P.in[27];
    for (int m = gw; m < M; m += ngw) {
        const u32x4* hp = (const u32x4*)(H1 + (size_t)m * D) + 2 * lane; const u32x4 hA = hp[0], hB = hp[1];
        float hv[16]; float hmx = 0.f;
#pragma unroll
        for (int i = 0; i < 4; ++i) { hv[2 * i] = __uint_as_float(hA[i] << 16); hv[2 * i + 1] = __uint_as_float(hA[i] & 0xffff0000u); hv[8 + 2 * i] = __uint_as_float(hB[i] << 16); hv[8 + 2 * i + 1] = __uint_as_float(hB[i] & 0xffff0000u); }
#pragma unroll
        for (int i = 0; i < 16; ++i) hmx = fmaxf(hmx, fabsf(hv[i]));
        hmx = wave_max_u(hmx); const float hinv = hmx > 0.f ? 127.f / hmx : 0.f, hsc = hmx * (1.f / 127.f);
        u32x4 hq;
#pragma unroll
        for (int i = 0; i < 4; ++i) hq[i] = pack_i8(hv[4 * i], hv[4 * i + 1], hv[4 * i + 2], hv[4 * i + 3], hinv, 0);
        const int id_lo = IDS[(size_t)m * 128 + lane], id_hi = IDS[(size_t)m * 128 + 64 + lane];
        const float gt_lo = GATES[(size_t)m * 128 + lane], gt_hi = GATES[(size_t)m * 128 + 64 + lane];
        const float su_lo = SU[id_lo], su_hi = SU[id_hi], sv_lo = SV[id_lo], sv_hi = SV[id_hi];
        float d_lo = 0.f, d_hi = 0.f;
        u32x4 A0[8], A1[8];
        peer_load8(A0, UT, id_lo, 0, lane);
        for (int g = 0; g < 8; g += 2) {
            peer_load8(A1, UT, id_lo, g + 1, lane); peer_dots8(A0, hq, g, d_lo, lane);
            if (g + 2 < 8) peer_load8(A0, UT, id_lo, g + 2, lane); else peer_load8(A0, UT, id_hi, 0, lane);
            peer_dots8(A1, hq, g + 1, d_lo, lane);
        }
        for (int g = 0; g < 8; g += 2) {
            peer_load8(A1, UT, id_hi, g + 1, lane); peer_dots8(A0, hq, g, d_hi, lane);
            if (g + 2 < 8) peer_load8(A0, UT, id_hi, g + 2, lane); else peer_load8(A0, VT, id_lo, 0, lane);
            peer_dots8(A1, hq, g + 1, d_hi, lane);
        }
        const float x_lo = d_lo * su_lo * hsc, x_hi = d_hi * su_hi * hsc;
        const float a_lo = 0.5f * x_lo * (1.f + erff(x_lo * 0.70710678118f)) * gt_lo * sv_lo, a_hi = 0.5f * x_hi * (1.f + erff(x_hi * 0.70710678118f)) * gt_hi * sv_hi;
        const float c0 = 128.f * wave_sum(a_lo + a_hi);
        float acc[16];
#pragma unroll
        for (int i = 0; i < 16; ++i) acc[i] = 0.f;
        for (int g = 0; g < 8; g += 2) {
            peer_load8(A1, VT, id_lo, g + 1, lane); peer_axpy8(A0, a_lo, g, acc);
            if (g + 2 < 8) peer_load8(A0, VT, id_lo, g + 2, lane); else peer_load8(A0, VT, id_hi, 0, lane);
            peer_axpy8(A1, a_lo, g + 1, acc);
        }
        for (int g = 0; g < 8; g += 2) {
            peer_load8(A1, VT, id_hi, g + 1, lane); peer_axpy8(A0, a_hi, g, acc);
            if (g + 2 < 8) peer_load8(A0, VT, id_hi, g + 2, lane);
            peer_axpy8(A1, a_hi, g + 1, acc);
        }
        float s = 0.f;
#pragma unroll
        for (int i = 0; i < 16; ++i) { acc[i] = ALPHA * hv[i] + (acc[i] - c0); s += acc[i]; }
        const float mean = wave_sum(s) * (1.f / D); float s2 = 0.f;
#pragma unroll
        for (int i = 0; i < 16; ++i) { acc[i] -= mean; s2 += acc[i] * acc[i]; }
        const float rstd = 1.f / sqrtf(wave_sum(s2) * (1.f / D) + LN_EPS);
#pragma unroll
        for (int c4 = 0; c4 < 4; ++c4) { const int e0 = 16 * lane + 4 * c4; const f32x4 gg = *(const f32x4*)(g2 + e0), bb = *(const f32x4*)(b2 + e0); f32x4 o;
#pragma unroll
            for (int j = 0; j < 4; ++j) o[j] = acc[c4 * 4 + j] * rstd * gg[j] + bb[j];
            *(f32x4*)(P.out + (size_t)m * D + e0) = o; }
    }
}

#define XB_TMO      128
#define XB_XCNT(j)  (256  + 64 * (j))
#define XB_XSUB(j)  (1280 + 64 * (j))
#define XB_XGEN(j)  (2304 + 64 * (j))
#define XB_TOP      3328
#define XB_TOPGEN   3392
#define XCD_BAR_WORDS 3456
#define XB_SPIN_CAP (1u << 18)
__device__ __forceinline__ unsigned xb_ld(unsigned* p)              { return __hip_atomic_load(p, __ATOMIC_RELAXED, __HIP_MEMORY_SCOPE_AGENT); }
__device__ __forceinline__ unsigned xb_add(unsigned* p, unsigned v) { return __hip_atomic_fetch_add(p, v, __ATOMIC_RELAXED, __HIP_MEMORY_SCOPE_AGENT); }
__device__ __forceinline__ unsigned xb_xcc_id() { return (unsigned)__builtin_amdgcn_s_getreg((3 << 11) | 20) & 0xFu; }
#define XB_SPIN(cond, bar) do { unsigned _sp = 0; while (cond) { __builtin_amdgcn_s_sleep(1); \
    if ((++_sp & 255u) == 0u) { if (xb_ld(&(bar)[XB_TMO])) break; if (_sp > XB_SPIN_CAP) { atomicAdd(&(bar)[XB_TMO], 1u); break; } } } } while (0)
struct XcdBarrier { unsigned* bar; unsigned x; volatile LAS unsigned* st; };
__device__ __forceinline__ XcdBarrier xcd_barrier_post(unsigned* bar, volatile LAS unsigned* st) {
    XcdBarrier b; b.bar = bar; b.x = xb_xcc_id(); b.st = st;
    if (threadIdx.x == 0) (void)xb_add(&bar[XB_XCNT(b.x)], 1u);
    return b;
}
__device__ __forceinline__ void xcd_barrier_complete(unsigned* bar, unsigned x, unsigned& nloc, unsigned& nx) {
    const unsigned G = gridDim.x * gridDim.y * gridDim.z;
    unsigned sum, cnt, mine, sp = 0u;
    for (;;) {
        sum = 0u; cnt = 0u; mine = 0u;
#pragma unroll
        for (unsigned j = 0; j < 16; ++j) { const unsigned c = xb_ld(&bar[XB_XCNT(j)]); sum += c; cnt += (c > 0u) ? 1u : 0u; mine = (j == x) ? c : mine; }
        if (sum == G) break;
        __builtin_amdgcn_s_sleep(1);
        if ((++sp & 255u) == 0u) { if (xb_ld(&bar[XB_TMO])) break; if (sp > XB_SPIN_CAP) { atomicAdd(&bar[XB_TMO], 1u); break; } }
    }
    nloc = mine > 0u ? mine : 1u; nx = cnt > 0u ? cnt : 1u;
}
__device__ __forceinline__ void xcd_barrier(const XcdBarrier& b) {
    asm volatile("s_waitcnt vmcnt(0)" ::: "memory");
    __syncthreads();
    if (threadIdx.x == 0) {
        unsigned* bar = b.bar;
        __builtin_amdgcn_s_waitcnt(0);
        unsigned nloc = b.st[0], nx = b.st[1];
        if (nloc == 0u) { xcd_barrier_complete(bar, b.x, nloc, nx); b.st[0] = nloc; b.st[1] = nx; }
        const unsigned old = xb_add(&bar[XB_XSUB(b.x)], 1u);
        const unsigned gen = old / nloc;
        if (old + 1u == (gen + 1u) * nloc) {
            __builtin_amdgcn_fence(__ATOMIC_RELEASE, "agent");
            asm volatile("s_waitcnt vmcnt(0)" ::: "memory");
            const unsigned og = xb_add(&bar[XB_TOP], 1u);
            const unsigned tg = og / nx;
            if (og + 1u == (tg + 1u) * nx) xb_add(&bar[XB_TOPGEN], 1u);
            else XB_SPIN(xb_ld(&bar[XB_TOPGEN]) == tg, bar);
            __builtin_amdgcn_fence(__ATOMIC_ACQUIRE, "agent");
            xb_add(&bar[XB_XGEN(b.x)], 1u);
            asm volatile("s_waitcnt vmcnt(0)" ::: "memory");
        } else {
            XB_SPIN(xb_ld(&bar[XB_XGEN(b.x)]) == gen, bar);
            __builtin_amdgcn_fence(__ATOMIC_ACQUIRE, "agent");
            asm volatile("s_waitcnt vmcnt(0)" ::: "memory");
        }
    }
    __syncthreads();
}

constexpr int N_PHASES = 12;
__global__ void __launch_bounds__(NTHR, 2) fwd_kernel(Params P) {
    extern __shared__ __attribute__((aligned(16))) unsigned char lds_raw[];
    LAS unsigned char* lds = (LAS unsigned char*)lds_raw;
    cg::grid_group grid = cg::this_grid();
    const int lo = P.ph_lo, hi = P.ph_hi;
    unsigned char* ws = P.ws;
    volatile LAS unsigned* bst = (volatile LAS unsigned*)(lds + LDS_MISC);
    if (threadIdx.x < 16) bst[threadIdx.x] = 0u;
    __syncthreads();
    const XcdBarrier bar = xcd_barrier_post((unsigned*)(ws + WS_CTL), bst);
#define IN(k) (lo <= (k) && (k) < hi)
#define SEAM(k) do { if (IN(k) && IN((k) + 1)) { if ((k) == 0) grid.sync(); else xcd_barrier(bar); } } while (0)
    if (IN(0)) phase_prologue(P);
    SEAM(0);
    if (IN(1)) {
        pg8::Gemm g{(const bf16*)(ws + WS_H0), (const bf16*)(ws + WS_WIN), M, NP, D, D, D, 0}; pg8::StaticOrder S; S.init(M, NP, gridDim.x, blockIdx.x);
        pg8::EpiBf16 E{(bf16*)(ws + WS_P), NP};
        pg8::gemm_phase<pg8::EpiBf16, pg8::StaticOrder, true, true>(lds, g, S, E);
    }
    SEAM(1);
    if (IN(2)) phase_prep(P, lds);
    SEAM(2);
    if (IN(3)) phase_scan(P, lds);
    SEAM(3);
    if (IN(4)) phase_fixup(P, lds);
    SEAM(4);
    if (IN(5)) phase_correct(P, lds);
    SEAM(5);
    if (IN(6)) {
        pg8::Gemm g{(const bf16*)(ws + WS_MIX), (const bf16*)(ws + WS_WOUT), M, D, D, D, D, 0}; pg8::StaticOrder S; S.init(M, D, gridDim.x, blockIdx.x);
        pg8::EpiResF32 E{(float*)(ws + WS_Z), (const bf16*)(ws + WS_H0), D, ALPHA};
        pg8::gemm_phase<pg8::EpiResF32, pg8::StaticOrder, true, true>(lds, g, S, E);
    }
    SEAM(6);
    if (IN(7)) phase_ln1(P);
    SEAM(7);
    if (IN(8)) {
        pg8::Gemm g{(const bf16*)(ws + WS_H1), (const bf16*)(ws + WS_WQ), M, NQ, D, D, D, 0}; pg8::StaticOrder S; S.init(M, NQ, gridDim.x, blockIdx.x);
        pg8::EpiBf16 E{(bf16*)(ws + WS_Q), NQ};
        pg8::gemm_phase<pg8::EpiBf16, pg8::StaticOrder, true, true>(lds, g, S, E);
    }
    SEAM(8);
    if (IN(9)) {
        pg8::Gemm g{(const bf16*)(ws + WS_Q), (const bf16*)(ws + WS_KBD), M, NQ, 256, NQ, 256, 256}; pg8::StaticOrder S; S.init(M, NQ, gridDim.x, blockIdx.x);
        pg8::EpiBf16 E{(bf16*)(ws + WS_S), NQ};
        pg8::gemm_phase<pg8::EpiBf16, pg8::StaticOrder, true, true>(lds, g, S, E);
    }
    SEAM(9);
    if (IN(10)) phase_topk(P);
    SEAM(10);
    if (IN(11)) phase_peer(P);
#undef IN
#undef SEAM
}

extern "C" void kernel_launch(void* const* d_in, const int* in_sizes, int n_in, void* d_out, int out_size, void* d_ws, size_t ws_size, hipStream_t stream) {
    static int grid = 0;
    if (grid == 0) {
        if (n_in != 28 || out_size != M * D || ws_size < WS_END) { fprintf(stderr, "kernel_launch: unexpected shapes (n_in %d out %d ws %zu)\n", n_in, out_size, ws_size); grid = -1; return; }
        int dev = 0, cus = 0, per_cu = 0;
        (void)hipGetDevice(&dev); (void)hipDeviceGetAttribute(&cus, hipDeviceAttributeMultiprocessorCount, dev);
        (void)hipFuncSetAttribute((const void*)fwd_kernel, hipFuncAttributeMaxDynamicSharedMemorySize, LDS_BYTES);
        (void)hipOccupancyMaxActiveBlocksPerMultiprocessor(&per_cu, (const void*)fwd_kernel, NTHR, LDS_BYTES);
        if (per_cu < 1) { fprintf(stderr, "kernel_launch: occupancy query says %d blocks per CU\n", per_cu); per_cu = 1; }
        (void)hipGetLastError();
        grid = cus;
    }
    if (grid < 0) return;
    Params p{};
    for (int i = 0; i < 28; ++i) p.in[i] = (const float*)d_in[i];
    p.out = (float*)d_out; p.ws = (unsigned char*)d_ws;
    (void)hipMemsetAsync((char*)d_ws + WS_CTL, 0, CTL_BYTES, stream);
#if MK_ONE_LAUNCH
    p.ph_lo = 0; p.ph_hi = N_PHASES;
    void* args[] = {&p};
    hipError_t e = hipLaunchCooperativeKernel((const void*)fwd_kernel, dim3(grid), dim3(NTHR), args, LDS_BYTES, stream);
    if (e != hipSuccess) fprintf(stderr, "cooperative launch failed: %s (grid %d)\n", hipGetErrorString(e), grid);
#else
    for (int ph = 0; ph < N_PHASES; ++ph) {
        p.ph_lo = ph; p.ph_hi = ph + 1;
        hipLaunchKernelGGL(fwd_kernel, dim3(grid), dim3(NTHR), LDS_BYTES, stream, p);
    }
#endif
}
```

```cpp
#include <hip/hip_runtime.h>
#include <hip/hip_cooperative_groups.h>
#include <cstdio>
#include <cstdint>
namespace cg = cooperative_groups;

#ifndef MK_ONE_LAUNCH
#define MK_ONE_LAUNCH 1
#endif

namespace pg8 {
#define PG8_LAS __attribute__((address_space(3)))
typedef unsigned short bf16_t;
typedef short bf16x8 __attribute__((ext_vector_type(8)));
typedef float f32x4 __attribute__((ext_vector_type(4)));
typedef float f32x2 __attribute__((ext_vector_type(2)));
typedef unsigned u32x4 __attribute__((ext_vector_type(4)));
typedef unsigned u32x2 __attribute__((ext_vector_type(2)));
constexpr int BM = 256, BK = 64, HALF = 128, HTB = HALF * BK * 2, STAGE_BYTES = 8 * HTB, NXCD = 8, WGM = 8;

__host__ __device__ __forceinline__ int lds_byte(int r, int c) { const int st = (r >> 4) * 2 + (c >> 5), rr = r & 15, cc = c & 31, ob = rr * 64 + cc * 2; return st * 1024 + (ob ^ (((ob >> 9) & 1) << 5)); }
__host__ __device__ __forceinline__ void stage_rc(int b, int& R, int& C) { const int st = b / 1024, sb = b % 1024, swz = sb ^ (((sb >> 9) & 1) << 5); R = (st >> 1) * 16 + swz / 64; C = (st & 1) * 32 + (swz % 64) / 2; }
__host__ __device__ __forceinline__ int perm32(int rho) { const int n = rho >> 4, i = rho & 15; return 8 * (i >> 2) + 4 * n + (i & 3); }

struct Unit { int pm, pn; };
struct Gemm { const bf16_t* A; const bf16_t* Bt; int M, N, K, lda, ldb, a_pn_koff; };

struct StaticOrder {
    int nM, nN, nwg, G, c;
    __host__ __device__ void init(int M, int N, int G_, int c_) { nM = M / BM; nN = N / BM; nwg = nM * nN; G = G_; c = c_; }
    __host__ __device__ bool next(int i, Unit& u) const {
        const long L = (long)i * G + c; if (L >= nwg) return false;
        int wgid = (int)L; { const int q = nwg / NXCD, r = nwg % NXCD, xcd = wgid % NXCD, off = wgid / NXCD; wgid = (xcd < r ? xcd * (q + 1) : r * (q + 1) + (xcd - r) * q) + off; }
        const int nig = WGM * nN, gid = wgid / nig, fm = gid * WGM, gsz = (nM - fm) < WGM ? (nM - fm) : WGM;
        u.pm = fm + ((wgid % nig) % gsz); u.pn = (wgid % nig) / gsz; return true;
    }
    __device__ __forceinline__ void a_ready(const Unit&) const {}
    __device__ __forceinline__ void done(const Unit&) const {}
};

__device__ __forceinline__ unsigned cvt_pk_bf16(float lo, float hi) { unsigned r; asm volatile("v_cvt_pk_bf16_f32 %0, %1, %2" : "=v"(r) : "v"(lo), "v"(hi)); return r; }

struct EpiBf16 {
    static constexpr bool PERM = true;
    bf16_t* O; int ldc;
    __device__ __forceinline__ void operator()(const f32x4 (&acc)[2][2][4][2], const Unit& u, int wr, int wc, int fr, int fq) const {
        const int row0 = u.pm * BM + wr * 64 + fr; const int col0 = u.pn * BM + wc * 32 + 8 * fq;
#pragma unroll
        for (int ai = 0; ai < 2; ++ai)
#pragma unroll
            for (int m = 0; m < 4; ++m) { bf16_t* rowp = O + (size_t)(row0 + ai * HALF + m * 16) * ldc + col0;
#pragma unroll
                for (int bj = 0; bj < 2; ++bj) { const f32x4 v0 = acc[ai][bj][m][0], v1 = acc[ai][bj][m][1];
                    u32x4 w; w.x = cvt_pk_bf16(v0[0], v0[1]); w.y = cvt_pk_bf16(v0[2], v0[3]); w.z = cvt_pk_bf16(v1[0], v1[1]); w.w = cvt_pk_bf16(v1[2], v1[3]);
                    *(u32x4*)(rowp + bj * HALF) = w; } }
    }
};
struct EpiResF32 {
    static constexpr bool PERM = false;
    float* Z; const bf16_t* R; int ldc; float alpha;
    __device__ __forceinline__ void operator()(const f32x4 (&acc)[2][2][4][2], const Unit& u, int wr, int wc, int fr, int fq) const {
        const int row0 = u.pm * BM + wr * 64 + fr; const int col0 = u.pn * BM + wc * 32 + 4 * fq;
#pragma unroll
        for (int ai = 0; ai < 2; ++ai)
#pragma unroll
            for (int m = 0; m < 4; ++m) { const size_t off = (size_t)(row0 + ai * HALF + m * 16) * ldc + col0;
#pragma unroll
                for (int bj = 0; bj < 2; ++bj)
#pragma unroll
                    for (int n = 0; n < 2; ++n) { const size_t o2 = off + bj * HALF + n * 16; const u32x2 rb = *(const u32x2*)(R + o2);
                        f32x4 h; h[0] = __uint_as_float(rb.x << 16); h[1] = __uint_as_float(rb.x & 0xffff0000u); h[2] = __uint_as_float(rb.y << 16); h[3] = __uint_as_float(rb.y & 0xffff0000u);
                        *(f32x4*)(Z + o2) = h * alpha + acc[ai][bj][m][n]; } }
    }
};

template <class Epi, class Sched, bool ALIGN_EPI = false, bool SP2 = false>
__device__ __forceinline__ void gemm_phase(PG8_LAS unsigned char* lds, const Gemm g, const Sched& S, const Epi& E) {
    const int tid = threadIdx.x, wid = __builtin_amdgcn_readfirstlane(tid >> 6), lane = tid & 63, wr = wid >> 2, wc = wid & 3, fr = lane & 15, fq = lane >> 4;
    const int K = g.K, nt = K / BK;
    unsigned voffA[2], voffB[2];
#pragma unroll
    for (int i = 0; i < 2; ++i) { int R, C; stage_rc(tid * 16 + i * 8192, R, C); const int Rb = Epi::PERM ? ((R & ~31) + perm32(R & 31)) : R;
        voffA[i] = (unsigned)(R * g.lda + C) * 2u; voffB[i] = (unsigned)(Rb * g.ldb + C) * 2u; }
    const size_t kstep = (size_t)(BK * 2);
    const size_t hstepA = (size_t)HALF * g.lda * 2, hstepB = (size_t)HALF * g.ldb * 2;
    const size_t tstepA = 2 * hstepA, tstepB = 2 * hstepB;
    const size_t pnA = (size_t)g.a_pn_koff * 2;
    const unsigned ldsw = (unsigned)wid * 1024u;
    const int aoff = lds_byte(wr * 64 + fr, fq * 8), boff = lds_byte(wc * 32 + fr, fq * 8);
#define PG8_SA(b, h) (((b) * 2 + (h)) * HTB)
#define PG8_SB(b, h) ((4 + (b) * 2 + (h)) * HTB)
#define PG8_STAGE(bufoff, gbase, voff) do { _Pragma("unroll") for (int _i = 0; _i < 2; ++_i) \
        __builtin_amdgcn_global_load_lds((const unsigned*)((const char*)(gbase) + (voff)[_i]), (PG8_LAS unsigned*)(lds + (bufoff) + ldsw + _i * 8192), 16, 0, 0); } while (0)
#define PG8_LDA(dst, b, h) do { _Pragma("unroll") for (int m = 0; m < 4; ++m) _Pragma("unroll") for (int k = 0; k < 2; ++k) dst[m][k] = *(const PG8_LAS bf16x8*)(lds + PG8_SA(b, h) + aoff + m * 2048 + k * 1024); } while (0)
#define PG8_LDB(dst, b, h) do { _Pragma("unroll") for (int n = 0; n < 2; ++n) _Pragma("unroll") for (int k = 0; k < 2; ++k) dst[n][k] = *(const PG8_LAS bf16x8*)(lds + PG8_SB(b, h) + boff + n * 2048 + k * 1024); } while (0)
#define PG8_MMA(ai, bj, At, Bt) do { __builtin_amdgcn_s_setprio(1); _Pragma("unroll") for (int m = 0; m < 4; ++m) _Pragma("unroll") for (int n = 0; n < 2; ++n) _Pragma("unroll") for (int k = 0; k < 2; ++k) \
        acc[ai][bj][m][n] = __builtin_amdgcn_mfma_f32_16x16x32_bf16(Bt[n][k], At[m][k], acc[ai][bj][m][n], 0, 0, 0); __builtin_amdgcn_s_setprio(0); } while (0)
#define PG8_WAIT_V(n) asm volatile("s_waitcnt vmcnt(" #n ")" ::: "memory")
#define PG8_WAIT_L(n) asm volatile("s_waitcnt lgkmcnt(" #n ")" ::: "memory")
#define PG8_BAR __builtin_amdgcn_s_barrier()
#define PG8_SCHED __builtin_amdgcn_sched_barrier(0)
    Unit cur, nxt; int ui = 0;
    if (!S.next(0, cur)) return;
    f32x4 acc[2][2][4][2];
#pragma unroll
    for (int a = 0; a < 2; ++a)
#pragma unroll
        for (int b = 0; b < 2; ++b)
#pragma unroll
            for (int m = 0; m < 4; ++m)
#pragma unroll
                for (int n = 0; n < 2; ++n) acc[a][b][m][n] = (f32x4){0.f, 0.f, 0.f, 0.f};
    bf16x8 At[4][2], B0[2][2], B1[2][2];
    const char* cA = (const char*)g.A + (size_t)cur.pm * tstepA + (size_t)cur.pn * pnA; const char* cB = (const char*)g.Bt + (size_t)cur.pn * tstepB;
    S.a_ready(cur);
    if constexpr (SP2) {
        PG8_STAGE(PG8_SB(0, 0), cB, voffB); PG8_STAGE(PG8_SB(0, 1), cB + hstepB, voffB); PG8_STAGE(PG8_SA(0, 0), cA, voffA); PG8_STAGE(PG8_SA(0, 1), cA + hstepA, voffA);
        if (wr == 1) PG8_BAR;
        PG8_WAIT_V(2); PG8_BAR;
        PG8_STAGE(PG8_SB(1, 0), cB + kstep, voffB); PG8_STAGE(PG8_SA(1, 0), cA + kstep, voffA); PG8_STAGE(PG8_SB(1, 1), cB + hstepB + kstep, voffB);
        PG8_WAIT_V(6); PG8_BAR;
    } else {
        PG8_STAGE(PG8_SB(0, 0), cB, voffB); PG8_STAGE(PG8_SA(0, 0), cA, voffA); PG8_STAGE(PG8_SB(0, 1), cB + hstepB, voffB); PG8_STAGE(PG8_SA(0, 1), cA + hstepA, voffA);
        if (wr == 1) PG8_BAR;
        PG8_WAIT_V(4); PG8_BAR;
        PG8_STAGE(PG8_SB(1, 0), cB + kstep, voffB); PG8_STAGE(PG8_SA(1, 0), cA + kstep, voffA); PG8_STAGE(PG8_SB(1, 1), cB + hstepB + kstep, voffB);
        PG8_WAIT_V(6); PG8_BAR;
    }
    for (;;) {
        const bool has_next = S.next(ui + 1, nxt);
        const char* nA = has_next ? (const char*)g.A + (size_t)nxt.pm * tstepA + (size_t)nxt.pn * pnA : cA; const char* nB = has_next ? (const char*)g.Bt + (size_t)nxt.pn * tstepB : cB;
        for (int t = 0; t < nt; t += 2) {
            const bool last = (t == nt - 2);
            const char* a1 = cA + (size_t)(t + 1) * kstep;
            const char* a2 = last ? nA : cA + (size_t)(t + 2) * kstep; const char* b2 = last ? nB : cB + (size_t)(t + 2) * kstep;
            const char* a3 = a2 + kstep; const char* b3 = b2 + kstep;
            if (last && has_next) S.a_ready(nxt);
            if constexpr (SP2) {
            PG8_LDB(B0, 0, 0); PG8_LDB(B1, 0, 1); PG8_SCHED; PG8_LDA(At, 0, 0); PG8_STAGE(PG8_SA(1, 1), a1 + hstepA, voffA);
            PG8_WAIT_V(8); PG8_WAIT_L(0); PG8_BAR; PG8_MMA(0, 0, At, B0); PG8_MMA(0, 1, At, B1); PG8_BAR; PG8_SCHED;
            PG8_LDA(At, 0, 1); PG8_STAGE(PG8_SB(0, 0), b2, voffB); PG8_STAGE(PG8_SB(0, 1), b2 + hstepB, voffB); PG8_STAGE(PG8_SA(0, 0), a2, voffA);
            PG8_WAIT_V(8); PG8_WAIT_L(0); PG8_BAR; PG8_MMA(1, 0, At, B0); PG8_MMA(1, 1, At, B1); PG8_BAR; PG8_SCHED;
            PG8_LDB(B0, 1, 0); PG8_LDB(B1, 1, 1); PG8_SCHED; PG8_LDA(At, 1, 0); PG8_STAGE(PG8_SA(0, 1), a2 + hstepA, voffA);
            PG8_WAIT_V(8); PG8_WAIT_L(0); PG8_BAR; PG8_MMA(0, 0, At, B0); PG8_MMA(0, 1, At, B1); PG8_BAR; PG8_SCHED;
            PG8_LDA(At, 1, 1); PG8_STAGE(PG8_SB(1, 0), b3, voffB); PG8_STAGE(PG8_SB(1, 1), b3 + hstepB, voffB); PG8_STAGE(PG8_SA(1, 0), a3, voffA);
            PG8_WAIT_V(8); PG8_WAIT_L(0); PG8_BAR; PG8_MMA(1, 0, At, B0); PG8_MMA(1, 1, At, B1); PG8_BAR; PG8_SCHED;
            } else {
            PG8_LDB(B0, 0, 0); PG8_SCHED; PG8_LDA(At, 0, 0); PG8_STAGE(PG8_SA(1, 1), a1 + hstepA, voffA);
            PG8_WAIT_L(8); PG8_BAR; PG8_WAIT_L(0); PG8_MMA(0, 0, At, B0); PG8_BAR; PG8_SCHED;
            PG8_LDB(B1, 0, 1); PG8_STAGE(PG8_SB(0, 0), b2, voffB);
            PG8_BAR; PG8_WAIT_L(0); PG8_MMA(0, 1, At, B1); PG8_BAR;
            PG8_LDA(At, 0, 1); PG8_STAGE(PG8_SA(0, 0), a2, voffA);
            PG8_BAR; PG8_WAIT_L(0); PG8_MMA(1, 0, At, B0); PG8_BAR; PG8_SCHED;
            PG8_STAGE(PG8_SB(0, 1), b2 + hstepB, voffB);
            PG8_WAIT_V(6); PG8_BAR; PG8_MMA(1, 1, At, B1); PG8_BAR;
            PG8_LDB(B0, 1, 0); PG8_SCHED; PG8_LDA(At, 1, 0); PG8_STAGE(PG8_SA(0, 1), a2 + hstepA, voffA);
            PG8_WAIT_L(8); PG8_BAR; PG8_WAIT_L(0); PG8_MMA(0, 0, At, B0); PG8_BAR; PG8_SCHED;
            PG8_LDB(B1, 1, 1); PG8_STAGE(PG8_SB(1, 0), b3, voffB);
            PG8_BAR; PG8_WAIT_L(0); PG8_MMA(0, 1, At, B1); PG8_BAR;
            PG8_LDA(At, 1, 1); PG8_STAGE(PG8_SA(1, 0), a3, voffA);
            PG8_BAR; PG8_WAIT_L(0); PG8_MMA(1, 0, At, B0); PG8_BAR; PG8_SCHED;
            PG8_STAGE(PG8_SB(1, 1), b3 + hstepB, voffB);
            PG8_WAIT_V(6); PG8_BAR; PG8_MMA(1, 1, At, B1); PG8_BAR;
            }
        }
        if constexpr (ALIGN_EPI) { if (wr == 0) PG8_BAR; }
        E(acc, cur, wr, wc, fr, fq); S.done(cur);
        if (!has_next) break;
#pragma unroll
        for (int a = 0; a < 2; ++a)
#pragma unroll
            for (int b = 0; b < 2; ++b)
#pragma unroll
                for (int m = 0; m < 4; ++m)
#pragma unroll
                    for (int n = 0; n < 2; ++n) acc[a][b][m][n] = (f32x4){0.f, 0.f, 0.f, 0.f};
        cur = nxt; cA = nA; cB = nB; ++ui;
        if constexpr (ALIGN_EPI) { if (wr == 1) PG8_BAR; }
    }
    PG8_WAIT_V(0);
    if constexpr (!ALIGN_EPI) { if (wr == 0) PG8_BAR; }
    PG8_BAR;
#undef PG8_SA
#undef PG8_SB
#undef PG8_STAGE
#undef PG8_LDA
#undef PG8_LDB
#undef PG8_MMA
#undef PG8_WAIT_V
#undef PG8_WAIT_L
#undef PG8_BAR
#undef PG8_SCHED
}
}

constexpr int NWAVES = 8, NTHR = NWAVES * 64;
constexpr int D = 1024, NBATCH = 4, T = 8192, M = NBATCH * T;
constexpr int A_W = 512, A_IN = 1792, IN_COLS = 3344, NP = 3584;
constexpr int C_R = 0, C_K = 512, C_V = 1024, C_WD = 1536, C_AD = 1600, C_GD = 1664;
constexpr int C_BQ = 1792, C_BK = 2048, C_BV = 2304, C_GKD = 2816, C_BG = 2832;
constexpr int NQ = 2048;
constexpr float LN_EPS = 1e-5f, GN_EPS = 64e-5f, RMS_EPS = 1e-5f;
constexpr float ALPHA = 1.189207115002721f;

typedef unsigned short bf16;
typedef float f32x4 __attribute__((ext_vector_type(4)));
typedef float f32x2 __attribute__((ext_vector_type(2)));
typedef unsigned u32x4 __attribute__((ext_vector_type(4)));
typedef unsigned u32x2 __attribute__((ext_vector_type(2)));
#define LAS __attribute__((address_space(3)))

constexpr size_t MiB = 1u << 20;
constexpr size_t WS_WIN = 1 * MiB, WS_WOUT = 8 * MiB, WS_WQ = 10 * MiB, WS_KBD = 14 * MiB;
constexpr size_t WS_W2T = 15 * MiB, WS_A2T = WS_W2T + 65536, WS_G2T = WS_A2T + 65536;
constexpr size_t WS_H0 = 16 * MiB;
constexpr size_t WS_P = 80 * MiB;
constexpr size_t WS_WL = 304 * MiB, WS_AA = 336 * MiB, WS_GG = 368 * MiB;
constexpr size_t WS_GK = 400 * MiB;
constexpr size_t WS_MIX = 416 * MiB;
constexpr size_t WS_Z = 80 * MiB;
constexpr size_t WS_H1 = 208 * MiB;
constexpr size_t WS_Q = 272 * MiB;
constexpr size_t WS_S = 80 * MiB;
constexpr size_t WS_IDS = 400 * MiB, WS_GATES = 416 * MiB;
constexpr size_t WS_UT = 432 * MiB, WS_VT = 448 * MiB;
constexpr size_t WS_SU = 464 * MiB, WS_SV = 465 * MiB;
constexpr int NSEG = 16, LSEG = 8192 / NSEG;
constexpr size_t WS_YI = WS_WL;
constexpr size_t WS_YIG = WS_GK;
constexpr size_t WS_SER = 480 * MiB;
constexpr size_t WS_SEG = 496 * MiB;
constexpr size_t WS_CEND = 504 * MiB;
constexpr size_t WS_END = 505 * MiB;

constexpr int LDS_BYTES = 147456, LDS_MISC = LDS_BYTES - 256;
constexpr size_t WS_CTL = 0, CTL_BYTES = 16384;

struct Params {
    const float* in[28];
    float* out; unsigned char* ws;
    int ph_lo, ph_hi;
};

__device__ __forceinline__ float bf2f(unsigned u) { return __uint_as_float(u << 16); }
__device__ __forceinline__ unsigned f2bf(float f) { unsigned u = __float_as_uint(f); return (u + 0x7fffu + ((u >> 16) & 1u)) >> 16; }
__device__ __forceinline__ unsigned pk2(float lo, float hi) { return f2bf(lo) | (f2bf(hi) << 16); }
#define DPP_F(v, ctrl) __builtin_bit_cast(float, __builtin_amdgcn_update_dpp(0, __builtin_bit_cast(int, (v)), (ctrl), 0xf, 0xf, false))
#define DPP_ADD(v, ctrl) ((v) + DPP_F(v, ctrl))
__device__ __forceinline__ float rlf(float v, int l) { return __builtin_bit_cast(float, __builtin_amdgcn_readlane(__builtin_bit_cast(int, v), l)); }
__device__ __forceinline__ float wave_sum_u(float v) {
    v = DPP_ADD(v, 0xB1); v = DPP_ADD(v, 0x4E); v = DPP_ADD(v, 0x141); v = DPP_ADD(v, 0x140);
    return (rlf(v, 0) + rlf(v, 16)) + (rlf(v, 32) + rlf(v, 48));
}
__device__ __forceinline__ float wave_sum(float v) { return wave_sum_u(v); }
#define DPP_I(v, ctrl) __builtin_amdgcn_update_dpp(0, (v), (ctrl), 0xf, 0xf, false)
__device__ __forceinline__ int wave_sum_i(int v) {
    v += DPP_I(v, 0xB1); v += DPP_I(v, 0x4E); v += DPP_I(v, 0x141); v += DPP_I(v, 0x140);
    return (__builtin_amdgcn_readlane(v, 0) + __builtin_amdgcn_readlane(v, 16)) + (__builtin_amdgcn_readlane(v, 32) + __builtin_amdgcn_readlane(v, 48));
}
__device__ __forceinline__ float wave_max_u(float v) {
    v = fmaxf(v, DPP_F(v, 0xB1)); v = fmaxf(v, DPP_F(v, 0x4E)); v = fmaxf(v, DPP_F(v, 0x141)); v = fmaxf(v, DPP_F(v, 0x140));
    return fmaxf(fmaxf(rlf(v, 0), rlf(v, 16)), fmaxf(rlf(v, 32), rlf(v, 48)));
}
__device__ __forceinline__ unsigned pack_i8(float a, float b, float c, float d, float inv, int off) {
    const int q0 = __float2int_rn(a * inv) + off, q1 = __float2int_rn(b * inv) + off, q2 = __float2int_rn(c * inv) + off, q3 = __float2int_rn(d * inv) + off;
    return (unsigned)(q0 & 0xff) | ((unsigned)(q1 & 0xff) << 8) | ((unsigned)(q2 & 0xff) << 16) | ((unsigned)(q3 & 0xff) << 24);
}
__device__ __forceinline__ float sigmoidf_(float x) { return 1.f / (1.f + __expf(-x)); }
__device__ __forceinline__ float softplusf_(float x) { return fmaxf(x, 0.f) + log1pf(__expf(-fabsf(x))); }
__device__ __forceinline__ float siluf_(float x) { return x * sigmoidf_(x); }

__device__ __forceinline__ void transpose_convert(const float* W, int K, int N, int Npad, bf16* WT, int gtid, int gthreads) {
    const int kc = K / 8, total = Npad * kc;
    for (int idx = gtid; idx < total; idx += gthreads) {
        const int n = idx % Npad, c = idx / Npad; float v[8];
#pragma unroll
        for (int j = 0; j < 8; ++j) v[j] = (n < N) ? W[(size_t)(8 * c + j) * N + n] : 0.f;
        u32x4 o; o.x = pk2(v[0], v[1]); o.y = pk2(v[2], v[3]); o.z = pk2(v[4], v[5]); o.w = pk2(v[6], v[7]);
        *(u32x4*)(WT + (size_t)n * K + 8 * c) = o;
    }
}
__device__ __forceinline__ void ln_row_bf16(const float* xrow, const float* g, const float* b, bf16* orow, int lane) {
    const f32x4* xr = (const f32x4*)xrow + lane; f32x4 v[4]; float s = 0.f;
#pragma unroll
    for (int j = 0; j < 4; ++j) { v[j] = xr[64 * j]; s += (v[j][0] + v[j][1]) + (v[j][2] + v[j][3]); }
    const float mean = wave_sum(s) * (1.f / D); float s2 = 0.f;
#pragma unroll
    for (int j = 0; j < 4; ++j) { v[j] = v[j] - mean; s2 += (v[j][0] * v[j][0] + v[j][1] * v[j][1]) + (v[j][2] * v[j][2] + v[j][3] * v[j][3]); }
    const float rstd = 1.f / sqrtf(wave_sum(s2) * (1.f / D) + LN_EPS);
    u32x2* o8 = (u32x2*)orow + lane;
#pragma unroll
    for (int j = 0; j < 4; ++j) { const f32x4 gg = ((const f32x4*)g)[lane + 64 * j], bb = ((const f32x4*)b)[lane + 64 * j]; const f32x4 y = v[j] * rstd * gg + bb;
        u32x2 w; w.x = pk2(y[0], y[1]); w.y = pk2(y[2], y[3]); o8[64 * j] = w; }
}
__device__ __forceinline__ void phase_prologue(const Params& P) {
    const int tid = threadIdx.x, lane = tid & 63, wave = tid >> 6;
    const int gtid = blockIdx.x * NTHR + tid, gthreads = gridDim.x * NTHR;
    unsigned char* ws = P.ws;
    transpose_convert(P.in[3], D, IN_COLS, NP, (bf16*)(ws + WS_WIN), gtid, gthreads);
    transpose_convert(P.in[19], D, D, D, (bf16*)(ws + WS_WOUT), gtid, gthreads);
    transpose_convert(P.in[22], D, NQ, NQ, (bf16*)(ws + WS_WQ), gtid, gthreads);
    transpose_convert(P.in[6], 64, A_W, A_W, (bf16*)(ws + WS_W2T), gtid, gthreads);
    transpose_convert(P.in[8], 64, A_W, A_W, (bf16*)(ws + WS_A2T), gtid, gthreads);
    transpose_convert(P.in[9], 128, A_W, A_W, (bf16*)(ws + WS_G2T), gtid, gthreads);
    {
        const float* keys = P.in[23]; bf16* kbd = (bf16*)(ws + WS_KBD);
        for (int idx = gtid; idx < 8 * 256 * 32; idx += gthreads) {
            const int kc = idx & 31, n = (idx >> 5) & 255, h = idx >> 13; const int k0 = kc * 8, hn = n >> 7, key = n & 127, hk = k0 >> 7, c0 = k0 & 127;
            u32x4 o = (u32x4){0u, 0u, 0u, 0u};
            if (hn == hk) { const float* s = keys + ((size_t)((h * 2 + hn) * 128 + key)) * 128 + c0; o.x = pk2(s[0], s[1]); o.y = pk2(s[2], s[3]); o.z = pk2(s[4], s[5]); o.w = pk2(s[6], s[7]); }
            *(u32x4*)(kbd + ((size_t)(h * 256 + n)) * 256 + k0) = o;
        }
    }
    const int gw = blockIdx.x * NWAVES + wave, ngw = gridDim.x * NWAVES;
    for (int m = gw; m < M; m += ngw) ln_row_bf16(P.in[0] + (size_t)m * D, P.in[1], P.in[2], (bf16*)(ws + WS_H0) + (size_t)m * D, lane);
}

typedef short bf16x8_t __attribute__((ext_vector_type(8)));
template <int KS, int LDA>
__device__ __forceinline__ void lora_mm(f32x4 (&acc)[4][4], const LAS bf16* ACT, const bf16* WT, int c0, int fr, int fq) {
#pragma unroll
    for (int mt = 0; mt < 4; ++mt)
#pragma unroll
        for (int nt = 0; nt < 4; ++nt) acc[mt][nt] = (f32x4){0.f, 0.f, 0.f, 0.f};
#pragma unroll
    for (int s = 0; s < KS; ++s) {
        bf16x8_t af[4], bfr[4];
#pragma unroll
        for (int mt = 0; mt < 4; ++mt) af[mt] = *(const LAS bf16x8_t*)(ACT + (mt * 16 + fr) * LDA + 32 * s + 8 * fq);
#pragma unroll
        for (int nt = 0; nt < 4; ++nt) bfr[nt] = *(const bf16x8_t*)(WT + (size_t)(c0 + nt * 16 + fr) * (32 * KS) + 32 * s + 8 * fq);
#pragma unroll
        for (int mt = 0; mt < 4; ++mt)
#pragma unroll
            for (int nt = 0; nt < 4; ++nt) acc[mt][nt] = __builtin_amdgcn_mfma_f32_16x16x32_bf16(bfr[nt], af[mt], acc[mt][nt], 0, 0, 0);
    }
}
__device__ __forceinline__ void phase_prep(const Params& P, LAS unsigned char* lds) {
    const int tid = threadIdx.x, lane = tid & 63, wave = __builtin_amdgcn_readfirstlane(tid >> 6), fr = lane & 15, fq = lane >> 4;
    unsigned char* ws = P.ws;
    const bf16* p = (const bf16*)(ws + WS_P);
    const float* mu = P.in[4]; const float* w0 = P.in[5]; const float* a0 = P.in[7];
    const float* gkw2 = P.in[16]; const float* gkb = P.in[17];
    const bf16* W2T = (const bf16*)(ws + WS_W2T); const bf16* A2T = (const bf16*)(ws + WS_A2T); const bf16* G2T = (const bf16*)(ws + WS_G2T);
    bf16* WL = (bf16*)(ws + WS_WL); bf16* AA = (bf16*)(ws + WS_AA); bf16* GG = (bf16*)(ws + WS_GG); bf16* GK = (bf16*)(ws + WS_GK);
    LAS bf16* TW = (LAS bf16*)lds; LAS bf16* AD = TW + 64 * 72; LAS bf16* SG = AD + 64 * 72;
    LAS float* gkd = (LAS float*)(SG + 64 * 136);
    const int c0 = wave * 64;
    for (int tile = blockIdx.x; tile < M / 64; tile += gridDim.x) {
        const int m0 = tile * 64;
        __syncthreads();
        for (int idx = tid; idx < 64 * 256; idx += NTHR) {
            const int j = idx & 255, tok = idx >> 8, m = m0 + tok, t = m & (T - 1);
            const float cur = bf2f(p[(size_t)m * NP + C_WD + j]);
            const float prev = (t > 0) ? bf2f(p[(size_t)(m - 1) * NP + C_WD + j]) : 0.f;
            const float x = cur + (prev - cur) * mu[C_WD + j];
            if (j < 64) TW[tok * 72 + j] = (bf16)f2bf(tanhf(x)); else if (j < 128) AD[tok * 72 + j - 64] = (bf16)f2bf(x); else SG[tok * 136 + j - 128] = (bf16)f2bf(sigmoidf_(x));
        }
        for (int idx = tid; idx < 64 * 16; idx += NTHR) { const int j = idx & 15, tok = idx >> 4; gkd[tok * 16 + j] = bf2f(p[(size_t)(m0 + tok) * NP + C_GKD + j]); }
        __syncthreads();
        f32x4 acc[4][4];
        lora_mm<2, 72>(acc, TW, W2T, c0, fr, fq);
#pragma unroll
        for (int nt = 0; nt < 4; ++nt) { const int c = c0 + nt * 16 + 4 * fq; const f32x4 b = *(const f32x4*)(w0 + c);
#pragma unroll
            for (int mt = 0; mt < 4; ++mt) { float o[4];
#pragma unroll
                for (int i = 0; i < 4; ++i) { const float z = b[i] + acc[mt][nt][i]; o[i] = -__expf(-softplusf_(-z) - 0.5f); }
                u32x2 w; w.x = pk2(o[0], o[1]); w.y = pk2(o[2], o[3]); *(u32x2*)(WL + (size_t)(m0 + mt * 16 + fr) * A_W + c) = w; } }
        lora_mm<2, 72>(acc, AD, A2T, c0, fr, fq);
#pragma unroll
        for (int nt = 0; nt < 4; ++nt) { const int c = c0 + nt * 16 + 4 * fq; const f32x4 b = *(const f32x4*)(a0 + c);
#pragma unroll
            for (int mt = 0; mt < 4; ++mt) { float o[4];
#pragma unroll
                for (int i = 0; i < 4; ++i) o[i] = sigmoidf_(b[i] + acc[mt][nt][i]);
                u32x2 w; w.x = pk2(o[0], o[1]); w.y = pk2(o[2], o[3]); *(u32x2*)(AA + (size_t)(m0 + mt * 16 + fr) * A_W + c) = w; } }
        lora_mm<4, 136>(acc, SG, G2T, c0, fr, fq);
#pragma unroll
        for (int nt = 0; nt < 4; ++nt) { const int c = c0 + nt * 16 + 4 * fq;
#pragma unroll
            for (int mt = 0; mt < 4; ++mt) { u32x2 w; w.x = pk2(acc[mt][nt][0], acc[mt][nt][1]); w.y = pk2(acc[mt][nt][2], acc[mt][nt][3]); *(u32x2*)(GG + (size_t)(m0 + mt * 16 + fr) * A_W + c) = w; } }
        { const int cc = tid & 255, th = tid >> 8; float wv[16];
#pragma unroll
          for (int j = 0; j < 16; ++j) wv[j] = gkw2[j * 256 + cc];
          const float bb = gkb[cc];
          for (int i = 0; i < 32; ++i) { const int tok = th * 32 + i; float sacc = bb;
#pragma unroll
              for (int j = 0; j < 16; ++j) sacc += gkd[tok * 16 + j] * wv[j];
              GK[(size_t)(m0 + tok) * 256 + cc] = (bf16)f2bf(-softplusf_(-sacc) * (1.f / 16.f)); } }
    }
}

constexpr int CH = 32;
__device__ __forceinline__ float red8(float v) { v = DPP_ADD(v, 0xB1); v = DPP_ADD(v, 0x4E); v = DPP_ADD(v, 0x141); return v; }
__device__ __forceinline__ float red4(float v) { v = DPP_ADD(v, 0xB1); v = DPP_ADD(v, 0x4E); return v; }

constexpr int RW_BUF = 6 * CH * 64;
__device__ __forceinline__ void rw_load(const bf16* p, const bf16* AA, const bf16* WL, int b, int t0, int col, int wave,
        unsigned (&rc)[4], unsigned (&kc)[4], unsigned (&vc)[4], unsigned (&rp)[4], unsigned (&kp)[4], unsigned (&vp)[4], unsigned (&a)[4], unsigned (&wl)[4]) {
#pragma unroll
    for (int q = 0; q < 4; ++q) {
        const int t = t0 + wave + 8 * q; const size_t m = (size_t)b * T + t; const bf16* pr = p + m * NP; const bf16* pp = (t > 0) ? pr - NP : pr;
        rc[q] = pr[C_R + col]; kc[q] = pr[C_K + col]; vc[q] = pr[C_V + col]; rp[q] = pp[C_R + col]; kp[q] = pp[C_K + col]; vp[q] = pp[C_V + col];
        a[q] = AA[m * A_W + col]; wl[q] = WL[m * A_W + col];
    }
}
__device__ __forceinline__ void rw_prep(LAS float* B, int t0, int wave, int lane, float mu_r, float mu_k, float mu_v, float kkc, float kac,
        const unsigned (&rc_)[4], const unsigned (&kc_)[4], const unsigned (&vc_)[4], const unsigned (&rp_)[4], const unsigned (&kp_)[4], const unsigned (&vp_)[4], const unsigned (&a_)[4], const unsigned (&wl_)[4]) {
    LAS float* R = B; LAS float* DEC = R + CH * 64; LAS float* KH = DEC + CH * 64; LAS float* KK = KH + CH * 64; LAS float* BB = KK + CH * 64; LAS float* V = BB + CH * 64;
#pragma unroll
    for (int q = 0; q < 4; ++q) {
        const int tt = wave + 8 * q; const float hp = (t0 + tt > 0) ? 1.f : 0.f;
        const float rc = bf2f(rc_[q]), kc = bf2f(kc_[q]), vc = bf2f(vc_[q]), rp = bf2f(rp_[q]) * hp, kp = bf2f(kp_[q]) * hp, vp = bf2f(vp_[q]) * hp;
        const float r = rc + (rp - rc) * mu_r, k = kc + (kp - kc) * mu_k, v = vc + (vp - vc) * mu_v;
        const float a = bf2f(a_[q]), wl = bf2f(wl_[q]);
        const float kr = k * kkc; const float nrm = sqrtf(wave_sum(kr * kr)); const float kk = kr / fmaxf(nrm, 1e-12f);
        const float kh = k * (1.f + (a - 1.f) * kac);
        R[tt * 64 + lane] = r; DEC[tt * 64 + lane] = __expf(wl); KH[tt * 64 + lane] = kh; KK[tt * 64 + lane] = kk; BB[tt * 64 + lane] = kk * a; V[tt * 64 + lane] = v;
    }
}
struct RwOps { f32x4 k0, k1, d0, d1, b0, b1, h0, h1, q0, q1; float v0, v1; };
__device__ __forceinline__ void rw_ops_load(RwOps& o, const LAS float* B, int tt, int s8, int vr0) {
    const LAS float* R = B; const LAS float* DEC = R + CH * 64; const LAS float* KH = DEC + CH * 64; const LAS float* KK = KH + CH * 64; const LAS float* BB = KK + CH * 64; const LAS float* V = BB + CH * 64;
    o.k0 = *(const LAS f32x4*)(KK + tt * 64 + s8); o.k1 = *(const LAS f32x4*)(KK + tt * 64 + s8 + 4);
    o.d0 = *(const LAS f32x4*)(DEC + tt * 64 + s8); o.d1 = *(const LAS f32x4*)(DEC + tt * 64 + s8 + 4);
    o.b0 = *(const LAS f32x4*)(BB + tt * 64 + s8); o.b1 = *(const LAS f32x4*)(BB + tt * 64 + s8 + 4);
    o.h0 = *(const LAS f32x4*)(KH + tt * 64 + s8); o.h1 = *(const LAS f32x4*)(KH + tt * 64 + s8 + 4);
    o.q0 = *(const LAS f32x4*)(R + tt * 64 + s8); o.q1 = *(const LAS f32x4*)(R + tt * 64 + s8 + 4);
    o.v0 = V[tt * 64 + vr0]; o.v1 = V[tt * 64 + vr0 + 1];
}
__device__ __forceinline__ void rw_step(const RwOps& o, f32x2 (&S0)[4], f32x2 (&S1)[4], float vmask, LAS float* Y, int tt, int r0, int lane) {
    const float vv0 = o.v0 * vmask, vv1 = o.v1 * vmask;
    const f32x2 kk[4] = {o.k0.lo, o.k0.hi, o.k1.lo, o.k1.hi}, dd[4] = {o.d0.lo, o.d0.hi, o.d1.lo, o.d1.hi}, bb[4] = {o.b0.lo, o.b0.hi, o.b1.lo, o.b1.hi}, hh[4] = {o.h0.lo, o.h0.hi, o.h1.lo, o.h1.hi}, rr[4] = {o.q0.lo, o.q0.hi, o.q1.lo, o.q1.hi};
    f32x2 a0 = S0[0] * kk[0], a1 = S1[0] * kk[0];
#pragma unroll
    for (int i = 1; i < 4; ++i) { a0 = S0[i] * kk[i] + a0; a1 = S1[i] * kk[i] + a1; }
    const float sa0 = -red8(a0.x + a0.y), sa1 = -red8(a1.x + a1.y);
    f32x2 y0 = (f32x2){0.f, 0.f}, y1 = (f32x2){0.f, 0.f};
#pragma unroll
    for (int i = 0; i < 4; ++i) {
        S0[i] = hh[i] * vv0 + (bb[i] * sa0 + S0[i] * dd[i]); S1[i] = hh[i] * vv1 + (bb[i] * sa1 + S1[i] * dd[i]);
        y0 = S0[i] * rr[i] + y0; y1 = S1[i] * rr[i] + y1;
    }
    const float yy0 = red8(y0.x + y0.y), yy1 = red8(y1.x + y1.y);
    if ((lane & 7) == 0) { Y[tt * 128 + r0] = yy0; Y[tt * 128 + r0 + 1] = yy1; }
}
struct GlOps { f32x4 k0, k1, d0, d1, q0, q1; float v0, v1; };
__device__ __forceinline__ void gl_ops_load(GlOps& o, const LAS float* B, int tt, int s8, int r0) {
    const LAS float* Q = B; const LAS float* K = Q + CH * 64; const LAS float* DEC = K + CH * 64; const LAS float* V = DEC + CH * 64;
    o.k0 = *(const LAS f32x4*)(K + tt * 64 + s8); o.k1 = *(const LAS f32x4*)(K + tt * 64 + s8 + 4);
    o.d0 = *(const LAS f32x4*)(DEC + tt * 64 + s8); o.d1 = *(const LAS f32x4*)(DEC + tt * 64 + s8 + 4);
    o.q0 = *(const LAS f32x4*)(Q + tt * 64 + s8); o.q1 = *(const LAS f32x4*)(Q + tt * 64 + s8 + 4);
    o.v0 = V[tt * 128 + r0]; o.v1 = V[tt * 128 + r0 + 1];
}
__device__ __forceinline__ void gl_step(const GlOps& o, f32x2 (&S0)[4], f32x2 (&S1)[4], f32x2 (&c)[4], LAS float* O, LAS float* YL, int tt, int r0, int s8, int lane, int wave) {
    const f32x2 kk[4] = {o.k0.lo, o.k0.hi, o.k1.lo, o.k1.hi}, dd[4] = {o.d0.lo, o.d0.hi, o.d1.lo, o.d1.hi}, qq[4] = {o.q0.lo, o.q0.hi, o.q1.lo, o.q1.hi};
    f32x2 y0 = (f32x2){0.f, 0.f}, y1 = (f32x2){0.f, 0.f};
#pragma unroll
    for (int i = 0; i < 4; ++i) {
        S0[i] = kk[i] * o.v0 + S0[i] * dd[i]; S1[i] = kk[i] * o.v1 + S1[i] * dd[i];
        y0 = S0[i] * qq[i] + y0; y1 = S1[i] * qq[i] + y1;
    }
    if (wave == 0) {
#pragma unroll
        for (int i = 0; i < 4; ++i) c[i] = c[i] * dd[i];
        if (lane < 8) { const f32x2 e0 = c[0] * qq[0], e1 = c[1] * qq[1], e2 = c[2] * qq[2], e3 = c[3] * qq[3];
            *(LAS f32x4*)(YL + tt * 64 + s8) = (f32x4){e0.x, e0.y, e1.x, e1.y}; *(LAS f32x4*)(YL + tt * 64 + s8 + 4) = (f32x4){e2.x, e2.y, e3.x, e3.y}; }
    }
    const float o0 = red8(y0.x + y0.y), o1 = red8(y1.x + y1.y);
    if ((lane & 7) == 0) { O[tt * 128 + r0] = o0; O[tt * 128 + r0 + 1] = o1; }
}
__device__ __forceinline__ void rwkv_item(const Params& P, LAS unsigned char* lds, int b, int h, int seg) {
    const int tid = threadIdx.x, lane = tid & 63, wave = tid >> 6;
    unsigned char* ws = P.ws;
    const bf16* p = (const bf16*)(ws + WS_P); const bf16* WL = (const bf16*)(ws + WS_WL); const bf16* AA = (const bf16*)(ws + WS_AA);
    bf16* MIX = (bf16*)(ws + WS_MIX); bf16* YI = (bf16*)(ws + WS_YI);
    const float* mu = P.in[4]; const float* k_k = P.in[10]; const float* k_a = P.in[11];
    LAS float* BUF = (LAS float*)lds; LAS float* Y = BUF + 2 * RW_BUF;
    const int col = h * 64 + lane;
    const float mu_r = mu[C_R + col], mu_k = mu[C_K + col], mu_v = mu[C_V + col], kkc = k_k[col], kac = k_a[col];
    const int r0 = wave * 16 + 2 * (lane >> 3), s8 = (lane & 7) * 8; const int ident = r0 >> 6, vr0 = r0 & 63, vr1 = vr0 + 1;
    float* SE = (float*)(ws + WS_SER) + ((((size_t)(b * 8 + h) * NSEG + seg) * 2 + ident) * 4096) + vr0 * 64 + s8;
    f32x2 S0[4], S1[4];
#pragma unroll
    for (int i = 0; i < 4; ++i) { S0[i] = (f32x2){(ident && (s8 + 2 * i == vr0)) ? 1.f : 0.f, (ident && (s8 + 2 * i + 1 == vr0)) ? 1.f : 0.f};
        S1[i] = (f32x2){(ident && (s8 + 2 * i == vr1)) ? 1.f : 0.f, (ident && (s8 + 2 * i + 1 == vr1)) ? 1.f : 0.f}; }
    const float vmask = ident ? 0.f : 1.f;
    const int tbeg = seg * LSEG;
    unsigned rc[4], kc[4], vc[4], rp[4], kp[4], vp[4], a[4], wl[4];
    __syncthreads();
    rw_load(p, AA, WL, b, tbeg, col, wave, rc, kc, vc, rp, kp, vp, a, wl);
    rw_prep(BUF, tbeg, wave, lane, mu_r, mu_k, mu_v, kkc, kac, rc, kc, vc, rp, kp, vp, a, wl);
    __syncthreads();
    for (int ci = 0; ci < LSEG / CH; ++ci) {
        const int t0 = tbeg + ci * CH; LAS float* B = BUF + (ci & 1) * RW_BUF;
        LAS float* R = B; LAS float* DEC = R + CH * 64; LAS float* KH = DEC + CH * 64; LAS float* KK = KH + CH * 64; LAS float* BB = KK + CH * 64; LAS float* V = BB + CH * 64;
        const bool more = (ci + 1 < LSEG / CH);
        if (more) rw_load(p, AA, WL, b, t0 + CH, col, wave, rc, kc, vc, rp, kp, vp, a, wl);
        { RwOps oa, ob; rw_ops_load(oa, B, 0, s8, vr0);
          for (int tt = 0; tt < CH; tt += 2) {
              rw_ops_load(ob, B, tt + 1, s8, vr0); rw_step(oa, S0, S1, vmask, Y, tt, r0, lane);
              rw_ops_load(oa, B, (tt + 2) & (CH - 1), s8, vr0); rw_step(ob, S0, S1, vmask, Y, tt + 1, r0, lane);
          } }
        __syncthreads();
        if (more) rw_prep(BUF + ((ci + 1) & 1) * RW_BUF, t0 + CH, wave, lane, mu_r, mu_k, mu_v, kkc, kac, rc, kc, vc, rp, kp, vp, a, wl);
#pragma unroll
        for (int q = 0; q < 4; ++q) {
            const int tt = wave + 8 * q; const size_t m = (size_t)b * T + t0 + tt;
            MIX[m * D + col] = (bf16)f2bf(Y[tt * 128 + lane]); YI[m * 512 + col] = (bf16)f2bf(Y[tt * 128 + 64 + lane]);
        }
        __syncthreads();
    }
    *(f32x4*)(SE) = (f32x4){S0[0].x, S0[0].y, S0[1].x, S0[1].y}; *(f32x4*)(SE + 4) = (f32x4){S0[2].x, S0[2].y, S0[3].x, S0[3].y};
    *(f32x4*)(SE + 64) = (f32x4){S1[0].x, S1[0].y, S1[1].x, S1[1].y}; *(f32x4*)(SE + 68) = (f32x4){S1[2].x, S1[2].y, S1[3].x, S1[3].y};
}

constexpr int GL_BUF = 3 * CH * 64 + CH * 128;
__device__ __forceinline__ void gl_load(const bf16* p, const bf16* GK, int b, int h, int t0, int lane, int wave, unsigned (&x)[4][4][4], unsigned (&gk)[4]) {
    const int cq = h * 64 + lane, ck = 256 + h * 64 + lane, cv0 = 512 + h * 128 + lane, cv1 = cv0 + 64;
#pragma unroll
    for (int q = 0; q < 4; ++q) {
        const int t = t0 + wave + 8 * q; const size_t m = (size_t)b * T + t;
#pragma unroll
        for (int j = 0; j < 4; ++j) { const int back = 3 - j; const bf16* pr = p + (m - (size_t)((t >= back) ? back : 0)) * NP + C_BQ;
            x[q][j][0] = pr[cq]; x[q][j][1] = pr[ck]; x[q][j][2] = pr[cv0]; x[q][j][3] = pr[cv1]; }
        gk[q] = GK[m * 256 + h * 64 + lane];
    }
}
__device__ __forceinline__ void gl_prep(LAS float* B, int t0, int wave, int lane, const float (&wq)[4], const float (&wk)[4], const float (&wv0)[4], const float (&wv1)[4],
        const unsigned (&x)[4][4][4], const unsigned (&gk)[4]) {
    LAS float* Q = B; LAS float* K = Q + CH * 64; LAS float* DEC = K + CH * 64; LAS float* V = DEC + CH * 64;
#pragma unroll
    for (int q = 0; q < 4; ++q) {
        const int tt = wave + 8 * q, t = t0 + tt; float aq = 0.f, ak = 0.f, av0 = 0.f, av1 = 0.f;
#pragma unroll
        for (int j = 0; j < 4; ++j) { const float ok = (t >= 3 - j) ? 1.f : 0.f;
            aq += wq[j] * ok * bf2f(x[q][j][0]); ak += wk[j] * ok * bf2f(x[q][j][1]); av0 += wv0[j] * ok * bf2f(x[q][j][2]); av1 += wv1[j] * ok * bf2f(x[q][j][3]); }
        Q[tt * 64 + lane] = siluf_(aq) * 0.125f; K[tt * 64 + lane] = siluf_(ak); V[tt * 128 + lane] = siluf_(av0); V[tt * 128 + 64 + lane] = siluf_(av1);
        DEC[tt * 64 + lane] = __expf(bf2f(gk[q]));
    }
}
__device__ __forceinline__ void gla_item(const Params& P, LAS unsigned char* lds, int b, int h, int seg) {
    const int tid = threadIdx.x, lane = tid & 63, wave = tid >> 6;
    unsigned char* ws = P.ws;
    const bf16* p = (const bf16*)(ws + WS_P); const bf16* GK = (const bf16*)(ws + WS_GK);
    bf16* MIX = (bf16*)(ws + WS_MIX); bf16* YIG = (bf16*)(ws + WS_YIG);
    float* SE = (float*)(ws + WS_SEG) + ((size_t)(b * 4 + h) * NSEG + seg) * 8192; float* CE = (float*)(ws + WS_CEND) + ((size_t)(b * 4 + h) * NSEG + seg) * 64;
    const float* conv = P.in[15];
    LAS float* BUF = (LAS float*)lds; LAS float* O = BUF + 2 * GL_BUF; LAS float* YL = O + CH * 128;
    const int cq = h * 64 + lane, ck = 256 + h * 64 + lane, cv0 = 512 + h * 128 + lane, cv1 = cv0 + 64;
    float wq[4], wk[4], wv0[4], wv1[4];
#pragma unroll
    for (int j = 0; j < 4; ++j) { wq[j] = conv[j * 1024 + cq]; wk[j] = conv[j * 1024 + ck]; wv0[j] = conv[j * 1024 + cv0]; wv1[j] = conv[j * 1024 + cv1]; }
    const int r0 = wave * 16 + 2 * (lane >> 3), s8 = (lane & 7) * 8;
    f32x2 S0[4], S1[4], c[4];
#pragma unroll
    for (int i = 0; i < 4; ++i) { S0[i] = (f32x2){0.f, 0.f}; S1[i] = (f32x2){0.f, 0.f}; c[i] = (f32x2){1.f, 1.f}; }
    const int tbeg = seg * LSEG;
    unsigned x[4][4][4], gk[4];
    __syncthreads();
    gl_load(p, GK, b, h, tbeg, lane, wave, x, gk);
    gl_prep(BUF, tbeg, wave, lane, wq, wk, wv0, wv1, x, gk);
    __syncthreads();
    for (int ci = 0; ci < LSEG / CH; ++ci) {
        const int t0 = tbeg + ci * CH; LAS float* B = BUF + (ci & 1) * GL_BUF;
        LAS float* Q = B; LAS float* K = Q + CH * 64; LAS float* DEC = K + CH * 64; LAS float* V = DEC + CH * 64;
        const bool more = (ci + 1 < LSEG / CH);
        if (more) gl_load(p, GK, b, h, t0 + CH, lane, wave, x, gk);
        { GlOps oa, ob; gl_ops_load(oa, B, 0, s8, r0);
          for (int tt = 0; tt < CH; tt += 2) {
              gl_ops_load(ob, B, tt + 1, s8, r0); gl_step(oa, S0, S1, c, O, YL, tt, r0, s8, lane, wave);
              gl_ops_load(oa, B, (tt + 2) & (CH - 1), s8, r0); gl_step(ob, S0, S1, c, O, YL, tt + 1, r0, s8, lane, wave);
          } }
        __syncthreads();
        if (more) gl_prep(BUF + ((ci + 1) & 1) * GL_BUF, t0 + CH, wave, lane, wq, wk, wv0, wv1, x, gk);
#pragma unroll
        for (int q = 0; q < 4; ++q) {
            const int tt = wave + 8 * q; const size_t m = (size_t)b * T + t0 + tt;
            MIX[m * D + 512 + h * 128 + lane] = (bf16)f2bf(O[tt * 128 + lane]); MIX[m * D + 512 + h * 128 + 64 + lane] = (bf16)f2bf(O[tt * 128 + 64 + lane]);
            YIG[m * 256 + h * 64 + lane] = (bf16)f2bf(YL[tt * 64 + lane]);
        }
        __syncthreads();
    }
    *(f32x4*)(SE + r0 * 64 + s8) = (f32x4){S0[0].x, S0[0].y, S0[1].x, S0[1].y}; *(f32x4*)(SE + r0 * 64 + s8 + 4) = (f32x4){S0[2].x, S0[2].y, S0[3].x, S0[3].y};
    *(f32x4*)(SE + (r0 + 1) * 64 + s8) = (f32x4){S1[0].x, S1[0].y, S1[1].x, S1[1].y}; *(f32x4*)(SE + (r0 + 1) * 64 + s8 + 4) = (f32x4){S1[2].x, S1[2].y, S1[3].x, S1[3].y};
    if (wave == 0 && lane < 8) { *(f32x4*)(CE + s8) = (f32x4){c[0].x, c[0].y, c[1].x, c[1].y}; *(f32x4*)(CE + s8 + 4) = (f32x4){c[2].x, c[2].y, c[3].x, c[3].y}; }
}
__device__ __forceinline__ void phase_scan(const Params& P, LAS unsigned char* lds) {
    for (int it = blockIdx.x; it < 512 + 256; it += gridDim.x) {
        if (it < 512) { const int bh = it >> 4; rwkv_item(P, lds, bh >> 3, bh & 7, it & 15); }
        else { const int g = it - 512, bh = g >> 4; gla_item(P, lds, bh >> 2, bh & 3, g & 15); }
        __syncthreads();
    }
}
__device__ __forceinline__ void phase_fixup(const Params& P, LAS unsigned char* lds) {
    const int tid = threadIdx.x;
    for (int it = blockIdx.x; it < 48; it += gridDim.x) {
        if (it < 32) {
            float* SE = (float*)(P.ws + WS_SER) + (size_t)it * NSEG * 2 * 4096;
            LAS float* Sc = (LAS float*)lds; LAS float* Ph = Sc + 64 * 65;
            const int v = tid >> 3, kq = (tid & 7) * 8;
            __syncthreads();
            for (int i = tid; i < 64 * 65; i += NTHR) Sc[i] = 0.f;
            for (int seg = 0; seg < NSEG - 1; ++seg) {
                float* s0 = SE + (size_t)(seg * 2 + 0) * 4096; const float* ph = SE + (size_t)(seg * 2 + 1) * 4096;
                __syncthreads();
                for (int i = tid; i < 1024; i += NTHR) *(LAS f32x4*)(Ph + 4 * i) = *(const f32x4*)(ph + 4 * i);
                f32x4 a0 = *(const f32x4*)(s0 + v * 64 + kq), a1 = *(const f32x4*)(s0 + v * 64 + kq + 4);
                __syncthreads();
                for (int j = 0; j < 64; ++j) { const float sv = Sc[v * 65 + j]; a0 += *(const LAS f32x4*)(Ph + j * 64 + kq) * sv; a1 += *(const LAS f32x4*)(Ph + j * 64 + kq + 4) * sv; }
                __syncthreads();
#pragma unroll
                for (int i = 0; i < 4; ++i) { Sc[v * 65 + kq + i] = a0[i]; Sc[v * 65 + kq + 4 + i] = a1[i]; }
                *(f32x4*)(s0 + v * 64 + kq) = a0; *(f32x4*)(s0 + v * 64 + kq + 4) = a1;
            }
        } else {
            const int bh = it - 32; float* SE = (float*)(P.ws + WS_SEG) + (size_t)bh * NSEG * 8192; const float* CE = (const float*)(P.ws + WS_CEND) + (size_t)bh * NSEG * 64;
            const int v = tid >> 2, d0 = (tid & 3) * 16; f32x4 sc[4];
#pragma unroll
            for (int q = 0; q < 4; ++q) sc[q] = (f32x4){0.f, 0.f, 0.f, 0.f};
            for (int seg = 0; seg < NSEG - 1; ++seg) {
#pragma unroll
                for (int q = 0; q < 4; ++q) { float* sp = SE + (size_t)seg * 8192 + v * 64 + d0 + 4 * q; sc[q] = sc[q] * *(const f32x4*)(CE + seg * 64 + d0 + 4 * q) + *(const f32x4*)sp; *(f32x4*)sp = sc[q]; }
            }
        }
    }
}
__device__ __forceinline__ void phase_correct(const Params& P, LAS unsigned char* lds) {
    const int tid = threadIdx.x, lane = tid & 63, wave = tid >> 6;
    unsigned char* ws = P.ws;
    const bf16* p = (const bf16*)(ws + WS_P); const bf16* AA = (const bf16*)(ws + WS_AA); const bf16* GG = (const bf16*)(ws + WS_GG);
    bf16* MIX = (bf16*)(ws + WS_MIX); const bf16* YI = (const bf16*)(ws + WS_YI); const bf16* YIG = (const bf16*)(ws + WS_YIG);
    const float* mu = P.in[4]; const float* k_a = P.in[11]; const float* r_k = P.in[12]; const float* gn_g = P.in[13]; const float* gn_b = P.in[14]; const float* norm_g = P.in[18];
    LAS float* SL = (LAS float*)lds;
    for (int it = blockIdx.x; it < 512 + 256; it += gridDim.x) {
        __syncthreads();
        if (it < 512) {
            const int seg = it & 15, bh = it >> 4, b = bh >> 3, h = bh & 7;
            if (seg > 0) { const float* ss = (const float*)(ws + WS_SER) + (((size_t)bh * NSEG + (seg - 1)) * 2) * 4096;
                for (int i = tid; i < 4096; i += NTHR) SL[(i & 63) * 65 + (i >> 6)] = ss[i]; }
            __syncthreads();
            const int col = h * 64 + lane;
            const float mu_r = mu[C_R + col], mu_k = mu[C_K + col], mu_v = mu[C_V + col], kac = k_a[col], rkc = r_k[col], gng = gn_g[col], gnb = gn_b[col];
            for (int i0 = 0; i0 < 64; i0 += 4) {
                float y[4], yi[4], r[4], k[4], v[4], a[4], g[4];
#pragma unroll
                for (int u = 0; u < 4; ++u) {
                    const int t = seg * LSEG + wave * 64 + i0 + u; const size_t m = (size_t)b * T + t; const bf16* pr = p + m * NP; const bf16* pp = (t > 0) ? pr - NP : pr; const float hp = (t > 0) ? 1.f : 0.f;
                    y[u] = bf2f(MIX[m * D + col]); yi[u] = bf2f(YI[m * 512 + col]);
                    const float rc = bf2f(pr[C_R + col]), kc = bf2f(pr[C_K + col]), vc = bf2f(pr[C_V + col]);
                    r[u] = rc + (bf2f(pp[C_R + col]) * hp - rc) * mu_r; k[u] = kc + (bf2f(pp[C_K + col]) * hp - kc) * mu_k; v[u] = vc + (bf2f(pp[C_V + col]) * hp - vc) * mu_v;
                    a[u] = bf2f(AA[m * A_W + col]); g[u] = bf2f(GG[m * A_W + col]);
                }
                if (seg > 0) {
                    for (int j = 0; j < 64; ++j) { const float sv = SL[j * 65 + lane];
#pragma unroll
                        for (int u = 0; u < 4; ++u) y[u] += rlf(yi[u], j) * sv; }
                }
#pragma unroll
                for (int u = 0; u < 4; ++u) {
                    const size_t m = (size_t)b * T + seg * LSEG + wave * 64 + i0 + u;
                    const float kh = k[u] * (1.f + (a[u] - 1.f) * kac); const float bon = wave_sum(r[u] * kh * rkc);
                    const float mean = wave_sum(y[u]) * (1.f / 64.f); const float d = y[u] - mean; const float var = wave_sum(d * d) * (1.f / 64.f);
                    float o = d * (1.f / sqrtf(var + GN_EPS)) * gng + gnb; o += bon * v[u]; o *= g[u];
                    MIX[m * D + col] = (bf16)f2bf(o);
                }
            }
        } else {
            const int g_ = it - 512, seg = g_ & 15, bh = g_ >> 4, b = bh >> 2, h = bh & 3;
            if (seg > 0) { const float* ss = (const float*)(ws + WS_SEG) + ((size_t)bh * NSEG + (seg - 1)) * 8192;
                for (int i = tid; i < 8192; i += NTHR) SL[(i & 63) * 129 + (i >> 6)] = ss[i]; }
            __syncthreads();
            const float ng0 = norm_g[lane], ng1 = norm_g[lane + 64];
            for (int i0 = 0; i0 < 64; i0 += 4) {
                float o0[4], o1[4], yi[4], g0[4], g1[4];
#pragma unroll
                for (int u = 0; u < 4; ++u) {
                    const size_t m = (size_t)b * T + seg * LSEG + wave * 64 + i0 + u;
                    o0[u] = bf2f(MIX[m * D + 512 + h * 128 + lane]); o1[u] = bf2f(MIX[m * D + 512 + h * 128 + 64 + lane]); yi[u] = bf2f(YIG[m * 256 + h * 64 + lane]);
                    g0[u] = bf2f(p[m * NP + C_BG + h * 128 + lane]); g1[u] = bf2f(p[m * NP + C_BG + h * 128 + 64 + lane]);
                }
                if (seg > 0) {
                    for (int d = 0; d < 64; ++d) { const float s0 = SL[d * 129 + lane], s1 = SL[d * 129 + 64 + lane];
#pragma unroll
                        for (int u = 0; u < 4; ++u) { const float q = rlf(yi[u], d); o0[u] += q * s0; o1[u] += q * s1; } }
                }
#pragma unroll
                for (int u = 0; u < 4; ++u) {
                    const size_t m = (size_t)b * T + seg * LSEG + wave * 64 + i0 + u;
                    const float ms = wave_sum(o0[u] * o0[u] + o1[u] * o1[u]) * (1.f / 128.f); const float rs = 1.f / sqrtf(ms + RMS_EPS);
                    MIX[m * D + 512 + h * 128 + lane] = (bf16)f2bf(o0[u] * rs * ng0 * siluf_(g0[u])); MIX[m * D + 512 + h * 128 + 64 + lane] = (bf16)f2bf(o1[u] * rs * ng1 * siluf_(g1[u]));
                }
            }
        }
    }
}

__device__ __forceinline__ void phase_ln1(const Params& P) {
    const int lane = threadIdx.x & 63, wave = threadIdx.x >> 6; const int gw = blockIdx.x * NWAVES + wave, ngw = gridDim.x * NWAVES;
    for (int m = gw; m < M; m += ngw) ln_row_bf16((const float*)(P.ws + WS_Z) + (size_t)m * D, P.in[20], P.in[21], (bf16*)(P.ws + WS_H1) + (size_t)m * D, lane);
#pragma unroll
    for (int tb = 0; tb < 2; ++tb) {
        const float* src = P.in[24 + tb]; unsigned char* dst = P.ws + (tb ? WS_VT : WS_UT); float* sc = (float*)(P.ws + (tb ? WS_SV : WS_SU));
        for (int e = gw; e < 16384; e += ngw) {
            const f32x4* sp = (const f32x4*)(src + (size_t)e * D) + 4 * lane; f32x4 a[4]; float mx = 0.f;
#pragma unroll
            for (int j = 0; j < 4; ++j) { a[j] = sp[j]; mx = fmaxf(fmaxf(mx, fmaxf(fabsf(a[j][0]), fabsf(a[j][1]))), fmaxf(fabsf(a[j][2]), fabsf(a[j][3]))); }
            mx = wave_max_u(mx); const float inv = mx > 0.f ? 127.f / mx : 0.f;
            u32x4 o;
#pragma unroll
            for (int j = 0; j < 4; ++j) o[j] = pack_i8(a[j][0], a[j][1], a[j][2], a[j][3], inv, tb ? 128 : 0);
            *((u32x4*)(dst + (size_t)e * D) + lane) = o;
            if (lane == 0) sc[e] = mx * (1.f / 127.f);
        }
    }
}

#define TK_INS(L, x) do { _Pragma("unroll") for (int _j = 0; _j < 16; ++_j) { const unsigned _h = max(L[_j], x); x = min(L[_j], x); L[_j] = _h; } } while (0)
__device__ __forceinline__ void topk128(const u32x4* r, unsigned (&L)[16]) {
#pragma unroll
    for (int j = 0; j < 16; ++j) L[j] = 0u;
    u32x4 cur = r[0];
    for (int c = 0; c < 16; ++c) {
        const u32x4 nxt = r[(c + 1) & 15];
        const unsigned kb = 0xFFFFu - 8u * (unsigned)c;
#pragma unroll
        for (int d = 0; d < 4; ++d) {
            unsigned w = cur[d]; const unsigned msk = ((w >> 15) & 0x00010001u) * 0xFFFFu; w ^= (msk | 0x80008000u);
            unsigned x0 = (w << 16) | (kb - 2u * d), x1 = (w & 0xFFFF0000u) | (kb - 2u * d - 1u);
            TK_INS(L, x0); TK_INS(L, x1);
        }
        cur = nxt;
    }
}
__device__ __forceinline__ void phase_topk(const Params& P) {
    const int gl = blockIdx.x * NTHR + threadIdx.x, nl = gridDim.x * NTHR;
    const bf16* Sc = (const bf16*)(P.ws + WS_S); int* IDS = (int*)(P.ws + WS_IDS); float* GATES = (float*)(P.ws + WS_GATES);
    for (int item = gl; item < M * 8; item += nl) {
        const u32x4* row = (const u32x4*)(Sc + (size_t)item * 256);
        unsigned L0[16], L1[16];
        topk128(row, L0); topk128(row + 16, L1);
        float f0[16], f1[16]; unsigned p0[16], p1[16];
#pragma unroll
        for (int i = 0; i < 16; ++i) {
            f0[i] = __uint_as_float((L0[i] & 0x80000000u) ? (L0[i] & 0x7FFF0000u) : (~L0[i] & 0xFFFF0000u)); p0[i] = (~L0[i] & 0x7Fu) << 7;
            f1[i] = __uint_as_float((L1[i] & 0x80000000u) ? (L1[i] & 0x7FFF0000u) : (~L1[i] & 0xFFFF0000u)); p1[i] = (~L1[i] & 0x7Fu);
        }
        unsigned C[16];
#pragma unroll
        for (int j = 0; j < 16; ++j) C[j] = 0u;
#pragma unroll
        for (int i = 0; i < 16; ++i)
#pragma unroll
            for (int j = 0; j < 16; ++j)
                if ((i + 1) * (j + 1) <= 16) {
                    const unsigned b = __float_as_uint(f0[i] + f1[j]); const unsigned mono = b ^ ((unsigned)((int)b >> 31) | 0x80000000u);
                    unsigned key = (mono & 0xFFFFC000u) | p0[i] | p1[j];
                    TK_INS(C, key);
                }
        float cv[16];
#pragma unroll
        for (int r = 0; r < 16; ++r) cv[r] = __uint_as_float((C[r] & 0x80000000u) ? (C[r] & 0x7FFFC000u) : (~C[r] & 0xFFFFC000u));
        const float cmax = cv[0]; float den = 0.f;
#pragma unroll
        for (int r = 0; r < 16; ++r) { cv[r] = __expf(cv[r] - cmax); den += cv[r]; }
        const float inv = 1.f / den;
        u32x4* ido = (u32x4*)(IDS + (size_t)item * 16); f32x4* go = (f32x4*)(GATES + (size_t)item * 16);
#pragma unroll
        for (int q = 0; q < 4; ++q) { u32x4 o; o.x = C[4 * q] & 0x3FFFu; o.y = C[4 * q + 1] & 0x3FFFu; o.z = C[4 * q + 2] & 0x3FFFu; o.w = C[4 * q + 3] & 0x3FFFu; ido[q] = o;
            f32x4 g; g[0] = cv[4 * q] * inv; g[1] = cv[4 * q + 1] * inv; g[2] = cv[4 * q + 2] * inv; g[3] = cv[4 * q + 3] * inv; go[q] = g; }
    }
}

typedef __bf16 bf16x2_t __attribute__((ext_vector_type(2)));
__device__ __forceinline__ float dot2bf(unsigned a, unsigned b, float c) { return __builtin_amdgcn_fdot2_f32_bf16(__builtin_bit_cast(bf16x2_t, a), __builtin_bit_cast(bf16x2_t, b), c, false); }
__device__ __forceinline__ void peer_load8(u32x4 (&buf)[8], const unsigned char* TAB, int idreg, int g, int lane) {
#pragma unroll
    for (int q = 0; q < 8; ++q) { const int id = __builtin_amdgcn_readlane(idreg, 8 * g + q); buf[q] = *((const u32x4*)(TAB + (size_t)id * D) + lane); }
}
__device__ __forceinline__ void peer_dots8(const u32x4 (&buf)[8], const u32x4& hq, int g, float& d, int lane) {
#pragma unroll
    for (int q = 0; q < 8; ++q) { int s = 0;
#pragma unroll
        for (int i = 0; i < 4; ++i) s = __builtin_amdgcn_sdot4((int)buf[q][i], (int)hq[i], s, false);
        const int tot = wave_sum_i(s);
        d = (lane == 8 * g + q) ? (float)tot : d; }
}
__device__ __forceinline__ void peer_axpy8(const u32x4 (&buf)[8], float areg, int g, float (&acc)[16]) {
#pragma unroll
    for (int q = 0; q < 8; ++q) { const float a = rlf(areg, 8 * g + q);
#pragma unroll
        for (int i = 0; i < 4; ++i) { const unsigned w = buf[q][i];
            acc[4 * i] += a * (float)(w & 0xffu); acc[4 * i + 1] += a * (float)((w >> 8) & 0xffu); acc[4 * i + 2] += a * (float)((w >> 16) & 0xffu); acc[4 * i + 3] += a * (float)(w >> 24); } }
}
__device__ __forceinline__ void phase_peer(const Params& P) {
    const int lane = threadIdx.x & 63, wave = threadIdx.x >> 6; const int gw = blockIdx.x * NWAVES + wave, ngw = gridDim.x * NWAVES;
    const bf16* H1 = (const bf16*)(P.ws + WS_H1); const int* IDS = (const int*)(P.ws + WS_IDS); const float* GATES = (const float*)(P.ws + WS_GATES);
    const unsigned char* UT = P.ws + WS_UT; const unsigned char* VT = P.ws + WS_VT; const float* SU = (const float*)(P.ws + WS_SU); const float* SV = (const float*)(P.ws + WS_SV);
    const float* g2 = P.in[26]; const float* b2 = P.in[27];
    for (int m = gw; m < M; m += ngw) {
        const u32x4* hp = (const u32x4*)(H1 + (size_t)m * D) + 2 * lane; const u32x4 hA = hp[0], hB = hp[1];
        float hv[16]; float hmx = 0.f;
#pragma unroll
        for (int i = 0; i < 4; ++i) { hv[2 * i] = __uint_as_float(hA[i] << 16); hv[2 * i + 1] = __uint_as_float(hA[i] & 0xffff0000u); hv[8 + 2 * i] = __uint_as_float(hB[i] << 16); hv[8 + 2 * i + 1] = __uint_as_float(hB[i] & 0xffff0000u); }
#pragma unroll
        for (int i = 0; i < 16; ++i) hmx = fmaxf(hmx, fabsf(hv[i]));
        hmx = wave_max_u(hmx); const float hinv = hmx > 0.f ? 127.f / hmx : 0.f, hsc = hmx * (1.f / 127.f);
        u32x4 hq;
#pragma unroll
        for (int i = 0; i < 4; ++i) hq[i] = pack_i8(hv[4 * i], hv[4 * i + 1], hv[4 * i + 2], hv[4 * i + 3], hinv, 0);
        const int id_lo = IDS[(size_t)m * 128 + lane], id_hi = IDS[(size_t)m * 128 + 64 + lane];
        const float gt_lo = GATES[(size_t)m * 128 + lane], gt_hi = GATES[(size_t)m * 128 + 64 + lane];
        const float su_lo = SU[id_lo], su_hi = SU[id_hi], sv_lo = SV[id_lo], sv_hi = SV[id_hi];
        float d_lo = 0.f, d_hi = 0.f;
        u32x4 A0[8], A1[8];
        peer_load8(A0, UT, id_lo, 0, lane);
        for (int g = 0; g < 8; g += 2) {
            peer_load8(A1, UT, id_lo, g + 1, lane); peer_dots8(A0, hq, g, d_lo, lane);
            if (g + 2 < 8) peer_load8(A0, UT, id_lo, g + 2, lane); else peer_load8(A0, UT, id_hi, 0, lane);
            peer_dots8(A1, hq, g + 1, d_lo, lane);
        }
        for (int g = 0; g < 8; g += 2) {
            peer_load8(A1, UT, id_hi, g + 1, lane); peer_dots8(A0, hq, g, d_hi, lane);
            if (g + 2 < 8) peer_load8(A0, UT, id_hi, g + 2, lane); else peer_load8(A0, VT, id_lo, 0, lane);
            peer_dots8(A1, hq, g + 1, d_hi, lane);
        }
        const float x_lo = d_lo * su_lo * hsc, x_hi = d_hi * su_hi * hsc;
        const float a_lo = 0.5f * x_lo * (1.f + erff(x_lo * 0.70710678118f)) * gt_lo * sv_lo, a_hi = 0.5f * x_hi * (1.f + erff(x_hi * 0.70710678118f)) * gt_hi * sv_hi;
        const float c0 = 128.f * wave_sum(a_lo + a_hi);
        float acc[16];
#pragma unroll
        for (int i = 0; i < 16; ++i) acc[i] = 0.f;
        for (int g = 0; g < 8; g += 2) {
            peer_load8(A1, VT, id_lo, g + 1, lane); peer_axpy8(A0, a_lo, g, acc);
            if (g + 2 < 8) peer_load8(A0, VT, id_lo, g + 2, lane); else peer_load8(A0, VT, id_hi, 0, lane);
            peer_axpy8(A1, a_lo, g + 1, acc);
        }
        for (int g = 0; g < 8; g += 2) {
            peer_load8(A1, VT, id_hi, g + 1, lane); peer_axpy8(A0, a_hi, g, acc);
            if (g + 2 < 8) peer_load8(A0, VT, id_hi, g + 2, lane);
            peer_axpy8(A1, a_hi, g + 1, acc);
        }
        float s = 0.f;
#pragma unroll
        for (int i = 0; i < 16; ++i) { acc[i] = ALPHA * hv[i] + (acc[i] - c0); s += acc[i]; }
        const float mean = wave_sum(s) * (1.f / D); float s2 = 0.f;
#pragma unroll
        for (int i = 0; i < 16; ++i) { acc[i] -= mean; s2 += acc[i] * acc[i]; }
        const float rstd = 1.f / sqrtf(wave_sum(s2) * (1.f / D) + LN_EPS);
#pragma unroll
        for (int c4 = 0; c4 < 4; ++c4) { const int e0 = 16 * lane + 4 * c4; const f32x4 gg = *(const f32x4*)(g2 + e0), bb = *(const f32x4*)(b2 + e0); f32x4 o;
#pragma unroll
            for (int j = 0; j < 4; ++j) o[j] = acc[c4 * 4 + j] * rstd * gg[j] + bb[j];
            *(f32x4*)(P.out + (size_t)m * D + e0) = o; }
    }
}

#define XB_TMO      128
#define XB_XCNT(j)  (256  + 64 * (j))
#define XB_XSUB(j)  (1280 + 64 * (j))
#define XB_XGEN(j)  (2304 + 64 * (j))
#define XB_TOP      3328
#define XB_TOPGEN   3392
#define XCD_BAR_WORDS 3456
#define XB_SPIN_CAP (1u << 18)
__device__ __forceinline__ unsigned xb_ld(unsigned* p)              { return __hip_atomic_load(p, __ATOMIC_RELAXED, __HIP_MEMORY_SCOPE_AGENT); }
__device__ __forceinline__ unsigned xb_add(unsigned* p, unsigned v) { return __hip_atomic_fetch_add(p, v, __ATOMIC_RELAXED, __HIP_MEMORY_SCOPE_AGENT); }
__device__ __forceinline__ unsigned xb_xcc_id() { return (unsigned)__builtin_amdgcn_s_getreg((3 << 11) | 20) & 0xFu; }
#define XB_SPIN(cond, bar) do { unsigned _sp = 0; while (cond) { __builtin_amdgcn_s_sleep(1); \
    if ((++_sp & 255u) == 0u) { if (xb_ld(&(bar)[XB_TMO])) break; if (_sp > XB_SPIN_CAP) { atomicAdd(&(bar)[XB_TMO], 1u); break; } } } } while (0)
struct XcdBarrier { unsigned* bar; unsigned x; volatile LAS unsigned* st; };
__device__ __forceinline__ XcdBarrier xcd_barrier_post(unsigned* bar, volatile LAS unsigned* st) {
    XcdBarrier b; b.bar = bar; b.x = xb_xcc_id(); b.st = st;
    if (threadIdx.x == 0) (void)xb_add(&bar[XB_XCNT(b.x)], 1u);
    return b;
}
__device__ __forceinline__ void xcd_barrier_complete(unsigned* bar, unsigned x, unsigned& nloc, unsigned& nx) {
    const unsigned G = gridDim.x * gridDim.y * gridDim.z;
    unsigned sum, cnt, mine, sp = 0u;
    for (;;) {
        sum = 0u; cnt = 0u; mine = 0u;
#pragma unroll
        for (unsigned j = 0; j < 16; ++j) { const unsigned c = xb_ld(&bar[XB_XCNT(j)]); sum += c; cnt += (c > 0u) ? 1u : 0u; mine = (j == x) ? c : mine; }
        if (sum == G) break;
        __builtin_amdgcn_s_sleep(1);
        if ((++sp & 255u) == 0u) { if (xb_ld(&bar[XB_TMO])) break; if (sp > XB_SPIN_CAP) { atomicAdd(&bar[XB_TMO], 1u); break; } }
    }
    nloc = mine > 0u ? mine : 1u; nx = cnt > 0u ? cnt : 1u;
}
__device__ __forceinline__ void xcd_barrier(const XcdBarrier& b) {
    asm volatile("s_waitcnt vmcnt(0)" ::: "memory");
    __syncthreads();
    if (threadIdx.x == 0) {
        unsigned* bar = b.bar;
        __builtin_amdgcn_s_waitcnt(0);
        unsigned nloc = b.st[0], nx = b.st[1];
        if (nloc == 0u) { xcd_barrier_complete(bar, b.x, nloc, nx); b.st[0] = nloc; b.st[1] = nx; }
        const unsigned old = xb_add(&bar[XB_XSUB(b.x)], 1u);
        const unsigned gen = old / nloc;
        if (old + 1u == (gen + 1u) * nloc) {
            __builtin_amdgcn_fence(__ATOMIC_RELEASE, "agent");
            asm volatile("s_waitcnt vmcnt(0)" ::: "memory");
            const unsigned og = xb_add(&bar[XB_TOP], 1u);
            const unsigned tg = og / nx;
            if (og + 1u == (tg + 1u) * nx) xb_add(&bar[XB_TOPGEN], 1u);
            else XB_SPIN(xb_ld(&bar[XB_TOPGEN]) == tg, bar);
            __builtin_amdgcn_fence(__ATOMIC_ACQUIRE, "agent");
            xb_add(&bar[XB_XGEN(b.x)], 1u);
            asm volatile("s_waitcnt vmcnt(0)" ::: "memory");
        } else {
            XB_SPIN(xb_ld(&bar[XB_XGEN(b.x)]) == gen, bar);
            __builtin_amdgcn_fence(__ATOMIC_ACQUIRE, "agent");
            asm volatile("s_waitcnt vmcnt(0)" ::: "memory");
        }
    }
    __syncthreads();
}

constexpr int N_PHASES = 12;
__global__ void __launch_bounds__(NTHR, 2) fwd_kernel(Params P) {
    extern __shared__ __attribute__((aligned(16))) unsigned char lds_raw[];
    LAS unsigned char* lds = (LAS unsigned char*)lds_raw;
    cg::grid_group grid = cg::this_grid();
    const int lo = P.ph_lo, hi = P.ph_hi;
    unsigned char* ws = P.ws;
    volatile LAS unsigned* bst = (volatile LAS unsigned*)(lds + LDS_MISC);
    if (threadIdx.x < 16) bst[threadIdx.x] = 0u;
    __syncthreads();
    const XcdBarrier bar = xcd_barrier_post((unsigned*)(ws + WS_CTL), bst);
#define IN(k) (lo <= (k) && (k) < hi)
#define SEAM(k) do { if (IN(k) && IN((k) + 1)) { if ((k) == 0) grid.sync(); else xcd_barrier(bar); } } while (0)
    if (IN(0)) phase_prologue(P);
    SEAM(0);
    if (IN(1)) {
        pg8::Gemm g{(const bf16*)(ws + WS_H0), (const bf16*)(ws + WS_WIN), M, NP, D, D, D, 0}; pg8::StaticOrder S; S.init(M, NP, gridDim.x, blockIdx.x);
        pg8::EpiBf16 E{(bf16*)(ws + WS_P), NP};
        pg8::gemm_phase<pg8::EpiBf16, pg8::StaticOrder, true, true>(lds, g, S, E);
    }
    SEAM(1);
    if (IN(2)) phase_prep(P, lds);
    SEAM(2);
    if (IN(3)) phase_scan(P, lds);
    SEAM(3);
    if (IN(4)) phase_fixup(P, lds);
    SEAM(4);
    if (IN(5)) phase_correct(P, lds);
    SEAM(5);
    if (IN(6)) {
        pg8::Gemm g{(const bf16*)(ws + WS_MIX), (const bf16*)(ws + WS_WOUT), M, D, D, D, D, 0}; pg8::StaticOrder S; S.init(M, D, gridDim.x, blockIdx.x);
        pg8::EpiResF32 E{(float*)(ws + WS_Z), (const bf16*)(ws + WS_H0), D, ALPHA};
        pg8::gemm_phase<pg8::EpiResF32, pg8::StaticOrder, true, true>(lds, g, S, E);
    }
    SEAM(6);
    if (IN(7)) phase_ln1(P);
    SEAM(7);
    if (IN(8)) {
        pg8::Gemm g{(const bf16*)(ws + WS_H1), (const bf16*)(ws + WS_WQ), M, NQ, D, D, D, 0}; pg8::StaticOrder S; S.init(M, NQ, gridDim.x, blockIdx.x);
        pg8::EpiBf16 E{(bf16*)(ws + WS_Q), NQ};
        pg8::gemm_phase<pg8::EpiBf16, pg8::StaticOrder, true, true>(lds, g, S, E);
    }
    SEAM(8);
    if (IN(9)) {
        pg8::Gemm g{(const bf16*)(ws + WS_Q), (const bf16*)(ws + WS_KBD), M, NQ, 256, NQ, 256, 256}; pg8::StaticOrder S; S.init(M, NQ, gridDim.x, blockIdx.x);
        pg8::EpiBf16 E{(bf16*)(ws + WS_S), NQ};
        pg8::gemm_phase<pg8::EpiBf16, pg8::StaticOrder, true, true>(lds, g, S, E);
    }
    SEAM(9);
    if (IN(10)) phase_topk(P);
    SEAM(10);
    if (IN(11)) phase_peer(P);
#undef IN
#undef SEAM
}

extern "C" void kernel_launch(void* const* d_in, const int* in_sizes, int n_in, void* d_out, int out_size, void* d_ws, size_t ws_size, hipStream_t stream) {
    static int grid = 0;
    if (grid == 0) {
        if (n_in != 28 || out_size != M * D || ws_size < WS_END) { fprintf(stderr, "kernel_launch: unexpected shapes (n_in %d out %d ws %zu)\n", n_in, out_size, ws_size); grid = -1; return; }
        int dev = 0, cus = 0, per_cu = 0;
        (void)hipGetDevice(&dev); (void)hipDeviceGetAttribute(&cus, hipDeviceAttributeMultiprocessorCount, dev);
        (void)hipFuncSetAttribute((const void*)fwd_kernel, hipFuncAttributeMaxDynamicSharedMemorySize, LDS_BYTES);
        (void)hipOccupancyMaxActiveBlocksPerMultiprocessor(&per_cu, (const void*)fwd_kernel, NTHR, LDS_BYTES);
        if (per_cu < 1) { fprintf(stderr, "kernel_launch: occupancy query says %d blocks per CU\n", per_cu); per_cu = 1; }
        (void)hipGetLastError();
        grid = cus;
    }
    if (grid < 0) return;
    Params p{};
    for (int i = 0; i < 28; ++i) p.in[i] = (const float*)d_in[i];
    p.out = (float*)d_out; p.ws = (unsigned char*)d_ws;
    (void)hipMemsetAsync((char*)d_ws + WS_CTL, 0, CTL_BYTES, stream);
#if MK_ONE_LAUNCH
    p.ph_lo = 0; p.ph_hi = N_PHASES;
    void* args[] = {&p};
    hipError_t e = hipLaunchCooperativeKernel((const void*)fwd_kernel, dim3(grid), dim3(NTHR), args, LDS_BYTES, stream);
    if (e != hipSuccess) fprintf(stderr, "cooperative launch failed: %s (grid %d)\n", hipGetErrorString(e), grid);
#else
    for (int ph = 0; ph < N_PHASES; ++ph) {
        p.ph_lo = ph; p.ph_hi = ph + 1;
        hipLaunchKernelGGL(fwd_kernel, dim3(grid), dim3(NTHR), LDS_BYTES, stream, p);
    }
#endif
}
```

```cpp
#include <hip/hip_runtime.h>
#include <hip/hip_cooperative_groups.h>
#include <cstdio>
#include <cstdint>
namespace cg = cooperative_groups;

#ifndef MK_ONE_LAUNCH
#define MK_ONE_LAUNCH 1
#endif

namespace pg8 {
#define PG8_LAS __attribute__((address_space(3)))
typedef unsigned short bf16_t;
typedef short bf16x8 __attribute__((ext_vector_type(8)));
typedef float f32x4 __attribute__((ext_vector_type(4)));
typedef float f32x2 __attribute__((ext_vector_type(2)));
typedef unsigned u32x4 __attribute__((ext_vector_type(4)));
typedef unsigned u32x2 __attribute__((ext_vector_type(2)));
constexpr int BM = 256, BK = 64, HALF = 128, HTB = HALF * BK * 2, STAGE_BYTES = 8 * HTB, NXCD = 8, WGM = 8;

__host__ __device__ __forceinline__ int lds_byte(int r, int c) { const int st = (r >> 4) * 2 + (c >> 5), rr = r & 15, cc = c & 31, ob = rr * 64 + cc * 2; return st * 1024 + (ob ^ (((ob >> 9) & 1) << 5)); }
__host__ __device__ __forceinline__ void stage_rc(int b, int& R, int& C) { const int st = b / 1024, sb = b % 1024, swz = sb ^ (((sb >> 9) & 1) << 5); R = (st >> 1) * 16 + swz / 64; C = (st & 1) * 32 + (swz % 64) / 2; }
__host__ __device__ __forceinline__ int perm32(int rho) { const int n = rho >> 4, i = rho & 15; return 8 * (i >> 2) + 4 * n + (i & 3); }

struct Unit { int pm, pn; };
struct Gemm { const bf16_t* A; const bf16_t* Bt; int M, N, K, lda, ldb, a_pn_koff; };

struct StaticOrder {
    int nM, nN, nwg, G, c;
    __host__ __device__ void init(int M, int N, int G_, int c_) { nM = M / BM; nN = N / BM; nwg = nM * nN; G = G_; c = c_; }
    __host__ __device__ bool next(int i, Unit& u) const {
        const long L = (long)i * G + c; if (L >= nwg) return false;
        int wgid = (int)L; { const int q = nwg / NXCD, r = nwg % NXCD, xcd = wgid % NXCD, off = wgid / NXCD; wgid = (xcd < r ? xcd * (q + 1) : r * (q + 1) + (xcd - r) * q) + off; }
        const int nig = WGM * nN, gid = wgid / nig, fm = gid * WGM, gsz = (nM - fm) < WGM ? (nM - fm) : WGM;
        u.pm = fm + ((wgid % nig) % gsz); u.pn = (wgid % nig) / gsz; return true;
    }
    __device__ __forceinline__ void a_ready(const Unit&) const {}
    __device__ __forceinline__ void done(const Unit&) const {}
};

__device__ __forceinline__ unsigned cvt_pk_bf16(float lo, float hi) { unsigned r; asm volatile("v_cvt_pk_bf16_f32 %0, %1, %2" : "=v"(r) : "v"(lo), "v"(hi)); return r; }

struct EpiBf16 {
    static constexpr bool PERM = true;
    bf16_t* O; int ldc;
    __device__ __forceinline__ void operator()(const f32x4 (&acc)[2][2][4][2], const Unit& u, int wr, int wc, int fr, int fq) const {
        const int row0 = u.pm * BM + wr * 64 + fr; const int col0 = u.pn * BM + wc * 32 + 8 * fq;
#pragma unroll
        for (int ai = 0; ai < 2; ++ai)
#pragma unroll
            for (int m = 0; m < 4; ++m) { bf16_t* rowp = O + (size_t)(row0 + ai * HALF + m * 16) * ldc + col0;
#pragma unroll
                for (int bj = 0; bj < 2; ++bj) { const f32x4 v0 = acc[ai][bj][m][0], v1 = acc[ai][bj][m][1];
                    u32x4 w; w.x = cvt_pk_bf16(v0[0], v0[1]); w.y = cvt_pk_bf16(v0[2], v0[3]); w.z = cvt_pk_bf16(v1[0], v1[1]); w.w = cvt_pk_bf16(v1[2], v1[3]);
                    *(u32x4*)(rowp + bj * HALF) = w; } }
    }
};
struct EpiResF32 {
    static constexpr bool PERM = false;
    float* Z; const bf16_t* R; int ldc; float alpha;
    __device__ __forceinline__ void operator()(const f32x4 (&acc)[2][2][4][2], const Unit& u, int wr, int wc, int fr, int fq) const {
        const int row0 = u.pm * BM + wr * 64 + fr; const int col0 = u.pn * BM + wc * 32 + 4 * fq;
#pragma unroll
        for (int ai = 0; ai < 2; ++ai)
#pragma unroll
            for (int m = 0; m < 4; ++m) { const size_t off = (size_t)(row0 + ai * HALF + m * 16) * ldc + col0;
#pragma unroll
                for (int bj = 0; bj < 2; ++bj)
#pragma unroll
                    for (int n = 0; n < 2; ++n) { const size_t o2 = off + bj * HALF + n * 16; const u32x2 rb = *(const u32x2*)(R + o2);
                        f32x4 h; h[0] = __uint_as_float(rb.x << 16); h[1] = __uint_as_float(rb.x & 0xffff0000u); h[2] = __uint_as_float(rb.y << 16); h[3] = __uint_as_float(rb.y & 0xffff0000u);
                        *(f32x4*)(Z + o2) = h * alpha + acc[ai][bj][m][n]; } }
    }
};

template <class Epi, class Sched, bool ALIGN_EPI = false, bool SP2 = false>
__device__ __forceinline__ void gemm_phase(PG8_LAS unsigned char* lds, const Gemm g, const Sched& S, const Epi& E) {
    const int tid = threadIdx.x, wid = __builtin_amdgcn_readfirstlane(tid >> 6), lane = tid & 63, wr = wid >> 2, wc = wid & 3, fr = lane & 15, fq = lane >> 4;
    const int K = g.K, nt = K / BK;
    unsigned voffA[2], voffB[2];
#pragma unroll
    for (int i = 0; i < 2; ++i) { int R, C; stage_rc(tid * 16 + i * 8192, R, C); const int Rb = Epi::PERM ? ((R & ~31) + perm32(R & 31)) : R;
        voffA[i] = (unsigned)(R * g.lda + C) * 2u; voffB[i] = (unsigned)(Rb * g.ldb + C) * 2u; }
    const size_t kstep = (size_t)(BK * 2);
    const size_t hstepA = (size_t)HALF * g.lda * 2, hstepB = (size_t)HALF * g.ldb * 2;
    const size_t tstepA = 2 * hstepA, tstepB = 2 * hstepB;
    const size_t pnA = (size_t)g.a_pn_koff * 2;
    const unsigned ldsw = (unsigned)wid * 1024u;
    const int aoff = lds_byte(wr * 64 + fr, fq * 8), boff = lds_byte(wc * 32 + fr, fq * 8);
#define PG8_SA(b, h) (((b) * 2 + (h)) * HTB)
#define PG8_SB(b, h) ((4 + (b) * 2 + (h)) * HTB)
#define PG8_STAGE(bufoff, gbase, voff) do { _Pragma("unroll") for (int _i = 0; _i < 2; ++_i) \
        __builtin_amdgcn_global_load_lds((const unsigned*)((const char*)(gbase) + (voff)[_i]), (PG8_LAS unsigned*)(lds + (bufoff) + ldsw + _i * 8192), 16, 0, 0); } while (0)
#define PG8_LDA(dst, b, h) do { _Pragma("unroll") for (int m = 0; m < 4; ++m) _Pragma("unroll") for (int k = 0; k < 2; ++k) dst[m][k] = *(const PG8_LAS bf16x8*)(lds + PG8_SA(b, h) + aoff + m * 2048 + k * 1024); } while (0)
#define PG8_LDB(dst, b, h) do { _Pragma("unroll") for (int n = 0; n < 2; ++n) _Pragma("unroll") for (int k = 0; k < 2; ++k) dst[n][k] = *(const PG8_LAS bf16x8*)(lds + PG8_SB(b, h) + boff + n * 2048 + k * 1024); } while (0)
#define PG8_MMA(ai, bj, At, Bt) do { __builtin_amdgcn_s_setprio(1); _Pragma("unroll") for (int m = 0; m < 4; ++m) _Pragma("unroll") for (int n = 0; n < 2; ++n) _Pragma("unroll") for (int k = 0; k < 2; ++k) \
        acc[ai][bj][m][n] = __builtin_amdgcn_mfma_f32_16x16x32_bf16(Bt[n][k], At[m][k], acc[ai][bj][m][n], 0, 0, 0); __builtin_amdgcn_s_setprio(0); } while (0)
#define PG8_WAIT_V(n) asm volatile("s_waitcnt vmcnt(" #n ")" ::: "memory")
#define PG8_WAIT_L(n) asm volatile("s_waitcnt lgkmcnt(" #n ")" ::: "memory")
#define PG8_BAR __builtin_amdgcn_s_barrier()
#define PG8_SCHED __builtin_amdgcn_sched_barrier(0)
    Unit cur, nxt; int ui = 0;
    if (!S.next(0, cur)) return;
    f32x4 acc[2][2][4][2];
#pragma unroll
    for (int a = 0; a < 2; ++a)
#pragma unroll
        for (int b = 0; b < 2; ++b)
#pragma unroll
            for (int m = 0; m < 4; ++m)
#pragma unroll
                for (int n = 0; n < 2; ++n) acc[a][b][m][n] = (f32x4){0.f, 0.f, 0.f, 0.f};
    bf16x8 At[4][2], B0[2][2], B1[2][2];
    const char* cA = (const char*)g.A + (size_t)cur.pm * tstepA + (size_t)cur.pn * pnA; const char* cB = (const char*)g.Bt + (size_t)cur.pn * tstepB;
    S.a_ready(cur);
    if constexpr (SP2) {
        PG8_STAGE(PG8_SB(0, 0), cB, voffB); PG8_STAGE(PG8_SB(0, 1), cB + hstepB, voffB); PG8_STAGE(PG8_SA(0, 0), cA, voffA); PG8_STAGE(PG8_SA(0, 1), cA + hstepA, voffA);
        if (wr == 1) PG8_BAR;
        PG8_WAIT_V(2); PG8_BAR;
        PG8_STAGE(PG8_SB(1, 0), cB + kstep, voffB); PG8_STAGE(PG8_SA(1, 0), cA + kstep, voffA); PG8_STAGE(PG8_SB(1, 1), cB + hstepB + kstep, voffB);
        PG8_WAIT_V(6); PG8_BAR;
    } else {
        PG8_STAGE(PG8_SB(0, 0), cB, voffB); PG8_STAGE(PG8_SA(0, 0), cA, voffA); PG8_STAGE(PG8_SB(0, 1), cB + hstepB, voffB); PG8_STAGE(PG8_SA(0, 1), cA + hstepA, voffA);
        if (wr == 1) PG8_BAR;
        PG8_WAIT_V(4); PG8_BAR;
        PG8_STAGE(PG8_SB(1, 0), cB + kstep, voffB); PG8_STAGE(PG8_SA(1, 0), cA + kstep, voffA); PG8_STAGE(PG8_SB(1, 1), cB + hstepB + kstep, voffB);
        PG8_WAIT_V(6); PG8_BAR;
    }
    for (;;) {
        const bool has_next = S.next(ui + 1, nxt);
        const char* nA = has_next ? (const char*)g.A + (size_t)nxt.pm * tstepA + (size_t)nxt.pn * pnA : cA; const char* nB = has_next ? (const char*)g.Bt + (size_t)nxt.pn * tstepB : cB;
        for (int t = 0; t < nt; t += 2) {
            const bool last = (t == nt - 2);
            const char* a1 = cA + (size_t)(t + 1) * kstep;
            const char* a2 = last ? nA : cA + (size_t)(t + 2) * kstep; const char* b2 = last ? nB : cB + (size_t)(t + 2) * kstep;
            const char* a3 = a2 + kstep; const char* b3 = b2 + kstep;
            if (last && has_next) S.a_ready(nxt);
            if constexpr (SP2) {
            PG8_LDB(B0, 0, 0); PG8_LDB(B1, 0, 1); PG8_SCHED; PG8_LDA(At, 0, 0); PG8_STAGE(PG8_SA(1, 1), a1 + hstepA, voffA);
            PG8_WAIT_V(8); PG8_WAIT_L(0); PG8_BAR; PG8_MMA(0, 0, At, B0); PG8_MMA(0, 1, At, B1); PG8_BAR; PG8_SCHED;
            PG8_LDA(At, 0, 1); PG8_STAGE(PG8_SB(0, 0), b2, voffB); PG8_STAGE(PG8_SB(0, 1), b2 + hstepB, voffB); PG8_STAGE(PG8_SA(0, 0), a2, voffA);
            PG8_WAIT_V(8); PG8_WAIT_L(0); PG8_BAR; PG8_MMA(1, 0, At, B0); PG8_MMA(1, 1, At, B1); PG8_BAR; PG8_SCHED;
            PG8_LDB(B0, 1, 0); PG8_LDB(B1, 1, 1); PG8_SCHED; PG8_LDA(At, 1, 0); PG8_STAGE(PG8_SA(0, 1), a2 + hstepA, voffA);
            PG8_WAIT_V(8); PG8_WAIT_L(0); PG8_BAR; PG8_MMA(0, 0, At, B0); PG8_MMA(0, 1, At, B1); PG8_BAR; PG8_SCHED;
            PG8_LDA(At, 1, 1); PG8_STAGE(PG8_SB(1, 0), b3, voffB); PG8_STAGE(PG8_SB(1, 1), b3 + hstepB, voffB); PG8_STAGE(PG8_SA(1, 0), a3, voffA);
            PG8_WAIT_V(8); PG8_WAIT_L(0); PG8_BAR; PG8_MMA(1, 0, At, B0); PG8_MMA(1, 1, At, B1); PG8_BAR; PG8_SCHED;
            } else {
            PG8_LDB(B0, 0, 0); PG8_SCHED; PG8_LDA(At, 0, 0); PG8_STAGE(PG8_SA(1, 1), a1 + hstepA, voffA);
            PG8_WAIT_L(8); PG8_BAR; PG8_WAIT_L(0); PG8_MMA(0, 0, At, B0); PG8_BAR; PG8_SCHED;
            PG8_LDB(B1, 0, 1); PG8_STAGE(PG8_SB(0, 0), b2, voffB);
            PG8_BAR; PG8_WAIT_L(0); PG8_MMA(0, 1, At, B1); PG8_BAR;
            PG8_LDA(At, 0, 1); PG8_STAGE(PG8_SA(0, 0), a2, voffA);
            PG8_BAR; PG8_WAIT_L(0); PG8_MMA(1, 0, At, B0); PG8_BAR; PG8_SCHED;
            PG8_STAGE(PG8_SB(0, 1), b2 + hstepB, voffB);
            PG8_WAIT_V(6); PG8_BAR; PG8_MMA(1, 1, At, B1); PG8_BAR;
            PG8_LDB(B0, 1, 0); PG8_SCHED; PG8_LDA(At, 1, 0); PG8_STAGE(PG8_SA(0, 1), a2 + hstepA, voffA);
            PG8_WAIT_L(8); PG8_BAR; PG8_WAIT_L(0); PG8_MMA(0, 0, At, B0); PG8_BAR; PG8_SCHED;
            PG8_LDB(B1, 1, 1); PG8_STAGE(PG8_SB(1, 0), b3, voffB);
            PG8_BAR; PG8_WAIT_L(0); PG8_MMA(0, 1, At, B1); PG8_BAR;
            PG8_LDA(At, 1, 1); PG8_STAGE(PG8_SA(1, 0), a3, voffA);
            PG8_BAR; PG8_WAIT_L(0); PG8_MMA(1, 0, At, B0); PG8_BAR; PG8_SCHED;
            PG8_STAGE(PG8_SB(1, 1), b3 + hstepB, voffB);
            PG8_WAIT_V(6); PG8_BAR; PG8_MMA(1, 1, At, B1); PG8_BAR;
            }
        }
        if constexpr (ALIGN_EPI) { if (wr == 0) PG8_BAR; }
        E(acc, cur, wr, wc, fr, fq); S.done(cur);
        if (!has_next) break;
#pragma unroll
        for (int a = 0; a < 2; ++a)
#pragma unroll
            for (int b = 0; b < 2; ++b)
#pragma unroll
                for (int m = 0; m < 4; ++m)
#pragma unroll
                    for (int n = 0; n < 2; ++n) acc[a][b][m][n] = (f32x4){0.f, 0.f, 0.f, 0.f};
        cur = nxt; cA = nA; cB = nB; ++ui;
        if constexpr (ALIGN_EPI) { if (wr == 1) PG8_BAR; }
    }
    PG8_WAIT_V(0);
    if constexpr (!ALIGN_EPI) { if (wr == 0) PG8_BAR; }
    PG8_BAR;
#undef PG8_SA
#undef PG8_SB
#undef PG8_STAGE
#undef PG8_LDA
#undef PG8_LDB
#undef PG8_MMA
#undef PG8_WAIT_V
#undef PG8_WAIT_L
#undef PG8_BAR
#undef PG8_SCHED
}
}

constexpr int NWAVES = 8, NTHR = NWAVES * 64;
constexpr int D = 1024, NBATCH = 4, T = 8192, M = NBATCH * T;
constexpr int A_W = 512, A_IN = 1792, IN_COLS = 3344, NP = 3584;
constexpr int C_R = 0, C_K = 512, C_V = 1024, C_WD = 1536, C_AD = 1600, C_GD = 1664;
constexpr int C_BQ = 1792, C_BK = 2048, C_BV = 2304, C_GKD = 2816, C_BG = 2832;
constexpr int NQ = 2048;
constexpr float LN_EPS = 1e-5f, GN_EPS = 64e-5f, RMS_EPS = 1e-5f;
constexpr float ALPHA = 1.189207115002721f;

typedef unsigned short bf16;
typedef float f32x4 __attribute__((ext_vector_type(4)));
typedef float f32x2 __attribute__((ext_vector_type(2)));
typedef unsigned u32x4 __attribute__((ext_vector_type(4)));
typedef unsigned u32x2 __attribute__((ext_vector_type(2)));
#define LAS __attribute__((address_space(3)))

constexpr size_t MiB = 1u << 20;
constexpr size_t WS_WIN = 1 * MiB, WS_WOUT = 8 * MiB, WS_WQ = 10 * MiB, WS_KBD = 14 * MiB;
constexpr size_t WS_W2T = 15 * MiB, WS_A2T = WS_W2T + 65536, WS_G2T = WS_A2T + 65536;
constexpr size_t WS_H0 = 16 * MiB;
constexpr size_t WS_P = 80 * MiB;
constexpr size_t WS_WL = 304 * MiB, WS_AA = 336 * MiB, WS_GG = 368 * MiB;
constexpr size_t WS_GK = 400 * MiB;
constexpr size_t WS_MIX = 416 * MiB;
constexpr size_t WS_Z = 80 * MiB;
constexpr size_t WS_H1 = 208 * MiB;
constexpr size_t WS_Q = 272 * MiB;
constexpr size_t WS_S = 80 * MiB;
constexpr size_t WS_IDS = 400 * MiB, WS_GATES = 416 * MiB;
constexpr size_t WS_UT = 432 * MiB, WS_VT = 448 * MiB;
constexpr size_t WS_SU = 464 * MiB, WS_SV = 465 * MiB;
constexpr int NSEG = 16, LSEG = 8192 / NSEG;
constexpr size_t WS_YI = WS_WL;
constexpr size_t WS_YIG = WS_GK;
constexpr size_t WS_SER = 480 * MiB;
constexpr size_t WS_SEG = 496 * MiB;
constexpr size_t WS_CEND = 504 * MiB;
constexpr size_t WS_END = 505 * MiB;

constexpr int LDS_BYTES = 147456, LDS_MISC = LDS_BYTES - 256;
constexpr size_t WS_CTL = 0, CTL_BYTES = 16384;

struct Params {
    const float* in[28];
    float* out; unsigned char* ws;
    int ph_lo, ph_hi;
};

__device__ __forceinline__ float bf2f(unsigned u) { return __uint_as_float(u << 16); }
__device__ __forceinline__ unsigned f2bf(float f) { unsigned u = __float_as_uint(f); return (u + 0x7fffu + ((u >> 16) & 1u)) >> 16; }
__device__ __forceinline__ unsigned pk2(float lo, float hi) { return f2bf(lo) | (f2bf(hi) << 16); }
#define DPP_F(v, ctrl) __builtin_bit_cast(float, __builtin_amdgcn_update_dpp(0, __builtin_bit_cast(int, (v)), (ctrl), 0xf, 0xf, false))
#define DPP_ADD(v, ctrl) ((v) + DPP_F(v, ctrl))
__device__ __forceinline__ float rlf(float v, int l) { return __builtin_bit_cast(float, __builtin_amdgcn_readlane(__builtin_bit_cast(int, v), l)); }
__device__ __forceinline__ float wave_sum_u(float v) {
    v = DPP_ADD(v, 0xB1); v = DPP_ADD(v, 0x4E); v = DPP_ADD(v, 0x141); v = DPP_ADD(v, 0x140);
    return (rlf(v, 0) + rlf(v, 16)) + (rlf(v, 32) + rlf(v, 48));
}
__device__ __forceinline__ float wave_sum(float v) { return wave_sum_u(v); }
#define DPP_I(v, ctrl) __builtin_amdgcn_update_dpp(0, (v), (ctrl), 0xf, 0xf, false)
__device__ __forceinline__ int wave_sum_i(int v) {
    v += DPP_I(v, 0xB1); v += DPP_I(v, 0x4E); v += DPP_I(v, 0x141); v += DPP_I(v, 0x140);
    return (__builtin_amdgcn_readlane(v, 0) + __builtin_amdgcn_readlane(v, 16)) + (__builtin_amdgcn_readlane(v, 32) + __builtin_amdgcn_readlane(v, 48));
}
__device__ __forceinline__ float wave_max_u(float v) {
    v = fmaxf(v, DPP_F(v, 0xB1)); v = fmaxf(v, DPP_F(v, 0x4E)); v = fmaxf(v, DPP_F(v, 0x141)); v = fmaxf(v, DPP_F(v, 0x140));
    return fmaxf(fmaxf(rlf(v, 0), rlf(v, 16)), fmaxf(rlf(v, 32), rlf(v, 48)));
}
__device__ __forceinline__ unsigned pack_i8(float a, float b, float c, float d, float inv, int off) {
    const int q0 = __float2int_rn(a * inv) + off, q1 = __float2int_rn(b * inv) + off, q2 = __float2int_rn(c * inv) + off, q3 = __float2int_rn(d * inv) + off;
    return (unsigned)(q0 & 0xff) | ((unsigned)(q1 & 0xff) << 8) | ((unsigned)(q2 & 0xff) << 16) | ((unsigned)(q3 & 0xff) << 24);
}
__device__ __forceinline__ float sigmoidf_(float x) { return 1.f / (1.f + __expf(-x)); }
__device__ __forceinline__ float softplusf_(float x) { return fmaxf(x, 0.f) + log1pf(__expf(-fabsf(x))); }
__device__ __forceinline__ float siluf_(float x) { return x * sigmoidf_(x); }

__device__ __forceinline__ void transpose_convert(const float* W, int K, int N, int Npad, bf16* WT, int gtid, int gthreads) {
    const int kc = K / 8, total = Npad * kc;
    for (int idx = gtid; idx < total; idx += gthreads) {
        const int n = idx % Npad, c = idx / Npad; float v[8];
#pragma unroll
        for (int j = 0; j < 8; ++j) v[j] = (n < N) ? W[(size_t)(8 * c + j) * N + n] : 0.f;
        u32x4 o; o.x = pk2(v[0], v[1]); o.y = pk2(v[2], v[3]); o.z = pk2(v[4], v[5]); o.w = pk2(v[6], v[7]);
        *(u32x4*)(WT + (size_t)n * K + 8 * c) = o;
    }
}
__device__ __forceinline__ void ln_row_bf16(const float* xrow, const float* g, const float* b, bf16* orow, int lane) {
    const f32x4* xr = (const f32x4*)xrow + lane; f32x4 v[4]; float s = 0.f;
#pragma unroll
    for (int j = 0; j < 4; ++j) { v[j] = xr[64 * j]; s += (v[j][0] + v[j][1]) + (v[j][2] + v[j][3]); }
    const float mean = wave_sum(s) * (1.f / D); float s2 = 0.f;
#pragma unroll
    for (int j = 0; j < 4; ++j) { v[j] = v[j] - mean; s2 += (v[j][0] * v[j][0] + v[j][1] * v[j][1]) + (v[j][2] * v[j][2] + v[j][3] * v[j][3]); }
    const float rstd = 1.f / sqrtf(wave_sum(s2) * (1.f / D) + LN_EPS);
    u32x2* o8 = (u32x2*)orow + lane;
#pragma unroll
    for (int j = 0; j < 4; ++j) { const f32x4 gg = ((const f32x4*)g)[lane + 64 * j], bb = ((const f32x4*)b)[lane + 64 * j]; const f32x4 y = v[j] * rstd * gg + bb;
        u32x2 w; w.x = pk2(y[0], y[1]); w.y = pk2(y[2], y[3]); o8[64 * j] = w; }
}
__device__ __forceinline__ void phase_prologue(const Params& P) {
    const int tid = threadIdx.x, lane = tid & 63, wave = tid >> 6;
    const int gtid = blockIdx.x * NTHR + tid, gthreads = gridDim.x * NTHR;
    unsigned char* ws = P.ws;
    transpose_convert(P.in[3], D, IN_COLS, NP, (bf16*)(ws + WS_WIN), gtid, gthreads);
    transpose_convert(P.in[19], D, D, D, (bf16*)(ws + WS_WOUT), gtid, gthreads);
    transpose_convert(P.in[22], D, NQ, NQ, (bf16*)(ws + WS_WQ), gtid, gthreads);
    transpose_convert(P.in[6], 64, A_W, A_W, (bf16*)(ws + WS_W2T), gtid, gthreads);
    transpose_convert(P.in[8], 64, A_W, A_W, (bf16*)(ws + WS_A2T), gtid, gthreads);
    transpose_convert(P.in[9], 128, A_W, A_W, (bf16*)(ws + WS_G2T), gtid, gthreads);
    {
        const float* keys = P.in[23]; bf16* kbd = (bf16*)(ws + WS_KBD);
        for (int idx = gtid; idx < 8 * 256 * 32; idx += gthreads) {
            const int kc = idx & 31, n = (idx >> 5) & 255, h = idx >> 13; const int k0 = kc * 8, hn = n >> 7, key = n & 127, hk = k0 >> 7, c0 = k0 & 127;
            u32x4 o = (u32x4){0u, 0u, 0u, 0u};
            if (hn == hk) { const float* s = keys + ((size_t)((h * 2 + hn) * 128 + key)) * 128 + c0; o.x = pk2(s[0], s[1]); o.y = pk2(s[2], s[3]); o.z = pk2(s[4], s[5]); o.w = pk2(s[6], s[7]); }
            *(u32x4*)(kbd + ((size_t)(h * 256 + n)) * 256 + k0) = o;
        }
    }
    const int gw = blockIdx.x * NWAVES + wave, ngw = gridDim.x * NWAVES;
    for (int m = gw; m < M; m += ngw) ln_row_bf16(P.in[0] + (size_t)m * D, P.in[1], P.in[2], (bf16*)(ws + WS_H0) + (size_t)m * D, lane);
}

typedef short bf16x8_t __attribute__((ext_vector_type(8)));
template <int KS, int LDA>
__device__ __forceinline__ void lora_mm(f32x4 (&acc)[4][4], const LAS bf16* ACT, const bf16* WT, int c0, int fr, int fq) {
#pragma unroll
    for (int mt = 0; mt < 4; ++mt)
#pragma unroll
        for (int nt = 0; nt < 4; ++nt) acc[mt][nt] = (f32x4){0.f, 0.f, 0.f, 0.f};
#pragma unroll
    for (int s = 0; s < KS; ++s) {
        bf16x8_t af[4], bfr[4];
#pragma unroll
        for (int mt = 0; mt < 4; ++mt) af[mt] = *(const LAS bf16x8_t*)(ACT + (mt * 16 + fr) * LDA + 32 * s + 8 * fq);
#pragma unroll
        for (int nt = 0; nt < 4; ++nt) bfr[nt] = *(const bf16x8_t*)(WT + (size_t)(c0 + nt * 16 + fr) * (32 * KS) + 32 * s + 8 * fq);
#pragma unroll
        for (int mt = 0; mt < 4; ++mt)
#pragma unroll
            for (int nt = 0; nt < 4; ++nt) acc[mt][nt] = __builtin_amdgcn_mfma_f32_16x16x32_bf16(bfr[nt], af[mt], acc[mt][nt], 0, 0, 0);
    }
}
__device__ __forceinline__ void phase_prep(const Params& P, LAS unsigned char* lds) {
    const int tid = threadIdx.x, lane = tid & 63, wave = __builtin_amdgcn_readfirstlane(tid >> 6), fr = lane & 15, fq = lane >> 4;
    unsigned char* ws = P.ws;
    const bf16* p = (const bf16*)(ws + WS_P);
    const float* mu = P.in[4]; const float* w0 = P.in[5]; const float* a0 = P.in[7];
    const float* gkw2 = P.in[16]; const float* gkb = P.in[17];
    const bf16* W2T = (const bf16*)(ws + WS_W2T); const bf16* A2T = (const bf16*)(ws + WS_A2T); const bf16* G2T = (const bf16*)(ws + WS_G2T);
    bf16* WL = (bf16*)(ws + WS_WL); bf16* AA = (bf16*)(ws + WS_AA); bf16* GG = (bf16*)(ws + WS_GG); bf16* GK = (bf16*)(ws + WS_GK);
    LAS bf16* TW = (LAS bf16*)lds; LAS bf16* AD = TW + 64 * 72; LAS bf16* SG = AD + 64 * 72;
    LAS float* gkd = (LAS float*)(SG + 64 * 136);
    const int c0 = wave * 64;
    for (int tile = blockIdx.x; tile < M / 64; tile += gridDim.x) {
        const int m0 = tile * 64;
        __syncthreads();
        for (int idx = tid; idx < 64 * 256; idx += NTHR) {
            const int j = idx & 255, tok = idx >> 8, m = m0 + tok, t = m & (T - 1);
            const float cur = bf2f(p[(size_t)m * NP + C_WD + j]);
            const float prev = (t > 0) ? bf2f(p[(size_t)(m - 1) * NP + C_WD + j]) : 0.f;
            const float x = cur + (prev - cur) * mu[C_WD + j];
            if (j < 64) TW[tok * 72 + j] = (bf16)f2bf(tanhf(x)); else if (j < 128) AD[tok * 72 + j - 64] = (bf16)f2bf(x); else SG[tok * 136 + j - 128] = (bf16)f2bf(sigmoidf_(x));
        }
        for (int idx = tid; idx < 64 * 16; idx += NTHR) { const int j = idx & 15, tok = idx >> 4; gkd[tok * 16 + j] = bf2f(p[(size_t)(m0 + tok) * NP + C_GKD + j]); }
        __syncthreads();
        f32x4 acc[4][4];
        lora_mm<2, 72>(acc, TW, W2T, c0, fr, fq);
#pragma unroll
        for (int nt = 0; nt < 4; ++nt) { const int c = c0 + nt * 16 + 4 * fq; const f32x4 b = *(const f32x4*)(w0 + c);
#pragma unroll
            for (int mt = 0; mt < 4; ++mt) { float o[4];
#pragma unroll
                for (int i = 0; i < 4; ++i) { const float z = b[i] + acc[mt][nt][i]; o[i] = -__expf(-softplusf_(-z) - 0.5f); }
                u32x2 w; w.x = pk2(o[0], o[1]); w.y = pk2(o[2], o[3]); *(u32x2*)(WL + (size_t)(m0 + mt * 16 + fr) * A_W + c) = w; } }
        lora_mm<2, 72>(acc, AD, A2T, c0, fr, fq);
#pragma unroll
        for (int nt = 0; nt < 4; ++nt) { const int c = c0 + nt * 16 + 4 * fq; const f32x4 b = *(const f32x4*)(a0 + c);
#pragma unroll
            for (int mt = 0; mt < 4; ++mt) { float o[4];
#pragma unroll
                for (int i = 0; i < 4; ++i) o[i] = sigmoidf_(b[i] + acc[mt][nt][i]);
                u32x2 w; w.x = pk2(o[0], o[1]); w.y = pk2(o[2], o[3]); *(u32x2*)(AA + (size_t)(m0 + mt * 16 + fr) * A_W + c) = w; } }
        lora_mm<4, 136>(acc, SG, G2T, c0, fr, fq);
#pragma unroll
        for (int nt = 0; nt < 4; ++nt) { const int c = c0 + nt * 16 + 4 * fq;
#pragma unroll
            for (int mt = 0; mt < 4; ++mt) { u32x2 w; w.x = pk2(acc[mt][nt][0], acc[mt][nt][1]); w.y = pk2(acc[mt][nt][2], acc[mt][nt][3]); *(u32x2*)(GG + (size_t)(m0 + mt * 16 + fr) * A_W + c) = w; } }
        { const int cc = tid & 255, th = tid >> 8; float wv[16];
#pragma unroll
          for (int j = 0; j < 16; ++j) wv[j] = gkw2[j * 256 + cc];
          const float bb = gkb[cc];
          for (int i = 0; i < 32; ++i) { const int tok = th * 32 + i; float sacc = bb;
#pragma unroll
              for (int j = 0; j < 16; ++j) sacc += gkd[tok * 16 + j] * wv[j];
              GK[(size_t)(m0 + tok) * 256 + cc] = (bf16)f2bf(-softplusf_(-sacc) * (1.f / 16.f)); } }
    }
}

constexpr int CH = 32;
__device__ __forceinline__ float red8(float v) { v = DPP_ADD(v, 0xB1); v = DPP_ADD(v, 0x4E); v = DPP_ADD(v, 0x141); return v; }
__device__ __forceinline__ float red4(float v) { v = DPP_ADD(v, 0xB1); v = DPP_ADD(v, 0x4E); return v; }

constexpr int RW_BUF = 6 * CH * 64;
__device__ __forceinline__ void rw_load(const bf16* p, const bf16* AA, const bf16* WL, int b, int t0, int col, int wave,
        unsigned (&rc)[4], unsigned (&kc)[4], unsigned (&vc)[4], unsigned (&rp)[4], unsigned (&kp)[4], unsigned (&vp)[4], unsigned (&a)[4], unsigned (&wl)[4]) {
#pragma unroll
    for (int q = 0; q < 4; ++q) {
        const int t = t0 + wave + 8 * q; const size_t m = (size_t)b * T + t; const bf16* pr = p + m * NP; const bf16* pp = (t > 0) ? pr - NP : pr;
        rc[q] = pr[C_R + col]; kc[q] = pr[C_K + col]; vc[q] = pr[C_V + col]; rp[q] = pp[C_R + col]; kp[q] = pp[C_K + col]; vp[q] = pp[C_V + col];
        a[q] = AA[m * A_W + col]; wl[q] = WL[m * A_W + col];
    }
}
__device__ __forceinline__ void rw_prep(LAS float* B, int t0, int wave, int lane, float mu_r, float mu_k, float mu_v, float kkc, float kac,
        const unsigned (&rc_)[4], const unsigned (&kc_)[4], const unsigned (&vc_)[4], const unsigned (&rp_)[4], const unsigned (&kp_)[4], const unsigned (&vp_)[4], const unsigned (&a_)[4], const unsigned (&wl_)[4]) {
    LAS float* R = B; LAS float* DEC = R + CH * 64; LAS float* KH = DEC + CH * 64; LAS float* KK = KH + CH * 64; LAS float* BB = KK + CH * 64; LAS float* V = BB + CH * 64;
#pragma unroll
    for (int q = 0; q < 4; ++q) {
        const int tt = wave + 8 * q; const float hp = (t0 + tt > 0) ? 1.f : 0.f;
        const float rc = bf2f(rc_[q]), kc = bf2f(kc_[q]), vc = bf2f(vc_[q]), rp = bf2f(rp_[q]) * hp, kp = bf2f(kp_[q]) * hp, vp = bf2f(vp_[q]) * hp;
        const float r = rc + (rp - rc) * mu_r, k = kc + (kp - kc) * mu_k, v = vc + (vp - vc) * mu_v;
        const float a = bf2f(a_[q]), wl = bf2f(wl_[q]);
        const float kr = k * kkc; const float nrm = sqrtf(wave_sum(kr * kr)); const float kk = kr / fmaxf(nrm, 1e-12f);
        const float kh = k * (1.f + (a - 1.f) * kac);
        R[tt * 64 + lane] = r; DEC[tt * 64 + lane] = __expf(wl); KH[tt * 64 + lane] = kh; KK[tt * 64 + lane] = kk; BB[tt * 64 + lane] = kk * a; V[tt * 64 + lane] = v;
    }
}
struct RwOps { f32x4 k0, k1, d0, d1, b0, b1, h0, h1, q0, q1; float v0, v1; };
__device__ __forceinline__ void rw_ops_load(RwOps& o, const LAS float* B, int tt, int s8, int vr0) {
    const LAS float* R = B; const LAS float* DEC = R + CH * 64; const LAS float* KH = DEC + CH * 64; const LAS float* KK = KH + CH * 64; const LAS float* BB = KK + CH * 64; const LAS float* V = BB + CH * 64;
    o.k0 = *(const LAS f32x4*)(KK + tt * 64 + s8); o.k1 = *(const LAS f32x4*)(KK + tt * 64 + s8 + 4);
    o.d0 = *(const LAS f32x4*)(DEC + tt * 64 + s8); o.d1 = *(const LAS f32x4*)(DEC + tt * 64 + s8 + 4);
    o.b0 = *(const LAS f32x4*)(BB + tt * 64 + s8); o.b1 = *(const LAS f32x4*)(BB + tt * 64 + s8 + 4);
    o.h0 = *(const LAS f32x4*)(KH + tt * 64 + s8); o.h1 = *(const LAS f32x4*)(KH + tt * 64 + s8 + 4);
    o.q0 = *(const LAS f32x4*)(R + tt * 64 + s8); o.q1 = *(const LAS f32x4*)(R + tt * 64 + s8 + 4);
    o.v0 = V[tt * 64 + vr0]; o.v1 = V[tt * 64 + vr0 + 1];
}
__device__ __forceinline__ void rw_step(const RwOps& o, f32x2 (&S0)[4], f32x2 (&S1)[4], float vmask, LAS float* Y, int tt, int r0, int lane) {
    const float vv0 = o.v0 * vmask, vv1 = o.v1 * vmask;
    const f32x2 kk[4] = {o.k0.lo, o.k0.hi, o.k1.lo, o.k1.hi}, dd[4] = {o.d0.lo, o.d0.hi, o.d1.lo, o.d1.hi}, bb[4] = {o.b0.lo, o.b0.hi, o.b1.lo, o.b1.hi}, hh[4] = {o.h0.lo, o.h0.hi, o.h1.lo, o.h1.hi}, rr[4] = {o.q0.lo, o.q0.hi, o.q1.lo, o.q1.hi};
    f32x2 a0 = S0[0] * kk[0], a1 = S1[0] * kk[0];
#pragma unroll
    for (int i = 1; i < 4; ++i) { a0 = S0[i] * kk[i] + a0; a1 = S1[i] * kk[i] + a1; }
    const float sa0 = -red8(a0.x + a0.y), sa1 = -red8(a1.x + a1.y);
    f32x2 y0 = (f32x2){0.f, 0.f}, y1 = (f32x2){0.f, 0.f};
#pragma unroll
    for (int i = 0; i < 4; ++i) {
        S0[i] = hh[i] * vv0 + (bb[i] * sa0 + S0[i] * dd[i]); S1[i] = hh[i] * vv1 + (bb[i] * sa1 + S1[i] * dd[i]);
        y0 = S0[i] * rr[i] + y0; y1 = S1[i] * rr[i] + y1;
    }
    const float yy0 = red8(y0.x + y0.y), yy1 = red8(y1.x + y1.y);
    if ((lane & 7) == 0) { Y[tt * 128 + r0] = yy0; Y[tt * 128 + r0 + 1] = yy1; }
}
struct GlOps { f32x4 k0, k1, d0, d1, q0, q1; float v0, v1; };
__device__ __forceinline__ void gl_ops_load(GlOps& o, const LAS float* B, int tt, int s8, int r0) {
    const LAS float* Q = B; const LAS float* K = Q + CH * 64; const LAS float* DEC = K + CH * 64; const LAS float* V = DEC + CH * 64;
    o.k0 = *(const LAS f32x4*)(K + tt * 64 + s8); o.k1 = *(const LAS f32x4*)(K + tt * 64 + s8 + 4);
    o.d0 = *(const LAS f32x4*)(DEC + tt * 64 + s8); o.d1 = *(const LAS f32x4*)(DEC + tt * 64 + s8 + 4);
    o.q0 = *(const LAS f32x4*)(Q + tt * 64 + s8); o.q1 = *(const LAS f32x4*)(Q + tt * 64 + s8 + 4);
    o.v0 = V[tt * 128 + r0]; o.v1 = V[tt * 128 + r0 + 1];
}
__device__ __forceinline__ void gl_step(const GlOps& o, f32x2 (&S0)[4], f32x2 (&S1)[4], f32x2 (&c)[4], LAS float* O, LAS float* YL, int tt, int r0, int s8, int lane, int wave) {
    const f32x2 kk[4] = {o.k0.lo, o.k0.hi, o.k1.lo, o.k1.hi}, dd[4] = {o.d0.lo, o.d0.hi, o.d1.lo, o.d1.hi}, qq[4] = {o.q0.lo, o.q0.hi, o.q1.lo, o.q1.hi};
    f32x2 y0 = (f32x2){0.f, 0.f}, y1 = (f32x2){0.f, 0.f};
#pragma unroll
    for (int i = 0; i < 4; ++i) {
        S0[i] = kk[i] * o.v0 + S0[i] * dd[i]; S1[i] = kk[i] * o.v1 + S1[i] * dd[i];
        y0 = S0[i] * qq[i] + y0; y1 = S1[i] * qq[i] + y1;
    }
    if (wave == 0) {
#pragma unroll
        for (int i = 0; i < 4; ++i) c[i] = c[i] * dd[i];
        if (lane < 8) { const f32x2 e0 = c[0] * qq[0], e1 = c[1] * qq[1], e2 = c[2] * qq[2], e3 = c[3] * qq[3];
            *(LAS f32x4*)(YL + tt * 64 + s8) = (f32x4){e0.x, e0.y, e1.x, e1.y}; *(LAS f32x4*)(YL + tt * 64 + s8 + 4) = (f32x4){e2.x, e2.y, e3.x, e3.y}; }
    }
    const float o0 = red8(y0.x + y0.y), o1 = red8(y1.x + y1.y);
    if ((lane & 7) == 0) { O[tt * 128 + r0] = o0; O[tt * 128 + r0 + 1] = o1; }
}
__device__ __forceinline__ void rwkv_item(const Params& P, LAS unsigned char* lds, int b, int h, int seg) {
    const int tid = threadIdx.x, lane = tid & 63, wave = tid >> 6;
    unsigned char* ws = P.ws;
    const bf16* p = (const bf16*)(ws + WS_P); const bf16* WL = (const bf16*)(ws + WS_WL); const bf16* AA = (const bf16*)(ws + WS_AA);
    bf16* MIX = (bf16*)(ws + WS_MIX); bf16* YI = (bf16*)(ws + WS_YI);
    const float* mu = P.in[4]; const float* k_k = P.in[10]; const float* k_a = P.in[11];
    LAS float* BUF = (LAS float*)lds; LAS float* Y = BUF + 2 * RW_BUF;
    const int col = h * 64 + lane;
    const float mu_r = mu[C_R + col], mu_k = mu[C_K + col], mu_v = mu[C_V + col], kkc = k_k[col], kac = k_a[col];
    const int r0 = wave * 16 + 2 * (lane >> 3), s8 = (lane & 7) * 8; const int ident = r0 >> 6, vr0 = r0 & 63, vr1 = vr0 + 1;
    float* SE = (float*)(ws + WS_SER) + ((((size_t)(b * 8 + h) * NSEG + seg) * 2 + ident) * 4096) + vr0 * 64 + s8;
    f32x2 S0[4], S1[4];
#pragma unroll
    for (int i = 0; i < 4; ++i) { S0[i] = (f32x2){(ident && (s8 + 2 * i == vr0)) ? 1.f : 0.f, (ident && (s8 + 2 * i + 1 == vr0)) ? 1.f : 0.f};
        S1[i] = (f32x2){(ident && (s8 + 2 * i == vr1)) ? 1.f : 0.f, (ident && (s8 + 2 * i + 1 == vr1)) ? 1.f : 0.f}; }
    const float vmask = ident ? 0.f : 1.f;
    const int tbeg = seg * LSEG;
    unsigned rc[4], kc[4], vc[4], rp[4], kp[4], vp[4], a[4], wl[4];
    __syncthreads();
    rw_load(p, AA, WL, b, tbeg, col, wave, rc, kc, vc, rp, kp, vp, a, wl);
    rw_prep(BUF, tbeg, wave, lane, mu_r, mu_k, mu_v, kkc, kac, rc, kc, vc, rp, kp, vp, a, wl);
    __syncthreads();
    for (int ci = 0; ci < LSEG / CH; ++ci) {
        const int t0 = tbeg + ci * CH; LAS float* B = BUF + (ci & 1) * RW_BUF;
        LAS float* R = B; LAS float* DEC = R + CH * 64; LAS float* KH = DEC + CH * 64; LAS float* KK = KH + CH * 64; LAS float* BB = KK + CH * 64; LAS float* V = BB + CH * 64;
        const bool more = (ci + 1 < LSEG / CH);
        if (more) rw_load(p, AA, WL, b, t0 + CH, col, wave, rc, kc, vc, rp, kp, vp, a, wl);
        { RwOps oa, ob; rw_ops_load(oa, B, 0, s8, vr0);
          for (int tt = 0; tt < CH; tt += 2) {
              rw_ops_load(ob, B, tt + 1, s8, vr0); rw_step(oa, S0, S1, vmask, Y, tt, r0, lane);
              rw_ops_load(oa, B, (tt + 2) & (CH - 1), s8, vr0); rw_step(ob, S0, S1, vmask, Y, tt + 1, r0, lane);
          } }
        __syncthreads();
        if (more) rw_prep(BUF + ((ci + 1) & 1) * RW_BUF, t0 + CH, wave, lane, mu_r, mu_k, mu_v, kkc, kac, rc, kc, vc, rp, kp, vp, a, wl);
#pragma unroll
        for (int q = 0; q < 4; ++q) {
            const int tt = wave + 8 * q; const size_t m = (size_t)b * T + t0 + tt;
            MIX[m * D + col] = (bf16)f2bf(Y[tt * 128 + lane]); YI[m * 512 + col] = (bf16)f2bf(Y[tt * 128 + 64 + lane]);
        }
        __syncthreads();
    }
    *(f32x4*)(SE) = (f32x4){S0[0].x, S0[0].y, S0[1].x, S0[1].y}; *(f32x4*)(SE + 4) = (f32x4){S0[2].x, S0[2].y, S0[3].x, S0[3].y};
    *(f32x4*)(SE + 64) = (f32x4){S1[0].x, S1[0].y, S1[1].x, S1[1].y}; *(f32x4*)(SE + 68) = (f32x4){S1[2].x, S1[2].y, S1[3].x, S1[3].y};
}

constexpr int GL_BUF = 3 * CH * 64 + CH * 128;
__device__ __forceinline__ void gl_load(const bf16* p, const bf16* GK, int b, int h, int t0, int lane, int wave, unsigned (&x)[4][4][4], unsigned (&gk)[4]) {
    const int cq = h * 64 + lane, ck = 256 + h * 64 + lane, cv0 = 512 + h * 128 + lane, cv1 = cv0 + 64;
#pragma unroll
    for (int q = 0; q < 4; ++q) {
        const int t = t0 + wave + 8 * q; const size_t m = (size_t)b * T + t;
#pragma unroll
        for (int j = 0; j < 4; ++j) { const int back = 3 - j; const bf16* pr = p + (m - (size_t)((t >= back) ? back : 0)) * NP + C_BQ;
            x[q][j][0] = pr[cq]; x[q][j][1] = pr[ck]; x[q][j][2] = pr[cv0]; x[q][j][3] = pr[cv1]; }
        gk[q] = GK[m * 256 + h * 64 + lane];
    }
}
__device__ __forceinline__ void gl_prep(LAS float* B, int t0, int wave, int lane, const float (&wq)[4], const float (&wk)[4], const float (&wv0)[4], const float (&wv1)[4],
        const unsigned (&x)[4][4][4], const unsigned (&gk)[4]) {
    LAS float* Q = B; LAS float* K = Q + CH * 64; LAS float* DEC = K + CH * 64; LAS float* V = DEC + CH * 64;
#pragma unroll
    for (int q = 0; q < 4; ++q) {
        const int tt = wave + 8 * q, t = t0 + tt; float aq = 0.f, ak = 0.f, av0 = 0.f, av1 = 0.f;
#pragma unroll
        for (int j = 0; j < 4; ++j) { const float ok = (t >= 3 - j) ? 1.f : 0.f;
            aq += wq[j] * ok * bf2f(x[q][j][0]); ak += wk[j] * ok * bf2f(x[q][j][1]); av0 += wv0[j] * ok * bf2f(x[q][j][2]); av1 += wv1[j] * ok * bf2f(x[q][j][3]); }
        Q[tt * 64 + lane] = siluf_(aq) * 0.125f; K[tt * 64 + lane] = siluf_(ak); V[tt * 128 + lane] = siluf_(av0); V[tt * 128 + 64 + lane] = siluf_(av1);
        DEC[tt * 64 + lane] = __expf(bf2f(gk[q]));
    }
}
__device__ __forceinline__ void gla_item(const Params& P, LAS unsigned char* lds, int b, int h, int seg) {
    const int tid = threadIdx.x, lane = tid & 63, wave = tid >> 6;
    unsigned char* ws = P.ws;
    const bf16* p = (const bf16*)(ws + WS_P); const bf16* GK = (const bf16*)(ws + WS_GK);
    bf16* MIX = (bf16*)(ws + WS_MIX); bf16* YIG = (bf16*)(ws + WS_YIG);
    float* SE = (float*)(ws + WS_SEG) + ((size_t)(b * 4 + h) * NSEG + seg) * 8192; float* CE = (float*)(ws + WS_CEND) + ((size_t)(b * 4 + h) * NSEG + seg) * 64;
    const float* conv = P.in[15];
    LAS float* BUF = (LAS float*)lds; LAS float* O = BUF + 2 * GL_BUF; LAS float* YL = O + CH * 128;
    const int cq = h * 64 + lane, ck = 256 + h * 64 + lane, cv0 = 512 + h * 128 + lane, cv1 = cv0 + 64;
    float wq[4], wk[4], wv0[4], wv1[4];
#pragma unroll
    for (int j = 0; j < 4; ++j) { wq[j] = conv[j * 1024 + cq]; wk[j] = conv[j * 1024 + ck]; wv0[j] = conv[j * 1024 + cv0]; wv1[j] = conv[j * 1024 + cv1]; }
    const int r0 = wave * 16 + 2 * (lane >> 3), s8 = (lane & 7) * 8;
    f32x2 S0[4], S1[4], c[4];
#pragma unroll
    for (int i = 0; i < 4; ++i) { S0[i] = (f32x2){0.f, 0.f}; S1[i] = (f32x2){0.f, 0.f}; c[i] = (f32x2){1.f, 1.f}; }
    const int tbeg = seg * LSEG;
    unsigned x[4][4][4], gk[4];
    __syncthreads();
    gl_load(p, GK, b, h, tbeg, lane, wave, x, gk);
    gl_prep(BUF, tbeg, wave, lane, wq, wk, wv0, wv1, x, gk);
    __syncthreads();
    for (int ci = 0; ci < LSEG / CH; ++ci) {
        const int t0 = tbeg + ci * CH; LAS float* B = BUF + (ci & 1) * GL_BUF;
        LAS float* Q = B; LAS float* K = Q + CH * 64; LAS float* DEC = K + CH * 64; LAS float* V = DEC + CH * 64;
        const bool more = (ci + 1 < LSEG / CH);
        if (more) gl_load(p, GK, b, h, t0 + CH, lane, wave, x, gk);
        { GlOps oa, ob; gl_ops_load(oa, B, 0, s8, r0);
          for (int tt = 0; tt < CH; tt += 2) {
              gl_ops_load(ob, B, tt + 1, s8, r0); gl_step(oa, S0, S1, c, O, YL, tt, r0, s8, lane, wave);
              gl_ops_load(oa, B, (tt + 2) & (CH - 1), s8, r0); gl_step(ob, S0, S1, c, O, YL, tt + 1, r0, s8, lane, wave);
          } }
        __syncthreads();
        if (more) gl_prep(BUF + ((ci + 1) & 1) * GL_BUF, t0 + CH, wave, lane, wq, wk, wv0, wv1, x, gk);
#pragma unroll
        for (int q = 0; q < 4; ++q) {
            const int tt = wave + 8 * q; const size_t m = (size_t)b * T + t0 + tt;
            MIX[m * D + 512 + h * 128 + lane] = (bf16)f2bf(O[tt * 128 + lane]); MIX[m * D + 512 + h * 128 + 64 + lane] = (bf16)f2bf(O[tt * 128 + 64 + lane]);
            YIG[m * 256 + h * 64 + lane] = (bf16)f2bf(YL[tt * 64 + lane]);
        }
        __syncthreads();
    }
    *(f32x4*)(SE + r0 * 64 + s8) = (f32x4){S0[0].x, S0[0].y, S0[1].x, S0[1].y}; *(f32x4*)(SE + r0 * 64 + s8 + 4) = (f32x4){S0[2].x, S0[2].y, S0[3].x, S0[3].y};
    *(f32x4*)(SE + (r0 + 1) * 64 + s8) = (f32x4){S1[0].x, S1[0].y, S1[1].x, S1[1].y}; *(f32x4*)(SE + (r0 + 1) * 64 + s8 + 4) = (f32x4){S1[2].x, S1[2].y, S1[3].x, S1[3].y};
    if (wave == 0 && lane < 8) { *(f32x4*)(CE + s8) = (f32x4){c[0].x, c[0].y, c[1].x, c[1].y}; *(f32x4*)(CE + s8 + 4) = (f32x4){c[2].x, c[2].y, c[3].x, c[3].y}; }
}
__device__ __forceinline__ void phase_scan(const Params& P, LAS unsigned char* lds) {
    for (int it = blockIdx.x; it < 512 + 256; it += gridDim.x) {
        if (it < 512) { const int bh = it >> 4; rwkv_item(P, lds, bh >> 3, bh & 7, it & 15); }
        else { const int g = it - 512, bh = g >> 4; gla_item(P, lds, bh >> 2, bh & 3, g & 15); }
        __syncthreads();
    }
}
__device__ __forceinline__ void phase_fixup(const Params& P, LAS unsigned char* lds) {
    const int tid = threadIdx.x;
    for (int it = blockIdx.x; it < 48; it += gridDim.x) {
        if (it < 32) {
            float* SE = (float*)(P.ws + WS_SER) + (size_t)it * NSEG * 2 * 4096;
            LAS float* Sc = (LAS float*)lds; LAS float* Ph = Sc + 64 * 65;
            const int v = tid >> 3, kq = (tid & 7) * 8;
            __syncthreads();
            for (int i = tid; i < 64 * 65; i += NTHR) Sc[i] = 0.f;
            for (int seg = 0; seg < NSEG - 1; ++seg) {
                float* s0 = SE + (size_t)(seg * 2 + 0) * 4096; const float* ph = SE + (size_t)(seg * 2 + 1) * 4096;
                __syncthreads();
                for (int i = tid; i < 1024; i += NTHR) *(LAS f32x4*)(Ph + 4 * i) = *(const f32x4*)(ph + 4 * i);
                f32x4 a0 = *(const f32x4*)(s0 + v * 64 + kq), a1 = *(const f32x4*)(s0 + v * 64 + kq + 4);
                __syncthreads();
                for (int j = 0; j < 64; ++j) { const float sv = Sc[v * 65 + j]; a0 += *(const LAS f32x4*)(Ph + j * 64 + kq) * sv; a1 += *(const LAS f32x4*)(Ph + j * 64 + kq + 4) * sv; }
                __syncthreads();
#pragma unroll
                for (int i = 0; i < 4; ++i) { Sc[v * 65 + kq + i] = a0[i]; Sc[v * 65 + kq + 4 + i] = a1[i]; }
                *(f32x4*)(s0 + v * 64 + kq) = a0; *(f32x4*)(s0 + v * 64 + kq + 4) = a1;
            }
        } else {
            const int bh = it - 32; float* SE = (float*)(P.ws + WS_SEG) + (size_t)bh * NSEG * 8192; const float* CE = (const float*)(P.ws + WS_CEND) + (size_t)bh * NSEG * 64;
            const int v = tid >> 2, d0 = (tid & 3) * 16; f32x4 sc[4];
#pragma unroll
            for (int q = 0; q < 4; ++q) sc[q] = (f32x4){0.f, 0.f, 0.f, 0.f};
            for (int seg = 0; seg < NSEG - 1; ++seg) {
#pragma unroll
                for (int q = 0; q < 4; ++q) { float* sp = SE + (size_t)seg * 8192 + v * 64 + d0 + 4 * q; sc[q] = sc[q] * *(const f32x4*)(CE + seg * 64 + d0 + 4 * q) + *(const f32x4*)sp; *(f32x4*)sp = sc[q]; }
            }
        }
    }
}
__device__ __forceinline__ float row_sum16(float v) { v = DPP_ADD(v, 0xB1); v = DPP_ADD(v, 0x4E); v = DPP_ADD(v, 0x141); v = DPP_ADD(v, 0x140); return v; }
__device__ __forceinline__ bf16x8_t pack_bf16x8(const f32x4 a, const f32x4 b) {
    u32x4 w; w.x = pk2(a[0], a[1]); w.y = pk2(a[2], a[3]); w.z = pk2(b[0], b[1]); w.w = pk2(b[2], b[3]); return __builtin_bit_cast(bf16x8_t, w);
}
__device__ __forceinline__ void unpack4(const u32x2 w, float (&o)[4]) { o[0] = __uint_as_float(w.x << 16); o[1] = __uint_as_float(w.x & 0xffff0000u); o[2] = __uint_as_float(w.y << 16); o[3] = __uint_as_float(w.y & 0xffff0000u); }
__device__ __forceinline__ void phase_correct(const Params& P, LAS unsigned char* lds) {
    const int tid = threadIdx.x, lane = tid & 63, wave = __builtin_amdgcn_readfirstlane(tid >> 6), fr = lane & 15, fq = lane >> 4;
    unsigned char* ws = P.ws;
    const bf16* p = (const bf16*)(ws + WS_P); const bf16* AA = (const bf16*)(ws + WS_AA); const bf16* GG = (const bf16*)(ws + WS_GG);
    bf16* MIX = (bf16*)(ws + WS_MIX); const bf16* YI = (const bf16*)(ws + WS_YI); const bf16* YIG = (const bf16*)(ws + WS_YIG);
    const float* mu = P.in[4]; const float* k_a = P.in[11]; const float* r_k = P.in[12]; const float* gn_g = P.in[13]; const float* gn_b = P.in[14]; const float* norm_g = P.in[18];
    LAS bf16* SB = (LAS bf16*)lds;
    for (int it = blockIdx.x; it < 512; it += gridDim.x) {
        {
            const int seg = it & 15, bh = it >> 4, b = bh >> 3, h = bh & 7;
            const int cb = h * 64 + 4 * fr;
            __syncthreads();
            if (seg > 0) { const float* ss = (const float*)(ws + WS_SER) + (((size_t)bh * NSEG + (seg - 1)) * 2) * 4096;
                for (int i = tid; i < 1024; i += NTHR) { const f32x4 x = *(const f32x4*)(ss + 4 * i); const int v = i >> 4, j = (4 * i) & 63; u32x2 w; w.x = pk2(x[0], x[1]); w.y = pk2(x[2], x[3]);
                    *(LAS u32x2*)(SB + ((v & 3) * 16 + (v >> 2)) * 72 + j) = w; } }
            __syncthreads();
            const f32x4 mur = *(const f32x4*)(mu + C_R + cb), muk = *(const f32x4*)(mu + C_K + cb), muv = *(const f32x4*)(mu + C_V + cb), kac = *(const f32x4*)(k_a + cb), rkc = *(const f32x4*)(r_k + cb), gng = *(const f32x4*)(gn_g + cb), gnb = *(const f32x4*)(gn_b + cb);
            for (int mt = 0; mt < 4; ++mt) {
                const int tb = seg * LSEG + wave * 64 + mt * 16;
                f32x4 acc[4];
#pragma unroll
                for (int vt = 0; vt < 4; ++vt) acc[vt] = (f32x4){0.f, 0.f, 0.f, 0.f};
                if (seg > 0) {
#pragma unroll
                    for (int sx = 0; sx < 2; ++sx) { const bf16x8_t af = *(const bf16x8_t*)(YI + ((size_t)b * T + tb + fr) * 512 + h * 64 + 32 * sx + 8 * fq);
#pragma unroll
                        for (int vt = 0; vt < 4; ++vt) acc[vt] = __builtin_amdgcn_mfma_f32_16x16x32_bf16(af, *(const LAS bf16x8_t*)(SB + (vt * 16 + fr) * 72 + 32 * sx + 8 * fq), acc[vt], 0, 0, 0); }
                }
                u32x2 W[2][9];
#define CORR_LOAD(buf, rg) do { const int t_ = tb + 4 * fq + (rg); const size_t m_ = (size_t)b * T + t_; const bf16* pr_ = p + m_ * NP + cb; const bf16* pp_ = (t_ > 0) ? pr_ - NP : pr_; \
                    W[buf][0] = *(const u32x2*)(MIX + m_ * D + cb); W[buf][1] = *(const u32x2*)(pr_ + C_R); W[buf][2] = *(const u32x2*)(pr_ + C_K); W[buf][3] = *(const u32x2*)(pr_ + C_V); \
                    W[buf][4] = *(const u32x2*)(pp_ + C_R); W[buf][5] = *(const u32x2*)(pp_ + C_K); W[buf][6] = *(const u32x2*)(pp_ + C_V); W[buf][7] = *(const u32x2*)(AA + m_ * A_W + cb); W[buf][8] = *(const u32x2*)(GG + m_ * A_W + cb); } while (0)
                CORR_LOAD(0, 0);
#pragma unroll
                for (int rg = 0; rg < 4; ++rg) { const int t = tb + 4 * fq + rg; const size_t m = (size_t)b * T + t; const float hp = (t > 0) ? 1.f : 0.f;
                    if (rg < 3) CORR_LOAD((rg + 1) & 1, rg + 1);
                    __builtin_amdgcn_sched_barrier(0);
                    float y[4], rc[4], kc[4], vc[4], rp_[4], kp[4], vp[4], a[4], g[4];
                    unpack4(W[rg & 1][0], y); unpack4(W[rg & 1][1], rc); unpack4(W[rg & 1][2], kc); unpack4(W[rg & 1][3], vc); unpack4(W[rg & 1][4], rp_); unpack4(W[rg & 1][5], kp); unpack4(W[rg & 1][6], vp); unpack4(W[rg & 1][7], a); unpack4(W[rg & 1][8], g);
                    float v[4], sy = 0.f, sb = 0.f;
#pragma unroll
                    for (int i = 0; i < 4; ++i) { y[i] += acc[i][rg];
                        const float r = rc[i] + (rp_[i] * hp - rc[i]) * mur[i], k = kc[i] + (kp[i] * hp - kc[i]) * muk[i]; v[i] = vc[i] + (vp[i] * hp - vc[i]) * muv[i];
                        const float kh = k * (1.f + (a[i] - 1.f) * kac[i]); sb += r * kh * rkc[i]; sy += y[i]; }
                    const float bon = row_sum16(sb), mean = row_sum16(sy) * (1.f / 64.f); float sq = 0.f;
#pragma unroll
                    for (int i = 0; i < 4; ++i) { y[i] -= mean; sq += y[i] * y[i]; }
                    const float rstd = 1.f / sqrtf(row_sum16(sq) * (1.f / 64.f) + GN_EPS); float o[4];
#pragma unroll
                    for (int i = 0; i < 4; ++i) o[i] = (y[i] * rstd * gng[i] + gnb[i] + bon * v[i]) * g[i];
                    u32x2 w; w.x = pk2(o[0], o[1]); w.y = pk2(o[2], o[3]); *(u32x2*)(MIX + m * D + cb) = w;
                    __builtin_amdgcn_sched_barrier(0); }
#undef CORR_LOAD
            }
        }
    }
    for (int g_ = blockIdx.x; g_ < 256; g_ += gridDim.x) {
        {
            const int seg = g_ & 15, bh = g_ >> 4, b = bh >> 2, h = bh & 3;
            const int cb = h * 128 + 8 * fr;
            __syncthreads();
            if (seg > 0) { const float* ss = (const float*)(ws + WS_SEG) + ((size_t)bh * NSEG + (seg - 1)) * 8192;
                for (int i = tid; i < 2048; i += NTHR) { const f32x4 x = *(const f32x4*)(ss + 4 * i); const int v = i >> 4, j = (4 * i) & 63; u32x2 w; w.x = pk2(x[0], x[1]); w.y = pk2(x[2], x[3]);
                    *(LAS u32x2*)(SB + ((v & 7) * 16 + (v >> 3)) * 72 + j) = w; } }
            __syncthreads();
            const f32x4 ng0 = *(const f32x4*)(norm_g + 8 * fr), ng1 = *(const f32x4*)(norm_g + 8 * fr + 4);
            for (int mt = 0; mt < 4; ++mt) {
                const int tb = seg * LSEG + wave * 64 + mt * 16;
                f32x4 acc[8];
#pragma unroll
                for (int vt = 0; vt < 8; ++vt) acc[vt] = (f32x4){0.f, 0.f, 0.f, 0.f};
                if (seg > 0) {
#pragma unroll
                    for (int sx = 0; sx < 2; ++sx) { const bf16x8_t af = *(const bf16x8_t*)(YIG + ((size_t)b * T + tb + fr) * 256 + h * 64 + 32 * sx + 8 * fq);
#pragma unroll
                        for (int vt = 0; vt < 8; ++vt) acc[vt] = __builtin_amdgcn_mfma_f32_16x16x32_bf16(af, *(const LAS bf16x8_t*)(SB + (vt * 16 + fr) * 72 + 32 * sx + 8 * fq), acc[vt], 0, 0, 0); }
                }
                u32x4 WG[2][2];
#define CORG_LOAD(buf, rg) do { const size_t m_ = (size_t)b * T + tb + 4 * fq + (rg); WG[buf][0] = *(const u32x4*)(MIX + m_ * D + 512 + cb); WG[buf][1] = *(const u32x4*)(p + m_ * NP + C_BG + cb); } while (0)
                CORG_LOAD(0, 0);
#pragma unroll
                for (int rg = 0; rg < 4; ++rg) { const size_t m = (size_t)b * T + tb + 4 * fq + rg;
                    if (rg < 3) CORG_LOAD((rg + 1) & 1, rg + 1);
                    __builtin_amdgcn_sched_barrier(0);
                    float o[8], g[8]; float sq = 0.f;
#pragma unroll
                    for (int i = 0; i < 4; ++i) { const unsigned a_ = WG[rg & 1][0][i], b_ = WG[rg & 1][1][i]; o[2 * i] = __uint_as_float(a_ << 16); o[2 * i + 1] = __uint_as_float(a_ & 0xffff0000u); g[2 * i] = __uint_as_float(b_ << 16); g[2 * i + 1] = __uint_as_float(b_ & 0xffff0000u); }
#pragma unroll
                    for (int i = 0; i < 8; ++i) { o[i] += acc[i][rg]; sq += o[i] * o[i]; }
                    const float rs = 1.f / sqrtf(row_sum16(sq) * (1.f / 128.f) + RMS_EPS);
                    float f[8];
#pragma unroll
                    for (int i = 0; i < 8; ++i) f[i] = o[i] * rs * (i < 4 ? ng0[i & 3] : ng1[i & 3]) * siluf_(g[i]);
                    u32x4 w; w.x = pk2(f[0], f[1]); w.y = pk2(f[2], f[3]); w.z = pk2(f[4], f[5]); w.w = pk2(f[6], f[7]); *(u32x4*)(MIX + m * D + 512 + cb) = w;
                    __builtin_amdgcn_sched_barrier(0); }
#undef CORG_LOAD
            }
        }
    }
}

__device__ __forceinline__ void phase_ln1(const Params& P) {
    const int lane = threadIdx.x & 63, wave = threadIdx.x >> 6; const int gw = blockIdx.x * NWAVES + wave, ngw = gridDim.x * NWAVES;
    for (int m = gw; m < M; m += ngw) ln_row_bf16((const float*)(P.ws + WS_Z) + (size_t)m * D, P.in[20], P.in[21], (bf16*)(P.ws + WS_H1) + (size_t)m * D, lane);
#pragma unroll
    for (int tb = 0; tb < 2; ++tb) {
        const float* src = P.in[24 + tb]; unsigned char* dst = P.ws + (tb ? WS_VT : WS_UT); float* sc = (float*)(P.ws + (tb ? WS_SV : WS_SU));
        for (int e = gw; e < 16384; e += ngw) {
            const f32x4* sp = (const f32x4*)(src + (size_t)e * D) + 4 * lane; f32x4 a[4]; float mx = 0.f;
#pragma unroll
            for (int j = 0; j < 4; ++j) { a[j] = sp[j]; mx = fmaxf(fmaxf(mx, fmaxf(fabsf(a[j][0]), fabsf(a[j][1]))), fmaxf(fabsf(a[j][2]), fabsf(a[j][3]))); }
            mx = wave_max_u(mx); const float inv = mx > 0.f ? 127.f / mx : 0.f;
            u32x4 o;
#pragma unroll
            for (int j = 0; j < 4; ++j) o[j] = pack_i8(a[j][0], a[j][1], a[j][2], a[j][3], inv, tb ? 128 : 0);
            *((u32x4*)(dst + (size_t)e * D) + lane) = o;
            if (lane == 0) sc[e] = mx * (1.f / 127.f);
        }
    }
}

#define TK_INS(L, x) do { _Pragma("unroll") for (int _j = 0; _j < 16; ++_j) { const unsigned _h = max(L[_j], x); x = min(L[_j], x); L[_j] = _h; } } while (0)
__device__ __forceinline__ void topk128(const u32x4* r, unsigned (&L)[16]) {
#pragma unroll
    for (int j = 0; j < 16; ++j) L[j] = 0u;
    u32x4 cur = r[0];
    for (int c = 0; c < 16; ++c) {
        const u32x4 nxt = r[(c + 1) & 15];
        const unsigned kb = 0xFFFFu - 8u * (unsigned)c;
#pragma unroll
        for (int d = 0; d < 4; ++d) {
            unsigned w = cur[d]; const unsigned msk = ((w >> 15) & 0x00010001u) * 0xFFFFu; w ^= (msk | 0x80008000u);
            unsigned x0 = (w << 16) | (kb - 2u * d), x1 = (w & 0xFFFF0000u) | (kb - 2u * d - 1u);
            TK_INS(L, x0); TK_INS(L, x1);
        }
        cur = nxt;
    }
}
__device__ __forceinline__ void phase_topk(const Params& P) {
    const int gl = blockIdx.x * NTHR + threadIdx.x, nl = gridDim.x * NTHR;
    const bf16* Sc = (const bf16*)(P.ws + WS_S); int* IDS = (int*)(P.ws + WS_IDS); float* GATES = (float*)(P.ws + WS_GATES);
    for (int item = gl; item < M * 8; item += nl) {
        const u32x4* row = (const u32x4*)(Sc + (size_t)item * 256);
        unsigned L0[16], L1[16];
        topk128(row, L0); topk128(row + 16, L1);
        float f0[16], f1[16]; unsigned p0[16], p1[16];
#pragma unroll
        for (int i = 0; i < 16; ++i) {
            f0[i] = __uint_as_float((L0[i] & 0x80000000u) ? (L0[i] & 0x7FFF0000u) : (~L0[i] & 0xFFFF0000u)); p0[i] = (~L0[i] & 0x7Fu) << 7;
            f1[i] = __uint_as_float((L1[i] & 0x80000000u) ? (L1[i] & 0x7FFF0000u) : (~L1[i] & 0xFFFF0000u)); p1[i] = (~L1[i] & 0x7Fu);
        }
        unsigned C[16];
#pragma unroll
        for (int j = 0; j < 16; ++j) C[j] = 0u;
#pragma unroll
        for (int i = 0; i < 16; ++i)
#pragma unroll
            for (int j = 0; j < 16; ++j)
                if ((i + 1) * (j + 1) <= 16) {
                    const unsigned b = __float_as_uint(f0[i] + f1[j]); const unsigned mono = b ^ ((unsigned)((int)b >> 31) | 0x80000000u);
                    unsigned key = (mono & 0xFFFFC000u) | p0[i] | p1[j];
                    TK_INS(C, key);
                }
        float cv[16];
#pragma unroll
        for (int r = 0; r < 16; ++r) cv[r] = __uint_as_float((C[r] & 0x80000000u) ? (C[r] & 0x7FFFC000u) : (~C[r] & 0xFFFFC000u));
        const float cmax = cv[0]; float den = 0.f;
#pragma unroll
        for (int r = 0; r < 16; ++r) { cv[r] = __expf(cv[r] - cmax); den += cv[r]; }
        const float inv = 1.f / den;
        u32x4* ido = (u32x4*)(IDS + (size_t)item * 16); f32x4* go = (f32x4*)(GATES + (size_t)item * 16);
#pragma unroll
        for (int q = 0; q < 4; ++q) { u32x4 o; o.x = C[4 * q] & 0x3FFFu; o.y = C[4 * q + 1] & 0x3FFFu; o.z = C[4 * q + 2] & 0x3FFFu; o.w = C[4 * q + 3] & 0x3FFFu; ido[q] = o;
            f32x4 g; g[0] = cv[4 * q] * inv; g[1] = cv[4 * q + 1] * inv; g[2] = cv[4 * q + 2] * inv; g[3] = cv[4 * q + 3] * inv; go[q] = g; }
    }
}

typedef __bf16 bf16x2_t __attribute__((ext_vector_type(2)));
__device__ __forceinline__ float dot2bf(unsigned a, unsigned b, float c) { return __builtin_amdgcn_fdot2_f32_bf16(__builtin_bit_cast(bf16x2_t, a), __builtin_bit_cast(bf16x2_t, b), c, false); }
__device__ __forceinline__ void peer_load8(u32x4 (&buf)[8], const unsigned char* TAB, int idreg, int g, int lane) {
#pragma unroll
    for (int q = 0; q < 8; ++q) { const int id = __builtin_amdgcn_readlane(idreg, 8 * g + q); buf[q] = *((const u32x4*)(TAB + (size_t)id * D) + lane); }
}
__device__ __forceinline__ void peer_dots8(const u32x4 (&buf)[8], const u32x4& hq, int g, float& d, int lane) {
#pragma unroll
    for (int q = 0; q < 8; ++q) { int s = 0;
#pragma unroll
        for (int i = 0; i < 4; ++i) s = __builtin_amdgcn_sdot4((int)buf[q][i], (int)hq[i], s, false);
        const int tot = wave_sum_i(s);
        d = (lane == 8 * g + q) ? (float)tot : d; }
}
__device__ __forceinline__ void peer_axpy8(const u32x4 (&buf)[8], float areg, int g, float (&acc)[16]) {
#pragma unroll
    for (int q = 0; q < 8; ++q) { const float a = rlf(areg, 8 * g + q);
#pragma unroll
        for (int i = 0; i < 4; ++i) { const unsigned w = buf[q][i];
            acc[4 * i] += a * (float)(w & 0xffu); acc[4 * i + 1] += a * (float)((w >> 8) & 0xffu); acc[4 * i + 2] += a * (float)((w >> 16) & 0xffu); acc[4 * i + 3] += a * (float)(w >> 24); } }
}
__device__ __forceinline__ void phase_peer(const Params& P) {
    const int lane = threadIdx.x & 63, wave = threadIdx.x >> 6; const int gw = blockIdx.x * NWAVES + wave, ngw = gridDim.x * NWAVES;
    const bf16* H1 = (const bf16*)(P.ws + WS_H1); const int* IDS = (const int*)(P.ws + WS_IDS); const float* GATES = (const float*)(P.ws + WS_GATES);
    const unsigned char* UT = P.ws + WS_UT; const unsigned char* VT = P.ws + WS_VT; const float* SU = (const float*)(P.ws + WS_SU); const float* SV = (const float*)(P.ws + WS_SV);
    const float* g2 = P.in[26]; const float* b2 = P.in[27];
    for (int m = gw; m < M; m += ngw) {
        const u32x4* hp = (const u32x4*)(H1 + (size_t)m * D) + 2 * lane; const u32x4 hA = hp[0], hB = hp[1];
        float hv[16]; float hmx = 0.f;
#pragma unroll
        for (int i = 0; i < 4; ++i) { hv[2 * i] = __uint_as_float(hA[i] << 16); hv[2 * i + 1] = __uint_as_float(hA[i] & 0xffff0000u); hv[8 + 2 * i] = __uint_as_float(hB[i] << 16); hv[8 + 2 * i + 1] = __uint_as_float(hB[i] & 0xffff0000u); }
#pragma unroll
        for (int i = 0; i < 16; ++i) hmx = fmaxf(hmx, fabsf(hv[i]));
        hmx = wave_max_u(hmx); const float hinv = hmx > 0.f ? 127.f / hmx : 0.f, hsc = hmx * (1.f / 127.f);
        u32x4 hq;
#pragma unroll
        for (int i = 0; i < 4; ++i) hq[i] = pack_i8(hv[4 * i], hv[4 * i + 1], hv[4 * i + 2], hv[4 * i + 3], hinv, 0);
        const int id_lo = IDS[(size_t)m * 128 + lane], id_hi = IDS[(size_t)m * 128 + 64 + lane];
        const float gt_lo = GATES[(size_t)m * 128 + lane], gt_hi = GATES[(size_t)m * 128 + 64 + lane];
        const float su_lo = SU[id_lo], su_hi = SU[id_hi], sv_lo = SV[id_lo], sv_hi = SV[id_hi];
        float d_lo = 0.f, d_hi = 0.f;
        u32x4 A0[8], A1[8];
        peer_load8(A0, UT, id_lo, 0, lane);
        for (int g = 0; g < 8; g += 2) {
            peer_load8(A1, UT, id_lo, g + 1, lane); peer_dots8(A0, hq, g, d_lo, lane);
            if (g + 2 < 8) peer_load8(A0, UT, id_lo, g + 2, lane); else peer_load8(A0, UT, id_hi, 0, lane);
            peer_dots8(A1, hq, g + 1, d_lo, lane);
        }
        for (int g = 0; g < 8; g += 2) {
            peer_load8(A1, UT, id_hi, g + 1, lane); peer_dots8(A0, hq, g, d_hi, lane);
            if (g + 2 < 8) peer_load8(A0, UT, id_hi, g + 2, lane); else peer_load8(A0, VT, id_lo, 0, lane);
            peer_dots8(A1, hq, g + 1, d_hi, lane);
        }
        const float x_lo = d_lo * su_lo * hsc, x_hi = d_hi * su_hi * hsc;
        const float a_lo = 0.5f * x_lo * (1.f + erff(x_lo * 0.70710678118f)) * gt_lo * sv_lo, a_hi = 0.5f * x_hi * (1.f + erff(x_hi * 0.70710678118f)) * gt_hi * sv_hi;
        const float c0 = 128.f * wave_sum(a_lo + a_hi);
        float acc[16];
#pragma unroll
        for (int i = 0; i < 16; ++i) acc[i] = 0.f;
        for (int g = 0; g < 8; g += 2) {
            peer_load8(A1, VT, id_lo, g + 1, lane); peer_axpy8(A0, a_lo, g, acc);
            if (g + 2 < 8) peer_load8(A0, VT, id_lo, g + 2, lane); else peer_load8(A0, VT, id_hi, 0, lane);
            peer_axpy8(A1, a_lo, g + 1, acc);
        }
        for (int g = 0; g < 8; g += 2) {
            peer_load8(A1, VT, id_hi, g + 1, lane); peer_axpy8(A0, a_hi, g, acc);
            if (g + 2 < 8) peer_load8(A0, VT, id_hi, g + 2, lane);
            peer_axpy8(A1, a_hi, g + 1, acc);
        }
        float s = 0.f;
#pragma unroll
        for (int i = 0; i < 16; ++i) { acc[i] = ALPHA * hv[i] + (acc[i] - c0); s += acc[i]; }
        const float mean = wave_sum(s) * (1.f / D); float s2 = 0.f;
#pragma unroll
        for (int i = 0; i < 16; ++i) { acc[i] -= mean; s2 += acc[i] * acc[i]; }
        const float rstd = 1.f / sqrtf(wave_sum(s2) * (1.f / D) + LN_EPS);
#pragma unroll
        for (int c4 = 0; c4 < 4; ++c4) { const int e0 = 16 * lane + 4 * c4; const f32x4 gg = *(const f32x4*)(g2 + e0), bb = *(const f32x4*)(b2 + e0); f32x4 o;
#pragma unroll
            for (int j = 0; j < 4; ++j) o[j] = acc[c4 * 4 + j] * rstd * gg[j] + bb[j];
            *(f32x4*)(P.out + (size_t)m * D + e0) = o; }
    }
}

#define XB_TMO      128
#define XB_XCNT(j)  (256  + 64 * (j))
#define XB_XSUB(j)  (1280 + 64 * (j))
#define XB_XGEN(j)  (2304 + 64 * (j))
#define XB_TOP      3328
#define XB_TOPGEN   3392
#define XCD_BAR_WORDS 3456
#define XB_SPIN_CAP (1u << 18)
__device__ __forceinline__ unsigned xb_ld(unsigned* p)              { return __hip_atomic_load(p, __ATOMIC_RELAXED, __HIP_MEMORY_SCOPE_AGENT); }
__device__ __forceinline__ unsigned xb_add(unsigned* p, unsigned v) { return __hip_atomic_fetch_add(p, v, __ATOMIC_RELAXED, __HIP_MEMORY_SCOPE_AGENT); }
__device__ __forceinline__ unsigned xb_xcc_id() { return (unsigned)__builtin_amdgcn_s_getreg((3 << 11) | 20) & 0xFu; }
#define XB_SPIN(cond, bar) do { unsigned _sp = 0; while (cond) { __builtin_amdgcn_s_sleep(1); \
    if ((++_sp & 255u) == 0u) { if (xb_ld(&(bar)[XB_TMO])) break; if (_sp > XB_SPIN_CAP) { atomicAdd(&(bar)[XB_TMO], 1u); break; } } } } while (0)
struct XcdBarrier { unsigned* bar; unsigned x; volatile LAS unsigned* st; };
__device__ __forceinline__ XcdBarrier xcd_barrier_post(unsigned* bar, volatile LAS unsigned* st) {
    XcdBarrier b; b.bar = bar; b.x = xb_xcc_id(); b.st = st;
    if (threadIdx.x == 0) (void)xb_add(&bar[XB_XCNT(b.x)], 1u);
    return b;
}
__device__ __forceinline__ void xcd_barrier_complete(unsigned* bar, unsigned x, unsigned& nloc, unsigned& nx) {
    const unsigned G = gridDim.x * gridDim.y * gridDim.z;
    unsigned sum, cnt, mine, sp = 0u;
    for (;;) {
        sum = 0u; cnt = 0u; mine = 0u;
#pragma unroll
        for (unsigned j = 0; j < 16; ++j) { const unsigned c = xb_ld(&bar[XB_XCNT(j)]); sum += c; cnt += (c > 0u) ? 1u : 0u; mine = (j == x) ? c : mine; }
        if (sum == G) break;
        __builtin_amdgcn_s_sleep(1);
        if ((++sp & 255u) == 0u) { if (xb_ld(&bar[XB_TMO])) break; if (sp > XB_SPIN_CAP) { atomicAdd(&bar[XB_TMO], 1u); break; } }
    }
    nloc = mine > 0u ? mine : 1u; nx = cnt > 0u ? cnt : 1u;
}
__device__ __forceinline__ void xcd_barrier(const XcdBarrier& b) {
    asm volatile("s_waitcnt vmcnt(0)" ::: "memory");
    __syncthreads();
    if (threadIdx.x == 0) {
        unsigned* bar = b.bar;
        __builtin_amdgcn_s_waitcnt(0);
        unsigned nloc = b.st[0], nx = b.st[1];
        if (nloc == 0u) { xcd_barrier_complete(bar, b.x, nloc, nx); b.st[0] = nloc; b.st[1] = nx; }
        const unsigned old = xb_add(&bar[XB_XSUB(b.x)], 1u);
        const unsigned gen = old / nloc;
        if (old + 1u == (gen + 1u) * nloc) {
            __builtin_amdgcn_fence(__ATOMIC_RELEASE, "agent");
            asm volatile("s_waitcnt vmcnt(0)" ::: "memory");
            const unsigned og = xb_add(&bar[XB_TOP], 1u);
            const unsigned tg = og / nx;
            if (og + 1u == (tg + 1u) * nx) xb_add(&bar[XB_TOPGEN], 1u);
            else XB_SPIN(xb_ld(&bar[XB_TOPGEN]) == tg, bar);
            __builtin_amdgcn_fence(__ATOMIC_ACQUIRE, "agent");
            xb_add(&bar[XB_XGEN(b.x)], 1u);
            asm volatile("s_waitcnt vmcnt(0)" ::: "memory");
        } else {
            XB_SPIN(xb_ld(&bar[XB_XGEN(b.x)]) == gen, bar);
            __builtin_amdgcn_fence(__ATOMIC_ACQUIRE, "agent");
            asm volatile("s_waitcnt vmcnt(0)" ::: "memory");
        }
    }
    __syncthreads();
}

constexpr int N_PHASES = 12;
__global__ void __launch_bounds__(NTHR, 2) fwd_kernel(Params P) {
    extern __shared__ __attribute__((aligned(16))) unsigned char lds_raw[];
    LAS unsigned char* lds = (LAS unsigned char*)lds_raw;
    cg::grid_group grid = cg::this_grid();
    const int lo = P.ph_lo, hi = P.ph_hi;
    unsigned char* ws = P.ws;
    volatile LAS unsigned* bst = (volatile LAS unsigned*)(lds + LDS_MISC);
    if (threadIdx.x < 16) bst[threadIdx.x] = 0u;
    __syncthreads();
    const XcdBarrier bar = xcd_barrier_post((unsigned*)(ws + WS_CTL), bst);
#define IN(k) (lo <= (k) && (k) < hi)
#define SEAM(k) do { if (IN(k) && IN((k) + 1)) { if ((k) == 0) grid.sync(); else xcd_barrier(bar); } } while (0)
    if (IN(0)) phase_prologue(P);
    SEAM(0);
    if (IN(1)) {
        pg8::Gemm g{(const bf16*)(ws + WS_H0), (const bf16*)(ws + WS_WIN), M, NP, D, D, D, 0}; pg8::StaticOrder S; S.init(M, NP, gridDim.x, blockIdx.x);
        pg8::EpiBf16 E{(bf16*)(ws + WS_P), NP};
        pg8::gemm_phase<pg8::EpiBf16, pg8::StaticOrder, true, true>(lds, g, S, E);
    }
    SEAM(1);
    if (IN(2)) phase_prep(P, lds);
    SEAM(2);
    if (IN(3)) phase_scan(P, lds);
    SEAM(3);
    if (IN(4)) phase_fixup(P, lds);
    SEAM(4);
    if (IN(5)) phase_correct(P, lds);
    SEAM(5);
    if (IN(6)) {
        pg8::Gemm g{(const bf16*)(ws + WS_MIX), (const bf16*)(ws + WS_WOUT), M, D, D, D, D, 0}; pg8::StaticOrder S; S.init(M, D, gridDim.x, blockIdx.x);
        pg8::EpiResF32 E{(float*)(ws + WS_Z), (const bf16*)(ws + WS_H0), D, ALPHA};
        pg8::gemm_phase<pg8::EpiResF32, pg8::StaticOrder, true, true>(lds, g, S, E);
    }
    SEAM(6);
    if (IN(7)) phase_ln1(P);
    SEAM(7);
    if (IN(8)) {
        pg8::Gemm g{(const bf16*)(ws + WS_H1), (const bf16*)(ws + WS_WQ), M, NQ, D, D, D, 0}; pg8::StaticOrder S; S.init(M, NQ, gridDim.x, blockIdx.x);
        pg8::EpiBf16 E{(bf16*)(ws + WS_Q), NQ};
        pg8::gemm_phase<pg8::EpiBf16, pg8::StaticOrder, true, true>(lds, g, S, E);
    }
    SEAM(8);
    if (IN(9)) {
        pg8::Gemm g{(const bf16*)(ws + WS_Q), (const bf16*)(ws + WS_KBD), M, NQ, 256, NQ, 256, 256}; pg8::StaticOrder S; S.init(M, NQ, gridDim.x, blockIdx.x);
        pg8::EpiBf16 E{(bf16*)(ws + WS_S), NQ};
        pg8::gemm_phase<pg8::EpiBf16, pg8::StaticOrder, true, true>(lds, g, S, E);
    }
    SEAM(9);
    if (IN(10)) phase_topk(P);
    SEAM(10);
    if (IN(11)) phase_peer(P);
#undef IN
#undef SEAM
}

extern "C" void kernel_launch(void* const* d_in, const int* in_sizes, int n_in, void* d_out, int out_size, void* d_ws, size_t ws_size, hipStream_t stream) {
    static int grid = 0;
    if (grid == 0) {
        if (n_in != 28 || out_size != M * D || ws_size < WS_END) { fprintf(stderr, "kernel_launch: unexpected shapes (n_in %d out %d ws %zu)\n", n_in, out_size, ws_size); grid = -1; return; }
        int dev = 0, cus = 0, per_cu = 0;
        (void)hipGetDevice(&dev); (void)hipDeviceGetAttribute(&cus, hipDeviceAttributeMultiprocessorCount, dev);
        (void)hipFuncSetAttribute((const void*)fwd_kernel, hipFuncAttributeMaxDynamicSharedMemorySize, LDS_BYTES);
        (void)hipOccupancyMaxActiveBlocksPerMultiprocessor(&per_cu, (const void*)fwd_kernel, NTHR, LDS_BYTES);
        if (per_cu < 1) { fprintf(stderr, "kernel_launch: occupancy query says %d blocks per CU\n", per_cu); per_cu = 1; }
        (void)hipGetLastError();
        grid = cus;
    }
    if (grid < 0) return;
    Params p{};
    for (int i = 0; i < 28; ++i) p.in[i] = (const float*)d_in[i];
    p.out = (float*)d_out; p.ws = (unsigned char*)d_ws;
    (void)hipMemsetAsync((char*)d_ws + WS_CTL, 0, CTL_BYTES, stream);
#if MK_ONE_LAUNCH
    p.ph_lo = 0; p.ph_hi = N_PHASES;
    void* args[] = {&p};
    hipError_t e = hipLaunchCooperativeKernel((const void*)fwd_kernel, dim3(grid), dim3(NTHR), args, LDS_BYTES, stream);
    if (e != hipSuccess) fprintf(stderr, "cooperative launch failed: %s (grid %d)\n", hipGetErrorString(e), grid);
#else
    for (int ph = 0; ph < N_PHASES; ++ph) {
        p.ph_lo = ph; p.ph_hi = ph + 1;
        hipLaunchKernelGGL(fwd_kernel, dim3(grid), dim3(NTHR), LDS_BYTES, stream, p);
    }
#endif
}
```

```cpp
#include <hip/hip_runtime.h>
#include <hip/hip_cooperative_groups.h>
#include <cstdio>
#include <cstdint>
namespace cg = cooperative_groups;

#ifndef MK_ONE_LAUNCH
#define MK_ONE_LAUNCH 1
#endif

namespace pg8 {
#define PG8_LAS __attribute__((address_space(3)))
typedef unsigned short bf16_t;
typedef short bf16x8 __attribute__((ext_vector_type(8)));
typedef float f32x4 __attribute__((ext_vector_type(4)));
typedef float f32x2 __attribute__((ext_vector_type(2)));
typedef unsigned u32x4 __attribute__((ext_vector_type(4)));
typedef unsigned u32x2 __attribute__((ext_vector_type(2)));
constexpr int BM = 256, BK = 64, HALF = 128, HTB = HALF * BK * 2, STAGE_BYTES = 8 * HTB, NXCD = 8, WGM = 8;

__host__ __device__ __forceinline__ int lds_byte(int r, int c) { const int st = (r >> 4) * 2 + (c >> 5), rr = r & 15, cc = c & 31, ob = rr * 64 + cc * 2; return st * 1024 + (ob ^ (((ob >> 9) & 1) << 5)); }
__host__ __device__ __forceinline__ void stage_rc(int b, int& R, int& C) { const int st = b / 1024, sb = b % 1024, swz = sb ^ (((sb >> 9) & 1) << 5); R = (st >> 1) * 16 + swz / 64; C = (st & 1) * 32 + (swz % 64) / 2; }
__host__ __device__ __forceinline__ int perm32(int rho) { const int n = rho >> 4, i = rho & 15; return 8 * (i >> 2) + 4 * n + (i & 3); }

struct Unit { int pm, pn; };
struct Gemm { const bf16_t* A; const bf16_t* Bt; int M, N, K, lda, ldb, a_pn_koff; };

struct StaticOrder {
    int nM, nN, nwg, G, c;
    __host__ __device__ void init(int M, int N, int G_, int c_) { nM = M / BM; nN = N / BM; nwg = nM * nN; G = G_; c = c_; }
    __host__ __device__ bool next(int i, Unit& u) const {
        const long L = (long)i * G + c; if (L >= nwg) return false;
        int wgid = (int)L; { const int q = nwg / NXCD, r = nwg % NXCD, xcd = wgid % NXCD, off = wgid / NXCD; wgid = (xcd < r ? xcd * (q + 1) : r * (q + 1) + (xcd - r) * q) + off; }
        const int nig = WGM * nN, gid = wgid / nig, fm = gid * WGM, gsz = (nM - fm) < WGM ? (nM - fm) : WGM;
        u.pm = fm + ((wgid % nig) % gsz); u.pn = (wgid % nig) / gsz; return true;
    }
    __device__ __forceinline__ void a_ready(const Unit&) const {}
    __device__ __forceinline__ void done(const Unit&) const {}
};

__device__ __forceinline__ unsigned cvt_pk_bf16(float lo, float hi) { unsigned r; asm volatile("v_cvt_pk_bf16_f32 %0, %1, %2" : "=v"(r) : "v"(lo), "v"(hi)); return r; }

struct EpiBf16 {
    static constexpr bool PERM = true;
    bf16_t* O; int ldc;
    __device__ __forceinline__ void operator()(const f32x4 (&acc)[2][2][4][2], const Unit& u, int wr, int wc, int fr, int fq) const {
        const int row0 = u.pm * BM + wr * 64 + fr; const int col0 = u.pn * BM + wc * 32 + 8 * fq;
#pragma unroll
        for (int ai = 0; ai < 2; ++ai)
#pragma unroll
            for (int m = 0; m < 4; ++m) { bf16_t* rowp = O + (size_t)(row0 + ai * HALF + m * 16) * ldc + col0;
#pragma unroll
                for (int bj = 0; bj < 2; ++bj) { const f32x4 v0 = acc[ai][bj][m][0], v1 = acc[ai][bj][m][1];
                    u32x4 w; w.x = cvt_pk_bf16(v0[0], v0[1]); w.y = cvt_pk_bf16(v0[2], v0[3]); w.z = cvt_pk_bf16(v1[0], v1[1]); w.w = cvt_pk_bf16(v1[2], v1[3]);
                    *(u32x4*)(rowp + bj * HALF) = w; } }
    }
};
struct EpiResF32 {
    static constexpr bool PERM = false;
    float* Z; const bf16_t* R; int ldc; float alpha;
    __device__ __forceinline__ void operator()(const f32x4 (&acc)[2][2][4][2], const Unit& u, int wr, int wc, int fr, int fq) const {
        const int row0 = u.pm * BM + wr * 64 + fr; const int col0 = u.pn * BM + wc * 32 + 4 * fq;
#pragma unroll
        for (int ai = 0; ai < 2; ++ai)
#pragma unroll
            for (int m = 0; m < 4; ++m) { const size_t off = (size_t)(row0 + ai * HALF + m * 16) * ldc + col0;
#pragma unroll
                for (int bj = 0; bj < 2; ++bj)
#pragma unroll
                    for (int n = 0; n < 2; ++n) { const size_t o2 = off + bj * HALF + n * 16; const u32x2 rb = *(const u32x2*)(R + o2);
                        f32x4 h; h[0] = __uint_as_float(rb.x << 16); h[1] = __uint_as_float(rb.x & 0xffff0000u); h[2] = __uint_as_float(rb.y << 16); h[3] = __uint_as_float(rb.y & 0xffff0000u);
                        *(f32x4*)(Z + o2) = h * alpha + acc[ai][bj][m][n]; } }
    }
};

template <class Epi, class Sched, bool ALIGN_EPI = false, bool SP2 = false>
__device__ __forceinline__ void gemm_phase(PG8_LAS unsigned char* lds, const Gemm g, const Sched& S, const Epi& E) {
    const int tid = threadIdx.x, wid = __builtin_amdgcn_readfirstlane(tid >> 6), lane = tid & 63, wr = wid >> 2, wc = wid & 3, fr = lane & 15, fq = lane >> 4;
    const int K = g.K, nt = K / BK;
    unsigned voffA[2], voffB[2];
#pragma unroll
    for (int i = 0; i < 2; ++i) { int R, C; stage_rc(tid * 16 + i * 8192, R, C); const int Rb = Epi::PERM ? ((R & ~31) + perm32(R & 31)) : R;
        voffA[i] = (unsigned)(R * g.lda + C) * 2u; voffB[i] = (unsigned)(Rb * g.ldb + C) * 2u; }
    const size_t kstep = (size_t)(BK * 2);
    const size_t hstepA = (size_t)HALF * g.lda * 2, hstepB = (size_t)HALF * g.ldb * 2;
    const size_t tstepA = 2 * hstepA, tstepB = 2 * hstepB;
    const size_t pnA = (size_t)g.a_pn_koff * 2;
    const unsigned ldsw = (unsigned)wid * 1024u;
    const int aoff = lds_byte(wr * 64 + fr, fq * 8), boff = lds_byte(wc * 32 + fr, fq * 8);
#define PG8_SA(b, h) (((b) * 2 + (h)) * HTB)
#define PG8_SB(b, h) ((4 + (b) * 2 + (h)) * HTB)
#define PG8_STAGE(bufoff, gbase, voff) do { _Pragma("unroll") for (int _i = 0; _i < 2; ++_i) \
        __builtin_amdgcn_global_load_lds((const unsigned*)((const char*)(gbase) + (voff)[_i]), (PG8_LAS unsigned*)(lds + (bufoff) + ldsw + _i * 8192), 16, 0, 0); } while (0)
#define PG8_LDA(dst, b, h) do { _Pragma("unroll") for (int m = 0; m < 4; ++m) _Pragma("unroll") for (int k = 0; k < 2; ++k) dst[m][k] = *(const PG8_LAS bf16x8*)(lds + PG8_SA(b, h) + aoff + m * 2048 + k * 1024); } while (0)
#define PG8_LDB(dst, b, h) do { _Pragma("unroll") for (int n = 0; n < 2; ++n) _Pragma("unroll") for (int k = 0; k < 2; ++k) dst[n][k] = *(const PG8_LAS bf16x8*)(lds + PG8_SB(b, h) + boff + n * 2048 + k * 1024); } while (0)
#define PG8_MMA(ai, bj, At, Bt) do { __builtin_amdgcn_s_setprio(1); _Pragma("unroll") for (int m = 0; m < 4; ++m) _Pragma("unroll") for (int n = 0; n < 2; ++n) _Pragma("unroll") for (int k = 0; k < 2; ++k) \
        acc[ai][bj][m][n] = __builtin_amdgcn_mfma_f32_16x16x32_bf16(Bt[n][k], At[m][k], acc[ai][bj][m][n], 0, 0, 0); __builtin_amdgcn_s_setprio(0); } while (0)
#define PG8_WAIT_V(n) asm volatile("s_waitcnt vmcnt(" #n ")" ::: "memory")
#define PG8_WAIT_L(n) asm volatile("s_waitcnt lgkmcnt(" #n ")" ::: "memory")
#define PG8_BAR __builtin_amdgcn_s_barrier()
#define PG8_SCHED __builtin_amdgcn_sched_barrier(0)
    Unit cur, nxt; int ui = 0;
    if (!S.next(0, cur)) return;
    f32x4 acc[2][2][4][2];
#pragma unroll
    for (int a = 0; a < 2; ++a)
#pragma unroll
        for (int b = 0; b < 2; ++b)
#pragma unroll
            for (int m = 0; m < 4; ++m)
#pragma unroll
                for (int n = 0; n < 2; ++n) acc[a][b][m][n] = (f32x4){0.f, 0.f, 0.f, 0.f};
    bf16x8 At[4][2], B0[2][2], B1[2][2];
    const char* cA = (const char*)g.A + (size_t)cur.pm * tstepA + (size_t)cur.pn * pnA; const char* cB = (const char*)g.Bt + (size_t)cur.pn * tstepB;
    S.a_ready(cur);
    if constexpr (SP2) {
        PG8_STAGE(PG8_SB(0, 0), cB, voffB); PG8_STAGE(PG8_SB(0, 1), cB + hstepB, voffB); PG8_STAGE(PG8_SA(0, 0), cA, voffA); PG8_STAGE(PG8_SA(0, 1), cA + hstepA, voffA);
        if (wr == 1) PG8_BAR;
        PG8_WAIT_V(2); PG8_BAR;
        PG8_STAGE(PG8_SB(1, 0), cB + kstep, voffB); PG8_STAGE(PG8_SA(1, 0), cA + kstep, voffA); PG8_STAGE(PG8_SB(1, 1), cB + hstepB + kstep, voffB);
        PG8_WAIT_V(6); PG8_BAR;
    } else {
        PG8_STAGE(PG8_SB(0, 0), cB, voffB); PG8_STAGE(PG8_SA(0, 0), cA, voffA); PG8_STAGE(PG8_SB(0, 1), cB + hstepB, voffB); PG8_STAGE(PG8_SA(0, 1), cA + hstepA, voffA);
        if (wr == 1) PG8_BAR;
        PG8_WAIT_V(4); PG8_BAR;
        PG8_STAGE(PG8_SB(1, 0), cB + kstep, voffB); PG8_STAGE(PG8_SA(1, 0), cA + kstep, voffA); PG8_STAGE(PG8_SB(1, 1), cB + hstepB + kstep, voffB);
        PG8_WAIT_V(6); PG8_BAR;
    }
    for (;;) {
        const bool has_next = S.next(ui + 1, nxt);
        const char* nA = has_next ? (const char*)g.A + (size_t)nxt.pm * tstepA + (size_t)nxt.pn * pnA : cA; const char* nB = has_next ? (const char*)g.Bt + (size_t)nxt.pn * tstepB : cB;
        for (int t = 0; t < nt; t += 2) {
            const bool last = (t == nt - 2);
            const char* a1 = cA + (size_t)(t + 1) * kstep;
            const char* a2 = last ? nA : cA + (size_t)(t + 2) * kstep; const char* b2 = last ? nB : cB + (size_t)(t + 2) * kstep;
            const char* a3 = a2 + kstep; const char* b3 = b2 + kstep;
            if (last && has_next) S.a_ready(nxt);
            if constexpr (SP2) {
            PG8_LDB(B0, 0, 0); PG8_LDB(B1, 0, 1); PG8_SCHED; PG8_LDA(At, 0, 0); PG8_STAGE(PG8_SA(1, 1), a1 + hstepA, voffA);
            PG8_WAIT_V(8); PG8_WAIT_L(0); PG8_BAR; PG8_MMA(0, 0, At, B0); PG8_MMA(0, 1, At, B1); PG8_BAR; PG8_SCHED;
            PG8_LDA(At, 0, 1); PG8_STAGE(PG8_SB(0, 0), b2, voffB); PG8_STAGE(PG8_SB(0, 1), b2 + hstepB, voffB); PG8_STAGE(PG8_SA(0, 0), a2, voffA);
            PG8_WAIT_V(8); PG8_WAIT_L(0); PG8_BAR; PG8_MMA(1, 0, At, B0); PG8_MMA(1, 1, At, B1); PG8_BAR; PG8_SCHED;
            PG8_LDB(B0, 1, 0); PG8_LDB(B1, 1, 1); PG8_SCHED; PG8_LDA(At, 1, 0); PG8_STAGE(PG8_SA(0, 1), a2 + hstepA, voffA);
            PG8_WAIT_V(8); PG8_WAIT_L(0); PG8_BAR; PG8_MMA(0, 0, At, B0); PG8_MMA(0, 1, At, B1); PG8_BAR; PG8_SCHED;
            PG8_LDA(At, 1, 1); PG8_STAGE(PG8_SB(1, 0), b3, voffB); PG8_STAGE(PG8_SB(1, 1), b3 + hstepB, voffB); PG8_STAGE(PG8_SA(1, 0), a3, voffA);
            PG8_WAIT_V(8); PG8_WAIT_L(0); PG8_BAR; PG8_MMA(1, 0, At, B0); PG8_MMA(1, 1, At, B1); PG8_BAR; PG8_SCHED;
            } else {
            PG8_LDB(B0, 0, 0); PG8_SCHED; PG8_LDA(At, 0, 0); PG8_STAGE(PG8_SA(1, 1), a1 + hstepA, voffA);
            PG8_WAIT_L(8); PG8_BAR; PG8_WAIT_L(0); PG8_MMA(0, 0, At, B0); PG8_BAR; PG8_SCHED;
            PG8_LDB(B1, 0, 1); PG8_STAGE(PG8_SB(0, 0), b2, voffB);
            PG8_BAR; PG8_WAIT_L(0); PG8_MMA(0, 1, At, B1); PG8_BAR;
            PG8_LDA(At, 0, 1); PG8_STAGE(PG8_SA(0, 0), a2, voffA);
            PG8_BAR; PG8_WAIT_L(0); PG8_MMA(1, 0, At, B0); PG8_BAR; PG8_SCHED;
            PG8_STAGE(PG8_SB(0, 1), b2 + hstepB, voffB);
            PG8_WAIT_V(6); PG8_BAR; PG8_MMA(1, 1, At, B1); PG8_BAR;
            PG8_LDB(B0, 1, 0); PG8_SCHED; PG8_LDA(At, 1, 0); PG8_STAGE(PG8_SA(0, 1), a2 + hstepA, voffA);
            PG8_WAIT_L(8); PG8_BAR; PG8_WAIT_L(0); PG8_MMA(0, 0, At, B0); PG8_BAR; PG8_SCHED;
            PG8_LDB(B1, 1, 1); PG8_STAGE(PG8_SB(1, 0), b3, voffB);
            PG8_BAR; PG8_WAIT_L(0); PG8_MMA(0, 1, At, B1); PG8_BAR;
            PG8_LDA(At, 1, 1); PG8_STAGE(PG8_SA(1, 0), a3, voffA);
            PG8_BAR; PG8_WAIT_L(0); PG8_MMA(1, 0, At, B0); PG8_BAR; PG8_SCHED;
            PG8_STAGE(PG8_SB(1, 1), b3 + hstepB, voffB);
            PG8_WAIT_V(6); PG8_BAR; PG8_MMA(1, 1, At, B1); PG8_BAR;
            }
        }
        if constexpr (ALIGN_EPI) { if (wr == 0) PG8_BAR; }
        E(acc, cur, wr, wc, fr, fq); S.done(cur);
        if (!has_next) break;
#pragma unroll
        for (int a = 0; a < 2; ++a)
#pragma unroll
            for (int b = 0; b < 2; ++b)
#pragma unroll
                for (int m = 0; m < 4; ++m)
#pragma unroll
                    for (int n = 0; n < 2; ++n) acc[a][b][m][n] = (f32x4){0.f, 0.f, 0.f, 0.f};
        cur = nxt; cA = nA; cB = nB; ++ui;
        if constexpr (ALIGN_EPI) { if (wr == 1) PG8_BAR; }
    }
    PG8_WAIT_V(0);
    if constexpr (!ALIGN_EPI) { if (wr == 0) PG8_BAR; }
    PG8_BAR;
#undef PG8_SA
#undef PG8_SB
#undef PG8_STAGE
#undef PG8_LDA
#undef PG8_LDB
#undef PG8_MMA
#undef PG8_WAIT_V
#undef PG8_WAIT_L
#undef PG8_BAR
#undef PG8_SCHED
}
}

constexpr int NWAVES = 8, NTHR = NWAVES * 64;
constexpr int D = 1024, NBATCH = 4, T = 8192, M = NBATCH * T;
constexpr int A_W = 512, A_IN = 1792, IN_COLS = 3344, NP = 3584;
constexpr int C_R = 0, C_K = 512, C_V = 1024, C_WD = 1536, C_AD = 1600, C_GD = 1664;
constexpr int C_BQ = 1792, C_BK = 2048, C_BV = 2304, C_GKD = 2816, C_BG = 2832;
constexpr int NQ = 2048;
constexpr float LN_EPS = 1e-5f, GN_EPS = 64e-5f, RMS_EPS = 1e-5f;
constexpr float ALPHA = 1.189207115002721f;

typedef unsigned short bf16;
typedef float f32x4 __attribute__((ext_vector_type(4)));
typedef float f32x2 __attribute__((ext_vector_type(2)));
typedef unsigned u32x4 __attribute__((ext_vector_type(4)));
typedef unsigned u32x2 __attribute__((ext_vector_type(2)));
#define LAS __attribute__((address_space(3)))

constexpr size_t MiB = 1u << 20;
constexpr size_t WS_WIN = 1 * MiB, WS_WOUT = 8 * MiB, WS_WQ = 10 * MiB, WS_KBD = 14 * MiB;
constexpr size_t WS_W2T = 15 * MiB, WS_A2T = WS_W2T + 65536, WS_G2T = WS_A2T + 65536;
constexpr size_t WS_H0 = 16 * MiB;
constexpr size_t WS_P = 80 * MiB;
constexpr size_t WS_WL = 304 * MiB, WS_AA = 336 * MiB, WS_GG = 368 * MiB;
constexpr size_t WS_GK = 400 * MiB;
constexpr size_t WS_MIX = 416 * MiB;
constexpr size_t WS_Z = 80 * MiB;
constexpr size_t WS_H1 = 208 * MiB;
constexpr size_t WS_Q = 272 * MiB;
constexpr size_t WS_S = 80 * MiB;
constexpr size_t WS_IDS = 400 * MiB, WS_GATES = 416 * MiB;
constexpr size_t WS_UT = 432 * MiB, WS_VT = 448 * MiB;
constexpr int ROWB = 768;
constexpr size_t WS_SU = 464 * MiB, WS_SV = 465 * MiB;
constexpr int NSEG = 16, LSEG = 8192 / NSEG;
constexpr size_t WS_YI = WS_WL;
constexpr size_t WS_YIG = WS_GK;
constexpr size_t WS_SER = 480 * MiB;
constexpr size_t WS_SEG = 496 * MiB;
constexpr size_t WS_CEND = 504 * MiB;
constexpr size_t WS_END = 505 * MiB;

constexpr int LDS_BYTES = 147456, LDS_MISC = LDS_BYTES - 256;
constexpr size_t WS_CTL = 0, CTL_BYTES = 16384;

struct Params {
    const float* in[28];
    float* out; unsigned char* ws;
    int ph_lo, ph_hi;
};

__device__ __forceinline__ float bf2f(unsigned u) { return __uint_as_float(u << 16); }
__device__ __forceinline__ unsigned f2bf(float f) { unsigned u = __float_as_uint(f); return (u + 0x7fffu + ((u >> 16) & 1u)) >> 16; }
__device__ __forceinline__ unsigned pk2(float lo, float hi) { return f2bf(lo) | (f2bf(hi) << 16); }
#define DPP_F(v, ctrl) __builtin_bit_cast(float, __builtin_amdgcn_update_dpp(0, __builtin_bit_cast(int, (v)), (ctrl), 0xf, 0xf, false))
#define DPP_ADD(v, ctrl) ((v) + DPP_F(v, ctrl))
__device__ __forceinline__ float rlf(float v, int l) { return __builtin_bit_cast(float, __builtin_amdgcn_readlane(__builtin_bit_cast(int, v), l)); }
__device__ __forceinline__ float wave_sum_u(float v) {
    v = DPP_ADD(v, 0xB1); v = DPP_ADD(v, 0x4E); v = DPP_ADD(v, 0x141); v = DPP_ADD(v, 0x140);
    return (rlf(v, 0) + rlf(v, 16)) + (rlf(v, 32) + rlf(v, 48));
}
__device__ __forceinline__ float wave_sum(float v) { return wave_sum_u(v); }
#define DPP_I(v, ctrl) __builtin_amdgcn_update_dpp(0, (v), (ctrl), 0xf, 0xf, false)
__device__ __forceinline__ int wave_sum_i(int v) {
    v += DPP_I(v, 0xB1); v += DPP_I(v, 0x4E); v += DPP_I(v, 0x141); v += DPP_I(v, 0x140);
    return (__builtin_amdgcn_readlane(v, 0) + __builtin_amdgcn_readlane(v, 16)) + (__builtin_amdgcn_readlane(v, 32) + __builtin_amdgcn_readlane(v, 48));
}
__device__ __forceinline__ float wave_max_u(float v) {
    v = fmaxf(v, DPP_F(v, 0xB1)); v = fmaxf(v, DPP_F(v, 0x4E)); v = fmaxf(v, DPP_F(v, 0x141)); v = fmaxf(v, DPP_F(v, 0x140));
    return fmaxf(fmaxf(rlf(v, 0), rlf(v, 16)), fmaxf(rlf(v, 32), rlf(v, 48)));
}
__device__ __forceinline__ unsigned pack_i8(float a, float b, float c, float d, float inv, int off) {
    const int q0 = __float2int_rn(a * inv) + off, q1 = __float2int_rn(b * inv) + off, q2 = __float2int_rn(c * inv) + off, q3 = __float2int_rn(d * inv) + off;
    return (unsigned)(q0 & 0xff) | ((unsigned)(q1 & 0xff) << 8) | ((unsigned)(q2 & 0xff) << 16) | ((unsigned)(q3 & 0xff) << 24);
}
__device__ __forceinline__ float sigmoidf_(float x) { return 1.f / (1.f + __expf(-x)); }
__device__ __forceinline__ float softplusf_(float x) { return fmaxf(x, 0.f) + log1pf(__expf(-fabsf(x))); }
__device__ __forceinline__ float siluf_(float x) { return x * sigmoidf_(x); }

__device__ __forceinline__ void transpose_convert(const float* W, int K, int N, int Npad, bf16* WT, int gtid, int gthreads) {
    const int kc = K / 8, total = Npad * kc;
    for (int idx = gtid; idx < total; idx += gthreads) {
        const int n = idx % Npad, c = idx / Npad; float v[8];
#pragma unroll
        for (int j = 0; j < 8; ++j) v[j] = (n < N) ? W[(size_t)(8 * c + j) * N + n] : 0.f;
        u32x4 o; o.x = pk2(v[0], v[1]); o.y = pk2(v[2], v[3]); o.z = pk2(v[4], v[5]); o.w = pk2(v[6], v[7]);
        *(u32x4*)(WT + (size_t)n * K + 8 * c) = o;
    }
}
__device__ __forceinline__ void ln_row_bf16(const float* xrow, const float* g, const float* b, bf16* orow, int lane) {
    const f32x4* xr = (const f32x4*)xrow + lane; f32x4 v[4]; float s = 0.f;
#pragma unroll
    for (int j = 0; j < 4; ++j) { v[j] = xr[64 * j]; s += (v[j][0] + v[j][1]) + (v[j][2] + v[j][3]); }
    const float mean = wave_sum(s) * (1.f / D); float s2 = 0.f;
#pragma unroll
    for (int j = 0; j < 4; ++j) { v[j] = v[j] - mean; s2 += (v[j][0] * v[j][0] + v[j][1] * v[j][1]) + (v[j][2] * v[j][2] + v[j][3] * v[j][3]); }
    const float rstd = 1.f / sqrtf(wave_sum(s2) * (1.f / D) + LN_EPS);
    u32x2* o8 = (u32x2*)orow + lane;
#pragma unroll
    for (int j = 0; j < 4; ++j) { const f32x4 gg = ((const f32x4*)g)[lane + 64 * j], bb = ((const f32x4*)b)[lane + 64 * j]; const f32x4 y = v[j] * rstd * gg + bb;
        u32x2 w; w.x = pk2(y[0], y[1]); w.y = pk2(y[2], y[3]); o8[64 * j] = w; }
}
__device__ __forceinline__ void phase_prologue(const Params& P) {
    const int tid = threadIdx.x, lane = tid & 63, wave = tid >> 6;
    const int gtid = blockIdx.x * NTHR + tid, gthreads = gridDim.x * NTHR;
    unsigned char* ws = P.ws;
    transpose_convert(P.in[3], D, IN_COLS, NP, (bf16*)(ws + WS_WIN), gtid, gthreads);
    transpose_convert(P.in[19], D, D, D, (bf16*)(ws + WS_WOUT), gtid, gthreads);
    transpose_convert(P.in[22], D, NQ, NQ, (bf16*)(ws + WS_WQ), gtid, gthreads);
    transpose_convert(P.in[6], 64, A_W, A_W, (bf16*)(ws + WS_W2T), gtid, gthreads);
    transpose_convert(P.in[8], 64, A_W, A_W, (bf16*)(ws + WS_A2T), gtid, gthreads);
    transpose_convert(P.in[9], 128, A_W, A_W, (bf16*)(ws + WS_G2T), gtid, gthreads);
    {
        const float* keys = P.in[23]; bf16* kbd = (bf16*)(ws + WS_KBD);
        for (int idx = gtid; idx < 8 * 256 * 32; idx += gthreads) {
            const int kc = idx & 31, n = (idx >> 5) & 255, h = idx >> 13; const int k0 = kc * 8, hn = n >> 7, key = n & 127, hk = k0 >> 7, c0 = k0 & 127;
            u32x4 o = (u32x4){0u, 0u, 0u, 0u};
            if (hn == hk) { const float* s = keys + ((size_t)((h * 2 + hn) * 128 + key)) * 128 + c0; o.x = pk2(s[0], s[1]); o.y = pk2(s[2], s[3]); o.z = pk2(s[4], s[5]); o.w = pk2(s[6], s[7]); }
            *(u32x4*)(kbd + ((size_t)(h * 256 + n)) * 256 + k0) = o;
        }
    }
    const int gw = blockIdx.x * NWAVES + wave, ngw = gridDim.x * NWAVES;
    for (int m = gw; m < M; m += ngw) ln_row_bf16(P.in[0] + (size_t)m * D, P.in[1], P.in[2], (bf16*)(ws + WS_H0) + (size_t)m * D, lane);
}

typedef short bf16x8_t __attribute__((ext_vector_type(8)));
template <int KS, int LDA>
__device__ __forceinline__ void lora_mm(f32x4 (&acc)[4][4], const LAS bf16* ACT, const bf16* WT, int c0, int fr, int fq) {
#pragma unroll
    for (int mt = 0; mt < 4; ++mt)
#pragma unroll
        for (int nt = 0; nt < 4; ++nt) acc[mt][nt] = (f32x4){0.f, 0.f, 0.f, 0.f};
#pragma unroll
    for (int s = 0; s < KS; ++s) {
        bf16x8_t af[4], bfr[4];
#pragma unroll
        for (int mt = 0; mt < 4; ++mt) af[mt] = *(const LAS bf16x8_t*)(ACT + (mt * 16 + fr) * LDA + 32 * s + 8 * fq);
#pragma unroll
        for (int nt = 0; nt < 4; ++nt) bfr[nt] = *(const bf16x8_t*)(WT + (size_t)(c0 + nt * 16 + fr) * (32 * KS) + 32 * s + 8 * fq);
#pragma unroll
        for (int mt = 0; mt < 4; ++mt)
#pragma unroll
            for (int nt = 0; nt < 4; ++nt) acc[mt][nt] = __builtin_amdgcn_mfma_f32_16x16x32_bf16(bfr[nt], af[mt], acc[mt][nt], 0, 0, 0);
    }
}
__device__ __forceinline__ void phase_prep(const Params& P, LAS unsigned char* lds) {
    const int tid = threadIdx.x, lane = tid & 63, wave = __builtin_amdgcn_readfirstlane(tid >> 6), fr = lane & 15, fq = lane >> 4;
    unsigned char* ws = P.ws;
    const bf16* p = (const bf16*)(ws + WS_P);
    const float* mu = P.in[4]; const float* w0 = P.in[5]; const float* a0 = P.in[7];
    const float* gkw2 = P.in[16]; const float* gkb = P.in[17];
    const bf16* W2T = (const bf16*)(ws + WS_W2T); const bf16* A2T = (const bf16*)(ws + WS_A2T); const bf16* G2T = (const bf16*)(ws + WS_G2T);
    bf16* WL = (bf16*)(ws + WS_WL); bf16* AA = (bf16*)(ws + WS_AA); bf16* GG = (bf16*)(ws + WS_GG); bf16* GK = (bf16*)(ws + WS_GK);
    LAS bf16* TW = (LAS bf16*)lds; LAS bf16* AD = TW + 64 * 72; LAS bf16* SG = AD + 64 * 72;
    LAS float* gkd = (LAS float*)(SG + 64 * 136);
    const int c0 = wave * 64;
    for (int tile = blockIdx.x; tile < M / 64; tile += gridDim.x) {
        const int m0 = tile * 64;
        __syncthreads();
        for (int idx = tid; idx < 64 * 256; idx += NTHR) {
            const int j = idx & 255, tok = idx >> 8, m = m0 + tok, t = m & (T - 1);
            const float cur = bf2f(p[(size_t)m * NP + C_WD + j]);
            const float prev = (t > 0) ? bf2f(p[(size_t)(m - 1) * NP + C_WD + j]) : 0.f;
            const float x = cur + (prev - cur) * mu[C_WD + j];
            if (j < 64) TW[tok * 72 + j] = (bf16)f2bf(tanhf(x)); else if (j < 128) AD[tok * 72 + j - 64] = (bf16)f2bf(x); else SG[tok * 136 + j - 128] = (bf16)f2bf(sigmoidf_(x));
        }
        for (int idx = tid; idx < 64 * 16; idx += NTHR) { const int j = idx & 15, tok = idx >> 4; gkd[tok * 16 + j] = bf2f(p[(size_t)(m0 + tok) * NP + C_GKD + j]); }
        __syncthreads();
        f32x4 acc[4][4];
        lora_mm<2, 72>(acc, TW, W2T, c0, fr, fq);
#pragma unroll
        for (int nt = 0; nt < 4; ++nt) { const int c = c0 + nt * 16 + 4 * fq; const f32x4 b = *(const f32x4*)(w0 + c);
#pragma unroll
            for (int mt = 0; mt < 4; ++mt) { float o[4];
#pragma unroll
                for (int i = 0; i < 4; ++i) { const float z = b[i] + acc[mt][nt][i]; o[i] = -__expf(-softplusf_(-z) - 0.5f); }
                u32x2 w; w.x = pk2(o[0], o[1]); w.y = pk2(o[2], o[3]); *(u32x2*)(WL + (size_t)(m0 + mt * 16 + fr) * A_W + c) = w; } }
        lora_mm<2, 72>(acc, AD, A2T, c0, fr, fq);
#pragma unroll
        for (int nt = 0; nt < 4; ++nt) { const int c = c0 + nt * 16 + 4 * fq; const f32x4 b = *(const f32x4*)(a0 + c);
#pragma unroll
            for (int mt = 0; mt < 4; ++mt) { float o[4];
#pragma unroll
                for (int i = 0; i < 4; ++i) o[i] = sigmoidf_(b[i] + acc[mt][nt][i]);
                u32x2 w; w.x = pk2(o[0], o[1]); w.y = pk2(o[2], o[3]); *(u32x2*)(AA + (size_t)(m0 + mt * 16 + fr) * A_W + c) = w; } }
        lora_mm<4, 136>(acc, SG, G2T, c0, fr, fq);
#pragma unroll
        for (int nt = 0; nt < 4; ++nt) { const int c = c0 + nt * 16 + 4 * fq;
#pragma unroll
            for (int mt = 0; mt < 4; ++mt) { u32x2 w; w.x = pk2(acc[mt][nt][0], acc[mt][nt][1]); w.y = pk2(acc[mt][nt][2], acc[mt][nt][3]); *(u32x2*)(GG + (size_t)(m0 + mt * 16 + fr) * A_W + c) = w; } }
        { const int cc = tid & 255, th = tid >> 8; float wv[16];
#pragma unroll
          for (int j = 0; j < 16; ++j) wv[j] = gkw2[j * 256 + cc];
          const float bb = gkb[cc];
          for (int i = 0; i < 32; ++i) { const int tok = th * 32 + i; float sacc = bb;
#pragma unroll
              for (int j = 0; j < 16; ++j) sacc += gkd[tok * 16 + j] * wv[j];
              GK[(size_t)(m0 + tok) * 256 + cc] = (bf16)f2bf(-softplusf_(-sacc) * (1.f / 16.f)); } }
    }
}

constexpr int CH = 32;
__device__ __forceinline__ float red8(float v) { v = DPP_ADD(v, 0xB1); v = DPP_ADD(v, 0x4E); v = DPP_ADD(v, 0x141); return v; }
__device__ __forceinline__ float red4(float v) { v = DPP_ADD(v, 0xB1); v = DPP_ADD(v, 0x4E); return v; }

constexpr int RW_BUF = 6 * CH * 64;
__device__ __forceinline__ void rw_load(const bf16* p, const bf16* AA, const bf16* WL, int b, int t0, int col, int wave,
        unsigned (&rc)[4], unsigned (&kc)[4], unsigned (&vc)[4], unsigned (&rp)[4], unsigned (&kp)[4], unsigned (&vp)[4], unsigned (&a)[4], unsigned (&wl)[4]) {
#pragma unroll
    for (int q = 0; q < 4; ++q) {
        const int t = t0 + wave + 8 * q; const size_t m = (size_t)b * T + t; const bf16* pr = p + m * NP; const bf16* pp = (t > 0) ? pr - NP : pr;
        rc[q] = pr[C_R + col]; kc[q] = pr[C_K + col]; vc[q] = pr[C_V + col]; rp[q] = pp[C_R + col]; kp[q] = pp[C_K + col]; vp[q] = pp[C_V + col];
        a[q] = AA[m * A_W + col]; wl[q] = WL[m * A_W + col];
    }
}
__device__ __forceinline__ void rw_prep(LAS float* B, int t0, int wave, int lane, float mu_r, float mu_k, float mu_v, float kkc, float kac,
        const unsigned (&rc_)[4], const unsigned (&kc_)[4], const unsigned (&vc_)[4], const unsigned (&rp_)[4], const unsigned (&kp_)[4], const unsigned (&vp_)[4], const unsigned (&a_)[4], const unsigned (&wl_)[4]) {
    LAS float* R = B; LAS float* DEC = R + CH * 64; LAS float* KH = DEC + CH * 64; LAS float* KK = KH + CH * 64; LAS float* BB = KK + CH * 64; LAS float* V = BB + CH * 64;
#pragma unroll
    for (int q = 0; q < 4; ++q) {
        const int tt = wave + 8 * q; const float hp = (t0 + tt > 0) ? 1.f : 0.f;
        const float rc = bf2f(rc_[q]), kc = bf2f(kc_[q]), vc = bf2f(vc_[q]), rp = bf2f(rp_[q]) * hp, kp = bf2f(kp_[q]) * hp, vp = bf2f(vp_[q]) * hp;
        const float r = rc + (rp - rc) * mu_r, k = kc + (kp - kc) * mu_k, v = vc + (vp - vc) * mu_v;
        const float a = bf2f(a_[q]), wl = bf2f(wl_[q]);
        const float kr = k * kkc; const float nrm = sqrtf(wave_sum(kr * kr)); const float kk = kr / fmaxf(nrm, 1e-12f);
        const float kh = k * (1.f + (a - 1.f) * kac);
        R[tt * 64 + lane] = r; DEC[tt * 64 + lane] = __expf(wl); KH[tt * 64 + lane] = kh; KK[tt * 64 + lane] = kk; BB[tt * 64 + lane] = kk * a; V[tt * 64 + lane] = v;
    }
}
struct RwOps { f32x4 k0, k1, d0, d1, b0, b1, h0, h1, q0, q1; float v0, v1; };
__device__ __forceinline__ void rw_ops_load(RwOps& o, const LAS float* B, int tt, int s8, int vr0) {
    const LAS float* R = B; const LAS float* DEC = R + CH * 64; const LAS float* KH = DEC + CH * 64; const LAS float* KK = KH + CH * 64; const LAS float* BB = KK + CH * 64; const LAS float* V = BB + CH * 64;
    o.k0 = *(const LAS f32x4*)(KK + tt * 64 + s8); o.k1 = *(const LAS f32x4*)(KK + tt * 64 + s8 + 4);
    o.d0 = *(const LAS f32x4*)(DEC + tt * 64 + s8); o.d1 = *(const LAS f32x4*)(DEC + tt * 64 + s8 + 4);
    o.b0 = *(const LAS f32x4*)(BB + tt * 64 + s8); o.b1 = *(const LAS f32x4*)(BB + tt * 64 + s8 + 4);
    o.h0 = *(const LAS f32x4*)(KH + tt * 64 + s8); o.h1 = *(const LAS f32x4*)(KH + tt * 64 + s8 + 4);
    o.q0 = *(const LAS f32x4*)(R + tt * 64 + s8); o.q1 = *(const LAS f32x4*)(R + tt * 64 + s8 + 4);
    o.v0 = V[tt * 64 + vr0]; o.v1 = V[tt * 64 + vr0 + 1];
}
__device__ __forceinline__ void rw_step(const RwOps& o, f32x2 (&S0)[4], f32x2 (&S1)[4], float vmask, LAS float* Y, int tt, int r0, int lane) {
    const float vv0 = o.v0 * vmask, vv1 = o.v1 * vmask;
    const f32x2 kk[4] = {o.k0.lo, o.k0.hi, o.k1.lo, o.k1.hi}, dd[4] = {o.d0.lo, o.d0.hi, o.d1.lo, o.d1.hi}, bb[4] = {o.b0.lo, o.b0.hi, o.b1.lo, o.b1.hi}, hh[4] = {o.h0.lo, o.h0.hi, o.h1.lo, o.h1.hi}, rr[4] = {o.q0.lo, o.q0.hi, o.q1.lo, o.q1.hi};
    f32x2 a0 = S0[0] * kk[0], a1 = S1[0] * kk[0];
#pragma unroll
    for (int i = 1; i < 4; ++i) { a0 = S0[i] * kk[i] + a0; a1 = S1[i] * kk[i] + a1; }
    const float sa0 = -red8(a0.x + a0.y), sa1 = -red8(a1.x + a1.y);
    f32x2 y0 = (f32x2){0.f, 0.f}, y1 = (f32x2){0.f, 0.f};
#pragma unroll
    for (int i = 0; i < 4; ++i) {
        S0[i] = hh[i] * vv0 + (bb[i] * sa0 + S0[i] * dd[i]); S1[i] = hh[i] * vv1 + (bb[i] * sa1 + S1[i] * dd[i]);
        y0 = S0[i] * rr[i] + y0; y1 = S1[i] * rr[i] + y1;
    }
    const float yy0 = red8(y0.x + y0.y), yy1 = red8(y1.x + y1.y);
    if ((lane & 7) == 0) { Y[tt * 128 + r0] = yy0; Y[tt * 128 + r0 + 1] = yy1; }
}
struct GlOps { f32x4 k0, k1, d0, d1, q0, q1; float v0, v1; };
__device__ __forceinline__ void gl_ops_load(GlOps& o, const LAS float* B, int tt, int s8, int r0) {
    const LAS float* Q = B; const LAS float* K = Q + CH * 64; const LAS float* DEC = K + CH * 64; const LAS float* V = DEC + CH * 64;
    o.k0 = *(const LAS f32x4*)(K + tt * 64 + s8); o.k1 = *(const LAS f32x4*)(K + tt * 64 + s8 + 4);
    o.d0 = *(const LAS f32x4*)(DEC + tt * 64 + s8); o.d1 = *(const LAS f32x4*)(DEC + tt * 64 + s8 + 4);
    o.q0 = *(const LAS f32x4*)(Q + tt * 64 + s8); o.q1 = *(const LAS f32x4*)(Q + tt * 64 + s8 + 4);
    o.v0 = V[tt * 128 + r0]; o.v1 = V[tt * 128 + r0 + 1];
}
__device__ __forceinline__ void gl_step(const GlOps& o, f32x2 (&S0)[4], f32x2 (&S1)[4], f32x2 (&c)[4], LAS float* O, LAS float* YL, int tt, int r0, int s8, int lane, int wave) {
    const f32x2 kk[4] = {o.k0.lo, o.k0.hi, o.k1.lo, o.k1.hi}, dd[4] = {o.d0.lo, o.d0.hi, o.d1.lo, o.d1.hi}, qq[4] = {o.q0.lo, o.q0.hi, o.q1.lo, o.q1.hi};
    f32x2 y0 = (f32x2){0.f, 0.f}, y1 = (f32x2){0.f, 0.f};
#pragma unroll
    for (int i = 0; i < 4; ++i) {
        S0[i] = kk[i] * o.v0 + S0[i] * dd[i]; S1[i] = kk[i] * o.v1 + S1[i] * dd[i];
        y0 = S0[i] * qq[i] + y0; y1 = S1[i] * qq[i] + y1;
    }
    if (wave == 0) {
#pragma unroll
        for (int i = 0; i < 4; ++i) c[i] = c[i] * dd[i];
        if (lane < 8) { const f32x2 e0 = c[0] * qq[0], e1 = c[1] * qq[1], e2 = c[2] * qq[2], e3 = c[3] * qq[3];
            *(LAS f32x4*)(YL + tt * 64 + s8) = (f32x4){e0.x, e0.y, e1.x, e1.y}; *(LAS f32x4*)(YL + tt * 64 + s8 + 4) = (f32x4){e2.x, e2.y, e3.x, e3.y}; }
    }
    const float o0 = red8(y0.x + y0.y), o1 = red8(y1.x + y1.y);
    if ((lane & 7) == 0) { O[tt * 128 + r0] = o0; O[tt * 128 + r0 + 1] = o1; }
}
__device__ __forceinline__ void rwkv_item(const Params& P, LAS unsigned char* lds, int b, int h, int seg) {
    const int tid = threadIdx.x, lane = tid & 63, wave = tid >> 6;
    unsigned char* ws = P.ws;
    const bf16* p = (const bf16*)(ws + WS_P); const bf16* WL = (const bf16*)(ws + WS_WL); const bf16* AA = (const bf16*)(ws + WS_AA);
    bf16* MIX = (bf16*)(ws + WS_MIX); bf16* YI = (bf16*)(ws + WS_YI);
    const float* mu = P.in[4]; const float* k_k = P.in[10]; const float* k_a = P.in[11];
    LAS float* BUF = (LAS float*)lds; LAS float* Y = BUF + 2 * RW_BUF;
    const int col = h * 64 + lane;
    const float mu_r = mu[C_R + col], mu_k = mu[C_K + col], mu_v = mu[C_V + col], kkc = k_k[col], kac = k_a[col];
    const int r0 = wave * 16 + 2 * (lane >> 3), s8 = (lane & 7) * 8; const int ident = r0 >> 6, vr0 = r0 & 63, vr1 = vr0 + 1;
    float* SE = (float*)(ws + WS_SER) + ((((size_t)(b * 8 + h) * NSEG + seg) * 2 + ident) * 4096) + vr0 * 64 + s8;
    f32x2 S0[4], S1[4];
#pragma unroll
    for (int i = 0; i < 4; ++i) { S0[i] = (f32x2){(ident && (s8 + 2 * i == vr0)) ? 1.f : 0.f, (ident && (s8 + 2 * i + 1 == vr0)) ? 1.f : 0.f};
        S1[i] = (f32x2){(ident && (s8 + 2 * i == vr1)) ? 1.f : 0.f, (ident && (s8 + 2 * i + 1 == vr1)) ? 1.f : 0.f}; }
    const float vmask = ident ? 0.f : 1.f;
    const int tbeg = seg * LSEG;
    unsigned rc[4], kc[4], vc[4], rp[4], kp[4], vp[4], a[4], wl[4];
    __syncthreads();
    rw_load(p, AA, WL, b, tbeg, col, wave, rc, kc, vc, rp, kp, vp, a, wl);
    rw_prep(BUF, tbeg, wave, lane, mu_r, mu_k, mu_v, kkc, kac, rc, kc, vc, rp, kp, vp, a, wl);
    __syncthreads();
    for (int ci = 0; ci < LSEG / CH; ++ci) {
        const int t0 = tbeg + ci * CH; LAS float* B = BUF + (ci & 1) * RW_BUF;
        LAS float* R = B; LAS float* DEC = R + CH * 64; LAS float* KH = DEC + CH * 64; LAS float* KK = KH + CH * 64; LAS float* BB = KK + CH * 64; LAS float* V = BB + CH * 64;
        const bool more = (ci + 1 < LSEG / CH);
        if (more) rw_load(p, AA, WL, b, t0 + CH, col, wave, rc, kc, vc, rp, kp, vp, a, wl);
        { RwOps oa, ob; rw_ops_load(oa, B, 0, s8, vr0);
          for (int tt = 0; tt < CH; tt += 2) {
              rw_ops_load(ob, B, tt + 1, s8, vr0); rw_step(oa, S0, S1, vmask, Y, tt, r0, lane);
              rw_ops_load(oa, B, (tt + 2) & (CH - 1), s8, vr0); rw_step(ob, S0, S1, vmask, Y, tt + 1, r0, lane);
          } }
        __syncthreads();
        if (more) rw_prep(BUF + ((ci + 1) & 1) * RW_BUF, t0 + CH, wave, lane, mu_r, mu_k, mu_v, kkc, kac, rc, kc, vc, rp, kp, vp, a, wl);
#pragma unroll
        for (int q = 0; q < 4; ++q) {
            const int tt = wave + 8 * q; const size_t m = (size_t)b * T + t0 + tt;
            MIX[m * D + col] = (bf16)f2bf(Y[tt * 128 + lane]); YI[m * 512 + col] = (bf16)f2bf(Y[tt * 128 + 64 + lane]);
        }
        __syncthreads();
    }
    *(f32x4*)(SE) = (f32x4){S0[0].x, S0[0].y, S0[1].x, S0[1].y}; *(f32x4*)(SE + 4) = (f32x4){S0[2].x, S0[2].y, S0[3].x, S0[3].y};
    *(f32x4*)(SE + 64) = (f32x4){S1[0].x, S1[0].y, S1[1].x, S1[1].y}; *(f32x4*)(SE + 68) = (f32x4){S1[2].x, S1[2].y, S1[3].x, S1[3].y};
}

constexpr int GL_BUF = 3 * CH * 64 + CH * 128;
__device__ __forceinline__ void gl_load(const bf16* p, const bf16* GK, int b, int h, int t0, int lane, int wave, unsigned (&x)[4][4][4], unsigned (&gk)[4]) {
    const int cq = h * 64 + lane, ck = 256 + h * 64 + lane, cv0 = 512 + h * 128 + lane, cv1 = cv0 + 64;
#pragma unroll
    for (int q = 0; q < 4; ++q) {
        const int t = t0 + wave + 8 * q; const size_t m = (size_t)b * T + t;
#pragma unroll
        for (int j = 0; j < 4; ++j) { const int back = 3 - j; const bf16* pr = p + (m - (size_t)((t >= back) ? back : 0)) * NP + C_BQ;
            x[q][j][0] = pr[cq]; x[q][j][1] = pr[ck]; x[q][j][2] = pr[cv0]; x[q][j][3] = pr[cv1]; }
        gk[q] = GK[m * 256 + h * 64 + lane];
    }
}
__device__ __forceinline__ void gl_prep(LAS float* B, int t0, int wave, int lane, const float (&wq)[4], const float (&wk)[4], const float (&wv0)[4], const float (&wv1)[4],
        const unsigned (&x)[4][4][4], const unsigned (&gk)[4]) {
    LAS float* Q = B; LAS float* K = Q + CH * 64; LAS float* DEC = K + CH * 64; LAS float* V = DEC + CH * 64;
#pragma unroll
    for (int q = 0; q < 4; ++q) {
        const int tt = wave + 8 * q, t = t0 + tt; float aq = 0.f, ak = 0.f, av0 = 0.f, av1 = 0.f;
#pragma unroll
        for (int j = 0; j < 4; ++j) { const float ok = (t >= 3 - j) ? 1.f : 0.f;
            aq += wq[j] * ok * bf2f(x[q][j][0]); ak += wk[j] * ok * bf2f(x[q][j][1]); av0 += wv0[j] * ok * bf2f(x[q][j][2]); av1 += wv1[j] * ok * bf2f(x[q][j][3]); }
        Q[tt * 64 + lane] = siluf_(aq) * 0.125f; K[tt * 64 + lane] = siluf_(ak); V[tt * 128 + lane] = siluf_(av0); V[tt * 128 + 64 + lane] = siluf_(av1);
        DEC[tt * 64 + lane] = __expf(bf2f(gk[q]));
    }
}
__device__ __forceinline__ void gla_item(const Params& P, LAS unsigned char* lds, int b, int h, int seg) {
    const int tid = threadIdx.x, lane = tid & 63, wave = tid >> 6;
    unsigned char* ws = P.ws;
    const bf16* p = (const bf16*)(ws + WS_P); const bf16* GK = (const bf16*)(ws + WS_GK);
    bf16* MIX = (bf16*)(ws + WS_MIX); bf16* YIG = (bf16*)(ws + WS_YIG);
    float* SE = (float*)(ws + WS_SEG) + ((size_t)(b * 4 + h) * NSEG + seg) * 8192; float* CE = (float*)(ws + WS_CEND) + ((size_t)(b * 4 + h) * NSEG + seg) * 64;
    const float* conv = P.in[15];
    LAS float* BUF = (LAS float*)lds; LAS float* O = BUF + 2 * GL_BUF; LAS float* YL = O + CH * 128;
    const int cq = h * 64 + lane, ck = 256 + h * 64 + lane, cv0 = 512 + h * 128 + lane, cv1 = cv0 + 64;
    float wq[4], wk[4], wv0[4], wv1[4];
#pragma unroll
    for (int j = 0; j < 4; ++j) { wq[j] = conv[j * 1024 + cq]; wk[j] = conv[j * 1024 + ck]; wv0[j] = conv[j * 1024 + cv0]; wv1[j] = conv[j * 1024 + cv1]; }
    const int r0 = wave * 16 + 2 * (lane >> 3), s8 = (lane & 7) * 8;
    f32x2 S0[4], S1[4], c[4];
#pragma unroll
    for (int i = 0; i < 4; ++i) { S0[i] = (f32x2){0.f, 0.f}; S1[i] = (f32x2){0.f, 0.f}; c[i] = (f32x2){1.f, 1.f}; }
    const int tbeg = seg * LSEG;
    unsigned x[4][4][4], gk[4];
    __syncthreads();
    gl_load(p, GK, b, h, tbeg, lane, wave, x, gk);
    gl_prep(BUF, tbeg, wave, lane, wq, wk, wv0, wv1, x, gk);
    __syncthreads();
    for (int ci = 0; ci < LSEG / CH; ++ci) {
        const int t0 = tbeg + ci * CH; LAS float* B = BUF + (ci & 1) * GL_BUF;
        LAS float* Q = B; LAS float* K = Q + CH * 64; LAS float* DEC = K + CH * 64; LAS float* V = DEC + CH * 64;
        const bool more = (ci + 1 < LSEG / CH);
        if (more) gl_load(p, GK, b, h, t0 + CH, lane, wave, x, gk);
        { GlOps oa, ob; gl_ops_load(oa, B, 0, s8, r0);
          for (int tt = 0; tt < CH; tt += 2) {
              gl_ops_load(ob, B, tt + 1, s8, r0); gl_step(oa, S0, S1, c, O, YL, tt, r0, s8, lane, wave);
              gl_ops_load(oa, B, (tt + 2) & (CH - 1), s8, r0); gl_step(ob, S0, S1, c, O, YL, tt + 1, r0, s8, lane, wave);
          } }
        __syncthreads();
        if (more) gl_prep(BUF + ((ci + 1) & 1) * GL_BUF, t0 + CH, wave, lane, wq, wk, wv0, wv1, x, gk);
#pragma unroll
        for (int q = 0; q < 4; ++q) {
            const int tt = wave + 8 * q; const size_t m = (size_t)b * T + t0 + tt;
            MIX[m * D + 512 + h * 128 + lane] = (bf16)f2bf(O[tt * 128 + lane]); MIX[m * D + 512 + h * 128 + 64 + lane] = (bf16)f2bf(O[tt * 128 + 64 + lane]);
            YIG[m * 256 + h * 64 + lane] = (bf16)f2bf(YL[tt * 64 + lane]);
        }
        __syncthreads();
    }
    *(f32x4*)(SE + r0 * 64 + s8) = (f32x4){S0[0].x, S0[0].y, S0[1].x, S0[1].y}; *(f32x4*)(SE + r0 * 64 + s8 + 4) = (f32x4){S0[2].x, S0[2].y, S0[3].x, S0[3].y};
    *(f32x4*)(SE + (r0 + 1) * 64 + s8) = (f32x4){S1[0].x, S1[0].y, S1[1].x, S1[1].y}; *(f32x4*)(SE + (r0 + 1) * 64 + s8 + 4) = (f32x4){S1[2].x, S1[2].y, S1[3].x, S1[3].y};
    if (wave == 0 && lane < 8) { *(f32x4*)(CE + s8) = (f32x4){c[0].x, c[0].y, c[1].x, c[1].y}; *(f32x4*)(CE + s8 + 4) = (f32x4){c[2].x, c[2].y, c[3].x, c[3].y}; }
}
__device__ __forceinline__ void phase_scan(const Params& P, LAS unsigned char* lds) {
    for (int it = blockIdx.x; it < 512 + 256; it += gridDim.x) {
        if (it < 512) { const int bh = it >> 4; rwkv_item(P, lds, bh >> 3, bh & 7, it & 15); }
        else { const int g = it - 512, bh = g >> 4; gla_item(P, lds, bh >> 2, bh & 3, g & 15); }
        __syncthreads();
    }
}
__device__ __forceinline__ void phase_fixup(const Params& P, LAS unsigned char* lds) {
    const int tid = threadIdx.x;
    for (int it = blockIdx.x; it < 48; it += gridDim.x) {
        if (it < 32) {
            float* SE = (float*)(P.ws + WS_SER) + (size_t)it * NSEG * 2 * 4096;
            LAS float* Sc = (LAS float*)lds; LAS float* Ph = Sc + 64 * 65;
            const int v = tid >> 3, kq = (tid & 7) * 8;
            __syncthreads();
            for (int i = tid; i < 64 * 65; i += NTHR) Sc[i] = 0.f;
            for (int seg = 0; seg < NSEG - 1; ++seg) {
                float* s0 = SE + (size_t)(seg * 2 + 0) * 4096; const float* ph = SE + (size_t)(seg * 2 + 1) * 4096;
                __syncthreads();
                for (int i = tid; i < 1024; i += NTHR) *(LAS f32x4*)(Ph + 4 * i) = *(const f32x4*)(ph + 4 * i);
                f32x4 a0 = *(const f32x4*)(s0 + v * 64 + kq), a1 = *(const f32x4*)(s0 + v * 64 + kq + 4);
                __syncthreads();
                for (int j = 0; j < 64; ++j) { const float sv = Sc[v * 65 + j]; a0 += *(const LAS f32x4*)(Ph + j * 64 + kq) * sv; a1 += *(const LAS f32x4*)(Ph + j * 64 + kq + 4) * sv; }
                __syncthreads();
#pragma unroll
                for (int i = 0; i < 4; ++i) { Sc[v * 65 + kq + i] = a0[i]; Sc[v * 65 + kq + 4 + i] = a1[i]; }
                *(f32x4*)(s0 + v * 64 + kq) = a0; *(f32x4*)(s0 + v * 64 + kq + 4) = a1;
            }
        } else {
            const int bh = it - 32; float* SE = (float*)(P.ws + WS_SEG) + (size_t)bh * NSEG * 8192; const float* CE = (const float*)(P.ws + WS_CEND) + (size_t)bh * NSEG * 64;
            const int v = tid >> 2, d0 = (tid & 3) * 16; f32x4 sc[4];
#pragma unroll
            for (int q = 0; q < 4; ++q) sc[q] = (f32x4){0.f, 0.f, 0.f, 0.f};
            for (int seg = 0; seg < NSEG - 1; ++seg) {
#pragma unroll
                for (int q = 0; q < 4; ++q) { float* sp = SE + (size_t)seg * 8192 + v * 64 + d0 + 4 * q; sc[q] = sc[q] * *(const f32x4*)(CE + seg * 64 + d0 + 4 * q) + *(const f32x4*)sp; *(f32x4*)sp = sc[q]; }
            }
        }
    }
}
__device__ __forceinline__ float row_sum16(float v) { v = DPP_ADD(v, 0xB1); v = DPP_ADD(v, 0x4E); v = DPP_ADD(v, 0x141); v = DPP_ADD(v, 0x140); return v; }
__device__ __forceinline__ bf16x8_t pack_bf16x8(const f32x4 a, const f32x4 b) {
    u32x4 w; w.x = pk2(a[0], a[1]); w.y = pk2(a[2], a[3]); w.z = pk2(b[0], b[1]); w.w = pk2(b[2], b[3]); return __builtin_bit_cast(bf16x8_t, w);
}
__device__ __forceinline__ void unpack4(const u32x2 w, float (&o)[4]) { o[0] = __uint_as_float(w.x << 16); o[1] = __uint_as_float(w.x & 0xffff0000u); o[2] = __uint_as_float(w.y << 16); o[3] = __uint_as_float(w.y & 0xffff0000u); }
__device__ __forceinline__ void phase_correct(const Params& P, LAS unsigned char* lds) {
    const int tid = threadIdx.x, lane = tid & 63, wave = __builtin_amdgcn_readfirstlane(tid >> 6), fr = lane & 15, fq = lane >> 4;
    unsigned char* ws = P.ws;
    const bf16* p = (const bf16*)(ws + WS_P); const bf16* AA = (const bf16*)(ws + WS_AA); const bf16* GG = (const bf16*)(ws + WS_GG);
    bf16* MIX = (bf16*)(ws + WS_MIX); const bf16* YI = (const bf16*)(ws + WS_YI); const bf16* YIG = (const bf16*)(ws + WS_YIG);
    const float* mu = P.in[4]; const float* k_a = P.in[11]; const float* r_k = P.in[12]; const float* gn_g = P.in[13]; const float* gn_b = P.in[14]; const float* norm_g = P.in[18];
    LAS bf16* SB = (LAS bf16*)lds;
    for (int it = blockIdx.x; it < 512; it += gridDim.x) {
        {
            const int seg = it & 15, bh = it >> 4, b = bh >> 3, h = bh & 7;
            const int cb = h * 64 + 4 * fr;
            __syncthreads();
            if (seg > 0) { const float* ss = (const float*)(ws + WS_SER) + (((size_t)bh * NSEG + (seg - 1)) * 2) * 4096;
                for (int i = tid; i < 1024; i += NTHR) { const f32x4 x = *(const f32x4*)(ss + 4 * i); const int v = i >> 4, j = (4 * i) & 63; u32x2 w; w.x = pk2(x[0], x[1]); w.y = pk2(x[2], x[3]);
                    *(LAS u32x2*)(SB + ((v & 3) * 16 + (v >> 2)) * 72 + j) = w; } }
            __syncthreads();
            const f32x4 mur = *(const f32x4*)(mu + C_R + cb), muk = *(const f32x4*)(mu + C_K + cb), muv = *(const f32x4*)(mu + C_V + cb), kac = *(const f32x4*)(k_a + cb), rkc = *(const f32x4*)(r_k + cb), gng = *(const f32x4*)(gn_g + cb), gnb = *(const f32x4*)(gn_b + cb);
            for (int mt = 0; mt < 4; ++mt) {
                const int tb = seg * LSEG + wave * 64 + mt * 16;
                f32x4 acc[4];
#pragma unroll
                for (int vt = 0; vt < 4; ++vt) acc[vt] = (f32x4){0.f, 0.f, 0.f, 0.f};
                if (seg > 0) {
#pragma unroll
                    for (int sx = 0; sx < 2; ++sx) { const bf16x8_t af = *(const bf16x8_t*)(YI + ((size_t)b * T + tb + fr) * 512 + h * 64 + 32 * sx + 8 * fq);
#pragma unroll
                        for (int vt = 0; vt < 4; ++vt) acc[vt] = __builtin_amdgcn_mfma_f32_16x16x32_bf16(af, *(const LAS bf16x8_t*)(SB + (vt * 16 + fr) * 72 + 32 * sx + 8 * fq), acc[vt], 0, 0, 0); }
                }
                u32x2 W[2][9];
#define CORR_LOAD(buf, rg) do { const int t_ = tb + 4 * fq + (rg); const size_t m_ = (size_t)b * T + t_; const bf16* pr_ = p + m_ * NP + cb; const bf16* pp_ = (t_ > 0) ? pr_ - NP : pr_; \
                    W[buf][0] = *(const u32x2*)(MIX + m_ * D + cb); W[buf][1] = *(const u32x2*)(pr_ + C_R); W[buf][2] = *(const u32x2*)(pr_ + C_K); W[buf][3] = *(const u32x2*)(pr_ + C_V); \
                    W[buf][4] = *(const u32x2*)(pp_ + C_R); W[buf][5] = *(const u32x2*)(pp_ + C_K); W[buf][6] = *(const u32x2*)(pp_ + C_V); W[buf][7] = *(const u32x2*)(AA + m_ * A_W + cb); W[buf][8] = *(const u32x2*)(GG + m_ * A_W + cb); } while (0)
                CORR_LOAD(0, 0);
#pragma unroll
                for (int rg = 0; rg < 4; ++rg) { const int t = tb + 4 * fq + rg; const size_t m = (size_t)b * T + t; const float hp = (t > 0) ? 1.f : 0.f;
                    if (rg < 3) CORR_LOAD((rg + 1) & 1, rg + 1);
                    __builtin_amdgcn_sched_barrier(0);
                    float y[4], rc[4], kc[4], vc[4], rp_[4], kp[4], vp[4], a[4], g[4];
                    unpack4(W[rg & 1][0], y); unpack4(W[rg & 1][1], rc); unpack4(W[rg & 1][2], kc); unpack4(W[rg & 1][3], vc); unpack4(W[rg & 1][4], rp_); unpack4(W[rg & 1][5], kp); unpack4(W[rg & 1][6], vp); unpack4(W[rg & 1][7], a); unpack4(W[rg & 1][8], g);
                    float v[4], sy = 0.f, sb = 0.f;
#pragma unroll
                    for (int i = 0; i < 4; ++i) { y[i] += acc[i][rg];
                        const float r = rc[i] + (rp_[i] * hp - rc[i]) * mur[i], k = kc[i] + (kp[i] * hp - kc[i]) * muk[i]; v[i] = vc[i] + (vp[i] * hp - vc[i]) * muv[i];
                        const float kh = k * (1.f + (a[i] - 1.f) * kac[i]); sb += r * kh * rkc[i]; sy += y[i]; }
                    const float bon = row_sum16(sb), mean = row_sum16(sy) * (1.f / 64.f); float sq = 0.f;
#pragma unroll
                    for (int i = 0; i < 4; ++i) { y[i] -= mean; sq += y[i] * y[i]; }
                    const float rstd = 1.f / sqrtf(row_sum16(sq) * (1.f / 64.f) + GN_EPS); float o[4];
#pragma unroll
                    for (int i = 0; i < 4; ++i) o[i] = (y[i] * rstd * gng[i] + gnb[i] + bon * v[i]) * g[i];
                    u32x2 w; w.x = pk2(o[0], o[1]); w.y = pk2(o[2], o[3]); *(u32x2*)(MIX + m * D + cb) = w;
                    __builtin_amdgcn_sched_barrier(0); }
#undef CORR_LOAD
            }
        }
    }
    for (int g_ = blockIdx.x; g_ < 256; g_ += gridDim.x) {
        {
            const int seg = g_ & 15, bh = g_ >> 4, b = bh >> 2, h = bh & 3;
            const int cb = h * 128 + 8 * fr;
            __syncthreads();
            if (seg > 0) { const float* ss = (const float*)(ws + WS_SEG) + ((size_t)bh * NSEG + (seg - 1)) * 8192;
                for (int i = tid; i < 2048; i += NTHR) { const f32x4 x = *(const f32x4*)(ss + 4 * i); const int v = i >> 4, j = (4 * i) & 63; u32x2 w; w.x = pk2(x[0], x[1]); w.y = pk2(x[2], x[3]);
                    *(LAS u32x2*)(SB + ((v & 7) * 16 + (v >> 3)) * 72 + j) = w; } }
            __syncthreads();
            const f32x4 ng0 = *(const f32x4*)(norm_g + 8 * fr), ng1 = *(const f32x4*)(norm_g + 8 * fr + 4);
            for (int mt = 0; mt < 4; ++mt) {
                const int tb = seg * LSEG + wave * 64 + mt * 16;
                f32x4 acc[8];
#pragma unroll
                for (int vt = 0; vt < 8; ++vt) acc[vt] = (f32x4){0.f, 0.f, 0.f, 0.f};
                if (seg > 0) {
#pragma unroll
                    for (int sx = 0; sx < 2; ++sx) { const bf16x8_t af = *(const bf16x8_t*)(YIG + ((size_t)b * T + tb + fr) * 256 + h * 64 + 32 * sx + 8 * fq);
#pragma unroll
                        for (int vt = 0; vt < 8; ++vt) acc[vt] = __builtin_amdgcn_mfma_f32_16x16x32_bf16(af, *(const LAS bf16x8_t*)(SB + (vt * 16 + fr) * 72 + 32 * sx + 8 * fq), acc[vt], 0, 0, 0); }
                }
                u32x4 WG[2][2];
#define CORG_LOAD(buf, rg) do { const size_t m_ = (size_t)b * T + tb + 4 * fq + (rg); WG[buf][0] = *(const u32x4*)(MIX + m_ * D + 512 + cb); WG[buf][1] = *(const u32x4*)(p + m_ * NP + C_BG + cb); } while (0)
                CORG_LOAD(0, 0);
#pragma unroll
                for (int rg = 0; rg < 4; ++rg) { const size_t m = (size_t)b * T + tb + 4 * fq + rg;
                    if (rg < 3) CORG_LOAD((rg + 1) & 1, rg + 1);
                    __builtin_amdgcn_sched_barrier(0);
                    float o[8], g[8]; float sq = 0.f;
#pragma unroll
                    for (int i = 0; i < 4; ++i) { const unsigned a_ = WG[rg & 1][0][i], b_ = WG[rg & 1][1][i]; o[2 * i] = __uint_as_float(a_ << 16); o[2 * i + 1] = __uint_as_float(a_ & 0xffff0000u); g[2 * i] = __uint_as_float(b_ << 16); g[2 * i + 1] = __uint_as_float(b_ & 0xffff0000u); }
#pragma unroll
                    for (int i = 0; i < 8; ++i) { o[i] += acc[i][rg]; sq += o[i] * o[i]; }
                    const float rs = 1.f / sqrtf(row_sum16(sq) * (1.f / 128.f) + RMS_EPS);
                    float f[8];
#pragma unroll
                    for (int i = 0; i < 8; ++i) f[i] = o[i] * rs * (i < 4 ? ng0[i & 3] : ng1[i & 3]) * siluf_(g[i]);
                    u32x4 w; w.x = pk2(f[0], f[1]); w.y = pk2(f[2], f[3]); w.z = pk2(f[4], f[5]); w.w = pk2(f[6], f[7]); *(u32x4*)(MIX + m * D + 512 + cb) = w;
                    __builtin_amdgcn_sched_barrier(0); }
#undef CORG_LOAD
            }
        }
    }
}

__device__ __forceinline__ void phase_ln1(const Params& P) {
    const int lane = threadIdx.x & 63, wave = threadIdx.x >> 6; const int gw = blockIdx.x * NWAVES + wave, ngw = gridDim.x * NWAVES;
    for (int m = gw; m < M; m += ngw) ln_row_bf16((const float*)(P.ws + WS_Z) + (size_t)m * D, P.in[20], P.in[21], (bf16*)(P.ws + WS_H1) + (size_t)m * D, lane);
#pragma unroll
    for (int tb = 0; tb < 2; ++tb) {
        const float* src = P.in[24 + tb]; unsigned char* dst = P.ws + (tb ? WS_VT : WS_UT); float* sc = (float*)(P.ws + (tb ? WS_SV : WS_SU));
        for (int e = gw; e < 16384; e += ngw) {
            const f32x4* sp = (const f32x4*)(src + (size_t)e * D) + 4 * lane; f32x4 a[4]; float mx = 0.f;
#pragma unroll
            for (int j = 0; j < 4; ++j) { a[j] = sp[j]; mx = fmaxf(fmaxf(mx, fmaxf(fabsf(a[j][0]), fabsf(a[j][1]))), fmaxf(fabsf(a[j][2]), fabsf(a[j][3]))); }
            mx = wave_max_u(mx); const float inv = mx > 0.f ? 31.f / mx : 0.f;
            unsigned q[16];
#pragma unroll
            for (int i = 0; i < 16; ++i) q[i] = (unsigned)(__float2int_rn(a[i >> 2][i & 3] * inv) + 32);
            unsigned p0 = 0u, p1 = 0u, p2 = 0u;
#pragma unroll
            for (int b = 0; b < 4; ++b) {
                p0 |= ((q[b] & 15u) | ((q[4 + b] & 15u) << 4)) << (8 * b);
                p1 |= ((q[8 + b] & 15u) | ((q[12 + b] & 15u) << 4)) << (8 * b);
                p2 |= ((q[b] >> 4) | ((q[4 + b] >> 4) << 2) | ((q[8 + b] >> 4) << 4) | ((q[12 + b] >> 4) << 6)) << (8 * b);
            }
            unsigned* o = (unsigned*)(dst + (size_t)e * ROWB) + 3 * lane; o[0] = p0; o[1] = p1; o[2] = p2;
            if (lane == 0) sc[e] = mx * (1.f / 31.f);
        }
    }
}

#define TK_INS(L, x) do { _Pragma("unroll") for (int _j = 0; _j < 16; ++_j) { const unsigned _h = max(L[_j], x); x = min(L[_j], x); L[_j] = _h; } } while (0)
__device__ __forceinline__ void topk128(const u32x4* r, unsigned (&L)[16]) {
#pragma unroll
    for (int j = 0; j < 16; ++j) L[j] = 0u;
    u32x4 cur = r[0];
    for (int c = 0; c < 16; ++c) {
        const u32x4 nxt = r[(c + 1) & 15];
        const unsigned kb = 0xFFFFu - 8u * (unsigned)c;
#pragma unroll
        for (int d = 0; d < 4; ++d) {
            unsigned w = cur[d]; const unsigned msk = ((w >> 15) & 0x00010001u) * 0xFFFFu; w ^= (msk | 0x80008000u);
            unsigned x0 = (w << 16) | (kb - 2u * d), x1 = (w & 0xFFFF0000u) | (kb - 2u * d - 1u);
            TK_INS(L, x0); TK_INS(L, x1);
        }
        cur = nxt;
    }
}
__device__ __forceinline__ void phase_topk(const Params& P) {
    const int gl = blockIdx.x * NTHR + threadIdx.x, nl = gridDim.x * NTHR;
    const bf16* Sc = (const bf16*)(P.ws + WS_S); int* IDS = (int*)(P.ws + WS_IDS); float* GATES = (float*)(P.ws + WS_GATES);
    for (int item = gl; item < M * 8; item += nl) {
        const u32x4* row = (const u32x4*)(Sc + (size_t)item * 256);
        unsigned L0[16], L1[16];
        topk128(row, L0); topk128(row + 16, L1);
        float f0[16], f1[16]; unsigned p0[16], p1[16];
#pragma unroll
        for (int i = 0; i < 16; ++i) {
            f0[i] = __uint_as_float((L0[i] & 0x80000000u) ? (L0[i] & 0x7FFF0000u) : (~L0[i] & 0xFFFF0000u)); p0[i] = (~L0[i] & 0x7Fu) << 7;
            f1[i] = __uint_as_float((L1[i] & 0x80000000u) ? (L1[i] & 0x7FFF0000u) : (~L1[i] & 0xFFFF0000u)); p1[i] = (~L1[i] & 0x7Fu);
        }
        unsigned C[16];
#pragma unroll
        for (int j = 0; j < 16; ++j) C[j] = 0u;
#pragma unroll
        for (int i = 0; i < 16; ++i)
#pragma unroll
            for (int j = 0; j < 16; ++j)
                if ((i + 1) * (j + 1) <= 16) {
                    const unsigned b = __float_as_uint(f0[i] + f1[j]); const unsigned mono = b ^ ((unsigned)((int)b >> 31) | 0x80000000u);
                    unsigned key = (mono & 0xFFFFC000u) | p0[i] | p1[j];
                    TK_INS(C, key);
                }
        float cv[16];
#pragma unroll
        for (int r = 0; r < 16; ++r) cv[r] = __uint_as_float((C[r] & 0x80000000u) ? (C[r] & 0x7FFFC000u) : (~C[r] & 0xFFFFC000u));
        const float cmax = cv[0]; float den = 0.f;
#pragma unroll
        for (int r = 0; r < 16; ++r) { cv[r] = __expf(cv[r] - cmax); den += cv[r]; }
        const float inv = 1.f / den;
        u32x4* ido = (u32x4*)(IDS + (size_t)item * 16); f32x4* go = (f32x4*)(GATES + (size_t)item * 16);
#pragma unroll
        for (int q = 0; q < 4; ++q) { u32x4 o; o.x = C[4 * q] & 0x3FFFu; o.y = C[4 * q + 1] & 0x3FFFu; o.z = C[4 * q + 2] & 0x3FFFu; o.w = C[4 * q + 3] & 0x3FFFu; ido[q] = o;
            f32x4 g; g[0] = cv[4 * q] * inv; g[1] = cv[4 * q + 1] * inv; g[2] = cv[4 * q + 2] * inv; g[3] = cv[4 * q + 3] * inv; go[q] = g; }
    }
}

typedef __bf16 bf16x2_t __attribute__((ext_vector_type(2)));
__device__ __forceinline__ float dot2bf(unsigned a, unsigned b, float c) { return __builtin_amdgcn_fdot2_f32_bf16(__builtin_bit_cast(bf16x2_t, a), __builtin_bit_cast(bf16x2_t, b), c, false); }
typedef unsigned u32x3 __attribute__((ext_vector_type(3)));
__device__ __forceinline__ void peer_load8(u32x3 (&buf)[8], const unsigned char* TAB, int idreg, int g, int lane) {
#pragma unroll
    for (int q = 0; q < 8; ++q) { const int id = __builtin_amdgcn_readlane(idreg, 8 * g + q); const unsigned* rp = (const unsigned*)(TAB + (size_t)id * ROWB) + 3 * lane; u32x3 w; w.x = rp[0]; w.y = rp[1]; w.z = rp[2]; buf[q] = w; }
}
__device__ __forceinline__ void peer_dots8(const u32x3 (&buf)[8], const u32x4& hq, int g, float& d, int lane) {
#pragma unroll
    for (int q = 0; q < 8; ++q) { const unsigned p0 = buf[q].x, p1 = buf[q].y, p2 = buf[q].z; int s = 0, t = 0;
        s = __builtin_amdgcn_sdot4((int)(p0 & 0x0F0F0F0Fu), (int)hq[0], s, false); s = __builtin_amdgcn_sdot4((int)((p0 >> 4) & 0x0F0F0F0Fu), (int)hq[1], s, false);
        s = __builtin_amdgcn_sdot4((int)(p1 & 0x0F0F0F0Fu), (int)hq[2], s, false); s = __builtin_amdgcn_sdot4((int)((p1 >> 4) & 0x0F0F0F0Fu), (int)hq[3], s, false);
#pragma unroll
        for (int f = 0; f < 4; ++f) t = __builtin_amdgcn_sdot4((int)((p2 >> (2 * f)) & 0x03030303u), (int)hq[f], t, false);
        const int tot = wave_sum_i(s + 16 * t);
        d = (lane == 8 * g + q) ? (float)tot : d; }
}
__device__ __forceinline__ void peer_axpy8(const u32x3 (&buf)[8], float areg, int g, float (&acc)[16]) {
#pragma unroll
    for (int q = 0; q < 8; ++q) { const float a = rlf(areg, 8 * g + q); const unsigned p0 = buf[q].x, p1 = buf[q].y, p2 = buf[q].z;
        const unsigned v0 = (p0 & 0x0F0F0F0Fu) | ((p2 & 0x03030303u) << 4), v1 = ((p0 >> 4) & 0x0F0F0F0Fu) | (((p2 >> 2) & 0x03030303u) << 4);
        const unsigned v2 = (p1 & 0x0F0F0F0Fu) | (((p2 >> 4) & 0x03030303u) << 4), v3 = ((p1 >> 4) & 0x0F0F0F0Fu) | (((p2 >> 6) & 0x03030303u) << 4);
        const unsigned vv[4] = {v0, v1, v2, v3};
#pragma unroll
        for (int i = 0; i < 4; ++i) { const unsigned w = vv[i];
            acc[4 * i] += a * (float)(w & 0xffu); acc[4 * i + 1] += a * (float)((w >> 8) & 0xffu); acc[4 * i + 2] += a * (float)((w >> 16) & 0xffu); acc[4 * i + 3] += a * (float)(w >> 24); } }
}
__device__ __forceinline__ void phase_peer(const Params& P) {
    const int lane = threadIdx.x & 63, wave = threadIdx.x >> 6; const int gw = blockIdx.x * NWAVES + wave, ngw = gridDim.x * NWAVES;
    const bf16* H1 = (const bf16*)(P.ws + WS_H1); const int* IDS = (const int*)(P.ws + WS_IDS); const float* GATES = (const float*)(P.ws + WS_GATES);
    const unsigned char* UT = P.ws + WS_UT; const unsigned char* VT = P.ws + WS_VT; const float* SU = (const float*)(P.ws + WS_SU); const float* SV = (const float*)(P.ws + WS_SV);
    const float* g2 = P.in[26]; const float* b2 = P.in[27];
    for (int m = gw; m < M; m += ngw) {
        const u32x4* hp = (const u32x4*)(H1 + (size_t)m * D) + 2 * lane; const u32x4 hA = hp[0], hB = hp[1];
        float hv[16]; float hmx = 0.f;
#pragma unroll
        for (int i = 0; i < 4; ++i) { hv[2 * i] = __uint_as_float(hA[i] << 16); hv[2 * i + 1] = __uint_as_float(hA[i] & 0xffff0000u); hv[8 + 2 * i] = __uint_as_float(hB[i] << 16); hv[8 + 2 * i + 1] = __uint_as_float(hB[i] & 0xffff0000u); }
#pragma unroll
        for (int i = 0; i < 16; ++i) hmx = fmaxf(hmx, fabsf(hv[i]));
        hmx = wave_max_u(hmx); const float hinv = hmx > 0.f ? 127.f / hmx : 0.f, hsc = hmx * (1.f / 127.f);
        u32x4 hq;
#pragma unroll
        for (int i = 0; i < 4; ++i) hq[i] = pack_i8(hv[4 * i], hv[4 * i + 1], hv[4 * i + 2], hv[4 * i + 3], hinv, 0);
        int hs = 0;
#pragma unroll
        for (int i = 0; i < 4; ++i) hs = __builtin_amdgcn_sdot4((int)hq[i], 0x01010101, hs, false);
        const float hoff = 32.f * (float)wave_sum_i(hs);
        const int id_lo = IDS[(size_t)m * 128 + lane], id_hi = IDS[(size_t)m * 128 + 64 + lane];
        const float gt_lo = GATES[(size_t)m * 128 + lane], gt_hi = GATES[(size_t)m * 128 + 64 + lane];
        const float su_lo = SU[id_lo], su_hi = SU[id_hi], sv_lo = SV[id_lo], sv_hi = SV[id_hi];
        float d_lo = 0.f, d_hi = 0.f;
        u32x3 A0[8], A1[8];
        peer_load8(A0, UT, id_lo, 0, lane);
        for (int g = 0; g < 8; g += 2) {
            peer_load8(A1, UT, id_lo, g + 1, lane); peer_dots8(A0, hq, g, d_lo, lane);
            if (g + 2 < 8) peer_load8(A0, UT, id_lo, g + 2, lane); else peer_load8(A0, UT, id_hi, 0, lane);
            peer_dots8(A1, hq, g + 1, d_lo, lane);
        }
        for (int g = 0; g < 8; g += 2) {
            peer_load8(A1, UT, id_hi, g + 1, lane); peer_dots8(A0, hq, g, d_hi, lane);
            if (g + 2 < 8) peer_load8(A0, UT, id_hi, g + 2, lane); else peer_load8(A0, VT, id_lo, 0, lane);
            peer_dots8(A1, hq, g + 1, d_hi, lane);
        }
        const float x_lo = (d_lo - hoff) * su_lo * hsc, x_hi = (d_hi - hoff) * su_hi * hsc;
        const float a_lo = 0.5f * x_lo * (1.f + erff(x_lo * 0.70710678118f)) * gt_lo * sv_lo, a_hi = 0.5f * x_hi * (1.f + erff(x_hi * 0.70710678118f)) * gt_hi * sv_hi;
        const float c0 = 32.f * wave_sum(a_lo + a_hi);
        float acc[16];
#pragma unroll
        for (int i = 0; i < 16; ++i) acc[i] = 0.f;
        for (int g = 0; g < 8; g += 2) {
            peer_load8(A1, VT, id_lo, g + 1, lane); peer_axpy8(A0, a_lo, g, acc);
            if (g + 2 < 8) peer_load8(A0, VT, id_lo, g + 2, lane); else peer_load8(A0, VT, id_hi, 0, lane);
            peer_axpy8(A1, a_lo, g + 1, acc);
        }
        for (int g = 0; g < 8; g += 2) {
            peer_load8(A1, VT, id_hi, g + 1, lane); peer_axpy8(A0, a_hi, g, acc);
            if (g + 2 < 8) peer_load8(A0, VT, id_hi, g + 2, lane);
            peer_axpy8(A1, a_hi, g + 1, acc);
        }
        float s = 0.f;
#pragma unroll
        for (int i = 0; i < 16; ++i) { acc[i] = ALPHA * hv[i] + (acc[i] - c0); s += acc[i]; }
        const float mean = wave_sum(s) * (1.f / D); float s2 = 0.f;
#pragma unroll
        for (int i = 0; i < 16; ++i) { acc[i] -= mean; s2 += acc[i] * acc[i]; }
        const float rstd = 1.f / sqrtf(wave_sum(s2) * (1.f / D) + LN_EPS);
#pragma unroll
        for (int c4 = 0; c4 < 4; ++c4) { const int e0 = 16 * lane + 4 * c4; const f32x4 gg = *(const f32x4*)(g2 + e0), bb = *(const f32x4*)(b2 + e0); f32x4 o;
#pragma unroll
            for (int j = 0; j < 4; ++j) o[j] = acc[c4 * 4 + j] * rstd * gg[j] + bb[j];
            *(f32x4*)(P.out + (size_t)m * D + e0) = o; }
    }
}

#define XB_TMO      128
#define XB_XCNT(j)  (256  + 64 * (j))
#define XB_XSUB(j)  (1280 + 64 * (j))
#define XB_XGEN(j)  (2304 + 64 * (j))
#define XB_TOP      3328
#define XB_TOPGEN   3392
#define XCD_BAR_WORDS 3456
#define XB_SPIN_CAP (1u << 18)
__device__ __forceinline__ unsigned xb_ld(unsigned* p)              { return __hip_atomic_load(p, __ATOMIC_RELAXED, __HIP_MEMORY_SCOPE_AGENT); }
__device__ __forceinline__ unsigned xb_add(unsigned* p, unsigned v) { return __hip_atomic_fetch_add(p, v, __ATOMIC_RELAXED, __HIP_MEMORY_SCOPE_AGENT); }
__device__ __forceinline__ unsigned xb_xcc_id() { return (unsigned)__builtin_amdgcn_s_getreg((3 << 11) | 20) & 0xFu; }
#define XB_SPIN(cond, bar) do { unsigned _sp = 0; while (cond) { __builtin_amdgcn_s_sleep(1); \
    if ((++_sp & 255u) == 0u) { if (xb_ld(&(bar)[XB_TMO])) break; if (_sp > XB_SPIN_CAP) { atomicAdd(&(bar)[XB_TMO], 1u); break; } } } } while (0)
struct XcdBarrier { unsigned* bar; unsigned x; volatile LAS unsigned* st; };
__device__ __forceinline__ XcdBarrier xcd_barrier_post(unsigned* bar, volatile LAS unsigned* st) {
    XcdBarrier b; b.bar = bar; b.x = xb_xcc_id(); b.st = st;
    if (threadIdx.x == 0) (void)xb_add(&bar[XB_XCNT(b.x)], 1u);
    return b;
}
__device__ __forceinline__ void xcd_barrier_complete(unsigned* bar, unsigned x, unsigned& nloc, unsigned& nx) {
    const unsigned G = gridDim.x * gridDim.y * gridDim.z;
    unsigned sum, cnt, mine, sp = 0u;
    for (;;) {
        sum = 0u; cnt = 0u; mine = 0u;
#pragma unroll
        for (unsigned j = 0; j < 16; ++j) { const unsigned c = xb_ld(&bar[XB_XCNT(j)]); sum += c; cnt += (c > 0u) ? 1u : 0u; mine = (j == x) ? c : mine; }
        if (sum == G) break;
        __builtin_amdgcn_s_sleep(1);
        if ((++sp & 255u) == 0u) { if (xb_ld(&bar[XB_TMO])) break; if (sp > XB_SPIN_CAP) { atomicAdd(&bar[XB_TMO], 1u); break; } }
    }
    nloc = mine > 0u ? mine : 1u; nx = cnt > 0u ? cnt : 1u;
}
__device__ __forceinline__ void xcd_barrier(const XcdBarrier& b) {
    asm volatile("s_waitcnt vmcnt(0)" ::: "memory");
    __syncthreads();
    if (threadIdx.x == 0) {
        unsigned* bar = b.bar;
        __builtin_amdgcn_s_waitcnt(0);
        unsigned nloc = b.st[0], nx = b.st[1];
        if (nloc == 0u) { xcd_barrier_complete(bar, b.x, nloc, nx); b.st[0] = nloc; b.st[1] = nx; }
        const unsigned old = xb_add(&bar[XB_XSUB(b.x)], 1u);
        const unsigned gen = old / nloc;
        if (old + 1u == (gen + 1u) * nloc) {
            __builtin_amdgcn_fence(__ATOMIC_RELEASE, "agent");
            asm volatile("s_waitcnt vmcnt(0)" ::: "memory");
            const unsigned og = xb_add(&bar[XB_TOP], 1u);
            const unsigned tg = og / nx;
            if (og + 1u == (tg + 1u) * nx) xb_add(&bar[XB_TOPGEN], 1u);
            else XB_SPIN(xb_ld(&bar[XB_TOPGEN]) == tg, bar);
            __builtin_amdgcn_fence(__ATOMIC_ACQUIRE, "agent");
            xb_add(&bar[XB_XGEN(b.x)], 1u);
            asm volatile("s_waitcnt vmcnt(0)" ::: "memory");
        } else {
            XB_SPIN(xb_ld(&bar[XB_XGEN(b.x)]) == gen, bar);
            __builtin_amdgcn_fence(__ATOMIC_ACQUIRE, "agent");
            asm volatile("s_waitcnt vmcnt(0)" ::: "memory");
        }
    }
    __syncthreads();
}

constexpr int N_PHASES = 12;
__global__ void __launch_bounds__(NTHR, 2) fwd_kernel(Params P) {
    extern __shared__ __attribute__((aligned(16))) unsigned char lds_raw[];
    LAS unsigned char* lds = (LAS unsigned char*)lds_raw;
    cg::grid_group grid = cg::this_grid();
    const int lo = P.ph_lo, hi = P.ph_hi;
    unsigned char* ws = P.ws;
    volatile LAS unsigned* bst = (volatile LAS unsigned*)(lds + LDS_MISC);
    if (threadIdx.x < 16) bst[threadIdx.x] = 0u;
    __syncthreads();
    const XcdBarrier bar = xcd_barrier_post((unsigned*)(ws + WS_CTL), bst);
#define IN(k) (lo <= (k) && (k) < hi)
#define SEAM(k) do { if (IN(k) && IN((k) + 1)) { if ((k) == 0) grid.sync(); else xcd_barrier(bar); } } while (0)
    if (IN(0)) phase_prologue(P);
    SEAM(0);
    if (IN(1)) {
        pg8::Gemm g{(const bf16*)(ws + WS_H0), (const bf16*)(ws + WS_WIN), M, NP, D, D, D, 0}; pg8::StaticOrder S; S.init(M, NP, gridDim.x, blockIdx.x);
        pg8::EpiBf16 E{(bf16*)(ws + WS_P), NP};
        pg8::gemm_phase<pg8::EpiBf16, pg8::StaticOrder, true, true>(lds, g, S, E);
    }
    SEAM(1);
    if (IN(2)) phase_prep(P, lds);
    SEAM(2);
    if (IN(3)) phase_scan(P, lds);
    SEAM(3);
    if (IN(4)) phase_fixup(P, lds);
    SEAM(4);
    if (IN(5)) phase_correct(P, lds);
    SEAM(5);
    if (IN(6)) {
        pg8::Gemm g{(const bf16*)(ws + WS_MIX), (const bf16*)(ws + WS_WOUT), M, D, D, D, D, 0}; pg8::StaticOrder S; S.init(M, D, gridDim.x, blockIdx.x);
        pg8::EpiResF32 E{(float*)(ws + WS_Z), (const bf16*)(ws + WS_H0), D, ALPHA};
        pg8::gemm_phase<pg8::EpiResF32, pg8::StaticOrder, true, true>(lds, g, S, E);
    }
    SEAM(6);
    if (IN(7)) phase_ln1(P);
    SEAM(7);
    if (IN(8)) {
        pg8::Gemm g{(const bf16*)(ws + WS_H1), (const bf16*)(ws + WS_WQ), M, NQ, D, D, D, 0}; pg8::StaticOrder S; S.init(M, NQ, gridDim.x, blockIdx.x);
        pg8::EpiBf16 E{(bf16*)(ws + WS_Q), NQ};
        pg8::gemm_phase<pg8::EpiBf16, pg8::StaticOrder, true, true>(lds, g, S, E);
    }
    SEAM(8);
    if (IN(9)) {
        pg8::Gemm g{(const bf16*)(ws + WS_Q), (const bf16*)(ws + WS_KBD), M, NQ, 256, NQ, 256, 256}; pg8::StaticOrder S; S.init(M, NQ, gridDim.x, blockIdx.x);
        pg8::EpiBf16 E{(bf16*)(ws + WS_S), NQ};
        pg8::gemm_phase<pg8::EpiBf16, pg8::StaticOrder, true, true>(lds, g, S, E);
    }
    SEAM(9);
    if (IN(10)) phase_topk(P);
    SEAM(10);
    if (IN(11)) phase_peer(P);
#undef IN
#undef SEAM
}

extern "C" void kernel_launch(void* const* d_in, const int* in_sizes, int n_in, void* d_out, int out_size, void* d_ws, size_t ws_size, hipStream_t stream) {
    static int grid = 0;
    if (grid == 0) {
        if (n_in != 28 || out_size != M * D || ws_size < WS_END) { fprintf(stderr, "kernel_launch: unexpected shapes (n_in %d out %d ws %zu)\n", n_in, out_size, ws_size); grid = -1; return; }
        int dev = 0, cus = 0, per_cu = 0;
        (void)hipGetDevice(&dev); (void)hipDeviceGetAttribute(&cus, hipDeviceAttributeMultiprocessorCount, dev);
        (void)hipFuncSetAttribute((const void*)fwd_kernel, hipFuncAttributeMaxDynamicSharedMemorySize, LDS_BYTES);
        (void)hipOccupancyMaxActiveBlocksPerMultiprocessor(&per_cu, (const void*)fwd_kernel, NTHR, LDS_BYTES);
        if (per_cu < 1) { fprintf(stderr, "kernel_launch: occupancy query says %d blocks per CU\n", per_cu); per_cu = 1; }
        (void)hipGetLastError();
        grid = cus;
    }
    if (grid < 0) return;
    Params p{};
    for (int i = 0; i < 28; ++i) p.in[i] = (const float*)d_in[i];
    p.out = (float*)d_out; p.ws = (unsigned char*)d_ws;
    (void)hipMemsetAsync((char*)d_ws + WS_CTL, 0, CTL_BYTES, stream);
#if MK_ONE_LAUNCH
    p.ph_lo = 0; p.ph_hi = N_PHASES;
    void* args[] = {&p};
    hipError_t e = hipLaunchCooperativeKernel((const void*)fwd_kernel, dim3(grid), dim3(NTHR), args, LDS_BYTES, stream);
    if (e != hipSuccess) fprintf(stderr, "cooperative launch failed: %s (grid %d)\n", hipGetErrorString(e), grid);
#else
    for (int ph = 0; ph < N_PHASES; ++ph) {
        p.ph_lo = ph; p.ph_hi = ph + 1;
        hipLaunchKernelGGL(fwd_kernel, dim3(grid), dim3(NTHR), LDS_BYTES, stream, p);
    }
#endif
}
```

```cpp
#include <hip/hip_runtime.h>
#include <hip/hip_cooperative_groups.h>
#include <cstdio>
#include <cstdint>
namespace cg = cooperative_groups;

#ifndef MK_ONE_LAUNCH
#define MK_ONE_LAUNCH 1
#endif

namespace pg8 {
#define PG8_LAS __attribute__((address_space(3)))
typedef unsigned short bf16_t;
typedef short bf16x8 __attribute__((ext_vector_type(8)));
typedef float f32x4 __attribute__((ext_vector_type(4)));
typedef float f32x2 __attribute__((ext_vector_type(2)));
typedef unsigned u32x4 __attribute__((ext_vector_type(4)));
typedef unsigned u32x2 __attribute__((ext_vector_type(2)));
constexpr int BM = 256, BK = 64, HALF = 128, HTB = HALF * BK * 2, STAGE_BYTES = 8 * HTB, NXCD = 8, WGM = 8;

__host__ __device__ __forceinline__ int lds_byte(int r, int c) { const int st = (r >> 4) * 2 + (c >> 5), rr = r & 15, cc = c & 31, ob = rr * 64 + cc * 2; return st * 1024 + (ob ^ (((ob >> 9) & 1) << 5)); }
__host__ __device__ __forceinline__ void stage_rc(int b, int& R, int& C) { const int st = b / 1024, sb = b % 1024, swz = sb ^ (((sb >> 9) & 1) << 5); R = (st >> 1) * 16 + swz / 64; C = (st & 1) * 32 + (swz % 64) / 2; }
__host__ __device__ __forceinline__ int perm32(int rho) { const int n = rho >> 4, i = rho & 15; return 8 * (i >> 2) + 4 * n + (i & 3); }

struct Unit { int pm, pn; };
struct Gemm { const bf16_t* A; const bf16_t* Bt; int M, N, K, lda, ldb, a_pn_koff; };

struct StaticOrder {
    int nM, nN, nwg, G, c;
    __host__ __device__ void init(int M, int N, int G_, int c_) { nM = M / BM; nN = N / BM; nwg = nM * nN; G = G_; c = c_; }
    __host__ __device__ bool next(int i, Unit& u) const {
        const long L = (long)i * G + c; if (L >= nwg) return false;
        int wgid = (int)L; { const int q = nwg / NXCD, r = nwg % NXCD, xcd = wgid % NXCD, off = wgid / NXCD; wgid = (xcd < r ? xcd * (q + 1) : r * (q + 1) + (xcd - r) * q) + off; }
        const int nig = WGM * nN, gid = wgid / nig, fm = gid * WGM, gsz = (nM - fm) < WGM ? (nM - fm) : WGM;
        u.pm = fm + ((wgid % nig) % gsz); u.pn = (wgid % nig) / gsz; return true;
    }
    __device__ __forceinline__ void a_ready(const Unit&) const {}
    __device__ __forceinline__ void done(const Unit&) const {}
};

__device__ __forceinline__ unsigned cvt_pk_bf16(float lo, float hi) { unsigned r; asm volatile("v_cvt_pk_bf16_f32 %0, %1, %2" : "=v"(r) : "v"(lo), "v"(hi)); return r; }

struct EpiBf16 {
    static constexpr bool PERM = true;
    bf16_t* O; int ldc;
    __device__ __forceinline__ void operator()(const f32x4 (&acc)[2][2][4][2], const Unit& u, int wr, int wc, int fr, int fq) const {
        const int row0 = u.pm * BM + wr * 64 + fr; const int col0 = u.pn * BM + wc * 32 + 8 * fq;
#pragma unroll
        for (int ai = 0; ai < 2; ++ai)
#pragma unroll
            for (int m = 0; m < 4; ++m) { bf16_t* rowp = O + (size_t)(row0 + ai * HALF + m * 16) * ldc + col0;
#pragma unroll
                for (int bj = 0; bj < 2; ++bj) { const f32x4 v0 = acc[ai][bj][m][0], v1 = acc[ai][bj][m][1];
                    u32x4 w; w.x = cvt_pk_bf16(v0[0], v0[1]); w.y = cvt_pk_bf16(v0[2], v0[3]); w.z = cvt_pk_bf16(v1[0], v1[1]); w.w = cvt_pk_bf16(v1[2], v1[3]);
                    *(u32x4*)(rowp + bj * HALF) = w; } }
    }
};
struct EpiResF32 {
    static constexpr bool PERM = false;
    float* Z; const bf16_t* R; int ldc; float alpha;
    __device__ __forceinline__ void operator()(const f32x4 (&acc)[2][2][4][2], const Unit& u, int wr, int wc, int fr, int fq) const {
        const int row0 = u.pm * BM + wr * 64 + fr; const int col0 = u.pn * BM + wc * 32 + 4 * fq;
#pragma unroll
        for (int ai = 0; ai < 2; ++ai)
#pragma unroll
            for (int m = 0; m < 4; ++m) { const size_t off = (size_t)(row0 + ai * HALF + m * 16) * ldc + col0;
#pragma unroll
                for (int bj = 0; bj < 2; ++bj)
#pragma unroll
                    for (int n = 0; n < 2; ++n) { const size_t o2 = off + bj * HALF + n * 16; const u32x2 rb = *(const u32x2*)(R + o2);
                        f32x4 h; h[0] = __uint_as_float(rb.x << 16); h[1] = __uint_as_float(rb.x & 0xffff0000u); h[2] = __uint_as_float(rb.y << 16); h[3] = __uint_as_float(rb.y & 0xffff0000u);
                        *(f32x4*)(Z + o2) = h * alpha + acc[ai][bj][m][n]; } }
    }
};

template <class Epi, class Sched, bool ALIGN_EPI = false, bool SP2 = false>
__device__ __forceinline__ void gemm_phase(PG8_LAS unsigned char* lds, const Gemm g, const Sched& S, const Epi& E) {
    const int tid = threadIdx.x, wid = __builtin_amdgcn_readfirstlane(tid >> 6), lane = tid & 63, wr = wid >> 2, wc = wid & 3, fr = lane & 15, fq = lane >> 4;
    const int K = g.K, nt = K / BK;
    unsigned voffA[2], voffB[2];
#pragma unroll
    for (int i = 0; i < 2; ++i) { int R, C; stage_rc(tid * 16 + i * 8192, R, C); const int Rb = Epi::PERM ? ((R & ~31) + perm32(R & 31)) : R;
        voffA[i] = (unsigned)(R * g.lda + C) * 2u; voffB[i] = (unsigned)(Rb * g.ldb + C) * 2u; }
    const size_t kstep = (size_t)(BK * 2);
    const size_t hstepA = (size_t)HALF * g.lda * 2, hstepB = (size_t)HALF * g.ldb * 2;
    const size_t tstepA = 2 * hstepA, tstepB = 2 * hstepB;
    const size_t pnA = (size_t)g.a_pn_koff * 2;
    const unsigned ldsw = (unsigned)wid * 1024u;
    const int aoff = lds_byte(wr * 64 + fr, fq * 8), boff = lds_byte(wc * 32 + fr, fq * 8);
#define PG8_SA(b, h) (((b) * 2 + (h)) * HTB)
#define PG8_SB(b, h) ((4 + (b) * 2 + (h)) * HTB)
#define PG8_STAGE(bufoff, gbase, voff) do { _Pragma("unroll") for (int _i = 0; _i < 2; ++_i) \
        __builtin_amdgcn_global_load_lds((const unsigned*)((const char*)(gbase) + (voff)[_i]), (PG8_LAS unsigned*)(lds + (bufoff) + ldsw + _i * 8192), 16, 0, 0); } while (0)
#define PG8_LDA(dst, b, h) do { _Pragma("unroll") for (int m = 0; m < 4; ++m) _Pragma("unroll") for (int k = 0; k < 2; ++k) dst[m][k] = *(const PG8_LAS bf16x8*)(lds + PG8_SA(b, h) + aoff + m * 2048 + k * 1024); } while (0)
#define PG8_LDB(dst, b, h) do { _Pragma("unroll") for (int n = 0; n < 2; ++n) _Pragma("unroll") for (int k = 0; k < 2; ++k) dst[n][k] = *(const PG8_LAS bf16x8*)(lds + PG8_SB(b, h) + boff + n * 2048 + k * 1024); } while (0)
#define PG8_MMA(ai, bj, At, Bt) do { __builtin_amdgcn_s_setprio(1); _Pragma("unroll") for (int m = 0; m < 4; ++m) _Pragma("unroll") for (int n = 0; n < 2; ++n) _Pragma("unroll") for (int k = 0; k < 2; ++k) \
        acc[ai][bj][m][n] = __builtin_amdgcn_mfma_f32_16x16x32_bf16(Bt[n][k], At[m][k], acc[ai][bj][m][n], 0, 0, 0); __builtin_amdgcn_s_setprio(0); } while (0)
#define PG8_WAIT_V(n) asm volatile("s_waitcnt vmcnt(" #n ")" ::: "memory")
#define PG8_WAIT_L(n) asm volatile("s_waitcnt lgkmcnt(" #n ")" ::: "memory")
#define PG8_BAR __builtin_amdgcn_s_barrier()
#define PG8_SCHED __builtin_amdgcn_sched_barrier(0)
    Unit cur, nxt; int ui = 0;
    if (!S.next(0, cur)) return;
    f32x4 acc[2][2][4][2];
#pragma unroll
    for (int a = 0; a < 2; ++a)
#pragma unroll
        for (int b = 0; b < 2; ++b)
#pragma unroll
            for (int m = 0; m < 4; ++m)
#pragma unroll
                for (int n = 0; n < 2; ++n) acc[a][b][m][n] = (f32x4){0.f, 0.f, 0.f, 0.f};
    bf16x8 At[4][2], B0[2][2], B1[2][2];
    const char* cA = (const char*)g.A + (size_t)cur.pm * tstepA + (size_t)cur.pn * pnA; const char* cB = (const char*)g.Bt + (size_t)cur.pn * tstepB;
    S.a_ready(cur);
    if constexpr (SP2) {
        PG8_STAGE(PG8_SB(0, 0), cB, voffB); PG8_STAGE(PG8_SB(0, 1), cB + hstepB, voffB); PG8_STAGE(PG8_SA(0, 0), cA, voffA); PG8_STAGE(PG8_SA(0, 1), cA + hstepA, voffA);
        if (wr == 1) PG8_BAR;
        PG8_WAIT_V(2); PG8_BAR;
        PG8_STAGE(PG8_SB(1, 0), cB + kstep, voffB); PG8_STAGE(PG8_SA(1, 0), cA + kstep, voffA); PG8_STAGE(PG8_SB(1, 1), cB + hstepB + kstep, voffB);
        PG8_WAIT_V(6); PG8_BAR;
    } else {
        PG8_STAGE(PG8_SB(0, 0), cB, voffB); PG8_STAGE(PG8_SA(0, 0), cA, voffA); PG8_STAGE(PG8_SB(0, 1), cB + hstepB, voffB); PG8_STAGE(PG8_SA(0, 1), cA + hstepA, voffA);
        if (wr == 1) PG8_BAR;
        PG8_WAIT_V(4); PG8_BAR;
        PG8_STAGE(PG8_SB(1, 0), cB + kstep, voffB); PG8_STAGE(PG8_SA(1, 0), cA + kstep, voffA); PG8_STAGE(PG8_SB(1, 1), cB + hstepB + kstep, voffB);
        PG8_WAIT_V(6); PG8_BAR;
    }
    for (;;) {
        const bool has_next = S.next(ui + 1, nxt);
        const char* nA = has_next ? (const char*)g.A + (size_t)nxt.pm * tstepA + (size_t)nxt.pn * pnA : cA; const char* nB = has_next ? (const char*)g.Bt + (size_t)nxt.pn * tstepB : cB;
        for (int t = 0; t < nt; t += 2) {
            const bool last = (t == nt - 2);
            const char* a1 = cA + (size_t)(t + 1) * kstep;
            const char* a2 = last ? nA : cA + (size_t)(t + 2) * kstep; const char* b2 = last ? nB : cB + (size_t)(t + 2) * kstep;
            const char* a3 = a2 + kstep; const char* b3 = b2 + kstep;
            if (last && has_next) S.a_ready(nxt);
            if constexpr (SP2) {
            PG8_LDB(B0, 0, 0); PG8_LDB(B1, 0, 1); PG8_SCHED; PG8_LDA(At, 0, 0); PG8_STAGE(PG8_SA(1, 1), a1 + hstepA, voffA);
            PG8_WAIT_V(8); PG8_WAIT_L(0); PG8_BAR; PG8_MMA(0, 0, At, B0); PG8_MMA(0, 1, At, B1); PG8_BAR; PG8_SCHED;
            PG8_LDA(At, 0, 1); PG8_STAGE(PG8_SB(0, 0), b2, voffB); PG8_STAGE(PG8_SB(0, 1), b2 + hstepB, voffB); PG8_STAGE(PG8_SA(0, 0), a2, voffA);
            PG8_WAIT_V(8); PG8_WAIT_L(0); PG8_BAR; PG8_MMA(1, 0, At, B0); PG8_MMA(1, 1, At, B1); PG8_BAR; PG8_SCHED;
            PG8_LDB(B0, 1, 0); PG8_LDB(B1, 1, 1); PG8_SCHED; PG8_LDA(At, 1, 0); PG8_STAGE(PG8_SA(0, 1), a2 + hstepA, voffA);
            PG8_WAIT_V(8); PG8_WAIT_L(0); PG8_BAR; PG8_MMA(0, 0, At, B0); PG8_MMA(0, 1, At, B1); PG8_BAR; PG8_SCHED;
            PG8_LDA(At, 1, 1); PG8_STAGE(PG8_SB(1, 0), b3, voffB); PG8_STAGE(PG8_SB(1, 1), b3 + hstepB, voffB); PG8_STAGE(PG8_SA(1, 0), a3, voffA);
            PG8_WAIT_V(8); PG8_WAIT_L(0); PG8_BAR; PG8_MMA(1, 0, At, B0); PG8_MMA(1, 1, At, B1); PG8_BAR; PG8_SCHED;
            } else {
            PG8_LDB(B0, 0, 0); PG8_SCHED; PG8_LDA(At, 0, 0); PG8_STAGE(PG8_SA(1, 1), a1 + hstepA, voffA);
            PG8_WAIT_L(8); PG8_BAR; PG8_WAIT_L(0); PG8_MMA(0, 0, At, B0); PG8_BAR; PG8_SCHED;
            PG8_LDB(B1, 0, 1); PG8_STAGE(PG8_SB(0, 0), b2, voffB);
            PG8_BAR; PG8_WAIT_L(0); PG8_MMA(0, 1, At, B1); PG8_BAR;
            PG8_LDA(At, 0, 1); PG8_STAGE(PG8_SA(0, 0), a2, voffA);
            PG8_BAR; PG8_WAIT_L(0); PG8_MMA(1, 0, At, B0); PG8_BAR; PG8_SCHED;
            PG8_STAGE(PG8_SB(0, 1), b2 + hstepB, voffB);
            PG8_WAIT_V(6); PG8_BAR; PG8_MMA(1, 1, At, B1); PG8_BAR;
            PG8_LDB(B0, 1, 0); PG8_SCHED; PG8_LDA(At, 1, 0); PG8_STAGE(PG8_SA(0, 1), a2 + hstepA, voffA);
            PG8_WAIT_L(8); PG8_BAR; PG8_WAIT_L(0); PG8_MMA(0, 0, At, B0); PG8_BAR; PG8_SCHED;
            PG8_LDB(B1, 1, 1); PG8_STAGE(PG8_SB(1, 0), b3, voffB);
            PG8_BAR; PG8_WAIT_L(0); PG8_MMA(0, 1, At, B1); PG8_BAR;
            PG8_LDA(At, 1, 1); PG8_STAGE(PG8_SA(1, 0), a3, voffA);
            PG8_BAR; PG8_WAIT_L(0); PG8_MMA(1, 0, At, B0); PG8_BAR; PG8_SCHED;
            PG8_STAGE(PG8_SB(1, 1), b3 + hstepB, voffB);
            PG8_WAIT_V(6); PG8_BAR; PG8_MMA(1, 1, At, B1); PG8_BAR;
            }
        }
        if constexpr (ALIGN_EPI) { if (wr == 0) PG8_BAR; }
        E(acc, cur, wr, wc, fr, fq); S.done(cur);
        if (!has_next) break;
#pragma unroll
        for (int a = 0; a < 2; ++a)
#pragma unroll
            for (int b = 0; b < 2; ++b)
#pragma unroll
                for (int m = 0; m < 4; ++m)
#pragma unroll
                    for (int n = 0; n < 2; ++n) acc[a][b][m][n] = (f32x4){0.f, 0.f, 0.f, 0.f};
        cur = nxt; cA = nA; cB = nB; ++ui;
        if constexpr (ALIGN_EPI) { if (wr == 1) PG8_BAR; }
    }
    PG8_WAIT_V(0);
    if constexpr (!ALIGN_EPI) { if (wr == 0) PG8_BAR; }
    PG8_BAR;
#undef PG8_SA
#undef PG8_SB
#undef PG8_STAGE
#undef PG8_LDA
#undef PG8_LDB
#undef PG8_MMA
#undef PG8_WAIT_V
#undef PG8_WAIT_L
#undef PG8_BAR
#undef PG8_SCHED
}
}

constexpr int NWAVES = 8, NTHR = NWAVES * 64;
constexpr int D = 1024, NBATCH = 4, T = 8192, M = NBATCH * T;
constexpr int A_W = 512, A_IN = 1792, IN_COLS = 3344, NP = 3584;
constexpr int C_R = 0, C_K = 512, C_V = 1024, C_WD = 1536, C_AD = 1600, C_GD = 1664;
constexpr int C_BQ = 1792, C_BK = 2048, C_BV = 2304, C_GKD = 2816, C_BG = 2832;
constexpr int NQ = 2048;
constexpr float LN_EPS = 1e-5f, GN_EPS = 64e-5f, RMS_EPS = 1e-5f;
constexpr float ALPHA = 1.189207115002721f;

typedef unsigned short bf16;
typedef float f32x4 __attribute__((ext_vector_type(4)));
typedef float f32x2 __attribute__((ext_vector_type(2)));
typedef unsigned u32x4 __attribute__((ext_vector_type(4)));
typedef unsigned u32x2 __attribute__((ext_vector_type(2)));
#define LAS __attribute__((address_space(3)))

constexpr size_t MiB = 1u << 20;
constexpr size_t WS_WIN = 1 * MiB, WS_WOUT = 8 * MiB, WS_WQ = 10 * MiB, WS_KBD = 14 * MiB;
constexpr size_t WS_W2T = 15 * MiB, WS_A2T = WS_W2T + 65536, WS_G2T = WS_A2T + 65536;
constexpr size_t WS_H0 = 16 * MiB;
constexpr size_t WS_P = 80 * MiB;
constexpr size_t WS_WL = 304 * MiB, WS_AA = 336 * MiB, WS_GG = 368 * MiB;
constexpr size_t WS_GK = 400 * MiB;
constexpr size_t WS_MIX = 416 * MiB;
constexpr size_t WS_Z = 80 * MiB;
constexpr size_t WS_H1 = 208 * MiB;
constexpr size_t WS_Q = 272 * MiB;
constexpr size_t WS_S = 80 * MiB;
constexpr size_t WS_IDS = 400 * MiB, WS_GATES = 416 * MiB;
constexpr size_t WS_UT = 432 * MiB, WS_VT = 448 * MiB;
constexpr int ROWB = 768;
constexpr size_t WS_SU = 464 * MiB, WS_SV = 465 * MiB;
constexpr int NSEG = 16, LSEG = 8192 / NSEG;
constexpr size_t WS_YI = WS_WL;
constexpr size_t WS_YIG = WS_GK;
constexpr size_t WS_SER = 480 * MiB;
constexpr size_t WS_SEG = 496 * MiB;
constexpr size_t WS_CEND = 504 * MiB;
constexpr size_t WS_END = 505 * MiB;

constexpr int LDS_BYTES = 147456, LDS_MISC = LDS_BYTES - 256;
constexpr size_t WS_CTL = 0, CTL_BYTES = 16384;

struct Params {
    const float* in[28];
    float* out; unsigned char* ws;
    int ph_lo, ph_hi;
};

__device__ __forceinline__ float bf2f(unsigned u) { return __uint_as_float(u << 16); }
__device__ __forceinline__ unsigned f2bf(float f) { unsigned u = __float_as_uint(f); return (u + 0x7fffu + ((u >> 16) & 1u)) >> 16; }
__device__ __forceinline__ unsigned pk2(float lo, float hi) { return f2bf(lo) | (f2bf(hi) << 16); }
#define DPP_F(v, ctrl) __builtin_bit_cast(float, __builtin_amdgcn_update_dpp(0, __builtin_bit_cast(int, (v)), (ctrl), 0xf, 0xf, false))
#define DPP_ADD(v, ctrl) ((v) + DPP_F(v, ctrl))
__device__ __forceinline__ float rlf(float v, int l) { return __builtin_bit_cast(float, __builtin_amdgcn_readlane(__builtin_bit_cast(int, v), l)); }
__device__ __forceinline__ float wave_sum_u(float v) {
    v = DPP_ADD(v, 0xB1); v = DPP_ADD(v, 0x4E); v = DPP_ADD(v, 0x141); v = DPP_ADD(v, 0x140);
    return (rlf(v, 0) + rlf(v, 16)) + (rlf(v, 32) + rlf(v, 48));
}
__device__ __forceinline__ float wave_sum(float v) { return wave_sum_u(v); }
#define DPP_I(v, ctrl) __builtin_amdgcn_update_dpp(0, (v), (ctrl), 0xf, 0xf, false)
__device__ __forceinline__ int wave_sum_i(int v) {
    v += DPP_I(v, 0xB1); v += DPP_I(v, 0x4E); v += DPP_I(v, 0x141); v += DPP_I(v, 0x140);
    return (__builtin_amdgcn_readlane(v, 0) + __builtin_amdgcn_readlane(v, 16)) + (__builtin_amdgcn_readlane(v, 32) + __builtin_amdgcn_readlane(v, 48));
}
__device__ __forceinline__ float wave_max_u(float v) {
    v = fmaxf(v, DPP_F(v, 0xB1)); v = fmaxf(v, DPP_F(v, 0x4E)); v = fmaxf(v, DPP_F(v, 0x141)); v = fmaxf(v, DPP_F(v, 0x140));
    return fmaxf(fmaxf(rlf(v, 0), rlf(v, 16)), fmaxf(rlf(v, 32), rlf(v, 48)));
}
__device__ __forceinline__ unsigned pack_i8(float a, float b, float c, float d, float inv, int off) {
    const int q0 = __float2int_rn(a * inv) + off, q1 = __float2int_rn(b * inv) + off, q2 = __float2int_rn(c * inv) + off, q3 = __float2int_rn(d * inv) + off;
    return (unsigned)(q0 & 0xff) | ((unsigned)(q1 & 0xff) << 8) | ((unsigned)(q2 & 0xff) << 16) | ((unsigned)(q3 & 0xff) << 24);
}
__device__ __forceinline__ float sigmoidf_(float x) { return 1.f / (1.f + __expf(-x)); }
__device__ __forceinline__ float softplusf_(float x) { return fmaxf(x, 0.f) + log1pf(__expf(-fabsf(x))); }
__device__ __forceinline__ float siluf_(float x) { return x * sigmoidf_(x); }

__device__ __forceinline__ void transpose_convert(const float* W, int K, int N, int Npad, bf16* WT, int gtid, int gthreads) {
    const int kc = K / 8, total = Npad * kc;
    for (int idx = gtid; idx < total; idx += gthreads) {
        const int n = idx % Npad, c = idx / Npad; float v[8];
#pragma unroll
        for (int j = 0; j < 8; ++j) v[j] = (n < N) ? W[(size_t)(8 * c + j) * N + n] : 0.f;
        u32x4 o; o.x = pk2(v[0], v[1]); o.y = pk2(v[2], v[3]); o.z = pk2(v[4], v[5]); o.w = pk2(v[6], v[7]);
        *(u32x4*)(WT + (size_t)n * K + 8 * c) = o;
    }
}
__device__ __forceinline__ void ln_row_bf16(const float* xrow, const float* g, const float* b, bf16* orow, int lane) {
    const f32x4* xr = (const f32x4*)xrow + lane; f32x4 v[4]; float s = 0.f;
#pragma unroll
    for (int j = 0; j < 4; ++j) { v[j] = xr[64 * j]; s += (v[j][0] + v[j][1]) + (v[j][2] + v[j][3]); }
    const float mean = wave_sum(s) * (1.f / D); float s2 = 0.f;
#pragma unroll
    for (int j = 0; j < 4; ++j) { v[j] = v[j] - mean; s2 += (v[j][0] * v[j][0] + v[j][1] * v[j][1]) + (v[j][2] * v[j][2] + v[j][3] * v[j][3]); }
    const float rstd = 1.f / sqrtf(wave_sum(s2) * (1.f / D) + LN_EPS);
    u32x2* o8 = (u32x2*)orow + lane;
#pragma unroll
    for (int j = 0; j < 4; ++j) { const f32x4 gg = ((const f32x4*)g)[lane + 64 * j], bb = ((const f32x4*)b)[lane + 64 * j]; const f32x4 y = v[j] * rstd * gg + bb;
        u32x2 w; w.x = pk2(y[0], y[1]); w.y = pk2(y[2], y[3]); o8[64 * j] = w; }
}
__device__ __forceinline__ void phase_prologue(const Params& P) {
    const int tid = threadIdx.x, lane = tid & 63, wave = tid >> 6;
    const int gtid = blockIdx.x * NTHR + tid, gthreads = gridDim.x * NTHR;
    unsigned char* ws = P.ws;
    transpose_convert(P.in[3], D, IN_COLS, NP, (bf16*)(ws + WS_WIN), gtid, gthreads);
    transpose_convert(P.in[19], D, D, D, (bf16*)(ws + WS_WOUT), gtid, gthreads);
    transpose_convert(P.in[22], D, NQ, NQ, (bf16*)(ws + WS_WQ), gtid, gthreads);
    transpose_convert(P.in[6], 64, A_W, A_W, (bf16*)(ws + WS_W2T), gtid, gthreads);
    transpose_convert(P.in[8], 64, A_W, A_W, (bf16*)(ws + WS_A2T), gtid, gthreads);
    transpose_convert(P.in[9], 128, A_W, A_W, (bf16*)(ws + WS_G2T), gtid, gthreads);
    {
        const float* keys = P.in[23]; bf16* kbd = (bf16*)(ws + WS_KBD);
        for (int idx = gtid; idx < 8 * 256 * 32; idx += gthreads) {
            const int kc = idx & 31, n = (idx >> 5) & 255, h = idx >> 13; const int k0 = kc * 8, hn = n >> 7, key = n & 127, hk = k0 >> 7, c0 = k0 & 127;
            u32x4 o = (u32x4){0u, 0u, 0u, 0u};
            if (hn == hk) { const float* s = keys + ((size_t)((h * 2 + hn) * 128 + key)) * 128 + c0; o.x = pk2(s[0], s[1]); o.y = pk2(s[2], s[3]); o.z = pk2(s[4], s[5]); o.w = pk2(s[6], s[7]); }
            *(u32x4*)(kbd + ((size_t)(h * 256 + n)) * 256 + k0) = o;
        }
    }
    const int gw = blockIdx.x * NWAVES + wave, ngw = gridDim.x * NWAVES;
    for (int m = gw; m < M; m += ngw) ln_row_bf16(P.in[0] + (size_t)m * D, P.in[1], P.in[2], (bf16*)(ws + WS_H0) + (size_t)m * D, lane);
}

typedef short bf16x8_t __attribute__((ext_vector_type(8)));
template <int KS, int LDA>
__device__ __forceinline__ void lora_mm(f32x4 (&acc)[4][4], const LAS bf16* ACT, const bf16* WT, int c0, int fr, int fq) {
#pragma unroll
    for (int mt = 0; mt < 4; ++mt)
#pragma unroll
        for (int nt = 0; nt < 4; ++nt) acc[mt][nt] = (f32x4){0.f, 0.f, 0.f, 0.f};
#pragma unroll
    for (int s = 0; s < KS; ++s) {
        bf16x8_t af[4], bfr[4];
#pragma unroll
        for (int mt = 0; mt < 4; ++mt) af[mt] = *(const LAS bf16x8_t*)(ACT + (mt * 16 + fr) * LDA + 32 * s + 8 * fq);
#pragma unroll
        for (int nt = 0; nt < 4; ++nt) bfr[nt] = *(const bf16x8_t*)(WT + (size_t)(c0 + nt * 16 + fr) * (32 * KS) + 32 * s + 8 * fq);
#pragma unroll
        for (int mt = 0; mt < 4; ++mt)
#pragma unroll
            for (int nt = 0; nt < 4; ++nt) acc[mt][nt] = __builtin_amdgcn_mfma_f32_16x16x32_bf16(bfr[nt], af[mt], acc[mt][nt], 0, 0, 0);
    }
}
__device__ __forceinline__ void phase_prep(const Params& P, LAS unsigned char* lds) {
    const int tid = threadIdx.x, lane = tid & 63, wave = __builtin_amdgcn_readfirstlane(tid >> 6), fr = lane & 15, fq = lane >> 4;
    unsigned char* ws = P.ws;
    const bf16* p = (const bf16*)(ws + WS_P);
    const float* mu = P.in[4]; const float* w0 = P.in[5]; const float* a0 = P.in[7];
    const float* gkw2 = P.in[16]; const float* gkb = P.in[17];
    const bf16* W2T = (const bf16*)(ws + WS_W2T); const bf16* A2T = (const bf16*)(ws + WS_A2T); const bf16* G2T = (const bf16*)(ws + WS_G2T);
    bf16* WL = (bf16*)(ws + WS_WL); bf16* AA = (bf16*)(ws + WS_AA); bf16* GG = (bf16*)(ws + WS_GG); bf16* GK = (bf16*)(ws + WS_GK);
    LAS bf16* TW = (LAS bf16*)lds; LAS bf16* AD = TW + 64 * 72; LAS bf16* SG = AD + 64 * 72;
    LAS float* gkd = (LAS float*)(SG + 64 * 136);
    const int c0 = wave * 64;
    for (int tile = blockIdx.x; tile < M / 64; tile += gridDim.x) {
        const int m0 = tile * 64;
        __syncthreads();
        for (int idx = tid; idx < 64 * 256; idx += NTHR) {
            const int j = idx & 255, tok = idx >> 8, m = m0 + tok, t = m & (T - 1);
            const float cur = bf2f(p[(size_t)m * NP + C_WD + j]);
            const float prev = (t > 0) ? bf2f(p[(size_t)(m - 1) * NP + C_WD + j]) : 0.f;
            const float x = cur + (prev - cur) * mu[C_WD + j];
            if (j < 64) TW[tok * 72 + j] = (bf16)f2bf(tanhf(x)); else if (j < 128) AD[tok * 72 + j - 64] = (bf16)f2bf(x); else SG[tok * 136 + j - 128] = (bf16)f2bf(sigmoidf_(x));
        }
        for (int idx = tid; idx < 64 * 16; idx += NTHR) { const int j = idx & 15, tok = idx >> 4; gkd[tok * 16 + j] = bf2f(p[(size_t)(m0 + tok) * NP + C_GKD + j]); }
        __syncthreads();
        f32x4 acc[4][4];
        lora_mm<2, 72>(acc, TW, W2T, c0, fr, fq);
#pragma unroll
        for (int nt = 0; nt < 4; ++nt) { const int c = c0 + nt * 16 + 4 * fq; const f32x4 b = *(const f32x4*)(w0 + c);
#pragma unroll
            for (int mt = 0; mt < 4; ++mt) { float o[4];
#pragma unroll
                for (int i = 0; i < 4; ++i) { const float z = b[i] + acc[mt][nt][i]; o[i] = -__expf(-softplusf_(-z) - 0.5f); }
                u32x2 w; w.x = pk2(o[0], o[1]); w.y = pk2(o[2], o[3]); *(u32x2*)(WL + (size_t)(m0 + mt * 16 + fr) * A_W + c) = w; } }
        lora_mm<2, 72>(acc, AD, A2T, c0, fr, fq);
#pragma unroll
        for (int nt = 0; nt < 4; ++nt) { const int c = c0 + nt * 16 + 4 * fq; const f32x4 b = *(const f32x4*)(a0 + c);
#pragma unroll
            for (int mt = 0; mt < 4; ++mt) { float o[4];
#pragma unroll
                for (int i = 0; i < 4; ++i) o[i] = sigmoidf_(b[i] + acc[mt][nt][i]);
                u32x2 w; w.x = pk2(o[0], o[1]); w.y = pk2(o[2], o[3]); *(u32x2*)(AA + (size_t)(m0 + mt * 16 + fr) * A_W + c) = w; } }
        lora_mm<4, 136>(acc, SG, G2T, c0, fr, fq);
#pragma unroll
        for (int nt = 0; nt < 4; ++nt) { const int c = c0 + nt * 16 + 4 * fq;
#pragma unroll
            for (int mt = 0; mt < 4; ++mt) { u32x2 w; w.x = pk2(acc[mt][nt][0], acc[mt][nt][1]); w.y = pk2(acc[mt][nt][2], acc[mt][nt][3]); *(u32x2*)(GG + (size_t)(m0 + mt * 16 + fr) * A_W + c) = w; } }
        { const int cc = tid & 255, th = tid >> 8; float wv[16];
#pragma unroll
          for (int j = 0; j < 16; ++j) wv[j] = gkw2[j * 256 + cc];
          const float bb = gkb[cc];
          for (int i = 0; i < 32; ++i) { const int tok = th * 32 + i; float sacc = bb;
#pragma unroll
              for (int j = 0; j < 16; ++j) sacc += gkd[tok * 16 + j] * wv[j];
              GK[(size_t)(m0 + tok) * 256 + cc] = (bf16)f2bf(-softplusf_(-sacc) * (1.f / 16.f)); } }
    }
}

constexpr int CH = 32;
__device__ __forceinline__ float red8(float v) { v = DPP_ADD(v, 0xB1); v = DPP_ADD(v, 0x4E); v = DPP_ADD(v, 0x141); return v; }
__device__ __forceinline__ float red4(float v) { v = DPP_ADD(v, 0xB1); v = DPP_ADD(v, 0x4E); return v; }

constexpr int RW_BUF = 6 * CH * 64;
__device__ __forceinline__ void rw_load(const bf16* p, const bf16* AA, const bf16* WL, int b, int t0, int col, int wave,
        unsigned (&rc)[4], unsigned (&kc)[4], unsigned (&vc)[4], unsigned (&rp)[4], unsigned (&kp)[4], unsigned (&vp)[4], unsigned (&a)[4], unsigned (&wl)[4]) {
#pragma unroll
    for (int q = 0; q < 4; ++q) {
        const int t = t0 + wave + 8 * q; const size_t m = (size_t)b * T + t; const bf16* pr = p + m * NP; const bf16* pp = (t > 0) ? pr - NP : pr;
        rc[q] = pr[C_R + col]; kc[q] = pr[C_K + col]; vc[q] = pr[C_V + col]; rp[q] = pp[C_R + col]; kp[q] = pp[C_K + col]; vp[q] = pp[C_V + col];
        a[q] = AA[m * A_W + col]; wl[q] = WL[m * A_W + col];
    }
}
__device__ __forceinline__ void rw_prep(LAS float* B, int t0, int wave, int lane, float mu_r, float mu_k, float mu_v, float kkc, float kac,
        const unsigned (&rc_)[4], const unsigned (&kc_)[4], const unsigned (&vc_)[4], const unsigned (&rp_)[4], const unsigned (&kp_)[4], const unsigned (&vp_)[4], const unsigned (&a_)[4], const unsigned (&wl_)[4]) {
    LAS float* R = B; LAS float* DEC = R + CH * 64; LAS float* KH = DEC + CH * 64; LAS float* KK = KH + CH * 64; LAS float* BB = KK + CH * 64; LAS float* V = BB + CH * 64;
#pragma unroll
    for (int q = 0; q < 4; ++q) {
        const int tt = wave + 8 * q; const float hp = (t0 + tt > 0) ? 1.f : 0.f;
        const float rc = bf2f(rc_[q]), kc = bf2f(kc_[q]), vc = bf2f(vc_[q]), rp = bf2f(rp_[q]) * hp, kp = bf2f(kp_[q]) * hp, vp = bf2f(vp_[q]) * hp;
        const float r = rc + (rp - rc) * mu_r, k = kc + (kp - kc) * mu_k, v = vc + (vp - vc) * mu_v;
        const float a = bf2f(a_[q]), wl = bf2f(wl_[q]);
        const float kr = k * kkc; const float nrm = sqrtf(wave_sum(kr * kr)); const float kk = kr / fmaxf(nrm, 1e-12f);
        const float kh = k * (1.f + (a - 1.f) * kac);
        R[tt * 64 + lane] = r; DEC[tt * 64 + lane] = __expf(wl); KH[tt * 64 + lane] = kh; KK[tt * 64 + lane] = kk; BB[tt * 64 + lane] = kk * a; V[tt * 64 + lane] = v;
    }
}
struct RwOps { f32x4 k0, k1, d0, d1, b0, b1, h0, h1, q0, q1; float v0, v1; };
__device__ __forceinline__ void rw_ops_load(RwOps& o, const LAS float* B, int tt, int s8, int vr0) {
    const LAS float* R = B; const LAS float* DEC = R + CH * 64; const LAS float* KH = DEC + CH * 64; const LAS float* KK = KH + CH * 64; const LAS float* BB = KK + CH * 64; const LAS float* V = BB + CH * 64;
    o.k0 = *(const LAS f32x4*)(KK + tt * 64 + s8); o.k1 = *(const LAS f32x4*)(KK + tt * 64 + s8 + 4);
    o.d0 = *(const LAS f32x4*)(DEC + tt * 64 + s8); o.d1 = *(const LAS f32x4*)(DEC + tt * 64 + s8 + 4);
    o.b0 = *(const LAS f32x4*)(BB + tt * 64 + s8); o.b1 = *(const LAS f32x4*)(BB + tt * 64 + s8 + 4);
    o.h0 = *(const LAS f32x4*)(KH + tt * 64 + s8); o.h1 = *(const LAS f32x4*)(KH + tt * 64 + s8 + 4);
    o.q0 = *(const LAS f32x4*)(R + tt * 64 + s8); o.q1 = *(const LAS f32x4*)(R + tt * 64 + s8 + 4);
    o.v0 = V[tt * 64 + vr0]; o.v1 = V[tt * 64 + vr0 + 1];
}
template <bool IDENT> __device__ __forceinline__ void rw_step(const RwOps& o, f32x2 (&S0)[4], f32x2 (&S1)[4], LAS float* Y, int tt, int r0, int lane) {
    const float vv0 = o.v0, vv1 = o.v1;
    const f32x2 kk[4] = {o.k0.lo, o.k0.hi, o.k1.lo, o.k1.hi}, dd[4] = {o.d0.lo, o.d0.hi, o.d1.lo, o.d1.hi}, bb[4] = {o.b0.lo, o.b0.hi, o.b1.lo, o.b1.hi}, hh[4] = {o.h0.lo, o.h0.hi, o.h1.lo, o.h1.hi}, rr[4] = {o.q0.lo, o.q0.hi, o.q1.lo, o.q1.hi};
    f32x2 a0 = S0[0] * kk[0], a1 = S1[0] * kk[0];
#pragma unroll
    for (int i = 1; i < 4; ++i) { a0 = S0[i] * kk[i] + a0; a1 = S1[i] * kk[i] + a1; }
    const float sa0 = -red8(a0.x + a0.y), sa1 = -red8(a1.x + a1.y);
    f32x2 y0 = (f32x2){0.f, 0.f}, y1 = (f32x2){0.f, 0.f};
#pragma unroll
    for (int i = 0; i < 4; ++i) {
        if (IDENT) { S0[i] = bb[i] * sa0 + S0[i] * dd[i]; S1[i] = bb[i] * sa1 + S1[i] * dd[i]; }
        else { S0[i] = hh[i] * vv0 + (bb[i] * sa0 + S0[i] * dd[i]); S1[i] = hh[i] * vv1 + (bb[i] * sa1 + S1[i] * dd[i]); }
        y0 = S0[i] * rr[i] + y0; y1 = S1[i] * rr[i] + y1;
    }
    const float yy0 = red8(y0.x + y0.y), yy1 = red8(y1.x + y1.y);
    if ((lane & 7) == 0) { Y[tt * 128 + r0] = yy0; Y[tt * 128 + r0 + 1] = yy1; }
}
struct GlOps { f32x4 k0, k1, d0, d1, q0, q1; float v0, v1; };
__device__ __forceinline__ void gl_ops_load(GlOps& o, const LAS float* B, int tt, int s8, int r0) {
    const LAS float* Q = B; const LAS float* K = Q + CH * 64; const LAS float* DEC = K + CH * 64; const LAS float* V = DEC + CH * 64;
    o.k0 = *(const LAS f32x4*)(K + tt * 64 + s8); o.k1 = *(const LAS f32x4*)(K + tt * 64 + s8 + 4);
    o.d0 = *(const LAS f32x4*)(DEC + tt * 64 + s8); o.d1 = *(const LAS f32x4*)(DEC + tt * 64 + s8 + 4);
    o.q0 = *(const LAS f32x4*)(Q + tt * 64 + s8); o.q1 = *(const LAS f32x4*)(Q + tt * 64 + s8 + 4);
    o.v0 = V[tt * 128 + r0]; o.v1 = V[tt * 128 + r0 + 1];
}
__device__ __forceinline__ void gl_step(const GlOps& o, f32x2 (&S0)[4], f32x2 (&S1)[4], f32x2 (&c)[4], LAS float* O, LAS float* YL, int tt, int r0, int s8, int lane, int wave) {
    const f32x2 kk[4] = {o.k0.lo, o.k0.hi, o.k1.lo, o.k1.hi}, dd[4] = {o.d0.lo, o.d0.hi, o.d1.lo, o.d1.hi}, qq[4] = {o.q0.lo, o.q0.hi, o.q1.lo, o.q1.hi};
    f32x2 y0 = (f32x2){0.f, 0.f}, y1 = (f32x2){0.f, 0.f};
#pragma unroll
    for (int i = 0; i < 4; ++i) {
        S0[i] = kk[i] * o.v0 + S0[i] * dd[i]; S1[i] = kk[i] * o.v1 + S1[i] * dd[i];
        y0 = S0[i] * qq[i] + y0; y1 = S1[i] * qq[i] + y1;
    }
    if (wave == 0) {
#pragma unroll
        for (int i = 0; i < 4; ++i) c[i] = c[i] * dd[i];
        if (lane < 8) { const f32x2 e0 = c[0] * qq[0], e1 = c[1] * qq[1], e2 = c[2] * qq[2], e3 = c[3] * qq[3];
            *(LAS f32x4*)(YL + tt * 64 + s8) = (f32x4){e0.x, e0.y, e1.x, e1.y}; *(LAS f32x4*)(YL + tt * 64 + s8 + 4) = (f32x4){e2.x, e2.y, e3.x, e3.y}; }
    }
    const float o0 = red8(y0.x + y0.y), o1 = red8(y1.x + y1.y);
    if ((lane & 7) == 0) { O[tt * 128 + r0] = o0; O[tt * 128 + r0 + 1] = o1; }
}
__device__ __forceinline__ void rwkv_item(const Params& P, LAS unsigned char* lds, int b, int h, int seg) {
    const int tid = threadIdx.x, lane = tid & 63, wave = tid >> 6;
    unsigned char* ws = P.ws;
    const bf16* p = (const bf16*)(ws + WS_P); const bf16* WL = (const bf16*)(ws + WS_WL); const bf16* AA = (const bf16*)(ws + WS_AA);
    bf16* MIX = (bf16*)(ws + WS_MIX); bf16* YI = (bf16*)(ws + WS_YI);
    const float* mu = P.in[4]; const float* k_k = P.in[10]; const float* k_a = P.in[11];
    LAS float* BUF = (LAS float*)lds; LAS float* Y = BUF + 2 * RW_BUF;
    const int col = h * 64 + lane;
    const float mu_r = mu[C_R + col], mu_k = mu[C_K + col], mu_v = mu[C_V + col], kkc = k_k[col], kac = k_a[col];
    const int r0 = wave * 16 + 2 * (lane >> 3), s8 = (lane & 7) * 8; const int ident = r0 >> 6, vr0 = r0 & 63, vr1 = vr0 + 1;
    float* SE = (float*)(ws + WS_SER) + ((((size_t)(b * 8 + h) * NSEG + seg) * 2 + ident) * 4096) + vr0 * 64 + s8;
    f32x2 S0[4], S1[4];
#pragma unroll
    for (int i = 0; i < 4; ++i) { S0[i] = (f32x2){(ident && (s8 + 2 * i == vr0)) ? 1.f : 0.f, (ident && (s8 + 2 * i + 1 == vr0)) ? 1.f : 0.f};
        S1[i] = (f32x2){(ident && (s8 + 2 * i == vr1)) ? 1.f : 0.f, (ident && (s8 + 2 * i + 1 == vr1)) ? 1.f : 0.f}; }
    const float vmask = ident ? 0.f : 1.f;
    const int tbeg = seg * LSEG;
    unsigned rc[4], kc[4], vc[4], rp[4], kp[4], vp[4], a[4], wl[4];
    __syncthreads();
    rw_load(p, AA, WL, b, tbeg, col, wave, rc, kc, vc, rp, kp, vp, a, wl);
    rw_prep(BUF, tbeg, wave, lane, mu_r, mu_k, mu_v, kkc, kac, rc, kc, vc, rp, kp, vp, a, wl);
    __syncthreads();
    for (int ci = 0; ci < LSEG / CH; ++ci) {
        const int t0 = tbeg + ci * CH; LAS float* B = BUF + (ci & 1) * RW_BUF;
        LAS float* R = B; LAS float* DEC = R + CH * 64; LAS float* KH = DEC + CH * 64; LAS float* KK = KH + CH * 64; LAS float* BB = KK + CH * 64; LAS float* V = BB + CH * 64;
        const bool more = (ci + 1 < LSEG / CH);
        if (more) rw_load(p, AA, WL, b, t0 + CH, col, wave, rc, kc, vc, rp, kp, vp, a, wl);
        { RwOps oa, ob; rw_ops_load(oa, B, 0, s8, vr0);
          if (ident) for (int tt = 0; tt < CH; tt += 2) {
              rw_ops_load(ob, B, tt + 1, s8, vr0); rw_step<true>(oa, S0, S1, Y, tt, r0, lane);
              rw_ops_load(oa, B, (tt + 2) & (CH - 1), s8, vr0); rw_step<true>(ob, S0, S1, Y, tt + 1, r0, lane);
          } else for (int tt = 0; tt < CH; tt += 2) {
              rw_ops_load(ob, B, tt + 1, s8, vr0); rw_step<false>(oa, S0, S1, Y, tt, r0, lane);
              rw_ops_load(oa, B, (tt + 2) & (CH - 1), s8, vr0); rw_step<false>(ob, S0, S1, Y, tt + 1, r0, lane);
          } }
        __syncthreads();
        if (more) rw_prep(BUF + ((ci + 1) & 1) * RW_BUF, t0 + CH, wave, lane, mu_r, mu_k, mu_v, kkc, kac, rc, kc, vc, rp, kp, vp, a, wl);
#pragma unroll
        for (int q = 0; q < 4; ++q) {
            const int tt = wave + 8 * q; const size_t m = (size_t)b * T + t0 + tt;
            MIX[m * D + col] = (bf16)f2bf(Y[tt * 128 + lane]); YI[m * 512 + col] = (bf16)f2bf(Y[tt * 128 + 64 + lane]);
        }
        __syncthreads();
    }
    *(f32x4*)(SE) = (f32x4){S0[0].x, S0[0].y, S0[1].x, S0[1].y}; *(f32x4*)(SE + 4) = (f32x4){S0[2].x, S0[2].y, S0[3].x, S0[3].y};
    *(f32x4*)(SE + 64) = (f32x4){S1[0].x, S1[0].y, S1[1].x, S1[1].y}; *(f32x4*)(SE + 68) = (f32x4){S1[2].x, S1[2].y, S1[3].x, S1[3].y};
}

constexpr int GL_BUF = 3 * CH * 64 + CH * 128;
__device__ __forceinline__ void gl_load(const bf16* p, const bf16* GK, int b, int h, int t0, int lane, int wave, unsigned (&x)[4][4][4], unsigned (&gk)[4]) {
    const int cq = h * 64 + lane, ck = 256 + h * 64 + lane, cv0 = 512 + h * 128 + lane, cv1 = cv0 + 64;
#pragma unroll
    for (int q = 0; q < 4; ++q) {
        const int t = t0 + wave + 8 * q; const size_t m = (size_t)b * T + t;
#pragma unroll
        for (int j = 0; j < 4; ++j) { const int back = 3 - j; const bf16* pr = p + (m - (size_t)((t >= back) ? back : 0)) * NP + C_BQ;
            x[q][j][0] = pr[cq]; x[q][j][1] = pr[ck]; x[q][j][2] = pr[cv0]; x[q][j][3] = pr[cv1]; }
        gk[q] = GK[m * 256 + h * 64 + lane];
    }
}
__device__ __forceinline__ void gl_prep(LAS float* B, int t0, int wave, int lane, const float (&wq)[4], const float (&wk)[4], const float (&wv0)[4], const float (&wv1)[4],
        const unsigned (&x)[4][4][4], const unsigned (&gk)[4]) {
    LAS float* Q = B; LAS float* K = Q + CH * 64; LAS float* DEC = K + CH * 64; LAS float* V = DEC + CH * 64;
#pragma unroll
    for (int q = 0; q < 4; ++q) {
        const int tt = wave + 8 * q, t = t0 + tt; float aq = 0.f, ak = 0.f, av0 = 0.f, av1 = 0.f;
#pragma unroll
        for (int j = 0; j < 4; ++j) { const float ok = (t >= 3 - j) ? 1.f : 0.f;
            aq += wq[j] * ok * bf2f(x[q][j][0]); ak += wk[j] * ok * bf2f(x[q][j][1]); av0 += wv0[j] * ok * bf2f(x[q][j][2]); av1 += wv1[j] * ok * bf2f(x[q][j][3]); }
        Q[tt * 64 + lane] = siluf_(aq) * 0.125f; K[tt * 64 + lane] = siluf_(ak); V[tt * 128 + lane] = siluf_(av0); V[tt * 128 + 64 + lane] = siluf_(av1);
        DEC[tt * 64 + lane] = __expf(bf2f(gk[q]));
    }
}
__device__ __forceinline__ void gla_item(const Params& P, LAS unsigned char* lds, int b, int h, int seg) {
    const int tid = threadIdx.x, lane = tid & 63, wave = tid >> 6;
    unsigned char* ws = P.ws;
    const bf16* p = (const bf16*)(ws + WS_P); const bf16* GK = (const bf16*)(ws + WS_GK);
    bf16* MIX = (bf16*)(ws + WS_MIX); bf16* YIG = (bf16*)(ws + WS_YIG);
    float* SE = (float*)(ws + WS_SEG) + ((size_t)(b * 4 + h) * NSEG + seg) * 8192; float* CE = (float*)(ws + WS_CEND) + ((size_t)(b * 4 + h) * NSEG + seg) * 64;
    const float* conv = P.in[15];
    LAS float* BUF = (LAS float*)lds; LAS float* O = BUF + 2 * GL_BUF; LAS float* YL = O + CH * 128;
    const int cq = h * 64 + lane, ck = 256 + h * 64 + lane, cv0 = 512 + h * 128 + lane, cv1 = cv0 + 64;
    float wq[4], wk[4], wv0[4], wv1[4];
#pragma unroll
    for (int j = 0; j < 4; ++j) { wq[j] = conv[j * 1024 + cq]; wk[j] = conv[j * 1024 + ck]; wv0[j] = conv[j * 1024 + cv0]; wv1[j] = conv[j * 1024 + cv1]; }
    const int r0 = wave * 16 + 2 * (lane >> 3), s8 = (lane & 7) * 8;
    f32x2 S0[4], S1[4], c[4];
#pragma unroll
    for (int i = 0; i < 4; ++i) { S0[i] = (f32x2){0.f, 0.f}; S1[i] = (f32x2){0.f, 0.f}; c[i] = (f32x2){1.f, 1.f}; }
    const int tbeg = seg * LSEG;
    unsigned x[4][4][4], gk[4];
    __syncthreads();
    gl_load(p, GK, b, h, tbeg, lane, wave, x, gk);
    gl_prep(BUF, tbeg, wave, lane, wq, wk, wv0, wv1, x, gk);
    __syncthreads();
    for (int ci = 0; ci < LSEG / CH; ++ci) {
        const int t0 = tbeg + ci * CH; LAS float* B = BUF + (ci & 1) * GL_BUF;
        LAS float* Q = B; LAS float* K = Q + CH * 64; LAS float* DEC = K + CH * 64; LAS float* V = DEC + CH * 64;
        const bool more = (ci + 1 < LSEG / CH);
        if (more) gl_load(p, GK, b, h, t0 + CH, lane, wave, x, gk);
        { GlOps oa, ob; gl_ops_load(oa, B, 0, s8, r0);
          for (int tt = 0; tt < CH; tt += 2) {
              gl_ops_load(ob, B, tt + 1, s8, r0); gl_step(oa, S0, S1, c, O, YL, tt, r0, s8, lane, wave);
              gl_ops_load(oa, B, (tt + 2) & (CH - 1), s8, r0); gl_step(ob, S0, S1, c, O, YL, tt + 1, r0, s8, lane, wave);
          } }
        __syncthreads();
        if (more) gl_prep(BUF + ((ci + 1) & 1) * GL_BUF, t0 + CH, wave, lane, wq, wk, wv0, wv1, x, gk);
#pragma unroll
        for (int q = 0; q < 4; ++q) {
            const int tt = wave + 8 * q; const size_t m = (size_t)b * T + t0 + tt;
            MIX[m * D + 512 + h * 128 + lane] = (bf16)f2bf(O[tt * 128 + lane]); MIX[m * D + 512 + h * 128 + 64 + lane] = (bf16)f2bf(O[tt * 128 + 64 + lane]);
            YIG[m * 256 + h * 64 + lane] = (bf16)f2bf(YL[tt * 64 + lane]);
        }
        __syncthreads();
    }
    *(f32x4*)(SE + r0 * 64 + s8) = (f32x4){S0[0].x, S0[0].y, S0[1].x, S0[1].y}; *(f32x4*)(SE + r0 * 64 + s8 + 4) = (f32x4){S0[2].x, S0[2].y, S0[3].x, S0[3].y};
    *(f32x4*)(SE + (r0 + 1) * 64 + s8) = (f32x4){S1[0].x, S1[0].y, S1[1].x, S1[1].y}; *(f32x4*)(SE + (r0 + 1) * 64 + s8 + 4) = (f32x4){S1[2].x, S1[2].y, S1[3].x, S1[3].y};
    if (wave == 0 && lane < 8) { *(f32x4*)(CE + s8) = (f32x4){c[0].x, c[0].y, c[1].x, c[1].y}; *(f32x4*)(CE + s8 + 4) = (f32x4){c[2].x, c[2].y, c[3].x, c[3].y}; }
}
__device__ __forceinline__ void phase_scan(const Params& P, LAS unsigned char* lds) {
    for (int it = blockIdx.x; it < 512 + 256; it += gridDim.x) {
        if (it < 512) { const int bh = it >> 4; rwkv_item(P, lds, bh >> 3, bh & 7, it & 15); }
        else { const int g = it - 512, bh = g >> 4; gla_item(P, lds, bh >> 2, bh & 3, g & 15); }
        __syncthreads();
    }
}
__device__ __forceinline__ void phase_fixup(const Params& P, LAS unsigned char* lds) {
    const int tid = threadIdx.x;
    for (int it = blockIdx.x; it < 48; it += gridDim.x) {
        if (it < 32) {
            float* SE = (float*)(P.ws + WS_SER) + (size_t)it * NSEG * 2 * 4096;
            LAS float* Sc = (LAS float*)lds; LAS float* Ph = Sc + 64 * 65;
            const int v = tid >> 3, kq = (tid & 7) * 8;
            __syncthreads();
            for (int i = tid; i < 64 * 65; i += NTHR) Sc[i] = 0.f;
            f32x4 pf0 = *(const f32x4*)(SE + 4096 + 4 * tid), pf1 = *(const f32x4*)(SE + 4096 + 4 * (tid + NTHR));
            f32x4 a0 = *(const f32x4*)(SE + v * 64 + kq), a1 = *(const f32x4*)(SE + v * 64 + kq + 4);
            for (int seg = 0; seg < NSEG - 1; ++seg) {
                float* s0 = SE + (size_t)(seg * 2 + 0) * 4096;
                __syncthreads();
                *(LAS f32x4*)(Ph + 4 * tid) = pf0; *(LAS f32x4*)(Ph + 4 * (tid + NTHR)) = pf1;
                f32x4 c0 = a0, c1 = a1;
                if (seg + 1 < NSEG - 1) { const float* nx = SE + (size_t)((seg + 1) * 2) * 4096; pf0 = *(const f32x4*)(nx + 4096 + 4 * tid); pf1 = *(const f32x4*)(nx + 4096 + 4 * (tid + NTHR)); a0 = *(const f32x4*)(nx + v * 64 + kq); a1 = *(const f32x4*)(nx + v * 64 + kq + 4); }
                __syncthreads();
                for (int j = 0; j < 64; ++j) { const float sv = Sc[v * 65 + j]; c0 += *(const LAS f32x4*)(Ph + j * 64 + kq) * sv; c1 += *(const LAS f32x4*)(Ph + j * 64 + kq + 4) * sv; }
                __syncthreads();
#pragma unroll
                for (int i = 0; i < 4; ++i) { Sc[v * 65 + kq + i] = c0[i]; Sc[v * 65 + kq + 4 + i] = c1[i]; }
                *(f32x4*)(s0 + v * 64 + kq) = c0; *(f32x4*)(s0 + v * 64 + kq + 4) = c1;
            }
        } else {
            const int bh = it - 32; float* SE = (float*)(P.ws + WS_SEG) + (size_t)bh * NSEG * 8192; const float* CE = (const float*)(P.ws + WS_CEND) + (size_t)bh * NSEG * 64;
            const int v = tid >> 2, d0 = (tid & 3) * 16; f32x4 sc[4];
#pragma unroll
            for (int q = 0; q < 4; ++q) sc[q] = (f32x4){0.f, 0.f, 0.f, 0.f};
            for (int seg = 0; seg < NSEG - 1; ++seg) {
#pragma unroll
                for (int q = 0; q < 4; ++q) { float* sp = SE + (size_t)seg * 8192 + v * 64 + d0 + 4 * q; sc[q] = sc[q] * *(const f32x4*)(CE + seg * 64 + d0 + 4 * q) + *(const f32x4*)sp; *(f32x4*)sp = sc[q]; }
            }
        }
    }
}
__device__ __forceinline__ float row_sum16(float v) { v = DPP_ADD(v, 0xB1); v = DPP_ADD(v, 0x4E); v = DPP_ADD(v, 0x141); v = DPP_ADD(v, 0x140); return v; }
__device__ __forceinline__ bf16x8_t pack_bf16x8(const f32x4 a, const f32x4 b) {
    u32x4 w; w.x = pk2(a[0], a[1]); w.y = pk2(a[2], a[3]); w.z = pk2(b[0], b[1]); w.w = pk2(b[2], b[3]); return __builtin_bit_cast(bf16x8_t, w);
}
__device__ __forceinline__ void unpack4(const u32x2 w, float (&o)[4]) { o[0] = __uint_as_float(w.x << 16); o[1] = __uint_as_float(w.x & 0xffff0000u); o[2] = __uint_as_float(w.y << 16); o[3] = __uint_as_float(w.y & 0xffff0000u); }
__device__ __forceinline__ void phase_correct(const Params& P, LAS unsigned char* lds) {
    const int tid = threadIdx.x, lane = tid & 63, wave = __builtin_amdgcn_readfirstlane(tid >> 6), fr = lane & 15, fq = lane >> 4;
    unsigned char* ws = P.ws;
    const bf16* p = (const bf16*)(ws + WS_P); const bf16* AA = (const bf16*)(ws + WS_AA); const bf16* GG = (const bf16*)(ws + WS_GG);
    bf16* MIX = (bf16*)(ws + WS_MIX); const bf16* YI = (const bf16*)(ws + WS_YI); const bf16* YIG = (const bf16*)(ws + WS_YIG);
    const float* mu = P.in[4]; const float* k_a = P.in[11]; const float* r_k = P.in[12]; const float* gn_g = P.in[13]; const float* gn_b = P.in[14]; const float* norm_g = P.in[18];
    LAS bf16* SB = (LAS bf16*)lds;
    for (int it = blockIdx.x; it < 512; it += gridDim.x) {
        {
            const int seg = it & 15, bh = it >> 4, b = bh >> 3, h = bh & 7;
            const int cb = h * 64 + 4 * fr;
            __syncthreads();
            if (seg > 0) { const float* ss = (const float*)(ws + WS_SER) + (((size_t)bh * NSEG + (seg - 1)) * 2) * 4096;
                for (int i = tid; i < 1024; i += NTHR) { const f32x4 x = *(const f32x4*)(ss + 4 * i); const int v = i >> 4, j = (4 * i) & 63; u32x2 w; w.x = pk2(x[0], x[1]); w.y = pk2(x[2], x[3]);
                    *(LAS u32x2*)(SB + ((v & 3) * 16 + (v >> 2)) * 72 + j) = w; } }
            __syncthreads();
            const f32x4 mur = *(const f32x4*)(mu + C_R + cb), muk = *(const f32x4*)(mu + C_K + cb), muv = *(const f32x4*)(mu + C_V + cb), kac = *(const f32x4*)(k_a + cb), rkc = *(const f32x4*)(r_k + cb), gng = *(const f32x4*)(gn_g + cb), gnb = *(const f32x4*)(gn_b + cb);
            for (int mt = 0; mt < 4; ++mt) {
                const int tb = seg * LSEG + wave * 64 + mt * 16;
                f32x4 acc[4];
#pragma unroll
                for (int vt = 0; vt < 4; ++vt) acc[vt] = (f32x4){0.f, 0.f, 0.f, 0.f};
                if (seg > 0) {
#pragma unroll
                    for (int sx = 0; sx < 2; ++sx) { const bf16x8_t af = *(const bf16x8_t*)(YI + ((size_t)b * T + tb + fr) * 512 + h * 64 + 32 * sx + 8 * fq);
#pragma unroll
                        for (int vt = 0; vt < 4; ++vt) acc[vt] = __builtin_amdgcn_mfma_f32_16x16x32_bf16(af, *(const LAS bf16x8_t*)(SB + (vt * 16 + fr) * 72 + 32 * sx + 8 * fq), acc[vt], 0, 0, 0); }
                }
                u32x2 W[2][9];
#define CORR_LOAD(buf, rg) do { const int t_ = tb + 4 * fq + (rg); const size_t m_ = (size_t)b * T + t_; const bf16* pr_ = p + m_ * NP + cb; const bf16* pp_ = (t_ > 0) ? pr_ - NP : pr_; \
                    W[buf][0] = *(const u32x2*)(MIX + m_ * D + cb); W[buf][1] = *(const u32x2*)(pr_ + C_R); W[buf][2] = *(const u32x2*)(pr_ + C_K); W[buf][3] = *(const u32x2*)(pr_ + C_V); \
                    W[buf][4] = *(const u32x2*)(pp_ + C_R); W[buf][5] = *(const u32x2*)(pp_ + C_K); W[buf][6] = *(const u32x2*)(pp_ + C_V); W[buf][7] = *(const u32x2*)(AA + m_ * A_W + cb); W[buf][8] = *(const u32x2*)(GG + m_ * A_W + cb); } while (0)
                CORR_LOAD(0, 0);
#pragma unroll
                for (int rg = 0; rg < 4; ++rg) { const int t = tb + 4 * fq + rg; const size_t m = (size_t)b * T + t; const float hp = (t > 0) ? 1.f : 0.f;
                    if (rg < 3) CORR_LOAD((rg + 1) & 1, rg + 1);
                    __builtin_amdgcn_sched_barrier(0);
                    float y[4], rc[4], kc[4], vc[4], rp_[4], kp[4], vp[4], a[4], g[4];
                    unpack4(W[rg & 1][0], y); unpack4(W[rg & 1][1], rc); unpack4(W[rg & 1][2], kc); unpack4(W[rg & 1][3], vc); unpack4(W[rg & 1][4], rp_); unpack4(W[rg & 1][5], kp); unpack4(W[rg & 1][6], vp); unpack4(W[rg & 1][7], a); unpack4(W[rg & 1][8], g);
                    float v[4], sy = 0.f, sb = 0.f;
#pragma unroll
                    for (int i = 0; i < 4; ++i) { y[i] += acc[i][rg];
                        const float r = rc[i] + (rp_[i] * hp - rc[i]) * mur[i], k = kc[i] + (kp[i] * hp - kc[i]) * muk[i]; v[i] = vc[i] + (vp[i] * hp - vc[i]) * muv[i];
                        const float kh = k * (1.f + (a[i] - 1.f) * kac[i]); sb += r * kh * rkc[i]; sy += y[i]; }
                    const float bon = row_sum16(sb), mean = row_sum16(sy) * (1.f / 64.f); float sq = 0.f;
#pragma unroll
                    for (int i = 0; i < 4; ++i) { y[i] -= mean; sq += y[i] * y[i]; }
                    const float rstd = 1.f / sqrtf(row_sum16(sq) * (1.f / 64.f) + GN_EPS); float o[4];
#pragma unroll
                    for (int i = 0; i < 4; ++i) o[i] = (y[i] * rstd * gng[i] + gnb[i] + bon * v[i]) * g[i];
                    u32x2 w; w.x = pk2(o[0], o[1]); w.y = pk2(o[2], o[3]); *(u32x2*)(MIX + m * D + cb) = w;
                    __builtin_amdgcn_sched_barrier(0); }
#undef CORR_LOAD
            }
        }
    }
    for (int g_ = blockIdx.x; g_ < 256; g_ += gridDim.x) {
        {
            const int seg = g_ & 15, bh = g_ >> 4, b = bh >> 2, h = bh & 3;
            const int cb = h * 128 + 8 * fr;
            __syncthreads();
            if (seg > 0) { const float* ss = (const float*)(ws + WS_SEG) + ((size_t)bh * NSEG + (seg - 1)) * 8192;
                for (int i = tid; i < 2048; i += NTHR) { const f32x4 x = *(const f32x4*)(ss + 4 * i); const int v = i >> 4, j = (4 * i) & 63; u32x2 w; w.x = pk2(x[0], x[1]); w.y = pk2(x[2], x[3]);
                    *(LAS u32x2*)(SB + ((v & 7) * 16 + (v >> 3)) * 72 + j) = w; } }
            __syncthreads();
            const f32x4 ng0 = *(const f32x4*)(norm_g + 8 * fr), ng1 = *(const f32x4*)(norm_g + 8 * fr + 4);
            for (int mt = 0; mt < 4; ++mt) {
                const int tb = seg * LSEG + wave * 64 + mt * 16;
                f32x4 acc[8];
#pragma unroll
                for (int vt = 0; vt < 8; ++vt) acc[vt] = (f32x4){0.f, 0.f, 0.f, 0.f};
                if (seg > 0) {
#pragma unroll
                    for (int sx = 0; sx < 2; ++sx) { const bf16x8_t af = *(const bf16x8_t*)(YIG + ((size_t)b * T + tb + fr) * 256 + h * 64 + 32 * sx + 8 * fq);
#pragma unroll
                        for (int vt = 0; vt < 8; ++vt) acc[vt] = __builtin_amdgcn_mfma_f32_16x16x32_bf16(af, *(const LAS bf16x8_t*)(SB + (vt * 16 + fr) * 72 + 32 * sx + 8 * fq), acc[vt], 0, 0, 0); }
                }
                u32x4 WG[2][2];
#define CORG_LOAD(buf, rg) do { const size_t m_ = (size_t)b * T + tb + 4 * fq + (rg); WG[buf][0] = *(const u32x4*)(MIX + m_ * D + 512 + cb); WG[buf][1] = *(const u32x4*)(p + m_ * NP + C_BG + cb); } while (0)
                CORG_LOAD(0, 0);
#pragma unroll
                for (int rg = 0; rg < 4; ++rg) { const size_t m = (size_t)b * T + tb + 4 * fq + rg;
                    if (rg < 3) CORG_LOAD((rg + 1) & 1, rg + 1);
                    __builtin_amdgcn_sched_barrier(0);
                    float o[8], g[8]; float sq = 0.f;
#pragma unroll
                    for (int i = 0; i < 4; ++i) { const unsigned a_ = WG[rg & 1][0][i], b_ = WG[rg & 1][1][i]; o[2 * i] = __uint_as_float(a_ << 16); o[2 * i + 1] = __uint_as_float(a_ & 0xffff0000u); g[2 * i] = __uint_as_float(b_ << 16); g[2 * i + 1] = __uint_as_float(b_ & 0xffff0000u); }
#pragma unroll
                    for (int i = 0; i < 8; ++i) { o[i] += acc[i][rg]; sq += o[i] * o[i]; }
                    const float rs = 1.f / sqrtf(row_sum16(sq) * (1.f / 128.f) + RMS_EPS);
                    float f[8];
#pragma unroll
                    for (int i = 0; i < 8; ++i) f[i] = o[i] * rs * (i < 4 ? ng0[i & 3] : ng1[i & 3]) * siluf_(g[i]);
                    u32x4 w; w.x = pk2(f[0], f[1]); w.y = pk2(f[2], f[3]); w.z = pk2(f[4], f[5]); w.w = pk2(f[6], f[7]); *(u32x4*)(MIX + m * D + 512 + cb) = w;
                    __builtin_amdgcn_sched_barrier(0); }
#undef CORG_LOAD
            }
        }
    }
}

__device__ __forceinline__ void phase_ln1(const Params& P) {
    const int lane = threadIdx.x & 63, wave = threadIdx.x >> 6; const int gw = blockIdx.x * NWAVES + wave, ngw = gridDim.x * NWAVES;
    for (int m = gw; m < M; m += ngw) ln_row_bf16((const float*)(P.ws + WS_Z) + (size_t)m * D, P.in[20], P.in[21], (bf16*)(P.ws + WS_H1) + (size_t)m * D, lane);
#pragma unroll
    for (int tb = 0; tb < 2; ++tb) {
        const float* src = P.in[24 + tb]; unsigned char* dst = P.ws + (tb ? WS_VT : WS_UT); float* sc = (float*)(P.ws + (tb ? WS_SV : WS_SU));
        for (int e = gw; e < 16384; e += ngw) {
            const f32x4* sp = (const f32x4*)(src + (size_t)e * D) + 4 * lane; f32x4 a[4]; float mx = 0.f;
#pragma unroll
            for (int j = 0; j < 4; ++j) { a[j] = sp[j]; mx = fmaxf(fmaxf(mx, fmaxf(fabsf(a[j][0]), fabsf(a[j][1]))), fmaxf(fabsf(a[j][2]), fabsf(a[j][3]))); }
            mx = wave_max_u(mx); const float inv = mx > 0.f ? 31.f / mx : 0.f;
            unsigned q[16];
#pragma unroll
            for (int i = 0; i < 16; ++i) q[i] = (unsigned)(__float2int_rn(a[i >> 2][i & 3] * inv) + 32);
            unsigned p0 = 0u, p1 = 0u, p2 = 0u;
#pragma unroll
            for (int b = 0; b < 4; ++b) {
                p0 |= ((q[b] & 15u) | ((q[4 + b] & 15u) << 4)) << (8 * b);
                p1 |= ((q[8 + b] & 15u) | ((q[12 + b] & 15u) << 4)) << (8 * b);
                p2 |= ((q[b] >> 4) | ((q[4 + b] >> 4) << 2) | ((q[8 + b] >> 4) << 4) | ((q[12 + b] >> 4) << 6)) << (8 * b);
            }
            unsigned* o = (unsigned*)(dst + (size_t)e * ROWB) + 3 * lane; o[0] = p0; o[1] = p1; o[2] = p2;
            if (lane == 0) sc[e] = mx * (1.f / 31.f);
        }
    }
}

#define TK_INS(L, x) do { _Pragma("unroll") for (int _j = 0; _j < 16; ++_j) { const unsigned _h = max(L[_j], x); x = min(L[_j], x); L[_j] = _h; } } while (0)
__device__ __forceinline__ void topk128(const u32x4* r, unsigned (&L)[16]) {
#pragma unroll
    for (int j = 0; j < 16; ++j) L[j] = 0u;
    u32x4 cur = r[0];
    for (int c = 0; c < 16; ++c) {
        const u32x4 nxt = r[(c + 1) & 15];
        const unsigned kb = 0xFFFFu - 8u * (unsigned)c;
#pragma unroll
        for (int d = 0; d < 4; ++d) {
            unsigned w = cur[d]; const unsigned msk = ((w >> 15) & 0x00010001u) * 0xFFFFu; w ^= (msk | 0x80008000u);
            unsigned x0 = (w << 16) | (kb - 2u * d), x1 = (w & 0xFFFF0000u) | (kb - 2u * d - 1u);
            TK_INS(L, x0); TK_INS(L, x1);
        }
        cur = nxt;
    }
}
__device__ __forceinline__ void phase_topk(const Params& P) {
    const int gl = blockIdx.x * NTHR + threadIdx.x, nl = gridDim.x * NTHR;
    const bf16* Sc = (const bf16*)(P.ws + WS_S); int* IDS = (int*)(P.ws + WS_IDS); float* GATES = (float*)(P.ws + WS_GATES);
    for (int item = gl; item < M * 8; item += nl) {
        const u32x4* row = (const u32x4*)(Sc + (size_t)item * 256);
        unsigned L0[16], L1[16];
        topk128(row, L0); topk128(row + 16, L1);
        float f0[16], f1[16]; unsigned p0[16], p1[16];
#pragma unroll
        for (int i = 0; i < 16; ++i) {
            f0[i] = __uint_as_float((L0[i] & 0x80000000u) ? (L0[i] & 0x7FFF0000u) : (~L0[i] & 0xFFFF0000u)); p0[i] = (~L0[i] & 0x7Fu) << 7;
            f1[i] = __uint_as_float((L1[i] & 0x80000000u) ? (L1[i] & 0x7FFF0000u) : (~L1[i] & 0xFFFF0000u)); p1[i] = (~L1[i] & 0x7Fu);
        }
        unsigned C[16];
#pragma unroll
        for (int j = 0; j < 16; ++j) C[j] = 0u;
#pragma unroll
        for (int i = 0; i < 16; ++i)
#pragma unroll
            for (int j = 0; j < 16; ++j)
                if ((i + 1) * (j + 1) <= 16) {
                    const unsigned b = __float_as_uint(f0[i] + f1[j]); const unsigned mono = b ^ ((unsigned)((int)b >> 31) | 0x80000000u);
                    unsigned key = (mono & 0xFFFFC000u) | p0[i] | p1[j];
                    TK_INS(C, key);
                }
        float cv[16];
#pragma unroll
        for (int r = 0; r < 16; ++r) cv[r] = __uint_as_float((C[r] & 0x80000000u) ? (C[r] & 0x7FFFC000u) : (~C[r] & 0xFFFFC000u));
        const float cmax = cv[0]; float den = 0.f;
#pragma unroll
        for (int r = 0; r < 16; ++r) { cv[r] = __expf(cv[r] - cmax); den += cv[r]; }
        const float inv = 1.f / den;
        u32x4* ido = (u32x4*)(IDS + (size_t)item * 16); f32x4* go = (f32x4*)(GATES + (size_t)item * 16);
#pragma unroll
        for (int q = 0; q < 4; ++q) { u32x4 o; o.x = C[4 * q] & 0x3FFFu; o.y = C[4 * q + 1] & 0x3FFFu; o.z = C[4 * q + 2] & 0x3FFFu; o.w = C[4 * q + 3] & 0x3FFFu; ido[q] = o;
            f32x4 g; g[0] = cv[4 * q] * inv; g[1] = cv[4 * q + 1] * inv; g[2] = cv[4 * q + 2] * inv; g[3] = cv[4 * q + 3] * inv; go[q] = g; }
    }
}

typedef __bf16 bf16x2_t __attribute__((ext_vector_type(2)));
__device__ __forceinline__ float dot2bf(unsigned a, unsigned b, float c) { return __builtin_amdgcn_fdot2_f32_bf16(__builtin_bit_cast(bf16x2_t, a), __builtin_bit_cast(bf16x2_t, b), c, false); }
typedef unsigned u32x3 __attribute__((ext_vector_type(3)));
__device__ __forceinline__ void peer_load8(u32x3 (&buf)[8], const unsigned char* TAB, int idreg, int g, int lane) {
#pragma unroll
    for (int q = 0; q < 8; ++q) { const int id = __builtin_amdgcn_readlane(idreg, 8 * g + q); const unsigned* rp = (const unsigned*)(TAB + (size_t)id * ROWB) + 3 * lane; u32x3 w; w.x = rp[0]; w.y = rp[1]; w.z = rp[2]; buf[q] = w; }
}
__device__ __forceinline__ void peer_dots8(const u32x3 (&buf)[8], const u32x4& hq, int g, float& d, int lane) {
#pragma unroll
    for (int q = 0; q < 8; ++q) { const unsigned p0 = buf[q].x, p1 = buf[q].y, p2 = buf[q].z; int s = 0, t = 0;
        s = __builtin_amdgcn_sdot4((int)(p0 & 0x0F0F0F0Fu), (int)hq[0], s, false); s = __builtin_amdgcn_sdot4((int)((p0 >> 4) & 0x0F0F0F0Fu), (int)hq[1], s, false);
        s = __builtin_amdgcn_sdot4((int)(p1 & 0x0F0F0F0Fu), (int)hq[2], s, false); s = __builtin_amdgcn_sdot4((int)((p1 >> 4) & 0x0F0F0F0Fu), (int)hq[3], s, false);
#pragma unroll
        for (int f = 0; f < 4; ++f) t = __builtin_amdgcn_sdot4((int)((p2 >> (2 * f)) & 0x03030303u), (int)hq[f], t, false);
        const int tot = wave_sum_i(s + 16 * t);
        d = (lane == 8 * g + q) ? (float)tot : d; }
}
__device__ __forceinline__ void peer_axpy8(const u32x3 (&buf)[8], float areg, int g, float (&acc)[16]) {
#pragma unroll
    for (int q = 0; q < 8; ++q) { const float a = rlf(areg, 8 * g + q); const unsigned p0 = buf[q].x, p1 = buf[q].y, p2 = buf[q].z;
        const unsigned v0 = (p0 & 0x0F0F0F0Fu) | ((p2 & 0x03030303u) << 4), v1 = ((p0 >> 4) & 0x0F0F0F0Fu) | (((p2 >> 2) & 0x03030303u) << 4);
        const unsigned v2 = (p1 & 0x0F0F0F0Fu) | (((p2 >> 4) & 0x03030303u) << 4), v3 = ((p1 >> 4) & 0x0F0F0F0Fu) | (((p2 >> 6) & 0x03030303u) << 4);
        const unsigned vv[4] = {v0, v1, v2, v3};
#pragma unroll
        for (int i = 0; i < 4; ++i) { const unsigned w = vv[i];
            acc[4 * i] += a * (float)(w & 0xffu); acc[4 * i + 1] += a * (float)((w >> 8) & 0xffu); acc[4 * i + 2] += a * (float)((w >> 16) & 0xffu); acc[4 * i + 3] += a * (float)(w >> 24); } }
}
__device__ __forceinline__ void phase_peer(const Params& P) {
    const int lane = threadIdx.x & 63, wave = threadIdx.x >> 6; const int gw = blockIdx.x * NWAVES + wave, ngw = gridDim.x * NWAVES;
    const bf16* H1 = (const bf16*)(P.ws + WS_H1); const int* IDS = (const int*)(P.ws + WS_IDS); const float* GATES = (const float*)(P.ws + WS_GATES);
    const unsigned char* UT = P.ws + WS_UT; const unsigned char* VT = P.ws + WS_VT; const float* SU = (const float*)(P.ws + WS_SU); const float* SV = (const float*)(P.ws + WS_SV);
    const float* g2 = P.in[26]; const float* b2 = P.in[27];
    for (int m = gw; m < M; m += ngw) {
        const u32x4* hp = (const u32x4*)(H1 + (size_t)m * D) + 2 * lane; const u32x4 hA = hp[0], hB = hp[1];
        float hv[16]; float hmx = 0.f;
#pragma unroll
        for (int i = 0; i < 4; ++i) { hv[2 * i] = __uint_as_float(hA[i] << 16); hv[2 * i + 1] = __uint_as_float(hA[i] & 0xffff0000u); hv[8 + 2 * i] = __uint_as_float(hB[i] << 16); hv[8 + 2 * i + 1] = __uint_as_float(hB[i] & 0xffff0000u); }
#pragma unroll
        for (int i = 0; i < 16; ++i) hmx = fmaxf(hmx, fabsf(hv[i]));
        hmx = wave_max_u(hmx); const float hinv = hmx > 0.f ? 127.f / hmx : 0.f, hsc = hmx * (1.f / 127.f);
        u32x4 hq;
#pragma unroll
        for (int i = 0; i < 4; ++i) hq[i] = pack_i8(hv[4 * i], hv[4 * i + 1], hv[4 * i + 2], hv[4 * i + 3], hinv, 0);
        int hs = 0;
#pragma unroll
        for (int i = 0; i < 4; ++i) hs = __builtin_amdgcn_sdot4((int)hq[i], 0x01010101, hs, false);
        const float hoff = 32.f * (float)wave_sum_i(hs);
        const int id_lo = IDS[(size_t)m * 128 + lane], id_hi = IDS[(size_t)m * 128 + 64 + lane];
        const float gt_lo = GATES[(size_t)m * 128 + lane], gt_hi = GATES[(size_t)m * 128 + 64 + lane];
        const float su_lo = SU[id_lo], su_hi = SU[id_hi], sv_lo = SV[id_lo], sv_hi = SV[id_hi];
        float d_lo = 0.f, d_hi = 0.f;
        u32x3 A0[8], A1[8];
        peer_load8(A0, UT, id_lo, 0, lane);
        for (int g = 0; g < 8; g += 2) {
            peer_load8(A1, UT, id_lo, g + 1, lane); peer_dots8(A0, hq, g, d_lo, lane);
            if (g + 2 < 8) peer_load8(A0, UT, id_lo, g + 2, lane); else peer_load8(A0, UT, id_hi, 0, lane);
            peer_dots8(A1, hq, g + 1, d_lo, lane);
        }
        for (int g = 0; g < 8; g += 2) {
            peer_load8(A1, UT, id_hi, g + 1, lane); peer_dots8(A0, hq, g, d_hi, lane);
            if (g + 2 < 8) peer_load8(A0, UT, id_hi, g + 2, lane); else peer_load8(A0, VT, id_lo, 0, lane);
            peer_dots8(A1, hq, g + 1, d_hi, lane);
        }
        const float x_lo = (d_lo - hoff) * su_lo * hsc, x_hi = (d_hi - hoff) * su_hi * hsc;
        const float a_lo = 0.5f * x_lo * (1.f + erff(x_lo * 0.70710678118f)) * gt_lo * sv_lo, a_hi = 0.5f * x_hi * (1.f + erff(x_hi * 0.70710678118f)) * gt_hi * sv_hi;
        const float c0 = 32.f * wave_sum(a_lo + a_hi);
        float acc[16];
#pragma unroll
        for (int i = 0; i < 16; ++i) acc[i] = 0.f;
        for (int g = 0; g < 8; g += 2) {
            peer_load8(A1, VT, id_lo, g + 1, lane); peer_axpy8(A0, a_lo, g, acc);
            if (g + 2 < 8) peer_load8(A0, VT, id_lo, g + 2, lane); else peer_load8(A0, VT, id_hi, 0, lane);
            peer_axpy8(A1, a_lo, g + 1, acc);
        }
        for (int g = 0; g < 8; g += 2) {
            peer_load8(A1, VT, id_hi, g + 1, lane); peer_axpy8(A0, a_hi, g, acc);
            if (g + 2 < 8) peer_load8(A0, VT, id_hi, g + 2, lane);
            peer_axpy8(A1, a_hi, g + 1, acc);
        }
        float s = 0.f;
#pragma unroll
        for (int i = 0; i < 16; ++i) { acc[i] = ALPHA * hv[i] + (acc[i] - c0); s += acc[i]; }
        const float mean = wave_sum(s) * (1.f / D); float s2 = 0.f;
#pragma unroll
        for (int i = 0; i < 16; ++i) { acc[i] -= mean; s2 += acc[i] * acc[i]; }
        const float rstd = 1.f / sqrtf(wave_sum(s2) * (1.f / D) + LN_EPS);
#pragma unroll
        for (int c4 = 0; c4 < 4; ++c4) { const int e0 = 16 * lane + 4 * c4; const f32x4 gg = *(const f32x4*)(g2 + e0), bb = *(const f32x4*)(b2 + e0); f32x4 o;
#pragma unroll
            for (int j = 0; j < 4; ++j) o[j] = acc[c4 * 4 + j] * rstd * gg[j] + bb[j];
            *(f32x4*)(P.out + (size_t)m * D + e0) = o; }
    }
}

#define XB_TMO      128
#define XB_XCNT(j)  (256  + 64 * (j))
#define XB_XSUB(j)  (1280 + 64 * (j))
#define XB_XGEN(j)  (2304 + 64 * (j))
#define XB_TOP      3328
#define XB_TOPGEN   3392
#define XCD_BAR_WORDS 3456
#define XB_SPIN_CAP (1u << 18)
__device__ __forceinline__ unsigned xb_ld(unsigned* p)              { return __hip_atomic_load(p, __ATOMIC_RELAXED, __HIP_MEMORY_SCOPE_AGENT); }
__device__ __forceinline__ unsigned xb_add(unsigned* p, unsigned v) { return __hip_atomic_fetch_add(p, v, __ATOMIC_RELAXED, __HIP_MEMORY_SCOPE_AGENT); }
__device__ __forceinline__ unsigned xb_xcc_id() { return (unsigned)__builtin_amdgcn_s_getreg((3 << 11) | 20) & 0xFu; }
#define XB_SPIN(cond, bar) do { unsigned _sp = 0; while (cond) { __builtin_amdgcn_s_sleep(1); \
    if ((++_sp & 255u) == 0u) { if (xb_ld(&(bar)[XB_TMO])) break; if (_sp > XB_SPIN_CAP) { atomicAdd(&(bar)[XB_TMO], 1u); break; } } } } while (0)
struct XcdBarrier { unsigned* bar; unsigned x; volatile LAS unsigned* st; };
__device__ __forceinline__ XcdBarrier xcd_barrier_post(unsigned* bar, volatile LAS unsigned* st) {
    XcdBarrier b; b.bar = bar; b.x = xb_xcc_id(); b.st = st;
    if (threadIdx.x == 0) (void)xb_add(&bar[XB_XCNT(b.x)], 1u);
    return b;
}
__device__ __forceinline__ void xcd_barrier_complete(unsigned* bar, unsigned x, unsigned& nloc, unsigned& nx) {
    const unsigned G = gridDim.x * gridDim.y * gridDim.z;
    unsigned sum, cnt, mine, sp = 0u;
    for (;;) {
        sum = 0u; cnt = 0u; mine = 0u;
#pragma unroll
        for (unsigned j = 0; j < 16; ++j) { const unsigned c = xb_ld(&bar[XB_XCNT(j)]); sum += c; cnt += (c > 0u) ? 1u : 0u; mine = (j == x) ? c : mine; }
        if (sum == G) break;
        __builtin_amdgcn_s_sleep(1);
        if ((++sp & 255u) == 0u) { if (xb_ld(&bar[XB_TMO])) break; if (sp > XB_SPIN_CAP) { atomicAdd(&bar[XB_TMO], 1u); break; } }
    }
    nloc = mine > 0u ? mine : 1u; nx = cnt > 0u ? cnt : 1u;
}
__device__ __forceinline__ void xcd_barrier(const XcdBarrier& b) {
    asm volatile("s_waitcnt vmcnt(0)" ::: "memory");
    __syncthreads();
    if (threadIdx.x == 0) {
        unsigned* bar = b.bar;
        __builtin_amdgcn_s_waitcnt(0);
        unsigned nloc = b.st[0], nx = b.st[1];
        if (nloc == 0u) { xcd_barrier_complete(bar, b.x, nloc, nx); b.st[0] = nloc; b.st[1] = nx; }
        const unsigned old = xb_add(&bar[XB_XSUB(b.x)], 1u);
        const unsigned gen = old / nloc;
        if (old + 1u == (gen + 1u) * nloc) {
            __builtin_amdgcn_fence(__ATOMIC_RELEASE, "agent");
            asm volatile("s_waitcnt vmcnt(0)" ::: "memory");
            const unsigned og = xb_add(&bar[XB_TOP], 1u);
            const unsigned tg = og / nx;
            if (og + 1u == (tg + 1u) * nx) xb_add(&bar[XB_TOPGEN], 1u);
            else XB_SPIN(xb_ld(&bar[XB_TOPGEN]) == tg, bar);
            __builtin_amdgcn_fence(__ATOMIC_ACQUIRE, "agent");
            xb_add(&bar[XB_XGEN(b.x)], 1u);
            asm volatile("s_waitcnt vmcnt(0)" ::: "memory");
        } else {
            XB_SPIN(xb_ld(&bar[XB_XGEN(b.x)]) == gen, bar);
            __builtin_amdgcn_fence(__ATOMIC_ACQUIRE, "agent");
            asm volatile("s_waitcnt vmcnt(0)" ::: "memory");
        }
    }
    __syncthreads();
}

constexpr int N_PHASES = 12;
__global__ void __launch_bounds__(NTHR, 2) fwd_kernel(Params P) {
    extern __shared__ __attribute__((aligned(16))) unsigned char lds_raw[];
    LAS unsigned char* lds = (LAS unsigned char*)lds_raw;
    cg::grid_group grid = cg::this_grid();
    const int lo = P.ph_lo, hi = P.ph_hi;
    unsigned char* ws = P.ws;
    volatile LAS unsigned* bst = (volatile LAS unsigned*)(lds + LDS_MISC);
    if (threadIdx.x < 16) bst[threadIdx.x] = 0u;
    __syncthreads();
    const XcdBarrier bar = xcd_barrier_post((unsigned*)(ws + WS_CTL), bst);
#define IN(k) (lo <= (k) && (k) < hi)
#define SEAM(k) do { if (IN(k) && IN((k) + 1)) { if ((k) == 0) grid.sync(); else xcd_barrier(bar); } } while (0)
    if (IN(0)) phase_prologue(P);
    SEAM(0);
    if (IN(1)) {
        pg8::Gemm g{(const bf16*)(ws + WS_H0), (const bf16*)(ws + WS_WIN), M, NP, D, D, D, 0}; pg8::StaticOrder S; S.init(M, NP, gridDim.x, blockIdx.x);
        pg8::EpiBf16 E{(bf16*)(ws + WS_P), NP};
        pg8::gemm_phase<pg8::EpiBf16, pg8::StaticOrder, true, true>(lds, g, S, E);
    }
    SEAM(1);
    if (IN(2)) phase_prep(P, lds);
    SEAM(2);
    if (IN(3)) phase_scan(P, lds);
    SEAM(3);
    if (IN(4)) phase_fixup(P, lds);
    SEAM(4);
    if (IN(5)) phase_correct(P, lds);
    SEAM(5);
    if (IN(6)) {
        pg8::Gemm g{(const bf16*)(ws + WS_MIX), (const bf16*)(ws + WS_WOUT), M, D, D, D, D, 0}; pg8::StaticOrder S; S.init(M, D, gridDim.x, blockIdx.x);
        pg8::EpiResF32 E{(float*)(ws + WS_Z), (const bf16*)(ws + WS_H0), D, ALPHA};
        pg8::gemm_phase<pg8::EpiResF32, pg8::StaticOrder, true, true>(lds, g, S, E);
    }
    SEAM(6);
    if (IN(7)) phase_ln1(P);
    SEAM(7);
    if (IN(8)) {
        pg8::Gemm g{(const bf16*)(ws + WS_H1), (const bf16*)(ws + WS_WQ), M, NQ, D, D, D, 0}; pg8::StaticOrder S; S.init(M, NQ, gridDim.x, blockIdx.x);
        pg8::EpiBf16 E{(bf16*)(ws + WS_Q), NQ};
        pg8::gemm_phase<pg8::EpiBf16, pg8::StaticOrder, true, true>(lds, g, S, E);
    }
    SEAM(8);
    if (IN(9)) {
        pg8::Gemm g{(const bf16*)(ws + WS_Q), (const bf16*)(ws + WS_KBD), M, NQ, 256, NQ, 256, 256}; pg8::StaticOrder S; S.init(M, NQ, gridDim.x, blockIdx.x);
        pg8::EpiBf16 E{(bf16*)(ws + WS_S), NQ};
        pg8::gemm_phase<pg8::EpiBf16, pg8::StaticOrder, true, true>(lds, g, S, E);
    }
    SEAM(9);
    if (IN(10)) phase_topk(P);
    SEAM(10);
    if (IN(11)) phase_peer(P);
#undef IN
#undef SEAM
}

extern "C" void kernel_launch(void* const* d_in, const int* in_sizes, int n_in, void* d_out, int out_size, void* d_ws, size_t ws_size, hipStream_t stream) {
    static int grid = 0;
    if (grid == 0) {
        if (n_in != 28 || out_size != M * D || ws_size < WS_END) { fprintf(stderr, "kernel_launch: unexpected shapes (n_in %d out %d ws %zu)\n", n_in, out_size, ws_size); grid = -1; return; }
        int dev = 0, cus = 0, per_cu = 0;
        (void)hipGetDevice(&dev); (void)hipDeviceGetAttribute(&cus, hipDeviceAttributeMultiprocessorCount, dev);
        (void)hipFuncSetAttribute((const void*)fwd_kernel, hipFuncAttributeMaxDynamicSharedMemorySize, LDS_BYTES);
        (void)hipOccupancyMaxActiveBlocksPerMultiprocessor(&per_cu, (const void*)fwd_kernel, NTHR, LDS_BYTES);
        if (per_cu < 1) { fprintf(stderr, "kernel_launch: occupancy query says %d blocks per CU\n", per_cu); per_cu = 1; }
        (void)hipGetLastError();
        grid = cus;
    }
    if (grid < 0) return;
    Params p{};
    for (int i = 0; i < 28; ++i) p.in[i] = (const float*)d_in[i];
    p.out = (float*)d_out; p.ws = (unsigned char*)d_ws;
    (void)hipMemsetAsync((char*)d_ws + WS_CTL, 0, CTL_BYTES, stream);
#if MK_ONE_LAUNCH
    p.ph_lo = 0; p.ph_hi = N_PHASES;
    void* args[] = {&p};
    hipError_t e = hipLaunchCooperativeKernel((const void*)fwd_kernel, dim3(grid), dim3(NTHR), args, LDS_BYTES, stream);
    if (e != hipSuccess) fprintf(stderr, "cooperative launch failed: %s (grid %d)\n", hipGetErrorString(e), grid);
#else
    for (int ph = 0; ph < N_PHASES; ++ph) {
        p.ph_lo = ph; p.ph_hi = ph + 1;
        hipLaunchKernelGGL(fwd_kernel, dim3(grid), dim3(NTHR), LDS_BYTES, stream, p);
    }
#endif
}
```

```cpp
#include <hip/hip_runtime.h>
#include <hip/hip_cooperative_groups.h>
#include <cstdio>
#include <cstdint>
namespace cg = cooperative_groups;

#ifndef MK_ONE_LAUNCH
#define MK_ONE_LAUNCH 1
#endif

namespace pg8 {
#define PG8_LAS __attribute__((address_space(3)))
typedef unsigned short bf16_t;
typedef short bf16x8 __attribute__((ext_vector_type(8)));
typedef float f32x4 __attribute__((ext_vector_type(4)));
typedef float f32x2 __attribute__((ext_vector_type(2)));
typedef unsigned u32x4 __attribute__((ext_vector_type(4)));
typedef unsigned u32x2 __attribute__((ext_vector_type(2)));
constexpr int BM = 256, BK = 64, HALF = 128, HTB = HALF * BK * 2, STAGE_BYTES = 8 * HTB, NXCD = 8, WGM = 8;

__host__ __device__ __forceinline__ int lds_byte(int r, int c) { const int st = (r >> 4) * 2 + (c >> 5), rr = r & 15, cc = c & 31, ob = rr * 64 + cc * 2; return st * 1024 + (ob ^ (((ob >> 9) & 1) << 5)); }
__host__ __device__ __forceinline__ void stage_rc(int b, int& R, int& C) { const int st = b / 1024, sb = b % 1024, swz = sb ^ (((sb >> 9) & 1) << 5); R = (st >> 1) * 16 + swz / 64; C = (st & 1) * 32 + (swz % 64) / 2; }
__host__ __device__ __forceinline__ int perm32(int rho) { const int n = rho >> 4, i = rho & 15; return 8 * (i >> 2) + 4 * n + (i & 3); }

struct Unit { int pm, pn; };
struct Gemm { const bf16_t* A; const bf16_t* Bt; int M, N, K, lda, ldb, a_pn_koff; };

struct StaticOrder {
    int nM, nN, nwg, G, c;
    __host__ __device__ void init(int M, int N, int G_, int c_) { nM = M / BM; nN = N / BM; nwg = nM * nN; G = G_; c = c_; }
    __host__ __device__ bool next(int i, Unit& u) const {
        const long L = (long)i * G + c; if (L >= nwg) return false;
        int wgid = (int)L; { const int q = nwg / NXCD, r = nwg % NXCD, xcd = wgid % NXCD, off = wgid / NXCD; wgid = (xcd < r ? xcd * (q + 1) : r * (q + 1) + (xcd - r) * q) + off; }
        const int nig = WGM * nN, gid = wgid / nig, fm = gid * WGM, gsz = (nM - fm) < WGM ? (nM - fm) : WGM;
        u.pm = fm + ((wgid % nig) % gsz); u.pn = (wgid % nig) / gsz; return true;
    }
    __device__ __forceinline__ void a_ready(const Unit&) const {}
    __device__ __forceinline__ void done(const Unit&) const {}
};

__device__ __forceinline__ unsigned cvt_pk_bf16(float lo, float hi) { unsigned r; asm volatile("v_cvt_pk_bf16_f32 %0, %1, %2" : "=v"(r) : "v"(lo), "v"(hi)); return r; }

struct EpiBf16 {
    static constexpr bool PERM = true;
    bf16_t* O; int ldc;
    __device__ __forceinline__ void operator()(const f32x4 (&acc)[2][2][4][2], const Unit& u, int wr, int wc, int fr, int fq) const {
        const int row0 = u.pm * BM + wr * 64 + fr; const int col0 = u.pn * BM + wc * 32 + 8 * fq;
#pragma unroll
        for (int ai = 0; ai < 2; ++ai)
#pragma unroll
            for (int m = 0; m < 4; ++m) { bf16_t* rowp = O + (size_t)(row0 + ai * HALF + m * 16) * ldc + col0;
#pragma unroll
                for (int bj = 0; bj < 2; ++bj) { const f32x4 v0 = acc[ai][bj][m][0], v1 = acc[ai][bj][m][1];
                    u32x4 w; w.x = cvt_pk_bf16(v0[0], v0[1]); w.y = cvt_pk_bf16(v0[2], v0[3]); w.z = cvt_pk_bf16(v1[0], v1[1]); w.w = cvt_pk_bf16(v1[2], v1[3]);
                    *(u32x4*)(rowp + bj * HALF) = w; } }
    }
};
struct EpiResF32 {
    static constexpr bool PERM = false;
    float* Z; const bf16_t* R; int ldc; float alpha;
    __device__ __forceinline__ void operator()(const f32x4 (&acc)[2][2][4][2], const Unit& u, int wr, int wc, int fr, int fq) const {
        const int row0 = u.pm * BM + wr * 64 + fr; const int col0 = u.pn * BM + wc * 32 + 4 * fq;
#pragma unroll
        for (int ai = 0; ai < 2; ++ai)
#pragma unroll
            for (int m = 0; m < 4; ++m) { const size_t off = (size_t)(row0 + ai * HALF + m * 16) * ldc + col0;
#pragma unroll
                for (int bj = 0; bj < 2; ++bj)
#pragma unroll
                    for (int n = 0; n < 2; ++n) { const size_t o2 = off + bj * HALF + n * 16; const u32x2 rb = *(const u32x2*)(R + o2);
                        f32x4 h; h[0] = __uint_as_float(rb.x << 16); h[1] = __uint_as_float(rb.x & 0xffff0000u); h[2] = __uint_as_float(rb.y << 16); h[3] = __uint_as_float(rb.y & 0xffff0000u);
                        *(f32x4*)(Z + o2) = h * alpha + acc[ai][bj][m][n]; } }
    }
};

template <class Epi, class Sched, bool ALIGN_EPI = false, bool SP2 = false>
__device__ __forceinline__ void gemm_phase(PG8_LAS unsigned char* lds, const Gemm g, const Sched& S, const Epi& E) {
    const int tid = threadIdx.x, wid = __builtin_amdgcn_readfirstlane(tid >> 6), lane = tid & 63, wr = wid >> 2, wc = wid & 3, fr = lane & 15, fq = lane >> 4;
    const int K = g.K, nt = K / BK;
    unsigned voffA[2], voffB[2];
#pragma unroll
    for (int i = 0; i < 2; ++i) { int R, C; stage_rc(tid * 16 + i * 8192, R, C); const int Rb = Epi::PERM ? ((R & ~31) + perm32(R & 31)) : R;
        voffA[i] = (unsigned)(R * g.lda + C) * 2u; voffB[i] = (unsigned)(Rb * g.ldb + C) * 2u; }
    const size_t kstep = (size_t)(BK * 2);
    const size_t hstepA = (size_t)HALF * g.lda * 2, hstepB = (size_t)HALF * g.ldb * 2;
    const size_t tstepA = 2 * hstepA, tstepB = 2 * hstepB;
    const size_t pnA = (size_t)g.a_pn_koff * 2;
    const unsigned ldsw = (unsigned)wid * 1024u;
    const int aoff = lds_byte(wr * 64 + fr, fq * 8), boff = lds_byte(wc * 32 + fr, fq * 8);
#define PG8_SA(b, h) (((b) * 2 + (h)) * HTB)
#define PG8_SB(b, h) ((4 + (b) * 2 + (h)) * HTB)
#define PG8_STAGE(bufoff, gbase, voff) do { _Pragma("unroll") for (int _i = 0; _i < 2; ++_i) \
        __builtin_amdgcn_global_load_lds((const unsigned*)((const char*)(gbase) + (voff)[_i]), (PG8_LAS unsigned*)(lds + (bufoff) + ldsw + _i * 8192), 16, 0, 0); } while (0)
#define PG8_LDA(dst, b, h) do { _Pragma("unroll") for (int m = 0; m < 4; ++m) _Pragma("unroll") for (int k = 0; k < 2; ++k) dst[m][k] = *(const PG8_LAS bf16x8*)(lds + PG8_SA(b, h) + aoff + m * 2048 + k * 1024); } while (0)
#define PG8_LDB(dst, b, h) do { _Pragma("unroll") for (int n = 0; n < 2; ++n) _Pragma("unroll") for (int k = 0; k < 2; ++k) dst[n][k] = *(const PG8_LAS bf16x8*)(lds + PG8_SB(b, h) + boff + n * 2048 + k * 1024); } while (0)
#define PG8_MMA(ai, bj, At, Bt) do { __builtin_amdgcn_s_setprio(1); _Pragma("unroll") for (int m = 0; m < 4; ++m) _Pragma("unroll") for (int n = 0; n < 2; ++n) _Pragma("unroll") for (int k = 0; k < 2; ++k) \
        acc[ai][bj][m][n] = __builtin_amdgcn_mfma_f32_16x16x32_bf16(Bt[n][k], At[m][k], acc[ai][bj][m][n], 0, 0, 0); __builtin_amdgcn_s_setprio(0); } while (0)
#define PG8_WAIT_V(n) asm volatile("s_waitcnt vmcnt(" #n ")" ::: "memory")
#define PG8_WAIT_L(n) asm volatile("s_waitcnt lgkmcnt(" #n ")" ::: "memory")
#define PG8_BAR __builtin_amdgcn_s_barrier()
#define PG8_SCHED __builtin_amdgcn_sched_barrier(0)
    Unit cur, nxt; int ui = 0;
    if (!S.next(0, cur)) return;
    f32x4 acc[2][2][4][2];
#pragma unroll
    for (int a = 0; a < 2; ++a)
#pragma unroll
        for (int b = 0; b < 2; ++b)
#pragma unroll
            for (int m = 0; m < 4; ++m)
#pragma unroll
                for (int n = 0; n < 2; ++n) acc[a][b][m][n] = (f32x4){0.f, 0.f, 0.f, 0.f};
    bf16x8 At[4][2], B0[2][2], B1[2][2];
    const char* cA = (const char*)g.A + (size_t)cur.pm * tstepA + (size_t)cur.pn * pnA; const char* cB = (const char*)g.Bt + (size_t)cur.pn * tstepB;
    S.a_ready(cur);
    if constexpr (SP2) {
        PG8_STAGE(PG8_SB(0, 0), cB, voffB); PG8_STAGE(PG8_SB(0, 1), cB + hstepB, voffB); PG8_STAGE(PG8_SA(0, 0), cA, voffA); PG8_STAGE(PG8_SA(0, 1), cA + hstepA, voffA);
        if (wr == 1) PG8_BAR;
        PG8_WAIT_V(2); PG8_BAR;
        PG8_STAGE(PG8_SB(1, 0), cB + kstep, voffB); PG8_STAGE(PG8_SA(1, 0), cA + kstep, voffA); PG8_STAGE(PG8_SB(1, 1), cB + hstepB + kstep, voffB);
        PG8_WAIT_V(6); PG8_BAR;
    } else {
        PG8_STAGE(PG8_SB(0, 0), cB, voffB); PG8_STAGE(PG8_SA(0, 0), cA, voffA); PG8_STAGE(PG8_SB(0, 1), cB + hstepB, voffB); PG8_STAGE(PG8_SA(0, 1), cA + hstepA, voffA);
        if (wr == 1) PG8_BAR;
        PG8_WAIT_V(4); PG8_BAR;
        PG8_STAGE(PG8_SB(1, 0), cB + kstep, voffB); PG8_STAGE(PG8_SA(1, 0), cA + kstep, voffA); PG8_STAGE(PG8_SB(1, 1), cB + hstepB + kstep, voffB);
        PG8_WAIT_V(6); PG8_BAR;
    }
    for (;;) {
        const bool has_next = S.next(ui + 1, nxt);
        const char* nA = has_next ? (const char*)g.A + (size_t)nxt.pm * tstepA + (size_t)nxt.pn * pnA : cA; const char* nB = has_next ? (const char*)g.Bt + (size_t)nxt.pn * tstepB : cB;
        for (int t = 0; t < nt; t += 2) {
            const bool last = (t == nt - 2);
            const char* a1 = cA + (size_t)(t + 1) * kstep;
            const char* a2 = last ? nA : cA + (size_t)(t + 2) * kstep; const char* b2 = last ? nB : cB + (size_t)(t + 2) * kstep;
            const char* a3 = a2 + kstep; const char* b3 = b2 + kstep;
            if (last && has_next) S.a_ready(nxt);
            if constexpr (SP2) {
            PG8_LDB(B0, 0, 0); PG8_LDB(B1, 0, 1); PG8_SCHED; PG8_LDA(At, 0, 0); PG8_STAGE(PG8_SA(1, 1), a1 + hstepA, voffA);
            PG8_WAIT_V(8); PG8_WAIT_L(0); PG8_BAR; PG8_MMA(0, 0, At, B0); PG8_MMA(0, 1, At, B1); PG8_BAR; PG8_SCHED;
            PG8_LDA(At, 0, 1); PG8_STAGE(PG8_SB(0, 0), b2, voffB); PG8_STAGE(PG8_SB(0, 1), b2 + hstepB, voffB); PG8_STAGE(PG8_SA(0, 0), a2, voffA);
            PG8_WAIT_V(8); PG8_WAIT_L(0); PG8_BAR; PG8_MMA(1, 0, At, B0); PG8_MMA(1, 1, At, B1); PG8_BAR; PG8_SCHED;
            PG8_LDB(B0, 1, 0); PG8_LDB(B1, 1, 1); PG8_SCHED; PG8_LDA(At, 1, 0); PG8_STAGE(PG8_SA(0, 1), a2 + hstepA, voffA);
            PG8_WAIT_V(8); PG8_WAIT_L(0); PG8_BAR; PG8_MMA(0, 0, At, B0); PG8_MMA(0, 1, At, B1); PG8_BAR; PG8_SCHED;
            PG8_LDA(At, 1, 1); PG8_STAGE(PG8_SB(1, 0), b3, voffB); PG8_STAGE(PG8_SB(1, 1), b3 + hstepB, voffB); PG8_STAGE(PG8_SA(1, 0), a3, voffA);
            PG8_WAIT_V(8); PG8_WAIT_L(0); PG8_BAR; PG8_MMA(1, 0, At, B0); PG8_MMA(1, 1, At, B1); PG8_BAR; PG8_SCHED;
            } else {
            PG8_LDB(B0, 0, 0); PG8_SCHED; PG8_LDA(At, 0, 0); PG8_STAGE(PG8_SA(1, 1), a1 + hstepA, voffA);
            PG8_WAIT_L(8); PG8_BAR; PG8_WAIT_L(0); PG8_MMA(0, 0, At, B0); PG8_BAR; PG8_SCHED;
            PG8_LDB(B1, 0, 1); PG8_STAGE(PG8_SB(0, 0), b2, voffB);
            PG8_BAR; PG8_WAIT_L(0); PG8_MMA(0, 1, At, B1); PG8_BAR;
            PG8_LDA(At, 0, 1); PG8_STAGE(PG8_SA(0, 0), a2, voffA);
            PG8_BAR; PG8_WAIT_L(0); PG8_MMA(1, 0, At, B0); PG8_BAR; PG8_SCHED;
            PG8_STAGE(PG8_SB(0, 1), b2 + hstepB, voffB);
            PG8_WAIT_V(6); PG8_BAR; PG8_MMA(1, 1, At, B1); PG8_BAR;
            PG8_LDB(B0, 1, 0); PG8_SCHED; PG8_LDA(At, 1, 0); PG8_STAGE(PG8_SA(0, 1), a2 + hstepA, voffA);
            PG8_WAIT_L(8); PG8_BAR; PG8_WAIT_L(0); PG8_MMA(0, 0, At, B0); PG8_BAR; PG8_SCHED;
            PG8_LDB(B1, 1, 1); PG8_STAGE(PG8_SB(1, 0), b3, voffB);
            PG8_BAR; PG8_WAIT_L(0); PG8_MMA(0, 1, At, B1); PG8_BAR;
            PG8_LDA(At, 1, 1); PG8_STAGE(PG8_SA(1, 0), a3, voffA);
            PG8_BAR; PG8_WAIT_L(0); PG8_MMA(1, 0, At, B0); PG8_BAR; PG8_SCHED;
            PG8_STAGE(PG8_SB(1, 1), b3 + hstepB, voffB);
            PG8_WAIT_V(6); PG8_BAR; PG8_MMA(1, 1, At, B1); PG8_BAR;
            }
        }
        if constexpr (ALIGN_EPI) { if (wr == 0) PG8_BAR; }
        E(acc, cur, wr, wc, fr, fq); S.done(cur);
        if (!has_next) break;
#pragma unroll
        for (int a = 0; a < 2; ++a)
#pragma unroll
            for (int b = 0; b < 2; ++b)
#pragma unroll
                for (int m = 0; m < 4; ++m)
#pragma unroll
                    for (int n = 0; n < 2; ++n) acc[a][b][m][n] = (f32x4){0.f, 0.f, 0.f, 0.f};
        cur = nxt; cA = nA; cB = nB; ++ui;
        if constexpr (ALIGN_EPI) { if (wr == 1) PG8_BAR; }
    }
    PG8_WAIT_V(0);
    if constexpr (!ALIGN_EPI) { if (wr == 0) PG8_BAR; }
    PG8_BAR;
#undef PG8_SA
#undef PG8_SB
#undef PG8_STAGE
#undef PG8_LDA
#undef PG8_LDB
#undef PG8_MMA
#undef PG8_WAIT_V
#undef PG8_WAIT_L
#undef PG8_BAR
#undef PG8_SCHED
}
}

constexpr int NWAVES = 8, NTHR = NWAVES * 64;
constexpr int D = 1024, NBATCH = 4, T = 8192, M = NBATCH * T;
constexpr int A_W = 512, A_IN = 1792, IN_COLS = 3344, NP = 3584;
constexpr int C_R = 0, C_K = 512, C_V = 1024, C_WD = 1536, C_AD = 1600, C_GD = 1664;
constexpr int C_BQ = 1792, C_BK = 2048, C_BV = 2304, C_GKD = 2816, C_BG = 2832;
constexpr int NQ = 2048;
constexpr float LN_EPS = 1e-5f, GN_EPS = 64e-5f, RMS_EPS = 1e-5f;
constexpr float ALPHA = 1.189207115002721f;

typedef unsigned short bf16;
typedef float f32x4 __attribute__((ext_vector_type(4)));
typedef float f32x2 __attribute__((ext_vector_type(2)));
typedef unsigned u32x4 __attribute__((ext_vector_type(4)));
typedef unsigned u32x2 __attribute__((ext_vector_type(2)));
#define LAS __attribute__((address_space(3)))

constexpr size_t MiB = 1u << 20;
constexpr size_t WS_WIN = 1 * MiB, WS_WOUT = 8 * MiB, WS_WQ = 10 * MiB, WS_KBD = 14 * MiB;
constexpr size_t WS_W2T = 15 * MiB, WS_A2T = WS_W2T + 65536, WS_G2T = WS_A2T + 65536;
constexpr size_t WS_H0 = 16 * MiB;
constexpr size_t WS_P = 80 * MiB;
constexpr size_t WS_WL = 304 * MiB, WS_AA = 336 * MiB, WS_GG = 368 * MiB;
constexpr size_t WS_GK = 400 * MiB;
constexpr size_t WS_MIX = 416 * MiB;
constexpr size_t WS_Z = 80 * MiB;
constexpr size_t WS_H1 = 208 * MiB;
constexpr size_t WS_Q = 272 * MiB;
constexpr size_t WS_S = 80 * MiB;
constexpr size_t WS_IDS = 400 * MiB, WS_GATES = 416 * MiB;
constexpr size_t WS_UT = 432 * MiB, WS_VT = 448 * MiB;
constexpr int ROWB = 768;
constexpr size_t WS_SU = 464 * MiB, WS_SV = 465 * MiB;
constexpr int NSEG = 16, LSEG = 8192 / NSEG;
constexpr size_t WS_YI = WS_WL;
constexpr size_t WS_YIG = WS_GK;
constexpr size_t WS_SER = 480 * MiB;
constexpr size_t WS_SEG = 496 * MiB;
constexpr size_t WS_CEND = 504 * MiB;
constexpr size_t WS_END = 505 * MiB;

constexpr int LDS_BYTES = 147456, LDS_MISC = LDS_BYTES - 256;
constexpr size_t WS_CTL = 0, CTL_BYTES = 16384;

struct Params {
    const float* in[28];
    float* out; unsigned char* ws;
    int ph_lo, ph_hi;
};

__device__ __forceinline__ float bf2f(unsigned u) { return __uint_as_float(u << 16); }
__device__ __forceinline__ unsigned f2bf(float f) { unsigned u = __float_as_uint(f); return (u + 0x7fffu + ((u >> 16) & 1u)) >> 16; }
__device__ __forceinline__ unsigned pk2(float lo, float hi) { return f2bf(lo) | (f2bf(hi) << 16); }
#define DPP_F(v, ctrl) __builtin_bit_cast(float, __builtin_amdgcn_update_dpp(0, __builtin_bit_cast(int, (v)), (ctrl), 0xf, 0xf, false))
#define DPP_ADD(v, ctrl) ((v) + DPP_F(v, ctrl))
__device__ __forceinline__ float rlf(float v, int l) { return __builtin_bit_cast(float, __builtin_amdgcn_readlane(__builtin_bit_cast(int, v), l)); }
__device__ __forceinline__ float wave_sum_u(float v) {
    v = DPP_ADD(v, 0xB1); v = DPP_ADD(v, 0x4E); v = DPP_ADD(v, 0x141); v = DPP_ADD(v, 0x140);
    return (rlf(v, 0) + rlf(v, 16)) + (rlf(v, 32) + rlf(v, 48));
}
__device__ __forceinline__ float wave_sum(float v) { return wave_sum_u(v); }
#define DPP_I(v, ctrl) __builtin_amdgcn_update_dpp(0, (v), (ctrl), 0xf, 0xf, false)
__device__ __forceinline__ int wave_sum_i(int v) {
    v += DPP_I(v, 0xB1); v += DPP_I(v, 0x4E); v += DPP_I(v, 0x141); v += DPP_I(v, 0x140);
    return (__builtin_amdgcn_readlane(v, 0) + __builtin_amdgcn_readlane(v, 16)) + (__builtin_amdgcn_readlane(v, 32) + __builtin_amdgcn_readlane(v, 48));
}
__device__ __forceinline__ float wave_max_u(float v) {
    v = fmaxf(v, DPP_F(v, 0xB1)); v = fmaxf(v, DPP_F(v, 0x4E)); v = fmaxf(v, DPP_F(v, 0x141)); v = fmaxf(v, DPP_F(v, 0x140));
    return fmaxf(fmaxf(rlf(v, 0), rlf(v, 16)), fmaxf(rlf(v, 32), rlf(v, 48)));
}
__device__ __forceinline__ unsigned pack_i8(float a, float b, float c, float d, float inv, int off) {
    const int q0 = __float2int_rn(a * inv) + off, q1 = __float2int_rn(b * inv) + off, q2 = __float2int_rn(c * inv) + off, q3 = __float2int_rn(d * inv) + off;
    return (unsigned)(q0 & 0xff) | ((unsigned)(q1 & 0xff) << 8) | ((unsigned)(q2 & 0xff) << 16) | ((unsigned)(q3 & 0xff) << 24);
}
__device__ __forceinline__ float sigmoidf_(float x) { return 1.f / (1.f + __expf(-x)); }
__device__ __forceinline__ float softplusf_(float x) { return fmaxf(x, 0.f) + log1pf(__expf(-fabsf(x))); }
__device__ __forceinline__ float siluf_(float x) { return x * sigmoidf_(x); }

__device__ __forceinline__ void transpose_convert(const float* W, int K, int N, int Npad, bf16* WT, int gtid, int gthreads) {
    const int kc = K / 8, total = Npad * kc;
    for (int idx = gtid; idx < total; idx += gthreads) {
        const int n = idx % Npad, c = idx / Npad; float v[8];
#pragma unroll
        for (int j = 0; j < 8; ++j) v[j] = (n < N) ? W[(size_t)(8 * c + j) * N + n] : 0.f;
        u32x4 o; o.x = pk2(v[0], v[1]); o.y = pk2(v[2], v[3]); o.z = pk2(v[4], v[5]); o.w = pk2(v[6], v[7]);
        *(u32x4*)(WT + (size_t)n * K + 8 * c) = o;
    }
}
__device__ __forceinline__ void ln_row_bf16(const float* xrow, const float* g, const float* b, bf16* orow, int lane) {
    const f32x4* xr = (const f32x4*)xrow + lane; f32x4 v[4]; float s = 0.f;
#pragma unroll
    for (int j = 0; j < 4; ++j) { v[j] = xr[64 * j]; s += (v[j][0] + v[j][1]) + (v[j][2] + v[j][3]); }
    const float mean = wave_sum(s) * (1.f / D); float s2 = 0.f;
#pragma unroll
    for (int j = 0; j < 4; ++j) { v[j] = v[j] - mean; s2 += (v[j][0] * v[j][0] + v[j][1] * v[j][1]) + (v[j][2] * v[j][2] + v[j][3] * v[j][3]); }
    const float rstd = 1.f / sqrtf(wave_sum(s2) * (1.f / D) + LN_EPS);
    u32x2* o8 = (u32x2*)orow + lane;
#pragma unroll
    for (int j = 0; j < 4; ++j) { const f32x4 gg = ((const f32x4*)g)[lane + 64 * j], bb = ((const f32x4*)b)[lane + 64 * j]; const f32x4 y = v[j] * rstd * gg + bb;
        u32x2 w; w.x = pk2(y[0], y[1]); w.y = pk2(y[2], y[3]); o8[64 * j] = w; }
}
__device__ __forceinline__ void phase_prologue(const Params& P) {
    const int tid = threadIdx.x, lane = tid & 63, wave = tid >> 6;
    const int gtid = blockIdx.x * NTHR + tid, gthreads = gridDim.x * NTHR;
    unsigned char* ws = P.ws;
    transpose_convert(P.in[3], D, IN_COLS, NP, (bf16*)(ws + WS_WIN), gtid, gthreads);
    transpose_convert(P.in[19], D, D, D, (bf16*)(ws + WS_WOUT), gtid, gthreads);
    transpose_convert(P.in[22], D, NQ, NQ, (bf16*)(ws + WS_WQ), gtid, gthreads);
    transpose_convert(P.in[6], 64, A_W, A_W, (bf16*)(ws + WS_W2T), gtid, gthreads);
    transpose_convert(P.in[8], 64, A_W, A_W, (bf16*)(ws + WS_A2T), gtid, gthreads);
    transpose_convert(P.in[9], 128, A_W, A_W, (bf16*)(ws + WS_G2T), gtid, gthreads);
    {
        const float* keys = P.in[23]; bf16* kbd = (bf16*)(ws + WS_KBD);
        for (int idx = gtid; idx < 8 * 256 * 32; idx += gthreads) {
            const int kc = idx & 31, n = (idx >> 5) & 255, h = idx >> 13; const int k0 = kc * 8, hn = n >> 7, key = n & 127, hk = k0 >> 7, c0 = k0 & 127;
            u32x4 o = (u32x4){0u, 0u, 0u, 0u};
            if (hn == hk) { const float* s = keys + ((size_t)((h * 2 + hn) * 128 + key)) * 128 + c0; o.x = pk2(s[0], s[1]); o.y = pk2(s[2], s[3]); o.z = pk2(s[4], s[5]); o.w = pk2(s[6], s[7]); }
            *(u32x4*)(kbd + ((size_t)(h * 256 + n)) * 256 + k0) = o;
        }
    }
    const int gw = blockIdx.x * NWAVES + wave, ngw = gridDim.x * NWAVES;
    for (int m = gw; m < M; m += ngw) ln_row_bf16(P.in[0] + (size_t)m * D, P.in[1], P.in[2], (bf16*)(ws + WS_H0) + (size_t)m * D, lane);
}

typedef short bf16x8_t __attribute__((ext_vector_type(8)));
template <int KS, int LDA>
__device__ __forceinline__ void lora_mm(f32x4 (&acc)[4][4], const LAS bf16* ACT, const bf16* WT, int c0, int fr, int fq) {
#pragma unroll
    for (int mt = 0; mt < 4; ++mt)
#pragma unroll
        for (int nt = 0; nt < 4; ++nt) acc[mt][nt] = (f32x4){0.f, 0.f, 0.f, 0.f};
#pragma unroll
    for (int s = 0; s < KS; ++s) {
        bf16x8_t af[4], bfr[4];
#pragma unroll
        for (int mt = 0; mt < 4; ++mt) af[mt] = *(const LAS bf16x8_t*)(ACT + (mt * 16 + fr) * LDA + 32 * s + 8 * fq);
#pragma unroll
        for (int nt = 0; nt < 4; ++nt) bfr[nt] = *(const bf16x8_t*)(WT + (size_t)(c0 + nt * 16 + fr) * (32 * KS) + 32 * s + 8 * fq);
#pragma unroll
        for (int mt = 0; mt < 4; ++mt)
#pragma unroll
            for (int nt = 0; nt < 4; ++nt) acc[mt][nt] = __builtin_amdgcn_mfma_f32_16x16x32_bf16(bfr[nt], af[mt], acc[mt][nt], 0, 0, 0);
    }
}
__device__ __forceinline__ void phase_prep(const Params& P, LAS unsigned char* lds) {
    const int tid = threadIdx.x, lane = tid & 63, wave = __builtin_amdgcn_readfirstlane(tid >> 6), fr = lane & 15, fq = lane >> 4;
    unsigned char* ws = P.ws;
    const bf16* p = (const bf16*)(ws + WS_P);
    const float* mu = P.in[4]; const float* w0 = P.in[5]; const float* a0 = P.in[7];
    const float* gkw2 = P.in[16]; const float* gkb = P.in[17];
    const bf16* W2T = (const bf16*)(ws + WS_W2T); const bf16* A2T = (const bf16*)(ws + WS_A2T); const bf16* G2T = (const bf16*)(ws + WS_G2T);
    bf16* WL = (bf16*)(ws + WS_WL); bf16* AA = (bf16*)(ws + WS_AA); bf16* GG = (bf16*)(ws + WS_GG); bf16* GK = (bf16*)(ws + WS_GK);
    LAS bf16* TW = (LAS bf16*)lds; LAS bf16* AD = TW + 64 * 72; LAS bf16* SG = AD + 64 * 72;
    LAS float* gkd = (LAS float*)(SG + 64 * 136);
    const int c0 = wave * 64;
    for (int tile = blockIdx.x; tile < M / 64; tile += gridDim.x) {
        const int m0 = tile * 64;
        __syncthreads();
        for (int idx = tid; idx < 64 * 32; idx += NTHR) {
            const int j = (idx & 31) * 8, tok = idx >> 5, m = m0 + tok, t = m & (T - 1);
            const u32x4 cw = *(const u32x4*)(p + (size_t)m * NP + C_WD + j); const u32x4 pw = (t > 0) ? *(const u32x4*)(p + (size_t)(m - 1) * NP + C_WD + j) : (u32x4){0u, 0u, 0u, 0u};
            const f32x4 m0v = *(const f32x4*)(mu + C_WD + j), m1v = *(const f32x4*)(mu + C_WD + j + 4);
            float x[8];
#pragma unroll
            for (int i = 0; i < 4; ++i) { const float c0 = __uint_as_float(cw[i] << 16), c1 = __uint_as_float(cw[i] & 0xffff0000u), q0 = __uint_as_float(pw[i] << 16), q1 = __uint_as_float(pw[i] & 0xffff0000u);
                const float mu0 = i < 2 ? m0v[2 * i] : m1v[2 * i - 4], mu1 = i < 2 ? m0v[2 * i + 1] : m1v[2 * i - 3];
                x[2 * i] = c0 + (q0 - c0) * mu0; x[2 * i + 1] = c1 + (q1 - c1) * mu1; }
            u32x4 o;
            if (j < 64) {
#pragma unroll
                for (int i = 0; i < 4; ++i) o[i] = pk2(1.f - 2.f * __builtin_amdgcn_rcpf(1.f + __expf(2.f * x[2 * i])), 1.f - 2.f * __builtin_amdgcn_rcpf(1.f + __expf(2.f * x[2 * i + 1])));
                *(LAS u32x4*)(TW + tok * 72 + j) = o;
            } else if (j < 128) {
#pragma unroll
                for (int i = 0; i < 4; ++i) o[i] = pk2(x[2 * i], x[2 * i + 1]);
                *(LAS u32x4*)(AD + tok * 72 + j - 64) = o;
            } else {
#pragma unroll
                for (int i = 0; i < 4; ++i) o[i] = pk2(sigmoidf_(x[2 * i]), sigmoidf_(x[2 * i + 1]));
                *(LAS u32x4*)(SG + tok * 136 + j - 128) = o;
            }
        }
        for (int idx = tid; idx < 64 * 16; idx += NTHR) { const int j = idx & 15, tok = idx >> 4; gkd[tok * 16 + j] = bf2f(p[(size_t)(m0 + tok) * NP + C_GKD + j]); }
        __syncthreads();
        f32x4 acc[4][4];
        lora_mm<2, 72>(acc, TW, W2T, c0, fr, fq);
#pragma unroll
        for (int nt = 0; nt < 4; ++nt) { const int c = c0 + nt * 16 + 4 * fq; const f32x4 b = *(const f32x4*)(w0 + c);
#pragma unroll
            for (int mt = 0; mt < 4; ++mt) { float o[4];
#pragma unroll
                for (int i = 0; i < 4; ++i) { const float z = b[i] + acc[mt][nt][i]; o[i] = -0.6065306597126334f * sigmoidf_(z); }
                u32x2 w; w.x = pk2(o[0], o[1]); w.y = pk2(o[2], o[3]); *(u32x2*)(WL + (size_t)(m0 + mt * 16 + fr) * A_W + c) = w; } }
        lora_mm<2, 72>(acc, AD, A2T, c0, fr, fq);
#pragma unroll
        for (int nt = 0; nt < 4; ++nt) { const int c = c0 + nt * 16 + 4 * fq; const f32x4 b = *(const f32x4*)(a0 + c);
#pragma unroll
            for (int mt = 0; mt < 4; ++mt) { float o[4];
#pragma unroll
                for (int i = 0; i < 4; ++i) o[i] = sigmoidf_(b[i] + acc[mt][nt][i]);
                u32x2 w; w.x = pk2(o[0], o[1]); w.y = pk2(o[2], o[3]); *(u32x2*)(AA + (size_t)(m0 + mt * 16 + fr) * A_W + c) = w; } }
        lora_mm<4, 136>(acc, SG, G2T, c0, fr, fq);
#pragma unroll
        for (int nt = 0; nt < 4; ++nt) { const int c = c0 + nt * 16 + 4 * fq;
#pragma unroll
            for (int mt = 0; mt < 4; ++mt) { u32x2 w; w.x = pk2(acc[mt][nt][0], acc[mt][nt][1]); w.y = pk2(acc[mt][nt][2], acc[mt][nt][3]); *(u32x2*)(GG + (size_t)(m0 + mt * 16 + fr) * A_W + c) = w; } }
        { const int cc = tid & 255, th = tid >> 8; float wv[16];
#pragma unroll
          for (int j = 0; j < 16; ++j) wv[j] = gkw2[j * 256 + cc];
          const float bb = gkb[cc];
          for (int i = 0; i < 32; ++i) { const int tok = th * 32 + i; float sacc = bb;
#pragma unroll
              for (int j = 0; j < 16; ++j) sacc += gkd[tok * 16 + j] * wv[j];
              GK[(size_t)(m0 + tok) * 256 + cc] = (bf16)f2bf(-(fmaxf(-sacc, 0.f) + __logf(1.f + __expf(-fabsf(sacc)))) * (1.f / 16.f)); } }
    }
}

constexpr int CH = 32;
__device__ __forceinline__ float red8(float v) { v = DPP_ADD(v, 0xB1); v = DPP_ADD(v, 0x4E); v = DPP_ADD(v, 0x141); return v; }
__device__ __forceinline__ float red4(float v) { v = DPP_ADD(v, 0xB1); v = DPP_ADD(v, 0x4E); return v; }

constexpr int RW_BUF = 6 * CH * 64;
__device__ __forceinline__ void rw_load(const bf16* p, const bf16* AA, const bf16* WL, int b, int t0, int col, int wave,
        unsigned (&rc)[4], unsigned (&kc)[4], unsigned (&vc)[4], unsigned (&rp)[4], unsigned (&kp)[4], unsigned (&vp)[4], unsigned (&a)[4], unsigned (&wl)[4]) {
#pragma unroll
    for (int q = 0; q < 4; ++q) {
        const int t = t0 + wave + 8 * q; const size_t m = (size_t)b * T + t; const bf16* pr = p + m * NP; const bf16* pp = (t > 0) ? pr - NP : pr;
        rc[q] = pr[C_R + col]; kc[q] = pr[C_K + col]; vc[q] = pr[C_V + col]; rp[q] = pp[C_R + col]; kp[q] = pp[C_K + col]; vp[q] = pp[C_V + col];
        a[q] = AA[m * A_W + col]; wl[q] = WL[m * A_W + col];
    }
}
__device__ __forceinline__ void rw_prep(LAS float* B, int t0, int wave, int lane, float mu_r, float mu_k, float mu_v, float kkc, float kac,
        const unsigned (&rc_)[4], const unsigned (&kc_)[4], const unsigned (&vc_)[4], const unsigned (&rp_)[4], const unsigned (&kp_)[4], const unsigned (&vp_)[4], const unsigned (&a_)[4], const unsigned (&wl_)[4]) {
    LAS float* R = B; LAS float* DEC = R + CH * 64; LAS float* KH = DEC + CH * 64; LAS float* KK = KH + CH * 64; LAS float* BB = KK + CH * 64; LAS float* V = BB + CH * 64;
#pragma unroll
    for (int q = 0; q < 4; ++q) {
        const int tt = wave + 8 * q; const float hp = (t0 + tt > 0) ? 1.f : 0.f;
        const float rc = bf2f(rc_[q]), kc = bf2f(kc_[q]), vc = bf2f(vc_[q]), rp = bf2f(rp_[q]) * hp, kp = bf2f(kp_[q]) * hp, vp = bf2f(vp_[q]) * hp;
        const float r = rc + (rp - rc) * mu_r, k = kc + (kp - kc) * mu_k, v = vc + (vp - vc) * mu_v;
        const float a = bf2f(a_[q]), wl = bf2f(wl_[q]);
        const float kr = k * kkc; const float nrm = sqrtf(wave_sum(kr * kr)); const float kk = kr / fmaxf(nrm, 1e-12f);
        const float kh = k * (1.f + (a - 1.f) * kac);
        R[tt * 64 + lane] = r; DEC[tt * 64 + lane] = __expf(wl); KH[tt * 64 + lane] = kh; KK[tt * 64 + lane] = kk; BB[tt * 64 + lane] = kk * a; V[tt * 64 + lane] = v;
    }
}
struct RwOps { f32x4 k0, k1, d0, d1, b0, b1, h0, h1, q0, q1; float v0, v1; };
__device__ __forceinline__ void rw_ops_load(RwOps& o, const LAS float* B, int tt, int s8, int vr0) {
    const LAS float* R = B; const LAS float* DEC = R + CH * 64; const LAS float* KH = DEC + CH * 64; const LAS float* KK = KH + CH * 64; const LAS float* BB = KK + CH * 64; const LAS float* V = BB + CH * 64;
    o.k0 = *(const LAS f32x4*)(KK + tt * 64 + s8); o.k1 = *(const LAS f32x4*)(KK + tt * 64 + s8 + 4);
    o.d0 = *(const LAS f32x4*)(DEC + tt * 64 + s8); o.d1 = *(const LAS f32x4*)(DEC + tt * 64 + s8 + 4);
    o.b0 = *(const LAS f32x4*)(BB + tt * 64 + s8); o.b1 = *(const LAS f32x4*)(BB + tt * 64 + s8 + 4);
    o.h0 = *(const LAS f32x4*)(KH + tt * 64 + s8); o.h1 = *(const LAS f32x4*)(KH + tt * 64 + s8 + 4);
    o.q0 = *(const LAS f32x4*)(R + tt * 64 + s8); o.q1 = *(const LAS f32x4*)(R + tt * 64 + s8 + 4);
    o.v0 = V[tt * 64 + vr0]; o.v1 = V[tt * 64 + vr0 + 1];
}
template <bool IDENT> __device__ __forceinline__ void rw_step(const RwOps& o, f32x2 (&S0)[4], f32x2 (&S1)[4], LAS float* Y, int tt, int r0, int lane) {
    const float vv0 = o.v0, vv1 = o.v1;
    const f32x2 kk[4] = {o.k0.lo, o.k0.hi, o.k1.lo, o.k1.hi}, dd[4] = {o.d0.lo, o.d0.hi, o.d1.lo, o.d1.hi}, bb[4] = {o.b0.lo, o.b0.hi, o.b1.lo, o.b1.hi}, hh[4] = {o.h0.lo, o.h0.hi, o.h1.lo, o.h1.hi}, rr[4] = {o.q0.lo, o.q0.hi, o.q1.lo, o.q1.hi};
    f32x2 a0 = S0[0] * kk[0], a1 = S1[0] * kk[0];
#pragma unroll
    for (int i = 1; i < 4; ++i) { a0 = S0[i] * kk[i] + a0; a1 = S1[i] * kk[i] + a1; }
    const float sa0 = -red8(a0.x + a0.y), sa1 = -red8(a1.x + a1.y);
    f32x2 y0 = (f32x2){0.f, 0.f}, y1 = (f32x2){0.f, 0.f};
#pragma unroll
    for (int i = 0; i < 4; ++i) {
        if (IDENT) { S0[i] = bb[i] * sa0 + S0[i] * dd[i]; S1[i] = bb[i] * sa1 + S1[i] * dd[i]; }
        else { S0[i] = hh[i] * vv0 + (bb[i] * sa0 + S0[i] * dd[i]); S1[i] = hh[i] * vv1 + (bb[i] * sa1 + S1[i] * dd[i]); }
        y0 = S0[i] * rr[i] + y0; y1 = S1[i] * rr[i] + y1;
    }
    const float yy0 = red8(y0.x + y0.y), yy1 = red8(y1.x + y1.y);
    if ((lane & 7) == 0) { Y[tt * 128 + r0] = yy0; Y[tt * 128 + r0 + 1] = yy1; }
}
struct GlOps { f32x4 k0, k1, d0, d1, q0, q1; float v0, v1; };
__device__ __forceinline__ void gl_ops_load(GlOps& o, const LAS float* B, int tt, int s8, int r0) {
    const LAS float* Q = B; const LAS float* K = Q + CH * 64; const LAS float* DEC = K + CH * 64; const LAS float* V = DEC + CH * 64;
    o.k0 = *(const LAS f32x4*)(K + tt * 64 + s8); o.k1 = *(const LAS f32x4*)(K + tt * 64 + s8 + 4);
    o.d0 = *(const LAS f32x4*)(DEC + tt * 64 + s8); o.d1 = *(const LAS f32x4*)(DEC + tt * 64 + s8 + 4);
    o.q0 = *(const LAS f32x4*)(Q + tt * 64 + s8); o.q1 = *(const LAS f32x4*)(Q + tt * 64 + s8 + 4);
    o.v0 = V[tt * 128 + r0]; o.v1 = V[tt * 128 + r0 + 1];
}
__device__ __forceinline__ void gl_step(const GlOps& o, f32x2 (&S0)[4], f32x2 (&S1)[4], f32x2 (&c)[4], LAS float* O, LAS float* YL, int tt, int r0, int s8, int lane, int wave) {
    const f32x2 kk[4] = {o.k0.lo, o.k0.hi, o.k1.lo, o.k1.hi}, dd[4] = {o.d0.lo, o.d0.hi, o.d1.lo, o.d1.hi}, qq[4] = {o.q0.lo, o.q0.hi, o.q1.lo, o.q1.hi};
    f32x2 y0 = (f32x2){0.f, 0.f}, y1 = (f32x2){0.f, 0.f};
#pragma unroll
    for (int i = 0; i < 4; ++i) {
        S0[i] = kk[i] * o.v0 + S0[i] * dd[i]; S1[i] = kk[i] * o.v1 + S1[i] * dd[i];
        y0 = S0[i] * qq[i] + y0; y1 = S1[i] * qq[i] + y1;
    }
    if (wave == 0) {
#pragma unroll
        for (int i = 0; i < 4; ++i) c[i] = c[i] * dd[i];
        if (lane < 8) { const f32x2 e0 = c[0] * qq[0], e1 = c[1] * qq[1], e2 = c[2] * qq[2], e3 = c[3] * qq[3];
            *(LAS f32x4*)(YL + tt * 64 + s8) = (f32x4){e0.x, e0.y, e1.x, e1.y}; *(LAS f32x4*)(YL + tt * 64 + s8 + 4) = (f32x4){e2.x, e2.y, e3.x, e3.y}; }
    }
    const float o0 = red8(y0.x + y0.y), o1 = red8(y1.x + y1.y);
    if ((lane & 7) == 0) { O[tt * 128 + r0] = o0; O[tt * 128 + r0 + 1] = o1; }
}
__device__ __forceinline__ void rwkv_item(const Params& P, LAS unsigned char* lds, int b, int h, int seg) {
    const int tid = threadIdx.x, lane = tid & 63, wave = tid >> 6;
    unsigned char* ws = P.ws;
    const bf16* p = (const bf16*)(ws + WS_P); const bf16* WL = (const bf16*)(ws + WS_WL); const bf16* AA = (const bf16*)(ws + WS_AA);
    bf16* MIX = (bf16*)(ws + WS_MIX); bf16* YI = (bf16*)(ws + WS_YI);
    const float* mu = P.in[4]; const float* k_k = P.in[10]; const float* k_a = P.in[11];
    LAS float* BUF = (LAS float*)lds; LAS float* Y = BUF + 2 * RW_BUF;
    const int col = h * 64 + lane;
    const float mu_r = mu[C_R + col], mu_k = mu[C_K + col], mu_v = mu[C_V + col], kkc = k_k[col], kac = k_a[col];
    const int r0 = wave * 16 + 2 * (lane >> 3), s8 = (lane & 7) * 8; const int ident = r0 >> 6, vr0 = r0 & 63, vr1 = vr0 + 1;
    float* SE = (float*)(ws + WS_SER) + ((((size_t)(b * 8 + h) * NSEG + seg) * 2 + ident) * 4096) + vr0 * 64 + s8;
    f32x2 S0[4], S1[4];
#pragma unroll
    for (int i = 0; i < 4; ++i) { S0[i] = (f32x2){(ident && (s8 + 2 * i == vr0)) ? 1.f : 0.f, (ident && (s8 + 2 * i + 1 == vr0)) ? 1.f : 0.f};
        S1[i] = (f32x2){(ident && (s8 + 2 * i == vr1)) ? 1.f : 0.f, (ident && (s8 + 2 * i + 1 == vr1)) ? 1.f : 0.f}; }
    const float vmask = ident ? 0.f : 1.f;
    const int tbeg = seg * LSEG;
    unsigned rc[4], kc[4], vc[4], rp[4], kp[4], vp[4], a[4], wl[4];
    __syncthreads();
    rw_load(p, AA, WL, b, tbeg, col, wave, rc, kc, vc, rp, kp, vp, a, wl);
    rw_prep(BUF, tbeg, wave, lane, mu_r, mu_k, mu_v, kkc, kac, rc, kc, vc, rp, kp, vp, a, wl);
    __syncthreads();
    for (int ci = 0; ci < LSEG / CH; ++ci) {
        const int t0 = tbeg + ci * CH; LAS float* B = BUF + (ci & 1) * RW_BUF;
        LAS float* R = B; LAS float* DEC = R + CH * 64; LAS float* KH = DEC + CH * 64; LAS float* KK = KH + CH * 64; LAS float* BB = KK + CH * 64; LAS float* V = BB + CH * 64;
        const bool more = (ci + 1 < LSEG / CH);
        if (more) rw_load(p, AA, WL, b, t0 + CH, col, wave, rc, kc, vc, rp, kp, vp, a, wl);
        { RwOps oa, ob; rw_ops_load(oa, B, 0, s8, vr0);
          if (ident) for (int tt = 0; tt < CH; tt += 2) {
              rw_ops_load(ob, B, tt + 1, s8, vr0); rw_step<true>(oa, S0, S1, Y, tt, r0, lane);
              rw_ops_load(oa, B, (tt + 2) & (CH - 1), s8, vr0); rw_step<true>(ob, S0, S1, Y, tt + 1, r0, lane);
          } else for (int tt = 0; tt < CH; tt += 2) {
              rw_ops_load(ob, B, tt + 1, s8, vr0); rw_step<false>(oa, S0, S1, Y, tt, r0, lane);
              rw_ops_load(oa, B, (tt + 2) & (CH - 1), s8, vr0); rw_step<false>(ob, S0, S1, Y, tt + 1, r0, lane);
          } }
        __syncthreads();
        if (more) rw_prep(BUF + ((ci + 1) & 1) * RW_BUF, t0 + CH, wave, lane, mu_r, mu_k, mu_v, kkc, kac, rc, kc, vc, rp, kp, vp, a, wl);
#pragma unroll
        for (int q = 0; q < 4; ++q) {
            const int tt = wave + 8 * q; const size_t m = (size_t)b * T + t0 + tt;
            MIX[m * D + col] = (bf16)f2bf(Y[tt * 128 + lane]); YI[m * 512 + col] = (bf16)f2bf(Y[tt * 128 + 64 + lane]);
        }
        __syncthreads();
    }
    *(f32x4*)(SE) = (f32x4){S0[0].x, S0[0].y, S0[1].x, S0[1].y}; *(f32x4*)(SE + 4) = (f32x4){S0[2].x, S0[2].y, S0[3].x, S0[3].y};
    *(f32x4*)(SE + 64) = (f32x4){S1[0].x, S1[0].y, S1[1].x, S1[1].y}; *(f32x4*)(SE + 68) = (f32x4){S1[2].x, S1[2].y, S1[3].x, S1[3].y};
}

constexpr int GL_BUF = 3 * CH * 64 + CH * 128;
__device__ __forceinline__ void gl_load(const bf16* p, const bf16* GK, int b, int h, int t0, int lane, int wave, unsigned (&x)[4][4][4], unsigned (&gk)[4]) {
    const int cq = h * 64 + lane, ck = 256 + h * 64 + lane, cv0 = 512 + h * 128 + lane, cv1 = cv0 + 64;
#pragma unroll
    for (int q = 0; q < 4; ++q) {
        const int t = t0 + wave + 8 * q; const size_t m = (size_t)b * T + t;
#pragma unroll
        for (int j = 0; j < 4; ++j) { const int back = 3 - j; const bf16* pr = p + (m - (size_t)((t >= back) ? back : 0)) * NP + C_BQ;
            x[q][j][0] = pr[cq]; x[q][j][1] = pr[ck]; x[q][j][2] = pr[cv0]; x[q][j][3] = pr[cv1]; }
        gk[q] = GK[m * 256 + h * 64 + lane];
    }
}
__device__ __forceinline__ void gl_prep(LAS float* B, int t0, int wave, int lane, const float (&wq)[4], const float (&wk)[4], const float (&wv0)[4], const float (&wv1)[4],
        const unsigned (&x)[4][4][4], const unsigned (&gk)[4]) {
    LAS float* Q = B; LAS float* K = Q + CH * 64; LAS float* DEC = K + CH * 64; LAS float* V = DEC + CH * 64;
#pragma unroll
    for (int q = 0; q < 4; ++q) {
        const int tt = wave + 8 * q, t = t0 + tt; float aq = 0.f, ak = 0.f, av0 = 0.f, av1 = 0.f;
#pragma unroll
        for (int j = 0; j < 4; ++j) { const float ok = (t >= 3 - j) ? 1.f : 0.f;
            aq += wq[j] * ok * bf2f(x[q][j][0]); ak += wk[j] * ok * bf2f(x[q][j][1]); av0 += wv0[j] * ok * bf2f(x[q][j][2]); av1 += wv1[j] * ok * bf2f(x[q][j][3]); }
        Q[tt * 64 + lane] = siluf_(aq) * 0.125f; K[tt * 64 + lane] = siluf_(ak); V[tt * 128 + lane] = siluf_(av0); V[tt * 128 + 64 + lane] = siluf_(av1);
        DEC[tt * 64 + lane] = __expf(bf2f(gk[q]));
    }
}
__device__ __forceinline__ void gla_item(const Params& P, LAS unsigned char* lds, int b, int h, int seg) {
    const int tid = threadIdx.x, lane = tid & 63, wave = tid >> 6;
    unsigned char* ws = P.ws;
    const bf16* p = (const bf16*)(ws + WS_P); const bf16* GK = (const bf16*)(ws + WS_GK);
    bf16* MIX = (bf16*)(ws + WS_MIX); bf16* YIG = (bf16*)(ws + WS_YIG);
    float* SE = (float*)(ws + WS_SEG) + ((size_t)(b * 4 + h) * NSEG + seg) * 8192; float* CE = (float*)(ws + WS_CEND) + ((size_t)(b * 4 + h) * NSEG + seg) * 64;
    const float* conv = P.in[15];
    LAS float* BUF = (LAS float*)lds; LAS float* O = BUF + 2 * GL_BUF; LAS float* YL = O + CH * 128;
    const int cq = h * 64 + lane, ck = 256 + h * 64 + lane, cv0 = 512 + h * 128 + lane, cv1 = cv0 + 64;
    float wq[4], wk[4], wv0[4], wv1[4];
#pragma unroll
    for (int j = 0; j < 4; ++j) { wq[j] = conv[j * 1024 + cq]; wk[j] = conv[j * 1024 + ck]; wv0[j] = conv[j * 1024 + cv0]; wv1[j] = conv[j * 1024 + cv1]; }
    const int r0 = wave * 16 + 2 * (lane >> 3), s8 = (lane & 7) * 8;
    f32x2 S0[4], S1[4], c[4];
#pragma unroll
    for (int i = 0; i < 4; ++i) { S0[i] = (f32x2){0.f, 0.f}; S1[i] = (f32x2){0.f, 0.f}; c[i] = (f32x2){1.f, 1.f}; }
    const int tbeg = seg * LSEG;
    unsigned x[4][4][4], gk[4];
    __syncthreads();
    gl_load(p, GK, b, h, tbeg, lane, wave, x, gk);
    gl_prep(BUF, tbeg, wave, lane, wq, wk, wv0, wv1, x, gk);
    __syncthreads();
    for (int ci = 0; ci < LSEG / CH; ++ci) {
        const int t0 = tbeg + ci * CH; LAS float* B = BUF + (ci & 1) * GL_BUF;
        LAS float* Q = B; LAS float* K = Q + CH * 64; LAS float* DEC = K + CH * 64; LAS float* V = DEC + CH * 64;
        const bool more = (ci + 1 < LSEG / CH);
        if (more) gl_load(p, GK, b, h, t0 + CH, lane, wave, x, gk);
        { GlOps oa, ob; gl_ops_load(oa, B, 0, s8, r0);
          for (int tt = 0; tt < CH; tt += 2) {
              gl_ops_load(ob, B, tt + 1, s8, r0); gl_step(oa, S0, S1, c, O, YL, tt, r0, s8, lane, wave);
              gl_ops_load(oa, B, (tt + 2) & (CH - 1), s8, r0); gl_step(ob, S0, S1, c, O, YL, tt + 1, r0, s8, lane, wave);
          } }
        __syncthreads();
        if (more) gl_prep(BUF + ((ci + 1) & 1) * GL_BUF, t0 + CH, wave, lane, wq, wk, wv0, wv1, x, gk);
#pragma unroll
        for (int q = 0; q < 4; ++q) {
            const int tt = wave + 8 * q; const size_t m = (size_t)b * T + t0 + tt;
            MIX[m * D + 512 + h * 128 + lane] = (bf16)f2bf(O[tt * 128 + lane]); MIX[m * D + 512 + h * 128 + 64 + lane] = (bf16)f2bf(O[tt * 128 + 64 + lane]);
            YIG[m * 256 + h * 64 + lane] = (bf16)f2bf(YL[tt * 64 + lane]);
        }
        __syncthreads();
    }
    *(f32x4*)(SE + r0 * 64 + s8) = (f32x4){S0[0].x, S0[0].y, S0[1].x, S0[1].y}; *(f32x4*)(SE + r0 * 64 + s8 + 4) = (f32x4){S0[2].x, S0[2].y, S0[3].x, S0[3].y};
    *(f32x4*)(SE + (r0 + 1) * 64 + s8) = (f32x4){S1[0].x, S1[0].y, S1[1].x, S1[1].y}; *(f32x4*)(SE + (r0 + 1) * 64 + s8 + 4) = (f32x4){S1[2].x, S1[2].y, S1[3].x, S1[3].y};
    if (wave == 0 && lane < 8) { *(f32x4*)(CE + s8) = (f32x4){c[0].x, c[0].y, c[1].x, c[1].y}; *(f32x4*)(CE + s8 + 4) = (f32x4){c[2].x, c[2].y, c[3].x, c[3].y}; }
}
__device__ __forceinline__ void phase_scan(const Params& P, LAS unsigned char* lds) {
    for (int it = blockIdx.x; it < 512 + 256; it += gridDim.x) {
        if (it < 512) { const int bh = it >> 4; rwkv_item(P, lds, bh >> 3, bh & 7, it & 15); }
        else { const int g = it - 512, bh = g >> 4; gla_item(P, lds, bh >> 2, bh & 3, g & 15); }
        __syncthreads();
    }
}
__device__ __forceinline__ void phase_fixup(const Params& P, LAS unsigned char* lds) {
    const int tid = threadIdx.x;
    for (int it = blockIdx.x; it < 48; it += gridDim.x) {
        if (it < 32) {
            float* SE = (float*)(P.ws + WS_SER) + (size_t)it * NSEG * 2 * 4096;
            LAS float* Sc = (LAS float*)lds; LAS float* Ph = Sc + 64 * 65;
            const int v = tid >> 3, kq = (tid & 7) * 8;
            __syncthreads();
            for (int i = tid; i < 64 * 65; i += NTHR) Sc[i] = 0.f;
            f32x4 pf0 = *(const f32x4*)(SE + 4096 + 4 * tid), pf1 = *(const f32x4*)(SE + 4096 + 4 * (tid + NTHR));
            f32x4 a0 = *(const f32x4*)(SE + v * 64 + kq), a1 = *(const f32x4*)(SE + v * 64 + kq + 4);
            for (int seg = 0; seg < NSEG - 1; ++seg) {
                float* s0 = SE + (size_t)(seg * 2 + 0) * 4096;
                __syncthreads();
                *(LAS f32x4*)(Ph + 4 * tid) = pf0; *(LAS f32x4*)(Ph + 4 * (tid + NTHR)) = pf1;
                f32x4 c0 = a0, c1 = a1;
                if (seg + 1 < NSEG - 1) { const float* nx = SE + (size_t)((seg + 1) * 2) * 4096; pf0 = *(const f32x4*)(nx + 4096 + 4 * tid); pf1 = *(const f32x4*)(nx + 4096 + 4 * (tid + NTHR)); a0 = *(const f32x4*)(nx + v * 64 + kq); a1 = *(const f32x4*)(nx + v * 64 + kq + 4); }
                __syncthreads();
                for (int j = 0; j < 64; ++j) { const float sv = Sc[v * 65 + j]; c0 += *(const LAS f32x4*)(Ph + j * 64 + kq) * sv; c1 += *(const LAS f32x4*)(Ph + j * 64 + kq + 4) * sv; }
                __syncthreads();
#pragma unroll
                for (int i = 0; i < 4; ++i) { Sc[v * 65 + kq + i] = c0[i]; Sc[v * 65 + kq + 4 + i] = c1[i]; }
                *(f32x4*)(s0 + v * 64 + kq) = c0; *(f32x4*)(s0 + v * 64 + kq + 4) = c1;
            }
        } else {
            const int bh = it - 32; float* SE = (float*)(P.ws + WS_SEG) + (size_t)bh * NSEG * 8192; const float* CE = (const float*)(P.ws + WS_CEND) + (size_t)bh * NSEG * 64;
            const int v = tid >> 2, d0 = (tid & 3) * 16; f32x4 sc[4];
#pragma unroll
            for (int q = 0; q < 4; ++q) sc[q] = (f32x4){0.f, 0.f, 0.f, 0.f};
            for (int seg = 0; seg < NSEG - 1; ++seg) {
#pragma unroll
                for (int q = 0; q < 4; ++q) { float* sp = SE + (size_t)seg * 8192 + v * 64 + d0 + 4 * q; sc[q] = sc[q] * *(const f32x4*)(CE + seg * 64 + d0 + 4 * q) + *(const f32x4*)sp; *(f32x4*)sp = sc[q]; }
            }
        }
    }
}
__device__ __forceinline__ float row_sum16(float v) { v = DPP_ADD(v, 0xB1); v = DPP_ADD(v, 0x4E); v = DPP_ADD(v, 0x141); v = DPP_ADD(v, 0x140); return v; }
__device__ __forceinline__ bf16x8_t pack_bf16x8(const f32x4 a, const f32x4 b) {
    u32x4 w; w.x = pk2(a[0], a[1]); w.y = pk2(a[2], a[3]); w.z = pk2(b[0], b[1]); w.w = pk2(b[2], b[3]); return __builtin_bit_cast(bf16x8_t, w);
}
__device__ __forceinline__ void unpack4(const u32x2 w, float (&o)[4]) { o[0] = __uint_as_float(w.x << 16); o[1] = __uint_as_float(w.x & 0xffff0000u); o[2] = __uint_as_float(w.y << 16); o[3] = __uint_as_float(w.y & 0xffff0000u); }
__device__ __forceinline__ void phase_correct(const Params& P, LAS unsigned char* lds) {
    const int tid = threadIdx.x, lane = tid & 63, wave = __builtin_amdgcn_readfirstlane(tid >> 6), fr = lane & 15, fq = lane >> 4;
    unsigned char* ws = P.ws;
    const bf16* p = (const bf16*)(ws + WS_P); const bf16* AA = (const bf16*)(ws + WS_AA); const bf16* GG = (const bf16*)(ws + WS_GG);
    bf16* MIX = (bf16*)(ws + WS_MIX); const bf16* YI = (const bf16*)(ws + WS_YI); const bf16* YIG = (const bf16*)(ws + WS_YIG);
    const float* mu = P.in[4]; const float* k_a = P.in[11]; const float* r_k = P.in[12]; const float* gn_g = P.in[13]; const float* gn_b = P.in[14]; const float* norm_g = P.in[18];
    LAS bf16* SB = (LAS bf16*)lds;
    for (int it = blockIdx.x; it < 512; it += gridDim.x) {
        {
            const int seg = it & 15, bh = it >> 4, b = bh >> 3, h = bh & 7;
            const int cb = h * 64 + 4 * fr;
            __syncthreads();
            if (seg > 0) { const float* ss = (const float*)(ws + WS_SER) + (((size_t)bh * NSEG + (seg - 1)) * 2) * 4096;
                for (int i = tid; i < 1024; i += NTHR) { const f32x4 x = *(const f32x4*)(ss + 4 * i); const int v = i >> 4, j = (4 * i) & 63; u32x2 w; w.x = pk2(x[0], x[1]); w.y = pk2(x[2], x[3]);
                    *(LAS u32x2*)(SB + ((v & 3) * 16 + (v >> 2)) * 72 + j) = w; } }
            __syncthreads();
            const f32x4 mur = *(const f32x4*)(mu + C_R + cb), muk = *(const f32x4*)(mu + C_K + cb), muv = *(const f32x4*)(mu + C_V + cb), kac = *(const f32x4*)(k_a + cb), rkc = *(const f32x4*)(r_k + cb), gng = *(const f32x4*)(gn_g + cb), gnb = *(const f32x4*)(gn_b + cb);
            for (int mt = 0; mt < 4; ++mt) {
                const int tb = seg * LSEG + wave * 64 + mt * 16;
                f32x4 acc[4];
#pragma unroll
                for (int vt = 0; vt < 4; ++vt) acc[vt] = (f32x4){0.f, 0.f, 0.f, 0.f};
                if (seg > 0) {
#pragma unroll
                    for (int sx = 0; sx < 2; ++sx) { const bf16x8_t af = *(const bf16x8_t*)(YI + ((size_t)b * T + tb + fr) * 512 + h * 64 + 32 * sx + 8 * fq);
#pragma unroll
                        for (int vt = 0; vt < 4; ++vt) acc[vt] = __builtin_amdgcn_mfma_f32_16x16x32_bf16(af, *(const LAS bf16x8_t*)(SB + (vt * 16 + fr) * 72 + 32 * sx + 8 * fq), acc[vt], 0, 0, 0); }
                }
                u32x2 W[2][9];
#define CORR_LOAD(buf, rg) do { const int t_ = tb + 4 * fq + (rg); const size_t m_ = (size_t)b * T + t_; const bf16* pr_ = p + m_ * NP + cb; const bf16* pp_ = (t_ > 0) ? pr_ - NP : pr_; \
                    W[buf][0] = *(const u32x2*)(MIX + m_ * D + cb); W[buf][1] = *(const u32x2*)(pr_ + C_R); W[buf][2] = *(const u32x2*)(pr_ + C_K); W[buf][3] = *(const u32x2*)(pr_ + C_V); \
                    W[buf][4] = *(const u32x2*)(pp_ + C_R); W[buf][5] = *(const u32x2*)(pp_ + C_K); W[buf][6] = *(const u32x2*)(pp_ + C_V); W[buf][7] = *(const u32x2*)(AA + m_ * A_W + cb); W[buf][8] = *(const u32x2*)(GG + m_ * A_W + cb); } while (0)
                CORR_LOAD(0, 0);
#pragma unroll
                for (int rg = 0; rg < 4; ++rg) { const int t = tb + 4 * fq + rg; const size_t m = (size_t)b * T + t; const float hp = (t > 0) ? 1.f : 0.f;
                    if (rg < 3) CORR_LOAD((rg + 1) & 1, rg + 1);
                    __builtin_amdgcn_sched_barrier(0);
                    float y[4], rc[4], kc[4], vc[4], rp_[4], kp[4], vp[4], a[4], g[4];
                    unpack4(W[rg & 1][0], y); unpack4(W[rg & 1][1], rc); unpack4(W[rg & 1][2], kc); unpack4(W[rg & 1][3], vc); unpack4(W[rg & 1][4], rp_); unpack4(W[rg & 1][5], kp); unpack4(W[rg & 1][6], vp); unpack4(W[rg & 1][7], a); unpack4(W[rg & 1][8], g);
                    float v[4], sy = 0.f, sb = 0.f;
#pragma unroll
                    for (int i = 0; i < 4; ++i) { y[i] += acc[i][rg];
                        const float r = rc[i] + (rp_[i] * hp - rc[i]) * mur[i], k = kc[i] + (kp[i] * hp - kc[i]) * muk[i]; v[i] = vc[i] + (vp[i] * hp - vc[i]) * muv[i];
                        const float kh = k * (1.f + (a[i] - 1.f) * kac[i]); sb += r * kh * rkc[i]; sy += y[i]; }
                    const float bon = row_sum16(sb), mean = row_sum16(sy) * (1.f / 64.f); float sq = 0.f;
#pragma unroll
                    for (int i = 0; i < 4; ++i) { y[i] -= mean; sq += y[i] * y[i]; }
                    const float rstd = 1.f / sqrtf(row_sum16(sq) * (1.f / 64.f) + GN_EPS); float o[4];
#pragma unroll
                    for (int i = 0; i < 4; ++i) o[i] = (y[i] * rstd * gng[i] + gnb[i] + bon * v[i]) * g[i];
                    u32x2 w; w.x = pk2(o[0], o[1]); w.y = pk2(o[2], o[3]); *(u32x2*)(MIX + m * D + cb) = w;
                    __builtin_amdgcn_sched_barrier(0); }
#undef CORR_LOAD
            }
        }
    }
    for (int g_ = blockIdx.x; g_ < 256; g_ += gridDim.x) {
        {
            const int seg = g_ & 15, bh = g_ >> 4, b = bh >> 2, h = bh & 3;
            const int cb = h * 128 + 8 * fr;
            __syncthreads();
            if (seg > 0) { const float* ss = (const float*)(ws + WS_SEG) + ((size_t)bh * NSEG + (seg - 1)) * 8192;
                for (int i = tid; i < 2048; i += NTHR) { const f32x4 x = *(const f32x4*)(ss + 4 * i); const int v = i >> 4, j = (4 * i) & 63; u32x2 w; w.x = pk2(x[0], x[1]); w.y = pk2(x[2], x[3]);
                    *(LAS u32x2*)(SB + ((v & 7) * 16 + (v >> 3)) * 72 + j) = w; } }
            __syncthreads();
            const f32x4 ng0 = *(const f32x4*)(norm_g + 8 * fr), ng1 = *(const f32x4*)(norm_g + 8 * fr + 4);
            for (int mt = 0; mt < 4; ++mt) {
                const int tb = seg * LSEG + wave * 64 + mt * 16;
                f32x4 acc[8];
#pragma unroll
                for (int vt = 0; vt < 8; ++vt) acc[vt] = (f32x4){0.f, 0.f, 0.f, 0.f};
                if (seg > 0) {
#pragma unroll
                    for (int sx = 0; sx < 2; ++sx) { const bf16x8_t af = *(const bf16x8_t*)(YIG + ((size_t)b * T + tb + fr) * 256 + h * 64 + 32 * sx + 8 * fq);
#pragma unroll
                        for (int vt = 0; vt < 8; ++vt) acc[vt] = __builtin_amdgcn_mfma_f32_16x16x32_bf16(af, *(const LAS bf16x8_t*)(SB + (vt * 16 + fr) * 72 + 32 * sx + 8 * fq), acc[vt], 0, 0, 0); }
                }
                u32x4 WG[2][2];
#define CORG_LOAD(buf, rg) do { const size_t m_ = (size_t)b * T + tb + 4 * fq + (rg); WG[buf][0] = *(const u32x4*)(MIX + m_ * D + 512 + cb); WG[buf][1] = *(const u32x4*)(p + m_ * NP + C_BG + cb); } while (0)
                CORG_LOAD(0, 0);
#pragma unroll
                for (int rg = 0; rg < 4; ++rg) { const size_t m = (size_t)b * T + tb + 4 * fq + rg;
                    if (rg < 3) CORG_LOAD((rg + 1) & 1, rg + 1);
                    __builtin_amdgcn_sched_barrier(0);
                    float o[8], g[8]; float sq = 0.f;
#pragma unroll
                    for (int i = 0; i < 4; ++i) { const unsigned a_ = WG[rg & 1][0][i], b_ = WG[rg & 1][1][i]; o[2 * i] = __uint_as_float(a_ << 16); o[2 * i + 1] = __uint_as_float(a_ & 0xffff0000u); g[2 * i] = __uint_as_float(b_ << 16); g[2 * i + 1] = __uint_as_float(b_ & 0xffff0000u); }
#pragma unroll
                    for (int i = 0; i < 8; ++i) { o[i] += acc[i][rg]; sq += o[i] * o[i]; }
                    const float rs = 1.f / sqrtf(row_sum16(sq) * (1.f / 128.f) + RMS_EPS);
                    float f[8];
#pragma unroll
                    for (int i = 0; i < 8; ++i) f[i] = o[i] * rs * (i < 4 ? ng0[i & 3] : ng1[i & 3]) * siluf_(g[i]);
                    u32x4 w; w.x = pk2(f[0], f[1]); w.y = pk2(f[2], f[3]); w.z = pk2(f[4], f[5]); w.w = pk2(f[6], f[7]); *(u32x4*)(MIX + m * D + 512 + cb) = w;
                    __builtin_amdgcn_sched_barrier(0); }
#undef CORG_LOAD
            }
        }
    }
}

__device__ __forceinline__ void phase_ln1(const Params& P) {
    const int lane = threadIdx.x & 63, wave = threadIdx.x >> 6; const int gw = blockIdx.x * NWAVES + wave, ngw = gridDim.x * NWAVES;
    for (int m = gw; m < M; m += ngw) ln_row_bf16((const float*)(P.ws + WS_Z) + (size_t)m * D, P.in[20], P.in[21], (bf16*)(P.ws + WS_H1) + (size_t)m * D, lane);
#pragma unroll
    for (int tb = 0; tb < 2; ++tb) {
        const float* src = P.in[24 + tb]; unsigned char* dst = P.ws + (tb ? WS_VT : WS_UT); float* sc = (float*)(P.ws + (tb ? WS_SV : WS_SU));
        for (int e = gw; e < 16384; e += ngw) {
            const f32x4* sp = (const f32x4*)(src + (size_t)e * D) + 4 * lane; f32x4 a[4]; float mx = 0.f;
#pragma unroll
            for (int j = 0; j < 4; ++j) { a[j] = sp[j]; mx = fmaxf(fmaxf(mx, fmaxf(fabsf(a[j][0]), fabsf(a[j][1]))), fmaxf(fabsf(a[j][2]), fabsf(a[j][3]))); }
            mx = wave_max_u(mx); const float inv = mx > 0.f ? 31.f / mx : 0.f;
            unsigned q[16];
#pragma unroll
            for (int i = 0; i < 16; ++i) q[i] = (unsigned)(__float2int_rn(a[i >> 2][i & 3] * inv) + 32);
            unsigned p0 = 0u, p1 = 0u, p2 = 0u;
#pragma unroll
            for (int b = 0; b < 4; ++b) {
                p0 |= ((q[b] & 15u) | ((q[4 + b] & 15u) << 4)) << (8 * b);
                p1 |= ((q[8 + b] & 15u) | ((q[12 + b] & 15u) << 4)) << (8 * b);
                p2 |= ((q[b] >> 4) | ((q[4 + b] >> 4) << 2) | ((q[8 + b] >> 4) << 4) | ((q[12 + b] >> 4) << 6)) << (8 * b);
            }
            unsigned* o = (unsigned*)(dst + (size_t)e * ROWB) + 3 * lane; o[0] = p0; o[1] = p1; o[2] = p2;
            if (lane == 0) sc[e] = mx * (1.f / 31.f);
        }
    }
}

#define TK_INS(L, x) do { _Pragma("unroll") for (int _j = 0; _j < 16; ++_j) { const unsigned _h = max(L[_j], x); x = min(L[_j], x); L[_j] = _h; } } while (0)
__device__ __forceinline__ void topk128(const u32x4* r, unsigned (&L)[16]) {
#pragma unroll
    for (int j = 0; j < 16; ++j) L[j] = 0u;
    u32x4 cur = r[0];
    for (int c = 0; c < 16; ++c) {
        const u32x4 nxt = r[(c + 1) & 15];
        const unsigned kb = 0xFFFFu - 8u * (unsigned)c;
#pragma unroll
        for (int d = 0; d < 4; ++d) {
            unsigned w = cur[d]; const unsigned msk = ((w >> 15) & 0x00010001u) * 0xFFFFu; w ^= (msk | 0x80008000u);
            unsigned x0 = (w << 16) | (kb - 2u * d), x1 = (w & 0xFFFF0000u) | (kb - 2u * d - 1u);
            TK_INS(L, x0); TK_INS(L, x1);
        }
        cur = nxt;
    }
}
__device__ __forceinline__ void phase_topk(const Params& P) {
    const int gl = blockIdx.x * NTHR + threadIdx.x, nl = gridDim.x * NTHR;
    const bf16* Sc = (const bf16*)(P.ws + WS_S); int* IDS = (int*)(P.ws + WS_IDS); float* GATES = (float*)(P.ws + WS_GATES);
    for (int item = gl; item < M * 8; item += nl) {
        const u32x4* row = (const u32x4*)(Sc + (size_t)item * 256);
        unsigned L0[16], L1[16];
        topk128(row, L0); topk128(row + 16, L1);
        float f0[16], f1[16]; unsigned p0[16], p1[16];
#pragma unroll
        for (int i = 0; i < 16; ++i) {
            f0[i] = __uint_as_float((L0[i] & 0x80000000u) ? (L0[i] & 0x7FFF0000u) : (~L0[i] & 0xFFFF0000u)); p0[i] = (~L0[i] & 0x7Fu) << 7;
            f1[i] = __uint_as_float((L1[i] & 0x80000000u) ? (L1[i] & 0x7FFF0000u) : (~L1[i] & 0xFFFF0000u)); p1[i] = (~L1[i] & 0x7Fu);
        }
        unsigned C[16];
#pragma unroll
        for (int j = 0; j < 16; ++j) C[j] = 0u;
#pragma unroll
        for (int i = 0; i < 16; ++i)
#pragma unroll
            for (int j = 0; j < 16; ++j)
                if ((i + 1) * (j + 1) <= 16) {
                    const unsigned b = __float_as_uint(f0[i] + f1[j]); const unsigned mono = b ^ ((unsigned)((int)b >> 31) | 0x80000000u);
                    unsigned key = (mono & 0xFFFFC000u) | p0[i] | p1[j];
                    TK_INS(C, key);
                }
        float cv[16];
#pragma unroll
        for (int r = 0; r < 16; ++r) cv[r] = __uint_as_float((C[r] & 0x80000000u) ? (C[r] & 0x7FFFC000u) : (~C[r] & 0xFFFFC000u));
        const float cmax = cv[0]; float den = 0.f;
#pragma unroll
        for (int r = 0; r < 16; ++r) { cv[r] = __expf(cv[r] - cmax); den += cv[r]; }
        const float inv = 1.f / den;
        u32x4* ido = (u32x4*)(IDS + (size_t)item * 16); f32x4* go = (f32x4*)(GATES + (size_t)item * 16);
#pragma unroll
        for (int q = 0; q < 4; ++q) { u32x4 o; o.x = C[4 * q] & 0x3FFFu; o.y = C[4 * q + 1] & 0x3FFFu; o.z = C[4 * q + 2] & 0x3FFFu; o.w = C[4 * q + 3] & 0x3FFFu; ido[q] = o;
            f32x4 g; g[0] = cv[4 * q] * inv; g[1] = cv[4 * q + 1] * inv; g[2] = cv[4 * q + 2] * inv; g[3] = cv[4 * q + 3] * inv; go[q] = g; }
    }
}

typedef __bf16 bf16x2_t __attribute__((ext_vector_type(2)));
__device__ __forceinline__ float dot2bf(unsigned a, unsigned b, float c) { return __builtin_amdgcn_fdot2_f32_bf16(__builtin_bit_cast(bf16x2_t, a), __builtin_bit_cast(bf16x2_t, b), c, false); }
typedef unsigned u32x3 __attribute__((ext_vector_type(3)));
__device__ __forceinline__ void peer_load8(u32x3 (&buf)[8], const unsigned char* TAB, int idreg, int g, int lane) {
#pragma unroll
    for (int q = 0; q < 8; ++q) { const int id = __builtin_amdgcn_readlane(idreg, 8 * g + q); const unsigned* rp = (const unsigned*)(TAB + (size_t)id * ROWB) + 3 * lane; u32x3 w; w.x = rp[0]; w.y = rp[1]; w.z = rp[2]; buf[q] = w; }
}
__device__ __forceinline__ void peer_dots8(const u32x3 (&buf)[8], const u32x4& hq, int g, float& d, int lane) {
#pragma unroll
    for (int q = 0; q < 8; ++q) { const unsigned p0 = buf[q].x, p1 = buf[q].y, p2 = buf[q].z; int s = 0, t = 0;
        s = __builtin_amdgcn_sdot4((int)(p0 & 0x0F0F0F0Fu), (int)hq[0], s, false); s = __builtin_amdgcn_sdot4((int)((p0 >> 4) & 0x0F0F0F0Fu), (int)hq[1], s, false);
        s = __builtin_amdgcn_sdot4((int)(p1 & 0x0F0F0F0Fu), (int)hq[2], s, false); s = __builtin_amdgcn_sdot4((int)((p1 >> 4) & 0x0F0F0F0Fu), (int)hq[3], s, false);
#pragma unroll
        for (int f = 0; f < 4; ++f) t = __builtin_amdgcn_sdot4((int)((p2 >> (2 * f)) & 0x03030303u), (int)hq[f], t, false);
        const int tot = wave_sum_i(s + 16 * t);
        d = (lane == 8 * g + q) ? (float)tot : d; }
}
__device__ __forceinline__ void peer_axpy8(const u32x3 (&buf)[8], float areg, int g, float (&acc)[16]) {
#pragma unroll
    for (int q = 0; q < 8; ++q) { const float a = rlf(areg, 8 * g + q); const unsigned p0 = buf[q].x, p1 = buf[q].y, p2 = buf[q].z;
        const unsigned v0 = (p0 & 0x0F0F0F0Fu) | ((p2 & 0x03030303u) << 4), v1 = ((p0 >> 4) & 0x0F0F0F0Fu) | (((p2 >> 2) & 0x03030303u) << 4);
        const unsigned v2 = (p1 & 0x0F0F0F0Fu) | (((p2 >> 4) & 0x03030303u) << 4), v3 = ((p1 >> 4) & 0x0F0F0F0Fu) | (((p2 >> 6) & 0x03030303u) << 4);
        const unsigned vv[4] = {v0, v1, v2, v3};
#pragma unroll
        for (int i = 0; i < 4; ++i) { const unsigned w = vv[i];
            acc[4 * i] += a * (float)(w & 0xffu); acc[4 * i + 1] += a * (float)((w >> 8) & 0xffu); acc[4 * i + 2] += a * (float)((w >> 16) & 0xffu); acc[4 * i + 3] += a * (float)(w >> 24); } }
}
__device__ __forceinline__ void phase_peer(const Params& P) {
    const int lane = threadIdx.x & 63, wave = threadIdx.x >> 6; const int gw = blockIdx.x * NWAVES + wave, ngw = gridDim.x * NWAVES;
    const bf16* H1 = (const bf16*)(P.ws + WS_H1); const int* IDS = (const int*)(P.ws + WS_IDS); const float* GATES = (const float*)(P.ws + WS_GATES);
    const unsigned char* UT = P.ws + WS_UT; const unsigned char* VT = P.ws + WS_VT; const float* SU = (const float*)(P.ws + WS_SU); const float* SV = (const float*)(P.ws + WS_SV);
    const float* g2 = P.in[26]; const float* b2 = P.in[27];
    for (int m = gw; m < M; m += ngw) {
        const u32x4* hp = (const u32x4*)(H1 + (size_t)m * D) + 2 * lane; const u32x4 hA = hp[0], hB = hp[1];
        float hv[16]; float hmx = 0.f;
#pragma unroll
        for (int i = 0; i < 4; ++i) { hv[2 * i] = __uint_as_float(hA[i] << 16); hv[2 * i + 1] = __uint_as_float(hA[i] & 0xffff0000u); hv[8 + 2 * i] = __uint_as_float(hB[i] << 16); hv[8 + 2 * i + 1] = __uint_as_float(hB[i] & 0xffff0000u); }
#pragma unroll
        for (int i = 0; i < 16; ++i) hmx = fmaxf(hmx, fabsf(hv[i]));
        hmx = wave_max_u(hmx); const float hinv = hmx > 0.f ? 127.f / hmx : 0.f, hsc = hmx * (1.f / 127.f);
        u32x4 hq;
#pragma unroll
        for (int i = 0; i < 4; ++i) hq[i] = pack_i8(hv[4 * i], hv[4 * i + 1], hv[4 * i + 2], hv[4 * i + 3], hinv, 0);
        int hs = 0;
#pragma unroll
        for (int i = 0; i < 4; ++i) hs = __builtin_amdgcn_sdot4((int)hq[i], 0x01010101, hs, false);
        const float hoff = 32.f * (float)wave_sum_i(hs);
        const int id_lo = IDS[(size_t)m * 128 + lane], id_hi = IDS[(size_t)m * 128 + 64 + lane];
        const float gt_lo = GATES[(size_t)m * 128 + lane], gt_hi = GATES[(size_t)m * 128 + 64 + lane];
        const float su_lo = SU[id_lo], su_hi = SU[id_hi], sv_lo = SV[id_lo], sv_hi = SV[id_hi];
        float d_lo = 0.f, d_hi = 0.f;
        u32x3 A0[8], A1[8];
        peer_load8(A0, UT, id_lo, 0, lane);
        for (int g = 0; g < 8; g += 2) {
            peer_load8(A1, UT, id_lo, g + 1, lane); peer_dots8(A0, hq, g, d_lo, lane);
            if (g + 2 < 8) peer_load8(A0, UT, id_lo, g + 2, lane); else peer_load8(A0, UT, id_hi, 0, lane);
            peer_dots8(A1, hq, g + 1, d_lo, lane);
        }
        for (int g = 0; g < 8; g += 2) {
            peer_load8(A1, UT, id_hi, g + 1, lane); peer_dots8(A0, hq, g, d_hi, lane);
            if (g + 2 < 8) peer_load8(A0, UT, id_hi, g + 2, lane); else peer_load8(A0, VT, id_lo, 0, lane);
            peer_dots8(A1, hq, g + 1, d_hi, lane);
        }
        const float x_lo = (d_lo - hoff) * su_lo * hsc, x_hi = (d_hi - hoff) * su_hi * hsc;
        const float a_lo = 0.5f * x_lo * (1.f + erff(x_lo * 0.70710678118f)) * gt_lo * sv_lo, a_hi = 0.5f * x_hi * (1.f + erff(x_hi * 0.70710678118f)) * gt_hi * sv_hi;
        const float c0 = 32.f * wave_sum(a_lo + a_hi);
        float acc[16];
#pragma unroll
        for (int i = 0; i < 16; ++i) acc[i] = 0.f;
        for (int g = 0; g < 8; g += 2) {
            peer_load8(A1, VT, id_lo, g + 1, lane); peer_axpy8(A0, a_lo, g, acc);
            if (g + 2 < 8) peer_load8(A0, VT, id_lo, g + 2, lane); else peer_load8(A0, VT, id_hi, 0, lane);
            peer_axpy8(A1, a_lo, g + 1, acc);
        }
        for (int g = 0; g < 8; g += 2) {
            peer_load8(A1, VT, id_hi, g + 1, lane); peer_axpy8(A0, a_hi, g, acc);
            if (g + 2 < 8) peer_load8(A0, VT, id_hi, g + 2, lane);
            peer_axpy8(A1, a_hi, g + 1, acc);
        }
        float s = 0.f;
#pragma unroll
        for (int i = 0; i < 16; ++i) { acc[i] = ALPHA * hv[i] + (acc[i] - c0); s += acc[i]; }
        const float mean = wave_sum(s) * (1.f / D); float s2 = 0.f;
#pragma unroll
        for (int i = 0; i < 16; ++i) { acc[i] -= mean; s2 += acc[i] * acc[i]; }
        const float rstd = 1.f / sqrtf(wave_sum(s2) * (1.f / D) + LN_EPS);
#pragma unroll
        for (int c4 = 0; c4 < 4; ++c4) { const int e0 = 16 * lane + 4 * c4; const f32x4 gg = *(const f32x4*)(g2 + e0), bb = *(const f32x4*)(b2 + e0); f32x4 o;
#pragma unroll
            for (int j = 0; j < 4; ++j) o[j] = acc[c4 * 4 + j] * rstd * gg[j] + bb[j];
            *(f32x4*)(P.out + (size_t)m * D + e0) = o; }
    }
}

#define XB_TMO      128
#define XB_XCNT(j)  (256  + 64 * (j))
#define XB_XSUB(j)  (1280 + 64 * (j))
#define XB_XGEN(j)  (2304 + 64 * (j))
#define XB_TOP      3328
#define XB_TOPGEN   3392
#define XCD_BAR_WORDS 3456
#define XB_SPIN_CAP (1u << 18)
__device__ __forceinline__ unsigned xb_ld(unsigned* p)              { return __hip_atomic_load(p, __ATOMIC_RELAXED, __HIP_MEMORY_SCOPE_AGENT); }
__device__ __forceinline__ unsigned xb_add(unsigned* p, unsigned v) { return __hip_atomic_fetch_add(p, v, __ATOMIC_RELAXED, __HIP_MEMORY_SCOPE_AGENT); }
__device__ __forceinline__ unsigned xb_xcc_id() { return (unsigned)__builtin_amdgcn_s_getreg((3 << 11) | 20) & 0xFu; }
#define XB_SPIN(cond, bar) do { unsigned _sp = 0; while (cond) { __builtin_amdgcn_s_sleep(1); \
    if ((++_sp & 255u) == 0u) { if (xb_ld(&(bar)[XB_TMO])) break; if (_sp > XB_SPIN_CAP) { atomicAdd(&(bar)[XB_TMO], 1u); break; } } } } while (0)
struct XcdBarrier { unsigned* bar; unsigned x; volatile LAS unsigned* st; };
__device__ __forceinline__ XcdBarrier xcd_barrier_post(unsigned* bar, volatile LAS unsigned* st) {
    XcdBarrier b; b.bar = bar; b.x = xb_xcc_id(); b.st = st;
    if (threadIdx.x == 0) (void)xb_add(&bar[XB_XCNT(b.x)], 1u);
    return b;
}
__device__ __forceinline__ void xcd_barrier_complete(unsigned* bar, unsigned x, unsigned& nloc, unsigned& nx) {
    const unsigned G = gridDim.x * gridDim.y * gridDim.z;
    unsigned sum, cnt, mine, sp = 0u;
    for (;;) {
        sum = 0u; cnt = 0u; mine = 0u;
#pragma unroll
        for (unsigned j = 0; j < 16; ++j) { const unsigned c = xb_ld(&bar[XB_XCNT(j)]); sum += c; cnt += (c > 0u) ? 1u : 0u; mine = (j == x) ? c : mine; }
        if (sum == G) break;
        __builtin_amdgcn_s_sleep(1);
        if ((++sp & 255u) == 0u) { if (xb_ld(&bar[XB_TMO])) break; if (sp > XB_SPIN_CAP) { atomicAdd(&bar[XB_TMO], 1u); break; } }
    }
    nloc = mine > 0u ? mine : 1u; nx = cnt > 0u ? cnt : 1u;
}
__device__ __forceinline__ void xcd_barrier(const XcdBarrier& b) {
    asm volatile("s_waitcnt vmcnt(0)" ::: "memory");
    __syncthreads();
    if (threadIdx.x == 0) {
        unsigned* bar = b.bar;
        __builtin_amdgcn_s_waitcnt(0);
        unsigned nloc = b.st[0], nx = b.st[1];
        if (nloc == 0u) { xcd_barrier_complete(bar, b.x, nloc, nx); b.st[0] = nloc; b.st[1] = nx; }
        const unsigned old = xb_add(&bar[XB_XSUB(b.x)], 1u);
        const unsigned gen = old / nloc;
        if (old + 1u == (gen + 1u) * nloc) {
            __builtin_amdgcn_fence(__ATOMIC_RELEASE, "agent");
            asm volatile("s_waitcnt vmcnt(0)" ::: "memory");
            const unsigned og = xb_add(&bar[XB_TOP], 1u);
            const unsigned tg = og / nx;
            if (og + 1u == (tg + 1u) * nx) xb_add(&bar[XB_TOPGEN], 1u);
            else XB_SPIN(xb_ld(&bar[XB_TOPGEN]) == tg, bar);
            __builtin_amdgcn_fence(__ATOMIC_ACQUIRE, "agent");
            xb_add(&bar[XB_XGEN(b.x)], 1u);
            asm volatile("s_waitcnt vmcnt(0)" ::: "memory");
        } else {
            XB_SPIN(xb_ld(&bar[XB_XGEN(b.x)]) == gen, bar);
            __builtin_amdgcn_fence(__ATOMIC_ACQUIRE, "agent");
            asm volatile("s_waitcnt vmcnt(0)" ::: "memory");
        }
    }
    __syncthreads();
}

constexpr int N_PHASES = 12;
__global__ void __launch_bounds__(NTHR, 2) fwd_kernel(Params P) {
    extern __shared__ __attribute__((aligned(16))) unsigned char lds_raw[];
    LAS unsigned char* lds = (LAS unsigned char*)lds_raw;
    cg::grid_group grid = cg::this_grid();
    const int lo = P.ph_lo, hi = P.ph_hi;
    unsigned char* ws = P.ws;
    volatile LAS unsigned* bst = (volatile LAS unsigned*)(lds + LDS_MISC);
    if (threadIdx.x < 16) bst[threadIdx.x] = 0u;
    __syncthreads();
    const XcdBarrier bar = xcd_barrier_post((unsigned*)(ws + WS_CTL), bst);
#define IN(k) (lo <= (k) && (k) < hi)
#define SEAM(k) do { if (IN(k) && IN((k) + 1)) { if ((k) == 0) grid.sync(); else xcd_barrier(bar); } } while (0)
    if (IN(0)) phase_prologue(P);
    SEAM(0);
    if (IN(1)) {
        pg8::Gemm g{(const bf16*)(ws + WS_H0), (const bf16*)(ws + WS_WIN), M, NP, D, D, D, 0}; pg8::StaticOrder S; S.init(M, NP, gridDim.x, blockIdx.x);
        pg8::EpiBf16 E{(bf16*)(ws + WS_P), NP};
        pg8::gemm_phase<pg8::EpiBf16, pg8::StaticOrder, true, true>(lds, g, S, E);
    }
    SEAM(1);
    if (IN(2)) phase_prep(P, lds);
    SEAM(2);
    if (IN(3)) phase_scan(P, lds);
    SEAM(3);
    if (IN(4)) phase_fixup(P, lds);
    SEAM(4);
    if (IN(5)) phase_correct(P, lds);
    SEAM(5);
    if (IN(6)) {
        pg8::Gemm g{(const bf16*)(ws + WS_MIX), (const bf16*)(ws + WS_WOUT), M, D, D, D, D, 0}; pg8::StaticOrder S; S.init(M, D, gridDim.x, blockIdx.x);
        pg8::EpiResF32 E{(float*)(ws + WS_Z), (const bf16*)(ws + WS_H0), D, ALPHA};
        pg8::gemm_phase<pg8::EpiResF32, pg8::StaticOrder, true, true>(lds, g, S, E);
    }
    SEAM(6);
    if (IN(7)) phase_ln1(P);
    SEAM(7);
    if (IN(8)) {
        pg8::Gemm g{(const bf16*)(ws + WS_H1), (const bf16*)(ws + WS_WQ), M, NQ, D, D, D, 0}; pg8::StaticOrder S; S.init(M, NQ, gridDim.x, blockIdx.x);
        pg8::EpiBf16 E{(bf16*)(ws + WS_Q), NQ};
        pg8::gemm_phase<pg8::EpiBf16, pg8::StaticOrder, true, true>(lds, g, S, E);
    }
    SEAM(8);
    if (IN(9)) {
        pg8::Gemm g{(const bf16*)(ws + WS_Q), (const bf16*)(ws + WS_KBD), M, NQ, 256, NQ, 256, 256}; pg8::StaticOrder S; S.init(M, NQ, gridDim.x, blockIdx.x);
        pg8::EpiBf16 E{(bf16*)(ws + WS_S), NQ};
        pg8::gemm_phase<pg8::EpiBf16, pg8::StaticOrder, true, true>(lds, g, S, E);
    }
    SEAM(9);
    if (IN(10)) phase_topk(P);
    SEAM(10);
    if (IN(11)) phase_peer(P);
#undef IN
#undef SEAM
}

extern "C" void kernel_launch(void* const* d_in, const int* in_sizes, int n_in, void* d_out, int out_size, void* d_ws, size_t ws_size, hipStream_t stream) {
    static int grid = 0;
    if (grid == 0) {
        if (n_in != 28 || out_size != M * D || ws_size < WS_END) { fprintf(stderr, "kernel_launch: unexpected shapes (n_in %d out %d ws %zu)\n", n_in, out_size, ws_size); grid = -1; return; }
        int dev = 0, cus = 0, per_cu = 0;
        (void)hipGetDevice(&dev); (void)hipDeviceGetAttribute(&cus, hipDeviceAttributeMultiprocessorCount, dev);
        (void)hipFuncSetAttribute((const void*)fwd_kernel, hipFuncAttributeMaxDynamicSharedMemorySize, LDS_BYTES);
        (void)hipOccupancyMaxActiveBlocksPerMultiprocessor(&per_cu, (const void*)fwd_kernel, NTHR, LDS_BYTES);
        if (per_cu < 1) { fprintf(stderr, "kernel_launch: occupancy query says %d blocks per CU\n", per_cu); per_cu = 1; }
        (void)hipGetLastError();
        grid = cus;
    }
    if (grid < 0) return;
    Params p{};
    for (int i = 0; i < 28; ++i) p.in[i] = (const float*)d_in[i];
    p.out = (float*)d_out; p.ws = (unsigned char*)d_ws;
    (void)hipMemsetAsync((char*)d_ws + WS_CTL, 0, CTL_BYTES, stream);
#if MK_ONE_LAUNCH
    p.ph_lo = 0; p.ph_hi = N_PHASES;
    void* args[] = {&p};
    hipError_t e = hipLaunchCooperativeKernel((const void*)fwd_kernel, dim3(grid), dim3(NTHR), args, LDS_BYTES, stream);
    if (e != hipSuccess) fprintf(stderr, "cooperative launch failed: %s (grid %d)\n", hipGetErrorString(e), grid);
#else
    for (int ph = 0; ph < N_PHASES; ++ph) {
        p.ph_lo = ph; p.ph_hi = ph + 1;
        hipLaunchKernelGGL(fwd_kernel, dim3(grid), dim3(NTHR), LDS_BYTES, stream, p);
    }
#endif
}
```

```cpp
#include <hip/hip_runtime.h>
#include <hip/hip_cooperative_groups.h>
#include <cstdio>
#include <cstdint>
namespace cg = cooperative_groups;

#ifndef MK_ONE_LAUNCH
#define MK_ONE_LAUNCH 1
#endif

namespace pg8 {
#define PG8_LAS __attribute__((address_space(3)))
typedef unsigned short bf16_t;
typedef short bf16x8 __attribute__((ext_vector_type(8)));
typedef float f32x4 __attribute__((ext_vector_type(4)));
typedef float f32x2 __attribute__((ext_vector_type(2)));
typedef unsigned u32x4 __attribute__((ext_vector_type(4)));
typedef unsigned u32x2 __attribute__((ext_vector_type(2)));
constexpr int BM = 256, BK = 64, HALF = 128, HTB = HALF * BK * 2, STAGE_BYTES = 8 * HTB, NXCD = 8, WGM = 8;

__host__ __device__ __forceinline__ int lds_byte(int r, int c) { const int st = (r >> 4) * 2 + (c >> 5), rr = r & 15, cc = c & 31, ob = rr * 64 + cc * 2; return st * 1024 + (ob ^ (((ob >> 9) & 1) << 5)); }
__host__ __device__ __forceinline__ void stage_rc(int b, int& R, int& C) { const int st = b / 1024, sb = b % 1024, swz = sb ^ (((sb >> 9) & 1) << 5); R = (st >> 1) * 16 + swz / 64; C = (st & 1) * 32 + (swz % 64) / 2; }
__host__ __device__ __forceinline__ int perm32(int rho) { const int n = rho >> 4, i = rho & 15; return 8 * (i >> 2) + 4 * n + (i & 3); }

struct Unit { int pm, pn; };
struct Gemm { const bf16_t* A; const bf16_t* Bt; int M, N, K, lda, ldb, a_pn_koff; };

struct StaticOrder {
    int nM, nN, nwg, G, c;
    __host__ __device__ void init(int M, int N, int G_, int c_) { nM = M / BM; nN = N / BM; nwg = nM * nN; G = G_; c = c_; }
    __host__ __device__ bool next(int i, Unit& u) const {
        const long L = (long)i * G + c; if (L >= nwg) return false;
        int wgid = (int)L; { const int q = nwg / NXCD, r = nwg % NXCD, xcd = wgid % NXCD, off = wgid / NXCD; wgid = (xcd < r ? xcd * (q + 1) : r * (q + 1) + (xcd - r) * q) + off; }
        const int nig = WGM * nN, gid = wgid / nig, fm = gid * WGM, gsz = (nM - fm) < WGM ? (nM - fm) : WGM;
        u.pm = fm + ((wgid % nig) % gsz); u.pn = (wgid % nig) / gsz; return true;
    }
    __device__ __forceinline__ void a_ready(const Unit&) const {}
    __device__ __forceinline__ void done(const Unit&) const {}
};

__device__ __forceinline__ unsigned cvt_pk_bf16(float lo, float hi) { unsigned r; asm volatile("v_cvt_pk_bf16_f32 %0, %1, %2" : "=v"(r) : "v"(lo), "v"(hi)); return r; }

struct EpiBf16 {
    static constexpr bool PERM = true;
    bf16_t* O; int ldc;
    __device__ __forceinline__ void operator()(const f32x4 (&acc)[2][2][4][2], const Unit& u, int wr, int wc, int fr, int fq) const {
        const int row0 = u.pm * BM + wr * 64 + fr; const int col0 = u.pn * BM + wc * 32 + 8 * fq;
#pragma unroll
        for (int ai = 0; ai < 2; ++ai)
#pragma unroll
            for (int m = 0; m < 4; ++m) { bf16_t* rowp = O + (size_t)(row0 + ai * HALF + m * 16) * ldc + col0;
#pragma unroll
                for (int bj = 0; bj < 2; ++bj) { const f32x4 v0 = acc[ai][bj][m][0], v1 = acc[ai][bj][m][1];
                    u32x4 w; w.x = cvt_pk_bf16(v0[0], v0[1]); w.y = cvt_pk_bf16(v0[2], v0[3]); w.z = cvt_pk_bf16(v1[0], v1[1]); w.w = cvt_pk_bf16(v1[2], v1[3]);
                    *(u32x4*)(rowp + bj * HALF) = w; } }
    }
};
struct EpiResBf16 {
    static constexpr bool PERM = true;
    bf16_t* Z; const bf16_t* R; int ldc; float alpha;
    __device__ __forceinline__ void operator()(const f32x4 (&acc)[2][2][4][2], const Unit& u, int wr, int wc, int fr, int fq) const {
        const int row0 = u.pm * BM + wr * 64 + fr; const int col0 = u.pn * BM + wc * 32 + 8 * fq;
#pragma unroll
        for (int ai = 0; ai < 2; ++ai)
#pragma unroll
            for (int m = 0; m < 4; ++m) { const size_t off = (size_t)(row0 + ai * HALF + m * 16) * ldc + col0;
#pragma unroll
                for (int bj = 0; bj < 2; ++bj) { const u32x4 rb = *(const u32x4*)(R + off + bj * HALF); const f32x4 v0 = acc[ai][bj][m][0], v1 = acc[ai][bj][m][1];
                    u32x4 w;
                    w.x = cvt_pk_bf16(__uint_as_float(rb.x << 16) * alpha + v0[0], __uint_as_float(rb.x & 0xffff0000u) * alpha + v0[1]);
                    w.y = cvt_pk_bf16(__uint_as_float(rb.y << 16) * alpha + v0[2], __uint_as_float(rb.y & 0xffff0000u) * alpha + v0[3]);
                    w.z = cvt_pk_bf16(__uint_as_float(rb.z << 16) * alpha + v1[0], __uint_as_float(rb.z & 0xffff0000u) * alpha + v1[1]);
                    w.w = cvt_pk_bf16(__uint_as_float(rb.w << 16) * alpha + v1[2], __uint_as_float(rb.w & 0xffff0000u) * alpha + v1[3]);
                    *(u32x4*)(Z + off + bj * HALF) = w; } }
    }
};
struct EpiResF32 {
    static constexpr bool PERM = false;
    float* Z; const bf16_t* R; int ldc; float alpha;
    __device__ __forceinline__ void operator()(const f32x4 (&acc)[2][2][4][2], const Unit& u, int wr, int wc, int fr, int fq) const {
        const int row0 = u.pm * BM + wr * 64 + fr; const int col0 = u.pn * BM + wc * 32 + 4 * fq;
#pragma unroll
        for (int ai = 0; ai < 2; ++ai)
#pragma unroll
            for (int m = 0; m < 4; ++m) { const size_t off = (size_t)(row0 + ai * HALF + m * 16) * ldc + col0;
#pragma unroll
                for (int bj = 0; bj < 2; ++bj)
#pragma unroll
                    for (int n = 0; n < 2; ++n) { const size_t o2 = off + bj * HALF + n * 16; const u32x2 rb = *(const u32x2*)(R + o2);
                        f32x4 h; h[0] = __uint_as_float(rb.x << 16); h[1] = __uint_as_float(rb.x & 0xffff0000u); h[2] = __uint_as_float(rb.y << 16); h[3] = __uint_as_float(rb.y & 0xffff0000u);
                        *(f32x4*)(Z + o2) = h * alpha + acc[ai][bj][m][n]; } }
    }
};

template <class Epi, class Sched, bool ALIGN_EPI = false, bool SP2 = false>
__device__ __forceinline__ void gemm_phase(PG8_LAS unsigned char* lds, const Gemm g, const Sched& S, const Epi& E) {
    const int tid = threadIdx.x, wid = __builtin_amdgcn_readfirstlane(tid >> 6), lane = tid & 63, wr = wid >> 2, wc = wid & 3, fr = lane & 15, fq = lane >> 4;
    const int K = g.K, nt = K / BK;
    unsigned voffA[2], voffB[2];
#pragma unroll
    for (int i = 0; i < 2; ++i) { int R, C; stage_rc(tid * 16 + i * 8192, R, C); const int Rb = Epi::PERM ? ((R & ~31) + perm32(R & 31)) : R;
        voffA[i] = (unsigned)(R * g.lda + C) * 2u; voffB[i] = (unsigned)(Rb * g.ldb + C) * 2u; }
    const size_t kstep = (size_t)(BK * 2);
    const size_t hstepA = (size_t)HALF * g.lda * 2, hstepB = (size_t)HALF * g.ldb * 2;
    const size_t tstepA = 2 * hstepA, tstepB = 2 * hstepB;
    const size_t pnA = (size_t)g.a_pn_koff * 2;
    const unsigned ldsw = (unsigned)wid * 1024u;
    const int aoff = lds_byte(wr * 64 + fr, fq * 8), boff = lds_byte(wc * 32 + fr, fq * 8);
#define PG8_SA(b, h) (((b) * 2 + (h)) * HTB)
#define PG8_SB(b, h) ((4 + (b) * 2 + (h)) * HTB)
#define PG8_STAGE(bufoff, gbase, voff) do { _Pragma("unroll") for (int _i = 0; _i < 2; ++_i) \
        __builtin_amdgcn_global_load_lds((const unsigned*)((const char*)(gbase) + (voff)[_i]), (PG8_LAS unsigned*)(lds + (bufoff) + ldsw + _i * 8192), 16, 0, 0); } while (0)
#define PG8_LDA(dst, b, h) do { _Pragma("unroll") for (int m = 0; m < 4; ++m) _Pragma("unroll") for (int k = 0; k < 2; ++k) dst[m][k] = *(const PG8_LAS bf16x8*)(lds + PG8_SA(b, h) + aoff + m * 2048 + k * 1024); } while (0)
#define PG8_LDB(dst, b, h) do { _Pragma("unroll") for (int n = 0; n < 2; ++n) _Pragma("unroll") for (int k = 0; k < 2; ++k) dst[n][k] = *(const PG8_LAS bf16x8*)(lds + PG8_SB(b, h) + boff + n * 2048 + k * 1024); } while (0)
#define PG8_MMA(ai, bj, At, Bt) do { __builtin_amdgcn_s_setprio(1); _Pragma("unroll") for (int m = 0; m < 4; ++m) _Pragma("unroll") for (int n = 0; n < 2; ++n) _Pragma("unroll") for (int k = 0; k < 2; ++k) \
        acc[ai][bj][m][n] = __builtin_amdgcn_mfma_f32_16x16x32_bf16(Bt[n][k], At[m][k], acc[ai][bj][m][n], 0, 0, 0); __builtin_amdgcn_s_setprio(0); } while (0)
#define PG8_WAIT_V(n) asm volatile("s_waitcnt vmcnt(" #n ")" ::: "memory")
#define PG8_WAIT_L(n) asm volatile("s_waitcnt lgkmcnt(" #n ")" ::: "memory")
#define PG8_BAR __builtin_amdgcn_s_barrier()
#define PG8_SCHED __builtin_amdgcn_sched_barrier(0)
    Unit cur, nxt; int ui = 0;
    if (!S.next(0, cur)) return;
    f32x4 acc[2][2][4][2];
#pragma unroll
    for (int a = 0; a < 2; ++a)
#pragma unroll
        for (int b = 0; b < 2; ++b)
#pragma unroll
            for (int m = 0; m < 4; ++m)
#pragma unroll
                for (int n = 0; n < 2; ++n) acc[a][b][m][n] = (f32x4){0.f, 0.f, 0.f, 0.f};
    bf16x8 At[4][2], B0[2][2], B1[2][2];
    const char* cA = (const char*)g.A + (size_t)cur.pm * tstepA + (size_t)cur.pn * pnA; const char* cB = (const char*)g.Bt + (size_t)cur.pn * tstepB;
    S.a_ready(cur);
    if constexpr (SP2) {
        PG8_STAGE(PG8_SB(0, 0), cB, voffB); PG8_STAGE(PG8_SB(0, 1), cB + hstepB, voffB); PG8_STAGE(PG8_SA(0, 0), cA, voffA); PG8_STAGE(PG8_SA(0, 1), cA + hstepA, voffA);
        if (wr == 1) PG8_BAR;
        PG8_WAIT_V(2); PG8_BAR;
        PG8_STAGE(PG8_SB(1, 0), cB + kstep, voffB); PG8_STAGE(PG8_SA(1, 0), cA + kstep, voffA); PG8_STAGE(PG8_SB(1, 1), cB + hstepB + kstep, voffB);
        PG8_WAIT_V(6); PG8_BAR;
    } else {
        PG8_STAGE(PG8_SB(0, 0), cB, voffB); PG8_STAGE(PG8_SA(0, 0), cA, voffA); PG8_STAGE(PG8_SB(0, 1), cB + hstepB, voffB); PG8_STAGE(PG8_SA(0, 1), cA + hstepA, voffA);
        if (wr == 1) PG8_BAR;
        PG8_WAIT_V(4); PG8_BAR;
        PG8_STAGE(PG8_SB(1, 0), cB + kstep, voffB); PG8_STAGE(PG8_SA(1, 0), cA + kstep, voffA); PG8_STAGE(PG8_SB(1, 1), cB + hstepB + kstep, voffB);
        PG8_WAIT_V(6); PG8_BAR;
    }
    for (;;) {
        const bool has_next = S.next(ui + 1, nxt);
        const char* nA = has_next ? (const char*)g.A + (size_t)nxt.pm * tstepA + (size_t)nxt.pn * pnA : cA; const char* nB = has_next ? (const char*)g.Bt + (size_t)nxt.pn * tstepB : cB;
        for (int t = 0; t < nt; t += 2) {
            const bool last = (t == nt - 2);
            const char* a1 = cA + (size_t)(t + 1) * kstep;
            const char* a2 = last ? nA : cA + (size_t)(t + 2) * kstep; const char* b2 = last ? nB : cB + (size_t)(t + 2) * kstep;
            const char* a3 = a2 + kstep; const char* b3 = b2 + kstep;
            if (last && has_next) S.a_ready(nxt);
            if constexpr (SP2) {
            PG8_LDB(B0, 0, 0); PG8_LDB(B1, 0, 1); PG8_SCHED; PG8_LDA(At, 0, 0); PG8_STAGE(PG8_SA(1, 1), a1 + hstepA, voffA);
            PG8_WAIT_V(8); PG8_WAIT_L(0); PG8_BAR; PG8_MMA(0, 0, At, B0); PG8_MMA(0, 1, At, B1); PG8_BAR; PG8_SCHED;
            PG8_LDA(At, 0, 1); PG8_STAGE(PG8_SB(0, 0), b2, voffB); PG8_STAGE(PG8_SB(0, 1), b2 + hstepB, voffB); PG8_STAGE(PG8_SA(0, 0), a2, voffA);
            PG8_WAIT_V(8); PG8_WAIT_L(0); PG8_BAR; PG8_MMA(1, 0, At, B0); PG8_MMA(1, 1, At, B1); PG8_BAR; PG8_SCHED;
            PG8_LDB(B0, 1, 0); PG8_LDB(B1, 1, 1); PG8_SCHED; PG8_LDA(At, 1, 0); PG8_STAGE(PG8_SA(0, 1), a2 + hstepA, voffA);
            PG8_WAIT_V(8); PG8_WAIT_L(0); PG8_BAR; PG8_MMA(0, 0, At, B0); PG8_MMA(0, 1, At, B1); PG8_BAR; PG8_SCHED;
            PG8_LDA(At, 1, 1); PG8_STAGE(PG8_SB(1, 0), b3, voffB); PG8_STAGE(PG8_SB(1, 1), b3 + hstepB, voffB); PG8_STAGE(PG8_SA(1, 0), a3, voffA);
            PG8_WAIT_V(8); PG8_WAIT_L(0); PG8_BAR; PG8_MMA(1, 0, At, B0); PG8_MMA(1, 1, At, B1); PG8_BAR; PG8_SCHED;
            } else {
            PG8_LDB(B0, 0, 0); PG8_SCHED; PG8_LDA(At, 0, 0); PG8_STAGE(PG8_SA(1, 1), a1 + hstepA, voffA);
            PG8_WAIT_L(8); PG8_BAR; PG8_WAIT_L(0); PG8_MMA(0, 0, At, B0); PG8_BAR; PG8_SCHED;
            PG8_LDB(B1, 0, 1); PG8_STAGE(PG8_SB(0, 0), b2, voffB);
            PG8_BAR; PG8_WAIT_L(0); PG8_MMA(0, 1, At, B1); PG8_BAR;
            PG8_LDA(At, 0, 1); PG8_STAGE(PG8_SA(0, 0), a2, voffA);
            PG8_BAR; PG8_WAIT_L(0); PG8_MMA(1, 0, At, B0); PG8_BAR; PG8_SCHED;
            PG8_STAGE(PG8_SB(0, 1), b2 + hstepB, voffB);
            PG8_WAIT_V(6); PG8_BAR; PG8_MMA(1, 1, At, B1); PG8_BAR;
            PG8_LDB(B0, 1, 0); PG8_SCHED; PG8_LDA(At, 1, 0); PG8_STAGE(PG8_SA(0, 1), a2 + hstepA, voffA);
            PG8_WAIT_L(8); PG8_BAR; PG8_WAIT_L(0); PG8_MMA(0, 0, At, B0); PG8_BAR; PG8_SCHED;
            PG8_LDB(B1, 1, 1); PG8_STAGE(PG8_SB(1, 0), b3, voffB);
            PG8_BAR; PG8_WAIT_L(0); PG8_MMA(0, 1, At, B1); PG8_BAR;
            PG8_LDA(At, 1, 1); PG8_STAGE(PG8_SA(1, 0), a3, voffA);
            PG8_BAR; PG8_WAIT_L(0); PG8_MMA(1, 0, At, B0); PG8_BAR; PG8_SCHED;
            PG8_STAGE(PG8_SB(1, 1), b3 + hstepB, voffB);
            PG8_WAIT_V(6); PG8_BAR; PG8_MMA(1, 1, At, B1); PG8_BAR;
            }
        }
        if constexpr (ALIGN_EPI) { if (wr == 0) PG8_BAR; }
        E(acc, cur, wr, wc, fr, fq); S.done(cur);
        if (!has_next) break;
#pragma unroll
        for (int a = 0; a < 2; ++a)
#pragma unroll
            for (int b = 0; b < 2; ++b)
#pragma unroll
                for (int m = 0; m < 4; ++m)
#pragma unroll
                    for (int n = 0; n < 2; ++n) acc[a][b][m][n] = (f32x4){0.f, 0.f, 0.f, 0.f};
        cur = nxt; cA = nA; cB = nB; ++ui;
        if constexpr (ALIGN_EPI) { if (wr == 1) PG8_BAR; }
    }
    PG8_WAIT_V(0);
    if constexpr (!ALIGN_EPI) { if (wr == 0) PG8_BAR; }
    PG8_BAR;
#undef PG8_SA
#undef PG8_SB
#undef PG8_STAGE
#undef PG8_LDA
#undef PG8_LDB
#undef PG8_MMA
#undef PG8_WAIT_V
#undef PG8_WAIT_L
#undef PG8_BAR
#undef PG8_SCHED
}
}

constexpr int NWAVES = 8, NTHR = NWAVES * 64;
constexpr int D = 1024, NBATCH = 4, T = 8192, M = NBATCH * T;
constexpr int A_W = 512, A_IN = 1792, IN_COLS = 3344, NP = 3584;
constexpr int C_R = 0, C_K = 512, C_V = 1024, C_WD = 1536, C_AD = 1600, C_GD = 1664;
constexpr int C_BQ = 1792, C_BK = 2048, C_BV = 2304, C_GKD = 2816, C_BG = 2832;
constexpr int NQ = 2048;
constexpr float LN_EPS = 1e-5f, GN_EPS = 64e-5f, RMS_EPS = 1e-5f;
constexpr float ALPHA = 1.189207115002721f;

typedef unsigned short bf16;
typedef float f32x4 __attribute__((ext_vector_type(4)));
typedef float f32x2 __attribute__((ext_vector_type(2)));
typedef unsigned u32x4 __attribute__((ext_vector_type(4)));
typedef unsigned u32x2 __attribute__((ext_vector_type(2)));
#define LAS __attribute__((address_space(3)))

constexpr size_t MiB = 1u << 20;
constexpr size_t WS_WIN = 1 * MiB, WS_WOUT = 8 * MiB, WS_WQ = 10 * MiB, WS_KBD = 14 * MiB;
constexpr size_t WS_W2T = 15 * MiB, WS_A2T = WS_W2T + 65536, WS_G2T = WS_A2T + 65536;
constexpr size_t WS_H0 = 16 * MiB;
constexpr size_t WS_P = 80 * MiB;
constexpr size_t WS_WL = 304 * MiB, WS_AA = 336 * MiB, WS_GG = 368 * MiB;
constexpr size_t WS_GK = 400 * MiB;
constexpr size_t WS_MIX = 416 * MiB;
constexpr size_t WS_Z = 80 * MiB;
constexpr size_t WS_H1 = 208 * MiB;
constexpr size_t WS_Q = 272 * MiB;
constexpr size_t WS_S = 80 * MiB;
constexpr size_t WS_IDS = 400 * MiB, WS_GATES = 416 * MiB;
constexpr size_t WS_UT = 432 * MiB, WS_VT = 448 * MiB;
constexpr int ROWB = 768;
constexpr size_t WS_SU = 464 * MiB, WS_SV = 465 * MiB;
constexpr int NSEG = 16, LSEG = 8192 / NSEG;
constexpr size_t WS_YI = WS_WL;
constexpr size_t WS_YIG = WS_GK;
constexpr size_t WS_SER = 480 * MiB;
constexpr size_t WS_SEG = 496 * MiB;
constexpr size_t WS_CEND = 504 * MiB;
constexpr size_t WS_END = 505 * MiB;

constexpr int LDS_BYTES = 147456, LDS_MISC = LDS_BYTES - 256;
constexpr size_t WS_CTL = 0, CTL_BYTES = 16384;

struct Params {
    const float* in[28];
    float* out; unsigned char* ws;
    int ph_lo, ph_hi;
};

__device__ __forceinline__ float bf2f(unsigned u) { return __uint_as_float(u << 16); }
__device__ __forceinline__ unsigned f2bf(float f) { unsigned u = __float_as_uint(f); return (u + 0x7fffu + ((u >> 16) & 1u)) >> 16; }
__device__ __forceinline__ unsigned pk2(float lo, float hi) { return f2bf(lo) | (f2bf(hi) << 16); }
#define DPP_F(v, ctrl) __builtin_bit_cast(float, __builtin_amdgcn_update_dpp(0, __builtin_bit_cast(int, (v)), (ctrl), 0xf, 0xf, false))
#define DPP_ADD(v, ctrl) ((v) + DPP_F(v, ctrl))
__device__ __forceinline__ float rlf(float v, int l) { return __builtin_bit_cast(float, __builtin_amdgcn_readlane(__builtin_bit_cast(int, v), l)); }
__device__ __forceinline__ float wave_sum_u(float v) {
    v = DPP_ADD(v, 0xB1); v = DPP_ADD(v, 0x4E); v = DPP_ADD(v, 0x141); v = DPP_ADD(v, 0x140);
    return (rlf(v, 0) + rlf(v, 16)) + (rlf(v, 32) + rlf(v, 48));
}
__device__ __forceinline__ float wave_sum(float v) { return wave_sum_u(v); }
#define DPP_I(v, ctrl) __builtin_amdgcn_update_dpp(0, (v), (ctrl), 0xf, 0xf, false)
__device__ __forceinline__ int wave_sum_i(int v) {
    v += DPP_I(v, 0xB1); v += DPP_I(v, 0x4E); v += DPP_I(v, 0x141); v += DPP_I(v, 0x140);
    return (__builtin_amdgcn_readlane(v, 0) + __builtin_amdgcn_readlane(v, 16)) + (__builtin_amdgcn_readlane(v, 32) + __builtin_amdgcn_readlane(v, 48));
}
__device__ __forceinline__ float wave_max_u(float v) {
    v = fmaxf(v, DPP_F(v, 0xB1)); v = fmaxf(v, DPP_F(v, 0x4E)); v = fmaxf(v, DPP_F(v, 0x141)); v = fmaxf(v, DPP_F(v, 0x140));
    return fmaxf(fmaxf(rlf(v, 0), rlf(v, 16)), fmaxf(rlf(v, 32), rlf(v, 48)));
}
__device__ __forceinline__ unsigned pack_i8(float a, float b, float c, float d, float inv, int off) {
    const int q0 = __float2int_rn(a * inv) + off, q1 = __float2int_rn(b * inv) + off, q2 = __float2int_rn(c * inv) + off, q3 = __float2int_rn(d * inv) + off;
    return (unsigned)(q0 & 0xff) | ((unsigned)(q1 & 0xff) << 8) | ((unsigned)(q2 & 0xff) << 16) | ((unsigned)(q3 & 0xff) << 24);
}
__device__ __forceinline__ float sigmoidf_(float x) { return 1.f / (1.f + __expf(-x)); }
__device__ __forceinline__ float softplusf_(float x) { return fmaxf(x, 0.f) + log1pf(__expf(-fabsf(x))); }
__device__ __forceinline__ float siluf_(float x) { return x * sigmoidf_(x); }

__device__ __forceinline__ void transpose_convert(const float* W, int K, int N, int Npad, bf16* WT, int gtid, int gthreads) {
    const int kc = K / 8, total = Npad * kc;
    for (int idx = gtid; idx < total; idx += gthreads) {
        const int n = idx % Npad, c = idx / Npad; float v[8];
#pragma unroll
        for (int j = 0; j < 8; ++j) v[j] = (n < N) ? W[(size_t)(8 * c + j) * N + n] : 0.f;
        u32x4 o; o.x = pk2(v[0], v[1]); o.y = pk2(v[2], v[3]); o.z = pk2(v[4], v[5]); o.w = pk2(v[6], v[7]);
        *(u32x4*)(WT + (size_t)n * K + 8 * c) = o;
    }
}
__device__ __forceinline__ void ln_row_bf16(const float* xrow, const float* g, const float* b, bf16* orow, int lane) {
    const f32x4* xr = (const f32x4*)xrow + lane; f32x4 v[4]; float s = 0.f;
#pragma unroll
    for (int j = 0; j < 4; ++j) { v[j] = xr[64 * j]; s += (v[j][0] + v[j][1]) + (v[j][2] + v[j][3]); }
    const float mean = wave_sum(s) * (1.f / D); float s2 = 0.f;
#pragma unroll
    for (int j = 0; j < 4; ++j) { v[j] = v[j] - mean; s2 += (v[j][0] * v[j][0] + v[j][1] * v[j][1]) + (v[j][2] * v[j][2] + v[j][3] * v[j][3]); }
    const float rstd = 1.f / sqrtf(wave_sum(s2) * (1.f / D) + LN_EPS);
    u32x2* o8 = (u32x2*)orow + lane;
#pragma unroll
    for (int j = 0; j < 4; ++j) { const f32x4 gg = ((const f32x4*)g)[lane + 64 * j], bb = ((const f32x4*)b)[lane + 64 * j]; const f32x4 y = v[j] * rstd * gg + bb;
        u32x2 w; w.x = pk2(y[0], y[1]); w.y = pk2(y[2], y[3]); o8[64 * j] = w; }
}
__device__ __forceinline__ void ln_rowb_bf16(const bf16* xrow, const float* g, const float* b, bf16* orow, int lane) {
    const u32x4* xr = (const u32x4*)xrow + 2 * lane; const u32x4 a = xr[0], c = xr[1]; float v[16]; float s = 0.f;
#pragma unroll
    for (int i = 0; i < 4; ++i) { v[2 * i] = __uint_as_float(a[i] << 16); v[2 * i + 1] = __uint_as_float(a[i] & 0xffff0000u); v[8 + 2 * i] = __uint_as_float(c[i] << 16); v[8 + 2 * i + 1] = __uint_as_float(c[i] & 0xffff0000u); }
#pragma unroll
    for (int i = 0; i < 16; ++i) s += v[i];
    const float mean = wave_sum(s) * (1.f / D); float s2 = 0.f;
#pragma unroll
    for (int i = 0; i < 16; ++i) { v[i] -= mean; s2 += v[i] * v[i]; }
    const float rstd = 1.f / sqrtf(wave_sum(s2) * (1.f / D) + LN_EPS);
    u32x4 o0, o1;
#pragma unroll
    for (int q = 0; q < 4; ++q) { const f32x4 gg = *(const f32x4*)(g + 16 * lane + 4 * q), bb = *(const f32x4*)(b + 16 * lane + 4 * q);
        const unsigned lo = pk2(v[4 * q] * rstd * gg[0] + bb[0], v[4 * q + 1] * rstd * gg[1] + bb[1]), hi = pk2(v[4 * q + 2] * rstd * gg[2] + bb[2], v[4 * q + 3] * rstd * gg[3] + bb[3]);
        if (q < 2) { o0[2 * q] = lo; o0[2 * q + 1] = hi; } else { o1[2 * q - 4] = lo; o1[2 * q - 3] = hi; } }
    u32x4* op = (u32x4*)orow + 2 * lane; op[0] = o0; op[1] = o1;
}
__device__ __forceinline__ void phase_prologue(const Params& P) {
    const int tid = threadIdx.x, lane = tid & 63, wave = tid >> 6;
    const int gtid = blockIdx.x * NTHR + tid, gthreads = gridDim.x * NTHR;
    unsigned char* ws = P.ws;
    transpose_convert(P.in[3], D, IN_COLS, NP, (bf16*)(ws + WS_WIN), gtid, gthreads);
    transpose_convert(P.in[19], D, D, D, (bf16*)(ws + WS_WOUT), gtid, gthreads);
    transpose_convert(P.in[22], D, NQ, NQ, (bf16*)(ws + WS_WQ), gtid, gthreads);
    transpose_convert(P.in[6], 64, A_W, A_W, (bf16*)(ws + WS_W2T), gtid, gthreads);
    transpose_convert(P.in[8], 64, A_W, A_W, (bf16*)(ws + WS_A2T), gtid, gthreads);
    transpose_convert(P.in[9], 128, A_W, A_W, (bf16*)(ws + WS_G2T), gtid, gthreads);
    {
        const float* keys = P.in[23]; bf16* kbd = (bf16*)(ws + WS_KBD);
        for (int idx = gtid; idx < 8 * 256 * 32; idx += gthreads) {
            const int kc = idx & 31, n = (idx >> 5) & 255, h = idx >> 13; const int k0 = kc * 8, hn = n >> 7, key = n & 127, hk = k0 >> 7, c0 = k0 & 127;
            u32x4 o = (u32x4){0u, 0u, 0u, 0u};
            if (hn == hk) { const float* s = keys + ((size_t)((h * 2 + hn) * 128 + key)) * 128 + c0; o.x = pk2(s[0], s[1]); o.y = pk2(s[2], s[3]); o.z = pk2(s[4], s[5]); o.w = pk2(s[6], s[7]); }
            *(u32x4*)(kbd + ((size_t)(h * 256 + n)) * 256 + k0) = o;
        }
    }
    const int gw = blockIdx.x * NWAVES + wave, ngw = gridDim.x * NWAVES;
    for (int m = gw; m < M; m += ngw) ln_row_bf16(P.in[0] + (size_t)m * D, P.in[1], P.in[2], (bf16*)(ws + WS_H0) + (size_t)m * D, lane);
}

typedef short bf16x8_t __attribute__((ext_vector_type(8)));
template <int KS, int LDA>
__device__ __forceinline__ void lora_mm(f32x4 (&acc)[4][4], const LAS bf16* ACT, const bf16* WT, int c0, int fr, int fq) {
#pragma unroll
    for (int mt = 0; mt < 4; ++mt)
#pragma unroll
        for (int nt = 0; nt < 4; ++nt) acc[mt][nt] = (f32x4){0.f, 0.f, 0.f, 0.f};
#pragma unroll
    for (int s = 0; s < KS; ++s) {
        bf16x8_t af[4], bfr[4];
#pragma unroll
        for (int mt = 0; mt < 4; ++mt) af[mt] = *(const LAS bf16x8_t*)(ACT + (mt * 16 + fr) * LDA + 32 * s + 8 * fq);
#pragma unroll
        for (int nt = 0; nt < 4; ++nt) bfr[nt] = *(const bf16x8_t*)(WT + (size_t)(c0 + nt * 16 + fr) * (32 * KS) + 32 * s + 8 * fq);
#pragma unroll
        for (int mt = 0; mt < 4; ++mt)
#pragma unroll
            for (int nt = 0; nt < 4; ++nt) acc[mt][nt] = __builtin_amdgcn_mfma_f32_16x16x32_bf16(bfr[nt], af[mt], acc[mt][nt], 0, 0, 0);
    }
}
__device__ __forceinline__ void phase_prep(const Params& P, LAS unsigned char* lds) {
    const int tid = threadIdx.x, lane = tid & 63, wave = __builtin_amdgcn_readfirstlane(tid >> 6), fr = lane & 15, fq = lane >> 4;
    unsigned char* ws = P.ws;
    const bf16* p = (const bf16*)(ws + WS_P);
    const float* mu = P.in[4]; const float* w0 = P.in[5]; const float* a0 = P.in[7];
    const float* gkw2 = P.in[16]; const float* gkb = P.in[17];
    const bf16* W2T = (const bf16*)(ws + WS_W2T); const bf16* A2T = (const bf16*)(ws + WS_A2T); const bf16* G2T = (const bf16*)(ws + WS_G2T);
    bf16* WL = (bf16*)(ws + WS_WL); bf16* AA = (bf16*)(ws + WS_AA); bf16* GG = (bf16*)(ws + WS_GG); bf16* GK = (bf16*)(ws + WS_GK);
    LAS bf16* TW = (LAS bf16*)lds; LAS bf16* AD = TW + 64 * 72; LAS bf16* SG = AD + 64 * 72;
    LAS float* gkd = (LAS float*)(SG + 64 * 136);
    const int c0 = wave * 64;
    for (int tile = blockIdx.x; tile < M / 64; tile += gridDim.x) {
        const int m0 = tile * 64;
        __syncthreads();
        for (int idx = tid; idx < 64 * 32; idx += NTHR) {
            const int j = (idx & 31) * 8, tok = idx >> 5, m = m0 + tok, t = m & (T - 1);
            const u32x4 cw = *(const u32x4*)(p + (size_t)m * NP + C_WD + j); const u32x4 pw = (t > 0) ? *(const u32x4*)(p + (size_t)(m - 1) * NP + C_WD + j) : (u32x4){0u, 0u, 0u, 0u};
            const f32x4 m0v = *(const f32x4*)(mu + C_WD + j), m1v = *(const f32x4*)(mu + C_WD + j + 4);
            float x[8];
#pragma unroll
            for (int i = 0; i < 4; ++i) { const float c0 = __uint_as_float(cw[i] << 16), c1 = __uint_as_float(cw[i] & 0xffff0000u), q0 = __uint_as_float(pw[i] << 16), q1 = __uint_as_float(pw[i] & 0xffff0000u);
                const float mu0 = i < 2 ? m0v[2 * i] : m1v[2 * i - 4], mu1 = i < 2 ? m0v[2 * i + 1] : m1v[2 * i - 3];
                x[2 * i] = c0 + (q0 - c0) * mu0; x[2 * i + 1] = c1 + (q1 - c1) * mu1; }
            u32x4 o;
            if (j < 64) {
#pragma unroll
                for (int i = 0; i < 4; ++i) o[i] = pk2(1.f - 2.f * __builtin_amdgcn_rcpf(1.f + __expf(2.f * x[2 * i])), 1.f - 2.f * __builtin_amdgcn_rcpf(1.f + __expf(2.f * x[2 * i + 1])));
                *(LAS u32x4*)(TW + tok * 72 + j) = o;
            } else if (j < 128) {
#pragma unroll
                for (int i = 0; i < 4; ++i) o[i] = pk2(x[2 * i], x[2 * i + 1]);
                *(LAS u32x4*)(AD + tok * 72 + j - 64) = o;
            } else {
#pragma unroll
                for (int i = 0; i < 4; ++i) o[i] = pk2(sigmoidf_(x[2 * i]), sigmoidf_(x[2 * i + 1]));
                *(LAS u32x4*)(SG + tok * 136 + j - 128) = o;
            }
        }
        for (int idx = tid; idx < 64 * 16; idx += NTHR) { const int j = idx & 15, tok = idx >> 4; gkd[tok * 16 + j] = bf2f(p[(size_t)(m0 + tok) * NP + C_GKD + j]); }
        __syncthreads();
        f32x4 acc[4][4];
        lora_mm<2, 72>(acc, TW, W2T, c0, fr, fq);
#pragma unroll
        for (int nt = 0; nt < 4; ++nt) { const int c = c0 + nt * 16 + 4 * fq; const f32x4 b = *(const f32x4*)(w0 + c);
#pragma unroll
            for (int mt = 0; mt < 4; ++mt) { float o[4];
#pragma unroll
                for (int i = 0; i < 4; ++i) { const float z = b[i] + acc[mt][nt][i]; o[i] = -0.6065306597126334f * sigmoidf_(z); }
                u32x2 w; w.x = pk2(o[0], o[1]); w.y = pk2(o[2], o[3]); *(u32x2*)(WL + (size_t)(m0 + mt * 16 + fr) * A_W + c) = w; } }
        lora_mm<2, 72>(acc, AD, A2T, c0, fr, fq);
#pragma unroll
        for (int nt = 0; nt < 4; ++nt) { const int c = c0 + nt * 16 + 4 * fq; const f32x4 b = *(const f32x4*)(a0 + c);
#pragma unroll
            for (int mt = 0; mt < 4; ++mt) { float o[4];
#pragma unroll
                for (int i = 0; i < 4; ++i) o[i] = sigmoidf_(b[i] + acc[mt][nt][i]);
                u32x2 w; w.x = pk2(o[0], o[1]); w.y = pk2(o[2], o[3]); *(u32x2*)(AA + (size_t)(m0 + mt * 16 + fr) * A_W + c) = w; } }
        lora_mm<4, 136>(acc, SG, G2T, c0, fr, fq);
#pragma unroll
        for (int nt = 0; nt < 4; ++nt) { const int c = c0 + nt * 16 + 4 * fq;
#pragma unroll
            for (int mt = 0; mt < 4; ++mt) { u32x2 w; w.x = pk2(acc[mt][nt][0], acc[mt][nt][1]); w.y = pk2(acc[mt][nt][2], acc[mt][nt][3]); *(u32x2*)(GG + (size_t)(m0 + mt * 16 + fr) * A_W + c) = w; } }
        { const int cc = tid & 255, th = tid >> 8; float wv[16];
#pragma unroll
          for (int j = 0; j < 16; ++j) wv[j] = gkw2[j * 256 + cc];
          const float bb = gkb[cc];
          for (int i = 0; i < 32; ++i) { const int tok = th * 32 + i; float sacc = bb;
#pragma unroll
              for (int j = 0; j < 16; ++j) sacc += gkd[tok * 16 + j] * wv[j];
              GK[(size_t)(m0 + tok) * 256 + cc] = (bf16)f2bf(-(fmaxf(-sacc, 0.f) + __logf(1.f + __expf(-fabsf(sacc)))) * (1.f / 16.f)); } }
    }
}

constexpr int CH = 32;
__device__ __forceinline__ float red8(float v) { v = DPP_ADD(v, 0xB1); v = DPP_ADD(v, 0x4E); v = DPP_ADD(v, 0x141); return v; }
__device__ __forceinline__ float red4(float v) { v = DPP_ADD(v, 0xB1); v = DPP_ADD(v, 0x4E); return v; }

constexpr int RW_BUF = 6 * CH * 64;
__device__ __forceinline__ void rw_load(const bf16* p, const bf16* AA, const bf16* WL, int b, int t0, int col, int wave,
        unsigned (&rc)[4], unsigned (&kc)[4], unsigned (&vc)[4], unsigned (&rp)[4], unsigned (&kp)[4], unsigned (&vp)[4], unsigned (&a)[4], unsigned (&wl)[4]) {
#pragma unroll
    for (int q = 0; q < 4; ++q) {
        const int t = t0 + wave + 8 * q; const size_t m = (size_t)b * T + t; const bf16* pr = p + m * NP; const bf16* pp = (t > 0) ? pr - NP : pr;
        rc[q] = pr[C_R + col]; kc[q] = pr[C_K + col]; vc[q] = pr[C_V + col]; rp[q] = pp[C_R + col]; kp[q] = pp[C_K + col]; vp[q] = pp[C_V + col];
        a[q] = AA[m * A_W + col]; wl[q] = WL[m * A_W + col];
    }
}
__device__ __forceinline__ void rw_prep(LAS float* B, int t0, int wave, int lane, float mu_r, float mu_k, float mu_v, float kkc, float kac,
        const unsigned (&rc_)[4], const unsigned (&kc_)[4], const unsigned (&vc_)[4], const unsigned (&rp_)[4], const unsigned (&kp_)[4], const unsigned (&vp_)[4], const unsigned (&a_)[4], const unsigned (&wl_)[4]) {
    LAS float* R = B; LAS float* DEC = R + CH * 64; LAS float* KH = DEC + CH * 64; LAS float* KK = KH + CH * 64; LAS float* BB = KK + CH * 64; LAS float* V = BB + CH * 64;
#pragma unroll
    for (int q = 0; q < 4; ++q) {
        const int tt = wave + 8 * q; const float hp = (t0 + tt > 0) ? 1.f : 0.f;
        const float rc = bf2f(rc_[q]), kc = bf2f(kc_[q]), vc = bf2f(vc_[q]), rp = bf2f(rp_[q]) * hp, kp = bf2f(kp_[q]) * hp, vp = bf2f(vp_[q]) * hp;
        const float r = rc + (rp - rc) * mu_r, k = kc + (kp - kc) * mu_k, v = vc + (vp - vc) * mu_v;
        const float a = bf2f(a_[q]), wl = bf2f(wl_[q]);
        const float kr = k * kkc; const float nrm = sqrtf(wave_sum(kr * kr)); const float kk = kr / fmaxf(nrm, 1e-12f);
        const float kh = k * (1.f + (a - 1.f) * kac);
        R[tt * 64 + lane] = r; DEC[tt * 64 + lane] = __expf(wl); KH[tt * 64 + lane] = kh; KK[tt * 64 + lane] = kk; BB[tt * 64 + lane] = kk * a; V[tt * 64 + lane] = v;
    }
}
struct RwOps { f32x4 k0, k1, d0, d1, b0, b1, h0, h1, q0, q1; float v0, v1; };
__device__ __forceinline__ void rw_ops_load(RwOps& o, const LAS float* B, int tt, int s8, int vr0) {
    const LAS float* R = B; const LAS float* DEC = R + CH * 64; const LAS float* KH = DEC + CH * 64; const LAS float* KK = KH + CH * 64; const LAS float* BB = KK + CH * 64; const LAS float* V = BB + CH * 64;
    o.k0 = *(const LAS f32x4*)(KK + tt * 64 + s8); o.k1 = *(const LAS f32x4*)(KK + tt * 64 + s8 + 4);
    o.d0 = *(const LAS f32x4*)(DEC + tt * 64 + s8); o.d1 = *(const LAS f32x4*)(DEC + tt * 64 + s8 + 4);
    o.b0 = *(const LAS f32x4*)(BB + tt * 64 + s8); o.b1 = *(const LAS f32x4*)(BB + tt * 64 + s8 + 4);
    o.h0 = *(const LAS f32x4*)(KH + tt * 64 + s8); o.h1 = *(const LAS f32x4*)(KH + tt * 64 + s8 + 4);
    o.q0 = *(const LAS f32x4*)(R + tt * 64 + s8); o.q1 = *(const LAS f32x4*)(R + tt * 64 + s8 + 4);
    o.v0 = V[tt * 64 + vr0]; o.v1 = V[tt * 64 + vr0 + 1];
}
template <bool IDENT> __device__ __forceinline__ void rw_step(const RwOps& o, f32x2 (&S0)[4], f32x2 (&S1)[4], LAS float* Y, int tt, int r0, int lane) {
    const float vv0 = o.v0, vv1 = o.v1;
    const f32x2 kk[4] = {o.k0.lo, o.k0.hi, o.k1.lo, o.k1.hi}, dd[4] = {o.d0.lo, o.d0.hi, o.d1.lo, o.d1.hi}, bb[4] = {o.b0.lo, o.b0.hi, o.b1.lo, o.b1.hi}, hh[4] = {o.h0.lo, o.h0.hi, o.h1.lo, o.h1.hi}, rr[4] = {o.q0.lo, o.q0.hi, o.q1.lo, o.q1.hi};
    f32x2 a0 = S0[0] * kk[0], a1 = S1[0] * kk[0];
#pragma unroll
    for (int i = 1; i < 4; ++i) { a0 = S0[i] * kk[i] + a0; a1 = S1[i] * kk[i] + a1; }
    const float sa0 = -red8(a0.x + a0.y), sa1 = -red8(a1.x + a1.y);
    f32x2 y0 = (f32x2){0.f, 0.f}, y1 = (f32x2){0.f, 0.f};
#pragma unroll
    for (int i = 0; i < 4; ++i) {
        if (IDENT) { S0[i] = bb[i] * sa0 + S0[i] * dd[i]; S1[i] = bb[i] * sa1 + S1[i] * dd[i]; }
        else { S0[i] = hh[i] * vv0 + (bb[i] * sa0 + S0[i] * dd[i]); S1[i] = hh[i] * vv1 + (bb[i] * sa1 + S1[i] * dd[i]); }
        y0 = S0[i] * rr[i] + y0; y1 = S1[i] * rr[i] + y1;
    }
    const float yy0 = red8(y0.x + y0.y), yy1 = red8(y1.x + y1.y);
    if ((lane & 7) == 0) { Y[tt * 128 + r0] = yy0; Y[tt * 128 + r0 + 1] = yy1; }
}
struct GlOps { f32x4 k0, k1, d0, d1, q0, q1; float v0, v1; };
__device__ __forceinline__ void gl_ops_load(GlOps& o, const LAS float* B, int tt, int s8, int r0) {
    const LAS float* Q = B; const LAS float* K = Q + CH * 64; const LAS float* DEC = K + CH * 64; const LAS float* V = DEC + CH * 64;
    o.k0 = *(const LAS f32x4*)(K + tt * 64 + s8); o.k1 = *(const LAS f32x4*)(K + tt * 64 + s8 + 4);
    o.d0 = *(const LAS f32x4*)(DEC + tt * 64 + s8); o.d1 = *(const LAS f32x4*)(DEC + tt * 64 + s8 + 4);
    o.q0 = *(const LAS f32x4*)(Q + tt * 64 + s8); o.q1 = *(const LAS f32x4*)(Q + tt * 64 + s8 + 4);
    o.v0 = V[tt * 128 + r0]; o.v1 = V[tt * 128 + r0 + 1];
}
__device__ __forceinline__ void gl_step(const GlOps& o, f32x2 (&S0)[4], f32x2 (&S1)[4], f32x2 (&c)[4], LAS float* O, LAS float* YL, int tt, int r0, int s8, int lane, int wave) {
    const f32x2 kk[4] = {o.k0.lo, o.k0.hi, o.k1.lo, o.k1.hi}, dd[4] = {o.d0.lo, o.d0.hi, o.d1.lo, o.d1.hi}, qq[4] = {o.q0.lo, o.q0.hi, o.q1.lo, o.q1.hi};
    f32x2 y0 = (f32x2){0.f, 0.f}, y1 = (f32x2){0.f, 0.f};
#pragma unroll
    for (int i = 0; i < 4; ++i) {
        S0[i] = kk[i] * o.v0 + S0[i] * dd[i]; S1[i] = kk[i] * o.v1 + S1[i] * dd[i];
        y0 = S0[i] * qq[i] + y0; y1 = S1[i] * qq[i] + y1;
    }
    if (wave == 0) {
#pragma unroll
        for (int i = 0; i < 4; ++i) c[i] = c[i] * dd[i];
        if (lane < 8) { const f32x2 e0 = c[0] * qq[0], e1 = c[1] * qq[1], e2 = c[2] * qq[2], e3 = c[3] * qq[3];
            *(LAS f32x4*)(YL + tt * 64 + s8) = (f32x4){e0.x, e0.y, e1.x, e1.y}; *(LAS f32x4*)(YL + tt * 64 + s8 + 4) = (f32x4){e2.x, e2.y, e3.x, e3.y}; }
    }
    const float o0 = red8(y0.x + y0.y), o1 = red8(y1.x + y1.y);
    if ((lane & 7) == 0) { O[tt * 128 + r0] = o0; O[tt * 128 + r0 + 1] = o1; }
}
__device__ __forceinline__ void rwkv_item(const Params& P, LAS unsigned char* lds, int b, int h, int seg) {
    const int tid = threadIdx.x, lane = tid & 63, wave = tid >> 6;
    unsigned char* ws = P.ws;
    const bf16* p = (const bf16*)(ws + WS_P); const bf16* WL = (const bf16*)(ws + WS_WL); const bf16* AA = (const bf16*)(ws + WS_AA);
    bf16* MIX = (bf16*)(ws + WS_MIX); bf16* YI = (bf16*)(ws + WS_YI);
    const float* mu = P.in[4]; const float* k_k = P.in[10]; const float* k_a = P.in[11];
    LAS float* BUF = (LAS float*)lds; LAS float* Y = BUF + 2 * RW_BUF;
    const int col = h * 64 + lane;
    const float mu_r = mu[C_R + col], mu_k = mu[C_K + col], mu_v = mu[C_V + col], kkc = k_k[col], kac = k_a[col];
    const int r0 = wave * 16 + 2 * (lane >> 3), s8 = (lane & 7) * 8; const int ident = r0 >> 6, vr0 = r0 & 63, vr1 = vr0 + 1;
    float* SE = (float*)(ws + WS_SER) + ((((size_t)(b * 8 + h) * NSEG + seg) * 2 + ident) * 4096) + vr0 * 64 + s8;
    f32x2 S0[4], S1[4];
#pragma unroll
    for (int i = 0; i < 4; ++i) { S0[i] = (f32x2){(ident && (s8 + 2 * i == vr0)) ? 1.f : 0.f, (ident && (s8 + 2 * i + 1 == vr0)) ? 1.f : 0.f};
        S1[i] = (f32x2){(ident && (s8 + 2 * i == vr1)) ? 1.f : 0.f, (ident && (s8 + 2 * i + 1 == vr1)) ? 1.f : 0.f}; }
    const float vmask = ident ? 0.f : 1.f;
    const int tbeg = seg * LSEG;
    unsigned rc[4], kc[4], vc[4], rp[4], kp[4], vp[4], a[4], wl[4];
    __syncthreads();
    rw_load(p, AA, WL, b, tbeg, col, wave, rc, kc, vc, rp, kp, vp, a, wl);
    rw_prep(BUF, tbeg, wave, lane, mu_r, mu_k, mu_v, kkc, kac, rc, kc, vc, rp, kp, vp, a, wl);
    __syncthreads();
    for (int ci = 0; ci < LSEG / CH; ++ci) {
        const int t0 = tbeg + ci * CH; LAS float* B = BUF + (ci & 1) * RW_BUF;
        LAS float* R = B; LAS float* DEC = R + CH * 64; LAS float* KH = DEC + CH * 64; LAS float* KK = KH + CH * 64; LAS float* BB = KK + CH * 64; LAS float* V = BB + CH * 64;
        const bool more = (ci + 1 < LSEG / CH);
        if (more) rw_load(p, AA, WL, b, t0 + CH, col, wave, rc, kc, vc, rp, kp, vp, a, wl);
        { RwOps oa, ob; rw_ops_load(oa, B, 0, s8, vr0);
          if (ident) for (int tt = 0; tt < CH; tt += 2) {
              rw_ops_load(ob, B, tt + 1, s8, vr0); rw_step<true>(oa, S0, S1, Y, tt, r0, lane);
              rw_ops_load(oa, B, (tt + 2) & (CH - 1), s8, vr0); rw_step<true>(ob, S0, S1, Y, tt + 1, r0, lane);
          } else for (int tt = 0; tt < CH; tt += 2) {
              rw_ops_load(ob, B, tt + 1, s8, vr0); rw_step<false>(oa, S0, S1, Y, tt, r0, lane);
              rw_ops_load(oa, B, (tt + 2) & (CH - 1), s8, vr0); rw_step<false>(ob, S0, S1, Y, tt + 1, r0, lane);
          } }
        __syncthreads();
        if (more) rw_prep(BUF + ((ci + 1) & 1) * RW_BUF, t0 + CH, wave, lane, mu_r, mu_k, mu_v, kkc, kac, rc, kc, vc, rp, kp, vp, a, wl);
#pragma unroll
        for (int q = 0; q < 4; ++q) {
            const int tt = wave + 8 * q; const size_t m = (size_t)b * T + t0 + tt;
            MIX[m * D + col] = (bf16)f2bf(Y[tt * 128 + lane]); YI[m * 512 + col] = (bf16)f2bf(Y[tt * 128 + 64 + lane]);
        }
        __syncthreads();
    }
    *(f32x4*)(SE) = (f32x4){S0[0].x, S0[0].y, S0[1].x, S0[1].y}; *(f32x4*)(SE + 4) = (f32x4){S0[2].x, S0[2].y, S0[3].x, S0[3].y};
    *(f32x4*)(SE + 64) = (f32x4){S1[0].x, S1[0].y, S1[1].x, S1[1].y}; *(f32x4*)(SE + 68) = (f32x4){S1[2].x, S1[2].y, S1[3].x, S1[3].y};
}

constexpr int GL_BUF = 3 * CH * 64 + CH * 128;
__device__ __forceinline__ void gl_load(const bf16* p, const bf16* GK, int b, int h, int t0, int lane, int wave, unsigned (&x)[4][4][4], unsigned (&gk)[4]) {
    const int cq = h * 64 + lane, ck = 256 + h * 64 + lane, cv0 = 512 + h * 128 + lane, cv1 = cv0 + 64;
#pragma unroll
    for (int q = 0; q < 4; ++q) {
        const int t = t0 + wave + 8 * q; const size_t m = (size_t)b * T + t;
#pragma unroll
        for (int j = 0; j < 4; ++j) { const int back = 3 - j; const bf16* pr = p + (m - (size_t)((t >= back) ? back : 0)) * NP + C_BQ;
            x[q][j][0] = pr[cq]; x[q][j][1] = pr[ck]; x[q][j][2] = pr[cv0]; x[q][j][3] = pr[cv1]; }
        gk[q] = GK[m * 256 + h * 64 + lane];
    }
}
__device__ __forceinline__ void gl_prep(LAS float* B, int t0, int wave, int lane, const float (&wq)[4], const float (&wk)[4], const float (&wv0)[4], const float (&wv1)[4],
        const unsigned (&x)[4][4][4], const unsigned (&gk)[4]) {
    LAS float* Q = B; LAS float* K = Q + CH * 64; LAS float* DEC = K + CH * 64; LAS float* V = DEC + CH * 64;
#pragma unroll
    for (int q = 0; q < 4; ++q) {
        const int tt = wave + 8 * q, t = t0 + tt; float aq = 0.f, ak = 0.f, av0 = 0.f, av1 = 0.f;
#pragma unroll
        for (int j = 0; j < 4; ++j) { const float ok = (t >= 3 - j) ? 1.f : 0.f;
            aq += wq[j] * ok * bf2f(x[q][j][0]); ak += wk[j] * ok * bf2f(x[q][j][1]); av0 += wv0[j] * ok * bf2f(x[q][j][2]); av1 += wv1[j] * ok * bf2f(x[q][j][3]); }
        Q[tt * 64 + lane] = siluf_(aq) * 0.125f; K[tt * 64 + lane] = siluf_(ak); V[tt * 128 + lane] = siluf_(av0); V[tt * 128 + 64 + lane] = siluf_(av1);
        DEC[tt * 64 + lane] = __expf(bf2f(gk[q]));
    }
}
__device__ __forceinline__ void gla_item(const Params& P, LAS unsigned char* lds, int b, int h, int seg) {
    const int tid = threadIdx.x, lane = tid & 63, wave = tid >> 6;
    unsigned char* ws = P.ws;
    const bf16* p = (const bf16*)(ws + WS_P); const bf16* GK = (const bf16*)(ws + WS_GK);
    bf16* MIX = (bf16*)(ws + WS_MIX); bf16* YIG = (bf16*)(ws + WS_YIG);
    float* SE = (float*)(ws + WS_SEG) + ((size_t)(b * 4 + h) * NSEG + seg) * 8192; float* CE = (float*)(ws + WS_CEND) + ((size_t)(b * 4 + h) * NSEG + seg) * 64;
    const float* conv = P.in[15];
    LAS float* BUF = (LAS float*)lds; LAS float* O = BUF + 2 * GL_BUF; LAS float* YL = O + CH * 128;
    const int cq = h * 64 + lane, ck = 256 + h * 64 + lane, cv0 = 512 + h * 128 + lane, cv1 = cv0 + 64;
    float wq[4], wk[4], wv0[4], wv1[4];
#pragma unroll
    for (int j = 0; j < 4; ++j) { wq[j] = conv[j * 1024 + cq]; wk[j] = conv[j * 1024 + ck]; wv0[j] = conv[j * 1024 + cv0]; wv1[j] = conv[j * 1024 + cv1]; }
    const int r0 = wave * 16 + 2 * (lane >> 3), s8 = (lane & 7) * 8;
    f32x2 S0[4], S1[4], c[4];
#pragma unroll
    for (int i = 0; i < 4; ++i) { S0[i] = (f32x2){0.f, 0.f}; S1[i] = (f32x2){0.f, 0.f}; c[i] = (f32x2){1.f, 1.f}; }
    const int tbeg = seg * LSEG;
    unsigned x[4][4][4], gk[4];
    __syncthreads();
    gl_load(p, GK, b, h, tbeg, lane, wave, x, gk);
    gl_prep(BUF, tbeg, wave, lane, wq, wk, wv0, wv1, x, gk);
    __syncthreads();
    for (int ci = 0; ci < LSEG / CH; ++ci) {
        const int t0 = tbeg + ci * CH; LAS float* B = BUF + (ci & 1) * GL_BUF;
        LAS float* Q = B; LAS float* K = Q + CH * 64; LAS float* DEC = K + CH * 64; LAS float* V = DEC + CH * 64;
        const bool more = (ci + 1 < LSEG / CH);
        if (more) gl_load(p, GK, b, h, t0 + CH, lane, wave, x, gk);
        { GlOps oa, ob; gl_ops_load(oa, B, 0, s8, r0);
          for (int tt = 0; tt < CH; tt += 2) {
              gl_ops_load(ob, B, tt + 1, s8, r0); gl_step(oa, S0, S1, c, O, YL, tt, r0, s8, lane, wave);
              gl_ops_load(oa, B, (tt + 2) & (CH - 1), s8, r0); gl_step(ob, S0, S1, c, O, YL, tt + 1, r0, s8, lane, wave);
          } }
        __syncthreads();
        if (more) gl_prep(BUF + ((ci + 1) & 1) * GL_BUF, t0 + CH, wave, lane, wq, wk, wv0, wv1, x, gk);
#pragma unroll
        for (int q = 0; q < 4; ++q) {
            const int tt = wave + 8 * q; const size_t m = (size_t)b * T + t0 + tt;
            MIX[m * D + 512 + h * 128 + lane] = (bf16)f2bf(O[tt * 128 + lane]); MIX[m * D + 512 + h * 128 + 64 + lane] = (bf16)f2bf(O[tt * 128 + 64 + lane]);
            YIG[m * 256 + h * 64 + lane] = (bf16)f2bf(YL[tt * 64 + lane]);
        }
        __syncthreads();
    }
    *(f32x4*)(SE + r0 * 64 + s8) = (f32x4){S0[0].x, S0[0].y, S0[1].x, S0[1].y}; *(f32x4*)(SE + r0 * 64 + s8 + 4) = (f32x4){S0[2].x, S0[2].y, S0[3].x, S0[3].y};
    *(f32x4*)(SE + (r0 + 1) * 64 + s8) = (f32x4){S1[0].x, S1[0].y, S1[1].x, S1[1].y}; *(f32x4*)(SE + (r0 + 1) * 64 + s8 + 4) = (f32x4){S1[2].x, S1[2].y, S1[3].x, S1[3].y};
    if (wave == 0 && lane < 8) { *(f32x4*)(CE + s8) = (f32x4){c[0].x, c[0].y, c[1].x, c[1].y}; *(f32x4*)(CE + s8 + 4) = (f32x4){c[2].x, c[2].y, c[3].x, c[3].y}; }
}
__device__ __forceinline__ void phase_scan(const Params& P, LAS unsigned char* lds) {
    for (int it = blockIdx.x; it < 512 + 256; it += gridDim.x) {
        if (it < 512) { const int bh = it >> 4; rwkv_item(P, lds, bh >> 3, bh & 7, it & 15); }
        else { const int g = it - 512, bh = g >> 4; gla_item(P, lds, bh >> 2, bh & 3, g & 15); }
        __syncthreads();
    }
}
__device__ __forceinline__ void phase_fixup(const Params& P, LAS unsigned char* lds) {
    const int tid = threadIdx.x;
    for (int it = blockIdx.x; it < 48; it += gridDim.x) {
        if (it < 32) {
            float* SE = (float*)(P.ws + WS_SER) + (size_t)it * NSEG * 2 * 4096;
            LAS float* Sc = (LAS float*)lds; LAS float* Ph = Sc + 64 * 65;
            const int v = tid >> 3, kq = (tid & 7) * 8;
            __syncthreads();
            for (int i = tid; i < 64 * 65; i += NTHR) Sc[i] = 0.f;
            f32x4 pf0 = *(const f32x4*)(SE + 4096 + 4 * tid), pf1 = *(const f32x4*)(SE + 4096 + 4 * (tid + NTHR));
            f32x4 a0 = *(const f32x4*)(SE + v * 64 + kq), a1 = *(const f32x4*)(SE + v * 64 + kq + 4);
            for (int seg = 0; seg < NSEG - 1; ++seg) {
                float* s0 = SE + (size_t)(seg * 2 + 0) * 4096;
                __syncthreads();
                *(LAS f32x4*)(Ph + 4 * tid) = pf0; *(LAS f32x4*)(Ph + 4 * (tid + NTHR)) = pf1;
                f32x4 c0 = a0, c1 = a1;
                if (seg + 1 < NSEG - 1) { const float* nx = SE + (size_t)((seg + 1) * 2) * 4096; pf0 = *(const f32x4*)(nx + 4096 + 4 * tid); pf1 = *(const f32x4*)(nx + 4096 + 4 * (tid + NTHR)); a0 = *(const f32x4*)(nx + v * 64 + kq); a1 = *(const f32x4*)(nx + v * 64 + kq + 4); }
                __syncthreads();
                for (int j = 0; j < 64; ++j) { const float sv = Sc[v * 65 + j]; c0 += *(const LAS f32x4*)(Ph + j * 64 + kq) * sv; c1 += *(const LAS f32x4*)(Ph + j * 64 + kq + 4) * sv; }
                __syncthreads();
#pragma unroll
                for (int i = 0; i < 4; ++i) { Sc[v * 65 + kq + i] = c0[i]; Sc[v * 65 + kq + 4 + i] = c1[i]; }
                *(f32x4*)(s0 + v * 64 + kq) = c0; *(f32x4*)(s0 + v * 64 + kq + 4) = c1;
            }
        } else {
            const int bh = it - 32; float* SE = (float*)(P.ws + WS_SEG) + (size_t)bh * NSEG * 8192; const float* CE = (const float*)(P.ws + WS_CEND) + (size_t)bh * NSEG * 64;
            const int v = tid >> 2, d0 = (tid & 3) * 16; f32x4 sc[4];
#pragma unroll
            for (int q = 0; q < 4; ++q) sc[q] = (f32x4){0.f, 0.f, 0.f, 0.f};
            for (int seg = 0; seg < NSEG - 1; ++seg) {
#pragma unroll
                for (int q = 0; q < 4; ++q) { float* sp = SE + (size_t)seg * 8192 + v * 64 + d0 + 4 * q; sc[q] = sc[q] * *(const f32x4*)(CE + seg * 64 + d0 + 4 * q) + *(const f32x4*)sp; *(f32x4*)sp = sc[q]; }
            }
        }
    }
}
__device__ __forceinline__ float row_sum16(float v) { v = DPP_ADD(v, 0xB1); v = DPP_ADD(v, 0x4E); v = DPP_ADD(v, 0x141); v = DPP_ADD(v, 0x140); return v; }
__device__ __forceinline__ bf16x8_t pack_bf16x8(const f32x4 a, const f32x4 b) {
    u32x4 w; w.x = pk2(a[0], a[1]); w.y = pk2(a[2], a[3]); w.z = pk2(b[0], b[1]); w.w = pk2(b[2], b[3]); return __builtin_bit_cast(bf16x8_t, w);
}
__device__ __forceinline__ void unpack4(const u32x2 w, float (&o)[4]) { o[0] = __uint_as_float(w.x << 16); o[1] = __uint_as_float(w.x & 0xffff0000u); o[2] = __uint_as_float(w.y << 16); o[3] = __uint_as_float(w.y & 0xffff0000u); }
__device__ __forceinline__ void phase_correct(const Params& P, LAS unsigned char* lds) {
    const int tid = threadIdx.x, lane = tid & 63, wave = __builtin_amdgcn_readfirstlane(tid >> 6), fr = lane & 15, fq = lane >> 4;
    unsigned char* ws = P.ws;
    const bf16* p = (const bf16*)(ws + WS_P); const bf16* AA = (const bf16*)(ws + WS_AA); const bf16* GG = (const bf16*)(ws + WS_GG);
    bf16* MIX = (bf16*)(ws + WS_MIX); const bf16* YI = (const bf16*)(ws + WS_YI); const bf16* YIG = (const bf16*)(ws + WS_YIG);
    const float* mu = P.in[4]; const float* k_a = P.in[11]; const float* r_k = P.in[12]; const float* gn_g = P.in[13]; const float* gn_b = P.in[14]; const float* norm_g = P.in[18];
    LAS bf16* SB = (LAS bf16*)lds;
    for (int it = blockIdx.x; it < 512; it += gridDim.x) {
        {
            const int seg = it & 15, bh = it >> 4, b = bh >> 3, h = bh & 7;
            const int cb = h * 64 + 4 * fr;
            __syncthreads();
            if (seg > 0) { const float* ss = (const float*)(ws + WS_SER) + (((size_t)bh * NSEG + (seg - 1)) * 2) * 4096;
                for (int i = tid; i < 1024; i += NTHR) { const f32x4 x = *(const f32x4*)(ss + 4 * i); const int v = i >> 4, j = (4 * i) & 63; u32x2 w; w.x = pk2(x[0], x[1]); w.y = pk2(x[2], x[3]);
                    *(LAS u32x2*)(SB + ((v & 3) * 16 + (v >> 2)) * 72 + j) = w; } }
            __syncthreads();
            const f32x4 mur = *(const f32x4*)(mu + C_R + cb), muk = *(const f32x4*)(mu + C_K + cb), muv = *(const f32x4*)(mu + C_V + cb), kac = *(const f32x4*)(k_a + cb), rkc = *(const f32x4*)(r_k + cb), gng = *(const f32x4*)(gn_g + cb), gnb = *(const f32x4*)(gn_b + cb);
            for (int mt = 0; mt < 4; ++mt) {
                const int tb = seg * LSEG + wave * 64 + mt * 16;
                f32x4 acc[4];
#pragma unroll
                for (int vt = 0; vt < 4; ++vt) acc[vt] = (f32x4){0.f, 0.f, 0.f, 0.f};
                if (seg > 0) {
#pragma unroll
                    for (int sx = 0; sx < 2; ++sx) { const bf16x8_t af = *(const bf16x8_t*)(YI + ((size_t)b * T + tb + fr) * 512 + h * 64 + 32 * sx + 8 * fq);
#pragma unroll
                        for (int vt = 0; vt < 4; ++vt) acc[vt] = __builtin_amdgcn_mfma_f32_16x16x32_bf16(af, *(const LAS bf16x8_t*)(SB + (vt * 16 + fr) * 72 + 32 * sx + 8 * fq), acc[vt], 0, 0, 0); }
                }
                u32x2 W[2][9];
#define CORR_LOAD(buf, rg) do { const int t_ = tb + 4 * fq + (rg); const size_t m_ = (size_t)b * T + t_; const bf16* pr_ = p + m_ * NP + cb; const bf16* pp_ = (t_ > 0) ? pr_ - NP : pr_; \
                    W[buf][0] = *(const u32x2*)(MIX + m_ * D + cb); W[buf][1] = *(const u32x2*)(pr_ + C_R); W[buf][2] = *(const u32x2*)(pr_ + C_K); W[buf][3] = *(const u32x2*)(pr_ + C_V); \
                    W[buf][4] = *(const u32x2*)(pp_ + C_R); W[buf][5] = *(const u32x2*)(pp_ + C_K); W[buf][6] = *(const u32x2*)(pp_ + C_V); W[buf][7] = *(const u32x2*)(AA + m_ * A_W + cb); W[buf][8] = *(const u32x2*)(GG + m_ * A_W + cb); } while (0)
                CORR_LOAD(0, 0);
#pragma unroll
                for (int rg = 0; rg < 4; ++rg) { const int t = tb + 4 * fq + rg; const size_t m = (size_t)b * T + t; const float hp = (t > 0) ? 1.f : 0.f;
                    if (rg < 3) CORR_LOAD((rg + 1) & 1, rg + 1);
                    __builtin_amdgcn_sched_barrier(0);
                    float y[4], rc[4], kc[4], vc[4], rp_[4], kp[4], vp[4], a[4], g[4];
                    unpack4(W[rg & 1][0], y); unpack4(W[rg & 1][1], rc); unpack4(W[rg & 1][2], kc); unpack4(W[rg & 1][3], vc); unpack4(W[rg & 1][4], rp_); unpack4(W[rg & 1][5], kp); unpack4(W[rg & 1][6], vp); unpack4(W[rg & 1][7], a); unpack4(W[rg & 1][8], g);
                    float v[4], sy = 0.f, sb = 0.f;
#pragma unroll
                    for (int i = 0; i < 4; ++i) { y[i] += acc[i][rg];
                        const float r = rc[i] + (rp_[i] * hp - rc[i]) * mur[i], k = kc[i] + (kp[i] * hp - kc[i]) * muk[i]; v[i] = vc[i] + (vp[i] * hp - vc[i]) * muv[i];
                        const float kh = k * (1.f + (a[i] - 1.f) * kac[i]); sb += r * kh * rkc[i]; sy += y[i]; }
                    const float bon = row_sum16(sb), mean = row_sum16(sy) * (1.f / 64.f); float sq = 0.f;
#pragma unroll
                    for (int i = 0; i < 4; ++i) { y[i] -= mean; sq += y[i] * y[i]; }
                    const float rstd = 1.f / sqrtf(row_sum16(sq) * (1.f / 64.f) + GN_EPS); float o[4];
#pragma unroll
                    for (int i = 0; i < 4; ++i) o[i] = (y[i] * rstd * gng[i] + gnb[i] + bon * v[i]) * g[i];
                    u32x2 w; w.x = pk2(o[0], o[1]); w.y = pk2(o[2], o[3]); *(u32x2*)(MIX + m * D + cb) = w;
                    __builtin_amdgcn_sched_barrier(0); }
#undef CORR_LOAD
            }
        }
    }
    for (int g_ = blockIdx.x; g_ < 256; g_ += gridDim.x) {
        {
            const int seg = g_ & 15, bh = g_ >> 4, b = bh >> 2, h = bh & 3;
            const int cb = h * 128 + 8 * fr;
            __syncthreads();
            if (seg > 0) { const float* ss = (const float*)(ws + WS_SEG) + ((size_t)bh * NSEG + (seg - 1)) * 8192;
                for (int i = tid; i < 2048; i += NTHR) { const f32x4 x = *(const f32x4*)(ss + 4 * i); const int v = i >> 4, j = (4 * i) & 63; u32x2 w; w.x = pk2(x[0], x[1]); w.y = pk2(x[2], x[3]);
                    *(LAS u32x2*)(SB + ((v & 7) * 16 + (v >> 3)) * 72 + j) = w; } }
            __syncthreads();
            const f32x4 ng0 = *(const f32x4*)(norm_g + 8 * fr), ng1 = *(const f32x4*)(norm_g + 8 * fr + 4);
            for (int mt = 0; mt < 4; ++mt) {
                const int tb = seg * LSEG + wave * 64 + mt * 16;
                f32x4 acc[8];
#pragma unroll
                for (int vt = 0; vt < 8; ++vt) acc[vt] = (f32x4){0.f, 0.f, 0.f, 0.f};
                if (seg > 0) {
#pragma unroll
                    for (int sx = 0; sx < 2; ++sx) { const bf16x8_t af = *(const bf16x8_t*)(YIG + ((size_t)b * T + tb + fr) * 256 + h * 64 + 32 * sx + 8 * fq);
#pragma unroll
                        for (int vt = 0; vt < 8; ++vt) acc[vt] = __builtin_amdgcn_mfma_f32_16x16x32_bf16(af, *(const LAS bf16x8_t*)(SB + (vt * 16 + fr) * 72 + 32 * sx + 8 * fq), acc[vt], 0, 0, 0); }
                }
                u32x4 WG[2][2];
#define CORG_LOAD(buf, rg) do { const size_t m_ = (size_t)b * T + tb + 4 * fq + (rg); WG[buf][0] = *(const u32x4*)(MIX + m_ * D + 512 + cb); WG[buf][1] = *(const u32x4*)(p + m_ * NP + C_BG + cb); } while (0)
                CORG_LOAD(0, 0);
#pragma unroll
                for (int rg = 0; rg < 4; ++rg) { const size_t m = (size_t)b * T + tb + 4 * fq + rg;
                    if (rg < 3) CORG_LOAD((rg + 1) & 1, rg + 1);
                    __builtin_amdgcn_sched_barrier(0);
                    float o[8], g[8]; float sq = 0.f;
#pragma unroll
                    for (int i = 0; i < 4; ++i) { const unsigned a_ = WG[rg & 1][0][i], b_ = WG[rg & 1][1][i]; o[2 * i] = __uint_as_float(a_ << 16); o[2 * i + 1] = __uint_as_float(a_ & 0xffff0000u); g[2 * i] = __uint_as_float(b_ << 16); g[2 * i + 1] = __uint_as_float(b_ & 0xffff0000u); }
#pragma unroll
                    for (int i = 0; i < 8; ++i) { o[i] += acc[i][rg]; sq += o[i] * o[i]; }
                    const float rs = 1.f / sqrtf(row_sum16(sq) * (1.f / 128.f) + RMS_EPS);
                    float f[8];
#pragma unroll
                    for (int i = 0; i < 8; ++i) f[i] = o[i] * rs * (i < 4 ? ng0[i & 3] : ng1[i & 3]) * siluf_(g[i]);
                    u32x4 w; w.x = pk2(f[0], f[1]); w.y = pk2(f[2], f[3]); w.z = pk2(f[4], f[5]); w.w = pk2(f[6], f[7]); *(u32x4*)(MIX + m * D + 512 + cb) = w;
                    __builtin_amdgcn_sched_barrier(0); }
#undef CORG_LOAD
            }
        }
    }
}

__device__ __forceinline__ void phase_ln1(const Params& P) {
    const int lane = threadIdx.x & 63, wave = threadIdx.x >> 6; const int gw = blockIdx.x * NWAVES + wave, ngw = gridDim.x * NWAVES;
    for (int m = gw; m < M; m += ngw) ln_rowb_bf16((const bf16*)(P.ws + WS_Z) + (size_t)m * D, P.in[20], P.in[21], (bf16*)(P.ws + WS_H1) + (size_t)m * D, lane);
#pragma unroll
    for (int tb = 0; tb < 2; ++tb) {
        const float* src = P.in[24 + tb]; unsigned char* dst = P.ws + (tb ? WS_VT : WS_UT); float* sc = (float*)(P.ws + (tb ? WS_SV : WS_SU));
        for (int e = gw; e < 16384; e += ngw) {
            const f32x4* sp = (const f32x4*)(src + (size_t)e * D) + 4 * lane; f32x4 a[4]; float mx = 0.f;
#pragma unroll
            for (int j = 0; j < 4; ++j) { a[j] = sp[j]; mx = fmaxf(fmaxf(mx, fmaxf(fabsf(a[j][0]), fabsf(a[j][1]))), fmaxf(fabsf(a[j][2]), fabsf(a[j][3]))); }
            mx = wave_max_u(mx); const float inv = mx > 0.f ? 31.f / mx : 0.f;
            unsigned q[16];
#pragma unroll
            for (int i = 0; i < 16; ++i) q[i] = (unsigned)(__float2int_rn(a[i >> 2][i & 3] * inv) + 32);
            unsigned p0 = 0u, p1 = 0u, p2 = 0u;
#pragma unroll
            for (int b = 0; b < 4; ++b) {
                p0 |= ((q[b] & 15u) | ((q[4 + b] & 15u) << 4)) << (8 * b);
                p1 |= ((q[8 + b] & 15u) | ((q[12 + b] & 15u) << 4)) << (8 * b);
                p2 |= ((q[b] >> 4) | ((q[4 + b] >> 4) << 2) | ((q[8 + b] >> 4) << 4) | ((q[12 + b] >> 4) << 6)) << (8 * b);
            }
            unsigned* o = (unsigned*)(dst + (size_t)e * ROWB) + 3 * lane; o[0] = p0; o[1] = p1; o[2] = p2;
            if (lane == 0) sc[e] = mx * (1.f / 31.f);
        }
    }
}

#define TK_INS(L, x) do { _Pragma("unroll") for (int _j = 0; _j < 16; ++_j) { const unsigned _h = max(L[_j], x); x = min(L[_j], x); L[_j] = _h; } } while (0)
__device__ __forceinline__ void topk128(const u32x4* r, unsigned (&L)[16]) {
#pragma unroll
    for (int j = 0; j < 16; ++j) L[j] = 0u;
    u32x4 cur = r[0];
    for (int c = 0; c < 16; ++c) {
        const u32x4 nxt = r[(c + 1) & 15];
        const unsigned kb = 0xFFFFu - 8u * (unsigned)c;
#pragma unroll
        for (int d = 0; d < 4; ++d) {
            unsigned w = cur[d]; const unsigned msk = ((w >> 15) & 0x00010001u) * 0xFFFFu; w ^= (msk | 0x80008000u);
            unsigned x0 = (w << 16) | (kb - 2u * d), x1 = (w & 0xFFFF0000u) | (kb - 2u * d - 1u);
            TK_INS(L, x0); TK_INS(L, x1);
        }
        cur = nxt;
    }
}
__device__ __forceinline__ void phase_topk(const Params& P) {
    const int gl = blockIdx.x * NTHR + threadIdx.x, nl = gridDim.x * NTHR;
    const bf16* Sc = (const bf16*)(P.ws + WS_S); int* IDS = (int*)(P.ws + WS_IDS); float* GATES = (float*)(P.ws + WS_GATES);
    for (int item = gl; item < M * 8; item += nl) {
        const u32x4* row = (const u32x4*)(Sc + (size_t)item * 256);
        unsigned L0[16], L1[16];
        topk128(row, L0); topk128(row + 16, L1);
        float f0[16], f1[16]; unsigned p0[16], p1[16];
#pragma unroll
        for (int i = 0; i < 16; ++i) {
            f0[i] = __uint_as_float((L0[i] & 0x80000000u) ? (L0[i] & 0x7FFF0000u) : (~L0[i] & 0xFFFF0000u)); p0[i] = (~L0[i] & 0x7Fu) << 7;
            f1[i] = __uint_as_float((L1[i] & 0x80000000u) ? (L1[i] & 0x7FFF0000u) : (~L1[i] & 0xFFFF0000u)); p1[i] = (~L1[i] & 0x7Fu);
        }
        unsigned C[16];
#pragma unroll
        for (int j = 0; j < 16; ++j) C[j] = 0u;
#pragma unroll
        for (int i = 0; i < 16; ++i)
#pragma unroll
            for (int j = 0; j < 16; ++j)
                if ((i + 1) * (j + 1) <= 16) {
                    const unsigned b = __float_as_uint(f0[i] + f1[j]); const unsigned mono = b ^ ((unsigned)((int)b >> 31) | 0x80000000u);
                    unsigned key = (mono & 0xFFFFC000u) | p0[i] | p1[j];
                    TK_INS(C, key);
                }
        float cv[16];
#pragma unroll
        for (int r = 0; r < 16; ++r) cv[r] = __uint_as_float((C[r] & 0x80000000u) ? (C[r] & 0x7FFFC000u) : (~C[r] & 0xFFFFC000u));
        const float cmax = cv[0]; float den = 0.f;
#pragma unroll
        for (int r = 0; r < 16; ++r) { cv[r] = __expf(cv[r] - cmax); den += cv[r]; }
        const float inv = 1.f / den;
        u32x4* ido = (u32x4*)(IDS + (size_t)item * 16); f32x4* go = (f32x4*)(GATES + (size_t)item * 16);
#pragma unroll
        for (int q = 0; q < 4; ++q) { u32x4 o; o.x = C[4 * q] & 0x3FFFu; o.y = C[4 * q + 1] & 0x3FFFu; o.z = C[4 * q + 2] & 0x3FFFu; o.w = C[4 * q + 3] & 0x3FFFu; ido[q] = o;
            f32x4 g; g[0] = cv[4 * q] * inv; g[1] = cv[4 * q + 1] * inv; g[2] = cv[4 * q + 2] * inv; g[3] = cv[4 * q + 3] * inv; go[q] = g; }
    }
}

typedef __bf16 bf16x2_t __attribute__((ext_vector_type(2)));
__device__ __forceinline__ float dot2bf(unsigned a, unsigned b, float c) { return __builtin_amdgcn_fdot2_f32_bf16(__builtin_bit_cast(bf16x2_t, a), __builtin_bit_cast(bf16x2_t, b), c, false); }
typedef unsigned u32x3 __attribute__((ext_vector_type(3)));
__device__ __forceinline__ void peer_load8(u32x3 (&buf)[8], const unsigned char* TAB, int idreg, int g, int lane) {
#pragma unroll
    for (int q = 0; q < 8; ++q) { const int id = __builtin_amdgcn_readlane(idreg, 8 * g + q); const unsigned* rp = (const unsigned*)(TAB + (size_t)id * ROWB) + 3 * lane; u32x3 w; w.x = rp[0]; w.y = rp[1]; w.z = rp[2]; buf[q] = w; }
}
__device__ __forceinline__ void peer_dots8(const u32x3 (&buf)[8], const u32x4& hq, int g, float& d, int lane) {
#pragma unroll
    for (int q = 0; q < 8; ++q) { const unsigned p0 = buf[q].x, p1 = buf[q].y, p2 = buf[q].z; int s = 0, t = 0;
        s = __builtin_amdgcn_sdot4((int)(p0 & 0x0F0F0F0Fu), (int)hq[0], s, false); s = __builtin_amdgcn_sdot4((int)((p0 >> 4) & 0x0F0F0F0Fu), (int)hq[1], s, false);
        s = __builtin_amdgcn_sdot4((int)(p1 & 0x0F0F0F0Fu), (int)hq[2], s, false); s = __builtin_amdgcn_sdot4((int)((p1 >> 4) & 0x0F0F0F0Fu), (int)hq[3], s, false);
#pragma unroll
        for (int f = 0; f < 4; ++f) t = __builtin_amdgcn_sdot4((int)((p2 >> (2 * f)) & 0x03030303u), (int)hq[f], t, false);
        const int tot = wave_sum_i(s + 16 * t);
        d = (lane == 8 * g + q) ? (float)tot : d; }
}
__device__ __forceinline__ void peer_axpy8(const u32x3 (&buf)[8], float areg, int g, float (&acc)[16]) {
#pragma unroll
    for (int q = 0; q < 8; ++q) { const float a = rlf(areg, 8 * g + q); const unsigned p0 = buf[q].x, p1 = buf[q].y, p2 = buf[q].z;
        const unsigned v0 = (p0 & 0x0F0F0F0Fu) | ((p2 & 0x03030303u) << 4), v1 = ((p0 >> 4) & 0x0F0F0F0Fu) | (((p2 >> 2) & 0x03030303u) << 4);
        const unsigned v2 = (p1 & 0x0F0F0F0Fu) | (((p2 >> 4) & 0x03030303u) << 4), v3 = ((p1 >> 4) & 0x0F0F0F0Fu) | (((p2 >> 6) & 0x03030303u) << 4);
        const unsigned vv[4] = {v0, v1, v2, v3};
#pragma unroll
        for (int i = 0; i < 4; ++i) { const unsigned w = vv[i];
            acc[4 * i] += a * (float)(w & 0xffu); acc[4 * i + 1] += a * (float)((w >> 8) & 0xffu); acc[4 * i + 2] += a * (float)((w >> 16) & 0xffu); acc[4 * i + 3] += a * (float)(w >> 24); } }
}
__device__ __forceinline__ void phase_peer(const Params& P) {
    const int lane = threadIdx.x & 63, wave = threadIdx.x >> 6; const int gw = blockIdx.x * NWAVES + wave, ngw = gridDim.x * NWAVES;
    const bf16* H1 = (const bf16*)(P.ws + WS_H1); const int* IDS = (const int*)(P.ws + WS_IDS); const float* GATES = (const float*)(P.ws + WS_GATES);
    const unsigned char* UT = P.ws + WS_UT; const unsigned char* VT = P.ws + WS_VT; const float* SU = (const float*)(P.ws + WS_SU); const float* SV = (const float*)(P.ws + WS_SV);
    const float* g2 = P.in[26]; const float* b2 = P.in[27];
    for (int m = gw; m < M; m += ngw) {
        const u32x4* hp = (const u32x4*)(H1 + (size_t)m * D) + 2 * lane; const u32x4 hA = hp[0], hB = hp[1];
        float hv[16]; float hmx = 0.f;
#pragma unroll
        for (int i = 0; i < 4; ++i) { hv[2 * i] = __uint_as_float(hA[i] << 16); hv[2 * i + 1] = __uint_as_float(hA[i] & 0xffff0000u); hv[8 + 2 * i] = __uint_as_float(hB[i] << 16); hv[8 + 2 * i + 1] = __uint_as_float(hB[i] & 0xffff0000u); }
#pragma unroll
        for (int i = 0; i < 16; ++i) hmx = fmaxf(hmx, fabsf(hv[i]));
        hmx = wave_max_u(hmx); const float hinv = hmx > 0.f ? 127.f / hmx : 0.f, hsc = hmx * (1.f / 127.f);
        u32x4 hq;
#pragma unroll
        for (int i = 0; i < 4; ++i) hq[i] = pack_i8(hv[4 * i], hv[4 * i + 1], hv[4 * i + 2], hv[4 * i + 3], hinv, 0);
        int hs = 0;
#pragma unroll
        for (int i = 0; i < 4; ++i) hs = __builtin_amdgcn_sdot4((int)hq[i], 0x01010101, hs, false);
        const float hoff = 32.f * (float)wave_sum_i(hs);
        const int id_lo = IDS[(size_t)m * 128 + lane], id_hi = IDS[(size_t)m * 128 + 64 + lane];
        const float gt_lo = GATES[(size_t)m * 128 + lane], gt_hi = GATES[(size_t)m * 128 + 64 + lane];
        const float su_lo = SU[id_lo], su_hi = SU[id_hi], sv_lo = SV[id_lo], sv_hi = SV[id_hi];
        float d_lo = 0.f, d_hi = 0.f;
        u32x3 A0[8], A1[8];
        peer_load8(A0, UT, id_lo, 0, lane);
        for (int g = 0; g < 8; g += 2) {
            peer_load8(A1, UT, id_lo, g + 1, lane); peer_dots8(A0, hq, g, d_lo, lane);
            if (g + 2 < 8) peer_load8(A0, UT, id_lo, g + 2, lane); else peer_load8(A0, UT, id_hi, 0, lane);
            peer_dots8(A1, hq, g + 1, d_lo, lane);
        }
        for (int g = 0; g < 8; g += 2) {
            peer_load8(A1, UT, id_hi, g + 1, lane); peer_dots8(A0, hq, g, d_hi, lane);
            if (g + 2 < 8) peer_load8(A0, UT, id_hi, g + 2, lane); else peer_load8(A0, VT, id_lo, 0, lane);
            peer_dots8(A1, hq, g + 1, d_hi, lane);
        }
        const float x_lo = (d_lo - hoff) * su_lo * hsc, x_hi = (d_hi - hoff) * su_hi * hsc;
        const float a_lo = 0.5f * x_lo * (1.f + erff(x_lo * 0.70710678118f)) * gt_lo * sv_lo, a_hi = 0.5f * x_hi * (1.f + erff(x_hi * 0.70710678118f)) * gt_hi * sv_hi;
        const float c0 = 32.f * wave_sum(a_lo + a_hi);
        float acc[16];
#pragma unroll
        for (int i = 0; i < 16; ++i) acc[i] = 0.f;
        for (int g = 0; g < 8; g += 2) {
            peer_load8(A1, VT, id_lo, g + 1, lane); peer_axpy8(A0, a_lo, g, acc);
            if (g + 2 < 8) peer_load8(A0, VT, id_lo, g + 2, lane); else peer_load8(A0, VT, id_hi, 0, lane);
            peer_axpy8(A1, a_lo, g + 1, acc);
        }
        for (int g = 0; g < 8; g += 2) {
            peer_load8(A1, VT, id_hi, g + 1, lane); peer_axpy8(A0, a_hi, g, acc);
            if (g + 2 < 8) peer_load8(A0, VT, id_hi, g + 2, lane);
            peer_axpy8(A1, a_hi, g + 1, acc);
        }
        float s = 0.f;
#pragma unroll
        for (int i = 0; i < 16; ++i) { acc[i] = ALPHA * hv[i] + (acc[i] - c0); s += acc[i]; }
        const float mean = wave_sum(s) * (1.f / D); float s2 = 0.f;
#pragma unroll
        for (int i = 0; i < 16; ++i) { acc[i] -= mean; s2 += acc[i] * acc[i]; }
        const float rstd = 1.f / sqrtf(wave_sum(s2) * (1.f / D) + LN_EPS);
#pragma unroll
        for (int c4 = 0; c4 < 4; ++c4) { const int e0 = 16 * lane + 4 * c4; const f32x4 gg = *(const f32x4*)(g2 + e0), bb = *(const f32x4*)(b2 + e0); f32x4 o;
#pragma unroll
            for (int j = 0; j < 4; ++j) o[j] = acc[c4 * 4 + j] * rstd * gg[j] + bb[j];
            *(f32x4*)(P.out + (size_t)m * D + e0) = o; }
    }
}

#define XB_TMO      128
#define XB_XCNT(j)  (256  + 64 * (j))
#define XB_XSUB(j)  (1280 + 64 * (j))
#define XB_XGEN(j)  (2304 + 64 * (j))
#define XB_TOP      3328
#define XB_TOPGEN   3392
#define XCD_BAR_WORDS 3456
#define XB_SPIN_CAP (1u << 18)
__device__ __forceinline__ unsigned xb_ld(unsigned* p)              { return __hip_atomic_load(p, __ATOMIC_RELAXED, __HIP_MEMORY_SCOPE_AGENT); }
__device__ __forceinline__ unsigned xb_add(unsigned* p, unsigned v) { return __hip_atomic_fetch_add(p, v, __ATOMIC_RELAXED, __HIP_MEMORY_SCOPE_AGENT); }
__device__ __forceinline__ unsigned xb_xcc_id() { return (unsigned)__builtin_amdgcn_s_getreg((3 << 11) | 20) & 0xFu; }
#define XB_SPIN(cond, bar) do { unsigned _sp = 0; while (cond) { __builtin_amdgcn_s_sleep(1); \
    if ((++_sp & 255u) == 0u) { if (xb_ld(&(bar)[XB_TMO])) break; if (_sp > XB_SPIN_CAP) { atomicAdd(&(bar)[XB_TMO], 1u); break; } } } } while (0)
struct XcdBarrier { unsigned* bar; unsigned x; volatile LAS unsigned* st; };
__device__ __forceinline__ XcdBarrier xcd_barrier_post(unsigned* bar, volatile LAS unsigned* st) {
    XcdBarrier b; b.bar = bar; b.x = xb_xcc_id(); b.st = st;
    if (threadIdx.x == 0) (void)xb_add(&bar[XB_XCNT(b.x)], 1u);
    return b;
}
__device__ __forceinline__ void xcd_barrier_complete(unsigned* bar, unsigned x, unsigned& nloc, unsigned& nx) {
    const unsigned G = gridDim.x * gridDim.y * gridDim.z;
    unsigned sum, cnt, mine, sp = 0u;
    for (;;) {
        sum = 0u; cnt = 0u; mine = 0u;
#pragma unroll
        for (unsigned j = 0; j < 16; ++j) { const unsigned c = xb_ld(&bar[XB_XCNT(j)]); sum += c; cnt += (c > 0u) ? 1u : 0u; mine = (j == x) ? c : mine; }
        if (sum == G) break;
        __builtin_amdgcn_s_sleep(1);
        if ((++sp & 255u) == 0u) { if (xb_ld(&bar[XB_TMO])) break; if (sp > XB_SPIN_CAP) { atomicAdd(&bar[XB_TMO], 1u); break; } }
    }
    nloc = mine > 0u ? mine : 1u; nx = cnt > 0u ? cnt : 1u;
}
__device__ __forceinline__ void xcd_barrier(const XcdBarrier& b) {
    asm volatile("s_waitcnt vmcnt(0)" ::: "memory");
    __syncthreads();
    if (threadIdx.x == 0) {
        unsigned* bar = b.bar;
        __builtin_amdgcn_s_waitcnt(0);
        unsigned nloc = b.st[0], nx = b.st[1];
        if (nloc == 0u) { xcd_barrier_complete(bar, b.x, nloc, nx); b.st[0] = nloc; b.st[1] = nx; }
        const unsigned old = xb_add(&bar[XB_XSUB(b.x)], 1u);
        const unsigned gen = old / nloc;
        if (old + 1u == (gen + 1u) * nloc) {
            __builtin_amdgcn_fence(__ATOMIC_RELEASE, "agent");
            asm volatile("s_waitcnt vmcnt(0)" ::: "memory");
            const unsigned og = xb_add(&bar[XB_TOP], 1u);
            const unsigned tg = og / nx;
            if (og + 1u == (tg + 1u) * nx) xb_add(&bar[XB_TOPGEN], 1u);
            else XB_SPIN(xb_ld(&bar[XB_TOPGEN]) == tg, bar);
            __builtin_amdgcn_fence(__ATOMIC_ACQUIRE, "agent");
            xb_add(&bar[XB_XGEN(b.x)], 1u);
            asm volatile("s_waitcnt vmcnt(0)" ::: "memory");
        } else {
            XB_SPIN(xb_ld(&bar[XB_XGEN(b.x)]) == gen, bar);
            __builtin_amdgcn_fence(__ATOMIC_ACQUIRE, "agent");
            asm volatile("s_waitcnt vmcnt(0)" ::: "memory");
        }
    }
    __syncthreads();
}

constexpr int N_PHASES = 12;
__global__ void __launch_bounds__(NTHR, 2) fwd_kernel(Params P) {
    extern __shared__ __attribute__((aligned(16))) unsigned char lds_raw[];
    LAS unsigned char* lds = (LAS unsigned char*)lds_raw;
    cg::grid_group grid = cg::this_grid();
    const int lo = P.ph_lo, hi = P.ph_hi;
    unsigned char* ws = P.ws;
    volatile LAS unsigned* bst = (volatile LAS unsigned*)(lds + LDS_MISC);
    if (threadIdx.x < 16) bst[threadIdx.x] = 0u;
    __syncthreads();
    const XcdBarrier bar = xcd_barrier_post((unsigned*)(ws + WS_CTL), bst);
#define IN(k) (lo <= (k) && (k) < hi)
#define SEAM(k) do { if (IN(k) && IN((k) + 1)) { if ((k) == 0) grid.sync(); else xcd_barrier(bar); } } while (0)
    if (IN(0)) phase_prologue(P);
    SEAM(0);
    if (IN(1)) {
        pg8::Gemm g{(const bf16*)(ws + WS_H0), (const bf16*)(ws + WS_WIN), M, NP, D, D, D, 0}; pg8::StaticOrder S; S.init(M, NP, gridDim.x, blockIdx.x);
        pg8::EpiBf16 E{(bf16*)(ws + WS_P), NP};
        pg8::gemm_phase<pg8::EpiBf16, pg8::StaticOrder, true, true>(lds, g, S, E);
    }
    SEAM(1);
    if (IN(2)) phase_prep(P, lds);
    SEAM(2);
    if (IN(3)) phase_scan(P, lds);
    SEAM(3);
    if (IN(4)) phase_fixup(P, lds);
    SEAM(4);
    if (IN(5)) phase_correct(P, lds);
    SEAM(5);
    if (IN(6)) {
        pg8::Gemm g{(const bf16*)(ws + WS_MIX), (const bf16*)(ws + WS_WOUT), M, D, D, D, D, 0}; pg8::StaticOrder S; S.init(M, D, gridDim.x, blockIdx.x);
        pg8::EpiResBf16 E{(bf16*)(ws + WS_Z), (const bf16*)(ws + WS_H0), D, ALPHA};
        pg8::gemm_phase<pg8::EpiResBf16, pg8::StaticOrder, true, true>(lds, g, S, E);
    }
    SEAM(6);
    if (IN(7)) phase_ln1(P);
    SEAM(7);
    if (IN(8)) {
        pg8::Gemm g{(const bf16*)(ws + WS_H1), (const bf16*)(ws + WS_WQ), M, NQ, D, D, D, 0}; pg8::StaticOrder S; S.init(M, NQ, gridDim.x, blockIdx.x);
        pg8::EpiBf16 E{(bf16*)(ws + WS_Q), NQ};
        pg8::gemm_phase<pg8::EpiBf16, pg8::StaticOrder, true, true>(lds, g, S, E);
    }
    SEAM(8);
    if (IN(9)) {
        pg8::Gemm g{(const bf16*)(ws + WS_Q), (const bf16*)(ws + WS_KBD), M, NQ, 256, NQ, 256, 256}; pg8::StaticOrder S; S.init(M, NQ, gridDim.x, blockIdx.x);
        pg8::EpiBf16 E{(bf16*)(ws + WS_S), NQ};
        pg8::gemm_phase<pg8::EpiBf16, pg8::StaticOrder, true, true>(lds, g, S, E);
    }
    SEAM(9);
    if (IN(10)) phase_topk(P);
    SEAM(10);
    if (IN(11)) phase_peer(P);
#undef IN
#undef SEAM
}

extern "C" void kernel_launch(void* const* d_in, const int* in_sizes, int n_in, void* d_out, int out_size, void* d_ws, size_t ws_size, hipStream_t stream) {
    static int grid = 0;
    if (grid == 0) {
        if (n_in != 28 || out_size != M * D || ws_size < WS_END) { fprintf(stderr, "kernel_launch: unexpected shapes (n_in %d out %d ws %zu)\n", n_in, out_size, ws_size); grid = -1; return; }
        int dev = 0, cus = 0, per_cu = 0;
        (void)hipGetDevice(&dev); (void)hipDeviceGetAttribute(&cus, hipDeviceAttributeMultiprocessorCount, dev);
        (void)hipFuncSetAttribute((const void*)fwd_kernel, hipFuncAttributeMaxDynamicSharedMemorySize, LDS_BYTES);
        (void)hipOccupancyMaxActiveBlocksPerMultiprocessor(&per_cu, (const void*)fwd_kernel, NTHR, LDS_BYTES);
        if (per_cu < 1) { fprintf(stderr, "kernel_launch: occupancy query says %d blocks per CU\n", per_cu); per_cu = 1; }
        (void)hipGetLastError();
        grid = cus;
    }
    if (grid < 0) return;
    Params p{};
    for (int i = 0; i < 28; ++i) p.in[i] = (const float*)d_in[i];
    p.out = (float*)d_out; p.ws = (unsigned char*)d_ws;
    (void)hipMemsetAsync((char*)d_ws + WS_CTL, 0, CTL_BYTES, stream);
#if MK_ONE_LAUNCH
    p.ph_lo = 0; p.ph_hi = N_PHASES;
    void* args[] = {&p};
    hipError_t e = hipLaunchCooperativeKernel((const void*)fwd_kernel, dim3(grid), dim3(NTHR), args, LDS_BYTES, stream);
    if (e != hipSuccess) fprintf(stderr, "cooperative launch failed: %s (grid %d)\n", hipGetErrorString(e), grid);
#else
    for (int ph = 0; ph < N_PHASES; ++ph) {
        p.ph_lo = ph; p.ph_hi = ph + 1;
        hipLaunchKernelGGL(fwd_kernel, dim3(grid), dim3(NTHR), LDS_BYTES, stream, p);
    }
#endif
}
```

```cpp
#include <hip/hip_runtime.h>
#include <hip/hip_cooperative_groups.h>
#include <cstdio>
#include <cstdint>
namespace cg = cooperative_groups;

#ifndef MK_ONE_LAUNCH
#define MK_ONE_LAUNCH 1
#endif

namespace pg8 {
#define PG8_LAS __attribute__((address_space(3)))
typedef unsigned short bf16_t;
typedef short bf16x8 __attribute__((ext_vector_type(8)));
typedef float f32x4 __attribute__((ext_vector_type(4)));
typedef float f32x2 __attribute__((ext_vector_type(2)));
typedef unsigned u32x4 __attribute__((ext_vector_type(4)));
typedef unsigned u32x2 __attribute__((ext_vector_type(2)));
constexpr int BM = 256, BK = 64, HALF = 128, HTB = HALF * BK * 2, STAGE_BYTES = 8 * HTB, NXCD = 8, WGM = 8;

__host__ __device__ __forceinline__ int lds_byte(int r, int c) { const int st = (r >> 4) * 2 + (c >> 5), rr = r & 15, cc = c & 31, ob = rr * 64 + cc * 2; return st * 1024 + (ob ^ (((ob >> 9) & 1) << 5)); }
__host__ __device__ __forceinline__ void stage_rc(int b, int& R, int& C) { const int st = b / 1024, sb = b % 1024, swz = sb ^ (((sb >> 9) & 1) << 5); R = (st >> 1) * 16 + swz / 64; C = (st & 1) * 32 + (swz % 64) / 2; }
__host__ __device__ __forceinline__ int perm32(int rho) { const int n = rho >> 4, i = rho & 15; return 8 * (i >> 2) + 4 * n + (i & 3); }

struct Unit { int pm, pn; };
struct Gemm { const bf16_t* A; const bf16_t* Bt; int M, N, K, lda, ldb, a_pn_koff; };

struct StaticOrder {
    int nM, nN, nwg, G, c;
    __host__ __device__ void init(int M, int N, int G_, int c_) { nM = M / BM; nN = N / BM; nwg = nM * nN; G = G_; c = c_; }
    __host__ __device__ bool next(int i, Unit& u) const {
        const long L = (long)i * G + c; if (L >= nwg) return false;
        int wgid = (int)L; { const int q = nwg / NXCD, r = nwg % NXCD, xcd = wgid % NXCD, off = wgid / NXCD; wgid = (xcd < r ? xcd * (q + 1) : r * (q + 1) + (xcd - r) * q) + off; }
        const int nig = WGM * nN, gid = wgid / nig, fm = gid * WGM, gsz = (nM - fm) < WGM ? (nM - fm) : WGM;
        u.pm = fm + ((wgid % nig) % gsz); u.pn = (wgid % nig) / gsz; return true;
    }
    __device__ __forceinline__ void a_ready(const Unit&) const {}
    __device__ __forceinline__ void done(const Unit&) const {}
};

__device__ __forceinline__ unsigned cvt_pk_bf16(float lo, float hi) { unsigned r; asm volatile("v_cvt_pk_bf16_f32 %0, %1, %2" : "=v"(r) : "v"(lo), "v"(hi)); return r; }

struct EpiBf16 {
    static constexpr bool PERM = true;
    bf16_t* O; int ldc;
    __device__ __forceinline__ void operator()(const f32x4 (&acc)[2][2][4][2], const Unit& u, int wr, int wc, int fr, int fq) const {
        const int row0 = u.pm * BM + wr * 64 + fr; const int col0 = u.pn * BM + wc * 32 + 8 * fq;
#pragma unroll
        for (int ai = 0; ai < 2; ++ai)
#pragma unroll
            for (int m = 0; m < 4; ++m) { bf16_t* rowp = O + (size_t)(row0 + ai * HALF + m * 16) * ldc + col0;
#pragma unroll
                for (int bj = 0; bj < 2; ++bj) { const f32x4 v0 = acc[ai][bj][m][0], v1 = acc[ai][bj][m][1];
                    u32x4 w; w.x = cvt_pk_bf16(v0[0], v0[1]); w.y = cvt_pk_bf16(v0[2], v0[3]); w.z = cvt_pk_bf16(v1[0], v1[1]); w.w = cvt_pk_bf16(v1[2], v1[3]);
                    *(u32x4*)(rowp + bj * HALF) = w; } }
    }
};
struct EpiResBf16 {
    static constexpr bool PERM = true;
    bf16_t* Z; const bf16_t* R; int ldc; float alpha;
    __device__ __forceinline__ void operator()(const f32x4 (&acc)[2][2][4][2], const Unit& u, int wr, int wc, int fr, int fq) const {
        const int row0 = u.pm * BM + wr * 64 + fr; const int col0 = u.pn * BM + wc * 32 + 8 * fq;
#pragma unroll
        for (int ai = 0; ai < 2; ++ai)
#pragma unroll
            for (int m = 0; m < 4; ++m) { const size_t off = (size_t)(row0 + ai * HALF + m * 16) * ldc + col0;
#pragma unroll
                for (int bj = 0; bj < 2; ++bj) { const u32x4 rb = *(const u32x4*)(R + off + bj * HALF); const f32x4 v0 = acc[ai][bj][m][0], v1 = acc[ai][bj][m][1];
                    u32x4 w;
                    w.x = cvt_pk_bf16(__uint_as_float(rb.x << 16) * alpha + v0[0], __uint_as_float(rb.x & 0xffff0000u) * alpha + v0[1]);
                    w.y = cvt_pk_bf16(__uint_as_float(rb.y << 16) * alpha + v0[2], __uint_as_float(rb.y & 0xffff0000u) * alpha + v0[3]);
                    w.z = cvt_pk_bf16(__uint_as_float(rb.z << 16) * alpha + v1[0], __uint_as_float(rb.z & 0xffff0000u) * alpha + v1[1]);
                    w.w = cvt_pk_bf16(__uint_as_float(rb.w << 16) * alpha + v1[2], __uint_as_float(rb.w & 0xffff0000u) * alpha + v1[3]);
                    *(u32x4*)(Z + off + bj * HALF) = w; } }
    }
};
struct EpiResF32 {
    static constexpr bool PERM = false;
    float* Z; const bf16_t* R; int ldc; float alpha;
    __device__ __forceinline__ void operator()(const f32x4 (&acc)[2][2][4][2], const Unit& u, int wr, int wc, int fr, int fq) const {
        const int row0 = u.pm * BM + wr * 64 + fr; const int col0 = u.pn * BM + wc * 32 + 4 * fq;
#pragma unroll
        for (int ai = 0; ai < 2; ++ai)
#pragma unroll
            for (int m = 0; m < 4; ++m) { const size_t off = (size_t)(row0 + ai * HALF + m * 16) * ldc + col0;
#pragma unroll
                for (int bj = 0; bj < 2; ++bj)
#pragma unroll
                    for (int n = 0; n < 2; ++n) { const size_t o2 = off + bj * HALF + n * 16; const u32x2 rb = *(const u32x2*)(R + o2);
                        f32x4 h; h[0] = __uint_as_float(rb.x << 16); h[1] = __uint_as_float(rb.x & 0xffff0000u); h[2] = __uint_as_float(rb.y << 16); h[3] = __uint_as_float(rb.y & 0xffff0000u);
                        *(f32x4*)(Z + o2) = h * alpha + acc[ai][bj][m][n]; } }
    }
};

template <class Epi, class Sched, bool ALIGN_EPI = false, bool SP2 = false>
__device__ __forceinline__ void gemm_phase(PG8_LAS unsigned char* lds, const Gemm g, const Sched& S, const Epi& E) {
    const int tid = threadIdx.x, wid = __builtin_amdgcn_readfirstlane(tid >> 6), lane = tid & 63, wr = wid >> 2, wc = wid & 3, fr = lane & 15, fq = lane >> 4;
    const int K = g.K, nt = K / BK;
    unsigned voffA[2], voffB[2];
#pragma unroll
    for (int i = 0; i < 2; ++i) { int R, C; stage_rc(tid * 16 + i * 8192, R, C); const int Rb = Epi::PERM ? ((R & ~31) + perm32(R & 31)) : R;
        voffA[i] = (unsigned)(R * g.lda + C) * 2u; voffB[i] = (unsigned)(Rb * g.ldb + C) * 2u; }
    const size_t kstep = (size_t)(BK * 2);
    const size_t hstepA = (size_t)HALF * g.lda * 2, hstepB = (size_t)HALF * g.ldb * 2;
    const size_t tstepA = 2 * hstepA, tstepB = 2 * hstepB;
    const size_t pnA = (size_t)g.a_pn_koff * 2;
    const unsigned ldsw = (unsigned)wid * 1024u;
    const int aoff = lds_byte(wr * 64 + fr, fq * 8), boff = lds_byte(wc * 32 + fr, fq * 8);
#define PG8_SA(b, h) (((b) * 2 + (h)) * HTB)
#define PG8_SB(b, h) ((4 + (b) * 2 + (h)) * HTB)
#define PG8_STAGE(bufoff, gbase, voff) do { _Pragma("unroll") for (int _i = 0; _i < 2; ++_i) \
        __builtin_amdgcn_global_load_lds((const unsigned*)((const char*)(gbase) + (voff)[_i]), (PG8_LAS unsigned*)(lds + (bufoff) + ldsw + _i * 8192), 16, 0, 0); } while (0)
#define PG8_LDA(dst, b, h) do { _Pragma("unroll") for (int m = 0; m < 4; ++m) _Pragma("unroll") for (int k = 0; k < 2; ++k) dst[m][k] = *(const PG8_LAS bf16x8*)(lds + PG8_SA(b, h) + aoff + m * 2048 + k * 1024); } while (0)
#define PG8_LDB(dst, b, h) do { _Pragma("unroll") for (int n = 0; n < 2; ++n) _Pragma("unroll") for (int k = 0; k < 2; ++k) dst[n][k] = *(const PG8_LAS bf16x8*)(lds + PG8_SB(b, h) + boff + n * 2048 + k * 1024); } while (0)
#define PG8_MMA(ai, bj, At, Bt) do { __builtin_amdgcn_s_setprio(1); _Pragma("unroll") for (int m = 0; m < 4; ++m) _Pragma("unroll") for (int n = 0; n < 2; ++n) _Pragma("unroll") for (int k = 0; k < 2; ++k) \
        acc[ai][bj][m][n] = __builtin_amdgcn_mfma_f32_16x16x32_bf16(Bt[n][k], At[m][k], acc[ai][bj][m][n], 0, 0, 0); __builtin_amdgcn_s_setprio(0); } while (0)
#define PG8_WAIT_V(n) asm volatile("s_waitcnt vmcnt(" #n ")" ::: "memory")
#define PG8_WAIT_L(n) asm volatile("s_waitcnt lgkmcnt(" #n ")" ::: "memory")
#define PG8_BAR __builtin_amdgcn_s_barrier()
#define PG8_SCHED __builtin_amdgcn_sched_barrier(0)
    Unit cur, nxt; int ui = 0;
    if (!S.next(0, cur)) return;
    f32x4 acc[2][2][4][2];
#pragma unroll
    for (int a = 0; a < 2; ++a)
#pragma unroll
        for (int b = 0; b < 2; ++b)
#pragma unroll
            for (int m = 0; m < 4; ++m)
#pragma unroll
                for (int n = 0; n < 2; ++n) acc[a][b][m][n] = (f32x4){0.f, 0.f, 0.f, 0.f};
    bf16x8 At[4][2], B0[2][2], B1[2][2];
    const char* cA = (const char*)g.A + (size_t)cur.pm * tstepA + (size_t)cur.pn * pnA; const char* cB = (const char*)g.Bt + (size_t)cur.pn * tstepB;
    S.a_ready(cur);
    if constexpr (SP2) {
        PG8_STAGE(PG8_SB(0, 0), cB, voffB); PG8_STAGE(PG8_SB(0, 1), cB + hstepB, voffB); PG8_STAGE(PG8_SA(0, 0), cA, voffA); PG8_STAGE(PG8_SA(0, 1), cA + hstepA, voffA);
        if (wr == 1) PG8_BAR;
        PG8_WAIT_V(2); PG8_BAR;
        PG8_STAGE(PG8_SB(1, 0), cB + kstep, voffB); PG8_STAGE(PG8_SA(1, 0), cA + kstep, voffA); PG8_STAGE(PG8_SB(1, 1), cB + hstepB + kstep, voffB);
        PG8_WAIT_V(6); PG8_BAR;
    } else {
        PG8_STAGE(PG8_SB(0, 0), cB, voffB); PG8_STAGE(PG8_SA(0, 0), cA, voffA); PG8_STAGE(PG8_SB(0, 1), cB + hstepB, voffB); PG8_STAGE(PG8_SA(0, 1), cA + hstepA, voffA);
        if (wr == 1) PG8_BAR;
        PG8_WAIT_V(4); PG8_BAR;
        PG8_STAGE(PG8_SB(1, 0), cB + kstep, voffB); PG8_STAGE(PG8_SA(1, 0), cA + kstep, voffA); PG8_STAGE(PG8_SB(1, 1), cB + hstepB + kstep, voffB);
        PG8_WAIT_V(6); PG8_BAR;
    }
    for (;;) {
        const bool has_next = S.next(ui + 1, nxt);
        const char* nA = has_next ? (const char*)g.A + (size_t)nxt.pm * tstepA + (size_t)nxt.pn * pnA : cA; const char* nB = has_next ? (const char*)g.Bt + (size_t)nxt.pn * tstepB : cB;
        for (int t = 0; t < nt; t += 2) {
            const bool last = (t == nt - 2);
            const char* a1 = cA + (size_t)(t + 1) * kstep;
            const char* a2 = last ? nA : cA + (size_t)(t + 2) * kstep; const char* b2 = last ? nB : cB + (size_t)(t + 2) * kstep;
            const char* a3 = a2 + kstep; const char* b3 = b2 + kstep;
            if (last && has_next) S.a_ready(nxt);
            if constexpr (SP2) {
            PG8_LDB(B0, 0, 0); PG8_LDB(B1, 0, 1); PG8_SCHED; PG8_LDA(At, 0, 0); PG8_STAGE(PG8_SA(1, 1), a1 + hstepA, voffA);
            PG8_WAIT_V(8); PG8_WAIT_L(0); PG8_BAR; PG8_MMA(0, 0, At, B0); PG8_MMA(0, 1, At, B1); PG8_BAR; PG8_SCHED;
            PG8_LDA(At, 0, 1); PG8_STAGE(PG8_SB(0, 0), b2, voffB); PG8_STAGE(PG8_SB(0, 1), b2 + hstepB, voffB); PG8_STAGE(PG8_SA(0, 0), a2, voffA);
            PG8_WAIT_V(8); PG8_WAIT_L(0); PG8_BAR; PG8_MMA(1, 0, At, B0); PG8_MMA(1, 1, At, B1); PG8_BAR; PG8_SCHED;
            PG8_LDB(B0, 1, 0); PG8_LDB(B1, 1, 1); PG8_SCHED; PG8_LDA(At, 1, 0); PG8_STAGE(PG8_SA(0, 1), a2 + hstepA, voffA);
            PG8_WAIT_V(8); PG8_WAIT_L(0); PG8_BAR; PG8_MMA(0, 0, At, B0); PG8_MMA(0, 1, At, B1); PG8_BAR; PG8_SCHED;
            PG8_LDA(At, 1, 1); PG8_STAGE(PG8_SB(1, 0), b3, voffB); PG8_STAGE(PG8_SB(1, 1), b3 + hstepB, voffB); PG8_STAGE(PG8_SA(1, 0), a3, voffA);
            PG8_WAIT_V(8); PG8_WAIT_L(0); PG8_BAR; PG8_MMA(1, 0, At, B0); PG8_MMA(1, 1, At, B1); PG8_BAR; PG8_SCHED;
            } else {
            PG8_LDB(B0, 0, 0); PG8_SCHED; PG8_LDA(At, 0, 0); PG8_STAGE(PG8_SA(1, 1), a1 + hstepA, voffA);
            PG8_WAIT_L(8); PG8_BAR; PG8_WAIT_L(0); PG8_MMA(0, 0, At, B0); PG8_BAR; PG8_SCHED;
            PG8_LDB(B1, 0, 1); PG8_STAGE(PG8_SB(0, 0), b2, voffB);
            PG8_BAR; PG8_WAIT_L(0); PG8_MMA(0, 1, At, B1); PG8_BAR;
            PG8_LDA(At, 0, 1); PG8_STAGE(PG8_SA(0, 0), a2, voffA);
            PG8_BAR; PG8_WAIT_L(0); PG8_MMA(1, 0, At, B0); PG8_BAR; PG8_SCHED;
            PG8_STAGE(PG8_SB(0, 1), b2 + hstepB, voffB);
            PG8_WAIT_V(6); PG8_BAR; PG8_MMA(1, 1, At, B1); PG8_BAR;
            PG8_LDB(B0, 1, 0); PG8_SCHED; PG8_LDA(At, 1, 0); PG8_STAGE(PG8_SA(0, 1), a2 + hstepA, voffA);
            PG8_WAIT_L(8); PG8_BAR; PG8_WAIT_L(0); PG8_MMA(0, 0, At, B0); PG8_BAR; PG8_SCHED;
            PG8_LDB(B1, 1, 1); PG8_STAGE(PG8_SB(1, 0), b3, voffB);
            PG8_BAR; PG8_WAIT_L(0); PG8_MMA(0, 1, At, B1); PG8_BAR;
            PG8_LDA(At, 1, 1); PG8_STAGE(PG8_SA(1, 0), a3, voffA);
            PG8_BAR; PG8_WAIT_L(0); PG8_MMA(1, 0, At, B0); PG8_BAR; PG8_SCHED;
            PG8_STAGE(PG8_SB(1, 1), b3 + hstepB, voffB);
            PG8_WAIT_V(6); PG8_BAR; PG8_MMA(1, 1, At, B1); PG8_BAR;
            }
        }
        if constexpr (ALIGN_EPI) { if (wr == 0) PG8_BAR; }
        E(acc, cur, wr, wc, fr, fq); S.done(cur);
        if (!has_next) break;
#pragma unroll
        for (int a = 0; a < 2; ++a)
#pragma unroll
            for (int b = 0; b < 2; ++b)
#pragma unroll
                for (int m = 0; m < 4; ++m)
#pragma unroll
                    for (int n = 0; n < 2; ++n) acc[a][b][m][n] = (f32x4){0.f, 0.f, 0.f, 0.f};
        cur = nxt; cA = nA; cB = nB; ++ui;
        if constexpr (ALIGN_EPI) { if (wr == 1) PG8_BAR; }
    }
    PG8_WAIT_V(0);
    if constexpr (!ALIGN_EPI) { if (wr == 0) PG8_BAR; }
    PG8_BAR;
#undef PG8_SA
#undef PG8_SB
#undef PG8_STAGE
#undef PG8_LDA
#undef PG8_LDB
#undef PG8_MMA
#undef PG8_WAIT_V
#undef PG8_WAIT_L
#undef PG8_BAR
#undef PG8_SCHED
}
}

constexpr int NWAVES = 8, NTHR = NWAVES * 64;
constexpr int D = 1024, NBATCH = 4, T = 8192, M = NBATCH * T;
constexpr int A_W = 512, A_IN = 1792, IN_COLS = 3344, NP = 3584;
constexpr int C_R = 0, C_K = 512, C_V = 1024, C_WD = 1536, C_AD = 1600, C_GD = 1664;
constexpr int C_BQ = 1792, C_BK = 2048, C_BV = 2304, C_GKD = 2816, C_BG = 2832;
constexpr int NQ = 2048;
constexpr float LN_EPS = 1e-5f, GN_EPS = 64e-5f, RMS_EPS = 1e-5f;
constexpr float ALPHA = 1.189207115002721f;

typedef unsigned short bf16;
typedef float f32x4 __attribute__((ext_vector_type(4)));
typedef float f32x2 __attribute__((ext_vector_type(2)));
typedef unsigned u32x4 __attribute__((ext_vector_type(4)));
typedef unsigned u32x2 __attribute__((ext_vector_type(2)));
#define LAS __attribute__((address_space(3)))

constexpr size_t MiB = 1u << 20;
constexpr size_t WS_WIN = 1 * MiB, WS_WOUT = 8 * MiB, WS_WQ = 10 * MiB, WS_KBD = 14 * MiB;
constexpr size_t WS_W2T = 15 * MiB, WS_A2T = WS_W2T + 65536, WS_G2T = WS_A2T + 65536;
constexpr size_t WS_H0 = 16 * MiB;
constexpr size_t WS_P = 80 * MiB;
constexpr size_t WS_WL = 304 * MiB, WS_AA = 336 * MiB, WS_GG = 368 * MiB;
constexpr size_t WS_GK = 400 * MiB;
constexpr size_t WS_MIX = 416 * MiB;
constexpr size_t WS_Z = 80 * MiB;
constexpr size_t WS_H1 = 208 * MiB;
constexpr size_t WS_Q = 272 * MiB;
constexpr size_t WS_S = 80 * MiB;
constexpr size_t WS_IDS = 400 * MiB, WS_GATES = 416 * MiB;
constexpr size_t WS_UT = 432 * MiB, WS_VT = 448 * MiB;
constexpr int ROWB = 768;
constexpr size_t WS_SU = 464 * MiB, WS_SV = 465 * MiB;
constexpr int NSEG = 16, LSEG = 8192 / NSEG;
constexpr size_t WS_YI = WS_WL;
constexpr size_t WS_YIG = WS_GK;
constexpr size_t WS_SER = 480 * MiB;
constexpr size_t WS_SEG = 496 * MiB;
constexpr size_t WS_CEND = 504 * MiB;
constexpr size_t WS_END = 505 * MiB;

constexpr int LDS_BYTES = 147456, LDS_MISC = LDS_BYTES - 256;
constexpr size_t WS_CTL = 0, CTL_BYTES = 16384;

struct Params {
    const float* in[28];
    float* out; unsigned char* ws;
    int ph_lo, ph_hi;
};

__device__ __forceinline__ float bf2f(unsigned u) { return __uint_as_float(u << 16); }
__device__ __forceinline__ unsigned f2bf(float f) { unsigned u = __float_as_uint(f); return (u + 0x7fffu + ((u >> 16) & 1u)) >> 16; }
__device__ __forceinline__ unsigned pk2(float lo, float hi) { return f2bf(lo) | (f2bf(hi) << 16); }
#define DPP_F(v, ctrl) __builtin_bit_cast(float, __builtin_amdgcn_update_dpp(0, __builtin_bit_cast(int, (v)), (ctrl), 0xf, 0xf, false))
#define DPP_ADD(v, ctrl) ((v) + DPP_F(v, ctrl))
__device__ __forceinline__ float rlf(float v, int l) { return __builtin_bit_cast(float, __builtin_amdgcn_readlane(__builtin_bit_cast(int, v), l)); }
__device__ __forceinline__ float wave_sum_u(float v) {
    v = DPP_ADD(v, 0xB1); v = DPP_ADD(v, 0x4E); v = DPP_ADD(v, 0x141); v = DPP_ADD(v, 0x140);
    return (rlf(v, 0) + rlf(v, 16)) + (rlf(v, 32) + rlf(v, 48));
}
__device__ __forceinline__ float wave_sum(float v) { return wave_sum_u(v); }
#define DPP_I(v, ctrl) __builtin_amdgcn_update_dpp(0, (v), (ctrl), 0xf, 0xf, false)
__device__ __forceinline__ int wave_sum_i(int v) {
    v += DPP_I(v, 0xB1); v += DPP_I(v, 0x4E); v += DPP_I(v, 0x141); v += DPP_I(v, 0x140);
    return (__builtin_amdgcn_readlane(v, 0) + __builtin_amdgcn_readlane(v, 16)) + (__builtin_amdgcn_readlane(v, 32) + __builtin_amdgcn_readlane(v, 48));
}
__device__ __forceinline__ float wave_max_u(float v) {
    v = fmaxf(v, DPP_F(v, 0xB1)); v = fmaxf(v, DPP_F(v, 0x4E)); v = fmaxf(v, DPP_F(v, 0x141)); v = fmaxf(v, DPP_F(v, 0x140));
    return fmaxf(fmaxf(rlf(v, 0), rlf(v, 16)), fmaxf(rlf(v, 32), rlf(v, 48)));
}
__device__ __forceinline__ unsigned pack_i8(float a, float b, float c, float d, float inv, int off) {
    const int q0 = __float2int_rn(a * inv) + off, q1 = __float2int_rn(b * inv) + off, q2 = __float2int_rn(c * inv) + off, q3 = __float2int_rn(d * inv) + off;
    return (unsigned)(q0 & 0xff) | ((unsigned)(q1 & 0xff) << 8) | ((unsigned)(q2 & 0xff) << 16) | ((unsigned)(q3 & 0xff) << 24);
}
__device__ __forceinline__ float sigmoidf_(float x) { return 1.f / (1.f + __expf(-x)); }
__device__ __forceinline__ float softplusf_(float x) { return fmaxf(x, 0.f) + log1pf(__expf(-fabsf(x))); }
__device__ __forceinline__ float siluf_(float x) { return x * sigmoidf_(x); }

__device__ __forceinline__ void transpose_convert(const float* W, int K, int N, int Npad, bf16* WT, int gtid, int gthreads) {
    const int kc = K / 8, total = Npad * kc;
    for (int idx = gtid; idx < total; idx += gthreads) {
        const int n = idx % Npad, c = idx / Npad; float v[8];
#pragma unroll
        for (int j = 0; j < 8; ++j) v[j] = (n < N) ? W[(size_t)(8 * c + j) * N + n] : 0.f;
        u32x4 o; o.x = pk2(v[0], v[1]); o.y = pk2(v[2], v[3]); o.z = pk2(v[4], v[5]); o.w = pk2(v[6], v[7]);
        *(u32x4*)(WT + (size_t)n * K + 8 * c) = o;
    }
}
__device__ __forceinline__ void ln_row_bf16(const float* xrow, const float* g, const float* b, bf16* orow, int lane) {
    const f32x4* xr = (const f32x4*)xrow + lane; f32x4 v[4]; float s = 0.f;
#pragma unroll
    for (int j = 0; j < 4; ++j) { v[j] = xr[64 * j]; s += (v[j][0] + v[j][1]) + (v[j][2] + v[j][3]); }
    const float mean = wave_sum(s) * (1.f / D); float s2 = 0.f;
#pragma unroll
    for (int j = 0; j < 4; ++j) { v[j] = v[j] - mean; s2 += (v[j][0] * v[j][0] + v[j][1] * v[j][1]) + (v[j][2] * v[j][2] + v[j][3] * v[j][3]); }
    const float rstd = 1.f / sqrtf(wave_sum(s2) * (1.f / D) + LN_EPS);
    u32x2* o8 = (u32x2*)orow + lane;
#pragma unroll
    for (int j = 0; j < 4; ++j) { const f32x4 gg = ((const f32x4*)g)[lane + 64 * j], bb = ((const f32x4*)b)[lane + 64 * j]; const f32x4 y = v[j] * rstd * gg + bb;
        u32x2 w; w.x = pk2(y[0], y[1]); w.y = pk2(y[2], y[3]); o8[64 * j] = w; }
}
__device__ __forceinline__ void ln_rowb_bf16(const bf16* xrow, const float* g, const float* b, bf16* orow, int lane) {
    const u32x4* xr = (const u32x4*)xrow + 2 * lane; const u32x4 a = xr[0], c = xr[1]; float v[16]; float s = 0.f;
#pragma unroll
    for (int i = 0; i < 4; ++i) { v[2 * i] = __uint_as_float(a[i] << 16); v[2 * i + 1] = __uint_as_float(a[i] & 0xffff0000u); v[8 + 2 * i] = __uint_as_float(c[i] << 16); v[8 + 2 * i + 1] = __uint_as_float(c[i] & 0xffff0000u); }
#pragma unroll
    for (int i = 0; i < 16; ++i) s += v[i];
    const float mean = wave_sum(s) * (1.f / D); float s2 = 0.f;
#pragma unroll
    for (int i = 0; i < 16; ++i) { v[i] -= mean; s2 += v[i] * v[i]; }
    const float rstd = 1.f / sqrtf(wave_sum(s2) * (1.f / D) + LN_EPS);
    u32x4 o0, o1;
#pragma unroll
    for (int q = 0; q < 4; ++q) { const f32x4 gg = *(const f32x4*)(g + 16 * lane + 4 * q), bb = *(const f32x4*)(b + 16 * lane + 4 * q);
        const unsigned lo = pk2(v[4 * q] * rstd * gg[0] + bb[0], v[4 * q + 1] * rstd * gg[1] + bb[1]), hi = pk2(v[4 * q + 2] * rstd * gg[2] + bb[2], v[4 * q + 3] * rstd * gg[3] + bb[3]);
        if (q < 2) { o0[2 * q] = lo; o0[2 * q + 1] = hi; } else { o1[2 * q - 4] = lo; o1[2 * q - 3] = hi; } }
    u32x4* op = (u32x4*)orow + 2 * lane; op[0] = o0; op[1] = o1;
}
__device__ __forceinline__ void phase_prologue(const Params& P) {
    const int tid = threadIdx.x, lane = tid & 63, wave = tid >> 6;
    const int gtid = blockIdx.x * NTHR + tid, gthreads = gridDim.x * NTHR;
    unsigned char* ws = P.ws;
    transpose_convert(P.in[3], D, IN_COLS, NP, (bf16*)(ws + WS_WIN), gtid, gthreads);
    transpose_convert(P.in[19], D, D, D, (bf16*)(ws + WS_WOUT), gtid, gthreads);
    transpose_convert(P.in[22], D, NQ, NQ, (bf16*)(ws + WS_WQ), gtid, gthreads);
    transpose_convert(P.in[6], 64, A_W, A_W, (bf16*)(ws + WS_W2T), gtid, gthreads);
    transpose_convert(P.in[8], 64, A_W, A_W, (bf16*)(ws + WS_A2T), gtid, gthreads);
    transpose_convert(P.in[9], 128, A_W, A_W, (bf16*)(ws + WS_G2T), gtid, gthreads);
    {
        const float* keys = P.in[23]; bf16* kbd = (bf16*)(ws + WS_KBD);
        for (int idx = gtid; idx < 8 * 256 * 32; idx += gthreads) {
            const int kc = idx & 31, n = (idx >> 5) & 255, h = idx >> 13; const int k0 = kc * 8, hn = n >> 7, key = n & 127, hk = k0 >> 7, c0 = k0 & 127;
            u32x4 o = (u32x4){0u, 0u, 0u, 0u};
            if (hn == hk) { const float* s = keys + ((size_t)((h * 2 + hn) * 128 + key)) * 128 + c0; o.x = pk2(s[0], s[1]); o.y = pk2(s[2], s[3]); o.z = pk2(s[4], s[5]); o.w = pk2(s[6], s[7]); }
            *(u32x4*)(kbd + ((size_t)(h * 256 + n)) * 256 + k0) = o;
        }
    }
    const int gw = blockIdx.x * NWAVES + wave, ngw = gridDim.x * NWAVES;
    for (int m = gw; m < M; m += ngw) ln_row_bf16(P.in[0] + (size_t)m * D, P.in[1], P.in[2], (bf16*)(ws + WS_H0) + (size_t)m * D, lane);
}

typedef short bf16x8_t __attribute__((ext_vector_type(8)));
template <int KS, int LDA>
__device__ __forceinline__ void lora_mm(f32x4 (&acc)[4][4], const LAS bf16* ACT, const bf16* WT, int c0, int fr, int fq) {
#pragma unroll
    for (int mt = 0; mt < 4; ++mt)
#pragma unroll
        for (int nt = 0; nt < 4; ++nt) acc[mt][nt] = (f32x4){0.f, 0.f, 0.f, 0.f};
#pragma unroll
    for (int s = 0; s < KS; ++s) {
        bf16x8_t af[4], bfr[4];
#pragma unroll
        for (int mt = 0; mt < 4; ++mt) af[mt] = *(const LAS bf16x8_t*)(ACT + (mt * 16 + fr) * LDA + 32 * s + 8 * fq);
#pragma unroll
        for (int nt = 0; nt < 4; ++nt) bfr[nt] = *(const bf16x8_t*)(WT + (size_t)(c0 + nt * 16 + fr) * (32 * KS) + 32 * s + 8 * fq);
#pragma unroll
        for (int mt = 0; mt < 4; ++mt)
#pragma unroll
            for (int nt = 0; nt < 4; ++nt) acc[mt][nt] = __builtin_amdgcn_mfma_f32_16x16x32_bf16(bfr[nt], af[mt], acc[mt][nt], 0, 0, 0);
    }
}
__device__ __forceinline__ void phase_prep(const Params& P, LAS unsigned char* lds) {
    const int tid = threadIdx.x, lane = tid & 63, wave = __builtin_amdgcn_readfirstlane(tid >> 6), fr = lane & 15, fq = lane >> 4;
    unsigned char* ws = P.ws;
    const bf16* p = (const bf16*)(ws + WS_P);
    const float* mu = P.in[4]; const float* w0 = P.in[5]; const float* a0 = P.in[7];
    const float* gkw2 = P.in[16]; const float* gkb = P.in[17];
    const bf16* W2T = (const bf16*)(ws + WS_W2T); const bf16* A2T = (const bf16*)(ws + WS_A2T); const bf16* G2T = (const bf16*)(ws + WS_G2T);
    bf16* WL = (bf16*)(ws + WS_WL); bf16* AA = (bf16*)(ws + WS_AA); bf16* GG = (bf16*)(ws + WS_GG); bf16* GK = (bf16*)(ws + WS_GK);
    LAS bf16* TW = (LAS bf16*)lds; LAS bf16* AD = TW + 64 * 72; LAS bf16* SG = AD + 64 * 72;
    LAS float* gkd = (LAS float*)(SG + 64 * 136);
    const int c0 = wave * 64;
    for (int tile = blockIdx.x; tile < M / 64; tile += gridDim.x) {
        const int m0 = tile * 64;
        __syncthreads();
        for (int idx = tid; idx < 64 * 32; idx += NTHR) {
            const int j = (idx & 31) * 8, tok = idx >> 5, m = m0 + tok, t = m & (T - 1);
            const u32x4 cw = *(const u32x4*)(p + (size_t)m * NP + C_WD + j); const u32x4 pw = (t > 0) ? *(const u32x4*)(p + (size_t)(m - 1) * NP + C_WD + j) : (u32x4){0u, 0u, 0u, 0u};
            const f32x4 m0v = *(const f32x4*)(mu + C_WD + j), m1v = *(const f32x4*)(mu + C_WD + j + 4);
            float x[8];
#pragma unroll
            for (int i = 0; i < 4; ++i) { const float c0 = __uint_as_float(cw[i] << 16), c1 = __uint_as_float(cw[i] & 0xffff0000u), q0 = __uint_as_float(pw[i] << 16), q1 = __uint_as_float(pw[i] & 0xffff0000u);
                const float mu0 = i < 2 ? m0v[2 * i] : m1v[2 * i - 4], mu1 = i < 2 ? m0v[2 * i + 1] : m1v[2 * i - 3];
                x[2 * i] = c0 + (q0 - c0) * mu0; x[2 * i + 1] = c1 + (q1 - c1) * mu1; }
            u32x4 o;
            if (j < 64) {
#pragma unroll
                for (int i = 0; i < 4; ++i) o[i] = pk2(1.f - 2.f * __builtin_amdgcn_rcpf(1.f + __expf(2.f * x[2 * i])), 1.f - 2.f * __builtin_amdgcn_rcpf(1.f + __expf(2.f * x[2 * i + 1])));
                *(LAS u32x4*)(TW + tok * 72 + j) = o;
            } else if (j < 128) {
#pragma unroll
                for (int i = 0; i < 4; ++i) o[i] = pk2(x[2 * i], x[2 * i + 1]);
                *(LAS u32x4*)(AD + tok * 72 + j - 64) = o;
            } else {
#pragma unroll
                for (int i = 0; i < 4; ++i) o[i] = pk2(sigmoidf_(x[2 * i]), sigmoidf_(x[2 * i + 1]));
                *(LAS u32x4*)(SG + tok * 136 + j - 128) = o;
            }
        }
        for (int idx = tid; idx < 64 * 16; idx += NTHR) { const int j = idx & 15, tok = idx >> 4; gkd[tok * 16 + j] = bf2f(p[(size_t)(m0 + tok) * NP + C_GKD + j]); }
        __syncthreads();
        f32x4 acc[4][4];
        lora_mm<2, 72>(acc, TW, W2T, c0, fr, fq);
#pragma unroll
        for (int nt = 0; nt < 4; ++nt) { const int c = c0 + nt * 16 + 4 * fq; const f32x4 b = *(const f32x4*)(w0 + c);
#pragma unroll
            for (int mt = 0; mt < 4; ++mt) { float o[4];
#pragma unroll
                for (int i = 0; i < 4; ++i) { const float z = b[i] + acc[mt][nt][i]; o[i] = -0.6065306597126334f * sigmoidf_(z); }
                u32x2 w; w.x = pk2(o[0], o[1]); w.y = pk2(o[2], o[3]); *(u32x2*)(WL + (size_t)(m0 + mt * 16 + fr) * A_W + c) = w; } }
        lora_mm<2, 72>(acc, AD, A2T, c0, fr, fq);
#pragma unroll
        for (int nt = 0; nt < 4; ++nt) { const int c = c0 + nt * 16 + 4 * fq; const f32x4 b = *(const f32x4*)(a0 + c);
#pragma unroll
            for (int mt = 0; mt < 4; ++mt) { float o[4];
#pragma unroll
                for (int i = 0; i < 4; ++i) o[i] = sigmoidf_(b[i] + acc[mt][nt][i]);
                u32x2 w; w.x = pk2(o[0], o[1]); w.y = pk2(o[2], o[3]); *(u32x2*)(AA + (size_t)(m0 + mt * 16 + fr) * A_W + c) = w; } }
        lora_mm<4, 136>(acc, SG, G2T, c0, fr, fq);
#pragma unroll
        for (int nt = 0; nt < 4; ++nt) { const int c = c0 + nt * 16 + 4 * fq;
#pragma unroll
            for (int mt = 0; mt < 4; ++mt) { u32x2 w; w.x = pk2(acc[mt][nt][0], acc[mt][nt][1]); w.y = pk2(acc[mt][nt][2], acc[mt][nt][3]); *(u32x2*)(GG + (size_t)(m0 + mt * 16 + fr) * A_W + c) = w; } }
        { const int cc = tid & 255, th = tid >> 8; float wv[16];
#pragma unroll
          for (int j = 0; j < 16; ++j) wv[j] = gkw2[j * 256 + cc];
          const float bb = gkb[cc];
          for (int i = 0; i < 32; ++i) { const int tok = th * 32 + i; float sacc = bb;
#pragma unroll
              for (int j = 0; j < 16; ++j) sacc += gkd[tok * 16 + j] * wv[j];
              GK[(size_t)(m0 + tok) * 256 + cc] = (bf16)f2bf(-(fmaxf(-sacc, 0.f) + __logf(1.f + __expf(-fabsf(sacc)))) * (1.f / 16.f)); } }
    }
}

constexpr int CH = 32;
__device__ __forceinline__ float red8(float v) { v = DPP_ADD(v, 0xB1); v = DPP_ADD(v, 0x4E); v = DPP_ADD(v, 0x141); return v; }
__device__ __forceinline__ float red4(float v) { v = DPP_ADD(v, 0xB1); v = DPP_ADD(v, 0x4E); return v; }

constexpr int RW_BUF = 6 * CH * 64;
__device__ __forceinline__ void rw_load(const bf16* p, const bf16* AA, const bf16* WL, int b, int t0, int col, int wave,
        unsigned (&rc)[4], unsigned (&kc)[4], unsigned (&vc)[4], unsigned (&rp)[4], unsigned (&kp)[4], unsigned (&vp)[4], unsigned (&a)[4], unsigned (&wl)[4]) {
#pragma unroll
    for (int q = 0; q < 4; ++q) {
        const int t = t0 + wave + 8 * q; const size_t m = (size_t)b * T + t; const bf16* pr = p + m * NP; const bf16* pp = (t > 0) ? pr - NP : pr;
        rc[q] = pr[C_R + col]; kc[q] = pr[C_K + col]; vc[q] = pr[C_V + col]; rp[q] = pp[C_R + col]; kp[q] = pp[C_K + col]; vp[q] = pp[C_V + col];
        a[q] = AA[m * A_W + col]; wl[q] = WL[m * A_W + col];
    }
}
__device__ __forceinline__ void rw_prep(LAS float* B, int t0, int wave, int lane, float mu_r, float mu_k, float mu_v, float kkc, float kac,
        const unsigned (&rc_)[4], const unsigned (&kc_)[4], const unsigned (&vc_)[4], const unsigned (&rp_)[4], const unsigned (&kp_)[4], const unsigned (&vp_)[4], const unsigned (&a_)[4], const unsigned (&wl_)[4]) {
    LAS float* R = B; LAS float* DEC = R + CH * 64; LAS float* KH = DEC + CH * 64; LAS float* KK = KH + CH * 64; LAS float* BB = KK + CH * 64; LAS float* V = BB + CH * 64;
#pragma unroll
    for (int q = 0; q < 4; ++q) {
        const int tt = wave + 8 * q; const float hp = (t0 + tt > 0) ? 1.f : 0.f;
        const float rc = bf2f(rc_[q]), kc = bf2f(kc_[q]), vc = bf2f(vc_[q]), rp = bf2f(rp_[q]) * hp, kp = bf2f(kp_[q]) * hp, vp = bf2f(vp_[q]) * hp;
        const float r = rc + (rp - rc) * mu_r, k = kc + (kp - kc) * mu_k, v = vc + (vp - vc) * mu_v;
        const float a = bf2f(a_[q]), wl = bf2f(wl_[q]);
        const float kr = k * kkc; const float nrm = sqrtf(wave_sum(kr * kr)); const float kk = kr / fmaxf(nrm, 1e-12f);
        const float kh = k * (1.f + (a - 1.f) * kac);
        R[tt * 64 + lane] = r; DEC[tt * 64 + lane] = __expf(wl); KH[tt * 64 + lane] = kh; KK[tt * 64 + lane] = kk; BB[tt * 64 + lane] = kk * a; V[tt * 64 + lane] = v;
    }
}
struct RwOps { f32x4 k0, k1, d0, d1, b0, b1, h0, h1, q0, q1; float v0, v1; };
__device__ __forceinline__ void rw_ops_load(RwOps& o, const LAS float* B, int tt, int s8, int vr0) {
    const LAS float* R = B; const LAS float* DEC = R + CH * 64; const LAS float* KH = DEC + CH * 64; const LAS float* KK = KH + CH * 64; const LAS float* BB = KK + CH * 64; const LAS float* V = BB + CH * 64;
    o.k0 = *(const LAS f32x4*)(KK + tt * 64 + s8); o.k1 = *(const LAS f32x4*)(KK + tt * 64 + s8 + 4);
    o.d0 = *(const LAS f32x4*)(DEC + tt * 64 + s8); o.d1 = *(const LAS f32x4*)(DEC + tt * 64 + s8 + 4);
    o.b0 = *(const LAS f32x4*)(BB + tt * 64 + s8); o.b1 = *(const LAS f32x4*)(BB + tt * 64 + s8 + 4);
    o.h0 = *(const LAS f32x4*)(KH + tt * 64 + s8); o.h1 = *(const LAS f32x4*)(KH + tt * 64 + s8 + 4);
    o.q0 = *(const LAS f32x4*)(R + tt * 64 + s8); o.q1 = *(const LAS f32x4*)(R + tt * 64 + s8 + 4);
    o.v0 = V[tt * 64 + vr0]; o.v1 = V[tt * 64 + vr0 + 1];
}
template <bool IDENT> __device__ __forceinline__ void rw_step(const RwOps& o, f32x2 (&S0)[4], f32x2 (&S1)[4], LAS float* Y, int tt, int r0, int lane) {
    const float vv0 = o.v0, vv1 = o.v1;
    const f32x2 kk[4] = {o.k0.lo, o.k0.hi, o.k1.lo, o.k1.hi}, dd[4] = {o.d0.lo, o.d0.hi, o.d1.lo, o.d1.hi}, bb[4] = {o.b0.lo, o.b0.hi, o.b1.lo, o.b1.hi}, hh[4] = {o.h0.lo, o.h0.hi, o.h1.lo, o.h1.hi}, rr[4] = {o.q0.lo, o.q0.hi, o.q1.lo, o.q1.hi};
    f32x2 a0 = S0[0] * kk[0], a1 = S1[0] * kk[0];
#pragma unroll
    for (int i = 1; i < 4; ++i) { a0 = S0[i] * kk[i] + a0; a1 = S1[i] * kk[i] + a1; }
    const float sa0 = -red8(a0.x + a0.y), sa1 = -red8(a1.x + a1.y);
    f32x2 y0 = (f32x2){0.f, 0.f}, y1 = (f32x2){0.f, 0.f};
#pragma unroll
    for (int i = 0; i < 4; ++i) {
        if (IDENT) { S0[i] = bb[i] * sa0 + S0[i] * dd[i]; S1[i] = bb[i] * sa1 + S1[i] * dd[i]; }
        else { S0[i] = hh[i] * vv0 + (bb[i] * sa0 + S0[i] * dd[i]); S1[i] = hh[i] * vv1 + (bb[i] * sa1 + S1[i] * dd[i]); }
        y0 = S0[i] * rr[i] + y0; y1 = S1[i] * rr[i] + y1;
    }
    const float yy0 = red8(y0.x + y0.y), yy1 = red8(y1.x + y1.y);
    if ((lane & 7) == 0) { Y[tt * 128 + r0] = yy0; Y[tt * 128 + r0 + 1] = yy1; }
}
struct GlOps { f32x4 k0, k1, d0, d1, q0, q1; float v0, v1; };
__device__ __forceinline__ void gl_ops_load(GlOps& o, const LAS float* B, int tt, int s8, int r0) {
    const LAS float* Q = B; const LAS float* K = Q + CH * 64; const LAS float* DEC = K + CH * 64; const LAS float* V = DEC + CH * 64;
    o.k0 = *(const LAS f32x4*)(K + tt * 64 + s8); o.k1 = *(const LAS f32x4*)(K + tt * 64 + s8 + 4);
    o.d0 = *(const LAS f32x4*)(DEC + tt * 64 + s8); o.d1 = *(const LAS f32x4*)(DEC + tt * 64 + s8 + 4);
    o.q0 = *(const LAS f32x4*)(Q + tt * 64 + s8); o.q1 = *(const LAS f32x4*)(Q + tt * 64 + s8 + 4);
    o.v0 = V[tt * 128 + r0]; o.v1 = V[tt * 128 + r0 + 1];
}
__device__ __forceinline__ void gl_step(const GlOps& o, f32x2 (&S0)[4], f32x2 (&S1)[4], f32x2 (&c)[4], LAS float* O, LAS float* YL, int tt, int r0, int s8, int lane, int wave) {
    const f32x2 kk[4] = {o.k0.lo, o.k0.hi, o.k1.lo, o.k1.hi}, dd[4] = {o.d0.lo, o.d0.hi, o.d1.lo, o.d1.hi}, qq[4] = {o.q0.lo, o.q0.hi, o.q1.lo, o.q1.hi};
    f32x2 y0 = (f32x2){0.f, 0.f}, y1 = (f32x2){0.f, 0.f};
#pragma unroll
    for (int i = 0; i < 4; ++i) {
        S0[i] = kk[i] * o.v0 + S0[i] * dd[i]; S1[i] = kk[i] * o.v1 + S1[i] * dd[i];
        y0 = S0[i] * qq[i] + y0; y1 = S1[i] * qq[i] + y1;
    }
    if (wave == 0) {
#pragma unroll
        for (int i = 0; i < 4; ++i) c[i] = c[i] * dd[i];
        if (lane < 8) { const f32x2 e0 = c[0] * qq[0], e1 = c[1] * qq[1], e2 = c[2] * qq[2], e3 = c[3] * qq[3];
            *(LAS f32x4*)(YL + tt * 64 + s8) = (f32x4){e0.x, e0.y, e1.x, e1.y}; *(LAS f32x4*)(YL + tt * 64 + s8 + 4) = (f32x4){e2.x, e2.y, e3.x, e3.y}; }
    }
    const float o0 = red8(y0.x + y0.y), o1 = red8(y1.x + y1.y);
    if ((lane & 7) == 0) { O[tt * 128 + r0] = o0; O[tt * 128 + r0 + 1] = o1; }
}
__device__ __forceinline__ void rwkv_item(const Params& P, LAS unsigned char* lds, int b, int h, int seg) {
    const int tid = threadIdx.x, lane = tid & 63, wave = tid >> 6;
    unsigned char* ws = P.ws;
    const bf16* p = (const bf16*)(ws + WS_P); const bf16* WL = (const bf16*)(ws + WS_WL); const bf16* AA = (const bf16*)(ws + WS_AA);
    bf16* MIX = (bf16*)(ws + WS_MIX); bf16* YI = (bf16*)(ws + WS_YI);
    const float* mu = P.in[4]; const float* k_k = P.in[10]; const float* k_a = P.in[11];
    LAS float* BUF = (LAS float*)lds; LAS float* Y = BUF + 2 * RW_BUF;
    const int col = h * 64 + lane;
    const float mu_r = mu[C_R + col], mu_k = mu[C_K + col], mu_v = mu[C_V + col], kkc = k_k[col], kac = k_a[col];
    const int r0 = wave * 16 + 2 * (lane >> 3), s8 = (lane & 7) * 8; const int ident = r0 >> 6, vr0 = r0 & 63, vr1 = vr0 + 1;
    float* SE = (float*)(ws + WS_SER) + ((((size_t)(b * 8 + h) * NSEG + seg) * 2 + ident) * 4096) + vr0 * 64 + s8;
    f32x2 S0[4], S1[4];
#pragma unroll
    for (int i = 0; i < 4; ++i) { S0[i] = (f32x2){(ident && (s8 + 2 * i == vr0)) ? 1.f : 0.f, (ident && (s8 + 2 * i + 1 == vr0)) ? 1.f : 0.f};
        S1[i] = (f32x2){(ident && (s8 + 2 * i == vr1)) ? 1.f : 0.f, (ident && (s8 + 2 * i + 1 == vr1)) ? 1.f : 0.f}; }
    const float vmask = ident ? 0.f : 1.f;
    const int tbeg = seg * LSEG;
    unsigned rc[4], kc[4], vc[4], rp[4], kp[4], vp[4], a[4], wl[4];
    __syncthreads();
    rw_load(p, AA, WL, b, tbeg, col, wave, rc, kc, vc, rp, kp, vp, a, wl);
    rw_prep(BUF, tbeg, wave, lane, mu_r, mu_k, mu_v, kkc, kac, rc, kc, vc, rp, kp, vp, a, wl);
    __syncthreads();
    for (int ci = 0; ci < LSEG / CH; ++ci) {
        const int t0 = tbeg + ci * CH; LAS float* B = BUF + (ci & 1) * RW_BUF;
        LAS float* R = B; LAS float* DEC = R + CH * 64; LAS float* KH = DEC + CH * 64; LAS float* KK = KH + CH * 64; LAS float* BB = KK + CH * 64; LAS float* V = BB + CH * 64;
        const bool more = (ci + 1 < LSEG / CH);
        if (more) rw_load(p, AA, WL, b, t0 + CH, col, wave, rc, kc, vc, rp, kp, vp, a, wl);
        { RwOps oa, ob; rw_ops_load(oa, B, 0, s8, vr0);
          if (ident) for (int tt = 0; tt < CH; tt += 2) {
              rw_ops_load(ob, B, tt + 1, s8, vr0); rw_step<true>(oa, S0, S1, Y, tt, r0, lane);
              rw_ops_load(oa, B, (tt + 2) & (CH - 1), s8, vr0); rw_step<true>(ob, S0, S1, Y, tt + 1, r0, lane);
          } else for (int tt = 0; tt < CH; tt += 2) {
              rw_ops_load(ob, B, tt + 1, s8, vr0); rw_step<false>(oa, S0, S1, Y, tt, r0, lane);
              rw_ops_load(oa, B, (tt + 2) & (CH - 1), s8, vr0); rw_step<false>(ob, S0, S1, Y, tt + 1, r0, lane);
          } }
        __syncthreads();
        if (more) rw_prep(BUF + ((ci + 1) & 1) * RW_BUF, t0 + CH, wave, lane, mu_r, mu_k, mu_v, kkc, kac, rc, kc, vc, rp, kp, vp, a, wl);
#pragma unroll
        for (int q = 0; q < 4; ++q) {
            const int tt = wave + 8 * q; const size_t m = (size_t)b * T + t0 + tt;
            MIX[m * D + col] = (bf16)f2bf(Y[tt * 128 + lane]); YI[m * 512 + col] = (bf16)f2bf(Y[tt * 128 + 64 + lane]);
        }
        __syncthreads();
    }
    *(f32x4*)(SE) = (f32x4){S0[0].x, S0[0].y, S0[1].x, S0[1].y}; *(f32x4*)(SE + 4) = (f32x4){S0[2].x, S0[2].y, S0[3].x, S0[3].y};
    *(f32x4*)(SE + 64) = (f32x4){S1[0].x, S1[0].y, S1[1].x, S1[1].y}; *(f32x4*)(SE + 68) = (f32x4){S1[2].x, S1[2].y, S1[3].x, S1[3].y};
}

constexpr int GL_BUF = 3 * CH * 64 + CH * 128;
__device__ __forceinline__ void gl_load(const bf16* p, const bf16* GK, int b, int h, int t0, int lane, int wave, unsigned (&x)[4][4][4], unsigned (&gk)[4]) {
    const int cq = h * 64 + lane, ck = 256 + h * 64 + lane, cv0 = 512 + h * 128 + lane, cv1 = cv0 + 64;
#pragma unroll
    for (int q = 0; q < 4; ++q) {
        const int t = t0 + wave + 8 * q; const size_t m = (size_t)b * T + t;
#pragma unroll
        for (int j = 0; j < 4; ++j) { const int back = 3 - j; const bf16* pr = p + (m - (size_t)((t >= back) ? back : 0)) * NP + C_BQ;
            x[q][j][0] = pr[cq]; x[q][j][1] = pr[ck]; x[q][j][2] = pr[cv0]; x[q][j][3] = pr[cv1]; }
        gk[q] = GK[m * 256 + h * 64 + lane];
    }
}
__device__ __forceinline__ void gl_prep(LAS float* B, int t0, int wave, int lane, const float (&wq)[4], const float (&wk)[4], const float (&wv0)[4], const float (&wv1)[4],
        const unsigned (&x)[4][4][4], const unsigned (&gk)[4]) {
    LAS float* Q = B; LAS float* K = Q + CH * 64; LAS float* DEC = K + CH * 64; LAS float* V = DEC + CH * 64;
#pragma unroll
    for (int q = 0; q < 4; ++q) {
        const int tt = wave + 8 * q, t = t0 + tt; float aq = 0.f, ak = 0.f, av0 = 0.f, av1 = 0.f;
#pragma unroll
        for (int j = 0; j < 4; ++j) { const float ok = (t >= 3 - j) ? 1.f : 0.f;
            aq += wq[j] * ok * bf2f(x[q][j][0]); ak += wk[j] * ok * bf2f(x[q][j][1]); av0 += wv0[j] * ok * bf2f(x[q][j][2]); av1 += wv1[j] * ok * bf2f(x[q][j][3]); }
        Q[tt * 64 + lane] = siluf_(aq) * 0.125f; K[tt * 64 + lane] = siluf_(ak); V[tt * 128 + lane] = siluf_(av0); V[tt * 128 + 64 + lane] = siluf_(av1);
        DEC[tt * 64 + lane] = __expf(bf2f(gk[q]));
    }
}
constexpr int GQ = 0, GK_ = GQ + 64 * 72, GD = GK_ + 64 * 72, GV = GD + 64 * 72, GA = GV + 128 * 72, GS = GA + 64 * 72, GEND = GS + 128 * 72;
__device__ __forceinline__ unsigned pk2f(float a, float b) { return pk2(a, b); }
__device__ __forceinline__ void gla_item(const Params& P, LAS unsigned char* lds, int b, int h, int seg) {
    const int tid = threadIdx.x, lane = tid & 63, wave = __builtin_amdgcn_readfirstlane(tid >> 6), fr = lane & 15, fq = lane >> 4;
    unsigned char* ws = P.ws;
    const bf16* p = (const bf16*)(ws + WS_P); bf16* GKB = (bf16*)(ws + WS_GK);
    bf16* MIX = (bf16*)(ws + WS_MIX);
    float* SE = (float*)(ws + WS_SEG) + ((size_t)(b * 4 + h) * NSEG + seg) * 8192; float* CE = (float*)(ws + WS_CEND) + ((size_t)(b * 4 + h) * NSEG + seg) * 64;
    const float* conv = P.in[15];
    LAS bf16* L = (LAS bf16*)lds; LAS bf16* QT = L + GQ; LAS bf16* KT = L + GK_; LAS bf16* KD = L + GD; LAS bf16* VT = L + GV; LAS bf16* AT = L + GA; LAS bf16* ST = L + GS;
    LAS float* GAM = (LAS float*)(lds + GEND * 2); LAS float* TOT = GAM + 64;
    const int ch = lane, tg = wave;
    const int cq = h * 64 + ch, ck = 256 + h * 64 + ch, cv0 = 512 + h * 128 + ch, cv1 = cv0 + 64;
    float wq[4], wk[4], wv0[4], wv1[4];
#pragma unroll
    for (int j = 0; j < 4; ++j) { wq[j] = conv[j * 1024 + cq]; wk[j] = conv[j * 1024 + ck]; wv0[j] = conv[j * 1024 + cv0]; wv1[j] = conv[j * 1024 + cv1]; }
    float gseg = 0.f;
    f32x4 Sacc[4];
#pragma unroll
    for (int k = 0; k < 4; ++k) Sacc[k] = (f32x4){0.f, 0.f, 0.f, 0.f};
    __syncthreads();
    for (int i = tid; i < 128 * 72 / 2; i += NTHR) ((LAS unsigned*)ST)[i] = 0u;
    for (int c = 0; c < LSEG / 64; ++c) {
        const int t0 = seg * LSEG + c * 64;
        __syncthreads();
        float xq[11], xk[11], xa[11], xb[11], g[8];
#pragma unroll
        for (int r = 0; r < 11; ++r) { const int t = t0 + 8 * tg - 3 + r; const size_t m = (size_t)b * T + (t > 0 ? t : 0); const float ok = (t >= 0) ? 1.f : 0.f; const bf16* pr = p + m * NP + C_BQ;
            xq[r] = bf2f(pr[cq]) * ok; xk[r] = bf2f(pr[ck]) * ok; xa[r] = bf2f(pr[cv0]) * ok; xb[r] = bf2f(pr[cv1]) * ok; }
#pragma unroll
        for (int i = 0; i < 8; ++i) g[i] = bf2f(GKB[((size_t)b * T + t0 + 8 * tg + i) * 256 + h * 64 + ch]);
#pragma unroll
        for (int i = 1; i < 8; ++i) g[i] += g[i - 1];
        TOT[tg * 64 + ch] = g[7];
        __syncthreads();
        float off = 0.f, total = 0.f;
#pragma unroll
        for (int w = 0; w < 8; ++w) { const float tv = TOT[w * 64 + ch]; total += tv; off += (w < tg) ? tv : 0.f; }
        float kd[8], va[8], vb[8];
#pragma unroll
        for (int i = 0; i < 8; ++i) {
            float aq = 0.f, ak = 0.f, a0 = 0.f, a1 = 0.f;
#pragma unroll
            for (int j = 0; j < 4; ++j) { aq += wq[j] * xq[i + j]; ak += wk[j] * xk[i + j]; a0 += wv0[j] * xa[i + j]; a1 += wv1[j] * xb[i + j]; }
            const float q = siluf_(aq) * 0.125f, k = siluf_(ak), Gc = off + g[i];
            QT[(8 * tg + i) * 72 + ch] = (bf16)f2bf(q * __expf(Gc)); KT[(8 * tg + i) * 72 + ch] = (bf16)f2bf(k * __expf(-Gc));
            kd[i] = k * __expf(total - Gc); va[i] = siluf_(a0); vb[i] = siluf_(a1);
            GKB[((size_t)b * T + t0 + 8 * tg + i) * 256 + h * 64 + ch] = (bf16)f2bf(q * __expf(gseg + Gc));
        }
        { u32x4 w; w.x = pk2f(kd[0], kd[1]); w.y = pk2f(kd[2], kd[3]); w.z = pk2f(kd[4], kd[5]); w.w = pk2f(kd[6], kd[7]); *(LAS u32x4*)(KD + ch * 72 + 8 * tg) = w;
          w.x = pk2f(va[0], va[1]); w.y = pk2f(va[2], va[3]); w.z = pk2f(va[4], va[5]); w.w = pk2f(va[6], va[7]); *(LAS u32x4*)(VT + ch * 72 + 8 * tg) = w;
          w.x = pk2f(vb[0], vb[1]); w.y = pk2f(vb[2], vb[3]); w.z = pk2f(vb[4], vb[5]); w.w = pk2f(vb[6], vb[7]); *(LAS u32x4*)(VT + (64 + ch) * 72 + 8 * tg) = w; }
        if (tg == 0) GAM[ch] = __expf(total);
        gseg += total;
        __syncthreads();
#pragma unroll
        for (int k2 = 0; k2 < 2; ++k2) { const int tile = wave * 2 + k2, jt = tile >> 2, it = tile & 3; f32x4 acc = (f32x4){0.f, 0.f, 0.f, 0.f};
            if (jt <= it) {
#pragma unroll
                for (int sx = 0; sx < 2; ++sx) acc = __builtin_amdgcn_mfma_f32_16x16x32_bf16(*(const LAS bf16x8_t*)(KT + (jt * 16 + fr) * 72 + 32 * sx + 8 * fq), *(const LAS bf16x8_t*)(QT + (it * 16 + fr) * 72 + 32 * sx + 8 * fq), acc, 0, 0, 0);
            }
            const int ii = it * 16 + fr, j0 = jt * 16 + 4 * fq; u32x2 w;
            w.x = pk2f(j0 <= ii ? acc[0] : 0.f, j0 + 1 <= ii ? acc[1] : 0.f); w.y = pk2f(j0 + 2 <= ii ? acc[2] : 0.f, j0 + 3 <= ii ? acc[3] : 0.f);
            *(LAS u32x2*)(AT + ii * 72 + j0) = w; }
        __syncthreads();
        { const int it = wave & 3, vts = (wave >> 2) * 4; f32x4 oacc[4];
#pragma unroll
          for (int k = 0; k < 4; ++k) oacc[k] = (f32x4){0.f, 0.f, 0.f, 0.f};
#pragma unroll
          for (int sx = 0; sx < 2; ++sx) { const bf16x8_t aA = *(const LAS bf16x8_t*)(AT + (it * 16 + fr) * 72 + 32 * sx + 8 * fq), aQ = *(const LAS bf16x8_t*)(QT + (it * 16 + fr) * 72 + 32 * sx + 8 * fq);
#pragma unroll
              for (int k = 0; k < 4; ++k) { const int vrow = 8 * fr + vts + k;
                  oacc[k] = __builtin_amdgcn_mfma_f32_16x16x32_bf16(aA, *(const LAS bf16x8_t*)(VT + vrow * 72 + 32 * sx + 8 * fq), oacc[k], 0, 0, 0);
                  oacc[k] = __builtin_amdgcn_mfma_f32_16x16x32_bf16(aQ, *(const LAS bf16x8_t*)(ST + vrow * 72 + 32 * sx + 8 * fq), oacc[k], 0, 0, 0); } }
#pragma unroll
          for (int rg = 0; rg < 4; ++rg) { const size_t m = (size_t)b * T + t0 + it * 16 + 4 * fq + rg; u32x2 w; w.x = pk2f(oacc[0][rg], oacc[1][rg]); w.y = pk2f(oacc[2][rg], oacc[3][rg]);
              *(u32x2*)(MIX + m * D + 512 + h * 128 + 8 * fr + vts) = w; } }
#pragma unroll
        for (int k = 0; k < 4; ++k) { f32x4 acc = Sacc[k] * GAM[k * 16 + fr];
#pragma unroll
            for (int sx = 0; sx < 2; ++sx) acc = __builtin_amdgcn_mfma_f32_16x16x32_bf16(*(const LAS bf16x8_t*)(VT + (wave * 16 + fr) * 72 + 32 * sx + 8 * fq), *(const LAS bf16x8_t*)(KD + (k * 16 + fr) * 72 + 32 * sx + 8 * fq), acc, 0, 0, 0);
            Sacc[k] = acc; }
        __syncthreads();
#pragma unroll
        for (int k = 0; k < 4; ++k)
#pragma unroll
            for (int rg = 0; rg < 4; ++rg) ST[(wave * 16 + 4 * fq + rg) * 72 + k * 16 + fr] = (bf16)f2bf(Sacc[k][rg]);
    }
#pragma unroll
    for (int k = 0; k < 4; ++k)
#pragma unroll
        for (int rg = 0; rg < 4; ++rg) SE[(wave * 16 + 4 * fq + rg) * 64 + k * 16 + fr] = Sacc[k][rg];
    if (tg == 0) CE[ch] = __expf(gseg);
}
__device__ __forceinline__ void phase_scan(const Params& P, LAS unsigned char* lds) {
    for (int it = blockIdx.x; it < 512 + 256; it += gridDim.x) {
        if (it < 512) { const int bh = it >> 4; rwkv_item(P, lds, bh >> 3, bh & 7, it & 15); }
        else { const int g = it - 512, bh = g >> 4; gla_item(P, lds, bh >> 2, bh & 3, g & 15); }
        __syncthreads();
    }
}
__device__ __forceinline__ void phase_fixup(const Params& P, LAS unsigned char* lds) {
    const int tid = threadIdx.x;
    for (int it = blockIdx.x; it < 48; it += gridDim.x) {
        if (it < 32) {
            float* SE = (float*)(P.ws + WS_SER) + (size_t)it * NSEG * 2 * 4096;
            LAS float* Sc = (LAS float*)lds; LAS float* Ph = Sc + 64 * 65;
            const int v = tid >> 3, kq = (tid & 7) * 8;
            __syncthreads();
            for (int i = tid; i < 64 * 65; i += NTHR) Sc[i] = 0.f;
            f32x4 pf0 = *(const f32x4*)(SE + 4096 + 4 * tid), pf1 = *(const f32x4*)(SE + 4096 + 4 * (tid + NTHR));
            f32x4 a0 = *(const f32x4*)(SE + v * 64 + kq), a1 = *(const f32x4*)(SE + v * 64 + kq + 4);
            for (int seg = 0; seg < NSEG - 1; ++seg) {
                float* s0 = SE + (size_t)(seg * 2 + 0) * 4096;
                __syncthreads();
                *(LAS f32x4*)(Ph + 4 * tid) = pf0; *(LAS f32x4*)(Ph + 4 * (tid + NTHR)) = pf1;
                f32x4 c0 = a0, c1 = a1;
                if (seg + 1 < NSEG - 1) { const float* nx = SE + (size_t)((seg + 1) * 2) * 4096; pf0 = *(const f32x4*)(nx + 4096 + 4 * tid); pf1 = *(const f32x4*)(nx + 4096 + 4 * (tid + NTHR)); a0 = *(const f32x4*)(nx + v * 64 + kq); a1 = *(const f32x4*)(nx + v * 64 + kq + 4); }
                __syncthreads();
                for (int j = 0; j < 64; ++j) { const float sv = Sc[v * 65 + j]; c0 += *(const LAS f32x4*)(Ph + j * 64 + kq) * sv; c1 += *(const LAS f32x4*)(Ph + j * 64 + kq + 4) * sv; }
                __syncthreads();
#pragma unroll
                for (int i = 0; i < 4; ++i) { Sc[v * 65 + kq + i] = c0[i]; Sc[v * 65 + kq + 4 + i] = c1[i]; }
                *(f32x4*)(s0 + v * 64 + kq) = c0; *(f32x4*)(s0 + v * 64 + kq + 4) = c1;
            }
        } else {
            const int bh = it - 32; float* SE = (float*)(P.ws + WS_SEG) + (size_t)bh * NSEG * 8192; const float* CE = (const float*)(P.ws + WS_CEND) + (size_t)bh * NSEG * 64;
            const int v = tid >> 2, d0 = (tid & 3) * 16; f32x4 sc[4];
#pragma unroll
            for (int q = 0; q < 4; ++q) sc[q] = (f32x4){0.f, 0.f, 0.f, 0.f};
            for (int seg = 0; seg < NSEG - 1; ++seg) {
#pragma unroll
                for (int q = 0; q < 4; ++q) { float* sp = SE + (size_t)seg * 8192 + v * 64 + d0 + 4 * q; sc[q] = sc[q] * *(const f32x4*)(CE + seg * 64 + d0 + 4 * q) + *(const f32x4*)sp; *(f32x4*)sp = sc[q]; }
            }
        }
    }
}
__device__ __forceinline__ float row_sum16(float v) { v = DPP_ADD(v, 0xB1); v = DPP_ADD(v, 0x4E); v = DPP_ADD(v, 0x141); v = DPP_ADD(v, 0x140); return v; }
__device__ __forceinline__ bf16x8_t pack_bf16x8(const f32x4 a, const f32x4 b) {
    u32x4 w; w.x = pk2(a[0], a[1]); w.y = pk2(a[2], a[3]); w.z = pk2(b[0], b[1]); w.w = pk2(b[2], b[3]); return __builtin_bit_cast(bf16x8_t, w);
}
__device__ __forceinline__ void unpack4(const u32x2 w, float (&o)[4]) { o[0] = __uint_as_float(w.x << 16); o[1] = __uint_as_float(w.x & 0xffff0000u); o[2] = __uint_as_float(w.y << 16); o[3] = __uint_as_float(w.y & 0xffff0000u); }
__device__ __forceinline__ void phase_correct(const Params& P, LAS unsigned char* lds) {
    const int tid = threadIdx.x, lane = tid & 63, wave = __builtin_amdgcn_readfirstlane(tid >> 6), fr = lane & 15, fq = lane >> 4;
    unsigned char* ws = P.ws;
    const bf16* p = (const bf16*)(ws + WS_P); const bf16* AA = (const bf16*)(ws + WS_AA); const bf16* GG = (const bf16*)(ws + WS_GG);
    bf16* MIX = (bf16*)(ws + WS_MIX); const bf16* YI = (const bf16*)(ws + WS_YI); const bf16* YIG = (const bf16*)(ws + WS_YIG);
    const float* mu = P.in[4]; const float* k_a = P.in[11]; const float* r_k = P.in[12]; const float* gn_g = P.in[13]; const float* gn_b = P.in[14]; const float* norm_g = P.in[18];
    LAS bf16* SB = (LAS bf16*)lds;
    for (int it = blockIdx.x; it < 512; it += gridDim.x) {
        {
            const int seg = it & 15, bh = it >> 4, b = bh >> 3, h = bh & 7;
            const int cb = h * 64 + 4 * fr;
            __syncthreads();
            if (seg > 0) { const float* ss = (const float*)(ws + WS_SER) + (((size_t)bh * NSEG + (seg - 1)) * 2) * 4096;
                for (int i = tid; i < 1024; i += NTHR) { const f32x4 x = *(const f32x4*)(ss + 4 * i); const int v = i >> 4, j = (4 * i) & 63; u32x2 w; w.x = pk2(x[0], x[1]); w.y = pk2(x[2], x[3]);
                    *(LAS u32x2*)(SB + ((v & 3) * 16 + (v >> 2)) * 72 + j) = w; } }
            __syncthreads();
            const f32x4 mur = *(const f32x4*)(mu + C_R + cb), muk = *(const f32x4*)(mu + C_K + cb), muv = *(const f32x4*)(mu + C_V + cb), kac = *(const f32x4*)(k_a + cb), rkc = *(const f32x4*)(r_k + cb), gng = *(const f32x4*)(gn_g + cb), gnb = *(const f32x4*)(gn_b + cb);
            for (int mt = 0; mt < 4; ++mt) {
                const int tb = seg * LSEG + wave * 64 + mt * 16;
                f32x4 acc[4];
#pragma unroll
                for (int vt = 0; vt < 4; ++vt) acc[vt] = (f32x4){0.f, 0.f, 0.f, 0.f};
                if (seg > 0) {
#pragma unroll
                    for (int sx = 0; sx < 2; ++sx) { const bf16x8_t af = *(const bf16x8_t*)(YI + ((size_t)b * T + tb + fr) * 512 + h * 64 + 32 * sx + 8 * fq);
#pragma unroll
                        for (int vt = 0; vt < 4; ++vt) acc[vt] = __builtin_amdgcn_mfma_f32_16x16x32_bf16(af, *(const LAS bf16x8_t*)(SB + (vt * 16 + fr) * 72 + 32 * sx + 8 * fq), acc[vt], 0, 0, 0); }
                }
                u32x2 W[2][9];
#define CORR_LOAD(buf, rg) do { const int t_ = tb + 4 * fq + (rg); const size_t m_ = (size_t)b * T + t_; const bf16* pr_ = p + m_ * NP + cb; const bf16* pp_ = (t_ > 0) ? pr_ - NP : pr_; \
                    W[buf][0] = *(const u32x2*)(MIX + m_ * D + cb); W[buf][1] = *(const u32x2*)(pr_ + C_R); W[buf][2] = *(const u32x2*)(pr_ + C_K); W[buf][3] = *(const u32x2*)(pr_ + C_V); \
                    W[buf][4] = *(const u32x2*)(pp_ + C_R); W[buf][5] = *(const u32x2*)(pp_ + C_K); W[buf][6] = *(const u32x2*)(pp_ + C_V); W[buf][7] = *(const u32x2*)(AA + m_ * A_W + cb); W[buf][8] = *(const u32x2*)(GG + m_ * A_W + cb); } while (0)
                CORR_LOAD(0, 0);
#pragma unroll
                for (int rg = 0; rg < 4; ++rg) { const int t = tb + 4 * fq + rg; const size_t m = (size_t)b * T + t; const float hp = (t > 0) ? 1.f : 0.f;
                    if (rg < 3) CORR_LOAD((rg + 1) & 1, rg + 1);
                    __builtin_amdgcn_sched_barrier(0);
                    float y[4], rc[4], kc[4], vc[4], rp_[4], kp[4], vp[4], a[4], g[4];
                    unpack4(W[rg & 1][0], y); unpack4(W[rg & 1][1], rc); unpack4(W[rg & 1][2], kc); unpack4(W[rg & 1][3], vc); unpack4(W[rg & 1][4], rp_); unpack4(W[rg & 1][5], kp); unpack4(W[rg & 1][6], vp); unpack4(W[rg & 1][7], a); unpack4(W[rg & 1][8], g);
                    float v[4], sy = 0.f, sb = 0.f;
#pragma unroll
                    for (int i = 0; i < 4; ++i) { y[i] += acc[i][rg];
                        const float r = rc[i] + (rp_[i] * hp - rc[i]) * mur[i], k = kc[i] + (kp[i] * hp - kc[i]) * muk[i]; v[i] = vc[i] + (vp[i] * hp - vc[i]) * muv[i];
                        const float kh = k * (1.f + (a[i] - 1.f) * kac[i]); sb += r * kh * rkc[i]; sy += y[i]; }
                    const float bon = row_sum16(sb), mean = row_sum16(sy) * (1.f / 64.f); float sq = 0.f;
#pragma unroll
                    for (int i = 0; i < 4; ++i) { y[i] -= mean; sq += y[i] * y[i]; }
                    const float rstd = 1.f / sqrtf(row_sum16(sq) * (1.f / 64.f) + GN_EPS); float o[4];
#pragma unroll
                    for (int i = 0; i < 4; ++i) o[i] = (y[i] * rstd * gng[i] + gnb[i] + bon * v[i]) * g[i];
                    u32x2 w; w.x = pk2(o[0], o[1]); w.y = pk2(o[2], o[3]); *(u32x2*)(MIX + m * D + cb) = w;
                    __builtin_amdgcn_sched_barrier(0); }
#undef CORR_LOAD
            }
        }
    }
    for (int g_ = blockIdx.x; g_ < 256; g_ += gridDim.x) {
        {
            const int seg = g_ & 15, bh = g_ >> 4, b = bh >> 2, h = bh & 3;
            const int cb = h * 128 + 8 * fr;
            __syncthreads();
            if (seg > 0) { const float* ss = (const float*)(ws + WS_SEG) + ((size_t)bh * NSEG + (seg - 1)) * 8192;
                for (int i = tid; i < 2048; i += NTHR) { const f32x4 x = *(const f32x4*)(ss + 4 * i); const int v = i >> 4, j = (4 * i) & 63; u32x2 w; w.x = pk2(x[0], x[1]); w.y = pk2(x[2], x[3]);
                    *(LAS u32x2*)(SB + ((v & 7) * 16 + (v >> 3)) * 72 + j) = w; } }
            __syncthreads();
            const f32x4 ng0 = *(const f32x4*)(norm_g + 8 * fr), ng1 = *(const f32x4*)(norm_g + 8 * fr + 4);
            for (int mt = 0; mt < 4; ++mt) {
                const int tb = seg * LSEG + wave * 64 + mt * 16;
                f32x4 acc[8];
#pragma unroll
                for (int vt = 0; vt < 8; ++vt) acc[vt] = (f32x4){0.f, 0.f, 0.f, 0.f};
                if (seg > 0) {
#pragma unroll
                    for (int sx = 0; sx < 2; ++sx) { const bf16x8_t af = *(const bf16x8_t*)(YIG + ((size_t)b * T + tb + fr) * 256 + h * 64 + 32 * sx + 8 * fq);
#pragma unroll
                        for (int vt = 0; vt < 8; ++vt) acc[vt] = __builtin_amdgcn_mfma_f32_16x16x32_bf16(af, *(const LAS bf16x8_t*)(SB + (vt * 16 + fr) * 72 + 32 * sx + 8 * fq), acc[vt], 0, 0, 0); }
                }
                u32x4 WG[2][2];
#define CORG_LOAD(buf, rg) do { const size_t m_ = (size_t)b * T + tb + 4 * fq + (rg); WG[buf][0] = *(const u32x4*)(MIX + m_ * D + 512 + cb); WG[buf][1] = *(const u32x4*)(p + m_ * NP + C_BG + cb); } while (0)
                CORG_LOAD(0, 0);
#pragma unroll
                for (int rg = 0; rg < 4; ++rg) { const size_t m = (size_t)b * T + tb + 4 * fq + rg;
                    if (rg < 3) CORG_LOAD((rg + 1) & 1, rg + 1);
                    __builtin_amdgcn_sched_barrier(0);
                    float o[8], g[8]; float sq = 0.f;
#pragma unroll
                    for (int i = 0; i < 4; ++i) { const unsigned a_ = WG[rg & 1][0][i], b_ = WG[rg & 1][1][i]; o[2 * i] = __uint_as_float(a_ << 16); o[2 * i + 1] = __uint_as_float(a_ & 0xffff0000u); g[2 * i] = __uint_as_float(b_ << 16); g[2 * i + 1] = __uint_as_float(b_ & 0xffff0000u); }
#pragma unroll
                    for (int i = 0; i < 8; ++i) { o[i] += acc[i][rg]; sq += o[i] * o[i]; }
                    const float rs = 1.f / sqrtf(row_sum16(sq) * (1.f / 128.f) + RMS_EPS);
                    float f[8];
#pragma unroll
                    for (int i = 0; i < 8; ++i) f[i] = o[i] * rs * (i < 4 ? ng0[i & 3] : ng1[i & 3]) * siluf_(g[i]);
                    u32x4 w; w.x = pk2(f[0], f[1]); w.y = pk2(f[2], f[3]); w.z = pk2(f[4], f[5]); w.w = pk2(f[6], f[7]); *(u32x4*)(MIX + m * D + 512 + cb) = w;
                    __builtin_amdgcn_sched_barrier(0); }
#undef CORG_LOAD
            }
        }
    }
}

__device__ __forceinline__ void phase_ln1(const Params& P) {
    const int lane = threadIdx.x & 63, wave = threadIdx.x >> 6; const int gw = blockIdx.x * NWAVES + wave, ngw = gridDim.x * NWAVES;
    for (int m = gw; m < M; m += ngw) ln_rowb_bf16((const bf16*)(P.ws + WS_Z) + (size_t)m * D, P.in[20], P.in[21], (bf16*)(P.ws + WS_H1) + (size_t)m * D, lane);
#pragma unroll
    for (int tb = 0; tb < 2; ++tb) {
        const float* src = P.in[24 + tb]; unsigned char* dst = P.ws + (tb ? WS_VT : WS_UT); float* sc = (float*)(P.ws + (tb ? WS_SV : WS_SU));
        for (int e = gw; e < 16384; e += ngw) {
            const f32x4* sp = (const f32x4*)(src + (size_t)e * D) + 4 * lane; f32x4 a[4]; float mx = 0.f;
#pragma unroll
            for (int j = 0; j < 4; ++j) { a[j] = sp[j]; mx = fmaxf(fmaxf(mx, fmaxf(fabsf(a[j][0]), fabsf(a[j][1]))), fmaxf(fabsf(a[j][2]), fabsf(a[j][3]))); }
            mx = wave_max_u(mx); const float inv = mx > 0.f ? 31.f / mx : 0.f;
            unsigned q[16];
#pragma unroll
            for (int i = 0; i < 16; ++i) q[i] = (unsigned)(__float2int_rn(a[i >> 2][i & 3] * inv) + 32);
            unsigned p0 = 0u, p1 = 0u, p2 = 0u;
#pragma unroll
            for (int b = 0; b < 4; ++b) {
                p0 |= ((q[b] & 15u) | ((q[4 + b] & 15u) << 4)) << (8 * b);
                p1 |= ((q[8 + b] & 15u) | ((q[12 + b] & 15u) << 4)) << (8 * b);
                p2 |= ((q[b] >> 4) | ((q[4 + b] >> 4) << 2) | ((q[8 + b] >> 4) << 4) | ((q[12 + b] >> 4) << 6)) << (8 * b);
            }
            unsigned* o = (unsigned*)(dst + (size_t)e * ROWB) + 3 * lane; o[0] = p0; o[1] = p1; o[2] = p2;
            if (lane == 0) sc[e] = mx * (1.f / 31.f);
        }
    }
}

#define TK_INS(L, x) do { _Pragma("unroll") for (int _j = 0; _j < 16; ++_j) { const unsigned _h = max(L[_j], x); x = min(L[_j], x); L[_j] = _h; } } while (0)
__device__ __forceinline__ void topk128(const u32x4* r, unsigned (&L)[16]) {
#pragma unroll
    for (int j = 0; j < 16; ++j) L[j] = 0u;
    u32x4 cur = r[0];
    for (int c = 0; c < 16; ++c) {
        const u32x4 nxt = r[(c + 1) & 15];
        const unsigned kb = 0xFFFFu - 8u * (unsigned)c;
#pragma unroll
        for (int d = 0; d < 4; ++d) {
            unsigned w = cur[d]; const unsigned msk = ((w >> 15) & 0x00010001u) * 0xFFFFu; w ^= (msk | 0x80008000u);
            unsigned x0 = (w << 16) | (kb - 2u * d), x1 = (w & 0xFFFF0000u) | (kb - 2u * d - 1u);
            TK_INS(L, x0); TK_INS(L, x1);
        }
        cur = nxt;
    }
}
__device__ __forceinline__ void phase_topk(const Params& P) {
    const int gl = blockIdx.x * NTHR + threadIdx.x, nl = gridDim.x * NTHR;
    const bf16* Sc = (const bf16*)(P.ws + WS_S); int* IDS = (int*)(P.ws + WS_IDS); float* GATES = (float*)(P.ws + WS_GATES);
    for (int item = gl; item < M * 8; item += nl) {
        const u32x4* row = (const u32x4*)(Sc + (size_t)item * 256);
        unsigned L0[16], L1[16];
        topk128(row, L0); topk128(row + 16, L1);
        float f0[16], f1[16]; unsigned p0[16], p1[16];
#pragma unroll
        for (int i = 0; i < 16; ++i) {
            f0[i] = __uint_as_float((L0[i] & 0x80000000u) ? (L0[i] & 0x7FFF0000u) : (~L0[i] & 0xFFFF0000u)); p0[i] = (~L0[i] & 0x7Fu) << 7;
            f1[i] = __uint_as_float((L1[i] & 0x80000000u) ? (L1[i] & 0x7FFF0000u) : (~L1[i] & 0xFFFF0000u)); p1[i] = (~L1[i] & 0x7Fu);
        }
        unsigned C[16];
#pragma unroll
        for (int j = 0; j < 16; ++j) C[j] = 0u;
#pragma unroll
        for (int i = 0; i < 16; ++i)
#pragma unroll
            for (int j = 0; j < 16; ++j)
                if ((i + 1) * (j + 1) <= 16) {
                    const unsigned b = __float_as_uint(f0[i] + f1[j]); const unsigned mono = b ^ ((unsigned)((int)b >> 31) | 0x80000000u);
                    unsigned key = (mono & 0xFFFFC000u) | p0[i] | p1[j];
                    TK_INS(C, key);
                }
        float cv[16];
#pragma unroll
        for (int r = 0; r < 16; ++r) cv[r] = __uint_as_float((C[r] & 0x80000000u) ? (C[r] & 0x7FFFC000u) : (~C[r] & 0xFFFFC000u));
        const float cmax = cv[0]; float den = 0.f;
#pragma unroll
        for (int r = 0; r < 16; ++r) { cv[r] = __expf(cv[r] - cmax); den += cv[r]; }
        const float inv = 1.f / den;
        u32x4* ido = (u32x4*)(IDS + (size_t)item * 16); f32x4* go = (f32x4*)(GATES + (size_t)item * 16);
#pragma unroll
        for (int q = 0; q < 4; ++q) { u32x4 o; o.x = C[4 * q] & 0x3FFFu; o.y = C[4 * q + 1] & 0x3FFFu; o.z = C[4 * q + 2] & 0x3FFFu; o.w = C[4 * q + 3] & 0x3FFFu; ido[q] = o;
            f32x4 g; g[0] = cv[4 * q] * inv; g[1] = cv[4 * q + 1] * inv; g[2] = cv[4 * q + 2] * inv; g[3] = cv[4 * q + 3] * inv; go[q] = g; }
    }
}

typedef __bf16 bf16x2_t __attribute__((ext_vector_type(2)));
__device__ __forceinline__ float dot2bf(unsigned a, unsigned b, float c) { return __builtin_amdgcn_fdot2_f32_bf16(__builtin_bit_cast(bf16x2_t, a), __builtin_bit_cast(bf16x2_t, b), c, false); }
typedef unsigned u32x3 __attribute__((ext_vector_type(3)));
__device__ __forceinline__ void peer_load8(u32x3 (&buf)[8], const unsigned char* TAB, int idreg, int g, int lane) {
#pragma unroll
    for (int q = 0; q < 8; ++q) { const int id = __builtin_amdgcn_readlane(idreg, 8 * g + q); const unsigned* rp = (const unsigned*)(TAB + (size_t)id * ROWB) + 3 * lane; u32x3 w; w.x = rp[0]; w.y = rp[1]; w.z = rp[2]; buf[q] = w; }
}
__device__ __forceinline__ void peer_dots8(const u32x3 (&buf)[8], const u32x4& hq, int g, float& d, int lane) {
#pragma unroll
    for (int q = 0; q < 8; ++q) { const unsigned p0 = buf[q].x, p1 = buf[q].y, p2 = buf[q].z; int s = 0, t = 0;
        s = __builtin_amdgcn_sdot4((int)(p0 & 0x0F0F0F0Fu), (int)hq[0], s, false); s = __builtin_amdgcn_sdot4((int)((p0 >> 4) & 0x0F0F0F0Fu), (int)hq[1], s, false);
        s = __builtin_amdgcn_sdot4((int)(p1 & 0x0F0F0F0Fu), (int)hq[2], s, false); s = __builtin_amdgcn_sdot4((int)((p1 >> 4) & 0x0F0F0F0Fu), (int)hq[3], s, false);
#pragma unroll
        for (int f = 0; f < 4; ++f) t = __builtin_amdgcn_sdot4((int)((p2 >> (2 * f)) & 0x03030303u), (int)hq[f], t, false);
        const int tot = wave_sum_i(s + 16 * t);
        d = (lane == 8 * g + q) ? (float)tot : d; }
}
__device__ __forceinline__ void peer_axpy8(const u32x3 (&buf)[8], float areg, int g, float (&acc)[16]) {
#pragma unroll
    for (int q = 0; q < 8; ++q) { const float a = rlf(areg, 8 * g + q); const unsigned p0 = buf[q].x, p1 = buf[q].y, p2 = buf[q].z;
        const unsigned v0 = (p0 & 0x0F0F0F0Fu) | ((p2 & 0x03030303u) << 4), v1 = ((p0 >> 4) & 0x0F0F0F0Fu) | (((p2 >> 2) & 0x03030303u) << 4);
        const unsigned v2 = (p1 & 0x0F0F0F0Fu) | (((p2 >> 4) & 0x03030303u) << 4), v3 = ((p1 >> 4) & 0x0F0F0F0Fu) | (((p2 >> 6) & 0x03030303u) << 4);
        const unsigned vv[4] = {v0, v1, v2, v3};
#pragma unroll
        for (int i = 0; i < 4; ++i) { const unsigned w = vv[i];
            acc[4 * i] += a * (float)(w & 0xffu); acc[4 * i + 1] += a * (float)((w >> 8) & 0xffu); acc[4 * i + 2] += a * (float)((w >> 16) & 0xffu); acc[4 * i + 3] += a * (float)(w >> 24); } }
}
__device__ __forceinline__ void phase_peer(const Params& P) {
    const int lane = threadIdx.x & 63, wave = threadIdx.x >> 6; const int gw = blockIdx.x * NWAVES + wave, ngw = gridDim.x * NWAVES;
    const bf16* H1 = (const bf16*)(P.ws + WS_H1); const int* IDS = (const int*)(P.ws + WS_IDS); const float* GATES = (const float*)(P.ws + WS_GATES);
    const unsigned char* UT = P.ws + WS_UT; const unsigned char* VT = P.ws + WS_VT; const float* SU = (const float*)(P.ws + WS_SU); const float* SV = (const float*)(P.ws + WS_SV);
    const float* g2 = P.in[26]; const float* b2 = P.in[27];
    for (int m = gw; m < M; m += ngw) {
        const u32x4* hp = (const u32x4*)(H1 + (size_t)m * D) + 2 * lane; const u32x4 hA = hp[0], hB = hp[1];
        float hv[16]; float hmx = 0.f;
#pragma unroll
        for (int i = 0; i < 4; ++i) { hv[2 * i] = __uint_as_float(hA[i] << 16); hv[2 * i + 1] = __uint_as_float(hA[i] & 0xffff0000u); hv[8 + 2 * i] = __uint_as_float(hB[i] << 16); hv[8 + 2 * i + 1] = __uint_as_float(hB[i] & 0xffff0000u); }
#pragma unroll
        for (int i = 0; i < 16; ++i) hmx = fmaxf(hmx, fabsf(hv[i]));
        hmx = wave_max_u(hmx); const float hinv = hmx > 0.f ? 127.f / hmx : 0.f, hsc = hmx * (1.f / 127.f);
        u32x4 hq;
#pragma unroll
        for (int i = 0; i < 4; ++i) hq[i] = pack_i8(hv[4 * i], hv[4 * i + 1], hv[4 * i + 2], hv[4 * i + 3], hinv, 0);
        int hs = 0;
#pragma unroll
        for (int i = 0; i < 4; ++i) hs = __builtin_amdgcn_sdot4((int)hq[i], 0x01010101, hs, false);
        const float hoff = 32.f * (float)wave_sum_i(hs);
        const int id_lo = IDS[(size_t)m * 128 + lane], id_hi = IDS[(size_t)m * 128 + 64 + lane];
        const float gt_lo = GATES[(size_t)m * 128 + lane], gt_hi = GATES[(size_t)m * 128 + 64 + lane];
        const float su_lo = SU[id_lo], su_hi = SU[id_hi], sv_lo = SV[id_lo], sv_hi = SV[id_hi];
        float d_lo = 0.f, d_hi = 0.f;
        u32x3 A0[8], A1[8];
        peer_load8(A0, UT, id_lo, 0, lane);
        for (int g = 0; g < 8; g += 2) {
            peer_load8(A1, UT, id_lo, g + 1, lane); peer_dots8(A0, hq, g, d_lo, lane);
            if (g + 2 < 8) peer_load8(A0, UT, id_lo, g + 2, lane); else peer_load8(A0, UT, id_hi, 0, lane);
            peer_dots8(A1, hq, g + 1, d_lo, lane);
        }
        for (int g = 0; g < 8; g += 2) {
            peer_load8(A1, UT, id_hi, g + 1, lane); peer_dots8(A0, hq, g, d_hi, lane);
            if (g + 2 < 8) peer_load8(A0, UT, id_hi, g + 2, lane); else peer_load8(A0, VT, id_lo, 0, lane);
            peer_dots8(A1, hq, g + 1, d_hi, lane);
        }
        const float x_lo = (d_lo - hoff) * su_lo * hsc, x_hi = (d_hi - hoff) * su_hi * hsc;
        const float a_lo = 0.5f * x_lo * (1.f + erff(x_lo * 0.70710678118f)) * gt_lo * sv_lo, a_hi = 0.5f * x_hi * (1.f + erff(x_hi * 0.70710678118f)) * gt_hi * sv_hi;
        const float c0 = 32.f * wave_sum(a_lo + a_hi);
        float acc[16];
#pragma unroll
        for (int i = 0; i < 16; ++i) acc[i] = 0.f;
        for (int g = 0; g < 8; g += 2) {
            peer_load8(A1, VT, id_lo, g + 1, lane); peer_axpy8(A0, a_lo, g, acc);
            if (g + 2 < 8) peer_load8(A0, VT, id_lo, g + 2, lane); else peer_load8(A0, VT, id_hi, 0, lane);
            peer_axpy8(A1, a_lo, g + 1, acc);
        }
        for (int g = 0; g < 8; g += 2) {
            peer_load8(A1, VT, id_hi, g + 1, lane); peer_axpy8(A0, a_hi, g, acc);
            if (g + 2 < 8) peer_load8(A0, VT, id_hi, g + 2, lane);
            peer_axpy8(A1, a_hi, g + 1, acc);
        }
        float s = 0.f;
#pragma unroll
        for (int i = 0; i < 16; ++i) { acc[i] = ALPHA * hv[i] + (acc[i] - c0); s += acc[i]; }
        const float mean = wave_sum(s) * (1.f / D); float s2 = 0.f;
#pragma unroll
        for (int i = 0; i < 16; ++i) { acc[i] -= mean; s2 += acc[i] * acc[i]; }
        const float rstd = 1.f / sqrtf(wave_sum(s2) * (1.f / D) + LN_EPS);
#pragma unroll
        for (int c4 = 0; c4 < 4; ++c4) { const int e0 = 16 * lane + 4 * c4; const f32x4 gg = *(const f32x4*)(g2 + e0), bb = *(const f32x4*)(b2 + e0); f32x4 o;
#pragma unroll
            for (int j = 0; j < 4; ++j) o[j] = acc[c4 * 4 + j] * rstd * gg[j] + bb[j];
            *(f32x4*)(P.out + (size_t)m * D + e0) = o; }
    }
}

#define XB_TMO      128
#define XB_XCNT(j)  (256  + 64 * (j))
#define XB_XSUB(j)  (1280 + 64 * (j))
#define XB_XGEN(j)  (2304 + 64 * (j))
#define XB_TOP      3328
#define XB_TOPGEN   3392
#define XCD_BAR_WORDS 3456
#define XB_SPIN_CAP (1u << 18)
__device__ __forceinline__ unsigned xb_ld(unsigned* p)              { return __hip_atomic_load(p, __ATOMIC_RELAXED, __HIP_MEMORY_SCOPE_AGENT); }
__device__ __forceinline__ unsigned xb_add(unsigned* p, unsigned v) { return __hip_atomic_fetch_add(p, v, __ATOMIC_RELAXED, __HIP_MEMORY_SCOPE_AGENT); }
__device__ __forceinline__ unsigned xb_xcc_id() { return (unsigned)__builtin_amdgcn_s_getreg((3 << 11) | 20) & 0xFu; }
#define XB_SPIN(cond, bar) do { unsigned _sp = 0; while (cond) { __builtin_amdgcn_s_sleep(1); \
    if ((++_sp & 255u) == 0u) { if (xb_ld(&(bar)[XB_TMO])) break; if (_sp > XB_SPIN_CAP) { atomicAdd(&(bar)[XB_TMO], 1u); break; } } } } while (0)
struct XcdBarrier { unsigned* bar; unsigned x; volatile LAS unsigned* st; };
__device__ __forceinline__ XcdBarrier xcd_barrier_post(unsigned* bar, volatile LAS unsigned* st) {
    XcdBarrier b; b.bar = bar; b.x = xb_xcc_id(); b.st = st;
    if (threadIdx.x == 0) (void)xb_add(&bar[XB_XCNT(b.x)], 1u);
    return b;
}
__device__ __forceinline__ void xcd_barrier_complete(unsigned* bar, unsigned x, unsigned& nloc, unsigned& nx) {
    const unsigned G = gridDim.x * gridDim.y * gridDim.z;
    unsigned sum, cnt, mine, sp = 0u;
    for (;;) {
        sum = 0u; cnt = 0u; mine = 0u;
#pragma unroll
        for (unsigned j = 0; j < 16; ++j) { const unsigned c = xb_ld(&bar[XB_XCNT(j)]); sum += c; cnt += (c > 0u) ? 1u : 0u; mine = (j == x) ? c : mine; }
        if (sum == G) break;
        __builtin_amdgcn_s_sleep(1);
        if ((++sp & 255u) == 0u) { if (xb_ld(&bar[XB_TMO])) break; if (sp > XB_SPIN_CAP) { atomicAdd(&bar[XB_TMO], 1u); break; } }
    }
    nloc = mine > 0u ? mine : 1u; nx = cnt > 0u ? cnt : 1u;
}
__device__ __forceinline__ void xcd_barrier(const XcdBarrier& b) {
    asm volatile("s_waitcnt vmcnt(0)" ::: "memory");
    __syncthreads();
    if (threadIdx.x == 0) {
        unsigned* bar = b.bar;
        __builtin_amdgcn_s_waitcnt(0);
        unsigned nloc = b.st[0], nx = b.st[1];
        if (nloc == 0u) { xcd_barrier_complete(bar, b.x, nloc, nx); b.st[0] = nloc; b.st[1] = nx; }
        const unsigned old = xb_add(&bar[XB_XSUB(b.x)], 1u);
        const unsigned gen = old / nloc;
        if (old + 1u == (gen + 1u) * nloc) {
            __builtin_amdgcn_fence(__ATOMIC_RELEASE, "agent");
            asm volatile("s_waitcnt vmcnt(0)" ::: "memory");
            const unsigned og = xb_add(&bar[XB_TOP], 1u);
            const unsigned tg = og / nx;
            if (og + 1u == (tg + 1u) * nx) xb_add(&bar[XB_TOPGEN], 1u);
            else XB_SPIN(xb_ld(&bar[XB_TOPGEN]) == tg, bar);
            __builtin_amdgcn_fence(__ATOMIC_ACQUIRE, "agent");
            xb_add(&bar[XB_XGEN(b.x)], 1u);
            asm volatile("s_waitcnt vmcnt(0)" ::: "memory");
        } else {
            XB_SPIN(xb_ld(&bar[XB_XGEN(b.x)]) == gen, bar);
            __builtin_amdgcn_fence(__ATOMIC_ACQUIRE, "agent");
            asm volatile("s_waitcnt vmcnt(0)" ::: "memory");
        }
    }
    __syncthreads();
}

constexpr int N_PHASES = 12;
__global__ void __launch_bounds__(NTHR, 2) fwd_kernel(Params P) {
    extern __shared__ __attribute__((aligned(16))) unsigned char lds_raw[];
    LAS unsigned char* lds = (LAS unsigned char*)lds_raw;
    cg::grid_group grid = cg::this_grid();
    const int lo = P.ph_lo, hi = P.ph_hi;
    unsigned char* ws = P.ws;
    volatile LAS unsigned* bst = (volatile LAS unsigned*)(lds + LDS_MISC);
    if (threadIdx.x < 16) bst[threadIdx.x] = 0u;
    __syncthreads();
    const XcdBarrier bar = xcd_barrier_post((unsigned*)(ws + WS_CTL), bst);
#define IN(k) (lo <= (k) && (k) < hi)
#define SEAM(k) do { if (IN(k) && IN((k) + 1)) { if ((k) == 0) grid.sync(); else xcd_barrier(bar); } } while (0)
    if (IN(0)) phase_prologue(P);
    SEAM(0);
    if (IN(1)) {
        pg8::Gemm g{(const bf16*)(ws + WS_H0), (const bf16*)(ws + WS_WIN), M, NP, D, D, D, 0}; pg8::StaticOrder S; S.init(M, NP, gridDim.x, blockIdx.x);
        pg8::EpiBf16 E{(bf16*)(ws + WS_P), NP};
        pg8::gemm_phase<pg8::EpiBf16, pg8::StaticOrder, true, true>(lds, g, S, E);
    }
    SEAM(1);
    if (IN(2)) phase_prep(P, lds);
    SEAM(2);
    if (IN(3)) phase_scan(P, lds);
    SEAM(3);
    if (IN(4)) phase_fixup(P, lds);
    SEAM(4);
    if (IN(5)) phase_correct(P, lds);
    SEAM(5);
    if (IN(6)) {
        pg8::Gemm g{(const bf16*)(ws + WS_MIX), (const bf16*)(ws + WS_WOUT), M, D, D, D, D, 0}; pg8::StaticOrder S; S.init(M, D, gridDim.x, blockIdx.x);
        pg8::EpiResBf16 E{(bf16*)(ws + WS_Z), (const bf16*)(ws + WS_H0), D, ALPHA};
        pg8::gemm_phase<pg8::EpiResBf16, pg8::StaticOrder, true, true>(lds, g, S, E);
    }
    SEAM(6);
    if (IN(7)) phase_ln1(P);
    SEAM(7);
    if (IN(8)) {
        pg8::Gemm g{(const bf16*)(ws + WS_H1), (const bf16*)(ws + WS_WQ), M, NQ, D, D, D, 0}; pg8::StaticOrder S; S.init(M, NQ, gridDim.x, blockIdx.x);
        pg8::EpiBf16 E{(bf16*)(ws + WS_Q), NQ};
        pg8::gemm_phase<pg8::EpiBf16, pg8::StaticOrder, true, true>(lds, g, S, E);
    }
    SEAM(8);
    if (IN(9)) {
        pg8::Gemm g{(const bf16*)(ws + WS_Q), (const bf16*)(ws + WS_KBD), M, NQ, 256, NQ, 256, 256}; pg8::StaticOrder S; S.init(M, NQ, gridDim.x, blockIdx.x);
        pg8::EpiBf16 E{(bf16*)(ws + WS_S), NQ};
        pg8::gemm_phase<pg8::EpiBf16, pg8::StaticOrder, true, true>(lds, g, S, E);
    }
    SEAM(9);
    if (IN(10)) phase_topk(P);
    SEAM(10);
    if (IN(11)) phase_peer(P);
#undef IN
#undef SEAM
}

extern "C" void kernel_launch(void* const* d_in, const int* in_sizes, int n_in, void* d_out, int out_size, void* d_ws, size_t ws_size, hipStream_t stream) {
    static int grid = 0;
    if (grid == 0) {
        if (n_in != 28 || out_size != M * D || ws_size < WS_END) { fprintf(stderr, "kernel_launch: unexpected shapes (n_in %d out %d ws %zu)\n", n_in, out_size, ws_size); grid = -1; return; }
        int dev = 0, cus = 0, per_cu = 0;
        (void)hipGetDevice(&dev); (void)hipDeviceGetAttribute(&cus, hipDeviceAttributeMultiprocessorCount, dev);
        (void)hipFuncSetAttribute((const void*)fwd_kernel, hipFuncAttributeMaxDynamicSharedMemorySize, LDS_BYTES);
        (void)hipOccupancyMaxActiveBlocksPerMultiprocessor(&per_cu, (const void*)fwd_kernel, NTHR, LDS_BYTES);
        if (per_cu < 1) { fprintf(stderr, "kernel_launch: occupancy query says %d blocks per CU\n", per_cu); per_cu = 1; }
        (void)hipGetLastError();
        grid = cus;
    }
    if (grid < 0) return;
    Params p{};
    for (int i = 0; i < 28; ++i) p.in[i] = (const float*)d_in[i];
    p.out = (float*)d_out; p.ws = (unsigned char*)d_ws;
    (void)hipMemsetAsync((char*)d_ws + WS_CTL, 0, CTL_BYTES, stream);
#if MK_ONE_LAUNCH
    p.ph_lo = 0; p.ph_hi = N_PHASES;
    void* args[] = {&p};
    hipError_t e = hipLaunchCooperativeKernel((const void*)fwd_kernel, dim3(grid), dim3(NTHR), args, LDS_BYTES, stream);
    if (e != hipSuccess) fprintf(stderr, "cooperative launch failed: %s (grid %d)\n", hipGetErrorString(e), grid);
#else
    for (int ph = 0; ph < N_PHASES; ++ph) {
        p.ph_lo = ph; p.ph_hi = ph + 1;
        hipLaunchKernelGGL(fwd_kernel, dim3(grid), dim3(NTHR), LDS_BYTES, stream, p);
    }
#endif
}
```

```cpp
#include <hip/hip_runtime.h>
#include <hip/hip_cooperative_groups.h>
#include <cstdio>
#include <cstdint>
namespace cg = cooperative_groups;

namespace pg8 {
#define PG8_LAS __attribute__((address_space(3)))
typedef unsigned short bf16_t;
typedef short bf16x8 __attribute__((ext_vector_type(8)));
typedef float f32x4 __attribute__((ext_vector_type(4)));
typedef float f32x2 __attribute__((ext_vector_type(2)));
typedef unsigned u32x4 __attribute__((ext_vector_type(4)));
typedef unsigned u32x2 __attribute__((ext_vector_type(2)));
constexpr int BM = 256, BK = 64, HALF = 128, HTB = HALF * BK * 2, STAGE_BYTES = 8 * HTB, NXCD = 8, WGM = 8;

__host__ __device__ __forceinline__ int lds_byte(int r, int c) { const int st = (r >> 4) * 2 + (c >> 5), rr = r & 15, cc = c & 31, ob = rr * 64 + cc * 2; return st * 1024 + (ob ^ (((ob >> 9) & 1) << 5)); }
__host__ __device__ __forceinline__ void stage_rc(int b, int& R, int& C) { const int st = b / 1024, sb = b % 1024, swz = sb ^ (((sb >> 9) & 1) << 5); R = (st >> 1) * 16 + swz / 64; C = (st & 1) * 32 + (swz % 64) / 2; }
__host__ __device__ __forceinline__ int perm32(int rho) { const int n = rho >> 4, i = rho & 15; return 8 * (i >> 2) + 4 * n + (i & 3); }

struct Unit { int pm, pn; };
struct Gemm { const bf16_t* A; const bf16_t* Bt; int M, N, K, lda, ldb, a_pn_koff; };

struct StaticOrder {
    int nM, nN, nwg, G, c;
    __host__ __device__ void init(int M, int N, int G_, int c_) { nM = M / BM; nN = N / BM; nwg = nM * nN; G = G_; c = c_; }
    __host__ __device__ bool next(int i, Unit& u) const {
        const long L = (long)i * G + c; if (L >= nwg) return false;
        int wgid = (int)L; { const int q = nwg / NXCD, r = nwg % NXCD, xcd = wgid % NXCD, off = wgid / NXCD; wgid = (xcd < r ? xcd * (q + 1) : r * (q + 1) + (xcd - r) * q) + off; }
        const int nig = WGM * nN, gid = wgid / nig, fm = gid * WGM, gsz = (nM - fm) < WGM ? (nM - fm) : WGM;
        u.pm = fm + ((wgid % nig) % gsz); u.pn = (wgid % nig) / gsz; return true;
    }
    __device__ __forceinline__ void a_ready(const Unit&) const {}
    __device__ __forceinline__ void done(const Unit&) const {}
};

typedef float f32x2p_t __attribute__((ext_vector_type(2))); typedef __bf16 bf16x2p_t __attribute__((ext_vector_type(2)));
__device__ __forceinline__ unsigned cvt_pk_bf16(float lo, float hi) { const f32x2p_t v = {lo, hi}; const bf16x2p_t b = __builtin_convertvector(v, bf16x2p_t); return __builtin_bit_cast(unsigned, b); }

struct EpiScores {
    static constexpr bool PERM = true;
    bf16_t* O;
    __device__ __forceinline__ void operator()(const f32x4 (&acc)[2][2][4][2], const Unit& u, int wr, int wc, int fr, int fq) const {
        const int row0 = u.pm * BM + wr * 64 + fr;
#pragma unroll
        for (int ai = 0; ai < 2; ++ai)
#pragma unroll
            for (int m = 0; m < 4; ++m) { const int row = row0 + ai * HALF + m * 16;
                bf16_t* tp = O + ((size_t)((row >> 6) * (2048 / BM) + u.pn) * 32 * 64 + (row & 63)) * 8;
#pragma unroll
                for (int bj = 0; bj < 2; ++bj) { const f32x4 v0 = acc[ai][bj][m][0], v1 = acc[ai][bj][m][1];
                    u32x4 w; w.x = cvt_pk_bf16(v0[0], v0[1]); w.y = cvt_pk_bf16(v0[2], v0[3]); w.z = cvt_pk_bf16(v1[0], v1[1]); w.w = cvt_pk_bf16(v1[2], v1[3]);
                    *(u32x4*)(tp + (size_t)(4 * wc + fq + 16 * bj) * 64 * 8) = w; } }
    }
};
struct EpiBf16 {
    static constexpr bool PERM = true;
    bf16_t* O; int ldc;
    __device__ __forceinline__ void operator()(const f32x4 (&acc)[2][2][4][2], const Unit& u, int wr, int wc, int fr, int fq) const {
        const int row0 = u.pm * BM + wr * 64 + fr; const int col0 = u.pn * BM + wc * 32 + 8 * fq;
#pragma unroll
        for (int ai = 0; ai < 2; ++ai)
#pragma unroll
            for (int m = 0; m < 4; ++m) { bf16_t* rowp = O + (size_t)(row0 + ai * HALF + m * 16) * ldc + col0;
#pragma unroll
                for (int bj = 0; bj < 2; ++bj) { const f32x4 v0 = acc[ai][bj][m][0], v1 = acc[ai][bj][m][1];
                    u32x4 w; w.x = cvt_pk_bf16(v0[0], v0[1]); w.y = cvt_pk_bf16(v0[2], v0[3]); w.z = cvt_pk_bf16(v1[0], v1[1]); w.w = cvt_pk_bf16(v1[2], v1[3]);
                    *(u32x4*)(rowp + bj * HALF) = w; } }
    }
};
struct EpiResBf16 {
    static constexpr bool PERM = true;
    bf16_t* Z; const bf16_t* R; int ldc; float alpha;
    __device__ __forceinline__ void operator()(const f32x4 (&acc)[2][2][4][2], const Unit& u, int wr, int wc, int fr, int fq) const {
        const int row0 = u.pm * BM + wr * 64 + fr; const int col0 = u.pn * BM + wc * 32 + 8 * fq;
#pragma unroll
        for (int ai = 0; ai < 2; ++ai)
#pragma unroll
            for (int m = 0; m < 4; ++m) { const size_t off = (size_t)(row0 + ai * HALF + m * 16) * ldc + col0;
#pragma unroll
                for (int bj = 0; bj < 2; ++bj) { const u32x4 rb = *(const u32x4*)(R + off + bj * HALF); const f32x4 v0 = acc[ai][bj][m][0], v1 = acc[ai][bj][m][1];
                    u32x4 w;
                    w.x = cvt_pk_bf16(__uint_as_float(rb.x << 16) * alpha + v0[0], __uint_as_float(rb.x & 0xffff0000u) * alpha + v0[1]);
                    w.y = cvt_pk_bf16(__uint_as_float(rb.y << 16) * alpha + v0[2], __uint_as_float(rb.y & 0xffff0000u) * alpha + v0[3]);
                    w.z = cvt_pk_bf16(__uint_as_float(rb.z << 16) * alpha + v1[0], __uint_as_float(rb.z & 0xffff0000u) * alpha + v1[1]);
                    w.w = cvt_pk_bf16(__uint_as_float(rb.w << 16) * alpha + v1[2], __uint_as_float(rb.w & 0xffff0000u) * alpha + v1[3]);
                    *(u32x4*)(Z + off + bj * HALF) = w; } }
    }
};
template <class Epi, class Sched, bool ALIGN_EPI = false, bool SP2 = false>
__device__ __forceinline__ void gemm_phase(PG8_LAS unsigned char* lds, const Gemm g, const Sched& S, const Epi& E) {
    const int tid = threadIdx.x, wid = __builtin_amdgcn_readfirstlane(tid >> 6), lane = tid & 63, wr = wid >> 2, wc = wid & 3, fr = lane & 15, fq = lane >> 4;
    const int K = g.K, nt = K / BK;
    unsigned voffA[2], voffB[2];
#pragma unroll
    for (int i = 0; i < 2; ++i) { int R, C; stage_rc(tid * 16 + i * 8192, R, C); const int Rb = Epi::PERM ? ((R & ~31) + perm32(R & 31)) : R;
        voffA[i] = (unsigned)(R * g.lda + C) * 2u; voffB[i] = (unsigned)(Rb * g.ldb + C) * 2u; }
    const size_t kstep = (size_t)(BK * 2);
    const size_t hstepA = (size_t)HALF * g.lda * 2, hstepB = (size_t)HALF * g.ldb * 2;
    const size_t tstepA = 2 * hstepA, tstepB = 2 * hstepB;
    const size_t pnA = (size_t)g.a_pn_koff * 2;
    const unsigned ldsw = (unsigned)wid * 1024u;
    const int aoff = lds_byte(wr * 64 + fr, fq * 8), boff = lds_byte(wc * 32 + fr, fq * 8);
#define PG8_SA(b, h) (((b) * 2 + (h)) * HTB)
#define PG8_SB(b, h) ((4 + (b) * 2 + (h)) * HTB)
#define PG8_STAGE(bufoff, gbase, voff) do { _Pragma("unroll") for (int _i = 0; _i < 2; ++_i) \
        __builtin_amdgcn_global_load_lds((const unsigned*)((const char*)(gbase) + (voff)[_i]), (PG8_LAS unsigned*)(lds + (bufoff) + ldsw + _i * 8192), 16, 0, 0); } while (0)
#define PG8_LDA(dst, b, h) do { _Pragma("unroll") for (int m = 0; m < 4; ++m) _Pragma("unroll") for (int k = 0; k < 2; ++k) dst[m][k] = *(const PG8_LAS bf16x8*)(lds + PG8_SA(b, h) + aoff + m * 2048 + k * 1024); } while (0)
#define PG8_LDB(dst, b, h) do { _Pragma("unroll") for (int n = 0; n < 2; ++n) _Pragma("unroll") for (int k = 0; k < 2; ++k) dst[n][k] = *(const PG8_LAS bf16x8*)(lds + PG8_SB(b, h) + boff + n * 2048 + k * 1024); } while (0)
#define PG8_MMA(ai, bj, At, Bt) do { __builtin_amdgcn_s_setprio(1); _Pragma("unroll") for (int m = 0; m < 4; ++m) _Pragma("unroll") for (int n = 0; n < 2; ++n) _Pragma("unroll") for (int k = 0; k < 2; ++k) \
        acc[ai][bj][m][n] = __builtin_amdgcn_mfma_f32_16x16x32_bf16(Bt[n][k], At[m][k], acc[ai][bj][m][n], 0, 0, 0); __builtin_amdgcn_s_setprio(0); } while (0)
#define PG8_WAIT_V(n) asm volatile("s_waitcnt vmcnt(" #n ")" ::: "memory")
#define PG8_WAIT_L(n) asm volatile("s_waitcnt lgkmcnt(" #n ")" ::: "memory")
#define PG8_BAR __builtin_amdgcn_s_barrier()
#define PG8_SCHED __builtin_amdgcn_sched_barrier(0)
    Unit cur, nxt; int ui = 0;
    if (!S.next(0, cur)) return;
    f32x4 acc[2][2][4][2];
#pragma unroll
    for (int a = 0; a < 2; ++a)
#pragma unroll
        for (int b = 0; b < 2; ++b)
#pragma unroll
            for (int m = 0; m < 4; ++m)
#pragma unroll
                for (int n = 0; n < 2; ++n) acc[a][b][m][n] = (f32x4){0.f, 0.f, 0.f, 0.f};
    bf16x8 At[4][2], B0[2][2], B1[2][2];
    const char* cA = (const char*)g.A + (size_t)cur.pm * tstepA + (size_t)cur.pn * pnA; const char* cB = (const char*)g.Bt + (size_t)cur.pn * tstepB;
    S.a_ready(cur);
    if constexpr (SP2) {
        PG8_STAGE(PG8_SB(0, 0), cB, voffB); PG8_STAGE(PG8_SB(0, 1), cB + hstepB, voffB); PG8_STAGE(PG8_SA(0, 0), cA, voffA); PG8_STAGE(PG8_SA(0, 1), cA + hstepA, voffA);
        if (wr == 1) PG8_BAR;
        PG8_WAIT_V(2); PG8_BAR;
        PG8_STAGE(PG8_SB(1, 0), cB + kstep, voffB); PG8_STAGE(PG8_SA(1, 0), cA + kstep, voffA); PG8_STAGE(PG8_SB(1, 1), cB + hstepB + kstep, voffB);
        PG8_WAIT_V(6); PG8_BAR;
    } else {
        PG8_STAGE(PG8_SB(0, 0), cB, voffB); PG8_STAGE(PG8_SA(0, 0), cA, voffA); PG8_STAGE(PG8_SB(0, 1), cB + hstepB, voffB); PG8_STAGE(PG8_SA(0, 1), cA + hstepA, voffA);
        if (wr == 1) PG8_BAR;
        PG8_WAIT_V(4); PG8_BAR;
        PG8_STAGE(PG8_SB(1, 0), cB + kstep, voffB); PG8_STAGE(PG8_SA(1, 0), cA + kstep, voffA); PG8_STAGE(PG8_SB(1, 1), cB + hstepB + kstep, voffB);
        PG8_WAIT_V(6); PG8_BAR;
    }
    for (;;) {
        const bool has_next = S.next(ui + 1, nxt);
        const char* nA = has_next ? (const char*)g.A + (size_t)nxt.pm * tstepA + (size_t)nxt.pn * pnA : cA; const char* nB = has_next ? (const char*)g.Bt + (size_t)nxt.pn * tstepB : cB;
        for (int t = 0; t < nt; t += 2) {
            const bool last = (t == nt - 2);
            const char* a1 = cA + (size_t)(t + 1) * kstep;
            const char* a2 = last ? nA : cA + (size_t)(t + 2) * kstep; const char* b2 = last ? nB : cB + (size_t)(t + 2) * kstep;
            const char* a3 = a2 + kstep; const char* b3 = b2 + kstep;
            if (last && has_next) S.a_ready(nxt);
            if constexpr (SP2) {
            PG8_LDB(B0, 0, 0); PG8_LDB(B1, 0, 1); PG8_SCHED; PG8_LDA(At, 0, 0); PG8_STAGE(PG8_SA(1, 1), a1 + hstepA, voffA);
            PG8_WAIT_V(8); PG8_WAIT_L(0); PG8_BAR; PG8_MMA(0, 0, At, B0); PG8_MMA(0, 1, At, B1); PG8_BAR; PG8_SCHED;
            PG8_LDA(At, 0, 1); PG8_STAGE(PG8_SB(0, 0), b2, voffB); PG8_STAGE(PG8_SB(0, 1), b2 + hstepB, voffB); PG8_STAGE(PG8_SA(0, 0), a2, voffA);
            PG8_WAIT_V(8); PG8_WAIT_L(0); PG8_BAR; PG8_MMA(1, 0, At, B0); PG8_MMA(1, 1, At, B1); PG8_BAR; PG8_SCHED;
            PG8_LDB(B0, 1, 0); PG8_LDB(B1, 1, 1); PG8_SCHED; PG8_LDA(At, 1, 0); PG8_STAGE(PG8_SA(0, 1), a2 + hstepA, voffA);
            PG8_WAIT_V(8); PG8_WAIT_L(0); PG8_BAR; PG8_MMA(0, 0, At, B0); PG8_MMA(0, 1, At, B1); PG8_BAR; PG8_SCHED;
            PG8_LDA(At, 1, 1); PG8_STAGE(PG8_SB(1, 0), b3, voffB); PG8_STAGE(PG8_SB(1, 1), b3 + hstepB, voffB); PG8_STAGE(PG8_SA(1, 0), a3, voffA);
            PG8_WAIT_V(8); PG8_WAIT_L(0); PG8_BAR; PG8_MMA(1, 0, At, B0); PG8_MMA(1, 1, At, B1); PG8_BAR; PG8_SCHED;
            } else {
            PG8_LDB(B0, 0, 0); PG8_SCHED; PG8_LDA(At, 0, 0); PG8_STAGE(PG8_SA(1, 1), a1 + hstepA, voffA);
            PG8_WAIT_L(8); PG8_BAR; PG8_WAIT_L(0); PG8_MMA(0, 0, At, B0); PG8_BAR; PG8_SCHED;
            PG8_LDB(B1, 0, 1); PG8_STAGE(PG8_SB(0, 0), b2, voffB);
            PG8_BAR; PG8_WAIT_L(0); PG8_MMA(0, 1, At, B1); PG8_BAR;
            PG8_LDA(At, 0, 1); PG8_STAGE(PG8_SA(0, 0), a2, voffA);
            PG8_BAR; PG8_WAIT_L(0); PG8_MMA(1, 0, At, B0); PG8_BAR; PG8_SCHED;
            PG8_STAGE(PG8_SB(0, 1), b2 + hstepB, voffB);
            PG8_WAIT_V(6); PG8_BAR; PG8_MMA(1, 1, At, B1); PG8_BAR;
            PG8_LDB(B0, 1, 0); PG8_SCHED; PG8_LDA(At, 1, 0); PG8_STAGE(PG8_SA(0, 1), a2 + hstepA, voffA);
            PG8_WAIT_L(8); PG8_BAR; PG8_WAIT_L(0); PG8_MMA(0, 0, At, B0); PG8_BAR; PG8_SCHED;
            PG8_LDB(B1, 1, 1); PG8_STAGE(PG8_SB(1, 0), b3, voffB);
            PG8_BAR; PG8_WAIT_L(0); PG8_MMA(0, 1, At, B1); PG8_BAR;
            PG8_LDA(At, 1, 1); PG8_STAGE(PG8_SA(1, 0), a3, voffA);
            PG8_BAR; PG8_WAIT_L(0); PG8_MMA(1, 0, At, B0); PG8_BAR; PG8_SCHED;
            PG8_STAGE(PG8_SB(1, 1), b3 + hstepB, voffB);
            PG8_WAIT_V(6); PG8_BAR; PG8_MMA(1, 1, At, B1); PG8_BAR;
            }
        }
        if constexpr (ALIGN_EPI) { if (wr == 0) PG8_BAR; }
        E(acc, cur, wr, wc, fr, fq); S.done(cur);
        if (!has_next) break;
#pragma unroll
        for (int a = 0; a < 2; ++a)
#pragma unroll
            for (int b = 0; b < 2; ++b)
#pragma unroll
                for (int m = 0; m < 4; ++m)
#pragma unroll
                    for (int n = 0; n < 2; ++n) acc[a][b][m][n] = (f32x4){0.f, 0.f, 0.f, 0.f};
        cur = nxt; cA = nA; cB = nB; ++ui;
        if constexpr (ALIGN_EPI) { if (wr == 1) PG8_BAR; }
    }
    PG8_WAIT_V(0);
    if constexpr (!ALIGN_EPI) { if (wr == 0) PG8_BAR; }
    PG8_BAR;
#undef PG8_SA
#undef PG8_SB
#undef PG8_STAGE
#undef PG8_LDA
#undef PG8_LDB
#undef PG8_MMA
#undef PG8_WAIT_V
#undef PG8_WAIT_L
#undef PG8_BAR
#undef PG8_SCHED
}
}

constexpr int NWAVES = 8, NTHR = NWAVES * 64;
constexpr int D = 1024, NBATCH = 4, T = 8192, M = NBATCH * T;
constexpr int A_W = 512, A_IN = 1792, IN_COLS = 3344, NP = 3584;
constexpr int C_R = 0, C_K = 512, C_V = 1024, C_WD = 1536, C_AD = 1600, C_GD = 1664;
constexpr int C_BQ = 1792, C_BK = 2048, C_BV = 2304, C_GKD = 2816, C_BG = 2832;
constexpr int NQ = 2048;
constexpr float LN_EPS = 1e-5f, GN_EPS = 64e-5f, RMS_EPS = 1e-5f;
constexpr float ALPHA = 1.189207115002721f;

typedef unsigned short bf16;
typedef float f32x4 __attribute__((ext_vector_type(4)));
typedef float f32x2 __attribute__((ext_vector_type(2)));
typedef unsigned u32x4 __attribute__((ext_vector_type(4)));
typedef unsigned u32x2 __attribute__((ext_vector_type(2)));
#define LAS __attribute__((address_space(3)))

constexpr size_t MiB = 1u << 20;
constexpr size_t WS_WIN = 1 * MiB, WS_WOUT = 8 * MiB, WS_WQ = 10 * MiB, WS_KBD = 14 * MiB;
constexpr size_t WS_W2T = 15 * MiB, WS_A2T = WS_W2T + 65536, WS_G2T = WS_A2T + 65536;
constexpr size_t WS_H0 = 16 * MiB;
constexpr size_t WS_P = 80 * MiB;
constexpr size_t WS_WL = 304 * MiB, WS_AA = 336 * MiB, WS_GG = 368 * MiB;
constexpr size_t WS_GK = 400 * MiB;
constexpr size_t WS_Z = 80 * MiB;
constexpr size_t WS_H1 = 208 * MiB;
constexpr size_t WS_Q = 272 * MiB;
constexpr size_t WS_S = 80 * MiB;
constexpr size_t WS_IDS = 400 * MiB, WS_GATES = 416 * MiB;
constexpr size_t WS_UT = 432 * MiB, WS_VT = 448 * MiB;
constexpr int ROWB = 768;
constexpr size_t WS_SU = 464 * MiB, WS_SV = 465 * MiB;
constexpr size_t WS_UF = WS_UT; constexpr size_t UF_SLICE = (size_t)16384 * 128;
constexpr size_t WS_H8 = 272 * MiB;
constexpr size_t WS_PD = 80 * MiB;
constexpr size_t WS_V8 = WS_VT; constexpr size_t V8_SLICE = (size_t)16384 * 128;
constexpr size_t WS_CQ = 336 * MiB;
constexpr size_t WS_CS = 344 * MiB;
constexpr size_t WS_ZP = 80 * MiB;
constexpr int NSEG = 16, LSEG = 8192 / NSEG;
constexpr size_t WS_YI = WS_WL;
constexpr size_t WS_YIG = WS_GK;
constexpr size_t WS_SER = 480 * MiB;
constexpr size_t WS_SEG = 496 * MiB;
constexpr size_t WS_CEND = 504 * MiB;
constexpr size_t WS_END = 505 * MiB;

constexpr int LDS_BYTES = 163840, LDS_MISC = LDS_BYTES - 256;
constexpr size_t WS_CTL = 0, CTL_BYTES = 16384;

struct Params {
    const float* in[28];
    float* out; unsigned char* ws;
    int ph_lo, ph_hi;
};

__device__ __forceinline__ float bf2f(unsigned u) { return __uint_as_float(u << 16); }
typedef float f32x2c_t __attribute__((ext_vector_type(2))); typedef __bf16 bf16x2c_t __attribute__((ext_vector_type(2)));
__device__ __forceinline__ unsigned pk2(float lo, float hi) { const f32x2c_t v = {lo, hi}; const bf16x2c_t b = __builtin_convertvector(v, bf16x2c_t); return __builtin_bit_cast(unsigned, b); }
__device__ __forceinline__ unsigned f2bf(float f) { return pk2(f, 0.f) & 0xffffu; }
#define DPP_F(v, ctrl) __builtin_bit_cast(float, __builtin_amdgcn_update_dpp(0, __builtin_bit_cast(int, (v)), (ctrl), 0xf, 0xf, false))
#define DPP_ADD(v, ctrl) ((v) + DPP_F(v, ctrl))
__device__ __forceinline__ float rlf(float v, int l) { return __builtin_bit_cast(float, __builtin_amdgcn_readlane(__builtin_bit_cast(int, v), l)); }
__device__ __forceinline__ float wave_sum_u(float v) {
    v = DPP_ADD(v, 0xB1); v = DPP_ADD(v, 0x4E); v = DPP_ADD(v, 0x141); v = DPP_ADD(v, 0x140);
    return (rlf(v, 0) + rlf(v, 16)) + (rlf(v, 32) + rlf(v, 48));
}
__device__ __forceinline__ float wave_sum(float v) { return wave_sum_u(v); }
#define DPP_I(v, ctrl) __builtin_amdgcn_update_dpp(0, (v), (ctrl), 0xf, 0xf, false)
__device__ __forceinline__ int wave_sum_i(int v) {
    v += DPP_I(v, 0xB1); v += DPP_I(v, 0x4E); v += DPP_I(v, 0x141); v += DPP_I(v, 0x140);
    return (__builtin_amdgcn_readlane(v, 0) + __builtin_amdgcn_readlane(v, 16)) + (__builtin_amdgcn_readlane(v, 32) + __builtin_amdgcn_readlane(v, 48));
}
__device__ __forceinline__ float wave_max_u(float v) {
    v = fmaxf(v, DPP_F(v, 0xB1)); v = fmaxf(v, DPP_F(v, 0x4E)); v = fmaxf(v, DPP_F(v, 0x141)); v = fmaxf(v, DPP_F(v, 0x140));
    return fmaxf(fmaxf(rlf(v, 0), rlf(v, 16)), fmaxf(rlf(v, 32), rlf(v, 48)));
}
__device__ __forceinline__ unsigned pack_i8(float a, float b, float c, float d, float inv, int off) {
    const int q0 = __float2int_rn(a * inv) + off, q1 = __float2int_rn(b * inv) + off, q2 = __float2int_rn(c * inv) + off, q3 = __float2int_rn(d * inv) + off;
    return (unsigned)(q0 & 0xff) | ((unsigned)(q1 & 0xff) << 8) | ((unsigned)(q2 & 0xff) << 16) | ((unsigned)(q3 & 0xff) << 24);
}
__device__ __forceinline__ float sigmoidf_(float x) { return 1.f / (1.f + __expf(-x)); }
__device__ __forceinline__ float siluf_(float x) { return x * sigmoidf_(x); }

__device__ __forceinline__ void transpose_convert(const float* W, int K, int N, int Npad, bf16* WT, int gtid, int gthreads) {
    const int kc = K / 8, total = Npad * kc;
    for (int idx = gtid; idx < total; idx += gthreads) {
        const int n = idx % Npad, c = idx / Npad; float v[8];
#pragma unroll
        for (int j = 0; j < 8; ++j) v[j] = (n < N) ? W[(size_t)(8 * c + j) * N + n] : 0.f;
        u32x4 o; o.x = pk2(v[0], v[1]); o.y = pk2(v[2], v[3]); o.z = pk2(v[4], v[5]); o.w = pk2(v[6], v[7]);
        *(u32x4*)(WT + (size_t)n * K + 8 * c) = o;
    }
}
__device__ __forceinline__ void ln_row_bf16(const float* xrow, const float* g, const float* b, bf16* orow, int lane) {
    const f32x4* xr = (const f32x4*)xrow + lane; f32x4 v[4]; float s = 0.f;
#pragma unroll
    for (int j = 0; j < 4; ++j) { v[j] = xr[64 * j]; s += (v[j][0] + v[j][1]) + (v[j][2] + v[j][3]); }
    const float mean = wave_sum(s) * (1.f / D); float s2 = 0.f;
#pragma unroll
    for (int j = 0; j < 4; ++j) { v[j] = v[j] - mean; s2 += (v[j][0] * v[j][0] + v[j][1] * v[j][1]) + (v[j][2] * v[j][2] + v[j][3] * v[j][3]); }
    const float rstd = 1.f / sqrtf(wave_sum(s2) * (1.f / D) + LN_EPS);
    u32x2* o8 = (u32x2*)orow + lane;
#pragma unroll
    for (int j = 0; j < 4; ++j) { const f32x4 gg = ((const f32x4*)g)[lane + 64 * j], bb = ((const f32x4*)b)[lane + 64 * j]; const f32x4 y = v[j] * rstd * gg + bb;
        u32x2 w; w.x = pk2(y[0], y[1]); w.y = pk2(y[2], y[3]); o8[64 * j] = w; }
}
template <bool F8>
__device__ __forceinline__ void ln_rowb_bf16(const bf16* xrow, const float* g, const float* b, bf16* orow, int lane, unsigned char* f8row = nullptr) {
    const u32x4* xr = (const u32x4*)xrow + 2 * lane; const u32x4 a = xr[0], c = xr[1]; float v[16]; float s = 0.f;
#pragma unroll
    for (int i = 0; i < 4; ++i) { v[2 * i] = __uint_as_float(a[i] << 16); v[2 * i + 1] = __uint_as_float(a[i] & 0xffff0000u); v[8 + 2 * i] = __uint_as_float(c[i] << 16); v[8 + 2 * i + 1] = __uint_as_float(c[i] & 0xffff0000u); }
#pragma unroll
    for (int i = 0; i < 16; ++i) s += v[i];
    const float mean = wave_sum(s) * (1.f / D); float s2 = 0.f;
#pragma unroll
    for (int i = 0; i < 16; ++i) { v[i] -= mean; s2 += v[i] * v[i]; }
    const float rstd = 1.f / sqrtf(wave_sum(s2) * (1.f / D) + LN_EPS);
    u32x4 o0, o1;
#pragma unroll
    for (int q = 0; q < 4; ++q) { const f32x4 gg = *(const f32x4*)(g + 16 * lane + 4 * q), bb = *(const f32x4*)(b + 16 * lane + 4 * q);
#pragma unroll
        for (int j = 0; j < 4; ++j) v[4 * q + j] = v[4 * q + j] * rstd * gg[j] + bb[j];
        const unsigned lo = pk2(v[4 * q], v[4 * q + 1]), hi = pk2(v[4 * q + 2], v[4 * q + 3]);
        if (q < 2) { o0[2 * q] = lo; o0[2 * q + 1] = hi; } else { o1[2 * q - 4] = lo; o1[2 * q - 3] = hi; } }
    u32x4* op = (u32x4*)orow + 2 * lane; op[0] = o0; op[1] = o1;
    if (F8) {
        u32x4 h8, l8;
#pragma unroll
        for (int q = 0; q < 4; ++q) {
            int ph = __builtin_amdgcn_cvt_pk_fp8_f32(v[4 * q], v[4 * q + 1], 0, false); ph = __builtin_amdgcn_cvt_pk_fp8_f32(v[4 * q + 2], v[4 * q + 3], ph, true);
            const float r0 = v[4 * q] - __builtin_amdgcn_cvt_f32_fp8(ph, 0), r1 = v[4 * q + 1] - __builtin_amdgcn_cvt_f32_fp8(ph, 1);
            const float r2 = v[4 * q + 2] - __builtin_amdgcn_cvt_f32_fp8(ph, 2), r3 = v[4 * q + 3] - __builtin_amdgcn_cvt_f32_fp8(ph, 3);
            int pl = __builtin_amdgcn_cvt_pk_fp8_f32(r0, r1, 0, false); pl = __builtin_amdgcn_cvt_pk_fp8_f32(r2, r3, pl, true);
            h8[q] = (unsigned)ph; l8[q] = (unsigned)pl; }
        *((u32x4*)f8row + lane) = h8; *((u32x4*)(f8row + 1024) + lane) = l8;
    }
}
__device__ __forceinline__ void fold_keys(const Params& P, LAS unsigned char* lds, int bi, int nb) {
    const int tid = threadIdx.x; unsigned char* ws = P.ws;
    {
        const float* Wq = P.in[22]; const float* keys = P.in[23]; bf16* WqkT = (bf16*)(ws + WS_WQ);
        LAS float* WQs = (LAS float*)lds; LAS float* KYs = WQs + 64 * 132;
        for (int item = bi; item < 256; item += nb) {
            const int hh = item >> 4, kt = item & 15;
            __syncthreads();
            for (int i = tid; i < 64 * 32; i += NTHR) { const int r = i >> 5, c4 = (i & 31) * 4; *(LAS f32x4*)(WQs + r * 132 + c4) = *(const f32x4*)(Wq + (size_t)(kt * 64 + r) * NQ + hh * 128 + c4); }
            for (int i = tid; i < 128 * 32; i += NTHR) { const int r = i >> 5, c4 = (i & 31) * 4; *(LAS f32x4*)(KYs + r * 132 + c4) = *(const f32x4*)(keys + (size_t)(hh * 128 + r) * 128 + c4); }
            __syncthreads();
            const int key = tid & 127, kg = tid >> 7; float acc[16];
#pragma unroll
            for (int j = 0; j < 16; ++j) acc[j] = 0.f;
            for (int c4 = 0; c4 < 32; ++c4) { const f32x4 kv = *(const LAS f32x4*)(KYs + key * 132 + 4 * c4);
#pragma unroll
                for (int j = 0; j < 16; ++j) { const f32x4 w = *(const LAS f32x4*)(WQs + (kg * 16 + j) * 132 + 4 * c4); acc[j] += (w[0] * kv[0] + w[1] * kv[1]) + (w[2] * kv[2] + w[3] * kv[3]); } }
            u32x4 o0, o1;
#pragma unroll
            for (int q = 0; q < 4; ++q) { o0[q] = pk2(acc[2 * q], acc[2 * q + 1]); o1[q] = pk2(acc[8 + 2 * q], acc[8 + 2 * q + 1]); }
            u32x4* dst = (u32x4*)(WqkT + (size_t)(hh * 128 + key) * D + kt * 64 + kg * 16); dst[0] = o0; dst[1] = o1;
        }
    }
}
__device__ __forceinline__ void phase_prologue(const Params& P, LAS unsigned char* lds) {
    const int tid = threadIdx.x, lane = tid & 63, wave = tid >> 6;
    const int gtid = blockIdx.x * NTHR + tid, gthreads = gridDim.x * NTHR;
    unsigned char* ws = P.ws;
    transpose_convert(P.in[3], D, IN_COLS, NP, (bf16*)(ws + WS_WIN), gtid, gthreads);
    transpose_convert(P.in[6], 64, A_W, A_W, (bf16*)(ws + WS_W2T), gtid, gthreads);
    transpose_convert(P.in[8], 64, A_W, A_W, (bf16*)(ws + WS_A2T), gtid, gthreads);
    transpose_convert(P.in[9], 128, A_W, A_W, (bf16*)(ws + WS_G2T), gtid, gthreads);
    const int gw = blockIdx.x * NWAVES + wave, ngw = gridDim.x * NWAVES;
    for (int m = gw; m < M; m += ngw) ln_row_bf16(P.in[0] + (size_t)m * D, P.in[1], P.in[2], (bf16*)(ws + WS_H0) + (size_t)m * D, lane);
}

typedef short bf16x8_t __attribute__((ext_vector_type(8)));
template <int KS, int LDA>
__device__ __forceinline__ void lora_mm(f32x4 (&acc)[4][4], const LAS bf16* ACT, const bf16* WT, int c0, int fr, int fq) {
#pragma unroll
    for (int mt = 0; mt < 4; ++mt)
#pragma unroll
        for (int nt = 0; nt < 4; ++nt) acc[mt][nt] = (f32x4){0.f, 0.f, 0.f, 0.f};
#pragma unroll
    for (int s = 0; s < KS; ++s) {
        bf16x8_t af[4], bfr[4];
#pragma unroll
        for (int mt = 0; mt < 4; ++mt) af[mt] = *(const LAS bf16x8_t*)(ACT + (mt * 16 + fr) * LDA + 32 * s + 8 * fq);
#pragma unroll
        for (int nt = 0; nt < 4; ++nt) bfr[nt] = *(const bf16x8_t*)(WT + (size_t)(c0 + nt * 16 + fr) * (32 * KS) + 32 * s + 8 * fq);
#pragma unroll
        for (int mt = 0; mt < 4; ++mt)
#pragma unroll
            for (int nt = 0; nt < 4; ++nt) acc[mt][nt] = __builtin_amdgcn_mfma_f32_16x16x32_bf16(bfr[nt], af[mt], acc[mt][nt], 0, 0, 0);
    }
}
__device__ __forceinline__ void phase_prep(const Params& P, LAS unsigned char* lds) {
    const int tid = threadIdx.x, lane = tid & 63, wave = __builtin_amdgcn_readfirstlane(tid >> 6), fr = lane & 15, fq = lane >> 4;
    unsigned char* ws = P.ws;
    const bf16* p = (const bf16*)(ws + WS_P);
    const float* mu = P.in[4]; const float* w0 = P.in[5]; const float* a0 = P.in[7];
    const float* gkw2 = P.in[16]; const float* gkb = P.in[17];
    const bf16* W2T = (const bf16*)(ws + WS_W2T); const bf16* A2T = (const bf16*)(ws + WS_A2T); const bf16* G2T = (const bf16*)(ws + WS_G2T);
    bf16* WL = (bf16*)(ws + WS_WL); bf16* AA = (bf16*)(ws + WS_AA); bf16* GG = (bf16*)(ws + WS_GG); bf16* GK = (bf16*)(ws + WS_GK);
    LAS bf16* TW = (LAS bf16*)lds; LAS bf16* AD = TW + 64 * 72; LAS bf16* SG = AD + 64 * 72;
    LAS float* gkd = (LAS float*)(SG + 64 * 136);
    const int c0 = wave * 64;
    for (int tile = blockIdx.x; tile < M / 64; tile += gridDim.x) {
        const int m0 = tile * 64;
        __syncthreads();
        for (int idx = tid; idx < 64 * 32; idx += NTHR) {
            const int j = (idx & 31) * 8, tok = idx >> 5, m = m0 + tok, t = m & (T - 1);
            const u32x4 cw = *(const u32x4*)(p + (size_t)m * NP + C_WD + j); const u32x4 pw = (t > 0) ? *(const u32x4*)(p + (size_t)(m - 1) * NP + C_WD + j) : (u32x4){0u, 0u, 0u, 0u};
            const f32x4 m0v = *(const f32x4*)(mu + C_WD + j), m1v = *(const f32x4*)(mu + C_WD + j + 4);
            float x[8];
#pragma unroll
            for (int i = 0; i < 4; ++i) { const float c0 = __uint_as_float(cw[i] << 16), c1 = __uint_as_float(cw[i] & 0xffff0000u), q0 = __uint_as_float(pw[i] << 16), q1 = __uint_as_float(pw[i] & 0xffff0000u);
                const float mu0 = i < 2 ? m0v[2 * i] : m1v[2 * i - 4], mu1 = i < 2 ? m0v[2 * i + 1] : m1v[2 * i - 3];
                x[2 * i] = c0 + (q0 - c0) * mu0; x[2 * i + 1] = c1 + (q1 - c1) * mu1; }
            u32x4 o;
            if (j < 64) {
#pragma unroll
                for (int i = 0; i < 4; ++i) o[i] = pk2(1.f - 2.f * __builtin_amdgcn_rcpf(1.f + __expf(2.f * x[2 * i])), 1.f - 2.f * __builtin_amdgcn_rcpf(1.f + __expf(2.f * x[2 * i + 1])));
                *(LAS u32x4*)(TW + tok * 72 + j) = o;
            } else if (j < 128) {
#pragma unroll
                for (int i = 0; i < 4; ++i) o[i] = pk2(x[2 * i], x[2 * i + 1]);
                *(LAS u32x4*)(AD + tok * 72 + j - 64) = o;
            } else {
#pragma unroll
                for (int i = 0; i < 4; ++i) o[i] = pk2(sigmoidf_(x[2 * i]), sigmoidf_(x[2 * i + 1]));
                *(LAS u32x4*)(SG + tok * 136 + j - 128) = o;
            }
        }
        for (int idx = tid; idx < 64 * 16; idx += NTHR) { const int j = idx & 15, tok = idx >> 4; gkd[tok * 16 + j] = bf2f(p[(size_t)(m0 + tok) * NP + C_GKD + j]); }
        __syncthreads();
        f32x4 acc[4][4];
        lora_mm<2, 72>(acc, TW, W2T, c0, fr, fq);
#pragma unroll
        for (int nt = 0; nt < 4; ++nt) { const int c = c0 + nt * 16 + 4 * fq; const f32x4 b = *(const f32x4*)(w0 + c);
#pragma unroll
            for (int mt = 0; mt < 4; ++mt) { float o[4];
#pragma unroll
                for (int i = 0; i < 4; ++i) { const float z = b[i] + acc[mt][nt][i]; o[i] = -0.6065306597126334f * sigmoidf_(z); }
                u32x2 w; w.x = pk2(o[0], o[1]); w.y = pk2(o[2], o[3]); *(u32x2*)(WL + (size_t)(m0 + mt * 16 + fr) * A_W + c) = w; } }
        lora_mm<2, 72>(acc, AD, A2T, c0, fr, fq);
#pragma unroll
        for (int nt = 0; nt < 4; ++nt) { const int c = c0 + nt * 16 + 4 * fq; const f32x4 b = *(const f32x4*)(a0 + c);
#pragma unroll
            for (int mt = 0; mt < 4; ++mt) { float o[4];
#pragma unroll
                for (int i = 0; i < 4; ++i) o[i] = sigmoidf_(b[i] + acc[mt][nt][i]);
                u32x2 w; w.x = pk2(o[0], o[1]); w.y = pk2(o[2], o[3]); *(u32x2*)(AA + (size_t)(m0 + mt * 16 + fr) * A_W + c) = w; } }
        lora_mm<4, 136>(acc, SG, G2T, c0, fr, fq);
#pragma unroll
        for (int nt = 0; nt < 4; ++nt) { const int c = c0 + nt * 16 + 4 * fq;
#pragma unroll
            for (int mt = 0; mt < 4; ++mt) { u32x2 w; w.x = pk2(acc[mt][nt][0], acc[mt][nt][1]); w.y = pk2(acc[mt][nt][2], acc[mt][nt][3]); *(u32x2*)(GG + (size_t)(m0 + mt * 16 + fr) * A_W + c) = w; } }
        { const int cc = tid & 255, th = tid >> 8; float wv[16];
#pragma unroll
          for (int j = 0; j < 16; ++j) wv[j] = gkw2[j * 256 + cc];
          const float bb = gkb[cc];
          for (int i = 0; i < 32; ++i) { const int tok = th * 32 + i; float sacc = bb;
#pragma unroll
              for (int j = 0; j < 16; ++j) sacc += gkd[tok * 16 + j] * wv[j];
              GK[(size_t)(m0 + tok) * 256 + cc] = (bf16)f2bf(-(fmaxf(-sacc, 0.f) + __logf(1.f + __expf(-fabsf(sacc)))) * (1.f / 16.f)); } }
    }
}

constexpr int CH = 32;
__device__ __forceinline__ float red8(float v) { v = DPP_ADD(v, 0xB1); v = DPP_ADD(v, 0x4E); v = DPP_ADD(v, 0x141); return v; }

constexpr int RW_BUF = 6 * CH * 64;
__device__ __forceinline__ void rw_load(const bf16* p, const bf16* AA, const bf16* WL, int b, int t0, int col, int wave,
        unsigned (&rc)[4], unsigned (&kc)[4], unsigned (&vc)[4], unsigned (&rp)[4], unsigned (&kp)[4], unsigned (&vp)[4], unsigned (&a)[4], unsigned (&wl)[4]) {
#pragma unroll
    for (int q = 0; q < 4; ++q) {
        const int t = t0 + wave + 8 * q; const size_t m = (size_t)b * T + t; const bf16* pr = p + m * NP; const bf16* pp = (t > 0) ? pr - NP : pr;
        rc[q] = pr[C_R + col]; kc[q] = pr[C_K + col]; vc[q] = pr[C_V + col]; rp[q] = pp[C_R + col]; kp[q] = pp[C_K + col]; vp[q] = pp[C_V + col];
        a[q] = AA[m * A_W + col]; wl[q] = WL[m * A_W + col];
    }
}
__device__ __forceinline__ void rw_prep(LAS float* B, int t0, int wave, int lane, float mu_r, float mu_k, float mu_v, float kkc, float kac,
        const unsigned (&rc_)[4], const unsigned (&kc_)[4], const unsigned (&vc_)[4], const unsigned (&rp_)[4], const unsigned (&kp_)[4], const unsigned (&vp_)[4], const unsigned (&a_)[4], const unsigned (&wl_)[4]) {
    LAS float* R = B; LAS float* DEC = R + CH * 64; LAS float* KH = DEC + CH * 64; LAS float* KK = KH + CH * 64; LAS float* BB = KK + CH * 64; LAS float* V = BB + CH * 64;
#pragma unroll
    for (int q = 0; q < 4; ++q) {
        const int tt = wave + 8 * q; const float hp = (t0 + tt > 0) ? 1.f : 0.f;
        const float rc = bf2f(rc_[q]), kc = bf2f(kc_[q]), vc = bf2f(vc_[q]), rp = bf2f(rp_[q]) * hp, kp = bf2f(kp_[q]) * hp, vp = bf2f(vp_[q]) * hp;
        const float r = rc + (rp - rc) * mu_r, k = kc + (kp - kc) * mu_k, v = vc + (vp - vc) * mu_v;
        const float a = bf2f(a_[q]), wl = bf2f(wl_[q]);
        const float kr = k * kkc; const float nrm = sqrtf(wave_sum(kr * kr)); const float kk = kr / fmaxf(nrm, 1e-12f);
        const float kh = k * (1.f + (a - 1.f) * kac);
        R[tt * 64 + lane] = r; DEC[tt * 64 + lane] = __expf(wl); KH[tt * 64 + lane] = kh; KK[tt * 64 + lane] = kk; BB[tt * 64 + lane] = kk * a; V[tt * 64 + lane] = v;
    }
}
struct RwOps { f32x4 k0, k1, d0, d1, b0, b1, h0, h1, q0, q1; float v0, v1; };
__device__ __forceinline__ void rw_ops_load(RwOps& o, const LAS float* B, int tt, int s8, int vr0) {
    const LAS float* R = B; const LAS float* DEC = R + CH * 64; const LAS float* KH = DEC + CH * 64; const LAS float* KK = KH + CH * 64; const LAS float* BB = KK + CH * 64; const LAS float* V = BB + CH * 64;
    o.k0 = *(const LAS f32x4*)(KK + tt * 64 + s8); o.k1 = *(const LAS f32x4*)(KK + tt * 64 + s8 + 4);
    o.d0 = *(const LAS f32x4*)(DEC + tt * 64 + s8); o.d1 = *(const LAS f32x4*)(DEC + tt * 64 + s8 + 4);
    o.b0 = *(const LAS f32x4*)(BB + tt * 64 + s8); o.b1 = *(const LAS f32x4*)(BB + tt * 64 + s8 + 4);
    o.h0 = *(const LAS f32x4*)(KH + tt * 64 + s8); o.h1 = *(const LAS f32x4*)(KH + tt * 64 + s8 + 4);
    o.q0 = *(const LAS f32x4*)(R + tt * 64 + s8); o.q1 = *(const LAS f32x4*)(R + tt * 64 + s8 + 4);
    o.v0 = V[tt * 64 + vr0]; o.v1 = V[tt * 64 + vr0 + 1];
}
template <bool IDENT> __device__ __forceinline__ void rw_step(const RwOps& o, f32x2 (&S0)[4], f32x2 (&S1)[4], LAS float* Y, int tt, int r0, int lane) {
    const float vv0 = o.v0, vv1 = o.v1;
    const f32x2 kk[4] = {o.k0.lo, o.k0.hi, o.k1.lo, o.k1.hi}, dd[4] = {o.d0.lo, o.d0.hi, o.d1.lo, o.d1.hi}, bb[4] = {o.b0.lo, o.b0.hi, o.b1.lo, o.b1.hi}, hh[4] = {o.h0.lo, o.h0.hi, o.h1.lo, o.h1.hi}, rr[4] = {o.q0.lo, o.q0.hi, o.q1.lo, o.q1.hi};
    f32x2 a0 = S0[0] * kk[0], a1 = S1[0] * kk[0];
#pragma unroll
    for (int i = 1; i < 4; ++i) { a0 = S0[i] * kk[i] + a0; a1 = S1[i] * kk[i] + a1; }
    const float sa0 = -red8(a0.x + a0.y), sa1 = -red8(a1.x + a1.y);
    f32x2 y0 = (f32x2){0.f, 0.f}, y1 = (f32x2){0.f, 0.f};
#pragma unroll
    for (int i = 0; i < 4; ++i) {
        if (IDENT) { S0[i] = bb[i] * sa0 + S0[i] * dd[i]; S1[i] = bb[i] * sa1 + S1[i] * dd[i]; }
        else { S0[i] = hh[i] * vv0 + (bb[i] * sa0 + S0[i] * dd[i]); S1[i] = hh[i] * vv1 + (bb[i] * sa1 + S1[i] * dd[i]); }
        y0 = S0[i] * rr[i] + y0; y1 = S1[i] * rr[i] + y1;
    }
    const float yy0 = red8(y0.x + y0.y), yy1 = red8(y1.x + y1.y);
    if ((lane & 7) == 0) { Y[tt * 128 + r0] = yy0; Y[tt * 128 + r0 + 1] = yy1; }
}
__device__ __forceinline__ void rwkv_item(const Params& P, LAS unsigned char* lds, int b, int h, int seg) {
    const int tid = threadIdx.x, lane = tid & 63, wave = tid >> 6;
    unsigned char* ws = P.ws;
    const bf16* p = (const bf16*)(ws + WS_P); const bf16* WL = (const bf16*)(ws + WS_WL); const bf16* AA = (const bf16*)(ws + WS_AA);
    bf16* MIX = (bf16*)P.out; bf16* YI = (bf16*)(ws + WS_YI);
    const float* mu = P.in[4]; const float* k_k = P.in[10]; const float* k_a = P.in[11];
    LAS float* BUF = (LAS float*)lds; LAS float* Y = BUF + 2 * RW_BUF;
    const int col = h * 64 + lane;
    const float mu_r = mu[C_R + col], mu_k = mu[C_K + col], mu_v = mu[C_V + col], kkc = k_k[col], kac = k_a[col];
    const int r0 = wave * 16 + 2 * (lane >> 3), s8 = (lane & 7) * 8; const int ident = r0 >> 6, vr0 = r0 & 63, vr1 = vr0 + 1;
    float* SE = (float*)(ws + WS_SER) + ((((size_t)(b * 8 + h) * NSEG + seg) * 2 + ident) * 4096) + vr0 * 64 + s8;
    f32x2 S0[4], S1[4];
#pragma unroll
    for (int i = 0; i < 4; ++i) { S0[i] = (f32x2){(ident && (s8 + 2 * i == vr0)) ? 1.f : 0.f, (ident && (s8 + 2 * i + 1 == vr0)) ? 1.f : 0.f};
        S1[i] = (f32x2){(ident && (s8 + 2 * i == vr1)) ? 1.f : 0.f, (ident && (s8 + 2 * i + 1 == vr1)) ? 1.f : 0.f}; }
    const int tbeg = seg * LSEG;
    unsigned rc[4], kc[4], vc[4], rp[4], kp[4], vp[4], a[4], wl[4];
    __syncthreads();
    rw_load(p, AA, WL, b, tbeg, col, wave, rc, kc, vc, rp, kp, vp, a, wl);
    rw_prep(BUF, tbeg, wave, lane, mu_r, mu_k, mu_v, kkc, kac, rc, kc, vc, rp, kp, vp, a, wl);
    __syncthreads();
    for (int ci = 0; ci < LSEG / CH; ++ci) {
        const int t0 = tbeg + ci * CH; LAS float* B = BUF + (ci & 1) * RW_BUF;
        LAS float* R = B; LAS float* DEC = R + CH * 64; LAS float* KH = DEC + CH * 64; LAS float* KK = KH + CH * 64; LAS float* BB = KK + CH * 64; LAS float* V = BB + CH * 64;
        const bool more = (ci + 1 < LSEG / CH);
        if (more) rw_load(p, AA, WL, b, t0 + CH, col, wave, rc, kc, vc, rp, kp, vp, a, wl);
        { RwOps oa, ob; rw_ops_load(oa, B, 0, s8, vr0);
          if (ident) for (int tt = 0; tt < CH; tt += 2) {
              rw_ops_load(ob, B, tt + 1, s8, vr0); rw_step<true>(oa, S0, S1, Y, tt, r0, lane);
              rw_ops_load(oa, B, (tt + 2) & (CH - 1), s8, vr0); rw_step<true>(ob, S0, S1, Y, tt + 1, r0, lane);
          } else for (int tt = 0; tt < CH; tt += 2) {
              rw_ops_load(ob, B, tt + 1, s8, vr0); rw_step<false>(oa, S0, S1, Y, tt, r0, lane);
              rw_ops_load(oa, B, (tt + 2) & (CH - 1), s8, vr0); rw_step<false>(ob, S0, S1, Y, tt + 1, r0, lane);
          } }
        __syncthreads();
        if (more) rw_prep(BUF + ((ci + 1) & 1) * RW_BUF, t0 + CH, wave, lane, mu_r, mu_k, mu_v, kkc, kac, rc, kc, vc, rp, kp, vp, a, wl);
#pragma unroll
        for (int q = 0; q < 4; ++q) {
            const int tt = wave + 8 * q; const size_t m = (size_t)b * T + t0 + tt;
            MIX[m * D + col] = (bf16)f2bf(Y[tt * 128 + lane]); YI[m * 512 + col] = (bf16)f2bf(Y[tt * 128 + 64 + lane]);
        }
        __syncthreads();
    }
    *(f32x4*)(SE) = (f32x4){S0[0].x, S0[0].y, S0[1].x, S0[1].y}; *(f32x4*)(SE + 4) = (f32x4){S0[2].x, S0[2].y, S0[3].x, S0[3].y};
    *(f32x4*)(SE + 64) = (f32x4){S1[0].x, S1[0].y, S1[1].x, S1[1].y}; *(f32x4*)(SE + 68) = (f32x4){S1[2].x, S1[2].y, S1[3].x, S1[3].y};
}

constexpr int W_AT = 0, W_BT = 4608, W_KT = 9216, W_LAK = 13824, W_L1 = 0, W_LT1 = 4608, W_X1 = 9216, W_RT = 18432, W_BTT = 23040, W_KTT = 27648, W_VTT = 32256, W_X0 = 36864,
              W_L0 = 46080, W_LT0 = 50688, W_QT = 46080, W_TT = 50688, W_LRB = 55296, W_LRK = 59904, W_SIM = 64512, W_PIM = 69120, W_END = 73728;
__device__ __forceinline__ bf16x8_t lfrag(const LAS bf16* base, int row, int sx, int fq) { return *(const LAS bf16x8_t*)(base + row * 72 + 32 * sx + 8 * fq); }
#define MFMA16(a, b, c) __builtin_amdgcn_mfma_f32_16x16x32_bf16((a), (b), (c), 0, 0, 0)
__device__ __forceinline__ void st4(LAS bf16* dst, float a, float b, float c, float d) { u32x2 w; w.x = pk2(a, b); w.y = pk2(c, d); *(LAS u32x2*)dst = w; }
__device__ __forceinline__ f32x4 ld4(const LAS bf16* src) { const u32x2 w = *(const LAS u32x2*)src; return (f32x4){__uint_as_float(w.x << 16), __uint_as_float(w.x & 0xffff0000u), __uint_as_float(w.y << 16), __uint_as_float(w.y & 0xffff0000u)}; }
__device__ __forceinline__ void rwkv_item_chunked(const Params& P, LAS unsigned char* lds, int b, int h, int seg) {
    const int tid = threadIdx.x, lane = tid & 63, wave = __builtin_amdgcn_readfirstlane(tid >> 6), fr = lane & 15, fq = lane >> 4;
    unsigned char* ws = P.ws;
    const bf16* p = (const bf16*)(ws + WS_P); const bf16* WL = (const bf16*)(ws + WS_WL); const bf16* AA = (const bf16*)(ws + WS_AA);
    bf16* MIX = (bf16*)P.out; bf16* YI = (bf16*)(ws + WS_YI);
    const float* mu = P.in[4]; const float* k_k = P.in[10]; const float* k_a = P.in[11];
    LAS bf16* L = (LAS bf16*)lds;
    LAS float* GAM = (LAS float*)(lds + W_END * 2); LAS float* TOT = GAM + 64;
    const int col = h * 64 + lane, tg = wave;
    const float mu_r = mu[C_R + col], mu_k = mu[C_K + col], mu_v = mu[C_V + col], kkc = k_k[col], kac = k_a[col];
    const bool ident = wave >= 4; const int w4 = wave & 3;
    f32x4 Wreg[4];
#pragma unroll
    for (int k = 0; k < 4; ++k) Wreg[k] = (f32x4){0.f, 0.f, 0.f, 0.f};
    __syncthreads();
    for (int i = tid; i < 2 * 64 * 72 / 2; i += NTHR) ((LAS unsigned*)(L + W_SIM))[i] = 0u;
    __syncthreads();
    if (tid < 64) L[W_PIM + tid * 72 + tid] = (bf16)0x3F80;
    unsigned nr_[9], nk_[9], nv_[9], na_[8], nw_[8];
    { const int t0 = seg * LSEG;
#pragma unroll
      for (int r = 0; r < 9; ++r) { const int t = t0 + 8 * tg - 1 + r; const bf16* pr = p + ((size_t)b * T + (t > 0 ? t : 0)) * NP; nr_[r] = pr[C_R + col]; nk_[r] = pr[C_K + col]; nv_[r] = pr[C_V + col]; }
#pragma unroll
      for (int i = 0; i < 8; ++i) { const size_t m = (size_t)b * T + t0 + 8 * tg + i; na_[i] = AA[m * A_W + col]; nw_[i] = WL[m * A_W + col]; } }
    for (int c = 0; c < LSEG / 64; ++c) {
        const int t0 = seg * LSEG + c * 64;
        __syncthreads();
        float rv[8], kkv[8], bv[8], khv[8], vv[8], g[8], wl[8];
        unsigned xr[9], xk[9], xv[9], xa[8], xw[8];
#pragma unroll
        for (int r = 0; r < 9; ++r) { xr[r] = nr_[r]; xk[r] = nk_[r]; xv[r] = nv_[r]; }
#pragma unroll
        for (int i = 0; i < 8; ++i) { xa[i] = na_[i]; xw[i] = nw_[i]; }
        if (c + 1 < LSEG / 64) {
#pragma unroll
            for (int r = 0; r < 9; ++r) { const int t = t0 + 64 + 8 * tg - 1 + r; const bf16* pr = p + ((size_t)b * T + t) * NP; nr_[r] = pr[C_R + col]; nk_[r] = pr[C_K + col]; nv_[r] = pr[C_V + col]; }
#pragma unroll
            for (int i = 0; i < 8; ++i) { const size_t m = (size_t)b * T + t0 + 64 + 8 * tg + i; na_[i] = AA[m * A_W + col]; nw_[i] = WL[m * A_W + col]; }
        }
#pragma unroll
        for (int i = 0; i < 8; ++i) { const int t = t0 + 8 * tg + i; const float hp = (t > 0) ? 1.f : 0.f;
            const float rc = bf2f(xr[i + 1]), kc = bf2f(xk[i + 1]), vc = bf2f(xv[i + 1]);
            const float r = rc + (bf2f(xr[i]) * hp - rc) * mu_r, k = kc + (bf2f(xk[i]) * hp - kc) * mu_k; vv[i] = vc + (bf2f(xv[i]) * hp - vc) * mu_v;
            const float a = bf2f(xa[i]); wl[i] = bf2f(xw[i]);
            const float kr = k * kkc; const float nrm = sqrtf(wave_sum(kr * kr)); const float kk = kr / fmaxf(nrm, 1e-12f);
            rv[i] = r; kkv[i] = kk; bv[i] = kk * a; khv[i] = k * (1.f + (a - 1.f) * kac); }
        g[0] = wl[0];
#pragma unroll
        for (int i = 1; i < 8; ++i) g[i] = g[i - 1] + wl[i];
        TOT[tg * 64 + lane] = g[7];
        __syncthreads();
        float off = 0.f, total = 0.f;
#pragma unroll
        for (int w = 0; w < 8; ++w) { const float tv = TOT[w * 64 + lane]; total += tv; off += (w < tg) ? tv : 0.f; }
        { float at[8], bt[8], kt[8];
#pragma unroll
          for (int i = 0; i < 8; ++i) { const float G = off + g[i]; const float eG = __expf(G), eGm = __expf(G - wl[i]), ei = __expf(-G);
              at[i] = -kkv[i] * eGm; bt[i] = bv[i] * ei; kt[i] = khv[i] * ei; const float rt = rv[i] * eG; const int row = 8 * tg + i;
              L[W_AT + row * 72 + lane] = (bf16)f2bf(at[i]); L[W_BT + row * 72 + lane] = (bf16)f2bf(bt[i]); L[W_KT + row * 72 + lane] = (bf16)f2bf(kt[i]); L[W_RT + row * 72 + lane] = (bf16)f2bf(rt); }
          u32x4 w;
          w.x = pk2(at[0], at[1]); w.y = pk2(at[2], at[3]); w.z = pk2(at[4], at[5]); w.w = pk2(at[6], at[7]); *(LAS u32x4*)(L + W_X0 + lane * 72 + 8 * tg) = w;
          w.x = pk2(bt[0], bt[1]); w.y = pk2(bt[2], bt[3]); w.z = pk2(bt[4], bt[5]); w.w = pk2(bt[6], bt[7]); *(LAS u32x4*)(L + W_BTT + lane * 72 + 8 * tg) = w;
          w.x = pk2(kt[0], kt[1]); w.y = pk2(kt[2], kt[3]); w.z = pk2(kt[4], kt[5]); w.w = pk2(kt[6], kt[7]); *(LAS u32x4*)(L + W_KTT + lane * 72 + 8 * tg) = w;
          w.x = pk2(vv[0], vv[1]); w.y = pk2(vv[2], vv[3]); w.z = pk2(vv[4], vv[5]); w.w = pk2(vv[6], vv[7]); *(LAS u32x4*)(L + W_VTT + lane * 72 + 8 * tg) = w; }
        if (tg == 0) GAM[lane] = __expf(total);
        __syncthreads();
        { bf16x8_t aB[2][2], aK[2][2], bA[2][2], bR[2][2]; f32x4 ab[2], ak[2], rb[2], rk[2];
#pragma unroll
          for (int q = 0; q < 2; ++q) { const int pos = wave * 2 + q, it = pos >> 2, tt = pos & 3;
#pragma unroll
              for (int sx = 0; sx < 2; ++sx) { aB[q][sx] = lfrag(L + W_BT, it * 16 + fr, sx, fq); aK[q][sx] = lfrag(L + W_KT, it * 16 + fr, sx, fq); bA[q][sx] = lfrag(L + W_AT, tt * 16 + fr, sx, fq); bR[q][sx] = lfrag(L + W_RT, tt * 16 + fr, sx, fq); } }
#pragma unroll
          for (int q = 0; q < 2; ++q) { ab[q] = (f32x4){0.f, 0.f, 0.f, 0.f}; ak[q] = ab[q]; rb[q] = ab[q]; rk[q] = ab[q];
#pragma unroll
              for (int sx = 0; sx < 2; ++sx) { ab[q] = MFMA16(aB[q][sx], bA[q][sx], ab[q]); ak[q] = MFMA16(aK[q][sx], bA[q][sx], ak[q]); rb[q] = MFMA16(aB[q][sx], bR[q][sx], rb[q]); rk[q] = MFMA16(aK[q][sx], bR[q][sx], rk[q]); } }
#pragma unroll
          for (int q = 0; q < 2; ++q) { const int pos = wave * 2 + q, it = pos >> 2, tt = pos & 3; const int t = tt * 16 + fr, i0 = it * 16 + 4 * fq;
#pragma unroll
              for (int rg = 0; rg < 4; ++rg) { const bool st = (i0 + rg < t), inc = (i0 + rg <= t); ab[q][rg] = st ? ab[q][rg] : 0.f; ak[q][rg] = st ? ak[q][rg] : 0.f; rb[q][rg] = inc ? rb[q][rg] : 0.f; rk[q][rg] = inc ? rk[q][rg] : 0.f; }
              st4(L + W_L0 + t * 72 + i0, ab[q][0], ab[q][1], ab[q][2], ab[q][3]); st4(L + W_LAK + t * 72 + i0, ak[q][0], ak[q][1], ak[q][2], ak[q][3]);
              st4(L + W_LRB + t * 72 + i0, rb[q][0], rb[q][1], rb[q][2], rb[q][3]); st4(L + W_LRK + t * 72 + i0, rk[q][0], rk[q][1], rk[q][2], rk[q][3]);
#pragma unroll
              for (int rg = 0; rg < 4; ++rg) L[W_LT0 + (i0 + rg) * 72 + t] = (bf16)f2bf(ab[q][rg]); } }
        __syncthreads();
        { bf16x8_t a[2][2], bb[2][2]; f32x4 acc[2];
#pragma unroll
          for (int q = 0; q < 2; ++q) { const int pos = wave * 2 + q, tt = pos >> 2, vt = pos & 3;
#pragma unroll
              for (int sx = 0; sx < 2; ++sx) { a[q][sx] = lfrag(L + W_LAK, tt * 16 + fr, sx, fq); bb[q][sx] = lfrag(L + W_VTT, vt * 16 + fr, sx, fq); } }
#pragma unroll
          for (int q = 0; q < 2; ++q) { acc[q] = (f32x4){0.f, 0.f, 0.f, 0.f};
#pragma unroll
              for (int sx = 0; sx < 2; ++sx) acc[q] = MFMA16(a[q][sx], bb[q][sx], acc[q]); }
#pragma unroll
          for (int q = 0; q < 2; ++q) { const int pos = wave * 2 + q, tt = pos >> 2, vt = pos & 3; st4(L + W_X0 + (64 + vt * 16 + fr) * 72 + tt * 16 + 4 * fq, acc[q][0], acc[q][1], acc[q][2], acc[q][3]); } }
        __syncthreads();
#pragma unroll 1
        for (int pp_ = 0; pp_ < 6; ++pp_) {
            const int odd = pp_ & 1;
            LAS bf16* Lr = L + (odd ? W_L1 : W_L0); LAS bf16* LTr = L + (odd ? W_LT1 : W_LT0); LAS bf16* Xr = L + (odd ? W_X1 : W_X0);
            LAS bf16* Lw = L + (odd ? W_L0 : W_L1); LAS bf16* LTw = L + (odd ? W_LT0 : W_LT1); LAS bf16* Xw = L + (odd ? W_X0 : W_X1);
            { const bf16x8_t b0 = lfrag(Xr, wave * 16 + fr, 0, fq), b1 = lfrag(Xr, wave * 16 + fr, 1, fq);
              bf16x8_t la[4][2], lt[2][2]; f32x4 xa[4], sq[2];
#pragma unroll
              for (int tt = 0; tt < 4; ++tt) { la[tt][0] = lfrag(Lr, tt * 16 + fr, 0, fq); la[tt][1] = lfrag(Lr, tt * 16 + fr, 1, fq); xa[tt] = ld4(Xr + (wave * 16 + fr) * 72 + tt * 16 + 4 * fq); }
#pragma unroll
              for (int q = 0; q < 2; ++q) { const int it = (wave * 2 + q) & 3; lt[q][0] = lfrag(LTr, it * 16 + fr, 0, fq); lt[q][1] = lfrag(LTr, it * 16 + fr, 1, fq); }
#pragma unroll
              for (int tt = 0; tt < 4; ++tt) { xa[tt] = MFMA16(la[tt][0], b0, xa[tt]); xa[tt] = MFMA16(la[tt][1], b1, xa[tt]); }
#pragma unroll
              for (int q = 0; q < 2; ++q) { const int tq = (wave * 2 + q) >> 2; sq[q] = (f32x4){0.f, 0.f, 0.f, 0.f};
                  const bf16x8_t a0 = tq == 0 ? la[0][0] : tq == 1 ? la[1][0] : tq == 2 ? la[2][0] : la[3][0], a1 = tq == 0 ? la[0][1] : tq == 1 ? la[1][1] : tq == 2 ? la[2][1] : la[3][1];
                  sq[q] = MFMA16(a0, lt[q][0], sq[q]); sq[q] = MFMA16(a1, lt[q][1], sq[q]); }
#pragma unroll
              for (int tt = 0; tt < 4; ++tt) st4(Xw + (wave * 16 + fr) * 72 + tt * 16 + 4 * fq, xa[tt][0], xa[tt][1], xa[tt][2], xa[tt][3]);
              if (pp_ < 5) {
#pragma unroll
                  for (int q = 0; q < 2; ++q) { const int pos = wave * 2 + q, tt = pos >> 2, it = pos & 3;
                      st4(LTw + (it * 16 + fr) * 72 + tt * 16 + 4 * fq, sq[q][0], sq[q][1], sq[q][2], sq[q][3]);
#pragma unroll
                      for (int rg = 0; rg < 4; ++rg) Lw[(tt * 16 + 4 * fq + rg) * 72 + it * 16 + fr] = (bf16)f2bf(sq[q][rg]); } } }
            __syncthreads();
        }
        { bf16x8_t aX[2][2], bT[2][2], bL[2][2]; f32x4 accT[2], accQ[2], rt[2]; float gm[2];
#pragma unroll
          for (int q = 0; q < 2; ++q) { const int pos = wave * 2 + q, kt = pos >> 2, nt = pos & 3;
#pragma unroll
              for (int sx = 0; sx < 2; ++sx) { aX[q][sx] = lfrag(L + W_X0, kt * 16 + fr, sx, fq); bT[q][sx] = lfrag(L + W_BTT, nt * 16 + fr, sx, fq); bL[q][sx] = lfrag(L + W_LRB, nt * 16 + fr, sx, fq); }
              gm[q] = GAM[nt * 16 + fr]; rt[q] = ld4(L + W_RT + (nt * 16 + fr) * 72 + kt * 16 + 4 * fq); }
#pragma unroll
          for (int q = 0; q < 2; ++q) { accT[q] = (f32x4){0.f, 0.f, 0.f, 0.f}; accQ[q] = accT[q];
#pragma unroll
              for (int sx = 0; sx < 2; ++sx) { accT[q] = MFMA16(aX[q][sx], bT[q][sx], accT[q]); accQ[q] = MFMA16(aX[q][sx], bL[q][sx], accQ[q]); } }
#pragma unroll
          for (int q = 0; q < 2; ++q) { const int pos = wave * 2 + q, kt = pos >> 2, nt = pos & 3; const int k0 = kt * 16 + 4 * fq, n = nt * 16 + fr;
#pragma unroll
              for (int rg = 0; rg < 4; ++rg) accT[q][rg] = (accT[q][rg] + ((k0 + rg == n) ? 1.f : 0.f)) * gm[q];
              st4(L + W_TT + n * 72 + k0, accT[q][0], accT[q][1], accT[q][2], accT[q][3]); st4(L + W_QT + n * 72 + k0, accQ[q][0] + rt[q][0], accQ[q][1] + rt[q][1], accQ[q][2] + rt[q][2], accQ[q][3] + rt[q][3]); } }
        __syncthreads();
        { f32x4 oacc[4];
#pragma unroll
          for (int vt = 0; vt < 4; ++vt) oacc[vt] = (f32x4){0.f, 0.f, 0.f, 0.f};
#pragma unroll
          for (int sx = 0; sx < 2; ++sx) { const bf16x8_t aQ = lfrag(L + W_QT, w4 * 16 + fr, sx, fq);
              if (!ident) { const bf16x8_t aB = lfrag(L + W_LRB, w4 * 16 + fr, sx, fq), aK = lfrag(L + W_LRK, w4 * 16 + fr, sx, fq);
#pragma unroll
                  for (int vt = 0; vt < 4; ++vt) { const int rw = 4 * fr + vt; oacc[vt] = MFMA16(aB, lfrag(L + W_X0, 64 + rw, sx, fq), oacc[vt]); oacc[vt] = MFMA16(aK, lfrag(L + W_VTT, rw, sx, fq), oacc[vt]); oacc[vt] = MFMA16(aQ, lfrag(L + W_SIM, rw, sx, fq), oacc[vt]); } }
              else {
#pragma unroll
                  for (int vt = 0; vt < 4; ++vt) oacc[vt] = MFMA16(aQ, lfrag(L + W_PIM, 4 * fr + vt, sx, fq), oacc[vt]); } }
          bf16* OUT = ident ? (YI + (size_t)h * 64) : (MIX + (size_t)h * 64); const int ldo = ident ? 512 : D;
#pragma unroll
          for (int rg = 0; rg < 4; ++rg) { const size_t m = (size_t)b * T + t0 + w4 * 16 + 4 * fq + rg; u32x2 w; w.x = pk2(oacc[0][rg], oacc[1][rg]); w.y = pk2(oacc[2][rg], oacc[3][rg]); *(u32x2*)(OUT + m * ldo + 4 * fr) = w; } }
#pragma unroll
        for (int nt = 0; nt < 4; ++nt) { f32x4 acc = (f32x4){0.f, 0.f, 0.f, 0.f};
            if (!ident) {
#pragma unroll
                for (int sx = 0; sx < 2; ++sx) { acc = MFMA16(lfrag(L + W_X0, 64 + w4 * 16 + fr, sx, fq), lfrag(L + W_BTT, nt * 16 + fr, sx, fq), acc); acc = MFMA16(lfrag(L + W_VTT, w4 * 16 + fr, sx, fq), lfrag(L + W_KTT, nt * 16 + fr, sx, fq), acc); }
                acc = acc * GAM[nt * 16 + fr]; }
            const LAS bf16* IM = L + (ident ? W_PIM : W_SIM);
#pragma unroll
            for (int sx = 0; sx < 2; ++sx) acc = MFMA16(lfrag(IM, w4 * 16 + fr, sx, fq), lfrag(L + W_TT, nt * 16 + fr, sx, fq), acc);
            Wreg[nt] = acc; }
        __syncthreads();
        { LAS bf16* IM = L + (ident ? W_PIM : W_SIM);
#pragma unroll
          for (int nt = 0; nt < 4; ++nt)
#pragma unroll
              for (int rg = 0; rg < 4; ++rg) IM[(w4 * 16 + 4 * fq + rg) * 72 + nt * 16 + fr] = (bf16)f2bf(Wreg[nt][rg]); }
    }
    float* SE = (float*)(ws + WS_SER) + ((((size_t)(b * 8 + h) * NSEG + seg) * 2 + (ident ? 1 : 0)) * 4096);
#pragma unroll
    for (int nt = 0; nt < 4; ++nt)
#pragma unroll
        for (int rg = 0; rg < 4; ++rg) SE[(w4 * 16 + 4 * fq + rg) * 64 + nt * 16 + fr] = Wreg[nt][rg];
}

constexpr int GQ = 0, GK_ = GQ + 64 * 72, GD = GK_ + 64 * 72, GV = GD + 64 * 72, GA = GV + 128 * 72, GS = GA + 64 * 72, GEND = GS + 128 * 72;
__device__ __forceinline__ unsigned pk2f(float a, float b) { return pk2(a, b); }
__device__ __forceinline__ void gla_item(const Params& P, LAS unsigned char* lds, int b, int h, int seg) {
    const int tid = threadIdx.x, lane = tid & 63, wave = __builtin_amdgcn_readfirstlane(tid >> 6), fr = lane & 15, fq = lane >> 4;
    unsigned char* ws = P.ws;
    const bf16* p = (const bf16*)(ws + WS_P); bf16* GKB = (bf16*)(ws + WS_GK);
    bf16* MIX = (bf16*)P.out;
    float* SE = (float*)(ws + WS_SEG) + ((size_t)(b * 4 + h) * NSEG + seg) * 8192; float* CE = (float*)(ws + WS_CEND) + ((size_t)(b * 4 + h) * NSEG + seg) * 64;
    const float* conv = P.in[15];
    LAS bf16* L = (LAS bf16*)lds; LAS bf16* QT = L + GQ; LAS bf16* KT = L + GK_; LAS bf16* KD = L + GD; LAS bf16* VT = L + GV; LAS bf16* AT = L + GA; LAS bf16* ST = L + GS;
    LAS float* GAM = (LAS float*)(lds + GEND * 2); LAS float* TOT = GAM + 64;
    const int ch = lane, tg = wave;
    const int cq = h * 64 + ch, ck = 256 + h * 64 + ch, cv0 = 512 + h * 128 + ch, cv1 = cv0 + 64;
    float wq[4], wk[4], wv0[4], wv1[4];
#pragma unroll
    for (int j = 0; j < 4; ++j) { wq[j] = conv[j * 1024 + cq]; wk[j] = conv[j * 1024 + ck]; wv0[j] = conv[j * 1024 + cv0]; wv1[j] = conv[j * 1024 + cv1]; }
    float gseg = 0.f;
    f32x4 Sacc[4];
#pragma unroll
    for (int k = 0; k < 4; ++k) Sacc[k] = (f32x4){0.f, 0.f, 0.f, 0.f};
    __syncthreads();
    for (int i = tid; i < 128 * 72 / 2; i += NTHR) ((LAS unsigned*)ST)[i] = 0u;
    for (int c = 0; c < LSEG / 64; ++c) {
        const int t0 = seg * LSEG + c * 64;
        __syncthreads();
        float xq[11], xk[11], xa[11], xb[11], g[8];
#pragma unroll
        for (int r = 0; r < 11; ++r) { const int t = t0 + 8 * tg - 3 + r; const size_t m = (size_t)b * T + (t > 0 ? t : 0); const float ok = (t >= 0) ? 1.f : 0.f; const bf16* pr = p + m * NP + C_BQ;
            xq[r] = bf2f(pr[cq]) * ok; xk[r] = bf2f(pr[ck]) * ok; xa[r] = bf2f(pr[cv0]) * ok; xb[r] = bf2f(pr[cv1]) * ok; }
#pragma unroll
        for (int i = 0; i < 8; ++i) g[i] = bf2f(GKB[((size_t)b * T + t0 + 8 * tg + i) * 256 + h * 64 + ch]);
#pragma unroll
        for (int i = 1; i < 8; ++i) g[i] += g[i - 1];
        TOT[tg * 64 + ch] = g[7];
        __syncthreads();
        float off = 0.f, total = 0.f;
#pragma unroll
        for (int w = 0; w < 8; ++w) { const float tv = TOT[w * 64 + ch]; total += tv; off += (w < tg) ? tv : 0.f; }
        float kd[8], va[8], vb[8];
#pragma unroll
        for (int i = 0; i < 8; ++i) {
            float aq = 0.f, ak = 0.f, a0 = 0.f, a1 = 0.f;
#pragma unroll
            for (int j = 0; j < 4; ++j) { aq += wq[j] * xq[i + j]; ak += wk[j] * xk[i + j]; a0 += wv0[j] * xa[i + j]; a1 += wv1[j] * xb[i + j]; }
            const float q = siluf_(aq) * 0.125f, k = siluf_(ak), Gc = off + g[i];
            QT[(8 * tg + i) * 72 + ch] = (bf16)f2bf(q * __expf(Gc)); KT[(8 * tg + i) * 72 + ch] = (bf16)f2bf(k * __expf(-Gc));
            kd[i] = k * __expf(total - Gc); va[i] = siluf_(a0); vb[i] = siluf_(a1);
            GKB[((size_t)b * T + t0 + 8 * tg + i) * 256 + h * 64 + ch] = (bf16)f2bf(q * __expf(gseg + Gc));
        }
        { u32x4 w; w.x = pk2f(kd[0], kd[1]); w.y = pk2f(kd[2], kd[3]); w.z = pk2f(kd[4], kd[5]); w.w = pk2f(kd[6], kd[7]); *(LAS u32x4*)(KD + ch * 72 + 8 * tg) = w;
          w.x = pk2f(va[0], va[1]); w.y = pk2f(va[2], va[3]); w.z = pk2f(va[4], va[5]); w.w = pk2f(va[6], va[7]); *(LAS u32x4*)(VT + ch * 72 + 8 * tg) = w;
          w.x = pk2f(vb[0], vb[1]); w.y = pk2f(vb[2], vb[3]); w.z = pk2f(vb[4], vb[5]); w.w = pk2f(vb[6], vb[7]); *(LAS u32x4*)(VT + (64 + ch) * 72 + 8 * tg) = w; }
        if (tg == 0) GAM[ch] = __expf(total);
        gseg += total;
        __syncthreads();
#pragma unroll
        for (int k2 = 0; k2 < 2; ++k2) { const int tile = wave * 2 + k2, jt = tile >> 2, it = tile & 3; f32x4 acc = (f32x4){0.f, 0.f, 0.f, 0.f};
            if (jt <= it) {
#pragma unroll
                for (int sx = 0; sx < 2; ++sx) acc = __builtin_amdgcn_mfma_f32_16x16x32_bf16(*(const LAS bf16x8_t*)(KT + (jt * 16 + fr) * 72 + 32 * sx + 8 * fq), *(const LAS bf16x8_t*)(QT + (it * 16 + fr) * 72 + 32 * sx + 8 * fq), acc, 0, 0, 0);
            }
            const int ii = it * 16 + fr, j0 = jt * 16 + 4 * fq; u32x2 w;
            w.x = pk2f(j0 <= ii ? acc[0] : 0.f, j0 + 1 <= ii ? acc[1] : 0.f); w.y = pk2f(j0 + 2 <= ii ? acc[2] : 0.f, j0 + 3 <= ii ? acc[3] : 0.f);
            *(LAS u32x2*)(AT + ii * 72 + j0) = w; }
        __syncthreads();
        { const int it = wave & 3, vts = (wave >> 2) * 4; f32x4 oacc[4];
#pragma unroll
          for (int k = 0; k < 4; ++k) oacc[k] = (f32x4){0.f, 0.f, 0.f, 0.f};
#pragma unroll
          for (int sx = 0; sx < 2; ++sx) { const bf16x8_t aA = *(const LAS bf16x8_t*)(AT + (it * 16 + fr) * 72 + 32 * sx + 8 * fq), aQ = *(const LAS bf16x8_t*)(QT + (it * 16 + fr) * 72 + 32 * sx + 8 * fq);
#pragma unroll
              for (int k = 0; k < 4; ++k) { const int vrow = 8 * fr + vts + k;
                  oacc[k] = __builtin_amdgcn_mfma_f32_16x16x32_bf16(aA, *(const LAS bf16x8_t*)(VT + vrow * 72 + 32 * sx + 8 * fq), oacc[k], 0, 0, 0);
                  oacc[k] = __builtin_amdgcn_mfma_f32_16x16x32_bf16(aQ, *(const LAS bf16x8_t*)(ST + vrow * 72 + 32 * sx + 8 * fq), oacc[k], 0, 0, 0); } }
#pragma unroll
          for (int rg = 0; rg < 4; ++rg) { const size_t m = (size_t)b * T + t0 + it * 16 + 4 * fq + rg; u32x2 w; w.x = pk2f(oacc[0][rg], oacc[1][rg]); w.y = pk2f(oacc[2][rg], oacc[3][rg]);
              *(u32x2*)(MIX + m * D + 512 + h * 128 + 8 * fr + vts) = w; } }
#pragma unroll
        for (int k = 0; k < 4; ++k) { f32x4 acc = Sacc[k] * GAM[k * 16 + fr];
#pragma unroll
            for (int sx = 0; sx < 2; ++sx) acc = __builtin_amdgcn_mfma_f32_16x16x32_bf16(*(const LAS bf16x8_t*)(VT + (wave * 16 + fr) * 72 + 32 * sx + 8 * fq), *(const LAS bf16x8_t*)(KD + (k * 16 + fr) * 72 + 32 * sx + 8 * fq), acc, 0, 0, 0);
            Sacc[k] = acc; }
        __syncthreads();
#pragma unroll
        for (int k = 0; k < 4; ++k)
#pragma unroll
            for (int rg = 0; rg < 4; ++rg) ST[(wave * 16 + 4 * fq + rg) * 72 + k * 16 + fr] = (bf16)f2bf(Sacc[k][rg]);
    }
#pragma unroll
    for (int k = 0; k < 4; ++k)
#pragma unroll
        for (int rg = 0; rg < 4; ++rg) SE[(wave * 16 + 4 * fq + rg) * 64 + k * 16 + fr] = Sacc[k][rg];
    if (tg == 0) CE[ch] = __expf(gseg);
}
__device__ __forceinline__ void phase_scan(const Params& P, LAS unsigned char* lds) {
    for (int it = blockIdx.x; it < 512 + 256; it += gridDim.x) {
        if (it < 512) { const int bh = it >> 4; rwkv_item_chunked(P, lds, bh >> 3, bh & 7, it & 15); }
        else { const int g = it - 512, bh = g >> 4; gla_item(P, lds, bh >> 2, bh & 3, g & 15); }
        __syncthreads();
    }
}
__device__ __forceinline__ void quant_tables(const Params& P, int gw, int ngw);
__device__ __forceinline__ void phase_fixup(const Params& P, LAS unsigned char* lds) {
    const int tid = threadIdx.x, lane = tid & 63, wave = __builtin_amdgcn_readfirstlane(tid >> 6), fr = lane & 15, fq = lane >> 4;
    for (int it = blockIdx.x; it < 192; it += gridDim.x) {
        if (it < 64) {
            float* SE = (float*)(P.ws + WS_SER) + (size_t)(it >> 1) * NSEG * 2 * 4096;
            LAS float* Sb = (LAS float*)lds;
            const int sl = wave >> 2, nt = wave & 3, r0 = ((it & 1) * 2 + sl) * 16;
            const int cpos = (r0 + 4 * fq) * 64 + nt * 16 + fr;
            const int bpos = (16 * fq) * 64 + nt * 16 + fr;
            __syncthreads();
            f32x4 en[4]; float ph[4][16];
#define FX_LOAD(sg) do { const float* nx_ = SE + (size_t)((sg) * 2) * 4096; \
                _Pragma("unroll") for (int ks = 0; ks < 16; ++ks) ph[(sg) & 3][ks] = nx_[4096 + bpos + 64 * ks]; \
                _Pragma("unroll") for (int rg = 0; rg < 4; ++rg) en[(sg) & 3][rg] = nx_[cpos + 64 * rg]; } while (0)
#pragma unroll
            for (int rg = 0; rg < 4; ++rg) Sb[(sl * 16 + 4 * fq + rg) * 68 + nt * 16 + fr] = SE[cpos + 64 * rg];
            FX_LOAD(1); FX_LOAD(2); FX_LOAD(3);
            __syncthreads();
#pragma unroll
            for (int seg = 1; seg < NSEG - 1; ++seg) {
                float* s0 = SE + (size_t)(seg * 2) * 4096;
                const LAS float* Sr = Sb + ((seg - 1) & 1) * (2 * 16 * 68) + (sl * 16 + fr) * 68 + 16 * fq; LAS float* Sw = Sb + (seg & 1) * (2 * 16 * 68);
                if (seg + 3 < NSEG - 1) FX_LOAD(seg + 3);
                f32x4 acc = en[seg & 3]; f32x4 av[4];
#pragma unroll
                for (int j = 0; j < 4; ++j) av[j] = *(const LAS f32x4*)(Sr + 4 * j);
#pragma unroll
                for (int ks = 0; ks < 16; ++ks) acc = __builtin_amdgcn_mfma_f32_16x16x4f32(av[ks >> 2][ks & 3], ph[seg & 3][ks], acc, 0, 0, 0);
#pragma unroll
                for (int rg = 0; rg < 4; ++rg) { s0[cpos + 64 * rg] = acc[rg]; Sw[(sl * 16 + 4 * fq + rg) * 68 + nt * 16 + fr] = acc[rg]; }
                __syncthreads();
            }
#undef FX_LOAD
        } else {
            const int g = it - 64, bh = g >> 3; float* SE = (float*)(P.ws + WS_SEG) + (size_t)bh * NSEG * 8192 + ((g & 7) * 16 + (tid >> 5)) * 64 + (tid & 31) * 2;
            const float* CE = (const float*)(P.ws + WS_CEND) + (size_t)bh * NSEG * 64 + (tid & 31) * 2;
            f32x2 x[NSEG - 1], ce[NSEG - 1];
#pragma unroll
            for (int seg = 0; seg < NSEG - 1; ++seg) { x[seg] = *(const f32x2*)(SE + (size_t)seg * 8192); ce[seg] = *(const f32x2*)(CE + seg * 64); }
            f32x2 sc = (f32x2){0.f, 0.f};
#pragma unroll
            for (int seg = 0; seg < NSEG - 1; ++seg) { sc = sc * ce[seg] + x[seg]; *(f32x2*)(SE + (size_t)seg * 8192) = sc; }
        }
    }
    {
        const bool sp = gridDim.x > 64; const int nb = sp ? (int)gridDim.x - 64 : (int)gridDim.x, bi = sp ? (int)blockIdx.x - 64 : (int)blockIdx.x;
        if (bi >= 0) {
            fold_keys(P, lds, bi, nb);
            transpose_convert(P.in[19], D, D, D, (bf16*)(P.ws + WS_WOUT), bi * NTHR + tid, nb * NTHR);
            quant_tables(P, bi * NWAVES + (tid >> 6), nb * NWAVES);
        }
    }
}
__device__ __forceinline__ float row_sum16(float v) { v = DPP_ADD(v, 0xB1); v = DPP_ADD(v, 0x4E); v = DPP_ADD(v, 0x141); v = DPP_ADD(v, 0x140); return v; }
__device__ __forceinline__ bf16x8_t pack_bf16x8(const f32x4 a, const f32x4 b) {
    u32x4 w; w.x = pk2(a[0], a[1]); w.y = pk2(a[2], a[3]); w.z = pk2(b[0], b[1]); w.w = pk2(b[2], b[3]); return __builtin_bit_cast(bf16x8_t, w);
}
__device__ __forceinline__ void unpack4(const u32x2 w, float (&o)[4]) { o[0] = __uint_as_float(w.x << 16); o[1] = __uint_as_float(w.x & 0xffff0000u); o[2] = __uint_as_float(w.y << 16); o[3] = __uint_as_float(w.y & 0xffff0000u); }
__device__ __forceinline__ void phase_correct(const Params& P, LAS unsigned char* lds) {
    const int tid = threadIdx.x, lane = tid & 63, wave = __builtin_amdgcn_readfirstlane(tid >> 6), fr = lane & 15, fq = lane >> 4;
    unsigned char* ws = P.ws;
    const bf16* p = (const bf16*)(ws + WS_P); const bf16* AA = (const bf16*)(ws + WS_AA); const bf16* GG = (const bf16*)(ws + WS_GG);
    bf16* MIX = (bf16*)P.out; const bf16* YI = (const bf16*)(ws + WS_YI); const bf16* YIG = (const bf16*)(ws + WS_YIG);
    const float* mu = P.in[4]; const float* k_a = P.in[11]; const float* r_k = P.in[12]; const float* gn_g = P.in[13]; const float* gn_b = P.in[14]; const float* norm_g = P.in[18];
    LAS bf16* SB = (LAS bf16*)lds;
    for (int it = blockIdx.x; it < 512; it += gridDim.x) {
        {
            const int seg = it & 15, bh = it >> 4, b = bh >> 3, h = bh & 7;
            const int cb = h * 64 + 4 * fr;
            __syncthreads();
            if (seg > 0) { const float* ss = (const float*)(ws + WS_SER) + (((size_t)bh * NSEG + (seg - 1)) * 2) * 4096;
                for (int i = tid; i < 1024; i += NTHR) { const f32x4 x = *(const f32x4*)(ss + 4 * i); const int v = i >> 4, j = (4 * i) & 63; u32x2 w; w.x = pk2(x[0], x[1]); w.y = pk2(x[2], x[3]);
                    *(LAS u32x2*)(SB + ((v & 3) * 16 + (v >> 2)) * 72 + j) = w; } }
            __syncthreads();
            const f32x4 mur = *(const f32x4*)(mu + C_R + cb), muk = *(const f32x4*)(mu + C_K + cb), muv = *(const f32x4*)(mu + C_V + cb), kac = *(const f32x4*)(k_a + cb), rkc = *(const f32x4*)(r_k + cb), gng = *(const f32x4*)(gn_g + cb), gnb = *(const f32x4*)(gn_b + cb);
            u32x2 W[4][9];
#define CORR_LOAD(buf, st) do { const int t_ = seg * LSEG + wave * 64 + ((st) >> 2) * 16 + 4 * fq + ((st) & 3); const size_t m_ = (size_t)b * T + t_; const bf16* pr_ = p + m_ * NP + cb; const bf16* pp_ = (t_ > 0) ? pr_ - NP : pr_; \
                    W[buf][0] = *(const u32x2*)(MIX + m_ * D + cb); W[buf][1] = *(const u32x2*)(pr_ + C_R); W[buf][2] = *(const u32x2*)(pr_ + C_K); W[buf][3] = *(const u32x2*)(pr_ + C_V); \
                    W[buf][4] = *(const u32x2*)(pp_ + C_R); W[buf][5] = *(const u32x2*)(pp_ + C_K); W[buf][6] = *(const u32x2*)(pp_ + C_V); W[buf][7] = *(const u32x2*)(AA + m_ * A_W + cb); W[buf][8] = *(const u32x2*)(GG + m_ * A_W + cb); } while (0)
            CORR_LOAD(0, 0); CORR_LOAD(1, 1); CORR_LOAD(2, 2);
#pragma unroll
            for (int mt = 0; mt < 4; ++mt) {
                const int tb = seg * LSEG + wave * 64 + mt * 16;
                f32x4 acc[4];
#pragma unroll
                for (int vt = 0; vt < 4; ++vt) acc[vt] = (f32x4){0.f, 0.f, 0.f, 0.f};
                if (seg > 0) {
#pragma unroll
                    for (int sx = 0; sx < 2; ++sx) { const bf16x8_t af = *(const bf16x8_t*)(YI + ((size_t)b * T + tb + fr) * 512 + h * 64 + 32 * sx + 8 * fq);
#pragma unroll
                        for (int vt = 0; vt < 4; ++vt) acc[vt] = __builtin_amdgcn_mfma_f32_16x16x32_bf16(af, *(const LAS bf16x8_t*)(SB + (vt * 16 + fr) * 72 + 32 * sx + 8 * fq), acc[vt], 0, 0, 0); }
                }
#pragma unroll
                for (int rg = 0; rg < 4; ++rg) { const int t = tb + 4 * fq + rg; const size_t m = (size_t)b * T + t; const float hp = (t > 0) ? 1.f : 0.f; const int st = mt * 4 + rg;
                    if (st + 3 < 16) CORR_LOAD((st + 3) & 3, st + 3);
                    __builtin_amdgcn_sched_barrier(0);
                    float y[4], rc[4], kc[4], vc[4], rp_[4], kp[4], vp[4], a[4], g[4];
                    unpack4(W[st & 3][0], y); unpack4(W[st & 3][1], rc); unpack4(W[st & 3][2], kc); unpack4(W[st & 3][3], vc); unpack4(W[st & 3][4], rp_); unpack4(W[st & 3][5], kp); unpack4(W[st & 3][6], vp); unpack4(W[st & 3][7], a); unpack4(W[st & 3][8], g);
                    float v[4], sy = 0.f, sb = 0.f;
#pragma unroll
                    for (int i = 0; i < 4; ++i) { y[i] += acc[i][rg];
                        const float r = rc[i] + (rp_[i] * hp - rc[i]) * mur[i], k = kc[i] + (kp[i] * hp - kc[i]) * muk[i]; v[i] = vc[i] + (vp[i] * hp - vc[i]) * muv[i];
                        const float kh = k * (1.f + (a[i] - 1.f) * kac[i]); sb += r * kh * rkc[i]; sy += y[i]; }
                    const float bon = row_sum16(sb), mean = row_sum16(sy) * (1.f / 64.f); float sq = 0.f;
#pragma unroll
                    for (int i = 0; i < 4; ++i) { y[i] -= mean; sq += y[i] * y[i]; }
                    const float rstd = 1.f / sqrtf(row_sum16(sq) * (1.f / 64.f) + GN_EPS); float o[4];
#pragma unroll
                    for (int i = 0; i < 4; ++i) o[i] = (y[i] * rstd * gng[i] + gnb[i] + bon * v[i]) * g[i];
                    u32x2 w; w.x = pk2(o[0], o[1]); w.y = pk2(o[2], o[3]); *(u32x2*)(MIX + m * D + cb) = w;
                    __builtin_amdgcn_sched_barrier(0); }
#undef CORR_LOAD
            }
        }
    }
    for (int g_ = blockIdx.x; g_ < 256; g_ += gridDim.x) {
        {
            const int seg = g_ & 15, bh = g_ >> 4, b = bh >> 2, h = bh & 3;
            const int cb = h * 128 + 8 * fr;
            __syncthreads();
            if (seg > 0) { const float* ss = (const float*)(ws + WS_SEG) + ((size_t)bh * NSEG + (seg - 1)) * 8192;
                for (int i = tid; i < 2048; i += NTHR) { const f32x4 x = *(const f32x4*)(ss + 4 * i); const int v = i >> 4, j = (4 * i) & 63; u32x2 w; w.x = pk2(x[0], x[1]); w.y = pk2(x[2], x[3]);
                    *(LAS u32x2*)(SB + ((v & 7) * 16 + (v >> 3)) * 72 + j) = w; } }
            __syncthreads();
            const f32x4 ng0 = *(const f32x4*)(norm_g + 8 * fr), ng1 = *(const f32x4*)(norm_g + 8 * fr + 4);
            u32x4 WG[4][2];
#define CORG_LOAD(buf, st) do { const size_t m_ = (size_t)b * T + seg * LSEG + wave * 64 + ((st) >> 2) * 16 + 4 * fq + ((st) & 3); WG[buf][0] = *(const u32x4*)(MIX + m_ * D + 512 + cb); WG[buf][1] = *(const u32x4*)(p + m_ * NP + C_BG + cb); } while (0)
            CORG_LOAD(0, 0); CORG_LOAD(1, 1); CORG_LOAD(2, 2);
#pragma unroll
            for (int mt = 0; mt < 4; ++mt) {
                const int tb = seg * LSEG + wave * 64 + mt * 16;
                f32x4 acc[8];
#pragma unroll
                for (int vt = 0; vt < 8; ++vt) acc[vt] = (f32x4){0.f, 0.f, 0.f, 0.f};
                if (seg > 0) {
#pragma unroll
                    for (int sx = 0; sx < 2; ++sx) { const bf16x8_t af = *(const bf16x8_t*)(YIG + ((size_t)b * T + tb + fr) * 256 + h * 64 + 32 * sx + 8 * fq);
#pragma unroll
                        for (int vt = 0; vt < 8; ++vt) acc[vt] = __builtin_amdgcn_mfma_f32_16x16x32_bf16(af, *(const LAS bf16x8_t*)(SB + (vt * 16 + fr) * 72 + 32 * sx + 8 * fq), acc[vt], 0, 0, 0); }
                }
#pragma unroll
                for (int rg = 0; rg < 4; ++rg) { const size_t m = (size_t)b * T + tb + 4 * fq + rg; const int st = mt * 4 + rg;
                    if (st + 3 < 16) CORG_LOAD((st + 3) & 3, st + 3);
                    __builtin_amdgcn_sched_barrier(0);
                    float o[8], g[8]; float sq = 0.f;
#pragma unroll
                    for (int i = 0; i < 4; ++i) { const unsigned a_ = WG[st & 3][0][i], b_ = WG[st & 3][1][i]; o[2 * i] = __uint_as_float(a_ << 16); o[2 * i + 1] = __uint_as_float(a_ & 0xffff0000u); g[2 * i] = __uint_as_float(b_ << 16); g[2 * i + 1] = __uint_as_float(b_ & 0xffff0000u); }
#pragma unroll
                    for (int i = 0; i < 8; ++i) { o[i] += acc[i][rg]; sq += o[i] * o[i]; }
                    const float rs = 1.f / sqrtf(row_sum16(sq) * (1.f / 128.f) + RMS_EPS);
                    float f[8];
#pragma unroll
                    for (int i = 0; i < 8; ++i) f[i] = o[i] * rs * (i < 4 ? ng0[i & 3] : ng1[i & 3]) * siluf_(g[i]);
                    u32x4 w; w.x = pk2(f[0], f[1]); w.y = pk2(f[2], f[3]); w.z = pk2(f[4], f[5]); w.w = pk2(f[6], f[7]); *(u32x4*)(MIX + m * D + 512 + cb) = w;
                    __builtin_amdgcn_sched_barrier(0); }
#undef CORG_LOAD
            }
        }
    }
}

__device__ __forceinline__ void phase_ln1(const Params& P) {
    const int lane = threadIdx.x & 63, wave = threadIdx.x >> 6; const int gw = blockIdx.x * NWAVES + wave, ngw = gridDim.x * NWAVES;
    for (int m = gw; m < M; m += ngw) ln_rowb_bf16<true>((const bf16*)(P.ws + WS_Z) + (size_t)m * D, P.in[20], P.in[21], (bf16*)(P.ws + WS_H1) + (size_t)m * D, lane, P.ws + WS_H8 + (size_t)m * 2048);
}
__device__ __forceinline__ void quant_tables(const Params& P, int gw, int ngw) {
    const int lane = threadIdx.x & 63;
    {
        const float* src = P.in[24]; unsigned char* dst = P.ws + WS_UF + (size_t)(lane >> 3) * UF_SLICE + 16 * (lane & 7); float* sc = (float*)(P.ws + WS_SU);
        for (int e = gw; e < 16384; e += ngw) {
            const f32x4* sp = (const f32x4*)(src + (size_t)e * D) + 4 * lane; f32x4 a[4]; float mx = 0.f;
#pragma unroll
            for (int j = 0; j < 4; ++j) { a[j] = sp[j]; mx = fmaxf(fmaxf(mx, fmaxf(fabsf(a[j][0]), fabsf(a[j][1]))), fmaxf(fabsf(a[j][2]), fabsf(a[j][3]))); }
            mx = wave_max_u(mx); const float inv = mx > 0.f ? 448.f / mx : 0.f;
            u32x4 w;
#pragma unroll
            for (int j = 0; j < 4; ++j) { int pk = __builtin_amdgcn_cvt_pk_fp8_f32(a[j][0] * inv, a[j][1] * inv, 0, false); pk = __builtin_amdgcn_cvt_pk_fp8_f32(a[j][2] * inv, a[j][3] * inv, pk, true); w[j] = (unsigned)pk; }
            *(u32x4*)(dst + (size_t)e * 128) = w;
            if (lane == 0) sc[e] = mx * (1.f / 448.f);
        }
    }
    {
        const float* src = P.in[25]; unsigned char* dst = P.ws + WS_V8 + (size_t)(lane >> 3) * V8_SLICE + 16 * (lane & 7); float* sc = (float*)(P.ws + WS_SV);
        for (int e = gw; e < 16384; e += ngw) {
            const f32x4* sp = (const f32x4*)(src + (size_t)e * D) + 4 * lane; f32x4 a[4]; float mx = 0.f;
#pragma unroll
            for (int j = 0; j < 4; ++j) { a[j] = sp[j]; mx = fmaxf(fmaxf(mx, fmaxf(fabsf(a[j][0]), fabsf(a[j][1]))), fmaxf(fabsf(a[j][2]), fabsf(a[j][3]))); }
            mx = wave_max_u(mx); const float inv = mx > 0.f ? 127.f / mx : 0.f;
            u32x4 w;
#pragma unroll
            for (int j = 0; j < 4; ++j) w[j] = pack_i8(a[j][0], a[j][1], a[j][2], a[j][3], inv, 0);
            *(u32x4*)(dst + (size_t)e * 128) = w;
            if (lane == 0) sc[e] = mx * (1.f / 127.f);
        }
    }
}

#define TK_CE(a, b) do { const unsigned _h = max((a), (b)); (b) = min((a), (b)); (a) = _h; } while (0)
#define TK_INS(L, x) do { _Pragma("unroll") for (int _j = 0; _j < 16; ++_j) { const unsigned _h = max(L[_j], x); x = min(L[_j], x); L[_j] = _h; } } while (0)
__device__ __forceinline__ void tk_sort16(unsigned (&x)[16]) { TK_CE(x[0], x[13]); TK_CE(x[1], x[12]); TK_CE(x[2], x[15]); TK_CE(x[3], x[14]); TK_CE(x[4], x[8]); TK_CE(x[5], x[6]); TK_CE(x[7], x[11]); TK_CE(x[9], x[10]); TK_CE(x[0], x[5]); TK_CE(x[1], x[7]); TK_CE(x[2], x[9]); TK_CE(x[3], x[4]); TK_CE(x[6], x[13]); TK_CE(x[8], x[14]); TK_CE(x[10], x[15]); TK_CE(x[11], x[12]); TK_CE(x[0], x[1]); TK_CE(x[2], x[3]); TK_CE(x[4], x[5]); TK_CE(x[6], x[8]); TK_CE(x[7], x[9]); TK_CE(x[10], x[11]); TK_CE(x[12], x[13]); TK_CE(x[14], x[15]); TK_CE(x[0], x[2]); TK_CE(x[1], x[3]); TK_CE(x[4], x[10]); TK_CE(x[5], x[11]); TK_CE(x[6], x[7]); TK_CE(x[8], x[9]); TK_CE(x[12], x[14]); TK_CE(x[13], x[15]); TK_CE(x[1], x[2]); TK_CE(x[3], x[12]); TK_CE(x[4], x[6]); TK_CE(x[5], x[7]); TK_CE(x[8], x[10]); TK_CE(x[9], x[11]); TK_CE(x[13], x[14]); TK_CE(x[1], x[4]); TK_CE(x[2], x[6]); TK_CE(x[5], x[8]); TK_CE(x[7], x[10]); TK_CE(x[9], x[13]); TK_CE(x[11], x[14]); TK_CE(x[2], x[4]); TK_CE(x[3], x[6]); TK_CE(x[9], x[12]); TK_CE(x[11], x[13]); TK_CE(x[3], x[5]); TK_CE(x[6], x[8]); TK_CE(x[7], x[9]); TK_CE(x[10], x[12]); TK_CE(x[3], x[4]); TK_CE(x[5], x[6]); TK_CE(x[7], x[8]); TK_CE(x[9], x[10]); TK_CE(x[11], x[12]); TK_CE(x[6], x[7]); TK_CE(x[8], x[9]); }
__device__ __forceinline__ void tk_merge16(unsigned (&R)[16], const unsigned (&S)[16]) {
#pragma unroll
    for (int i = 0; i < 16; ++i) R[i] = max(R[i], S[15 - i]);
    TK_CE(R[0], R[8]); TK_CE(R[1], R[9]); TK_CE(R[2], R[10]); TK_CE(R[3], R[11]); TK_CE(R[4], R[12]); TK_CE(R[5], R[13]); TK_CE(R[6], R[14]); TK_CE(R[7], R[15]); TK_CE(R[0], R[4]); TK_CE(R[1], R[5]); TK_CE(R[2], R[6]); TK_CE(R[3], R[7]); TK_CE(R[8], R[12]); TK_CE(R[9], R[13]); TK_CE(R[10], R[14]); TK_CE(R[11], R[15]); TK_CE(R[0], R[2]); TK_CE(R[1], R[3]); TK_CE(R[4], R[6]); TK_CE(R[5], R[7]); TK_CE(R[8], R[10]); TK_CE(R[9], R[11]); TK_CE(R[12], R[14]); TK_CE(R[13], R[15]); TK_CE(R[0], R[1]); TK_CE(R[2], R[3]); TK_CE(R[4], R[5]); TK_CE(R[6], R[7]); TK_CE(R[8], R[9]); TK_CE(R[10], R[11]); TK_CE(R[12], R[13]); TK_CE(R[14], R[15]);
}
__device__ __forceinline__ unsigned tk_ckey(float sum, unsigned payload) { const unsigned b = __float_as_uint(sum); const unsigned mono = b ^ ((unsigned)((int)b >> 31) | 0x80000000u); return (mono & 0xFFFFC000u) | payload; }
__device__ __forceinline__ void topk128(const u32x4* r, unsigned (&L)[16]) {
    u32x4 c0 = r[0], c1 = r[64];
    for (int c = 0; c < 8; ++c) {
        const u32x4 n0 = r[64 * ((2 * c + 2) & 15)], n1 = r[64 * ((2 * c + 3) & 15)];
        const unsigned kb = 0xFFFFu - 16u * (unsigned)c; unsigned x[16];
#pragma unroll
        for (int d = 0; d < 4; ++d) {
            unsigned w = c0[d]; unsigned msk = ((w >> 15) & 0x00010001u) * 0xFFFFu; w ^= (msk | 0x80008000u);
            x[2 * d] = (w << 16) | (kb - 2u * d); x[2 * d + 1] = (w & 0xFFFF0000u) | (kb - 2u * d - 1u);
            w = c1[d]; msk = ((w >> 15) & 0x00010001u) * 0xFFFFu; w ^= (msk | 0x80008000u);
            x[8 + 2 * d] = (w << 16) | (kb - 8u - 2u * d); x[8 + 2 * d + 1] = (w & 0xFFFF0000u) | (kb - 8u - 2u * d - 1u);
        }
        tk_sort16(x);
        if (c == 0) {
#pragma unroll
            for (int q = 0; q < 16; ++q) L[q] = x[q];
        } else tk_merge16(L, x);
        c0 = n0; c1 = n1;
    }
}
__device__ __forceinline__ void phase_topk(const Params& P) {
    const int gl = blockIdx.x * NTHR + threadIdx.x, nl = gridDim.x * NTHR;
    const bf16* Sc = (const bf16*)(P.ws + WS_S); int* IDS = (int*)(P.ws + WS_IDS); float* GATES = (float*)(P.ws + WS_GATES);
    for (int item = gl; item < M * 8; item += nl) {
        const u32x4* row = (const u32x4*)Sc + (size_t)((item >> 6) * 32) * 64 + (item & 63);
        unsigned L0[16], L1[16];
        topk128(row, L0); topk128(row + 16 * 64, L1);
        float f0[16], f1[16]; unsigned p0[16], p1[16];
#pragma unroll
        for (int i = 0; i < 16; ++i) {
            f0[i] = __uint_as_float((L0[i] & 0x80000000u) ? (L0[i] & 0x7FFF0000u) : (~L0[i] & 0xFFFF0000u)); p0[i] = (~L0[i] & 0x7Fu) << 7;
            f1[i] = __uint_as_float((L1[i] & 0x80000000u) ? (L1[i] & 0x7FFF0000u) : (~L1[i] & 0xFFFF0000u)); p1[i] = (~L1[i] & 0x7Fu);
        }
        unsigned C[16];
        { unsigned x[16] = {tk_ckey(f0[0] + f1[0], p0[0] | p1[0]), tk_ckey(f0[0] + f1[1], p0[0] | p1[1]), tk_ckey(f0[0] + f1[2], p0[0] | p1[2]), tk_ckey(f0[0] + f1[3], p0[0] | p1[3]), tk_ckey(f0[0] + f1[4], p0[0] | p1[4]), tk_ckey(f0[0] + f1[5], p0[0] | p1[5]), tk_ckey(f0[0] + f1[6], p0[0] | p1[6]), tk_ckey(f0[0] + f1[7], p0[0] | p1[7]), tk_ckey(f0[0] + f1[8], p0[0] | p1[8]), tk_ckey(f0[0] + f1[9], p0[0] | p1[9]), tk_ckey(f0[0] + f1[10], p0[0] | p1[10]), tk_ckey(f0[0] + f1[11], p0[0] | p1[11]), tk_ckey(f0[0] + f1[12], p0[0] | p1[12]), tk_ckey(f0[0] + f1[13], p0[0] | p1[13]), tk_ckey(f0[0] + f1[14], p0[0] | p1[14]), tk_ckey(f0[0] + f1[15], p0[0] | p1[15])};
          tk_sort16(x);
#pragma unroll
          for (int q = 0; q < 16; ++q) C[q] = x[q]; }
        { unsigned x[16] = {tk_ckey(f0[1] + f1[0], p0[1] | p1[0]), tk_ckey(f0[1] + f1[1], p0[1] | p1[1]), tk_ckey(f0[1] + f1[2], p0[1] | p1[2]), tk_ckey(f0[1] + f1[3], p0[1] | p1[3]), tk_ckey(f0[1] + f1[4], p0[1] | p1[4]), tk_ckey(f0[1] + f1[5], p0[1] | p1[5]), tk_ckey(f0[1] + f1[6], p0[1] | p1[6]), tk_ckey(f0[1] + f1[7], p0[1] | p1[7]), tk_ckey(f0[2] + f1[0], p0[2] | p1[0]), tk_ckey(f0[2] + f1[1], p0[2] | p1[1]), tk_ckey(f0[2] + f1[2], p0[2] | p1[2]), tk_ckey(f0[2] + f1[3], p0[2] | p1[3]), tk_ckey(f0[2] + f1[4], p0[2] | p1[4]), tk_ckey(f0[3] + f1[0], p0[3] | p1[0]), tk_ckey(f0[3] + f1[1], p0[3] | p1[1]), tk_ckey(f0[3] + f1[2], p0[3] | p1[2])};
          tk_sort16(x); tk_merge16(C, x); }
        { unsigned x[16] = {tk_ckey(f0[3] + f1[3], p0[3] | p1[3]), tk_ckey(f0[4] + f1[0], p0[4] | p1[0]), tk_ckey(f0[4] + f1[1], p0[4] | p1[1]), tk_ckey(f0[4] + f1[2], p0[4] | p1[2]), tk_ckey(f0[5] + f1[0], p0[5] | p1[0]), tk_ckey(f0[5] + f1[1], p0[5] | p1[1]), tk_ckey(f0[6] + f1[0], p0[6] | p1[0]), tk_ckey(f0[6] + f1[1], p0[6] | p1[1]), tk_ckey(f0[7] + f1[0], p0[7] | p1[0]), tk_ckey(f0[7] + f1[1], p0[7] | p1[1]), tk_ckey(f0[8] + f1[0], p0[8] | p1[0]), tk_ckey(f0[9] + f1[0], p0[9] | p1[0]), tk_ckey(f0[10] + f1[0], p0[10] | p1[0]), tk_ckey(f0[11] + f1[0], p0[11] | p1[0]), tk_ckey(f0[12] + f1[0], p0[12] | p1[0]), tk_ckey(f0[13] + f1[0], p0[13] | p1[0])};
          tk_sort16(x); tk_merge16(C, x); }
        { unsigned key = tk_ckey(f0[14] + f1[0], p0[14] | p1[0]); TK_INS(C, key); }
        { unsigned key = tk_ckey(f0[15] + f1[0], p0[15] | p1[0]); TK_INS(C, key); }
        float cv[16];
#pragma unroll
        for (int r = 0; r < 16; ++r) cv[r] = __uint_as_float((C[r] & 0x80000000u) ? (C[r] & 0x7FFFC000u) : (~C[r] & 0xFFFFC000u));
        const float cmax = cv[0]; float den = 0.f;
#pragma unroll
        for (int r = 0; r < 16; ++r) { cv[r] = __expf(cv[r] - cmax); den += cv[r]; }
        const float inv = 1.f / den;
        const int oi = ((((item >> 9) << 6) | (item & 63)) << 3) | ((item >> 6) & 7);
        u32x4* ido = (u32x4*)(IDS + (size_t)oi * 16); f32x4* go = (f32x4*)(GATES + (size_t)oi * 16);
#pragma unroll
        for (int q = 0; q < 4; ++q) { u32x4 o; o.x = C[4 * q] & 0x3FFFu; o.y = C[4 * q + 1] & 0x3FFFu; o.z = C[4 * q + 2] & 0x3FFFu; o.w = C[4 * q + 3] & 0x3FFFu; ido[q] = o;
            f32x4 g; g[0] = cv[4 * q] * inv; g[1] = cv[4 * q + 1] * inv; g[2] = cv[4 * q + 2] * inv; g[3] = cv[4 * q + 3] * inv; go[q] = g; }
    }
}

#define XB_TMO      128
#define XB_XCNT(j)  (256  + 64 * (j))
#define XB_XSUB(j)  (1280 + 64 * (j))
#define XB_XGEN(j)  (2304 + 64 * (j))
#define XB_TOP      3328
#define XB_TOPGEN   3392
#define XCD_BAR_WORDS 3456
#define XB_SPIN_CAP (1u << 18)
__device__ __forceinline__ unsigned xb_ld(unsigned* p)              { return __hip_atomic_load(p, __ATOMIC_RELAXED, __HIP_MEMORY_SCOPE_AGENT); }
__device__ __forceinline__ unsigned xb_add(unsigned* p, unsigned v) { return __hip_atomic_fetch_add(p, v, __ATOMIC_RELAXED, __HIP_MEMORY_SCOPE_AGENT); }
__device__ __forceinline__ unsigned xb_xcc_id() { return (unsigned)__builtin_amdgcn_s_getreg((3 << 11) | 20) & 0xFu; }
#define XB_SPIN(cond, bar) do { unsigned _sp = 0; while (cond) { __builtin_amdgcn_s_sleep(1); \
    if ((++_sp & 255u) == 0u) { if (xb_ld(&(bar)[XB_TMO])) break; if (_sp > XB_SPIN_CAP) { atomicAdd(&(bar)[XB_TMO], 1u); break; } } } } while (0)
struct XcdBarrier { unsigned* bar; unsigned x; volatile LAS unsigned* st; };
__device__ __forceinline__ XcdBarrier xcd_barrier_post(unsigned* bar, volatile LAS unsigned* st) {
    XcdBarrier b; b.bar = bar; b.x = xb_xcc_id(); b.st = st;
    if (threadIdx.x == 0) { const unsigned r = xb_add(&bar[XB_XCNT(b.x)], 1u); st[4] = r; st[5] = b.x; }
    return b;
}
__device__ __forceinline__ void xcd_barrier_complete(unsigned* bar, unsigned x, unsigned& nloc, unsigned& nx) {
    const unsigned G = gridDim.x * gridDim.y * gridDim.z;
    unsigned sum, cnt, mine, sp = 0u;
    for (;;) {
        sum = 0u; cnt = 0u; mine = 0u;
#pragma unroll
        for (unsigned j = 0; j < 16; ++j) { const unsigned c = xb_ld(&bar[XB_XCNT(j)]); sum += c; cnt += (c > 0u) ? 1u : 0u; mine = (j == x) ? c : mine; }
        if (sum == G) break;
        __builtin_amdgcn_s_sleep(1);
        if ((++sp & 255u) == 0u) { if (xb_ld(&bar[XB_TMO])) break; if (sp > XB_SPIN_CAP) { atomicAdd(&bar[XB_TMO], 1u); break; } }
    }
    nloc = mine > 0u ? mine : 1u; nx = cnt > 0u ? cnt : 1u;
}
__device__ __forceinline__ void xcd_barrier(const XcdBarrier& b) {
    asm volatile("s_waitcnt vmcnt(0)" ::: "memory");
    __syncthreads();
    if (threadIdx.x == 0) {
        unsigned* bar = b.bar;
        __builtin_amdgcn_s_waitcnt(0);
        unsigned nloc = b.st[0], nx = b.st[1];
        if (nloc == 0u) { xcd_barrier_complete(bar, b.x, nloc, nx); b.st[0] = nloc; b.st[1] = nx; }
        const unsigned old = xb_add(&bar[XB_XSUB(b.x)], 1u);
        const unsigned gen = old / nloc;
        if (old + 1u == (gen + 1u) * nloc) {
            __builtin_amdgcn_fence(__ATOMIC_RELEASE, "agent");
            asm volatile("s_waitcnt vmcnt(0)" ::: "memory");
            const unsigned og = xb_add(&bar[XB_TOP], 1u);
            const unsigned tg = og / nx;
            if (og + 1u == (tg + 1u) * nx) xb_add(&bar[XB_TOPGEN], 1u);
            else XB_SPIN(xb_ld(&bar[XB_TOPGEN]) == tg, bar);
            __builtin_amdgcn_fence(__ATOMIC_ACQUIRE, "agent");
            xb_add(&bar[XB_XGEN(b.x)], 1u);
            asm volatile("s_waitcnt vmcnt(0)" ::: "memory");
        } else {
            XB_SPIN(xb_ld(&bar[XB_XGEN(b.x)]) == gen, bar);
            __builtin_amdgcn_fence(__ATOMIC_ACQUIRE, "agent");
            asm volatile("s_waitcnt vmcnt(0)" ::: "memory");
        }
    }
    __syncthreads();
}

typedef int v8i_t __attribute__((ext_vector_type(8)));
#define PD_LO 1
struct PdTok { int idl, idh; unsigned hw; };
__device__ __forceinline__ PdTok pd_fetch(const int* IDS, const unsigned char* H8s, int m, int lane) {
    PdTok t; t.idl = IDS[(size_t)m * 128 + lane]; t.idh = IDS[(size_t)m * 128 + 64 + lane]; t.hw = *(const unsigned*)(H8s + (size_t)m * 2048); return t;
}
__device__ __forceinline__ void pd_issue(u32x4 (&X0)[8], u32x4 (&X1)[8], const PdTok& t, const unsigned char* UFs, LAS unsigned char* slot, int lane) {
#pragma unroll
    for (int g = 0; g < 8; ++g) { const unsigned id = (unsigned)__builtin_amdgcn_ds_bpermute(4 * (16 * (g & 3) + (lane >> 2)), g < 4 ? t.idl : t.idh);
        const u32x4* rp = (const u32x4*)(UFs + ((id << 7) + 16u * (unsigned)(lane & 3))); X0[g] = rp[0]; X1[g] = rp[4]; }
    *(LAS unsigned*)(slot + 4 * lane) = t.hw;
}
__device__ __forceinline__ float pd_trace(const f32x4 v) {
    const float v0 = v[0], v1 = v[1], v2 = v[2], v3 = v[3];
#define PD_BC(x, ctrl) __builtin_bit_cast(float, __builtin_amdgcn_update_dpp(0, __builtin_bit_cast(int, (x)), (ctrl), 0xf, 0xf, true))
    float s = PD_BC(v0, 0x00); s += PD_BC(v1, 0x55); s += PD_BC(v2, 0xAA); s += PD_BC(v3, 0xFF); return s;
#undef PD_BC
}
__device__ __forceinline__ void pd_compute(const u32x4 (&X0)[8], const u32x4 (&X1)[8], const LAS unsigned char* arp, float* PDs, int m, int lane) {
    const int q = lane & 3;
    float dl = 0.f, dh = 0.f;
    const LAS u32x4* hp = (const LAS u32x4*)arp; const u32x4 A0 = hp[0], A1 = hp[4];
#if PD_LO
    const u32x4 A2 = hp[8], A3 = hp[12];
#endif
    const v8i_t ah = {(int)A0.x, (int)A0.y, (int)A0.z, (int)A0.w, (int)A1.x, (int)A1.y, (int)A1.z, (int)A1.w};
#if PD_LO
    const v8i_t al = {(int)A2.x, (int)A2.y, (int)A2.z, (int)A2.w, (int)A3.x, (int)A3.y, (int)A3.z, (int)A3.w};
#endif
    f32x4 acc[8];
#pragma unroll
    for (int g = 0; g < 8; ++g) { const v8i_t b = {(int)X0[g].x, (int)X0[g].y, (int)X0[g].z, (int)X0[g].w, (int)X1[g].x, (int)X1[g].y, (int)X1[g].z, (int)X1[g].w};
        acc[g] = __builtin_amdgcn_mfma_scale_f32_16x16x128_f8f6f4(ah, b, (f32x4){0.f, 0.f, 0.f, 0.f}, 0, 0, 0, 0, 0, 0); }
#if PD_LO
    __builtin_amdgcn_sched_barrier(0);
#pragma unroll
    for (int g = 0; g < 8; ++g) { const v8i_t b = {(int)X0[g].x, (int)X0[g].y, (int)X0[g].z, (int)X0[g].w, (int)X1[g].x, (int)X1[g].y, (int)X1[g].z, (int)X1[g].w};
        acc[g] = __builtin_amdgcn_mfma_scale_f32_16x16x128_f8f6f4(al, b, acc[g], 0, 0, 0, 0, 0, 0); }
#endif
    __builtin_amdgcn_sched_barrier(0);
#pragma unroll
    for (int g = 0; g < 8; ++g) { const float d = pd_trace(acc[g]);
        if (g < 4) dl = (q == g) ? d : dl; else dh = (q == g - 4) ? d : dh; }
    const int srcl = 4 * (4 * (lane & 15) + (lane >> 4));
    dl = __int_as_float(__builtin_amdgcn_ds_bpermute(srcl, __float_as_int(dl))); dh = __int_as_float(__builtin_amdgcn_ds_bpermute(srcl, __float_as_int(dh)));
    PDs[(size_t)m * 128 + lane] = dl; PDs[(size_t)m * 128 + 64 + lane] = dh;
}
__device__ __forceinline__ void phase_peer_dots(const Params& P, LAS unsigned char* lds) {
    const int lane = threadIdx.x & 63, wave = __builtin_amdgcn_readfirstlane(threadIdx.x >> 6);
    const int* IDS = (const int*)(P.ws + WS_IDS); float* PD = (float*)(P.ws + WS_PD);
    volatile LAS unsigned* bst = (volatile LAS unsigned*)(lds + LDS_MISC);
    const unsigned rank = __builtin_amdgcn_readfirstlane(bst[4]), x = __builtin_amdgcn_readfirstlane(bst[5]);
    unsigned* bar = (unsigned*)(P.ws + WS_CTL);
    unsigned n = 1, xi = 0, nx = 0;
    for (unsigned j = 0; j < 16; ++j) { const unsigned cnt = __builtin_amdgcn_readfirstlane(xb_ld(&bar[XB_XCNT(j)])); if (cnt) { if (j < x) ++xi; ++nx; } if (j == x) n = cnt; }
    if (nx == 0) nx = 1; if (n == 0) n = 1;
    constexpr int NCW = NWAVES - 1;
    const int stride = (int)n * NCW; const bool arow = ((lane >> 2) & 3) == (lane >> 4);
    LAS unsigned char* slot0 = lds + wave * 512; LAS unsigned char* slot1 = slot0 + 256; LAS unsigned char* zer = lds + NWAVES * 512;
    volatile LAS unsigned* prog = (volatile LAS unsigned*)(zer + 256);
    __syncthreads();
    if (threadIdx.x < 80) ((LAS unsigned*)zer)[threadIdx.x] = 0u;
    __syncthreads();
    if (wave == NCW) {
        constexpr unsigned AHEAD = 600;
        unsigned base = 0;
        for (unsigned s = xi; s < 8; s += nx) {
            const int r7 = (int)rank * NCW; unsigned total = 0;
            for (int w = 0; w < NCW; ++w) { const int m0 = r7 + w; total += (m0 < M) ? (unsigned)((M - m0 + stride - 1) / stride) : 0u; }
            const int tk = lane / 6, ln = lane - 6 * tk;
            for (unsigned done = 0; done < total; ) {
                if (done + base < *prog + AHEAD) {
                    const unsigned char* pa[4];
#pragma unroll
                    for (int k = 0; k < 4; ++k) { unsigned j = done + 10u * k + (unsigned)(tk < 10 ? tk : 9); if (j >= total) j = total - 1;
                        const int i = (int)(j / NCW), w = (int)(j - (unsigned)i * NCW); int m = r7 + w + i * stride; if (m >= M) m = r7;
                        pa[k] = (ln < 4) ? (const unsigned char*)IDS + (size_t)m * 512 + 128 * ln : P.ws + WS_H8 + (size_t)m * 2048 + 128 * s + 1024 * (ln - 4); }
                    unsigned d0, d1, d2, d3;
                    asm volatile("global_load_dword %0, %4, off\n\tglobal_load_dword %1, %5, off\n\tglobal_load_dword %2, %6, off\n\tglobal_load_dword %3, %7, off\n\ts_waitcnt vmcnt(0)"
                                 : "=&v"(d0), "=&v"(d1), "=&v"(d2), "=&v"(d3) : "v"(pa[0]), "v"(pa[1]), "v"(pa[2]), "v"(pa[3]) : "memory");
                    done += 40;
                } else __builtin_amdgcn_s_sleep(4);
            }
            base += total;
        }
        return;
    }
    const LAS unsigned char* ar0 = arow ? slot0 + 16 * (lane & 3) : zer; const LAS unsigned char* ar1 = arow ? slot1 + 16 * (lane & 3) : zer;
    for (unsigned s = xi; s < 8; s += nx) {
        const unsigned char* UFs = P.ws + WS_UF + (size_t)s * UF_SLICE;
        const unsigned char* H8s = P.ws + WS_H8 + 128 * s + (lane < 32 ? 4 * lane : 1024 + 4 * (lane - 32)); float* PDs = PD + (size_t)s * M * 128;
        const int m0 = (int)rank * NCW + wave;
        if (m0 >= M) continue;
        const int cnt = (M - m0 + stride - 1) / stride;
#define PD_TOK(i) ((i) < cnt ? m0 + (i) * stride : m0)
        u32x4 RA4[8], RB4[8], RA2[8], RB2[8];
        PdTok t0 = pd_fetch(IDS, H8s, m0, lane), t1 = pd_fetch(IDS, H8s, PD_TOK(1), lane), t2 = pd_fetch(IDS, H8s, PD_TOK(2), lane);
        pd_issue(RA4, RA2, t0, UFs, slot0, lane);
        for (int i = 0; i < cnt; i += 2) {
            const int ma = PD_TOK(i), mb = PD_TOK(i + 1);
            const PdTok t3 = pd_fetch(IDS, H8s, PD_TOK(i + 3), lane);
            pd_issue(RB4, RB2, t1, UFs, slot1, lane);
            __builtin_amdgcn_sched_barrier(0);
            pd_compute(RA4, RA2, ar0, PDs, ma, lane);
            if (lane == 0) __hip_atomic_fetch_add((LAS unsigned*)prog, 1u, __ATOMIC_RELAXED, __HIP_MEMORY_SCOPE_WORKGROUP);
            __builtin_amdgcn_sched_barrier(0);
            const PdTok t4 = pd_fetch(IDS, H8s, PD_TOK(i + 4), lane);
            pd_issue(RA4, RA2, t2, UFs, slot0, lane);
            __builtin_amdgcn_sched_barrier(0);
            pd_compute(RB4, RB2, ar1, PDs, mb, lane);
            if (lane == 0 && i + 1 < cnt) __hip_atomic_fetch_add((LAS unsigned*)prog, 1u, __ATOMIC_RELAXED, __HIP_MEMORY_SCOPE_WORKGROUP);
            __builtin_amdgcn_sched_barrier(0);
            t1 = t3; t2 = t4;
        }
#undef PD_TOK
    }
}

__device__ __forceinline__ void phase_peer_coef(const Params& P) {
    const int lane = threadIdx.x & 63, wave = threadIdx.x >> 6; const int gw = blockIdx.x * NWAVES + wave, ngw = gridDim.x * NWAVES;
    const int* IDS = (const int*)(P.ws + WS_IDS); const float* GATES = (const float*)(P.ws + WS_GATES); const float* PD = (const float*)(P.ws + WS_PD);
    const float* SU = (const float*)(P.ws + WS_SU); const float* SV = (const float*)(P.ws + WS_SV);
    unsigned char* CQ = P.ws + WS_CQ; float* CS = (float*)(P.ws + WS_CS);
    constexpr int TB = 4;
    for (int mb = gw; mb < M; mb += TB * ngw) {
        int id_lo[TB], id_hi[TB]; float gt_lo[TB], gt_hi[TB], d_lo[TB], d_hi[TB], su_lo[TB], su_hi[TB], sv_lo[TB], sv_hi[TB];
#pragma unroll
        for (int t = 0; t < TB; ++t) { const int m = (mb + t * ngw < M) ? mb + t * ngw : mb;
            id_lo[t] = IDS[(size_t)m * 128 + lane]; id_hi[t] = IDS[(size_t)m * 128 + 64 + lane]; gt_lo[t] = GATES[(size_t)m * 128 + lane]; gt_hi[t] = GATES[(size_t)m * 128 + 64 + lane]; }
#pragma unroll
        for (int t = 0; t < TB; ++t) { const int m = (mb + t * ngw < M) ? mb + t * ngw : mb; float a = 0.f, b = 0.f;
#pragma unroll
            for (int s = 0; s < 8; ++s) { a += PD[((size_t)s * M + m) * 128 + lane]; b += PD[((size_t)s * M + m) * 128 + 64 + lane]; }
            d_lo[t] = a; d_hi[t] = b; }
#pragma unroll
        for (int t = 0; t < TB; ++t) { su_lo[t] = SU[id_lo[t]]; su_hi[t] = SU[id_hi[t]]; sv_lo[t] = SV[id_lo[t]]; sv_hi[t] = SV[id_hi[t]]; }
#pragma unroll
        for (int t = 0; t < TB; ++t) { const int m = (mb + t * ngw < M) ? mb + t * ngw : mb;
            const float x_lo = d_lo[t] * su_lo[t], x_hi = d_hi[t] * su_hi[t];
            const float a_lo = 0.5f * x_lo * (1.f + erff(x_lo * 0.70710678118f)) * gt_lo[t] * sv_lo[t], a_hi = 0.5f * x_hi * (1.f + erff(x_hi * 0.70710678118f)) * gt_hi[t] * sv_hi[t];
            const float amx = wave_max_u(fmaxf(fabsf(a_lo), fabsf(a_hi))); const float ainv = amx > 0.f ? 127.f / amx : 0.f;
            const int q_lo = __float2int_rn(a_lo * ainv), q_hi = __float2int_rn(a_hi * ainv);
            const int j0 = lane, j1 = 64 + lane;
            CQ[(size_t)m * 128 + 16 * ((j0 >> 2) & 7) + 4 * (j0 >> 5) + (j0 & 3)] = (unsigned char)q_lo;
            CQ[(size_t)m * 128 + 16 * ((j1 >> 2) & 7) + 4 * (j1 >> 5) + (j1 & 3)] = (unsigned char)q_hi;
            if (lane == 0) CS[m] = amx * (1.f / 127.f); }
    }
}

struct AxTok { u32x4 id[4]; u32x4 cq; float cs; unsigned hw; };
__device__ __forceinline__ void ax_fetch(AxTok& t, const int* IDS, const unsigned char* CQ, const float* CS, const bf16* H1s, int m, int lane) {
    const u32x4* ip = (const u32x4*)(IDS + (size_t)m * 128) + (lane >> 3);
#pragma unroll
    for (int r = 0; r < 4; ++r) t.id[r] = ip[8 * r];
    t.cq = *((const u32x4*)(CQ + (size_t)m * 128) + (lane >> 3)); t.cs = CS[m]; t.hw = *(const unsigned*)(H1s + (size_t)m * D);
}
__device__ __forceinline__ void ax_issue(u32x4 (&W)[4], const u32x4 ids, const unsigned char* V8s, int lane) {
#pragma unroll
    for (int k = 0; k < 4; ++k) W[k] = *(const u32x4*)(V8s + ((ids[k] << 7) + 16u * (unsigned)(lane & 7)));
}
__device__ __forceinline__ void ax_round(const u32x4 (&W)[4], int c4, int (&acc)[16]) {
#pragma unroll
    for (int i = 0; i < 4; ++i) {
        const unsigned t0 = __builtin_amdgcn_perm(W[1][i], W[0][i], 0x05010400u), t1 = __builtin_amdgcn_perm(W[1][i], W[0][i], 0x07030602u);
        const unsigned t2 = __builtin_amdgcn_perm(W[3][i], W[2][i], 0x05010400u), t3 = __builtin_amdgcn_perm(W[3][i], W[2][i], 0x07030602u);
        const unsigned T0 = __builtin_amdgcn_perm(t2, t0, 0x05040100u), T1 = __builtin_amdgcn_perm(t2, t0, 0x07060302u), T2 = __builtin_amdgcn_perm(t3, t1, 0x05040100u), T3 = __builtin_amdgcn_perm(t3, t1, 0x07060302u);
        acc[4 * i] = __builtin_amdgcn_sdot4((int)T0, c4, acc[4 * i], false); acc[4 * i + 1] = __builtin_amdgcn_sdot4((int)T1, c4, acc[4 * i + 1], false);
        acc[4 * i + 2] = __builtin_amdgcn_sdot4((int)T2, c4, acc[4 * i + 2], false); acc[4 * i + 3] = __builtin_amdgcn_sdot4((int)T3, c4, acc[4 * i + 3], false); }
}
__device__ __forceinline__ void ax_finish(int (&acc)[16], float cs, unsigned hw, bf16* ZPs, int m, int lane) {
    const bool b3 = (lane & 8) != 0, b4 = (lane & 16) != 0, b5 = (lane & 32) != 0;
    int w8[8], w4[4], w2[2];
#pragma unroll
    for (int i = 0; i < 8; ++i) { const int keep = b3 ? acc[i + 8] : acc[i], send = b3 ? acc[i] : acc[i + 8]; w8[i] = keep + DPP_I(send, 0x128); }
#pragma unroll
    for (int i = 0; i < 4; ++i) { const int keep = b4 ? w8[i + 4] : w8[i], send = b4 ? w8[i] : w8[i + 4]; w4[i] = keep + __builtin_amdgcn_ds_swizzle(send, 0x401F); }
#pragma unroll
    for (int i = 0; i < 2; ++i) { const int keep = b5 ? w4[i + 2] : w4[i], send = b5 ? w4[i] : w4[i + 2]; w2[i] = keep + __shfl_xor(send, 32); }
    const float z0 = ALPHA * __uint_as_float(hw << 16) + cs * (float)w2[0], z1 = ALPHA * __uint_as_float(hw & 0xffff0000u) + cs * (float)w2[1];
    const int d0 = 16 * (lane & 7) + (b3 ? 8 : 0) + (b4 ? 4 : 0) + (b5 ? 2 : 0);
    *(unsigned*)(ZPs + (size_t)m * D + d0) = pk2(z0, z1);
}
__device__ __forceinline__ void phase_peer_axpy(const Params& P, LAS unsigned char* lds) {
    const int lane = threadIdx.x & 63, wave = __builtin_amdgcn_readfirstlane(threadIdx.x >> 6);
    const int* IDS = (const int*)(P.ws + WS_IDS); const unsigned char* CQ = P.ws + WS_CQ; const float* CS = (const float*)(P.ws + WS_CS);
    volatile LAS unsigned* bst = (volatile LAS unsigned*)(lds + LDS_MISC);
    const unsigned rank = __builtin_amdgcn_readfirstlane(bst[4]), x = __builtin_amdgcn_readfirstlane(bst[5]);
    unsigned* bar = (unsigned*)(P.ws + WS_CTL);
    unsigned n = 1, xi = 0, nx = 0;
    for (unsigned j = 0; j < 16; ++j) { const unsigned cnt = __builtin_amdgcn_readfirstlane(xb_ld(&bar[XB_XCNT(j)])); if (cnt) { if (j < x) ++xi; ++nx; } if (j == x) n = cnt; }
    if (nx == 0) nx = 1; if (n == 0) n = 1;
    constexpr int NCW = NWAVES - 1;
    const int stride = (int)n * NCW;
    volatile LAS unsigned* prog = (volatile LAS unsigned*)lds;
    __syncthreads();
    if (threadIdx.x == 0) *prog = 0u;
    __syncthreads();
    if (wave == NCW) {
        constexpr unsigned AHEAD = 600;
        unsigned base = 0;
        for (unsigned s = xi; s < 8; s += nx) {
            const int r7 = (int)rank * NCW; unsigned total = 0;
            for (int w = 0; w < NCW; ++w) { const int m0 = r7 + w; total += (m0 < M) ? (unsigned)((M - m0 + stride - 1) / stride) : 0u; }
            const int tk = lane >> 3, ln = lane & 7;
            for (unsigned done = 0; done < total; ) {
                if (done + base < *prog + AHEAD) {
                    const unsigned char* pa[4];
#pragma unroll
                    for (int k = 0; k < 4; ++k) { unsigned j = done + 8u * k + (unsigned)tk; if (j >= total) j = total - 1;
                        const int i = (int)(j / NCW), w = (int)(j - (unsigned)i * NCW); int m = r7 + w + i * stride; if (m >= M) m = r7;
                        pa[k] = (ln < 4) ? (const unsigned char*)IDS + (size_t)m * 512 + 128 * ln : (ln == 4) ? CQ + (size_t)m * 128 : (ln < 7) ? P.ws + WS_H1 + (size_t)m * 2048 + 256 * s + 128 * (ln - 5) : (const unsigned char*)(CS + m); }
                    unsigned d0, d1, d2, d3;
                    asm volatile("global_load_dword %0, %4, off\n\tglobal_load_dword %1, %5, off\n\tglobal_load_dword %2, %6, off\n\tglobal_load_dword %3, %7, off\n\ts_waitcnt vmcnt(0)"
                                 : "=&v"(d0), "=&v"(d1), "=&v"(d2), "=&v"(d3) : "v"(pa[0]), "v"(pa[1]), "v"(pa[2]), "v"(pa[3]) : "memory");
                    done += 32;
                } else __builtin_amdgcn_s_sleep(4);
            }
            base += total;
        }
        return;
    }
    const int dsel = 16 * (lane & 7) + ((lane & 8) ? 8 : 0) + ((lane & 16) ? 4 : 0) + ((lane & 32) ? 2 : 0);
    for (unsigned s = xi; s < 8; s += nx) {
        const unsigned char* V8s = P.ws + WS_V8 + (size_t)s * V8_SLICE;
        const bf16* H1s = (const bf16*)(P.ws + WS_H1) + 128 * s + dsel; bf16* ZPs = (bf16*)(P.ws + WS_ZP) + 128 * s;
        const int m0 = (int)rank * NCW + wave;
        if (m0 >= M) continue;
        const int cnt = (M - m0 + stride - 1) / stride;
#define AX_TOK(i) ((i) < cnt ? m0 + (i) * stride : m0)
        u32x4 W0[4], W1[4], W2[4], W3[4];
        AxTok ta, tb, tc; ax_fetch(ta, IDS, CQ, CS, H1s, m0, lane); ax_fetch(tb, IDS, CQ, CS, H1s, AX_TOK(1), lane);
        ax_issue(W0, ta.id[0], V8s, lane); ax_issue(W1, ta.id[1], V8s, lane); ax_issue(W2, ta.id[2], V8s, lane);
#define AX_STEP(CUR, NXT, FRE, ii) do { \
            const int ma_ = AX_TOK(ii); \
            ax_fetch(FRE, IDS, CQ, CS, H1s, AX_TOK((ii) + 2), lane); \
            int acc[16]; \
            _Pragma("unroll") for (int j = 0; j < 16; ++j) acc[j] = 0; \
            ax_issue(W3, CUR.id[3], V8s, lane); __builtin_amdgcn_sched_barrier(0); ax_round(W0, (int)CUR.cq[0], acc); __builtin_amdgcn_sched_barrier(0); \
            ax_issue(W0, NXT.id[0], V8s, lane); __builtin_amdgcn_sched_barrier(0); ax_round(W1, (int)CUR.cq[1], acc); __builtin_amdgcn_sched_barrier(0); \
            ax_issue(W1, NXT.id[1], V8s, lane); __builtin_amdgcn_sched_barrier(0); ax_round(W2, (int)CUR.cq[2], acc); __builtin_amdgcn_sched_barrier(0); \
            ax_issue(W2, NXT.id[2], V8s, lane); __builtin_amdgcn_sched_barrier(0); ax_round(W3, (int)CUR.cq[3], acc); __builtin_amdgcn_sched_barrier(0); \
            ax_finish(acc, CUR.cs, CUR.hw, ZPs, ma_, lane); \
            if (lane == 0 && (ii) < cnt) __hip_atomic_fetch_add((LAS unsigned*)prog, 1u, __ATOMIC_RELAXED, __HIP_MEMORY_SCOPE_WORKGROUP); } while (0)
        for (int i = 0; i < cnt; i += 3) { AX_STEP(ta, tb, tc, i); AX_STEP(tb, tc, ta, i + 1); AX_STEP(tc, ta, tb, i + 2); }
#undef AX_STEP
#undef AX_TOK
    }
}

__device__ __forceinline__ void phase_ln2(const Params& P) {
    const int lane = threadIdx.x & 63, wave = threadIdx.x >> 6; const int gw = blockIdx.x * NWAVES + wave, ngw = gridDim.x * NWAVES;
    const float* g2 = P.in[26]; const float* b2 = P.in[27]; const bf16* ZP = (const bf16*)(P.ws + WS_ZP);
    for (int m = gw; m < M; m += ngw) {
        const u32x4* xr = (const u32x4*)(ZP + (size_t)m * D) + 2 * lane; const u32x4 a = xr[0], c = xr[1]; float v[16]; float s = 0.f;
#pragma unroll
        for (int i = 0; i < 4; ++i) { v[2 * i] = __uint_as_float(a[i] << 16); v[2 * i + 1] = __uint_as_float(a[i] & 0xffff0000u); v[8 + 2 * i] = __uint_as_float(c[i] << 16); v[8 + 2 * i + 1] = __uint_as_float(c[i] & 0xffff0000u); }
#pragma unroll
        for (int i = 0; i < 16; ++i) s += v[i];
        const float mean = wave_sum(s) * (1.f / D); float s2 = 0.f;
#pragma unroll
        for (int i = 0; i < 16; ++i) { v[i] -= mean; s2 += v[i] * v[i]; }
        const float rstd = 1.f / sqrtf(wave_sum(s2) * (1.f / D) + LN_EPS);
#pragma unroll
        for (int c4 = 0; c4 < 4; ++c4) { const int e0 = 16 * lane + 4 * c4; const f32x4 gg = *(const f32x4*)(g2 + e0), bb = *(const f32x4*)(b2 + e0); f32x4 o;
#pragma unroll
            for (int j = 0; j < 4; ++j) o[j] = v[c4 * 4 + j] * rstd * gg[j] + bb[j];
            *(f32x4*)(P.out + (size_t)m * D + e0) = o; }
    }
}

constexpr int N_PHASES = 14;
__global__ void __launch_bounds__(NTHR, 2) fwd_kernel(Params P) {
    extern __shared__ __attribute__((aligned(16))) unsigned char lds_raw[];
    LAS unsigned char* lds = (LAS unsigned char*)lds_raw;
    cg::grid_group grid = cg::this_grid();
    const int lo = P.ph_lo, hi = P.ph_hi;
    unsigned char* ws = P.ws;
    volatile LAS unsigned* bst = (volatile LAS unsigned*)(lds + LDS_MISC);
    if (threadIdx.x < 16) bst[threadIdx.x] = 0u;
    __syncthreads();
    const XcdBarrier bar = xcd_barrier_post((unsigned*)(ws + WS_CTL), bst);
#define IN(k) (lo <= (k) && (k) < hi)
#define SEAM(k) do { if (IN(k) && IN((k) + 1)) { if ((k) == 0) grid.sync(); else xcd_barrier(bar); } } while (0)
    if (IN(0)) phase_prologue(P, lds);
    SEAM(0);
    if (IN(1)) {
        pg8::Gemm g{(const bf16*)(ws + WS_H0), (const bf16*)(ws + WS_WIN), M, NP, D, D, D, 0}; pg8::StaticOrder S; S.init(M, NP, gridDim.x, blockIdx.x);
        pg8::EpiBf16 E{(bf16*)(ws + WS_P), NP};
        pg8::gemm_phase<pg8::EpiBf16, pg8::StaticOrder, true, true>(lds, g, S, E);
    }
    SEAM(1);
    if (IN(2)) phase_prep(P, lds);
    SEAM(2);
    if (IN(3)) phase_scan(P, lds);
    SEAM(3);
    if (IN(4)) phase_fixup(P, lds);
    SEAM(4);
    if (IN(5)) phase_correct(P, lds);
    SEAM(5);
    if (IN(6)) {
        pg8::Gemm g{(const bf16*)P.out, (const bf16*)(ws + WS_WOUT), M, D, D, D, D, 0}; pg8::StaticOrder S; S.init(M, D, gridDim.x, blockIdx.x);
        pg8::EpiResBf16 E{(bf16*)(ws + WS_Z), (const bf16*)(ws + WS_H0), D, ALPHA};
        pg8::gemm_phase<pg8::EpiResBf16, pg8::StaticOrder, true, true>(lds, g, S, E);
    }
    SEAM(6);
    if (IN(7)) phase_ln1(P);
    SEAM(7);
    if (IN(8)) {
        pg8::Gemm g{(const bf16*)(ws + WS_H1), (const bf16*)(ws + WS_WQ), M, NQ, D, D, D, 0}; pg8::StaticOrder S; S.init(M, NQ, gridDim.x, blockIdx.x);
        pg8::EpiScores E{(bf16*)(ws + WS_S)};
        pg8::gemm_phase<pg8::EpiScores, pg8::StaticOrder, true, true>(lds, g, S, E);
    }
    SEAM(8);
    if (IN(9)) phase_topk(P);
    SEAM(9);
    if (IN(10)) phase_peer_dots(P, lds);
    SEAM(10);
    if (IN(11)) phase_peer_coef(P);
    SEAM(11);
    if (IN(12)) phase_peer_axpy(P, lds);
    SEAM(12);
    if (IN(13)) phase_ln2(P);
#undef IN
#undef SEAM
}

extern "C" void kernel_launch(void* const* d_in, const int* in_sizes, int n_in, void* d_out, int out_size, void* d_ws, size_t ws_size, hipStream_t stream) {
    static int grid = 0;
    if (grid == 0) {
        if (n_in != 28 || out_size != M * D || ws_size < WS_END) { fprintf(stderr, "kernel_launch: unexpected shapes (n_in %d out %d ws %zu)\n", n_in, out_size, ws_size); grid = -1; return; }
        int dev = 0, cus = 0, per_cu = 0;
        (void)hipGetDevice(&dev); (void)hipDeviceGetAttribute(&cus, hipDeviceAttributeMultiprocessorCount, dev);
        (void)hipFuncSetAttribute((const void*)fwd_kernel, hipFuncAttributeMaxDynamicSharedMemorySize, LDS_BYTES);
        (void)hipOccupancyMaxActiveBlocksPerMultiprocessor(&per_cu, (const void*)fwd_kernel, NTHR, LDS_BYTES);
        if (per_cu < 1) { fprintf(stderr, "kernel_launch: occupancy query says %d blocks per CU\n", per_cu); per_cu = 1; }
        (void)hipGetLastError();
        grid = cus;
    }
    if (grid < 0) return;
    Params p{};
    for (int i = 0; i < 28; ++i) p.in[i] = (const float*)d_in[i];
    p.out = (float*)d_out; p.ws = (unsigned char*)d_ws;
    (void)hipMemsetAsync((char*)d_ws + WS_CTL, 0, CTL_BYTES, stream);
    p.ph_lo = 0; p.ph_hi = N_PHASES;
    void* args[] = {&p};
    hipError_t e = hipLaunchCooperativeKernel((const void*)fwd_kernel, dim3(grid), dim3(NTHR), args, LDS_BYTES, stream);
    if (e != hipSuccess) fprintf(stderr, "cooperative launch failed: %s (grid %d)\n", hipGetErrorString(e), grid);
}
```

```cpp
#include <hip/hip_runtime.h>
#include <hip/hip_cooperative_groups.h>
#include <cstdio>
#include <cstdint>
namespace cg = cooperative_groups;

namespace pg8 {
#define PG8_LAS __attribute__((address_space(3)))
typedef unsigned short bf16_t;
typedef short bf16x8 __attribute__((ext_vector_type(8)));
typedef float f32x4 __attribute__((ext_vector_type(4)));
typedef float f32x2 __attribute__((ext_vector_type(2)));
typedef unsigned u32x4 __attribute__((ext_vector_type(4)));
typedef unsigned u32x2 __attribute__((ext_vector_type(2)));
constexpr int BM = 256, BK = 64, HALF = 128, HTB = HALF * BK * 2, STAGE_BYTES = 8 * HTB, NXCD = 8, WGM = 8;

__host__ __device__ __forceinline__ int lds_byte(int r, int c) { const int st = (r >> 4) * 2 + (c >> 5), rr = r & 15, cc = c & 31, ob = rr * 64 + cc * 2; return st * 1024 + (ob ^ (((ob >> 9) & 1) << 5)); }
__host__ __device__ __forceinline__ void stage_rc(int b, int& R, int& C) { const int st = b / 1024, sb = b % 1024, swz = sb ^ (((sb >> 9) & 1) << 5); R = (st >> 1) * 16 + swz / 64; C = (st & 1) * 32 + (swz % 64) / 2; }
__host__ __device__ __forceinline__ int perm32(int rho) { const int n = rho >> 4, i = rho & 15; return 8 * (i >> 2) + 4 * n + (i & 3); }

struct Unit { int pm, pn; };
struct Gemm { const bf16_t* A; const bf16_t* Bt; int M, N, K, lda, ldb, a_pn_koff; };

struct StaticOrder {
    int nM, nN, nwg, G, c;
    __host__ __device__ void init(int M, int N, int G_, int c_) { nM = M / BM; nN = N / BM; nwg = nM * nN; G = G_; c = c_; }
    __host__ __device__ bool next(int i, Unit& u) const {
        const long L = (long)i * G + c; if (L >= nwg) return false;
        int wgid = (int)L; { const int q = nwg / NXCD, r = nwg % NXCD, xcd = wgid % NXCD, off = wgid / NXCD; wgid = (xcd < r ? xcd * (q + 1) : r * (q + 1) + (xcd - r) * q) + off; }
        const int nig = WGM * nN, gid = wgid / nig, fm = gid * WGM, gsz = (nM - fm) < WGM ? (nM - fm) : WGM;
        u.pm = fm + ((wgid % nig) % gsz); u.pn = (wgid % nig) / gsz; return true;
    }
    __device__ __forceinline__ void a_ready(const Unit&) const {}
    __device__ __forceinline__ void done(const Unit&) const {}
};

typedef float f32x2p_t __attribute__((ext_vector_type(2))); typedef __bf16 bf16x2p_t __attribute__((ext_vector_type(2)));
__device__ __forceinline__ unsigned cvt_pk_bf16(float lo, float hi) { const f32x2p_t v = {lo, hi}; const bf16x2p_t b = __builtin_convertvector(v, bf16x2p_t); return __builtin_bit_cast(unsigned, b); }

struct EpiScores {
    static constexpr bool PERM = true;
    bf16_t* O;
    __device__ __forceinline__ void operator()(const f32x4 (&acc)[2][2][4][2], const Unit& u, int wr, int wc, int fr, int fq) const {
        const int row0 = u.pm * BM + wr * 64 + fr;
#pragma unroll
        for (int ai = 0; ai < 2; ++ai)
#pragma unroll
            for (int m = 0; m < 4; ++m) { const int row = row0 + ai * HALF + m * 16;
                bf16_t* tp = O + ((size_t)((row >> 6) * (2048 / BM) + u.pn) * 32 * 64 + (row & 63)) * 8;
#pragma unroll
                for (int bj = 0; bj < 2; ++bj) { const f32x4 v0 = acc[ai][bj][m][0], v1 = acc[ai][bj][m][1];
                    u32x4 w; w.x = cvt_pk_bf16(v0[0], v0[1]); w.y = cvt_pk_bf16(v0[2], v0[3]); w.z = cvt_pk_bf16(v1[0], v1[1]); w.w = cvt_pk_bf16(v1[2], v1[3]);
                    *(u32x4*)(tp + (size_t)(4 * wc + fq + 16 * bj) * 64 * 8) = w; } }
    }
};
struct EpiBf16 {
    static constexpr bool PERM = true;
    bf16_t* O; int ldc;
    __device__ __forceinline__ void operator()(const f32x4 (&acc)[2][2][4][2], const Unit& u, int wr, int wc, int fr, int fq) const {
        const int row0 = u.pm * BM + wr * 64 + fr; const int col0 = u.pn * BM + wc * 32 + 8 * fq;
#pragma unroll
        for (int ai = 0; ai < 2; ++ai)
#pragma unroll
            for (int m = 0; m < 4; ++m) { bf16_t* rowp = O + (size_t)(row0 + ai * HALF + m * 16) * ldc + col0;
#pragma unroll
                for (int bj = 0; bj < 2; ++bj) { const f32x4 v0 = acc[ai][bj][m][0], v1 = acc[ai][bj][m][1];
                    u32x4 w; w.x = cvt_pk_bf16(v0[0], v0[1]); w.y = cvt_pk_bf16(v0[2], v0[3]); w.z = cvt_pk_bf16(v1[0], v1[1]); w.w = cvt_pk_bf16(v1[2], v1[3]);
                    *(u32x4*)(rowp + bj * HALF) = w; } }
    }
};
struct EpiResBf16 {
    static constexpr bool PERM = true;
    bf16_t* Z; const bf16_t* R; int ldc; float alpha;
    __device__ __forceinline__ void operator()(const f32x4 (&acc)[2][2][4][2], const Unit& u, int wr, int wc, int fr, int fq) const {
        const int row0 = u.pm * BM + wr * 64 + fr; const int col0 = u.pn * BM + wc * 32 + 8 * fq;
#pragma unroll
        for (int ai = 0; ai < 2; ++ai)
#pragma unroll
            for (int m = 0; m < 4; ++m) { const size_t off = (size_t)(row0 + ai * HALF + m * 16) * ldc + col0;
#pragma unroll
                for (int bj = 0; bj < 2; ++bj) { const u32x4 rb = *(const u32x4*)(R + off + bj * HALF); const f32x4 v0 = acc[ai][bj][m][0], v1 = acc[ai][bj][m][1];
                    u32x4 w;
                    w.x = cvt_pk_bf16(__uint_as_float(rb.x << 16) * alpha + v0[0], __uint_as_float(rb.x & 0xffff0000u) * alpha + v0[1]);
                    w.y = cvt_pk_bf16(__uint_as_float(rb.y << 16) * alpha + v0[2], __uint_as_float(rb.y & 0xffff0000u) * alpha + v0[3]);
                    w.z = cvt_pk_bf16(__uint_as_float(rb.z << 16) * alpha + v1[0], __uint_as_float(rb.z & 0xffff0000u) * alpha + v1[1]);
                    w.w = cvt_pk_bf16(__uint_as_float(rb.w << 16) * alpha + v1[2], __uint_as_float(rb.w & 0xffff0000u) * alpha + v1[3]);
                    *(u32x4*)(Z + off + bj * HALF) = w; } }
    }
};
template <class Epi, class Sched, bool ALIGN_EPI = false, bool SP2 = false>
__device__ __forceinline__ void gemm_phase(PG8_LAS unsigned char* lds, const Gemm g, const Sched& S, const Epi& E) {
    const int tid = threadIdx.x, wid = __builtin_amdgcn_readfirstlane(tid >> 6), lane = tid & 63, wr = wid >> 2, wc = wid & 3, fr = lane & 15, fq = lane >> 4;
    const int K = g.K, nt = K / BK;
    unsigned voffA[2], voffB[2];
#pragma unroll
    for (int i = 0; i < 2; ++i) { int R, C; stage_rc(tid * 16 + i * 8192, R, C); const int Rb = Epi::PERM ? ((R & ~31) + perm32(R & 31)) : R;
        voffA[i] = (unsigned)(R * g.lda + C) * 2u; voffB[i] = (unsigned)(Rb * g.ldb + C) * 2u; }
    const size_t kstep = (size_t)(BK * 2);
    const size_t hstepA = (size_t)HALF * g.lda * 2, hstepB = (size_t)HALF * g.ldb * 2;
    const size_t tstepA = 2 * hstepA, tstepB = 2 * hstepB;
    const size_t pnA = (size_t)g.a_pn_koff * 2;
    const unsigned ldsw = (unsigned)wid * 1024u;
    const int aoff = lds_byte(wr * 64 + fr, fq * 8), boff = lds_byte(wc * 32 + fr, fq * 8);
#define PG8_SA(b, h) (((b) * 2 + (h)) * HTB)
#define PG8_SB(b, h) ((4 + (b) * 2 + (h)) * HTB)
#define PG8_STAGE(bufoff, gbase, voff) do { _Pragma("unroll") for (int _i = 0; _i < 2; ++_i) \
        __builtin_amdgcn_global_load_lds((const unsigned*)((const char*)(gbase) + (voff)[_i]), (PG8_LAS unsigned*)(lds + (bufoff) + ldsw + _i * 8192), 16, 0, 0); } while (0)
#define PG8_LDA(dst, b, h) do { _Pragma("unroll") for (int m = 0; m < 4; ++m) _Pragma("unroll") for (int k = 0; k < 2; ++k) dst[m][k] = *(const PG8_LAS bf16x8*)(lds + PG8_SA(b, h) + aoff + m * 2048 + k * 1024); } while (0)
#define PG8_LDB(dst, b, h) do { _Pragma("unroll") for (int n = 0; n < 2; ++n) _Pragma("unroll") for (int k = 0; k < 2; ++k) dst[n][k] = *(const PG8_LAS bf16x8*)(lds + PG8_SB(b, h) + boff + n * 2048 + k * 1024); } while (0)
#define PG8_MMA(ai, bj, At, Bt) do { __builtin_amdgcn_s_setprio(1); _Pragma("unroll") for (int m = 0; m < 4; ++m) _Pragma("unroll") for (int n = 0; n < 2; ++n) _Pragma("unroll") for (int k = 0; k < 2; ++k) \
        acc[ai][bj][m][n] = __builtin_amdgcn_mfma_f32_16x16x32_bf16(Bt[n][k], At[m][k], acc[ai][bj][m][n], 0, 0, 0); __builtin_amdgcn_s_setprio(0); } while (0)
#define PG8_WAIT_V(n) asm volatile("s_waitcnt vmcnt(" #n ")" ::: "memory")
#define PG8_WAIT_L(n) asm volatile("s_waitcnt lgkmcnt(" #n ")" ::: "memory")
#define PG8_BAR __builtin_amdgcn_s_barrier()
#define PG8_SCHED __builtin_amdgcn_sched_barrier(0)
    Unit cur, nxt; int ui = 0;
    if (!S.next(0, cur)) return;
    f32x4 acc[2][2][4][2];
#pragma unroll
    for (int a = 0; a < 2; ++a)
#pragma unroll
        for (int b = 0; b < 2; ++b)
#pragma unroll
            for (int m = 0; m < 4; ++m)
#pragma unroll
                for (int n = 0; n < 2; ++n) acc[a][b][m][n] = (f32x4){0.f, 0.f, 0.f, 0.f};
    bf16x8 At[4][2], B0[2][2], B1[2][2];
    const char* cA = (const char*)g.A + (size_t)cur.pm * tstepA + (size_t)cur.pn * pnA; const char* cB = (const char*)g.Bt + (size_t)cur.pn * tstepB;
    S.a_ready(cur);
    if constexpr (SP2) {
        PG8_STAGE(PG8_SB(0, 0), cB, voffB); PG8_STAGE(PG8_SB(0, 1), cB + hstepB, voffB); PG8_STAGE(PG8_SA(0, 0), cA, voffA); PG8_STAGE(PG8_SA(0, 1), cA + hstepA, voffA);
        if (wr == 1) PG8_BAR;
        PG8_WAIT_V(2); PG8_BAR;
        PG8_STAGE(PG8_SB(1, 0), cB + kstep, voffB); PG8_STAGE(PG8_SA(1, 0), cA + kstep, voffA); PG8_STAGE(PG8_SB(1, 1), cB + hstepB + kstep, voffB);
        PG8_WAIT_V(6); PG8_BAR;
    } else {
        PG8_STAGE(PG8_SB(0, 0), cB, voffB); PG8_STAGE(PG8_SA(0, 0), cA, voffA); PG8_STAGE(PG8_SB(0, 1), cB + hstepB, voffB); PG8_STAGE(PG8_SA(0, 1), cA + hstepA, voffA);
        if (wr == 1) PG8_BAR;
        PG8_WAIT_V(4); PG8_BAR;
        PG8_STAGE(PG8_SB(1, 0), cB + kstep, voffB); PG8_STAGE(PG8_SA(1, 0), cA + kstep, voffA); PG8_STAGE(PG8_SB(1, 1), cB + hstepB + kstep, voffB);
        PG8_WAIT_V(6); PG8_BAR;
    }
    for (;;) {
        const bool has_next = S.next(ui + 1, nxt);
        const char* nA = has_next ? (const char*)g.A + (size_t)nxt.pm * tstepA + (size_t)nxt.pn * pnA : cA; const char* nB = has_next ? (const char*)g.Bt + (size_t)nxt.pn * tstepB : cB;
        for (int t = 0; t < nt; t += 2) {
            const bool last = (t == nt - 2);
            const char* a1 = cA + (size_t)(t + 1) * kstep;
            const char* a2 = last ? nA : cA + (size_t)(t + 2) * kstep; const char* b2 = last ? nB : cB + (size_t)(t + 2) * kstep;
            const char* a3 = a2 + kstep; const char* b3 = b2 + kstep;
            if (last && has_next) S.a_ready(nxt);
            if constexpr (SP2) {
            PG8_LDB(B0, 0, 0); PG8_LDB(B1, 0, 1); PG8_SCHED; PG8_LDA(At, 0, 0); PG8_STAGE(PG8_SA(1, 1), a1 + hstepA, voffA);
            PG8_WAIT_V(8); PG8_WAIT_L(0); PG8_BAR; PG8_MMA(0, 0, At, B0); PG8_MMA(0, 1, At, B1); PG8_BAR; PG8_SCHED;
            PG8_LDA(At, 0, 1); PG8_STAGE(PG8_SB(0, 0), b2, voffB); PG8_STAGE(PG8_SB(0, 1), b2 + hstepB, voffB); PG8_STAGE(PG8_SA(0, 0), a2, voffA);
            PG8_WAIT_V(8); PG8_WAIT_L(0); PG8_BAR; PG8_MMA(1, 0, At, B0); PG8_MMA(1, 1, At, B1); PG8_BAR; PG8_SCHED;
            PG8_LDB(B0, 1, 0); PG8_LDB(B1, 1, 1); PG8_SCHED; PG8_LDA(At, 1, 0); PG8_STAGE(PG8_SA(0, 1), a2 + hstepA, voffA);
            PG8_WAIT_V(8); PG8_WAIT_L(0); PG8_BAR; PG8_MMA(0, 0, At, B0); PG8_MMA(0, 1, At, B1); PG8_BAR; PG8_SCHED;
            PG8_LDA(At, 1, 1); PG8_STAGE(PG8_SB(1, 0), b3, voffB); PG8_STAGE(PG8_SB(1, 1), b3 + hstepB, voffB); PG8_STAGE(PG8_SA(1, 0), a3, voffA);
            PG8_WAIT_V(8); PG8_WAIT_L(0); PG8_BAR; PG8_MMA(1, 0, At, B0); PG8_MMA(1, 1, At, B1); PG8_BAR; PG8_SCHED;
            } else {
            PG8_LDB(B0, 0, 0); PG8_SCHED; PG8_LDA(At, 0, 0); PG8_STAGE(PG8_SA(1, 1), a1 + hstepA, voffA);
            PG8_WAIT_L(8); PG8_BAR; PG8_WAIT_L(0); PG8_MMA(0, 0, At, B0); PG8_BAR; PG8_SCHED;
            PG8_LDB(B1, 0, 1); PG8_STAGE(PG8_SB(0, 0), b2, voffB);
            PG8_BAR; PG8_WAIT_L(0); PG8_MMA(0, 1, At, B1); PG8_BAR;
            PG8_LDA(At, 0, 1); PG8_STAGE(PG8_SA(0, 0), a2, voffA);
            PG8_BAR; PG8_WAIT_L(0); PG8_MMA(1, 0, At, B0); PG8_BAR; PG8_SCHED;
            PG8_STAGE(PG8_SB(0, 1), b2 + hstepB, voffB);
            PG8_WAIT_V(6); PG8_BAR; PG8_MMA(1, 1, At, B1); PG8_BAR;
            PG8_LDB(B0, 1, 0); PG8_SCHED; PG8_LDA(At, 1, 0); PG8_STAGE(PG8_SA(0, 1), a2 + hstepA, voffA);
            PG8_WAIT_L(8); PG8_BAR; PG8_WAIT_L(0); PG8_MMA(0, 0, At, B0); PG8_BAR; PG8_SCHED;
            PG8_LDB(B1, 1, 1); PG8_STAGE(PG8_SB(1, 0), b3, voffB);
            PG8_BAR; PG8_WAIT_L(0); PG8_MMA(0, 1, At, B1); PG8_BAR;
            PG8_LDA(At, 1, 1); PG8_STAGE(PG8_SA(1, 0), a3, voffA);
            PG8_BAR; PG8_WAIT_L(0); PG8_MMA(1, 0, At, B0); PG8_BAR; PG8_SCHED;
            PG8_STAGE(PG8_SB(1, 1), b3 + hstepB, voffB);
            PG8_WAIT_V(6); PG8_BAR; PG8_MMA(1, 1, At, B1); PG8_BAR;
            }
        }
        if constexpr (ALIGN_EPI) { if (wr == 0) PG8_BAR; }
        E(acc, cur, wr, wc, fr, fq); S.done(cur);
        if (!has_next) break;
#pragma unroll
        for (int a = 0; a < 2; ++a)
#pragma unroll
            for (int b = 0; b < 2; ++b)
#pragma unroll
                for (int m = 0; m < 4; ++m)
#pragma unroll
                    for (int n = 0; n < 2; ++n) acc[a][b][m][n] = (f32x4){0.f, 0.f, 0.f, 0.f};
        cur = nxt; cA = nA; cB = nB; ++ui;
        if constexpr (ALIGN_EPI) { if (wr == 1) PG8_BAR; }
    }
    PG8_WAIT_V(0);
    if constexpr (!ALIGN_EPI) { if (wr == 0) PG8_BAR; }
    PG8_BAR;
#undef PG8_SA
#undef PG8_SB
#undef PG8_STAGE
#undef PG8_LDA
#undef PG8_LDB
#undef PG8_MMA
#undef PG8_WAIT_V
#undef PG8_WAIT_L
#undef PG8_BAR
#undef PG8_SCHED
}
}

constexpr int NWAVES = 8, NTHR = NWAVES * 64;
constexpr int D = 1024, NBATCH = 4, T = 8192, M = NBATCH * T;
constexpr int A_W = 512, A_IN = 1792, IN_COLS = 3344, NP = 3584;
constexpr int C_R = 0, C_K = 512, C_V = 1024, C_WD = 1536, C_AD = 1600, C_GD = 1664;
constexpr int C_BQ = 1792, C_BK = 2048, C_BV = 2304, C_GKD = 2816, C_BG = 2832;
constexpr int NQ = 2048;
constexpr float LN_EPS = 1e-5f, GN_EPS = 64e-5f, RMS_EPS = 1e-5f;
constexpr float ALPHA = 1.189207115002721f;

typedef unsigned short bf16;
typedef float f32x4 __attribute__((ext_vector_type(4)));
typedef float f32x2 __attribute__((ext_vector_type(2)));
typedef unsigned u32x4 __attribute__((ext_vector_type(4)));
typedef unsigned u32x2 __attribute__((ext_vector_type(2)));
#define LAS __attribute__((address_space(3)))

constexpr size_t MiB = 1u << 20;
constexpr size_t WS_WIN = 1 * MiB, WS_WOUT = 8 * MiB, WS_WQ = 10 * MiB, WS_KBD = 14 * MiB;
constexpr size_t WS_W2T = 15 * MiB, WS_A2T = WS_W2T + 65536, WS_G2T = WS_A2T + 65536;
constexpr size_t WS_H0 = 16 * MiB;
constexpr size_t WS_P = 80 * MiB;
constexpr size_t WS_WL = 304 * MiB, WS_AA = 336 * MiB, WS_GG = 368 * MiB;
constexpr size_t WS_GK = 400 * MiB;
constexpr size_t WS_Z = 80 * MiB;
constexpr size_t WS_H1 = 208 * MiB;
constexpr size_t WS_Q = 272 * MiB;
constexpr size_t WS_S = 80 * MiB;
constexpr size_t WS_IDS = 400 * MiB, WS_GATES = 416 * MiB;
constexpr size_t WS_UT = 432 * MiB, WS_VT = 448 * MiB;
constexpr int ROWB = 768;
constexpr size_t WS_SU = 464 * MiB, WS_SV = 465 * MiB;
constexpr size_t WS_UF = WS_UT; constexpr size_t UF_SLICE = (size_t)16384 * 128;
constexpr size_t WS_H8 = 272 * MiB;
constexpr size_t WS_PD = 80 * MiB;
constexpr size_t WS_V8 = WS_VT; constexpr size_t V8_SLICE = (size_t)16384 * 128;
constexpr size_t WS_CQ = 336 * MiB;
constexpr size_t WS_CS = 344 * MiB;
constexpr size_t WS_ZP = 80 * MiB;
constexpr int NSEG = 16, LSEG = 8192 / NSEG;
constexpr size_t WS_YI = WS_WL;
constexpr size_t WS_YIG = WS_GK;
constexpr size_t WS_SER = 480 * MiB;
constexpr size_t WS_SEG = 496 * MiB;
constexpr size_t WS_CEND = 504 * MiB;
constexpr size_t WS_END = 505 * MiB;

constexpr int LDS_BYTES = 163840, LDS_MISC = LDS_BYTES - 256;
constexpr size_t WS_CTL = 0, CTL_BYTES = 16384;

struct Params {
    const float* in[28];
    float* out; unsigned char* ws;
    int ph_lo, ph_hi;
};

__device__ __forceinline__ float bf2f(unsigned u) { return __uint_as_float(u << 16); }
typedef float f32x2c_t __attribute__((ext_vector_type(2))); typedef __bf16 bf16x2c_t __attribute__((ext_vector_type(2)));
__device__ __forceinline__ unsigned pk2(float lo, float hi) { const f32x2c_t v = {lo, hi}; const bf16x2c_t b = __builtin_convertvector(v, bf16x2c_t); return __builtin_bit_cast(unsigned, b); }
__device__ __forceinline__ unsigned f2bf(float f) { return pk2(f, 0.f) & 0xffffu; }
#define DPP_F(v, ctrl) __builtin_bit_cast(float, __builtin_amdgcn_update_dpp(0, __builtin_bit_cast(int, (v)), (ctrl), 0xf, 0xf, false))
#define DPP_ADD(v, ctrl) ((v) + DPP_F(v, ctrl))
__device__ __forceinline__ float rlf(float v, int l) { return __builtin_bit_cast(float, __builtin_amdgcn_readlane(__builtin_bit_cast(int, v), l)); }
__device__ __forceinline__ float wave_sum_u(float v) {
    v = DPP_ADD(v, 0xB1); v = DPP_ADD(v, 0x4E); v = DPP_ADD(v, 0x141); v = DPP_ADD(v, 0x140);
    return (rlf(v, 0) + rlf(v, 16)) + (rlf(v, 32) + rlf(v, 48));
}
__device__ __forceinline__ float wave_sum(float v) { return wave_sum_u(v); }
#define DPP_I(v, ctrl) __builtin_amdgcn_update_dpp(0, (v), (ctrl), 0xf, 0xf, false)
__device__ __forceinline__ int wave_sum_i(int v) {
    v += DPP_I(v, 0xB1); v += DPP_I(v, 0x4E); v += DPP_I(v, 0x141); v += DPP_I(v, 0x140);
    return (__builtin_amdgcn_readlane(v, 0) + __builtin_amdgcn_readlane(v, 16)) + (__builtin_amdgcn_readlane(v, 32) + __builtin_amdgcn_readlane(v, 48));
}
__device__ __forceinline__ float wave_max_u(float v) {
    v = fmaxf(v, DPP_F(v, 0xB1)); v = fmaxf(v, DPP_F(v, 0x4E)); v = fmaxf(v, DPP_F(v, 0x141)); v = fmaxf(v, DPP_F(v, 0x140));
    return fmaxf(fmaxf(rlf(v, 0), rlf(v, 16)), fmaxf(rlf(v, 32), rlf(v, 48)));
}
__device__ __forceinline__ unsigned pack_i8(float a, float b, float c, float d, float inv, int off) {
    const int q0 = __float2int_rn(a * inv) + off, q1 = __float2int_rn(b * inv) + off, q2 = __float2int_rn(c * inv) + off, q3 = __float2int_rn(d * inv) + off;
    return (unsigned)(q0 & 0xff) | ((unsigned)(q1 & 0xff) << 8) | ((unsigned)(q2 & 0xff) << 16) | ((unsigned)(q3 & 0xff) << 24);
}
__device__ __forceinline__ float sigmoidf_(float x) { return 1.f / (1.f + __expf(-x)); }
__device__ __forceinline__ float siluf_(float x) { return x * sigmoidf_(x); }

__device__ __forceinline__ void transpose_convert(const float* W, int K, int N, int Npad, bf16* WT, int gtid, int gthreads) {
    const int kc = K / 8, total = Npad * kc;
    for (int idx = gtid; idx < total; idx += gthreads) {
        const int n = idx % Npad, c = idx / Npad; float v[8];
#pragma unroll
        for (int j = 0; j < 8; ++j) v[j] = (n < N) ? W[(size_t)(8 * c + j) * N + n] : 0.f;
        u32x4 o; o.x = pk2(v[0], v[1]); o.y = pk2(v[2], v[3]); o.z = pk2(v[4], v[5]); o.w = pk2(v[6], v[7]);
        *(u32x4*)(WT + (size_t)n * K + 8 * c) = o;
    }
}
__device__ __forceinline__ void ln_row_bf16(const float* xrow, const float* g, const float* b, bf16* orow, int lane) {
    const f32x4* xr = (const f32x4*)xrow + lane; f32x4 v[4]; float s = 0.f;
#pragma unroll
    for (int j = 0; j < 4; ++j) { v[j] = xr[64 * j]; s += (v[j][0] + v[j][1]) + (v[j][2] + v[j][3]); }
    const float mean = wave_sum(s) * (1.f / D); float s2 = 0.f;
#pragma unroll
    for (int j = 0; j < 4; ++j) { v[j] = v[j] - mean; s2 += (v[j][0] * v[j][0] + v[j][1] * v[j][1]) + (v[j][2] * v[j][2] + v[j][3] * v[j][3]); }
    const float rstd = 1.f / sqrtf(wave_sum(s2) * (1.f / D) + LN_EPS);
    u32x2* o8 = (u32x2*)orow + lane;
#pragma unroll
    for (int j = 0; j < 4; ++j) { const f32x4 gg = ((const f32x4*)g)[lane + 64 * j], bb = ((const f32x4*)b)[lane + 64 * j]; const f32x4 y = v[j] * rstd * gg + bb;
        u32x2 w; w.x = pk2(y[0], y[1]); w.y = pk2(y[2], y[3]); o8[64 * j] = w; }
}
template <bool F8>
__device__ __forceinline__ void ln_rowb_bf16(const bf16* xrow, const float* g, const float* b, bf16* orow, int lane, unsigned char* f8row = nullptr) {
    const u32x4* xr = (const u32x4*)xrow + 2 * lane; const u32x4 a = xr[0], c = xr[1]; float v[16]; float s = 0.f;
#pragma unroll
    for (int i = 0; i < 4; ++i) { v[2 * i] = __uint_as_float(a[i] << 16); v[2 * i + 1] = __uint_as_float(a[i] & 0xffff0000u); v[8 + 2 * i] = __uint_as_float(c[i] << 16); v[8 + 2 * i + 1] = __uint_as_float(c[i] & 0xffff0000u); }
#pragma unroll
    for (int i = 0; i < 16; ++i) s += v[i];
    const float mean = wave_sum(s) * (1.f / D); float s2 = 0.f;
#pragma unroll
    for (int i = 0; i < 16; ++i) { v[i] -= mean; s2 += v[i] * v[i]; }
    const float rstd = 1.f / sqrtf(wave_sum(s2) * (1.f / D) + LN_EPS);
    u32x4 o0, o1;
#pragma unroll
    for (int q = 0; q < 4; ++q) { const f32x4 gg = *(const f32x4*)(g + 16 * lane + 4 * q), bb = *(const f32x4*)(b + 16 * lane + 4 * q);
#pragma unroll
        for (int j = 0; j < 4; ++j) v[4 * q + j] = v[4 * q + j] * rstd * gg[j] + bb[j];
        const unsigned lo = pk2(v[4 * q], v[4 * q + 1]), hi = pk2(v[4 * q + 2], v[4 * q + 3]);
        if (q < 2) { o0[2 * q] = lo; o0[2 * q + 1] = hi; } else { o1[2 * q - 4] = lo; o1[2 * q - 3] = hi; } }
    u32x4* op = (u32x4*)orow + 2 * lane; op[0] = o0; op[1] = o1;
    if (F8) {
        u32x4 h8, l8;
#pragma unroll
        for (int q = 0; q < 4; ++q) {
            int ph = __builtin_amdgcn_cvt_pk_fp8_f32(v[4 * q], v[4 * q + 1], 0, false); ph = __builtin_amdgcn_cvt_pk_fp8_f32(v[4 * q + 2], v[4 * q + 3], ph, true);
            const float r0 = v[4 * q] - __builtin_amdgcn_cvt_f32_fp8(ph, 0), r1 = v[4 * q + 1] - __builtin_amdgcn_cvt_f32_fp8(ph, 1);
            const float r2 = v[4 * q + 2] - __builtin_amdgcn_cvt_f32_fp8(ph, 2), r3 = v[4 * q + 3] - __builtin_amdgcn_cvt_f32_fp8(ph, 3);
            int pl = __builtin_amdgcn_cvt_pk_fp8_f32(r0, r1, 0, false); pl = __builtin_amdgcn_cvt_pk_fp8_f32(r2, r3, pl, true);
            h8[q] = (unsigned)ph; l8[q] = (unsigned)pl; }
        *((u32x4*)f8row + lane) = h8; *((u32x4*)(f8row + 1024) + lane) = l8;
    }
}
__device__ __forceinline__ void fold_keys(const Params& P, LAS unsigned char* lds, int bi, int nb) {
    const int tid = threadIdx.x; unsigned char* ws = P.ws;
    {
        const float* Wq = P.in[22]; const float* keys = P.in[23]; bf16* WqkT = (bf16*)(ws + WS_WQ);
        LAS float* WQs = (LAS float*)lds; LAS float* KYs = WQs + 64 * 132;
        for (int item = bi; item < 256; item += nb) {
            const int hh = item >> 4, kt = item & 15;
            __syncthreads();
            for (int i = tid; i < 64 * 32; i += NTHR) { const int r = i >> 5, c4 = (i & 31) * 4; *(LAS f32x4*)(WQs + r * 132 + c4) = *(const f32x4*)(Wq + (size_t)(kt * 64 + r) * NQ + hh * 128 + c4); }
            for (int i = tid; i < 128 * 32; i += NTHR) { const int r = i >> 5, c4 = (i & 31) * 4; *(LAS f32x4*)(KYs + r * 132 + c4) = *(const f32x4*)(keys + (size_t)(hh * 128 + r) * 128 + c4); }
            __syncthreads();
            const int key = tid & 127, kg = tid >> 7; float acc[16];
#pragma unroll
            for (int j = 0; j < 16; ++j) acc[j] = 0.f;
            for (int c4 = 0; c4 < 32; ++c4) { const f32x4 kv = *(const LAS f32x4*)(KYs + key * 132 + 4 * c4);
#pragma unroll
                for (int j = 0; j < 16; ++j) { const f32x4 w = *(const LAS f32x4*)(WQs + (kg * 16 + j) * 132 + 4 * c4); acc[j] += (w[0] * kv[0] + w[1] * kv[1]) + (w[2] * kv[2] + w[3] * kv[3]); } }
            u32x4 o0, o1;
#pragma unroll
            for (int q = 0; q < 4; ++q) { o0[q] = pk2(acc[2 * q], acc[2 * q + 1]); o1[q] = pk2(acc[8 + 2 * q], acc[8 + 2 * q + 1]); }
            u32x4* dst = (u32x4*)(WqkT + (size_t)(hh * 128 + key) * D + kt * 64 + kg * 16); dst[0] = o0; dst[1] = o1;
        }
    }
}
__device__ __forceinline__ void phase_prologue(const Params& P, LAS unsigned char* lds) {
    const int tid = threadIdx.x, lane = tid & 63, wave = tid >> 6;
    const int gtid = blockIdx.x * NTHR + tid, gthreads = gridDim.x * NTHR;
    unsigned char* ws = P.ws;
    transpose_convert(P.in[3], D, IN_COLS, NP, (bf16*)(ws + WS_WIN), gtid, gthreads);
    transpose_convert(P.in[6], 64, A_W, A_W, (bf16*)(ws + WS_W2T), gtid, gthreads);
    transpose_convert(P.in[8], 64, A_W, A_W, (bf16*)(ws + WS_A2T), gtid, gthreads);
    transpose_convert(P.in[9], 128, A_W, A_W, (bf16*)(ws + WS_G2T), gtid, gthreads);
    const int gw = blockIdx.x * NWAVES + wave, ngw = gridDim.x * NWAVES;
    for (int m = gw; m < M; m += ngw) ln_row_bf16(P.in[0] + (size_t)m * D, P.in[1], P.in[2], (bf16*)(ws + WS_H0) + (size_t)m * D, lane);
}

typedef short bf16x8_t __attribute__((ext_vector_type(8)));
template <int KS, int LDA>
__device__ __forceinline__ void lora_mm(f32x4 (&acc)[4][4], const LAS bf16* ACT, const bf16* WT, int c0, int fr, int fq) {
#pragma unroll
    for (int mt = 0; mt < 4; ++mt)
#pragma unroll
        for (int nt = 0; nt < 4; ++nt) acc[mt][nt] = (f32x4){0.f, 0.f, 0.f, 0.f};
#pragma unroll
    for (int s = 0; s < KS; ++s) {
        bf16x8_t af[4], bfr[4];
#pragma unroll
        for (int mt = 0; mt < 4; ++mt) af[mt] = *(const LAS bf16x8_t*)(ACT + (mt * 16 + fr) * LDA + 32 * s + 8 * fq);
#pragma unroll
        for (int nt = 0; nt < 4; ++nt) bfr[nt] = *(const bf16x8_t*)(WT + (size_t)(c0 + nt * 16 + fr) * (32 * KS) + 32 * s + 8 * fq);
#pragma unroll
        for (int mt = 0; mt < 4; ++mt)
#pragma unroll
            for (int nt = 0; nt < 4; ++nt) acc[mt][nt] = __builtin_amdgcn_mfma_f32_16x16x32_bf16(bfr[nt], af[mt], acc[mt][nt], 0, 0, 0);
    }
}
__device__ __forceinline__ void phase_prep(const Params& P, LAS unsigned char* lds) {
    const int tid = threadIdx.x, lane = tid & 63, wave = __builtin_amdgcn_readfirstlane(tid >> 6), fr = lane & 15, fq = lane >> 4;
    unsigned char* ws = P.ws;
    const bf16* p = (const bf16*)(ws + WS_P);
    const float* mu = P.in[4]; const float* w0 = P.in[5]; const float* a0 = P.in[7];
    const float* gkw2 = P.in[16]; const float* gkb = P.in[17];
    const bf16* W2T = (const bf16*)(ws + WS_W2T); const bf16* A2T = (const bf16*)(ws + WS_A2T); const bf16* G2T = (const bf16*)(ws + WS_G2T);
    bf16* WL = (bf16*)(ws + WS_WL); bf16* AA = (bf16*)(ws + WS_AA); bf16* GG = (bf16*)(ws + WS_GG); bf16* GK = (bf16*)(ws + WS_GK);
    LAS bf16* TW = (LAS bf16*)lds; LAS bf16* AD = TW + 64 * 72; LAS bf16* SG = AD + 64 * 72;
    LAS float* gkd = (LAS float*)(SG + 64 * 136);
    const int c0 = wave * 64;
    for (int tile = blockIdx.x; tile < M / 64; tile += gridDim.x) {
        const int m0 = tile * 64;
        __syncthreads();
        for (int idx = tid; idx < 64 * 32; idx += NTHR) {
            const int j = (idx & 31) * 8, tok = idx >> 5, m = m0 + tok, t = m & (T - 1);
            const u32x4 cw = *(const u32x4*)(p + (size_t)m * NP + C_WD + j); const u32x4 pw = (t > 0) ? *(const u32x4*)(p + (size_t)(m - 1) * NP + C_WD + j) : (u32x4){0u, 0u, 0u, 0u};
            const f32x4 m0v = *(const f32x4*)(mu + C_WD + j), m1v = *(const f32x4*)(mu + C_WD + j + 4);
            float x[8];
#pragma unroll
            for (int i = 0; i < 4; ++i) { const float c0 = __uint_as_float(cw[i] << 16), c1 = __uint_as_float(cw[i] & 0xffff0000u), q0 = __uint_as_float(pw[i] << 16), q1 = __uint_as_float(pw[i] & 0xffff0000u);
                const float mu0 = i < 2 ? m0v[2 * i] : m1v[2 * i - 4], mu1 = i < 2 ? m0v[2 * i + 1] : m1v[2 * i - 3];
                x[2 * i] = c0 + (q0 - c0) * mu0; x[2 * i + 1] = c1 + (q1 - c1) * mu1; }
            u32x4 o;
            if (j < 64) {
#pragma unroll
                for (int i = 0; i < 4; ++i) o[i] = pk2(1.f - 2.f * __builtin_amdgcn_rcpf(1.f + __expf(2.f * x[2 * i])), 1.f - 2.f * __builtin_amdgcn_rcpf(1.f + __expf(2.f * x[2 * i + 1])));
                *(LAS u32x4*)(TW + tok * 72 + j) = o;
            } else if (j < 128) {
#pragma unroll
                for (int i = 0; i < 4; ++i) o[i] = pk2(x[2 * i], x[2 * i + 1]);
                *(LAS u32x4*)(AD + tok * 72 + j - 64) = o;
            } else {
#pragma unroll
                for (int i = 0; i < 4; ++i) o[i] = pk2(sigmoidf_(x[2 * i]), sigmoidf_(x[2 * i + 1]));
                *(LAS u32x4*)(SG + tok * 136 + j - 128) = o;
            }
        }
        for (int idx = tid; idx < 64 * 16; idx += NTHR) { const int j = idx & 15, tok = idx >> 4; gkd[tok * 16 + j] = bf2f(p[(size_t)(m0 + tok) * NP + C_GKD + j]); }
        __syncthreads();
        f32x4 acc[4][4];
        lora_mm<2, 72>(acc, TW, W2T, c0, fr, fq);
#pragma unroll
        for (int nt = 0; nt < 4; ++nt) { const int c = c0 + nt * 16 + 4 * fq; const f32x4 b = *(const f32x4*)(w0 + c);
#pragma unroll
            for (int mt = 0; mt < 4; ++mt) { float o[4];
#pragma unroll
                for (int i = 0; i < 4; ++i) { const float z = b[i] + acc[mt][nt][i]; o[i] = -0.6065306597126334f * sigmoidf_(z); }
                u32x2 w; w.x = pk2(o[0], o[1]); w.y = pk2(o[2], o[3]); *(u32x2*)(WL + (size_t)(m0 + mt * 16 + fr) * A_W + c) = w; } }
        lora_mm<2, 72>(acc, AD, A2T, c0, fr, fq);
#pragma unroll
        for (int nt = 0; nt < 4; ++nt) { const int c = c0 + nt * 16 + 4 * fq; const f32x4 b = *(const f32x4*)(a0 + c);
#pragma unroll
            for (int mt = 0; mt < 4; ++mt) { float o[4];
#pragma unroll
                for (int i = 0; i < 4; ++i) o[i] = sigmoidf_(b[i] + acc[mt][nt][i]);
                u32x2 w; w.x = pk2(o[0], o[1]); w.y = pk2(o[2], o[3]); *(u32x2*)(AA + (size_t)(m0 + mt * 16 + fr) * A_W + c) = w; } }
        lora_mm<4, 136>(acc, SG, G2T, c0, fr, fq);
#pragma unroll
        for (int nt = 0; nt < 4; ++nt) { const int c = c0 + nt * 16 + 4 * fq;
#pragma unroll
            for (int mt = 0; mt < 4; ++mt) { u32x2 w; w.x = pk2(acc[mt][nt][0], acc[mt][nt][1]); w.y = pk2(acc[mt][nt][2], acc[mt][nt][3]); *(u32x2*)(GG + (size_t)(m0 + mt * 16 + fr) * A_W + c) = w; } }
        { const int cc = tid & 255, th = tid >> 8; float wv[16];
#pragma unroll
          for (int j = 0; j < 16; ++j) wv[j] = gkw2[j * 256 + cc];
          const float bb = gkb[cc];
          for (int i = 0; i < 32; ++i) { const int tok = th * 32 + i; float sacc = bb;
#pragma unroll
              for (int j = 0; j < 16; ++j) sacc += gkd[tok * 16 + j] * wv[j];
              GK[(size_t)(m0 + tok) * 256 + cc] = (bf16)f2bf(-(fmaxf(-sacc, 0.f) + __logf(1.f + __expf(-fabsf(sacc)))) * (1.f / 16.f)); } }
    }
}

constexpr int CH = 32;
__device__ __forceinline__ float red8(float v) { v = DPP_ADD(v, 0xB1); v = DPP_ADD(v, 0x4E); v = DPP_ADD(v, 0x141); return v; }

constexpr int RW_BUF = 6 * CH * 64;
__device__ __forceinline__ void rw_load(const bf16* p, const bf16* AA, const bf16* WL, int b, int t0, int col, int wave,
        unsigned (&rc)[4], unsigned (&kc)[4], unsigned (&vc)[4], unsigned (&rp)[4], unsigned (&kp)[4], unsigned (&vp)[4], unsigned (&a)[4], unsigned (&wl)[4]) {
#pragma unroll
    for (int q = 0; q < 4; ++q) {
        const int t = t0 + wave + 8 * q; const size_t m = (size_t)b * T + t; const bf16* pr = p + m * NP; const bf16* pp = (t > 0) ? pr - NP : pr;
        rc[q] = pr[C_R + col]; kc[q] = pr[C_K + col]; vc[q] = pr[C_V + col]; rp[q] = pp[C_R + col]; kp[q] = pp[C_K + col]; vp[q] = pp[C_V + col];
        a[q] = AA[m * A_W + col]; wl[q] = WL[m * A_W + col];
    }
}
__device__ __forceinline__ void rw_prep(LAS float* B, int t0, int wave, int lane, float mu_r, float mu_k, float mu_v, float kkc, float kac,
        const unsigned (&rc_)[4], const unsigned (&kc_)[4], const unsigned (&vc_)[4], const unsigned (&rp_)[4], const unsigned (&kp_)[4], const unsigned (&vp_)[4], const unsigned (&a_)[4], const unsigned (&wl_)[4]) {
    LAS float* R = B; LAS float* DEC = R + CH * 64; LAS float* KH = DEC + CH * 64; LAS float* KK = KH + CH * 64; LAS float* BB = KK + CH * 64; LAS float* V = BB + CH * 64;
#pragma unroll
    for (int q = 0; q < 4; ++q) {
        const int tt = wave + 8 * q; const float hp = (t0 + tt > 0) ? 1.f : 0.f;
        const float rc = bf2f(rc_[q]), kc = bf2f(kc_[q]), vc = bf2f(vc_[q]), rp = bf2f(rp_[q]) * hp, kp = bf2f(kp_[q]) * hp, vp = bf2f(vp_[q]) * hp;
        const float r = rc + (rp - rc) * mu_r, k = kc + (kp - kc) * mu_k, v = vc + (vp - vc) * mu_v;
        const float a = bf2f(a_[q]), wl = bf2f(wl_[q]);
        const float kr = k * kkc; const float nrm = sqrtf(wave_sum(kr * kr)); const float kk = kr / fmaxf(nrm, 1e-12f);
        const float kh = k * (1.f + (a - 1.f) * kac);
        R[tt * 64 + lane] = r; DEC[tt * 64 + lane] = __expf(wl); KH[tt * 64 + lane] = kh; KK[tt * 64 + lane] = kk; BB[tt * 64 + lane] = kk * a; V[tt * 64 + lane] = v;
    }
}
struct RwOps { f32x4 k0, k1, d0, d1, b0, b1, h0, h1, q0, q1; float v0, v1; };
__device__ __forceinline__ void rw_ops_load(RwOps& o, const LAS float* B, int tt, int s8, int vr0) {
    const LAS float* R = B; const LAS float* DEC = R + CH * 64; const LAS float* KH = DEC + CH * 64; const LAS float* KK = KH + CH * 64; const LAS float* BB = KK + CH * 64; const LAS float* V = BB + CH * 64;
    o.k0 = *(const LAS f32x4*)(KK + tt * 64 + s8); o.k1 = *(const LAS f32x4*)(KK + tt * 64 + s8 + 4);
    o.d0 = *(const LAS f32x4*)(DEC + tt * 64 + s8); o.d1 = *(const LAS f32x4*)(DEC + tt * 64 + s8 + 4);
    o.b0 = *(const LAS f32x4*)(BB + tt * 64 + s8); o.b1 = *(const LAS f32x4*)(BB + tt * 64 + s8 + 4);
    o.h0 = *(const LAS f32x4*)(KH + tt * 64 + s8); o.h1 = *(const LAS f32x4*)(KH + tt * 64 + s8 + 4);
    o.q0 = *(const LAS f32x4*)(R + tt * 64 + s8); o.q1 = *(const LAS f32x4*)(R + tt * 64 + s8 + 4);
    o.v0 = V[tt * 64 + vr0]; o.v1 = V[tt * 64 + vr0 + 1];
}
template <bool IDENT> __device__ __forceinline__ void rw_step(const RwOps& o, f32x2 (&S0)[4], f32x2 (&S1)[4], LAS float* Y, int tt, int r0, int lane) {
    const float vv0 = o.v0, vv1 = o.v1;
    const f32x2 kk[4] = {o.k0.lo, o.k0.hi, o.k1.lo, o.k1.hi}, dd[4] = {o.d0.lo, o.d0.hi, o.d1.lo, o.d1.hi}, bb[4] = {o.b0.lo, o.b0.hi, o.b1.lo, o.b1.hi}, hh[4] = {o.h0.lo, o.h0.hi, o.h1.lo, o.h1.hi}, rr[4] = {o.q0.lo, o.q0.hi, o.q1.lo, o.q1.hi};
    f32x2 a0 = S0[0] * kk[0], a1 = S1[0] * kk[0];
#pragma unroll
    for (int i = 1; i < 4; ++i) { a0 = S0[i] * kk[i] + a0; a1 = S1[i] * kk[i] + a1; }
    const float sa0 = -red8(a0.x + a0.y), sa1 = -red8(a1.x + a1.y);
    f32x2 y0 = (f32x2){0.f, 0.f}, y1 = (f32x2){0.f, 0.f};
#pragma unroll
    for (int i = 0; i < 4; ++i) {
        if (IDENT) { S0[i] = bb[i] * sa0 + S0[i] * dd[i]; S1[i] = bb[i] * sa1 + S1[i] * dd[i]; }
        else { S0[i] = hh[i] * vv0 + (bb[i] * sa0 + S0[i] * dd[i]); S1[i] = hh[i] * vv1 + (bb[i] * sa1 + S1[i] * dd[i]); }
        y0 = S0[i] * rr[i] + y0; y1 = S1[i] * rr[i] + y1;
    }
    const float yy0 = red8(y0.x + y0.y), yy1 = red8(y1.x + y1.y);
    if ((lane & 7) == 0) { Y[tt * 128 + r0] = yy0; Y[tt * 128 + r0 + 1] = yy1; }
}
__device__ __forceinline__ void rwkv_item(const Params& P, LAS unsigned char* lds, int b, int h, int seg) {
    const int tid = threadIdx.x, lane = tid & 63, wave = tid >> 6;
    unsigned char* ws = P.ws;
    const bf16* p = (const bf16*)(ws + WS_P); const bf16* WL = (const bf16*)(ws + WS_WL); const bf16* AA = (const bf16*)(ws + WS_AA);
    bf16* MIX = (bf16*)P.out; bf16* YI = (bf16*)(ws + WS_YI);
    const float* mu = P.in[4]; const float* k_k = P.in[10]; const float* k_a = P.in[11];
    LAS float* BUF = (LAS float*)lds; LAS float* Y = BUF + 2 * RW_BUF;
    const int col = h * 64 + lane;
    const float mu_r = mu[C_R + col], mu_k = mu[C_K + col], mu_v = mu[C_V + col], kkc = k_k[col], kac = k_a[col];
    const int r0 = wave * 16 + 2 * (lane >> 3), s8 = (lane & 7) * 8; const int ident = r0 >> 6, vr0 = r0 & 63, vr1 = vr0 + 1;
    float* SE = (float*)(ws + WS_SER) + ((((size_t)(b * 8 + h) * NSEG + seg) * 2 + ident) * 4096) + vr0 * 64 + s8;
    f32x2 S0[4], S1[4];
#pragma unroll
    for (int i = 0; i < 4; ++i) { S0[i] = (f32x2){(ident && (s8 + 2 * i == vr0)) ? 1.f : 0.f, (ident && (s8 + 2 * i + 1 == vr0)) ? 1.f : 0.f};
        S1[i] = (f32x2){(ident && (s8 + 2 * i == vr1)) ? 1.f : 0.f, (ident && (s8 + 2 * i + 1 == vr1)) ? 1.f : 0.f}; }
    const int tbeg = seg * LSEG;
    unsigned rc[4], kc[4], vc[4], rp[4], kp[4], vp[4], a[4], wl[4];
    __syncthreads();
    rw_load(p, AA, WL, b, tbeg, col, wave, rc, kc, vc, rp, kp, vp, a, wl);
    rw_prep(BUF, tbeg, wave, lane, mu_r, mu_k, mu_v, kkc, kac, rc, kc, vc, rp, kp, vp, a, wl);
    __syncthreads();
    for (int ci = 0; ci < LSEG / CH; ++ci) {
        const int t0 = tbeg + ci * CH; LAS float* B = BUF + (ci & 1) * RW_BUF;
        LAS float* R = B; LAS float* DEC = R + CH * 64; LAS float* KH = DEC + CH * 64; LAS float* KK = KH + CH * 64; LAS float* BB = KK + CH * 64; LAS float* V = BB + CH * 64;
        const bool more = (ci + 1 < LSEG / CH);
        if (more) rw_load(p, AA, WL, b, t0 + CH, col, wave, rc, kc, vc, rp, kp, vp, a, wl);
        { RwOps oa, ob; rw_ops_load(oa, B, 0, s8, vr0);
          if (ident) for (int tt = 0; tt < CH; tt += 2) {
              rw_ops_load(ob, B, tt + 1, s8, vr0); rw_step<true>(oa, S0, S1, Y, tt, r0, lane);
              rw_ops_load(oa, B, (tt + 2) & (CH - 1), s8, vr0); rw_step<true>(ob, S0, S1, Y, tt + 1, r0, lane);
          } else for (int tt = 0; tt < CH; tt += 2) {
              rw_ops_load(ob, B, tt + 1, s8, vr0); rw_step<false>(oa, S0, S1, Y, tt, r0, lane);
              rw_ops_load(oa, B, (tt + 2) & (CH - 1), s8, vr0); rw_step<false>(ob, S0, S1, Y, tt + 1, r0, lane);
          } }
        __syncthreads();
        if (more) rw_prep(BUF + ((ci + 1) & 1) * RW_BUF, t0 + CH, wave, lane, mu_r, mu_k, mu_v, kkc, kac, rc, kc, vc, rp, kp, vp, a, wl);
#pragma unroll
        for (int q = 0; q < 4; ++q) {
            const int tt = wave + 8 * q; const size_t m = (size_t)b * T + t0 + tt;
            MIX[m * D + col] = (bf16)f2bf(Y[tt * 128 + lane]); YI[m * 512 + col] = (bf16)f2bf(Y[tt * 128 + 64 + lane]);
        }
        __syncthreads();
    }
    *(f32x4*)(SE) = (f32x4){S0[0].x, S0[0].y, S0[1].x, S0[1].y}; *(f32x4*)(SE + 4) = (f32x4){S0[2].x, S0[2].y, S0[3].x, S0[3].y};
    *(f32x4*)(SE + 64) = (f32x4){S1[0].x, S1[0].y, S1[1].x, S1[1].y}; *(f32x4*)(SE + 68) = (f32x4){S1[2].x, S1[2].y, S1[3].x, S1[3].y};
}

constexpr int W_AT = 0, W_BT = 4608, W_KT = 9216, W_LAK = 13824, W_L1 = 0, W_LT1 = 4608, W_X1 = 9216, W_RT = 18432, W_BTT = 23040, W_KTT = 27648, W_VTT = 32256, W_X0 = 36864,
              W_L0 = 46080, W_LT0 = 50688, W_QT = 46080, W_TT = 50688, W_LRB = 55296, W_LRK = 59904, W_SIM = 64512, W_PIM = 69120, W_END = 73728;
__device__ __forceinline__ bf16x8_t lfrag(const LAS bf16* base, int row, int sx, int fq) { return *(const LAS bf16x8_t*)(base + row * 72 + 32 * sx + 8 * fq); }
#define MFMA16(a, b, c) __builtin_amdgcn_mfma_f32_16x16x32_bf16((a), (b), (c), 0, 0, 0)
__device__ __forceinline__ void st4(LAS bf16* dst, float a, float b, float c, float d) { u32x2 w; w.x = pk2(a, b); w.y = pk2(c, d); *(LAS u32x2*)dst = w; }
__device__ __forceinline__ f32x4 ld4(const LAS bf16* src) { const u32x2 w = *(const LAS u32x2*)src; return (f32x4){__uint_as_float(w.x << 16), __uint_as_float(w.x & 0xffff0000u), __uint_as_float(w.y << 16), __uint_as_float(w.y & 0xffff0000u)}; }
__device__ __forceinline__ void rwkv_item_chunked(const Params& P, LAS unsigned char* lds, int b, int h, int seg) {
    const int tid = threadIdx.x, lane = tid & 63, wave = __builtin_amdgcn_readfirstlane(tid >> 6), fr = lane & 15, fq = lane >> 4;
    unsigned char* ws = P.ws;
    const bf16* p = (const bf16*)(ws + WS_P); const bf16* WL = (const bf16*)(ws + WS_WL); const bf16* AA = (const bf16*)(ws + WS_AA);
    bf16* MIX = (bf16*)P.out; bf16* YI = (bf16*)(ws + WS_YI);
    const float* mu = P.in[4]; const float* k_k = P.in[10]; const float* k_a = P.in[11];
    LAS bf16* L = (LAS bf16*)lds;
    LAS float* GAM = (LAS float*)(lds + W_END * 2); LAS float* TOT = GAM + 64;
    const int col = h * 64 + lane, tg = wave;
    const float mu_r = mu[C_R + col], mu_k = mu[C_K + col], mu_v = mu[C_V + col], kkc = k_k[col], kac = k_a[col];
    const bool ident = wave >= 4; const int w4 = wave & 3;
    f32x4 Wreg[4];
#pragma unroll
    for (int k = 0; k < 4; ++k) Wreg[k] = (f32x4){0.f, 0.f, 0.f, 0.f};
    __syncthreads();
    for (int i = tid; i < 2 * 64 * 72 / 2; i += NTHR) ((LAS unsigned*)(L + W_SIM))[i] = 0u;
    __syncthreads();
    if (tid < 64) L[W_PIM + tid * 72 + tid] = (bf16)0x3F80;
    unsigned nr_[9], nk_[9], nv_[9], na_[8], nw_[8];
    { const int t0 = seg * LSEG;
#pragma unroll
      for (int r = 0; r < 9; ++r) { const int t = t0 + 8 * tg - 1 + r; const bf16* pr = p + ((size_t)b * T + (t > 0 ? t : 0)) * NP; nr_[r] = pr[C_R + col]; nk_[r] = pr[C_K + col]; nv_[r] = pr[C_V + col]; }
#pragma unroll
      for (int i = 0; i < 8; ++i) { const size_t m = (size_t)b * T + t0 + 8 * tg + i; na_[i] = AA[m * A_W + col]; nw_[i] = WL[m * A_W + col]; } }
    for (int c = 0; c < LSEG / 64; ++c) {
        const int t0 = seg * LSEG + c * 64;
        __syncthreads();
        float rv[8], kkv[8], bv[8], khv[8], vv[8], g[8], wl[8];
        unsigned xr[9], xk[9], xv[9], xa[8], xw[8];
#pragma unroll
        for (int r = 0; r < 9; ++r) { xr[r] = nr_[r]; xk[r] = nk_[r]; xv[r] = nv_[r]; }
#pragma unroll
        for (int i = 0; i < 8; ++i) { xa[i] = na_[i]; xw[i] = nw_[i]; }
        if (c + 1 < LSEG / 64) {
#pragma unroll
            for (int r = 0; r < 9; ++r) { const int t = t0 + 64 + 8 * tg - 1 + r; const bf16* pr = p + ((size_t)b * T + t) * NP; nr_[r] = pr[C_R + col]; nk_[r] = pr[C_K + col]; nv_[r] = pr[C_V + col]; }
#pragma unroll
            for (int i = 0; i < 8; ++i) { const size_t m = (size_t)b * T + t0 + 64 + 8 * tg + i; na_[i] = AA[m * A_W + col]; nw_[i] = WL[m * A_W + col]; }
        }
#pragma unroll
        for (int i = 0; i < 8; ++i) { const int t = t0 + 8 * tg + i; const float hp = (t > 0) ? 1.f : 0.f;
            const float rc = bf2f(xr[i + 1]), kc = bf2f(xk[i + 1]), vc = bf2f(xv[i + 1]);
            const float r = rc + (bf2f(xr[i]) * hp - rc) * mu_r, k = kc + (bf2f(xk[i]) * hp - kc) * mu_k; vv[i] = vc + (bf2f(xv[i]) * hp - vc) * mu_v;
            const float a = bf2f(xa[i]); wl[i] = bf2f(xw[i]);
            const float kr = k * kkc; const float nrm = sqrtf(wave_sum(kr * kr)); const float kk = kr / fmaxf(nrm, 1e-12f);
            rv[i] = r; kkv[i] = kk; bv[i] = kk * a; khv[i] = k * (1.f + (a - 1.f) * kac); }
        g[0] = wl[0];
#pragma unroll
        for (int i = 1; i < 8; ++i) g[i] = g[i - 1] + wl[i];
        TOT[tg * 64 + lane] = g[7];
        __syncthreads();
        float off = 0.f, total = 0.f;
#pragma unroll
        for (int w = 0; w < 8; ++w) { const float tv = TOT[w * 64 + lane]; total += tv; off += (w < tg) ? tv : 0.f; }
        { float at[8], bt[8], kt[8];
#pragma unroll
          for (int i = 0; i < 8; ++i) { const float G = off + g[i]; const float eG = __expf(G), eGm = __expf(G - wl[i]), ei = __expf(-G);
              at[i] = -kkv[i] * eGm; bt[i] = bv[i] * ei; kt[i] = khv[i] * ei; const float rt = rv[i] * eG; const int row = 8 * tg + i;
              L[W_AT + row * 72 + lane] = (bf16)f2bf(at[i]); L[W_BT + row * 72 + lane] = (bf16)f2bf(bt[i]); L[W_KT + row * 72 + lane] = (bf16)f2bf(kt[i]); L[W_RT + row * 72 + lane] = (bf16)f2bf(rt); }
          u32x4 w;
          w.x = pk2(at[0], at[1]); w.y = pk2(at[2], at[3]); w.z = pk2(at[4], at[5]); w.w = pk2(at[6], at[7]); *(LAS u32x4*)(L + W_X0 + lane * 72 + 8 * tg) = w;
          w.x = pk2(bt[0], bt[1]); w.y = pk2(bt[2], bt[3]); w.z = pk2(bt[4], bt[5]); w.w = pk2(bt[6], bt[7]); *(LAS u32x4*)(L + W_BTT + lane * 72 + 8 * tg) = w;
          w.x = pk2(kt[0], kt[1]); w.y = pk2(kt[2], kt[3]); w.z = pk2(kt[4], kt[5]); w.w = pk2(kt[6], kt[7]); *(LAS u32x4*)(L + W_KTT + lane * 72 + 8 * tg) = w;
          w.x = pk2(vv[0], vv[1]); w.y = pk2(vv[2], vv[3]); w.z = pk2(vv[4], vv[5]); w.w = pk2(vv[6], vv[7]); *(LAS u32x4*)(L + W_VTT + lane * 72 + 8 * tg) = w; }
        if (tg == 0) GAM[lane] = __expf(total);
        __syncthreads();
        { bf16x8_t aB[2][2], aK[2][2], bA[2][2], bR[2][2]; f32x4 ab[2], ak[2], rb[2], rk[2];
#pragma unroll
          for (int q = 0; q < 2; ++q) { const int pos = wave * 2 + q, it = pos >> 2, tt = pos & 3;
#pragma unroll
              for (int sx = 0; sx < 2; ++sx) { aB[q][sx] = lfrag(L + W_BT, it * 16 + fr, sx, fq); aK[q][sx] = lfrag(L + W_KT, it * 16 + fr, sx, fq); bA[q][sx] = lfrag(L + W_AT, tt * 16 + fr, sx, fq); bR[q][sx] = lfrag(L + W_RT, tt * 16 + fr, sx, fq); } }
#pragma unroll
          for (int q = 0; q < 2; ++q) { ab[q] = (f32x4){0.f, 0.f, 0.f, 0.f}; ak[q] = ab[q]; rb[q] = ab[q]; rk[q] = ab[q];
#pragma unroll
              for (int sx = 0; sx < 2; ++sx) { ab[q] = MFMA16(aB[q][sx], bA[q][sx], ab[q]); ak[q] = MFMA16(aK[q][sx], bA[q][sx], ak[q]); rb[q] = MFMA16(aB[q][sx], bR[q][sx], rb[q]); rk[q] = MFMA16(aK[q][sx], bR[q][sx], rk[q]); } }
#pragma unroll
          for (int q = 0; q < 2; ++q) { const int pos = wave * 2 + q, it = pos >> 2, tt = pos & 3; const int t = tt * 16 + fr, i0 = it * 16 + 4 * fq;
#pragma unroll
              for (int rg = 0; rg < 4; ++rg) { const bool st = (i0 + rg < t), inc = (i0 + rg <= t); ab[q][rg] = st ? ab[q][rg] : 0.f; ak[q][rg] = st ? ak[q][rg] : 0.f; rb[q][rg] = inc ? rb[q][rg] : 0.f; rk[q][rg] = inc ? rk[q][rg] : 0.f; }
              st4(L + W_L0 + t * 72 + i0, ab[q][0], ab[q][1], ab[q][2], ab[q][3]); st4(L + W_LAK + t * 72 + i0, ak[q][0], ak[q][1], ak[q][2], ak[q][3]);
              st4(L + W_LRB + t * 72 + i0, rb[q][0], rb[q][1], rb[q][2], rb[q][3]); st4(L + W_LRK + t * 72 + i0, rk[q][0], rk[q][1], rk[q][2], rk[q][3]);
#pragma unroll
              for (int rg = 0; rg < 4; ++rg) L[W_LT0 + (i0 + rg) * 72 + t] = (bf16)f2bf(ab[q][rg]); } }
        __syncthreads();
        { bf16x8_t a[2][2], bb[2][2]; f32x4 acc[2];
#pragma unroll
          for (int q = 0; q < 2; ++q) { const int pos = wave * 2 + q, tt = pos >> 2, vt = pos & 3;
#pragma unroll
              for (int sx = 0; sx < 2; ++sx) { a[q][sx] = lfrag(L + W_LAK, tt * 16 + fr, sx, fq); bb[q][sx] = lfrag(L + W_VTT, vt * 16 + fr, sx, fq); } }
#pragma unroll
          for (int q = 0; q < 2; ++q) { acc[q] = (f32x4){0.f, 0.f, 0.f, 0.f};
#pragma unroll
              for (int sx = 0; sx < 2; ++sx) acc[q] = MFMA16(a[q][sx], bb[q][sx], acc[q]); }
#pragma unroll
          for (int q = 0; q < 2; ++q) { const int pos = wave * 2 + q, tt = pos >> 2, vt = pos & 3; st4(L + W_X0 + (64 + vt * 16 + fr) * 72 + tt * 16 + 4 * fq, acc[q][0], acc[q][1], acc[q][2], acc[q][3]); } }
        __syncthreads();
#pragma unroll 1
        for (int pp_ = 0; pp_ < 6; ++pp_) {
            const int odd = pp_ & 1;
            LAS bf16* Lr = L + (odd ? W_L1 : W_L0); LAS bf16* LTr = L + (odd ? W_LT1 : W_LT0); LAS bf16* Xr = L + (odd ? W_X1 : W_X0);
            LAS bf16* Lw = L + (odd ? W_L0 : W_L1); LAS bf16* LTw = L + (odd ? W_LT0 : W_LT1); LAS bf16* Xw = L + (odd ? W_X0 : W_X1);
            { const bf16x8_t b0 = lfrag(Xr, wave * 16 + fr, 0, fq), b1 = lfrag(Xr, wave * 16 + fr, 1, fq);
              bf16x8_t la[4][2], lt[2][2]; f32x4 xa[4], sq[2];
#pragma unroll
              for (int tt = 0; tt < 4; ++tt) { la[tt][0] = lfrag(Lr, tt * 16 + fr, 0, fq); la[tt][1] = lfrag(Lr, tt * 16 + fr, 1, fq); xa[tt] = ld4(Xr + (wave * 16 + fr) * 72 + tt * 16 + 4 * fq); }
#pragma unroll
              for (int q = 0; q < 2; ++q) { const int it = (wave * 2 + q) & 3; lt[q][0] = lfrag(LTr, it * 16 + fr, 0, fq); lt[q][1] = lfrag(LTr, it * 16 + fr, 1, fq); }
#pragma unroll
              for (int tt = 0; tt < 4; ++tt) { xa[tt] = MFMA16(la[tt][0], b0, xa[tt]); xa[tt] = MFMA16(la[tt][1], b1, xa[tt]); }
#pragma unroll
              for (int q = 0; q < 2; ++q) { const int tq = (wave * 2 + q) >> 2; sq[q] = (f32x4){0.f, 0.f, 0.f, 0.f};
                  const bf16x8_t a0 = tq == 0 ? la[0][0] : tq == 1 ? la[1][0] : tq == 2 ? la[2][0] : la[3][0], a1 = tq == 0 ? la[0][1] : tq == 1 ? la[1][1] : tq == 2 ? la[2][1] : la[3][1];
                  sq[q] = MFMA16(a0, lt[q][0], sq[q]); sq[q] = MFMA16(a1, lt[q][1], sq[q]); }
#pragma unroll
              for (int tt = 0; tt < 4; ++tt) st4(Xw + (wave * 16 + fr) * 72 + tt * 16 + 4 * fq, xa[tt][0], xa[tt][1], xa[tt][2], xa[tt][3]);
              if (pp_ < 5) {
#pragma unroll
                  for (int q = 0; q < 2; ++q) { const int pos = wave * 2 + q, tt = pos >> 2, it = pos & 3;
                      st4(LTw + (it * 16 + fr) * 72 + tt * 16 + 4 * fq, sq[q][0], sq[q][1], sq[q][2], sq[q][3]);
#pragma unroll
                      for (int rg = 0; rg < 4; ++rg) Lw[(tt * 16 + 4 * fq + rg) * 72 + it * 16 + fr] = (bf16)f2bf(sq[q][rg]); } } }
            __syncthreads();
        }
        { bf16x8_t aX[2][2], bT[2][2], bL[2][2]; f32x4 accT[2], accQ[2], rt[2]; float gm[2];
#pragma unroll
          for (int q = 0; q < 2; ++q) { const int pos = wave * 2 + q, kt = pos >> 2, nt = pos & 3;
#pragma unroll
              for (int sx = 0; sx < 2; ++sx) { aX[q][sx] = lfrag(L + W_X0, kt * 16 + fr, sx, fq); bT[q][sx] = lfrag(L + W_BTT, nt * 16 + fr, sx, fq); bL[q][sx] = lfrag(L + W_LRB, nt * 16 + fr, sx, fq); }
              gm[q] = GAM[nt * 16 + fr]; rt[q] = ld4(L + W_RT + (nt * 16 + fr) * 72 + kt * 16 + 4 * fq); }
#pragma unroll
          for (int q = 0; q < 2; ++q) { accT[q] = (f32x4){0.f, 0.f, 0.f, 0.f}; accQ[q] = accT[q];
#pragma unroll
              for (int sx = 0; sx < 2; ++sx) { accT[q] = MFMA16(aX[q][sx], bT[q][sx], accT[q]); accQ[q] = MFMA16(aX[q][sx], bL[q][sx], accQ[q]); } }
#pragma unroll
          for (int q = 0; q < 2; ++q) { const int pos = wave * 2 + q, kt = pos >> 2, nt = pos & 3; const int k0 = kt * 16 + 4 * fq, n = nt * 16 + fr;
#pragma unroll
              for (int rg = 0; rg < 4; ++rg) accT[q][rg] = (accT[q][rg] + ((k0 + rg == n) ? 1.f : 0.f)) * gm[q];
              st4(L + W_TT + n * 72 + k0, accT[q][0], accT[q][1], accT[q][2], accT[q][3]); st4(L + W_QT + n * 72 + k0, accQ[q][0] + rt[q][0], accQ[q][1] + rt[q][1], accQ[q][2] + rt[q][2], accQ[q][3] + rt[q][3]); } }
        __syncthreads();
        { f32x4 oacc[4];
#pragma unroll
          for (int vt = 0; vt < 4; ++vt) oacc[vt] = (f32x4){0.f, 0.f, 0.f, 0.f};
#pragma unroll
          for (int sx = 0; sx < 2; ++sx) { const bf16x8_t aQ = lfrag(L + W_QT, w4 * 16 + fr, sx, fq);
              if (!ident) { const bf16x8_t aB = lfrag(L + W_LRB, w4 * 16 + fr, sx, fq), aK = lfrag(L + W_LRK, w4 * 16 + fr, sx, fq);
#pragma unroll
                  for (int vt = 0; vt < 4; ++vt) { const int rw = 4 * fr + vt; oacc[vt] = MFMA16(aB, lfrag(L + W_X0, 64 + rw, sx, fq), oacc[vt]); oacc[vt] = MFMA16(aK, lfrag(L + W_VTT, rw, sx, fq), oacc[vt]); oacc[vt] = MFMA16(aQ, lfrag(L + W_SIM, rw, sx, fq), oacc[vt]); } }
              else {
#pragma unroll
                  for (int vt = 0; vt < 4; ++vt) oacc[vt] = MFMA16(aQ, lfrag(L + W_PIM, 4 * fr + vt, sx, fq), oacc[vt]); } }
          bf16* OUT = ident ? (YI + (size_t)h * 64) : (MIX + (size_t)h * 64); const int ldo = ident ? 512 : D;
#pragma unroll
          for (int rg = 0; rg < 4; ++rg) { const size_t m = (size_t)b * T + t0 + w4 * 16 + 4 * fq + rg; u32x2 w; w.x = pk2(oacc[0][rg], oacc[1][rg]); w.y = pk2(oacc[2][rg], oacc[3][rg]); *(u32x2*)(OUT + m * ldo + 4 * fr) = w; } }
#pragma unroll
        for (int nt = 0; nt < 4; ++nt) { f32x4 acc = (f32x4){0.f, 0.f, 0.f, 0.f};
            if (!ident) {
#pragma unroll
                for (int sx = 0; sx < 2; ++sx) { acc = MFMA16(lfrag(L + W_X0, 64 + w4 * 16 + fr, sx, fq), lfrag(L + W_BTT, nt * 16 + fr, sx, fq), acc); acc = MFMA16(lfrag(L + W_VTT, w4 * 16 + fr, sx, fq), lfrag(L + W_KTT, nt * 16 + fr, sx, fq), acc); }
                acc = acc * GAM[nt * 16 + fr]; }
            const LAS bf16* IM = L + (ident ? W_PIM : W_SIM);
#pragma unroll
            for (int sx = 0; sx < 2; ++sx) acc = MFMA16(lfrag(IM, w4 * 16 + fr, sx, fq), lfrag(L + W_TT, nt * 16 + fr, sx, fq), acc);
            Wreg[nt] = acc; }
        __syncthreads();
        { LAS bf16* IM = L + (ident ? W_PIM : W_SIM);
#pragma unroll
          for (int nt = 0; nt < 4; ++nt)
#pragma unroll
              for (int rg = 0; rg < 4; ++rg) IM[(w4 * 16 + 4 * fq + rg) * 72 + nt * 16 + fr] = (bf16)f2bf(Wreg[nt][rg]); }
    }
    float* SE = (float*)(ws + WS_SER) + ((((size_t)(b * 8 + h) * NSEG + seg) * 2 + (ident ? 1 : 0)) * 4096);
#pragma unroll
    for (int nt = 0; nt < 4; ++nt)
#pragma unroll
        for (int rg = 0; rg < 4; ++rg) SE[(w4 * 16 + 4 * fq + rg) * 64 + nt * 16 + fr] = Wreg[nt][rg];
}

constexpr int GQ = 0, GK_ = GQ + 64 * 72, GD = GK_ + 64 * 72, GV = GD + 64 * 72, GA = GV + 128 * 72, GS = GA + 64 * 72, GEND = GS + 128 * 72;
__device__ __forceinline__ unsigned pk2f(float a, float b) { return pk2(a, b); }
__device__ __forceinline__ void gla_item(const Params& P, LAS unsigned char* lds, int b, int h, int seg) {
    const int tid = threadIdx.x, lane = tid & 63, wave = __builtin_amdgcn_readfirstlane(tid >> 6), fr = lane & 15, fq = lane >> 4;
    unsigned char* ws = P.ws;
    const bf16* p = (const bf16*)(ws + WS_P); bf16* GKB = (bf16*)(ws + WS_GK);
    bf16* MIX = (bf16*)P.out;
    float* SE = (float*)(ws + WS_SEG) + ((size_t)(b * 4 + h) * NSEG + seg) * 8192; float* CE = (float*)(ws + WS_CEND) + ((size_t)(b * 4 + h) * NSEG + seg) * 64;
    const float* conv = P.in[15];
    LAS bf16* L = (LAS bf16*)lds; LAS bf16* QT = L + GQ; LAS bf16* KT = L + GK_; LAS bf16* KD = L + GD; LAS bf16* VT = L + GV; LAS bf16* AT = L + GA; LAS bf16* ST = L + GS;
    LAS float* GAM = (LAS float*)(lds + GEND * 2); LAS float* TOT = GAM + 64;
    const int ch = lane, tg = wave;
    const int cq = h * 64 + ch, ck = 256 + h * 64 + ch, cv0 = 512 + h * 128 + ch, cv1 = cv0 + 64;
    float wq[4], wk[4], wv0[4], wv1[4];
#pragma unroll
    for (int j = 0; j < 4; ++j) { wq[j] = conv[j * 1024 + cq]; wk[j] = conv[j * 1024 + ck]; wv0[j] = conv[j * 1024 + cv0]; wv1[j] = conv[j * 1024 + cv1]; }
    float gseg = 0.f;
    f32x4 Sacc[4];
#pragma unroll
    for (int k = 0; k < 4; ++k) Sacc[k] = (f32x4){0.f, 0.f, 0.f, 0.f};
    __syncthreads();
    for (int i = tid; i < 128 * 72 / 2; i += NTHR) ((LAS unsigned*)ST)[i] = 0u;
    for (int c = 0; c < LSEG / 64; ++c) {
        const int t0 = seg * LSEG + c * 64;
        __syncthreads();
        float xq[11], xk[11], xa[11], xb[11], g[8];
#pragma unroll
        for (int r = 0; r < 11; ++r) { const int t = t0 + 8 * tg - 3 + r; const size_t m = (size_t)b * T + (t > 0 ? t : 0); const float ok = (t >= 0) ? 1.f : 0.f; const bf16* pr = p + m * NP + C_BQ;
            xq[r] = bf2f(pr[cq]) * ok; xk[r] = bf2f(pr[ck]) * ok; xa[r] = bf2f(pr[cv0]) * ok; xb[r] = bf2f(pr[cv1]) * ok; }
#pragma unroll
        for (int i = 0; i < 8; ++i) g[i] = bf2f(GKB[((size_t)b * T + t0 + 8 * tg + i) * 256 + h * 64 + ch]);
#pragma unroll
        for (int i = 1; i < 8; ++i) g[i] += g[i - 1];
        TOT[tg * 64 + ch] = g[7];
        __syncthreads();
        float off = 0.f, total = 0.f;
#pragma unroll
        for (int w = 0; w < 8; ++w) { const float tv = TOT[w * 64 + ch]; total += tv; off += (w < tg) ? tv : 0.f; }
        float kd[8], va[8], vb[8];
#pragma unroll
        for (int i = 0; i < 8; ++i) {
            float aq = 0.f, ak = 0.f, a0 = 0.f, a1 = 0.f;
#pragma unroll
            for (int j = 0; j < 4; ++j) { aq += wq[j] * xq[i + j]; ak += wk[j] * xk[i + j]; a0 += wv0[j] * xa[i + j]; a1 += wv1[j] * xb[i + j]; }
            const float q = siluf_(aq) * 0.125f, k = siluf_(ak), Gc = off + g[i];
            QT[(8 * tg + i) * 72 + ch] = (bf16)f2bf(q * __expf(Gc)); KT[(8 * tg + i) * 72 + ch] = (bf16)f2bf(k * __expf(-Gc));
            kd[i] = k * __expf(total - Gc); va[i] = siluf_(a0); vb[i] = siluf_(a1);
            GKB[((size_t)b * T + t0 + 8 * tg + i) * 256 + h * 64 + ch] = (bf16)f2bf(q * __expf(gseg + Gc));
        }
        { u32x4 w; w.x = pk2f(kd[0], kd[1]); w.y = pk2f(kd[2], kd[3]); w.z = pk2f(kd[4], kd[5]); w.w = pk2f(kd[6], kd[7]); *(LAS u32x4*)(KD + ch * 72 + 8 * tg) = w;
          w.x = pk2f(va[0], va[1]); w.y = pk2f(va[2], va[3]); w.z = pk2f(va[4], va[5]); w.w = pk2f(va[6], va[7]); *(LAS u32x4*)(VT + ch * 72 + 8 * tg) = w;
          w.x = pk2f(vb[0], vb[1]); w.y = pk2f(vb[2], vb[3]); w.z = pk2f(vb[4], vb[5]); w.w = pk2f(vb[6], vb[7]); *(LAS u32x4*)(VT + (64 + ch) * 72 + 8 * tg) = w; }
        if (tg == 0) GAM[ch] = __expf(total);
        gseg += total;
        __syncthreads();
#pragma unroll
        for (int k2 = 0; k2 < 2; ++k2) { const int tile = wave * 2 + k2, jt = tile >> 2, it = tile & 3; f32x4 acc = (f32x4){0.f, 0.f, 0.f, 0.f};
            if (jt <= it) {
#pragma unroll
                for (int sx = 0; sx < 2; ++sx) acc = __builtin_amdgcn_mfma_f32_16x16x32_bf16(*(const LAS bf16x8_t*)(KT + (jt * 16 + fr) * 72 + 32 * sx + 8 * fq), *(const LAS bf16x8_t*)(QT + (it * 16 + fr) * 72 + 32 * sx + 8 * fq), acc, 0, 0, 0);
            }
            const int ii = it * 16 + fr, j0 = jt * 16 + 4 * fq; u32x2 w;
            w.x = pk2f(j0 <= ii ? acc[0] : 0.f, j0 + 1 <= ii ? acc[1] : 0.f); w.y = pk2f(j0 + 2 <= ii ? acc[2] : 0.f, j0 + 3 <= ii ? acc[3] : 0.f);
            *(LAS u32x2*)(AT + ii * 72 + j0) = w; }
        __syncthreads();
        { const int it = wave & 3, vts = (wave >> 2) * 4; f32x4 oacc[4];
#pragma unroll
          for (int k = 0; k < 4; ++k) oacc[k] = (f32x4){0.f, 0.f, 0.f, 0.f};
#pragma unroll
          for (int sx = 0; sx < 2; ++sx) { const bf16x8_t aA = *(const LAS bf16x8_t*)(AT + (it * 16 + fr) * 72 + 32 * sx + 8 * fq), aQ = *(const LAS bf16x8_t*)(QT + (it * 16 + fr) * 72 + 32 * sx + 8 * fq);
#pragma unroll
              for (int k = 0; k < 4; ++k) { const int vrow = 8 * fr + vts + k;
                  oacc[k] = __builtin_amdgcn_mfma_f32_16x16x32_bf16(aA, *(const LAS bf16x8_t*)(VT + vrow * 72 + 32 * sx + 8 * fq), oacc[k], 0, 0, 0);
                  oacc[k] = __builtin_amdgcn_mfma_f32_16x16x32_bf16(aQ, *(const LAS bf16x8_t*)(ST + vrow * 72 + 32 * sx + 8 * fq), oacc[k], 0, 0, 0); } }
#pragma unroll
          for (int rg = 0; rg < 4; ++rg) { const size_t m = (size_t)b * T + t0 + it * 16 + 4 * fq + rg; u32x2 w; w.x = pk2f(oacc[0][rg], oacc[1][rg]); w.y = pk2f(oacc[2][rg], oacc[3][rg]);
              *(u32x2*)(MIX + m * D + 512 + h * 128 + 8 * fr + vts) = w; } }
#pragma unroll
        for (int k = 0; k < 4; ++k) { f32x4 acc = Sacc[k] * GAM[k * 16 + fr];
#pragma unroll
            for (int sx = 0; sx < 2; ++sx) acc = __builtin_amdgcn_mfma_f32_16x16x32_bf16(*(const LAS bf16x8_t*)(VT + (wave * 16 + fr) * 72 + 32 * sx + 8 * fq), *(const LAS bf16x8_t*)(KD + (k * 16 + fr) * 72 + 32 * sx + 8 * fq), acc, 0, 0, 0);
            Sacc[k] = acc; }
        __syncthreads();
#pragma unroll
        for (int k = 0; k < 4; ++k)
#pragma unroll
            for (int rg = 0; rg < 4; ++rg) ST[(wave * 16 + 4 * fq + rg) * 72 + k * 16 + fr] = (bf16)f2bf(Sacc[k][rg]);
    }
#pragma unroll
    for (int k = 0; k < 4; ++k)
#pragma unroll
        for (int rg = 0; rg < 4; ++rg) SE[(wave * 16 + 4 * fq + rg) * 64 + k * 16 + fr] = Sacc[k][rg];
    if (tg == 0) CE[ch] = __expf(gseg);
}
__device__ __forceinline__ void phase_scan(const Params& P, LAS unsigned char* lds) {
    for (int it = blockIdx.x; it < 512 + 256; it += gridDim.x) {
        if (it < 512) { const int bh = it >> 4; rwkv_item_chunked(P, lds, bh >> 3, bh & 7, it & 15); }
        else { const int g = it - 512, bh = g >> 4; gla_item(P, lds, bh >> 2, bh & 3, g & 15); }
        __syncthreads();
    }
}
__device__ __forceinline__ void quant_tables(const Params& P, int gw, int ngw);
__device__ __forceinline__ void phase_fixup(const Params& P, LAS unsigned char* lds) {
    const int tid = threadIdx.x, lane = tid & 63, wave = __builtin_amdgcn_readfirstlane(tid >> 6), fr = lane & 15, fq = lane >> 4;
    for (int it = blockIdx.x; it < 192; it += gridDim.x) {
        if (it < 64) {
            float* SE = (float*)(P.ws + WS_SER) + (size_t)(it >> 1) * NSEG * 2 * 4096;
            LAS float* Sb = (LAS float*)lds;
            const int sl = wave >> 2, nt = wave & 3, r0 = ((it & 1) * 2 + sl) * 16;
            const int cpos = (r0 + 4 * fq) * 64 + nt * 16 + fr;
            const int bpos = (16 * fq) * 64 + nt * 16 + fr;
            __syncthreads();
            f32x4 en[4]; float ph[4][16];
#define FX_LOAD(sg) do { const float* nx_ = SE + (size_t)((sg) * 2) * 4096; \
                _Pragma("unroll") for (int ks = 0; ks < 16; ++ks) ph[(sg) & 3][ks] = nx_[4096 + bpos + 64 * ks]; \
                _Pragma("unroll") for (int rg = 0; rg < 4; ++rg) en[(sg) & 3][rg] = nx_[cpos + 64 * rg]; } while (0)
#pragma unroll
            for (int rg = 0; rg < 4; ++rg) Sb[(sl * 16 + 4 * fq + rg) * 68 + nt * 16 + fr] = SE[cpos + 64 * rg];
            FX_LOAD(1); FX_LOAD(2); FX_LOAD(3);
            __syncthreads();
#pragma unroll
            for (int seg = 1; seg < NSEG - 1; ++seg) {
                float* s0 = SE + (size_t)(seg * 2) * 4096;
                const LAS float* Sr = Sb + ((seg - 1) & 1) * (2 * 16 * 68) + (sl * 16 + fr) * 68 + 16 * fq; LAS float* Sw = Sb + (seg & 1) * (2 * 16 * 68);
                if (seg + 3 < NSEG - 1) FX_LOAD(seg + 3);
                f32x4 acc = en[seg & 3]; f32x4 av[4];
#pragma unroll
                for (int j = 0; j < 4; ++j) av[j] = *(const LAS f32x4*)(Sr + 4 * j);
#pragma unroll
                for (int ks = 0; ks < 16; ++ks) acc = __builtin_amdgcn_mfma_f32_16x16x4f32(av[ks >> 2][ks & 3], ph[seg & 3][ks], acc, 0, 0, 0);
#pragma unroll
                for (int rg = 0; rg < 4; ++rg) { s0[cpos + 64 * rg] = acc[rg]; Sw[(sl * 16 + 4 * fq + rg) * 68 + nt * 16 + fr] = acc[rg]; }
                __syncthreads();
            }
#undef FX_LOAD
        } else {
            const int g = it - 64, bh = g >> 3; float* SE = (float*)(P.ws + WS_SEG) + (size_t)bh * NSEG * 8192 + ((g & 7) * 16 + (tid >> 5)) * 64 + (tid & 31) * 2;
            const float* CE = (const float*)(P.ws + WS_CEND) + (size_t)bh * NSEG * 64 + (tid & 31) * 2;
            f32x2 x[NSEG - 1], ce[NSEG - 1];
#pragma unroll
            for (int seg = 0; seg < NSEG - 1; ++seg) { x[seg] = *(const f32x2*)(SE + (size_t)seg * 8192); ce[seg] = *(const f32x2*)(CE + seg * 64); }
            f32x2 sc = (f32x2){0.f, 0.f};
#pragma unroll
            for (int seg = 0; seg < NSEG - 1; ++seg) { sc = sc * ce[seg] + x[seg]; *(f32x2*)(SE + (size_t)seg * 8192) = sc; }
        }
    }
    {
        const bool sp = gridDim.x > 64; const int nb = sp ? (int)gridDim.x - 64 : (int)gridDim.x, bi = sp ? (int)blockIdx.x - 64 : (int)blockIdx.x;
        if (bi >= 0) {
            fold_keys(P, lds, bi, nb);
            transpose_convert(P.in[19], D, D, D, (bf16*)(P.ws + WS_WOUT), bi * NTHR + tid, nb * NTHR);
            quant_tables(P, bi * NWAVES + (tid >> 6), nb * NWAVES);
        }
    }
}
__device__ __forceinline__ float row_sum16(float v) { v = DPP_ADD(v, 0xB1); v = DPP_ADD(v, 0x4E); v = DPP_ADD(v, 0x141); v = DPP_ADD(v, 0x140); return v; }
__device__ __forceinline__ bf16x8_t pack_bf16x8(const f32x4 a, const f32x4 b) {
    u32x4 w; w.x = pk2(a[0], a[1]); w.y = pk2(a[2], a[3]); w.z = pk2(b[0], b[1]); w.w = pk2(b[2], b[3]); return __builtin_bit_cast(bf16x8_t, w);
}
__device__ __forceinline__ void unpack4(const u32x2 w, float (&o)[4]) { o[0] = __uint_as_float(w.x << 16); o[1] = __uint_as_float(w.x & 0xffff0000u); o[2] = __uint_as_float(w.y << 16); o[3] = __uint_as_float(w.y & 0xffff0000u); }
__device__ __forceinline__ void phase_correct(const Params& P, LAS unsigned char* lds) {
    const int tid = threadIdx.x, lane = tid & 63, wave = __builtin_amdgcn_readfirstlane(tid >> 6), fr = lane & 15, fq = lane >> 4;
    unsigned char* ws = P.ws;
    const bf16* p = (const bf16*)(ws + WS_P); const bf16* AA = (const bf16*)(ws + WS_AA); const bf16* GG = (const bf16*)(ws + WS_GG);
    bf16* MIX = (bf16*)P.out; const bf16* YI = (const bf16*)(ws + WS_YI); const bf16* YIG = (const bf16*)(ws + WS_YIG);
    const float* mu = P.in[4]; const float* k_a = P.in[11]; const float* r_k = P.in[12]; const float* gn_g = P.in[13]; const float* gn_b = P.in[14]; const float* norm_g = P.in[18];
    LAS bf16* SB = (LAS bf16*)lds;
    for (int it = blockIdx.x; it < 512; it += gridDim.x) {
        {
            const int seg = it & 15, bh = it >> 4, b = bh >> 3, h = bh & 7;
            const int cb = h * 64 + 4 * fr;
            __syncthreads();
            if (seg > 0) { const float* ss = (const float*)(ws + WS_SER) + (((size_t)bh * NSEG + (seg - 1)) * 2) * 4096;
                for (int i = tid; i < 1024; i += NTHR) { const f32x4 x = *(const f32x4*)(ss + 4 * i); const int v = i >> 4, j = (4 * i) & 63; u32x2 w; w.x = pk2(x[0], x[1]); w.y = pk2(x[2], x[3]);
                    *(LAS u32x2*)(SB + ((v & 3) * 16 + (v >> 2)) * 72 + j) = w; } }
            __syncthreads();
            const f32x4 mur = *(const f32x4*)(mu + C_R + cb), muk = *(const f32x4*)(mu + C_K + cb), muv = *(const f32x4*)(mu + C_V + cb), kac = *(const f32x4*)(k_a + cb), rkc = *(const f32x4*)(r_k + cb), gng = *(const f32x4*)(gn_g + cb), gnb = *(const f32x4*)(gn_b + cb);
            u32x2 W[4][9];
#define CORR_LOAD(buf, st) do { const int t_ = seg * LSEG + wave * 64 + ((st) >> 2) * 16 + 4 * fq + ((st) & 3); const size_t m_ = (size_t)b * T + t_; const bf16* pr_ = p + m_ * NP + cb; const bf16* pp_ = (t_ > 0) ? pr_ - NP : pr_; \
                    W[buf][0] = *(const u32x2*)(MIX + m_ * D + cb); W[buf][1] = *(const u32x2*)(pr_ + C_R); W[buf][2] = *(const u32x2*)(pr_ + C_K); W[buf][3] = *(const u32x2*)(pr_ + C_V); \
                    W[buf][4] = *(const u32x2*)(pp_ + C_R); W[buf][5] = *(const u32x2*)(pp_ + C_K); W[buf][6] = *(const u32x2*)(pp_ + C_V); W[buf][7] = *(const u32x2*)(AA + m_ * A_W + cb); W[buf][8] = *(const u32x2*)(GG + m_ * A_W + cb); } while (0)
            CORR_LOAD(0, 0); CORR_LOAD(1, 1); CORR_LOAD(2, 2);
#pragma unroll
            for (int mt = 0; mt < 4; ++mt) {
                const int tb = seg * LSEG + wave * 64 + mt * 16;
                f32x4 acc[4];
#pragma unroll
                for (int vt = 0; vt < 4; ++vt) acc[vt] = (f32x4){0.f, 0.f, 0.f, 0.f};
                if (seg > 0) {
#pragma unroll
                    for (int sx = 0; sx < 2; ++sx) { const bf16x8_t af = *(const bf16x8_t*)(YI + ((size_t)b * T + tb + fr) * 512 + h * 64 + 32 * sx + 8 * fq);
#pragma unroll
                        for (int vt = 0; vt < 4; ++vt) acc[vt] = __builtin_amdgcn_mfma_f32_16x16x32_bf16(af, *(const LAS bf16x8_t*)(SB + (vt * 16 + fr) * 72 + 32 * sx + 8 * fq), acc[vt], 0, 0, 0); }
                }
#pragma unroll
                for (int rg = 0; rg < 4; ++rg) { const int t = tb + 4 * fq + rg; const size_t m = (size_t)b * T + t; const float hp = (t > 0) ? 1.f : 0.f; const int st = mt * 4 + rg;
                    if (st + 3 < 16) CORR_LOAD((st + 3) & 3, st + 3);
                    __builtin_amdgcn_sched_barrier(0);
                    float y[4], rc[4], kc[4], vc[4], rp_[4], kp[4], vp[4], a[4], g[4];
                    unpack4(W[st & 3][0], y); unpack4(W[st & 3][1], rc); unpack4(W[st & 3][2], kc); unpack4(W[st & 3][3], vc); unpack4(W[st & 3][4], rp_); unpack4(W[st & 3][5], kp); unpack4(W[st & 3][6], vp); unpack4(W[st & 3][7], a); unpack4(W[st & 3][8], g);
                    float v[4], sy = 0.f, sb = 0.f;
#pragma unroll
                    for (int i = 0; i < 4; ++i) { y[i] += acc[i][rg];
                        const float r = rc[i] + (rp_[i] * hp - rc[i]) * mur[i], k = kc[i] + (kp[i] * hp - kc[i]) * muk[i]; v[i] = vc[i] + (vp[i] * hp - vc[i]) * muv[i];
                        const float kh = k * (1.f + (a[i] - 1.f) * kac[i]); sb += r * kh * rkc[i]; sy += y[i]; }
                    const float bon = row_sum16(sb), mean = row_sum16(sy) * (1.f / 64.f); float sq = 0.f;
#pragma unroll
                    for (int i = 0; i < 4; ++i) { y[i] -= mean; sq += y[i] * y[i]; }
                    const float rstd = 1.f / sqrtf(row_sum16(sq) * (1.f / 64.f) + GN_EPS); float o[4];
#pragma unroll
                    for (int i = 0; i < 4; ++i) o[i] = (y[i] * rstd * gng[i] + gnb[i] + bon * v[i]) * g[i];
                    u32x2 w; w.x = pk2(o[0], o[1]); w.y = pk2(o[2], o[3]); *(u32x2*)(MIX + m * D + cb) = w;
                    __builtin_amdgcn_sched_barrier(0); }
#undef CORR_LOAD
            }
        }
    }
    for (int g_ = blockIdx.x; g_ < 256; g_ += gridDim.x) {
        {
            const int seg = g_ & 15, bh = g_ >> 4, b = bh >> 2, h = bh & 3;
            const int cb = h * 128 + 8 * fr;
            __syncthreads();
            if (seg > 0) { const float* ss = (const float*)(ws + WS_SEG) + ((size_t)bh * NSEG + (seg - 1)) * 8192;
                for (int i = tid; i < 2048; i += NTHR) { const f32x4 x = *(const f32x4*)(ss + 4 * i); const int v = i >> 4, j = (4 * i) & 63; u32x2 w; w.x = pk2(x[0], x[1]); w.y = pk2(x[2], x[3]);
                    *(LAS u32x2*)(SB + ((v & 7) * 16 + (v >> 3)) * 72 + j) = w; } }
            __syncthreads();
            const f32x4 ng0 = *(const f32x4*)(norm_g + 8 * fr), ng1 = *(const f32x4*)(norm_g + 8 * fr + 4);
            u32x4 WG[4][2];
#define CORG_LOAD(buf, st) do { const size_t m_ = (size_t)b * T + seg * LSEG + wave * 64 + ((st) >> 2) * 16 + 4 * fq + ((st) & 3); WG[buf][0] = *(const u32x4*)(MIX + m_ * D + 512 + cb); WG[buf][1] = *(const u32x4*)(p + m_ * NP + C_BG + cb); } while (0)
            CORG_LOAD(0, 0); CORG_LOAD(1, 1); CORG_LOAD(2, 2);
#pragma unroll
            for (int mt = 0; mt < 4; ++mt) {
                const int tb = seg * LSEG + wave * 64 + mt * 16;
                f32x4 acc[8];
#pragma unroll
                for (int vt = 0; vt < 8; ++vt) acc[vt] = (f32x4){0.f, 0.f, 0.f, 0.f};
                if (seg > 0) {
#pragma unroll
                    for (int sx = 0; sx < 2; ++sx) { const bf16x8_t af = *(const bf16x8_t*)(YIG + ((size_t)b * T + tb + fr) * 256 + h * 64 + 32 * sx + 8 * fq);
#pragma unroll
                        for (int vt = 0; vt < 8; ++vt) acc[vt] = __builtin_amdgcn_mfma_f32_16x16x32_bf16(af, *(const LAS bf16x8_t*)(SB + (vt * 16 + fr) * 72 + 32 * sx + 8 * fq), acc[vt], 0, 0, 0); }
                }
#pragma unroll
                for (int rg = 0; rg < 4; ++rg) { const size_t m = (size_t)b * T + tb + 4 * fq + rg; const int st = mt * 4 + rg;
                    if (st + 3 < 16) CORG_LOAD((st + 3) & 3, st + 3);
                    __builtin_amdgcn_sched_barrier(0);
                    float o[8], g[8]; float sq = 0.f;
#pragma unroll
                    for (int i = 0; i < 4; ++i) { const unsigned a_ = WG[st & 3][0][i], b_ = WG[st & 3][1][i]; o[2 * i] = __uint_as_float(a_ << 16); o[2 * i + 1] = __uint_as_float(a_ & 0xffff0000u); g[2 * i] = __uint_as_float(b_ << 16); g[2 * i + 1] = __uint_as_float(b_ & 0xffff0000u); }
#pragma unroll
                    for (int i = 0; i < 8; ++i) { o[i] += acc[i][rg]; sq += o[i] * o[i]; }
                    const float rs = 1.f / sqrtf(row_sum16(sq) * (1.f / 128.f) + RMS_EPS);
                    float f[8];
#pragma unroll
                    for (int i = 0; i < 8; ++i) f[i] = o[i] * rs * (i < 4 ? ng0[i & 3] : ng1[i & 3]) * siluf_(g[i]);
                    u32x4 w; w.x = pk2(f[0], f[1]); w.y = pk2(f[2], f[3]); w.z = pk2(f[4], f[5]); w.w = pk2(f[6], f[7]); *(u32x4*)(MIX + m * D + 512 + cb) = w;
                    __builtin_amdgcn_sched_barrier(0); }
#undef CORG_LOAD
            }
        }
    }
}

__device__ __forceinline__ void phase_ln1(const Params& P) {
    const int lane = threadIdx.x & 63, wave = threadIdx.x >> 6; const int gw = blockIdx.x * NWAVES + wave, ngw = gridDim.x * NWAVES;
    for (int m = gw; m < M; m += ngw) ln_rowb_bf16<true>((const bf16*)(P.ws + WS_Z) + (size_t)m * D, P.in[20], P.in[21], (bf16*)(P.ws + WS_H1) + (size_t)m * D, lane, P.ws + WS_H8 + (size_t)m * 2048);
}
__device__ __forceinline__ void quant_tables(const Params& P, int gw, int ngw) {
    const int lane = threadIdx.x & 63;
    {
        const float* src = P.in[24]; unsigned char* dst = P.ws + WS_UF + (size_t)(lane >> 3) * UF_SLICE + 16 * (lane & 7); float* sc = (float*)(P.ws + WS_SU);
        for (int e = gw; e < 16384; e += ngw) {
            const f32x4* sp = (const f32x4*)(src + (size_t)e * D) + 4 * lane; f32x4 a[4]; float mx = 0.f;
#pragma unroll
            for (int j = 0; j < 4; ++j) { a[j] = sp[j]; mx = fmaxf(fmaxf(mx, fmaxf(fabsf(a[j][0]), fabsf(a[j][1]))), fmaxf(fabsf(a[j][2]), fabsf(a[j][3]))); }
            mx = wave_max_u(mx); const float inv = mx > 0.f ? 448.f / mx : 0.f;
            u32x4 w;
#pragma unroll
            for (int j = 0; j < 4; ++j) { int pk = __builtin_amdgcn_cvt_pk_fp8_f32(a[j][0] * inv, a[j][1] * inv, 0, false); pk = __builtin_amdgcn_cvt_pk_fp8_f32(a[j][2] * inv, a[j][3] * inv, pk, true); w[j] = (unsigned)pk; }
            *(u32x4*)(dst + (size_t)e * 128) = w;
            if (lane == 0) sc[e] = mx * (1.f / 448.f);
        }
    }
    {
        const float* src = P.in[25]; unsigned char* dst = P.ws + WS_V8 + (size_t)(lane >> 3) * V8_SLICE + 16 * (lane & 7); float* sc = (float*)(P.ws + WS_SV);
        for (int e = gw; e < 16384; e += ngw) {
            const f32x4* sp = (const f32x4*)(src + (size_t)e * D) + 4 * lane; f32x4 a[4]; float mx = 0.f;
#pragma unroll
            for (int j = 0; j < 4; ++j) { a[j] = sp[j]; mx = fmaxf(fmaxf(mx, fmaxf(fabsf(a[j][0]), fabsf(a[j][1]))), fmaxf(fabsf(a[j][2]), fabsf(a[j][3]))); }
            mx = wave_max_u(mx); const float inv = mx > 0.f ? 127.f / mx : 0.f;
            u32x4 w;
#pragma unroll
            for (int j = 0; j < 4; ++j) w[j] = pack_i8(a[j][0], a[j][1], a[j][2], a[j][3], inv, 0);
            *(u32x4*)(dst + (size_t)e * 128) = w;
            if (lane == 0) sc[e] = mx * (1.f / 127.f);
        }
    }
}

#define TK_CE(a, b) do { const unsigned _h = max((a), (b)); (b) = min((a), (b)); (a) = _h; } while (0)
#define TK_INS(L, x) do { _Pragma("unroll") for (int _j = 0; _j < 16; ++_j) { const unsigned _h = max(L[_j], x); x = min(L[_j], x); L[_j] = _h; } } while (0)
__device__ __forceinline__ void tk_sort16(unsigned (&x)[16]) { TK_CE(x[0], x[13]); TK_CE(x[1], x[12]); TK_CE(x[2], x[15]); TK_CE(x[3], x[14]); TK_CE(x[4], x[8]); TK_CE(x[5], x[6]); TK_CE(x[7], x[11]); TK_CE(x[9], x[10]); TK_CE(x[0], x[5]); TK_CE(x[1], x[7]); TK_CE(x[2], x[9]); TK_CE(x[3], x[4]); TK_CE(x[6], x[13]); TK_CE(x[8], x[14]); TK_CE(x[10], x[15]); TK_CE(x[11], x[12]); TK_CE(x[0], x[1]); TK_CE(x[2], x[3]); TK_CE(x[4], x[5]); TK_CE(x[6], x[8]); TK_CE(x[7], x[9]); TK_CE(x[10], x[11]); TK_CE(x[12], x[13]); TK_CE(x[14], x[15]); TK_CE(x[0], x[2]); TK_CE(x[1], x[3]); TK_CE(x[4], x[10]); TK_CE(x[5], x[11]); TK_CE(x[6], x[7]); TK_CE(x[8], x[9]); TK_CE(x[12], x[14]); TK_CE(x[13], x[15]); TK_CE(x[1], x[2]); TK_CE(x[3], x[12]); TK_CE(x[4], x[6]); TK_CE(x[5], x[7]); TK_CE(x[8], x[10]); TK_CE(x[9], x[11]); TK_CE(x[13], x[14]); TK_CE(x[1], x[4]); TK_CE(x[2], x[6]); TK_CE(x[5], x[8]); TK_CE(x[7], x[10]); TK_CE(x[9], x[13]); TK_CE(x[11], x[14]); TK_CE(x[2], x[4]); TK_CE(x[3], x[6]); TK_CE(x[9], x[12]); TK_CE(x[11], x[13]); TK_CE(x[3], x[5]); TK_CE(x[6], x[8]); TK_CE(x[7], x[9]); TK_CE(x[10], x[12]); TK_CE(x[3], x[4]); TK_CE(x[5], x[6]); TK_CE(x[7], x[8]); TK_CE(x[9], x[10]); TK_CE(x[11], x[12]); TK_CE(x[6], x[7]); TK_CE(x[8], x[9]); }
__device__ __forceinline__ void tk_merge16(unsigned (&R)[16], const unsigned (&S)[16]) {
#pragma unroll
    for (int i = 0; i < 16; ++i) R[i] = max(R[i], S[15 - i]);
    TK_CE(R[0], R[8]); TK_CE(R[1], R[9]); TK_CE(R[2], R[10]); TK_CE(R[3], R[11]); TK_CE(R[4], R[12]); TK_CE(R[5], R[13]); TK_CE(R[6], R[14]); TK_CE(R[7], R[15]); TK_CE(R[0], R[4]); TK_CE(R[1], R[5]); TK_CE(R[2], R[6]); TK_CE(R[3], R[7]); TK_CE(R[8], R[12]); TK_CE(R[9], R[13]); TK_CE(R[10], R[14]); TK_CE(R[11], R[15]); TK_CE(R[0], R[2]); TK_CE(R[1], R[3]); TK_CE(R[4], R[6]); TK_CE(R[5], R[7]); TK_CE(R[8], R[10]); TK_CE(R[9], R[11]); TK_CE(R[12], R[14]); TK_CE(R[13], R[15]); TK_CE(R[0], R[1]); TK_CE(R[2], R[3]); TK_CE(R[4], R[5]); TK_CE(R[6], R[7]); TK_CE(R[8], R[9]); TK_CE(R[10], R[11]); TK_CE(R[12], R[13]); TK_CE(R[14], R[15]);
}
__device__ __forceinline__ unsigned tk_ckey(float sum, unsigned payload) { const unsigned b = __float_as_uint(sum); const unsigned mono = b ^ ((unsigned)((int)b >> 31) | 0x80000000u); return (mono & 0xFFFFC000u) | payload; }
__device__ __forceinline__ void topk128(const u32x4* r, unsigned (&L)[16]) {
    u32x4 c0 = r[0], c1 = r[64];
    for (int c = 0; c < 8; ++c) {
        const u32x4 n0 = r[64 * ((2 * c + 2) & 15)], n1 = r[64 * ((2 * c + 3) & 15)];
        const unsigned kb = 0xFFFFu - 16u * (unsigned)c; unsigned x[16];
#pragma unroll
        for (int d = 0; d < 4; ++d) {
            unsigned w = c0[d]; unsigned msk = ((w >> 15) & 0x00010001u) * 0xFFFFu; w ^= (msk | 0x80008000u);
            x[2 * d] = (w << 16) | (kb - 2u * d); x[2 * d + 1] = (w & 0xFFFF0000u) | (kb - 2u * d - 1u);
            w = c1[d]; msk = ((w >> 15) & 0x00010001u) * 0xFFFFu; w ^= (msk | 0x80008000u);
            x[8 + 2 * d] = (w << 16) | (kb - 8u - 2u * d); x[8 + 2 * d + 1] = (w & 0xFFFF0000u) | (kb - 8u - 2u * d - 1u);
        }
        tk_sort16(x);
        if (c == 0) {
#pragma unroll
            for (int q = 0; q < 16; ++q) L[q] = x[q];
        } else tk_merge16(L, x);
        c0 = n0; c1 = n1;
    }
}
__device__ __forceinline__ void phase_topk(const Params& P) {
    const int gl = blockIdx.x * NTHR + threadIdx.x, nl = gridDim.x * NTHR;
    const bf16* Sc = (const bf16*)(P.ws + WS_S); int* IDS = (int*)(P.ws + WS_IDS); float* GATES = (float*)(P.ws + WS_GATES);
    for (int item = gl; item < M * 8; item += nl) {
        const u32x4* row = (const u32x4*)Sc + (size_t)((item >> 6) * 32) * 64 + (item & 63);
        unsigned L0[16], L1[16];
        topk128(row, L0); topk128(row + 16 * 64, L1);
        float f0[16], f1[16]; unsigned p0[16], p1[16];
#pragma unroll
        for (int i = 0; i < 16; ++i) {
            f0[i] = __uint_as_float((L0[i] & 0x80000000u) ? (L0[i] & 0x7FFF0000u) : (~L0[i] & 0xFFFF0000u)); p0[i] = (~L0[i] & 0x7Fu) << 7;
            f1[i] = __uint_as_float((L1[i] & 0x80000000u) ? (L1[i] & 0x7FFF0000u) : (~L1[i] & 0xFFFF0000u)); p1[i] = (~L1[i] & 0x7Fu);
        }
        unsigned C[16];
        { unsigned x[16] = {tk_ckey(f0[0] + f1[0], p0[0] | p1[0]), tk_ckey(f0[0] + f1[1], p0[0] | p1[1]), tk_ckey(f0[0] + f1[2], p0[0] | p1[2]), tk_ckey(f0[0] + f1[3], p0[0] | p1[3]), tk_ckey(f0[0] + f1[4], p0[0] | p1[4]), tk_ckey(f0[0] + f1[5], p0[0] | p1[5]), tk_ckey(f0[0] + f1[6], p0[0] | p1[6]), tk_ckey(f0[0] + f1[7], p0[0] | p1[7]), tk_ckey(f0[0] + f1[8], p0[0] | p1[8]), tk_ckey(f0[0] + f1[9], p0[0] | p1[9]), tk_ckey(f0[0] + f1[10], p0[0] | p1[10]), tk_ckey(f0[0] + f1[11], p0[0] | p1[11]), tk_ckey(f0[0] + f1[12], p0[0] | p1[12]), tk_ckey(f0[0] + f1[13], p0[0] | p1[13]), tk_ckey(f0[0] + f1[14], p0[0] | p1[14]), tk_ckey(f0[0] + f1[15], p0[0] | p1[15])};
          tk_sort16(x);
#pragma unroll
          for (int q = 0; q < 16; ++q) C[q] = x[q]; }
        { unsigned x[16] = {tk_ckey(f0[1] + f1[0], p0[1] | p1[0]), tk_ckey(f0[1] + f1[1], p0[1] | p1[1]), tk_ckey(f0[1] + f1[2], p0[1] | p1[2]), tk_ckey(f0[1] + f1[3], p0[1] | p1[3]), tk_ckey(f0[1] + f1[4], p0[1] | p1[4]), tk_ckey(f0[1] + f1[5], p0[1] | p1[5]), tk_ckey(f0[1] + f1[6], p0[1] | p1[6]), tk_ckey(f0[1] + f1[7], p0[1] | p1[7]), tk_ckey(f0[2] + f1[0], p0[2] | p1[0]), tk_ckey(f0[2] + f1[1], p0[2] | p1[1]), tk_ckey(f0[2] + f1[2], p0[2] | p1[2]), tk_ckey(f0[2] + f1[3], p0[2] | p1[3]), tk_ckey(f0[2] + f1[4], p0[2] | p1[4]), tk_ckey(f0[3] + f1[0], p0[3] | p1[0]), tk_ckey(f0[3] + f1[1], p0[3] | p1[1]), tk_ckey(f0[3] + f1[2], p0[3] | p1[2])};
          tk_sort16(x); tk_merge16(C, x); }
        { unsigned x[16] = {tk_ckey(f0[3] + f1[3], p0[3] | p1[3]), tk_ckey(f0[4] + f1[0], p0[4] | p1[0]), tk_ckey(f0[4] + f1[1], p0[4] | p1[1]), tk_ckey(f0[4] + f1[2], p0[4] | p1[2]), tk_ckey(f0[5] + f1[0], p0[5] | p1[0]), tk_ckey(f0[5] + f1[1], p0[5] | p1[1]), tk_ckey(f0[6] + f1[0], p0[6] | p1[0]), tk_ckey(f0[6] + f1[1], p0[6] | p1[1]), tk_ckey(f0[7] + f1[0], p0[7] | p1[0]), tk_ckey(f0[7] + f1[1], p0[7] | p1[1]), tk_ckey(f0[8] + f1[0], p0[8] | p1[0]), tk_ckey(f0[9] + f1[0], p0[9] | p1[0]), tk_ckey(f0[10] + f1[0], p0[10] | p1[0]), tk_ckey(f0[11] + f1[0], p0[11] | p1[0]), tk_ckey(f0[12] + f1[0], p0[12] | p1[0]), tk_ckey(f0[13] + f1[0], p0[13] | p1[0])};
          tk_sort16(x); tk_merge16(C, x); }
        { unsigned key = tk_ckey(f0[14] + f1[0], p0[14] | p1[0]); TK_INS(C, key); }
        { unsigned key = tk_ckey(f0[15] + f1[0], p0[15] | p1[0]); TK_INS(C, key); }
        float cv[16];
#pragma unroll
        for (int r = 0; r < 16; ++r) cv[r] = __uint_as_float((C[r] & 0x80000000u) ? (C[r] & 0x7FFFC000u) : (~C[r] & 0xFFFFC000u));
        const float cmax = cv[0]; float den = 0.f;
#pragma unroll
        for (int r = 0; r < 16; ++r) { cv[r] = __expf(cv[r] - cmax); den += cv[r]; }
        const float inv = 1.f / den;
        const int oi = ((((item >> 9) << 6) | (item & 63)) << 3) | ((item >> 6) & 7);
        u32x4* ido = (u32x4*)(IDS + (size_t)oi * 16); f32x4* go = (f32x4*)(GATES + (size_t)oi * 16);
#pragma unroll
        for (int q = 0; q < 4; ++q) { u32x4 o; o.x = C[4 * q] & 0x3FFFu; o.y = C[4 * q + 1] & 0x3FFFu; o.z = C[4 * q + 2] & 0x3FFFu; o.w = C[4 * q + 3] & 0x3FFFu; ido[q] = o;
            f32x4 g; g[0] = cv[4 * q] * inv; g[1] = cv[4 * q + 1] * inv; g[2] = cv[4 * q + 2] * inv; g[3] = cv[4 * q + 3] * inv; go[q] = g; }
    }
}

#define XB_TMO      128
#define XB_XCNT(j)  (256  + 64 * (j))
#define XB_XSUB(j)  (1280 + 64 * (j))
#define XB_XGEN(j)  (2304 + 64 * (j))
#define XB_TOP      3328
#define XB_TOPGEN   3392
#define XCD_BAR_WORDS 3456
#define XB_SPIN_CAP (1u << 18)
__device__ __forceinline__ unsigned xb_ld(unsigned* p)              { return __hip_atomic_load(p, __ATOMIC_RELAXED, __HIP_MEMORY_SCOPE_AGENT); }
__device__ __forceinline__ unsigned xb_add(unsigned* p, unsigned v) { return __hip_atomic_fetch_add(p, v, __ATOMIC_RELAXED, __HIP_MEMORY_SCOPE_AGENT); }
__device__ __forceinline__ unsigned xb_xcc_id() { return (unsigned)__builtin_amdgcn_s_getreg((3 << 11) | 20) & 0xFu; }
#define XB_SPIN(cond, bar) do { unsigned _sp = 0; while (cond) { __builtin_amdgcn_s_sleep(1); \
    if ((++_sp & 255u) == 0u) { if (xb_ld(&(bar)[XB_TMO])) break; if (_sp > XB_SPIN_CAP) { atomicAdd(&(bar)[XB_TMO], 1u); break; } } } } while (0)
struct XcdBarrier { unsigned* bar; unsigned x; volatile LAS unsigned* st; };
__device__ __forceinline__ XcdBarrier xcd_barrier_post(unsigned* bar, volatile LAS unsigned* st) {
    XcdBarrier b; b.bar = bar; b.x = xb_xcc_id(); b.st = st;
    if (threadIdx.x == 0) { const unsigned r = xb_add(&bar[XB_XCNT(b.x)], 1u); st[4] = r; st[5] = b.x; }
    return b;
}
__device__ __forceinline__ void xcd_barrier_complete(unsigned* bar, unsigned x, unsigned& nloc, unsigned& nx) {
    const unsigned G = gridDim.x * gridDim.y * gridDim.z;
    unsigned sum, cnt, mine, sp = 0u;
    for (;;) {
        sum = 0u; cnt = 0u; mine = 0u;
#pragma unroll
        for (unsigned j = 0; j < 16; ++j) { const unsigned c = xb_ld(&bar[XB_XCNT(j)]); sum += c; cnt += (c > 0u) ? 1u : 0u; mine = (j == x) ? c : mine; }
        if (sum == G) break;
        __builtin_amdgcn_s_sleep(1);
        if ((++sp & 255u) == 0u) { if (xb_ld(&bar[XB_TMO])) break; if (sp > XB_SPIN_CAP) { atomicAdd(&bar[XB_TMO], 1u); break; } }
    }
    nloc = mine > 0u ? mine : 1u; nx = cnt > 0u ? cnt : 1u;
}
__device__ __forceinline__ void xcd_barrier(const XcdBarrier& b) {
    asm volatile("s_waitcnt vmcnt(0)" ::: "memory");
    __syncthreads();
    if (threadIdx.x == 0) {
        unsigned* bar = b.bar;
        __builtin_amdgcn_s_waitcnt(0);
        unsigned nloc = b.st[0], nx = b.st[1];
        if (nloc == 0u) { xcd_barrier_complete(bar, b.x, nloc, nx); b.st[0] = nloc; b.st[1] = nx; }
        const unsigned old = xb_add(&bar[XB_XSUB(b.x)], 1u);
        const unsigned gen = old / nloc;
        if (old + 1u == (gen + 1u) * nloc) {
            __builtin_amdgcn_fence(__ATOMIC_RELEASE, "agent");
            asm volatile("s_waitcnt vmcnt(0)" ::: "memory");
            const unsigned og = xb_add(&bar[XB_TOP], 1u);
            const unsigned tg = og / nx;
            if (og + 1u == (tg + 1u) * nx) xb_add(&bar[XB_TOPGEN], 1u);
            else XB_SPIN(xb_ld(&bar[XB_TOPGEN]) == tg, bar);
            __builtin_amdgcn_fence(__ATOMIC_ACQUIRE, "agent");
            xb_add(&bar[XB_XGEN(b.x)], 1u);
            asm volatile("s_waitcnt vmcnt(0)" ::: "memory");
        } else {
            XB_SPIN(xb_ld(&bar[XB_XGEN(b.x)]) == gen, bar);
            __builtin_amdgcn_fence(__ATOMIC_ACQUIRE, "agent");
            asm volatile("s_waitcnt vmcnt(0)" ::: "memory");
        }
    }
    __syncthreads();
}

typedef int v8i_t __attribute__((ext_vector_type(8)));
#define PD_LO 1
struct PdTok { int idl, idh; unsigned hw; };
__device__ __forceinline__ PdTok pd_fetch(const int* IDS, const unsigned char* H8s, int m, int lane) {
    PdTok t; t.idl = IDS[(size_t)m * 128 + lane]; t.idh = IDS[(size_t)m * 128 + 64 + lane]; t.hw = *(const unsigned*)(H8s + (size_t)m * 2048); return t;
}
__device__ __forceinline__ void pd_issue(u32x4 (&X0)[8], u32x4 (&X1)[8], const PdTok& t, const unsigned char* UFs, LAS unsigned char* slot, int lane) {
#pragma unroll
    for (int g = 0; g < 8; ++g) { const unsigned id = (unsigned)__builtin_amdgcn_ds_bpermute(4 * (16 * (g & 3) + (lane >> 2)), g < 4 ? t.idl : t.idh);
        const u32x4* rp = (const u32x4*)(UFs + ((id << 7) + 16u * (unsigned)(lane & 3))); X0[g] = rp[0]; X1[g] = rp[4]; }
    *(LAS unsigned*)(slot + 4 * lane) = t.hw;
}
__device__ __forceinline__ float pd_trace(const f32x4 v) {
    const float v0 = v[0], v1 = v[1], v2 = v[2], v3 = v[3];
#define PD_BC(x, ctrl) __builtin_bit_cast(float, __builtin_amdgcn_update_dpp(0, __builtin_bit_cast(int, (x)), (ctrl), 0xf, 0xf, true))
    float s = PD_BC(v0, 0x00); s += PD_BC(v1, 0x55); s += PD_BC(v2, 0xAA); s += PD_BC(v3, 0xFF); return s;
#undef PD_BC
}
__device__ __forceinline__ void pd_compute(const u32x4 (&X0)[8], const u32x4 (&X1)[8], const LAS unsigned char* arp, unsigned* PDs, int m, int lane) {
    const int q = lane & 3;
    float dl = 0.f, dh = 0.f;
    const LAS u32x4* hp = (const LAS u32x4*)arp; const u32x4 A0 = hp[0], A1 = hp[4];
#if PD_LO
    const u32x4 A2 = hp[8], A3 = hp[12];
#endif
    const v8i_t ah = {(int)A0.x, (int)A0.y, (int)A0.z, (int)A0.w, (int)A1.x, (int)A1.y, (int)A1.z, (int)A1.w};
#if PD_LO
    const v8i_t al = {(int)A2.x, (int)A2.y, (int)A2.z, (int)A2.w, (int)A3.x, (int)A3.y, (int)A3.z, (int)A3.w};
#endif
    f32x4 acc[8];
#pragma unroll
    for (int g = 0; g < 8; ++g) { const v8i_t b = {(int)X0[g].x, (int)X0[g].y, (int)X0[g].z, (int)X0[g].w, (int)X1[g].x, (int)X1[g].y, (int)X1[g].z, (int)X1[g].w};
        acc[g] = __builtin_amdgcn_mfma_scale_f32_16x16x128_f8f6f4(ah, b, (f32x4){0.f, 0.f, 0.f, 0.f}, 0, 0, 0, 0, 0, 0); }
#if PD_LO
    __builtin_amdgcn_sched_barrier(0);
#pragma unroll
    for (int g = 0; g < 8; ++g) { const v8i_t b = {(int)X0[g].x, (int)X0[g].y, (int)X0[g].z, (int)X0[g].w, (int)X1[g].x, (int)X1[g].y, (int)X1[g].z, (int)X1[g].w};
        acc[g] = __builtin_amdgcn_mfma_scale_f32_16x16x128_f8f6f4(al, b, acc[g], 0, 0, 0, 0, 0, 0); }
#endif
    __builtin_amdgcn_sched_barrier(0);
#pragma unroll
    for (int g = 0; g < 8; ++g) { const float d = pd_trace(acc[g]);
        if (g < 4) dl = (q == g) ? d : dl; else dh = (q == g - 4) ? d : dh; }
    const int srcl = 4 * (4 * (lane & 15) + (lane >> 4));
    dl = __int_as_float(__builtin_amdgcn_ds_bpermute(srcl, __float_as_int(dl))); dh = __int_as_float(__builtin_amdgcn_ds_bpermute(srcl, __float_as_int(dh)));
    PDs[(size_t)m * 64 + lane] = pk2(dl, dh);
}
__device__ __forceinline__ void phase_peer_dots(const Params& P, LAS unsigned char* lds) {
    const int lane = threadIdx.x & 63, wave = __builtin_amdgcn_readfirstlane(threadIdx.x >> 6);
    const int* IDS = (const int*)(P.ws + WS_IDS); unsigned* PD = (unsigned*)(P.ws + WS_PD);
    volatile LAS unsigned* bst = (volatile LAS unsigned*)(lds + LDS_MISC);
    const unsigned rank = __builtin_amdgcn_readfirstlane(bst[4]), x = __builtin_amdgcn_readfirstlane(bst[5]);
    unsigned* bar = (unsigned*)(P.ws + WS_CTL);
    unsigned n = 1, xi = 0, nx = 0;
    for (unsigned j = 0; j < 16; ++j) { const unsigned cnt = __builtin_amdgcn_readfirstlane(xb_ld(&bar[XB_XCNT(j)])); if (cnt) { if (j < x) ++xi; ++nx; } if (j == x) n = cnt; }
    if (nx == 0) nx = 1; if (n == 0) n = 1;
    constexpr int NCW = NWAVES - 1;
    const int stride = (int)n * NCW; const bool arow = ((lane >> 2) & 3) == (lane >> 4);
    LAS unsigned char* slot0 = lds + wave * 512; LAS unsigned char* slot1 = slot0 + 256; LAS unsigned char* zer = lds + NWAVES * 512;
    volatile LAS unsigned* prog = (volatile LAS unsigned*)(zer + 256);
    __syncthreads();
    if (threadIdx.x < 80) ((LAS unsigned*)zer)[threadIdx.x] = 0u;
    __syncthreads();
    if (wave == NCW) {
        constexpr unsigned AHEAD = 600;
        unsigned base = 0;
        for (unsigned s = xi; s < 8; s += nx) {
            const int r7 = (int)rank * NCW; unsigned total = 0;
            for (int w = 0; w < NCW; ++w) { const int m0 = r7 + w; total += (m0 < M) ? (unsigned)((M - m0 + stride - 1) / stride) : 0u; }
            const int tk = lane / 6, ln = lane - 6 * tk;
            for (unsigned done = 0; done < total; ) {
                if (done + base < *prog + AHEAD) {
                    const unsigned char* pa[4];
#pragma unroll
                    for (int k = 0; k < 4; ++k) { unsigned j = done + 10u * k + (unsigned)(tk < 10 ? tk : 9); if (j >= total) j = total - 1;
                        const int i = (int)(j / NCW), w = (int)(j - (unsigned)i * NCW); int m = r7 + w + i * stride; if (m >= M) m = r7;
                        pa[k] = (ln < 4) ? (const unsigned char*)IDS + (size_t)m * 512 + 128 * ln : P.ws + WS_H8 + (size_t)m * 2048 + 128 * s + 1024 * (ln - 4); }
                    unsigned d0, d1, d2, d3;
                    asm volatile("global_load_dword %0, %4, off\n\tglobal_load_dword %1, %5, off\n\tglobal_load_dword %2, %6, off\n\tglobal_load_dword %3, %7, off\n\ts_waitcnt vmcnt(0)"
                                 : "=&v"(d0), "=&v"(d1), "=&v"(d2), "=&v"(d3) : "v"(pa[0]), "v"(pa[1]), "v"(pa[2]), "v"(pa[3]) : "memory");
                    done += 40;
                } else __builtin_amdgcn_s_sleep(4);
            }
            base += total;
        }
        return;
    }
    const LAS unsigned char* ar0 = arow ? slot0 + 16 * (lane & 3) : zer; const LAS unsigned char* ar1 = arow ? slot1 + 16 * (lane & 3) : zer;
    for (unsigned s = xi; s < 8; s += nx) {
        const unsigned char* UFs = P.ws + WS_UF + (size_t)s * UF_SLICE;
        const unsigned char* H8s = P.ws + WS_H8 + 128 * s + (lane < 32 ? 4 * lane : 1024 + 4 * (lane - 32)); unsigned* PDs = PD + (size_t)s * M * 64;
        const int m0 = (int)rank * NCW + wave;
        if (m0 >= M) continue;
        const int cnt = (M - m0 + stride - 1) / stride;
#define PD_TOK(i) ((i) < cnt ? m0 + (i) * stride : m0)
        u32x4 RA4[8], RB4[8], RA2[8], RB2[8];
        PdTok t0 = pd_fetch(IDS, H8s, m0, lane), t1 = pd_fetch(IDS, H8s, PD_TOK(1), lane), t2 = pd_fetch(IDS, H8s, PD_TOK(2), lane);
        pd_issue(RA4, RA2, t0, UFs, slot0, lane);
        for (int i = 0; i < cnt; i += 2) {
            const int ma = PD_TOK(i), mb = PD_TOK(i + 1);
            const PdTok t3 = pd_fetch(IDS, H8s, PD_TOK(i + 3), lane);
            pd_issue(RB4, RB2, t1, UFs, slot1, lane);
            __builtin_amdgcn_sched_barrier(0);
            pd_compute(RA4, RA2, ar0, PDs, ma, lane);
            if (lane == 0) __hip_atomic_fetch_add((LAS unsigned*)prog, 1u, __ATOMIC_RELAXED, __HIP_MEMORY_SCOPE_WORKGROUP);
            __builtin_amdgcn_sched_barrier(0);
            const PdTok t4 = pd_fetch(IDS, H8s, PD_TOK(i + 4), lane);
            pd_issue(RA4, RA2, t2, UFs, slot0, lane);
            __builtin_amdgcn_sched_barrier(0);
            pd_compute(RB4, RB2, ar1, PDs, mb, lane);
            if (lane == 0 && i + 1 < cnt) __hip_atomic_fetch_add((LAS unsigned*)prog, 1u, __ATOMIC_RELAXED, __HIP_MEMORY_SCOPE_WORKGROUP);
            __builtin_amdgcn_sched_barrier(0);
            t1 = t3; t2 = t4;
        }
#undef PD_TOK
    }
}

__device__ __forceinline__ void phase_peer_coef(const Params& P) {
    const int lane = threadIdx.x & 63, wave = threadIdx.x >> 6; const int gw = blockIdx.x * NWAVES + wave, ngw = gridDim.x * NWAVES;
    const int* IDS = (const int*)(P.ws + WS_IDS); const float* GATES = (const float*)(P.ws + WS_GATES); const unsigned* PD = (const unsigned*)(P.ws + WS_PD);
    const float* SU = (const float*)(P.ws + WS_SU); const float* SV = (const float*)(P.ws + WS_SV);
    unsigned char* CQ = P.ws + WS_CQ; float* CS = (float*)(P.ws + WS_CS);
    constexpr int TB = 4;
    for (int mb = gw; mb < M; mb += TB * ngw) {
        int id_lo[TB], id_hi[TB]; float gt_lo[TB], gt_hi[TB], d_lo[TB], d_hi[TB], su_lo[TB], su_hi[TB], sv_lo[TB], sv_hi[TB];
#pragma unroll
        for (int t = 0; t < TB; ++t) { const int m = (mb + t * ngw < M) ? mb + t * ngw : mb;
            id_lo[t] = IDS[(size_t)m * 128 + lane]; id_hi[t] = IDS[(size_t)m * 128 + 64 + lane]; gt_lo[t] = GATES[(size_t)m * 128 + lane]; gt_hi[t] = GATES[(size_t)m * 128 + 64 + lane]; }
#pragma unroll
        for (int t = 0; t < TB; ++t) { const int m = (mb + t * ngw < M) ? mb + t * ngw : mb; float a = 0.f, b = 0.f;
#pragma unroll
            for (int s = 0; s < 8; ++s) { const unsigned w = PD[((size_t)s * M + m) * 64 + lane]; a += __uint_as_float(w << 16); b += __uint_as_float(w & 0xffff0000u); }
            d_lo[t] = a; d_hi[t] = b; }
#pragma unroll
        for (int t = 0; t < TB; ++t) { su_lo[t] = SU[id_lo[t]]; su_hi[t] = SU[id_hi[t]]; sv_lo[t] = SV[id_lo[t]]; sv_hi[t] = SV[id_hi[t]]; }
#pragma unroll
        for (int t = 0; t < TB; ++t) { const int m = (mb + t * ngw < M) ? mb + t * ngw : mb;
            const float x_lo = d_lo[t] * su_lo[t], x_hi = d_hi[t] * su_hi[t];
            const float a_lo = 0.5f * x_lo * (1.f + erff(x_lo * 0.70710678118f)) * gt_lo[t] * sv_lo[t], a_hi = 0.5f * x_hi * (1.f + erff(x_hi * 0.70710678118f)) * gt_hi[t] * sv_hi[t];
            const float amx = wave_max_u(fmaxf(fabsf(a_lo), fabsf(a_hi))); const float ainv = amx > 0.f ? 127.f / amx : 0.f;
            const int q_lo = __float2int_rn(a_lo * ainv), q_hi = __float2int_rn(a_hi * ainv);
            const int j0 = lane, j1 = 64 + lane;
            CQ[(size_t)m * 128 + 16 * ((j0 >> 2) & 7) + 4 * (j0 >> 5) + (j0 & 3)] = (unsigned char)q_lo;
            CQ[(size_t)m * 128 + 16 * ((j1 >> 2) & 7) + 4 * (j1 >> 5) + (j1 & 3)] = (unsigned char)q_hi;
            if (lane == 0) CS[m] = amx * (1.f / 127.f); }
    }
}

struct AxTok { u32x4 id[4]; u32x4 cq; float cs; unsigned hw; };
__device__ __forceinline__ void ax_fetch(AxTok& t, const int* IDS, const unsigned char* CQ, const float* CS, const bf16* H1s, int m, int lane) {
    const u32x4* ip = (const u32x4*)(IDS + (size_t)m * 128) + (lane >> 3);
#pragma unroll
    for (int r = 0; r < 4; ++r) t.id[r] = ip[8 * r];
    t.cq = *((const u32x4*)(CQ + (size_t)m * 128) + (lane >> 3)); t.cs = CS[m]; t.hw = *(const unsigned*)(H1s + (size_t)m * D);
}
__device__ __forceinline__ void ax_issue(u32x4 (&W)[4], const u32x4 ids, const unsigned char* V8s, int lane) {
#pragma unroll
    for (int k = 0; k < 4; ++k) W[k] = *(const u32x4*)(V8s + ((ids[k] << 7) + 16u * (unsigned)(lane & 7)));
}
__device__ __forceinline__ void ax_round(const u32x4 (&W)[4], int c4, int (&acc)[16]) {
#pragma unroll
    for (int i = 0; i < 4; ++i) {
        const unsigned t0 = __builtin_amdgcn_perm(W[1][i], W[0][i], 0x05010400u), t1 = __builtin_amdgcn_perm(W[1][i], W[0][i], 0x07030602u);
        const unsigned t2 = __builtin_amdgcn_perm(W[3][i], W[2][i], 0x05010400u), t3 = __builtin_amdgcn_perm(W[3][i], W[2][i], 0x07030602u);
        const unsigned T0 = __builtin_amdgcn_perm(t2, t0, 0x05040100u), T1 = __builtin_amdgcn_perm(t2, t0, 0x07060302u), T2 = __builtin_amdgcn_perm(t3, t1, 0x05040100u), T3 = __builtin_amdgcn_perm(t3, t1, 0x07060302u);
        acc[4 * i] = __builtin_amdgcn_sdot4((int)T0, c4, acc[4 * i], false); acc[4 * i + 1] = __builtin_amdgcn_sdot4((int)T1, c4, acc[4 * i + 1], false);
        acc[4 * i + 2] = __builtin_amdgcn_sdot4((int)T2, c4, acc[4 * i + 2], false); acc[4 * i + 3] = __builtin_amdgcn_sdot4((int)T3, c4, acc[4 * i + 3], false); }
}
__device__ __forceinline__ void ax_finish(int (&acc)[16], float cs, unsigned hw, bf16* ZPs, int m, int lane) {
    const bool b3 = (lane & 8) != 0, b4 = (lane & 16) != 0, b5 = (lane & 32) != 0;
    int w8[8], w4[4], w2[2];
#pragma unroll
    for (int i = 0; i < 8; ++i) { const int keep = b3 ? acc[i + 8] : acc[i], send = b3 ? acc[i] : acc[i + 8]; w8[i] = keep + DPP_I(send, 0x128); }
#pragma unroll
    for (int i = 0; i < 4; ++i) { const int keep = b4 ? w8[i + 4] : w8[i], send = b4 ? w8[i] : w8[i + 4]; w4[i] = keep + __builtin_amdgcn_ds_swizzle(send, 0x401F); }
#pragma unroll
    for (int i = 0; i < 2; ++i) { const int keep = b5 ? w4[i + 2] : w4[i], send = b5 ? w4[i] : w4[i + 2]; w2[i] = keep + __shfl_xor(send, 32); }
    const float z0 = ALPHA * __uint_as_float(hw << 16) + cs * (float)w2[0], z1 = ALPHA * __uint_as_float(hw & 0xffff0000u) + cs * (float)w2[1];
    const int d0 = 16 * (lane & 7) + (b3 ? 8 : 0) + (b4 ? 4 : 0) + (b5 ? 2 : 0);
    *(unsigned*)(ZPs + (size_t)m * D + d0) = pk2(z0, z1);
}
__device__ __forceinline__ void phase_peer_axpy(const Params& P, LAS unsigned char* lds) {
    const int lane = threadIdx.x & 63, wave = __builtin_amdgcn_readfirstlane(threadIdx.x >> 6);
    const int* IDS = (const int*)(P.ws + WS_IDS); const unsigned char* CQ = P.ws + WS_CQ; const float* CS = (const float*)(P.ws + WS_CS);
    volatile LAS unsigned* bst = (volatile LAS unsigned*)(lds + LDS_MISC);
    const unsigned rank = __builtin_amdgcn_readfirstlane(bst[4]), x = __builtin_amdgcn_readfirstlane(bst[5]);
    unsigned* bar = (unsigned*)(P.ws + WS_CTL);
    unsigned n = 1, xi = 0, nx = 0;
    for (unsigned j = 0; j < 16; ++j) { const unsigned cnt = __builtin_amdgcn_readfirstlane(xb_ld(&bar[XB_XCNT(j)])); if (cnt) { if (j < x) ++xi; ++nx; } if (j == x) n = cnt; }
    if (nx == 0) nx = 1; if (n == 0) n = 1;
    constexpr int NCW = NWAVES - 1;
    const int stride = (int)n * NCW;
    volatile LAS unsigned* prog = (volatile LAS unsigned*)lds;
    __syncthreads();
    if (threadIdx.x == 0) *prog = 0u;
    __syncthreads();
    if (wave == NCW) {
        constexpr unsigned AHEAD = 600;
        unsigned base = 0;
        for (unsigned s = xi; s < 8; s += nx) {
            const int r7 = (int)rank * NCW; unsigned total = 0;
            for (int w = 0; w < NCW; ++w) { const int m0 = r7 + w; total += (m0 < M) ? (unsigned)((M - m0 + stride - 1) / stride) : 0u; }
            const int tk = lane >> 3, ln = lane & 7;
            for (unsigned done = 0; done < total; ) {
                if (done + base < *prog + AHEAD) {
                    const unsigned char* pa[4];
#pragma unroll
                    for (int k = 0; k < 4; ++k) { unsigned j = done + 8u * k + (unsigned)tk; if (j >= total) j = total - 1;
                        const int i = (int)(j / NCW), w = (int)(j - (unsigned)i * NCW); int m = r7 + w + i * stride; if (m >= M) m = r7;
                        pa[k] = (ln < 4) ? (const unsigned char*)IDS + (size_t)m * 512 + 128 * ln : (ln == 4) ? CQ + (size_t)m * 128 : (ln < 7) ? P.ws + WS_H1 + (size_t)m * 2048 + 256 * s + 128 * (ln - 5) : (const unsigned char*)(CS + m); }
                    unsigned d0, d1, d2, d3;
                    asm volatile("global_load_dword %0, %4, off\n\tglobal_load_dword %1, %5, off\n\tglobal_load_dword %2, %6, off\n\tglobal_load_dword %3, %7, off\n\ts_waitcnt vmcnt(0)"
                                 : "=&v"(d0), "=&v"(d1), "=&v"(d2), "=&v"(d3) : "v"(pa[0]), "v"(pa[1]), "v"(pa[2]), "v"(pa[3]) : "memory");
                    done += 32;
                } else __builtin_amdgcn_s_sleep(4);
            }
            base += total;
        }
        return;
    }
    const int dsel = 16 * (lane & 7) + ((lane & 8) ? 8 : 0) + ((lane & 16) ? 4 : 0) + ((lane & 32) ? 2 : 0);
    for (unsigned s = xi; s < 8; s += nx) {
        const unsigned char* V8s = P.ws + WS_V8 + (size_t)s * V8_SLICE;
        const bf16* H1s = (const bf16*)(P.ws + WS_H1) + 128 * s + dsel; bf16* ZPs = (bf16*)(P.ws + WS_ZP) + 128 * s;
        const int m0 = (int)rank * NCW + wave;
        if (m0 >= M) continue;
        const int cnt = (M - m0 + stride - 1) / stride;
#define AX_TOK(i) ((i) < cnt ? m0 + (i) * stride : m0)
        u32x4 W0[4], W1[4], W2[4], W3[4];
        AxTok ta, tb, tc; ax_fetch(ta, IDS, CQ, CS, H1s, m0, lane); ax_fetch(tb, IDS, CQ, CS, H1s, AX_TOK(1), lane);
        ax_issue(W0, ta.id[0], V8s, lane); ax_issue(W1, ta.id[1], V8s, lane); ax_issue(W2, ta.id[2], V8s, lane);
#define AX_STEP(CUR, NXT, FRE, ii) do { \
            const int ma_ = AX_TOK(ii); \
            ax_fetch(FRE, IDS, CQ, CS, H1s, AX_TOK((ii) + 2), lane); \
            int acc[16]; \
            _Pragma("unroll") for (int j = 0; j < 16; ++j) acc[j] = 0; \
            ax_issue(W3, CUR.id[3], V8s, lane); __builtin_amdgcn_sched_barrier(0); ax_round(W0, (int)CUR.cq[0], acc); __builtin_amdgcn_sched_barrier(0); \
            ax_issue(W0, NXT.id[0], V8s, lane); __builtin_amdgcn_sched_barrier(0); ax_round(W1, (int)CUR.cq[1], acc); __builtin_amdgcn_sched_barrier(0); \
            ax_issue(W1, NXT.id[1], V8s, lane); __builtin_amdgcn_sched_barrier(0); ax_round(W2, (int)CUR.cq[2], acc); __builtin_amdgcn_sched_barrier(0); \
            ax_issue(W2, NXT.id[2], V8s, lane); __builtin_amdgcn_sched_barrier(0); ax_round(W3, (int)CUR.cq[3], acc); __builtin_amdgcn_sched_barrier(0); \
            ax_finish(acc, CUR.cs, CUR.hw, ZPs, ma_, lane); \
            if (lane == 0 && (ii) < cnt) __hip_atomic_fetch_add((LAS unsigned*)prog, 1u, __ATOMIC_RELAXED, __HIP_MEMORY_SCOPE_WORKGROUP); } while (0)
        for (int i = 0; i < cnt; i += 3) { AX_STEP(ta, tb, tc, i); AX_STEP(tb, tc, ta, i + 1); AX_STEP(tc, ta, tb, i + 2); }
#undef AX_STEP
#undef AX_TOK
    }
}

__device__ __forceinline__ void phase_ln2(const Params& P) {
    const int lane = threadIdx.x & 63, wave = threadIdx.x >> 6; const int gw = blockIdx.x * NWAVES + wave, ngw = gridDim.x * NWAVES;
    const float* g2 = P.in[26]; const float* b2 = P.in[27]; const bf16* ZP = (const bf16*)(P.ws + WS_ZP);
    for (int m = gw; m < M; m += ngw) {
        const u32x4* xr = (const u32x4*)(ZP + (size_t)m * D) + 2 * lane; const u32x4 a = xr[0], c = xr[1]; float v[16]; float s = 0.f;
#pragma unroll
        for (int i = 0; i < 4; ++i) { v[2 * i] = __uint_as_float(a[i] << 16); v[2 * i + 1] = __uint_as_float(a[i] & 0xffff0000u); v[8 + 2 * i] = __uint_as_float(c[i] << 16); v[8 + 2 * i + 1] = __uint_as_float(c[i] & 0xffff0000u); }
#pragma unroll
        for (int i = 0; i < 16; ++i) s += v[i];
        const float mean = wave_sum(s) * (1.f / D); float s2 = 0.f;
#pragma unroll
        for (int i = 0; i < 16; ++i) { v[i] -= mean; s2 += v[i] * v[i]; }
        const float rstd = 1.f / sqrtf(wave_sum(s2) * (1.f / D) + LN_EPS);
#pragma unroll
        for (int c4 = 0; c4 < 4; ++c4) { const int e0 = 16 * lane + 4 * c4; const f32x4 gg = *(const f32x4*)(g2 + e0), bb = *(const f32x4*)(b2 + e0); f32x4 o;
#pragma unroll
            for (int j = 0; j < 4; ++j) o[j] = v[c4 * 4 + j] * rstd * gg[j] + bb[j];
            *(f32x4*)(P.out + (size_t)m * D + e0) = o; }
    }
}

constexpr int N_PHASES = 14;
__global__ void __launch_bounds__(NTHR, 2) fwd_kernel(Params P) {
    extern __shared__ __attribute__((aligned(16))) unsigned char lds_raw[];
    LAS unsigned char* lds = (LAS unsigned char*)lds_raw;
    cg::grid_group grid = cg::this_grid();
    const int lo = P.ph_lo, hi = P.ph_hi;
    unsigned char* ws = P.ws;
    volatile LAS unsigned* bst = (volatile LAS unsigned*)(lds + LDS_MISC);
    if (threadIdx.x < 16) bst[threadIdx.x] = 0u;
    __syncthreads();
    const XcdBarrier bar = xcd_barrier_post((unsigned*)(ws + WS_CTL), bst);
#define IN(k) (lo <= (k) && (k) < hi)
#define SEAM(k) do { if (IN(k) && IN((k) + 1)) { if ((k) == 0) grid.sync(); else xcd_barrier(bar); } } while (0)
    if (IN(0)) phase_prologue(P, lds);
    SEAM(0);
    if (IN(1)) {
        pg8::Gemm g{(const bf16*)(ws + WS_H0), (const bf16*)(ws + WS_WIN), M, NP, D, D, D, 0}; pg8::StaticOrder S; S.init(M, NP, gridDim.x, blockIdx.x);
        pg8::EpiBf16 E{(bf16*)(ws + WS_P), NP};
        pg8::gemm_phase<pg8::EpiBf16, pg8::StaticOrder, true, true>(lds, g, S, E);
    }
    SEAM(1);
    if (IN(2)) phase_prep(P, lds);
    SEAM(2);
    if (IN(3)) phase_scan(P, lds);
    SEAM(3);
    if (IN(4)) phase_fixup(P, lds);
    SEAM(4);
    if (IN(5)) phase_correct(P, lds);
    SEAM(5);
    if (IN(6)) {
        pg8::Gemm g{(const bf16*)P.out, (const bf16*)(ws + WS_WOUT), M, D, D, D, D, 0}; pg8::StaticOrder S; S.init(M, D, gridDim.x, blockIdx.x);
        pg8::EpiResBf16 E{(bf16*)(ws + WS_Z), (const bf16*)(ws + WS_H0), D, ALPHA};
        pg8::gemm_phase<pg8::EpiResBf16, pg8::StaticOrder, true, true>(lds, g, S, E);
    }
    SEAM(6);
    if (IN(7)) phase_ln1(P);
    SEAM(7);
    if (IN(8)) {
        pg8::Gemm g{(const bf16*)(ws + WS_H1), (const bf16*)(ws + WS_WQ), M, NQ, D, D, D, 0}; pg8::StaticOrder S; S.init(M, NQ, gridDim.x, blockIdx.x);
        pg8::EpiScores E{(bf16*)(ws + WS_S)};
        pg8::gemm_phase<pg8::EpiScores, pg8::StaticOrder, true, true>(lds, g, S, E);
    }
    SEAM(8);
    if (IN(9)) phase_topk(P);
    SEAM(9);
    if (IN(10)) phase_peer_dots(P, lds);
    SEAM(10);
    if (IN(11)) phase_peer_coef(P);
    SEAM(11);
    if (IN(12)) phase_peer_axpy(P, lds);
    SEAM(12);
    if (IN(13)) phase_ln2(P);
#undef IN
#undef SEAM
}

extern "C" void kernel_launch(void* const* d_in, const int* in_sizes, int n_in, void* d_out, int out_size, void* d_ws, size_t ws_size, hipStream_t stream) {
    static int grid = 0;
    if (grid == 0) {
        if (n_in != 28 || out_size != M * D || ws_size < WS_END) { fprintf(stderr, "kernel_launch: unexpected shapes (n_in %d out %d ws %zu)\n", n_in, out_size, ws_size); grid = -1; return; }
        int dev = 0, cus = 0, per_cu = 0;
        (void)hipGetDevice(&dev); (void)hipDeviceGetAttribute(&cus, hipDeviceAttributeMultiprocessorCount, dev);
        (void)hipFuncSetAttribute((const void*)fwd_kernel, hipFuncAttributeMaxDynamicSharedMemorySize, LDS_BYTES);
        (void)hipOccupancyMaxActiveBlocksPerMultiprocessor(&per_cu, (const void*)fwd_kernel, NTHR, LDS_BYTES);
        if (per_cu < 1) { fprintf(stderr, "kernel_launch: occupancy query says %d blocks per CU\n", per_cu); per_cu = 1; }
        (void)hipGetLastError();
        grid = cus;
    }
    if (grid < 0) return;
    Params p{};
    for (int i = 0; i < 28; ++i) p.in[i] = (const float*)d_in[i];
    p.out = (float*)d_out; p.ws = (unsigned char*)d_ws;
    (void)hipMemsetAsync((char*)d_ws + WS_CTL, 0, CTL_BYTES, stream);
    p.ph_lo = 0; p.ph_hi = N_PHASES;
    void* args[] = {&p};
    hipError_t e = hipLaunchCooperativeKernel((const void*)fwd_kernel, dim3(grid), dim3(NTHR), args, LDS_BYTES, stream);
    if (e != hipSuccess) fprintf(stderr, "cooperative launch failed: %s (grid %d)\n", hipGetErrorString(e), grid);
}
```

```cpp
#include <hip/hip_runtime.h>
#include <hip/hip_cooperative_groups.h>
#include <cstdio>
#include <cstdint>
namespace cg = cooperative_groups;

namespace pg8 {
#define PG8_LAS __attribute__((address_space(3)))
typedef unsigned short bf16_t;
typedef short bf16x8 __attribute__((ext_vector_type(8)));
typedef float f32x4 __attribute__((ext_vector_type(4)));
typedef float f32x2 __attribute__((ext_vector_type(2)));
typedef unsigned u32x4 __attribute__((ext_vector_type(4)));
typedef unsigned u32x2 __attribute__((ext_vector_type(2)));
constexpr int BM = 256, BK = 64, HALF = 128, HTB = HALF * BK * 2, STAGE_BYTES = 8 * HTB, NXCD = 8, WGM = 8;

__host__ __device__ __forceinline__ int lds_byte(int r, int c) { const int st = (r >> 4) * 2 + (c >> 5), rr = r & 15, cc = c & 31, ob = rr * 64 + cc * 2; return st * 1024 + (ob ^ (((ob >> 9) & 1) << 5)); }
__host__ __device__ __forceinline__ void stage_rc(int b, int& R, int& C) { const int st = b / 1024, sb = b % 1024, swz = sb ^ (((sb >> 9) & 1) << 5); R = (st >> 1) * 16 + swz / 64; C = (st & 1) * 32 + (swz % 64) / 2; }
__host__ __device__ __forceinline__ int perm32(int rho) { const int n = rho >> 4, i = rho & 15; return 8 * (i >> 2) + 4 * n + (i & 3); }

struct Unit { int pm, pn; };
struct Gemm { const bf16_t* A; const bf16_t* Bt; int M, N, K, lda, ldb, a_pn_koff; };

struct StaticOrder {
    int nM, nN, nwg, G, c;
    __host__ __device__ void init(int M, int N, int G_, int c_) { nM = M / BM; nN = N / BM; nwg = nM * nN; G = G_; c = c_; }
    __host__ __device__ bool next(int i, Unit& u) const {
        const long L = (long)i * G + c; if (L >= nwg) return false;
        int wgid = (int)L; { const int q = nwg / NXCD, r = nwg % NXCD, xcd = wgid % NXCD, off = wgid / NXCD; wgid = (xcd < r ? xcd * (q + 1) : r * (q + 1) + (xcd - r) * q) + off; }
        const int nig = WGM * nN, gid = wgid / nig, fm = gid * WGM, gsz = (nM - fm) < WGM ? (nM - fm) : WGM;
        u.pm = fm + ((wgid % nig) % gsz); u.pn = (wgid % nig) / gsz; return true;
    }
    __device__ __forceinline__ void a_ready(const Unit&) const {}
    __device__ __forceinline__ void done(const Unit&) const {}
};

typedef float f32x2p_t __attribute__((ext_vector_type(2))); typedef __bf16 bf16x2p_t __attribute__((ext_vector_type(2)));
__device__ __forceinline__ unsigned cvt_pk_bf16(float lo, float hi) { const f32x2p_t v = {lo, hi}; const bf16x2p_t b = __builtin_convertvector(v, bf16x2p_t); return __builtin_bit_cast(unsigned, b); }

struct EpiScores {
    static constexpr bool PERM = true;
    bf16_t* O;
    __device__ __forceinline__ void operator()(const f32x4 (&acc)[2][2][4][2], const Unit& u, int wr, int wc, int fr, int fq) const {
        const int row0 = u.pm * BM + wr * 64 + fr;
#pragma unroll
        for (int ai = 0; ai < 2; ++ai)
#pragma unroll
            for (int m = 0; m < 4; ++m) { const int row = row0 + ai * HALF + m * 16;
                bf16_t* tp = O + ((size_t)((row >> 6) * (2048 / BM) + u.pn) * 32 * 64 + (row & 63)) * 8;
#pragma unroll
                for (int bj = 0; bj < 2; ++bj) { const f32x4 v0 = acc[ai][bj][m][0], v1 = acc[ai][bj][m][1];
                    u32x4 w; w.x = cvt_pk_bf16(v0[0], v0[1]); w.y = cvt_pk_bf16(v0[2], v0[3]); w.z = cvt_pk_bf16(v1[0], v1[1]); w.w = cvt_pk_bf16(v1[2], v1[3]);
                    *(u32x4*)(tp + (size_t)(4 * wc + fq + 16 * bj) * 64 * 8) = w; } }
    }
};
struct EpiBf16 {
    static constexpr bool PERM = true;
    bf16_t* O; int ldc;
    __device__ __forceinline__ void operator()(const f32x4 (&acc)[2][2][4][2], const Unit& u, int wr, int wc, int fr, int fq) const {
        const int row0 = u.pm * BM + wr * 64 + fr; const int col0 = u.pn * BM + wc * 32 + 8 * fq;
#pragma unroll
        for (int ai = 0; ai < 2; ++ai)
#pragma unroll
            for (int m = 0; m < 4; ++m) { bf16_t* rowp = O + (size_t)(row0 + ai * HALF + m * 16) * ldc + col0;
#pragma unroll
                for (int bj = 0; bj < 2; ++bj) { const f32x4 v0 = acc[ai][bj][m][0], v1 = acc[ai][bj][m][1];
                    u32x4 w; w.x = cvt_pk_bf16(v0[0], v0[1]); w.y = cvt_pk_bf16(v0[2], v0[3]); w.z = cvt_pk_bf16(v1[0], v1[1]); w.w = cvt_pk_bf16(v1[2], v1[3]);
                    *(u32x4*)(rowp + bj * HALF) = w; } }
    }
};
struct EpiResBf16 {
    static constexpr bool PERM = true;
    bf16_t* Z; const bf16_t* R; int ldc; float alpha;
    __device__ __forceinline__ void operator()(const f32x4 (&acc)[2][2][4][2], const Unit& u, int wr, int wc, int fr, int fq) const {
        const int row0 = u.pm * BM + wr * 64 + fr; const int col0 = u.pn * BM + wc * 32 + 8 * fq;
#pragma unroll
        for (int ai = 0; ai < 2; ++ai)
#pragma unroll
            for (int m = 0; m < 4; ++m) { const size_t off = (size_t)(row0 + ai * HALF + m * 16) * ldc + col0;
#pragma unroll
                for (int bj = 0; bj < 2; ++bj) { const u32x4 rb = *(const u32x4*)(R + off + bj * HALF); const f32x4 v0 = acc[ai][bj][m][0], v1 = acc[ai][bj][m][1];
                    u32x4 w;
                    w.x = cvt_pk_bf16(__uint_as_float(rb.x << 16) * alpha + v0[0], __uint_as_float(rb.x & 0xffff0000u) * alpha + v0[1]);
                    w.y = cvt_pk_bf16(__uint_as_float(rb.y << 16) * alpha + v0[2], __uint_as_float(rb.y & 0xffff0000u) * alpha + v0[3]);
                    w.z = cvt_pk_bf16(__uint_as_float(rb.z << 16) * alpha + v1[0], __uint_as_float(rb.z & 0xffff0000u) * alpha + v1[1]);
                    w.w = cvt_pk_bf16(__uint_as_float(rb.w << 16) * alpha + v1[2], __uint_as_float(rb.w & 0xffff0000u) * alpha + v1[3]);
                    *(u32x4*)(Z + off + bj * HALF) = w; } }
    }
};
template <class Epi, class Sched, bool ALIGN_EPI = false, bool SP2 = false>
__device__ __forceinline__ void gemm_phase(PG8_LAS unsigned char* lds, const Gemm g, const Sched& S, const Epi& E) {
    const int tid = threadIdx.x, wid = __builtin_amdgcn_readfirstlane(tid >> 6), lane = tid & 63, wr = wid >> 2, wc = wid & 3, fr = lane & 15, fq = lane >> 4;
    const int K = g.K, nt = K / BK;
    unsigned voffA[2], voffB[2];
#pragma unroll
    for (int i = 0; i < 2; ++i) { int R, C; stage_rc(tid * 16 + i * 8192, R, C); const int Rb = Epi::PERM ? ((R & ~31) + perm32(R & 31)) : R;
        voffA[i] = (unsigned)(R * g.lda + C) * 2u; voffB[i] = (unsigned)(Rb * g.ldb + C) * 2u; }
    const size_t kstep = (size_t)(BK * 2);
    const size_t hstepA = (size_t)HALF * g.lda * 2, hstepB = (size_t)HALF * g.ldb * 2;
    const size_t tstepA = 2 * hstepA, tstepB = 2 * hstepB;
    const size_t pnA = (size_t)g.a_pn_koff * 2;
    const unsigned ldsw = (unsigned)wid * 1024u;
    const int aoff = lds_byte(wr * 64 + fr, fq * 8), boff = lds_byte(wc * 32 + fr, fq * 8);
#define PG8_SA(b, h) (((b) * 2 + (h)) * HTB)
#define PG8_SB(b, h) ((4 + (b) * 2 + (h)) * HTB)
#define PG8_STAGE(bufoff, gbase, voff) do { _Pragma("unroll") for (int _i = 0; _i < 2; ++_i) \
        __builtin_amdgcn_global_load_lds((const unsigned*)((const char*)(gbase) + (voff)[_i]), (PG8_LAS unsigned*)(lds + (bufoff) + ldsw + _i * 8192), 16, 0, 0); } while (0)
#define PG8_LDA(dst, b, h) do { _Pragma("unroll") for (int m = 0; m < 4; ++m) _Pragma("unroll") for (int k = 0; k < 2; ++k) dst[m][k] = *(const PG8_LAS bf16x8*)(lds + PG8_SA(b, h) + aoff + m * 2048 + k * 1024); } while (0)
#define PG8_LDB(dst, b, h) do { _Pragma("unroll") for (int n = 0; n < 2; ++n) _Pragma("unroll") for (int k = 0; k < 2; ++k) dst[n][k] = *(const PG8_LAS bf16x8*)(lds + PG8_SB(b, h) + boff + n * 2048 + k * 1024); } while (0)
#define PG8_MMA(ai, bj, At, Bt) do { __builtin_amdgcn_s_setprio(1); _Pragma("unroll") for (int m = 0; m < 4; ++m) _Pragma("unroll") for (int n = 0; n < 2; ++n) _Pragma("unroll") for (int k = 0; k < 2; ++k) \
        acc[ai][bj][m][n] = __builtin_amdgcn_mfma_f32_16x16x32_bf16(Bt[n][k], At[m][k], acc[ai][bj][m][n], 0, 0, 0); __builtin_amdgcn_s_setprio(0); } while (0)
#define PG8_WAIT_V(n) asm volatile("s_waitcnt vmcnt(" #n ")" ::: "memory")
#define PG8_WAIT_L(n) asm volatile("s_waitcnt lgkmcnt(" #n ")" ::: "memory")
#define PG8_BAR __builtin_amdgcn_s_barrier()
#define PG8_SCHED __builtin_amdgcn_sched_barrier(0)
    Unit cur, nxt; int ui = 0;
    if (!S.next(0, cur)) return;
    f32x4 acc[2][2][4][2];
#pragma unroll
    for (int a = 0; a < 2; ++a)
#pragma unroll
        for (int b = 0; b < 2; ++b)
#pragma unroll
            for (int m = 0; m < 4; ++m)
#pragma unroll
                for (int n = 0; n < 2; ++n) acc[a][b][m][n] = (f32x4){0.f, 0.f, 0.f, 0.f};
    bf16x8 At[4][2], B0[2][2], B1[2][2];
    const char* cA = (const char*)g.A + (size_t)cur.pm * tstepA + (size_t)cur.pn * pnA; const char* cB = (const char*)g.Bt + (size_t)cur.pn * tstepB;
    S.a_ready(cur);
    if constexpr (SP2) {
        PG8_STAGE(PG8_SB(0, 0), cB, voffB); PG8_STAGE(PG8_SB(0, 1), cB + hstepB, voffB); PG8_STAGE(PG8_SA(0, 0), cA, voffA); PG8_STAGE(PG8_SA(0, 1), cA + hstepA, voffA);
        if (wr == 1) PG8_BAR;
        PG8_WAIT_V(2); PG8_BAR;
        PG8_STAGE(PG8_SB(1, 0), cB + kstep, voffB); PG8_STAGE(PG8_SA(1, 0), cA + kstep, voffA); PG8_STAGE(PG8_SB(1, 1), cB + hstepB + kstep, voffB);
        PG8_WAIT_V(6); PG8_BAR;
    } else {
        PG8_STAGE(PG8_SB(0, 0), cB, voffB); PG8_STAGE(PG8_SA(0, 0), cA, voffA); PG8_STAGE(PG8_SB(0, 1), cB + hstepB, voffB); PG8_STAGE(PG8_SA(0, 1), cA + hstepA, voffA);
        if (wr == 1) PG8_BAR;
        PG8_WAIT_V(4); PG8_BAR;
        PG8_STAGE(PG8_SB(1, 0), cB + kstep, voffB); PG8_STAGE(PG8_SA(1, 0), cA + kstep, voffA); PG8_STAGE(PG8_SB(1, 1), cB + hstepB + kstep, voffB);
        PG8_WAIT_V(6); PG8_BAR;
    }
    for (;;) {
        const bool has_next = S.next(ui + 1, nxt);
        const char* nA = has_next ? (const char*)g.A + (size_t)nxt.pm * tstepA + (size_t)nxt.pn * pnA : cA; const char* nB = has_next ? (const char*)g.Bt + (size_t)nxt.pn * tstepB : cB;
        for (int t = 0; t < nt; t += 2) {
            const bool last = (t == nt - 2);
            const char* a1 = cA + (size_t)(t + 1) * kstep;
            const char* a2 = last ? nA : cA + (size_t)(t + 2) * kstep; const char* b2 = last ? nB : cB + (size_t)(t + 2) * kstep;
            const char* a3 = a2 + kstep; const char* b3 = b2 + kstep;
            if (last && has_next) S.a_ready(nxt);
            if constexpr (SP2) {
            PG8_LDB(B0, 0, 0); PG8_LDB(B1, 0, 1); PG8_SCHED; PG8_LDA(At, 0, 0); PG8_STAGE(PG8_SA(1, 1), a1 + hstepA, voffA);
            PG8_WAIT_V(8); PG8_WAIT_L(0); PG8_BAR; PG8_MMA(0, 0, At, B0); PG8_MMA(0, 1, At, B1); PG8_BAR; PG8_SCHED;
            PG8_LDA(At, 0, 1); PG8_STAGE(PG8_SB(0, 0), b2, voffB); PG8_STAGE(PG8_SB(0, 1), b2 + hstepB, voffB); PG8_STAGE(PG8_SA(0, 0), a2, voffA);
            PG8_WAIT_V(8); PG8_WAIT_L(0); PG8_BAR; PG8_MMA(1, 0, At, B0); PG8_MMA(1, 1, At, B1); PG8_BAR; PG8_SCHED;
            PG8_LDB(B0, 1, 0); PG8_LDB(B1, 1, 1); PG8_SCHED; PG8_LDA(At, 1, 0); PG8_STAGE(PG8_SA(0, 1), a2 + hstepA, voffA);
            PG8_WAIT_V(8); PG8_WAIT_L(0); PG8_BAR; PG8_MMA(0, 0, At, B0); PG8_MMA(0, 1, At, B1); PG8_BAR; PG8_SCHED;
            PG8_LDA(At, 1, 1); PG8_STAGE(PG8_SB(1, 0), b3, voffB); PG8_STAGE(PG8_SB(1, 1), b3 + hstepB, voffB); PG8_STAGE(PG8_SA(1, 0), a3, voffA);
            PG8_WAIT_V(8); PG8_WAIT_L(0); PG8_BAR; PG8_MMA(1, 0, At, B0); PG8_MMA(1, 1, At, B1); PG8_BAR; PG8_SCHED;
            } else {
            PG8_LDB(B0, 0, 0); PG8_SCHED; PG8_LDA(At, 0, 0); PG8_STAGE(PG8_SA(1, 1), a1 + hstepA, voffA);
            PG8_WAIT_L(8); PG8_BAR; PG8_WAIT_L(0); PG8_MMA(0, 0, At, B0); PG8_BAR; PG8_SCHED;
            PG8_LDB(B1, 0, 1); PG8_STAGE(PG8_SB(0, 0), b2, voffB);
            PG8_BAR; PG8_WAIT_L(0); PG8_MMA(0, 1, At, B1); PG8_BAR;
            PG8_LDA(At, 0, 1); PG8_STAGE(PG8_SA(0, 0), a2, voffA);
            PG8_BAR; PG8_WAIT_L(0); PG8_MMA(1, 0, At, B0); PG8_BAR; PG8_SCHED;
            PG8_STAGE(PG8_SB(0, 1), b2 + hstepB, voffB);
            PG8_WAIT_V(6); PG8_BAR; PG8_MMA(1, 1, At, B1); PG8_BAR;
            PG8_LDB(B0, 1, 0); PG8_SCHED; PG8_LDA(At, 1, 0); PG8_STAGE(PG8_SA(0, 1), a2 + hstepA, voffA);
            PG8_WAIT_L(8); PG8_BAR; PG8_WAIT_L(0); PG8_MMA(0, 0, At, B0); PG8_BAR; PG8_SCHED;
            PG8_LDB(B1, 1, 1); PG8_STAGE(PG8_SB(1, 0), b3, voffB);
            PG8_BAR; PG8_WAIT_L(0); PG8_MMA(0, 1, At, B1); PG8_BAR;
            PG8_LDA(At, 1, 1); PG8_STAGE(PG8_SA(1, 0), a3, voffA);
            PG8_BAR; PG8_WAIT_L(0); PG8_MMA(1, 0, At, B0); PG8_BAR; PG8_SCHED;
            PG8_STAGE(PG8_SB(1, 1), b3 + hstepB, voffB);
            PG8_WAIT_V(6); PG8_BAR; PG8_MMA(1, 1, At, B1); PG8_BAR;
            }
        }
        if constexpr (ALIGN_EPI) { if (wr == 0) PG8_BAR; }
        E(acc, cur, wr, wc, fr, fq); S.done(cur);
        if (!has_next) break;
#pragma unroll
        for (int a = 0; a < 2; ++a)
#pragma unroll
            for (int b = 0; b < 2; ++b)
#pragma unroll
                for (int m = 0; m < 4; ++m)
#pragma unroll
                    for (int n = 0; n < 2; ++n) acc[a][b][m][n] = (f32x4){0.f, 0.f, 0.f, 0.f};
        cur = nxt; cA = nA; cB = nB; ++ui;
        if constexpr (ALIGN_EPI) { if (wr == 1) PG8_BAR; }
    }
    PG8_WAIT_V(0);
    if constexpr (!ALIGN_EPI) { if (wr == 0) PG8_BAR; }
    PG8_BAR;
#undef PG8_SA
#undef PG8_SB
#undef PG8_STAGE
#undef PG8_LDA
#undef PG8_LDB
#undef PG8_MMA
#undef PG8_WAIT_V
#undef PG8_WAIT_L
#undef PG8_BAR
#undef PG8_SCHED
}
}

constexpr int NWAVES = 8, NTHR = NWAVES * 64;
constexpr int D = 1024, NBATCH = 4, T = 8192, M = NBATCH * T;
constexpr int A_W = 512, A_IN = 1792, IN_COLS = 3344, NP = 3584;
constexpr int C_R = 0, C_K = 512, C_V = 1024, C_WD = 1536, C_AD = 1600, C_GD = 1664;
constexpr int C_BQ = 1792, C_BK = 2048, C_BV = 2304, C_GKD = 2816, C_BG = 2832;
constexpr int NQ = 2048;
constexpr float LN_EPS = 1e-5f, GN_EPS = 64e-5f, RMS_EPS = 1e-5f;
constexpr float ALPHA = 1.189207115002721f;

typedef unsigned short bf16;
typedef float f32x4 __attribute__((ext_vector_type(4)));
typedef float f32x2 __attribute__((ext_vector_type(2)));
typedef unsigned u32x4 __attribute__((ext_vector_type(4)));
typedef unsigned u32x2 __attribute__((ext_vector_type(2)));
#define LAS __attribute__((address_space(3)))

constexpr size_t MiB = 1u << 20;
constexpr size_t WS_WIN = 1 * MiB, WS_WOUT = 8 * MiB, WS_WQ = 10 * MiB, WS_KBD = 14 * MiB;
constexpr size_t WS_W2T = 15 * MiB, WS_A2T = WS_W2T + 65536, WS_G2T = WS_A2T + 65536;
constexpr size_t WS_H0 = 16 * MiB;
constexpr size_t WS_P = 80 * MiB;
constexpr size_t WS_WL = 304 * MiB, WS_AA = 336 * MiB, WS_GG = 368 * MiB;
constexpr size_t WS_GK = 400 * MiB;
constexpr size_t WS_Z = 80 * MiB;
constexpr size_t WS_H1 = 208 * MiB;
constexpr size_t WS_Q = 272 * MiB;
constexpr size_t WS_S = 80 * MiB;
constexpr size_t WS_IDS = 400 * MiB, WS_GATES = 416 * MiB;
constexpr size_t WS_UT = 432 * MiB, WS_VT = 448 * MiB;
constexpr int ROWB = 768;
constexpr size_t WS_SU = 464 * MiB, WS_SV = 465 * MiB;
constexpr size_t WS_UF = WS_UT; constexpr size_t UF_SLICE = (size_t)16384 * 128;
constexpr size_t WS_H8 = 272 * MiB;
constexpr size_t WS_PD = 80 * MiB;
constexpr size_t WS_V8 = WS_VT; constexpr size_t V8_SLICE = (size_t)16384 * 128;
constexpr size_t WS_CQ = 336 * MiB;
constexpr size_t WS_CS = 344 * MiB;
constexpr size_t WS_ZP = 80 * MiB;
constexpr int NSEG = 16, LSEG = 8192 / NSEG;
constexpr size_t WS_YI = WS_WL;
constexpr size_t WS_YIG = WS_GK;
constexpr size_t WS_SER = 480 * MiB;
constexpr size_t WS_SEG = 496 * MiB;
constexpr size_t WS_CEND = 504 * MiB;
constexpr size_t WS_END = 505 * MiB;

constexpr int LDS_BYTES = 163840, LDS_MISC = LDS_BYTES - 256;
constexpr size_t WS_CTL = 0, CTL_BYTES = 16384;

struct Params {
    const float* in[28];
    float* out; unsigned char* ws;
    int ph_lo, ph_hi;
};

__device__ __forceinline__ float bf2f(unsigned u) { return __uint_as_float(u << 16); }
typedef float f32x2c_t __attribute__((ext_vector_type(2))); typedef __bf16 bf16x2c_t __attribute__((ext_vector_type(2)));
__device__ __forceinline__ unsigned pk2(float lo, float hi) { const f32x2c_t v = {lo, hi}; const bf16x2c_t b = __builtin_convertvector(v, bf16x2c_t); return __builtin_bit_cast(unsigned, b); }
__device__ __forceinline__ unsigned f2bf(float f) { return pk2(f, 0.f) & 0xffffu; }
#define DPP_F(v, ctrl) __builtin_bit_cast(float, __builtin_amdgcn_update_dpp(0, __builtin_bit_cast(int, (v)), (ctrl), 0xf, 0xf, false))
#define DPP_ADD(v, ctrl) ((v) + DPP_F(v, ctrl))
__device__ __forceinline__ float rlf(float v, int l) { return __builtin_bit_cast(float, __builtin_amdgcn_readlane(__builtin_bit_cast(int, v), l)); }
__device__ __forceinline__ float wave_sum_u(float v) {
    v = DPP_ADD(v, 0xB1); v = DPP_ADD(v, 0x4E); v = DPP_ADD(v, 0x141); v = DPP_ADD(v, 0x140);
    return (rlf(v, 0) + rlf(v, 16)) + (rlf(v, 32) + rlf(v, 48));
}
__device__ __forceinline__ float wave_sum(float v) { return wave_sum_u(v); }
#define DPP_I(v, ctrl) __builtin_amdgcn_update_dpp(0, (v), (ctrl), 0xf, 0xf, false)
__device__ __forceinline__ int wave_sum_i(int v) {
    v += DPP_I(v, 0xB1); v += DPP_I(v, 0x4E); v += DPP_I(v, 0x141); v += DPP_I(v, 0x140);
    return (__builtin_amdgcn_readlane(v, 0) + __builtin_amdgcn_readlane(v, 16)) + (__builtin_amdgcn_readlane(v, 32) + __builtin_amdgcn_readlane(v, 48));
}
__device__ __forceinline__ float wave_max_u(float v) {
    v = fmaxf(v, DPP_F(v, 0xB1)); v = fmaxf(v, DPP_F(v, 0x4E)); v = fmaxf(v, DPP_F(v, 0x141)); v = fmaxf(v, DPP_F(v, 0x140));
    return fmaxf(fmaxf(rlf(v, 0), rlf(v, 16)), fmaxf(rlf(v, 32), rlf(v, 48)));
}
__device__ __forceinline__ unsigned pack_i8(float a, float b, float c, float d, float inv, int off) {
    const int q0 = __float2int_rn(a * inv) + off, q1 = __float2int_rn(b * inv) + off, q2 = __float2int_rn(c * inv) + off, q3 = __float2int_rn(d * inv) + off;
    return (unsigned)(q0 & 0xff) | ((unsigned)(q1 & 0xff) << 8) | ((unsigned)(q2 & 0xff) << 16) | ((unsigned)(q3 & 0xff) << 24);
}
__device__ __forceinline__ float sigmoidf_(float x) { return 1.f / (1.f + __expf(-x)); }
__device__ __forceinline__ float siluf_(float x) { return x * sigmoidf_(x); }

__device__ __forceinline__ void transpose_convert(const float* W, int K, int N, int Npad, bf16* WT, int gtid, int gthreads) {
    const int kc = K / 8, total = Npad * kc;
    for (int idx = gtid; idx < total; idx += gthreads) {
        const int n = idx % Npad, c = idx / Npad; float v[8];
#pragma unroll
        for (int j = 0; j < 8; ++j) v[j] = (n < N) ? W[(size_t)(8 * c + j) * N + n] : 0.f;
        u32x4 o; o.x = pk2(v[0], v[1]); o.y = pk2(v[2], v[3]); o.z = pk2(v[4], v[5]); o.w = pk2(v[6], v[7]);
        *(u32x4*)(WT + (size_t)n * K + 8 * c) = o;
    }
}
__device__ __forceinline__ void ln_row_bf16(const float* xrow, const float* g, const float* b, bf16* orow, int lane) {
    const f32x4* xr = (const f32x4*)xrow + lane; f32x4 v[4]; float s = 0.f;
#pragma unroll
    for (int j = 0; j < 4; ++j) { v[j] = xr[64 * j]; s += (v[j][0] + v[j][1]) + (v[j][2] + v[j][3]); }
    const float mean = wave_sum(s) * (1.f / D); float s2 = 0.f;
#pragma unroll
    for (int j = 0; j < 4; ++j) { v[j] = v[j] - mean; s2 += (v[j][0] * v[j][0] + v[j][1] * v[j][1]) + (v[j][2] * v[j][2] + v[j][3] * v[j][3]); }
    const float rstd = 1.f / sqrtf(wave_sum(s2) * (1.f / D) + LN_EPS);
    u32x2* o8 = (u32x2*)orow + lane;
#pragma unroll
    for (int j = 0; j < 4; ++j) { const f32x4 gg = ((const f32x4*)g)[lane + 64 * j], bb = ((const f32x4*)b)[lane + 64 * j]; const f32x4 y = v[j] * rstd * gg + bb;
        u32x2 w; w.x = pk2(y[0], y[1]); w.y = pk2(y[2], y[3]); o8[64 * j] = w; }
}
template <bool F8>
__device__ __forceinline__ void ln_rowb_bf16(const bf16* xrow, const float* g, const float* b, bf16* orow, int lane, unsigned char* f8row = nullptr) {
    const u32x4* xr = (const u32x4*)xrow + 2 * lane; const u32x4 a = xr[0], c = xr[1]; float v[16]; float s = 0.f;
#pragma unroll
    for (int i = 0; i < 4; ++i) { v[2 * i] = __uint_as_float(a[i] << 16); v[2 * i + 1] = __uint_as_float(a[i] & 0xffff0000u); v[8 + 2 * i] = __uint_as_float(c[i] << 16); v[8 + 2 * i + 1] = __uint_as_float(c[i] & 0xffff0000u); }
#pragma unroll
    for (int i = 0; i < 16; ++i) s += v[i];
    const float mean = wave_sum(s) * (1.f / D); float s2 = 0.f;
#pragma unroll
    for (int i = 0; i < 16; ++i) { v[i] -= mean; s2 += v[i] * v[i]; }
    const float rstd = 1.f / sqrtf(wave_sum(s2) * (1.f / D) + LN_EPS);
    u32x4 o0, o1;
#pragma unroll
    for (int q = 0; q < 4; ++q) { const f32x4 gg = *(const f32x4*)(g + 16 * lane + 4 * q), bb = *(const f32x4*)(b + 16 * lane + 4 * q);
#pragma unroll
        for (int j = 0; j < 4; ++j) v[4 * q + j] = v[4 * q + j] * rstd * gg[j] + bb[j];
        const unsigned lo = pk2(v[4 * q], v[4 * q + 1]), hi = pk2(v[4 * q + 2], v[4 * q + 3]);
        if (q < 2) { o0[2 * q] = lo; o0[2 * q + 1] = hi; } else { o1[2 * q - 4] = lo; o1[2 * q - 3] = hi; } }
    u32x4* op = (u32x4*)orow + 2 * lane; op[0] = o0; op[1] = o1;
    if (F8) {
        u32x4 h8, l8;
#pragma unroll
        for (int q = 0; q < 4; ++q) {
            int ph = __builtin_amdgcn_cvt_pk_fp8_f32(v[4 * q], v[4 * q + 1], 0, false); ph = __builtin_amdgcn_cvt_pk_fp8_f32(v[4 * q + 2], v[4 * q + 3], ph, true);
            const float r0 = v[4 * q] - __builtin_amdgcn_cvt_f32_fp8(ph, 0), r1 = v[4 * q + 1] - __builtin_amdgcn_cvt_f32_fp8(ph, 1);
            const float r2 = v[4 * q + 2] - __builtin_amdgcn_cvt_f32_fp8(ph, 2), r3 = v[4 * q + 3] - __builtin_amdgcn_cvt_f32_fp8(ph, 3);
            int pl = __builtin_amdgcn_cvt_pk_fp8_f32(r0, r1, 0, false); pl = __builtin_amdgcn_cvt_pk_fp8_f32(r2, r3, pl, true);
            h8[q] = (unsigned)ph; l8[q] = (unsigned)pl; }
        *((u32x4*)f8row + lane) = h8; *((u32x4*)(f8row + 1024) + lane) = l8;
    }
}
__device__ __forceinline__ void fold_keys(const Params& P, LAS unsigned char* lds, int bi, int nb) {
    const int tid = threadIdx.x; unsigned char* ws = P.ws;
    {
        const float* Wq = P.in[22]; const float* keys = P.in[23]; bf16* WqkT = (bf16*)(ws + WS_WQ);
        LAS float* WQs = (LAS float*)lds; LAS float* KYs = WQs + 64 * 132;
        for (int item = bi; item < 256; item += nb) {
            const int hh = item >> 4, kt = item & 15;
            __syncthreads();
            for (int i = tid; i < 64 * 32; i += NTHR) { const int r = i >> 5, c4 = (i & 31) * 4; *(LAS f32x4*)(WQs + r * 132 + c4) = *(const f32x4*)(Wq + (size_t)(kt * 64 + r) * NQ + hh * 128 + c4); }
            for (int i = tid; i < 128 * 32; i += NTHR) { const int r = i >> 5, c4 = (i & 31) * 4; *(LAS f32x4*)(KYs + r * 132 + c4) = *(const f32x4*)(keys + (size_t)(hh * 128 + r) * 128 + c4); }
            __syncthreads();
            const int key = tid & 127, kg = tid >> 7; float acc[16];
#pragma unroll
            for (int j = 0; j < 16; ++j) acc[j] = 0.f;
            for (int c4 = 0; c4 < 32; ++c4) { const f32x4 kv = *(const LAS f32x4*)(KYs + key * 132 + 4 * c4);
#pragma unroll
                for (int j = 0; j < 16; ++j) { const f32x4 w = *(const LAS f32x4*)(WQs + (kg * 16 + j) * 132 + 4 * c4); acc[j] += (w[0] * kv[0] + w[1] * kv[1]) + (w[2] * kv[2] + w[3] * kv[3]); } }
            u32x4 o0, o1;
#pragma unroll
            for (int q = 0; q < 4; ++q) { o0[q] = pk2(acc[2 * q], acc[2 * q + 1]); o1[q] = pk2(acc[8 + 2 * q], acc[8 + 2 * q + 1]); }
            u32x4* dst = (u32x4*)(WqkT + (size_t)(hh * 128 + key) * D + kt * 64 + kg * 16); dst[0] = o0; dst[1] = o1;
        }
    }
}
__device__ __forceinline__ void phase_prologue(const Params& P, LAS unsigned char* lds) {
    const int tid = threadIdx.x, lane = tid & 63, wave = tid >> 6;
    const int gtid = blockIdx.x * NTHR + tid, gthreads = gridDim.x * NTHR;
    unsigned char* ws = P.ws;
    transpose_convert(P.in[3], D, IN_COLS, NP, (bf16*)(ws + WS_WIN), gtid, gthreads);
    transpose_convert(P.in[6], 64, A_W, A_W, (bf16*)(ws + WS_W2T), gtid, gthreads);
    transpose_convert(P.in[8], 64, A_W, A_W, (bf16*)(ws + WS_A2T), gtid, gthreads);
    transpose_convert(P.in[9], 128, A_W, A_W, (bf16*)(ws + WS_G2T), gtid, gthreads);
    const int gw = blockIdx.x * NWAVES + wave, ngw = gridDim.x * NWAVES;
    for (int m = gw; m < M; m += ngw) ln_row_bf16(P.in[0] + (size_t)m * D, P.in[1], P.in[2], (bf16*)(ws + WS_H0) + (size_t)m * D, lane);
}

typedef short bf16x8_t __attribute__((ext_vector_type(8)));
template <int KS, int LDA>
__device__ __forceinline__ void lora_mm(f32x4 (&acc)[4][4], const LAS bf16* ACT, const bf16* WT, int c0, int fr, int fq) {
#pragma unroll
    for (int mt = 0; mt < 4; ++mt)
#pragma unroll
        for (int nt = 0; nt < 4; ++nt) acc[mt][nt] = (f32x4){0.f, 0.f, 0.f, 0.f};
#pragma unroll
    for (int s = 0; s < KS; ++s) {
        bf16x8_t af[4], bfr[4];
#pragma unroll
        for (int mt = 0; mt < 4; ++mt) af[mt] = *(const LAS bf16x8_t*)(ACT + (mt * 16 + fr) * LDA + 32 * s + 8 * fq);
#pragma unroll
        for (int nt = 0; nt < 4; ++nt) bfr[nt] = *(const bf16x8_t*)(WT + (size_t)(c0 + nt * 16 + fr) * (32 * KS) + 32 * s + 8 * fq);
#pragma unroll
        for (int mt = 0; mt < 4; ++mt)
#pragma unroll
            for (int nt = 0; nt < 4; ++nt) acc[mt][nt] = __builtin_amdgcn_mfma_f32_16x16x32_bf16(bfr[nt], af[mt], acc[mt][nt], 0, 0, 0);
    }
}
__device__ __forceinline__ void phase_prep(const Params& P, LAS unsigned char* lds) {
    const int tid = threadIdx.x, lane = tid & 63, wave = __builtin_amdgcn_readfirstlane(tid >> 6), fr = lane & 15, fq = lane >> 4;
    unsigned char* ws = P.ws;
    const bf16* p = (const bf16*)(ws + WS_P);
    const float* mu = P.in[4]; const float* w0 = P.in[5]; const float* a0 = P.in[7];
    const float* gkw2 = P.in[16]; const float* gkb = P.in[17];
    const bf16* W2T = (const bf16*)(ws + WS_W2T); const bf16* A2T = (const bf16*)(ws + WS_A2T); const bf16* G2T = (const bf16*)(ws + WS_G2T);
    bf16* WL = (bf16*)(ws + WS_WL); bf16* AA = (bf16*)(ws + WS_AA); bf16* GG = (bf16*)(ws + WS_GG); bf16* GK = (bf16*)(ws + WS_GK);
    LAS bf16* TW = (LAS bf16*)lds; LAS bf16* AD = TW + 64 * 72; LAS bf16* SG = AD + 64 * 72;
    LAS float* gkd = (LAS float*)(SG + 64 * 136);
    const int c0 = wave * 64;
    for (int tile = blockIdx.x; tile < M / 64; tile += gridDim.x) {
        const int m0 = tile * 64;
        __syncthreads();
        for (int idx = tid; idx < 64 * 32; idx += NTHR) {
            const int j = (idx & 31) * 8, tok = idx >> 5, m = m0 + tok, t = m & (T - 1);
            const u32x4 cw = *(const u32x4*)(p + (size_t)m * NP + C_WD + j); const u32x4 pw = (t > 0) ? *(const u32x4*)(p + (size_t)(m - 1) * NP + C_WD + j) : (u32x4){0u, 0u, 0u, 0u};
            const f32x4 m0v = *(const f32x4*)(mu + C_WD + j), m1v = *(const f32x4*)(mu + C_WD + j + 4);
            float x[8];
#pragma unroll
            for (int i = 0; i < 4; ++i) { const float c0 = __uint_as_float(cw[i] << 16), c1 = __uint_as_float(cw[i] & 0xffff0000u), q0 = __uint_as_float(pw[i] << 16), q1 = __uint_as_float(pw[i] & 0xffff0000u);
                const float mu0 = i < 2 ? m0v[2 * i] : m1v[2 * i - 4], mu1 = i < 2 ? m0v[2 * i + 1] : m1v[2 * i - 3];
                x[2 * i] = c0 + (q0 - c0) * mu0; x[2 * i + 1] = c1 + (q1 - c1) * mu1; }
            u32x4 o;
            if (j < 64) {
#pragma unroll
                for (int i = 0; i < 4; ++i) o[i] = pk2(1.f - 2.f * __builtin_amdgcn_rcpf(1.f + __expf(2.f * x[2 * i])), 1.f - 2.f * __builtin_amdgcn_rcpf(1.f + __expf(2.f * x[2 * i + 1])));
                *(LAS u32x4*)(TW + tok * 72 + j) = o;
            } else if (j < 128) {
#pragma unroll
                for (int i = 0; i < 4; ++i) o[i] = pk2(x[2 * i], x[2 * i + 1]);
                *(LAS u32x4*)(AD + tok * 72 + j - 64) = o;
            } else {
#pragma unroll
                for (int i = 0; i < 4; ++i) o[i] = pk2(sigmoidf_(x[2 * i]), sigmoidf_(x[2 * i + 1]));
                *(LAS u32x4*)(SG + tok * 136 + j - 128) = o;
            }
        }
        for (int idx = tid; idx < 64 * 16; idx += NTHR) { const int j = idx & 15, tok = idx >> 4; gkd[tok * 16 + j] = bf2f(p[(size_t)(m0 + tok) * NP + C_GKD + j]); }
        __syncthreads();
        f32x4 acc[4][4];
        lora_mm<2, 72>(acc, TW, W2T, c0, fr, fq);
#pragma unroll
        for (int nt = 0; nt < 4; ++nt) { const int c = c0 + nt * 16 + 4 * fq; const f32x4 b = *(const f32x4*)(w0 + c);
#pragma unroll
            for (int mt = 0; mt < 4; ++mt) { float o[4];
#pragma unroll
                for (int i = 0; i < 4; ++i) { const float z = b[i] + acc[mt][nt][i]; o[i] = -0.6065306597126334f * sigmoidf_(z); }
                u32x2 w; w.x = pk2(o[0], o[1]); w.y = pk2(o[2], o[3]); *(u32x2*)(WL + (size_t)(m0 + mt * 16 + fr) * A_W + c) = w; } }
        lora_mm<2, 72>(acc, AD, A2T, c0, fr, fq);
#pragma unroll
        for (int nt = 0; nt < 4; ++nt) { const int c = c0 + nt * 16 + 4 * fq; const f32x4 b = *(const f32x4*)(a0 + c);
#pragma unroll
            for (int mt = 0; mt < 4; ++mt) { float o[4];
#pragma unroll
                for (int i = 0; i < 4; ++i) o[i] = sigmoidf_(b[i] + acc[mt][nt][i]);
                u32x2 w; w.x = pk2(o[0], o[1]); w.y = pk2(o[2], o[3]); *(u32x2*)(AA + (size_t)(m0 + mt * 16 + fr) * A_W + c) = w; } }
        lora_mm<4, 136>(acc, SG, G2T, c0, fr, fq);
#pragma unroll
        for (int nt = 0; nt < 4; ++nt) { const int c = c0 + nt * 16 + 4 * fq;
#pragma unroll
            for (int mt = 0; mt < 4; ++mt) { u32x2 w; w.x = pk2(acc[mt][nt][0], acc[mt][nt][1]); w.y = pk2(acc[mt][nt][2], acc[mt][nt][3]); *(u32x2*)(GG + (size_t)(m0 + mt * 16 + fr) * A_W + c) = w; } }
        { const int cc = tid & 255, th = tid >> 8; float wv[16];
#pragma unroll
          for (int j = 0; j < 16; ++j) wv[j] = gkw2[j * 256 + cc];
          const float bb = gkb[cc];
          for (int i = 0; i < 32; ++i) { const int tok = th * 32 + i; float sacc = bb;
#pragma unroll
              for (int j = 0; j < 16; ++j) sacc += gkd[tok * 16 + j] * wv[j];
              GK[(size_t)(m0 + tok) * 256 + cc] = (bf16)f2bf(-(fmaxf(-sacc, 0.f) + __logf(1.f + __expf(-fabsf(sacc)))) * (1.f / 16.f)); } }
    }
}

constexpr int CH = 32;
__device__ __forceinline__ float red8(float v) { v = DPP_ADD(v, 0xB1); v = DPP_ADD(v, 0x4E); v = DPP_ADD(v, 0x141); return v; }

constexpr int RW_BUF = 6 * CH * 64;
__device__ __forceinline__ void rw_load(const bf16* p, const bf16* AA, const bf16* WL, int b, int t0, int col, int wave,
        unsigned (&rc)[4], unsigned (&kc)[4], unsigned (&vc)[4], unsigned (&rp)[4], unsigned (&kp)[4], unsigned (&vp)[4], unsigned (&a)[4], unsigned (&wl)[4]) {
#pragma unroll
    for (int q = 0; q < 4; ++q) {
        const int t = t0 + wave + 8 * q; const size_t m = (size_t)b * T + t; const bf16* pr = p + m * NP; const bf16* pp = (t > 0) ? pr - NP : pr;
        rc[q] = pr[C_R + col]; kc[q] = pr[C_K + col]; vc[q] = pr[C_V + col]; rp[q] = pp[C_R + col]; kp[q] = pp[C_K + col]; vp[q] = pp[C_V + col];
        a[q] = AA[m * A_W + col]; wl[q] = WL[m * A_W + col];
    }
}
__device__ __forceinline__ void rw_prep(LAS float* B, int t0, int wave, int lane, float mu_r, float mu_k, float mu_v, float kkc, float kac,
        const unsigned (&rc_)[4], const unsigned (&kc_)[4], const unsigned (&vc_)[4], const unsigned (&rp_)[4], const unsigned (&kp_)[4], const unsigned (&vp_)[4], const unsigned (&a_)[4], const unsigned (&wl_)[4]) {
    LAS float* R = B; LAS float* DEC = R + CH * 64; LAS float* KH = DEC + CH * 64; LAS float* KK = KH + CH * 64; LAS float* BB = KK + CH * 64; LAS float* V = BB + CH * 64;
#pragma unroll
    for (int q = 0; q < 4; ++q) {
        const int tt = wave + 8 * q; const float hp = (t0 + tt > 0) ? 1.f : 0.f;
        const float rc = bf2f(rc_[q]), kc = bf2f(kc_[q]), vc = bf2f(vc_[q]), rp = bf2f(rp_[q]) * hp, kp = bf2f(kp_[q]) * hp, vp = bf2f(vp_[q]) * hp;
        const float r = rc + (rp - rc) * mu_r, k = kc + (kp - kc) * mu_k, v = vc + (vp - vc) * mu_v;
        const float a = bf2f(a_[q]), wl = bf2f(wl_[q]);
        const float kr = k * kkc; const float nrm = sqrtf(wave_sum(kr * kr)); const float kk = kr / fmaxf(nrm, 1e-12f);
        const float kh = k * (1.f + (a - 1.f) * kac);
        R[tt * 64 + lane] = r; DEC[tt * 64 + lane] = __expf(wl); KH[tt * 64 + lane] = kh; KK[tt * 64 + lane] = kk; BB[tt * 64 + lane] = kk * a; V[tt * 64 + lane] = v;
    }
}
struct RwOps { f32x4 k0, k1, d0, d1, b0, b1, h0, h1, q0, q1; float v0, v1; };
__device__ __forceinline__ void rw_ops_load(RwOps& o, const LAS float* B, int tt, int s8, int vr0) {
    const LAS float* R = B; const LAS float* DEC = R + CH * 64; const LAS float* KH = DEC + CH * 64; const LAS float* KK = KH + CH * 64; const LAS float* BB = KK + CH * 64; const LAS float* V = BB + CH * 64;
    o.k0 = *(const LAS f32x4*)(KK + tt * 64 + s8); o.k1 = *(const LAS f32x4*)(KK + tt * 64 + s8 + 4);
    o.d0 = *(const LAS f32x4*)(DEC + tt * 64 + s8); o.d1 = *(const LAS f32x4*)(DEC + tt * 64 + s8 + 4);
    o.b0 = *(const LAS f32x4*)(BB + tt * 64 + s8); o.b1 = *(const LAS f32x4*)(BB + tt * 64 + s8 + 4);
    o.h0 = *(const LAS f32x4*)(KH + tt * 64 + s8); o.h1 = *(const LAS f32x4*)(KH + tt * 64 + s8 + 4);
    o.q0 = *(const LAS f32x4*)(R + tt * 64 + s8); o.q1 = *(const LAS f32x4*)(R + tt * 64 + s8 + 4);
    o.v0 = V[tt * 64 + vr0]; o.v1 = V[tt * 64 + vr0 + 1];
}
template <bool IDENT> __device__ __forceinline__ void rw_step(const RwOps& o, f32x2 (&S0)[4], f32x2 (&S1)[4], LAS float* Y, int tt, int r0, int lane) {
    const float vv0 = o.v0, vv1 = o.v1;
    const f32x2 kk[4] = {o.k0.lo, o.k0.hi, o.k1.lo, o.k1.hi}, dd[4] = {o.d0.lo, o.d0.hi, o.d1.lo, o.d1.hi}, bb[4] = {o.b0.lo, o.b0.hi, o.b1.lo, o.b1.hi}, hh[4] = {o.h0.lo, o.h0.hi, o.h1.lo, o.h1.hi}, rr[4] = {o.q0.lo, o.q0.hi, o.q1.lo, o.q1.hi};
    f32x2 a0 = S0[0] * kk[0], a1 = S1[0] * kk[0];
#pragma unroll
    for (int i = 1; i < 4; ++i) { a0 = S0[i] * kk[i] + a0; a1 = S1[i] * kk[i] + a1; }
    const float sa0 = -red8(a0.x + a0.y), sa1 = -red8(a1.x + a1.y);
    f32x2 y0 = (f32x2){0.f, 0.f}, y1 = (f32x2){0.f, 0.f};
#pragma unroll
    for (int i = 0; i < 4; ++i) {
        if (IDENT) { S0[i] = bb[i] * sa0 + S0[i] * dd[i]; S1[i] = bb[i] * sa1 + S1[i] * dd[i]; }
        else { S0[i] = hh[i] * vv0 + (bb[i] * sa0 + S0[i] * dd[i]); S1[i] = hh[i] * vv1 + (bb[i] * sa1 + S1[i] * dd[i]); }
        y0 = S0[i] * rr[i] + y0; y1 = S1[i] * rr[i] + y1;
    }
    const float yy0 = red8(y0.x + y0.y), yy1 = red8(y1.x + y1.y);
    if ((lane & 7) == 0) { Y[tt * 128 + r0] = yy0; Y[tt * 128 + r0 + 1] = yy1; }
}
__device__ __forceinline__ void rwkv_item(const Params& P, LAS unsigned char* lds, int b, int h, int seg) {
    const int tid = threadIdx.x, lane = tid & 63, wave = tid >> 6;
    unsigned char* ws = P.ws;
    const bf16* p = (const bf16*)(ws + WS_P); const bf16* WL = (const bf16*)(ws + WS_WL); const bf16* AA = (const bf16*)(ws + WS_AA);
    bf16* MIX = (bf16*)P.out; bf16* YI = (bf16*)(ws + WS_YI);
    const float* mu = P.in[4]; const float* k_k = P.in[10]; const float* k_a = P.in[11];
    LAS float* BUF = (LAS float*)lds; LAS float* Y = BUF + 2 * RW_BUF;
    const int col = h * 64 + lane;
    const float mu_r = mu[C_R + col], mu_k = mu[C_K + col], mu_v = mu[C_V + col], kkc = k_k[col], kac = k_a[col];
    const int r0 = wave * 16 + 2 * (lane >> 3), s8 = (lane & 7) * 8; const int ident = r0 >> 6, vr0 = r0 & 63, vr1 = vr0 + 1;
    float* SE = (float*)(ws + WS_SER) + ((((size_t)(b * 8 + h) * NSEG + seg) * 2 + ident) * 4096) + vr0 * 64 + s8;
    f32x2 S0[4], S1[4];
#pragma unroll
    for (int i = 0; i < 4; ++i) { S0[i] = (f32x2){(ident && (s8 + 2 * i == vr0)) ? 1.f : 0.f, (ident && (s8 + 2 * i + 1 == vr0)) ? 1.f : 0.f};
        S1[i] = (f32x2){(ident && (s8 + 2 * i == vr1)) ? 1.f : 0.f, (ident && (s8 + 2 * i + 1 == vr1)) ? 1.f : 0.f}; }
    const int tbeg = seg * LSEG;
    unsigned rc[4], kc[4], vc[4], rp[4], kp[4], vp[4], a[4], wl[4];
    __syncthreads();
    rw_load(p, AA, WL, b, tbeg, col, wave, rc, kc, vc, rp, kp, vp, a, wl);
    rw_prep(BUF, tbeg, wave, lane, mu_r, mu_k, mu_v, kkc, kac, rc, kc, vc, rp, kp, vp, a, wl);
    __syncthreads();
    for (int ci = 0; ci < LSEG / CH; ++ci) {
        const int t0 = tbeg + ci * CH; LAS float* B = BUF + (ci & 1) * RW_BUF;
        LAS float* R = B; LAS float* DEC = R + CH * 64; LAS float* KH = DEC + CH * 64; LAS float* KK = KH + CH * 64; LAS float* BB = KK + CH * 64; LAS float* V = BB + CH * 64;
        const bool more = (ci + 1 < LSEG / CH);
        if (more) rw_load(p, AA, WL, b, t0 + CH, col, wave, rc, kc, vc, rp, kp, vp, a, wl);
        { RwOps oa, ob; rw_ops_load(oa, B, 0, s8, vr0);
          if (ident) for (int tt = 0; tt < CH; tt += 2) {
              rw_ops_load(ob, B, tt + 1, s8, vr0); rw_step<true>(oa, S0, S1, Y, tt, r0, lane);
              rw_ops_load(oa, B, (tt + 2) & (CH - 1), s8, vr0); rw_step<true>(ob, S0, S1, Y, tt + 1, r0, lane);
          } else for (int tt = 0; tt < CH; tt += 2) {
              rw_ops_load(ob, B, tt + 1, s8, vr0); rw_step<false>(oa, S0, S1, Y, tt, r0, lane);
              rw_ops_load(oa, B, (tt + 2) & (CH - 1), s8, vr0); rw_step<false>(ob, S0, S1, Y, tt + 1, r0, lane);
          } }
        __syncthreads();
        if (more) rw_prep(BUF + ((ci + 1) & 1) * RW_BUF, t0 + CH, wave, lane, mu_r, mu_k, mu_v, kkc, kac, rc, kc, vc, rp, kp, vp, a, wl);
#pragma unroll
        for (int q = 0; q < 4; ++q) {
            const int tt = wave + 8 * q; const size_t m = (size_t)b * T + t0 + tt;
            MIX[m * D + col] = (bf16)f2bf(Y[tt * 128 + lane]); YI[m * 512 + col] = (bf16)f2bf(Y[tt * 128 + 64 + lane]);
        }
        __syncthreads();
    }
    *(f32x4*)(SE) = (f32x4){S0[0].x, S0[0].y, S0[1].x, S0[1].y}; *(f32x4*)(SE + 4) = (f32x4){S0[2].x, S0[2].y, S0[3].x, S0[3].y};
    *(f32x4*)(SE + 64) = (f32x4){S1[0].x, S1[0].y, S1[1].x, S1[1].y}; *(f32x4*)(SE + 68) = (f32x4){S1[2].x, S1[2].y, S1[3].x, S1[3].y};
}

constexpr int W_AT = 0, W_BT = 4608, W_KT = 9216, W_LAK = 13824, W_L1 = 0, W_LT1 = 4608, W_X1 = 9216, W_RT = 18432, W_BTT = 23040, W_KTT = 27648, W_VTT = 32256, W_X0 = 36864,
              W_L0 = 46080, W_LT0 = 50688, W_QT = 46080, W_TT = 50688, W_LRB = 55296, W_LRK = 59904, W_SIM = 64512, W_PIM = 69120, W_END = 73728, W_MI = 0;
__device__ __forceinline__ bf16x8_t lfrag(const LAS bf16* base, int row, int sx, int fq) { return *(const LAS bf16x8_t*)(base + row * 72 + 32 * sx + 8 * fq); }
#define MFMA16(a, b, c) __builtin_amdgcn_mfma_f32_16x16x32_bf16((a), (b), (c), 0, 0, 0)
typedef short bf16x4_t __attribute__((ext_vector_type(4)));
#define MFMA16K(a, b, c) __builtin_amdgcn_mfma_f32_16x16x16bf16_1k((a), (b), (c), 0, 0, 0)
__device__ __forceinline__ bf16x4_t pack4(const f32x4 v) { u32x2 w; w.x = pk2(v[0], v[1]); w.y = pk2(v[2], v[3]); return __builtin_bit_cast(bf16x4_t, w); }
__device__ __forceinline__ void st4(LAS bf16* dst, float a, float b, float c, float d) { u32x2 w; w.x = pk2(a, b); w.y = pk2(c, d); *(LAS u32x2*)dst = w; }
__device__ __forceinline__ f32x4 ld4(const LAS bf16* src) { const u32x2 w = *(const LAS u32x2*)src; return (f32x4){__uint_as_float(w.x << 16), __uint_as_float(w.x & 0xffff0000u), __uint_as_float(w.y << 16), __uint_as_float(w.y & 0xffff0000u)}; }
__device__ __forceinline__ void rwkv_item_chunked(const Params& P, LAS unsigned char* lds, int b, int h, int seg) {
    const int tid = threadIdx.x, lane = tid & 63, wave = __builtin_amdgcn_readfirstlane(tid >> 6), fr = lane & 15, fq = lane >> 4;
    unsigned char* ws = P.ws;
    const bf16* p = (const bf16*)(ws + WS_P); const bf16* WL = (const bf16*)(ws + WS_WL); const bf16* AA = (const bf16*)(ws + WS_AA);
    bf16* MIX = (bf16*)P.out; bf16* YI = (bf16*)(ws + WS_YI);
    const float* mu = P.in[4]; const float* k_k = P.in[10]; const float* k_a = P.in[11];
    LAS bf16* L = (LAS bf16*)lds;
    LAS float* GAM = (LAS float*)(lds + W_END * 2); LAS float* TOT = GAM + 64;
    const int col = h * 64 + lane, tg = wave;
    const float mu_r = mu[C_R + col], mu_k = mu[C_K + col], mu_v = mu[C_V + col], kkc = k_k[col], kac = k_a[col];
    const bool ident = wave >= 4; const int w4 = wave & 3;
    f32x4 Wreg[4];
#pragma unroll
    for (int k = 0; k < 4; ++k) Wreg[k] = (f32x4){0.f, 0.f, 0.f, 0.f};
    __syncthreads();
    for (int i = tid; i < 2 * 64 * 72 / 2; i += NTHR) ((LAS unsigned*)(L + W_SIM))[i] = 0u;
    __syncthreads();
    if (tid < 64) L[W_PIM + tid * 72 + tid] = (bf16)0x3F80;
    unsigned nr_[9], nk_[9], nv_[9], na_[8], nw_[8];
    { const int t0 = seg * LSEG;
#pragma unroll
      for (int r = 0; r < 9; ++r) { const int t = t0 + 8 * tg - 1 + r; const bf16* pr = p + ((size_t)b * T + (t > 0 ? t : 0)) * NP; nr_[r] = pr[C_R + col]; nk_[r] = pr[C_K + col]; nv_[r] = pr[C_V + col]; }
#pragma unroll
      for (int i = 0; i < 8; ++i) { const size_t m = (size_t)b * T + t0 + 8 * tg + i; na_[i] = AA[m * A_W + col]; nw_[i] = WL[m * A_W + col]; } }
    for (int c = 0; c < LSEG / 64; ++c) {
        const int t0 = seg * LSEG + c * 64;
        __syncthreads();
        float rv[8], kkv[8], bv[8], khv[8], vv[8], g[8], wl[8];
        unsigned xr[9], xk[9], xv[9], xa[8], xw[8];
#pragma unroll
        for (int r = 0; r < 9; ++r) { xr[r] = nr_[r]; xk[r] = nk_[r]; xv[r] = nv_[r]; }
#pragma unroll
        for (int i = 0; i < 8; ++i) { xa[i] = na_[i]; xw[i] = nw_[i]; }
        if (c + 1 < LSEG / 64) {
#pragma unroll
            for (int r = 0; r < 9; ++r) { const int t = t0 + 64 + 8 * tg - 1 + r; const bf16* pr = p + ((size_t)b * T + t) * NP; nr_[r] = pr[C_R + col]; nk_[r] = pr[C_K + col]; nv_[r] = pr[C_V + col]; }
#pragma unroll
            for (int i = 0; i < 8; ++i) { const size_t m = (size_t)b * T + t0 + 64 + 8 * tg + i; na_[i] = AA[m * A_W + col]; nw_[i] = WL[m * A_W + col]; }
        }
#pragma unroll
        for (int i = 0; i < 8; ++i) { const int t = t0 + 8 * tg + i; const float hp = (t > 0) ? 1.f : 0.f;
            const float rc = bf2f(xr[i + 1]), kc = bf2f(xk[i + 1]), vc = bf2f(xv[i + 1]);
            const float r = rc + (bf2f(xr[i]) * hp - rc) * mu_r, k = kc + (bf2f(xk[i]) * hp - kc) * mu_k; vv[i] = vc + (bf2f(xv[i]) * hp - vc) * mu_v;
            const float a = bf2f(xa[i]); wl[i] = bf2f(xw[i]);
            const float kr = k * kkc; const float nrm = sqrtf(wave_sum(kr * kr)); const float kk = kr / fmaxf(nrm, 1e-12f);
            rv[i] = r; kkv[i] = kk; bv[i] = kk * a; khv[i] = k * (1.f + (a - 1.f) * kac); }
        g[0] = wl[0];
#pragma unroll
        for (int i = 1; i < 8; ++i) g[i] = g[i - 1] + wl[i];
        TOT[tg * 64 + lane] = g[7];
        __syncthreads();
        float off = 0.f, total = 0.f;
#pragma unroll
        for (int w = 0; w < 8; ++w) { const float tv = TOT[w * 64 + lane]; total += tv; off += (w < tg) ? tv : 0.f; }
        { float at[8], bt[8], kt[8];
#pragma unroll
          for (int i = 0; i < 8; ++i) { const float G = off + g[i]; const float eG = __expf(G), eGm = __expf(G - wl[i]), ei = __expf(-G);
              at[i] = -kkv[i] * eGm; bt[i] = bv[i] * ei; kt[i] = khv[i] * ei; const float rt = rv[i] * eG; const int row = 8 * tg + i;
              L[W_AT + row * 72 + lane] = (bf16)f2bf(at[i]); L[W_BT + row * 72 + lane] = (bf16)f2bf(bt[i]); L[W_KT + row * 72 + lane] = (bf16)f2bf(kt[i]); L[W_RT + row * 72 + lane] = (bf16)f2bf(rt); }
          u32x4 w;
          w.x = pk2(at[0], at[1]); w.y = pk2(at[2], at[3]); w.z = pk2(at[4], at[5]); w.w = pk2(at[6], at[7]); *(LAS u32x4*)(L + W_X0 + lane * 72 + 8 * tg) = w;
          w.x = pk2(bt[0], bt[1]); w.y = pk2(bt[2], bt[3]); w.z = pk2(bt[4], bt[5]); w.w = pk2(bt[6], bt[7]); *(LAS u32x4*)(L + W_BTT + lane * 72 + 8 * tg) = w;
          w.x = pk2(kt[0], kt[1]); w.y = pk2(kt[2], kt[3]); w.z = pk2(kt[4], kt[5]); w.w = pk2(kt[6], kt[7]); *(LAS u32x4*)(L + W_KTT + lane * 72 + 8 * tg) = w;
          w.x = pk2(vv[0], vv[1]); w.y = pk2(vv[2], vv[3]); w.z = pk2(vv[4], vv[5]); w.w = pk2(vv[6], vv[7]); *(LAS u32x4*)(L + W_VTT + lane * 72 + 8 * tg) = w; }
        if (tg == 0) GAM[lane] = __expf(total);
        __syncthreads();
        { bf16x8_t aB[2][2], aK[2][2], bA[2][2], bR[2][2]; f32x4 ab[2], ak[2], rb[2], rk[2];
#pragma unroll
          for (int q = 0; q < 2; ++q) { const int pos = wave * 2 + q, it = pos >> 2, tt = pos & 3;
#pragma unroll
              for (int sx = 0; sx < 2; ++sx) { aB[q][sx] = lfrag(L + W_BT, it * 16 + fr, sx, fq); aK[q][sx] = lfrag(L + W_KT, it * 16 + fr, sx, fq); bA[q][sx] = lfrag(L + W_AT, tt * 16 + fr, sx, fq); bR[q][sx] = lfrag(L + W_RT, tt * 16 + fr, sx, fq); } }
#pragma unroll
          for (int q = 0; q < 2; ++q) { ab[q] = (f32x4){0.f, 0.f, 0.f, 0.f}; ak[q] = ab[q]; rb[q] = ab[q]; rk[q] = ab[q];
#pragma unroll
              for (int sx = 0; sx < 2; ++sx) { ab[q] = MFMA16(aB[q][sx], bA[q][sx], ab[q]); ak[q] = MFMA16(aK[q][sx], bA[q][sx], ak[q]); rb[q] = MFMA16(aB[q][sx], bR[q][sx], rb[q]); rk[q] = MFMA16(aK[q][sx], bR[q][sx], rk[q]); } }
#pragma unroll
          for (int q = 0; q < 2; ++q) { const int pos = wave * 2 + q, it = pos >> 2, tt = pos & 3; const int t = tt * 16 + fr, i0 = it * 16 + 4 * fq;
#pragma unroll
              for (int rg = 0; rg < 4; ++rg) { const bool st = (i0 + rg < t), inc = (i0 + rg <= t); ab[q][rg] = st ? ab[q][rg] : 0.f; ak[q][rg] = st ? ak[q][rg] : 0.f; rb[q][rg] = inc ? rb[q][rg] : 0.f; rk[q][rg] = inc ? rk[q][rg] : 0.f; }
              st4(L + W_L0 + t * 72 + i0, ab[q][0], ab[q][1], ab[q][2], ab[q][3]); st4(L + W_LAK + t * 72 + i0, ak[q][0], ak[q][1], ak[q][2], ak[q][3]);
              st4(L + W_LRB + t * 72 + i0, rb[q][0], rb[q][1], rb[q][2], rb[q][3]); st4(L + W_LRK + t * 72 + i0, rk[q][0], rk[q][1], rk[q][2], rk[q][3]);
#pragma unroll
              for (int rg = 0; rg < 4; ++rg) L[W_LT0 + (i0 + rg) * 72 + t] = (bf16)f2bf(ab[q][rg]); } }
        __syncthreads();
        { bf16x8_t a[2][2], bb[2][2]; f32x4 acc[2];
#pragma unroll
          for (int q = 0; q < 2; ++q) { const int pos = wave * 2 + q, tt = pos >> 2, vt = pos & 3;
#pragma unroll
              for (int sx = 0; sx < 2; ++sx) { a[q][sx] = lfrag(L + W_LAK, tt * 16 + fr, sx, fq); bb[q][sx] = lfrag(L + W_VTT, vt * 16 + fr, sx, fq); } }
#pragma unroll
          for (int q = 0; q < 2; ++q) { acc[q] = (f32x4){0.f, 0.f, 0.f, 0.f};
#pragma unroll
              for (int sx = 0; sx < 2; ++sx) acc[q] = MFMA16(a[q][sx], bb[q][sx], acc[q]); }
#pragma unroll
          for (int q = 0; q < 2; ++q) { const int pos = wave * 2 + q, tt = pos >> 2, vt = pos & 3; st4(L + W_X0 + (64 + vt * 16 + fr) * 72 + tt * 16 + 4 * fq, acc[q][0], acc[q][1], acc[q][2], acc[q][3]); } }
        if (wave < 4) {
            const int r16 = wave * 16;
            f32x4 PA = ld4(L + W_L0 + (r16 + fr) * 72 + r16 + 4 * fq), PB = ld4(L + W_LT0 + (r16 + fr) * 72 + r16 + 4 * fq);
            f32x4 MA = PA, MB = PB;
#pragma unroll
            for (int j = 0; j < 4; ++j) { const float d = (fr == 4 * fq + j) ? 1.f : 0.f; MA[j] += d; MB[j] += d; }
#pragma unroll
            for (int it3 = 0; it3 < 3; ++it3) {
                const bf16x4_t pa = pack4(PA), pb = pack4(PB);
                const f32x4 QB = MFMA16K(pa, pb, ((f32x4){0.f, 0.f, 0.f, 0.f})), QA = MFMA16K(pb, pa, ((f32x4){0.f, 0.f, 0.f, 0.f}));
                PA = QA; PB = QB;
                const bf16x4_t qb = pack4(QB), ma = pack4(MA);
                MB = MFMA16K(ma, qb, MB); MA = MFMA16K(qb, ma, MA);
            }
            st4(L + W_MI + (r16 + fr) * 24 + 4 * fq, MA[0], MA[1], MA[2], MA[3]);
        }
        __syncthreads();
        { bf16x4_t y[4]; LAS bf16* Xrow = L + W_X0 + (wave * 16 + fr) * 72 + 4 * fq;
#pragma unroll
          for (int r = 0; r < 4; ++r) {
              f32x4 acc = ld4(Xrow + 16 * r);
#pragma unroll
              for (int cc = 0; cc < 4; ++cc) if (cc < r) acc = MFMA16K(*(const LAS bf16x4_t*)(L + W_L0 + (16 * r + fr) * 72 + 16 * cc + 4 * fq), y[cc], acc);
              const bf16x4_t tb = pack4(acc);
              const f32x4 xr = MFMA16K(*(const LAS bf16x4_t*)(L + W_MI + (16 * r + fr) * 24 + 4 * fq), tb, ((f32x4){0.f, 0.f, 0.f, 0.f}));
              y[r] = pack4(xr);
              *(LAS bf16x4_t*)(Xrow + 16 * r) = y[r]; } }
        __syncthreads();
        { bf16x8_t aX[2][2], bT[2][2], bL[2][2]; f32x4 accT[2], accQ[2], rt[2]; float gm[2];
#pragma unroll
          for (int q = 0; q < 2; ++q) { const int pos = wave * 2 + q, kt = pos >> 2, nt = pos & 3;
#pragma unroll
              for (int sx = 0; sx < 2; ++sx) { aX[q][sx] = lfrag(L + W_X0, kt * 16 + fr, sx, fq); bT[q][sx] = lfrag(L + W_BTT, nt * 16 + fr, sx, fq); bL[q][sx] = lfrag(L + W_LRB, nt * 16 + fr, sx, fq); }
              gm[q] = GAM[nt * 16 + fr]; rt[q] = ld4(L + W_RT + (nt * 16 + fr) * 72 + kt * 16 + 4 * fq); }
#pragma unroll
          for (int q = 0; q < 2; ++q) { accT[q] = (f32x4){0.f, 0.f, 0.f, 0.f}; accQ[q] = accT[q];
#pragma unroll
              for (int sx = 0; sx < 2; ++sx) { accT[q] = MFMA16(aX[q][sx], bT[q][sx], accT[q]); accQ[q] = MFMA16(aX[q][sx], bL[q][sx], accQ[q]); } }
#pragma unroll
          for (int q = 0; q < 2; ++q) { const int pos = wave * 2 + q, kt = pos >> 2, nt = pos & 3; const int k0 = kt * 16 + 4 * fq, n = nt * 16 + fr;
#pragma unroll
              for (int rg = 0; rg < 4; ++rg) accT[q][rg] = (accT[q][rg] + ((k0 + rg == n) ? 1.f : 0.f)) * gm[q];
              st4(L + W_TT + n * 72 + k0, accT[q][0], accT[q][1], accT[q][2], accT[q][3]); st4(L + W_QT + n * 72 + k0, accQ[q][0] + rt[q][0], accQ[q][1] + rt[q][1], accQ[q][2] + rt[q][2], accQ[q][3] + rt[q][3]); } }
        __syncthreads();
        { f32x4 oacc[4];
#pragma unroll
          for (int vt = 0; vt < 4; ++vt) oacc[vt] = (f32x4){0.f, 0.f, 0.f, 0.f};
#pragma unroll
          for (int sx = 0; sx < 2; ++sx) { const bf16x8_t aQ = lfrag(L + W_QT, w4 * 16 + fr, sx, fq);
              if (!ident) { const bf16x8_t aB = lfrag(L + W_LRB, w4 * 16 + fr, sx, fq), aK = lfrag(L + W_LRK, w4 * 16 + fr, sx, fq);
#pragma unroll
                  for (int vt = 0; vt < 4; ++vt) { const int rw = 4 * fr + vt; oacc[vt] = MFMA16(aB, lfrag(L + W_X0, 64 + rw, sx, fq), oacc[vt]); oacc[vt] = MFMA16(aK, lfrag(L + W_VTT, rw, sx, fq), oacc[vt]); oacc[vt] = MFMA16(aQ, lfrag(L + W_SIM, rw, sx, fq), oacc[vt]); } }
              else {
#pragma unroll
                  for (int vt = 0; vt < 4; ++vt) oacc[vt] = MFMA16(aQ, lfrag(L + W_PIM, 4 * fr + vt, sx, fq), oacc[vt]); } }
          bf16* OUT = ident ? (YI + (size_t)h * 64) : (MIX + (size_t)h * 64); const int ldo = ident ? 512 : D;
#pragma unroll
          for (int rg = 0; rg < 4; ++rg) { const size_t m = (size_t)b * T + t0 + w4 * 16 + 4 * fq + rg; u32x2 w; w.x = pk2(oacc[0][rg], oacc[1][rg]); w.y = pk2(oacc[2][rg], oacc[3][rg]); *(u32x2*)(OUT + m * ldo + 4 * fr) = w; } }
#pragma unroll
        for (int nt = 0; nt < 4; ++nt) { f32x4 acc = (f32x4){0.f, 0.f, 0.f, 0.f};
            if (!ident) {
#pragma unroll
                for (int sx = 0; sx < 2; ++sx) { acc = MFMA16(lfrag(L + W_X0, 64 + w4 * 16 + fr, sx, fq), lfrag(L + W_BTT, nt * 16 + fr, sx, fq), acc); acc = MFMA16(lfrag(L + W_VTT, w4 * 16 + fr, sx, fq), lfrag(L + W_KTT, nt * 16 + fr, sx, fq), acc); }
                acc = acc * GAM[nt * 16 + fr]; }
            const LAS bf16* IM = L + (ident ? W_PIM : W_SIM);
#pragma unroll
            for (int sx = 0; sx < 2; ++sx) acc = MFMA16(lfrag(IM, w4 * 16 + fr, sx, fq), lfrag(L + W_TT, nt * 16 + fr, sx, fq), acc);
            Wreg[nt] = acc; }
        __syncthreads();
        { LAS bf16* IM = L + (ident ? W_PIM : W_SIM);
#pragma unroll
          for (int nt = 0; nt < 4; ++nt)
#pragma unroll
              for (int rg = 0; rg < 4; ++rg) IM[(w4 * 16 + 4 * fq + rg) * 72 + nt * 16 + fr] = (bf16)f2bf(Wreg[nt][rg]); }
    }
    float* SE = (float*)(ws + WS_SER) + ((((size_t)(b * 8 + h) * NSEG + seg) * 2 + (ident ? 1 : 0)) * 4096);
#pragma unroll
    for (int nt = 0; nt < 4; ++nt)
#pragma unroll
        for (int rg = 0; rg < 4; ++rg) SE[(w4 * 16 + 4 * fq + rg) * 64 + nt * 16 + fr] = Wreg[nt][rg];
}

constexpr int GQ = 0, GK_ = GQ + 64 * 72, GD = GK_ + 64 * 72, GV = GD + 64 * 72, GA = GV + 128 * 72, GS = GA + 64 * 72, GEND = GS + 128 * 72;
__device__ __forceinline__ unsigned pk2f(float a, float b) { return pk2(a, b); }
__device__ __forceinline__ void gla_item(const Params& P, LAS unsigned char* lds, int b, int h, int seg) {
    const int tid = threadIdx.x, lane = tid & 63, wave = __builtin_amdgcn_readfirstlane(tid >> 6), fr = lane & 15, fq = lane >> 4;
    unsigned char* ws = P.ws;
    const bf16* p = (const bf16*)(ws + WS_P); bf16* GKB = (bf16*)(ws + WS_GK);
    bf16* MIX = (bf16*)P.out;
    float* SE = (float*)(ws + WS_SEG) + ((size_t)(b * 4 + h) * NSEG + seg) * 8192; float* CE = (float*)(ws + WS_CEND) + ((size_t)(b * 4 + h) * NSEG + seg) * 64;
    const float* conv = P.in[15];
    LAS bf16* L = (LAS bf16*)lds; LAS bf16* QT = L + GQ; LAS bf16* KT = L + GK_; LAS bf16* KD = L + GD; LAS bf16* VT = L + GV; LAS bf16* AT = L + GA; LAS bf16* ST = L + GS;
    LAS float* GAM = (LAS float*)(lds + GEND * 2); LAS float* TOT = GAM + 64;
    const int ch = lane, tg = wave;
    const int cq = h * 64 + ch, ck = 256 + h * 64 + ch, cv0 = 512 + h * 128 + ch, cv1 = cv0 + 64;
    float wq[4], wk[4], wv0[4], wv1[4];
#pragma unroll
    for (int j = 0; j < 4; ++j) { wq[j] = conv[j * 1024 + cq]; wk[j] = conv[j * 1024 + ck]; wv0[j] = conv[j * 1024 + cv0]; wv1[j] = conv[j * 1024 + cv1]; }
    float gseg = 0.f;
    f32x4 Sacc[4];
#pragma unroll
    for (int k = 0; k < 4; ++k) Sacc[k] = (f32x4){0.f, 0.f, 0.f, 0.f};
    __syncthreads();
    for (int i = tid; i < 128 * 72 / 2; i += NTHR) ((LAS unsigned*)ST)[i] = 0u;
    for (int c = 0; c < LSEG / 64; ++c) {
        const int t0 = seg * LSEG + c * 64;
        __syncthreads();
        float xq[11], xk[11], xa[11], xb[11], g[8];
#pragma unroll
        for (int r = 0; r < 11; ++r) { const int t = t0 + 8 * tg - 3 + r; const size_t m = (size_t)b * T + (t > 0 ? t : 0); const float ok = (t >= 0) ? 1.f : 0.f; const bf16* pr = p + m * NP + C_BQ;
            xq[r] = bf2f(pr[cq]) * ok; xk[r] = bf2f(pr[ck]) * ok; xa[r] = bf2f(pr[cv0]) * ok; xb[r] = bf2f(pr[cv1]) * ok; }
#pragma unroll
        for (int i = 0; i < 8; ++i) g[i] = bf2f(GKB[((size_t)b * T + t0 + 8 * tg + i) * 256 + h * 64 + ch]);
#pragma unroll
        for (int i = 1; i < 8; ++i) g[i] += g[i - 1];
        TOT[tg * 64 + ch] = g[7];
        __syncthreads();
        float off = 0.f, total = 0.f;
#pragma unroll
        for (int w = 0; w < 8; ++w) { const float tv = TOT[w * 64 + ch]; total += tv; off += (w < tg) ? tv : 0.f; }
        float kd[8], va[8], vb[8];
#pragma unroll
        for (int i = 0; i < 8; ++i) {
            float aq = 0.f, ak = 0.f, a0 = 0.f, a1 = 0.f;
#pragma unroll
            for (int j = 0; j < 4; ++j) { aq += wq[j] * xq[i + j]; ak += wk[j] * xk[i + j]; a0 += wv0[j] * xa[i + j]; a1 += wv1[j] * xb[i + j]; }
            const float q = siluf_(aq) * 0.125f, k = siluf_(ak), Gc = off + g[i];
            QT[(8 * tg + i) * 72 + ch] = (bf16)f2bf(q * __expf(Gc)); KT[(8 * tg + i) * 72 + ch] = (bf16)f2bf(k * __expf(-Gc));
            kd[i] = k * __expf(total - Gc); va[i] = siluf_(a0); vb[i] = siluf_(a1);
            GKB[((size_t)b * T + t0 + 8 * tg + i) * 256 + h * 64 + ch] = (bf16)f2bf(q * __expf(gseg + Gc));
        }
        { u32x4 w; w.x = pk2f(kd[0], kd[1]); w.y = pk2f(kd[2], kd[3]); w.z = pk2f(kd[4], kd[5]); w.w = pk2f(kd[6], kd[7]); *(LAS u32x4*)(KD + ch * 72 + 8 * tg) = w;
          w.x = pk2f(va[0], va[1]); w.y = pk2f(va[2], va[3]); w.z = pk2f(va[4], va[5]); w.w = pk2f(va[6], va[7]); *(LAS u32x4*)(VT + ch * 72 + 8 * tg) = w;
          w.x = pk2f(vb[0], vb[1]); w.y = pk2f(vb[2], vb[3]); w.z = pk2f(vb[4], vb[5]); w.w = pk2f(vb[6], vb[7]); *(LAS u32x4*)(VT + (64 + ch) * 72 + 8 * tg) = w; }
        if (tg == 0) GAM[ch] = __expf(total);
        gseg += total;
        __syncthreads();
#pragma unroll
        for (int k2 = 0; k2 < 2; ++k2) { const int tile = wave * 2 + k2, jt = tile >> 2, it = tile & 3; f32x4 acc = (f32x4){0.f, 0.f, 0.f, 0.f};
            if (jt <= it) {
#pragma unroll
                for (int sx = 0; sx < 2; ++sx) acc = __builtin_amdgcn_mfma_f32_16x16x32_bf16(*(const LAS bf16x8_t*)(KT + (jt * 16 + fr) * 72 + 32 * sx + 8 * fq), *(const LAS bf16x8_t*)(QT + (it * 16 + fr) * 72 + 32 * sx + 8 * fq), acc, 0, 0, 0);
            }
            const int ii = it * 16 + fr, j0 = jt * 16 + 4 * fq; u32x2 w;
            w.x = pk2f(j0 <= ii ? acc[0] : 0.f, j0 + 1 <= ii ? acc[1] : 0.f); w.y = pk2f(j0 + 2 <= ii ? acc[2] : 0.f, j0 + 3 <= ii ? acc[3] : 0.f);
            *(LAS u32x2*)(AT + ii * 72 + j0) = w; }
        __syncthreads();
        { const int it = wave & 3, vts = (wave >> 2) * 4; f32x4 oacc[4];
#pragma unroll
          for (int k = 0; k < 4; ++k) oacc[k] = (f32x4){0.f, 0.f, 0.f, 0.f};
#pragma unroll
          for (int sx = 0; sx < 2; ++sx) { const bf16x8_t aA = *(const LAS bf16x8_t*)(AT + (it * 16 + fr) * 72 + 32 * sx + 8 * fq), aQ = *(const LAS bf16x8_t*)(QT + (it * 16 + fr) * 72 + 32 * sx + 8 * fq);
#pragma unroll
              for (int k = 0; k < 4; ++k) { const int vrow = 8 * fr + vts + k;
                  oacc[k] = __builtin_amdgcn_mfma_f32_16x16x32_bf16(aA, *(const LAS bf16x8_t*)(VT + vrow * 72 + 32 * sx + 8 * fq), oacc[k], 0, 0, 0);
                  oacc[k] = __builtin_amdgcn_mfma_f32_16x16x32_bf16(aQ, *(const LAS bf16x8_t*)(ST + vrow * 72 + 32 * sx + 8 * fq), oacc[k], 0, 0, 0); } }
#pragma unroll
          for (int rg = 0; rg < 4; ++rg) { const size_t m = (size_t)b * T + t0 + it * 16 + 4 * fq + rg; u32x2 w; w.x = pk2f(oacc[0][rg], oacc[1][rg]); w.y = pk2f(oacc[2][rg], oacc[3][rg]);
              *(u32x2*)(MIX + m * D + 512 + h * 128 + 8 * fr + vts) = w; } }
#pragma unroll
        for (int k = 0; k < 4; ++k) { f32x4 acc = Sacc[k] * GAM[k * 16 + fr];
#pragma unroll
            for (int sx = 0; sx < 2; ++sx) acc = __builtin_amdgcn_mfma_f32_16x16x32_bf16(*(const LAS bf16x8_t*)(VT + (wave * 16 + fr) * 72 + 32 * sx + 8 * fq), *(const LAS bf16x8_t*)(KD + (k * 16 + fr) * 72 + 32 * sx + 8 * fq), acc, 0, 0, 0);
            Sacc[k] = acc; }
        __syncthreads();
#pragma unroll
        for (int k = 0; k < 4; ++k)
#pragma unroll
            for (int rg = 0; rg < 4; ++rg) ST[(wave * 16 + 4 * fq + rg) * 72 + k * 16 + fr] = (bf16)f2bf(Sacc[k][rg]);
    }
#pragma unroll
    for (int k = 0; k < 4; ++k)
#pragma unroll
        for (int rg = 0; rg < 4; ++rg) SE[(wave * 16 + 4 * fq + rg) * 64 + k * 16 + fr] = Sacc[k][rg];
    if (tg == 0) CE[ch] = __expf(gseg);
}
__device__ __forceinline__ void phase_scan(const Params& P, LAS unsigned char* lds) {
    for (int it = blockIdx.x; it < 512 + 256; it += gridDim.x) {
        if (it < 512) { const int bh = it >> 4; rwkv_item_chunked(P, lds, bh >> 3, bh & 7, it & 15); }
        else { const int g = it - 512, bh = g >> 4; gla_item(P, lds, bh >> 2, bh & 3, g & 15); }
        __syncthreads();
    }
}
__device__ __forceinline__ void quant_tables(const Params& P, int gw, int ngw);
__device__ __forceinline__ void phase_fixup(const Params& P, LAS unsigned char* lds) {
    const int tid = threadIdx.x, lane = tid & 63, wave = __builtin_amdgcn_readfirstlane(tid >> 6), fr = lane & 15, fq = lane >> 4;
    for (int it = blockIdx.x; it < 192; it += gridDim.x) {
        if (it < 64) {
            float* SE = (float*)(P.ws + WS_SER) + (size_t)(it >> 1) * NSEG * 2 * 4096;
            LAS float* Sb = (LAS float*)lds;
            const int sl = wave >> 2, nt = wave & 3, r0 = ((it & 1) * 2 + sl) * 16;
            const int cpos = (r0 + 4 * fq) * 64 + nt * 16 + fr;
            const int bpos = (16 * fq) * 64 + nt * 16 + fr;
            __syncthreads();
            f32x4 en[4]; float ph[4][16];
#define FX_LOAD(sg) do { const float* nx_ = SE + (size_t)((sg) * 2) * 4096; \
                _Pragma("unroll") for (int ks = 0; ks < 16; ++ks) ph[(sg) & 3][ks] = nx_[4096 + bpos + 64 * ks]; \
                _Pragma("unroll") for (int rg = 0; rg < 4; ++rg) en[(sg) & 3][rg] = nx_[cpos + 64 * rg]; } while (0)
#pragma unroll
            for (int rg = 0; rg < 4; ++rg) Sb[(sl * 16 + 4 * fq + rg) * 68 + nt * 16 + fr] = SE[cpos + 64 * rg];
            FX_LOAD(1); FX_LOAD(2); FX_LOAD(3);
            __syncthreads();
#pragma unroll
            for (int seg = 1; seg < NSEG - 1; ++seg) {
                float* s0 = SE + (size_t)(seg * 2) * 4096;
                const LAS float* Sr = Sb + ((seg - 1) & 1) * (2 * 16 * 68) + (sl * 16 + fr) * 68 + 16 * fq; LAS float* Sw = Sb + (seg & 1) * (2 * 16 * 68);
                if (seg + 3 < NSEG - 1) FX_LOAD(seg + 3);
                f32x4 acc = en[seg & 3]; f32x4 av[4];
#pragma unroll
                for (int j = 0; j < 4; ++j) av[j] = *(const LAS f32x4*)(Sr + 4 * j);
#pragma unroll
                for (int ks = 0; ks < 16; ++ks) acc = __builtin_amdgcn_mfma_f32_16x16x4f32(av[ks >> 2][ks & 3], ph[seg & 3][ks], acc, 0, 0, 0);
#pragma unroll
                for (int rg = 0; rg < 4; ++rg) { s0[cpos + 64 * rg] = acc[rg]; Sw[(sl * 16 + 4 * fq + rg) * 68 + nt * 16 + fr] = acc[rg]; }
                __syncthreads();
            }
#undef FX_LOAD
        } else {
            const int g = it - 64, bh = g >> 3; float* SE = (float*)(P.ws + WS_SEG) + (size_t)bh * NSEG * 8192 + ((g & 7) * 16 + (tid >> 5)) * 64 + (tid & 31) * 2;
            const float* CE = (const float*)(P.ws + WS_CEND) + (size_t)bh * NSEG * 64 + (tid & 31) * 2;
            f32x2 x[NSEG - 1], ce[NSEG - 1];
#pragma unroll
            for (int seg = 0; seg < NSEG - 1; ++seg) { x[seg] = *(const f32x2*)(SE + (size_t)seg * 8192); ce[seg] = *(const f32x2*)(CE + seg * 64); }
            f32x2 sc = (f32x2){0.f, 0.f};
#pragma unroll
            for (int seg = 0; seg < NSEG - 1; ++seg) { sc = sc * ce[seg] + x[seg]; *(f32x2*)(SE + (size_t)seg * 8192) = sc; }
        }
    }
    {
        const bool sp = gridDim.x > 64; const int nb = sp ? (int)gridDim.x - 64 : (int)gridDim.x, bi = sp ? (int)blockIdx.x - 64 : (int)blockIdx.x;
        if (bi >= 0) {
            fold_keys(P, lds, bi, nb);
            transpose_convert(P.in[19], D, D, D, (bf16*)(P.ws + WS_WOUT), bi * NTHR + tid, nb * NTHR);
            quant_tables(P, bi * NWAVES + (tid >> 6), nb * NWAVES);
        }
    }
}
__device__ __forceinline__ float row_sum16(float v) { v = DPP_ADD(v, 0xB1); v = DPP_ADD(v, 0x4E); v = DPP_ADD(v, 0x141); v = DPP_ADD(v, 0x140); return v; }
__device__ __forceinline__ bf16x8_t pack_bf16x8(const f32x4 a, const f32x4 b) {
    u32x4 w; w.x = pk2(a[0], a[1]); w.y = pk2(a[2], a[3]); w.z = pk2(b[0], b[1]); w.w = pk2(b[2], b[3]); return __builtin_bit_cast(bf16x8_t, w);
}
__device__ __forceinline__ void unpack4(const u32x2 w, float (&o)[4]) { o[0] = __uint_as_float(w.x << 16); o[1] = __uint_as_float(w.x & 0xffff0000u); o[2] = __uint_as_float(w.y << 16); o[3] = __uint_as_float(w.y & 0xffff0000u); }
__device__ __forceinline__ void phase_correct(const Params& P, LAS unsigned char* lds) {
    const int tid = threadIdx.x, lane = tid & 63, wave = __builtin_amdgcn_readfirstlane(tid >> 6), fr = lane & 15, fq = lane >> 4;
    unsigned char* ws = P.ws;
    const bf16* p = (const bf16*)(ws + WS_P); const bf16* AA = (const bf16*)(ws + WS_AA); const bf16* GG = (const bf16*)(ws + WS_GG);
    bf16* MIX = (bf16*)P.out; const bf16* YI = (const bf16*)(ws + WS_YI); const bf16* YIG = (const bf16*)(ws + WS_YIG);
    const float* mu = P.in[4]; const float* k_a = P.in[11]; const float* r_k = P.in[12]; const float* gn_g = P.in[13]; const float* gn_b = P.in[14]; const float* norm_g = P.in[18];
    LAS bf16* SB = (LAS bf16*)lds;
    for (int it = blockIdx.x; it < 512; it += gridDim.x) {
        {
            const int seg = it & 15, bh = it >> 4, b = bh >> 3, h = bh & 7;
            const int cb = h * 64 + 4 * fr;
            __syncthreads();
            if (seg > 0) { const float* ss = (const float*)(ws + WS_SER) + (((size_t)bh * NSEG + (seg - 1)) * 2) * 4096;
                for (int i = tid; i < 1024; i += NTHR) { const f32x4 x = *(const f32x4*)(ss + 4 * i); const int v = i >> 4, j = (4 * i) & 63; u32x2 w; w.x = pk2(x[0], x[1]); w.y = pk2(x[2], x[3]);
                    *(LAS u32x2*)(SB + ((v & 3) * 16 + (v >> 2)) * 72 + j) = w; } }
            __syncthreads();
            const f32x4 mur = *(const f32x4*)(mu + C_R + cb), muk = *(const f32x4*)(mu + C_K + cb), muv = *(const f32x4*)(mu + C_V + cb), kac = *(const f32x4*)(k_a + cb), rkc = *(const f32x4*)(r_k + cb), gng = *(const f32x4*)(gn_g + cb), gnb = *(const f32x4*)(gn_b + cb);
            u32x2 W[4][9];
#define CORR_LOAD(buf, st) do { const int t_ = seg * LSEG + wave * 64 + ((st) >> 2) * 16 + 4 * fq + ((st) & 3); const size_t m_ = (size_t)b * T + t_; const bf16* pr_ = p + m_ * NP + cb; const bf16* pp_ = (t_ > 0) ? pr_ - NP : pr_; \
                    W[buf][0] = *(const u32x2*)(MIX + m_ * D + cb); W[buf][1] = *(const u32x2*)(pr_ + C_R); W[buf][2] = *(const u32x2*)(pr_ + C_K); W[buf][3] = *(const u32x2*)(pr_ + C_V); \
                    W[buf][4] = *(const u32x2*)(pp_ + C_R); W[buf][5] = *(const u32x2*)(pp_ + C_K); W[buf][6] = *(const u32x2*)(pp_ + C_V); W[buf][7] = *(const u32x2*)(AA + m_ * A_W + cb); W[buf][8] = *(const u32x2*)(GG + m_ * A_W + cb); } while (0)
            CORR_LOAD(0, 0); CORR_LOAD(1, 1); CORR_LOAD(2, 2);
#pragma unroll
            for (int mt = 0; mt < 4; ++mt) {
                const int tb = seg * LSEG + wave * 64 + mt * 16;
                f32x4 acc[4];
#pragma unroll
                for (int vt = 0; vt < 4; ++vt) acc[vt] = (f32x4){0.f, 0.f, 0.f, 0.f};
                if (seg > 0) {
#pragma unroll
                    for (int sx = 0; sx < 2; ++sx) { const bf16x8_t af = *(const bf16x8_t*)(YI + ((size_t)b * T + tb + fr) * 512 + h * 64 + 32 * sx + 8 * fq);
#pragma unroll
                        for (int vt = 0; vt < 4; ++vt) acc[vt] = __builtin_amdgcn_mfma_f32_16x16x32_bf16(af, *(const LAS bf16x8_t*)(SB + (vt * 16 + fr) * 72 + 32 * sx + 8 * fq), acc[vt], 0, 0, 0); }
                }
#pragma unroll
                for (int rg = 0; rg < 4; ++rg) { const int t = tb + 4 * fq + rg; const size_t m = (size_t)b * T + t; const float hp = (t > 0) ? 1.f : 0.f; const int st = mt * 4 + rg;
                    if (st + 3 < 16) CORR_LOAD((st + 3) & 3, st + 3);
                    __builtin_amdgcn_sched_barrier(0);
                    float y[4], rc[4], kc[4], vc[4], rp_[4], kp[4], vp[4], a[4], g[4];
                    unpack4(W[st & 3][0], y); unpack4(W[st & 3][1], rc); unpack4(W[st & 3][2], kc); unpack4(W[st & 3][3], vc); unpack4(W[st & 3][4], rp_); unpack4(W[st & 3][5], kp); unpack4(W[st & 3][6], vp); unpack4(W[st & 3][7], a); unpack4(W[st & 3][8], g);
                    float v[4], sy = 0.f, sb = 0.f;
#pragma unroll
                    for (int i = 0; i < 4; ++i) { y[i] += acc[i][rg];
                        const float r = rc[i] + (rp_[i] * hp - rc[i]) * mur[i], k = kc[i] + (kp[i] * hp - kc[i]) * muk[i]; v[i] = vc[i] + (vp[i] * hp - vc[i]) * muv[i];
                        const float kh = k * (1.f + (a[i] - 1.f) * kac[i]); sb += r * kh * rkc[i]; sy += y[i]; }
                    const float bon = row_sum16(sb), mean = row_sum16(sy) * (1.f / 64.f); float sq = 0.f;
#pragma unroll
                    for (int i = 0; i < 4; ++i) { y[i] -= mean; sq += y[i] * y[i]; }
                    const float rstd = 1.f / sqrtf(row_sum16(sq) * (1.f / 64.f) + GN_EPS); float o[4];
#pragma unroll
                    for (int i = 0; i < 4; ++i) o[i] = (y[i] * rstd * gng[i] + gnb[i] + bon * v[i]) * g[i];
                    u32x2 w; w.x = pk2(o[0], o[1]); w.y = pk2(o[2], o[3]); *(u32x2*)(MIX + m * D + cb) = w;
                    __builtin_amdgcn_sched_barrier(0); }
#undef CORR_LOAD
            }
        }
    }
    for (int g_ = blockIdx.x; g_ < 256; g_ += gridDim.x) {
        {
            const int seg = g_ & 15, bh = g_ >> 4, b = bh >> 2, h = bh & 3;
            const int cb = h * 128 + 8 * fr;
            __syncthreads();
            if (seg > 0) { const float* ss = (const float*)(ws + WS_SEG) + ((size_t)bh * NSEG + (seg - 1)) * 8192;
                for (int i = tid; i < 2048; i += NTHR) { const f32x4 x = *(const f32x4*)(ss + 4 * i); const int v = i >> 4, j = (4 * i) & 63; u32x2 w; w.x = pk2(x[0], x[1]); w.y = pk2(x[2], x[3]);
                    *(LAS u32x2*)(SB + ((v & 7) * 16 + (v >> 3)) * 72 + j) = w; } }
            __syncthreads();
            const f32x4 ng0 = *(const f32x4*)(norm_g + 8 * fr), ng1 = *(const f32x4*)(norm_g + 8 * fr + 4);
            u32x4 WG[4][2];
#define CORG_LOAD(buf, st) do { const size_t m_ = (size_t)b * T + seg * LSEG + wave * 64 + ((st) >> 2) * 16 + 4 * fq + ((st) & 3); WG[buf][0] = *(const u32x4*)(MIX + m_ * D + 512 + cb); WG[buf][1] = *(const u32x4*)(p + m_ * NP + C_BG + cb); } while (0)
            CORG_LOAD(0, 0); CORG_LOAD(1, 1); CORG_LOAD(2, 2);
#pragma unroll
            for (int mt = 0; mt < 4; ++mt) {
                const int tb = seg * LSEG + wave * 64 + mt * 16;
                f32x4 acc[8];
#pragma unroll
                for (int vt = 0; vt < 8; ++vt) acc[vt] = (f32x4){0.f, 0.f, 0.f, 0.f};
                if (seg > 0) {
#pragma unroll
                    for (int sx = 0; sx < 2; ++sx) { const bf16x8_t af = *(const bf16x8_t*)(YIG + ((size_t)b * T + tb + fr) * 256 + h * 64 + 32 * sx + 8 * fq);
#pragma unroll
                        for (int vt = 0; vt < 8; ++vt) acc[vt] = __builtin_amdgcn_mfma_f32_16x16x32_bf16(af, *(const LAS bf16x8_t*)(SB + (vt * 16 + fr) * 72 + 32 * sx + 8 * fq), acc[vt], 0, 0, 0); }
                }
#pragma unroll
                for (int rg = 0; rg < 4; ++rg) { const size_t m = (size_t)b * T + tb + 4 * fq + rg; const int st = mt * 4 + rg;
                    if (st + 3 < 16) CORG_LOAD((st + 3) & 3, st + 3);
                    __builtin_amdgcn_sched_barrier(0);
                    float o[8], g[8]; float sq = 0.f;
#pragma unroll
                    for (int i = 0; i < 4; ++i) { const unsigned a_ = WG[st & 3][0][i], b_ = WG[st & 3][1][i]; o[2 * i] = __uint_as_float(a_ << 16); o[2 * i + 1] = __uint_as_float(a_ & 0xffff0000u); g[2 * i] = __uint_as_float(b_ << 16); g[2 * i + 1] = __uint_as_float(b_ & 0xffff0000u); }
#pragma unroll
                    for (int i = 0; i < 8; ++i) { o[i] += acc[i][rg]; sq += o[i] * o[i]; }
                    const float rs = 1.f / sqrtf(row_sum16(sq) * (1.f / 128.f) + RMS_EPS);
                    float f[8];
#pragma unroll
                    for (int i = 0; i < 8; ++i) f[i] = o[i] * rs * (i < 4 ? ng0[i & 3] : ng1[i & 3]) * siluf_(g[i]);
                    u32x4 w; w.x = pk2(f[0], f[1]); w.y = pk2(f[2], f[3]); w.z = pk2(f[4], f[5]); w.w = pk2(f[6], f[7]); *(u32x4*)(MIX + m * D + 512 + cb) = w;
                    __builtin_amdgcn_sched_barrier(0); }
#undef CORG_LOAD
            }
        }
    }
}

__device__ __forceinline__ void phase_ln1(const Params& P) {
    const int lane = threadIdx.x & 63, wave = threadIdx.x >> 6; const int gw = blockIdx.x * NWAVES + wave, ngw = gridDim.x * NWAVES;
    for (int m = gw; m < M; m += ngw) ln_rowb_bf16<true>((const bf16*)(P.ws + WS_Z) + (size_t)m * D, P.in[20], P.in[21], (bf16*)(P.ws + WS_H1) + (size_t)m * D, lane, P.ws + WS_H8 + (size_t)m * 2048);
}
__device__ __forceinline__ void quant_tables(const Params& P, int gw, int ngw) {
    const int lane = threadIdx.x & 63;
    {
        const float* src = P.in[24]; unsigned char* dst = P.ws + WS_UF + (size_t)(lane >> 3) * UF_SLICE + 16 * (lane & 7); float* sc = (float*)(P.ws + WS_SU);
        for (int e = gw; e < 16384; e += ngw) {
            const f32x4* sp = (const f32x4*)(src + (size_t)e * D) + 4 * lane; f32x4 a[4]; float mx = 0.f;
#pragma unroll
            for (int j = 0; j < 4; ++j) { a[j] = sp[j]; mx = fmaxf(fmaxf(mx, fmaxf(fabsf(a[j][0]), fabsf(a[j][1]))), fmaxf(fabsf(a[j][2]), fabsf(a[j][3]))); }
            mx = wave_max_u(mx); const float inv = mx > 0.f ? 448.f / mx : 0.f;
            u32x4 w;
#pragma unroll
            for (int j = 0; j < 4; ++j) { int pk = __builtin_amdgcn_cvt_pk_fp8_f32(a[j][0] * inv, a[j][1] * inv, 0, false); pk = __builtin_amdgcn_cvt_pk_fp8_f32(a[j][2] * inv, a[j][3] * inv, pk, true); w[j] = (unsigned)pk; }
            *(u32x4*)(dst + (size_t)e * 128) = w;
            if (lane == 0) sc[e] = mx * (1.f / 448.f);
        }
    }
    {
        const float* src = P.in[25]; unsigned char* dst = P.ws + WS_V8 + (size_t)(lane >> 3) * V8_SLICE + 16 * (lane & 7); float* sc = (float*)(P.ws + WS_SV);
        for (int e = gw; e < 16384; e += ngw) {
            const f32x4* sp = (const f32x4*)(src + (size_t)e * D) + 4 * lane; f32x4 a[4]; float mx = 0.f;
#pragma unroll
            for (int j = 0; j < 4; ++j) { a[j] = sp[j]; mx = fmaxf(fmaxf(mx, fmaxf(fabsf(a[j][0]), fabsf(a[j][1]))), fmaxf(fabsf(a[j][2]), fabsf(a[j][3]))); }
            mx = wave_max_u(mx); const float inv = mx > 0.f ? 127.f / mx : 0.f;
            u32x4 w;
#pragma unroll
            for (int j = 0; j < 4; ++j) w[j] = pack_i8(a[j][0], a[j][1], a[j][2], a[j][3], inv, 0);
            *(u32x4*)(dst + (size_t)e * 128) = w;
            if (lane == 0) sc[e] = mx * (1.f / 127.f);
        }
    }
}

#define TK_CE(a, b) do { const unsigned _h = max((a), (b)); (b) = min((a), (b)); (a) = _h; } while (0)
#define TK_INS(L, x) do { _Pragma("unroll") for (int _j = 0; _j < 16; ++_j) { const unsigned _h = max(L[_j], x); x = min(L[_j], x); L[_j] = _h; } } while (0)
__device__ __forceinline__ void tk_sort16(unsigned (&x)[16]) { TK_CE(x[0], x[13]); TK_CE(x[1], x[12]); TK_CE(x[2], x[15]); TK_CE(x[3], x[14]); TK_CE(x[4], x[8]); TK_CE(x[5], x[6]); TK_CE(x[7], x[11]); TK_CE(x[9], x[10]); TK_CE(x[0], x[5]); TK_CE(x[1], x[7]); TK_CE(x[2], x[9]); TK_CE(x[3], x[4]); TK_CE(x[6], x[13]); TK_CE(x[8], x[14]); TK_CE(x[10], x[15]); TK_CE(x[11], x[12]); TK_CE(x[0], x[1]); TK_CE(x[2], x[3]); TK_CE(x[4], x[5]); TK_CE(x[6], x[8]); TK_CE(x[7], x[9]); TK_CE(x[10], x[11]); TK_CE(x[12], x[13]); TK_CE(x[14], x[15]); TK_CE(x[0], x[2]); TK_CE(x[1], x[3]); TK_CE(x[4], x[10]); TK_CE(x[5], x[11]); TK_CE(x[6], x[7]); TK_CE(x[8], x[9]); TK_CE(x[12], x[14]); TK_CE(x[13], x[15]); TK_CE(x[1], x[2]); TK_CE(x[3], x[12]); TK_CE(x[4], x[6]); TK_CE(x[5], x[7]); TK_CE(x[8], x[10]); TK_CE(x[9], x[11]); TK_CE(x[13], x[14]); TK_CE(x[1], x[4]); TK_CE(x[2], x[6]); TK_CE(x[5], x[8]); TK_CE(x[7], x[10]); TK_CE(x[9], x[13]); TK_CE(x[11], x[14]); TK_CE(x[2], x[4]); TK_CE(x[3], x[6]); TK_CE(x[9], x[12]); TK_CE(x[11], x[13]); TK_CE(x[3], x[5]); TK_CE(x[6], x[8]); TK_CE(x[7], x[9]); TK_CE(x[10], x[12]); TK_CE(x[3], x[4]); TK_CE(x[5], x[6]); TK_CE(x[7], x[8]); TK_CE(x[9], x[10]); TK_CE(x[11], x[12]); TK_CE(x[6], x[7]); TK_CE(x[8], x[9]); }
__device__ __forceinline__ void tk_merge16(unsigned (&R)[16], const unsigned (&S)[16]) {
#pragma unroll
    for (int i = 0; i < 16; ++i) R[i] = max(R[i], S[15 - i]);
    TK_CE(R[0], R[8]); TK_CE(R[1], R[9]); TK_CE(R[2], R[10]); TK_CE(R[3], R[11]); TK_CE(R[4], R[12]); TK_CE(R[5], R[13]); TK_CE(R[6], R[14]); TK_CE(R[7], R[15]); TK_CE(R[0], R[4]); TK_CE(R[1], R[5]); TK_CE(R[2], R[6]); TK_CE(R[3], R[7]); TK_CE(R[8], R[12]); TK_CE(R[9], R[13]); TK_CE(R[10], R[14]); TK_CE(R[11], R[15]); TK_CE(R[0], R[2]); TK_CE(R[1], R[3]); TK_CE(R[4], R[6]); TK_CE(R[5], R[7]); TK_CE(R[8], R[10]); TK_CE(R[9], R[11]); TK_CE(R[12], R[14]); TK_CE(R[13], R[15]); TK_CE(R[0], R[1]); TK_CE(R[2], R[3]); TK_CE(R[4], R[5]); TK_CE(R[6], R[7]); TK_CE(R[8], R[9]); TK_CE(R[10], R[11]); TK_CE(R[12], R[13]); TK_CE(R[14], R[15]);
}
__device__ __forceinline__ unsigned tk_ckey(float sum, unsigned payload) { const unsigned b = __float_as_uint(sum); const unsigned mono = b ^ ((unsigned)((int)b >> 31) | 0x80000000u); return (mono & 0xFFFFC000u) | payload; }
__device__ __forceinline__ void topk128(const u32x4* r, unsigned (&L)[16]) {
    u32x4 c0 = r[0], c1 = r[64];
    for (int c = 0; c < 8; ++c) {
        const u32x4 n0 = r[64 * ((2 * c + 2) & 15)], n1 = r[64 * ((2 * c + 3) & 15)];
        const unsigned kb = 0xFFFFu - 16u * (unsigned)c; unsigned x[16];
#pragma unroll
        for (int d = 0; d < 4; ++d) {
            unsigned w = c0[d]; unsigned msk = ((w >> 15) & 0x00010001u) * 0xFFFFu; w ^= (msk | 0x80008000u);
            x[2 * d] = (w << 16) | (kb - 2u * d); x[2 * d + 1] = (w & 0xFFFF0000u) | (kb - 2u * d - 1u);
            w = c1[d]; msk = ((w >> 15) & 0x00010001u) * 0xFFFFu; w ^= (msk | 0x80008000u);
            x[8 + 2 * d] = (w << 16) | (kb - 8u - 2u * d); x[8 + 2 * d + 1] = (w & 0xFFFF0000u) | (kb - 8u - 2u * d - 1u);
        }
        tk_sort16(x);
        if (c == 0) {
#pragma unroll
            for (int q = 0; q < 16; ++q) L[q] = x[q];
        } else tk_merge16(L, x);
        c0 = n0; c1 = n1;
    }
}
__device__ __forceinline__ void phase_topk(const Params& P) {
    const int gl = blockIdx.x * NTHR + threadIdx.x, nl = gridDim.x * NTHR;
    const bf16* Sc = (const bf16*)(P.ws + WS_S); int* IDS = (int*)(P.ws + WS_IDS); float* GATES = (float*)(P.ws + WS_GATES);
    for (int item = gl; item < M * 8; item += nl) {
        const u32x4* row = (const u32x4*)Sc + (size_t)((item >> 6) * 32) * 64 + (item & 63);
        unsigned L0[16], L1[16];
        topk128(row, L0); topk128(row + 16 * 64, L1);
        float f0[16], f1[16]; unsigned p0[16], p1[16];
#pragma unroll
        for (int i = 0; i < 16; ++i) {
            f0[i] = __uint_as_float((L0[i] & 0x80000000u) ? (L0[i] & 0x7FFF0000u) : (~L0[i] & 0xFFFF0000u)); p0[i] = (~L0[i] & 0x7Fu) << 7;
            f1[i] = __uint_as_float((L1[i] & 0x80000000u) ? (L1[i] & 0x7FFF0000u) : (~L1[i] & 0xFFFF0000u)); p1[i] = (~L1[i] & 0x7Fu);
        }
        unsigned C[16];
        { unsigned x[16] = {tk_ckey(f0[0] + f1[0], p0[0] | p1[0]), tk_ckey(f0[0] + f1[1], p0[0] | p1[1]), tk_ckey(f0[0] + f1[2], p0[0] | p1[2]), tk_ckey(f0[0] + f1[3], p0[0] | p1[3]), tk_ckey(f0[0] + f1[4], p0[0] | p1[4]), tk_ckey(f0[0] + f1[5], p0[0] | p1[5]), tk_ckey(f0[0] + f1[6], p0[0] | p1[6]), tk_ckey(f0[0] + f1[7], p0[0] | p1[7]), tk_ckey(f0[0] + f1[8], p0[0] | p1[8]), tk_ckey(f0[0] + f1[9], p0[0] | p1[9]), tk_ckey(f0[0] + f1[10], p0[0] | p1[10]), tk_ckey(f0[0] + f1[11], p0[0] | p1[11]), tk_ckey(f0[0] + f1[12], p0[0] | p1[12]), tk_ckey(f0[0] + f1[13], p0[0] | p1[13]), tk_ckey(f0[0] + f1[14], p0[0] | p1[14]), tk_ckey(f0[0] + f1[15], p0[0] | p1[15])};
          tk_sort16(x);
#pragma unroll
          for (int q = 0; q < 16; ++q) C[q] = x[q]; }
        { unsigned x[16] = {tk_ckey(f0[1] + f1[0], p0[1] | p1[0]), tk_ckey(f0[1] + f1[1], p0[1] | p1[1]), tk_ckey(f0[1] + f1[2], p0[1] | p1[2]), tk_ckey(f0[1] + f1[3], p0[1] | p1[3]), tk_ckey(f0[1] + f1[4], p0[1] | p1[4]), tk_ckey(f0[1] + f1[5], p0[1] | p1[5]), tk_ckey(f0[1] + f1[6], p0[1] | p1[6]), tk_ckey(f0[1] + f1[7], p0[1] | p1[7]), tk_ckey(f0[2] + f1[0], p0[2] | p1[0]), tk_ckey(f0[2] + f1[1], p0[2] | p1[1]), tk_ckey(f0[2] + f1[2], p0[2] | p1[2]), tk_ckey(f0[2] + f1[3], p0[2] | p1[3]), tk_ckey(f0[2] + f1[4], p0[2] | p1[4]), tk_ckey(f0[3] + f1[0], p0[3] | p1[0]), tk_ckey(f0[3] + f1[1], p0[3] | p1[1]), tk_ckey(f0[3] + f1[2], p0[3] | p1[2])};
          tk_sort16(x); tk_merge16(C, x); }
        { unsigned x[16] = {tk_ckey(f0[3] + f1[3], p0[3] | p1[3]), tk_ckey(f0[4] + f1[0], p0[4] | p1[0]), tk_ckey(f0[4] + f1[1], p0[4] | p1[1]), tk_ckey(f0[4] + f1[2], p0[4] | p1[2]), tk_ckey(f0[5] + f1[0], p0[5] | p1[0]), tk_ckey(f0[5] + f1[1], p0[5] | p1[1]), tk_ckey(f0[6] + f1[0], p0[6] | p1[0]), tk_ckey(f0[6] + f1[1], p0[6] | p1[1]), tk_ckey(f0[7] + f1[0], p0[7] | p1[0]), tk_ckey(f0[7] + f1[1], p0[7] | p1[1]), tk_ckey(f0[8] + f1[0], p0[8] | p1[0]), tk_ckey(f0[9] + f1[0], p0[9] | p1[0]), tk_ckey(f0[10] + f1[0], p0[10] | p1[0]), tk_ckey(f0[11] + f1[0], p0[11] | p1[0]), tk_ckey(f0[12] + f1[0], p0[12] | p1[0]), tk_ckey(f0[13] + f1[0], p0[13] | p1[0])};
          tk_sort16(x); tk_merge16(C, x); }
        { unsigned key = tk_ckey(f0[14] + f1[0], p0[14] | p1[0]); TK_INS(C, key); }
        { unsigned key = tk_ckey(f0[15] + f1[0], p0[15] | p1[0]); TK_INS(C, key); }
        float cv[16];
#pragma unroll
        for (int r = 0; r < 16; ++r) cv[r] = __uint_as_float((C[r] & 0x80000000u) ? (C[r] & 0x7FFFC000u) : (~C[r] & 0xFFFFC000u));
        const float cmax = cv[0]; float den = 0.f;
#pragma unroll
        for (int r = 0; r < 16; ++r) { cv[r] = __expf(cv[r] - cmax); den += cv[r]; }
        const float inv = 1.f / den;
        const int oi = ((((item >> 9) << 6) | (item & 63)) << 3) | ((item >> 6) & 7);
        u32x4* ido = (u32x4*)(IDS + (size_t)oi * 16); f32x4* go = (f32x4*)(GATES + (size_t)oi * 16);
#pragma unroll
        for (int q = 0; q < 4; ++q) { u32x4 o; o.x = C[4 * q] & 0x3FFFu; o.y = C[4 * q + 1] & 0x3FFFu; o.z = C[4 * q + 2] & 0x3FFFu; o.w = C[4 * q + 3] & 0x3FFFu; ido[q] = o;
            f32x4 g; g[0] = cv[4 * q] * inv; g[1] = cv[4 * q + 1] * inv; g[2] = cv[4 * q + 2] * inv; g[3] = cv[4 * q + 3] * inv; go[q] = g; }
    }
}

#define XB_TMO      128
#define XB_XCNT(j)  (256  + 64 * (j))
#define XB_XSUB(j)  (1280 + 64 * (j))
#define XB_XGEN(j)  (2304 + 64 * (j))
#define XB_TOP      3328
#define XB_TOPGEN   3392
#define XCD_BAR_WORDS 3456
#define XB_SPIN_CAP (1u << 18)
__device__ __forceinline__ unsigned xb_ld(unsigned* p)              { return __hip_atomic_load(p, __ATOMIC_RELAXED, __HIP_MEMORY_SCOPE_AGENT); }
__device__ __forceinline__ unsigned xb_add(unsigned* p, unsigned v) { return __hip_atomic_fetch_add(p, v, __ATOMIC_RELAXED, __HIP_MEMORY_SCOPE_AGENT); }
__device__ __forceinline__ unsigned xb_xcc_id() { return (unsigned)__builtin_amdgcn_s_getreg((3 << 11) | 20) & 0xFu; }
#define XB_SPIN(cond, bar) do { unsigned _sp = 0; while (cond) { __builtin_amdgcn_s_sleep(1); \
    if ((++_sp & 255u) == 0u) { if (xb_ld(&(bar)[XB_TMO])) break; if (_sp > XB_SPIN_CAP) { atomicAdd(&(bar)[XB_TMO], 1u); break; } } } } while (0)
struct XcdBarrier { unsigned* bar; unsigned x; volatile LAS unsigned* st; };
__device__ __forceinline__ XcdBarrier xcd_barrier_post(unsigned* bar, volatile LAS unsigned* st) {
    XcdBarrier b; b.bar = bar; b.x = xb_xcc_id(); b.st = st;
    if (threadIdx.x == 0) { const unsigned r = xb_add(&bar[XB_XCNT(b.x)], 1u); st[4] = r; st[5] = b.x; }
    return b;
}
__device__ __forceinline__ void xcd_barrier_complete(unsigned* bar, unsigned x, unsigned& nloc, unsigned& nx) {
    const unsigned G = gridDim.x * gridDim.y * gridDim.z;
    unsigned sum, cnt, mine, sp = 0u;
    for (;;) {
        sum = 0u; cnt = 0u; mine = 0u;
#pragma unroll
        for (unsigned j = 0; j < 16; ++j) { const unsigned c = xb_ld(&bar[XB_XCNT(j)]); sum += c; cnt += (c > 0u) ? 1u : 0u; mine = (j == x) ? c : mine; }
        if (sum == G) break;
        __builtin_amdgcn_s_sleep(1);
        if ((++sp & 255u) == 0u) { if (xb_ld(&bar[XB_TMO])) break; if (sp > XB_SPIN_CAP) { atomicAdd(&bar[XB_TMO], 1u); break; } }
    }
    nloc = mine > 0u ? mine : 1u; nx = cnt > 0u ? cnt : 1u;
}
__device__ __forceinline__ void xcd_barrier(const XcdBarrier& b) {
    asm volatile("s_waitcnt vmcnt(0)" ::: "memory");
    __syncthreads();
    if (threadIdx.x == 0) {
        unsigned* bar = b.bar;
        __builtin_amdgcn_s_waitcnt(0);
        unsigned nloc = b.st[0], nx = b.st[1];
        if (nloc == 0u) { xcd_barrier_complete(bar, b.x, nloc, nx); b.st[0] = nloc; b.st[1] = nx; }
        const unsigned old = xb_add(&bar[XB_XSUB(b.x)], 1u);
        const unsigned gen = old / nloc;
        if (old + 1u == (gen + 1u) * nloc) {
            __builtin_amdgcn_fence(__ATOMIC_RELEASE, "agent");
            asm volatile("s_waitcnt vmcnt(0)" ::: "memory");
            const unsigned og = xb_add(&bar[XB_TOP], 1u);
            const unsigned tg = og / nx;
            if (og + 1u == (tg + 1u) * nx) xb_add(&bar[XB_TOPGEN], 1u);
            else XB_SPIN(xb_ld(&bar[XB_TOPGEN]) == tg, bar);
            __builtin_amdgcn_fence(__ATOMIC_ACQUIRE, "agent");
            xb_add(&bar[XB_XGEN(b.x)], 1u);
            asm volatile("s_waitcnt vmcnt(0)" ::: "memory");
        } else {
            XB_SPIN(xb_ld(&bar[XB_XGEN(b.x)]) == gen, bar);
            __builtin_amdgcn_fence(__ATOMIC_ACQUIRE, "agent");
            asm volatile("s_waitcnt vmcnt(0)" ::: "memory");
        }
    }
    __syncthreads();
}

typedef int v8i_t __attribute__((ext_vector_type(8)));
#define PD_LO 1
struct PdTok { int idl, idh; unsigned hw; };
__device__ __forceinline__ PdTok pd_fetch(const int* IDS, const unsigned char* H8s, int m, int lane) {
    PdTok t; t.idl = IDS[(size_t)m * 128 + lane]; t.idh = IDS[(size_t)m * 128 + 64 + lane]; t.hw = *(const unsigned*)(H8s + (size_t)m * 2048); return t;
}
__device__ __forceinline__ void pd_issue(u32x4 (&X0)[8], u32x4 (&X1)[8], const PdTok& t, const unsigned char* UFs, LAS unsigned char* slot, int lane) {
#pragma unroll
    for (int g = 0; g < 8; ++g) { const unsigned id = (unsigned)__builtin_amdgcn_ds_bpermute(4 * (16 * (g & 3) + (lane >> 2)), g < 4 ? t.idl : t.idh);
        const u32x4* rp = (const u32x4*)(UFs + ((id << 7) + 16u * (unsigned)(lane & 3))); X0[g] = rp[0]; X1[g] = rp[4]; }
    *(LAS unsigned*)(slot + 4 * lane) = t.hw;
}
__device__ __forceinline__ float pd_trace(const f32x4 v) {
    const float v0 = v[0], v1 = v[1], v2 = v[2], v3 = v[3];
#define PD_BC(x, ctrl) __builtin_bit_cast(float, __builtin_amdgcn_update_dpp(0, __builtin_bit_cast(int, (x)), (ctrl), 0xf, 0xf, true))
    float s = PD_BC(v0, 0x00); s += PD_BC(v1, 0x55); s += PD_BC(v2, 0xAA); s += PD_BC(v3, 0xFF); return s;
#undef PD_BC
}
__device__ __forceinline__ void pd_compute(const u32x4 (&X0)[8], const u32x4 (&X1)[8], const LAS unsigned char* arp, unsigned* PDs, int m, int lane) {
    const int q = lane & 3;
    float dl = 0.f, dh = 0.f;
    const LAS u32x4* hp = (const LAS u32x4*)arp; const u32x4 A0 = hp[0], A1 = hp[4];
#if PD_LO
    const u32x4 A2 = hp[8], A3 = hp[12];
#endif
    const v8i_t ah = {(int)A0.x, (int)A0.y, (int)A0.z, (int)A0.w, (int)A1.x, (int)A1.y, (int)A1.z, (int)A1.w};
#if PD_LO
    const v8i_t al = {(int)A2.x, (int)A2.y, (int)A2.z, (int)A2.w, (int)A3.x, (int)A3.y, (int)A3.z, (int)A3.w};
#endif
    f32x4 acc[8];
#pragma unroll
    for (int g = 0; g < 8; ++g) { const v8i_t b = {(int)X0[g].x, (int)X0[g].y, (int)X0[g].z, (int)X0[g].w, (int)X1[g].x, (int)X1[g].y, (int)X1[g].z, (int)X1[g].w};
        acc[g] = __builtin_amdgcn_mfma_scale_f32_16x16x128_f8f6f4(ah, b, (f32x4){0.f, 0.f, 0.f, 0.f}, 0, 0, 0, 0, 0, 0); }
#if PD_LO
    __builtin_amdgcn_sched_barrier(0);
#pragma unroll
    for (int g = 0; g < 8; ++g) { const v8i_t b = {(int)X0[g].x, (int)X0[g].y, (int)X0[g].z, (int)X0[g].w, (int)X1[g].x, (int)X1[g].y, (int)X1[g].z, (int)X1[g].w};
        acc[g] = __builtin_amdgcn_mfma_scale_f32_16x16x128_f8f6f4(al, b, acc[g], 0, 0, 0, 0, 0, 0); }
#endif
    __builtin_amdgcn_sched_barrier(0);
#pragma unroll
    for (int g = 0; g < 8; ++g) { const float d = pd_trace(acc[g]);
        if (g < 4) dl = (q == g) ? d : dl; else dh = (q == g - 4) ? d : dh; }
    const int srcl = 4 * (4 * (lane & 15) + (lane >> 4));
    dl = __int_as_float(__builtin_amdgcn_ds_bpermute(srcl, __float_as_int(dl))); dh = __int_as_float(__builtin_amdgcn_ds_bpermute(srcl, __float_as_int(dh)));
    PDs[(size_t)m * 64 + lane] = pk2(dl, dh);
}
__device__ __forceinline__ void phase_peer_dots(const Params& P, LAS unsigned char* lds) {
    const int lane = threadIdx.x & 63, wave = __builtin_amdgcn_readfirstlane(threadIdx.x >> 6);
    const int* IDS = (const int*)(P.ws + WS_IDS); unsigned* PD = (unsigned*)(P.ws + WS_PD);
    volatile LAS unsigned* bst = (volatile LAS unsigned*)(lds + LDS_MISC);
    const unsigned rank = __builtin_amdgcn_readfirstlane(bst[4]), x = __builtin_amdgcn_readfirstlane(bst[5]);
    unsigned* bar = (unsigned*)(P.ws + WS_CTL);
    unsigned n = 1, xi = 0, nx = 0;
    for (unsigned j = 0; j < 16; ++j) { const unsigned cnt = __builtin_amdgcn_readfirstlane(xb_ld(&bar[XB_XCNT(j)])); if (cnt) { if (j < x) ++xi; ++nx; } if (j == x) n = cnt; }
    if (nx == 0) nx = 1; if (n == 0) n = 1;
    constexpr int NCW = NWAVES - 1;
    const int stride = (int)n * NCW; const bool arow = ((lane >> 2) & 3) == (lane >> 4);
    LAS unsigned char* slot0 = lds + wave * 512; LAS unsigned char* slot1 = slot0 + 256; LAS unsigned char* zer = lds + NWAVES * 512;
    volatile LAS unsigned* prog = (volatile LAS unsigned*)(zer + 256);
    __syncthreads();
    if (threadIdx.x < 80) ((LAS unsigned*)zer)[threadIdx.x] = 0u;
    __syncthreads();
    if (wave == NCW) {
        constexpr unsigned AHEAD = 600;
        unsigned base = 0;
        for (unsigned s = xi; s < 8; s += nx) {
            const int r7 = (int)rank * NCW; unsigned total = 0;
            for (int w = 0; w < NCW; ++w) { const int m0 = r7 + w; total += (m0 < M) ? (unsigned)((M - m0 + stride - 1) / stride) : 0u; }
            const int tk = lane / 6, ln = lane - 6 * tk;
            for (unsigned done = 0; done < total; ) {
                if (done + base < *prog + AHEAD) {
                    const unsigned char* pa[4];
#pragma unroll
                    for (int k = 0; k < 4; ++k) { unsigned j = done + 10u * k + (unsigned)(tk < 10 ? tk : 9); if (j >= total) j = total - 1;
                        const int i = (int)(j / NCW), w = (int)(j - (unsigned)i * NCW); int m = r7 + w + i * stride; if (m >= M) m = r7;
                        pa[k] = (ln < 4) ? (const unsigned char*)IDS + (size_t)m * 512 + 128 * ln : P.ws + WS_H8 + (size_t)m * 2048 + 128 * s + 1024 * (ln - 4); }
                    unsigned d0, d1, d2, d3;
                    asm volatile("global_load_dword %0, %4, off\n\tglobal_load_dword %1, %5, off\n\tglobal_load_dword %2, %6, off\n\tglobal_load_dword %3, %7, off\n\ts_waitcnt vmcnt(0)"
                                 : "=&v"(d0), "=&v"(d1), "=&v"(d2), "=&v"(d3) : "v"(pa[0]), "v"(pa[1]), "v"(pa[2]), "v"(pa[3]) : "memory");
                    done += 40;
                } else __builtin_amdgcn_s_sleep(4);
            }
            base += total;
        }
        return;
    }
    const LAS unsigned char* ar0 = arow ? slot0 + 16 * (lane & 3) : zer; const LAS unsigned char* ar1 = arow ? slot1 + 16 * (lane & 3) : zer;
    for (unsigned s = xi; s < 8; s += nx) {
        const unsigned char* UFs = P.ws + WS_UF + (size_t)s * UF_SLICE;
        const unsigned char* H8s = P.ws + WS_H8 + 128 * s + (lane < 32 ? 4 * lane : 1024 + 4 * (lane - 32)); unsigned* PDs = PD + (size_t)s * M * 64;
        const int m0 = (int)rank * NCW + wave;
        if (m0 >= M) continue;
        const int cnt = (M - m0 + stride - 1) / stride;
#define PD_TOK(i) ((i) < cnt ? m0 + (i) * stride : m0)
        u32x4 RA4[8], RB4[8], RA2[8], RB2[8];
        PdTok t0 = pd_fetch(IDS, H8s, m0, lane), t1 = pd_fetch(IDS, H8s, PD_TOK(1), lane), t2 = pd_fetch(IDS, H8s, PD_TOK(2), lane);
        pd_issue(RA4, RA2, t0, UFs, slot0, lane);
        for (int i = 0; i < cnt; i += 2) {
            const int ma = PD_TOK(i), mb = PD_TOK(i + 1);
            const PdTok t3 = pd_fetch(IDS, H8s, PD_TOK(i + 3), lane);
            pd_issue(RB4, RB2, t1, UFs, slot1, lane);
            __builtin_amdgcn_sched_barrier(0);
            pd_compute(RA4, RA2, ar0, PDs, ma, lane);
            if (lane == 0) __hip_atomic_fetch_add((LAS unsigned*)prog, 1u, __ATOMIC_RELAXED, __HIP_MEMORY_SCOPE_WORKGROUP);
            __builtin_amdgcn_sched_barrier(0);
            const PdTok t4 = pd_fetch(IDS, H8s, PD_TOK(i + 4), lane);
            pd_issue(RA4, RA2, t2, UFs, slot0, lane);
            __builtin_amdgcn_sched_barrier(0);
            pd_compute(RB4, RB2, ar1, PDs, mb, lane);
            if (lane == 0 && i + 1 < cnt) __hip_atomic_fetch_add((LAS unsigned*)prog, 1u, __ATOMIC_RELAXED, __HIP_MEMORY_SCOPE_WORKGROUP);
            __builtin_amdgcn_sched_barrier(0);
            t1 = t3; t2 = t4;
        }
#undef PD_TOK
    }
}

__device__ __forceinline__ void phase_peer_coef(const Params& P) {
    const int lane = threadIdx.x & 63, wave = threadIdx.x >> 6; const int gw = blockIdx.x * NWAVES + wave, ngw = gridDim.x * NWAVES;
    const int* IDS = (const int*)(P.ws + WS_IDS); const float* GATES = (const float*)(P.ws + WS_GATES); const unsigned* PD = (const unsigned*)(P.ws + WS_PD);
    const float* SU = (const float*)(P.ws + WS_SU); const float* SV = (const float*)(P.ws + WS_SV);
    unsigned char* CQ = P.ws + WS_CQ; float* CS = (float*)(P.ws + WS_CS);
    constexpr int TB = 4;
    for (int mb = gw; mb < M; mb += TB * ngw) {
        int id_lo[TB], id_hi[TB]; float gt_lo[TB], gt_hi[TB], d_lo[TB], d_hi[TB], su_lo[TB], su_hi[TB], sv_lo[TB], sv_hi[TB];
#pragma unroll
        for (int t = 0; t < TB; ++t) { const int m = (mb + t * ngw < M) ? mb + t * ngw : mb;
            id_lo[t] = IDS[(size_t)m * 128 + lane]; id_hi[t] = IDS[(size_t)m * 128 + 64 + lane]; gt_lo[t] = GATES[(size_t)m * 128 + lane]; gt_hi[t] = GATES[(size_t)m * 128 + 64 + lane]; }
#pragma unroll
        for (int t = 0; t < TB; ++t) { const int m = (mb + t * ngw < M) ? mb + t * ngw : mb; float a = 0.f, b = 0.f;
#pragma unroll
            for (int s = 0; s < 8; ++s) { const unsigned w = PD[((size_t)s * M + m) * 64 + lane]; a += __uint_as_float(w << 16); b += __uint_as_float(w & 0xffff0000u); }
            d_lo[t] = a; d_hi[t] = b; }
#pragma unroll
        for (int t = 0; t < TB; ++t) { su_lo[t] = SU[id_lo[t]]; su_hi[t] = SU[id_hi[t]]; sv_lo[t] = SV[id_lo[t]]; sv_hi[t] = SV[id_hi[t]]; }
#pragma unroll
        for (int t = 0; t < TB; ++t) { const int m = (mb + t * ngw < M) ? mb + t * ngw : mb;
            const float x_lo = d_lo[t] * su_lo[t], x_hi = d_hi[t] * su_hi[t];
            const float a_lo = 0.5f * x_lo * (1.f + erff(x_lo * 0.70710678118f)) * gt_lo[t] * sv_lo[t], a_hi = 0.5f * x_hi * (1.f + erff(x_hi * 0.70710678118f)) * gt_hi[t] * sv_hi[t];
            const float amx = wave_max_u(fmaxf(fabsf(a_lo), fabsf(a_hi))); const float ainv = amx > 0.f ? 127.f / amx : 0.f;
            const int q_lo = __float2int_rn(a_lo * ainv), q_hi = __float2int_rn(a_hi * ainv);
            const int j0 = lane, j1 = 64 + lane;
            CQ[(size_t)m * 128 + 16 * ((j0 >> 2) & 7) + 4 * (j0 >> 5) + (j0 & 3)] = (unsigned char)q_lo;
            CQ[(size_t)m * 128 + 16 * ((j1 >> 2) & 7) + 4 * (j1 >> 5) + (j1 & 3)] = (unsigned char)q_hi;
            if (lane == 0) CS[m] = amx * (1.f / 127.f); }
    }
}

struct AxTok { u32x4 id[4]; u32x4 cq; float cs; unsigned hw; };
__device__ __forceinline__ void ax_fetch(AxTok& t, const int* IDS, const unsigned char* CQ, const float* CS, const bf16* H1s, int m, int lane) {
    const u32x4* ip = (const u32x4*)(IDS + (size_t)m * 128) + (lane >> 3);
#pragma unroll
    for (int r = 0; r < 4; ++r) t.id[r] = ip[8 * r];
    t.cq = *((const u32x4*)(CQ + (size_t)m * 128) + (lane >> 3)); t.cs = CS[m]; t.hw = *(const unsigned*)(H1s + (size_t)m * D);
}
__device__ __forceinline__ void ax_issue(u32x4 (&W)[4], const u32x4 ids, const unsigned char* V8s, int lane) {
#pragma unroll
    for (int k = 0; k < 4; ++k) W[k] = *(const u32x4*)(V8s + ((ids[k] << 7) + 16u * (unsigned)(lane & 7)));
}
__device__ __forceinline__ void ax_round(const u32x4 (&W)[4], int c4, int (&acc)[16]) {
#pragma unroll
    for (int i = 0; i < 4; ++i) {
        const unsigned t0 = __builtin_amdgcn_perm(W[1][i], W[0][i], 0x05010400u), t1 = __builtin_amdgcn_perm(W[1][i], W[0][i], 0x07030602u);
        const unsigned t2 = __builtin_amdgcn_perm(W[3][i], W[2][i], 0x05010400u), t3 = __builtin_amdgcn_perm(W[3][i], W[2][i], 0x07030602u);
        const unsigned T0 = __builtin_amdgcn_perm(t2, t0, 0x05040100u), T1 = __builtin_amdgcn_perm(t2, t0, 0x07060302u), T2 = __builtin_amdgcn_perm(t3, t1, 0x05040100u), T3 = __builtin_amdgcn_perm(t3, t1, 0x07060302u);
        acc[4 * i] = __builtin_amdgcn_sdot4((int)T0, c4, acc[4 * i], false); acc[4 * i + 1] = __builtin_amdgcn_sdot4((int)T1, c4, acc[4 * i + 1], false);
        acc[4 * i + 2] = __builtin_amdgcn_sdot4((int)T2, c4, acc[4 * i + 2], false); acc[4 * i + 3] = __builtin_amdgcn_sdot4((int)T3, c4, acc[4 * i + 3], false); }
}
__device__ __forceinline__ void ax_finish(int (&acc)[16], float cs, unsigned hw, bf16* ZPs, int m, int lane) {
    const bool b3 = (lane & 8) != 0, b4 = (lane & 16) != 0, b5 = (lane & 32) != 0;
    int w8[8], w4[4], w2[2];
#pragma unroll
    for (int i = 0; i < 8; ++i) { const int keep = b3 ? acc[i + 8] : acc[i], send = b3 ? acc[i] : acc[i + 8]; w8[i] = keep + DPP_I(send, 0x128); }
#pragma unroll
    for (int i = 0; i < 4; ++i) { const int keep = b4 ? w8[i + 4] : w8[i], send = b4 ? w8[i] : w8[i + 4]; w4[i] = keep + __builtin_amdgcn_ds_swizzle(send, 0x401F); }
#pragma unroll
    for (int i = 0; i < 2; ++i) { const int keep = b5 ? w4[i + 2] : w4[i], send = b5 ? w4[i] : w4[i + 2]; w2[i] = keep + __shfl_xor(send, 32); }
    const float z0 = ALPHA * __uint_as_float(hw << 16) + cs * (float)w2[0], z1 = ALPHA * __uint_as_float(hw & 0xffff0000u) + cs * (float)w2[1];
    const int d0 = 16 * (lane & 7) + (b3 ? 8 : 0) + (b4 ? 4 : 0) + (b5 ? 2 : 0);
    *(unsigned*)(ZPs + (size_t)m * D + d0) = pk2(z0, z1);
}
__device__ __forceinline__ void phase_peer_axpy(const Params& P, LAS unsigned char* lds) {
    const int lane = threadIdx.x & 63, wave = __builtin_amdgcn_readfirstlane(threadIdx.x >> 6);
    const int* IDS = (const int*)(P.ws + WS_IDS); const unsigned char* CQ = P.ws + WS_CQ; const float* CS = (const float*)(P.ws + WS_CS);
    volatile LAS unsigned* bst = (volatile LAS unsigned*)(lds + LDS_MISC);
    const unsigned rank = __builtin_amdgcn_readfirstlane(bst[4]), x = __builtin_amdgcn_readfirstlane(bst[5]);
    unsigned* bar = (unsigned*)(P.ws + WS_CTL);
    unsigned n = 1, xi = 0, nx = 0;
    for (unsigned j = 0; j < 16; ++j) { const unsigned cnt = __builtin_amdgcn_readfirstlane(xb_ld(&bar[XB_XCNT(j)])); if (cnt) { if (j < x) ++xi; ++nx; } if (j == x) n = cnt; }
    if (nx == 0) nx = 1; if (n == 0) n = 1;
    constexpr int NCW = NWAVES - 1;
    const int stride = (int)n * NCW;
    volatile LAS unsigned* prog = (volatile LAS unsigned*)lds;
    __syncthreads();
    if (threadIdx.x == 0) *prog = 0u;
    __syncthreads();
    if (wave == NCW) {
        constexpr unsigned AHEAD = 600;
        unsigned base = 0;
        for (unsigned s = xi; s < 8; s += nx) {
            const int r7 = (int)rank * NCW; unsigned total = 0;
            for (int w = 0; w < NCW; ++w) { const int m0 = r7 + w; total += (m0 < M) ? (unsigned)((M - m0 + stride - 1) / stride) : 0u; }
            const int tk = lane >> 3, ln = lane & 7;
            for (unsigned done = 0; done < total; ) {
                if (done + base < *prog + AHEAD) {
                    const unsigned char* pa[4];
#pragma unroll
                    for (int k = 0; k < 4; ++k) { unsigned j = done + 8u * k + (unsigned)tk; if (j >= total) j = total - 1;
                        const int i = (int)(j / NCW), w = (int)(j - (unsigned)i * NCW); int m = r7 + w + i * stride; if (m >= M) m = r7;
                        pa[k] = (ln < 4) ? (const unsigned char*)IDS + (size_t)m * 512 + 128 * ln : (ln == 4) ? CQ + (size_t)m * 128 : (ln < 7) ? P.ws + WS_H1 + (size_t)m * 2048 + 256 * s + 128 * (ln - 5) : (const unsigned char*)(CS + m); }
                    unsigned d0, d1, d2, d3;
                    asm volatile("global_load_dword %0, %4, off\n\tglobal_load_dword %1, %5, off\n\tglobal_load_dword %2, %6, off\n\tglobal_load_dword %3, %7, off\n\ts_waitcnt vmcnt(0)"
                                 : "=&v"(d0), "=&v"(d1), "=&v"(d2), "=&v"(d3) : "v"(pa[0]), "v"(pa[1]), "v"(pa[2]), "v"(pa[3]) : "memory");
                    done += 32;
                } else __builtin_amdgcn_s_sleep(4);
            }
            base += total;
        }
        return;
    }
    const int dsel = 16 * (lane & 7) + ((lane & 8) ? 8 : 0) + ((lane & 16) ? 4 : 0) + ((lane & 32) ? 2 : 0);
    for (unsigned s = xi; s < 8; s += nx) {
        const unsigned char* V8s = P.ws + WS_V8 + (size_t)s * V8_SLICE;
        const bf16* H1s = (const bf16*)(P.ws + WS_H1) + 128 * s + dsel; bf16* ZPs = (bf16*)(P.ws + WS_ZP) + 128 * s;
        const int m0 = (int)rank * NCW + wave;
        if (m0 >= M) continue;
        const int cnt = (M - m0 + stride - 1) / stride;
#define AX_TOK(i) ((i) < cnt ? m0 + (i) * stride : m0)
        u32x4 W0[4], W1[4], W2[4], W3[4];
        AxTok ta, tb, tc; ax_fetch(ta, IDS, CQ, CS, H1s, m0, lane); ax_fetch(tb, IDS, CQ, CS, H1s, AX_TOK(1), lane);
        ax_issue(W0, ta.id[0], V8s, lane); ax_issue(W1, ta.id[1], V8s, lane); ax_issue(W2, ta.id[2], V8s, lane);
#define AX_STEP(CUR, NXT, FRE, ii) do { \
            const int ma_ = AX_TOK(ii); \
            ax_fetch(FRE, IDS, CQ, CS, H1s, AX_TOK((ii) + 2), lane); \
            int acc[16]; \
            _Pragma("unroll") for (int j = 0; j < 16; ++j) acc[j] = 0; \
            ax_issue(W3, CUR.id[3], V8s, lane); __builtin_amdgcn_sched_barrier(0); ax_round(W0, (int)CUR.cq[0], acc); __builtin_amdgcn_sched_barrier(0); \
            ax_issue(W0, NXT.id[0], V8s, lane); __builtin_amdgcn_sched_barrier(0); ax_round(W1, (int)CUR.cq[1], acc); __builtin_amdgcn_sched_barrier(0); \
            ax_issue(W1, NXT.id[1], V8s, lane); __builtin_amdgcn_sched_barrier(0); ax_round(W2, (int)CUR.cq[2], acc); __builtin_amdgcn_sched_barrier(0); \
            ax_issue(W2, NXT.id[2], V8s, lane); __builtin_amdgcn_sched_barrier(0); ax_round(W3, (int)CUR.cq[3], acc); __builtin_amdgcn_sched_barrier(0); \
            ax_finish(acc, CUR.cs, CUR.hw, ZPs, ma_, lane); \
            if (lane == 0 && (ii) < cnt) __hip_atomic_fetch_add((LAS unsigned*)prog, 1u, __ATOMIC_RELAXED, __HIP_MEMORY_SCOPE_WORKGROUP); } while (0)
        for (int i = 0; i < cnt; i += 3) { AX_STEP(ta, tb, tc, i); AX_STEP(tb, tc, ta, i + 1); AX_STEP(tc, ta, tb, i + 2); }
#undef AX_STEP
#undef AX_TOK
    }
}

__device__ __forceinline__ void phase_ln2(const Params& P) {
    const int lane = threadIdx.x & 63, wave = threadIdx.x >> 6; const int gw = blockIdx.x * NWAVES + wave, ngw = gridDim.x * NWAVES;
    const float* g2 = P.in[26]; const float* b2 = P.in[27]; const bf16* ZP = (const bf16*)(P.ws + WS_ZP);
    for (int m = gw; m < M; m += ngw) {
        const u32x4* xr = (const u32x4*)(ZP + (size_t)m * D) + 2 * lane; const u32x4 a = xr[0], c = xr[1]; float v[16]; float s = 0.f;
#pragma unroll
        for (int i = 0; i < 4; ++i) { v[2 * i] = __uint_as_float(a[i] << 16); v[2 * i + 1] = __uint_as_float(a[i] & 0xffff0000u); v[8 + 2 * i] = __uint_as_float(c[i] << 16); v[8 + 2 * i + 1] = __uint_as_float(c[i] & 0xffff0000u); }
#pragma unroll
        for (int i = 0; i < 16; ++i) s += v[i];
        const float mean = wave_sum(s) * (1.f / D); float s2 = 0.f;
#pragma unroll
        for (int i = 0; i < 16; ++i) { v[i] -= mean; s2 += v[i] * v[i]; }
        const float rstd = 1.f / sqrtf(wave_sum(s2) * (1.f / D) + LN_EPS);
#pragma unroll
        for (int c4 = 0; c4 < 4; ++c4) { const int e0 = 16 * lane + 4 * c4; const f32x4 gg = *(const f32x4*)(g2 + e0), bb = *(const f32x4*)(b2 + e0); f32x4 o;
#pragma unroll
            for (int j = 0; j < 4; ++j) o[j] = v[c4 * 4 + j] * rstd * gg[j] + bb[j];
            *(f32x4*)(P.out + (size_t)m * D + e0) = o; }
    }
}

constexpr int N_PHASES = 14;
__global__ void __launch_bounds__(NTHR, 2) fwd_kernel(Params P) {
    extern __shared__ __attribute__((aligned(16))) unsigned char lds_raw[];
    LAS unsigned char* lds = (LAS unsigned char*)lds_raw;
    cg::grid_group grid = cg::this_grid();
    const int lo = P.ph_lo, hi = P.ph_hi;
    unsigned char* ws = P.ws;
    volatile LAS unsigned* bst = (volatile LAS unsigned*)(lds + LDS_MISC);
    if (threadIdx.x < 16) bst[threadIdx.x] = 0u;
    __syncthreads();
    const XcdBarrier bar = xcd_barrier_post((unsigned*)(ws + WS_CTL), bst);
#define IN(k) (lo <= (k) && (k) < hi)
#define SEAM(k) do { if (IN(k) && IN((k) + 1)) { if ((k) == 0) grid.sync(); else xcd_barrier(bar); } } while (0)
    if (IN(0)) phase_prologue(P, lds);
    SEAM(0);
    if (IN(1)) {
        pg8::Gemm g{(const bf16*)(ws + WS_H0), (const bf16*)(ws + WS_WIN), M, NP, D, D, D, 0}; pg8::StaticOrder S; S.init(M, NP, gridDim.x, blockIdx.x);
        pg8::EpiBf16 E{(bf16*)(ws + WS_P), NP};
        pg8::gemm_phase<pg8::EpiBf16, pg8::StaticOrder, true, true>(lds, g, S, E);
    }
    SEAM(1);
    if (IN(2)) phase_prep(P, lds);
    SEAM(2);
    if (IN(3)) phase_scan(P, lds);
    SEAM(3);
    if (IN(4)) phase_fixup(P, lds);
    SEAM(4);
    if (IN(5)) phase_correct(P, lds);
    SEAM(5);
    if (IN(6)) {
        pg8::Gemm g{(const bf16*)P.out, (const bf16*)(ws + WS_WOUT), M, D, D, D, D, 0}; pg8::StaticOrder S; S.init(M, D, gridDim.x, blockIdx.x);
        pg8::EpiResBf16 E{(bf16*)(ws + WS_Z), (const bf16*)(ws + WS_H0), D, ALPHA};
        pg8::gemm_phase<pg8::EpiResBf16, pg8::StaticOrder, true, true>(lds, g, S, E);
    }
    SEAM(6);
    if (IN(7)) phase_ln1(P);
    SEAM(7);
    if (IN(8)) {
        pg8::Gemm g{(const bf16*)(ws + WS_H1), (const bf16*)(ws + WS_WQ), M, NQ, D, D, D, 0}; pg8::StaticOrder S; S.init(M, NQ, gridDim.x, blockIdx.x);
        pg8::EpiScores E{(bf16*)(ws + WS_S)};
        pg8::gemm_phase<pg8::EpiScores, pg8::StaticOrder, true, true>(lds, g, S, E);
    }
    SEAM(8);
    if (IN(9)) phase_topk(P);
    SEAM(9);
    if (IN(10)) phase_peer_dots(P, lds);
    SEAM(10);
    if (IN(11)) phase_peer_coef(P);
    SEAM(11);
    if (IN(12)) phase_peer_axpy(P, lds);
    SEAM(12);
    if (IN(13)) phase_ln2(P);
#undef IN
#undef SEAM
}

extern "C" void kernel_launch(void* const* d_in, const int* in_sizes, int n_in, void* d_out, int out_size, void* d_ws, size_t ws_size, hipStream_t stream) {
    static int grid = 0;
    if (grid == 0) {
        if (n_in != 28 || out_size != M * D || ws_size < WS_END) { fprintf(stderr, "kernel_launch: unexpected shapes (n_in %d out %d ws %zu)\n", n_in, out_size, ws_size); grid = -1; return; }
        int dev = 0, cus = 0, per_cu = 0;
        (void)hipGetDevice(&dev); (void)hipDeviceGetAttribute(&cus, hipDeviceAttributeMultiprocessorCount, dev);
        (void)hipFuncSetAttribute((const void*)fwd_kernel, hipFuncAttributeMaxDynamicSharedMemorySize, LDS_BYTES);
        (void)hipOccupancyMaxActiveBlocksPerMultiprocessor(&per_cu, (const void*)fwd_kernel, NTHR, LDS_BYTES);
        if (per_cu < 1) { fprintf(stderr, "kernel_launch: occupancy query says %d blocks per CU\n", per_cu); per_cu = 1; }
        (void)hipGetLastError();
        grid = cus;
    }
    if (grid < 0) return;
    Params p{};
    for (int i = 0; i < 28; ++i) p.in[i] = (const float*)d_in[i];
    p.out = (float*)d_out; p.ws = (unsigned char*)d_ws;
    (void)hipMemsetAsync((char*)d_ws + WS_CTL, 0, CTL_BYTES, stream);
    p.ph_lo = 0; p.ph_hi = N_PHASES;
    void* args[] = {&p};
    hipError_t e = hipLaunchCooperativeKernel((const void*)fwd_kernel, dim3(grid), dim3(NTHR), args, LDS_BYTES, stream);
    if (e != hipSuccess) fprintf(stderr, "cooperative launch failed: %s (grid %d)\n", hipGetErrorString(e), grid);
}
```

```cpp
#include <hip/hip_runtime.h>
#include <hip/hip_cooperative_groups.h>
#include <cstdio>
#include <cstdint>
namespace cg = cooperative_groups;

namespace pg8 {
#define PG8_LAS __attribute__((address_space(3)))
typedef unsigned short bf16_t;
typedef short bf16x8 __attribute__((ext_vector_type(8)));
typedef float f32x4 __attribute__((ext_vector_type(4)));
typedef float f32x2 __attribute__((ext_vector_type(2)));
typedef unsigned u32x4 __attribute__((ext_vector_type(4)));
typedef unsigned u32x2 __attribute__((ext_vector_type(2)));
constexpr int BM = 256, BK = 64, HALF = 128, HTB = HALF * BK * 2, STAGE_BYTES = 8 * HTB, NXCD = 8, WGM = 8;

__host__ __device__ __forceinline__ int lds_byte(int r, int c) { const int st = (r >> 4) * 2 + (c >> 5), rr = r & 15, cc = c & 31, ob = rr * 64 + cc * 2; return st * 1024 + (ob ^ (((ob >> 9) & 1) << 5)); }
__host__ __device__ __forceinline__ void stage_rc(int b, int& R, int& C) { const int st = b / 1024, sb = b % 1024, swz = sb ^ (((sb >> 9) & 1) << 5); R = (st >> 1) * 16 + swz / 64; C = (st & 1) * 32 + (swz % 64) / 2; }
__host__ __device__ __forceinline__ int perm32(int rho) { const int n = rho >> 4, i = rho & 15; return 8 * (i >> 2) + 4 * n + (i & 3); }

struct Unit { int pm, pn; };
struct Gemm { const bf16_t* A; const bf16_t* Bt; int M, N, K, lda, ldb, a_pn_koff; };

struct StaticOrder {
    int nM, nN, nwg, G, c;
    __host__ __device__ void init(int M, int N, int G_, int c_) { nM = M / BM; nN = N / BM; nwg = nM * nN; G = G_; c = c_; }
    __host__ __device__ bool next(int i, Unit& u) const {
        const long L = (long)i * G + c; if (L >= nwg) return false;
        int wgid = (int)L; { const int q = nwg / NXCD, r = nwg % NXCD, xcd = wgid % NXCD, off = wgid / NXCD; wgid = (xcd < r ? xcd * (q + 1) : r * (q + 1) + (xcd - r) * q) + off; }
        const int nig = WGM * nN, gid = wgid / nig, fm = gid * WGM, gsz = (nM - fm) < WGM ? (nM - fm) : WGM;
        u.pm = fm + ((wgid % nig) % gsz); u.pn = (wgid % nig) / gsz; return true;
    }
    __device__ __forceinline__ void a_ready(const Unit&) const {}
    __device__ __forceinline__ void done(const Unit&) const {}
};

typedef float f32x2p_t __attribute__((ext_vector_type(2))); typedef __bf16 bf16x2p_t __attribute__((ext_vector_type(2)));
__device__ __forceinline__ unsigned cvt_pk_bf16(float lo, float hi) { const f32x2p_t v = {lo, hi}; const bf16x2p_t b = __builtin_convertvector(v, bf16x2p_t); return __builtin_bit_cast(unsigned, b); }

struct EpiScores {
    static constexpr bool PERM = true;
    bf16_t* O;
    __device__ __forceinline__ void operator()(const f32x4 (&acc)[2][2][4][2], const Unit& u, int wr, int wc, int fr, int fq) const {
        const int row0 = u.pm * BM + wr * 64 + fr;
#pragma unroll
        for (int ai = 0; ai < 2; ++ai)
#pragma unroll
            for (int m = 0; m < 4; ++m) { const int row = row0 + ai * HALF + m * 16;
                bf16_t* tp = O + ((size_t)((row >> 6) * (2048 / BM) + u.pn) * 32 * 64 + (row & 63)) * 8;
#pragma unroll
                for (int bj = 0; bj < 2; ++bj) { const f32x4 v0 = acc[ai][bj][m][0], v1 = acc[ai][bj][m][1];
                    u32x4 w; w.x = cvt_pk_bf16(v0[0], v0[1]); w.y = cvt_pk_bf16(v0[2], v0[3]); w.z = cvt_pk_bf16(v1[0], v1[1]); w.w = cvt_pk_bf16(v1[2], v1[3]);
                    *(u32x4*)(tp + (size_t)(4 * wc + fq + 16 * bj) * 64 * 8) = w; } }
    }
};
struct EpiBf16 {
    static constexpr bool PERM = true;
    bf16_t* O; int ldc;
    __device__ __forceinline__ void operator()(const f32x4 (&acc)[2][2][4][2], const Unit& u, int wr, int wc, int fr, int fq) const {
        const int row0 = u.pm * BM + wr * 64 + fr; const int col0 = u.pn * BM + wc * 32 + 8 * fq;
#pragma unroll
        for (int ai = 0; ai < 2; ++ai)
#pragma unroll
            for (int m = 0; m < 4; ++m) { bf16_t* rowp = O + (size_t)(row0 + ai * HALF + m * 16) * ldc + col0;
#pragma unroll
                for (int bj = 0; bj < 2; ++bj) { const f32x4 v0 = acc[ai][bj][m][0], v1 = acc[ai][bj][m][1];
                    u32x4 w; w.x = cvt_pk_bf16(v0[0], v0[1]); w.y = cvt_pk_bf16(v0[2], v0[3]); w.z = cvt_pk_bf16(v1[0], v1[1]); w.w = cvt_pk_bf16(v1[2], v1[3]);
                    *(u32x4*)(rowp + bj * HALF) = w; } }
    }
};
struct EpiResBf16 {
    static constexpr bool PERM = true;
    bf16_t* Z; const bf16_t* R; int ldc; float alpha;
    __device__ __forceinline__ void operator()(const f32x4 (&acc)[2][2][4][2], const Unit& u, int wr, int wc, int fr, int fq) const {
        const int row0 = u.pm * BM + wr * 64 + fr; const int col0 = u.pn * BM + wc * 32 + 8 * fq;
#pragma unroll
        for (int ai = 0; ai < 2; ++ai)
#pragma unroll
            for (int m = 0; m < 4; ++m) { const size_t off = (size_t)(row0 + ai * HALF + m * 16) * ldc + col0;
#pragma unroll
                for (int bj = 0; bj < 2; ++bj) { const u32x4 rb = *(const u32x4*)(R + off + bj * HALF); const f32x4 v0 = acc[ai][bj][m][0], v1 = acc[ai][bj][m][1];
                    u32x4 w;
                    w.x = cvt_pk_bf16(__uint_as_float(rb.x << 16) * alpha + v0[0], __uint_as_float(rb.x & 0xffff0000u) * alpha + v0[1]);
                    w.y = cvt_pk_bf16(__uint_as_float(rb.y << 16) * alpha + v0[2], __uint_as_float(rb.y & 0xffff0000u) * alpha + v0[3]);
                    w.z = cvt_pk_bf16(__uint_as_float(rb.z << 16) * alpha + v1[0], __uint_as_float(rb.z & 0xffff0000u) * alpha + v1[1]);
                    w.w = cvt_pk_bf16(__uint_as_float(rb.w << 16) * alpha + v1[2], __uint_as_float(rb.w & 0xffff0000u) * alpha + v1[3]);
                    *(u32x4*)(Z + off + bj * HALF) = w; } }
    }
};
template <class Epi, class Sched, bool ALIGN_EPI = false, bool SP2 = false>
__device__ __forceinline__ void gemm_phase(PG8_LAS unsigned char* lds, const Gemm g, const Sched& S, const Epi& E) {
    const int tid = threadIdx.x, wid = __builtin_amdgcn_readfirstlane(tid >> 6), lane = tid & 63, wr = wid >> 2, wc = wid & 3, fr = lane & 15, fq = lane >> 4;
    const int K = g.K, nt = K / BK;
    unsigned voffA[2], voffB[2];
#pragma unroll
    for (int i = 0; i < 2; ++i) { int R, C; stage_rc(tid * 16 + i * 8192, R, C); const int Rb = Epi::PERM ? ((R & ~31) + perm32(R & 31)) : R;
        voffA[i] = (unsigned)(R * g.lda + C) * 2u; voffB[i] = (unsigned)(Rb * g.ldb + C) * 2u; }
    const size_t kstep = (size_t)(BK * 2);
    const size_t hstepA = (size_t)HALF * g.lda * 2, hstepB = (size_t)HALF * g.ldb * 2;
    const size_t tstepA = 2 * hstepA, tstepB = 2 * hstepB;
    const size_t pnA = (size_t)g.a_pn_koff * 2;
    const unsigned ldsw = (unsigned)wid * 1024u;
    const int aoff = lds_byte(wr * 64 + fr, fq * 8), boff = lds_byte(wc * 32 + fr, fq * 8);
#define PG8_SA(b, h) (((b) * 2 + (h)) * HTB)
#define PG8_SB(b, h) ((4 + (b) * 2 + (h)) * HTB)
#define PG8_STAGE(bufoff, gbase, voff) do { _Pragma("unroll") for (int _i = 0; _i < 2; ++_i) \
        __builtin_amdgcn_global_load_lds((const unsigned*)((const char*)(gbase) + (voff)[_i]), (PG8_LAS unsigned*)(lds + (bufoff) + ldsw + _i * 8192), 16, 0, 0); } while (0)
#define PG8_LDA(dst, b, h) do { _Pragma("unroll") for (int m = 0; m < 4; ++m) _Pragma("unroll") for (int k = 0; k < 2; ++k) dst[m][k] = *(const PG8_LAS bf16x8*)(lds + PG8_SA(b, h) + aoff + m * 2048 + k * 1024); } while (0)
#define PG8_LDB(dst, b, h) do { _Pragma("unroll") for (int n = 0; n < 2; ++n) _Pragma("unroll") for (int k = 0; k < 2; ++k) dst[n][k] = *(const PG8_LAS bf16x8*)(lds + PG8_SB(b, h) + boff + n * 2048 + k * 1024); } while (0)
#define PG8_MMA(ai, bj, At, Bt) do { __builtin_amdgcn_s_setprio(1); _Pragma("unroll") for (int m = 0; m < 4; ++m) _Pragma("unroll") for (int n = 0; n < 2; ++n) _Pragma("unroll") for (int k = 0; k < 2; ++k) \
        acc[ai][bj][m][n] = __builtin_amdgcn_mfma_f32_16x16x32_bf16(Bt[n][k], At[m][k], acc[ai][bj][m][n], 0, 0, 0); __builtin_amdgcn_s_setprio(0); } while (0)
#define PG8_WAIT_V(n) asm volatile("s_waitcnt vmcnt(" #n ")" ::: "memory")
#define PG8_WAIT_L(n) asm volatile("s_waitcnt lgkmcnt(" #n ")" ::: "memory")
#define PG8_BAR __builtin_amdgcn_s_barrier()
#define PG8_SCHED __builtin_amdgcn_sched_barrier(0)
    Unit cur, nxt; int ui = 0;
    if (!S.next(0, cur)) return;
    f32x4 acc[2][2][4][2];
#pragma unroll
    for (int a = 0; a < 2; ++a)
#pragma unroll
        for (int b = 0; b < 2; ++b)
#pragma unroll
            for (int m = 0; m < 4; ++m)
#pragma unroll
                for (int n = 0; n < 2; ++n) acc[a][b][m][n] = (f32x4){0.f, 0.f, 0.f, 0.f};
    bf16x8 At[4][2], B0[2][2], B1[2][2];
    const char* cA = (const char*)g.A + (size_t)cur.pm * tstepA + (size_t)cur.pn * pnA; const char* cB = (const char*)g.Bt + (size_t)cur.pn * tstepB;
    S.a_ready(cur);
    if constexpr (SP2) {
        PG8_STAGE(PG8_SB(0, 0), cB, voffB); PG8_STAGE(PG8_SB(0, 1), cB + hstepB, voffB); PG8_STAGE(PG8_SA(0, 0), cA, voffA); PG8_STAGE(PG8_SA(0, 1), cA + hstepA, voffA);
        if (wr == 1) PG8_BAR;
        PG8_WAIT_V(2); PG8_BAR;
        PG8_STAGE(PG8_SB(1, 0), cB + kstep, voffB); PG8_STAGE(PG8_SA(1, 0), cA + kstep, voffA); PG8_STAGE(PG8_SB(1, 1), cB + hstepB + kstep, voffB);
        PG8_WAIT_V(6); PG8_BAR;
    } else {
        PG8_STAGE(PG8_SB(0, 0), cB, voffB); PG8_STAGE(PG8_SA(0, 0), cA, voffA); PG8_STAGE(PG8_SB(0, 1), cB + hstepB, voffB); PG8_STAGE(PG8_SA(0, 1), cA + hstepA, voffA);
        if (wr == 1) PG8_BAR;
        PG8_WAIT_V(4); PG8_BAR;
        PG8_STAGE(PG8_SB(1, 0), cB + kstep, voffB); PG8_STAGE(PG8_SA(1, 0), cA + kstep, voffA); PG8_STAGE(PG8_SB(1, 1), cB + hstepB + kstep, voffB);
        PG8_WAIT_V(6); PG8_BAR;
    }
    for (;;) {
        const bool has_next = S.next(ui + 1, nxt);
        const char* nA = has_next ? (const char*)g.A + (size_t)nxt.pm * tstepA + (size_t)nxt.pn * pnA : cA; const char* nB = has_next ? (const char*)g.Bt + (size_t)nxt.pn * tstepB : cB;
        for (int t = 0; t < nt; t += 2) {
            const bool last = (t == nt - 2);
            const char* a1 = cA + (size_t)(t + 1) * kstep;
            const char* a2 = last ? nA : cA + (size_t)(t + 2) * kstep; const char* b2 = last ? nB : cB + (size_t)(t + 2) * kstep;
            const char* a3 = a2 + kstep; const char* b3 = b2 + kstep;
            if (last && has_next) S.a_ready(nxt);
            if constexpr (SP2) {
            PG8_LDB(B0, 0, 0); PG8_LDB(B1, 0, 1); PG8_SCHED; PG8_LDA(At, 0, 0); PG8_STAGE(PG8_SA(1, 1), a1 + hstepA, voffA);
            PG8_WAIT_V(8); PG8_WAIT_L(0); PG8_BAR; PG8_MMA(0, 0, At, B0); PG8_MMA(0, 1, At, B1); PG8_BAR; PG8_SCHED;
            PG8_LDA(At, 0, 1); PG8_STAGE(PG8_SB(0, 0), b2, voffB); PG8_STAGE(PG8_SB(0, 1), b2 + hstepB, voffB); PG8_STAGE(PG8_SA(0, 0), a2, voffA);
            PG8_WAIT_V(8); PG8_WAIT_L(0); PG8_BAR; PG8_MMA(1, 0, At, B0); PG8_MMA(1, 1, At, B1); PG8_BAR; PG8_SCHED;
            PG8_LDB(B0, 1, 0); PG8_LDB(B1, 1, 1); PG8_SCHED; PG8_LDA(At, 1, 0); PG8_STAGE(PG8_SA(0, 1), a2 + hstepA, voffA);
            PG8_WAIT_V(8); PG8_WAIT_L(0); PG8_BAR; PG8_MMA(0, 0, At, B0); PG8_MMA(0, 1, At, B1); PG8_BAR; PG8_SCHED;
            PG8_LDA(At, 1, 1); PG8_STAGE(PG8_SB(1, 0), b3, voffB); PG8_STAGE(PG8_SB(1, 1), b3 + hstepB, voffB); PG8_STAGE(PG8_SA(1, 0), a3, voffA);
            PG8_WAIT_V(8); PG8_WAIT_L(0); PG8_BAR; PG8_MMA(1, 0, At, B0); PG8_MMA(1, 1, At, B1); PG8_BAR; PG8_SCHED;
            } else {
            PG8_LDB(B0, 0, 0); PG8_SCHED; PG8_LDA(At, 0, 0); PG8_STAGE(PG8_SA(1, 1), a1 + hstepA, voffA);
            PG8_WAIT_L(8); PG8_BAR; PG8_WAIT_L(0); PG8_MMA(0, 0, At, B0); PG8_BAR; PG8_SCHED;
            PG8_LDB(B1, 0, 1); PG8_STAGE(PG8_SB(0, 0), b2, voffB);
            PG8_BAR; PG8_WAIT_L(0); PG8_MMA(0, 1, At, B1); PG8_BAR;
            PG8_LDA(At, 0, 1); PG8_STAGE(PG8_SA(0, 0), a2, voffA);
            PG8_BAR; PG8_WAIT_L(0); PG8_MMA(1, 0, At, B0); PG8_BAR; PG8_SCHED;
            PG8_STAGE(PG8_SB(0, 1), b2 + hstepB, voffB);
            PG8_WAIT_V(6); PG8_BAR; PG8_MMA(1, 1, At, B1); PG8_BAR;
            PG8_LDB(B0, 1, 0); PG8_SCHED; PG8_LDA(At, 1, 0); PG8_STAGE(PG8_SA(0, 1), a2 + hstepA, voffA);
            PG8_WAIT_L(8); PG8_BAR; PG8_WAIT_L(0); PG8_MMA(0, 0, At, B0); PG8_BAR; PG8_SCHED;
            PG8_LDB(B1, 1, 1); PG8_STAGE(PG8_SB(1, 0), b3, voffB);
            PG8_BAR; PG8_WAIT_L(0); PG8_MMA(0, 1, At, B1); PG8_BAR;
            PG8_LDA(At, 1, 1); PG8_STAGE(PG8_SA(1, 0), a3, voffA);
            PG8_BAR; PG8_WAIT_L(0); PG8_MMA(1, 0, At, B0); PG8_BAR; PG8_SCHED;
            PG8_STAGE(PG8_SB(1, 1), b3 + hstepB, voffB);
            PG8_WAIT_V(6); PG8_BAR; PG8_MMA(1, 1, At, B1); PG8_BAR;
            }
        }
        if constexpr (ALIGN_EPI) { if (wr == 0) PG8_BAR; }
        E(acc, cur, wr, wc, fr, fq); S.done(cur);
        if (!has_next) break;
#pragma unroll
        for (int a = 0; a < 2; ++a)
#pragma unroll
            for (int b = 0; b < 2; ++b)
#pragma unroll
                for (int m = 0; m < 4; ++m)
#pragma unroll
                    for (int n = 0; n < 2; ++n) acc[a][b][m][n] = (f32x4){0.f, 0.f, 0.f, 0.f};
        cur = nxt; cA = nA; cB = nB; ++ui;
        if constexpr (ALIGN_EPI) { if (wr == 1) PG8_BAR; }
    }
    PG8_WAIT_V(0);
    if constexpr (!ALIGN_EPI) { if (wr == 0) PG8_BAR; }
    PG8_BAR;
#undef PG8_SA
#undef PG8_SB
#undef PG8_STAGE
#undef PG8_LDA
#undef PG8_LDB
#undef PG8_MMA
#undef PG8_WAIT_V
#undef PG8_WAIT_L
#undef PG8_BAR
#undef PG8_SCHED
}
}

constexpr int NWAVES = 8, NTHR = NWAVES * 64;
constexpr int D = 1024, NBATCH = 4, T = 8192, M = NBATCH * T;
constexpr int A_W = 512, A_IN = 1792, IN_COLS = 3344, NP = 3584;
constexpr int C_R = 0, C_K = 512, C_V = 1024, C_WD = 1536, C_AD = 1600, C_GD = 1664;
constexpr int C_BQ = 1792, C_BK = 2048, C_BV = 2304, C_GKD = 2816, C_BG = 2832;
constexpr int NQ = 2048;
constexpr float LN_EPS = 1e-5f, GN_EPS = 64e-5f, RMS_EPS = 1e-5f;
constexpr float ALPHA = 1.189207115002721f;

typedef unsigned short bf16;
typedef float f32x4 __attribute__((ext_vector_type(4)));
typedef float f32x2 __attribute__((ext_vector_type(2)));
typedef unsigned u32x4 __attribute__((ext_vector_type(4)));
typedef unsigned u32x2 __attribute__((ext_vector_type(2)));
#define LAS __attribute__((address_space(3)))

constexpr size_t MiB = 1u << 20;
constexpr size_t WS_WIN = 1 * MiB, WS_WOUT = 8 * MiB, WS_WQ = 10 * MiB, WS_KBD = 14 * MiB;
constexpr size_t WS_W2T = 15 * MiB, WS_A2T = WS_W2T + 65536, WS_G2T = WS_A2T + 65536;
constexpr size_t WS_H0 = 16 * MiB;
constexpr size_t WS_P = 80 * MiB;
constexpr size_t WS_WL = 304 * MiB, WS_AA = 336 * MiB, WS_GG = 368 * MiB;
constexpr size_t WS_GK = 400 * MiB;
constexpr size_t WS_Z = 80 * MiB;
constexpr size_t WS_H1 = 208 * MiB;
constexpr size_t WS_Q = 272 * MiB;
constexpr size_t WS_S = 80 * MiB;
constexpr size_t WS_IDS = 400 * MiB, WS_GATES = 416 * MiB;
constexpr size_t WS_UT = 432 * MiB, WS_VT = 448 * MiB;
constexpr int ROWB = 768;
constexpr size_t WS_SU = 464 * MiB, WS_SV = 465 * MiB;
constexpr size_t WS_UF = WS_UT; constexpr size_t UF_SLICE = (size_t)16384 * 128;
constexpr size_t WS_H8 = 272 * MiB;
constexpr size_t WS_PD = 80 * MiB;
constexpr size_t WS_V8 = WS_VT; constexpr size_t V8_SLICE = (size_t)16384 * 128;
constexpr size_t WS_CQ = 336 * MiB;
constexpr size_t WS_CS = 344 * MiB;
constexpr size_t WS_ZP = 80 * MiB;
constexpr int NSEG = 16, LSEG = 8192 / NSEG;
constexpr size_t WS_YI = WS_WL;
constexpr size_t WS_YIG = WS_GK;
constexpr size_t WS_SER = 480 * MiB;
constexpr size_t WS_SEG = 496 * MiB;
constexpr size_t WS_CEND = 504 * MiB;
constexpr size_t WS_END = 505 * MiB;

constexpr int LDS_BYTES = 163840, LDS_MISC = LDS_BYTES - 256;
constexpr size_t WS_CTL = 0, CTL_BYTES = 16384;

struct Params {
    const float* in[28];
    float* out; unsigned char* ws;
    int ph_lo, ph_hi;
};

__device__ __forceinline__ float bf2f(unsigned u) { return __uint_as_float(u << 16); }
typedef float f32x2c_t __attribute__((ext_vector_type(2))); typedef __bf16 bf16x2c_t __attribute__((ext_vector_type(2)));
__device__ __forceinline__ unsigned pk2(float lo, float hi) { const f32x2c_t v = {lo, hi}; const bf16x2c_t b = __builtin_convertvector(v, bf16x2c_t); return __builtin_bit_cast(unsigned, b); }
__device__ __forceinline__ unsigned f2bf(float f) { return pk2(f, 0.f) & 0xffffu; }
#define DPP_F(v, ctrl) __builtin_bit_cast(float, __builtin_amdgcn_update_dpp(0, __builtin_bit_cast(int, (v)), (ctrl), 0xf, 0xf, false))
#define DPP_ADD(v, ctrl) ((v) + DPP_F(v, ctrl))
__device__ __forceinline__ float rlf(float v, int l) { return __builtin_bit_cast(float, __builtin_amdgcn_readlane(__builtin_bit_cast(int, v), l)); }
__device__ __forceinline__ float wave_sum_u(float v) {
    v = DPP_ADD(v, 0xB1); v = DPP_ADD(v, 0x4E); v = DPP_ADD(v, 0x141); v = DPP_ADD(v, 0x140);
    return (rlf(v, 0) + rlf(v, 16)) + (rlf(v, 32) + rlf(v, 48));
}
__device__ __forceinline__ float wave_sum(float v) { return wave_sum_u(v); }
#define DPP_I(v, ctrl) __builtin_amdgcn_update_dpp(0, (v), (ctrl), 0xf, 0xf, false)
__device__ __forceinline__ int wave_sum_i(int v) {
    v += DPP_I(v, 0xB1); v += DPP_I(v, 0x4E); v += DPP_I(v, 0x141); v += DPP_I(v, 0x140);
    return (__builtin_amdgcn_readlane(v, 0) + __builtin_amdgcn_readlane(v, 16)) + (__builtin_amdgcn_readlane(v, 32) + __builtin_amdgcn_readlane(v, 48));
}
__device__ __forceinline__ float wave_max_u(float v) {
    v = fmaxf(v, DPP_F(v, 0xB1)); v = fmaxf(v, DPP_F(v, 0x4E)); v = fmaxf(v, DPP_F(v, 0x141)); v = fmaxf(v, DPP_F(v, 0x140));
    return fmaxf(fmaxf(rlf(v, 0), rlf(v, 16)), fmaxf(rlf(v, 32), rlf(v, 48)));
}
__device__ __forceinline__ unsigned pack_i8(float a, float b, float c, float d, float inv, int off) {
    const int q0 = __float2int_rn(a * inv) + off, q1 = __float2int_rn(b * inv) + off, q2 = __float2int_rn(c * inv) + off, q3 = __float2int_rn(d * inv) + off;
    return (unsigned)(q0 & 0xff) | ((unsigned)(q1 & 0xff) << 8) | ((unsigned)(q2 & 0xff) << 16) | ((unsigned)(q3 & 0xff) << 24);
}
__device__ __forceinline__ float sigmoidf_(float x) { return 1.f / (1.f + __expf(-x)); }
__device__ __forceinline__ float siluf_(float x) { return x * sigmoidf_(x); }

__device__ __forceinline__ void transpose_convert(const float* W, int K, int N, int Npad, bf16* WT, int gtid, int gthreads) {
    const int kc = K / 8, total = Npad * kc;
    for (int idx = gtid; idx < total; idx += gthreads) {
        const int n = idx % Npad, c = idx / Npad; float v[8];
#pragma unroll
        for (int j = 0; j < 8; ++j) v[j] = (n < N) ? W[(size_t)(8 * c + j) * N + n] : 0.f;
        u32x4 o; o.x = pk2(v[0], v[1]); o.y = pk2(v[2], v[3]); o.z = pk2(v[4], v[5]); o.w = pk2(v[6], v[7]);
        *(u32x4*)(WT + (size_t)n * K + 8 * c) = o;
    }
}
__device__ __forceinline__ void ln_row_bf16(const float* xrow, const float* g, const float* b, bf16* orow, int lane) {
    const f32x4* xr = (const f32x4*)xrow + lane; f32x4 v[4]; float s = 0.f;
#pragma unroll
    for (int j = 0; j < 4; ++j) { v[j] = xr[64 * j]; s += (v[j][0] + v[j][1]) + (v[j][2] + v[j][3]); }
    const float mean = wave_sum(s) * (1.f / D); float s2 = 0.f;
#pragma unroll
    for (int j = 0; j < 4; ++j) { v[j] = v[j] - mean; s2 += (v[j][0] * v[j][0] + v[j][1] * v[j][1]) + (v[j][2] * v[j][2] + v[j][3] * v[j][3]); }
    const float rstd = 1.f / sqrtf(wave_sum(s2) * (1.f / D) + LN_EPS);
    u32x2* o8 = (u32x2*)orow + lane;
#pragma unroll
    for (int j = 0; j < 4; ++j) { const f32x4 gg = ((const f32x4*)g)[lane + 64 * j], bb = ((const f32x4*)b)[lane + 64 * j]; const f32x4 y = v[j] * rstd * gg + bb;
        u32x2 w; w.x = pk2(y[0], y[1]); w.y = pk2(y[2], y[3]); o8[64 * j] = w; }
}
template <bool F8>
__device__ __forceinline__ void ln_rowb_bf16(const bf16* xrow, const float* g, const float* b, bf16* orow, int lane, unsigned char* f8row = nullptr) {
    const u32x4* xr = (const u32x4*)xrow + 2 * lane; const u32x4 a = xr[0], c = xr[1]; float v[16]; float s = 0.f;
#pragma unroll
    for (int i = 0; i < 4; ++i) { v[2 * i] = __uint_as_float(a[i] << 16); v[2 * i + 1] = __uint_as_float(a[i] & 0xffff0000u); v[8 + 2 * i] = __uint_as_float(c[i] << 16); v[8 + 2 * i + 1] = __uint_as_float(c[i] & 0xffff0000u); }
#pragma unroll
    for (int i = 0; i < 16; ++i) s += v[i];
    const float mean = wave_sum(s) * (1.f / D); float s2 = 0.f;
#pragma unroll
    for (int i = 0; i < 16; ++i) { v[i] -= mean; s2 += v[i] * v[i]; }
    const float rstd = 1.f / sqrtf(wave_sum(s2) * (1.f / D) + LN_EPS);
    u32x4 o0, o1;
#pragma unroll
    for (int q = 0; q < 4; ++q) { const f32x4 gg = *(const f32x4*)(g + 16 * lane + 4 * q), bb = *(const f32x4*)(b + 16 * lane + 4 * q);
#pragma unroll
        for (int j = 0; j < 4; ++j) v[4 * q + j] = v[4 * q + j] * rstd * gg[j] + bb[j];
        const unsigned lo = pk2(v[4 * q], v[4 * q + 1]), hi = pk2(v[4 * q + 2], v[4 * q + 3]);
        if (q < 2) { o0[2 * q] = lo; o0[2 * q + 1] = hi; } else { o1[2 * q - 4] = lo; o1[2 * q - 3] = hi; } }
    u32x4* op = (u32x4*)orow + 2 * lane; op[0] = o0; op[1] = o1;
    if (F8) {
        u32x4 h8, l8;
#pragma unroll
        for (int q = 0; q < 4; ++q) {
            int ph = __builtin_amdgcn_cvt_pk_fp8_f32(v[4 * q], v[4 * q + 1], 0, false); ph = __builtin_amdgcn_cvt_pk_fp8_f32(v[4 * q + 2], v[4 * q + 3], ph, true);
            const float r0 = v[4 * q] - __builtin_amdgcn_cvt_f32_fp8(ph, 0), r1 = v[4 * q + 1] - __builtin_amdgcn_cvt_f32_fp8(ph, 1);
            const float r2 = v[4 * q + 2] - __builtin_amdgcn_cvt_f32_fp8(ph, 2), r3 = v[4 * q + 3] - __builtin_amdgcn_cvt_f32_fp8(ph, 3);
            int pl = __builtin_amdgcn_cvt_pk_fp8_f32(r0, r1, 0, false); pl = __builtin_amdgcn_cvt_pk_fp8_f32(r2, r3, pl, true);
            h8[q] = (unsigned)ph; l8[q] = (unsigned)pl; }
        *((u32x4*)f8row + lane) = h8; *((u32x4*)(f8row + 1024) + lane) = l8;
    }
}
__device__ __forceinline__ void fold_keys(const Params& P, LAS unsigned char* lds, int bi, int nb) {
    const int tid = threadIdx.x; unsigned char* ws = P.ws;
    {
        const float* Wq = P.in[22]; const float* keys = P.in[23]; bf16* WqkT = (bf16*)(ws + WS_WQ);
        LAS float* WQs = (LAS float*)lds; LAS float* KYs = WQs + 64 * 132;
        for (int item = bi; item < 256; item += nb) {
            const int hh = item >> 4, kt = item & 15;
            __syncthreads();
            for (int i = tid; i < 64 * 32; i += NTHR) { const int r = i >> 5, c4 = (i & 31) * 4; *(LAS f32x4*)(WQs + r * 132 + c4) = *(const f32x4*)(Wq + (size_t)(kt * 64 + r) * NQ + hh * 128 + c4); }
            for (int i = tid; i < 128 * 32; i += NTHR) { const int r = i >> 5, c4 = (i & 31) * 4; *(LAS f32x4*)(KYs + r * 132 + c4) = *(const f32x4*)(keys + (size_t)(hh * 128 + r) * 128 + c4); }
            __syncthreads();
            const int key = tid & 127, kg = tid >> 7; float acc[16];
#pragma unroll
            for (int j = 0; j < 16; ++j) acc[j] = 0.f;
            for (int c4 = 0; c4 < 32; ++c4) { const f32x4 kv = *(const LAS f32x4*)(KYs + key * 132 + 4 * c4);
#pragma unroll
                for (int j = 0; j < 16; ++j) { const f32x4 w = *(const LAS f32x4*)(WQs + (kg * 16 + j) * 132 + 4 * c4); acc[j] += (w[0] * kv[0] + w[1] * kv[1]) + (w[2] * kv[2] + w[3] * kv[3]); } }
            u32x4 o0, o1;
#pragma unroll
            for (int q = 0; q < 4; ++q) { o0[q] = pk2(acc[2 * q], acc[2 * q + 1]); o1[q] = pk2(acc[8 + 2 * q], acc[8 + 2 * q + 1]); }
            u32x4* dst = (u32x4*)(WqkT + (size_t)(hh * 128 + key) * D + kt * 64 + kg * 16); dst[0] = o0; dst[1] = o1;
        }
    }
}
__device__ __forceinline__ void phase_prologue(const Params& P, LAS unsigned char* lds) {
    const int tid = threadIdx.x, lane = tid & 63, wave = tid >> 6;
    const int gtid = blockIdx.x * NTHR + tid, gthreads = gridDim.x * NTHR;
    unsigned char* ws = P.ws;
    transpose_convert(P.in[3], D, IN_COLS, NP, (bf16*)(ws + WS_WIN), gtid, gthreads);
    transpose_convert(P.in[6], 64, A_W, A_W, (bf16*)(ws + WS_W2T), gtid, gthreads);
    transpose_convert(P.in[8], 64, A_W, A_W, (bf16*)(ws + WS_A2T), gtid, gthreads);
    transpose_convert(P.in[9], 128, A_W, A_W, (bf16*)(ws + WS_G2T), gtid, gthreads);
    const int gw = blockIdx.x * NWAVES + wave, ngw = gridDim.x * NWAVES;
    for (int m = gw; m < M; m += ngw) ln_row_bf16(P.in[0] + (size_t)m * D, P.in[1], P.in[2], (bf16*)(ws + WS_H0) + (size_t)m * D, lane);
}

typedef short bf16x8_t __attribute__((ext_vector_type(8)));
template <int KS, int LDA>
__device__ __forceinline__ void lora_mm(f32x4 (&acc)[4][4], const LAS bf16* ACT, const bf16* WT, int c0, int fr, int fq) {
#pragma unroll
    for (int mt = 0; mt < 4; ++mt)
#pragma unroll
        for (int nt = 0; nt < 4; ++nt) acc[mt][nt] = (f32x4){0.f, 0.f, 0.f, 0.f};
#pragma unroll
    for (int s = 0; s < KS; ++s) {
        bf16x8_t af[4], bfr[4];
#pragma unroll
        for (int mt = 0; mt < 4; ++mt) af[mt] = *(const LAS bf16x8_t*)(ACT + (mt * 16 + fr) * LDA + 32 * s + 8 * fq);
#pragma unroll
        for (int nt = 0; nt < 4; ++nt) bfr[nt] = *(const bf16x8_t*)(WT + (size_t)(c0 + nt * 16 + fr) * (32 * KS) + 32 * s + 8 * fq);
#pragma unroll
        for (int mt = 0; mt < 4; ++mt)
#pragma unroll
            for (int nt = 0; nt < 4; ++nt) acc[mt][nt] = __builtin_amdgcn_mfma_f32_16x16x32_bf16(bfr[nt], af[mt], acc[mt][nt], 0, 0, 0);
    }
}
__device__ __forceinline__ void phase_prep(const Params& P, LAS unsigned char* lds) {
    const int tid = threadIdx.x, lane = tid & 63, wave = __builtin_amdgcn_readfirstlane(tid >> 6), fr = lane & 15, fq = lane >> 4;
    unsigned char* ws = P.ws;
    const bf16* p = (const bf16*)(ws + WS_P);
    const float* mu = P.in[4]; const float* w0 = P.in[5]; const float* a0 = P.in[7];
    const float* gkw2 = P.in[16]; const float* gkb = P.in[17];
    const bf16* W2T = (const bf16*)(ws + WS_W2T); const bf16* A2T = (const bf16*)(ws + WS_A2T); const bf16* G2T = (const bf16*)(ws + WS_G2T);
    bf16* WL = (bf16*)(ws + WS_WL); bf16* AA = (bf16*)(ws + WS_AA); bf16* GG = (bf16*)(ws + WS_GG); bf16* GK = (bf16*)(ws + WS_GK);
    LAS bf16* TW = (LAS bf16*)lds; LAS bf16* AD = TW + 64 * 72; LAS bf16* SG = AD + 64 * 72;
    LAS float* gkd = (LAS float*)(SG + 64 * 136);
    const int c0 = wave * 64;
    for (int tile = blockIdx.x; tile < M / 64; tile += gridDim.x) {
        const int m0 = tile * 64;
        __syncthreads();
        for (int idx = tid; idx < 64 * 32; idx += NTHR) {
            const int j = (idx & 31) * 8, tok = idx >> 5, m = m0 + tok, t = m & (T - 1);
            const u32x4 cw = *(const u32x4*)(p + (size_t)m * NP + C_WD + j); const u32x4 pw = (t > 0) ? *(const u32x4*)(p + (size_t)(m - 1) * NP + C_WD + j) : (u32x4){0u, 0u, 0u, 0u};
            const f32x4 m0v = *(const f32x4*)(mu + C_WD + j), m1v = *(const f32x4*)(mu + C_WD + j + 4);
            float x[8];
#pragma unroll
            for (int i = 0; i < 4; ++i) { const float c0 = __uint_as_float(cw[i] << 16), c1 = __uint_as_float(cw[i] & 0xffff0000u), q0 = __uint_as_float(pw[i] << 16), q1 = __uint_as_float(pw[i] & 0xffff0000u);
                const float mu0 = i < 2 ? m0v[2 * i] : m1v[2 * i - 4], mu1 = i < 2 ? m0v[2 * i + 1] : m1v[2 * i - 3];
                x[2 * i] = c0 + (q0 - c0) * mu0; x[2 * i + 1] = c1 + (q1 - c1) * mu1; }
            u32x4 o;
            if (j < 64) {
#pragma unroll
                for (int i = 0; i < 4; ++i) o[i] = pk2(1.f - 2.f * __builtin_amdgcn_rcpf(1.f + __expf(2.f * x[2 * i])), 1.f - 2.f * __builtin_amdgcn_rcpf(1.f + __expf(2.f * x[2 * i + 1])));
                *(LAS u32x4*)(TW + tok * 72 + j) = o;
            } else if (j < 128) {
#pragma unroll
                for (int i = 0; i < 4; ++i) o[i] = pk2(x[2 * i], x[2 * i + 1]);
                *(LAS u32x4*)(AD + tok * 72 + j - 64) = o;
            } else {
#pragma unroll
                for (int i = 0; i < 4; ++i) o[i] = pk2(sigmoidf_(x[2 * i]), sigmoidf_(x[2 * i + 1]));
                *(LAS u32x4*)(SG + tok * 136 + j - 128) = o;
            }
        }
        for (int idx = tid; idx < 64 * 16; idx += NTHR) { const int j = idx & 15, tok = idx >> 4; gkd[tok * 16 + j] = bf2f(p[(size_t)(m0 + tok) * NP + C_GKD + j]); }
        __syncthreads();
        f32x4 acc[4][4];
        lora_mm<2, 72>(acc, TW, W2T, c0, fr, fq);
#pragma unroll
        for (int nt = 0; nt < 4; ++nt) { const int c = c0 + nt * 16 + 4 * fq; const f32x4 b = *(const f32x4*)(w0 + c);
#pragma unroll
            for (int mt = 0; mt < 4; ++mt) { float o[4];
#pragma unroll
                for (int i = 0; i < 4; ++i) { const float z = b[i] + acc[mt][nt][i]; o[i] = -0.6065306597126334f * sigmoidf_(z); }
                u32x2 w; w.x = pk2(o[0], o[1]); w.y = pk2(o[2], o[3]); *(u32x2*)(WL + (size_t)(m0 + mt * 16 + fr) * A_W + c) = w; } }
        lora_mm<2, 72>(acc, AD, A2T, c0, fr, fq);
#pragma unroll
        for (int nt = 0; nt < 4; ++nt) { const int c = c0 + nt * 16 + 4 * fq; const f32x4 b = *(const f32x4*)(a0 + c);
#pragma unroll
            for (int mt = 0; mt < 4; ++mt) { float o[4];
#pragma unroll
                for (int i = 0; i < 4; ++i) o[i] = sigmoidf_(b[i] + acc[mt][nt][i]);
                u32x2 w; w.x = pk2(o[0], o[1]); w.y = pk2(o[2], o[3]); *(u32x2*)(AA + (size_t)(m0 + mt * 16 + fr) * A_W + c) = w; } }
        lora_mm<4, 136>(acc, SG, G2T, c0, fr, fq);
#pragma unroll
        for (int nt = 0; nt < 4; ++nt) { const int c = c0 + nt * 16 + 4 * fq;
#pragma unroll
            for (int mt = 0; mt < 4; ++mt) { u32x2 w; w.x = pk2(acc[mt][nt][0], acc[mt][nt][1]); w.y = pk2(acc[mt][nt][2], acc[mt][nt][3]); *(u32x2*)(GG + (size_t)(m0 + mt * 16 + fr) * A_W + c) = w; } }
        { const int cc = tid & 255, th = tid >> 8; float wv[16];
#pragma unroll
          for (int j = 0; j < 16; ++j) wv[j] = gkw2[j * 256 + cc];
          const float bb = gkb[cc];
          for (int i = 0; i < 32; ++i) { const int tok = th * 32 + i; float sacc = bb;
#pragma unroll
              for (int j = 0; j < 16; ++j) sacc += gkd[tok * 16 + j] * wv[j];
              GK[(size_t)(m0 + tok) * 256 + cc] = (bf16)f2bf(-(fmaxf(-sacc, 0.f) + __logf(1.f + __expf(-fabsf(sacc)))) * (1.f / 16.f)); } }
    }
}

constexpr int CH = 32;
__device__ __forceinline__ float red8(float v) { v = DPP_ADD(v, 0xB1); v = DPP_ADD(v, 0x4E); v = DPP_ADD(v, 0x141); return v; }

constexpr int RW_BUF = 6 * CH * 64;
__device__ __forceinline__ void rw_load(const bf16* p, const bf16* AA, const bf16* WL, int b, int t0, int col, int wave,
        unsigned (&rc)[4], unsigned (&kc)[4], unsigned (&vc)[4], unsigned (&rp)[4], unsigned (&kp)[4], unsigned (&vp)[4], unsigned (&a)[4], unsigned (&wl)[4]) {
#pragma unroll
    for (int q = 0; q < 4; ++q) {
        const int t = t0 + wave + 8 * q; const size_t m = (size_t)b * T + t; const bf16* pr = p + m * NP; const bf16* pp = (t > 0) ? pr - NP : pr;
        rc[q] = pr[C_R + col]; kc[q] = pr[C_K + col]; vc[q] = pr[C_V + col]; rp[q] = pp[C_R + col]; kp[q] = pp[C_K + col]; vp[q] = pp[C_V + col];
        a[q] = AA[m * A_W + col]; wl[q] = WL[m * A_W + col];
    }
}
__device__ __forceinline__ void rw_prep(LAS float* B, int t0, int wave, int lane, float mu_r, float mu_k, float mu_v, float kkc, float kac,
        const unsigned (&rc_)[4], const unsigned (&kc_)[4], const unsigned (&vc_)[4], const unsigned (&rp_)[4], const unsigned (&kp_)[4], const unsigned (&vp_)[4], const unsigned (&a_)[4], const unsigned (&wl_)[4]) {
    LAS float* R = B; LAS float* DEC = R + CH * 64; LAS float* KH = DEC + CH * 64; LAS float* KK = KH + CH * 64; LAS float* BB = KK + CH * 64; LAS float* V = BB + CH * 64;
#pragma unroll
    for (int q = 0; q < 4; ++q) {
        const int tt = wave + 8 * q; const float hp = (t0 + tt > 0) ? 1.f : 0.f;
        const float rc = bf2f(rc_[q]), kc = bf2f(kc_[q]), vc = bf2f(vc_[q]), rp = bf2f(rp_[q]) * hp, kp = bf2f(kp_[q]) * hp, vp = bf2f(vp_[q]) * hp;
        const float r = rc + (rp - rc) * mu_r, k = kc + (kp - kc) * mu_k, v = vc + (vp - vc) * mu_v;
        const float a = bf2f(a_[q]), wl = bf2f(wl_[q]);
        const float kr = k * kkc; const float nrm = sqrtf(wave_sum(kr * kr)); const float kk = kr / fmaxf(nrm, 1e-12f);
        const float kh = k * (1.f + (a - 1.f) * kac);
        R[tt * 64 + lane] = r; DEC[tt * 64 + lane] = __expf(wl); KH[tt * 64 + lane] = kh; KK[tt * 64 + lane] = kk; BB[tt * 64 + lane] = kk * a; V[tt * 64 + lane] = v;
    }
}
struct RwOps { f32x4 k0, k1, d0, d1, b0, b1, h0, h1, q0, q1; float v0, v1; };
__device__ __forceinline__ void rw_ops_load(RwOps& o, const LAS float* B, int tt, int s8, int vr0) {
    const LAS float* R = B; const LAS float* DEC = R + CH * 64; const LAS float* KH = DEC + CH * 64; const LAS float* KK = KH + CH * 64; const LAS float* BB = KK + CH * 64; const LAS float* V = BB + CH * 64;
    o.k0 = *(const LAS f32x4*)(KK + tt * 64 + s8); o.k1 = *(const LAS f32x4*)(KK + tt * 64 + s8 + 4);
    o.d0 = *(const LAS f32x4*)(DEC + tt * 64 + s8); o.d1 = *(const LAS f32x4*)(DEC + tt * 64 + s8 + 4);
    o.b0 = *(const LAS f32x4*)(BB + tt * 64 + s8); o.b1 = *(const LAS f32x4*)(BB + tt * 64 + s8 + 4);
    o.h0 = *(const LAS f32x4*)(KH + tt * 64 + s8); o.h1 = *(const LAS f32x4*)(KH + tt * 64 + s8 + 4);
    o.q0 = *(const LAS f32x4*)(R + tt * 64 + s8); o.q1 = *(const LAS f32x4*)(R + tt * 64 + s8 + 4);
    o.v0 = V[tt * 64 + vr0]; o.v1 = V[tt * 64 + vr0 + 1];
}
template <bool IDENT> __device__ __forceinline__ void rw_step(const RwOps& o, f32x2 (&S0)[4], f32x2 (&S1)[4], LAS float* Y, int tt, int r0, int lane) {
    const float vv0 = o.v0, vv1 = o.v1;
    const f32x2 kk[4] = {o.k0.lo, o.k0.hi, o.k1.lo, o.k1.hi}, dd[4] = {o.d0.lo, o.d0.hi, o.d1.lo, o.d1.hi}, bb[4] = {o.b0.lo, o.b0.hi, o.b1.lo, o.b1.hi}, hh[4] = {o.h0.lo, o.h0.hi, o.h1.lo, o.h1.hi}, rr[4] = {o.q0.lo, o.q0.hi, o.q1.lo, o.q1.hi};
    f32x2 a0 = S0[0] * kk[0], a1 = S1[0] * kk[0];
#pragma unroll
    for (int i = 1; i < 4; ++i) { a0 = S0[i] * kk[i] + a0; a1 = S1[i] * kk[i] + a1; }
    const float sa0 = -red8(a0.x + a0.y), sa1 = -red8(a1.x + a1.y);
    f32x2 y0 = (f32x2){0.f, 0.f}, y1 = (f32x2){0.f, 0.f};
#pragma unroll
    for (int i = 0; i < 4; ++i) {
        if (IDENT) { S0[i] = bb[i] * sa0 + S0[i] * dd[i]; S1[i] = bb[i] * sa1 + S1[i] * dd[i]; }
        else { S0[i] = hh[i] * vv0 + (bb[i] * sa0 + S0[i] * dd[i]); S1[i] = hh[i] * vv1 + (bb[i] * sa1 + S1[i] * dd[i]); }
        y0 = S0[i] * rr[i] + y0; y1 = S1[i] * rr[i] + y1;
    }
    const float yy0 = red8(y0.x + y0.y), yy1 = red8(y1.x + y1.y);
    if ((lane & 7) == 0) { Y[tt * 128 + r0] = yy0; Y[tt * 128 + r0 + 1] = yy1; }
}
__device__ __forceinline__ void rwkv_item(const Params& P, LAS unsigned char* lds, int b, int h, int seg) {
    const int tid = threadIdx.x, lane = tid & 63, wave = tid >> 6;
    unsigned char* ws = P.ws;
    const bf16* p = (const bf16*)(ws + WS_P); const bf16* WL = (const bf16*)(ws + WS_WL); const bf16* AA = (const bf16*)(ws + WS_AA);
    bf16* MIX = (bf16*)P.out; bf16* YI = (bf16*)(ws + WS_YI);
    const float* mu = P.in[4]; const float* k_k = P.in[10]; const float* k_a = P.in[11];
    LAS float* BUF = (LAS float*)lds; LAS float* Y = BUF + 2 * RW_BUF;
    const int col = h * 64 + lane;
    const float mu_r = mu[C_R + col], mu_k = mu[C_K + col], mu_v = mu[C_V + col], kkc = k_k[col], kac = k_a[col];
    const int r0 = wave * 16 + 2 * (lane >> 3), s8 = (lane & 7) * 8; const int ident = r0 >> 6, vr0 = r0 & 63, vr1 = vr0 + 1;
    float* SE = (float*)(ws + WS_SER) + ((((size_t)(b * 8 + h) * NSEG + seg) * 2 + ident) * 4096) + vr0 * 64 + s8;
    f32x2 S0[4], S1[4];
#pragma unroll
    for (int i = 0; i < 4; ++i) { S0[i] = (f32x2){(ident && (s8 + 2 * i == vr0)) ? 1.f : 0.f, (ident && (s8 + 2 * i + 1 == vr0)) ? 1.f : 0.f};
        S1[i] = (f32x2){(ident && (s8 + 2 * i == vr1)) ? 1.f : 0.f, (ident && (s8 + 2 * i + 1 == vr1)) ? 1.f : 0.f}; }
    const int tbeg = seg * LSEG;
    unsigned rc[4], kc[4], vc[4], rp[4], kp[4], vp[4], a[4], wl[4];
    __syncthreads();
    rw_load(p, AA, WL, b, tbeg, col, wave, rc, kc, vc, rp, kp, vp, a, wl);
    rw_prep(BUF, tbeg, wave, lane, mu_r, mu_k, mu_v, kkc, kac, rc, kc, vc, rp, kp, vp, a, wl);
    __syncthreads();
    for (int ci = 0; ci < LSEG / CH; ++ci) {
        const int t0 = tbeg + ci * CH; LAS float* B = BUF + (ci & 1) * RW_BUF;
        LAS float* R = B; LAS float* DEC = R + CH * 64; LAS float* KH = DEC + CH * 64; LAS float* KK = KH + CH * 64; LAS float* BB = KK + CH * 64; LAS float* V = BB + CH * 64;
        const bool more = (ci + 1 < LSEG / CH);
        if (more) rw_load(p, AA, WL, b, t0 + CH, col, wave, rc, kc, vc, rp, kp, vp, a, wl);
        { RwOps oa, ob; rw_ops_load(oa, B, 0, s8, vr0);
          if (ident) for (int tt = 0; tt < CH; tt += 2) {
              rw_ops_load(ob, B, tt + 1, s8, vr0); rw_step<true>(oa, S0, S1, Y, tt, r0, lane);
              rw_ops_load(oa, B, (tt + 2) & (CH - 1), s8, vr0); rw_step<true>(ob, S0, S1, Y, tt + 1, r0, lane);
          } else for (int tt = 0; tt < CH; tt += 2) {
              rw_ops_load(ob, B, tt + 1, s8, vr0); rw_step<false>(oa, S0, S1, Y, tt, r0, lane);
              rw_ops_load(oa, B, (tt + 2) & (CH - 1), s8, vr0); rw_step<false>(ob, S0, S1, Y, tt + 1, r0, lane);
          } }
        __syncthreads();
        if (more) rw_prep(BUF + ((ci + 1) & 1) * RW_BUF, t0 + CH, wave, lane, mu_r, mu_k, mu_v, kkc, kac, rc, kc, vc, rp, kp, vp, a, wl);
#pragma unroll
        for (int q = 0; q < 4; ++q) {
            const int tt = wave + 8 * q; const size_t m = (size_t)b * T + t0 + tt;
            MIX[m * D + col] = (bf16)f2bf(Y[tt * 128 + lane]); YI[m * 512 + col] = (bf16)f2bf(Y[tt * 128 + 64 + lane]);
        }
        __syncthreads();
    }
    *(f32x4*)(SE) = (f32x4){S0[0].x, S0[0].y, S0[1].x, S0[1].y}; *(f32x4*)(SE + 4) = (f32x4){S0[2].x, S0[2].y, S0[3].x, S0[3].y};
    *(f32x4*)(SE + 64) = (f32x4){S1[0].x, S1[0].y, S1[1].x, S1[1].y}; *(f32x4*)(SE + 68) = (f32x4){S1[2].x, S1[2].y, S1[3].x, S1[3].y};
}

constexpr int W_AT = 0, W_BT = 4608, W_KT = 9216, W_LAK = 13824, W_L1 = 0, W_LT1 = 4608, W_X1 = 9216, W_RT = 18432, W_BTT = 23040, W_KTT = 27648, W_VTT = 32256, W_X0 = 36864,
              W_L0 = 46080, W_LT0 = 50688, W_QT = 46080, W_TT = 50688, W_LRB = 55296, W_LRK = 59904, W_SIM = 64512, W_PIM = 69120, W_END = 73728, W_MI = 0;
__device__ __forceinline__ bf16x8_t lfrag(const LAS bf16* base, int row, int sx, int fq) { return *(const LAS bf16x8_t*)(base + row * 72 + 32 * sx + 8 * fq); }
#define MFMA16(a, b, c) __builtin_amdgcn_mfma_f32_16x16x32_bf16((a), (b), (c), 0, 0, 0)
typedef short bf16x4_t __attribute__((ext_vector_type(4)));
#define MFMA16K(a, b, c) __builtin_amdgcn_mfma_f32_16x16x16bf16_1k((a), (b), (c), 0, 0, 0)
__device__ __forceinline__ bf16x4_t pack4(const f32x4 v) { u32x2 w; w.x = pk2(v[0], v[1]); w.y = pk2(v[2], v[3]); return __builtin_bit_cast(bf16x4_t, w); }
__device__ __forceinline__ void st4(LAS bf16* dst, float a, float b, float c, float d) { u32x2 w; w.x = pk2(a, b); w.y = pk2(c, d); *(LAS u32x2*)dst = w; }
__device__ __forceinline__ f32x4 ld4(const LAS bf16* src) { const u32x2 w = *(const LAS u32x2*)src; return (f32x4){__uint_as_float(w.x << 16), __uint_as_float(w.x & 0xffff0000u), __uint_as_float(w.y << 16), __uint_as_float(w.y & 0xffff0000u)}; }
__device__ __forceinline__ void rwkv_item_chunked(const Params& P, LAS unsigned char* lds, int b, int h, int seg) {
    const int tid = threadIdx.x, lane = tid & 63, wave = __builtin_amdgcn_readfirstlane(tid >> 6), fr = lane & 15, fq = lane >> 4;
    unsigned char* ws = P.ws;
    const bf16* p = (const bf16*)(ws + WS_P); const bf16* WL = (const bf16*)(ws + WS_WL); const bf16* AA = (const bf16*)(ws + WS_AA);
    bf16* MIX = (bf16*)P.out; bf16* YI = (bf16*)(ws + WS_YI);
    const float* mu = P.in[4]; const float* k_k = P.in[10]; const float* k_a = P.in[11];
    LAS bf16* L = (LAS bf16*)lds;
    LAS float* GAM = (LAS float*)(lds + W_END * 2); LAS float* TOT = GAM + 64;
    const int col = h * 64 + lane, tg = wave;
    const float mu_r = mu[C_R + col], mu_k = mu[C_K + col], mu_v = mu[C_V + col], kkc = k_k[col], kac = k_a[col];
    const bool ident = wave >= 4; const int w4 = wave & 3;
    f32x4 Wreg[4];
#pragma unroll
    for (int k = 0; k < 4; ++k) Wreg[k] = (f32x4){0.f, 0.f, 0.f, 0.f};
    __syncthreads();
    for (int i = tid; i < 2 * 64 * 72 / 2; i += NTHR) ((LAS unsigned*)(L + W_SIM))[i] = 0u;
    __syncthreads();
    if (tid < 64) L[W_PIM + tid * 72 + tid] = (bf16)0x3F80;
    unsigned nr_[9], nk_[9], nv_[9], na_[8], nw_[8];
    { const int t0 = seg * LSEG;
#pragma unroll
      for (int r = 0; r < 9; ++r) { const int t = t0 + 8 * tg - 1 + r; const bf16* pr = p + ((size_t)b * T + (t > 0 ? t : 0)) * NP; nr_[r] = pr[C_R + col]; nk_[r] = pr[C_K + col]; nv_[r] = pr[C_V + col]; }
#pragma unroll
      for (int i = 0; i < 8; ++i) { const size_t m = (size_t)b * T + t0 + 8 * tg + i; na_[i] = AA[m * A_W + col]; nw_[i] = WL[m * A_W + col]; } }
    for (int c = 0; c < LSEG / 64; ++c) {
        const int t0 = seg * LSEG + c * 64;
        float rv[8], kkv[8], bv[8], khv[8], vv[8], g[8], wl[8];
        unsigned xr[9], xk[9], xv[9], xa[8], xw[8];
#pragma unroll
        for (int r = 0; r < 9; ++r) { xr[r] = nr_[r]; xk[r] = nk_[r]; xv[r] = nv_[r]; }
#pragma unroll
        for (int i = 0; i < 8; ++i) { xa[i] = na_[i]; xw[i] = nw_[i]; }
        if (c + 1 < LSEG / 64) {
#pragma unroll
            for (int r = 0; r < 9; ++r) { const int t = t0 + 64 + 8 * tg - 1 + r; const bf16* pr = p + ((size_t)b * T + t) * NP; nr_[r] = pr[C_R + col]; nk_[r] = pr[C_K + col]; nv_[r] = pr[C_V + col]; }
#pragma unroll
            for (int i = 0; i < 8; ++i) { const size_t m = (size_t)b * T + t0 + 64 + 8 * tg + i; na_[i] = AA[m * A_W + col]; nw_[i] = WL[m * A_W + col]; }
        }
#pragma unroll
        for (int i = 0; i < 8; ++i) { const int t = t0 + 8 * tg + i; const float hp = (t > 0) ? 1.f : 0.f;
            const float rc = bf2f(xr[i + 1]), kc = bf2f(xk[i + 1]), vc = bf2f(xv[i + 1]);
            const float r = rc + (bf2f(xr[i]) * hp - rc) * mu_r, k = kc + (bf2f(xk[i]) * hp - kc) * mu_k; vv[i] = vc + (bf2f(xv[i]) * hp - vc) * mu_v;
            const float a = bf2f(xa[i]); wl[i] = bf2f(xw[i]);
            const float kr = k * kkc; const float nrm = sqrtf(wave_sum(kr * kr)); const float kk = kr / fmaxf(nrm, 1e-12f);
            rv[i] = r; kkv[i] = kk; bv[i] = kk * a; khv[i] = k * (1.f + (a - 1.f) * kac); }
        g[0] = wl[0];
#pragma unroll
        for (int i = 1; i < 8; ++i) g[i] = g[i - 1] + wl[i];
        TOT[tg * 64 + lane] = g[7];
        __syncthreads();
        float off = 0.f, total = 0.f;
#pragma unroll
        for (int w = 0; w < 8; ++w) { const float tv = TOT[w * 64 + lane]; total += tv; off += (w < tg) ? tv : 0.f; }
        { float at[8], bt[8], kt[8];
#pragma unroll
          for (int i = 0; i < 8; ++i) { const float G = off + g[i]; const float eG = __expf(G), eGm = __expf(G - wl[i]), ei = __expf(-G);
              at[i] = -kkv[i] * eGm; bt[i] = bv[i] * ei; kt[i] = khv[i] * ei; const float rt = rv[i] * eG; const int row = 8 * tg + i;
              L[W_AT + row * 72 + lane] = (bf16)f2bf(at[i]); L[W_BT + row * 72 + lane] = (bf16)f2bf(bt[i]); L[W_KT + row * 72 + lane] = (bf16)f2bf(kt[i]); L[W_RT + row * 72 + lane] = (bf16)f2bf(rt); }
          u32x4 w;
          w.x = pk2(at[0], at[1]); w.y = pk2(at[2], at[3]); w.z = pk2(at[4], at[5]); w.w = pk2(at[6], at[7]); *(LAS u32x4*)(L + W_X0 + lane * 72 + 8 * tg) = w;
          w.x = pk2(bt[0], bt[1]); w.y = pk2(bt[2], bt[3]); w.z = pk2(bt[4], bt[5]); w.w = pk2(bt[6], bt[7]); *(LAS u32x4*)(L + W_BTT + lane * 72 + 8 * tg) = w;
          w.x = pk2(kt[0], kt[1]); w.y = pk2(kt[2], kt[3]); w.z = pk2(kt[4], kt[5]); w.w = pk2(kt[6], kt[7]); *(LAS u32x4*)(L + W_KTT + lane * 72 + 8 * tg) = w;
          w.x = pk2(vv[0], vv[1]); w.y = pk2(vv[2], vv[3]); w.z = pk2(vv[4], vv[5]); w.w = pk2(vv[6], vv[7]); *(LAS u32x4*)(L + W_VTT + lane * 72 + 8 * tg) = w; }
        if (tg == 0) GAM[lane] = __expf(total);
        __syncthreads();
        { bf16x8_t aB[2][2], aK[2][2], bA[2][2], bR[2][2]; f32x4 ab[2], ak[2], rb[2], rk[2];
#pragma unroll
          for (int q = 0; q < 2; ++q) { const int pos = wave * 2 + q, it = pos >> 2, tt = pos & 3;
#pragma unroll
              for (int sx = 0; sx < 2; ++sx) { aB[q][sx] = lfrag(L + W_BT, it * 16 + fr, sx, fq); aK[q][sx] = lfrag(L + W_KT, it * 16 + fr, sx, fq); bA[q][sx] = lfrag(L + W_AT, tt * 16 + fr, sx, fq); bR[q][sx] = lfrag(L + W_RT, tt * 16 + fr, sx, fq); } }
#pragma unroll
          for (int q = 0; q < 2; ++q) { ab[q] = (f32x4){0.f, 0.f, 0.f, 0.f}; ak[q] = ab[q]; rb[q] = ab[q]; rk[q] = ab[q];
#pragma unroll
              for (int sx = 0; sx < 2; ++sx) { ab[q] = MFMA16(aB[q][sx], bA[q][sx], ab[q]); ak[q] = MFMA16(aK[q][sx], bA[q][sx], ak[q]); rb[q] = MFMA16(aB[q][sx], bR[q][sx], rb[q]); rk[q] = MFMA16(aK[q][sx], bR[q][sx], rk[q]); } }
#pragma unroll
          for (int q = 0; q < 2; ++q) { const int pos = wave * 2 + q, it = pos >> 2, tt = pos & 3; const int t = tt * 16 + fr, i0 = it * 16 + 4 * fq;
#pragma unroll
              for (int rg = 0; rg < 4; ++rg) { const bool st = (i0 + rg < t), inc = (i0 + rg <= t); ab[q][rg] = st ? ab[q][rg] : 0.f; ak[q][rg] = st ? ak[q][rg] : 0.f; rb[q][rg] = inc ? rb[q][rg] : 0.f; rk[q][rg] = inc ? rk[q][rg] : 0.f; }
              st4(L + W_L0 + t * 72 + i0, ab[q][0], ab[q][1], ab[q][2], ab[q][3]); st4(L + W_LAK + t * 72 + i0, ak[q][0], ak[q][1], ak[q][2], ak[q][3]);
              st4(L + W_LRB + t * 72 + i0, rb[q][0], rb[q][1], rb[q][2], rb[q][3]); st4(L + W_LRK + t * 72 + i0, rk[q][0], rk[q][1], rk[q][2], rk[q][3]);
#pragma unroll
              for (int rg = 0; rg < 4; ++rg) L[W_LT0 + (i0 + rg) * 72 + t] = (bf16)f2bf(ab[q][rg]); } }
        __syncthreads();
        { bf16x8_t a[2][2], bb[2][2]; f32x4 acc[2];
#pragma unroll
          for (int q = 0; q < 2; ++q) { const int pos = wave * 2 + q, tt = pos >> 2, vt = pos & 3;
#pragma unroll
              for (int sx = 0; sx < 2; ++sx) { a[q][sx] = lfrag(L + W_LAK, tt * 16 + fr, sx, fq); bb[q][sx] = lfrag(L + W_VTT, vt * 16 + fr, sx, fq); } }
#pragma unroll
          for (int q = 0; q < 2; ++q) { acc[q] = (f32x4){0.f, 0.f, 0.f, 0.f};
#pragma unroll
              for (int sx = 0; sx < 2; ++sx) acc[q] = MFMA16(a[q][sx], bb[q][sx], acc[q]); }
#pragma unroll
          for (int q = 0; q < 2; ++q) { const int pos = wave * 2 + q, tt = pos >> 2, vt = pos & 3; st4(L + W_X0 + (64 + vt * 16 + fr) * 72 + tt * 16 + 4 * fq, acc[q][0], acc[q][1], acc[q][2], acc[q][3]); } }
        if (wave < 4) {
            const int r16 = wave * 16;
            f32x4 PA = ld4(L + W_L0 + (r16 + fr) * 72 + r16 + 4 * fq), PB = ld4(L + W_LT0 + (r16 + fr) * 72 + r16 + 4 * fq);
            f32x4 MA = PA, MB = PB;
#pragma unroll
            for (int j = 0; j < 4; ++j) { const float d = (fr == 4 * fq + j) ? 1.f : 0.f; MA[j] += d; MB[j] += d; }
#pragma unroll
            for (int it3 = 0; it3 < 3; ++it3) {
                const bf16x4_t pa = pack4(PA), pb = pack4(PB);
                const f32x4 QB = MFMA16K(pa, pb, ((f32x4){0.f, 0.f, 0.f, 0.f})), QA = MFMA16K(pb, pa, ((f32x4){0.f, 0.f, 0.f, 0.f}));
                PA = QA; PB = QB;
                const bf16x4_t qb = pack4(QB), ma = pack4(MA);
                MB = MFMA16K(ma, qb, MB); MA = MFMA16K(qb, ma, MA);
            }
            st4(L + W_MI + (r16 + fr) * 24 + 4 * fq, MA[0], MA[1], MA[2], MA[3]);
        }
        __syncthreads();
        { bf16x4_t y[4]; LAS bf16* Xrow = L + W_X0 + (wave * 16 + fr) * 72 + 4 * fq;
#pragma unroll
          for (int r = 0; r < 4; ++r) {
              f32x4 acc = ld4(Xrow + 16 * r);
#pragma unroll
              for (int cc = 0; cc < 4; ++cc) if (cc < r) acc = MFMA16K(*(const LAS bf16x4_t*)(L + W_L0 + (16 * r + fr) * 72 + 16 * cc + 4 * fq), y[cc], acc);
              const bf16x4_t tb = pack4(acc);
              const f32x4 xr = MFMA16K(*(const LAS bf16x4_t*)(L + W_MI + (16 * r + fr) * 24 + 4 * fq), tb, ((f32x4){0.f, 0.f, 0.f, 0.f}));
              y[r] = pack4(xr);
              *(LAS bf16x4_t*)(Xrow + 16 * r) = y[r]; } }
        __syncthreads();
        { bf16x8_t aX[2][2], bT[2][2], bL[2][2]; f32x4 accT[2], accQ[2], rt[2]; float gm[2];
#pragma unroll
          for (int q = 0; q < 2; ++q) { const int pos = wave * 2 + q, kt = pos >> 2, nt = pos & 3;
#pragma unroll
              for (int sx = 0; sx < 2; ++sx) { aX[q][sx] = lfrag(L + W_X0, kt * 16 + fr, sx, fq); bT[q][sx] = lfrag(L + W_BTT, nt * 16 + fr, sx, fq); bL[q][sx] = lfrag(L + W_LRB, nt * 16 + fr, sx, fq); }
              gm[q] = GAM[nt * 16 + fr]; rt[q] = ld4(L + W_RT + (nt * 16 + fr) * 72 + kt * 16 + 4 * fq); }
#pragma unroll
          for (int q = 0; q < 2; ++q) { accT[q] = (f32x4){0.f, 0.f, 0.f, 0.f}; accQ[q] = accT[q];
#pragma unroll
              for (int sx = 0; sx < 2; ++sx) { accT[q] = MFMA16(aX[q][sx], bT[q][sx], accT[q]); accQ[q] = MFMA16(aX[q][sx], bL[q][sx], accQ[q]); } }
#pragma unroll
          for (int q = 0; q < 2; ++q) { const int pos = wave * 2 + q, kt = pos >> 2, nt = pos & 3; const int k0 = kt * 16 + 4 * fq, n = nt * 16 + fr;
#pragma unroll
              for (int rg = 0; rg < 4; ++rg) accT[q][rg] = (accT[q][rg] + ((k0 + rg == n) ? 1.f : 0.f)) * gm[q];
              st4(L + W_TT + n * 72 + k0, accT[q][0], accT[q][1], accT[q][2], accT[q][3]); st4(L + W_QT + n * 72 + k0, accQ[q][0] + rt[q][0], accQ[q][1] + rt[q][1], accQ[q][2] + rt[q][2], accQ[q][3] + rt[q][3]); } }
        __syncthreads();
        { f32x4 oacc[4];
#pragma unroll
          for (int vt = 0; vt < 4; ++vt) oacc[vt] = (f32x4){0.f, 0.f, 0.f, 0.f};
#pragma unroll
          for (int sx = 0; sx < 2; ++sx) { const bf16x8_t aQ = lfrag(L + W_QT, w4 * 16 + fr, sx, fq);
              if (!ident) { const bf16x8_t aB = lfrag(L + W_LRB, w4 * 16 + fr, sx, fq), aK = lfrag(L + W_LRK, w4 * 16 + fr, sx, fq);
#pragma unroll
                  for (int vt = 0; vt < 4; ++vt) { const int rw = 4 * fr + vt; oacc[vt] = MFMA16(aB, lfrag(L + W_X0, 64 + rw, sx, fq), oacc[vt]); oacc[vt] = MFMA16(aK, lfrag(L + W_VTT, rw, sx, fq), oacc[vt]); oacc[vt] = MFMA16(aQ, lfrag(L + W_SIM, rw, sx, fq), oacc[vt]); } }
              else {
#pragma unroll
                  for (int vt = 0; vt < 4; ++vt) oacc[vt] = MFMA16(aQ, lfrag(L + W_PIM, 4 * fr + vt, sx, fq), oacc[vt]); } }
          bf16* OUT = ident ? (YI + (size_t)h * 64) : (MIX + (size_t)h * 64); const int ldo = ident ? 512 : D;
#pragma unroll
          for (int rg = 0; rg < 4; ++rg) { const size_t m = (size_t)b * T + t0 + w4 * 16 + 4 * fq + rg; u32x2 w; w.x = pk2(oacc[0][rg], oacc[1][rg]); w.y = pk2(oacc[2][rg], oacc[3][rg]); *(u32x2*)(OUT + m * ldo + 4 * fr) = w; } }
#pragma unroll
        for (int nt = 0; nt < 4; ++nt) { f32x4 acc = (f32x4){0.f, 0.f, 0.f, 0.f};
            if (!ident) {
#pragma unroll
                for (int sx = 0; sx < 2; ++sx) { acc = MFMA16(lfrag(L + W_X0, 64 + w4 * 16 + fr, sx, fq), lfrag(L + W_BTT, nt * 16 + fr, sx, fq), acc); acc = MFMA16(lfrag(L + W_VTT, w4 * 16 + fr, sx, fq), lfrag(L + W_KTT, nt * 16 + fr, sx, fq), acc); }
                acc = acc * GAM[nt * 16 + fr]; }
            const LAS bf16* IM = L + (ident ? W_PIM : W_SIM);
#pragma unroll
            for (int sx = 0; sx < 2; ++sx) acc = MFMA16(lfrag(IM, w4 * 16 + fr, sx, fq), lfrag(L + W_TT, nt * 16 + fr, sx, fq), acc);
            Wreg[nt] = acc; }
        __syncthreads();
        { LAS bf16* IM = L + (ident ? W_PIM : W_SIM);
#pragma unroll
          for (int nt = 0; nt < 4; ++nt)
#pragma unroll
              for (int rg = 0; rg < 4; ++rg) IM[(w4 * 16 + 4 * fq + rg) * 72 + nt * 16 + fr] = (bf16)f2bf(Wreg[nt][rg]); }
    }
    float* SE = (float*)(ws + WS_SER) + ((((size_t)(b * 8 + h) * NSEG + seg) * 2 + (ident ? 1 : 0)) * 4096);
#pragma unroll
    for (int nt = 0; nt < 4; ++nt)
#pragma unroll
        for (int rg = 0; rg < 4; ++rg) SE[(w4 * 16 + 4 * fq + rg) * 64 + nt * 16 + fr] = Wreg[nt][rg];
}

constexpr int GQ = 0, GK_ = GQ + 64 * 72, GD = GK_ + 64 * 72, GV = GD + 64 * 72, GA = GV + 128 * 72, GS = GA + 64 * 72, GEND = GS + 128 * 72;
__device__ __forceinline__ unsigned pk2f(float a, float b) { return pk2(a, b); }
__device__ __forceinline__ void gla_item(const Params& P, LAS unsigned char* lds, int b, int h, int seg) {
    const int tid = threadIdx.x, lane = tid & 63, wave = __builtin_amdgcn_readfirstlane(tid >> 6), fr = lane & 15, fq = lane >> 4;
    unsigned char* ws = P.ws;
    const bf16* p = (const bf16*)(ws + WS_P); bf16* GKB = (bf16*)(ws + WS_GK);
    bf16* MIX = (bf16*)P.out;
    float* SE = (float*)(ws + WS_SEG) + ((size_t)(b * 4 + h) * NSEG + seg) * 8192; float* CE = (float*)(ws + WS_CEND) + ((size_t)(b * 4 + h) * NSEG + seg) * 64;
    const float* conv = P.in[15];
    LAS bf16* L = (LAS bf16*)lds; LAS bf16* QT = L + GQ; LAS bf16* KT = L + GK_; LAS bf16* KD = L + GD; LAS bf16* VT = L + GV; LAS bf16* AT = L + GA; LAS bf16* ST = L + GS;
    LAS float* GAM = (LAS float*)(lds + GEND * 2); LAS float* TOT = GAM + 64;
    const int ch = lane, tg = wave;
    const int cq = h * 64 + ch, ck = 256 + h * 64 + ch, cv0 = 512 + h * 128 + ch, cv1 = cv0 + 64;
    float wq[4], wk[4], wv0[4], wv1[4];
#pragma unroll
    for (int j = 0; j < 4; ++j) { wq[j] = conv[j * 1024 + cq]; wk[j] = conv[j * 1024 + ck]; wv0[j] = conv[j * 1024 + cv0]; wv1[j] = conv[j * 1024 + cv1]; }
    float gseg = 0.f;
    f32x4 Sacc[4];
#pragma unroll
    for (int k = 0; k < 4; ++k) Sacc[k] = (f32x4){0.f, 0.f, 0.f, 0.f};
    __syncthreads();
    for (int i = tid; i < 128 * 72 / 2; i += NTHR) ((LAS unsigned*)ST)[i] = 0u;
    for (int c = 0; c < LSEG / 64; ++c) {
        const int t0 = seg * LSEG + c * 64;
        __syncthreads();
        float xq[11], xk[11], xa[11], xb[11], g[8];
#pragma unroll
        for (int r = 0; r < 11; ++r) { const int t = t0 + 8 * tg - 3 + r; const size_t m = (size_t)b * T + (t > 0 ? t : 0); const float ok = (t >= 0) ? 1.f : 0.f; const bf16* pr = p + m * NP + C_BQ;
            xq[r] = bf2f(pr[cq]) * ok; xk[r] = bf2f(pr[ck]) * ok; xa[r] = bf2f(pr[cv0]) * ok; xb[r] = bf2f(pr[cv1]) * ok; }
#pragma unroll
        for (int i = 0; i < 8; ++i) g[i] = bf2f(GKB[((size_t)b * T + t0 + 8 * tg + i) * 256 + h * 64 + ch]);
#pragma unroll
        for (int i = 1; i < 8; ++i) g[i] += g[i - 1];
        TOT[tg * 64 + ch] = g[7];
        __syncthreads();
        float off = 0.f, total = 0.f;
#pragma unroll
        for (int w = 0; w < 8; ++w) { const float tv = TOT[w * 64 + ch]; total += tv; off += (w < tg) ? tv : 0.f; }
        float kd[8], va[8], vb[8];
#pragma unroll
        for (int i = 0; i < 8; ++i) {
            float aq = 0.f, ak = 0.f, a0 = 0.f, a1 = 0.f;
#pragma unroll
            for (int j = 0; j < 4; ++j) { aq += wq[j] * xq[i + j]; ak += wk[j] * xk[i + j]; a0 += wv0[j] * xa[i + j]; a1 += wv1[j] * xb[i + j]; }
            const float q = siluf_(aq) * 0.125f, k = siluf_(ak), Gc = off + g[i];
            QT[(8 * tg + i) * 72 + ch] = (bf16)f2bf(q * __expf(Gc)); KT[(8 * tg + i) * 72 + ch] = (bf16)f2bf(k * __expf(-Gc));
            kd[i] = k * __expf(total - Gc); va[i] = siluf_(a0); vb[i] = siluf_(a1);
            GKB[((size_t)b * T + t0 + 8 * tg + i) * 256 + h * 64 + ch] = (bf16)f2bf(q * __expf(gseg + Gc));
        }
        { u32x4 w; w.x = pk2f(kd[0], kd[1]); w.y = pk2f(kd[2], kd[3]); w.z = pk2f(kd[4], kd[5]); w.w = pk2f(kd[6], kd[7]); *(LAS u32x4*)(KD + ch * 72 + 8 * tg) = w;
          w.x = pk2f(va[0], va[1]); w.y = pk2f(va[2], va[3]); w.z = pk2f(va[4], va[5]); w.w = pk2f(va[6], va[7]); *(LAS u32x4*)(VT + ch * 72 + 8 * tg) = w;
          w.x = pk2f(vb[0], vb[1]); w.y = pk2f(vb[2], vb[3]); w.z = pk2f(vb[4], vb[5]); w.w = pk2f(vb[6], vb[7]); *(LAS u32x4*)(VT + (64 + ch) * 72 + 8 * tg) = w; }
        if (tg == 0) GAM[ch] = __expf(total);
        gseg += total;
        __syncthreads();
#pragma unroll
        for (int k2 = 0; k2 < 2; ++k2) { const int tile = wave * 2 + k2, jt = tile >> 2, it = tile & 3; f32x4 acc = (f32x4){0.f, 0.f, 0.f, 0.f};
            if (jt <= it) {
#pragma unroll
                for (int sx = 0; sx < 2; ++sx) acc = __builtin_amdgcn_mfma_f32_16x16x32_bf16(*(const LAS bf16x8_t*)(KT + (jt * 16 + fr) * 72 + 32 * sx + 8 * fq), *(const LAS bf16x8_t*)(QT + (it * 16 + fr) * 72 + 32 * sx + 8 * fq), acc, 0, 0, 0);
            }
            const int ii = it * 16 + fr, j0 = jt * 16 + 4 * fq; u32x2 w;
            w.x = pk2f(j0 <= ii ? acc[0] : 0.f, j0 + 1 <= ii ? acc[1] : 0.f); w.y = pk2f(j0 + 2 <= ii ? acc[2] : 0.f, j0 + 3 <= ii ? acc[3] : 0.f);
            *(LAS u32x2*)(AT + ii * 72 + j0) = w; }
        __syncthreads();
        { const int it = wave & 3, vts = (wave >> 2) * 4; f32x4 oacc[4];
#pragma unroll
          for (int k = 0; k < 4; ++k) oacc[k] = (f32x4){0.f, 0.f, 0.f, 0.f};
#pragma unroll
          for (int sx = 0; sx < 2; ++sx) { const bf16x8_t aA = *(const LAS bf16x8_t*)(AT + (it * 16 + fr) * 72 + 32 * sx + 8 * fq), aQ = *(const LAS bf16x8_t*)(QT + (it * 16 + fr) * 72 + 32 * sx + 8 * fq);
#pragma unroll
              for (int k = 0; k < 4; ++k) { const int vrow = 8 * fr + vts + k;
                  oacc[k] = __builtin_amdgcn_mfma_f32_16x16x32_bf16(aA, *(const LAS bf16x8_t*)(VT + vrow * 72 + 32 * sx + 8 * fq), oacc[k], 0, 0, 0);
                  oacc[k] = __builtin_amdgcn_mfma_f32_16x16x32_bf16(aQ, *(const LAS bf16x8_t*)(ST + vrow * 72 + 32 * sx + 8 * fq), oacc[k], 0, 0, 0); } }
#pragma unroll
          for (int rg = 0; rg < 4; ++rg) { const size_t m = (size_t)b * T + t0 + it * 16 + 4 * fq + rg; u32x2 w; w.x = pk2f(oacc[0][rg], oacc[1][rg]); w.y = pk2f(oacc[2][rg], oacc[3][rg]);
              *(u32x2*)(MIX + m * D + 512 + h * 128 + 8 * fr + vts) = w; } }
#pragma unroll
        for (int k = 0; k < 4; ++k) { f32x4 acc = Sacc[k] * GAM[k * 16 + fr];
#pragma unroll
            for (int sx = 0; sx < 2; ++sx) acc = __builtin_amdgcn_mfma_f32_16x16x32_bf16(*(const LAS bf16x8_t*)(VT + (wave * 16 + fr) * 72 + 32 * sx + 8 * fq), *(const LAS bf16x8_t*)(KD + (k * 16 + fr) * 72 + 32 * sx + 8 * fq), acc, 0, 0, 0);
            Sacc[k] = acc; }
        __syncthreads();
#pragma unroll
        for (int k = 0; k < 4; ++k)
#pragma unroll
            for (int rg = 0; rg < 4; ++rg) ST[(wave * 16 + 4 * fq + rg) * 72 + k * 16 + fr] = (bf16)f2bf(Sacc[k][rg]);
    }
#pragma unroll
    for (int k = 0; k < 4; ++k)
#pragma unroll
        for (int rg = 0; rg < 4; ++rg) SE[(wave * 16 + 4 * fq + rg) * 64 + k * 16 + fr] = Sacc[k][rg];
    if (tg == 0) CE[ch] = __expf(gseg);
}
__device__ __forceinline__ void phase_scan(const Params& P, LAS unsigned char* lds) {
    for (int it = blockIdx.x; it < 512 + 256; it += gridDim.x) {
        if (it < 512) { const int bh = it >> 4; rwkv_item_chunked(P, lds, bh >> 3, bh & 7, it & 15); }
        else { const int g = it - 512, bh = g >> 4; gla_item(P, lds, bh >> 2, bh & 3, g & 15); }
        __syncthreads();
    }
}
__device__ __forceinline__ void quant_tables(const Params& P, int gw, int ngw);
__device__ __forceinline__ void phase_fixup(const Params& P, LAS unsigned char* lds) {
    const int tid = threadIdx.x, lane = tid & 63, wave = __builtin_amdgcn_readfirstlane(tid >> 6), fr = lane & 15, fq = lane >> 4;
    for (int it = blockIdx.x; it < 192; it += gridDim.x) {
        if (it < 64) {
            float* SE = (float*)(P.ws + WS_SER) + (size_t)(it >> 1) * NSEG * 2 * 4096;
            LAS float* Sb = (LAS float*)lds;
            const int sl = wave >> 2, nt = wave & 3, r0 = ((it & 1) * 2 + sl) * 16;
            const int cpos = (r0 + 4 * fq) * 64 + nt * 16 + fr;
            const int bpos = (16 * fq) * 64 + nt * 16 + fr;
            __syncthreads();
            f32x4 en[4]; float ph[4][16];
#define FX_LOAD(sg) do { const float* nx_ = SE + (size_t)((sg) * 2) * 4096; \
                _Pragma("unroll") for (int ks = 0; ks < 16; ++ks) ph[(sg) & 3][ks] = nx_[4096 + bpos + 64 * ks]; \
                _Pragma("unroll") for (int rg = 0; rg < 4; ++rg) en[(sg) & 3][rg] = nx_[cpos + 64 * rg]; } while (0)
#pragma unroll
            for (int rg = 0; rg < 4; ++rg) Sb[(sl * 16 + 4 * fq + rg) * 68 + nt * 16 + fr] = SE[cpos + 64 * rg];
            FX_LOAD(1); FX_LOAD(2); FX_LOAD(3);
            __syncthreads();
#pragma unroll
            for (int seg = 1; seg < NSEG - 1; ++seg) {
                float* s0 = SE + (size_t)(seg * 2) * 4096;
                const LAS float* Sr = Sb + ((seg - 1) & 1) * (2 * 16 * 68) + (sl * 16 + fr) * 68 + 16 * fq; LAS float* Sw = Sb + (seg & 1) * (2 * 16 * 68);
                if (seg + 3 < NSEG - 1) FX_LOAD(seg + 3);
                f32x4 acc = en[seg & 3]; f32x4 av[4];
#pragma unroll
                for (int j = 0; j < 4; ++j) av[j] = *(const LAS f32x4*)(Sr + 4 * j);
#pragma unroll
                for (int ks = 0; ks < 16; ++ks) acc = __builtin_amdgcn_mfma_f32_16x16x4f32(av[ks >> 2][ks & 3], ph[seg & 3][ks], acc, 0, 0, 0);
#pragma unroll
                for (int rg = 0; rg < 4; ++rg) { s0[cpos + 64 * rg] = acc[rg]; Sw[(sl * 16 + 4 * fq + rg) * 68 + nt * 16 + fr] = acc[rg]; }
                __syncthreads();
            }
#undef FX_LOAD
        } else {
            const int g = it - 64, bh = g >> 3; float* SE = (float*)(P.ws + WS_SEG) + (size_t)bh * NSEG * 8192 + ((g & 7) * 16 + (tid >> 5)) * 64 + (tid & 31) * 2;
            const float* CE = (const float*)(P.ws + WS_CEND) + (size_t)bh * NSEG * 64 + (tid & 31) * 2;
            f32x2 x[NSEG - 1], ce[NSEG - 1];
#pragma unroll
            for (int seg = 0; seg < NSEG - 1; ++seg) { x[seg] = *(const f32x2*)(SE + (size_t)seg * 8192); ce[seg] = *(const f32x2*)(CE + seg * 64); }
            f32x2 sc = (f32x2){0.f, 0.f};
#pragma unroll
            for (int seg = 0; seg < NSEG - 1; ++seg) { sc = sc * ce[seg] + x[seg]; *(f32x2*)(SE + (size_t)seg * 8192) = sc; }
        }
    }
    {
        const bool sp = gridDim.x > 64; const int nb = sp ? (int)gridDim.x - 64 : (int)gridDim.x, bi = sp ? (int)blockIdx.x - 64 : (int)blockIdx.x;
        if (bi >= 0) {
            fold_keys(P, lds, bi, nb);
            transpose_convert(P.in[19], D, D, D, (bf16*)(P.ws + WS_WOUT), bi * NTHR + tid, nb * NTHR);
            quant_tables(P, bi * NWAVES + (tid >> 6), nb * NWAVES);
        }
    }
}
__device__ __forceinline__ float row_sum16(float v) { v = DPP_ADD(v, 0xB1); v = DPP_ADD(v, 0x4E); v = DPP_ADD(v, 0x141); v = DPP_ADD(v, 0x140); return v; }
__device__ __forceinline__ bf16x8_t pack_bf16x8(const f32x4 a, const f32x4 b) {
    u32x4 w; w.x = pk2(a[0], a[1]); w.y = pk2(a[2], a[3]); w.z = pk2(b[0], b[1]); w.w = pk2(b[2], b[3]); return __builtin_bit_cast(bf16x8_t, w);
}
__device__ __forceinline__ void unpack4(const u32x2 w, float (&o)[4]) { o[0] = __uint_as_float(w.x << 16); o[1] = __uint_as_float(w.x & 0xffff0000u); o[2] = __uint_as_float(w.y << 16); o[3] = __uint_as_float(w.y & 0xffff0000u); }
__device__ __forceinline__ void phase_correct(const Params& P, LAS unsigned char* lds) {
    const int tid = threadIdx.x, lane = tid & 63, wave = __builtin_amdgcn_readfirstlane(tid >> 6), fr = lane & 15, fq = lane >> 4;
    unsigned char* ws = P.ws;
    const bf16* p = (const bf16*)(ws + WS_P); const bf16* AA = (const bf16*)(ws + WS_AA); const bf16* GG = (const bf16*)(ws + WS_GG);
    bf16* MIX = (bf16*)P.out; const bf16* YI = (const bf16*)(ws + WS_YI); const bf16* YIG = (const bf16*)(ws + WS_YIG);
    const float* mu = P.in[4]; const float* k_a = P.in[11]; const float* r_k = P.in[12]; const float* gn_g = P.in[13]; const float* gn_b = P.in[14]; const float* norm_g = P.in[18];
    LAS bf16* SB = (LAS bf16*)lds;
    for (int it = blockIdx.x; it < 512; it += gridDim.x) {
        {
            const int seg = it & 15, bh = it >> 4, b = bh >> 3, h = bh & 7;
            const int cb = h * 64 + 4 * fr;
            __syncthreads();
            if (seg > 0) { const float* ss = (const float*)(ws + WS_SER) + (((size_t)bh * NSEG + (seg - 1)) * 2) * 4096;
                for (int i = tid; i < 1024; i += NTHR) { const f32x4 x = *(const f32x4*)(ss + 4 * i); const int v = i >> 4, j = (4 * i) & 63; u32x2 w; w.x = pk2(x[0], x[1]); w.y = pk2(x[2], x[3]);
                    *(LAS u32x2*)(SB + ((v & 3) * 16 + (v >> 2)) * 72 + j) = w; } }
            __syncthreads();
            const f32x4 mur = *(const f32x4*)(mu + C_R + cb), muk = *(const f32x4*)(mu + C_K + cb), muv = *(const f32x4*)(mu + C_V + cb), kac = *(const f32x4*)(k_a + cb), rkc = *(const f32x4*)(r_k + cb), gng = *(const f32x4*)(gn_g + cb), gnb = *(const f32x4*)(gn_b + cb);
            u32x2 W[4][9];
#define CORR_LOAD(buf, st) do { const int t_ = seg * LSEG + wave * 64 + ((st) >> 2) * 16 + 4 * fq + ((st) & 3); const size_t m_ = (size_t)b * T + t_; const bf16* pr_ = p + m_ * NP + cb; const bf16* pp_ = (t_ > 0) ? pr_ - NP : pr_; \
                    W[buf][0] = *(const u32x2*)(MIX + m_ * D + cb); W[buf][1] = *(const u32x2*)(pr_ + C_R); W[buf][2] = *(const u32x2*)(pr_ + C_K); W[buf][3] = *(const u32x2*)(pr_ + C_V); \
                    W[buf][4] = *(const u32x2*)(pp_ + C_R); W[buf][5] = *(const u32x2*)(pp_ + C_K); W[buf][6] = *(const u32x2*)(pp_ + C_V); W[buf][7] = *(const u32x2*)(AA + m_ * A_W + cb); W[buf][8] = *(const u32x2*)(GG + m_ * A_W + cb); } while (0)
            CORR_LOAD(0, 0); CORR_LOAD(1, 1); CORR_LOAD(2, 2);
#pragma unroll
            for (int mt = 0; mt < 4; ++mt) {
                const int tb = seg * LSEG + wave * 64 + mt * 16;
                f32x4 acc[4];
#pragma unroll
                for (int vt = 0; vt < 4; ++vt) acc[vt] = (f32x4){0.f, 0.f, 0.f, 0.f};
                if (seg > 0) {
#pragma unroll
                    for (int sx = 0; sx < 2; ++sx) { const bf16x8_t af = *(const bf16x8_t*)(YI + ((size_t)b * T + tb + fr) * 512 + h * 64 + 32 * sx + 8 * fq);
#pragma unroll
                        for (int vt = 0; vt < 4; ++vt) acc[vt] = __builtin_amdgcn_mfma_f32_16x16x32_bf16(af, *(const LAS bf16x8_t*)(SB + (vt * 16 + fr) * 72 + 32 * sx + 8 * fq), acc[vt], 0, 0, 0); }
                }
#pragma unroll
                for (int rg = 0; rg < 4; ++rg) { const int t = tb + 4 * fq + rg; const size_t m = (size_t)b * T + t; const float hp = (t > 0) ? 1.f : 0.f; const int st = mt * 4 + rg;
                    if (st + 3 < 16) CORR_LOAD((st + 3) & 3, st + 3);
                    __builtin_amdgcn_sched_barrier(0);
                    float y[4], rc[4], kc[4], vc[4], rp_[4], kp[4], vp[4], a[4], g[4];
                    unpack4(W[st & 3][0], y); unpack4(W[st & 3][1], rc); unpack4(W[st & 3][2], kc); unpack4(W[st & 3][3], vc); unpack4(W[st & 3][4], rp_); unpack4(W[st & 3][5], kp); unpack4(W[st & 3][6], vp); unpack4(W[st & 3][7], a); unpack4(W[st & 3][8], g);
                    float v[4], sy = 0.f, sb = 0.f;
#pragma unroll
                    for (int i = 0; i < 4; ++i) { y[i] += acc[i][rg];
                        const float r = rc[i] + (rp_[i] * hp - rc[i]) * mur[i], k = kc[i] + (kp[i] * hp - kc[i]) * muk[i]; v[i] = vc[i] + (vp[i] * hp - vc[i]) * muv[i];
                        const float kh = k * (1.f + (a[i] - 1.f) * kac[i]); sb += r * kh * rkc[i]; sy += y[i]; }
                    const float bon = row_sum16(sb), mean = row_sum16(sy) * (1.f / 64.f); float sq = 0.f;
#pragma unroll
                    for (int i = 0; i < 4; ++i) { y[i] -= mean; sq += y[i] * y[i]; }
                    const float rstd = 1.f / sqrtf(row_sum16(sq) * (1.f / 64.f) + GN_EPS); float o[4];
#pragma unroll
                    for (int i = 0; i < 4; ++i) o[i] = (y[i] * rstd * gng[i] + gnb[i] + bon * v[i]) * g[i];
                    u32x2 w; w.x = pk2(o[0], o[1]); w.y = pk2(o[2], o[3]); *(u32x2*)(MIX + m * D + cb) = w;
                    __builtin_amdgcn_sched_barrier(0); }
#undef CORR_LOAD
            }
        }
    }
    for (int g_ = blockIdx.x; g_ < 256; g_ += gridDim.x) {
        {
            const int seg = g_ & 15, bh = g_ >> 4, b = bh >> 2, h = bh & 3;
            const int cb = h * 128 + 8 * fr;
            __syncthreads();
            if (seg > 0) { const float* ss = (const float*)(ws + WS_SEG) + ((size_t)bh * NSEG + (seg - 1)) * 8192;
                for (int i = tid; i < 2048; i += NTHR) { const f32x4 x = *(const f32x4*)(ss + 4 * i); const int v = i >> 4, j = (4 * i) & 63; u32x2 w; w.x = pk2(x[0], x[1]); w.y = pk2(x[2], x[3]);
                    *(LAS u32x2*)(SB + ((v & 7) * 16 + (v >> 3)) * 72 + j) = w; } }
            __syncthreads();
            const f32x4 ng0 = *(const f32x4*)(norm_g + 8 * fr), ng1 = *(const f32x4*)(norm_g + 8 * fr + 4);
            u32x4 WG[4][2];
#define CORG_LOAD(buf, st) do { const size_t m_ = (size_t)b * T + seg * LSEG + wave * 64 + ((st) >> 2) * 16 + 4 * fq + ((st) & 3); WG[buf][0] = *(const u32x4*)(MIX + m_ * D + 512 + cb); WG[buf][1] = *(const u32x4*)(p + m_ * NP + C_BG + cb); } while (0)
            CORG_LOAD(0, 0); CORG_LOAD(1, 1); CORG_LOAD(2, 2);
#pragma unroll
            for (int mt = 0; mt < 4; ++mt) {
                const int tb = seg * LSEG + wave * 64 + mt * 16;
                f32x4 acc[8];
#pragma unroll
                for (int vt = 0; vt < 8; ++vt) acc[vt] = (f32x4){0.f, 0.f, 0.f, 0.f};
                if (seg > 0) {
#pragma unroll
                    for (int sx = 0; sx < 2; ++sx) { const bf16x8_t af = *(const bf16x8_t*)(YIG + ((size_t)b * T + tb + fr) * 256 + h * 64 + 32 * sx + 8 * fq);
#pragma unroll
                        for (int vt = 0; vt < 8; ++vt) acc[vt] = __builtin_amdgcn_mfma_f32_16x16x32_bf16(af, *(const LAS bf16x8_t*)(SB + (vt * 16 + fr) * 72 + 32 * sx + 8 * fq), acc[vt], 0, 0, 0); }
                }
#pragma unroll
                for (int rg = 0; rg < 4; ++rg) { const size_t m = (size_t)b * T + tb + 4 * fq + rg; const int st = mt * 4 + rg;
                    if (st + 3 < 16) CORG_LOAD((st + 3) & 3, st + 3);
                    __builtin_amdgcn_sched_barrier(0);
                    float o[8], g[8]; float sq = 0.f;
#pragma unroll
                    for (int i = 0; i < 4; ++i) { const unsigned a_ = WG[st & 3][0][i], b_ = WG[st & 3][1][i]; o[2 * i] = __uint_as_float(a_ << 16); o[2 * i + 1] = __uint_as_float(a_ & 0xffff0000u); g[2 * i] = __uint_as_float(b_ << 16); g[2 * i + 1] = __uint_as_float(b_ & 0xffff0000u); }
#pragma unroll
                    for (int i = 0; i < 8; ++i) { o[i] += acc[i][rg]; sq += o[i] * o[i]; }
                    const float rs = 1.f / sqrtf(row_sum16(sq) * (1.f / 128.f) + RMS_EPS);
                    float f[8];
#pragma unroll
                    for (int i = 0; i < 8; ++i) f[i] = o[i] * rs * (i < 4 ? ng0[i & 3] : ng1[i & 3]) * siluf_(g[i]);
                    u32x4 w; w.x = pk2(f[0], f[1]); w.y = pk2(f[2], f[3]); w.z = pk2(f[4], f[5]); w.w = pk2(f[6], f[7]); *(u32x4*)(MIX + m * D + 512 + cb) = w;
                    __builtin_amdgcn_sched_barrier(0); }
#undef CORG_LOAD
            }
        }
    }
}

__device__ __forceinline__ void phase_ln1(const Params& P) {
    const int lane = threadIdx.x & 63, wave = threadIdx.x >> 6; const int gw = blockIdx.x * NWAVES + wave, ngw = gridDim.x * NWAVES;
    for (int m = gw; m < M; m += ngw) ln_rowb_bf16<true>((const bf16*)(P.ws + WS_Z) + (size_t)m * D, P.in[20], P.in[21], (bf16*)(P.ws + WS_H1) + (size_t)m * D, lane, P.ws + WS_H8 + (size_t)m * 2048);
}
__device__ __forceinline__ void quant_tables(const Params& P, int gw, int ngw) {
    const int lane = threadIdx.x & 63;
    {
        const float* src = P.in[24]; unsigned char* dst = P.ws + WS_UF + (size_t)(lane >> 3) * UF_SLICE + 16 * (lane & 7); float* sc = (float*)(P.ws + WS_SU);
        for (int e = gw; e < 16384; e += ngw) {
            const f32x4* sp = (const f32x4*)(src + (size_t)e * D) + 4 * lane; f32x4 a[4]; float mx = 0.f;
#pragma unroll
            for (int j = 0; j < 4; ++j) { a[j] = sp[j]; mx = fmaxf(fmaxf(mx, fmaxf(fabsf(a[j][0]), fabsf(a[j][1]))), fmaxf(fabsf(a[j][2]), fabsf(a[j][3]))); }
            mx = wave_max_u(mx); const float inv = mx > 0.f ? 448.f / mx : 0.f;
            u32x4 w;
#pragma unroll
            for (int j = 0; j < 4; ++j) { int pk = __builtin_amdgcn_cvt_pk_fp8_f32(a[j][0] * inv, a[j][1] * inv, 0, false); pk = __builtin_amdgcn_cvt_pk_fp8_f32(a[j][2] * inv, a[j][3] * inv, pk, true); w[j] = (unsigned)pk; }
            *(u32x4*)(dst + (size_t)e * 128) = w;
            if (lane == 0) sc[e] = mx * (1.f / 448.f);
        }
    }
    {
        const float* src = P.in[25]; unsigned char* dst = P.ws + WS_V8 + (size_t)(lane >> 3) * V8_SLICE + 16 * (lane & 7); float* sc = (float*)(P.ws + WS_SV);
        for (int e = gw; e < 16384; e += ngw) {
            const f32x4* sp = (const f32x4*)(src + (size_t)e * D) + 4 * lane; f32x4 a[4]; float mx = 0.f;
#pragma unroll
            for (int j = 0; j < 4; ++j) { a[j] = sp[j]; mx = fmaxf(fmaxf(mx, fmaxf(fabsf(a[j][0]), fabsf(a[j][1]))), fmaxf(fabsf(a[j][2]), fabsf(a[j][3]))); }
            mx = wave_max_u(mx); const float inv = mx > 0.f ? 127.f / mx : 0.f;
            u32x4 w;
#pragma unroll
            for (int j = 0; j < 4; ++j) w[j] = pack_i8(a[j][0], a[j][1], a[j][2], a[j][3], inv, 0);
            *(u32x4*)(dst + (size_t)e * 128) = w;
            if (lane == 0) sc[e] = mx * (1.f / 127.f);
        }
    }
}

#define TK_CE(a, b) do { const unsigned _h = max((a), (b)); (b) = min((a), (b)); (a) = _h; } while (0)
#define TK_INS(L, x) do { _Pragma("unroll") for (int _j = 0; _j < 16; ++_j) { const unsigned _h = max(L[_j], x); x = min(L[_j], x); L[_j] = _h; } } while (0)
__device__ __forceinline__ void tk_sort16(unsigned (&x)[16]) { TK_CE(x[0], x[13]); TK_CE(x[1], x[12]); TK_CE(x[2], x[15]); TK_CE(x[3], x[14]); TK_CE(x[4], x[8]); TK_CE(x[5], x[6]); TK_CE(x[7], x[11]); TK_CE(x[9], x[10]); TK_CE(x[0], x[5]); TK_CE(x[1], x[7]); TK_CE(x[2], x[9]); TK_CE(x[3], x[4]); TK_CE(x[6], x[13]); TK_CE(x[8], x[14]); TK_CE(x[10], x[15]); TK_CE(x[11], x[12]); TK_CE(x[0], x[1]); TK_CE(x[2], x[3]); TK_CE(x[4], x[5]); TK_CE(x[6], x[8]); TK_CE(x[7], x[9]); TK_CE(x[10], x[11]); TK_CE(x[12], x[13]); TK_CE(x[14], x[15]); TK_CE(x[0], x[2]); TK_CE(x[1], x[3]); TK_CE(x[4], x[10]); TK_CE(x[5], x[11]); TK_CE(x[6], x[7]); TK_CE(x[8], x[9]); TK_CE(x[12], x[14]); TK_CE(x[13], x[15]); TK_CE(x[1], x[2]); TK_CE(x[3], x[12]); TK_CE(x[4], x[6]); TK_CE(x[5], x[7]); TK_CE(x[8], x[10]); TK_CE(x[9], x[11]); TK_CE(x[13], x[14]); TK_CE(x[1], x[4]); TK_CE(x[2], x[6]); TK_CE(x[5], x[8]); TK_CE(x[7], x[10]); TK_CE(x[9], x[13]); TK_CE(x[11], x[14]); TK_CE(x[2], x[4]); TK_CE(x[3], x[6]); TK_CE(x[9], x[12]); TK_CE(x[11], x[13]); TK_CE(x[3], x[5]); TK_CE(x[6], x[8]); TK_CE(x[7], x[9]); TK_CE(x[10], x[12]); TK_CE(x[3], x[4]); TK_CE(x[5], x[6]); TK_CE(x[7], x[8]); TK_CE(x[9], x[10]); TK_CE(x[11], x[12]); TK_CE(x[6], x[7]); TK_CE(x[8], x[9]); }
__device__ __forceinline__ void tk_merge16(unsigned (&R)[16], const unsigned (&S)[16]) {
#pragma unroll
    for (int i = 0; i < 16; ++i) R[i] = max(R[i], S[15 - i]);
    TK_CE(R[0], R[8]); TK_CE(R[1], R[9]); TK_CE(R[2], R[10]); TK_CE(R[3], R[11]); TK_CE(R[4], R[12]); TK_CE(R[5], R[13]); TK_CE(R[6], R[14]); TK_CE(R[7], R[15]); TK_CE(R[0], R[4]); TK_CE(R[1], R[5]); TK_CE(R[2], R[6]); TK_CE(R[3], R[7]); TK_CE(R[8], R[12]); TK_CE(R[9], R[13]); TK_CE(R[10], R[14]); TK_CE(R[11], R[15]); TK_CE(R[0], R[2]); TK_CE(R[1], R[3]); TK_CE(R[4], R[6]); TK_CE(R[5], R[7]); TK_CE(R[8], R[10]); TK_CE(R[9], R[11]); TK_CE(R[12], R[14]); TK_CE(R[13], R[15]); TK_CE(R[0], R[1]); TK_CE(R[2], R[3]); TK_CE(R[4], R[5]); TK_CE(R[6], R[7]); TK_CE(R[8], R[9]); TK_CE(R[10], R[11]); TK_CE(R[12], R[13]); TK_CE(R[14], R[15]);
}
__device__ __forceinline__ unsigned tk_ckey(float sum, unsigned payload) { const unsigned b = __float_as_uint(sum); const unsigned mono = b ^ ((unsigned)((int)b >> 31) | 0x80000000u); return (mono & 0xFFFFC000u) | payload; }
__device__ __forceinline__ void topk128(const u32x4* r, unsigned (&L)[16]) {
    u32x4 c0 = r[0], c1 = r[64];
    for (int c = 0; c < 8; ++c) {
        const u32x4 n0 = r[64 * ((2 * c + 2) & 15)], n1 = r[64 * ((2 * c + 3) & 15)];
        const unsigned kb = 0xFFFFu - 16u * (unsigned)c; unsigned x[16];
#pragma unroll
        for (int d = 0; d < 4; ++d) {
            unsigned w = c0[d]; unsigned msk = ((w >> 15) & 0x00010001u) * 0xFFFFu; w ^= (msk | 0x80008000u);
            x[2 * d] = (w << 16) | (kb - 2u * d); x[2 * d + 1] = (w & 0xFFFF0000u) | (kb - 2u * d - 1u);
            w = c1[d]; msk = ((w >> 15) & 0x00010001u) * 0xFFFFu; w ^= (msk | 0x80008000u);
            x[8 + 2 * d] = (w << 16) | (kb - 8u - 2u * d); x[8 + 2 * d + 1] = (w & 0xFFFF0000u) | (kb - 8u - 2u * d - 1u);
        }
        tk_sort16(x);
        if (c == 0) {
#pragma unroll
            for (int q = 0; q < 16; ++q) L[q] = x[q];
        } else tk_merge16(L, x);
        c0 = n0; c1 = n1;
    }
}
__device__ __forceinline__ void phase_topk(const Params& P) {
    const int gl = blockIdx.x * NTHR + threadIdx.x, nl = gridDim.x * NTHR;
    const bf16* Sc = (const bf16*)(P.ws + WS_S); int* IDS = (int*)(P.ws + WS_IDS); float* GATES = (float*)(P.ws + WS_GATES);
    for (int item = gl; item < M * 8; item += nl) {
        const u32x4* row = (const u32x4*)Sc + (size_t)((item >> 6) * 32) * 64 + (item & 63);
        unsigned L0[16], L1[16];
        topk128(row, L0); topk128(row + 16 * 64, L1);
        float f0[16], f1[16]; unsigned p0[16], p1[16];
#pragma unroll
        for (int i = 0; i < 16; ++i) {
            f0[i] = __uint_as_float((L0[i] & 0x80000000u) ? (L0[i] & 0x7FFF0000u) : (~L0[i] & 0xFFFF0000u)); p0[i] = (~L0[i] & 0x7Fu) << 7;
            f1[i] = __uint_as_float((L1[i] & 0x80000000u) ? (L1[i] & 0x7FFF0000u) : (~L1[i] & 0xFFFF0000u)); p1[i] = (~L1[i] & 0x7Fu);
        }
        unsigned C[16];
        { unsigned x[16] = {tk_ckey(f0[0] + f1[0], p0[0] | p1[0]), tk_ckey(f0[0] + f1[1], p0[0] | p1[1]), tk_ckey(f0[0] + f1[2], p0[0] | p1[2]), tk_ckey(f0[0] + f1[3], p0[0] | p1[3]), tk_ckey(f0[0] + f1[4], p0[0] | p1[4]), tk_ckey(f0[0] + f1[5], p0[0] | p1[5]), tk_ckey(f0[0] + f1[6], p0[0] | p1[6]), tk_ckey(f0[0] + f1[7], p0[0] | p1[7]), tk_ckey(f0[0] + f1[8], p0[0] | p1[8]), tk_ckey(f0[0] + f1[9], p0[0] | p1[9]), tk_ckey(f0[0] + f1[10], p0[0] | p1[10]), tk_ckey(f0[0] + f1[11], p0[0] | p1[11]), tk_ckey(f0[0] + f1[12], p0[0] | p1[12]), tk_ckey(f0[0] + f1[13], p0[0] | p1[13]), tk_ckey(f0[0] + f1[14], p0[0] | p1[14]), tk_ckey(f0[0] + f1[15], p0[0] | p1[15])};
          tk_sort16(x);
#pragma unroll
          for (int q = 0; q < 16; ++q) C[q] = x[q]; }
        { unsigned x[16] = {tk_ckey(f0[1] + f1[0], p0[1] | p1[0]), tk_ckey(f0[1] + f1[1], p0[1] | p1[1]), tk_ckey(f0[1] + f1[2], p0[1] | p1[2]), tk_ckey(f0[1] + f1[3], p0[1] | p1[3]), tk_ckey(f0[1] + f1[4], p0[1] | p1[4]), tk_ckey(f0[1] + f1[5], p0[1] | p1[5]), tk_ckey(f0[1] + f1[6], p0[1] | p1[6]), tk_ckey(f0[1] + f1[7], p0[1] | p1[7]), tk_ckey(f0[2] + f1[0], p0[2] | p1[0]), tk_ckey(f0[2] + f1[1], p0[2] | p1[1]), tk_ckey(f0[2] + f1[2], p0[2] | p1[2]), tk_ckey(f0[2] + f1[3], p0[2] | p1[3]), tk_ckey(f0[2] + f1[4], p0[2] | p1[4]), tk_ckey(f0[3] + f1[0], p0[3] | p1[0]), tk_ckey(f0[3] + f1[1], p0[3] | p1[1]), tk_ckey(f0[3] + f1[2], p0[3] | p1[2])};
          tk_sort16(x); tk_merge16(C, x); }
        { unsigned x[16] = {tk_ckey(f0[3] + f1[3], p0[3] | p1[3]), tk_ckey(f0[4] + f1[0], p0[4] | p1[0]), tk_ckey(f0[4] + f1[1], p0[4] | p1[1]), tk_ckey(f0[4] + f1[2], p0[4] | p1[2]), tk_ckey(f0[5] + f1[0], p0[5] | p1[0]), tk_ckey(f0[5] + f1[1], p0[5] | p1[1]), tk_ckey(f0[6] + f1[0], p0[6] | p1[0]), tk_ckey(f0[6] + f1[1], p0[6] | p1[1]), tk_ckey(f0[7] + f1[0], p0[7] | p1[0]), tk_ckey(f0[7] + f1[1], p0[7] | p1[1]), tk_ckey(f0[8] + f1[0], p0[8] | p1[0]), tk_ckey(f0[9] + f1[0], p0[9] | p1[0]), tk_ckey(f0[10] + f1[0], p0[10] | p1[0]), tk_ckey(f0[11] + f1[0], p0[11] | p1[0]), tk_ckey(f0[12] + f1[0], p0[12] | p1[0]), tk_ckey(f0[13] + f1[0], p0[13] | p1[0])};
          tk_sort16(x); tk_merge16(C, x); }
        { unsigned key = tk_ckey(f0[14] + f1[0], p0[14] | p1[0]); TK_INS(C, key); }
        { unsigned key = tk_ckey(f0[15] + f1[0], p0[15] | p1[0]); TK_INS(C, key); }
        float cv[16];
#pragma unroll
        for (int r = 0; r < 16; ++r) cv[r] = __uint_as_float((C[r] & 0x80000000u) ? (C[r] & 0x7FFFC000u) : (~C[r] & 0xFFFFC000u));
        const float cmax = cv[0]; float den = 0.f;
#pragma unroll
        for (int r = 0; r < 16; ++r) { cv[r] = __expf(cv[r] - cmax); den += cv[r]; }
        const float inv = 1.f / den;
        const int oi = ((((item >> 9) << 6) | (item & 63)) << 3) | ((item >> 6) & 7);
        u32x4* ido = (u32x4*)(IDS + (size_t)oi * 16); f32x4* go = (f32x4*)(GATES + (size_t)oi * 16);
#pragma unroll
        for (int q = 0; q < 4; ++q) { u32x4 o; o.x = C[4 * q] & 0x3FFFu; o.y = C[4 * q + 1] & 0x3FFFu; o.z = C[4 * q + 2] & 0x3FFFu; o.w = C[4 * q + 3] & 0x3FFFu; ido[q] = o;
            f32x4 g; g[0] = cv[4 * q] * inv; g[1] = cv[4 * q + 1] * inv; g[2] = cv[4 * q + 2] * inv; g[3] = cv[4 * q + 3] * inv; go[q] = g; }
    }
}

#define XB_TMO      128
#define XB_XCNT(j)  (256  + 64 * (j))
#define XB_XSUB(j)  (1280 + 64 * (j))
#define XB_XGEN(j)  (2304 + 64 * (j))
#define XB_TOP      3328
#define XB_TOPGEN   3392
#define XCD_BAR_WORDS 3456
#define XB_SPIN_CAP (1u << 18)
__device__ __forceinline__ unsigned xb_ld(unsigned* p)              { return __hip_atomic_load(p, __ATOMIC_RELAXED, __HIP_MEMORY_SCOPE_AGENT); }
__device__ __forceinline__ unsigned xb_add(unsigned* p, unsigned v) { return __hip_atomic_fetch_add(p, v, __ATOMIC_RELAXED, __HIP_MEMORY_SCOPE_AGENT); }
__device__ __forceinline__ unsigned xb_xcc_id() { return (unsigned)__builtin_amdgcn_s_getreg((3 << 11) | 20) & 0xFu; }
#define XB_SPIN(cond, bar) do { unsigned _sp = 0; while (cond) { __builtin_amdgcn_s_sleep(1); \
    if ((++_sp & 255u) == 0u) { if (xb_ld(&(bar)[XB_TMO])) break; if (_sp > XB_SPIN_CAP) { atomicAdd(&(bar)[XB_TMO], 1u); break; } } } } while (0)
struct XcdBarrier { unsigned* bar; unsigned x; volatile LAS unsigned* st; };
__device__ __forceinline__ XcdBarrier xcd_barrier_post(unsigned* bar, volatile LAS unsigned* st) {
    XcdBarrier b; b.bar = bar; b.x = xb_xcc_id(); b.st = st;
    if (threadIdx.x == 0) { const unsigned r = xb_add(&bar[XB_XCNT(b.x)], 1u); st[4] = r; st[5] = b.x; }
    return b;
}
__device__ __forceinline__ void xcd_barrier_complete(unsigned* bar, unsigned x, unsigned& nloc, unsigned& nx) {
    const unsigned G = gridDim.x * gridDim.y * gridDim.z;
    unsigned sum, cnt, mine, sp = 0u;
    for (;;) {
        sum = 0u; cnt = 0u; mine = 0u;
#pragma unroll
        for (unsigned j = 0; j < 16; ++j) { const unsigned c = xb_ld(&bar[XB_XCNT(j)]); sum += c; cnt += (c > 0u) ? 1u : 0u; mine = (j == x) ? c : mine; }
        if (sum == G) break;
        __builtin_amdgcn_s_sleep(1);
        if ((++sp & 255u) == 0u) { if (xb_ld(&bar[XB_TMO])) break; if (sp > XB_SPIN_CAP) { atomicAdd(&bar[XB_TMO], 1u); break; } }
    }
    nloc = mine > 0u ? mine : 1u; nx = cnt > 0u ? cnt : 1u;
}
__device__ __forceinline__ void xcd_barrier(const XcdBarrier& b) {
    asm volatile("s_waitcnt vmcnt(0)" ::: "memory");
    __syncthreads();
    if (threadIdx.x == 0) {
        unsigned* bar = b.bar;
        __builtin_amdgcn_s_waitcnt(0);
        unsigned nloc = b.st[0], nx = b.st[1];
        if (nloc == 0u) { xcd_barrier_complete(bar, b.x, nloc, nx); b.st[0] = nloc; b.st[1] = nx; }
        const unsigned old = xb_add(&bar[XB_XSUB(b.x)], 1u);
        const unsigned gen = old / nloc;
        if (old + 1u == (gen + 1u) * nloc) {
            __builtin_amdgcn_fence(__ATOMIC_RELEASE, "agent");
            asm volatile("s_waitcnt vmcnt(0)" ::: "memory");
            const unsigned og = xb_add(&bar[XB_TOP], 1u);
            const unsigned tg = og / nx;
            if (og + 1u == (tg + 1u) * nx) xb_add(&bar[XB_TOPGEN], 1u);
            else XB_SPIN(xb_ld(&bar[XB_TOPGEN]) == tg, bar);
            __builtin_amdgcn_fence(__ATOMIC_ACQUIRE, "agent");
            xb_add(&bar[XB_XGEN(b.x)], 1u);
            asm volatile("s_waitcnt vmcnt(0)" ::: "memory");
        } else {
            XB_SPIN(xb_ld(&bar[XB_XGEN(b.x)]) == gen, bar);
            __builtin_amdgcn_fence(__ATOMIC_ACQUIRE, "agent");
            asm volatile("s_waitcnt vmcnt(0)" ::: "memory");
        }
    }
    __syncthreads();
}

typedef int v8i_t __attribute__((ext_vector_type(8)));
#define PD_LO 1
struct PdTok { int idl, idh; unsigned hw; };
__device__ __forceinline__ PdTok pd_fetch(const int* IDS, const unsigned char* H8s, int m, int lane) {
    PdTok t; t.idl = IDS[(size_t)m * 128 + lane]; t.idh = IDS[(size_t)m * 128 + 64 + lane]; t.hw = *(const unsigned*)(H8s + (size_t)m * 2048); return t;
}
__device__ __forceinline__ void pd_issue(u32x4 (&X0)[8], u32x4 (&X1)[8], const PdTok& t, const unsigned char* UFs, LAS unsigned char* slot, int lane) {
#pragma unroll
    for (int g = 0; g < 8; ++g) { const unsigned id = (unsigned)__builtin_amdgcn_ds_bpermute(4 * (16 * (g & 3) + (lane >> 2)), g < 4 ? t.idl : t.idh);
        const u32x4* rp = (const u32x4*)(UFs + ((id << 7) + 16u * (unsigned)(lane & 3))); X0[g] = rp[0]; X1[g] = rp[4]; }
    *(LAS unsigned*)(slot + 4 * lane) = t.hw;
}
__device__ __forceinline__ float pd_trace(const f32x4 v) {
    const float v0 = v[0], v1 = v[1], v2 = v[2], v3 = v[3];
#define PD_BC(x, ctrl) __builtin_bit_cast(float, __builtin_amdgcn_update_dpp(0, __builtin_bit_cast(int, (x)), (ctrl), 0xf, 0xf, true))
    float s = PD_BC(v0, 0x00); s += PD_BC(v1, 0x55); s += PD_BC(v2, 0xAA); s += PD_BC(v3, 0xFF); return s;
#undef PD_BC
}
__device__ __forceinline__ void pd_compute(const u32x4 (&X0)[8], const u32x4 (&X1)[8], const LAS unsigned char* arp, unsigned* PDs, int m, int lane) {
    const int q = lane & 3;
    float dl = 0.f, dh = 0.f;
    const LAS u32x4* hp = (const LAS u32x4*)arp; const u32x4 A0 = hp[0], A1 = hp[4];
#if PD_LO
    const u32x4 A2 = hp[8], A3 = hp[12];
#endif
    const v8i_t ah = {(int)A0.x, (int)A0.y, (int)A0.z, (int)A0.w, (int)A1.x, (int)A1.y, (int)A1.z, (int)A1.w};
#if PD_LO
    const v8i_t al = {(int)A2.x, (int)A2.y, (int)A2.z, (int)A2.w, (int)A3.x, (int)A3.y, (int)A3.z, (int)A3.w};
#endif
    f32x4 acc[8];
#pragma unroll
    for (int g = 0; g < 8; ++g) { const v8i_t b = {(int)X0[g].x, (int)X0[g].y, (int)X0[g].z, (int)X0[g].w, (int)X1[g].x, (int)X1[g].y, (int)X1[g].z, (int)X1[g].w};
        acc[g] = __builtin_amdgcn_mfma_scale_f32_16x16x128_f8f6f4(ah, b, (f32x4){0.f, 0.f, 0.f, 0.f}, 0, 0, 0, 0, 0, 0); }
#if PD_LO
    __builtin_amdgcn_sched_barrier(0);
#pragma unroll
    for (int g = 0; g < 8; ++g) { const v8i_t b = {(int)X0[g].x, (int)X0[g].y, (int)X0[g].z, (int)X0[g].w, (int)X1[g].x, (int)X1[g].y, (int)X1[g].z, (int)X1[g].w};
        acc[g] = __builtin_amdgcn_mfma_scale_f32_16x16x128_f8f6f4(al, b, acc[g], 0, 0, 0, 0, 0, 0); }
#endif
    __builtin_amdgcn_sched_barrier(0);
#pragma unroll
    for (int g = 0; g < 8; ++g) { const float d = pd_trace(acc[g]);
        if (g < 4) dl = (q == g) ? d : dl; else dh = (q == g - 4) ? d : dh; }
    const int srcl = 4 * (4 * (lane & 15) + (lane >> 4));
    dl = __int_as_float(__builtin_amdgcn_ds_bpermute(srcl, __float_as_int(dl))); dh = __int_as_float(__builtin_amdgcn_ds_bpermute(srcl, __float_as_int(dh)));
    PDs[(size_t)m * 64 + lane] = pk2(dl, dh);
}
__device__ __forceinline__ void phase_peer_dots(const Params& P, LAS unsigned char* lds) {
    const int lane = threadIdx.x & 63, wave = __builtin_amdgcn_readfirstlane(threadIdx.x >> 6);
    const int* IDS = (const int*)(P.ws + WS_IDS); unsigned* PD = (unsigned*)(P.ws + WS_PD);
    volatile LAS unsigned* bst = (volatile LAS unsigned*)(lds + LDS_MISC);
    const unsigned rank = __builtin_amdgcn_readfirstlane(bst[4]), x = __builtin_amdgcn_readfirstlane(bst[5]);
    unsigned* bar = (unsigned*)(P.ws + WS_CTL);
    unsigned n = 1, xi = 0, nx = 0;
    for (unsigned j = 0; j < 16; ++j) { const unsigned cnt = __builtin_amdgcn_readfirstlane(xb_ld(&bar[XB_XCNT(j)])); if (cnt) { if (j < x) ++xi; ++nx; } if (j == x) n = cnt; }
    if (nx == 0) nx = 1; if (n == 0) n = 1;
    constexpr int NCW = NWAVES - 1;
    const int stride = (int)n * NCW; const bool arow = ((lane >> 2) & 3) == (lane >> 4);
    LAS unsigned char* slot0 = lds + wave * 512; LAS unsigned char* slot1 = slot0 + 256; LAS unsigned char* zer = lds + NWAVES * 512;
    volatile LAS unsigned* prog = (volatile LAS unsigned*)(zer + 256);
    __syncthreads();
    if (threadIdx.x < 80) ((LAS unsigned*)zer)[threadIdx.x] = 0u;
    __syncthreads();
    if (wave == NCW) {
        constexpr unsigned AHEAD = 600;
        unsigned base = 0;
        for (unsigned s = xi; s < 8; s += nx) {
            const int r7 = (int)rank * NCW; unsigned total = 0;
            for (int w = 0; w < NCW; ++w) { const int m0 = r7 + w; total += (m0 < M) ? (unsigned)((M - m0 + stride - 1) / stride) : 0u; }
            const int tk = lane / 6, ln = lane - 6 * tk;
            for (unsigned done = 0; done < total; ) {
                if (done + base < *prog + AHEAD) {
                    const unsigned char* pa[4];
#pragma unroll
                    for (int k = 0; k < 4; ++k) { unsigned j = done + 10u * k + (unsigned)(tk < 10 ? tk : 9); if (j >= total) j = total - 1;
                        const int i = (int)(j / NCW), w = (int)(j - (unsigned)i * NCW); int m = r7 + w + i * stride; if (m >= M) m = r7;
                        pa[k] = (ln < 4) ? (const unsigned char*)IDS + (size_t)m * 512 + 128 * ln : P.ws + WS_H8 + (size_t)m * 2048 + 128 * s + 1024 * (ln - 4); }
                    unsigned d0, d1, d2, d3;
                    asm volatile("global_load_dword %0, %4, off\n\tglobal_load_dword %1, %5, off\n\tglobal_load_dword %2, %6, off\n\tglobal_load_dword %3, %7, off\n\ts_waitcnt vmcnt(0)"
                                 : "=&v"(d0), "=&v"(d1), "=&v"(d2), "=&v"(d3) : "v"(pa[0]), "v"(pa[1]), "v"(pa[2]), "v"(pa[3]) : "memory");
                    done += 40;
                } else __builtin_amdgcn_s_sleep(4);
            }
            base += total;
        }
        return;
    }
    const LAS unsigned char* ar0 = arow ? slot0 + 16 * (lane & 3) : zer; const LAS unsigned char* ar1 = arow ? slot1 + 16 * (lane & 3) : zer;
    for (unsigned s = xi; s < 8; s += nx) {
        const unsigned char* UFs = P.ws + WS_UF + (size_t)s * UF_SLICE;
        const unsigned char* H8s = P.ws + WS_H8 + 128 * s + (lane < 32 ? 4 * lane : 1024 + 4 * (lane - 32)); unsigned* PDs = PD + (size_t)s * M * 64;
        const int m0 = (int)rank * NCW + wave;
        if (m0 >= M) continue;
        const int cnt = (M - m0 + stride - 1) / stride;
#define PD_TOK(i) ((i) < cnt ? m0 + (i) * stride : m0)
        u32x4 RA4[8], RB4[8], RA2[8], RB2[8];
        PdTok t0 = pd_fetch(IDS, H8s, m0, lane), t1 = pd_fetch(IDS, H8s, PD_TOK(1), lane), t2 = pd_fetch(IDS, H8s, PD_TOK(2), lane);
        pd_issue(RA4, RA2, t0, UFs, slot0, lane);
        for (int i = 0; i < cnt; i += 2) {
            const int ma = PD_TOK(i), mb = PD_TOK(i + 1);
            const PdTok t3 = pd_fetch(IDS, H8s, PD_TOK(i + 3), lane);
            pd_issue(RB4, RB2, t1, UFs, slot1, lane);
            __builtin_amdgcn_sched_barrier(0);
            pd_compute(RA4, RA2, ar0, PDs, ma, lane);
            if (lane == 0) __hip_atomic_fetch_add((LAS unsigned*)prog, 1u, __ATOMIC_RELAXED, __HIP_MEMORY_SCOPE_WORKGROUP);
            __builtin_amdgcn_sched_barrier(0);
            const PdTok t4 = pd_fetch(IDS, H8s, PD_TOK(i + 4), lane);
            pd_issue(RA4, RA2, t2, UFs, slot0, lane);
            __builtin_amdgcn_sched_barrier(0);
            pd_compute(RB4, RB2, ar1, PDs, mb, lane);
            if (lane == 0 && i + 1 < cnt) __hip_atomic_fetch_add((LAS unsigned*)prog, 1u, __ATOMIC_RELAXED, __HIP_MEMORY_SCOPE_WORKGROUP);
            __builtin_amdgcn_sched_barrier(0);
            t1 = t3; t2 = t4;
        }
#undef PD_TOK
    }
}

__device__ __forceinline__ void phase_peer_coef(const Params& P) {
    const int lane = threadIdx.x & 63, wave = threadIdx.x >> 6; const int gw = blockIdx.x * NWAVES + wave, ngw = gridDim.x * NWAVES;
    const int* IDS = (const int*)(P.ws + WS_IDS); const float* GATES = (const float*)(P.ws + WS_GATES); const unsigned* PD = (const unsigned*)(P.ws + WS_PD);
    const float* SU = (const float*)(P.ws + WS_SU); const float* SV = (const float*)(P.ws + WS_SV);
    unsigned char* CQ = P.ws + WS_CQ; float* CS = (float*)(P.ws + WS_CS);
    constexpr int TB = 4;
    for (int mb = gw; mb < M; mb += TB * ngw) {
        int id_lo[TB], id_hi[TB]; float gt_lo[TB], gt_hi[TB], d_lo[TB], d_hi[TB], su_lo[TB], su_hi[TB], sv_lo[TB], sv_hi[TB];
#pragma unroll
        for (int t = 0; t < TB; ++t) { const int m = (mb + t * ngw < M) ? mb + t * ngw : mb;
            id_lo[t] = IDS[(size_t)m * 128 + lane]; id_hi[t] = IDS[(size_t)m * 128 + 64 + lane]; gt_lo[t] = GATES[(size_t)m * 128 + lane]; gt_hi[t] = GATES[(size_t)m * 128 + 64 + lane]; }
#pragma unroll
        for (int t = 0; t < TB; ++t) { const int m = (mb + t * ngw < M) ? mb + t * ngw : mb; float a = 0.f, b = 0.f;
#pragma unroll
            for (int s = 0; s < 8; ++s) { const unsigned w = PD[((size_t)s * M + m) * 64 + lane]; a += __uint_as_float(w << 16); b += __uint_as_float(w & 0xffff0000u); }
            d_lo[t] = a; d_hi[t] = b; }
#pragma unroll
        for (int t = 0; t < TB; ++t) { su_lo[t] = SU[id_lo[t]]; su_hi[t] = SU[id_hi[t]]; sv_lo[t] = SV[id_lo[t]]; sv_hi[t] = SV[id_hi[t]]; }
#pragma unroll
        for (int t = 0; t < TB; ++t) { const int m = (mb + t * ngw < M) ? mb + t * ngw : mb;
            const float x_lo = d_lo[t] * su_lo[t], x_hi = d_hi[t] * su_hi[t];
            const float a_lo = 0.5f * x_lo * (1.f + erff(x_lo * 0.70710678118f)) * gt_lo[t] * sv_lo[t], a_hi = 0.5f * x_hi * (1.f + erff(x_hi * 0.70710678118f)) * gt_hi[t] * sv_hi[t];
            const float amx = wave_max_u(fmaxf(fabsf(a_lo), fabsf(a_hi))); const float ainv = amx > 0.f ? 127.f / amx : 0.f;
            const int q_lo = __float2int_rn(a_lo * ainv), q_hi = __float2int_rn(a_hi * ainv);
            const int j0 = lane, j1 = 64 + lane;
            CQ[(size_t)m * 128 + 16 * ((j0 >> 2) & 7) + 4 * (j0 >> 5) + (j0 & 3)] = (unsigned char)q_lo;
            CQ[(size_t)m * 128 + 16 * ((j1 >> 2) & 7) + 4 * (j1 >> 5) + (j1 & 3)] = (unsigned char)q_hi;
            if (lane == 0) CS[m] = amx * (1.f / 127.f); }
    }
}

struct AxTok { u32x4 id[4]; u32x4 cq; float cs; unsigned hw; };
__device__ __forceinline__ void ax_fetch(AxTok& t, const int* IDS, const unsigned char* CQ, const float* CS, const bf16* H1s, int m, int lane) {
    const u32x4* ip = (const u32x4*)(IDS + (size_t)m * 128) + (lane >> 3);
#pragma unroll
    for (int r = 0; r < 4; ++r) t.id[r] = ip[8 * r];
    t.cq = *((const u32x4*)(CQ + (size_t)m * 128) + (lane >> 3)); t.cs = CS[m]; t.hw = *(const unsigned*)(H1s + (size_t)m * D);
}
__device__ __forceinline__ void ax_issue(u32x4 (&W)[4], const u32x4 ids, const unsigned char* V8s, int lane) {
#pragma unroll
    for (int k = 0; k < 4; ++k) W[k] = *(const u32x4*)(V8s + ((ids[k] << 7) + 16u * (unsigned)(lane & 7)));
}
__device__ __forceinline__ void ax_round(const u32x4 (&W)[4], int c4, int (&acc)[16]) {
#pragma unroll
    for (int i = 0; i < 4; ++i) {
        const unsigned t0 = __builtin_amdgcn_perm(W[1][i], W[0][i], 0x05010400u), t1 = __builtin_amdgcn_perm(W[1][i], W[0][i], 0x07030602u);
        const unsigned t2 = __builtin_amdgcn_perm(W[3][i], W[2][i], 0x05010400u), t3 = __builtin_amdgcn_perm(W[3][i], W[2][i], 0x07030602u);
        const unsigned T0 = __builtin_amdgcn_perm(t2, t0, 0x05040100u), T1 = __builtin_amdgcn_perm(t2, t0, 0x07060302u), T2 = __builtin_amdgcn_perm(t3, t1, 0x05040100u), T3 = __builtin_amdgcn_perm(t3, t1, 0x07060302u);
        acc[4 * i] = __builtin_amdgcn_sdot4((int)T0, c4, acc[4 * i], false); acc[4 * i + 1] = __builtin_amdgcn_sdot4((int)T1, c4, acc[4 * i + 1], false);
        acc[4 * i + 2] = __builtin_amdgcn_sdot4((int)T2, c4, acc[4 * i + 2], false); acc[4 * i + 3] = __builtin_amdgcn_sdot4((int)T3, c4, acc[4 * i + 3], false); }
}
__device__ __forceinline__ void ax_finish(int (&acc)[16], float cs, unsigned hw, bf16* ZPs, int m, int lane) {
    const bool b3 = (lane & 8) != 0, b4 = (lane & 16) != 0, b5 = (lane & 32) != 0;
    int w8[8], w4[4], w2[2];
#pragma unroll
    for (int i = 0; i < 8; ++i) { const int keep = b3 ? acc[i + 8] : acc[i], send = b3 ? acc[i] : acc[i + 8]; w8[i] = keep + DPP_I(send, 0x128); }
#pragma unroll
    for (int i = 0; i < 4; ++i) { const int keep = b4 ? w8[i + 4] : w8[i], send = b4 ? w8[i] : w8[i + 4]; w4[i] = keep + __builtin_amdgcn_ds_swizzle(send, 0x401F); }
#pragma unroll
    for (int i = 0; i < 2; ++i) { const int keep = b5 ? w4[i + 2] : w4[i], send = b5 ? w4[i] : w4[i + 2]; w2[i] = keep + __shfl_xor(send, 32); }
    const float z0 = ALPHA * __uint_as_float(hw << 16) + cs * (float)w2[0], z1 = ALPHA * __uint_as_float(hw & 0xffff0000u) + cs * (float)w2[1];
    const int d0 = 16 * (lane & 7) + (b3 ? 8 : 0) + (b4 ? 4 : 0) + (b5 ? 2 : 0);
    *(unsigned*)(ZPs + (size_t)m * D + d0) = pk2(z0, z1);
}
__device__ __forceinline__ void phase_peer_axpy(const Params& P, LAS unsigned char* lds) {
    const int lane = threadIdx.x & 63, wave = __builtin_amdgcn_readfirstlane(threadIdx.x >> 6);
    const int* IDS = (const int*)(P.ws + WS_IDS); const unsigned char* CQ = P.ws + WS_CQ; const float* CS = (const float*)(P.ws + WS_CS);
    volatile LAS unsigned* bst = (volatile LAS unsigned*)(lds + LDS_MISC);
    const unsigned rank = __builtin_amdgcn_readfirstlane(bst[4]), x = __builtin_amdgcn_readfirstlane(bst[5]);
    unsigned* bar = (unsigned*)(P.ws + WS_CTL);
    unsigned n = 1, xi = 0, nx = 0;
    for (unsigned j = 0; j < 16; ++j) { const unsigned cnt = __builtin_amdgcn_readfirstlane(xb_ld(&bar[XB_XCNT(j)])); if (cnt) { if (j < x) ++xi; ++nx; } if (j == x) n = cnt; }
    if (nx == 0) nx = 1; if (n == 0) n = 1;
    constexpr int NCW = NWAVES - 1;
    const int stride = (int)n * NCW;
    volatile LAS unsigned* prog = (volatile LAS unsigned*)lds;
    __syncthreads();
    if (threadIdx.x == 0) *prog = 0u;
    __syncthreads();
    if (wave == NCW) {
        constexpr unsigned AHEAD = 600;
        unsigned base = 0;
        for (unsigned s = xi; s < 8; s += nx) {
            const int r7 = (int)rank * NCW; unsigned total = 0;
            for (int w = 0; w < NCW; ++w) { const int m0 = r7 + w; total += (m0 < M) ? (unsigned)((M - m0 + stride - 1) / stride) : 0u; }
            const int tk = lane >> 3, ln = lane & 7;
            for (unsigned done = 0; done < total; ) {
                if (done + base < *prog + AHEAD) {
                    const unsigned char* pa[4];
#pragma unroll
                    for (int k = 0; k < 4; ++k) { unsigned j = done + 8u * k + (unsigned)tk; if (j >= total) j = total - 1;
                        const int i = (int)(j / NCW), w = (int)(j - (unsigned)i * NCW); int m = r7 + w + i * stride; if (m >= M) m = r7;
                        pa[k] = (ln < 4) ? (const unsigned char*)IDS + (size_t)m * 512 + 128 * ln : (ln == 4) ? CQ + (size_t)m * 128 : (ln < 7) ? P.ws + WS_H1 + (size_t)m * 2048 + 256 * s + 128 * (ln - 5) : (const unsigned char*)(CS + m); }
                    unsigned d0, d1, d2, d3;
                    asm volatile("global_load_dword %0, %4, off\n\tglobal_load_dword %1, %5, off\n\tglobal_load_dword %2, %6, off\n\tglobal_load_dword %3, %7, off\n\ts_waitcnt vmcnt(0)"
                                 : "=&v"(d0), "=&v"(d1), "=&v"(d2), "=&v"(d3) : "v"(pa[0]), "v"(pa[1]), "v"(pa[2]), "v"(pa[3]) : "memory");
                    done += 32;
                } else __builtin_amdgcn_s_sleep(4);
            }
            base += total;
        }
        return;
    }
    const int dsel = 16 * (lane & 7) + ((lane & 8) ? 8 : 0) + ((lane & 16) ? 4 : 0) + ((lane & 32) ? 2 : 0);
    for (unsigned s = xi; s < 8; s += nx) {
        const unsigned char* V8s = P.ws + WS_V8 + (size_t)s * V8_SLICE;
        const bf16* H1s = (const bf16*)(P.ws + WS_H1) + 128 * s + dsel; bf16* ZPs = (bf16*)(P.ws + WS_ZP) + 128 * s;
        const int m0 = (int)rank * NCW + wave;
        if (m0 >= M) continue;
        const int cnt = (M - m0 + stride - 1) / stride;
#define AX_TOK(i) ((i) < cnt ? m0 + (i) * stride : m0)
        u32x4 W0[4], W1[4], W2[4], W3[4];
        AxTok ta, tb, tc; ax_fetch(ta, IDS, CQ, CS, H1s, m0, lane); ax_fetch(tb, IDS, CQ, CS, H1s, AX_TOK(1), lane);
        ax_issue(W0, ta.id[0], V8s, lane); ax_issue(W1, ta.id[1], V8s, lane); ax_issue(W2, ta.id[2], V8s, lane);
#define AX_STEP(CUR, NXT, FRE, ii) do { \
            const int ma_ = AX_TOK(ii); \
            ax_fetch(FRE, IDS, CQ, CS, H1s, AX_TOK((ii) + 2), lane); \
            int acc[16]; \
            _Pragma("unroll") for (int j = 0; j < 16; ++j) acc[j] = 0; \
            ax_issue(W3, CUR.id[3], V8s, lane); __builtin_amdgcn_sched_barrier(0); ax_round(W0, (int)CUR.cq[0], acc); __builtin_amdgcn_sched_barrier(0); \
            ax_issue(W0, NXT.id[0], V8s, lane); __builtin_amdgcn_sched_barrier(0); ax_round(W1, (int)CUR.cq[1], acc); __builtin_amdgcn_sched_barrier(0); \
            ax_issue(W1, NXT.id[1], V8s, lane); __builtin_amdgcn_sched_barrier(0); ax_round(W2, (int)CUR.cq[2], acc); __builtin_amdgcn_sched_barrier(0); \
            ax_issue(W2, NXT.id[2], V8s, lane); __builtin_amdgcn_sched_barrier(0); ax_round(W3, (int)CUR.cq[3], acc); __builtin_amdgcn_sched_barrier(0); \
            ax_finish(acc, CUR.cs, CUR.hw, ZPs, ma_, lane); \
            if (lane == 0 && (ii) < cnt) __hip_atomic_fetch_add((LAS unsigned*)prog, 1u, __ATOMIC_RELAXED, __HIP_MEMORY_SCOPE_WORKGROUP); } while (0)
        for (int i = 0; i < cnt; i += 3) { AX_STEP(ta, tb, tc, i); AX_STEP(tb, tc, ta, i + 1); AX_STEP(tc, ta, tb, i + 2); }
#undef AX_STEP
#undef AX_TOK
    }
}

__device__ __forceinline__ void phase_ln2(const Params& P) {
    const int lane = threadIdx.x & 63, wave = threadIdx.x >> 6; const int gw = blockIdx.x * NWAVES + wave, ngw = gridDim.x * NWAVES;
    const float* g2 = P.in[26]; const float* b2 = P.in[27]; const bf16* ZP = (const bf16*)(P.ws + WS_ZP);
    for (int m = gw; m < M; m += ngw) {
        const u32x4* xr = (const u32x4*)(ZP + (size_t)m * D) + 2 * lane; const u32x4 a = xr[0], c = xr[1]; float v[16]; float s = 0.f;
#pragma unroll
        for (int i = 0; i < 4; ++i) { v[2 * i] = __uint_as_float(a[i] << 16); v[2 * i + 1] = __uint_as_float(a[i] & 0xffff0000u); v[8 + 2 * i] = __uint_as_float(c[i] << 16); v[8 + 2 * i + 1] = __uint_as_float(c[i] & 0xffff0000u); }
#pragma unroll
        for (int i = 0; i < 16; ++i) s += v[i];
        const float mean = wave_sum(s) * (1.f / D); float s2 = 0.f;
#pragma unroll
        for (int i = 0; i < 16; ++i) { v[i] -= mean; s2 += v[i] * v[i]; }
        const float rstd = 1.f / sqrtf(wave_sum(s2) * (1.f / D) + LN_EPS);
#pragma unroll
        for (int c4 = 0; c4 < 4; ++c4) { const int e0 = 16 * lane + 4 * c4; const f32x4 gg = *(const f32x4*)(g2 + e0), bb = *(const f32x4*)(b2 + e0); f32x4 o;
#pragma unroll
            for (int j = 0; j < 4; ++j) o[j] = v[c4 * 4 + j] * rstd * gg[j] + bb[j];
            *(f32x4*)(P.out + (size_t)m * D + e0) = o; }
    }
}

constexpr int N_PHASES = 14;
__global__ void __launch_bounds__(NTHR, 2) fwd_kernel(Params P) {
    extern __shared__ __attribute__((aligned(16))) unsigned char lds_raw[];
    LAS unsigned char* lds = (LAS unsigned char*)lds_raw;
    cg::grid_group grid = cg::this_grid();
    const int lo = P.ph_lo, hi = P.ph_hi;
    unsigned char* ws = P.ws;
    volatile LAS unsigned* bst = (volatile LAS unsigned*)(lds + LDS_MISC);
    if (threadIdx.x < 16) bst[threadIdx.x] = 0u;
    __syncthreads();
    const XcdBarrier bar = xcd_barrier_post((unsigned*)(ws + WS_CTL), bst);
#define IN(k) (lo <= (k) && (k) < hi)
#define SEAM(k) do { if (IN(k) && IN((k) + 1)) { if ((k) == 0) grid.sync(); else xcd_barrier(bar); } } while (0)
    if (IN(0)) phase_prologue(P, lds);
    SEAM(0);
    if (IN(1)) {
        pg8::Gemm g{(const bf16*)(ws + WS_H0), (const bf16*)(ws + WS_WIN), M, NP, D, D, D, 0}; pg8::StaticOrder S; S.init(M, NP, gridDim.x, blockIdx.x);
        pg8::EpiBf16 E{(bf16*)(ws + WS_P), NP};
        pg8::gemm_phase<pg8::EpiBf16, pg8::StaticOrder, true, true>(lds, g, S, E);
    }
    SEAM(1);
    if (IN(2)) phase_prep(P, lds);
    SEAM(2);
    if (IN(3)) phase_scan(P, lds);
    SEAM(3);
    if (IN(4)) phase_fixup(P, lds);
    SEAM(4);
    if (IN(5)) phase_correct(P, lds);
    SEAM(5);
    if (IN(6)) {
        pg8::Gemm g{(const bf16*)P.out, (const bf16*)(ws + WS_WOUT), M, D, D, D, D, 0}; pg8::StaticOrder S; S.init(M, D, gridDim.x, blockIdx.x);
        pg8::EpiResBf16 E{(bf16*)(ws + WS_Z), (const bf16*)(ws + WS_H0), D, ALPHA};
        pg8::gemm_phase<pg8::EpiResBf16, pg8::StaticOrder, true, true>(lds, g, S, E);
    }
    SEAM(6);
    if (IN(7)) phase_ln1(P);
    SEAM(7);
    if (IN(8)) {
        pg8::Gemm g{(const bf16*)(ws + WS_H1), (const bf16*)(ws + WS_WQ), M, NQ, D, D, D, 0}; pg8::StaticOrder S; S.init(M, NQ, gridDim.x, blockIdx.x);
        pg8::EpiScores E{(bf16*)(ws + WS_S)};
        pg8::gemm_phase<pg8::EpiScores, pg8::StaticOrder, true, true>(lds, g, S, E);
    }
    SEAM(8);
    if (IN(9)) phase_topk(P);
    SEAM(9);
    if (IN(10)) phase_peer_dots(P, lds);
    SEAM(10);
    if (IN(11)) phase_peer_coef(P);
    SEAM(11);
    if (IN(12)) phase_peer_axpy(P, lds);
    SEAM(12);
    if (IN(13)) phase_ln2(P);
#undef IN
#undef SEAM
}

extern "C" void kernel_launch(void* const* d_in, const int* in_sizes, int n_in, void* d_out, int out_size, void* d_ws, size_t ws_size, hipStream_t stream) {
    static int grid = 0;
    if (grid == 0) {
        if (n_in != 28 || out_size != M * D || ws_size < WS_END) { fprintf(stderr, "kernel_launch: unexpected shapes (n_in %d out %d ws %zu)\n", n_in, out_size, ws_size); grid = -1; return; }
        int dev = 0, cus = 0, per_cu = 0;
        (void)hipGetDevice(&dev); (void)hipDeviceGetAttribute(&cus, hipDeviceAttributeMultiprocessorCount, dev);
        (void)hipFuncSetAttribute((const void*)fwd_kernel, hipFuncAttributeMaxDynamicSharedMemorySize, LDS_BYTES);
        (void)hipOccupancyMaxActiveBlocksPerMultiprocessor(&per_cu, (const void*)fwd_kernel, NTHR, LDS_BYTES);
        if (per_cu < 1) { fprintf(stderr, "kernel_launch: occupancy query says %d blocks per CU\n", per_cu); per_cu = 1; }
        (void)hipGetLastError();
        grid = cus;
    }
    if (grid < 0) return;
    Params p{};
    for (int i = 0; i < 28; ++i) p.in[i] = (const float*)d_in[i];
    p.out = (float*)d_out; p.ws = (unsigned char*)d_ws;
    (void)hipMemsetAsync((char*)d_ws + WS_CTL, 0, CTL_BYTES, stream);
    p.ph_lo = 0; p.ph_hi = N_PHASES;
    void* args[] = {&p};
    hipError_t e = hipLaunchCooperativeKernel((const void*)fwd_kernel, dim3(grid), dim3(NTHR), args, LDS_BYTES, stream);
    if (e != hipSuccess) fprintf(stderr, "cooperative launch failed: %s (grid %d)\n", hipGetErrorString(e), grid);
}
```

```cpp
#include <hip/hip_runtime.h>
#include <hip/hip_cooperative_groups.h>
#include <cstdio>
#include <cstdint>
namespace cg = cooperative_groups;

namespace pg8 {
#define PG8_LAS __attribute__((address_space(3)))
typedef unsigned short bf16_t;
typedef short bf16x8 __attribute__((ext_vector_type(8)));
typedef float f32x4 __attribute__((ext_vector_type(4)));
typedef float f32x2 __attribute__((ext_vector_type(2)));
typedef unsigned u32x4 __attribute__((ext_vector_type(4)));
typedef unsigned u32x2 __attribute__((ext_vector_type(2)));
constexpr int BM = 256, BK = 64, HALF = 128, HTB = HALF * BK * 2, STAGE_BYTES = 8 * HTB, NXCD = 8, WGM = 8;

__host__ __device__ __forceinline__ int lds_byte(int r, int c) { const int st = (r >> 4) * 2 + (c >> 5), rr = r & 15, cc = c & 31, ob = rr * 64 + cc * 2; return st * 1024 + (ob ^ (((ob >> 9) & 1) << 5)); }
__host__ __device__ __forceinline__ void stage_rc(int b, int& R, int& C) { const int st = b / 1024, sb = b % 1024, swz = sb ^ (((sb >> 9) & 1) << 5); R = (st >> 1) * 16 + swz / 64; C = (st & 1) * 32 + (swz % 64) / 2; }
__host__ __device__ __forceinline__ int perm32(int rho) { const int n = rho >> 4, i = rho & 15; return 8 * (i >> 2) + 4 * n + (i & 3); }

struct Unit { int pm, pn; };
struct Gemm { const bf16_t* A; const bf16_t* Bt; int M, N, K, lda, ldb, a_pn_koff; };

struct StaticOrder {
    int nM, nN, nwg, G, c;
    __host__ __device__ void init(int M, int N, int G_, int c_) { nM = M / BM; nN = N / BM; nwg = nM * nN; G = G_; c = c_; }
    __host__ __device__ bool next(int i, Unit& u) const {
        const long L = (long)i * G + c; if (L >= nwg) return false;
        int wgid = (int)L; { const int q = nwg / NXCD, r = nwg % NXCD, xcd = wgid % NXCD, off = wgid / NXCD; wgid = (xcd < r ? xcd * (q + 1) : r * (q + 1) + (xcd - r) * q) + off; }
        const int nig = WGM * nN, gid = wgid / nig, fm = gid * WGM, gsz = (nM - fm) < WGM ? (nM - fm) : WGM;
        u.pm = fm + ((wgid % nig) % gsz); u.pn = (wgid % nig) / gsz; return true;
    }
    __device__ __forceinline__ void a_ready(const Unit&) const {}
    __device__ __forceinline__ void done(const Unit&) const {}
};

typedef float f32x2p_t __attribute__((ext_vector_type(2))); typedef __bf16 bf16x2p_t __attribute__((ext_vector_type(2)));
__device__ __forceinline__ unsigned cvt_pk_bf16(float lo, float hi) { const f32x2p_t v = {lo, hi}; const bf16x2p_t b = __builtin_convertvector(v, bf16x2p_t); return __builtin_bit_cast(unsigned, b); }

struct EpiScores {
    static constexpr bool PERM = true;
    bf16_t* O;
    __device__ __forceinline__ void operator()(const f32x4 (&acc)[2][2][4][2], const Unit& u, int wr, int wc, int fr, int fq) const {
        const int row0 = u.pm * BM + wr * 64 + fr;
#pragma unroll
        for (int ai = 0; ai < 2; ++ai)
#pragma unroll
            for (int m = 0; m < 4; ++m) { const int row = row0 + ai * HALF + m * 16;
                bf16_t* tp = O + ((size_t)((row >> 6) * (2048 / BM) + u.pn) * 32 * 64 + (row & 63)) * 8;
#pragma unroll
                for (int bj = 0; bj < 2; ++bj) { const f32x4 v0 = acc[ai][bj][m][0], v1 = acc[ai][bj][m][1];
                    u32x4 w; w.x = cvt_pk_bf16(v0[0], v0[1]); w.y = cvt_pk_bf16(v0[2], v0[3]); w.z = cvt_pk_bf16(v1[0], v1[1]); w.w = cvt_pk_bf16(v1[2], v1[3]);
                    *(u32x4*)(tp + (size_t)(4 * wc + fq + 16 * bj) * 64 * 8) = w; } }
    }
};
struct EpiBf16 {
    static constexpr bool PERM = true;
    bf16_t* O; int ldc;
    __device__ __forceinline__ void operator()(const f32x4 (&acc)[2][2][4][2], const Unit& u, int wr, int wc, int fr, int fq) const {
        const int row0 = u.pm * BM + wr * 64 + fr; const int col0 = u.pn * BM + wc * 32 + 8 * fq;
#pragma unroll
        for (int ai = 0; ai < 2; ++ai)
#pragma unroll
            for (int m = 0; m < 4; ++m) { bf16_t* rowp = O + (size_t)(row0 + ai * HALF + m * 16) * ldc + col0;
#pragma unroll
                for (int bj = 0; bj < 2; ++bj) { const f32x4 v0 = acc[ai][bj][m][0], v1 = acc[ai][bj][m][1];
                    u32x4 w; w.x = cvt_pk_bf16(v0[0], v0[1]); w.y = cvt_pk_bf16(v0[2], v0[3]); w.z = cvt_pk_bf16(v1[0], v1[1]); w.w = cvt_pk_bf16(v1[2], v1[3]);
                    *(u32x4*)(rowp + bj * HALF) = w; } }
    }
};
struct EpiResBf16 {
    static constexpr bool PERM = true;
    bf16_t* Z; const bf16_t* R; int ldc; float alpha;
    __device__ __forceinline__ void operator()(const f32x4 (&acc)[2][2][4][2], const Unit& u, int wr, int wc, int fr, int fq) const {
        const int row0 = u.pm * BM + wr * 64 + fr; const int col0 = u.pn * BM + wc * 32 + 8 * fq;
#pragma unroll
        for (int ai = 0; ai < 2; ++ai)
#pragma unroll
            for (int m = 0; m < 4; ++m) { const size_t off = (size_t)(row0 + ai * HALF + m * 16) * ldc + col0;
#pragma unroll
                for (int bj = 0; bj < 2; ++bj) { const u32x4 rb = *(const u32x4*)(R + off + bj * HALF); const f32x4 v0 = acc[ai][bj][m][0], v1 = acc[ai][bj][m][1];
                    u32x4 w;
                    w.x = cvt_pk_bf16(__uint_as_float(rb.x << 16) * alpha + v0[0], __uint_as_float(rb.x & 0xffff0000u) * alpha + v0[1]);
                    w.y = cvt_pk_bf16(__uint_as_float(rb.y << 16) * alpha + v0[2], __uint_as_float(rb.y & 0xffff0000u) * alpha + v0[3]);
                    w.z = cvt_pk_bf16(__uint_as_float(rb.z << 16) * alpha + v1[0], __uint_as_float(rb.z & 0xffff0000u) * alpha + v1[1]);
                    w.w = cvt_pk_bf16(__uint_as_float(rb.w << 16) * alpha + v1[2], __uint_as_float(rb.w & 0xffff0000u) * alpha + v1[3]);
                    *(u32x4*)(Z + off + bj * HALF) = w; } }
    }
};
template <class Epi, class Sched, bool ALIGN_EPI = false, bool SP2 = false>
__device__ __forceinline__ void gemm_phase(PG8_LAS unsigned char* lds, const Gemm g, const Sched& S, const Epi& E) {
    const int tid = threadIdx.x, wid = __builtin_amdgcn_readfirstlane(tid >> 6), lane = tid & 63, wr = wid >> 2, wc = wid & 3, fr = lane & 15, fq = lane >> 4;
    const int K = g.K, nt = K / BK;
    unsigned voffA[2], voffB[2];
#pragma unroll
    for (int i = 0; i < 2; ++i) { int R, C; stage_rc(tid * 16 + i * 8192, R, C); const int Rb = Epi::PERM ? ((R & ~31) + perm32(R & 31)) : R;
        voffA[i] = (unsigned)(R * g.lda + C) * 2u; voffB[i] = (unsigned)(Rb * g.ldb + C) * 2u; }
    const size_t kstep = (size_t)(BK * 2);
    const size_t hstepA = (size_t)HALF * g.lda * 2, hstepB = (size_t)HALF * g.ldb * 2;
    const size_t tstepA = 2 * hstepA, tstepB = 2 * hstepB;
    const size_t pnA = (size_t)g.a_pn_koff * 2;
    const unsigned ldsw = (unsigned)wid * 1024u;
    const int aoff = lds_byte(wr * 64 + fr, fq * 8), boff = lds_byte(wc * 32 + fr, fq * 8);
#define PG8_SA(b, h) (((b) * 2 + (h)) * HTB)
#define PG8_SB(b, h) ((4 + (b) * 2 + (h)) * HTB)
#define PG8_STAGE(bufoff, gbase, voff) do { _Pragma("unroll") for (int _i = 0; _i < 2; ++_i) \
        __builtin_amdgcn_global_load_lds((const unsigned*)((const char*)(gbase) + (voff)[_i]), (PG8_LAS unsigned*)(lds + (bufoff) + ldsw + _i * 8192), 16, 0, 0); } while (0)
#define PG8_LDA(dst, b, h) do { _Pragma("unroll") for (int m = 0; m < 4; ++m) _Pragma("unroll") for (int k = 0; k < 2; ++k) dst[m][k] = *(const PG8_LAS bf16x8*)(lds + PG8_SA(b, h) + aoff + m * 2048 + k * 1024); } while (0)
#define PG8_LDB(dst, b, h) do { _Pragma("unroll") for (int n = 0; n < 2; ++n) _Pragma("unroll") for (int k = 0; k < 2; ++k) dst[n][k] = *(const PG8_LAS bf16x8*)(lds + PG8_SB(b, h) + boff + n * 2048 + k * 1024); } while (0)
#define PG8_MMA(ai, bj, At, Bt) do { __builtin_amdgcn_s_setprio(1); _Pragma("unroll") for (int m = 0; m < 4; ++m) _Pragma("unroll") for (int n = 0; n < 2; ++n) _Pragma("unroll") for (int k = 0; k < 2; ++k) \
        acc[ai][bj][m][n] = __builtin_amdgcn_mfma_f32_16x16x32_bf16(Bt[n][k], At[m][k], acc[ai][bj][m][n], 0, 0, 0); __builtin_amdgcn_s_setprio(0); } while (0)
#define PG8_WAIT_V(n) asm volatile("s_waitcnt vmcnt(" #n ")" ::: "memory")
#define PG8_WAIT_L(n) asm volatile("s_waitcnt lgkmcnt(" #n ")" ::: "memory")
#define PG8_BAR __builtin_amdgcn_s_barrier()
#define PG8_SCHED __builtin_amdgcn_sched_barrier(0)
    Unit cur, nxt; int ui = 0;
    if (!S.next(0, cur)) return;
    f32x4 acc[2][2][4][2];
#pragma unroll
    for (int a = 0; a < 2; ++a)
#pragma unroll
        for (int b = 0; b < 2; ++b)
#pragma unroll
            for (int m = 0; m < 4; ++m)
#pragma unroll
                for (int n = 0; n < 2; ++n) acc[a][b][m][n] = (f32x4){0.f, 0.f, 0.f, 0.f};
    bf16x8 At[4][2], B0[2][2], B1[2][2];
    const char* cA = (const char*)g.A + (size_t)cur.pm * tstepA + (size_t)cur.pn * pnA; const char* cB = (const char*)g.Bt + (size_t)cur.pn * tstepB;
    S.a_ready(cur);
    if constexpr (SP2) {
        PG8_STAGE(PG8_SB(0, 0), cB, voffB); PG8_STAGE(PG8_SB(0, 1), cB + hstepB, voffB); PG8_STAGE(PG8_SA(0, 0), cA, voffA); PG8_STAGE(PG8_SA(0, 1), cA + hstepA, voffA);
        if (wr == 1) PG8_BAR;
        PG8_WAIT_V(2); PG8_BAR;
        PG8_STAGE(PG8_SB(1, 0), cB + kstep, voffB); PG8_STAGE(PG8_SA(1, 0), cA + kstep, voffA); PG8_STAGE(PG8_SB(1, 1), cB + hstepB + kstep, voffB);
        PG8_WAIT_V(6); PG8_BAR;
    } else {
        PG8_STAGE(PG8_SB(0, 0), cB, voffB); PG8_STAGE(PG8_SA(0, 0), cA, voffA); PG8_STAGE(PG8_SB(0, 1), cB + hstepB, voffB); PG8_STAGE(PG8_SA(0, 1), cA + hstepA, voffA);
        if (wr == 1) PG8_BAR;
        PG8_WAIT_V(4); PG8_BAR;
        PG8_STAGE(PG8_SB(1, 0), cB + kstep, voffB); PG8_STAGE(PG8_SA(1, 0), cA + kstep, voffA); PG8_STAGE(PG8_SB(1, 1), cB + hstepB + kstep, voffB);
        PG8_WAIT_V(6); PG8_BAR;
    }
    for (;;) {
        const bool has_next = S.next(ui + 1, nxt);
        const char* nA = has_next ? (const char*)g.A + (size_t)nxt.pm * tstepA + (size_t)nxt.pn * pnA : cA; const char* nB = has_next ? (const char*)g.Bt + (size_t)nxt.pn * tstepB : cB;
        for (int t = 0; t < nt; t += 2) {
            const bool last = (t == nt - 2);
            const char* a1 = cA + (size_t)(t + 1) * kstep;
            const char* a2 = last ? nA : cA + (size_t)(t + 2) * kstep; const char* b2 = last ? nB : cB + (size_t)(t + 2) * kstep;
            const char* a3 = a2 + kstep; const char* b3 = b2 + kstep;
            if (last && has_next) S.a_ready(nxt);
            if constexpr (SP2) {
            PG8_LDB(B0, 0, 0); PG8_LDB(B1, 0, 1); PG8_SCHED; PG8_LDA(At, 0, 0); PG8_STAGE(PG8_SA(1, 1), a1 + hstepA, voffA);
            PG8_WAIT_V(8); PG8_WAIT_L(0); PG8_BAR; PG8_MMA(0, 0, At, B0); PG8_MMA(0, 1, At, B1); PG8_BAR; PG8_SCHED;
            PG8_LDA(At, 0, 1); PG8_STAGE(PG8_SB(0, 0), b2, voffB); PG8_STAGE(PG8_SB(0, 1), b2 + hstepB, voffB); PG8_STAGE(PG8_SA(0, 0), a2, voffA);
            PG8_WAIT_V(8); PG8_WAIT_L(0); PG8_BAR; PG8_MMA(1, 0, At, B0); PG8_MMA(1, 1, At, B1); PG8_BAR; PG8_SCHED;
            PG8_LDB(B0, 1, 0); PG8_LDB(B1, 1, 1); PG8_SCHED; PG8_LDA(At, 1, 0); PG8_STAGE(PG8_SA(0, 1), a2 + hstepA, voffA);
            PG8_WAIT_V(8); PG8_WAIT_L(0); PG8_BAR; PG8_MMA(0, 0, At, B0); PG8_MMA(0, 1, At, B1); PG8_BAR; PG8_SCHED;
            PG8_LDA(At, 1, 1); PG8_STAGE(PG8_SB(1, 0), b3, voffB); PG8_STAGE(PG8_SB(1, 1), b3 + hstepB, voffB); PG8_STAGE(PG8_SA(1, 0), a3, voffA);
            PG8_WAIT_V(8); PG8_WAIT_L(0); PG8_BAR; PG8_MMA(1, 0, At, B0); PG8_MMA(1, 1, At, B1); PG8_BAR; PG8_SCHED;
            } else {
            PG8_LDB(B0, 0, 0); PG8_SCHED; PG8_LDA(At, 0, 0); PG8_STAGE(PG8_SA(1, 1), a1 + hstepA, voffA);
            PG8_WAIT_L(8); PG8_BAR; PG8_WAIT_L(0); PG8_MMA(0, 0, At, B0); PG8_BAR; PG8_SCHED;
            PG8_LDB(B1, 0, 1); PG8_STAGE(PG8_SB(0, 0), b2, voffB);
            PG8_BAR; PG8_WAIT_L(0); PG8_MMA(0, 1, At, B1); PG8_BAR;
            PG8_LDA(At, 0, 1); PG8_STAGE(PG8_SA(0, 0), a2, voffA);
            PG8_BAR; PG8_WAIT_L(0); PG8_MMA(1, 0, At, B0); PG8_BAR; PG8_SCHED;
            PG8_STAGE(PG8_SB(0, 1), b2 + hstepB, voffB);
            PG8_WAIT_V(6); PG8_BAR; PG8_MMA(1, 1, At, B1); PG8_BAR;
            PG8_LDB(B0, 1, 0); PG8_SCHED; PG8_LDA(At, 1, 0); PG8_STAGE(PG8_SA(0, 1), a2 + hstepA, voffA);
            PG8_WAIT_L(8); PG8_BAR; PG8_WAIT_L(0); PG8_MMA(0, 0, At, B0); PG8_BAR; PG8_SCHED;
            PG8_LDB(B1, 1, 1); PG8_STAGE(PG8_SB(1, 0), b3, voffB);
            PG8_BAR; PG8_WAIT_L(0); PG8_MMA(0, 1, At, B1); PG8_BAR;
            PG8_LDA(At, 1, 1); PG8_STAGE(PG8_SA(1, 0), a3, voffA);
            PG8_BAR; PG8_WAIT_L(0); PG8_MMA(1, 0, At, B0); PG8_BAR; PG8_SCHED;
            PG8_STAGE(PG8_SB(1, 1), b3 + hstepB, voffB);
            PG8_WAIT_V(6); PG8_BAR; PG8_MMA(1, 1, At, B1); PG8_BAR;
            }
        }
        if constexpr (ALIGN_EPI) { if (wr == 0) PG8_BAR; }
        E(acc, cur, wr, wc, fr, fq); S.done(cur);
        if (!has_next) break;
#pragma unroll
        for (int a = 0; a < 2; ++a)
#pragma unroll
            for (int b = 0; b < 2; ++b)
#pragma unroll
                for (int m = 0; m < 4; ++m)
#pragma unroll
                    for (int n = 0; n < 2; ++n) acc[a][b][m][n] = (f32x4){0.f, 0.f, 0.f, 0.f};
        cur = nxt; cA = nA; cB = nB; ++ui;
        if constexpr (ALIGN_EPI) { if (wr == 1) PG8_BAR; }
    }
    PG8_WAIT_V(0);
    if constexpr (!ALIGN_EPI) { if (wr == 0) PG8_BAR; }
    PG8_BAR;
#undef PG8_SA
#undef PG8_SB
#undef PG8_STAGE
#undef PG8_LDA
#undef PG8_LDB
#undef PG8_MMA
#undef PG8_WAIT_V
#undef PG8_WAIT_L
#undef PG8_BAR
#undef PG8_SCHED
}
}

constexpr int NWAVES = 8, NTHR = NWAVES * 64;
constexpr int D = 1024, NBATCH = 4, T = 8192, M = NBATCH * T;
constexpr int A_W = 512, A_IN = 1792, IN_COLS = 3344, NP = 3584;
constexpr int C_R = 0, C_K = 512, C_V = 1024, C_WD = 1536, C_AD = 1600, C_GD = 1664;
constexpr int C_BQ = 1792, C_BK = 2048, C_BV = 2304, C_GKD = 2816, C_BG = 2832;
constexpr int NQ = 2048;
constexpr float LN_EPS = 1e-5f, GN_EPS = 64e-5f, RMS_EPS = 1e-5f;
constexpr float ALPHA = 1.189207115002721f;

typedef unsigned short bf16;
typedef float f32x4 __attribute__((ext_vector_type(4)));
typedef float f32x2 __attribute__((ext_vector_type(2)));
typedef unsigned u32x4 __attribute__((ext_vector_type(4)));
typedef unsigned u32x2 __attribute__((ext_vector_type(2)));
#define LAS __attribute__((address_space(3)))

constexpr size_t MiB = 1u << 20;
constexpr size_t WS_WIN = 1 * MiB, WS_WOUT = 8 * MiB, WS_WQ = 10 * MiB, WS_KBD = 14 * MiB;
constexpr size_t WS_W2T = 15 * MiB, WS_A2T = WS_W2T + 65536, WS_G2T = WS_A2T + 65536;
constexpr size_t WS_H0 = 16 * MiB;
constexpr size_t WS_P = 80 * MiB;
constexpr size_t WS_WL = 304 * MiB, WS_AA = 336 * MiB, WS_GG = 368 * MiB;
constexpr size_t WS_GK = 400 * MiB;
constexpr size_t WS_Z = 80 * MiB;
constexpr size_t WS_H1 = 208 * MiB;
constexpr size_t WS_Q = 272 * MiB;
constexpr size_t WS_S = 80 * MiB;
constexpr size_t WS_IDS = 400 * MiB, WS_GATES = 416 * MiB;
constexpr size_t WS_UT = 432 * MiB, WS_VT = 448 * MiB;
constexpr int ROWB = 768;
constexpr size_t WS_SU = 464 * MiB, WS_SV = 465 * MiB;
constexpr size_t WS_UF = WS_UT; constexpr size_t UF_SLICE = (size_t)16384 * 128;
constexpr size_t WS_H8 = 272 * MiB;
constexpr size_t WS_PD = 80 * MiB;
constexpr size_t WS_V8 = WS_VT; constexpr size_t V8_SLICE = (size_t)16384 * 128;
constexpr size_t WS_CQ = 336 * MiB;
constexpr size_t WS_CS = 344 * MiB;
constexpr size_t WS_ZP = 80 * MiB;
constexpr int NSEG = 16, LSEG = 8192 / NSEG;
constexpr size_t WS_YI = WS_WL;
constexpr size_t WS_YIG = WS_GK;
constexpr size_t WS_SER = 480 * MiB;
constexpr size_t WS_SEG = 496 * MiB;
constexpr size_t WS_CEND = 504 * MiB;
constexpr size_t WS_END = 505 * MiB;

constexpr int LDS_BYTES = 163840, LDS_MISC = LDS_BYTES - 256;
constexpr size_t WS_CTL = 0, CTL_BYTES = 16384;

struct Params {
    const float* in[28];
    float* out; unsigned char* ws;
    int ph_lo, ph_hi;
};

__device__ __forceinline__ float bf2f(unsigned u) { return __uint_as_float(u << 16); }
typedef float f32x2c_t __attribute__((ext_vector_type(2))); typedef __bf16 bf16x2c_t __attribute__((ext_vector_type(2)));
__device__ __forceinline__ unsigned pk2(float lo, float hi) { const f32x2c_t v = {lo, hi}; const bf16x2c_t b = __builtin_convertvector(v, bf16x2c_t); return __builtin_bit_cast(unsigned, b); }
__device__ __forceinline__ unsigned f2bf(float f) { return pk2(f, 0.f) & 0xffffu; }
#define DPP_F(v, ctrl) __builtin_bit_cast(float, __builtin_amdgcn_update_dpp(0, __builtin_bit_cast(int, (v)), (ctrl), 0xf, 0xf, false))
#define DPP_ADD(v, ctrl) ((v) + DPP_F(v, ctrl))
__device__ __forceinline__ float rlf(float v, int l) { return __builtin_bit_cast(float, __builtin_amdgcn_readlane(__builtin_bit_cast(int, v), l)); }
__device__ __forceinline__ float wave_sum_u(float v) {
    v = DPP_ADD(v, 0xB1); v = DPP_ADD(v, 0x4E); v = DPP_ADD(v, 0x141); v = DPP_ADD(v, 0x140);
    return (rlf(v, 0) + rlf(v, 16)) + (rlf(v, 32) + rlf(v, 48));
}
__device__ __forceinline__ float wave_sum(float v) { return wave_sum_u(v); }
#define DPP_I(v, ctrl) __builtin_amdgcn_update_dpp(0, (v), (ctrl), 0xf, 0xf, false)
__device__ __forceinline__ int wave_sum_i(int v) {
    v += DPP_I(v, 0xB1); v += DPP_I(v, 0x4E); v += DPP_I(v, 0x141); v += DPP_I(v, 0x140);
    return (__builtin_amdgcn_readlane(v, 0) + __builtin_amdgcn_readlane(v, 16)) + (__builtin_amdgcn_readlane(v, 32) + __builtin_amdgcn_readlane(v, 48));
}
__device__ __forceinline__ float wave_max_u(float v) {
    v = fmaxf(v, DPP_F(v, 0xB1)); v = fmaxf(v, DPP_F(v, 0x4E)); v = fmaxf(v, DPP_F(v, 0x141)); v = fmaxf(v, DPP_F(v, 0x140));
    return fmaxf(fmaxf(rlf(v, 0), rlf(v, 16)), fmaxf(rlf(v, 32), rlf(v, 48)));
}
__device__ __forceinline__ unsigned pack_i8(float a, float b, float c, float d, float inv, int off) {
    const int q0 = __float2int_rn(a * inv) + off, q1 = __float2int_rn(b * inv) + off, q2 = __float2int_rn(c * inv) + off, q3 = __float2int_rn(d * inv) + off;
    return (unsigned)(q0 & 0xff) | ((unsigned)(q1 & 0xff) << 8) | ((unsigned)(q2 & 0xff) << 16) | ((unsigned)(q3 & 0xff) << 24);
}
__device__ __forceinline__ float sigmoidf_(float x) { return 1.f / (1.f + __expf(-x)); }
__device__ __forceinline__ float siluf_(float x) { return x * sigmoidf_(x); }

__device__ __forceinline__ void transpose_convert(const float* W, int K, int N, int Npad, bf16* WT, int gtid, int gthreads) {
    const int kc = K / 8, total = Npad * kc;
    for (int idx = gtid; idx < total; idx += gthreads) {
        const int n = idx % Npad, c = idx / Npad; float v[8];
#pragma unroll
        for (int j = 0; j < 8; ++j) v[j] = (n < N) ? W[(size_t)(8 * c + j) * N + n] : 0.f;
        u32x4 o; o.x = pk2(v[0], v[1]); o.y = pk2(v[2], v[3]); o.z = pk2(v[4], v[5]); o.w = pk2(v[6], v[7]);
        *(u32x4*)(WT + (size_t)n * K + 8 * c) = o;
    }
}
__device__ __forceinline__ void ln_row_bf16(const float* xrow, const float* g, const float* b, bf16* orow, int lane) {
    const f32x4* xr = (const f32x4*)xrow + lane; f32x4 v[4]; float s = 0.f;
#pragma unroll
    for (int j = 0; j < 4; ++j) { v[j] = xr[64 * j]; s += (v[j][0] + v[j][1]) + (v[j][2] + v[j][3]); }
    const float mean = wave_sum(s) * (1.f / D); float s2 = 0.f;
#pragma unroll
    for (int j = 0; j < 4; ++j) { v[j] = v[j] - mean; s2 += (v[j][0] * v[j][0] + v[j][1] * v[j][1]) + (v[j][2] * v[j][2] + v[j][3] * v[j][3]); }
    const float rstd = 1.f / sqrtf(wave_sum(s2) * (1.f / D) + LN_EPS);
    u32x2* o8 = (u32x2*)orow + lane;
#pragma unroll
    for (int j = 0; j < 4; ++j) { const f32x4 gg = ((const f32x4*)g)[lane + 64 * j], bb = ((const f32x4*)b)[lane + 64 * j]; const f32x4 y = v[j] * rstd * gg + bb;
        u32x2 w; w.x = pk2(y[0], y[1]); w.y = pk2(y[2], y[3]); o8[64 * j] = w; }
}
template <bool F8>
__device__ __forceinline__ void ln_rowb_bf16(const bf16* xrow, const float* g, const float* b, bf16* orow, int lane, unsigned char* f8row = nullptr) {
    const u32x4* xr = (const u32x4*)xrow + 2 * lane; const u32x4 a = xr[0], c = xr[1]; float v[16]; float s = 0.f;
#pragma unroll
    for (int i = 0; i < 4; ++i) { v[2 * i] = __uint_as_float(a[i] << 16); v[2 * i + 1] = __uint_as_float(a[i] & 0xffff0000u); v[8 + 2 * i] = __uint_as_float(c[i] << 16); v[8 + 2 * i + 1] = __uint_as_float(c[i] & 0xffff0000u); }
#pragma unroll
    for (int i = 0; i < 16; ++i) s += v[i];
    const float mean = wave_sum(s) * (1.f / D); float s2 = 0.f;
#pragma unroll
    for (int i = 0; i < 16; ++i) { v[i] -= mean; s2 += v[i] * v[i]; }
    const float rstd = 1.f / sqrtf(wave_sum(s2) * (1.f / D) + LN_EPS);
    u32x4 o0, o1;
#pragma unroll
    for (int q = 0; q < 4; ++q) { const f32x4 gg = *(const f32x4*)(g + 16 * lane + 4 * q), bb = *(const f32x4*)(b + 16 * lane + 4 * q);
#pragma unroll
        for (int j = 0; j < 4; ++j) v[4 * q + j] = v[4 * q + j] * rstd * gg[j] + bb[j];
        const unsigned lo = pk2(v[4 * q], v[4 * q + 1]), hi = pk2(v[4 * q + 2], v[4 * q + 3]);
        if (q < 2) { o0[2 * q] = lo; o0[2 * q + 1] = hi; } else { o1[2 * q - 4] = lo; o1[2 * q - 3] = hi; } }
    u32x4* op = (u32x4*)orow + 2 * lane; op[0] = o0; op[1] = o1;
    if (F8) {
        u32x4 h8, l8;
#pragma unroll
        for (int q = 0; q < 4; ++q) {
            int ph = __builtin_amdgcn_cvt_pk_fp8_f32(v[4 * q], v[4 * q + 1], 0, false); ph = __builtin_amdgcn_cvt_pk_fp8_f32(v[4 * q + 2], v[4 * q + 3], ph, true);
            const float r0 = v[4 * q] - __builtin_amdgcn_cvt_f32_fp8(ph, 0), r1 = v[4 * q + 1] - __builtin_amdgcn_cvt_f32_fp8(ph, 1);
            const float r2 = v[4 * q + 2] - __builtin_amdgcn_cvt_f32_fp8(ph, 2), r3 = v[4 * q + 3] - __builtin_amdgcn_cvt_f32_fp8(ph, 3);
            int pl = __builtin_amdgcn_cvt_pk_fp8_f32(r0, r1, 0, false); pl = __builtin_amdgcn_cvt_pk_fp8_f32(r2, r3, pl, true);
            h8[q] = (unsigned)ph; l8[q] = (unsigned)pl; }
        *((u32x4*)f8row + lane) = h8; *((u32x4*)(f8row + 1024) + lane) = l8;
    }
}
__device__ __forceinline__ void fold_keys(const Params& P, LAS unsigned char* lds, int bi, int nb) {
    const int tid = threadIdx.x; unsigned char* ws = P.ws;
    {
        const float* Wq = P.in[22]; const float* keys = P.in[23]; bf16* WqkT = (bf16*)(ws + WS_WQ);
        LAS float* WQs = (LAS float*)lds; LAS float* KYs = WQs + 64 * 132;
        for (int item = bi; item < 256; item += nb) {
            const int hh = item >> 4, kt = item & 15;
            __syncthreads();
            for (int i = tid; i < 64 * 32; i += NTHR) { const int r = i >> 5, c4 = (i & 31) * 4; *(LAS f32x4*)(WQs + r * 132 + c4) = *(const f32x4*)(Wq + (size_t)(kt * 64 + r) * NQ + hh * 128 + c4); }
            for (int i = tid; i < 128 * 32; i += NTHR) { const int r = i >> 5, c4 = (i & 31) * 4; *(LAS f32x4*)(KYs + r * 132 + c4) = *(const f32x4*)(keys + (size_t)(hh * 128 + r) * 128 + c4); }
            __syncthreads();
            const int key = tid & 127, kg = tid >> 7; float acc[16];
#pragma unroll
            for (int j = 0; j < 16; ++j) acc[j] = 0.f;
            for (int c4 = 0; c4 < 32; ++c4) { const f32x4 kv = *(const LAS f32x4*)(KYs + key * 132 + 4 * c4);
#pragma unroll
                for (int j = 0; j < 16; ++j) { const f32x4 w = *(const LAS f32x4*)(WQs + (kg * 16 + j) * 132 + 4 * c4); acc[j] += (w[0] * kv[0] + w[1] * kv[1]) + (w[2] * kv[2] + w[3] * kv[3]); } }
            u32x4 o0, o1;
#pragma unroll
            for (int q = 0; q < 4; ++q) { o0[q] = pk2(acc[2 * q], acc[2 * q + 1]); o1[q] = pk2(acc[8 + 2 * q], acc[8 + 2 * q + 1]); }
            u32x4* dst = (u32x4*)(WqkT + (size_t)(hh * 128 + key) * D + kt * 64 + kg * 16); dst[0] = o0; dst[1] = o1;
        }
    }
}
__device__ __forceinline__ void phase_prologue(const Params& P, LAS unsigned char* lds) {
    const int tid = threadIdx.x, lane = tid & 63, wave = tid >> 6;
    const int gtid = blockIdx.x * NTHR + tid, gthreads = gridDim.x * NTHR;
    unsigned char* ws = P.ws;
    transpose_convert(P.in[3], D, IN_COLS, NP, (bf16*)(ws + WS_WIN), gtid, gthreads);
    transpose_convert(P.in[6], 64, A_W, A_W, (bf16*)(ws + WS_W2T), gtid, gthreads);
    transpose_convert(P.in[8], 64, A_W, A_W, (bf16*)(ws + WS_A2T), gtid, gthreads);
    transpose_convert(P.in[9], 128, A_W, A_W, (bf16*)(ws + WS_G2T), gtid, gthreads);
    const int gw = blockIdx.x * NWAVES + wave, ngw = gridDim.x * NWAVES;
    for (int m = gw; m < M; m += ngw) ln_row_bf16(P.in[0] + (size_t)m * D, P.in[1], P.in[2], (bf16*)(ws + WS_H0) + (size_t)m * D, lane);
}

typedef short bf16x8_t __attribute__((ext_vector_type(8)));
template <int KS, int LDA>
__device__ __forceinline__ void lora_mm(f32x4 (&acc)[4][4], const LAS bf16* ACT, const bf16* WT, int c0, int fr, int fq) {
#pragma unroll
    for (int mt = 0; mt < 4; ++mt)
#pragma unroll
        for (int nt = 0; nt < 4; ++nt) acc[mt][nt] = (f32x4){0.f, 0.f, 0.f, 0.f};
#pragma unroll
    for (int s = 0; s < KS; ++s) {
        bf16x8_t af[4], bfr[4];
#pragma unroll
        for (int mt = 0; mt < 4; ++mt) af[mt] = *(const LAS bf16x8_t*)(ACT + (mt * 16 + fr) * LDA + 32 * s + 8 * fq);
#pragma unroll
        for (int nt = 0; nt < 4; ++nt) bfr[nt] = *(const bf16x8_t*)(WT + (size_t)(c0 + nt * 16 + fr) * (32 * KS) + 32 * s + 8 * fq);
#pragma unroll
        for (int mt = 0; mt < 4; ++mt)
#pragma unroll
            for (int nt = 0; nt < 4; ++nt) acc[mt][nt] = __builtin_amdgcn_mfma_f32_16x16x32_bf16(bfr[nt], af[mt], acc[mt][nt], 0, 0, 0);
    }
}
__device__ __forceinline__ void phase_prep(const Params& P, LAS unsigned char* lds) {
    const int tid = threadIdx.x, lane = tid & 63, wave = __builtin_amdgcn_readfirstlane(tid >> 6), fr = lane & 15, fq = lane >> 4;
    unsigned char* ws = P.ws;
    const bf16* p = (const bf16*)(ws + WS_P);
    const float* mu = P.in[4]; const float* w0 = P.in[5]; const float* a0 = P.in[7];
    const float* gkw2 = P.in[16]; const float* gkb = P.in[17];
    const bf16* W2T = (const bf16*)(ws + WS_W2T); const bf16* A2T = (const bf16*)(ws + WS_A2T); const bf16* G2T = (const bf16*)(ws + WS_G2T);
    bf16* WL = (bf16*)(ws + WS_WL); bf16* AA = (bf16*)(ws + WS_AA); bf16* GG = (bf16*)(ws + WS_GG); bf16* GK = (bf16*)(ws + WS_GK);
    LAS bf16* TW = (LAS bf16*)lds; LAS bf16* AD = TW + 64 * 72; LAS bf16* SG = AD + 64 * 72;
    LAS float* gkd = (LAS float*)(SG + 64 * 136);
    const int c0 = wave * 64;
    for (int tile = blockIdx.x; tile < M / 64; tile += gridDim.x) {
        const int m0 = tile * 64;
        __syncthreads();
        for (int idx = tid; idx < 64 * 32; idx += NTHR) {
            const int j = (idx & 31) * 8, tok = idx >> 5, m = m0 + tok, t = m & (T - 1);
            const u32x4 cw = *(const u32x4*)(p + (size_t)m * NP + C_WD + j); const u32x4 pw = (t > 0) ? *(const u32x4*)(p + (size_t)(m - 1) * NP + C_WD + j) : (u32x4){0u, 0u, 0u, 0u};
            const f32x4 m0v = *(const f32x4*)(mu + C_WD + j), m1v = *(const f32x4*)(mu + C_WD + j + 4);
            float x[8];
#pragma unroll
            for (int i = 0; i < 4; ++i) { const float c0 = __uint_as_float(cw[i] << 16), c1 = __uint_as_float(cw[i] & 0xffff0000u), q0 = __uint_as_float(pw[i] << 16), q1 = __uint_as_float(pw[i] & 0xffff0000u);
                const float mu0 = i < 2 ? m0v[2 * i] : m1v[2 * i - 4], mu1 = i < 2 ? m0v[2 * i + 1] : m1v[2 * i - 3];
                x[2 * i] = c0 + (q0 - c0) * mu0; x[2 * i + 1] = c1 + (q1 - c1) * mu1; }
            u32x4 o;
            if (j < 64) {
#pragma unroll
                for (int i = 0; i < 4; ++i) o[i] = pk2(1.f - 2.f * __builtin_amdgcn_rcpf(1.f + __expf(2.f * x[2 * i])), 1.f - 2.f * __builtin_amdgcn_rcpf(1.f + __expf(2.f * x[2 * i + 1])));
                *(LAS u32x4*)(TW + tok * 72 + j) = o;
            } else if (j < 128) {
#pragma unroll
                for (int i = 0; i < 4; ++i) o[i] = pk2(x[2 * i], x[2 * i + 1]);
                *(LAS u32x4*)(AD + tok * 72 + j - 64) = o;
            } else {
#pragma unroll
                for (int i = 0; i < 4; ++i) o[i] = pk2(sigmoidf_(x[2 * i]), sigmoidf_(x[2 * i + 1]));
                *(LAS u32x4*)(SG + tok * 136 + j - 128) = o;
            }
        }
        for (int idx = tid; idx < 64 * 16; idx += NTHR) { const int j = idx & 15, tok = idx >> 4; gkd[tok * 16 + j] = bf2f(p[(size_t)(m0 + tok) * NP + C_GKD + j]); }
        __syncthreads();
        f32x4 acc[4][4];
        lora_mm<2, 72>(acc, TW, W2T, c0, fr, fq);
#pragma unroll
        for (int nt = 0; nt < 4; ++nt) { const int c = c0 + nt * 16 + 4 * fq; const f32x4 b = *(const f32x4*)(w0 + c);
#pragma unroll
            for (int mt = 0; mt < 4; ++mt) { float o[4];
#pragma unroll
                for (int i = 0; i < 4; ++i) { const float z = b[i] + acc[mt][nt][i]; o[i] = -0.6065306597126334f * sigmoidf_(z); }
                u32x2 w; w.x = pk2(o[0], o[1]); w.y = pk2(o[2], o[3]); *(u32x2*)(WL + (size_t)(m0 + mt * 16 + fr) * A_W + c) = w; } }
        lora_mm<2, 72>(acc, AD, A2T, c0, fr, fq);
#pragma unroll
        for (int nt = 0; nt < 4; ++nt) { const int c = c0 + nt * 16 + 4 * fq; const f32x4 b = *(const f32x4*)(a0 + c);
#pragma unroll
            for (int mt = 0; mt < 4; ++mt) { float o[4];
#pragma unroll
                for (int i = 0; i < 4; ++i) o[i] = sigmoidf_(b[i] + acc[mt][nt][i]);
                u32x2 w; w.x = pk2(o[0], o[1]); w.y = pk2(o[2], o[3]); *(u32x2*)(AA + (size_t)(m0 + mt * 16 + fr) * A_W + c) = w; } }
        lora_mm<4, 136>(acc, SG, G2T, c0, fr, fq);
#pragma unroll
        for (int nt = 0; nt < 4; ++nt) { const int c = c0 + nt * 16 + 4 * fq;
#pragma unroll
            for (int mt = 0; mt < 4; ++mt) { u32x2 w; w.x = pk2(acc[mt][nt][0], acc[mt][nt][1]); w.y = pk2(acc[mt][nt][2], acc[mt][nt][3]); *(u32x2*)(GG + (size_t)(m0 + mt * 16 + fr) * A_W + c) = w; } }
        { const int cc = tid & 255, th = tid >> 8; float wv[16];
#pragma unroll
          for (int j = 0; j < 16; ++j) wv[j] = gkw2[j * 256 + cc];
          const float bb = gkb[cc];
          for (int i = 0; i < 32; ++i) { const int tok = th * 32 + i; float sacc = bb;
#pragma unroll
              for (int j = 0; j < 16; ++j) sacc += gkd[tok * 16 + j] * wv[j];
              GK[(size_t)(m0 + tok) * 256 + cc] = (bf16)f2bf(-(fmaxf(-sacc, 0.f) + __logf(1.f + __expf(-fabsf(sacc)))) * (1.f / 16.f)); } }
    }
}

constexpr int CH = 32;
__device__ __forceinline__ float red8(float v) { v = DPP_ADD(v, 0xB1); v = DPP_ADD(v, 0x4E); v = DPP_ADD(v, 0x141); return v; }

constexpr int RW_BUF = 6 * CH * 64;
__device__ __forceinline__ void rw_load(const bf16* p, const bf16* AA, const bf16* WL, int b, int t0, int col, int wave,
        unsigned (&rc)[4], unsigned (&kc)[4], unsigned (&vc)[4], unsigned (&rp)[4], unsigned (&kp)[4], unsigned (&vp)[4], unsigned (&a)[4], unsigned (&wl)[4]) {
#pragma unroll
    for (int q = 0; q < 4; ++q) {
        const int t = t0 + wave + 8 * q; const size_t m = (size_t)b * T + t; const bf16* pr = p + m * NP; const bf16* pp = (t > 0) ? pr - NP : pr;
        rc[q] = pr[C_R + col]; kc[q] = pr[C_K + col]; vc[q] = pr[C_V + col]; rp[q] = pp[C_R + col]; kp[q] = pp[C_K + col]; vp[q] = pp[C_V + col];
        a[q] = AA[m * A_W + col]; wl[q] = WL[m * A_W + col];
    }
}
__device__ __forceinline__ void rw_prep(LAS float* B, int t0, int wave, int lane, float mu_r, float mu_k, float mu_v, float kkc, float kac,
        const unsigned (&rc_)[4], const unsigned (&kc_)[4], const unsigned (&vc_)[4], const unsigned (&rp_)[4], const unsigned (&kp_)[4], const unsigned (&vp_)[4], const unsigned (&a_)[4], const unsigned (&wl_)[4]) {
    LAS float* R = B; LAS float* DEC = R + CH * 64; LAS float* KH = DEC + CH * 64; LAS float* KK = KH + CH * 64; LAS float* BB = KK + CH * 64; LAS float* V = BB + CH * 64;
#pragma unroll
    for (int q = 0; q < 4; ++q) {
        const int tt = wave + 8 * q; const float hp = (t0 + tt > 0) ? 1.f : 0.f;
        const float rc = bf2f(rc_[q]), kc = bf2f(kc_[q]), vc = bf2f(vc_[q]), rp = bf2f(rp_[q]) * hp, kp = bf2f(kp_[q]) * hp, vp = bf2f(vp_[q]) * hp;
        const float r = rc + (rp - rc) * mu_r, k = kc + (kp - kc) * mu_k, v = vc + (vp - vc) * mu_v;
        const float a = bf2f(a_[q]), wl = bf2f(wl_[q]);
        const float kr = k * kkc; const float nrm = sqrtf(wave_sum(kr * kr)); const float kk = kr / fmaxf(nrm, 1e-12f);
        const float kh = k * (1.f + (a - 1.f) * kac);
        R[tt * 64 + lane] = r; DEC[tt * 64 + lane] = __expf(wl); KH[tt * 64 + lane] = kh; KK[tt * 64 + lane] = kk; BB[tt * 64 + lane] = kk * a; V[tt * 64 + lane] = v;
    }
}
struct RwOps { f32x4 k0, k1, d0, d1, b0, b1, h0, h1, q0, q1; float v0, v1; };
__device__ __forceinline__ void rw_ops_load(RwOps& o, const LAS float* B, int tt, int s8, int vr0) {
    const LAS float* R = B; const LAS float* DEC = R + CH * 64; const LAS float* KH = DEC + CH * 64; const LAS float* KK = KH + CH * 64; const LAS float* BB = KK + CH * 64; const LAS float* V = BB + CH * 64;
    o.k0 = *(const LAS f32x4*)(KK + tt * 64 + s8); o.k1 = *(const LAS f32x4*)(KK + tt * 64 + s8 + 4);
    o.d0 = *(const LAS f32x4*)(DEC + tt * 64 + s8); o.d1 = *(const LAS f32x4*)(DEC + tt * 64 + s8 + 4);
    o.b0 = *(const LAS f32x4*)(BB + tt * 64 + s8); o.b1 = *(const LAS f32x4*)(BB + tt * 64 + s8 + 4);
    o.h0 = *(const LAS f32x4*)(KH + tt * 64 + s8); o.h1 = *(const LAS f32x4*)(KH + tt * 64 + s8 + 4);
    o.q0 = *(const LAS f32x4*)(R + tt * 64 + s8); o.q1 = *(const LAS f32x4*)(R + tt * 64 + s8 + 4);
    o.v0 = V[tt * 64 + vr0]; o.v1 = V[tt * 64 + vr0 + 1];
}
template <bool IDENT> __device__ __forceinline__ void rw_step(const RwOps& o, f32x2 (&S0)[4], f32x2 (&S1)[4], LAS float* Y, int tt, int r0, int lane) {
    const float vv0 = o.v0, vv1 = o.v1;
    const f32x2 kk[4] = {o.k0.lo, o.k0.hi, o.k1.lo, o.k1.hi}, dd[4] = {o.d0.lo, o.d0.hi, o.d1.lo, o.d1.hi}, bb[4] = {o.b0.lo, o.b0.hi, o.b1.lo, o.b1.hi}, hh[4] = {o.h0.lo, o.h0.hi, o.h1.lo, o.h1.hi}, rr[4] = {o.q0.lo, o.q0.hi, o.q1.lo, o.q1.hi};
    f32x2 a0 = S0[0] * kk[0], a1 = S1[0] * kk[0];
#pragma unroll
    for (int i = 1; i < 4; ++i) { a0 = S0[i] * kk[i] + a0; a1 = S1[i] * kk[i] + a1; }
    const float sa0 = -red8(a0.x + a0.y), sa1 = -red8(a1.x + a1.y);
    f32x2 y0 = (f32x2){0.f, 0.f}, y1 = (f32x2){0.f, 0.f};
#pragma unroll
    for (int i = 0; i < 4; ++i) {
        if (IDENT) { S0[i] = bb[i] * sa0 + S0[i] * dd[i]; S1[i] = bb[i] * sa1 + S1[i] * dd[i]; }
        else { S0[i] = hh[i] * vv0 + (bb[i] * sa0 + S0[i] * dd[i]); S1[i] = hh[i] * vv1 + (bb[i] * sa1 + S1[i] * dd[i]); }
        y0 = S0[i] * rr[i] + y0; y1 = S1[i] * rr[i] + y1;
    }
    const float yy0 = red8(y0.x + y0.y), yy1 = red8(y1.x + y1.y);
    if ((lane & 7) == 0) { Y[tt * 128 + r0] = yy0; Y[tt * 128 + r0 + 1] = yy1; }
}
__device__ __forceinline__ void rwkv_item(const Params& P, LAS unsigned char* lds, int b, int h, int seg) {
    const int tid = threadIdx.x, lane = tid & 63, wave = tid >> 6;
    unsigned char* ws = P.ws;
    const bf16* p = (const bf16*)(ws + WS_P); const bf16* WL = (const bf16*)(ws + WS_WL); const bf16* AA = (const bf16*)(ws + WS_AA);
    bf16* MIX = (bf16*)P.out; bf16* YI = (bf16*)(ws + WS_YI);
    const float* mu = P.in[4]; const float* k_k = P.in[10]; const float* k_a = P.in[11];
    LAS float* BUF = (LAS float*)lds; LAS float* Y = BUF + 2 * RW_BUF;
    const int col = h * 64 + lane;
    const float mu_r = mu[C_R + col], mu_k = mu[C_K + col], mu_v = mu[C_V + col], kkc = k_k[col], kac = k_a[col];
    const int r0 = wave * 16 + 2 * (lane >> 3), s8 = (lane & 7) * 8; const int ident = r0 >> 6, vr0 = r0 & 63, vr1 = vr0 + 1;
    float* SE = (float*)(ws + WS_SER) + ((((size_t)(b * 8 + h) * NSEG + seg) * 2 + ident) * 4096) + vr0 * 64 + s8;
    f32x2 S0[4], S1[4];
#pragma unroll
    for (int i = 0; i < 4; ++i) { S0[i] = (f32x2){(ident && (s8 + 2 * i == vr0)) ? 1.f : 0.f, (ident && (s8 + 2 * i + 1 == vr0)) ? 1.f : 0.f};
        S1[i] = (f32x2){(ident && (s8 + 2 * i == vr1)) ? 1.f : 0.f, (ident && (s8 + 2 * i + 1 == vr1)) ? 1.f : 0.f}; }
    const int tbeg = seg * LSEG;
    unsigned rc[4], kc[4], vc[4], rp[4], kp[4], vp[4], a[4], wl[4];
    __syncthreads();
    rw_load(p, AA, WL, b, tbeg, col, wave, rc, kc, vc, rp, kp, vp, a, wl);
    rw_prep(BUF, tbeg, wave, lane, mu_r, mu_k, mu_v, kkc, kac, rc, kc, vc, rp, kp, vp, a, wl);
    __syncthreads();
    for (int ci = 0; ci < LSEG / CH; ++ci) {
        const int t0 = tbeg + ci * CH; LAS float* B = BUF + (ci & 1) * RW_BUF;
        LAS float* R = B; LAS float* DEC = R + CH * 64; LAS float* KH = DEC + CH * 64; LAS float* KK = KH + CH * 64; LAS float* BB = KK + CH * 64; LAS float* V = BB + CH * 64;
        const bool more = (ci + 1 < LSEG / CH);
        if (more) rw_load(p, AA, WL, b, t0 + CH, col, wave, rc, kc, vc, rp, kp, vp, a, wl);
        { RwOps oa, ob; rw_ops_load(oa, B, 0, s8, vr0);
          if (ident) for (int tt = 0; tt < CH; tt += 2) {
              rw_ops_load(ob, B, tt + 1, s8, vr0); rw_step<true>(oa, S0, S1, Y, tt, r0, lane);
              rw_ops_load(oa, B, (tt + 2) & (CH - 1), s8, vr0); rw_step<true>(ob, S0, S1, Y, tt + 1, r0, lane);
          } else for (int tt = 0; tt < CH; tt += 2) {
              rw_ops_load(ob, B, tt + 1, s8, vr0); rw_step<false>(oa, S0, S1, Y, tt, r0, lane);
              rw_ops_load(oa, B, (tt + 2) & (CH - 1), s8, vr0); rw_step<false>(ob, S0, S1, Y, tt + 1, r0, lane);
          } }
        __syncthreads();
        if (more) rw_prep(BUF + ((ci + 1) & 1) * RW_BUF, t0 + CH, wave, lane, mu_r, mu_k, mu_v, kkc, kac, rc, kc, vc, rp, kp, vp, a, wl);
#pragma unroll
        for (int q = 0; q < 4; ++q) {
            const int tt = wave + 8 * q; const size_t m = (size_t)b * T + t0 + tt;
            MIX[m * D + col] = (bf16)f2bf(Y[tt * 128 + lane]); YI[m * 512 + col] = (bf16)f2bf(Y[tt * 128 + 64 + lane]);
        }
        __syncthreads();
    }
    *(f32x4*)(SE) = (f32x4){S0[0].x, S0[0].y, S0[1].x, S0[1].y}; *(f32x4*)(SE + 4) = (f32x4){S0[2].x, S0[2].y, S0[3].x, S0[3].y};
    *(f32x4*)(SE + 64) = (f32x4){S1[0].x, S1[0].y, S1[1].x, S1[1].y}; *(f32x4*)(SE + 68) = (f32x4){S1[2].x, S1[2].y, S1[3].x, S1[3].y};
}

constexpr int W_AT = 0, W_BT = 4608, W_KT = 9216, W_LAK = 13824, W_L1 = 0, W_LT1 = 4608, W_X1 = 9216, W_RT = 18432, W_BTT = 23040, W_KTT = 27648, W_VTT = 32256, W_X0 = 36864,
              W_L0 = 46080, W_LT0 = 50688, W_QT = 46080, W_TT = 50688, W_LRB = 55296, W_LRK = 59904, W_SIM = 64512, W_PIM = 69120, W_END = 73728, W_MI = 0;
__device__ __forceinline__ bf16x8_t lfrag(const LAS bf16* base, int row, int sx, int fq) { return *(const LAS bf16x8_t*)(base + row * 72 + 32 * sx + 8 * fq); }
#define MFMA16(a, b, c) __builtin_amdgcn_mfma_f32_16x16x32_bf16((a), (b), (c), 0, 0, 0)
typedef short bf16x4_t __attribute__((ext_vector_type(4)));
#define MFMA16K(a, b, c) __builtin_amdgcn_mfma_f32_16x16x16bf16_1k((a), (b), (c), 0, 0, 0)
__device__ __forceinline__ bf16x4_t pack4(const f32x4 v) { u32x2 w; w.x = pk2(v[0], v[1]); w.y = pk2(v[2], v[3]); return __builtin_bit_cast(bf16x4_t, w); }
__device__ __forceinline__ void st4(LAS bf16* dst, float a, float b, float c, float d) { u32x2 w; w.x = pk2(a, b); w.y = pk2(c, d); *(LAS u32x2*)dst = w; }
__device__ __forceinline__ f32x4 ld4(const LAS bf16* src) { const u32x2 w = *(const LAS u32x2*)src; return (f32x4){__uint_as_float(w.x << 16), __uint_as_float(w.x & 0xffff0000u), __uint_as_float(w.y << 16), __uint_as_float(w.y & 0xffff0000u)}; }
__device__ __forceinline__ void rwkv_item_chunked(const Params& P, LAS unsigned char* lds, int b, int h, int seg) {
    const int tid = threadIdx.x, lane = tid & 63, wave = __builtin_amdgcn_readfirstlane(tid >> 6), fr = lane & 15, fq = lane >> 4;
    unsigned char* ws = P.ws;
    const bf16* p = (const bf16*)(ws + WS_P); const bf16* WL = (const bf16*)(ws + WS_WL); const bf16* AA = (const bf16*)(ws + WS_AA);
    bf16* MIX = (bf16*)P.out; bf16* YI = (bf16*)(ws + WS_YI);
    const float* mu = P.in[4]; const float* k_k = P.in[10]; const float* k_a = P.in[11];
    LAS bf16* L = (LAS bf16*)lds;
    LAS float* GAM = (LAS float*)(lds + W_END * 2); LAS float* TOT = GAM + 64;
    const int col = h * 64 + lane, tg = wave;
    const float mu_r = mu[C_R + col], mu_k = mu[C_K + col], mu_v = mu[C_V + col], kkc = k_k[col], kac = k_a[col];
    const int hv = wave >> 2, w4 = wave & 3;
    f32x4 Wreg[4];
#pragma unroll
    for (int k = 0; k < 4; ++k) Wreg[k] = (f32x4){0.f, 0.f, 0.f, 0.f};
    __syncthreads();
    for (int i = tid; i < 2 * 64 * 72 / 2; i += NTHR) ((LAS unsigned*)(L + W_SIM))[i] = 0u;
    __syncthreads();
    if (tid < 64) L[W_PIM + tid * 72 + tid] = (bf16)0x3F80;
    unsigned nr_[9], nk_[9], nv_[9], na_[8], nw_[8];
    { const int t0 = seg * LSEG;
#pragma unroll
      for (int r = 0; r < 9; ++r) { const int t = t0 + 8 * tg - 1 + r; const bf16* pr = p + ((size_t)b * T + (t > 0 ? t : 0)) * NP; nr_[r] = pr[C_R + col]; nk_[r] = pr[C_K + col]; nv_[r] = pr[C_V + col]; }
#pragma unroll
      for (int i = 0; i < 8; ++i) { const size_t m = (size_t)b * T + t0 + 8 * tg + i; na_[i] = AA[m * A_W + col]; nw_[i] = WL[m * A_W + col]; } }
    for (int c = 0; c < LSEG / 64; ++c) {
        const int t0 = seg * LSEG + c * 64;
        float rv[8], kkv[8], bv[8], khv[8], vv[8], g[8], wl[8];
        unsigned xr[9], xk[9], xv[9], xa[8], xw[8];
#pragma unroll
        for (int r = 0; r < 9; ++r) { xr[r] = nr_[r]; xk[r] = nk_[r]; xv[r] = nv_[r]; }
#pragma unroll
        for (int i = 0; i < 8; ++i) { xa[i] = na_[i]; xw[i] = nw_[i]; }
        if (c + 1 < LSEG / 64) {
#pragma unroll
            for (int r = 0; r < 9; ++r) { const int t = t0 + 64 + 8 * tg - 1 + r; const bf16* pr = p + ((size_t)b * T + t) * NP; nr_[r] = pr[C_R + col]; nk_[r] = pr[C_K + col]; nv_[r] = pr[C_V + col]; }
#pragma unroll
            for (int i = 0; i < 8; ++i) { const size_t m = (size_t)b * T + t0 + 64 + 8 * tg + i; na_[i] = AA[m * A_W + col]; nw_[i] = WL[m * A_W + col]; }
        }
#pragma unroll
        for (int i = 0; i < 8; ++i) { const int t = t0 + 8 * tg + i; const float hp = (t > 0) ? 1.f : 0.f;
            const float rc = bf2f(xr[i + 1]), kc = bf2f(xk[i + 1]), vc = bf2f(xv[i + 1]);
            const float r = rc + (bf2f(xr[i]) * hp - rc) * mu_r, k = kc + (bf2f(xk[i]) * hp - kc) * mu_k; vv[i] = vc + (bf2f(xv[i]) * hp - vc) * mu_v;
            const float a = bf2f(xa[i]); wl[i] = bf2f(xw[i]);
            const float kr = k * kkc; const float nrm = sqrtf(wave_sum(kr * kr)); const float kk = kr / fmaxf(nrm, 1e-12f);
            rv[i] = r; kkv[i] = kk; bv[i] = kk * a; khv[i] = k * (1.f + (a - 1.f) * kac); }
        g[0] = wl[0];
#pragma unroll
        for (int i = 1; i < 8; ++i) g[i] = g[i - 1] + wl[i];
        TOT[tg * 64 + lane] = g[7];
        __syncthreads();
        float off = 0.f, total = 0.f;
#pragma unroll
        for (int w = 0; w < 8; ++w) { const float tv = TOT[w * 64 + lane]; total += tv; off += (w < tg) ? tv : 0.f; }
        { float at[8], bt[8], kt[8];
#pragma unroll
          for (int i = 0; i < 8; ++i) { const float G = off + g[i]; const float eG = __expf(G), eGm = __expf(G - wl[i]), ei = __expf(-G);
              at[i] = -kkv[i] * eGm; bt[i] = bv[i] * ei; kt[i] = khv[i] * ei; const float rt = rv[i] * eG; const int row = 8 * tg + i;
              L[W_AT + row * 72 + lane] = (bf16)f2bf(at[i]); L[W_BT + row * 72 + lane] = (bf16)f2bf(bt[i]); L[W_KT + row * 72 + lane] = (bf16)f2bf(kt[i]); L[W_RT + row * 72 + lane] = (bf16)f2bf(rt); }
          u32x4 w;
          w.x = pk2(at[0], at[1]); w.y = pk2(at[2], at[3]); w.z = pk2(at[4], at[5]); w.w = pk2(at[6], at[7]); *(LAS u32x4*)(L + W_X0 + lane * 72 + 8 * tg) = w;
          w.x = pk2(bt[0], bt[1]); w.y = pk2(bt[2], bt[3]); w.z = pk2(bt[4], bt[5]); w.w = pk2(bt[6], bt[7]); *(LAS u32x4*)(L + W_BTT + lane * 72 + 8 * tg) = w;
          w.x = pk2(kt[0], kt[1]); w.y = pk2(kt[2], kt[3]); w.z = pk2(kt[4], kt[5]); w.w = pk2(kt[6], kt[7]); *(LAS u32x4*)(L + W_KTT + lane * 72 + 8 * tg) = w;
          w.x = pk2(vv[0], vv[1]); w.y = pk2(vv[2], vv[3]); w.z = pk2(vv[4], vv[5]); w.w = pk2(vv[6], vv[7]); *(LAS u32x4*)(L + W_VTT + lane * 72 + 8 * tg) = w; }
        if (tg == 0) GAM[lane] = __expf(total);
        __syncthreads();
        { bf16x8_t aB[2][2], aK[2][2], bA[2][2], bR[2][2]; f32x4 ab[2], ak[2], rb[2], rk[2];
#pragma unroll
          for (int q = 0; q < 2; ++q) { const int pos = wave * 2 + q, it = pos >> 2, tt = pos & 3;
#pragma unroll
              for (int sx = 0; sx < 2; ++sx) { aB[q][sx] = lfrag(L + W_BT, it * 16 + fr, sx, fq); aK[q][sx] = lfrag(L + W_KT, it * 16 + fr, sx, fq); bA[q][sx] = lfrag(L + W_AT, tt * 16 + fr, sx, fq); bR[q][sx] = lfrag(L + W_RT, tt * 16 + fr, sx, fq); } }
#pragma unroll
          for (int q = 0; q < 2; ++q) { ab[q] = (f32x4){0.f, 0.f, 0.f, 0.f}; ak[q] = ab[q]; rb[q] = ab[q]; rk[q] = ab[q];
#pragma unroll
              for (int sx = 0; sx < 2; ++sx) { ab[q] = MFMA16(aB[q][sx], bA[q][sx], ab[q]); ak[q] = MFMA16(aK[q][sx], bA[q][sx], ak[q]); rb[q] = MFMA16(aB[q][sx], bR[q][sx], rb[q]); rk[q] = MFMA16(aK[q][sx], bR[q][sx], rk[q]); } }
#pragma unroll
          for (int q = 0; q < 2; ++q) { const int pos = wave * 2 + q, it = pos >> 2, tt = pos & 3; const int t = tt * 16 + fr, i0 = it * 16 + 4 * fq;
#pragma unroll
              for (int rg = 0; rg < 4; ++rg) { const bool st = (i0 + rg < t), inc = (i0 + rg <= t); ab[q][rg] = st ? ab[q][rg] : 0.f; ak[q][rg] = st ? ak[q][rg] : 0.f; rb[q][rg] = inc ? rb[q][rg] : 0.f; rk[q][rg] = inc ? rk[q][rg] : 0.f; }
              st4(L + W_L0 + t * 72 + i0, ab[q][0], ab[q][1], ab[q][2], ab[q][3]); st4(L + W_LAK + t * 72 + i0, ak[q][0], ak[q][1], ak[q][2], ak[q][3]);
              st4(L + W_LRB + t * 72 + i0, rb[q][0], rb[q][1], rb[q][2], rb[q][3]); st4(L + W_LRK + t * 72 + i0, rk[q][0], rk[q][1], rk[q][2], rk[q][3]);
#pragma unroll
              for (int rg = 0; rg < 4; ++rg) L[W_LT0 + (i0 + rg) * 72 + t] = (bf16)f2bf(ab[q][rg]); } }
        __syncthreads();
        { bf16x8_t a[2][2], bb[2][2]; f32x4 acc[2];
#pragma unroll
          for (int q = 0; q < 2; ++q) { const int pos = wave * 2 + q, tt = pos >> 2, vt = pos & 3;
#pragma unroll
              for (int sx = 0; sx < 2; ++sx) { a[q][sx] = lfrag(L + W_LAK, tt * 16 + fr, sx, fq); bb[q][sx] = lfrag(L + W_VTT, vt * 16 + fr, sx, fq); } }
#pragma unroll
          for (int q = 0; q < 2; ++q) { acc[q] = (f32x4){0.f, 0.f, 0.f, 0.f};
#pragma unroll
              for (int sx = 0; sx < 2; ++sx) acc[q] = MFMA16(a[q][sx], bb[q][sx], acc[q]); }
#pragma unroll
          for (int q = 0; q < 2; ++q) { const int pos = wave * 2 + q, tt = pos >> 2, vt = pos & 3; st4(L + W_X0 + (64 + vt * 16 + fr) * 72 + tt * 16 + 4 * fq, acc[q][0], acc[q][1], acc[q][2], acc[q][3]); } }
        if (wave < 4) {
            const int r16 = wave * 16;
            f32x4 PA = ld4(L + W_L0 + (r16 + fr) * 72 + r16 + 4 * fq), PB = ld4(L + W_LT0 + (r16 + fr) * 72 + r16 + 4 * fq);
            f32x4 MA = PA, MB = PB;
#pragma unroll
            for (int j = 0; j < 4; ++j) { const float d = (fr == 4 * fq + j) ? 1.f : 0.f; MA[j] += d; MB[j] += d; }
#pragma unroll
            for (int it3 = 0; it3 < 3; ++it3) {
                const bf16x4_t pa = pack4(PA), pb = pack4(PB);
                const f32x4 QB = MFMA16K(pa, pb, ((f32x4){0.f, 0.f, 0.f, 0.f})), QA = MFMA16K(pb, pa, ((f32x4){0.f, 0.f, 0.f, 0.f}));
                PA = QA; PB = QB;
                const bf16x4_t qb = pack4(QB), ma = pack4(MA);
                MB = MFMA16K(ma, qb, MB); MA = MFMA16K(qb, ma, MA);
            }
            st4(L + W_MI + (r16 + fr) * 24 + 4 * fq, MA[0], MA[1], MA[2], MA[3]);
        }
        __syncthreads();
        { bf16x4_t y[4]; LAS bf16* Xrow = L + W_X0 + (wave * 16 + fr) * 72 + 4 * fq;
#pragma unroll
          for (int r = 0; r < 4; ++r) {
              f32x4 acc = ld4(Xrow + 16 * r);
#pragma unroll
              for (int cc = 0; cc < 4; ++cc) if (cc < r) acc = MFMA16K(*(const LAS bf16x4_t*)(L + W_L0 + (16 * r + fr) * 72 + 16 * cc + 4 * fq), y[cc], acc);
              const bf16x4_t tb = pack4(acc);
              const f32x4 xr = MFMA16K(*(const LAS bf16x4_t*)(L + W_MI + (16 * r + fr) * 24 + 4 * fq), tb, ((f32x4){0.f, 0.f, 0.f, 0.f}));
              y[r] = pack4(xr);
              *(LAS bf16x4_t*)(Xrow + 16 * r) = y[r]; } }
        __syncthreads();
        { bf16x8_t aX[2][2], bT[2][2], bL[2][2]; f32x4 accT[2], accQ[2], rt[2]; float gm[2];
#pragma unroll
          for (int q = 0; q < 2; ++q) { const int pos = wave * 2 + q, kt = pos >> 2, nt = pos & 3;
#pragma unroll
              for (int sx = 0; sx < 2; ++sx) { aX[q][sx] = lfrag(L + W_X0, kt * 16 + fr, sx, fq); bT[q][sx] = lfrag(L + W_BTT, nt * 16 + fr, sx, fq); bL[q][sx] = lfrag(L + W_LRB, nt * 16 + fr, sx, fq); }
              gm[q] = GAM[nt * 16 + fr]; rt[q] = ld4(L + W_RT + (nt * 16 + fr) * 72 + kt * 16 + 4 * fq); }
#pragma unroll
          for (int q = 0; q < 2; ++q) { accT[q] = (f32x4){0.f, 0.f, 0.f, 0.f}; accQ[q] = accT[q];
#pragma unroll
              for (int sx = 0; sx < 2; ++sx) { accT[q] = MFMA16(aX[q][sx], bT[q][sx], accT[q]); accQ[q] = MFMA16(aX[q][sx], bL[q][sx], accQ[q]); } }
#pragma unroll
          for (int q = 0; q < 2; ++q) { const int pos = wave * 2 + q, kt = pos >> 2, nt = pos & 3; const int k0 = kt * 16 + 4 * fq, n = nt * 16 + fr;
#pragma unroll
              for (int rg = 0; rg < 4; ++rg) accT[q][rg] = (accT[q][rg] + ((k0 + rg == n) ? 1.f : 0.f)) * gm[q];
              st4(L + W_TT + n * 72 + k0, accT[q][0], accT[q][1], accT[q][2], accT[q][3]); st4(L + W_QT + n * 72 + k0, accQ[q][0] + rt[q][0], accQ[q][1] + rt[q][1], accQ[q][2] + rt[q][2], accQ[q][3] + rt[q][3]); } }
        __syncthreads();
        { f32x4 ov[2], oi[2];
#pragma unroll
          for (int j = 0; j < 2; ++j) { ov[j] = (f32x4){0.f, 0.f, 0.f, 0.f}; oi[j] = ov[j]; }
#pragma unroll
          for (int sx = 0; sx < 2; ++sx) { const bf16x8_t aQ = lfrag(L + W_QT, w4 * 16 + fr, sx, fq), aB = lfrag(L + W_LRB, w4 * 16 + fr, sx, fq), aK = lfrag(L + W_LRK, w4 * 16 + fr, sx, fq);
#pragma unroll
              for (int j = 0; j < 2; ++j) { const int rw = 4 * fr + 2 * hv + j;
                  ov[j] = MFMA16(aB, lfrag(L + W_X0, 64 + rw, sx, fq), ov[j]); ov[j] = MFMA16(aK, lfrag(L + W_VTT, rw, sx, fq), ov[j]); ov[j] = MFMA16(aQ, lfrag(L + W_SIM, rw, sx, fq), ov[j]);
                  oi[j] = MFMA16(aQ, lfrag(L + W_PIM, rw, sx, fq), oi[j]); } }
#pragma unroll
          for (int rg = 0; rg < 4; ++rg) { const size_t m = (size_t)b * T + t0 + w4 * 16 + 4 * fq + rg;
              *(unsigned*)(MIX + m * D + h * 64 + 4 * fr + 2 * hv) = pk2(ov[0][rg], ov[1][rg]); *(unsigned*)(YI + m * 512 + h * 64 + 4 * fr + 2 * hv) = pk2(oi[0][rg], oi[1][rg]); } }
#pragma unroll
        for (int j = 0; j < 2; ++j) { const int nt = 2 * hv + j; f32x4 acc = (f32x4){0.f, 0.f, 0.f, 0.f}, aci = acc;
#pragma unroll
            for (int sx = 0; sx < 2; ++sx) { acc = MFMA16(lfrag(L + W_X0, 64 + w4 * 16 + fr, sx, fq), lfrag(L + W_BTT, nt * 16 + fr, sx, fq), acc); acc = MFMA16(lfrag(L + W_VTT, w4 * 16 + fr, sx, fq), lfrag(L + W_KTT, nt * 16 + fr, sx, fq), acc); }
            acc = acc * GAM[nt * 16 + fr];
#pragma unroll
            for (int sx = 0; sx < 2; ++sx) { const bf16x8_t tf = lfrag(L + W_TT, nt * 16 + fr, sx, fq); acc = MFMA16(lfrag(L + W_SIM, w4 * 16 + fr, sx, fq), tf, acc); aci = MFMA16(lfrag(L + W_PIM, w4 * 16 + fr, sx, fq), tf, aci); }
            Wreg[j] = acc; Wreg[2 + j] = aci; }
        __syncthreads();
#pragma unroll
        for (int j = 0; j < 2; ++j)
#pragma unroll
            for (int rg = 0; rg < 4; ++rg) { const int ix = (w4 * 16 + 4 * fq + rg) * 72 + (2 * hv + j) * 16 + fr; L[W_SIM + ix] = (bf16)f2bf(Wreg[j][rg]); L[W_PIM + ix] = (bf16)f2bf(Wreg[2 + j][rg]); }
    }
    float* SE = (float*)(ws + WS_SER) + (((size_t)(b * 8 + h) * NSEG + seg) * 2) * 4096;
#pragma unroll
    for (int j = 0; j < 2; ++j)
#pragma unroll
        for (int rg = 0; rg < 4; ++rg) { const int ix = (w4 * 16 + 4 * fq + rg) * 64 + (2 * hv + j) * 16 + fr; SE[ix] = Wreg[j][rg]; SE[4096 + ix] = Wreg[2 + j][rg]; }
}

constexpr int GQ = 0, GK_ = GQ + 64 * 72, GD = GK_ + 64 * 72, GV = GD + 64 * 72, GA = GV + 128 * 72, GS = GA + 64 * 72, GEND = GS + 128 * 72;
__device__ __forceinline__ unsigned pk2f(float a, float b) { return pk2(a, b); }
__device__ __forceinline__ void gla_item(const Params& P, LAS unsigned char* lds, int b, int h, int seg) {
    const int tid = threadIdx.x, lane = tid & 63, wave = __builtin_amdgcn_readfirstlane(tid >> 6), fr = lane & 15, fq = lane >> 4;
    unsigned char* ws = P.ws;
    const bf16* p = (const bf16*)(ws + WS_P); bf16* GKB = (bf16*)(ws + WS_GK);
    bf16* MIX = (bf16*)P.out;
    float* SE = (float*)(ws + WS_SEG) + ((size_t)(b * 4 + h) * NSEG + seg) * 8192; float* CE = (float*)(ws + WS_CEND) + ((size_t)(b * 4 + h) * NSEG + seg) * 64;
    const float* conv = P.in[15];
    LAS bf16* L = (LAS bf16*)lds; LAS bf16* QT = L + GQ; LAS bf16* KT = L + GK_; LAS bf16* KD = L + GD; LAS bf16* VT = L + GV; LAS bf16* AT = L + GA; LAS bf16* ST = L + GS;
    LAS float* GAM = (LAS float*)(lds + GEND * 2); LAS float* TOT = GAM + 64;
    const int ch = lane, tg = wave;
    const int cq = h * 64 + ch, ck = 256 + h * 64 + ch, cv0 = 512 + h * 128 + ch, cv1 = cv0 + 64;
    float wq[4], wk[4], wv0[4], wv1[4];
#pragma unroll
    for (int j = 0; j < 4; ++j) { wq[j] = conv[j * 1024 + cq]; wk[j] = conv[j * 1024 + ck]; wv0[j] = conv[j * 1024 + cv0]; wv1[j] = conv[j * 1024 + cv1]; }
    float gseg = 0.f;
    f32x4 Sacc[4];
#pragma unroll
    for (int k = 0; k < 4; ++k) Sacc[k] = (f32x4){0.f, 0.f, 0.f, 0.f};
    __syncthreads();
    for (int i = tid; i < 128 * 72 / 2; i += NTHR) ((LAS unsigned*)ST)[i] = 0u;
    for (int c = 0; c < LSEG / 64; ++c) {
        const int t0 = seg * LSEG + c * 64;
        __syncthreads();
        float xq[11], xk[11], xa[11], xb[11], g[8];
#pragma unroll
        for (int r = 0; r < 11; ++r) { const int t = t0 + 8 * tg - 3 + r; const size_t m = (size_t)b * T + (t > 0 ? t : 0); const float ok = (t >= 0) ? 1.f : 0.f; const bf16* pr = p + m * NP + C_BQ;
            xq[r] = bf2f(pr[cq]) * ok; xk[r] = bf2f(pr[ck]) * ok; xa[r] = bf2f(pr[cv0]) * ok; xb[r] = bf2f(pr[cv1]) * ok; }
#pragma unroll
        for (int i = 0; i < 8; ++i) g[i] = bf2f(GKB[((size_t)b * T + t0 + 8 * tg + i) * 256 + h * 64 + ch]);
#pragma unroll
        for (int i = 1; i < 8; ++i) g[i] += g[i - 1];
        TOT[tg * 64 + ch] = g[7];
        __syncthreads();
        float off = 0.f, total = 0.f;
#pragma unroll
        for (int w = 0; w < 8; ++w) { const float tv = TOT[w * 64 + ch]; total += tv; off += (w < tg) ? tv : 0.f; }
        float kd[8], va[8], vb[8];
#pragma unroll
        for (int i = 0; i < 8; ++i) {
            float aq = 0.f, ak = 0.f, a0 = 0.f, a1 = 0.f;
#pragma unroll
            for (int j = 0; j < 4; ++j) { aq += wq[j] * xq[i + j]; ak += wk[j] * xk[i + j]; a0 += wv0[j] * xa[i + j]; a1 += wv1[j] * xb[i + j]; }
            const float q = siluf_(aq) * 0.125f, k = siluf_(ak), Gc = off + g[i];
            QT[(8 * tg + i) * 72 + ch] = (bf16)f2bf(q * __expf(Gc)); KT[(8 * tg + i) * 72 + ch] = (bf16)f2bf(k * __expf(-Gc));
            kd[i] = k * __expf(total - Gc); va[i] = siluf_(a0); vb[i] = siluf_(a1);
            GKB[((size_t)b * T + t0 + 8 * tg + i) * 256 + h * 64 + ch] = (bf16)f2bf(q * __expf(gseg + Gc));
        }
        { u32x4 w; w.x = pk2f(kd[0], kd[1]); w.y = pk2f(kd[2], kd[3]); w.z = pk2f(kd[4], kd[5]); w.w = pk2f(kd[6], kd[7]); *(LAS u32x4*)(KD + ch * 72 + 8 * tg) = w;
          w.x = pk2f(va[0], va[1]); w.y = pk2f(va[2], va[3]); w.z = pk2f(va[4], va[5]); w.w = pk2f(va[6], va[7]); *(LAS u32x4*)(VT + ch * 72 + 8 * tg) = w;
          w.x = pk2f(vb[0], vb[1]); w.y = pk2f(vb[2], vb[3]); w.z = pk2f(vb[4], vb[5]); w.w = pk2f(vb[6], vb[7]); *(LAS u32x4*)(VT + (64 + ch) * 72 + 8 * tg) = w; }
        if (tg == 0) GAM[ch] = __expf(total);
        gseg += total;
        __syncthreads();
#pragma unroll
        for (int k2 = 0; k2 < 2; ++k2) { const int tile = wave * 2 + k2, jt = tile >> 2, it = tile & 3; f32x4 acc = (f32x4){0.f, 0.f, 0.f, 0.f};
            if (jt <= it) {
#pragma unroll
                for (int sx = 0; sx < 2; ++sx) acc = __builtin_amdgcn_mfma_f32_16x16x32_bf16(*(const LAS bf16x8_t*)(KT + (jt * 16 + fr) * 72 + 32 * sx + 8 * fq), *(const LAS bf16x8_t*)(QT + (it * 16 + fr) * 72 + 32 * sx + 8 * fq), acc, 0, 0, 0);
            }
            const int ii = it * 16 + fr, j0 = jt * 16 + 4 * fq; u32x2 w;
            w.x = pk2f(j0 <= ii ? acc[0] : 0.f, j0 + 1 <= ii ? acc[1] : 0.f); w.y = pk2f(j0 + 2 <= ii ? acc[2] : 0.f, j0 + 3 <= ii ? acc[3] : 0.f);
            *(LAS u32x2*)(AT + ii * 72 + j0) = w; }
        __syncthreads();
        { const int it = wave & 3, vts = (wave >> 2) * 4; f32x4 oacc[4];
#pragma unroll
          for (int k = 0; k < 4; ++k) oacc[k] = (f32x4){0.f, 0.f, 0.f, 0.f};
#pragma unroll
          for (int sx = 0; sx < 2; ++sx) { const bf16x8_t aA = *(const LAS bf16x8_t*)(AT + (it * 16 + fr) * 72 + 32 * sx + 8 * fq), aQ = *(const LAS bf16x8_t*)(QT + (it * 16 + fr) * 72 + 32 * sx + 8 * fq);
#pragma unroll
              for (int k = 0; k < 4; ++k) { const int vrow = 8 * fr + vts + k;
                  oacc[k] = __builtin_amdgcn_mfma_f32_16x16x32_bf16(aA, *(const LAS bf16x8_t*)(VT + vrow * 72 + 32 * sx + 8 * fq), oacc[k], 0, 0, 0);
                  oacc[k] = __builtin_amdgcn_mfma_f32_16x16x32_bf16(aQ, *(const LAS bf16x8_t*)(ST + vrow * 72 + 32 * sx + 8 * fq), oacc[k], 0, 0, 0); } }
#pragma unroll
          for (int rg = 0; rg < 4; ++rg) { const size_t m = (size_t)b * T + t0 + it * 16 + 4 * fq + rg; u32x2 w; w.x = pk2f(oacc[0][rg], oacc[1][rg]); w.y = pk2f(oacc[2][rg], oacc[3][rg]);
              *(u32x2*)(MIX + m * D + 512 + h * 128 + 8 * fr + vts) = w; } }
#pragma unroll
        for (int k = 0; k < 4; ++k) { f32x4 acc = Sacc[k] * GAM[k * 16 + fr];
#pragma unroll
            for (int sx = 0; sx < 2; ++sx) acc = __builtin_amdgcn_mfma_f32_16x16x32_bf16(*(const LAS bf16x8_t*)(VT + (wave * 16 + fr) * 72 + 32 * sx + 8 * fq), *(const LAS bf16x8_t*)(KD + (k * 16 + fr) * 72 + 32 * sx + 8 * fq), acc, 0, 0, 0);
            Sacc[k] = acc; }
        __syncthreads();
#pragma unroll
        for (int k = 0; k < 4; ++k)
#pragma unroll
            for (int rg = 0; rg < 4; ++rg) ST[(wave * 16 + 4 * fq + rg) * 72 + k * 16 + fr] = (bf16)f2bf(Sacc[k][rg]);
    }
#pragma unroll
    for (int k = 0; k < 4; ++k)
#pragma unroll
        for (int rg = 0; rg < 4; ++rg) SE[(wave * 16 + 4 * fq + rg) * 64 + k * 16 + fr] = Sacc[k][rg];
    if (tg == 0) CE[ch] = __expf(gseg);
}
__device__ __forceinline__ void phase_scan(const Params& P, LAS unsigned char* lds) {
    for (int it = blockIdx.x; it < 512 + 256; it += gridDim.x) {
        if (it < 512) { const int bh = it >> 4; rwkv_item_chunked(P, lds, bh >> 3, bh & 7, it & 15); }
        else { const int g = it - 512, bh = g >> 4; gla_item(P, lds, bh >> 2, bh & 3, g & 15); }
        __syncthreads();
    }
}
__device__ __forceinline__ void quant_tables(const Params& P, int gw, int ngw);
__device__ __forceinline__ void phase_fixup(const Params& P, LAS unsigned char* lds) {
    const int tid = threadIdx.x, lane = tid & 63, wave = __builtin_amdgcn_readfirstlane(tid >> 6), fr = lane & 15, fq = lane >> 4;
    for (int it = blockIdx.x; it < 192; it += gridDim.x) {
        if (it < 64) {
            float* SE = (float*)(P.ws + WS_SER) + (size_t)(it >> 1) * NSEG * 2 * 4096;
            LAS float* Sb = (LAS float*)lds;
            const int sl = wave >> 2, nt = wave & 3, r0 = ((it & 1) * 2 + sl) * 16;
            const int cpos = (r0 + 4 * fq) * 64 + nt * 16 + fr;
            const int bpos = (16 * fq) * 64 + nt * 16 + fr;
            __syncthreads();
            f32x4 en[4]; float ph[4][16];
#define FX_LOAD(sg) do { const float* nx_ = SE + (size_t)((sg) * 2) * 4096; \
                _Pragma("unroll") for (int ks = 0; ks < 16; ++ks) ph[(sg) & 3][ks] = nx_[4096 + bpos + 64 * ks]; \
                _Pragma("unroll") for (int rg = 0; rg < 4; ++rg) en[(sg) & 3][rg] = nx_[cpos + 64 * rg]; } while (0)
#pragma unroll
            for (int rg = 0; rg < 4; ++rg) Sb[(sl * 16 + 4 * fq + rg) * 68 + nt * 16 + fr] = SE[cpos + 64 * rg];
            FX_LOAD(1); FX_LOAD(2); FX_LOAD(3);
            __syncthreads();
#pragma unroll
            for (int seg = 1; seg < NSEG - 1; ++seg) {
                float* s0 = SE + (size_t)(seg * 2) * 4096;
                const LAS float* Sr = Sb + ((seg - 1) & 1) * (2 * 16 * 68) + (sl * 16 + fr) * 68 + 16 * fq; LAS float* Sw = Sb + (seg & 1) * (2 * 16 * 68);
                if (seg + 3 < NSEG - 1) FX_LOAD(seg + 3);
                f32x4 acc = en[seg & 3]; f32x4 av[4];
#pragma unroll
                for (int j = 0; j < 4; ++j) av[j] = *(const LAS f32x4*)(Sr + 4 * j);
#pragma unroll
                for (int ks = 0; ks < 16; ++ks) acc = __builtin_amdgcn_mfma_f32_16x16x4f32(av[ks >> 2][ks & 3], ph[seg & 3][ks], acc, 0, 0, 0);
#pragma unroll
                for (int rg = 0; rg < 4; ++rg) { s0[cpos + 64 * rg] = acc[rg]; Sw[(sl * 16 + 4 * fq + rg) * 68 + nt * 16 + fr] = acc[rg]; }
                __syncthreads();
            }
#undef FX_LOAD
        } else {
            const int g = it - 64, bh = g >> 3; float* SE = (float*)(P.ws + WS_SEG) + (size_t)bh * NSEG * 8192 + ((g & 7) * 16 + (tid >> 5)) * 64 + (tid & 31) * 2;
            const float* CE = (const float*)(P.ws + WS_CEND) + (size_t)bh * NSEG * 64 + (tid & 31) * 2;
            f32x2 x[NSEG - 1], ce[NSEG - 1];
#pragma unroll
            for (int seg = 0; seg < NSEG - 1; ++seg) { x[seg] = *(const f32x2*)(SE + (size_t)seg * 8192); ce[seg] = *(const f32x2*)(CE + seg * 64); }
            f32x2 sc = (f32x2){0.f, 0.f};
#pragma unroll
            for (int seg = 0; seg < NSEG - 1; ++seg) { sc = sc * ce[seg] + x[seg]; *(f32x2*)(SE + (size_t)seg * 8192) = sc; }
        }
    }
    {
        const bool sp = gridDim.x > 64; const int nb = sp ? (int)gridDim.x - 64 : (int)gridDim.x, bi = sp ? (int)blockIdx.x - 64 : (int)blockIdx.x;
        if (bi >= 0) {
            fold_keys(P, lds, bi, nb);
            transpose_convert(P.in[19], D, D, D, (bf16*)(P.ws + WS_WOUT), bi * NTHR + tid, nb * NTHR);
            quant_tables(P, bi * NWAVES + (tid >> 6), nb * NWAVES);
        }
    }
}
__device__ __forceinline__ float row_sum16(float v) { v = DPP_ADD(v, 0xB1); v = DPP_ADD(v, 0x4E); v = DPP_ADD(v, 0x141); v = DPP_ADD(v, 0x140); return v; }
__device__ __forceinline__ bf16x8_t pack_bf16x8(const f32x4 a, const f32x4 b) {
    u32x4 w; w.x = pk2(a[0], a[1]); w.y = pk2(a[2], a[3]); w.z = pk2(b[0], b[1]); w.w = pk2(b[2], b[3]); return __builtin_bit_cast(bf16x8_t, w);
}
__device__ __forceinline__ void unpack4(const u32x2 w, float (&o)[4]) { o[0] = __uint_as_float(w.x << 16); o[1] = __uint_as_float(w.x & 0xffff0000u); o[2] = __uint_as_float(w.y << 16); o[3] = __uint_as_float(w.y & 0xffff0000u); }
__device__ __forceinline__ void phase_correct(const Params& P, LAS unsigned char* lds) {
    const int tid = threadIdx.x, lane = tid & 63, wave = __builtin_amdgcn_readfirstlane(tid >> 6), fr = lane & 15, fq = lane >> 4;
    unsigned char* ws = P.ws;
    const bf16* p = (const bf16*)(ws + WS_P); const bf16* AA = (const bf16*)(ws + WS_AA); const bf16* GG = (const bf16*)(ws + WS_GG);
    bf16* MIX = (bf16*)P.out; const bf16* YI = (const bf16*)(ws + WS_YI); const bf16* YIG = (const bf16*)(ws + WS_YIG);
    const float* mu = P.in[4]; const float* k_a = P.in[11]; const float* r_k = P.in[12]; const float* gn_g = P.in[13]; const float* gn_b = P.in[14]; const float* norm_g = P.in[18];
    LAS bf16* SB = (LAS bf16*)lds;
    for (int it = blockIdx.x; it < 512; it += gridDim.x) {
        {
            const int seg = it & 15, bh = it >> 4, b = bh >> 3, h = bh & 7;
            const int cb = h * 64 + 4 * fr;
            __syncthreads();
            if (seg > 0) { const float* ss = (const float*)(ws + WS_SER) + (((size_t)bh * NSEG + (seg - 1)) * 2) * 4096;
                for (int i = tid; i < 1024; i += NTHR) { const f32x4 x = *(const f32x4*)(ss + 4 * i); const int v = i >> 4, j = (4 * i) & 63; u32x2 w; w.x = pk2(x[0], x[1]); w.y = pk2(x[2], x[3]);
                    *(LAS u32x2*)(SB + ((v & 3) * 16 + (v >> 2)) * 72 + j) = w; } }
            __syncthreads();
            const f32x4 mur = *(const f32x4*)(mu + C_R + cb), muk = *(const f32x4*)(mu + C_K + cb), muv = *(const f32x4*)(mu + C_V + cb), kac = *(const f32x4*)(k_a + cb), rkc = *(const f32x4*)(r_k + cb), gng = *(const f32x4*)(gn_g + cb), gnb = *(const f32x4*)(gn_b + cb);
            u32x2 W[4][9];
#define CORR_LOAD(buf, st) do { const int t_ = seg * LSEG + wave * 64 + ((st) >> 2) * 16 + 4 * fq + ((st) & 3); const size_t m_ = (size_t)b * T + t_; const bf16* pr_ = p + m_ * NP + cb; const bf16* pp_ = (t_ > 0) ? pr_ - NP : pr_; \
                    W[buf][0] = *(const u32x2*)(MIX + m_ * D + cb); W[buf][1] = *(const u32x2*)(pr_ + C_R); W[buf][2] = *(const u32x2*)(pr_ + C_K); W[buf][3] = *(const u32x2*)(pr_ + C_V); \
                    W[buf][4] = *(const u32x2*)(pp_ + C_R); W[buf][5] = *(const u32x2*)(pp_ + C_K); W[buf][6] = *(const u32x2*)(pp_ + C_V); W[buf][7] = *(const u32x2*)(AA + m_ * A_W + cb); W[buf][8] = *(const u32x2*)(GG + m_ * A_W + cb); } while (0)
            CORR_LOAD(0, 0); CORR_LOAD(1, 1); CORR_LOAD(2, 2);
#pragma unroll
            for (int mt = 0; mt < 4; ++mt) {
                const int tb = seg * LSEG + wave * 64 + mt * 16;
                f32x4 acc[4];
#pragma unroll
                for (int vt = 0; vt < 4; ++vt) acc[vt] = (f32x4){0.f, 0.f, 0.f, 0.f};
                if (seg > 0) {
#pragma unroll
                    for (int sx = 0; sx < 2; ++sx) { const bf16x8_t af = *(const bf16x8_t*)(YI + ((size_t)b * T + tb + fr) * 512 + h * 64 + 32 * sx + 8 * fq);
#pragma unroll
                        for (int vt = 0; vt < 4; ++vt) acc[vt] = __builtin_amdgcn_mfma_f32_16x16x32_bf16(af, *(const LAS bf16x8_t*)(SB + (vt * 16 + fr) * 72 + 32 * sx + 8 * fq), acc[vt], 0, 0, 0); }
                }
#pragma unroll
                for (int rg = 0; rg < 4; ++rg) { const int t = tb + 4 * fq + rg; const size_t m = (size_t)b * T + t; const float hp = (t > 0) ? 1.f : 0.f; const int st = mt * 4 + rg;
                    if (st + 3 < 16) CORR_LOAD((st + 3) & 3, st + 3);
                    __builtin_amdgcn_sched_barrier(0);
                    float y[4], rc[4], kc[4], vc[4], rp_[4], kp[4], vp[4], a[4], g[4];
                    unpack4(W[st & 3][0], y); unpack4(W[st & 3][1], rc); unpack4(W[st & 3][2], kc); unpack4(W[st & 3][3], vc); unpack4(W[st & 3][4], rp_); unpack4(W[st & 3][5], kp); unpack4(W[st & 3][6], vp); unpack4(W[st & 3][7], a); unpack4(W[st & 3][8], g);
                    float v[4], sy = 0.f, sb = 0.f;
#pragma unroll
                    for (int i = 0; i < 4; ++i) { y[i] += acc[i][rg];
                        const float r = rc[i] + (rp_[i] * hp - rc[i]) * mur[i], k = kc[i] + (kp[i] * hp - kc[i]) * muk[i]; v[i] = vc[i] + (vp[i] * hp - vc[i]) * muv[i];
                        const float kh = k * (1.f + (a[i] - 1.f) * kac[i]); sb += r * kh * rkc[i]; sy += y[i]; }
                    const float bon = row_sum16(sb), mean = row_sum16(sy) * (1.f / 64.f); float sq = 0.f;
#pragma unroll
                    for (int i = 0; i < 4; ++i) { y[i] -= mean; sq += y[i] * y[i]; }
                    const float rstd = 1.f / sqrtf(row_sum16(sq) * (1.f / 64.f) + GN_EPS); float o[4];
#pragma unroll
                    for (int i = 0; i < 4; ++i) o[i] = (y[i] * rstd * gng[i] + gnb[i] + bon * v[i]) * g[i];
                    u32x2 w; w.x = pk2(o[0], o[1]); w.y = pk2(o[2], o[3]); *(u32x2*)(MIX + m * D + cb) = w;
                    __builtin_amdgcn_sched_barrier(0); }
#undef CORR_LOAD
            }
        }
    }
    for (int g_ = blockIdx.x; g_ < 256; g_ += gridDim.x) {
        {
            const int seg = g_ & 15, bh = g_ >> 4, b = bh >> 2, h = bh & 3;
            const int cb = h * 128 + 8 * fr;
            __syncthreads();
            if (seg > 0) { const float* ss = (const float*)(ws + WS_SEG) + ((size_t)bh * NSEG + (seg - 1)) * 8192;
                for (int i = tid; i < 2048; i += NTHR) { const f32x4 x = *(const f32x4*)(ss + 4 * i); const int v = i >> 4, j = (4 * i) & 63; u32x2 w; w.x = pk2(x[0], x[1]); w.y = pk2(x[2], x[3]);
                    *(LAS u32x2*)(SB + ((v & 7) * 16 + (v >> 3)) * 72 + j) = w; } }
            __syncthreads();
            const f32x4 ng0 = *(const f32x4*)(norm_g + 8 * fr), ng1 = *(const f32x4*)(norm_g + 8 * fr + 4);
            u32x4 WG[4][2];
#define CORG_LOAD(buf, st) do { const size_t m_ = (size_t)b * T + seg * LSEG + wave * 64 + ((st) >> 2) * 16 + 4 * fq + ((st) & 3); WG[buf][0] = *(const u32x4*)(MIX + m_ * D + 512 + cb); WG[buf][1] = *(const u32x4*)(p + m_ * NP + C_BG + cb); } while (0)
            CORG_LOAD(0, 0); CORG_LOAD(1, 1); CORG_LOAD(2, 2);
#pragma unroll
            for (int mt = 0; mt < 4; ++mt) {
                const int tb = seg * LSEG + wave * 64 + mt * 16;
                f32x4 acc[8];
#pragma unroll
                for (int vt = 0; vt < 8; ++vt) acc[vt] = (f32x4){0.f, 0.f, 0.f, 0.f};
                if (seg > 0) {
#pragma unroll
                    for (int sx = 0; sx < 2; ++sx) { const bf16x8_t af = *(const bf16x8_t*)(YIG + ((size_t)b * T + tb + fr) * 256 + h * 64 + 32 * sx + 8 * fq);
#pragma unroll
                        for (int vt = 0; vt < 8; ++vt) acc[vt] = __builtin_amdgcn_mfma_f32_16x16x32_bf16(af, *(const LAS bf16x8_t*)(SB + (vt * 16 + fr) * 72 + 32 * sx + 8 * fq), acc[vt], 0, 0, 0); }
                }
#pragma unroll
                for (int rg = 0; rg < 4; ++rg) { const size_t m = (size_t)b * T + tb + 4 * fq + rg; const int st = mt * 4 + rg;
                    if (st + 3 < 16) CORG_LOAD((st + 3) & 3, st + 3);
                    __builtin_amdgcn_sched_barrier(0);
                    float o[8], g[8]; float sq = 0.f;
#pragma unroll
                    for (int i = 0; i < 4; ++i) { const unsigned a_ = WG[st & 3][0][i], b_ = WG[st & 3][1][i]; o[2 * i] = __uint_as_float(a_ << 16); o[2 * i + 1] = __uint_as_float(a_ & 0xffff0000u); g[2 * i] = __uint_as_float(b_ << 16); g[2 * i + 1] = __uint_as_float(b_ & 0xffff0000u); }
#pragma unroll
                    for (int i = 0; i < 8; ++i) { o[i] += acc[i][rg]; sq += o[i] * o[i]; }
                    const float rs = 1.f / sqrtf(row_sum16(sq) * (1.f / 128.f) + RMS_EPS);
                    float f[8];
#pragma unroll
                    for (int i = 0; i < 8; ++i) f[i] = o[i] * rs * (i < 4 ? ng0[i & 3] : ng1[i & 3]) * siluf_(g[i]);
                    u32x4 w; w.x = pk2(f[0], f[1]); w.y = pk2(f[2], f[3]); w.z = pk2(f[4], f[5]); w.w = pk2(f[6], f[7]); *(u32x4*)(MIX + m * D + 512 + cb) = w;
                    __builtin_amdgcn_sched_barrier(0); }
#undef CORG_LOAD
            }
        }
    }
}

__device__ __forceinline__ void phase_ln1(const Params& P) {
    const int lane = threadIdx.x & 63, wave = threadIdx.x >> 6; const int gw = blockIdx.x * NWAVES + wave, ngw = gridDim.x * NWAVES;
    for (int m = gw; m < M; m += ngw) ln_rowb_bf16<true>((const bf16*)(P.ws + WS_Z) + (size_t)m * D, P.in[20], P.in[21], (bf16*)(P.ws + WS_H1) + (size_t)m * D, lane, P.ws + WS_H8 + (size_t)m * 2048);
}
__device__ __forceinline__ void quant_tables(const Params& P, int gw, int ngw) {
    const int lane = threadIdx.x & 63;
    {
        const float* src = P.in[24]; unsigned char* dst = P.ws + WS_UF + (size_t)(lane >> 3) * UF_SLICE + 16 * (lane & 7); float* sc = (float*)(P.ws + WS_SU);
        for (int e = gw; e < 16384; e += ngw) {
            const f32x4* sp = (const f32x4*)(src + (size_t)e * D) + 4 * lane; f32x4 a[4]; float mx = 0.f;
#pragma unroll
            for (int j = 0; j < 4; ++j) { a[j] = sp[j]; mx = fmaxf(fmaxf(mx, fmaxf(fabsf(a[j][0]), fabsf(a[j][1]))), fmaxf(fabsf(a[j][2]), fabsf(a[j][3]))); }
            mx = wave_max_u(mx); const float inv = mx > 0.f ? 448.f / mx : 0.f;
            u32x4 w;
#pragma unroll
            for (int j = 0; j < 4; ++j) { int pk = __builtin_amdgcn_cvt_pk_fp8_f32(a[j][0] * inv, a[j][1] * inv, 0, false); pk = __builtin_amdgcn_cvt_pk_fp8_f32(a[j][2] * inv, a[j][3] * inv, pk, true); w[j] = (unsigned)pk; }
            *(u32x4*)(dst + (size_t)e * 128) = w;
            if (lane == 0) sc[e] = mx * (1.f / 448.f);
        }
    }
    {
        const float* src = P.in[25]; unsigned char* dst = P.ws + WS_V8 + (size_t)(lane >> 3) * V8_SLICE + 16 * (lane & 7); float* sc = (float*)(P.ws + WS_SV);
        for (int e = gw; e < 16384; e += ngw) {
            const f32x4* sp = (const f32x4*)(src + (size_t)e * D) + 4 * lane; f32x4 a[4]; float mx = 0.f;
#pragma unroll
            for (int j = 0; j < 4; ++j) { a[j] = sp[j]; mx = fmaxf(fmaxf(mx, fmaxf(fabsf(a[j][0]), fabsf(a[j][1]))), fmaxf(fabsf(a[j][2]), fabsf(a[j][3]))); }
            mx = wave_max_u(mx); const float inv = mx > 0.f ? 127.f / mx : 0.f;
            u32x4 w;
#pragma unroll
            for (int j = 0; j < 4; ++j) w[j] = pack_i8(a[j][0], a[j][1], a[j][2], a[j][3], inv, 0);
            *(u32x4*)(dst + (size_t)e * 128) = w;
            if (lane == 0) sc[e] = mx * (1.f / 127.f);
        }
    }
}

#define TK_CE(a, b) do { const unsigned _h = max((a), (b)); (b) = min((a), (b)); (a) = _h; } while (0)
#define TK_INS(L, x) do { _Pragma("unroll") for (int _j = 0; _j < 16; ++_j) { const unsigned _h = max(L[_j], x); x = min(L[_j], x); L[_j] = _h; } } while (0)
__device__ __forceinline__ void tk_sort16(unsigned (&x)[16]) { TK_CE(x[0], x[13]); TK_CE(x[1], x[12]); TK_CE(x[2], x[15]); TK_CE(x[3], x[14]); TK_CE(x[4], x[8]); TK_CE(x[5], x[6]); TK_CE(x[7], x[11]); TK_CE(x[9], x[10]); TK_CE(x[0], x[5]); TK_CE(x[1], x[7]); TK_CE(x[2], x[9]); TK_CE(x[3], x[4]); TK_CE(x[6], x[13]); TK_CE(x[8], x[14]); TK_CE(x[10], x[15]); TK_CE(x[11], x[12]); TK_CE(x[0], x[1]); TK_CE(x[2], x[3]); TK_CE(x[4], x[5]); TK_CE(x[6], x[8]); TK_CE(x[7], x[9]); TK_CE(x[10], x[11]); TK_CE(x[12], x[13]); TK_CE(x[14], x[15]); TK_CE(x[0], x[2]); TK_CE(x[1], x[3]); TK_CE(x[4], x[10]); TK_CE(x[5], x[11]); TK_CE(x[6], x[7]); TK_CE(x[8], x[9]); TK_CE(x[12], x[14]); TK_CE(x[13], x[15]); TK_CE(x[1], x[2]); TK_CE(x[3], x[12]); TK_CE(x[4], x[6]); TK_CE(x[5], x[7]); TK_CE(x[8], x[10]); TK_CE(x[9], x[11]); TK_CE(x[13], x[14]); TK_CE(x[1], x[4]); TK_CE(x[2], x[6]); TK_CE(x[5], x[8]); TK_CE(x[7], x[10]); TK_CE(x[9], x[13]); TK_CE(x[11], x[14]); TK_CE(x[2], x[4]); TK_CE(x[3], x[6]); TK_CE(x[9], x[12]); TK_CE(x[11], x[13]); TK_CE(x[3], x[5]); TK_CE(x[6], x[8]); TK_CE(x[7], x[9]); TK_CE(x[10], x[12]); TK_CE(x[3], x[4]); TK_CE(x[5], x[6]); TK_CE(x[7], x[8]); TK_CE(x[9], x[10]); TK_CE(x[11], x[12]); TK_CE(x[6], x[7]); TK_CE(x[8], x[9]); }
__device__ __forceinline__ void tk_merge16(unsigned (&R)[16], const unsigned (&S)[16]) {
#pragma unroll
    for (int i = 0; i < 16; ++i) R[i] = max(R[i], S[15 - i]);
    TK_CE(R[0], R[8]); TK_CE(R[1], R[9]); TK_CE(R[2], R[10]); TK_CE(R[3], R[11]); TK_CE(R[4], R[12]); TK_CE(R[5], R[13]); TK_CE(R[6], R[14]); TK_CE(R[7], R[15]); TK_CE(R[0], R[4]); TK_CE(R[1], R[5]); TK_CE(R[2], R[6]); TK_CE(R[3], R[7]); TK_CE(R[8], R[12]); TK_CE(R[9], R[13]); TK_CE(R[10], R[14]); TK_CE(R[11], R[15]); TK_CE(R[0], R[2]); TK_CE(R[1], R[3]); TK_CE(R[4], R[6]); TK_CE(R[5], R[7]); TK_CE(R[8], R[10]); TK_CE(R[9], R[11]); TK_CE(R[12], R[14]); TK_CE(R[13], R[15]); TK_CE(R[0], R[1]); TK_CE(R[2], R[3]); TK_CE(R[4], R[5]); TK_CE(R[6], R[7]); TK_CE(R[8], R[9]); TK_CE(R[10], R[11]); TK_CE(R[12], R[13]); TK_CE(R[14], R[15]);
}
__device__ __forceinline__ unsigned tk_ckey(float sum, unsigned payload) { const unsigned b = __float_as_uint(sum); const unsigned mono = b ^ ((unsigned)((int)b >> 31) | 0x80000000u); return (mono & 0xFFFFC000u) | payload; }
__device__ __forceinline__ void topk128(const u32x4* r, unsigned (&L)[16]) {
    u32x4 c0 = r[0], c1 = r[64];
    for (int c = 0; c < 8; ++c) {
        const u32x4 n0 = r[64 * ((2 * c + 2) & 15)], n1 = r[64 * ((2 * c + 3) & 15)];
        const unsigned kb = 0xFFFFu - 16u * (unsigned)c; unsigned x[16];
#pragma unroll
        for (int d = 0; d < 4; ++d) {
            unsigned w = c0[d]; unsigned msk = ((w >> 15) & 0x00010001u) * 0xFFFFu; w ^= (msk | 0x80008000u);
            x[2 * d] = (w << 16) | (kb - 2u * d); x[2 * d + 1] = (w & 0xFFFF0000u) | (kb - 2u * d - 1u);
            w = c1[d]; msk = ((w >> 15) & 0x00010001u) * 0xFFFFu; w ^= (msk | 0x80008000u);
            x[8 + 2 * d] = (w << 16) | (kb - 8u - 2u * d); x[8 + 2 * d + 1] = (w & 0xFFFF0000u) | (kb - 8u - 2u * d - 1u);
        }
        tk_sort16(x);
        if (c == 0) {
#pragma unroll
            for (int q = 0; q < 16; ++q) L[q] = x[q];
        } else tk_merge16(L, x);
        c0 = n0; c1 = n1;
    }
}
__device__ __forceinline__ void phase_topk(const Params& P) {
    const int gl = blockIdx.x * NTHR + threadIdx.x, nl = gridDim.x * NTHR;
    const bf16* Sc = (const bf16*)(P.ws + WS_S); int* IDS = (int*)(P.ws + WS_IDS); float* GATES = (float*)(P.ws + WS_GATES);
    for (int item = gl; item < M * 8; item += nl) {
        const u32x4* row = (const u32x4*)Sc + (size_t)((item >> 6) * 32) * 64 + (item & 63);
        unsigned L0[16], L1[16];
        topk128(row, L0); topk128(row + 16 * 64, L1);
        float f0[16], f1[16]; unsigned p0[16], p1[16];
#pragma unroll
        for (int i = 0; i < 16; ++i) {
            f0[i] = __uint_as_float((L0[i] & 0x80000000u) ? (L0[i] & 0x7FFF0000u) : (~L0[i] & 0xFFFF0000u)); p0[i] = (~L0[i] & 0x7Fu) << 7;
            f1[i] = __uint_as_float((L1[i] & 0x80000000u) ? (L1[i] & 0x7FFF0000u) : (~L1[i] & 0xFFFF0000u)); p1[i] = (~L1[i] & 0x7Fu);
        }
        unsigned C[16];
        { unsigned x[16] = {tk_ckey(f0[0] + f1[0], p0[0] | p1[0]), tk_ckey(f0[0] + f1[1], p0[0] | p1[1]), tk_ckey(f0[0] + f1[2], p0[0] | p1[2]), tk_ckey(f0[0] + f1[3], p0[0] | p1[3]), tk_ckey(f0[0] + f1[4], p0[0] | p1[4]), tk_ckey(f0[0] + f1[5], p0[0] | p1[5]), tk_ckey(f0[0] + f1[6], p0[0] | p1[6]), tk_ckey(f0[0] + f1[7], p0[0] | p1[7]), tk_ckey(f0[0] + f1[8], p0[0] | p1[8]), tk_ckey(f0[0] + f1[9], p0[0] | p1[9]), tk_ckey(f0[0] + f1[10], p0[0] | p1[10]), tk_ckey(f0[0] + f1[11], p0[0] | p1[11]), tk_ckey(f0[0] + f1[12], p0[0] | p1[12]), tk_ckey(f0[0] + f1[13], p0[0] | p1[13]), tk_ckey(f0[0] + f1[14], p0[0] | p1[14]), tk_ckey(f0[0] + f1[15], p0[0] | p1[15])};
          tk_sort16(x);
#pragma unroll
          for (int q = 0; q < 16; ++q) C[q] = x[q]; }
        { unsigned x[16] = {tk_ckey(f0[1] + f1[0], p0[1] | p1[0]), tk_ckey(f0[1] + f1[1], p0[1] | p1[1]), tk_ckey(f0[1] + f1[2], p0[1] | p1[2]), tk_ckey(f0[1] + f1[3], p0[1] | p1[3]), tk_ckey(f0[1] + f1[4], p0[1] | p1[4]), tk_ckey(f0[1] + f1[5], p0[1] | p1[5]), tk_ckey(f0[1] + f1[6], p0[1] | p1[6]), tk_ckey(f0[1] + f1[7], p0[1] | p1[7]), tk_ckey(f0[2] + f1[0], p0[2] | p1[0]), tk_ckey(f0[2] + f1[1], p0[2] | p1[1]), tk_ckey(f0[2] + f1[2], p0[2] | p1[2]), tk_ckey(f0[2] + f1[3], p0[2] | p1[3]), tk_ckey(f0[2] + f1[4], p0[2] | p1[4]), tk_ckey(f0[3] + f1[0], p0[3] | p1[0]), tk_ckey(f0[3] + f1[1], p0[3] | p1[1]), tk_ckey(f0[3] + f1[2], p0[3] | p1[2])};
          tk_sort16(x); tk_merge16(C, x); }
        { unsigned x[16] = {tk_ckey(f0[3] + f1[3], p0[3] | p1[3]), tk_ckey(f0[4] + f1[0], p0[4] | p1[0]), tk_ckey(f0[4] + f1[1], p0[4] | p1[1]), tk_ckey(f0[4] + f1[2], p0[4] | p1[2]), tk_ckey(f0[5] + f1[0], p0[5] | p1[0]), tk_ckey(f0[5] + f1[1], p0[5] | p1[1]), tk_ckey(f0[6] + f1[0], p0[6] | p1[0]), tk_ckey(f0[6] + f1[1], p0[6] | p1[1]), tk_ckey(f0[7] + f1[0], p0[7] | p1[0]), tk_ckey(f0[7] + f1[1], p0[7] | p1[1]), tk_ckey(f0[8] + f1[0], p0[8] | p1[0]), tk_ckey(f0[9] + f1[0], p0[9] | p1[0]), tk_ckey(f0[10] + f1[0], p0[10] | p1[0]), tk_ckey(f0[11] + f1[0], p0[11] | p1[0]), tk_ckey(f0[12] + f1[0], p0[12] | p1[0]), tk_ckey(f0[13] + f1[0], p0[13] | p1[0])};
          tk_sort16(x); tk_merge16(C, x); }
        { unsigned key = tk_ckey(f0[14] + f1[0], p0[14] | p1[0]); TK_INS(C, key); }
        { unsigned key = tk_ckey(f0[15] + f1[0], p0[15] | p1[0]); TK_INS(C, key); }
        float cv[16];
#pragma unroll
        for (int r = 0; r < 16; ++r) cv[r] = __uint_as_float((C[r] & 0x80000000u) ? (C[r] & 0x7FFFC000u) : (~C[r] & 0xFFFFC000u));
        const float cmax = cv[0]; float den = 0.f;
#pragma unroll
        for (int r = 0; r < 16; ++r) { cv[r] = __expf(cv[r] - cmax); den += cv[r]; }
        const float inv = 1.f / den;
        const int oi = ((((item >> 9) << 6) | (item & 63)) << 3) | ((item >> 6) & 7);
        u32x4* ido = (u32x4*)(IDS + (size_t)oi * 16); f32x4* go = (f32x4*)(GATES + (size_t)oi * 16);
#pragma unroll
        for (int q = 0; q < 4; ++q) { u32x4 o; o.x = C[4 * q] & 0x3FFFu; o.y = C[4 * q + 1] & 0x3FFFu; o.z = C[4 * q + 2] & 0x3FFFu; o.w = C[4 * q + 3] & 0x3FFFu; ido[q] = o;
            f32x4 g; g[0] = cv[4 * q] * inv; g[1] = cv[4 * q + 1] * inv; g[2] = cv[4 * q + 2] * inv; g[3] = cv[4 * q + 3] * inv; go[q] = g; }
    }
}

#define XB_TMO      128
#define XB_XCNT(j)  (256  + 64 * (j))
#define XB_XSUB(j)  (1280 + 64 * (j))
#define XB_XGEN(j)  (2304 + 64 * (j))
#define XB_TOP      3328
#define XB_TOPGEN   3392
#define XCD_BAR_WORDS 3456
#define XB_SPIN_CAP (1u << 18)
__device__ __forceinline__ unsigned xb_ld(unsigned* p)              { return __hip_atomic_load(p, __ATOMIC_RELAXED, __HIP_MEMORY_SCOPE_AGENT); }
__device__ __forceinline__ unsigned xb_add(unsigned* p, unsigned v) { return __hip_atomic_fetch_add(p, v, __ATOMIC_RELAXED, __HIP_MEMORY_SCOPE_AGENT); }
__device__ __forceinline__ unsigned xb_xcc_id() { return (unsigned)__builtin_amdgcn_s_getreg((3 << 11) | 20) & 0xFu; }
#define XB_SPIN(cond, bar) do { unsigned _sp = 0; while (cond) { __builtin_amdgcn_s_sleep(1); \
    if ((++_sp & 255u) == 0u) { if (xb_ld(&(bar)[XB_TMO])) break; if (_sp > XB_SPIN_CAP) { atomicAdd(&(bar)[XB_TMO], 1u); break; } } } } while (0)
struct XcdBarrier { unsigned* bar; unsigned x; volatile LAS unsigned* st; };
__device__ __forceinline__ XcdBarrier xcd_barrier_post(unsigned* bar, volatile LAS unsigned* st) {
    XcdBarrier b; b.bar = bar; b.x = xb_xcc_id(); b.st = st;
    if (threadIdx.x == 0) { const unsigned r = xb_add(&bar[XB_XCNT(b.x)], 1u); st[4] = r; st[5] = b.x; }
    return b;
}
__device__ __forceinline__ void xcd_barrier_complete(unsigned* bar, unsigned x, unsigned& nloc, unsigned& nx) {
    const unsigned G = gridDim.x * gridDim.y * gridDim.z;
    unsigned sum, cnt, mine, sp = 0u;
    for (;;) {
        sum = 0u; cnt = 0u; mine = 0u;
#pragma unroll
        for (unsigned j = 0; j < 16; ++j) { const unsigned c = xb_ld(&bar[XB_XCNT(j)]); sum += c; cnt += (c > 0u) ? 1u : 0u; mine = (j == x) ? c : mine; }
        if (sum == G) break;
        __builtin_amdgcn_s_sleep(1);
        if ((++sp & 255u) == 0u) { if (xb_ld(&bar[XB_TMO])) break; if (sp > XB_SPIN_CAP) { atomicAdd(&bar[XB_TMO], 1u); break; } }
    }
    nloc = mine > 0u ? mine : 1u; nx = cnt > 0u ? cnt : 1u;
}
__device__ __forceinline__ void xcd_barrier(const XcdBarrier& b) {
    asm volatile("s_waitcnt vmcnt(0)" ::: "memory");
    __syncthreads();
    if (threadIdx.x == 0) {
        unsigned* bar = b.bar;
        __builtin_amdgcn_s_waitcnt(0);
        unsigned nloc = b.st[0], nx = b.st[1];
        if (nloc == 0u) { xcd_barrier_complete(bar, b.x, nloc, nx); b.st[0] = nloc; b.st[1] = nx; }
        const unsigned old = xb_add(&bar[XB_XSUB(b.x)], 1u);
        const unsigned gen = old / nloc;
        if (old + 1u == (gen + 1u) * nloc) {
            __builtin_amdgcn_fence(__ATOMIC_RELEASE, "agent");
            asm volatile("s_waitcnt vmcnt(0)" ::: "memory");
            const unsigned og = xb_add(&bar[XB_TOP], 1u);
            const unsigned tg = og / nx;
            if (og + 1u == (tg + 1u) * nx) xb_add(&bar[XB_TOPGEN], 1u);
            else XB_SPIN(xb_ld(&bar[XB_TOPGEN]) == tg, bar);
            __builtin_amdgcn_fence(__ATOMIC_ACQUIRE, "agent");
            xb_add(&bar[XB_XGEN(b.x)], 1u);
            asm volatile("s_waitcnt vmcnt(0)" ::: "memory");
        } else {
            XB_SPIN(xb_ld(&bar[XB_XGEN(b.x)]) == gen, bar);
            __builtin_amdgcn_fence(__ATOMIC_ACQUIRE, "agent");
            asm volatile("s_waitcnt vmcnt(0)" ::: "memory");
        }
    }
    __syncthreads();
}

typedef int v8i_t __attribute__((ext_vector_type(8)));
#define PD_LO 1
struct PdTok { int idl, idh; unsigned hw; };
__device__ __forceinline__ PdTok pd_fetch(const int* IDS, const unsigned char* H8s, int m, int lane) {
    PdTok t; t.idl = IDS[(size_t)m * 128 + lane]; t.idh = IDS[(size_t)m * 128 + 64 + lane]; t.hw = *(const unsigned*)(H8s + (size_t)m * 2048); return t;
}
__device__ __forceinline__ void pd_issue(u32x4 (&X0)[8], u32x4 (&X1)[8], const PdTok& t, const unsigned char* UFs, LAS unsigned char* slot, int lane) {
#pragma unroll
    for (int g = 0; g < 8; ++g) { const unsigned id = (unsigned)__builtin_amdgcn_ds_bpermute(4 * (16 * (g & 3) + (lane >> 2)), g < 4 ? t.idl : t.idh);
        const u32x4* rp = (const u32x4*)(UFs + ((id << 7) + 16u * (unsigned)(lane & 3))); X0[g] = rp[0]; X1[g] = rp[4]; }
    *(LAS unsigned*)(slot + 4 * lane) = t.hw;
}
__device__ __forceinline__ float pd_trace(const f32x4 v) {
    const float v0 = v[0], v1 = v[1], v2 = v[2], v3 = v[3];
#define PD_BC(x, ctrl) __builtin_bit_cast(float, __builtin_amdgcn_update_dpp(0, __builtin_bit_cast(int, (x)), (ctrl), 0xf, 0xf, true))
    float s = PD_BC(v0, 0x00); s += PD_BC(v1, 0x55); s += PD_BC(v2, 0xAA); s += PD_BC(v3, 0xFF); return s;
#undef PD_BC
}
__device__ __forceinline__ void pd_compute(const u32x4 (&X0)[8], const u32x4 (&X1)[8], const LAS unsigned char* arp, unsigned* PDs, int m, int lane) {
    const int q = lane & 3;
    float dl = 0.f, dh = 0.f;
    const LAS u32x4* hp = (const LAS u32x4*)arp; const u32x4 A0 = hp[0], A1 = hp[4];
#if PD_LO
    const u32x4 A2 = hp[8], A3 = hp[12];
#endif
    const v8i_t ah = {(int)A0.x, (int)A0.y, (int)A0.z, (int)A0.w, (int)A1.x, (int)A1.y, (int)A1.z, (int)A1.w};
#if PD_LO
    const v8i_t al = {(int)A2.x, (int)A2.y, (int)A2.z, (int)A2.w, (int)A3.x, (int)A3.y, (int)A3.z, (int)A3.w};
#endif
    f32x4 acc[8];
#pragma unroll
    for (int g = 0; g < 8; ++g) { const v8i_t b = {(int)X0[g].x, (int)X0[g].y, (int)X0[g].z, (int)X0[g].w, (int)X1[g].x, (int)X1[g].y, (int)X1[g].z, (int)X1[g].w};
        acc[g] = __builtin_amdgcn_mfma_scale_f32_16x16x128_f8f6f4(ah, b, (f32x4){0.f, 0.f, 0.f, 0.f}, 0, 0, 0, 0, 0, 0); }
#if PD_LO
    __builtin_amdgcn_sched_barrier(0);
#pragma unroll
    for (int g = 0; g < 8; ++g) { const v8i_t b = {(int)X0[g].x, (int)X0[g].y, (int)X0[g].z, (int)X0[g].w, (int)X1[g].x, (int)X1[g].y, (int)X1[g].z, (int)X1[g].w};
        acc[g] = __builtin_amdgcn_mfma_scale_f32_16x16x128_f8f6f4(al, b, acc[g], 0, 0, 0, 0, 0, 0); }
#endif
    __builtin_amdgcn_sched_barrier(0);
#pragma unroll
    for (int g = 0; g < 8; ++g) { const float d = pd_trace(acc[g]);
        if (g < 4) dl = (q == g) ? d : dl; else dh = (q == g - 4) ? d : dh; }
    const int srcl = 4 * (4 * (lane & 15) + (lane >> 4));
    dl = __int_as_float(__builtin_amdgcn_ds_bpermute(srcl, __float_as_int(dl))); dh = __int_as_float(__builtin_amdgcn_ds_bpermute(srcl, __float_as_int(dh)));
    PDs[(size_t)m * 64 + lane] = pk2(dl, dh);
}
__device__ __forceinline__ void phase_peer_dots(const Params& P, LAS unsigned char* lds) {
    const int lane = threadIdx.x & 63, wave = __builtin_amdgcn_readfirstlane(threadIdx.x >> 6);
    const int* IDS = (const int*)(P.ws + WS_IDS); unsigned* PD = (unsigned*)(P.ws + WS_PD);
    volatile LAS unsigned* bst = (volatile LAS unsigned*)(lds + LDS_MISC);
    const unsigned rank = __builtin_amdgcn_readfirstlane(bst[4]), x = __builtin_amdgcn_readfirstlane(bst[5]);
    unsigned* bar = (unsigned*)(P.ws + WS_CTL);
    unsigned n = 1, xi = 0, nx = 0;
    for (unsigned j = 0; j < 16; ++j) { const unsigned cnt = __builtin_amdgcn_readfirstlane(xb_ld(&bar[XB_XCNT(j)])); if (cnt) { if (j < x) ++xi; ++nx; } if (j == x) n = cnt; }
    if (nx == 0) nx = 1; if (n == 0) n = 1;
    constexpr int NCW = NWAVES - 1;
    const int stride = (int)n * NCW; const bool arow = ((lane >> 2) & 3) == (lane >> 4);
    LAS unsigned char* slot0 = lds + wave * 512; LAS unsigned char* slot1 = slot0 + 256; LAS unsigned char* zer = lds + NWAVES * 512;
    volatile LAS unsigned* prog = (volatile LAS unsigned*)(zer + 256);
    __syncthreads();
    if (threadIdx.x < 80) ((LAS unsigned*)zer)[threadIdx.x] = 0u;
    __syncthreads();
    if (wave == NCW) {
        constexpr unsigned AHEAD = 600;
        unsigned base = 0;
        for (unsigned s = xi; s < 8; s += nx) {
            const int r7 = (int)rank * NCW; unsigned total = 0;
            for (int w = 0; w < NCW; ++w) { const int m0 = r7 + w; total += (m0 < M) ? (unsigned)((M - m0 + stride - 1) / stride) : 0u; }
            const int tk = lane / 6, ln = lane - 6 * tk;
            for (unsigned done = 0; done < total; ) {
                if (done + base < *prog + AHEAD) {
                    const unsigned char* pa[4];
#pragma unroll
                    for (int k = 0; k < 4; ++k) { unsigned j = done + 10u * k + (unsigned)(tk < 10 ? tk : 9); if (j >= total) j = total - 1;
                        const int i = (int)(j / NCW), w = (int)(j - (unsigned)i * NCW); int m = r7 + w + i * stride; if (m >= M) m = r7;
                        pa[k] = (ln < 4) ? (const unsigned char*)IDS + (size_t)m * 512 + 128 * ln : P.ws + WS_H8 + (size_t)m * 2048 + 128 * s + 1024 * (ln - 4); }
                    unsigned d0, d1, d2, d3;
                    asm volatile("global_load_dword %0, %4, off\n\tglobal_load_dword %1, %5, off\n\tglobal_load_dword %2, %6, off\n\tglobal_load_dword %3, %7, off\n\ts_waitcnt vmcnt(0)"
                                 : "=&v"(d0), "=&v"(d1), "=&v"(d2), "=&v"(d3) : "v"(pa[0]), "v"(pa[1]), "v"(pa[2]), "v"(pa[3]) : "memory");
                    done += 40;
                } else __builtin_amdgcn_s_sleep(4);
            }
            base += total;
        }
        return;
    }
    const LAS unsigned char* ar0 = arow ? slot0 + 16 * (lane & 3) : zer; const LAS unsigned char* ar1 = arow ? slot1 + 16 * (lane & 3) : zer;
    for (unsigned s = xi; s < 8; s += nx) {
        const unsigned char* UFs = P.ws + WS_UF + (size_t)s * UF_SLICE;
        const unsigned char* H8s = P.ws + WS_H8 + 128 * s + (lane < 32 ? 4 * lane : 1024 + 4 * (lane - 32)); unsigned* PDs = PD + (size_t)s * M * 64;
        const int m0 = (int)rank * NCW + wave;
        if (m0 >= M) continue;
        const int cnt = (M - m0 + stride - 1) / stride;
#define PD_TOK(i) ((i) < cnt ? m0 + (i) * stride : m0)
        u32x4 RA4[8], RB4[8], RA2[8], RB2[8];
        PdTok t0 = pd_fetch(IDS, H8s, m0, lane), t1 = pd_fetch(IDS, H8s, PD_TOK(1), lane), t2 = pd_fetch(IDS, H8s, PD_TOK(2), lane);
        pd_issue(RA4, RA2, t0, UFs, slot0, lane);
        for (int i = 0; i < cnt; i += 2) {
            const int ma = PD_TOK(i), mb = PD_TOK(i + 1);
            const PdTok t3 = pd_fetch(IDS, H8s, PD_TOK(i + 3), lane);
            pd_issue(RB4, RB2, t1, UFs, slot1, lane);
            __builtin_amdgcn_sched_barrier(0);
            pd_compute(RA4, RA2, ar0, PDs, ma, lane);
            if (lane == 0) __hip_atomic_fetch_add((LAS unsigned*)prog, 1u, __ATOMIC_RELAXED, __HIP_MEMORY_SCOPE_WORKGROUP);
            __builtin_amdgcn_sched_barrier(0);
            const PdTok t4 = pd_fetch(IDS, H8s, PD_TOK(i + 4), lane);
            pd_issue(RA4, RA2, t2, UFs, slot0, lane);
            __builtin_amdgcn_sched_barrier(0);
            pd_compute(RB4, RB2, ar1, PDs, mb, lane);
            if (lane == 0 && i + 1 < cnt) __hip_atomic_fetch_add((LAS unsigned*)prog, 1u, __ATOMIC_RELAXED, __HIP_MEMORY_SCOPE_WORKGROUP);
            __builtin_amdgcn_sched_barrier(0);
            t1 = t3; t2 = t4;
        }
#undef PD_TOK
    }
}

__device__ __forceinline__ void phase_peer_coef(const Params& P) {
    const int lane = threadIdx.x & 63, wave = threadIdx.x >> 6; const int gw = blockIdx.x * NWAVES + wave, ngw = gridDim.x * NWAVES;
    const int* IDS = (const int*)(P.ws + WS_IDS); const float* GATES = (const float*)(P.ws + WS_GATES); const unsigned* PD = (const unsigned*)(P.ws + WS_PD);
    const float* SU = (const float*)(P.ws + WS_SU); const float* SV = (const float*)(P.ws + WS_SV);
    unsigned char* CQ = P.ws + WS_CQ; float* CS = (float*)(P.ws + WS_CS);
    constexpr int TB = 4;
    for (int mb = gw; mb < M; mb += TB * ngw) {
        int id_lo[TB], id_hi[TB]; float gt_lo[TB], gt_hi[TB], d_lo[TB], d_hi[TB], su_lo[TB], su_hi[TB], sv_lo[TB], sv_hi[TB];
#pragma unroll
        for (int t = 0; t < TB; ++t) { const int m = (mb + t * ngw < M) ? mb + t * ngw : mb;
            id_lo[t] = IDS[(size_t)m * 128 + lane]; id_hi[t] = IDS[(size_t)m * 128 + 64 + lane]; gt_lo[t] = GATES[(size_t)m * 128 + lane]; gt_hi[t] = GATES[(size_t)m * 128 + 64 + lane]; }
#pragma unroll
        for (int t = 0; t < TB; ++t) { const int m = (mb + t * ngw < M) ? mb + t * ngw : mb; float a = 0.f, b = 0.f;
#pragma unroll
            for (int s = 0; s < 8; ++s) { const unsigned w = PD[((size_t)s * M + m) * 64 + lane]; a += __uint_as_float(w << 16); b += __uint_as_float(w & 0xffff0000u); }
            d_lo[t] = a; d_hi[t] = b; }
#pragma unroll
        for (int t = 0; t < TB; ++t) { su_lo[t] = SU[id_lo[t]]; su_hi[t] = SU[id_hi[t]]; sv_lo[t] = SV[id_lo[t]]; sv_hi[t] = SV[id_hi[t]]; }
#pragma unroll
        for (int t = 0; t < TB; ++t) { const int m = (mb + t * ngw < M) ? mb + t * ngw : mb;
            const float x_lo = d_lo[t] * su_lo[t], x_hi = d_hi[t] * su_hi[t];
            const float a_lo = 0.5f * x_lo * (1.f + erff(x_lo * 0.70710678118f)) * gt_lo[t] * sv_lo[t], a_hi = 0.5f * x_hi * (1.f + erff(x_hi * 0.70710678118f)) * gt_hi[t] * sv_hi[t];
            const float amx = wave_max_u(fmaxf(fabsf(a_lo), fabsf(a_hi))); const float ainv = amx > 0.f ? 127.f / amx : 0.f;
            const int q_lo = __float2int_rn(a_lo * ainv), q_hi = __float2int_rn(a_hi * ainv);
            const int j0 = lane, j1 = 64 + lane;
            CQ[(size_t)m * 128 + 16 * ((j0 >> 2) & 7) + 4 * (j0 >> 5) + (j0 & 3)] = (unsigned char)q_lo;
            CQ[(size_t)m * 128 + 16 * ((j1 >> 2) & 7) + 4 * (j1 >> 5) + (j1 & 3)] = (unsigned char)q_hi;
            if (lane == 0) CS[m] = amx * (1.f / 127.f); }
    }
}

struct AxTok { u32x4 id[4]; u32x4 cq; float cs; unsigned hw; };
__device__ __forceinline__ void ax_fetch(AxTok& t, const int* IDS, const unsigned char* CQ, const float* CS, const bf16* H1s, int m, int lane) {
    const u32x4* ip = (const u32x4*)(IDS + (size_t)m * 128) + (lane >> 3);
#pragma unroll
    for (int r = 0; r < 4; ++r) t.id[r] = ip[8 * r];
    t.cq = *((const u32x4*)(CQ + (size_t)m * 128) + (lane >> 3)); t.cs = CS[m]; t.hw = *(const unsigned*)(H1s + (size_t)m * D);
}
__device__ __forceinline__ void ax_issue(u32x4 (&W)[4], const u32x4 ids, const unsigned char* V8s, int lane) {
#pragma unroll
    for (int k = 0; k < 4; ++k) W[k] = *(const u32x4*)(V8s + ((ids[k] << 7) + 16u * (unsigned)(lane & 7)));
}
__device__ __forceinline__ void ax_round(const u32x4 (&W)[4], int c4, int (&acc)[16]) {
#pragma unroll
    for (int i = 0; i < 4; ++i) {
        const unsigned t0 = __builtin_amdgcn_perm(W[1][i], W[0][i], 0x05010400u), t1 = __builtin_amdgcn_perm(W[1][i], W[0][i], 0x07030602u);
        const unsigned t2 = __builtin_amdgcn_perm(W[3][i], W[2][i], 0x05010400u), t3 = __builtin_amdgcn_perm(W[3][i], W[2][i], 0x07030602u);
        const unsigned T0 = __builtin_amdgcn_perm(t2, t0, 0x05040100u), T1 = __builtin_amdgcn_perm(t2, t0, 0x07060302u), T2 = __builtin_amdgcn_perm(t3, t1, 0x05040100u), T3 = __builtin_amdgcn_perm(t3, t1, 0x07060302u);
        acc[4 * i] = __builtin_amdgcn_sdot4((int)T0, c4, acc[4 * i], false); acc[4 * i + 1] = __builtin_amdgcn_sdot4((int)T1, c4, acc[4 * i + 1], false);
        acc[4 * i + 2] = __builtin_amdgcn_sdot4((int)T2, c4, acc[4 * i + 2], false); acc[4 * i + 3] = __builtin_amdgcn_sdot4((int)T3, c4, acc[4 * i + 3], false); }
}
__device__ __forceinline__ void ax_finish(int (&acc)[16], float cs, unsigned hw, bf16* ZPs, int m, int lane) {
    const bool b3 = (lane & 8) != 0, b4 = (lane & 16) != 0, b5 = (lane & 32) != 0;
    int w8[8], w4[4], w2[2];
#pragma unroll
    for (int i = 0; i < 8; ++i) { const int keep = b3 ? acc[i + 8] : acc[i], send = b3 ? acc[i] : acc[i + 8]; w8[i] = keep + DPP_I(send, 0x128); }
#pragma unroll
    for (int i = 0; i < 4; ++i) { const int keep = b4 ? w8[i + 4] : w8[i], send = b4 ? w8[i] : w8[i + 4]; w4[i] = keep + __builtin_amdgcn_ds_swizzle(send, 0x401F); }
#pragma unroll
    for (int i = 0; i < 2; ++i) { const int keep = b5 ? w4[i + 2] : w4[i], send = b5 ? w4[i] : w4[i + 2]; w2[i] = keep + __shfl_xor(send, 32); }
    const float z0 = ALPHA * __uint_as_float(hw << 16) + cs * (float)w2[0], z1 = ALPHA * __uint_as_float(hw & 0xffff0000u) + cs * (float)w2[1];
    const int d0 = 16 * (lane & 7) + (b3 ? 8 : 0) + (b4 ? 4 : 0) + (b5 ? 2 : 0);
    *(unsigned*)(ZPs + (size_t)m * D + d0) = pk2(z0, z1);
}
__device__ __forceinline__ void phase_peer_axpy(const Params& P, LAS unsigned char* lds) {
    const int lane = threadIdx.x & 63, wave = __builtin_amdgcn_readfirstlane(threadIdx.x >> 6);
    const int* IDS = (const int*)(P.ws + WS_IDS); const unsigned char* CQ = P.ws + WS_CQ; const float* CS = (const float*)(P.ws + WS_CS);
    volatile LAS unsigned* bst = (volatile LAS unsigned*)(lds + LDS_MISC);
    const unsigned rank = __builtin_amdgcn_readfirstlane(bst[4]), x = __builtin_amdgcn_readfirstlane(bst[5]);
    unsigned* bar = (unsigned*)(P.ws + WS_CTL);
    unsigned n = 1, xi = 0, nx = 0;
    for (unsigned j = 0; j < 16; ++j) { const unsigned cnt = __builtin_amdgcn_readfirstlane(xb_ld(&bar[XB_XCNT(j)])); if (cnt) { if (j < x) ++xi; ++nx; } if (j == x) n = cnt; }
    if (nx == 0) nx = 1; if (n == 0) n = 1;
    constexpr int NCW = NWAVES - 1;
    const int stride = (int)n * NCW;
    volatile LAS unsigned* prog = (volatile LAS unsigned*)lds;
    __syncthreads();
    if (threadIdx.x == 0) *prog = 0u;
    __syncthreads();
    if (wave == NCW) {
        constexpr unsigned AHEAD = 600;
        unsigned base = 0;
        for (unsigned s = xi; s < 8; s += nx) {
            const int r7 = (int)rank * NCW; unsigned total = 0;
            for (int w = 0; w < NCW; ++w) { const int m0 = r7 + w; total += (m0 < M) ? (unsigned)((M - m0 + stride - 1) / stride) : 0u; }
            const int tk = lane >> 3, ln = lane & 7;
            for (unsigned done = 0; done < total; ) {
                if (done + base < *prog + AHEAD) {
                    const unsigned char* pa[4];
#pragma unroll
                    for (int k = 0; k < 4; ++k) { unsigned j = done + 8u * k + (unsigned)tk; if (j >= total) j = total - 1;
                        const int i = (int)(j / NCW), w = (int)(j - (unsigned)i * NCW); int m = r7 + w + i * stride; if (m >= M) m = r7;
                        pa[k] = (ln < 4) ? (const unsigned char*)IDS + (size_t)m * 512 + 128 * ln : (ln == 4) ? CQ + (size_t)m * 128 : (ln < 7) ? P.ws + WS_H1 + (size_t)m * 2048 + 256 * s + 128 * (ln - 5) : (const unsigned char*)(CS + m); }
                    unsigned d0, d1, d2, d3;
                    asm volatile("global_load_dword %0, %4, off\n\tglobal_load_dword %1, %5, off\n\tglobal_load_dword %2, %6, off\n\tglobal_load_dword %3, %7, off\n\ts_waitcnt vmcnt(0)"
                                 : "=&v"(d0), "=&v"(d1), "=&v"(d2), "=&v"(d3) : "v"(pa[0]), "v"(pa[1]), "v"(pa[2]), "v"(pa[3]) : "memory");
                    done += 32;
                } else __builtin_amdgcn_s_sleep(4);
            }
            base += total;
        }
        return;
    }
    const int dsel = 16 * (lane & 7) + ((lane & 8) ? 8 : 0) + ((lane & 16) ? 4 : 0) + ((lane & 32) ? 2 : 0);
    for (unsigned s = xi; s < 8; s += nx) {
        const unsigned char* V8s = P.ws + WS_V8 + (size_t)s * V8_SLICE;
        const bf16* H1s = (const bf16*)(P.ws + WS_H1) + 128 * s + dsel; bf16* ZPs = (bf16*)(P.ws + WS_ZP) + 128 * s;
        const int m0 = (int)rank * NCW + wave;
        if (m0 >= M) continue;
        const int cnt = (M - m0 + stride - 1) / stride;
#define AX_TOK(i) ((i) < cnt ? m0 + (i) * stride : m0)
        u32x4 W0[4], W1[4], W2[4], W3[4];
        AxTok ta, tb, tc; ax_fetch(ta, IDS, CQ, CS, H1s, m0, lane); ax_fetch(tb, IDS, CQ, CS, H1s, AX_TOK(1), lane);
        ax_issue(W0, ta.id[0], V8s, lane); ax_issue(W1, ta.id[1], V8s, lane); ax_issue(W2, ta.id[2], V8s, lane);
#define AX_STEP(CUR, NXT, FRE, ii) do { \
            const int ma_ = AX_TOK(ii); \
            ax_fetch(FRE, IDS, CQ, CS, H1s, AX_TOK((ii) + 2), lane); \
            int acc[16]; \
            _Pragma("unroll") for (int j = 0; j < 16; ++j) acc[j] = 0; \
            ax_issue(W3, CUR.id[3], V8s, lane); __builtin_amdgcn_sched_barrier(0); ax_round(W0, (int)CUR.cq[0], acc); __builtin_amdgcn_sched_barrier(0); \
            ax_issue(W0, NXT.id[0], V8s, lane); __builtin_amdgcn_sched_barrier(0); ax_round(W1, (int)CUR.cq[1], acc); __builtin_amdgcn_sched_barrier(0); \
            ax_issue(W1, NXT.id[1], V8s, lane); __builtin_amdgcn_sched_barrier(0); ax_round(W2, (int)CUR.cq[2], acc); __builtin_amdgcn_sched_barrier(0); \
            ax_issue(W2, NXT.id[2], V8s, lane); __builtin_amdgcn_sched_barrier(0); ax_round(W3, (int)CUR.cq[3], acc); __builtin_amdgcn_sched_barrier(0); \
            ax_finish(acc, CUR.cs, CUR.hw, ZPs, ma_, lane); \
            if (lane == 0 && (ii) < cnt) __hip_atomic_fetch_add((LAS unsigned*)prog, 1u, __ATOMIC_RELAXED, __HIP_MEMORY_SCOPE_WORKGROUP); } while (0)
        for (int i = 0; i < cnt; i += 3) { AX_STEP(ta, tb, tc, i); AX_STEP(tb, tc, ta, i + 1); AX_STEP(tc, ta, tb, i + 2); }
#undef AX_STEP
#undef AX_TOK
    }
}

__device__ __forceinline__ void phase_ln2(const Params& P) {
    const int lane = threadIdx.x & 63, wave = threadIdx.x >> 6; const int gw = blockIdx.x * NWAVES + wave, ngw = gridDim.x * NWAVES;
    const float* g2 = P.in[26]; const float* b2 = P.in[27]; const bf16* ZP = (const bf16*)(P.ws + WS_ZP);
    for (int m = gw; m < M; m += ngw) {
        const u32x4* xr = (const u32x4*)(ZP + (size_t)m * D) + 2 * lane; const u32x4 a = xr[0], c = xr[1]; float v[16]; float s = 0.f;
#pragma unroll
        for (int i = 0; i < 4; ++i) { v[2 * i] = __uint_as_float(a[i] << 16); v[2 * i + 1] = __uint_as_float(a[i] & 0xffff0000u); v[8 + 2 * i] = __uint_as_float(c[i] << 16); v[8 + 2 * i + 1] = __uint_as_float(c[i] & 0xffff0000u); }
#pragma unroll
        for (int i = 0; i < 16; ++i) s += v[i];
        const float mean = wave_sum(s) * (1.f / D); float s2 = 0.f;
#pragma unroll
        for (int i = 0; i < 16; ++i) { v[i] -= mean; s2 += v[i] * v[i]; }
        const float rstd = 1.f / sqrtf(wave_sum(s2) * (1.f / D) + LN_EPS);
#pragma unroll
        for (int c4 = 0; c4 < 4; ++c4) { const int e0 = 16 * lane + 4 * c4; const f32x4 gg = *(const f32x4*)(g2 + e0), bb = *(const f32x4*)(b2 + e0); f32x4 o;
#pragma unroll
            for (int j = 0; j < 4; ++j) o[j] = v[c4 * 4 + j] * rstd * gg[j] + bb[j];
            *(f32x4*)(P.out + (size_t)m * D + e0) = o; }
    }
}

constexpr int N_PHASES = 14;
__global__ void __launch_bounds__(NTHR, 2) fwd_kernel(Params P) {
    extern __shared__ __attribute__((aligned(16))) unsigned char lds_raw[];
    LAS unsigned char* lds = (LAS unsigned char*)lds_raw;
    cg::grid_group grid = cg::this_grid();
    const int lo = P.ph_lo, hi = P.ph_hi;
    unsigned char* ws = P.ws;
    volatile LAS unsigned* bst = (volatile LAS unsigned*)(lds + LDS_MISC);
    if (threadIdx.x < 16) bst[threadIdx.x] = 0u;
    __syncthreads();
    const XcdBarrier bar = xcd_barrier_post((unsigned*)(ws + WS_CTL), bst);
#define IN(k) (lo <= (k) && (k) < hi)
#define SEAM(k) do { if (IN(k) && IN((k) + 1)) { if ((k) == 0) grid.sync(); else xcd_barrier(bar); } } while (0)
    if (IN(0)) phase_prologue(P, lds);
    SEAM(0);
    if (IN(1)) {
        pg8::Gemm g{(const bf16*)(ws + WS_H0), (const bf16*)(ws + WS_WIN), M, NP, D, D, D, 0}; pg8::StaticOrder S; S.init(M, NP, gridDim.x, blockIdx.x);
        pg8::EpiBf16 E{(bf16*)(ws + WS_P), NP};
        pg8::gemm_phase<pg8::EpiBf16, pg8::StaticOrder, true, true>(lds, g, S, E);
    }
    SEAM(1);
    if (IN(2)) phase_prep(P, lds);
    SEAM(2);
    if (IN(3)) phase_scan(P, lds);
    SEAM(3);
    if (IN(4)) phase_fixup(P, lds);
    SEAM(4);
    if (IN(5)) phase_correct(P, lds);
    SEAM(5);
    if (IN(6)) {
        pg8::Gemm g{(const bf16*)P.out, (const bf16*)(ws + WS_WOUT), M, D, D, D, D, 0}; pg8::StaticOrder S; S.init(M, D, gridDim.x, blockIdx.x);
        pg8::EpiResBf16 E{(bf16*)(ws + WS_Z), (const bf16*)(ws + WS_H0), D, ALPHA};
        pg8::gemm_phase<pg8::EpiResBf16, pg8::StaticOrder, true, true>(lds, g, S, E);
    }
    SEAM(6);
    if (IN(7)) phase_ln1(P);
    SEAM(7);
    if (IN(8)) {
        pg8::Gemm g{(const bf16*)(ws + WS_H1), (const bf16*)(ws + WS_WQ), M, NQ, D, D, D, 0}; pg8::StaticOrder S; S.init(M, NQ, gridDim.x, blockIdx.x);
        pg8::EpiScores E{(bf16*)(ws + WS_S)};
        pg8::gemm_phase<pg8::EpiScores, pg8::StaticOrder, true, true>(lds, g, S, E);
    }
    SEAM(8);
    if (IN(9)) phase_topk(P);
    SEAM(9);
    if (IN(10)) phase_peer_dots(P, lds);
    SEAM(10);
    if (IN(11)) phase_peer_coef(P);
    SEAM(11);
    if (IN(12)) phase_peer_axpy(P, lds);
    SEAM(12);
    if (IN(13)) phase_ln2(P);
#undef IN
#undef SEAM
}

extern "C" void kernel_launch(void* const* d_in, const int* in_sizes, int n_in, void* d_out, int out_size, void* d_ws, size_t ws_size, hipStream_t stream) {
    static int grid = 0;
    if (grid == 0) {
        if (n_in != 28 || out_size != M * D || ws_size < WS_END) { fprintf(stderr, "kernel_launch: unexpected shapes (n_in %d out %d ws %zu)\n", n_in, out_size, ws_size); grid = -1; return; }
        int dev = 0, cus = 0, per_cu = 0;
        (void)hipGetDevice(&dev); (void)hipDeviceGetAttribute(&cus, hipDeviceAttributeMultiprocessorCount, dev);
        (void)hipFuncSetAttribute((const void*)fwd_kernel, hipFuncAttributeMaxDynamicSharedMemorySize, LDS_BYTES);
        (void)hipOccupancyMaxActiveBlocksPerMultiprocessor(&per_cu, (const void*)fwd_kernel, NTHR, LDS_BYTES);
        if (per_cu < 1) { fprintf(stderr, "kernel_launch: occupancy query says %d blocks per CU\n", per_cu); per_cu = 1; }
        (void)hipGetLastError();
        grid = cus;
    }
    if (grid < 0) return;
    Params p{};
    for (int i = 0; i < 28; ++i) p.in[i] = (const float*)d_in[i];
    p.out = (float*)d_out; p.ws = (unsigned char*)d_ws;
    (void)hipMemsetAsync((char*)d_ws + WS_CTL, 0, CTL_BYTES, stream);
    p.ph_lo = 0; p.ph_hi = N_PHASES;
    void* args[] = {&p};
    hipError_t e = hipLaunchCooperativeKernel((const void*)fwd_kernel, dim3(grid), dim3(NTHR), args, LDS_BYTES, stream);
    if (e != hipSuccess) fprintf(stderr, "cooperative launch failed: %s (grid %d)\n", hipGetErrorString(e), grid);
}
```

```cpp
#include <hip/hip_runtime.h>
#include <hip/hip_cooperative_groups.h>
#include <cstdio>
#include <cstdint>
namespace cg = cooperative_groups;

namespace pg8 {
#define PG8_LAS __attribute__((address_space(3)))
typedef unsigned short bf16_t;
typedef short bf16x8 __attribute__((ext_vector_type(8)));
typedef float f32x4 __attribute__((ext_vector_type(4)));
typedef float f32x2 __attribute__((ext_vector_type(2)));
typedef unsigned u32x4 __attribute__((ext_vector_type(4)));
typedef unsigned u32x2 __attribute__((ext_vector_type(2)));
constexpr int BM = 256, BK = 64, HALF = 128, HTB = HALF * BK * 2, STAGE_BYTES = 8 * HTB, NXCD = 8, WGM = 8;

__host__ __device__ __forceinline__ int lds_byte(int r, int c) { const int st = (r >> 4) * 2 + (c >> 5), rr = r & 15, cc = c & 31, ob = rr * 64 + cc * 2; return st * 1024 + (ob ^ (((ob >> 9) & 1) << 5)); }
__host__ __device__ __forceinline__ void stage_rc(int b, int& R, int& C) { const int st = b / 1024, sb = b % 1024, swz = sb ^ (((sb >> 9) & 1) << 5); R = (st >> 1) * 16 + swz / 64; C = (st & 1) * 32 + (swz % 64) / 2; }
__host__ __device__ __forceinline__ int perm32(int rho) { const int n = rho >> 4, i = rho & 15; return 8 * (i >> 2) + 4 * n + (i & 3); }

struct Unit { int pm, pn; };
struct Gemm { const bf16_t* A; const bf16_t* Bt; int M, N, K, lda, ldb, a_pn_koff; };

struct StaticOrder {
    int nM, nN, nwg, G, c;
    __host__ __device__ void init(int M, int N, int G_, int c_) { nM = M / BM; nN = N / BM; nwg = nM * nN; G = G_; c = c_; }
    __host__ __device__ bool next(int i, Unit& u) const {
        const long L = (long)i * G + c; if (L >= nwg) return false;
        int wgid = (int)L; { const int q = nwg / NXCD, r = nwg % NXCD, xcd = wgid % NXCD, off = wgid / NXCD; wgid = (xcd < r ? xcd * (q + 1) : r * (q + 1) + (xcd - r) * q) + off; }
        const int nig = WGM * nN, gid = wgid / nig, fm = gid * WGM, gsz = (nM - fm) < WGM ? (nM - fm) : WGM;
        u.pm = fm + ((wgid % nig) % gsz); u.pn = (wgid % nig) / gsz; return true;
    }
    __device__ __forceinline__ void a_ready(const Unit&) const {}
    __device__ __forceinline__ void done(const Unit&) const {}
};

typedef float f32x2p_t __attribute__((ext_vector_type(2))); typedef __bf16 bf16x2p_t __attribute__((ext_vector_type(2)));
__device__ __forceinline__ unsigned cvt_pk_bf16(float lo, float hi) { const f32x2p_t v = {lo, hi}; const bf16x2p_t b = __builtin_convertvector(v, bf16x2p_t); return __builtin_bit_cast(unsigned, b); }

struct EpiScores {
    static constexpr bool PERM = true;
    bf16_t* O;
    __device__ __forceinline__ void operator()(const f32x4 (&acc)[2][2][4][2], const Unit& u, int wr, int wc, int fr, int fq) const {
        const int row0 = u.pm * BM + wr * 64 + fr;
#pragma unroll
        for (int ai = 0; ai < 2; ++ai)
#pragma unroll
            for (int m = 0; m < 4; ++m) { const int row = row0 + ai * HALF + m * 16;
                bf16_t* tp = O + ((size_t)((row >> 6) * (2048 / BM) + u.pn) * 32 * 64 + (row & 63)) * 8;
#pragma unroll
                for (int bj = 0; bj < 2; ++bj) { const f32x4 v0 = acc[ai][bj][m][0], v1 = acc[ai][bj][m][1];
                    u32x4 w; w.x = cvt_pk_bf16(v0[0], v0[1]); w.y = cvt_pk_bf16(v0[2], v0[3]); w.z = cvt_pk_bf16(v1[0], v1[1]); w.w = cvt_pk_bf16(v1[2], v1[3]);
                    *(u32x4*)(tp + (size_t)(4 * wc + fq + 16 * bj) * 64 * 8) = w; } }
    }
};
struct EpiBf16 {
    static constexpr bool PERM = true;
    bf16_t* O; int ldc;
    __device__ __forceinline__ void operator()(const f32x4 (&acc)[2][2][4][2], const Unit& u, int wr, int wc, int fr, int fq) const {
        const int row0 = u.pm * BM + wr * 64 + fr; const int col0 = u.pn * BM + wc * 32 + 8 * fq;
#pragma unroll
        for (int ai = 0; ai < 2; ++ai)
#pragma unroll
            for (int m = 0; m < 4; ++m) { bf16_t* rowp = O + (size_t)(row0 + ai * HALF + m * 16) * ldc + col0;
#pragma unroll
                for (int bj = 0; bj < 2; ++bj) { const f32x4 v0 = acc[ai][bj][m][0], v1 = acc[ai][bj][m][1];
                    u32x4 w; w.x = cvt_pk_bf16(v0[0], v0[1]); w.y = cvt_pk_bf16(v0[2], v0[3]); w.z = cvt_pk_bf16(v1[0], v1[1]); w.w = cvt_pk_bf16(v1[2], v1[3]);
                    *(u32x4*)(rowp + bj * HALF) = w; } }
    }
};
struct EpiResBf16 {
    static constexpr bool PERM = true;
    bf16_t* Z; const bf16_t* R; int ldc; float alpha;
    __device__ __forceinline__ void operator()(const f32x4 (&acc)[2][2][4][2], const Unit& u, int wr, int wc, int fr, int fq) const {
        const int row0 = u.pm * BM + wr * 64 + fr; const int col0 = u.pn * BM + wc * 32 + 8 * fq;
#pragma unroll
        for (int ai = 0; ai < 2; ++ai)
#pragma unroll
            for (int m = 0; m < 4; ++m) { const size_t off = (size_t)(row0 + ai * HALF + m * 16) * ldc + col0;
#pragma unroll
                for (int bj = 0; bj < 2; ++bj) { const u32x4 rb = *(const u32x4*)(R + off + bj * HALF); const f32x4 v0 = acc[ai][bj][m][0], v1 = acc[ai][bj][m][1];
                    u32x4 w;
                    w.x = cvt_pk_bf16(__uint_as_float(rb.x << 16) * alpha + v0[0], __uint_as_float(rb.x & 0xffff0000u) * alpha + v0[1]);
                    w.y = cvt_pk_bf16(__uint_as_float(rb.y << 16) * alpha + v0[2], __uint_as_float(rb.y & 0xffff0000u) * alpha + v0[3]);
                    w.z = cvt_pk_bf16(__uint_as_float(rb.z << 16) * alpha + v1[0], __uint_as_float(rb.z & 0xffff0000u) * alpha + v1[1]);
                    w.w = cvt_pk_bf16(__uint_as_float(rb.w << 16) * alpha + v1[2], __uint_as_float(rb.w & 0xffff0000u) * alpha + v1[3]);
                    *(u32x4*)(Z + off + bj * HALF) = w; } }
    }
};
template <class Epi, class Sched, bool ALIGN_EPI = false, bool SP2 = false>
__device__ __forceinline__ void gemm_phase(PG8_LAS unsigned char* lds, const Gemm g, const Sched& S, const Epi& E) {
    const int tid = threadIdx.x, wid = __builtin_amdgcn_readfirstlane(tid >> 6), lane = tid & 63, wr = wid >> 2, wc = wid & 3, fr = lane & 15, fq = lane >> 4;
    const int K = g.K, nt = K / BK;
    unsigned voffA[2], voffB[2];
#pragma unroll
    for (int i = 0; i < 2; ++i) { int R, C; stage_rc(tid * 16 + i * 8192, R, C); const int Rb = Epi::PERM ? ((R & ~31) + perm32(R & 31)) : R;
        voffA[i] = (unsigned)(R * g.lda + C) * 2u; voffB[i] = (unsigned)(Rb * g.ldb + C) * 2u; }
    const size_t kstep = (size_t)(BK * 2);
    const size_t hstepA = (size_t)HALF * g.lda * 2, hstepB = (size_t)HALF * g.ldb * 2;
    const size_t tstepA = 2 * hstepA, tstepB = 2 * hstepB;
    const size_t pnA = (size_t)g.a_pn_koff * 2;
    const unsigned ldsw = (unsigned)wid * 1024u;
    const int aoff = lds_byte(wr * 64 + fr, fq * 8), boff = lds_byte(wc * 32 + fr, fq * 8);
#define PG8_SA(b, h) (((b) * 2 + (h)) * HTB)
#define PG8_SB(b, h) ((4 + (b) * 2 + (h)) * HTB)
#define PG8_STAGE(bufoff, gbase, voff) do { _Pragma("unroll") for (int _i = 0; _i < 2; ++_i) \
        __builtin_amdgcn_global_load_lds((const unsigned*)((const char*)(gbase) + (voff)[_i]), (PG8_LAS unsigned*)(lds + (bufoff) + ldsw + _i * 8192), 16, 0, 0); } while (0)
#define PG8_LDA(dst, b, h) do { _Pragma("unroll") for (int m = 0; m < 4; ++m) _Pragma("unroll") for (int k = 0; k < 2; ++k) dst[m][k] = *(const PG8_LAS bf16x8*)(lds + PG8_SA(b, h) + aoff + m * 2048 + k * 1024); } while (0)
#define PG8_LDB(dst, b, h) do { _Pragma("unroll") for (int n = 0; n < 2; ++n) _Pragma("unroll") for (int k = 0; k < 2; ++k) dst[n][k] = *(const PG8_LAS bf16x8*)(lds + PG8_SB(b, h) + boff + n * 2048 + k * 1024); } while (0)
#define PG8_MMA(ai, bj, At, Bt) do { __builtin_amdgcn_s_setprio(1); _Pragma("unroll") for (int m = 0; m < 4; ++m) _Pragma("unroll") for (int n = 0; n < 2; ++n) _Pragma("unroll") for (int k = 0; k < 2; ++k) \
        acc[ai][bj][m][n] = __builtin_amdgcn_mfma_f32_16x16x32_bf16(Bt[n][k], At[m][k], acc[ai][bj][m][n], 0, 0, 0); __builtin_amdgcn_s_setprio(0); } while (0)
#define PG8_WAIT_V(n) asm volatile("s_waitcnt vmcnt(" #n ")" ::: "memory")
#define PG8_WAIT_L(n) asm volatile("s_waitcnt lgkmcnt(" #n ")" ::: "memory")
#define PG8_BAR __builtin_amdgcn_s_barrier()
#define PG8_SCHED __builtin_amdgcn_sched_barrier(0)
    Unit cur, nxt; int ui = 0;
    if (!S.next(0, cur)) return;
    f32x4 acc[2][2][4][2];
#pragma unroll
    for (int a = 0; a < 2; ++a)
#pragma unroll
        for (int b = 0; b < 2; ++b)
#pragma unroll
            for (int m = 0; m < 4; ++m)
#pragma unroll
                for (int n = 0; n < 2; ++n) acc[a][b][m][n] = (f32x4){0.f, 0.f, 0.f, 0.f};
    bf16x8 At[4][2], B0[2][2], B1[2][2];
    const char* cA = (const char*)g.A + (size_t)cur.pm * tstepA + (size_t)cur.pn * pnA; const char* cB = (const char*)g.Bt + (size_t)cur.pn * tstepB;
    S.a_ready(cur);
    if constexpr (SP2) {
        PG8_STAGE(PG8_SB(0, 0), cB, voffB); PG8_STAGE(PG8_SB(0, 1), cB + hstepB, voffB); PG8_STAGE(PG8_SA(0, 0), cA, voffA); PG8_STAGE(PG8_SA(0, 1), cA + hstepA, voffA);
        if (wr == 1) PG8_BAR;
        PG8_WAIT_V(2); PG8_BAR;
        PG8_STAGE(PG8_SB(1, 0), cB + kstep, voffB); PG8_STAGE(PG8_SA(1, 0), cA + kstep, voffA); PG8_STAGE(PG8_SB(1, 1), cB + hstepB + kstep, voffB);
        PG8_WAIT_V(6); PG8_BAR;
    } else {
        PG8_STAGE(PG8_SB(0, 0), cB, voffB); PG8_STAGE(PG8_SA(0, 0), cA, voffA); PG8_STAGE(PG8_SB(0, 1), cB + hstepB, voffB); PG8_STAGE(PG8_SA(0, 1), cA + hstepA, voffA);
        if (wr == 1) PG8_BAR;
        PG8_WAIT_V(4); PG8_BAR;
        PG8_STAGE(PG8_SB(1, 0), cB + kstep, voffB); PG8_STAGE(PG8_SA(1, 0), cA + kstep, voffA); PG8_STAGE(PG8_SB(1, 1), cB + hstepB + kstep, voffB);
        PG8_WAIT_V(6); PG8_BAR;
    }
    for (;;) {
        const bool has_next = S.next(ui + 1, nxt);
        const char* nA = has_next ? (const char*)g.A + (size_t)nxt.pm * tstepA + (size_t)nxt.pn * pnA : cA; const char* nB = has_next ? (const char*)g.Bt + (size_t)nxt.pn * tstepB : cB;
        for (int t = 0; t < nt; t += 2) {
            const bool last = (t == nt - 2);
            const char* a1 = cA + (size_t)(t + 1) * kstep;
            const char* a2 = last ? nA : cA + (size_t)(t + 2) * kstep; const char* b2 = last ? nB : cB + (size_t)(t + 2) * kstep;
            const char* a3 = a2 + kstep; const char* b3 = b2 + kstep;
            if (last && has_next) S.a_ready(nxt);
            if constexpr (SP2) {
            PG8_LDB(B0, 0, 0); PG8_LDB(B1, 0, 1); PG8_SCHED; PG8_LDA(At, 0, 0); PG8_STAGE(PG8_SA(1, 1), a1 + hstepA, voffA);
            PG8_WAIT_V(8); PG8_WAIT_L(0); PG8_BAR; PG8_MMA(0, 0, At, B0); PG8_MMA(0, 1, At, B1); PG8_BAR; PG8_SCHED;
            PG8_LDA(At, 0, 1); PG8_STAGE(PG8_SB(0, 0), b2, voffB); PG8_STAGE(PG8_SB(0, 1), b2 + hstepB, voffB); PG8_STAGE(PG8_SA(0, 0), a2, voffA);
            PG8_WAIT_V(8); PG8_WAIT_L(0); PG8_BAR; PG8_MMA(1, 0, At, B0); PG8_MMA(1, 1, At, B1); PG8_BAR; PG8_SCHED;
            PG8_LDB(B0, 1, 0); PG8_LDB(B1, 1, 1); PG8_SCHED; PG8_LDA(At, 1, 0); PG8_STAGE(PG8_SA(0, 1), a2 + hstepA, voffA);
            PG8_WAIT_V(8); PG8_WAIT_L(0); PG8_BAR; PG8_MMA(0, 0, At, B0); PG8_MMA(0, 1, At, B1); PG8_BAR; PG8_SCHED;
            PG8_LDA(At, 1, 1); PG8_STAGE(PG8_SB(1, 0), b3, voffB); PG8_STAGE(PG8_SB(1, 1), b3 + hstepB, voffB); PG8_STAGE(PG8_SA(1, 0), a3, voffA);
            PG8_WAIT_V(8); PG8_WAIT_L(0); PG8_BAR; PG8_MMA(1, 0, At, B0); PG8_MMA(1, 1, At, B1); PG8_BAR; PG8_SCHED;
            } else {
            PG8_LDB(B0, 0, 0); PG8_SCHED; PG8_LDA(At, 0, 0); PG8_STAGE(PG8_SA(1, 1), a1 + hstepA, voffA);
            PG8_WAIT_L(8); PG8_BAR; PG8_WAIT_L(0); PG8_MMA(0, 0, At, B0); PG8_BAR; PG8_SCHED;
            PG8_LDB(B1, 0, 1); PG8_STAGE(PG8_SB(0, 0), b2, voffB);
            PG8_BAR; PG8_WAIT_L(0); PG8_MMA(0, 1, At, B1); PG8_BAR;
            PG8_LDA(At, 0, 1); PG8_STAGE(PG8_SA(0, 0), a2, voffA);
            PG8_BAR; PG8_WAIT_L(0); PG8_MMA(1, 0, At, B0); PG8_BAR; PG8_SCHED;
            PG8_STAGE(PG8_SB(0, 1), b2 + hstepB, voffB);
            PG8_WAIT_V(6); PG8_BAR; PG8_MMA(1, 1, At, B1); PG8_BAR;
            PG8_LDB(B0, 1, 0); PG8_SCHED; PG8_LDA(At, 1, 0); PG8_STAGE(PG8_SA(0, 1), a2 + hstepA, voffA);
            PG8_WAIT_L(8); PG8_BAR; PG8_WAIT_L(0); PG8_MMA(0, 0, At, B0); PG8_BAR; PG8_SCHED;
            PG8_LDB(B1, 1, 1); PG8_STAGE(PG8_SB(1, 0), b3, voffB);
            PG8_BAR; PG8_WAIT_L(0); PG8_MMA(0, 1, At, B1); PG8_BAR;
            PG8_LDA(At, 1, 1); PG8_STAGE(PG8_SA(1, 0), a3, voffA);
            PG8_BAR; PG8_WAIT_L(0); PG8_MMA(1, 0, At, B0); PG8_BAR; PG8_SCHED;
            PG8_STAGE(PG8_SB(1, 1), b3 + hstepB, voffB);
            PG8_WAIT_V(6); PG8_BAR; PG8_MMA(1, 1, At, B1); PG8_BAR;
            }
        }
        if constexpr (ALIGN_EPI) { if (wr == 0) PG8_BAR; }
        E(acc, cur, wr, wc, fr, fq); S.done(cur);
        if (!has_next) break;
#pragma unroll
        for (int a = 0; a < 2; ++a)
#pragma unroll
            for (int b = 0; b < 2; ++b)
#pragma unroll
                for (int m = 0; m < 4; ++m)
#pragma unroll
                    for (int n = 0; n < 2; ++n) acc[a][b][m][n] = (f32x4){0.f, 0.f, 0.f, 0.f};
        cur = nxt; cA = nA; cB = nB; ++ui;
        if constexpr (ALIGN_EPI) { if (wr == 1) PG8_BAR; }
    }
    PG8_WAIT_V(0);
    if constexpr (!ALIGN_EPI) { if (wr == 0) PG8_BAR; }
    PG8_BAR;
#undef PG8_SA
#undef PG8_SB
#undef PG8_STAGE
#undef PG8_LDA
#undef PG8_LDB
#undef PG8_MMA
#undef PG8_WAIT_V
#undef PG8_WAIT_L
#undef PG8_BAR
#undef PG8_SCHED
}
}

constexpr int NWAVES = 8, NTHR = NWAVES * 64;
constexpr int D = 1024, NBATCH = 4, T = 8192, M = NBATCH * T;
constexpr int A_W = 512, A_IN = 1792, IN_COLS = 3344, NP = 3584;
constexpr int C_R = 0, C_K = 512, C_V = 1024, C_WD = 1536, C_AD = 1600, C_GD = 1664;
constexpr int C_BQ = 1792, C_BK = 2048, C_BV = 2304, C_GKD = 2816, C_BG = 2832;
constexpr int NQ = 2048;
constexpr float LN_EPS = 1e-5f, GN_EPS = 64e-5f, RMS_EPS = 1e-5f;
constexpr float ALPHA = 1.189207115002721f;

typedef unsigned short bf16;
typedef float f32x4 __attribute__((ext_vector_type(4)));
typedef float f32x2 __attribute__((ext_vector_type(2)));
typedef unsigned u32x4 __attribute__((ext_vector_type(4)));
typedef unsigned u32x2 __attribute__((ext_vector_type(2)));
#define LAS __attribute__((address_space(3)))

constexpr size_t MiB = 1u << 20;
constexpr size_t WS_WIN = 1 * MiB, WS_WOUT = 8 * MiB, WS_WQ = 10 * MiB, WS_KBD = 14 * MiB;
constexpr size_t WS_W2T = 15 * MiB, WS_A2T = WS_W2T + 65536, WS_G2T = WS_A2T + 65536;
constexpr size_t WS_H0 = 16 * MiB;
constexpr size_t WS_P = 80 * MiB;
constexpr size_t WS_WL = 304 * MiB, WS_AA = 336 * MiB, WS_GG = 368 * MiB;
constexpr size_t WS_GK = 400 * MiB;
constexpr size_t WS_Z = 80 * MiB;
constexpr size_t WS_H1 = 208 * MiB;
constexpr size_t WS_Q = 272 * MiB;
constexpr size_t WS_S = 80 * MiB;
constexpr size_t WS_IDS = 400 * MiB, WS_GATES = 416 * MiB;
constexpr size_t WS_UT = 432 * MiB, WS_VT = 448 * MiB;
constexpr int ROWB = 768;
constexpr size_t WS_SU = 464 * MiB, WS_SV = 465 * MiB;
constexpr size_t WS_UF = WS_UT; constexpr size_t UF_SLICE = (size_t)16384 * 128;
constexpr size_t WS_H8 = 272 * MiB;
constexpr size_t WS_PD = 80 * MiB;
constexpr size_t WS_V8 = WS_VT; constexpr size_t V8_SLICE = (size_t)16384 * 128;
constexpr size_t WS_CQ = 336 * MiB;
constexpr size_t WS_CS = 344 * MiB;
constexpr size_t WS_ZP = 80 * MiB;
constexpr int NSEG = 16, LSEG = 8192 / NSEG;
constexpr size_t WS_YI = WS_WL;
constexpr size_t WS_YIG = WS_GK;
constexpr size_t WS_SER = 480 * MiB;
constexpr size_t WS_SEG = 496 * MiB;
constexpr size_t WS_CEND = 504 * MiB;
constexpr size_t WS_END = 505 * MiB;

constexpr int LDS_BYTES = 163840, LDS_MISC = LDS_BYTES - 256;
constexpr size_t WS_CTL = 0, CTL_BYTES = 16384;

struct Params {
    const float* in[28];
    float* out; unsigned char* ws;
    int ph_lo, ph_hi;
};

__device__ __forceinline__ float bf2f(unsigned u) { return __uint_as_float(u << 16); }
typedef float f32x2c_t __attribute__((ext_vector_type(2))); typedef __bf16 bf16x2c_t __attribute__((ext_vector_type(2)));
__device__ __forceinline__ unsigned pk2(float lo, float hi) { const f32x2c_t v = {lo, hi}; const bf16x2c_t b = __builtin_convertvector(v, bf16x2c_t); return __builtin_bit_cast(unsigned, b); }
__device__ __forceinline__ unsigned f2bf(float f) { return pk2(f, 0.f) & 0xffffu; }
#define DPP_F(v, ctrl) __builtin_bit_cast(float, __builtin_amdgcn_update_dpp(0, __builtin_bit_cast(int, (v)), (ctrl), 0xf, 0xf, false))
#define DPP_ADD(v, ctrl) ((v) + DPP_F(v, ctrl))
__device__ __forceinline__ float rlf(float v, int l) { return __builtin_bit_cast(float, __builtin_amdgcn_readlane(__builtin_bit_cast(int, v), l)); }
__device__ __forceinline__ float wave_sum_u(float v) {
    v = DPP_ADD(v, 0xB1); v = DPP_ADD(v, 0x4E); v = DPP_ADD(v, 0x141); v = DPP_ADD(v, 0x140);
    return (rlf(v, 0) + rlf(v, 16)) + (rlf(v, 32) + rlf(v, 48));
}
__device__ __forceinline__ float wave_sum(float v) { return wave_sum_u(v); }
#define DPP_I(v, ctrl) __builtin_amdgcn_update_dpp(0, (v), (ctrl), 0xf, 0xf, false)
__device__ __forceinline__ int wave_sum_i(int v) {
    v += DPP_I(v, 0xB1); v += DPP_I(v, 0x4E); v += DPP_I(v, 0x141); v += DPP_I(v, 0x140);
    return (__builtin_amdgcn_readlane(v, 0) + __builtin_amdgcn_readlane(v, 16)) + (__builtin_amdgcn_readlane(v, 32) + __builtin_amdgcn_readlane(v, 48));
}
__device__ __forceinline__ float wave_max_u(float v) {
    v = fmaxf(v, DPP_F(v, 0xB1)); v = fmaxf(v, DPP_F(v, 0x4E)); v = fmaxf(v, DPP_F(v, 0x141)); v = fmaxf(v, DPP_F(v, 0x140));
    return fmaxf(fmaxf(rlf(v, 0), rlf(v, 16)), fmaxf(rlf(v, 32), rlf(v, 48)));
}
__device__ __forceinline__ unsigned pack_i8(float a, float b, float c, float d, float inv, int off) {
    const int q0 = __float2int_rn(a * inv) + off, q1 = __float2int_rn(b * inv) + off, q2 = __float2int_rn(c * inv) + off, q3 = __float2int_rn(d * inv) + off;
    return (unsigned)(q0 & 0xff) | ((unsigned)(q1 & 0xff) << 8) | ((unsigned)(q2 & 0xff) << 16) | ((unsigned)(q3 & 0xff) << 24);
}
__device__ __forceinline__ float sigmoidf_(float x) { return __builtin_amdgcn_rcpf(1.f + __expf(-x)); }
__device__ __forceinline__ float siluf_(float x) { return x * sigmoidf_(x); }

__device__ __forceinline__ void transpose_convert(const float* W, int K, int N, int Npad, bf16* WT, int gtid, int gthreads) {
    const int kc = K / 8, total = Npad * kc;
    for (int idx = gtid; idx < total; idx += gthreads) {
        const int n = idx % Npad, c = idx / Npad; float v[8];
#pragma unroll
        for (int j = 0; j < 8; ++j) v[j] = (n < N) ? W[(size_t)(8 * c + j) * N + n] : 0.f;
        u32x4 o; o.x = pk2(v[0], v[1]); o.y = pk2(v[2], v[3]); o.z = pk2(v[4], v[5]); o.w = pk2(v[6], v[7]);
        *(u32x4*)(WT + (size_t)n * K + 8 * c) = o;
    }
}
__device__ __forceinline__ void ln_row_bf16(const float* xrow, const float* g, const float* b, bf16* orow, int lane) {
    const f32x4* xr = (const f32x4*)xrow + lane; f32x4 v[4]; float s = 0.f;
#pragma unroll
    for (int j = 0; j < 4; ++j) { v[j] = xr[64 * j]; s += (v[j][0] + v[j][1]) + (v[j][2] + v[j][3]); }
    const float mean = wave_sum(s) * (1.f / D); float s2 = 0.f;
#pragma unroll
    for (int j = 0; j < 4; ++j) { v[j] = v[j] - mean; s2 += (v[j][0] * v[j][0] + v[j][1] * v[j][1]) + (v[j][2] * v[j][2] + v[j][3] * v[j][3]); }
    const float rstd = 1.f / sqrtf(wave_sum(s2) * (1.f / D) + LN_EPS);
    u32x2* o8 = (u32x2*)orow + lane;
#pragma unroll
    for (int j = 0; j < 4; ++j) { const f32x4 gg = ((const f32x4*)g)[lane + 64 * j], bb = ((const f32x4*)b)[lane + 64 * j]; const f32x4 y = v[j] * rstd * gg + bb;
        u32x2 w; w.x = pk2(y[0], y[1]); w.y = pk2(y[2], y[3]); o8[64 * j] = w; }
}
template <bool F8>
__device__ __forceinline__ void ln_rowb_bf16(const bf16* xrow, const float* g, const float* b, bf16* orow, int lane, unsigned char* f8row = nullptr) {
    const u32x4* xr = (const u32x4*)xrow + 2 * lane; const u32x4 a = xr[0], c = xr[1]; float v[16]; float s = 0.f;
#pragma unroll
    for (int i = 0; i < 4; ++i) { v[2 * i] = __uint_as_float(a[i] << 16); v[2 * i + 1] = __uint_as_float(a[i] & 0xffff0000u); v[8 + 2 * i] = __uint_as_float(c[i] << 16); v[8 + 2 * i + 1] = __uint_as_float(c[i] & 0xffff0000u); }
#pragma unroll
    for (int i = 0; i < 16; ++i) s += v[i];
    const float mean = wave_sum(s) * (1.f / D); float s2 = 0.f;
#pragma unroll
    for (int i = 0; i < 16; ++i) { v[i] -= mean; s2 += v[i] * v[i]; }
    const float rstd = 1.f / sqrtf(wave_sum(s2) * (1.f / D) + LN_EPS);
    u32x4 o0, o1;
#pragma unroll
    for (int q = 0; q < 4; ++q) { const f32x4 gg = *(const f32x4*)(g + 16 * lane + 4 * q), bb = *(const f32x4*)(b + 16 * lane + 4 * q);
#pragma unroll
        for (int j = 0; j < 4; ++j) v[4 * q + j] = v[4 * q + j] * rstd * gg[j] + bb[j];
        const unsigned lo = pk2(v[4 * q], v[4 * q + 1]), hi = pk2(v[4 * q + 2], v[4 * q + 3]);
        if (q < 2) { o0[2 * q] = lo; o0[2 * q + 1] = hi; } else { o1[2 * q - 4] = lo; o1[2 * q - 3] = hi; } }
    u32x4* op = (u32x4*)orow + 2 * lane; op[0] = o0; op[1] = o1;
    if (F8) {
        u32x4 h8, l8;
#pragma unroll
        for (int q = 0; q < 4; ++q) {
            int ph = __builtin_amdgcn_cvt_pk_fp8_f32(v[4 * q], v[4 * q + 1], 0, false); ph = __builtin_amdgcn_cvt_pk_fp8_f32(v[4 * q + 2], v[4 * q + 3], ph, true);
            const float r0 = v[4 * q] - __builtin_amdgcn_cvt_f32_fp8(ph, 0), r1 = v[4 * q + 1] - __builtin_amdgcn_cvt_f32_fp8(ph, 1);
            const float r2 = v[4 * q + 2] - __builtin_amdgcn_cvt_f32_fp8(ph, 2), r3 = v[4 * q + 3] - __builtin_amdgcn_cvt_f32_fp8(ph, 3);
            int pl = __builtin_amdgcn_cvt_pk_fp8_f32(r0, r1, 0, false); pl = __builtin_amdgcn_cvt_pk_fp8_f32(r2, r3, pl, true);
            h8[q] = (unsigned)ph; l8[q] = (unsigned)pl; }
        *((u32x4*)f8row + lane) = h8; *((u32x4*)(f8row + 1024) + lane) = l8;
    }
}
__device__ __forceinline__ void fold_keys(const Params& P, LAS unsigned char* lds, int bi, int nb) {
    const int tid = threadIdx.x; unsigned char* ws = P.ws;
    {
        const float* Wq = P.in[22]; const float* keys = P.in[23]; bf16* WqkT = (bf16*)(ws + WS_WQ);
        LAS float* WQs = (LAS float*)lds; LAS float* KYs = WQs + 64 * 132;
        for (int item = bi; item < 256; item += nb) {
            const int hh = item >> 4, kt = item & 15;
            __syncthreads();
            for (int i = tid; i < 64 * 32; i += NTHR) { const int r = i >> 5, c4 = (i & 31) * 4; *(LAS f32x4*)(WQs + r * 132 + c4) = *(const f32x4*)(Wq + (size_t)(kt * 64 + r) * NQ + hh * 128 + c4); }
            for (int i = tid; i < 128 * 32; i += NTHR) { const int r = i >> 5, c4 = (i & 31) * 4; *(LAS f32x4*)(KYs + r * 132 + c4) = *(const f32x4*)(keys + (size_t)(hh * 128 + r) * 128 + c4); }
            __syncthreads();
            const int key = tid & 127, kg = tid >> 7; float acc[16];
#pragma unroll
            for (int j = 0; j < 16; ++j) acc[j] = 0.f;
            for (int c4 = 0; c4 < 32; ++c4) { const f32x4 kv = *(const LAS f32x4*)(KYs + key * 132 + 4 * c4);
#pragma unroll
                for (int j = 0; j < 16; ++j) { const f32x4 w = *(const LAS f32x4*)(WQs + (kg * 16 + j) * 132 + 4 * c4); acc[j] += (w[0] * kv[0] + w[1] * kv[1]) + (w[2] * kv[2] + w[3] * kv[3]); } }
            u32x4 o0, o1;
#pragma unroll
            for (int q = 0; q < 4; ++q) { o0[q] = pk2(acc[2 * q], acc[2 * q + 1]); o1[q] = pk2(acc[8 + 2 * q], acc[8 + 2 * q + 1]); }
            u32x4* dst = (u32x4*)(WqkT + (size_t)(hh * 128 + key) * D + kt * 64 + kg * 16); dst[0] = o0; dst[1] = o1;
        }
    }
}
__device__ __forceinline__ void phase_prologue(const Params& P, LAS unsigned char* lds) {
    const int tid = threadIdx.x, lane = tid & 63, wave = tid >> 6;
    const int gtid = blockIdx.x * NTHR + tid, gthreads = gridDim.x * NTHR;
    unsigned char* ws = P.ws;
    transpose_convert(P.in[3], D, IN_COLS, NP, (bf16*)(ws + WS_WIN), gtid, gthreads);
    transpose_convert(P.in[6], 64, A_W, A_W, (bf16*)(ws + WS_W2T), gtid, gthreads);
    transpose_convert(P.in[8], 64, A_W, A_W, (bf16*)(ws + WS_A2T), gtid, gthreads);
    transpose_convert(P.in[9], 128, A_W, A_W, (bf16*)(ws + WS_G2T), gtid, gthreads);
    const int gw = blockIdx.x * NWAVES + wave, ngw = gridDim.x * NWAVES;
    for (int m = gw; m < M; m += ngw) ln_row_bf16(P.in[0] + (size_t)m * D, P.in[1], P.in[2], (bf16*)(ws + WS_H0) + (size_t)m * D, lane);
}

typedef short bf16x8_t __attribute__((ext_vector_type(8)));
template <int KS, int LDA>
__device__ __forceinline__ void lora_mm(f32x4 (&acc)[4][4], const LAS bf16* ACT, const bf16* WT, int c0, int fr, int fq) {
#pragma unroll
    for (int mt = 0; mt < 4; ++mt)
#pragma unroll
        for (int nt = 0; nt < 4; ++nt) acc[mt][nt] = (f32x4){0.f, 0.f, 0.f, 0.f};
#pragma unroll
    for (int s = 0; s < KS; ++s) {
        bf16x8_t af[4], bfr[4];
#pragma unroll
        for (int mt = 0; mt < 4; ++mt) af[mt] = *(const LAS bf16x8_t*)(ACT + (mt * 16 + fr) * LDA + 32 * s + 8 * fq);
#pragma unroll
        for (int nt = 0; nt < 4; ++nt) bfr[nt] = *(const bf16x8_t*)(WT + (size_t)(c0 + nt * 16 + fr) * (32 * KS) + 32 * s + 8 * fq);
#pragma unroll
        for (int mt = 0; mt < 4; ++mt)
#pragma unroll
            for (int nt = 0; nt < 4; ++nt) acc[mt][nt] = __builtin_amdgcn_mfma_f32_16x16x32_bf16(bfr[nt], af[mt], acc[mt][nt], 0, 0, 0);
    }
}
__device__ __forceinline__ void phase_prep(const Params& P, LAS unsigned char* lds) {
    const int tid = threadIdx.x, lane = tid & 63, wave = __builtin_amdgcn_readfirstlane(tid >> 6), fr = lane & 15, fq = lane >> 4;
    unsigned char* ws = P.ws;
    const bf16* p = (const bf16*)(ws + WS_P);
    const float* mu = P.in[4]; const float* w0 = P.in[5]; const float* a0 = P.in[7];
    const float* gkw2 = P.in[16]; const float* gkb = P.in[17];
    const bf16* W2T = (const bf16*)(ws + WS_W2T); const bf16* A2T = (const bf16*)(ws + WS_A2T); const bf16* G2T = (const bf16*)(ws + WS_G2T);
    bf16* WL = (bf16*)(ws + WS_WL); bf16* AA = (bf16*)(ws + WS_AA); bf16* GG = (bf16*)(ws + WS_GG); bf16* GK = (bf16*)(ws + WS_GK);
    LAS bf16* TW = (LAS bf16*)lds; LAS bf16* AD = TW + 64 * 72; LAS bf16* SG = AD + 64 * 72;
    LAS float* gkd = (LAS float*)(SG + 64 * 136);
    const int c0 = wave * 64;
    for (int tile = blockIdx.x; tile < M / 64; tile += gridDim.x) {
        const int m0 = tile * 64;
        __syncthreads();
        for (int idx = tid; idx < 64 * 32; idx += NTHR) {
            const int j = (idx & 31) * 8, tok = idx >> 5, m = m0 + tok, t = m & (T - 1);
            const u32x4 cw = *(const u32x4*)(p + (size_t)m * NP + C_WD + j); const u32x4 pw = (t > 0) ? *(const u32x4*)(p + (size_t)(m - 1) * NP + C_WD + j) : (u32x4){0u, 0u, 0u, 0u};
            const f32x4 m0v = *(const f32x4*)(mu + C_WD + j), m1v = *(const f32x4*)(mu + C_WD + j + 4);
            float x[8];
#pragma unroll
            for (int i = 0; i < 4; ++i) { const float c0 = __uint_as_float(cw[i] << 16), c1 = __uint_as_float(cw[i] & 0xffff0000u), q0 = __uint_as_float(pw[i] << 16), q1 = __uint_as_float(pw[i] & 0xffff0000u);
                const float mu0 = i < 2 ? m0v[2 * i] : m1v[2 * i - 4], mu1 = i < 2 ? m0v[2 * i + 1] : m1v[2 * i - 3];
                x[2 * i] = c0 + (q0 - c0) * mu0; x[2 * i + 1] = c1 + (q1 - c1) * mu1; }
            u32x4 o;
            if (j < 64) {
#pragma unroll
                for (int i = 0; i < 4; ++i) o[i] = pk2(1.f - 2.f * __builtin_amdgcn_rcpf(1.f + __expf(2.f * x[2 * i])), 1.f - 2.f * __builtin_amdgcn_rcpf(1.f + __expf(2.f * x[2 * i + 1])));
                *(LAS u32x4*)(TW + tok * 72 + j) = o;
            } else if (j < 128) {
#pragma unroll
                for (int i = 0; i < 4; ++i) o[i] = pk2(x[2 * i], x[2 * i + 1]);
                *(LAS u32x4*)(AD + tok * 72 + j - 64) = o;
            } else {
#pragma unroll
                for (int i = 0; i < 4; ++i) o[i] = pk2(sigmoidf_(x[2 * i]), sigmoidf_(x[2 * i + 1]));
                *(LAS u32x4*)(SG + tok * 136 + j - 128) = o;
            }
        }
        for (int idx = tid; idx < 64 * 16; idx += NTHR) { const int j = idx & 15, tok = idx >> 4; gkd[tok * 16 + j] = bf2f(p[(size_t)(m0 + tok) * NP + C_GKD + j]); }
        __syncthreads();
        f32x4 acc[4][4];
        lora_mm<2, 72>(acc, TW, W2T, c0, fr, fq);
#pragma unroll
        for (int nt = 0; nt < 4; ++nt) { const int c = c0 + nt * 16 + 4 * fq; const f32x4 b = *(const f32x4*)(w0 + c);
#pragma unroll
            for (int mt = 0; mt < 4; ++mt) { float o[4];
#pragma unroll
                for (int i = 0; i < 4; ++i) { const float z = b[i] + acc[mt][nt][i]; o[i] = -0.6065306597126334f * sigmoidf_(z); }
                u32x2 w; w.x = pk2(o[0], o[1]); w.y = pk2(o[2], o[3]); *(u32x2*)(WL + (size_t)(m0 + mt * 16 + fr) * A_W + c) = w; } }
        lora_mm<2, 72>(acc, AD, A2T, c0, fr, fq);
#pragma unroll
        for (int nt = 0; nt < 4; ++nt) { const int c = c0 + nt * 16 + 4 * fq; const f32x4 b = *(const f32x4*)(a0 + c);
#pragma unroll
            for (int mt = 0; mt < 4; ++mt) { float o[4];
#pragma unroll
                for (int i = 0; i < 4; ++i) o[i] = sigmoidf_(b[i] + acc[mt][nt][i]);
                u32x2 w; w.x = pk2(o[0], o[1]); w.y = pk2(o[2], o[3]); *(u32x2*)(AA + (size_t)(m0 + mt * 16 + fr) * A_W + c) = w; } }
        lora_mm<4, 136>(acc, SG, G2T, c0, fr, fq);
#pragma unroll
        for (int nt = 0; nt < 4; ++nt) { const int c = c0 + nt * 16 + 4 * fq;
#pragma unroll
            for (int mt = 0; mt < 4; ++mt) { u32x2 w; w.x = pk2(acc[mt][nt][0], acc[mt][nt][1]); w.y = pk2(acc[mt][nt][2], acc[mt][nt][3]); *(u32x2*)(GG + (size_t)(m0 + mt * 16 + fr) * A_W + c) = w; } }
        { const int cc = tid & 255, th = tid >> 8; float wv[16];
#pragma unroll
          for (int j = 0; j < 16; ++j) wv[j] = gkw2[j * 256 + cc];
          const float bb = gkb[cc];
          for (int i = 0; i < 32; ++i) { const int tok = th * 32 + i; float sacc = bb;
#pragma unroll
              for (int j = 0; j < 16; ++j) sacc += gkd[tok * 16 + j] * wv[j];
              GK[(size_t)(m0 + tok) * 256 + cc] = (bf16)f2bf(-(fmaxf(-sacc, 0.f) + __logf(1.f + __expf(-fabsf(sacc)))) * (1.f / 16.f)); } }
    }
}

constexpr int CH = 32;
__device__ __forceinline__ float red8(float v) { v = DPP_ADD(v, 0xB1); v = DPP_ADD(v, 0x4E); v = DPP_ADD(v, 0x141); return v; }

constexpr int RW_BUF = 6 * CH * 64;
__device__ __forceinline__ void rw_load(const bf16* p, const bf16* AA, const bf16* WL, int b, int t0, int col, int wave,
        unsigned (&rc)[4], unsigned (&kc)[4], unsigned (&vc)[4], unsigned (&rp)[4], unsigned (&kp)[4], unsigned (&vp)[4], unsigned (&a)[4], unsigned (&wl)[4]) {
#pragma unroll
    for (int q = 0; q < 4; ++q) {
        const int t = t0 + wave + 8 * q; const size_t m = (size_t)b * T + t; const bf16* pr = p + m * NP; const bf16* pp = (t > 0) ? pr - NP : pr;
        rc[q] = pr[C_R + col]; kc[q] = pr[C_K + col]; vc[q] = pr[C_V + col]; rp[q] = pp[C_R + col]; kp[q] = pp[C_K + col]; vp[q] = pp[C_V + col];
        a[q] = AA[m * A_W + col]; wl[q] = WL[m * A_W + col];
    }
}
__device__ __forceinline__ void rw_prep(LAS float* B, int t0, int wave, int lane, float mu_r, float mu_k, float mu_v, float kkc, float kac,
        const unsigned (&rc_)[4], const unsigned (&kc_)[4], const unsigned (&vc_)[4], const unsigned (&rp_)[4], const unsigned (&kp_)[4], const unsigned (&vp_)[4], const unsigned (&a_)[4], const unsigned (&wl_)[4]) {
    LAS float* R = B; LAS float* DEC = R + CH * 64; LAS float* KH = DEC + CH * 64; LAS float* KK = KH + CH * 64; LAS float* BB = KK + CH * 64; LAS float* V = BB + CH * 64;
#pragma unroll
    for (int q = 0; q < 4; ++q) {
        const int tt = wave + 8 * q; const float hp = (t0 + tt > 0) ? 1.f : 0.f;
        const float rc = bf2f(rc_[q]), kc = bf2f(kc_[q]), vc = bf2f(vc_[q]), rp = bf2f(rp_[q]) * hp, kp = bf2f(kp_[q]) * hp, vp = bf2f(vp_[q]) * hp;
        const float r = rc + (rp - rc) * mu_r, k = kc + (kp - kc) * mu_k, v = vc + (vp - vc) * mu_v;
        const float a = bf2f(a_[q]), wl = bf2f(wl_[q]);
        const float kr = k * kkc; const float nrm = sqrtf(wave_sum(kr * kr)); const float kk = kr / fmaxf(nrm, 1e-12f);
        const float kh = k * (1.f + (a - 1.f) * kac);
        R[tt * 64 + lane] = r; DEC[tt * 64 + lane] = __expf(wl); KH[tt * 64 + lane] = kh; KK[tt * 64 + lane] = kk; BB[tt * 64 + lane] = kk * a; V[tt * 64 + lane] = v;
    }
}
struct RwOps { f32x4 k0, k1, d0, d1, b0, b1, h0, h1, q0, q1; float v0, v1; };
__device__ __forceinline__ void rw_ops_load(RwOps& o, const LAS float* B, int tt, int s8, int vr0) {
    const LAS float* R = B; const LAS float* DEC = R + CH * 64; const LAS float* KH = DEC + CH * 64; const LAS float* KK = KH + CH * 64; const LAS float* BB = KK + CH * 64; const LAS float* V = BB + CH * 64;
    o.k0 = *(const LAS f32x4*)(KK + tt * 64 + s8); o.k1 = *(const LAS f32x4*)(KK + tt * 64 + s8 + 4);
    o.d0 = *(const LAS f32x4*)(DEC + tt * 64 + s8); o.d1 = *(const LAS f32x4*)(DEC + tt * 64 + s8 + 4);
    o.b0 = *(const LAS f32x4*)(BB + tt * 64 + s8); o.b1 = *(const LAS f32x4*)(BB + tt * 64 + s8 + 4);
    o.h0 = *(const LAS f32x4*)(KH + tt * 64 + s8); o.h1 = *(const LAS f32x4*)(KH + tt * 64 + s8 + 4);
    o.q0 = *(const LAS f32x4*)(R + tt * 64 + s8); o.q1 = *(const LAS f32x4*)(R + tt * 64 + s8 + 4);
    o.v0 = V[tt * 64 + vr0]; o.v1 = V[tt * 64 + vr0 + 1];
}
template <bool IDENT> __device__ __forceinline__ void rw_step(const RwOps& o, f32x2 (&S0)[4], f32x2 (&S1)[4], LAS float* Y, int tt, int r0, int lane) {
    const float vv0 = o.v0, vv1 = o.v1;
    const f32x2 kk[4] = {o.k0.lo, o.k0.hi, o.k1.lo, o.k1.hi}, dd[4] = {o.d0.lo, o.d0.hi, o.d1.lo, o.d1.hi}, bb[4] = {o.b0.lo, o.b0.hi, o.b1.lo, o.b1.hi}, hh[4] = {o.h0.lo, o.h0.hi, o.h1.lo, o.h1.hi}, rr[4] = {o.q0.lo, o.q0.hi, o.q1.lo, o.q1.hi};
    f32x2 a0 = S0[0] * kk[0], a1 = S1[0] * kk[0];
#pragma unroll
    for (int i = 1; i < 4; ++i) { a0 = S0[i] * kk[i] + a0; a1 = S1[i] * kk[i] + a1; }
    const float sa0 = -red8(a0.x + a0.y), sa1 = -red8(a1.x + a1.y);
    f32x2 y0 = (f32x2){0.f, 0.f}, y1 = (f32x2){0.f, 0.f};
#pragma unroll
    for (int i = 0; i < 4; ++i) {
        if (IDENT) { S0[i] = bb[i] * sa0 + S0[i] * dd[i]; S1[i] = bb[i] * sa1 + S1[i] * dd[i]; }
        else { S0[i] = hh[i] * vv0 + (bb[i] * sa0 + S0[i] * dd[i]); S1[i] = hh[i] * vv1 + (bb[i] * sa1 + S1[i] * dd[i]); }
        y0 = S0[i] * rr[i] + y0; y1 = S1[i] * rr[i] + y1;
    }
    const float yy0 = red8(y0.x + y0.y), yy1 = red8(y1.x + y1.y);
    if ((lane & 7) == 0) { Y[tt * 128 + r0] = yy0; Y[tt * 128 + r0 + 1] = yy1; }
}
__device__ __forceinline__ void rwkv_item(const Params& P, LAS unsigned char* lds, int b, int h, int seg) {
    const int tid = threadIdx.x, lane = tid & 63, wave = tid >> 6;
    unsigned char* ws = P.ws;
    const bf16* p = (const bf16*)(ws + WS_P); const bf16* WL = (const bf16*)(ws + WS_WL); const bf16* AA = (const bf16*)(ws + WS_AA);
    bf16* MIX = (bf16*)P.out; bf16* YI = (bf16*)(ws + WS_YI);
    const float* mu = P.in[4]; const float* k_k = P.in[10]; const float* k_a = P.in[11];
    LAS float* BUF = (LAS float*)lds; LAS float* Y = BUF + 2 * RW_BUF;
    const int col = h * 64 + lane;
    const float mu_r = mu[C_R + col], mu_k = mu[C_K + col], mu_v = mu[C_V + col], kkc = k_k[col], kac = k_a[col];
    const int r0 = wave * 16 + 2 * (lane >> 3), s8 = (lane & 7) * 8; const int ident = r0 >> 6, vr0 = r0 & 63, vr1 = vr0 + 1;
    float* SE = (float*)(ws + WS_SER) + ((((size_t)(b * 8 + h) * NSEG + seg) * 2 + ident) * 4096) + vr0 * 64 + s8;
    f32x2 S0[4], S1[4];
#pragma unroll
    for (int i = 0; i < 4; ++i) { S0[i] = (f32x2){(ident && (s8 + 2 * i == vr0)) ? 1.f : 0.f, (ident && (s8 + 2 * i + 1 == vr0)) ? 1.f : 0.f};
        S1[i] = (f32x2){(ident && (s8 + 2 * i == vr1)) ? 1.f : 0.f, (ident && (s8 + 2 * i + 1 == vr1)) ? 1.f : 0.f}; }
    const int tbeg = seg * LSEG;
    unsigned rc[4], kc[4], vc[4], rp[4], kp[4], vp[4], a[4], wl[4];
    __syncthreads();
    rw_load(p, AA, WL, b, tbeg, col, wave, rc, kc, vc, rp, kp, vp, a, wl);
    rw_prep(BUF, tbeg, wave, lane, mu_r, mu_k, mu_v, kkc, kac, rc, kc, vc, rp, kp, vp, a, wl);
    __syncthreads();
    for (int ci = 0; ci < LSEG / CH; ++ci) {
        const int t0 = tbeg + ci * CH; LAS float* B = BUF + (ci & 1) * RW_BUF;
        LAS float* R = B; LAS float* DEC = R + CH * 64; LAS float* KH = DEC + CH * 64; LAS float* KK = KH + CH * 64; LAS float* BB = KK + CH * 64; LAS float* V = BB + CH * 64;
        const bool more = (ci + 1 < LSEG / CH);
        if (more) rw_load(p, AA, WL, b, t0 + CH, col, wave, rc, kc, vc, rp, kp, vp, a, wl);
        { RwOps oa, ob; rw_ops_load(oa, B, 0, s8, vr0);
          if (ident) for (int tt = 0; tt < CH; tt += 2) {
              rw_ops_load(ob, B, tt + 1, s8, vr0); rw_step<true>(oa, S0, S1, Y, tt, r0, lane);
              rw_ops_load(oa, B, (tt + 2) & (CH - 1), s8, vr0); rw_step<true>(ob, S0, S1, Y, tt + 1, r0, lane);
          } else for (int tt = 0; tt < CH; tt += 2) {
              rw_ops_load(ob, B, tt + 1, s8, vr0); rw_step<false>(oa, S0, S1, Y, tt, r0, lane);
              rw_ops_load(oa, B, (tt + 2) & (CH - 1), s8, vr0); rw_step<false>(ob, S0, S1, Y, tt + 1, r0, lane);
          } }
        __syncthreads();
        if (more) rw_prep(BUF + ((ci + 1) & 1) * RW_BUF, t0 + CH, wave, lane, mu_r, mu_k, mu_v, kkc, kac, rc, kc, vc, rp, kp, vp, a, wl);
#pragma unroll
        for (int q = 0; q < 4; ++q) {
            const int tt = wave + 8 * q; const size_t m = (size_t)b * T + t0 + tt;
            MIX[m * D + col] = (bf16)f2bf(Y[tt * 128 + lane]); YI[m * 512 + col] = (bf16)f2bf(Y[tt * 128 + 64 + lane]);
        }
        __syncthreads();
    }
    *(f32x4*)(SE) = (f32x4){S0[0].x, S0[0].y, S0[1].x, S0[1].y}; *(f32x4*)(SE + 4) = (f32x4){S0[2].x, S0[2].y, S0[3].x, S0[3].y};
    *(f32x4*)(SE + 64) = (f32x4){S1[0].x, S1[0].y, S1[1].x, S1[1].y}; *(f32x4*)(SE + 68) = (f32x4){S1[2].x, S1[2].y, S1[3].x, S1[3].y};
}

constexpr int W_AT = 0, W_BT = 4608, W_KT = 9216, W_LAK = 13824, W_L1 = 0, W_LT1 = 4608, W_X1 = 9216, W_RT = 18432, W_BTT = 23040, W_KTT = 27648, W_VTT = 32256, W_X0 = 36864,
              W_L0 = 46080, W_LT0 = 50688, W_QT = 46080, W_TT = 50688, W_LRB = 55296, W_LRK = 59904, W_SIM = 64512, W_PIM = 69120, W_END = 73728, W_MI = 0;
__device__ __forceinline__ bf16x8_t lfrag(const LAS bf16* base, int row, int sx, int fq) { return *(const LAS bf16x8_t*)(base + row * 72 + 32 * sx + 8 * fq); }
#define MFMA16(a, b, c) __builtin_amdgcn_mfma_f32_16x16x32_bf16((a), (b), (c), 0, 0, 0)
typedef short bf16x4_t __attribute__((ext_vector_type(4)));
#define MFMA16K(a, b, c) __builtin_amdgcn_mfma_f32_16x16x16bf16_1k((a), (b), (c), 0, 0, 0)
__device__ __forceinline__ bf16x4_t pack4(const f32x4 v) { u32x2 w; w.x = pk2(v[0], v[1]); w.y = pk2(v[2], v[3]); return __builtin_bit_cast(bf16x4_t, w); }
__device__ __forceinline__ void st4(LAS bf16* dst, float a, float b, float c, float d) { u32x2 w; w.x = pk2(a, b); w.y = pk2(c, d); *(LAS u32x2*)dst = w; }
__device__ __forceinline__ f32x4 ld4(const LAS bf16* src) { const u32x2 w = *(const LAS u32x2*)src; return (f32x4){__uint_as_float(w.x << 16), __uint_as_float(w.x & 0xffff0000u), __uint_as_float(w.y << 16), __uint_as_float(w.y & 0xffff0000u)}; }
__device__ __forceinline__ void rwkv_item_chunked(const Params& P, LAS unsigned char* lds, int b, int h, int seg) {
    const int tid = threadIdx.x, lane = tid & 63, wave = __builtin_amdgcn_readfirstlane(tid >> 6), fr = lane & 15, fq = lane >> 4;
    unsigned char* ws = P.ws;
    const bf16* p = (const bf16*)(ws + WS_P); const bf16* WL = (const bf16*)(ws + WS_WL); const bf16* AA = (const bf16*)(ws + WS_AA);
    bf16* MIX = (bf16*)P.out; bf16* YI = (bf16*)(ws + WS_YI);
    const float* mu = P.in[4]; const float* k_k = P.in[10]; const float* k_a = P.in[11];
    LAS bf16* L = (LAS bf16*)lds;
    LAS float* GAM = (LAS float*)(lds + W_END * 2); LAS float* TOT = GAM + 64;
    const int col = h * 64 + lane, tg = wave;
    const float mu_r = mu[C_R + col], mu_k = mu[C_K + col], mu_v = mu[C_V + col], kkc = k_k[col], kac = k_a[col];
    const int hv = wave >> 2, w4 = wave & 3;
    f32x4 Wreg[4];
#pragma unroll
    for (int k = 0; k < 4; ++k) Wreg[k] = (f32x4){0.f, 0.f, 0.f, 0.f};
    __syncthreads();
    for (int i = tid; i < 2 * 64 * 72 / 2; i += NTHR) ((LAS unsigned*)(L + W_SIM))[i] = 0u;
    __syncthreads();
    if (tid < 64) L[W_PIM + tid * 72 + tid] = (bf16)0x3F80;
    unsigned nr_[9], nk_[9], nv_[9], na_[8], nw_[8];
    { const int t0 = seg * LSEG;
#pragma unroll
      for (int r = 0; r < 9; ++r) { const int t = t0 + 8 * tg - 1 + r; const bf16* pr = p + ((size_t)b * T + (t > 0 ? t : 0)) * NP; nr_[r] = pr[C_R + col]; nk_[r] = pr[C_K + col]; nv_[r] = pr[C_V + col]; }
#pragma unroll
      for (int i = 0; i < 8; ++i) { const size_t m = (size_t)b * T + t0 + 8 * tg + i; na_[i] = AA[m * A_W + col]; nw_[i] = WL[m * A_W + col]; } }
    for (int c = 0; c < LSEG / 64; ++c) {
        const int t0 = seg * LSEG + c * 64;
        float rv[8], kkv[8], bv[8], khv[8], vv[8], g[8], wl[8];
        unsigned xr[9], xk[9], xv[9], xa[8], xw[8];
#pragma unroll
        for (int r = 0; r < 9; ++r) { xr[r] = nr_[r]; xk[r] = nk_[r]; xv[r] = nv_[r]; }
#pragma unroll
        for (int i = 0; i < 8; ++i) { xa[i] = na_[i]; xw[i] = nw_[i]; }
        if (c + 1 < LSEG / 64) {
#pragma unroll
            for (int r = 0; r < 9; ++r) { const int t = t0 + 64 + 8 * tg - 1 + r; const bf16* pr = p + ((size_t)b * T + t) * NP; nr_[r] = pr[C_R + col]; nk_[r] = pr[C_K + col]; nv_[r] = pr[C_V + col]; }
#pragma unroll
            for (int i = 0; i < 8; ++i) { const size_t m = (size_t)b * T + t0 + 64 + 8 * tg + i; na_[i] = AA[m * A_W + col]; nw_[i] = WL[m * A_W + col]; }
        }
#pragma unroll
        for (int i = 0; i < 8; ++i) { const int t = t0 + 8 * tg + i; const float hp = (t > 0) ? 1.f : 0.f;
            const float rc = bf2f(xr[i + 1]), kc = bf2f(xk[i + 1]), vc = bf2f(xv[i + 1]);
            const float r = rc + (bf2f(xr[i]) * hp - rc) * mu_r, k = kc + (bf2f(xk[i]) * hp - kc) * mu_k; vv[i] = vc + (bf2f(xv[i]) * hp - vc) * mu_v;
            const float a = bf2f(xa[i]); wl[i] = bf2f(xw[i]);
            const float kr = k * kkc; const float kk = kr * __builtin_amdgcn_rsqf(fmaxf(wave_sum(kr * kr), 1e-24f));
            rv[i] = r; kkv[i] = kk; bv[i] = kk * a; khv[i] = k * (1.f + (a - 1.f) * kac); }
        g[0] = wl[0];
#pragma unroll
        for (int i = 1; i < 8; ++i) g[i] = g[i - 1] + wl[i];
        TOT[tg * 64 + lane] = g[7];
        __syncthreads();
        float off = 0.f, total = 0.f;
#pragma unroll
        for (int w = 0; w < 8; ++w) { const float tv = TOT[w * 64 + lane]; total += tv; off += (w < tg) ? tv : 0.f; }
        { float at[8], bt[8], kt[8];
#pragma unroll
          for (int i = 0; i < 8; ++i) { const float G = off + g[i]; const float eG = __expf(G), eGm = __expf(G - wl[i]), ei = __expf(-G);
              at[i] = -kkv[i] * eGm; bt[i] = bv[i] * ei; kt[i] = khv[i] * ei; const float rt = rv[i] * eG; const int row = 8 * tg + i;
              L[W_AT + row * 72 + lane] = (bf16)f2bf(at[i]); L[W_BT + row * 72 + lane] = (bf16)f2bf(bt[i]); L[W_KT + row * 72 + lane] = (bf16)f2bf(kt[i]); L[W_RT + row * 72 + lane] = (bf16)f2bf(rt); }
          u32x4 w;
          w.x = pk2(at[0], at[1]); w.y = pk2(at[2], at[3]); w.z = pk2(at[4], at[5]); w.w = pk2(at[6], at[7]); *(LAS u32x4*)(L + W_X0 + lane * 72 + 8 * tg) = w;
          w.x = pk2(bt[0], bt[1]); w.y = pk2(bt[2], bt[3]); w.z = pk2(bt[4], bt[5]); w.w = pk2(bt[6], bt[7]); *(LAS u32x4*)(L + W_BTT + lane * 72 + 8 * tg) = w;
          w.x = pk2(kt[0], kt[1]); w.y = pk2(kt[2], kt[3]); w.z = pk2(kt[4], kt[5]); w.w = pk2(kt[6], kt[7]); *(LAS u32x4*)(L + W_KTT + lane * 72 + 8 * tg) = w;
          w.x = pk2(vv[0], vv[1]); w.y = pk2(vv[2], vv[3]); w.z = pk2(vv[4], vv[5]); w.w = pk2(vv[6], vv[7]); *(LAS u32x4*)(L + W_VTT + lane * 72 + 8 * tg) = w; }
        if (tg == 0) GAM[lane] = __expf(total);
        __syncthreads();
        { bf16x8_t aB[2][2], aK[2][2], bA[2][2], bR[2][2]; f32x4 ab[2], ak[2], rb[2], rk[2];
#pragma unroll
          for (int q = 0; q < 2; ++q) { const int pos = wave * 2 + q, it = pos >> 2, tt = pos & 3;
#pragma unroll
              for (int sx = 0; sx < 2; ++sx) { aB[q][sx] = lfrag(L + W_BT, it * 16 + fr, sx, fq); aK[q][sx] = lfrag(L + W_KT, it * 16 + fr, sx, fq); bA[q][sx] = lfrag(L + W_AT, tt * 16 + fr, sx, fq); bR[q][sx] = lfrag(L + W_RT, tt * 16 + fr, sx, fq); } }
#pragma unroll
          for (int q = 0; q < 2; ++q) { ab[q] = (f32x4){0.f, 0.f, 0.f, 0.f}; ak[q] = ab[q]; rb[q] = ab[q]; rk[q] = ab[q];
#pragma unroll
              for (int sx = 0; sx < 2; ++sx) { ab[q] = MFMA16(aB[q][sx], bA[q][sx], ab[q]); ak[q] = MFMA16(aK[q][sx], bA[q][sx], ak[q]); rb[q] = MFMA16(aB[q][sx], bR[q][sx], rb[q]); rk[q] = MFMA16(aK[q][sx], bR[q][sx], rk[q]); } }
#pragma unroll
          for (int q = 0; q < 2; ++q) { const int pos = wave * 2 + q, it = pos >> 2, tt = pos & 3; const int t = tt * 16 + fr, i0 = it * 16 + 4 * fq;
#pragma unroll
              for (int rg = 0; rg < 4; ++rg) { const bool st = (i0 + rg < t), inc = (i0 + rg <= t); ab[q][rg] = st ? ab[q][rg] : 0.f; ak[q][rg] = st ? ak[q][rg] : 0.f; rb[q][rg] = inc ? rb[q][rg] : 0.f; rk[q][rg] = inc ? rk[q][rg] : 0.f; }
              st4(L + W_L0 + t * 72 + i0, ab[q][0], ab[q][1], ab[q][2], ab[q][3]); st4(L + W_LAK + t * 72 + i0, ak[q][0], ak[q][1], ak[q][2], ak[q][3]);
              st4(L + W_LRB + t * 72 + i0, rb[q][0], rb[q][1], rb[q][2], rb[q][3]); st4(L + W_LRK + t * 72 + i0, rk[q][0], rk[q][1], rk[q][2], rk[q][3]);
#pragma unroll
              for (int rg = 0; rg < 4; ++rg) L[W_LT0 + (i0 + rg) * 72 + t] = (bf16)f2bf(ab[q][rg]); } }
        __syncthreads();
        { bf16x8_t a[2][2], bb[2][2]; f32x4 acc[2];
#pragma unroll
          for (int q = 0; q < 2; ++q) { const int pos = wave * 2 + q, tt = pos >> 2, vt = pos & 3;
#pragma unroll
              for (int sx = 0; sx < 2; ++sx) { a[q][sx] = lfrag(L + W_LAK, tt * 16 + fr, sx, fq); bb[q][sx] = lfrag(L + W_VTT, vt * 16 + fr, sx, fq); } }
#pragma unroll
          for (int q = 0; q < 2; ++q) { acc[q] = (f32x4){0.f, 0.f, 0.f, 0.f};
#pragma unroll
              for (int sx = 0; sx < 2; ++sx) acc[q] = MFMA16(a[q][sx], bb[q][sx], acc[q]); }
#pragma unroll
          for (int q = 0; q < 2; ++q) { const int pos = wave * 2 + q, tt = pos >> 2, vt = pos & 3; st4(L + W_X0 + (64 + vt * 16 + fr) * 72 + tt * 16 + 4 * fq, acc[q][0], acc[q][1], acc[q][2], acc[q][3]); } }
        if (wave < 4) {
            const int r16 = wave * 16;
            f32x4 PA = ld4(L + W_L0 + (r16 + fr) * 72 + r16 + 4 * fq), PB = ld4(L + W_LT0 + (r16 + fr) * 72 + r16 + 4 * fq);
            f32x4 MA = PA, MB = PB;
#pragma unroll
            for (int j = 0; j < 4; ++j) { const float d = (fr == 4 * fq + j) ? 1.f : 0.f; MA[j] += d; MB[j] += d; }
#pragma unroll
            for (int it3 = 0; it3 < 3; ++it3) {
                const bf16x4_t pa = pack4(PA), pb = pack4(PB);
                const f32x4 QB = MFMA16K(pa, pb, ((f32x4){0.f, 0.f, 0.f, 0.f})), QA = MFMA16K(pb, pa, ((f32x4){0.f, 0.f, 0.f, 0.f}));
                PA = QA; PB = QB;
                const bf16x4_t qb = pack4(QB), ma = pack4(MA);
                MB = MFMA16K(ma, qb, MB); MA = MFMA16K(qb, ma, MA);
            }
            st4(L + W_MI + (r16 + fr) * 24 + 4 * fq, MA[0], MA[1], MA[2], MA[3]);
        }
        __syncthreads();
        { bf16x4_t y[4]; LAS bf16* Xrow = L + W_X0 + (wave * 16 + fr) * 72 + 4 * fq;
#pragma unroll
          for (int r = 0; r < 4; ++r) {
              f32x4 acc = ld4(Xrow + 16 * r);
#pragma unroll
              for (int cc = 0; cc < 4; ++cc) if (cc < r) acc = MFMA16K(*(const LAS bf16x4_t*)(L + W_L0 + (16 * r + fr) * 72 + 16 * cc + 4 * fq), y[cc], acc);
              const bf16x4_t tb = pack4(acc);
              const f32x4 xr = MFMA16K(*(const LAS bf16x4_t*)(L + W_MI + (16 * r + fr) * 24 + 4 * fq), tb, ((f32x4){0.f, 0.f, 0.f, 0.f}));
              y[r] = pack4(xr);
              *(LAS bf16x4_t*)(Xrow + 16 * r) = y[r]; } }
        __syncthreads();
        { bf16x8_t aX[2][2], bT[2][2], bL[2][2]; f32x4 accT[2], accQ[2], rt[2]; float gm[2];
#pragma unroll
          for (int q = 0; q < 2; ++q) { const int pos = wave * 2 + q, kt = pos >> 2, nt = pos & 3;
#pragma unroll
              for (int sx = 0; sx < 2; ++sx) { aX[q][sx] = lfrag(L + W_X0, kt * 16 + fr, sx, fq); bT[q][sx] = lfrag(L + W_BTT, nt * 16 + fr, sx, fq); bL[q][sx] = lfrag(L + W_LRB, nt * 16 + fr, sx, fq); }
              gm[q] = GAM[nt * 16 + fr]; rt[q] = ld4(L + W_RT + (nt * 16 + fr) * 72 + kt * 16 + 4 * fq); }
#pragma unroll
          for (int q = 0; q < 2; ++q) { accT[q] = (f32x4){0.f, 0.f, 0.f, 0.f}; accQ[q] = accT[q];
#pragma unroll
              for (int sx = 0; sx < 2; ++sx) { accT[q] = MFMA16(aX[q][sx], bT[q][sx], accT[q]); accQ[q] = MFMA16(aX[q][sx], bL[q][sx], accQ[q]); } }
#pragma unroll
          for (int q = 0; q < 2; ++q) { const int pos = wave * 2 + q, kt = pos >> 2, nt = pos & 3; const int k0 = kt * 16 + 4 * fq, n = nt * 16 + fr;
#pragma unroll
              for (int rg = 0; rg < 4; ++rg) accT[q][rg] = (accT[q][rg] + ((k0 + rg == n) ? 1.f : 0.f)) * gm[q];
              st4(L + W_TT + n * 72 + k0, accT[q][0], accT[q][1], accT[q][2], accT[q][3]); st4(L + W_QT + n * 72 + k0, accQ[q][0] + rt[q][0], accQ[q][1] + rt[q][1], accQ[q][2] + rt[q][2], accQ[q][3] + rt[q][3]); } }
        __syncthreads();
        { f32x4 ov[2], oi[2];
#pragma unroll
          for (int j = 0; j < 2; ++j) { ov[j] = (f32x4){0.f, 0.f, 0.f, 0.f}; oi[j] = ov[j]; }
#pragma unroll
          for (int sx = 0; sx < 2; ++sx) { const bf16x8_t aQ = lfrag(L + W_QT, w4 * 16 + fr, sx, fq), aB = lfrag(L + W_LRB, w4 * 16 + fr, sx, fq), aK = lfrag(L + W_LRK, w4 * 16 + fr, sx, fq);
#pragma unroll
              for (int j = 0; j < 2; ++j) { const int rw = 4 * fr + 2 * hv + j;
                  ov[j] = MFMA16(aB, lfrag(L + W_X0, 64 + rw, sx, fq), ov[j]); ov[j] = MFMA16(aK, lfrag(L + W_VTT, rw, sx, fq), ov[j]); ov[j] = MFMA16(aQ, lfrag(L + W_SIM, rw, sx, fq), ov[j]);
                  oi[j] = MFMA16(aQ, lfrag(L + W_PIM, rw, sx, fq), oi[j]); } }
#pragma unroll
          for (int rg = 0; rg < 4; ++rg) { const size_t m = (size_t)b * T + t0 + w4 * 16 + 4 * fq + rg;
              *(unsigned*)(MIX + m * D + h * 64 + 4 * fr + 2 * hv) = pk2(ov[0][rg], ov[1][rg]); *(unsigned*)(YI + m * 512 + h * 64 + 4 * fr + 2 * hv) = pk2(oi[0][rg], oi[1][rg]); } }
#pragma unroll
        for (int j = 0; j < 2; ++j) { const int nt = 2 * hv + j; f32x4 acc = (f32x4){0.f, 0.f, 0.f, 0.f}, aci = acc;
#pragma unroll
            for (int sx = 0; sx < 2; ++sx) { acc = MFMA16(lfrag(L + W_X0, 64 + w4 * 16 + fr, sx, fq), lfrag(L + W_BTT, nt * 16 + fr, sx, fq), acc); acc = MFMA16(lfrag(L + W_VTT, w4 * 16 + fr, sx, fq), lfrag(L + W_KTT, nt * 16 + fr, sx, fq), acc); }
            acc = acc * GAM[nt * 16 + fr];
#pragma unroll
            for (int sx = 0; sx < 2; ++sx) { const bf16x8_t tf = lfrag(L + W_TT, nt * 16 + fr, sx, fq); acc = MFMA16(lfrag(L + W_SIM, w4 * 16 + fr, sx, fq), tf, acc); aci = MFMA16(lfrag(L + W_PIM, w4 * 16 + fr, sx, fq), tf, aci); }
            Wreg[j] = acc; Wreg[2 + j] = aci; }
        __syncthreads();
#pragma unroll
        for (int j = 0; j < 2; ++j)
#pragma unroll
            for (int rg = 0; rg < 4; ++rg) { const int ix = (w4 * 16 + 4 * fq + rg) * 72 + (2 * hv + j) * 16 + fr; L[W_SIM + ix] = (bf16)f2bf(Wreg[j][rg]); L[W_PIM + ix] = (bf16)f2bf(Wreg[2 + j][rg]); }
    }
    float* SE = (float*)(ws + WS_SER) + (((size_t)(b * 8 + h) * NSEG + seg) * 2) * 4096;
#pragma unroll
    for (int j = 0; j < 2; ++j)
#pragma unroll
        for (int rg = 0; rg < 4; ++rg) { const int ix = (w4 * 16 + 4 * fq + rg) * 64 + (2 * hv + j) * 16 + fr; SE[ix] = Wreg[j][rg]; SE[4096 + ix] = Wreg[2 + j][rg]; }
}

constexpr int GQ = 0, GK_ = GQ + 64 * 72, GD = GK_ + 64 * 72, GV = GD + 64 * 72, GA = GV + 128 * 72, GS = GA + 64 * 72, GEND = GS + 128 * 72;
__device__ __forceinline__ unsigned pk2f(float a, float b) { return pk2(a, b); }
__device__ __forceinline__ void gla_item(const Params& P, LAS unsigned char* lds, int b, int h, int seg) {
    const int tid = threadIdx.x, lane = tid & 63, wave = __builtin_amdgcn_readfirstlane(tid >> 6), fr = lane & 15, fq = lane >> 4;
    unsigned char* ws = P.ws;
    const bf16* p = (const bf16*)(ws + WS_P); bf16* GKB = (bf16*)(ws + WS_GK);
    bf16* MIX = (bf16*)P.out;
    float* SE = (float*)(ws + WS_SEG) + ((size_t)(b * 4 + h) * NSEG + seg) * 8192; float* CE = (float*)(ws + WS_CEND) + ((size_t)(b * 4 + h) * NSEG + seg) * 64;
    const float* conv = P.in[15];
    LAS bf16* L = (LAS bf16*)lds; LAS bf16* QT = L + GQ; LAS bf16* KT = L + GK_; LAS bf16* KD = L + GD; LAS bf16* VT = L + GV; LAS bf16* AT = L + GA; LAS bf16* ST = L + GS;
    LAS float* GAM = (LAS float*)(lds + GEND * 2); LAS float* TOT = GAM + 64;
    const int ch = lane, tg = wave;
    const int cq = h * 64 + ch, ck = 256 + h * 64 + ch, cv0 = 512 + h * 128 + ch, cv1 = cv0 + 64;
    float wq[4], wk[4], wv0[4], wv1[4];
#pragma unroll
    for (int j = 0; j < 4; ++j) { wq[j] = conv[j * 1024 + cq]; wk[j] = conv[j * 1024 + ck]; wv0[j] = conv[j * 1024 + cv0]; wv1[j] = conv[j * 1024 + cv1]; }
    float gseg = 0.f;
    f32x4 Sacc[4];
#pragma unroll
    for (int k = 0; k < 4; ++k) Sacc[k] = (f32x4){0.f, 0.f, 0.f, 0.f};
    __syncthreads();
    for (int i = tid; i < 128 * 72 / 2; i += NTHR) ((LAS unsigned*)ST)[i] = 0u;
    for (int c = 0; c < LSEG / 64; ++c) {
        const int t0 = seg * LSEG + c * 64;
        __syncthreads();
        float xq[11], xk[11], xa[11], xb[11], g[8];
#pragma unroll
        for (int r = 0; r < 11; ++r) { const int t = t0 + 8 * tg - 3 + r; const size_t m = (size_t)b * T + (t > 0 ? t : 0); const float ok = (t >= 0) ? 1.f : 0.f; const bf16* pr = p + m * NP + C_BQ;
            xq[r] = bf2f(pr[cq]) * ok; xk[r] = bf2f(pr[ck]) * ok; xa[r] = bf2f(pr[cv0]) * ok; xb[r] = bf2f(pr[cv1]) * ok; }
#pragma unroll
        for (int i = 0; i < 8; ++i) g[i] = bf2f(GKB[((size_t)b * T + t0 + 8 * tg + i) * 256 + h * 64 + ch]);
#pragma unroll
        for (int i = 1; i < 8; ++i) g[i] += g[i - 1];
        TOT[tg * 64 + ch] = g[7];
        __syncthreads();
        float off = 0.f, total = 0.f;
#pragma unroll
        for (int w = 0; w < 8; ++w) { const float tv = TOT[w * 64 + ch]; total += tv; off += (w < tg) ? tv : 0.f; }
        float kd[8], va[8], vb[8];
#pragma unroll
        for (int i = 0; i < 8; ++i) {
            float aq = 0.f, ak = 0.f, a0 = 0.f, a1 = 0.f;
#pragma unroll
            for (int j = 0; j < 4; ++j) { aq += wq[j] * xq[i + j]; ak += wk[j] * xk[i + j]; a0 += wv0[j] * xa[i + j]; a1 += wv1[j] * xb[i + j]; }
            const float q = siluf_(aq) * 0.125f, k = siluf_(ak), Gc = off + g[i];
            QT[(8 * tg + i) * 72 + ch] = (bf16)f2bf(q * __expf(Gc)); KT[(8 * tg + i) * 72 + ch] = (bf16)f2bf(k * __expf(-Gc));
            kd[i] = k * __expf(total - Gc); va[i] = siluf_(a0); vb[i] = siluf_(a1);
            GKB[((size_t)b * T + t0 + 8 * tg + i) * 256 + h * 64 + ch] = (bf16)f2bf(q * __expf(gseg + Gc));
        }
        { u32x4 w; w.x = pk2f(kd[0], kd[1]); w.y = pk2f(kd[2], kd[3]); w.z = pk2f(kd[4], kd[5]); w.w = pk2f(kd[6], kd[7]); *(LAS u32x4*)(KD + ch * 72 + 8 * tg) = w;
          w.x = pk2f(va[0], va[1]); w.y = pk2f(va[2], va[3]); w.z = pk2f(va[4], va[5]); w.w = pk2f(va[6], va[7]); *(LAS u32x4*)(VT + ch * 72 + 8 * tg) = w;
          w.x = pk2f(vb[0], vb[1]); w.y = pk2f(vb[2], vb[3]); w.z = pk2f(vb[4], vb[5]); w.w = pk2f(vb[6], vb[7]); *(LAS u32x4*)(VT + (64 + ch) * 72 + 8 * tg) = w; }
        if (tg == 0) GAM[ch] = __expf(total);
        gseg += total;
        __syncthreads();
#pragma unroll
        for (int k2 = 0; k2 < 2; ++k2) { const int tile = wave * 2 + k2, jt = tile >> 2, it = tile & 3; f32x4 acc = (f32x4){0.f, 0.f, 0.f, 0.f};
            if (jt <= it) {
#pragma unroll
                for (int sx = 0; sx < 2; ++sx) acc = __builtin_amdgcn_mfma_f32_16x16x32_bf16(*(const LAS bf16x8_t*)(KT + (jt * 16 + fr) * 72 + 32 * sx + 8 * fq), *(const LAS bf16x8_t*)(QT + (it * 16 + fr) * 72 + 32 * sx + 8 * fq), acc, 0, 0, 0);
            }
            const int ii = it * 16 + fr, j0 = jt * 16 + 4 * fq; u32x2 w;
            w.x = pk2f(j0 <= ii ? acc[0] : 0.f, j0 + 1 <= ii ? acc[1] : 0.f); w.y = pk2f(j0 + 2 <= ii ? acc[2] : 0.f, j0 + 3 <= ii ? acc[3] : 0.f);
            *(LAS u32x2*)(AT + ii * 72 + j0) = w; }
        __syncthreads();
        { const int it = wave & 3, vts = (wave >> 2) * 4; f32x4 oacc[4];
#pragma unroll
          for (int k = 0; k < 4; ++k) oacc[k] = (f32x4){0.f, 0.f, 0.f, 0.f};
#pragma unroll
          for (int sx = 0; sx < 2; ++sx) { const bf16x8_t aA = *(const LAS bf16x8_t*)(AT + (it * 16 + fr) * 72 + 32 * sx + 8 * fq), aQ = *(const LAS bf16x8_t*)(QT + (it * 16 + fr) * 72 + 32 * sx + 8 * fq);
#pragma unroll
              for (int k = 0; k < 4; ++k) { const int vrow = 8 * fr + vts + k;
                  oacc[k] = __builtin_amdgcn_mfma_f32_16x16x32_bf16(aA, *(const LAS bf16x8_t*)(VT + vrow * 72 + 32 * sx + 8 * fq), oacc[k], 0, 0, 0);
                  oacc[k] = __builtin_amdgcn_mfma_f32_16x16x32_bf16(aQ, *(const LAS bf16x8_t*)(ST + vrow * 72 + 32 * sx + 8 * fq), oacc[k], 0, 0, 0); } }
#pragma unroll
          for (int rg = 0; rg < 4; ++rg) { const size_t m = (size_t)b * T + t0 + it * 16 + 4 * fq + rg; u32x2 w; w.x = pk2f(oacc[0][rg], oacc[1][rg]); w.y = pk2f(oacc[2][rg], oacc[3][rg]);
              *(u32x2*)(MIX + m * D + 512 + h * 128 + 8 * fr + vts) = w; } }
#pragma unroll
        for (int k = 0; k < 4; ++k) { f32x4 acc = Sacc[k] * GAM[k * 16 + fr];
#pragma unroll
            for (int sx = 0; sx < 2; ++sx) acc = __builtin_amdgcn_mfma_f32_16x16x32_bf16(*(const LAS bf16x8_t*)(VT + (wave * 16 + fr) * 72 + 32 * sx + 8 * fq), *(const LAS bf16x8_t*)(KD + (k * 16 + fr) * 72 + 32 * sx + 8 * fq), acc, 0, 0, 0);
            Sacc[k] = acc; }
        __syncthreads();
#pragma unroll
        for (int k = 0; k < 4; ++k)
#pragma unroll
            for (int rg = 0; rg < 4; ++rg) ST[(wave * 16 + 4 * fq + rg) * 72 + k * 16 + fr] = (bf16)f2bf(Sacc[k][rg]);
    }
#pragma unroll
    for (int k = 0; k < 4; ++k)
#pragma unroll
        for (int rg = 0; rg < 4; ++rg) SE[(wave * 16 + 4 * fq + rg) * 64 + k * 16 + fr] = Sacc[k][rg];
    if (tg == 0) CE[ch] = __expf(gseg);
}
__device__ __forceinline__ void phase_scan(const Params& P, LAS unsigned char* lds) {
    for (int it = blockIdx.x; it < 512 + 256; it += gridDim.x) {
        if (it < 512) { const int bh = it >> 4; rwkv_item_chunked(P, lds, bh >> 3, bh & 7, it & 15); }
        else { const int g = it - 512, bh = g >> 4; gla_item(P, lds, bh >> 2, bh & 3, g & 15); }
        __syncthreads();
    }
}
__device__ __forceinline__ void quant_tables(const Params& P, int gw, int ngw);
__device__ __forceinline__ void phase_fixup(const Params& P, LAS unsigned char* lds) {
    const int tid = threadIdx.x, lane = tid & 63, wave = __builtin_amdgcn_readfirstlane(tid >> 6), fr = lane & 15, fq = lane >> 4;
    for (int it = blockIdx.x; it < 192; it += gridDim.x) {
        if (it < 64) {
            float* SE = (float*)(P.ws + WS_SER) + (size_t)(it >> 1) * NSEG * 2 * 4096;
            LAS float* Sb = (LAS float*)lds;
            const int sl = wave >> 2, nt = wave & 3, r0 = ((it & 1) * 2 + sl) * 16;
            const int cpos = (r0 + 4 * fq) * 64 + nt * 16 + fr;
            const int bpos = (16 * fq) * 64 + nt * 16 + fr;
            __syncthreads();
            f32x4 en[4]; float ph[4][16];
#define FX_LOAD(sg) do { const float* nx_ = SE + (size_t)((sg) * 2) * 4096; \
                _Pragma("unroll") for (int ks = 0; ks < 16; ++ks) ph[(sg) & 3][ks] = nx_[4096 + bpos + 64 * ks]; \
                _Pragma("unroll") for (int rg = 0; rg < 4; ++rg) en[(sg) & 3][rg] = nx_[cpos + 64 * rg]; } while (0)
#pragma unroll
            for (int rg = 0; rg < 4; ++rg) Sb[(sl * 16 + 4 * fq + rg) * 68 + nt * 16 + fr] = SE[cpos + 64 * rg];
            FX_LOAD(1); FX_LOAD(2); FX_LOAD(3);
            __syncthreads();
#pragma unroll
            for (int seg = 1; seg < NSEG - 1; ++seg) {
                float* s0 = SE + (size_t)(seg * 2) * 4096;
                const LAS float* Sr = Sb + ((seg - 1) & 1) * (2 * 16 * 68) + (sl * 16 + fr) * 68 + 16 * fq; LAS float* Sw = Sb + (seg & 1) * (2 * 16 * 68);
                if (seg + 3 < NSEG - 1) FX_LOAD(seg + 3);
                f32x4 acc = en[seg & 3]; f32x4 av[4];
#pragma unroll
                for (int j = 0; j < 4; ++j) av[j] = *(const LAS f32x4*)(Sr + 4 * j);
#pragma unroll
                for (int ks = 0; ks < 16; ++ks) acc = __builtin_amdgcn_mfma_f32_16x16x4f32(av[ks >> 2][ks & 3], ph[seg & 3][ks], acc, 0, 0, 0);
#pragma unroll
                for (int rg = 0; rg < 4; ++rg) { s0[cpos + 64 * rg] = acc[rg]; Sw[(sl * 16 + 4 * fq + rg) * 68 + nt * 16 + fr] = acc[rg]; }
                __syncthreads();
            }
#undef FX_LOAD
        } else {
            const int g = it - 64, bh = g >> 3; float* SE = (float*)(P.ws + WS_SEG) + (size_t)bh * NSEG * 8192 + ((g & 7) * 16 + (tid >> 5)) * 64 + (tid & 31) * 2;
            const float* CE = (const float*)(P.ws + WS_CEND) + (size_t)bh * NSEG * 64 + (tid & 31) * 2;
            f32x2 x[NSEG - 1], ce[NSEG - 1];
#pragma unroll
            for (int seg = 0; seg < NSEG - 1; ++seg) { x[seg] = *(const f32x2*)(SE + (size_t)seg * 8192); ce[seg] = *(const f32x2*)(CE + seg * 64); }
            f32x2 sc = (f32x2){0.f, 0.f};
#pragma unroll
            for (int seg = 0; seg < NSEG - 1; ++seg) { sc = sc * ce[seg] + x[seg]; *(f32x2*)(SE + (size_t)seg * 8192) = sc; }
        }
    }
    {
        const bool sp = gridDim.x > 64; const int nb = sp ? (int)gridDim.x - 64 : (int)gridDim.x, bi = sp ? (int)blockIdx.x - 64 : (int)blockIdx.x;
        if (bi >= 0) {
            fold_keys(P, lds, bi, nb);
            transpose_convert(P.in[19], D, D, D, (bf16*)(P.ws + WS_WOUT), bi * NTHR + tid, nb * NTHR);
            quant_tables(P, bi * NWAVES + (tid >> 6), nb * NWAVES);
        }
    }
}
__device__ __forceinline__ float row_sum16(float v) { v = DPP_ADD(v, 0xB1); v = DPP_ADD(v, 0x4E); v = DPP_ADD(v, 0x141); v = DPP_ADD(v, 0x140); return v; }
__device__ __forceinline__ bf16x8_t pack_bf16x8(const f32x4 a, const f32x4 b) {
    u32x4 w; w.x = pk2(a[0], a[1]); w.y = pk2(a[2], a[3]); w.z = pk2(b[0], b[1]); w.w = pk2(b[2], b[3]); return __builtin_bit_cast(bf16x8_t, w);
}
__device__ __forceinline__ void unpack4(const u32x2 w, float (&o)[4]) { o[0] = __uint_as_float(w.x << 16); o[1] = __uint_as_float(w.x & 0xffff0000u); o[2] = __uint_as_float(w.y << 16); o[3] = __uint_as_float(w.y & 0xffff0000u); }
__device__ __forceinline__ void phase_correct(const Params& P, LAS unsigned char* lds) {
    const int tid = threadIdx.x, lane = tid & 63, wave = __builtin_amdgcn_readfirstlane(tid >> 6), fr = lane & 15, fq = lane >> 4;
    unsigned char* ws = P.ws;
    const bf16* p = (const bf16*)(ws + WS_P); const bf16* AA = (const bf16*)(ws + WS_AA); const bf16* GG = (const bf16*)(ws + WS_GG);
    bf16* MIX = (bf16*)P.out; const bf16* YI = (const bf16*)(ws + WS_YI); const bf16* YIG = (const bf16*)(ws + WS_YIG);
    const float* mu = P.in[4]; const float* k_a = P.in[11]; const float* r_k = P.in[12]; const float* gn_g = P.in[13]; const float* gn_b = P.in[14]; const float* norm_g = P.in[18];
    LAS bf16* SB = (LAS bf16*)lds;
    for (int it = blockIdx.x; it < 512; it += gridDim.x) {
        {
            const int seg = it & 15, bh = it >> 4, b = bh >> 3, h = bh & 7;
            const int cb = h * 64 + 4 * fr;
            __syncthreads();
            if (seg > 0) { const float* ss = (const float*)(ws + WS_SER) + (((size_t)bh * NSEG + (seg - 1)) * 2) * 4096;
                for (int i = tid; i < 1024; i += NTHR) { const f32x4 x = *(const f32x4*)(ss + 4 * i); const int v = i >> 4, j = (4 * i) & 63; u32x2 w; w.x = pk2(x[0], x[1]); w.y = pk2(x[2], x[3]);
                    *(LAS u32x2*)(SB + ((v & 3) * 16 + (v >> 2)) * 72 + j) = w; } }
            __syncthreads();
            const f32x4 mur = *(const f32x4*)(mu + C_R + cb), muk = *(const f32x4*)(mu + C_K + cb), muv = *(const f32x4*)(mu + C_V + cb), kac = *(const f32x4*)(k_a + cb), rkc = *(const f32x4*)(r_k + cb), gng = *(const f32x4*)(gn_g + cb), gnb = *(const f32x4*)(gn_b + cb);
            u32x2 W[4][9];
#define CORR_LOAD(buf, st) do { const int t_ = seg * LSEG + wave * 64 + ((st) >> 2) * 16 + 4 * fq + ((st) & 3); const size_t m_ = (size_t)b * T + t_; const bf16* pr_ = p + m_ * NP + cb; const bf16* pp_ = (t_ > 0) ? pr_ - NP : pr_; \
                    W[buf][0] = *(const u32x2*)(MIX + m_ * D + cb); W[buf][1] = *(const u32x2*)(pr_ + C_R); W[buf][2] = *(const u32x2*)(pr_ + C_K); W[buf][3] = *(const u32x2*)(pr_ + C_V); \
                    W[buf][4] = *(const u32x2*)(pp_ + C_R); W[buf][5] = *(const u32x2*)(pp_ + C_K); W[buf][6] = *(const u32x2*)(pp_ + C_V); W[buf][7] = *(const u32x2*)(AA + m_ * A_W + cb); W[buf][8] = *(const u32x2*)(GG + m_ * A_W + cb); } while (0)
            CORR_LOAD(0, 0); CORR_LOAD(1, 1); CORR_LOAD(2, 2);
#pragma unroll
            for (int mt = 0; mt < 4; ++mt) {
                const int tb = seg * LSEG + wave * 64 + mt * 16;
                f32x4 acc[4];
#pragma unroll
                for (int vt = 0; vt < 4; ++vt) acc[vt] = (f32x4){0.f, 0.f, 0.f, 0.f};
                if (seg > 0) {
#pragma unroll
                    for (int sx = 0; sx < 2; ++sx) { const bf16x8_t af = *(const bf16x8_t*)(YI + ((size_t)b * T + tb + fr) * 512 + h * 64 + 32 * sx + 8 * fq);
#pragma unroll
                        for (int vt = 0; vt < 4; ++vt) acc[vt] = __builtin_amdgcn_mfma_f32_16x16x32_bf16(af, *(const LAS bf16x8_t*)(SB + (vt * 16 + fr) * 72 + 32 * sx + 8 * fq), acc[vt], 0, 0, 0); }
                }
#pragma unroll
                for (int rg = 0; rg < 4; ++rg) { const int t = tb + 4 * fq + rg; const size_t m = (size_t)b * T + t; const float hp = (t > 0) ? 1.f : 0.f; const int st = mt * 4 + rg;
                    if (st + 3 < 16) CORR_LOAD((st + 3) & 3, st + 3);
                    __builtin_amdgcn_sched_barrier(0);
                    float y[4], rc[4], kc[4], vc[4], rp_[4], kp[4], vp[4], a[4], g[4];
                    unpack4(W[st & 3][0], y); unpack4(W[st & 3][1], rc); unpack4(W[st & 3][2], kc); unpack4(W[st & 3][3], vc); unpack4(W[st & 3][4], rp_); unpack4(W[st & 3][5], kp); unpack4(W[st & 3][6], vp); unpack4(W[st & 3][7], a); unpack4(W[st & 3][8], g);
                    float v[4], sy = 0.f, sb = 0.f;
#pragma unroll
                    for (int i = 0; i < 4; ++i) { y[i] += acc[i][rg];
                        const float r = rc[i] + (rp_[i] * hp - rc[i]) * mur[i], k = kc[i] + (kp[i] * hp - kc[i]) * muk[i]; v[i] = vc[i] + (vp[i] * hp - vc[i]) * muv[i];
                        const float kh = k * (1.f + (a[i] - 1.f) * kac[i]); sb += r * kh * rkc[i]; sy += y[i]; }
                    const float bon = row_sum16(sb), mean = row_sum16(sy) * (1.f / 64.f); float sq = 0.f;
#pragma unroll
                    for (int i = 0; i < 4; ++i) { y[i] -= mean; sq += y[i] * y[i]; }
                    const float rstd = __builtin_amdgcn_rsqf(row_sum16(sq) * (1.f / 64.f) + GN_EPS); float o[4];
#pragma unroll
                    for (int i = 0; i < 4; ++i) o[i] = (y[i] * rstd * gng[i] + gnb[i] + bon * v[i]) * g[i];
                    u32x2 w; w.x = pk2(o[0], o[1]); w.y = pk2(o[2], o[3]); *(u32x2*)(MIX + m * D + cb) = w;
                    __builtin_amdgcn_sched_barrier(0); }
#undef CORR_LOAD
            }
        }
    }
    for (int g_ = blockIdx.x; g_ < 256; g_ += gridDim.x) {
        {
            const int seg = g_ & 15, bh = g_ >> 4, b = bh >> 2, h = bh & 3;
            const int cb = h * 128 + 8 * fr;
            __syncthreads();
            if (seg > 0) { const float* ss = (const float*)(ws + WS_SEG) + ((size_t)bh * NSEG + (seg - 1)) * 8192;
                for (int i = tid; i < 2048; i += NTHR) { const f32x4 x = *(const f32x4*)(ss + 4 * i); const int v = i >> 4, j = (4 * i) & 63; u32x2 w; w.x = pk2(x[0], x[1]); w.y = pk2(x[2], x[3]);
                    *(LAS u32x2*)(SB + ((v & 7) * 16 + (v >> 3)) * 72 + j) = w; } }
            __syncthreads();
            const f32x4 ng0 = *(const f32x4*)(norm_g + 8 * fr), ng1 = *(const f32x4*)(norm_g + 8 * fr + 4);
            u32x4 WG[4][2];
#define CORG_LOAD(buf, st) do { const size_t m_ = (size_t)b * T + seg * LSEG + wave * 64 + ((st) >> 2) * 16 + 4 * fq + ((st) & 3); WG[buf][0] = *(const u32x4*)(MIX + m_ * D + 512 + cb); WG[buf][1] = *(const u32x4*)(p + m_ * NP + C_BG + cb); } while (0)
            CORG_LOAD(0, 0); CORG_LOAD(1, 1); CORG_LOAD(2, 2);
#pragma unroll
            for (int mt = 0; mt < 4; ++mt) {
                const int tb = seg * LSEG + wave * 64 + mt * 16;
                f32x4 acc[8];
#pragma unroll
                for (int vt = 0; vt < 8; ++vt) acc[vt] = (f32x4){0.f, 0.f, 0.f, 0.f};
                if (seg > 0) {
#pragma unroll
                    for (int sx = 0; sx < 2; ++sx) { const bf16x8_t af = *(const bf16x8_t*)(YIG + ((size_t)b * T + tb + fr) * 256 + h * 64 + 32 * sx + 8 * fq);
#pragma unroll
                        for (int vt = 0; vt < 8; ++vt) acc[vt] = __builtin_amdgcn_mfma_f32_16x16x32_bf16(af, *(const LAS bf16x8_t*)(SB + (vt * 16 + fr) * 72 + 32 * sx + 8 * fq), acc[vt], 0, 0, 0); }
                }
#pragma unroll
                for (int rg = 0; rg < 4; ++rg) { const size_t m = (size_t)b * T + tb + 4 * fq + rg; const int st = mt * 4 + rg;
                    if (st + 3 < 16) CORG_LOAD((st + 3) & 3, st + 3);
                    __builtin_amdgcn_sched_barrier(0);
                    float o[8], g[8]; float sq = 0.f;
#pragma unroll
                    for (int i = 0; i < 4; ++i) { const unsigned a_ = WG[st & 3][0][i], b_ = WG[st & 3][1][i]; o[2 * i] = __uint_as_float(a_ << 16); o[2 * i + 1] = __uint_as_float(a_ & 0xffff0000u); g[2 * i] = __uint_as_float(b_ << 16); g[2 * i + 1] = __uint_as_float(b_ & 0xffff0000u); }
#pragma unroll
                    for (int i = 0; i < 8; ++i) { o[i] += acc[i][rg]; sq += o[i] * o[i]; }
                    const float rs = __builtin_amdgcn_rsqf(row_sum16(sq) * (1.f / 128.f) + RMS_EPS);
                    float f[8];
#pragma unroll
                    for (int i = 0; i < 8; ++i) f[i] = o[i] * rs * (i < 4 ? ng0[i & 3] : ng1[i & 3]) * siluf_(g[i]);
                    u32x4 w; w.x = pk2(f[0], f[1]); w.y = pk2(f[2], f[3]); w.z = pk2(f[4], f[5]); w.w = pk2(f[6], f[7]); *(u32x4*)(MIX + m * D + 512 + cb) = w;
                    __builtin_amdgcn_sched_barrier(0); }
#undef CORG_LOAD
            }
        }
    }
}

__device__ __forceinline__ void phase_ln1(const Params& P) {
    const int lane = threadIdx.x & 63, wave = threadIdx.x >> 6; const int gw = blockIdx.x * NWAVES + wave, ngw = gridDim.x * NWAVES;
    for (int m = gw; m < M; m += ngw) ln_rowb_bf16<true>((const bf16*)(P.ws + WS_Z) + (size_t)m * D, P.in[20], P.in[21], (bf16*)(P.ws + WS_H1) + (size_t)m * D, lane, P.ws + WS_H8 + (size_t)m * 2048);
}
__device__ __forceinline__ void quant_tables(const Params& P, int gw, int ngw) {
    const int lane = threadIdx.x & 63;
    {
        const float* src = P.in[24]; unsigned char* dst = P.ws + WS_UF + (size_t)(lane >> 3) * UF_SLICE + 16 * (lane & 7); float* sc = (float*)(P.ws + WS_SU);
        for (int e = gw; e < 16384; e += ngw) {
            const f32x4* sp = (const f32x4*)(src + (size_t)e * D) + 4 * lane; f32x4 a[4]; float mx = 0.f;
#pragma unroll
            for (int j = 0; j < 4; ++j) { a[j] = sp[j]; mx = fmaxf(fmaxf(mx, fmaxf(fabsf(a[j][0]), fabsf(a[j][1]))), fmaxf(fabsf(a[j][2]), fabsf(a[j][3]))); }
            mx = wave_max_u(mx); const float inv = mx > 0.f ? 448.f / mx : 0.f;
            u32x4 w;
#pragma unroll
            for (int j = 0; j < 4; ++j) { int pk = __builtin_amdgcn_cvt_pk_fp8_f32(a[j][0] * inv, a[j][1] * inv, 0, false); pk = __builtin_amdgcn_cvt_pk_fp8_f32(a[j][2] * inv, a[j][3] * inv, pk, true); w[j] = (unsigned)pk; }
            *(u32x4*)(dst + (size_t)e * 128) = w;
            if (lane == 0) sc[e] = mx * (1.f / 448.f);
        }
    }
    {
        const float* src = P.in[25]; unsigned char* dst = P.ws + WS_V8 + (size_t)(lane >> 3) * V8_SLICE + 16 * (lane & 7); float* sc = (float*)(P.ws + WS_SV);
        for (int e = gw; e < 16384; e += ngw) {
            const f32x4* sp = (const f32x4*)(src + (size_t)e * D) + 4 * lane; f32x4 a[4]; float mx = 0.f;
#pragma unroll
            for (int j = 0; j < 4; ++j) { a[j] = sp[j]; mx = fmaxf(fmaxf(mx, fmaxf(fabsf(a[j][0]), fabsf(a[j][1]))), fmaxf(fabsf(a[j][2]), fabsf(a[j][3]))); }
            mx = wave_max_u(mx); const float inv = mx > 0.f ? 127.f / mx : 0.f;
            u32x4 w;
#pragma unroll
            for (int j = 0; j < 4; ++j) w[j] = pack_i8(a[j][0], a[j][1], a[j][2], a[j][3], inv, 0);
            *(u32x4*)(dst + (size_t)e * 128) = w;
            if (lane == 0) sc[e] = mx * (1.f / 127.f);
        }
    }
}

#define TK_CE(a, b) do { const unsigned _h = max((a), (b)); (b) = min((a), (b)); (a) = _h; } while (0)
#define TK_INS(L, x) do { _Pragma("unroll") for (int _j = 0; _j < 16; ++_j) { const unsigned _h = max(L[_j], x); x = min(L[_j], x); L[_j] = _h; } } while (0)
__device__ __forceinline__ void tk_sort16(unsigned (&x)[16]) { TK_CE(x[0], x[13]); TK_CE(x[1], x[12]); TK_CE(x[2], x[15]); TK_CE(x[3], x[14]); TK_CE(x[4], x[8]); TK_CE(x[5], x[6]); TK_CE(x[7], x[11]); TK_CE(x[9], x[10]); TK_CE(x[0], x[5]); TK_CE(x[1], x[7]); TK_CE(x[2], x[9]); TK_CE(x[3], x[4]); TK_CE(x[6], x[13]); TK_CE(x[8], x[14]); TK_CE(x[10], x[15]); TK_CE(x[11], x[12]); TK_CE(x[0], x[1]); TK_CE(x[2], x[3]); TK_CE(x[4], x[5]); TK_CE(x[6], x[8]); TK_CE(x[7], x[9]); TK_CE(x[10], x[11]); TK_CE(x[12], x[13]); TK_CE(x[14], x[15]); TK_CE(x[0], x[2]); TK_CE(x[1], x[3]); TK_CE(x[4], x[10]); TK_CE(x[5], x[11]); TK_CE(x[6], x[7]); TK_CE(x[8], x[9]); TK_CE(x[12], x[14]); TK_CE(x[13], x[15]); TK_CE(x[1], x[2]); TK_CE(x[3], x[12]); TK_CE(x[4], x[6]); TK_CE(x[5], x[7]); TK_CE(x[8], x[10]); TK_CE(x[9], x[11]); TK_CE(x[13], x[14]); TK_CE(x[1], x[4]); TK_CE(x[2], x[6]); TK_CE(x[5], x[8]); TK_CE(x[7], x[10]); TK_CE(x[9], x[13]); TK_CE(x[11], x[14]); TK_CE(x[2], x[4]); TK_CE(x[3], x[6]); TK_CE(x[9], x[12]); TK_CE(x[11], x[13]); TK_CE(x[3], x[5]); TK_CE(x[6], x[8]); TK_CE(x[7], x[9]); TK_CE(x[10], x[12]); TK_CE(x[3], x[4]); TK_CE(x[5], x[6]); TK_CE(x[7], x[8]); TK_CE(x[9], x[10]); TK_CE(x[11], x[12]); TK_CE(x[6], x[7]); TK_CE(x[8], x[9]); }
__device__ __forceinline__ void tk_merge16(unsigned (&R)[16], const unsigned (&S)[16]) {
#pragma unroll
    for (int i = 0; i < 16; ++i) R[i] = max(R[i], S[15 - i]);
    TK_CE(R[0], R[8]); TK_CE(R[1], R[9]); TK_CE(R[2], R[10]); TK_CE(R[3], R[11]); TK_CE(R[4], R[12]); TK_CE(R[5], R[13]); TK_CE(R[6], R[14]); TK_CE(R[7], R[15]); TK_CE(R[0], R[4]); TK_CE(R[1], R[5]); TK_CE(R[2], R[6]); TK_CE(R[3], R[7]); TK_CE(R[8], R[12]); TK_CE(R[9], R[13]); TK_CE(R[10], R[14]); TK_CE(R[11], R[15]); TK_CE(R[0], R[2]); TK_CE(R[1], R[3]); TK_CE(R[4], R[6]); TK_CE(R[5], R[7]); TK_CE(R[8], R[10]); TK_CE(R[9], R[11]); TK_CE(R[12], R[14]); TK_CE(R[13], R[15]); TK_CE(R[0], R[1]); TK_CE(R[2], R[3]); TK_CE(R[4], R[5]); TK_CE(R[6], R[7]); TK_CE(R[8], R[9]); TK_CE(R[10], R[11]); TK_CE(R[12], R[13]); TK_CE(R[14], R[15]);
}
__device__ __forceinline__ unsigned tk_ckey(float sum, unsigned payload) { const unsigned b = __float_as_uint(sum); const unsigned mono = b ^ ((unsigned)((int)b >> 31) | 0x80000000u); return (mono & 0xFFFFC000u) | payload; }
__device__ __forceinline__ void topk128(const u32x4* r, unsigned (&L)[16]) {
    u32x4 c0 = r[0], c1 = r[64];
    for (int c = 0; c < 8; ++c) {
        const u32x4 n0 = r[64 * ((2 * c + 2) & 15)], n1 = r[64 * ((2 * c + 3) & 15)];
        const unsigned kb = 0xFFFFu - 16u * (unsigned)c; unsigned x[16];
#pragma unroll
        for (int d = 0; d < 4; ++d) {
            unsigned w = c0[d]; unsigned msk = ((w >> 15) & 0x00010001u) * 0xFFFFu; w ^= (msk | 0x80008000u);
            x[2 * d] = (w << 16) | (kb - 2u * d); x[2 * d + 1] = (w & 0xFFFF0000u) | (kb - 2u * d - 1u);
            w = c1[d]; msk = ((w >> 15) & 0x00010001u) * 0xFFFFu; w ^= (msk | 0x80008000u);
            x[8 + 2 * d] = (w << 16) | (kb - 8u - 2u * d); x[8 + 2 * d + 1] = (w & 0xFFFF0000u) | (kb - 8u - 2u * d - 1u);
        }
        tk_sort16(x);
        if (c == 0) {
#pragma unroll
            for (int q = 0; q < 16; ++q) L[q] = x[q];
        } else tk_merge16(L, x);
        c0 = n0; c1 = n1;
    }
}
__device__ __forceinline__ void phase_topk(const Params& P) {
    const int gl = blockIdx.x * NTHR + threadIdx.x, nl = gridDim.x * NTHR;
    const bf16* Sc = (const bf16*)(P.ws + WS_S); int* IDS = (int*)(P.ws + WS_IDS); float* GATES = (float*)(P.ws + WS_GATES);
    for (int item = gl; item < M * 8; item += nl) {
        const u32x4* row = (const u32x4*)Sc + (size_t)((item >> 6) * 32) * 64 + (item & 63);
        unsigned L0[16], L1[16];
        topk128(row, L0); topk128(row + 16 * 64, L1);
        float f0[16], f1[16]; unsigned p0[16], p1[16];
#pragma unroll
        for (int i = 0; i < 16; ++i) {
            f0[i] = __uint_as_float((L0[i] & 0x80000000u) ? (L0[i] & 0x7FFF0000u) : (~L0[i] & 0xFFFF0000u)); p0[i] = (~L0[i] & 0x7Fu) << 7;
            f1[i] = __uint_as_float((L1[i] & 0x80000000u) ? (L1[i] & 0x7FFF0000u) : (~L1[i] & 0xFFFF0000u)); p1[i] = (~L1[i] & 0x7Fu);
        }
        unsigned C[16];
        { unsigned x[16] = {tk_ckey(f0[0] + f1[0], p0[0] | p1[0]), tk_ckey(f0[0] + f1[1], p0[0] | p1[1]), tk_ckey(f0[0] + f1[2], p0[0] | p1[2]), tk_ckey(f0[0] + f1[3], p0[0] | p1[3]), tk_ckey(f0[0] + f1[4], p0[0] | p1[4]), tk_ckey(f0[0] + f1[5], p0[0] | p1[5]), tk_ckey(f0[0] + f1[6], p0[0] | p1[6]), tk_ckey(f0[0] + f1[7], p0[0] | p1[7]), tk_ckey(f0[0] + f1[8], p0[0] | p1[8]), tk_ckey(f0[0] + f1[9], p0[0] | p1[9]), tk_ckey(f0[0] + f1[10], p0[0] | p1[10]), tk_ckey(f0[0] + f1[11], p0[0] | p1[11]), tk_ckey(f0[0] + f1[12], p0[0] | p1[12]), tk_ckey(f0[0] + f1[13], p0[0] | p1[13]), tk_ckey(f0[0] + f1[14], p0[0] | p1[14]), tk_ckey(f0[0] + f1[15], p0[0] | p1[15])};
          tk_sort16(x);
#pragma unroll
          for (int q = 0; q < 16; ++q) C[q] = x[q]; }
        { unsigned x[16] = {tk_ckey(f0[1] + f1[0], p0[1] | p1[0]), tk_ckey(f0[1] + f1[1], p0[1] | p1[1]), tk_ckey(f0[1] + f1[2], p0[1] | p1[2]), tk_ckey(f0[1] + f1[3], p0[1] | p1[3]), tk_ckey(f0[1] + f1[4], p0[1] | p1[4]), tk_ckey(f0[1] + f1[5], p0[1] | p1[5]), tk_ckey(f0[1] + f1[6], p0[1] | p1[6]), tk_ckey(f0[1] + f1[7], p0[1] | p1[7]), tk_ckey(f0[2] + f1[0], p0[2] | p1[0]), tk_ckey(f0[2] + f1[1], p0[2] | p1[1]), tk_ckey(f0[2] + f1[2], p0[2] | p1[2]), tk_ckey(f0[2] + f1[3], p0[2] | p1[3]), tk_ckey(f0[2] + f1[4], p0[2] | p1[4]), tk_ckey(f0[3] + f1[0], p0[3] | p1[0]), tk_ckey(f0[3] + f1[1], p0[3] | p1[1]), tk_ckey(f0[3] + f1[2], p0[3] | p1[2])};
          tk_sort16(x); tk_merge16(C, x); }
        { unsigned x[16] = {tk_ckey(f0[3] + f1[3], p0[3] | p1[3]), tk_ckey(f0[4] + f1[0], p0[4] | p1[0]), tk_ckey(f0[4] + f1[1], p0[4] | p1[1]), tk_ckey(f0[4] + f1[2], p0[4] | p1[2]), tk_ckey(f0[5] + f1[0], p0[5] | p1[0]), tk_ckey(f0[5] + f1[1], p0[5] | p1[1]), tk_ckey(f0[6] + f1[0], p0[6] | p1[0]), tk_ckey(f0[6] + f1[1], p0[6] | p1[1]), tk_ckey(f0[7] + f1[0], p0[7] | p1[0]), tk_ckey(f0[7] + f1[1], p0[7] | p1[1]), tk_ckey(f0[8] + f1[0], p0[8] | p1[0]), tk_ckey(f0[9] + f1[0], p0[9] | p1[0]), tk_ckey(f0[10] + f1[0], p0[10] | p1[0]), tk_ckey(f0[11] + f1[0], p0[11] | p1[0]), tk_ckey(f0[12] + f1[0], p0[12] | p1[0]), tk_ckey(f0[13] + f1[0], p0[13] | p1[0])};
          tk_sort16(x); tk_merge16(C, x); }
        { unsigned key = tk_ckey(f0[14] + f1[0], p0[14] | p1[0]); TK_INS(C, key); }
        { unsigned key = tk_ckey(f0[15] + f1[0], p0[15] | p1[0]); TK_INS(C, key); }
        float cv[16];
#pragma unroll
        for (int r = 0; r < 16; ++r) cv[r] = __uint_as_float((C[r] & 0x80000000u) ? (C[r] & 0x7FFFC000u) : (~C[r] & 0xFFFFC000u));
        const float cmax = cv[0]; float den = 0.f;
#pragma unroll
        for (int r = 0; r < 16; ++r) { cv[r] = __expf(cv[r] - cmax); den += cv[r]; }
        const float inv = 1.f / den;
        const int oi = ((((item >> 9) << 6) | (item & 63)) << 3) | ((item >> 6) & 7);
        u32x4* ido = (u32x4*)(IDS + (size_t)oi * 16); f32x4* go = (f32x4*)(GATES + (size_t)oi * 16);
#pragma unroll
        for (int q = 0; q < 4; ++q) { u32x4 o; o.x = C[4 * q] & 0x3FFFu; o.y = C[4 * q + 1] & 0x3FFFu; o.z = C[4 * q + 2] & 0x3FFFu; o.w = C[4 * q + 3] & 0x3FFFu; ido[q] = o;
            f32x4 g; g[0] = cv[4 * q] * inv; g[1] = cv[4 * q + 1] * inv; g[2] = cv[4 * q + 2] * inv; g[3] = cv[4 * q + 3] * inv; go[q] = g; }
    }
}

#define XB_TMO      128
#define XB_XCNT(j)  (256  + 64 * (j))
#define XB_XSUB(j)  (1280 + 64 * (j))
#define XB_XGEN(j)  (2304 + 64 * (j))
#define XB_TOP      3328
#define XB_TOPGEN   3392
#define XCD_BAR_WORDS 3456
#define XB_SPIN_CAP (1u << 18)
__device__ __forceinline__ unsigned xb_ld(unsigned* p)              { return __hip_atomic_load(p, __ATOMIC_RELAXED, __HIP_MEMORY_SCOPE_AGENT); }
__device__ __forceinline__ unsigned xb_add(unsigned* p, unsigned v) { return __hip_atomic_fetch_add(p, v, __ATOMIC_RELAXED, __HIP_MEMORY_SCOPE_AGENT); }
__device__ __forceinline__ unsigned xb_xcc_id() { return (unsigned)__builtin_amdgcn_s_getreg((3 << 11) | 20) & 0xFu; }
#define XB_SPIN(cond, bar) do { unsigned _sp = 0; while (cond) { __builtin_amdgcn_s_sleep(1); \
    if ((++_sp & 255u) == 0u) { if (xb_ld(&(bar)[XB_TMO])) break; if (_sp > XB_SPIN_CAP) { atomicAdd(&(bar)[XB_TMO], 1u); break; } } } } while (0)
struct XcdBarrier { unsigned* bar; unsigned x; volatile LAS unsigned* st; };
__device__ __forceinline__ XcdBarrier xcd_barrier_post(unsigned* bar, volatile LAS unsigned* st) {
    XcdBarrier b; b.bar = bar; b.x = xb_xcc_id(); b.st = st;
    if (threadIdx.x == 0) { const unsigned r = xb_add(&bar[XB_XCNT(b.x)], 1u); st[4] = r; st[5] = b.x; }
    return b;
}
__device__ __forceinline__ void xcd_barrier_complete(unsigned* bar, unsigned x, unsigned& nloc, unsigned& nx) {
    const unsigned G = gridDim.x * gridDim.y * gridDim.z;
    unsigned sum, cnt, mine, sp = 0u;
    for (;;) {
        sum = 0u; cnt = 0u; mine = 0u;
#pragma unroll
        for (unsigned j = 0; j < 16; ++j) { const unsigned c = xb_ld(&bar[XB_XCNT(j)]); sum += c; cnt += (c > 0u) ? 1u : 0u; mine = (j == x) ? c : mine; }
        if (sum == G) break;
        __builtin_amdgcn_s_sleep(1);
        if ((++sp & 255u) == 0u) { if (xb_ld(&bar[XB_TMO])) break; if (sp > XB_SPIN_CAP) { atomicAdd(&bar[XB_TMO], 1u); break; } }
    }
    nloc = mine > 0u ? mine : 1u; nx = cnt > 0u ? cnt : 1u;
}
__device__ __forceinline__ void xcd_barrier(const XcdBarrier& b) {
    asm volatile("s_waitcnt vmcnt(0)" ::: "memory");
    __syncthreads();
    if (threadIdx.x == 0) {
        unsigned* bar = b.bar;
        __builtin_amdgcn_s_waitcnt(0);
        unsigned nloc = b.st[0], nx = b.st[1];
        if (nloc == 0u) { xcd_barrier_complete(bar, b.x, nloc, nx); b.st[0] = nloc; b.st[1] = nx; }
        const unsigned old = xb_add(&bar[XB_XSUB(b.x)], 1u);
        const unsigned gen = old / nloc;
        if (old + 1u == (gen + 1u) * nloc) {
            __builtin_amdgcn_fence(__ATOMIC_RELEASE, "agent");
            asm volatile("s_waitcnt vmcnt(0)" ::: "memory");
            const unsigned og = xb_add(&bar[XB_TOP], 1u);
            const unsigned tg = og / nx;
            if (og + 1u == (tg + 1u) * nx) xb_add(&bar[XB_TOPGEN], 1u);
            else XB_SPIN(xb_ld(&bar[XB_TOPGEN]) == tg, bar);
            __builtin_amdgcn_fence(__ATOMIC_ACQUIRE, "agent");
            xb_add(&bar[XB_XGEN(b.x)], 1u);
            asm volatile("s_waitcnt vmcnt(0)" ::: "memory");
        } else {
            XB_SPIN(xb_ld(&bar[XB_XGEN(b.x)]) == gen, bar);
            __builtin_amdgcn_fence(__ATOMIC_ACQUIRE, "agent");
            asm volatile("s_waitcnt vmcnt(0)" ::: "memory");
        }
    }
    __syncthreads();
}

typedef int v8i_t __attribute__((ext_vector_type(8)));
#define PD_LO 1
struct PdTok { int idl, idh; unsigned hw; };
__device__ __forceinline__ PdTok pd_fetch(const int* IDS, const unsigned char* H8s, int m, int lane) {
    PdTok t; t.idl = IDS[(size_t)m * 128 + lane]; t.idh = IDS[(size_t)m * 128 + 64 + lane]; t.hw = *(const unsigned*)(H8s + (size_t)m * 2048); return t;
}
__device__ __forceinline__ void pd_issue(u32x4 (&X0)[8], u32x4 (&X1)[8], const PdTok& t, const unsigned char* UFs, LAS unsigned char* slot, int lane) {
#pragma unroll
    for (int g = 0; g < 8; ++g) { const unsigned id = (unsigned)__builtin_amdgcn_ds_bpermute(4 * (16 * (g & 3) + (lane >> 2)), g < 4 ? t.idl : t.idh);
        const u32x4* rp = (const u32x4*)(UFs + ((id << 7) + 16u * (unsigned)(lane & 3))); X0[g] = rp[0]; X1[g] = rp[4]; }
    *(LAS unsigned*)(slot + 4 * lane) = t.hw;
}
__device__ __forceinline__ float pd_trace(const f32x4 v) {
    const float v0 = v[0], v1 = v[1], v2 = v[2], v3 = v[3];
#define PD_BC(x, ctrl) __builtin_bit_cast(float, __builtin_amdgcn_update_dpp(0, __builtin_bit_cast(int, (x)), (ctrl), 0xf, 0xf, true))
    float s = PD_BC(v0, 0x00); s += PD_BC(v1, 0x55); s += PD_BC(v2, 0xAA); s += PD_BC(v3, 0xFF); return s;
#undef PD_BC
}
__device__ __forceinline__ void pd_compute(const u32x4 (&X0)[8], const u32x4 (&X1)[8], const LAS unsigned char* arp, unsigned* PDs, int m, int lane) {
    const int q = lane & 3;
    float dl = 0.f, dh = 0.f;
    const LAS u32x4* hp = (const LAS u32x4*)arp; const u32x4 A0 = hp[0], A1 = hp[4];
#if PD_LO
    const u32x4 A2 = hp[8], A3 = hp[12];
#endif
    const v8i_t ah = {(int)A0.x, (int)A0.y, (int)A0.z, (int)A0.w, (int)A1.x, (int)A1.y, (int)A1.z, (int)A1.w};
#if PD_LO
    const v8i_t al = {(int)A2.x, (int)A2.y, (int)A2.z, (int)A2.w, (int)A3.x, (int)A3.y, (int)A3.z, (int)A3.w};
#endif
    f32x4 acc[8];
#pragma unroll
    for (int g = 0; g < 8; ++g) { const v8i_t b = {(int)X0[g].x, (int)X0[g].y, (int)X0[g].z, (int)X0[g].w, (int)X1[g].x, (int)X1[g].y, (int)X1[g].z, (int)X1[g].w};
        acc[g] = __builtin_amdgcn_mfma_scale_f32_16x16x128_f8f6f4(ah, b, (f32x4){0.f, 0.f, 0.f, 0.f}, 0, 0, 0, 0, 0, 0); }
#if PD_LO
    __builtin_amdgcn_sched_barrier(0);
#pragma unroll
    for (int g = 0; g < 8; ++g) { const v8i_t b = {(int)X0[g].x, (int)X0[g].y, (int)X0[g].z, (int)X0[g].w, (int)X1[g].x, (int)X1[g].y, (int)X1[g].z, (int)X1[g].w};
        acc[g] = __builtin_amdgcn_mfma_scale_f32_16x16x128_f8f6f4(al, b, acc[g], 0, 0, 0, 0, 0, 0); }
#endif
    __builtin_amdgcn_sched_barrier(0);
#pragma unroll
    for (int g = 0; g < 8; ++g) { const float d = pd_trace(acc[g]);
        if (g < 4) dl = (q == g) ? d : dl; else dh = (q == g - 4) ? d : dh; }
    const int srcl = 4 * (4 * (lane & 15) + (lane >> 4));
    dl = __int_as_float(__builtin_amdgcn_ds_bpermute(srcl, __float_as_int(dl))); dh = __int_as_float(__builtin_amdgcn_ds_bpermute(srcl, __float_as_int(dh)));
    PDs[(size_t)m * 64 + lane] = pk2(dl, dh);
}
__device__ __forceinline__ void phase_peer_dots(const Params& P, LAS unsigned char* lds) {
    const int lane = threadIdx.x & 63, wave = __builtin_amdgcn_readfirstlane(threadIdx.x >> 6);
    const int* IDS = (const int*)(P.ws + WS_IDS); unsigned* PD = (unsigned*)(P.ws + WS_PD);
    volatile LAS unsigned* bst = (volatile LAS unsigned*)(lds + LDS_MISC);
    const unsigned rank = __builtin_amdgcn_readfirstlane(bst[4]), x = __builtin_amdgcn_readfirstlane(bst[5]);
    unsigned* bar = (unsigned*)(P.ws + WS_CTL);
    unsigned n = 1, xi = 0, nx = 0;
    for (unsigned j = 0; j < 16; ++j) { const unsigned cnt = __builtin_amdgcn_readfirstlane(xb_ld(&bar[XB_XCNT(j)])); if (cnt) { if (j < x) ++xi; ++nx; } if (j == x) n = cnt; }
    if (nx == 0) nx = 1; if (n == 0) n = 1;
    constexpr int NCW = NWAVES - 1;
    const int stride = (int)n * NCW; const bool arow = ((lane >> 2) & 3) == (lane >> 4);
    LAS unsigned char* slot0 = lds + wave * 512; LAS unsigned char* slot1 = slot0 + 256; LAS unsigned char* zer = lds + NWAVES * 512;
    volatile LAS unsigned* prog = (volatile LAS unsigned*)(zer + 256);
    __syncthreads();
    if (threadIdx.x < 80) ((LAS unsigned*)zer)[threadIdx.x] = 0u;
    __syncthreads();
    if (wave == NCW) {
        constexpr unsigned AHEAD = 600;
        unsigned base = 0;
        for (unsigned s = xi; s < 8; s += nx) {
            const int r7 = (int)rank * NCW; unsigned total = 0;
            for (int w = 0; w < NCW; ++w) { const int m0 = r7 + w; total += (m0 < M) ? (unsigned)((M - m0 + stride - 1) / stride) : 0u; }
            const int tk = lane / 6, ln = lane - 6 * tk;
            for (unsigned done = 0; done < total; ) {
                if (done + base < *prog + AHEAD) {
                    const unsigned char* pa[4];
#pragma unroll
                    for (int k = 0; k < 4; ++k) { unsigned j = done + 10u * k + (unsigned)(tk < 10 ? tk : 9); if (j >= total) j = total - 1;
                        const int i = (int)(j / NCW), w = (int)(j - (unsigned)i * NCW); int m = r7 + w + i * stride; if (m >= M) m = r7;
                        pa[k] = (ln < 4) ? (const unsigned char*)IDS + (size_t)m * 512 + 128 * ln : P.ws + WS_H8 + (size_t)m * 2048 + 128 * s + 1024 * (ln - 4); }
                    unsigned d0, d1, d2, d3;
                    asm volatile("global_load_dword %0, %4, off\n\tglobal_load_dword %1, %5, off\n\tglobal_load_dword %2, %6, off\n\tglobal_load_dword %3, %7, off\n\ts_waitcnt vmcnt(0)"
                                 : "=&v"(d0), "=&v"(d1), "=&v"(d2), "=&v"(d3) : "v"(pa[0]), "v"(pa[1]), "v"(pa[2]), "v"(pa[3]) : "memory");
                    done += 40;
                } else __builtin_amdgcn_s_sleep(4);
            }
            base += total;
        }
        return;
    }
    const LAS unsigned char* ar0 = arow ? slot0 + 16 * (lane & 3) : zer; const LAS unsigned char* ar1 = arow ? slot1 + 16 * (lane & 3) : zer;
    for (unsigned s = xi; s < 8; s += nx) {
        const unsigned char* UFs = P.ws + WS_UF + (size_t)s * UF_SLICE;
        const unsigned char* H8s = P.ws + WS_H8 + 128 * s + (lane < 32 ? 4 * lane : 1024 + 4 * (lane - 32)); unsigned* PDs = PD + (size_t)s * M * 64;
        const int m0 = (int)rank * NCW + wave;
        if (m0 >= M) continue;
        const int cnt = (M - m0 + stride - 1) / stride;
#define PD_TOK(i) ((i) < cnt ? m0 + (i) * stride : m0)
        u32x4 RA4[8], RB4[8], RA2[8], RB2[8];
        PdTok t0 = pd_fetch(IDS, H8s, m0, lane), t1 = pd_fetch(IDS, H8s, PD_TOK(1), lane), t2 = pd_fetch(IDS, H8s, PD_TOK(2), lane);
        pd_issue(RA4, RA2, t0, UFs, slot0, lane);
        for (int i = 0; i < cnt; i += 2) {
            const int ma = PD_TOK(i), mb = PD_TOK(i + 1);
            const PdTok t3 = pd_fetch(IDS, H8s, PD_TOK(i + 3), lane);
            pd_issue(RB4, RB2, t1, UFs, slot1, lane);
            __builtin_amdgcn_sched_barrier(0);
            pd_compute(RA4, RA2, ar0, PDs, ma, lane);
            if (lane == 0) __hip_atomic_fetch_add((LAS unsigned*)prog, 1u, __ATOMIC_RELAXED, __HIP_MEMORY_SCOPE_WORKGROUP);
            __builtin_amdgcn_sched_barrier(0);
            const PdTok t4 = pd_fetch(IDS, H8s, PD_TOK(i + 4), lane);
            pd_issue(RA4, RA2, t2, UFs, slot0, lane);
            __builtin_amdgcn_sched_barrier(0);
            pd_compute(RB4, RB2, ar1, PDs, mb, lane);
            if (lane == 0 && i + 1 < cnt) __hip_atomic_fetch_add((LAS unsigned*)prog, 1u, __ATOMIC_RELAXED, __HIP_MEMORY_SCOPE_WORKGROUP);
            __builtin_amdgcn_sched_barrier(0);
            t1 = t3; t2 = t4;
        }
#undef PD_TOK
    }
}

__device__ __forceinline__ void phase_peer_coef(const Params& P) {
    const int lane = threadIdx.x & 63, wave = threadIdx.x >> 6; const int gw = blockIdx.x * NWAVES + wave, ngw = gridDim.x * NWAVES;
    const int* IDS = (const int*)(P.ws + WS_IDS); const float* GATES = (const float*)(P.ws + WS_GATES); const unsigned* PD = (const unsigned*)(P.ws + WS_PD);
    const float* SU = (const float*)(P.ws + WS_SU); const float* SV = (const float*)(P.ws + WS_SV);
    unsigned char* CQ = P.ws + WS_CQ; float* CS = (float*)(P.ws + WS_CS);
    constexpr int TB = 4;
    for (int mb = gw; mb < M; mb += TB * ngw) {
        int id_lo[TB], id_hi[TB]; float gt_lo[TB], gt_hi[TB], d_lo[TB], d_hi[TB], su_lo[TB], su_hi[TB], sv_lo[TB], sv_hi[TB];
#pragma unroll
        for (int t = 0; t < TB; ++t) { const int m = (mb + t * ngw < M) ? mb + t * ngw : mb;
            id_lo[t] = IDS[(size_t)m * 128 + lane]; id_hi[t] = IDS[(size_t)m * 128 + 64 + lane]; gt_lo[t] = GATES[(size_t)m * 128 + lane]; gt_hi[t] = GATES[(size_t)m * 128 + 64 + lane]; }
#pragma unroll
        for (int t = 0; t < TB; ++t) { const int m = (mb + t * ngw < M) ? mb + t * ngw : mb; float a = 0.f, b = 0.f;
#pragma unroll
            for (int s = 0; s < 8; ++s) { const unsigned w = PD[((size_t)s * M + m) * 64 + lane]; a += __uint_as_float(w << 16); b += __uint_as_float(w & 0xffff0000u); }
            d_lo[t] = a; d_hi[t] = b; }
#pragma unroll
        for (int t = 0; t < TB; ++t) { su_lo[t] = SU[id_lo[t]]; su_hi[t] = SU[id_hi[t]]; sv_lo[t] = SV[id_lo[t]]; sv_hi[t] = SV[id_hi[t]]; }
#pragma unroll
        for (int t = 0; t < TB; ++t) { const int m = (mb + t * ngw < M) ? mb + t * ngw : mb;
            const float x_lo = d_lo[t] * su_lo[t], x_hi = d_hi[t] * su_hi[t];
            const float a_lo = 0.5f * x_lo * (1.f + erff(x_lo * 0.70710678118f)) * gt_lo[t] * sv_lo[t], a_hi = 0.5f * x_hi * (1.f + erff(x_hi * 0.70710678118f)) * gt_hi[t] * sv_hi[t];
            const float amx = wave_max_u(fmaxf(fabsf(a_lo), fabsf(a_hi))); const float ainv = amx > 0.f ? 127.f / amx : 0.f;
            const int q_lo = __float2int_rn(a_lo * ainv), q_hi = __float2int_rn(a_hi * ainv);
            const int j0 = lane, j1 = 64 + lane;
            CQ[(size_t)m * 128 + 16 * ((j0 >> 2) & 7) + 4 * (j0 >> 5) + (j0 & 3)] = (unsigned char)q_lo;
            CQ[(size_t)m * 128 + 16 * ((j1 >> 2) & 7) + 4 * (j1 >> 5) + (j1 & 3)] = (unsigned char)q_hi;
            if (lane == 0) CS[m] = amx * (1.f / 127.f); }
    }
}

struct AxTok { u32x4 id[4]; u32x4 cq; float cs; unsigned hw; };
__device__ __forceinline__ void ax_fetch(AxTok& t, const int* IDS, const unsigned char* CQ, const float* CS, const bf16* H1s, int m, int lane) {
    const u32x4* ip = (const u32x4*)(IDS + (size_t)m * 128) + (lane >> 3);
#pragma unroll
    for (int r = 0; r < 4; ++r) t.id[r] = ip[8 * r];
    t.cq = *((const u32x4*)(CQ + (size_t)m * 128) + (lane >> 3)); t.cs = CS[m]; t.hw = *(const unsigned*)(H1s + (size_t)m * D);
}
__device__ __forceinline__ void ax_issue(u32x4 (&W)[4], const u32x4 ids, const unsigned char* V8s, int lane) {
#pragma unroll
    for (int k = 0; k < 4; ++k) W[k] = *(const u32x4*)(V8s + ((ids[k] << 7) + 16u * (unsigned)(lane & 7)));
}
__device__ __forceinline__ void ax_round(const u32x4 (&W)[4], int c4, int (&acc)[16]) {
#pragma unroll
    for (int i = 0; i < 4; ++i) {
        const unsigned t0 = __builtin_amdgcn_perm(W[1][i], W[0][i], 0x05010400u), t1 = __builtin_amdgcn_perm(W[1][i], W[0][i], 0x07030602u);
        const unsigned t2 = __builtin_amdgcn_perm(W[3][i], W[2][i], 0x05010400u), t3 = __builtin_amdgcn_perm(W[3][i], W[2][i], 0x07030602u);
        const unsigned T0 = __builtin_amdgcn_perm(t2, t0, 0x05040100u), T1 = __builtin_amdgcn_perm(t2, t0, 0x07060302u), T2 = __builtin_amdgcn_perm(t3, t1, 0x05040100u), T3 = __builtin_amdgcn_perm(t3, t1, 0x07060302u);
        acc[4 * i] = __builtin_amdgcn_sdot4((int)T0, c4, acc[4 * i], false); acc[4 * i + 1] = __builtin_amdgcn_sdot4((int)T1, c4, acc[4 * i + 1], false);
        acc[4 * i + 2] = __builtin_amdgcn_sdot4((int)T2, c4, acc[4 * i + 2], false); acc[4 * i + 3] = __builtin_amdgcn_sdot4((int)T3, c4, acc[4 * i + 3], false); }
}
__device__ __forceinline__ void ax_finish(int (&acc)[16], float cs, unsigned hw, bf16* ZPs, int m, int lane) {
    const bool b3 = (lane & 8) != 0, b4 = (lane & 16) != 0, b5 = (lane & 32) != 0;
    int w8[8], w4[4], w2[2];
#pragma unroll
    for (int i = 0; i < 8; ++i) { const int keep = b3 ? acc[i + 8] : acc[i], send = b3 ? acc[i] : acc[i + 8]; w8[i] = keep + DPP_I(send, 0x128); }
#pragma unroll
    for (int i = 0; i < 4; ++i) { const int keep = b4 ? w8[i + 4] : w8[i], send = b4 ? w8[i] : w8[i + 4]; w4[i] = keep + __builtin_amdgcn_ds_swizzle(send, 0x401F); }
#pragma unroll
    for (int i = 0; i < 2; ++i) { const int keep = b5 ? w4[i + 2] : w4[i], send = b5 ? w4[i] : w4[i + 2]; w2[i] = keep + __shfl_xor(send, 32); }
    const float z0 = ALPHA * __uint_as_float(hw << 16) + cs * (float)w2[0], z1 = ALPHA * __uint_as_float(hw & 0xffff0000u) + cs * (float)w2[1];
    const int d0 = 16 * (lane & 7) + (b3 ? 8 : 0) + (b4 ? 4 : 0) + (b5 ? 2 : 0);
    *(unsigned*)(ZPs + (size_t)m * D + d0) = pk2(z0, z1);
}
__device__ __forceinline__ void phase_peer_axpy(const Params& P, LAS unsigned char* lds) {
    const int lane = threadIdx.x & 63, wave = __builtin_amdgcn_readfirstlane(threadIdx.x >> 6);
    const int* IDS = (const int*)(P.ws + WS_IDS); const unsigned char* CQ = P.ws + WS_CQ; const float* CS = (const float*)(P.ws + WS_CS);
    volatile LAS unsigned* bst = (volatile LAS unsigned*)(lds + LDS_MISC);
    const unsigned rank = __builtin_amdgcn_readfirstlane(bst[4]), x = __builtin_amdgcn_readfirstlane(bst[5]);
    unsigned* bar = (unsigned*)(P.ws + WS_CTL);
    unsigned n = 1, xi = 0, nx = 0;
    for (unsigned j = 0; j < 16; ++j) { const unsigned cnt = __builtin_amdgcn_readfirstlane(xb_ld(&bar[XB_XCNT(j)])); if (cnt) { if (j < x) ++xi; ++nx; } if (j == x) n = cnt; }
    if (nx == 0) nx = 1; if (n == 0) n = 1;
    constexpr int NCW = NWAVES - 1;
    const int stride = (int)n * NCW;
    volatile LAS unsigned* prog = (volatile LAS unsigned*)lds;
    __syncthreads();
    if (threadIdx.x == 0) *prog = 0u;
    __syncthreads();
    if (wave == NCW) {
        constexpr unsigned AHEAD = 600;
        unsigned base = 0;
        for (unsigned s = xi; s < 8; s += nx) {
            const int r7 = (int)rank * NCW; unsigned total = 0;
            for (int w = 0; w < NCW; ++w) { const int m0 = r7 + w; total += (m0 < M) ? (unsigned)((M - m0 + stride - 1) / stride) : 0u; }
            const int tk = lane >> 3, ln = lane & 7;
            for (unsigned done = 0; done < total; ) {
                if (done + base < *prog + AHEAD) {
                    const unsigned char* pa[4];
#pragma unroll
                    for (int k = 0; k < 4; ++k) { unsigned j = done + 8u * k + (unsigned)tk; if (j >= total) j = total - 1;
                        const int i = (int)(j / NCW), w = (int)(j - (unsigned)i * NCW); int m = r7 + w + i * stride; if (m >= M) m = r7;
                        pa[k] = (ln < 4) ? (const unsigned char*)IDS + (size_t)m * 512 + 128 * ln : (ln == 4) ? CQ + (size_t)m * 128 : (ln < 7) ? P.ws + WS_H1 + (size_t)m * 2048 + 256 * s + 128 * (ln - 5) : (const unsigned char*)(CS + m); }
                    unsigned d0, d1, d2, d3;
                    asm volatile("global_load_dword %0, %4, off\n\tglobal_load_dword %1, %5, off\n\tglobal_load_dword %2, %6, off\n\tglobal_load_dword %3, %7, off\n\ts_waitcnt vmcnt(0)"
                                 : "=&v"(d0), "=&v"(d1), "=&v"(d2), "=&v"(d3) : "v"(pa[0]), "v"(pa[1]), "v"(pa[2]), "v"(pa[3]) : "memory");
                    done += 32;
                } else __builtin_amdgcn_s_sleep(4);
            }
            base += total;
        }
        return;
    }
    const int dsel = 16 * (lane & 7) + ((lane & 8) ? 8 : 0) + ((lane & 16) ? 4 : 0) + ((lane & 32) ? 2 : 0);
    for (unsigned s = xi; s < 8; s += nx) {
        const unsigned char* V8s = P.ws + WS_V8 + (size_t)s * V8_SLICE;
        const bf16* H1s = (const bf16*)(P.ws + WS_H1) + 128 * s + dsel; bf16* ZPs = (bf16*)(P.ws + WS_ZP) + 128 * s;
        const int m0 = (int)rank * NCW + wave;
        if (m0 >= M) continue;
        const int cnt = (M - m0 + stride - 1) / stride;
#define AX_TOK(i) ((i) < cnt ? m0 + (i) * stride : m0)
        u32x4 W0[4], W1[4], W2[4], W3[4];
        AxTok ta, tb, tc; ax_fetch(ta, IDS, CQ, CS, H1s, m0, lane); ax_fetch(tb, IDS, CQ, CS, H1s, AX_TOK(1), lane);
        ax_issue(W0, ta.id[0], V8s, lane); ax_issue(W1, ta.id[1], V8s, lane); ax_issue(W2, ta.id[2], V8s, lane);
#define AX_STEP(CUR, NXT, FRE, ii) do { \
            const int ma_ = AX_TOK(ii); \
            ax_fetch(FRE, IDS, CQ, CS, H1s, AX_TOK((ii) + 2), lane); \
            int acc[16]; \
            _Pragma("unroll") for (int j = 0; j < 16; ++j) acc[j] = 0; \
            ax_issue(W3, CUR.id[3], V8s, lane); __builtin_amdgcn_sched_barrier(0); ax_round(W0, (int)CUR.cq[0], acc); __builtin_amdgcn_sched_barrier(0); \
            ax_issue(W0, NXT.id[0], V8s, lane); __builtin_amdgcn_sched_barrier(0); ax_round(W1, (int)CUR.cq[1], acc); __builtin_amdgcn_sched_barrier(0); \
            ax_issue(W1, NXT.id[1], V8s, lane); __builtin_amdgcn_sched_barrier(0); ax_round(W2, (int)CUR.cq[2], acc); __builtin_amdgcn_sched_barrier(0); \
            ax_issue(W2, NXT.id[2], V8s, lane); __builtin_amdgcn_sched_barrier(0); ax_round(W3, (int)CUR.cq[3], acc); __builtin_amdgcn_sched_barrier(0); \
            ax_finish(acc, CUR.cs, CUR.hw, ZPs, ma_, lane); \
            if (lane == 0 && (ii) < cnt) __hip_atomic_fetch_add((LAS unsigned*)prog, 1u, __ATOMIC_RELAXED, __HIP_MEMORY_SCOPE_WORKGROUP); } while (0)
        for (int i = 0; i < cnt; i += 3) { AX_STEP(ta, tb, tc, i); AX_STEP(tb, tc, ta, i + 1); AX_STEP(tc, ta, tb, i + 2); }
#undef AX_STEP
#undef AX_TOK
    }
}

__device__ __forceinline__ void phase_ln2(const Params& P) {
    const int lane = threadIdx.x & 63, wave = threadIdx.x >> 6; const int gw = blockIdx.x * NWAVES + wave, ngw = gridDim.x * NWAVES;
    const float* g2 = P.in[26]; const float* b2 = P.in[27]; const bf16* ZP = (const bf16*)(P.ws + WS_ZP);
    for (int m = gw; m < M; m += ngw) {
        const u32x4* xr = (const u32x4*)(ZP + (size_t)m * D) + 2 * lane; const u32x4 a = xr[0], c = xr[1]; float v[16]; float s = 0.f;
#pragma unroll
        for (int i = 0; i < 4; ++i) { v[2 * i] = __uint_as_float(a[i] << 16); v[2 * i + 1] = __uint_as_float(a[i] & 0xffff0000u); v[8 + 2 * i] = __uint_as_float(c[i] << 16); v[8 + 2 * i + 1] = __uint_as_float(c[i] & 0xffff0000u); }
#pragma unroll
        for (int i = 0; i < 16; ++i) s += v[i];
        const float mean = wave_sum(s) * (1.f / D); float s2 = 0.f;
#pragma unroll
        for (int i = 0; i < 16; ++i) { v[i] -= mean; s2 += v[i] * v[i]; }
        const float rstd = 1.f / sqrtf(wave_sum(s2) * (1.f / D) + LN_EPS);
#pragma unroll
        for (int c4 = 0; c4 < 4; ++c4) { const int e0 = 16 * lane + 4 * c4; const f32x4 gg = *(const f32x4*)(g2 + e0), bb = *(const f32x4*)(b2 + e0); f32x4 o;
#pragma unroll
            for (int j = 0; j < 4; ++j) o[j] = v[c4 * 4 + j] * rstd * gg[j] + bb[j];
            *(f32x4*)(P.out + (size_t)m * D + e0) = o; }
    }
}

constexpr int N_PHASES = 14;
__global__ void __launch_bounds__(NTHR, 2) fwd_kernel(Params P) {
    extern __shared__ __attribute__((aligned(16))) unsigned char lds_raw[];
    LAS unsigned char* lds = (LAS unsigned char*)lds_raw;
    cg::grid_group grid = cg::this_grid();
    const int lo = P.ph_lo, hi = P.ph_hi;
    unsigned char* ws = P.ws;
    volatile LAS unsigned* bst = (volatile LAS unsigned*)(lds + LDS_MISC);
    if (threadIdx.x < 16) bst[threadIdx.x] = 0u;
    __syncthreads();
    const XcdBarrier bar = xcd_barrier_post((unsigned*)(ws + WS_CTL), bst);
#define IN(k) (lo <= (k) && (k) < hi)
#define SEAM(k) do { if (IN(k) && IN((k) + 1)) { if ((k) == 0) grid.sync(); else xcd_barrier(bar); } } while (0)
    if (IN(0)) phase_prologue(P, lds);
    SEAM(0);
    if (IN(1)) {
        pg8::Gemm g{(const bf16*)(ws + WS_H0), (const bf16*)(ws + WS_WIN), M, NP, D, D, D, 0}; pg8::StaticOrder S; S.init(M, NP, gridDim.x, blockIdx.x);
        pg8::EpiBf16 E{(bf16*)(ws + WS_P), NP};
        pg8::gemm_phase<pg8::EpiBf16, pg8::StaticOrder, true, true>(lds, g, S, E);
    }
    SEAM(1);
    if (IN(2)) phase_prep(P, lds);
    SEAM(2);
    if (IN(3)) phase_scan(P, lds);
    SEAM(3);
    if (IN(4)) phase_fixup(P, lds);
    SEAM(4);
    if (IN(5)) phase_correct(P, lds);
    SEAM(5);
    if (IN(6)) {
        pg8::Gemm g{(const bf16*)P.out, (const bf16*)(ws + WS_WOUT), M, D, D, D, D, 0}; pg8::StaticOrder S; S.init(M, D, gridDim.x, blockIdx.x);
        pg8::EpiResBf16 E{(bf16*)(ws + WS_Z), (const bf16*)(ws + WS_H0), D, ALPHA};
        pg8::gemm_phase<pg8::EpiResBf16, pg8::StaticOrder, true, true>(lds, g, S, E);
    }
    SEAM(6);
    if (IN(7)) phase_ln1(P);
    SEAM(7);
    if (IN(8)) {
        pg8::Gemm g{(const bf16*)(ws + WS_H1), (const bf16*)(ws + WS_WQ), M, NQ, D, D, D, 0}; pg8::StaticOrder S; S.init(M, NQ, gridDim.x, blockIdx.x);
        pg8::EpiScores E{(bf16*)(ws + WS_S)};
        pg8::gemm_phase<pg8::EpiScores, pg8::StaticOrder, true, true>(lds, g, S, E);
    }
    SEAM(8);
    if (IN(9)) phase_topk(P);
    SEAM(9);
    if (IN(10)) phase_peer_dots(P, lds);
    SEAM(10);
    if (IN(11)) phase_peer_coef(P);
    SEAM(11);
    if (IN(12)) phase_peer_axpy(P, lds);
    SEAM(12);
    if (IN(13)) phase_ln2(P);
#undef IN
#undef SEAM
}

extern "C" void kernel_launch(void* const* d_in, const int* in_sizes, int n_in, void* d_out, int out_size, void* d_ws, size_t ws_size, hipStream_t stream) {
    static int grid = 0;
    if (grid == 0) {
        if (n_in != 28 || out_size != M * D || ws_size < WS_END) { fprintf(stderr, "kernel_launch: unexpected shapes (n_in %d out %d ws %zu)\n", n_in, out_size, ws_size); grid = -1; return; }
        int dev = 0, cus = 0, per_cu = 0;
        (void)hipGetDevice(&dev); (void)hipDeviceGetAttribute(&cus, hipDeviceAttributeMultiprocessorCount, dev);
        (void)hipFuncSetAttribute((const void*)fwd_kernel, hipFuncAttributeMaxDynamicSharedMemorySize, LDS_BYTES);
        (void)hipOccupancyMaxActiveBlocksPerMultiprocessor(&per_cu, (const void*)fwd_kernel, NTHR, LDS_BYTES);
        if (per_cu < 1) { fprintf(stderr, "kernel_launch: occupancy query says %d blocks per CU\n", per_cu); per_cu = 1; }
        (void)hipGetLastError();
        grid = cus;
    }
    if (grid < 0) return;
    Params p{};
    for (int i = 0; i < 28; ++i) p.in[i] = (const float*)d_in[i];
    p.out = (float*)d_out; p.ws = (unsigned char*)d_ws;
    (void)hipMemsetAsync((char*)d_ws + WS_CTL, 0, CTL_BYTES, stream);
    p.ph_lo = 0; p.ph_hi = N_PHASES;
    void* args[] = {&p};
    hipError_t e = hipLaunchCooperativeKernel((const void*)fwd_kernel, dim3(grid), dim3(NTHR), args, LDS_BYTES, stream);
    if (e != hipSuccess) fprintf(stderr, "cooperative launch failed: %s (grid %d)\n", hipGetErrorString(e), grid);
}
```
